# Optimizing an MI355X kernel written in HIP

```python
import jax, jax.numpy as jnp
from jax import lax
import numpy as np

D_MODEL = 1024
BATCH = 1
SEQ = 16384
DEPTH = 2

RWKV_HEADS = 8
RWKV_HEAD_DIM = 64
RWKV_WIDTH = RWKV_HEADS * RWKV_HEAD_DIM
DECAY_LORA = 64
AAA_LORA = 64
MV_LORA = 32
GATE_LORA = 128
GN_EPS = 64e-5
SG_GROUPS = 8
SG_GROUP_DIM = 64
SG_WIDTH = SG_GROUPS * SG_GROUP_DIM
SG_CHUNK = 128
RWKV_COLS = 3 * RWKV_WIDTH + DECAY_LORA + AAA_LORA + GATE_LORA
SG_COLS = 2 * SG_WIDTH
GATE_COLS = 2 * D_MODEL
IN_COLS = RWKV_COLS + SG_COLS + GATE_COLS
N_EXPERTS = 16
N_EXPERT_GROUPS = 4
EXPERTS_PER_GROUP = N_EXPERTS // N_EXPERT_GROUPS
TOP_K = 2
D_FF_EXPERT = 512
MOE_BLOCK = 128
LN_EPS = 1e-5
DEEPNORM_ALPHA = (2 * DEPTH) ** 0.25
DEEPNORM_BETA = (8 * DEPTH) ** -0.25

kernel_name = 'hybrid_rwkv7_spatialgate_grouped_moe_deepnorm'


def _ln(x, eps=LN_EPS):
    xf = x.astype(jnp.float32)
    mu = jnp.mean(xf, -1, keepdims=True)
    var = jnp.mean(jnp.square(xf - mu), -1, keepdims=True)
    return (xf - mu) * lax.rsqrt(var + eps)


def layer_norm(x, g, b, eps=LN_EPS):
    return (_ln(x, eps) * g + b).astype(x.dtype)


def token_shift(z, mu):
    prev = jnp.pad(z[:, :-1], ((0, 0), (1, 0), (0, 0)))
    return z + (prev - z) * mu


def wkv7_scan(r, w, k, v, a, b):
    B, T, H, N = r.shape
    seq = tuple(jnp.moveaxis(t.astype(jnp.float32), 1, 0) for t in (r, w, k, v, a, b))

    def step(S, inp):
        r_t, w_t, k_t, v_t, a_t, b_t = inp
        sa = jnp.einsum('bhvk,bhk->bhv', S, a_t)
        S = S * w_t[:, :, None, :] + sa[..., None] * b_t[:, :, None, :] + v_t[..., None] * k_t[:, :, None, :]
        return S, jnp.einsum('bhvk,bhk->bhv', S, r_t)

    S0 = jnp.zeros((B, H, N, N), jnp.float32)
    _, y = lax.scan(step, S0, seq)
    return jnp.moveaxis(y, 0, 1)


def rwkv7_branch(z, v_first, vmix, mu, w0, w2, a0, a2, g2, k_k, k_a, r_k, gn_g, gn_b):
    B, T, _ = z.shape
    H, N, W = RWKV_HEADS, RWKV_HEAD_DIM, RWKV_WIDTH
    z = token_shift(z, mu)
    o_w = 3 * W
    o_a = o_w + DECAY_LORA
    o_g = o_a + AAA_LORA
    r = z[..., :W]
    k = z[..., W:2 * W]
    v = z[..., 2 * W:3 * W]
    zw = z[..., o_w:o_a]
    za = z[..., o_a:o_g]
    zg = z[..., o_g:]
    w_log = -jax.nn.softplus(-(w0 + jnp.tanh(zw) @ w2)) - 0.5
    decay = jnp.exp(-jnp.exp(w_log.astype(jnp.float32)))
    a = jax.nn.sigmoid(a0 + za @ a2)
    g = jax.nn.sigmoid(zg) @ g2
    if vmix is None:
        v_first = v
    else:
        vm0, vm1, vm2 = vmix
        v = v + (v_first - v) * jax.nn.sigmoid(vm0 + (v @ vm1) @ vm2)
    heads = lambda t: t.reshape(B, T, H, N)
    kk = heads(k * k_k).astype(jnp.float32)
    kk = kk / jnp.maximum(jnp.sqrt(jnp.sum(kk * kk, -1, keepdims=True)), 1e-12)
    k = k * (1 + (a - 1) * k_a)
    rh, kh, vh, ah = heads(r), heads(k), heads(v), heads(a)
    y = wkv7_scan(rh, heads(decay), kh, vh, -kk, kk * ah.astype(jnp.float32))
    y = _ln(y, GN_EPS) * gn_g.reshape(H, N) + gn_b.reshape(H, N)
    y = y + jnp.sum(rh * kh * r_k, -1, keepdims=True) * vh
    return (y.reshape(B, T, W) * g).astype(z.dtype), v_first


def spatial_gating_branch(z, ln_g, ln_b, w_s, b_s):
    B, T, _ = z.shape
    z = jax.nn.gelu(z)
    u, v = z[..., :SG_WIDTH], z[..., SG_WIDTH:]
    v = layer_norm(v, ln_g, ln_b)
    v = v.reshape(B, T // SG_CHUNK, SG_CHUNK, SG_GROUPS, SG_GROUP_DIM)
    causal = jnp.tril(jnp.ones((SG_CHUNK, SG_CHUNK), bool))
    w_m = jnp.where(causal, w_s, 0.0)
    s = jnp.einsum('gts,bnsgd->bntgd', w_m, v) + b_s.T[:, :, None]
    return u * s.reshape(B, T, SG_WIDTH)


def group_limited_route(h, router_w, router_b):
    scores = jax.nn.sigmoid((h @ router_w).astype(jnp.float32))
    sel = (scores + router_b.astype(jnp.float32)).reshape(-1, N_EXPERT_GROUPS, EXPERTS_PER_GROUP)
    group_score = jnp.sum(lax.top_k(sel, TOP_K)[0], -1)
    best = jnp.argmax(group_score, -1)
    in_group = jnp.arange(N_EXPERT_GROUPS)[None, :] == best[:, None]
    masked = jnp.where(in_group[..., None], sel, -jnp.inf).reshape(-1, N_EXPERTS)
    _, idx = lax.top_k(masked, TOP_K)
    wts = jnp.take_along_axis(scores, idx, -1)
    wts = wts / jnp.sum(wts, -1, keepdims=True)
    return idx, wts


def moe_ffn(h, router_w, router_b, e_gate, e_up, e_down):
    B, T, D = h.shape
    hf = h.reshape(-1, D)
    N = hf.shape[0]
    idx, wts = group_limited_route(hf, router_w, router_b)
    A = N * TOP_K
    flat_e = idx.reshape(-1)
    flat_tok = jnp.repeat(jnp.arange(N, dtype=jnp.int32), TOP_K)
    flat_w = wts.reshape(-1)
    order = jnp.argsort(flat_e)
    e_sorted = flat_e[order]
    counts = jnp.bincount(flat_e, length=N_EXPERTS)
    padded = (counts + MOE_BLOCK - 1) // MOE_BLOCK * MOE_BLOCK
    pad_end = jnp.cumsum(padded)
    pad_start = pad_end - padded
    start = jnp.cumsum(counts) - counts
    dest = pad_start[e_sorted] + jnp.arange(A) - start[e_sorted]
    n_blocks = -(-A // MOE_BLOCK) + N_EXPERTS
    P = n_blocks * MOE_BLOCK
    slot_tok = jnp.zeros((P,), jnp.int32).at[dest].set(flat_tok[order])
    slot_w = jnp.zeros((P,), jnp.float32).at[dest].set(flat_w[order])
    block_expert = jnp.minimum(jnp.searchsorted(pad_end, jnp.arange(n_blocks) * MOE_BLOCK, side='right'), N_EXPERTS - 1)
    xb = hf[slot_tok].reshape(n_blocks, MOE_BLOCK, D)

    def expert_block(args):
        xblk, e = args
        hid = jax.nn.silu(xblk @ e_gate[e]) * (xblk @ e_up[e])
        return hid @ e_down[e]

    yb = lax.map(expert_block, (xb, block_expert)).reshape(P, D)
    y = jax.ops.segment_sum(yb * slot_w[:, None].astype(yb.dtype), slot_tok, num_segments=N)
    return y.reshape(B, T, D)


def setup_inputs(seed: int = 0) -> dict:
    key = jax.random.key(seed)
    ks = iter(jax.random.split(key, 40))

    def nrm(shape, scale):
        return jax.random.normal(next(ks), shape, jnp.float32) * scale

    def unif(shape, lo, hi):
        return jax.random.uniform(next(ks), shape, jnp.float32, lo, hi)

    L, D, W, S = DEPTH, D_MODEL, RWKV_WIDTH, SG_WIDTH
    return {
        'x': nrm((BATCH, SEQ, D), 1.0),
        'c': nrm((BATCH, D), 1.0),
        'w_mod': nrm((L, D, 6 * D), 0.5 * D ** -0.5),
        'b_mod': nrm((L, 6 * D), 0.01),
        'w_in': nrm((L, D, IN_COLS), D ** -0.5),
        'rwkv_mu': unif((L, RWKV_COLS), 0.0, 1.0),
        'w0': unif((L, W), -5.0, 0.0),
        'w2': nrm((L, DECAY_LORA, W), 0.5 * DECAY_LORA ** -0.5),
        'a0': nrm((L, W), 0.1),
        'a2': nrm((L, AAA_LORA, W), AAA_LORA ** -0.5),
        'g2': nrm((L, GATE_LORA, W), GATE_LORA ** -0.5),
        'k_k': 0.85 + nrm((L, W), 0.05),
        'k_a': 1.0 + nrm((L, W), 0.05),
        'r_k': nrm((L, RWKV_HEADS, RWKV_HEAD_DIM), 0.1),
        'gn_g': 1.0 + nrm((L, W), 0.05),
        'gn_b': nrm((L, W), 0.01),
        'vm0': nrm((L - 1, W), 0.1),
        'vm1': nrm((L - 1, W, MV_LORA), W ** -0.5),
        'vm2': nrm((L - 1, MV_LORA, W), MV_LORA ** -0.5),
        'sg_ln_g': 1.0 + nrm((L, S), 0.05),
        'sg_ln_b': nrm((L, S), 0.01),
        'w_s': nrm((L, SG_GROUPS, SG_CHUNK, SG_CHUNK), SG_CHUNK ** -0.5),
        'b_s': 1.0 + nrm((L, SG_GROUPS, SG_CHUNK), 0.05),
        'w_branch_a': nrm((L, W, D), W ** -0.5),
        'w_branch_b': nrm((L, S, D), S ** -0.5),
        'w_out': nrm((L, D, D), DEEPNORM_BETA * D ** -0.5),
        'ln1_g': 1.0 + nrm((L, D), 0.05),
        'ln1_b': nrm((L, D), 0.01),
        'router_w': nrm((D, N_EXPERTS), D ** -0.5),
        'router_b': nrm((N_EXPERTS,), 0.01),
        'e_gate': nrm((L, N_EXPERTS, D, D_FF_EXPERT), D ** -0.5),
        'e_up': nrm((L, N_EXPERTS, D, D_FF_EXPERT), D ** -0.5),
        'e_down': nrm((L, N_EXPERTS, D_FF_EXPERT, D), DEEPNORM_BETA * D_FF_EXPERT ** -0.5),
        'ln2_g': 1.0 + nrm((L, D), 0.05),
        'ln2_b': nrm((L, D), 0.01),
    }


def reference(x, c, w_mod, b_mod, w_in, rwkv_mu, w0, w2, a0, a2, g2, k_k, k_a, r_k, gn_g, gn_b,
              vm0, vm1, vm2, sg_ln_g, sg_ln_b, w_s, b_s, w_branch_a, w_branch_b, w_out, ln1_g, ln1_b,
              router_w, router_b, e_gate, e_up, e_down, ln2_g, ln2_b):
    cond = jax.nn.silu(c)
    v_first = None
    for i in range(DEPTH):
        mod = (cond @ w_mod[i] + b_mod[i])[:, None, :]
        shift1, scale1, gate1, shift2, scale2, gate2 = jnp.split(mod, 6, axis=-1)
        h = (_ln(x) * (1 + scale1) + shift1).astype(x.dtype)
        z = h @ w_in[i]
        z_rwkv = z[..., :RWKV_COLS]
        z_sg = z[..., RWKV_COLS:RWKV_COLS + SG_COLS]
        z_gate = z[..., RWKV_COLS + SG_COLS:]
        vmix = None if i == 0 else (vm0[i - 1], vm1[i - 1], vm2[i - 1])
        y_a, v_first = rwkv7_branch(z_rwkv, v_first, vmix, rwkv_mu[i], w0[i], w2[i], a0[i], a2[i], g2[i],
                                    k_k[i], k_a[i], r_k[i], gn_g[i], gn_b[i])
        y_b = spatial_gating_branch(z_sg, sg_ln_g[i], sg_ln_b[i], w_s[i], b_s[i])
        gate_a = jax.nn.sigmoid(z_gate[..., :D_MODEL])
        gate_b = jax.nn.sigmoid(z_gate[..., D_MODEL:])
        mixed = (gate_a * (y_a @ w_branch_a[i]) + gate_b * (y_b @ w_branch_b[i])) @ w_out[i]
        x = layer_norm(DEEPNORM_ALPHA * x + (1 + gate1) * mixed, ln1_g[i], ln1_b[i])
        h = (_ln(x) * (1 + scale2) + shift2).astype(x.dtype)
        ffn = moe_ffn(h, router_w, router_b, e_gate[i], e_up[i], e_down[i])
        x = layer_norm(DEEPNORM_ALPHA * x + (1 + gate2) * ffn, ln2_g[i], ln2_b[i])
    return x
```

```cpp
#include <hip/hip_runtime.h>
#include <cstdio>
#include <cstdint>
#include <utility>

typedef unsigned short bf16;
typedef _Float16 f16;
typedef float f32x4 __attribute__((ext_vector_type(4)));
typedef unsigned u32x4 __attribute__((ext_vector_type(4)));
typedef unsigned u32x2 __attribute__((ext_vector_type(2)));

constexpr int T = 16384, D = 1024, W = 512, NH = 8, HN = 64, RC = 1792, INC = 4864;
constexpr int NE = 16, FF = 512, DEPTH = 2;
constexpr float LN_EPS = 1e-5f, GN_EPS = 64e-5f, ALPHA = 1.41421356237f;
constexpr int NTHREADS = 512, NWAVES = 8;
constexpr int MAXSLOT = 36864;

constexpr size_t MiB = 1u << 20;
constexpr size_t WS_CTL = 0, CTL_BYTES = 1 * MiB;
constexpr int CW_CNT = 16384;
constexpr size_t WS_PART = 1 * MiB;
constexpr size_t WS_MODF = 2 * MiB;
constexpr size_t WS_TOKI = 2 * MiB + 65536;
constexpr size_t WS_TOKW = WS_TOKI + 131072;
constexpr size_t WS_TOKP = WS_TOKW + 131072;
constexpr size_t WS_S2T = 3 * MiB;
constexpr size_t WS_LORA = 4 * MiB;
constexpr size_t WS_WIN = 8 * MiB;
constexpr size_t WS_WA = 28 * MiB, WS_WB = 29 * MiB, WS_WO = 30 * MiB, WS_WL1 = 4 * MiB;
constexpr size_t WS_ZG = 36 * MiB;
constexpr size_t WS_XN = 100 * MiB;
constexpr size_t WS_G = 100 * MiB, WS_YB = 116 * MiB;
constexpr size_t WS_ZR = 132 * MiB;
constexpr size_t WS_ZS = 188 * MiB;
constexpr size_t WS_YSC = 132 * MiB;
constexpr size_t WS_ST = 148 * MiB;
constexpr size_t WS_YA = 148 * MiB;
constexpr size_t WS_MP = 164 * MiB;
constexpr size_t WS_XS = 132 * MiB;
constexpr size_t WS_Y = 132 * MiB;
constexpr size_t WS_R = 224 * MiB, WS_WM1 = 240 * MiB, WS_KP = 256 * MiB, WS_AA = 272 * MiB, WS_BB = 288 * MiB, WS_V = 304 * MiB;
constexpr size_t WS_WGU = 224 * MiB;
constexpr size_t WS_WD = 256 * MiB;
constexpr size_t WS_HID = 272 * MiB;
constexpr size_t WS_VF = 320 * MiB;
constexpr size_t WS_END = 336 * MiB;

enum { I_X = 0, I_C, I_WMOD, I_BMOD, I_WIN, I_MU, I_W0, I_W2, I_A0, I_A2, I_G2, I_KK, I_KA, I_RK, I_GNG, I_GNB, I_VM0, I_VM1, I_VM2,
       I_SGG, I_SGB, I_WS, I_BS, I_WBA, I_WBB, I_WOUT, I_LN1G, I_LN1B, I_RW, I_RB, I_EG, I_EU, I_ED, I_LN2G, I_LN2B, N_IN };

struct Args { const float* in[N_IN]; float* out; unsigned char* ws; int ph_lo, ph_hi; };

__device__ __forceinline__ float bf2f(bf16 h) { return __uint_as_float(((unsigned)h) << 16); }
__device__ __forceinline__ unsigned f2bfu(float f) { unsigned u = __float_as_uint(f); return (u + 0x7fffu + ((u >> 16) & 1u)) >> 16; }
__device__ __forceinline__ bf16 f2bf(float f) { return (bf16)f2bfu(f); }
__device__ __forceinline__ unsigned pk2(float lo, float hi) { return f2bfu(lo) | (f2bfu(hi) << 16); }
__device__ __forceinline__ void store4bf(bf16* p, f32x4 v) { u32x2 w; w.x = pk2(v[0], v[1]); w.y = pk2(v[2], v[3]); *(u32x2*)p = w; }
__device__ __forceinline__ f32x4 load4bf(const bf16* p) { u32x2 w = *(const u32x2*)p; f32x4 r; r[0] = __uint_as_float(w.x << 16); r[1] = __uint_as_float(w.x & 0xffff0000u); r[2] = __uint_as_float(w.y << 16); r[3] = __uint_as_float(w.y & 0xffff0000u); return r; }
__device__ __forceinline__ float wave_sum(float v) {
#pragma unroll
    for (int o = 1; o < 64; o <<= 1) v += __shfl_xor(v, o);
    return v;
}
__device__ __forceinline__ float sigmoidf_(float x) { return 1.0f / (1.0f + __expf(-x)); }
__device__ __forceinline__ float siluf_(float x) { return x * sigmoidf_(x); }
__device__ __forceinline__ float gelu_tanh(float x) { const float u = 0.7978845608028654f * (x + 0.044715f * x * x * x); return 0.5f * x * (1.0f + tanhf(u)); }
__device__ __forceinline__ float softplusf_(float y) { return fmaxf(y, 0.f) + log1pf(__expf(-fabsf(y))); }

struct Ctx { int tid, lane, wave, gw, ngw; unsigned char* lds; };

__device__ __forceinline__ void transpose_item(const float* Wsrc, int N, int k0, int n0, bf16* dst, int ldk, float* scr, int lane) {
#pragma unroll 8
    for (int i = 0; i < 32; ++i) { const int kk = 2 * i + (lane >> 5); scr[kk * 33 + (lane & 31)] = Wsrc[(size_t)(k0 + kk) * N + n0 + (lane & 31)]; }
    asm volatile("s_waitcnt lgkmcnt(0)" ::: "memory");
    const int c = lane & 7;
#pragma unroll
    for (int j = 0; j < 4; ++j) { const int n = (lane >> 3) + 8 * j; const float* s = scr + (8 * c) * 33 + n;
        u32x4 o; o.x = pk2(s[0 * 33], s[1 * 33]); o.y = pk2(s[2 * 33], s[3 * 33]); o.z = pk2(s[4 * 33], s[5 * 33]); o.w = pk2(s[6 * 33], s[7 * 33]);
        *(u32x4*)(dst + (size_t)n * ldk + k0 + 8 * c) = o; }
    asm volatile("s_waitcnt lgkmcnt(0)" ::: "memory");
}
template <class RowMap>
__device__ __forceinline__ void transpose_matrix_item(const float* Wsrc, int K, int N, bf16* dst, int item, float* scr, int lane, const RowMap& rm) {
    const int nblk = N / 32, kb = item / nblk, nb = item % nblk, n0 = 32 * nb;
    transpose_item(Wsrc, N, 64 * kb, n0, dst + (size_t)rm(n0) * K, K, scr, lane);
}
struct RowId { __device__ __forceinline__ int operator()(int n) const { return n; } };
struct RowGU { int up; __device__ __forceinline__ int operator()(int n) const { return (n >> 7) * 256 + (n & 127) + up * 128; } };

__device__ __forceinline__ void phase_p0a(const Args& a, const Ctx& c) {
    float* scr = (float*)(c.lds + c.wave * 16384);
    float* PART = (float*)(a.ws + WS_PART);
    for (int it = c.gw; it < 2 * 96 * 16; it += c.ngw) {
        const int kb = it & 15, cb = (it >> 4) % 96, l = it / (16 * 96);
        const int n = cb * 64 + c.lane;
        const float* wm = a.in[I_WMOD] + (size_t)l * D * 6144;
        float acc = 0.f;
#pragma unroll 8
        for (int k = 0; k < 64; ++k) { const int kk = kb * 64 + k; acc += siluf_(a.in[I_C][kk]) * wm[(size_t)kk * 6144 + n]; }
        PART[((size_t)l * 16 + kb) * 6144 + n] = acc;
    }
    constexpr int I_WINL = (D / 64) * (INC / 32);
    constexpr int I_WAL = (W / 64) * (D / 32);
    constexpr int I_WOL = (D / 64) * (D / 32);
    constexpr int PER_L = I_WINL + 2 * I_WAL + I_WOL;
    for (int it = c.gw; it < 2 * PER_L; it += c.ngw) {
        const int l = it / PER_L; int r = it % PER_L;
        if (r < I_WINL) { transpose_matrix_item(a.in[I_WIN] + (size_t)l * D * INC, D, INC, (bf16*)(a.ws + WS_WIN + (size_t)l * 10 * MiB), r, scr, c.lane, RowId()); continue; } r -= I_WINL;
        if (r < I_WAL) { transpose_matrix_item(a.in[I_WBA] + (size_t)l * W * D, W, D, (bf16*)(a.ws + WS_WA + (size_t)l * WS_WL1), r, scr, c.lane, RowId()); continue; } r -= I_WAL;
        if (r < I_WAL) { transpose_matrix_item(a.in[I_WBB] + (size_t)l * W * D, W, D, (bf16*)(a.ws + WS_WB + (size_t)l * WS_WL1), r, scr, c.lane, RowId()); continue; } r -= I_WAL;
        transpose_matrix_item(a.in[I_WOUT] + (size_t)l * D * D, D, D, (bf16*)(a.ws + WS_WO + (size_t)l * WS_WL1), r, scr, c.lane, RowId());
    }
}

__device__ __forceinline__ void row_stats(const float (&v)[16], float& mean, float& rstd) {
    float s = 0.f;
#pragma unroll
    for (int j = 0; j < 16; ++j) s += v[j];
    mean = wave_sum(s) * (1.f / D);
    float q = 0.f;
#pragma unroll
    for (int j = 0; j < 16; ++j) { const float d = v[j] - mean; q += d * d; }
    rstd = 1.0f / sqrtf(wave_sum(q) * (1.f / D) + LN_EPS);
}
__device__ __forceinline__ void load_row16(const float* p, int lane, float (&v)[16]) {
#pragma unroll
    for (int j = 0; j < 4; ++j) { const f32x4 x = *(const f32x4*)(p + 4 * lane + 256 * j); v[4 * j] = x[0]; v[4 * j + 1] = x[1]; v[4 * j + 2] = x[2]; v[4 * j + 3] = x[3]; }
}

__device__ __forceinline__ void phase_p0b(const Args& a, const Ctx& c) {
    const float* PART = (const float*)(a.ws + WS_PART);
    float* MODF = (float*)(a.ws + WS_MODF);
    for (int i = blockIdx.x * NTHREADS + c.tid; i < 2 * 6144; i += gridDim.x * NTHREADS) {
        const int l = i / 6144, n = i % 6144; float s = a.in[I_BMOD][i];
#pragma unroll
        for (int kb = 0; kb < 16; ++kb) s += PART[((size_t)l * 16 + kb) * 6144 + n];
        MODF[i] = s;
    }
    float sh[16], sc[16];
#pragma unroll
    for (int j = 0; j < 4; ++j)
#pragma unroll
        for (int e = 0; e < 4; ++e) { const int col = 4 * c.lane + 256 * j + e; float s0 = a.in[I_BMOD][col], s1 = a.in[I_BMOD][1024 + col];
            for (int kb = 0; kb < 16; ++kb) { s0 += PART[(size_t)kb * 6144 + col]; s1 += PART[(size_t)kb * 6144 + 1024 + col]; }
            sh[4 * j + e] = s0; sc[4 * j + e] = 1.f + s1; }
    bf16* XN = (bf16*)(a.ws + WS_XN);
    for (int m = c.gw; m < T; m += c.ngw) {
        float v[16]; load_row16(a.in[I_X] + (size_t)m * D, c.lane, v);
        float mean, rstd; row_stats(v, mean, rstd);
#pragma unroll
        for (int j = 0; j < 4; ++j) { f32x4 o;
#pragma unroll
            for (int e = 0; e < 4; ++e) o[e] = (v[4 * j + e] - mean) * rstd * sc[4 * j + e] + sh[4 * j + e];
            store4bf(XN + (size_t)m * D + 4 * c.lane + 256 * j, o); }
    }
}

struct Unit { int pm, pn; };
struct DenseSched { int nN, n, G, c;
    __device__ __forceinline__ bool next(int i, Unit& u) const { const int L = i * G + c; if (L >= n) return false; u.pm = L / nN; u.pn = L % nN; return true; } };

template <class Sched, class Epi>
__device__ __forceinline__ void gemm_simple(const Ctx& c, const bf16* A, const bf16* Bt, int K, const Sched& S, const Epi& E) {
    float* As = (float*)c.lds;
    float* Bs = As + 32 * 256;
    const int tid = c.tid, rg = tid >> 4, cg = tid & 15;
    Unit u;
    for (int ui = 0; S.next(ui, u); ++ui) {
        float acc[8][16];
#pragma unroll
        for (int i = 0; i < 8; ++i)
#pragma unroll
            for (int j = 0; j < 16; ++j) acc[i][j] = 0.f;
        const bf16* Ab = A + (size_t)u.pm * 256 * K; const bf16* Bb = Bt + (size_t)u.pn * 256 * K;
        for (int k0 = 0; k0 < K; k0 += 32) {
            { const int row = tid >> 1, kh = tid & 1;
              const u32x4* pa = (const u32x4*)(Ab + (size_t)row * K + k0 + 16 * kh); const u32x4 a0 = pa[0], a1 = pa[1];
              const u32x4* pb = (const u32x4*)(Bb + (size_t)row * K + k0 + 16 * kh); const u32x4 b0 = pb[0], b1 = pb[1];
#pragma unroll
              for (int j = 0; j < 4; ++j) {
                  As[(16 * kh + 2 * j) * 256 + row] = __uint_as_float(a0[j] << 16); As[(16 * kh + 2 * j + 1) * 256 + row] = __uint_as_float(a0[j] & 0xffff0000u);
                  As[(16 * kh + 8 + 2 * j) * 256 + row] = __uint_as_float(a1[j] << 16); As[(16 * kh + 8 + 2 * j + 1) * 256 + row] = __uint_as_float(a1[j] & 0xffff0000u);
                  Bs[(16 * kh + 2 * j) * 256 + row] = __uint_as_float(b0[j] << 16); Bs[(16 * kh + 2 * j + 1) * 256 + row] = __uint_as_float(b0[j] & 0xffff0000u);
                  Bs[(16 * kh + 8 + 2 * j) * 256 + row] = __uint_as_float(b1[j] << 16); Bs[(16 * kh + 8 + 2 * j + 1) * 256 + row] = __uint_as_float(b1[j] & 0xffff0000u);
              } }
            __syncthreads();
#pragma unroll 4
            for (int kk = 0; kk < 32; ++kk) {
                const f32x4 a0 = *(const f32x4*)(As + kk * 256 + rg * 8), a1 = *(const f32x4*)(As + kk * 256 + rg * 8 + 4);
                f32x4 b[4];
#pragma unroll
                for (int q = 0; q < 4; ++q) b[q] = *(const f32x4*)(Bs + kk * 256 + 64 * q + 4 * cg);
#pragma unroll
                for (int i = 0; i < 8; ++i) { const float av = i < 4 ? a0[i & 3] : a1[i & 3];
#pragma unroll
                    for (int q = 0; q < 4; ++q)
#pragma unroll
                        for (int e = 0; e < 4; ++e) acc[i][4 * q + e] += av * b[q][e]; }
            }
            __syncthreads();
        }
#pragma unroll
        for (int i = 0; i < 8; ++i) { const int row = u.pm * 256 + rg * 8 + i;
#pragma unroll
            for (int q = 0; q < 2; ++q) { const int col = u.pn * 256 + 64 * q + 4 * cg;
                f32x4 v0, v1;
#pragma unroll
                for (int e = 0; e < 4; ++e) { v0[e] = acc[i][4 * q + e]; v1[e] = acc[i][4 * (q + 2) + e]; }
                E(row, col, v0, v1); } }
    }
}

struct EpiZ { bf16 *ZR, *ZS, *ZG;
    __device__ __forceinline__ void one(int row, int col, f32x4 v) const {
        if (col < RC) store4bf(ZR + (size_t)row * RC + col, v);
        else if (col < RC + 1024) { f32x4 g; for (int e = 0; e < 4; ++e) g[e] = gelu_tanh(v[e]); store4bf(ZS + (size_t)row * 1024 + (col - RC), g); }
        else { f32x4 g; for (int e = 0; e < 4; ++e) g[e] = sigmoidf_(v[e]); store4bf(ZG + (size_t)row * 2048 + (col - RC - 1024), g); } }
    __device__ __forceinline__ void operator()(int row, int col, f32x4 v0, f32x4 v1) const { one(row, col, v0); one(row, col + 128, v1); } };
struct EpiGA { const bf16* ZG; bf16* MP;
    __device__ __forceinline__ void one(int row, int col, f32x4 v) const { const f32x4 g = load4bf(ZG + (size_t)row * 2048 + col); store4bf(MP + (size_t)row * D + col, g * v); }
    __device__ __forceinline__ void operator()(int row, int col, f32x4 v0, f32x4 v1) const { one(row, col, v0); one(row, col + 128, v1); } };
struct EpiGB { const bf16* ZG; bf16* MP;
    __device__ __forceinline__ void one(int row, int col, f32x4 v) const { const f32x4 g = load4bf(ZG + (size_t)row * 2048 + 1024 + col); const f32x4 m = load4bf(MP + (size_t)row * D + col); store4bf(MP + (size_t)row * D + col, m + g * v); }
    __device__ __forceinline__ void operator()(int row, int col, f32x4 v0, f32x4 v1) const { one(row, col, v0); one(row, col + 128, v1); } };
struct EpiOut { const float* xin; float* out; const float* gate1;
    __device__ __forceinline__ void one(int row, int col, f32x4 v) const { const f32x4 x = *(const f32x4*)(xin + (size_t)row * D + col); const f32x4 g = *(const f32x4*)(gate1 + col);
        *(f32x4*)(out + (size_t)row * D + col) = ALPHA * x + (1.0f + g) * v; }
    __device__ __forceinline__ void operator()(int row, int col, f32x4 v0, f32x4 v1) const { one(row, col, v0); one(row, col + 128, v1); } };
struct EpiSwi { bf16* HID;
    __device__ __forceinline__ void operator()(int row, int col, f32x4 v0, f32x4 v1) const { const int ct = (col >> 8) & 3, cc = col & 127;
        f32x4 h; for (int e = 0; e < 4; ++e) h[e] = siluf_(v0[e]) * v1[e]; store4bf(HID + (size_t)row * FF + ct * 128 + cc, h); } };
struct EpiDown { const int* S2T; const float* TOKW; bf16* Y;
    __device__ __forceinline__ void operator()(int row, int col, f32x4 v0, f32x4 v1) const { const int st = S2T[row]; if (st < 0) return; const float w = TOKW[st]; const int cc = col & 1023;
        store4bf(Y + (size_t)st * D + cc, w * v0); store4bf(Y + (size_t)st * D + cc + 128, w * v1); } };

struct MoeSched { int ts[17]; int G, c;
    __device__ __forceinline__ void init(const unsigned* cnt, int G_, int c_) { G = G_; c = c_; int s = 0;
#pragma unroll
        for (int e = 0; e < 16; ++e) { ts[e] = s; s += ((int)cnt[e] + 255) >> 8; } ts[16] = s; }
    __device__ __forceinline__ bool next(int i, Unit& u) const { const int L = i * G + c; if (L >= 4 * ts[16]) return false; const int rt = L >> 2, ct = L & 3; int e = 0;
#pragma unroll
        for (int j = 1; j < 16; ++j) e += (rt >= ts[j]) ? 1 : 0;
        u.pm = rt; u.pn = e * 4 + ct; return true; } };

__device__ __forceinline__ void phase_prep_simple(const Args& a, const Ctx& c, int l) {
    const bf16* ZR = (const bf16*)(a.ws + WS_ZR);
    const float* mu = a.in[I_MU] + l * RC; const float* w0 = a.in[I_W0] + l * W; const float* w2 = a.in[I_W2] + (size_t)l * 64 * W;
    const float* a0 = a.in[I_A0] + l * W; const float* a2 = a.in[I_A2] + (size_t)l * 64 * W; const float* g2 = a.in[I_G2] + (size_t)l * 128 * W;
    const float* k_k = a.in[I_KK] + l * W; const float* k_a = a.in[I_KA] + l * W;
    const float* vm0 = a.in[I_VM0]; const float* vm1 = a.in[I_VM1]; const float* vm2 = a.in[I_VM2];
    f16* R = (f16*)(a.ws + WS_R); f16* WM1 = (f16*)(a.ws + WS_WM1); f16* KP = (f16*)(a.ws + WS_KP); f16* AA = (f16*)(a.ws + WS_AA); f16* BB = (f16*)(a.ws + WS_BB); f16* V = (f16*)(a.ws + WS_V);
    bf16* G = (bf16*)(a.ws + WS_G); bf16* VF = (bf16*)(a.ws + WS_VF);
    const int lane = c.lane;
    for (int t = c.gw; t < T; t += c.ngw) {
        float z[28];
#pragma unroll
        for (int i = 0; i < 28; ++i) { const int col = lane + 64 * i; const float zc = bf2f(ZR[(size_t)t * RC + col]); const float zp = t > 0 ? bf2f(ZR[(size_t)(t - 1) * RC + col]) : 0.f; z[i] = zc + (zp - zc) * mu[col]; }
        const float tw = tanhf(z[24]), za = z[25], sg0 = sigmoidf_(z[26]), sg1 = sigmoidf_(z[27]);
        float wlo[8], alo[8], gg[8];
#pragma unroll
        for (int i = 0; i < 8; ++i) { wlo[i] = 0.f; alo[i] = 0.f; gg[i] = 0.f; }
        for (int j = 0; j < 64; ++j) { const float tj = __shfl(tw, j), aj = __shfl(za, j), s0 = __shfl(sg0, j), s1 = __shfl(sg1, j);
#pragma unroll
            for (int i = 0; i < 8; ++i) { const int n = lane + 64 * i; wlo[i] += tj * w2[j * W + n]; alo[i] += aj * a2[j * W + n]; gg[i] += s0 * g2[j * W + n] + s1 * g2[(64 + j) * W + n]; } }
        float vv[8];
#pragma unroll
        for (int i = 0; i < 8; ++i) vv[i] = z[16 + i];
        if (l == 0) {
#pragma unroll
            for (int i = 0; i < 8; ++i) VF[(size_t)t * W + lane + 64 * i] = f2bf(vv[i]);
        } else {
            float vmid = 0.f;
#pragma unroll
            for (int i = 0; i < 8; ++i)
                for (int j = 0; j < 64; ++j) { const float vc = __shfl(vv[i], j); vmid += vc * vm1[(size_t)(64 * i + j) * 32 + (lane & 31)]; }
            float vg[8];
#pragma unroll
            for (int i = 0; i < 8; ++i) vg[i] = 0.f;
            for (int m = 0; m < 32; ++m) { const float vmm = __shfl(vmid, m);
#pragma unroll
                for (int i = 0; i < 8; ++i) vg[i] += vmm * vm2[m * W + lane + 64 * i]; }
#pragma unroll
            for (int i = 0; i < 8; ++i) { const int n = lane + 64 * i; const float vf = bf2f(VF[(size_t)t * W + n]); vv[i] = vv[i] + (vf - vv[i]) * sigmoidf_(vm0[n] + vg[i]); }
        }
#pragma unroll
        for (int i = 0; i < 8; ++i) {
            const int n = lane + 64 * i; const size_t o = (size_t)t * W + n;
            const float x = w0[n] + wlo[i]; const float wl = -softplusf_(-x) - 0.5f; const float dm1 = expm1f(-__expf(wl));
            const float av = sigmoidf_(a0[n] + alo[i]);
            const float kraw = z[8 + i];
            float kk = kraw * k_k[n]; const float nrm = sqrtf(wave_sum(kk * kk)); kk = kk / fmaxf(nrm, 1e-12f);
            const float kp = kraw * (1.0f + (av - 1.0f) * k_a[n]);
            R[o] = (f16)z[i]; WM1[o] = (f16)dm1; KP[o] = (f16)kp; AA[o] = (f16)(-kk); BB[o] = (f16)(kk * av); V[o] = (f16)vv[i]; G[o] = f2bf(gg[i]);
        }
    }
}

__device__ __forceinline__ void phase_sg_simple(const Args& a, const Ctx& c, int l) {
    const bf16* ZS = (const bf16*)(a.ws + WS_ZS); bf16* YB = (bf16*)(a.ws + WS_YB);
    const float* lng = a.in[I_SGG] + l * W; const float* lnb = a.in[I_SGB] + l * W;
    float* vn = (float*)c.lds;
    float* st = vn + 128 * 64;
    for (int uidx = blockIdx.x; uidx < 128 * 8; uidx += gridDim.x) {
        const int ch = uidx >> 3, g = uidx & 7; const int tok0 = ch * 128;
        for (int i = 0; i < 16; ++i) { const int s = c.wave * 16 + i; const bf16* p = ZS + (size_t)(tok0 + s) * 1024 + 512 + c.lane * 8;
            const f32x4 x0 = load4bf(p), x1 = load4bf(p + 4);
            float sm = (x0[0] + x0[1]) + (x0[2] + x0[3]) + (x1[0] + x1[1]) + (x1[2] + x1[3]); const float mean = wave_sum(sm) * (1.f / 512.f);
            float q = 0.f; for (int e = 0; e < 4; ++e) { const float d0 = x0[e] - mean, d1 = x1[e] - mean; q += d0 * d0 + d1 * d1; }
            const float rstd = 1.0f / sqrtf(wave_sum(q) * (1.f / 512.f) + LN_EPS);
            if (c.lane == 0) { st[2 * s] = mean; st[2 * s + 1] = rstd; } }
        __syncthreads();
        for (int i = c.tid; i < 128 * 64; i += NTHREADS) { const int s = i >> 6, d = i & 63; const float x = bf2f(ZS[(size_t)(tok0 + s) * 1024 + 512 + g * 64 + d]);
            vn[i] = (x - st[2 * s]) * st[2 * s + 1] * lng[g * 64 + d] + lnb[g * 64 + d]; }
        __syncthreads();
        const int d = c.tid & 63, tq = c.tid >> 6;
        const float* Wg = a.in[I_WS] + (size_t)(l * 8 + g) * 128 * 128; const float* bs = a.in[I_BS] + (size_t)(l * 8 + g) * 128;
        for (int i = 0; i < 16; ++i) { const int t = tq + 8 * i; float acc = 0.f;
            for (int s = 0; s <= t; ++s) acc += Wg[t * 128 + s] * vn[s * 64 + d];
            const float u = bf2f(ZS[(size_t)(tok0 + t) * 1024 + g * 64 + d]);
            YB[(size_t)(tok0 + t) * W + g * 64 + d] = f2bf(u * (acc + bs[t])); }
        __syncthreads();
    }
}

__device__ __forceinline__ void phase_scan_simple(const Args& a, const Ctx& c) {
    if (c.wave != 0 || blockIdx.x >= NH) return;
    const int h = blockIdx.x, lane = c.lane;
    const f16* R = (const f16*)(a.ws + WS_R); const f16* WM1 = (const f16*)(a.ws + WS_WM1); const f16* KP = (const f16*)(a.ws + WS_KP);
    const f16* AA = (const f16*)(a.ws + WS_AA); const f16* BB = (const f16*)(a.ws + WS_BB); const f16* V = (const f16*)(a.ws + WS_V);
    bf16* YSC = (bf16*)(a.ws + WS_YSC);
    float S[64];
#pragma unroll
    for (int j = 0; j < 64; ++j) S[j] = 0.f;
    for (int t = 0; t < T; ++t) {
        const size_t base = (size_t)t * W + h * 64;
        const float vv = (float)V[base + lane];
        float sa = 0.f;
#pragma unroll
        for (int j = 0; j < 64; ++j) sa += S[j] * (float)AA[base + j];
        float y = 0.f;
#pragma unroll
        for (int j = 0; j < 64; ++j) { float s = S[j]; s = s + s * (float)WM1[base + j]; s += sa * (float)BB[base + j]; s += vv * (float)KP[base + j]; S[j] = s; y += s * (float)R[base + j]; }
        YSC[base + lane] = f2bf(y);
    }
}

__device__ __forceinline__ void phase_post(const Args& a, const Ctx& c, int l) {
    const bf16* YSC = (const bf16*)(a.ws + WS_YSC); const f16* R = (const f16*)(a.ws + WS_R); const f16* KP = (const f16*)(a.ws + WS_KP); const f16* V = (const f16*)(a.ws + WS_V);
    const bf16* G = (const bf16*)(a.ws + WS_G); bf16* YA = (bf16*)(a.ws + WS_YA);
    const float* gng = a.in[I_GNG] + l * W; const float* gnb = a.in[I_GNB] + l * W; const float* rk = a.in[I_RK] + l * W;
    for (int t = c.gw; t < T; t += c.ngw) {
#pragma unroll
        for (int i = 0; i < 8; ++i) { const int n = c.lane + 64 * i; const size_t o = (size_t)t * W + n;
            const float y = bf2f(YSC[o]); const float mean = wave_sum(y) * (1.f / 64.f); const float d = y - mean; const float var = wave_sum(d * d) * (1.f / 64.f);
            float yn = d * (1.0f / sqrtf(var + GN_EPS)) * gng[n] + gnb[n];
            const float r = (float)R[o], k = (float)KP[o], v = (float)V[o];
            const float bonus = wave_sum(r * k * rk[n]);
            yn += bonus * v;
            YA[o] = f2bf(yn * bf2f(G[o])); }
    }
}

__device__ __forceinline__ void phase_ln1(const Args& a, const Ctx& c, int l) {
    const float* MODF = (const float*)(a.ws + WS_MODF) + l * 6144;
    const float* g1 = a.in[I_LN1G] + l * D; const float* b1 = a.in[I_LN1B] + l * D;
    bf16* XN = (bf16*)(a.ws + WS_XN);
    int* TOKI = (int*)(a.ws + WS_TOKI); float* TOKW = (float*)(a.ws + WS_TOKW); int* TOKP = (int*)(a.ws + WS_TOKP);
    unsigned* cnt = (unsigned*)(a.ws + WS_CTL) + CW_CNT + 64 * l;
    const float* rw = a.in[I_RW]; const float* rb = a.in[I_RB];
    for (int m = c.gw; m < T; m += c.ngw) {
        float v[16]; load_row16(a.out + (size_t)m * D, c.lane, v);
        float mean, rstd; row_stats(v, mean, rstd);
#pragma unroll
        for (int j = 0; j < 4; ++j) { f32x4 o; const int col = 4 * c.lane + 256 * j;
#pragma unroll
            for (int e = 0; e < 4; ++e) { v[4 * j + e] = (v[4 * j + e] - mean) * rstd * g1[col + e] + b1[col + e]; o[e] = v[4 * j + e]; }
            *(f32x4*)(a.out + (size_t)m * D + col) = o; }
        row_stats(v, mean, rstd);
        float lg[16];
#pragma unroll
        for (int e = 0; e < 16; ++e) lg[e] = 0.f;
#pragma unroll
        for (int j = 0; j < 4; ++j) { f32x4 o; const int col = 4 * c.lane + 256 * j;
#pragma unroll
            for (int e = 0; e < 4; ++e) { const float h = (v[4 * j + e] - mean) * rstd * (1.0f + MODF[4096 + col + e]) + MODF[3072 + col + e]; o[e] = h;
                const f32x4* rr = (const f32x4*)(rw + (size_t)(col + e) * NE);
#pragma unroll
                for (int q = 0; q < 4; ++q) { const f32x4 r4 = rr[q]; lg[4 * q] += h * r4[0]; lg[4 * q + 1] += h * r4[1]; lg[4 * q + 2] += h * r4[2]; lg[4 * q + 3] += h * r4[3]; } }
            store4bf(XN + (size_t)m * D + col, o); }
        float sc[16], sel[16];
#pragma unroll
        for (int e = 0; e < 16; ++e) { sc[e] = 1.0f / (1.0f + expf(-wave_sum(lg[e]))); sel[e] = sc[e] + rb[e]; }
        int best = 0; float bestv = -INFINITY;
#pragma unroll
        for (int g = 0; g < 4; ++g) { float m1 = -INFINITY, m2 = -INFINITY;
#pragma unroll
            for (int q = 0; q < 4; ++q) { const float s = sel[4 * g + q]; if (s > m1) { m2 = m1; m1 = s; } else if (s > m2) m2 = s; }
            const float gs = m1 + m2; if (gs > bestv) { bestv = gs; best = g; } }
        int i1 = 0, i2 = 0; float s1 = -INFINITY, s2 = -INFINITY, w1 = 0.f, w2 = 0.f;
#pragma unroll
        for (int e = 0; e < 16; ++e) { if ((e >> 2) == best) { const float s = sel[e];
                if (s > s1) { s2 = s1; i2 = i1; w2 = w1; s1 = s; i1 = e; w1 = sc[e]; } else if (s > s2) { s2 = s; i2 = e; w2 = sc[e]; } } }
        if (c.lane == 0) { const float ws = w1 + w2;
            TOKI[2 * m] = i1; TOKI[2 * m + 1] = i2; TOKW[2 * m] = w1 / ws; TOKW[2 * m + 1] = w2 / ws;
            TOKP[2 * m] = (int)atomicAdd(cnt + i1, 1u); TOKP[2 * m + 1] = (int)atomicAdd(cnt + i2, 1u); }
    }
    float* scr = (float*)(c.lds + c.wave * 16384);
    bf16* WGU = (bf16*)(a.ws + WS_WGU); bf16* WD = (bf16*)(a.ws + WS_WD);
    constexpr int IG = (D / 64) * (FF / 32);
    constexpr int ID = (FF / 64) * (D / 32);
    for (int it = c.gw; it < NE * (2 * IG + ID); it += c.ngw) {
        const int e = it / (2 * IG + ID); int r = it % (2 * IG + ID);
        const size_t eo = ((size_t)l * NE + e) * (size_t)D * FF;
        if (r < IG) { transpose_matrix_item(a.in[I_EG] + eo, D, FF, WGU + (size_t)e * 1024 * 1024, r, scr, c.lane, RowGU{0}); continue; } r -= IG;
        if (r < IG) { transpose_matrix_item(a.in[I_EU] + eo, D, FF, WGU + (size_t)e * 1024 * 1024, r, scr, c.lane, RowGU{1}); continue; } r -= IG;
        transpose_matrix_item(a.in[I_ED] + eo, FF, D, WD + (size_t)e * 1024 * 512, r, scr, c.lane, RowId());
    }
}

__device__ __forceinline__ void phase_perm(const Args& a, const Ctx& c, int l) {
    const unsigned* cnt = (const unsigned*)(a.ws + WS_CTL) + CW_CNT + 64 * l;
    int ts[17]; { int s = 0;
#pragma unroll
        for (int e = 0; e < 16; ++e) { ts[e] = s; s += ((int)cnt[e] + 255) >> 8; } ts[16] = s; }
    const int* TOKI = (const int*)(a.ws + WS_TOKI); const int* TOKP = (const int*)(a.ws + WS_TOKP); int* S2T = (int*)(a.ws + WS_S2T);
    const bf16* XN = (const bf16*)(a.ws + WS_XN); bf16* XS = (bf16*)(a.ws + WS_XS);
    for (int as = c.gw; as < 2 * T; as += c.ngw) {
        const int e = TOKI[as]; int base = 0;
#pragma unroll
        for (int j = 0; j < 16; ++j) base = (j == e) ? ts[j] : base;
        const int slot = base * 256 + TOKP[as];
        if (c.lane == 0) S2T[slot] = as;
        const u32x4* src = (const u32x4*)(XN + (size_t)(as >> 1) * D); u32x4* dst = (u32x4*)(XS + (size_t)slot * D);
        dst[c.lane] = src[c.lane]; dst[64 + c.lane] = src[64 + c.lane];
    }
    for (int e = 0; e < 16; ++e) {
        int tse = 0, tsn = 0;
#pragma unroll
        for (int j = 0; j < 16; ++j) { tse = (j == e) ? ts[j] : tse; tsn = (j == e) ? ts[j + 1] : tsn; }
        const int lo = tse * 256 + (int)cnt[e], hi = tsn * 256;
        for (int s = lo + c.gw; s < hi; s += c.ngw) { if (c.lane == 0) S2T[s] = -1; u32x4* dst = (u32x4*)(XS + (size_t)s * D); const u32x4 zz = {0u, 0u, 0u, 0u}; dst[c.lane] = zz; dst[64 + c.lane] = zz; }
    }
}

__device__ __forceinline__ void phase_ln2(const Args& a, const Ctx& c, int l) {
    const float* MODF = (const float*)(a.ws + WS_MODF) + l * 6144;
    const float* g2 = a.in[I_LN2G] + l * D; const float* b2 = a.in[I_LN2B] + l * D;
    const bf16* Y = (const bf16*)(a.ws + WS_Y); bf16* XN = (bf16*)(a.ws + WS_XN);
    for (int m = c.gw; m < T; m += c.ngw) {
        float v[16]; load_row16(a.out + (size_t)m * D, c.lane, v);
#pragma unroll
        for (int j = 0; j < 4; ++j) { const int col = 4 * c.lane + 256 * j; const f32x4 y0 = load4bf(Y + (size_t)(2 * m) * D + col), y1 = load4bf(Y + (size_t)(2 * m + 1) * D + col);
#pragma unroll
            for (int e = 0; e < 4; ++e) v[4 * j + e] = ALPHA * v[4 * j + e] + (1.0f + MODF[5120 + col + e]) * (y0[e] + y1[e]); }
        float mean, rstd; row_stats(v, mean, rstd);
#pragma unroll
        for (int j = 0; j < 4; ++j) { f32x4 o; const int col = 4 * c.lane + 256 * j;
#pragma unroll
            for (int e = 0; e < 4; ++e) { v[4 * j + e] = (v[4 * j + e] - mean) * rstd * g2[col + e] + b2[col + e]; o[e] = v[4 * j + e]; }
            *(f32x4*)(a.out + (size_t)m * D + col) = o; }
        if (l + 1 < DEPTH) {
            const float* MN = MODF + 6144;
            row_stats(v, mean, rstd);
#pragma unroll
            for (int j = 0; j < 4; ++j) { f32x4 o; const int col = 4 * c.lane + 256 * j;
#pragma unroll
                for (int e = 0; e < 4; ++e) o[e] = (v[4 * j + e] - mean) * rstd * (1.0f + MN[1024 + col + e]) + MN[col + e];
                store4bf(XN + (size_t)m * D + col, o); }
        }
    }
}

constexpr int N_KINDS = 15;

template <int KIND>
__device__ __forceinline__ void run_phase(const Args& a, const Ctx& c, int l) {
    unsigned char* ws = a.ws;
    const int G = gridDim.x, b = blockIdx.x;
    if constexpr (KIND == 0) phase_p0a(a, c);
    if constexpr (KIND == 1) phase_p0b(a, c);
    if constexpr (KIND == 2) { DenseSched S{INC / 256, (T / 256) * (INC / 256), G, b}; EpiZ E{(bf16*)(ws + WS_ZR), (bf16*)(ws + WS_ZS), (bf16*)(ws + WS_ZG)};
        gemm_simple(c, (const bf16*)(ws + WS_XN), (const bf16*)(ws + WS_WIN + (size_t)l * 10 * MiB), D, S, E); }
    if constexpr (KIND == 3) phase_prep_simple(a, c, l);
    if constexpr (KIND == 4) phase_sg_simple(a, c, l);
    if constexpr (KIND == 5) phase_scan_simple(a, c);
    if constexpr (KIND == 6) phase_post(a, c, l);
    if constexpr (KIND == 7) { DenseSched S{D / 256, (T / 256) * (D / 256), G, b}; EpiGA E{(const bf16*)(ws + WS_ZG), (bf16*)(ws + WS_MP)};
        gemm_simple(c, (const bf16*)(ws + WS_YA), (const bf16*)(ws + WS_WA + (size_t)l * WS_WL1), W, S, E); }
    if constexpr (KIND == 8) { DenseSched S{D / 256, (T / 256) * (D / 256), G, b}; EpiGB E{(const bf16*)(ws + WS_ZG), (bf16*)(ws + WS_MP)};
        gemm_simple(c, (const bf16*)(ws + WS_YB), (const bf16*)(ws + WS_WB + (size_t)l * WS_WL1), W, S, E); }
    if constexpr (KIND == 9) { DenseSched S{D / 256, (T / 256) * (D / 256), G, b}; EpiOut E{l == 0 ? a.in[I_X] : a.out, a.out, (const float*)(ws + WS_MODF) + l * 6144 + 2048};
        gemm_simple(c, (const bf16*)(ws + WS_MP), (const bf16*)(ws + WS_WO + (size_t)l * WS_WL1), D, S, E); }
    if constexpr (KIND == 10) phase_ln1(a, c, l);
    if constexpr (KIND == 11) phase_perm(a, c, l);
    if constexpr (KIND == 12) { MoeSched S; S.init((const unsigned*)(ws + WS_CTL) + CW_CNT + 64 * l, G, b); EpiSwi E{(bf16*)(ws + WS_HID)};
        gemm_simple(c, (const bf16*)(ws + WS_XS), (const bf16*)(ws + WS_WGU), D, S, E); }
    if constexpr (KIND == 13) { MoeSched S; S.init((const unsigned*)(ws + WS_CTL) + CW_CNT + 64 * l, G, b); EpiDown E{(const int*)(ws + WS_S2T), (const float*)(ws + WS_TOKW), (bf16*)(ws + WS_Y)};
        gemm_simple(c, (const bf16*)(ws + WS_HID), (const bf16*)(ws + WS_WD), FF, S, E); }
    if constexpr (KIND == 14) phase_ln2(a, c, l);
}

constexpr int LDS_BYTES = 147456;

template <int KIND>
__global__ void __launch_bounds__(NTHREADS, 2) mk_phase(Args a, int l) {
    extern __shared__ __attribute__((aligned(16))) unsigned char lds[];
    Ctx c; c.tid = threadIdx.x; c.lane = c.tid & 63; c.wave = __builtin_amdgcn_readfirstlane(c.tid >> 6);
    c.gw = blockIdx.x * NWAVES + c.wave; c.ngw = gridDim.x * NWAVES; c.lds = lds;
    run_phase<KIND>(a, c, l);
}

template <int KIND> static bool set_attr() { return hipFuncSetAttribute((const void*)mk_phase<KIND>, hipFuncAttributeMaxDynamicSharedMemorySize, LDS_BYTES) == hipSuccess; }
template <int... K> static bool set_attrs(std::integer_sequence<int, K...>) { return (set_attr<K>() && ...); }
template <int KIND> static void launch(int grid, hipStream_t stream, const Args& a, int l) { hipLaunchKernelGGL(mk_phase<KIND>, dim3(grid), dim3(NTHREADS), LDS_BYTES, stream, a, l); }

extern "C" void kernel_launch(void* const* d_in, const int* in_sizes, int n_in, void* d_out, int out_size, void* d_ws, size_t ws_size, hipStream_t stream) {
    static int grid = 0;
    if (grid == 0) {
        if (n_in != N_IN || out_size != T * D || ws_size < WS_END) { fprintf(stderr, "kernel_launch: unexpected shapes: n_in %d out %d ws %zu (need %zu)\n", n_in, out_size, ws_size, (size_t)WS_END); grid = -1; return; }
        int dev = 0, cus = 0;
        (void)hipGetDevice(&dev); (void)hipDeviceGetAttribute(&cus, hipDeviceAttributeMultiprocessorCount, dev);
        if (!set_attrs(std::make_integer_sequence<int, N_KINDS>())) { fprintf(stderr, "kernel_launch: hipFuncSetAttribute failed\n"); grid = -1; return; }
        grid = cus > 0 ? cus : 256;
        fprintf(stderr, "kernel_launch: ws_size %zu grid %d\n", ws_size, grid);
    }
    if (grid < 0) return;
    (void)hipMemsetAsync((char*)d_ws + WS_CTL, 0, CTL_BYTES, stream);
    Args a{};
    for (int i = 0; i < N_IN; ++i) a.in[i] = (const float*)d_in[i];
    a.out = (float*)d_out; a.ws = (unsigned char*)d_ws;
    launch<0>(grid, stream, a, 0); launch<1>(grid, stream, a, 0);
    for (int l = 0; l < DEPTH; ++l) {
        launch<2>(grid, stream, a, l); launch<3>(grid, stream, a, l); launch<4>(grid, stream, a, l); launch<5>(grid, stream, a, l); launch<6>(grid, stream, a, l);
        launch<7>(grid, stream, a, l); launch<8>(grid, stream, a, l); launch<9>(grid, stream, a, l); launch<10>(grid, stream, a, l); launch<11>(grid, stream, a, l);
        launch<12>(grid, stream, a, l); launch<13>(grid, stream, a, l); launch<14>(grid, stream, a, l);
    }
}
```

```cpp
#include <hip/hip_runtime.h>
#include <cstdio>
#include <cstdint>
#include <utility>

typedef unsigned short bf16;
typedef _Float16 f16;
typedef float f32x4 __attribute__((ext_vector_type(4)));
typedef unsigned u32x4 __attribute__((ext_vector_type(4)));
typedef unsigned u32x2 __attribute__((ext_vector_type(2)));

constexpr int T = 16384, D = 1024, W = 512, NH = 8, HN = 64, RC = 1792, INC = 4864;
constexpr int NE = 16, FF = 512, DEPTH = 2;
constexpr float LN_EPS = 1e-5f, GN_EPS = 64e-5f, ALPHA = 1.41421356237f;
constexpr int NTHREADS = 512, NWAVES = 8;
constexpr int MAXSLOT = 36864;

constexpr size_t MiB = 1u << 20;
constexpr size_t WS_CTL = 0, CTL_BYTES = 1 * MiB;
constexpr int CW_CNT = 16384;
constexpr size_t WS_PART = 1 * MiB;
constexpr size_t WS_MODF = 2 * MiB;
constexpr size_t WS_TOKI = 2 * MiB + 65536;
constexpr size_t WS_TOKW = WS_TOKI + 131072;
constexpr size_t WS_TOKP = WS_TOKW + 131072;
constexpr size_t WS_S2T = 3 * MiB;
constexpr size_t WS_LORA = 4 * MiB;
constexpr size_t WS_WIN = 8 * MiB;
constexpr size_t WS_WA = 28 * MiB, WS_WB = 29 * MiB, WS_WO = 30 * MiB, WS_WL1 = 4 * MiB;
constexpr size_t WS_ZG = 36 * MiB;
constexpr size_t WS_XN = 100 * MiB;
constexpr size_t WS_G = 100 * MiB, WS_YB = 116 * MiB;
constexpr size_t WS_ZR = 132 * MiB;
constexpr size_t WS_ZS = 188 * MiB;
constexpr size_t WS_YSC = 132 * MiB;
constexpr size_t WS_ST = 148 * MiB;
constexpr size_t WS_YA = 148 * MiB;
constexpr size_t WS_MP = 164 * MiB;
constexpr size_t WS_XS = 132 * MiB;
constexpr size_t WS_Y = 132 * MiB;
constexpr size_t WS_R = 224 * MiB, WS_WM1 = 240 * MiB, WS_KP = 256 * MiB, WS_AA = 272 * MiB, WS_BB = 288 * MiB, WS_V = 304 * MiB;
constexpr size_t WS_WGU = 224 * MiB;
constexpr size_t WS_WD = 256 * MiB;
constexpr size_t WS_HID = 272 * MiB;
constexpr size_t WS_VF = 320 * MiB;
constexpr size_t WS_END = 336 * MiB;

enum { I_X = 0, I_C, I_WMOD, I_BMOD, I_WIN, I_MU, I_W0, I_W2, I_A0, I_A2, I_G2, I_KK, I_KA, I_RK, I_GNG, I_GNB, I_VM0, I_VM1, I_VM2,
       I_SGG, I_SGB, I_WS, I_BS, I_WBA, I_WBB, I_WOUT, I_LN1G, I_LN1B, I_RW, I_RB, I_EG, I_EU, I_ED, I_LN2G, I_LN2B, N_IN };

struct Args { const float* in[N_IN]; float* out; unsigned char* ws; int ph_lo, ph_hi; };

__device__ __forceinline__ float bf2f(bf16 h) { return __uint_as_float(((unsigned)h) << 16); }
__device__ __forceinline__ unsigned f2bfu(float f) { unsigned u = __float_as_uint(f); return (u + 0x7fffu + ((u >> 16) & 1u)) >> 16; }
__device__ __forceinline__ bf16 f2bf(float f) { return (bf16)f2bfu(f); }
__device__ __forceinline__ unsigned pk2(float lo, float hi) { return f2bfu(lo) | (f2bfu(hi) << 16); }
__device__ __forceinline__ void store4bf(bf16* p, f32x4 v) { u32x2 w; w.x = pk2(v[0], v[1]); w.y = pk2(v[2], v[3]); *(u32x2*)p = w; }
__device__ __forceinline__ f32x4 load4bf(const bf16* p) { u32x2 w = *(const u32x2*)p; f32x4 r; r[0] = __uint_as_float(w.x << 16); r[1] = __uint_as_float(w.x & 0xffff0000u); r[2] = __uint_as_float(w.y << 16); r[3] = __uint_as_float(w.y & 0xffff0000u); return r; }
__device__ __forceinline__ float wave_sum(float v) {
#pragma unroll
    for (int o = 1; o < 64; o <<= 1) v += __shfl_xor(v, o);
    return v;
}
__device__ __forceinline__ float sigmoidf_(float x) { return 1.0f / (1.0f + __expf(-x)); }
__device__ __forceinline__ float siluf_(float x) { return x * sigmoidf_(x); }
__device__ __forceinline__ float gelu_tanh(float x) { const float u = 0.7978845608028654f * (x + 0.044715f * x * x * x); return x * (1.0f - 1.0f / (1.0f + __expf(2.0f * u))); }
__device__ __forceinline__ float softplusf_(float y) { return fmaxf(y, 0.f) + log1pf(__expf(-fabsf(y))); }

struct Ctx { int tid, lane, wave, gw, ngw; unsigned char* lds; };

__device__ __forceinline__ void transpose_item(const float* Wsrc, int N, int k0, int n0, bf16* dst, int ldk, float* scr, int lane) {
#pragma unroll 8
    for (int i = 0; i < 32; ++i) { const int kk = 2 * i + (lane >> 5); scr[kk * 33 + (lane & 31)] = Wsrc[(size_t)(k0 + kk) * N + n0 + (lane & 31)]; }
    asm volatile("s_waitcnt lgkmcnt(0)" ::: "memory");
    const int c = lane & 7;
#pragma unroll
    for (int j = 0; j < 4; ++j) { const int n = (lane >> 3) + 8 * j; const float* s = scr + (8 * c) * 33 + n;
        u32x4 o; o.x = pk2(s[0 * 33], s[1 * 33]); o.y = pk2(s[2 * 33], s[3 * 33]); o.z = pk2(s[4 * 33], s[5 * 33]); o.w = pk2(s[6 * 33], s[7 * 33]);
        *(u32x4*)(dst + (size_t)n * ldk + k0 + 8 * c) = o; }
    asm volatile("s_waitcnt lgkmcnt(0)" ::: "memory");
}
template <class RowMap>
__device__ __forceinline__ void transpose_matrix_item(const float* Wsrc, int K, int N, bf16* dst, int item, float* scr, int lane, const RowMap& rm) {
    const int nblk = N / 32, kb = item / nblk, nb = item % nblk, n0 = 32 * nb;
    transpose_item(Wsrc, N, 64 * kb, n0, dst + (size_t)rm(n0) * K, K, scr, lane);
}
struct RowId { __device__ __forceinline__ int operator()(int n) const { return n; } };
struct RowGU { int up; __device__ __forceinline__ int operator()(int n) const { return (n >> 7) * 256 + (n & 127) + up * 128; } };

__device__ __forceinline__ void phase_p0a(const Args& a, const Ctx& c) {
    float* scr = (float*)(c.lds + c.wave * 16384);
    float* PART = (float*)(a.ws + WS_PART);
    for (int it = c.gw; it < 2 * 96 * 16; it += c.ngw) {
        const int kb = it & 15, cb = (it >> 4) % 96, l = it / (16 * 96);
        const int n = cb * 64 + c.lane;
        const float* wm = a.in[I_WMOD] + (size_t)l * D * 6144;
        float acc = 0.f;
#pragma unroll 8
        for (int k = 0; k < 64; ++k) { const int kk = kb * 64 + k; acc += siluf_(a.in[I_C][kk]) * wm[(size_t)kk * 6144 + n]; }
        PART[((size_t)l * 16 + kb) * 6144 + n] = acc;
    }
    constexpr int I_WINL = (D / 64) * (INC / 32);
    constexpr int I_WAL = (W / 64) * (D / 32);
    constexpr int I_WOL = (D / 64) * (D / 32);
    constexpr int PER_L = I_WINL + 2 * I_WAL + I_WOL;
    for (int it = c.gw; it < 2 * PER_L; it += c.ngw) {
        const int l = it / PER_L; int r = it % PER_L;
        if (r < I_WINL) { transpose_matrix_item(a.in[I_WIN] + (size_t)l * D * INC, D, INC, (bf16*)(a.ws + WS_WIN + (size_t)l * 10 * MiB), r, scr, c.lane, RowId()); continue; } r -= I_WINL;
        if (r < I_WAL) { transpose_matrix_item(a.in[I_WBA] + (size_t)l * W * D, W, D, (bf16*)(a.ws + WS_WA + (size_t)l * WS_WL1), r, scr, c.lane, RowId()); continue; } r -= I_WAL;
        if (r < I_WAL) { transpose_matrix_item(a.in[I_WBB] + (size_t)l * W * D, W, D, (bf16*)(a.ws + WS_WB + (size_t)l * WS_WL1), r, scr, c.lane, RowId()); continue; } r -= I_WAL;
        transpose_matrix_item(a.in[I_WOUT] + (size_t)l * D * D, D, D, (bf16*)(a.ws + WS_WO + (size_t)l * WS_WL1), r, scr, c.lane, RowId());
    }
}

__device__ __forceinline__ void row_stats(const float (&v)[16], float& mean, float& rstd) {
    float s = 0.f;
#pragma unroll
    for (int j = 0; j < 16; ++j) s += v[j];
    mean = wave_sum(s) * (1.f / D);
    float q = 0.f;
#pragma unroll
    for (int j = 0; j < 16; ++j) { const float d = v[j] - mean; q += d * d; }
    rstd = 1.0f / sqrtf(wave_sum(q) * (1.f / D) + LN_EPS);
}
__device__ __forceinline__ void load_row16(const float* p, int lane, float (&v)[16]) {
#pragma unroll
    for (int j = 0; j < 4; ++j) { const f32x4 x = *(const f32x4*)(p + 4 * lane + 256 * j); v[4 * j] = x[0]; v[4 * j + 1] = x[1]; v[4 * j + 2] = x[2]; v[4 * j + 3] = x[3]; }
}

__device__ __forceinline__ void phase_p0b(const Args& a, const Ctx& c) {
    const float* PART = (const float*)(a.ws + WS_PART);
    float* MODF = (float*)(a.ws + WS_MODF);
    for (int i = blockIdx.x * NTHREADS + c.tid; i < 2 * 6144; i += gridDim.x * NTHREADS) {
        const int l = i / 6144, n = i % 6144; float s = a.in[I_BMOD][i];
#pragma unroll
        for (int kb = 0; kb < 16; ++kb) s += PART[((size_t)l * 16 + kb) * 6144 + n];
        MODF[i] = s;
    }
    float sh[16], sc[16];
#pragma unroll
    for (int j = 0; j < 4; ++j)
#pragma unroll
        for (int e = 0; e < 4; ++e) { const int col = 4 * c.lane + 256 * j + e; float s0 = a.in[I_BMOD][col], s1 = a.in[I_BMOD][1024 + col];
            for (int kb = 0; kb < 16; ++kb) { s0 += PART[(size_t)kb * 6144 + col]; s1 += PART[(size_t)kb * 6144 + 1024 + col]; }
            sh[4 * j + e] = s0; sc[4 * j + e] = 1.f + s1; }
    bf16* XN = (bf16*)(a.ws + WS_XN);
    for (int m = c.gw; m < T; m += c.ngw) {
        float v[16]; load_row16(a.in[I_X] + (size_t)m * D, c.lane, v);
        float mean, rstd; row_stats(v, mean, rstd);
#pragma unroll
        for (int j = 0; j < 4; ++j) { f32x4 o;
#pragma unroll
            for (int e = 0; e < 4; ++e) o[e] = (v[4 * j + e] - mean) * rstd * sc[4 * j + e] + sh[4 * j + e];
            store4bf(XN + (size_t)m * D + 4 * c.lane + 256 * j, o); }
    }
}

namespace pg8 {
#define PG8_LAS __attribute__((address_space(3)))
typedef unsigned short bf16_t;
typedef short bf16x8 __attribute__((ext_vector_type(8)));
typedef float f32x4 __attribute__((ext_vector_type(4)));
typedef unsigned u32x4 __attribute__((ext_vector_type(4)));
constexpr int BM = 256, BK = 64, HALF = 128, HTB = HALF * BK * 2  , STAGE_BYTES = 8 * HTB, NXCD = 8, WGM = 8;

__host__ __device__ __forceinline__ int lds_byte(int r, int c) { const int st = (r >> 4) * 2 + (c >> 5), rr = r & 15, cc = c & 31, ob = rr * 64 + cc * 2; return st * 1024 + (ob ^ (((ob >> 9) & 1) << 5)); }
__host__ __device__ __forceinline__ void stage_rc(int b, int& R, int& C) { const int st = b / 1024, sb = b % 1024, swz = sb ^ (((sb >> 9) & 1) << 5); R = (st >> 1) * 16 + swz / 64; C = (st & 1) * 32 + (swz % 64) / 2; }
__host__ __device__ __forceinline__ int perm32(int rho) { const int n = rho >> 4, i = rho & 15; return 8 * (i >> 2) + 4 * n + (i & 3); }

struct Unit { int pm, pn; };
struct Gemm { const bf16_t* A; const bf16_t* Bt; int M, N, K; };

struct StaticOrder {
    int nM, nN, nwg, G, c;
    __host__ __device__ void init(int M, int N, int G_, int c_) { nM = M / BM; nN = N / BM; nwg = nM * nN; G = G_; c = c_; }
    __host__ __device__ bool next(int i, Unit& u) const {
        const long L = (long)i * G + c; if (L >= nwg) return false;
        int wgid = (int)L; { const int q = nwg / NXCD, r = nwg % NXCD, xcd = wgid % NXCD, off = wgid / NXCD; wgid = (xcd < r ? xcd * (q + 1) : r * (q + 1) + (xcd - r) * q) + off; }
        const int nig = WGM * nN, gid = wgid / nig, fm = gid * WGM, gsz = (nM - fm) < WGM ? (nM - fm) : WGM;
        u.pm = fm + ((wgid % nig) % gsz); u.pn = (wgid % nig) / gsz; return true;
    }
    __device__ __forceinline__ void a_ready(const Unit&) const {}
    __device__ __forceinline__ void done(const Unit&) const {}
};


template <class Epi, class Sched, bool ALIGN_EPI = false, bool SP2 = false>
__device__ __forceinline__ void gemm_phase(PG8_LAS unsigned char* lds, const Gemm g, const Sched& S, const Epi& E) {
    const int tid = threadIdx.x, wid = __builtin_amdgcn_readfirstlane(tid >> 6), lane = tid & 63, wr = wid >> 2, wc = wid & 3, fr = lane & 15, fq = lane >> 4;
    const int K = g.K, nt = K / BK;
    unsigned voffA[2], voffB[2];
#pragma unroll
    for (int i = 0; i < 2; ++i) { int R, C; stage_rc(tid * 16 + i * 8192, R, C); const int Rb = Epi::PERM ? ((R & ~31) + perm32(R & 31)) : R;
        voffA[i] = (unsigned)(R * K + C) * 2u; voffB[i] = (unsigned)(Rb * K + C) * 2u; }
    const size_t kstep = (size_t)(BK * 2);
    const size_t hstep = (size_t)HALF * K * 2;
    const size_t tstep = 2 * hstep;
    const unsigned ldsw = (unsigned)wid * 1024u;
    const int aoff = lds_byte(wr * 64 + fr, fq * 8), boff = lds_byte(wc * 32 + fr, fq * 8);
#define PG8_SA(b, h) (((b) * 2 + (h)) * HTB)
#define PG8_SB(b, h) ((4 + (b) * 2 + (h)) * HTB)
#define PG8_STAGE(bufoff, gbase, voff) do { _Pragma("unroll") for (int _i = 0; _i < 2; ++_i) \
        __builtin_amdgcn_global_load_lds((const unsigned*)((const char*)(gbase) + (voff)[_i]), (PG8_LAS unsigned*)(lds + (bufoff) + ldsw + _i * 8192), 16, 0, 0); } while (0)
#define PG8_LDA(dst, b, h) do { _Pragma("unroll") for (int m = 0; m < 4; ++m) _Pragma("unroll") for (int k = 0; k < 2; ++k) dst[m][k] = *(const PG8_LAS bf16x8*)(lds + PG8_SA(b, h) + aoff + m * 2048 + k * 1024); } while (0)
#define PG8_LDB(dst, b, h) do { _Pragma("unroll") for (int n = 0; n < 2; ++n) _Pragma("unroll") for (int k = 0; k < 2; ++k) dst[n][k] = *(const PG8_LAS bf16x8*)(lds + PG8_SB(b, h) + boff + n * 2048 + k * 1024); } while (0)
#define PG8_MMA(ai, bj, At, Bt) do { __builtin_amdgcn_s_setprio(1); _Pragma("unroll") for (int m = 0; m < 4; ++m) _Pragma("unroll") for (int n = 0; n < 2; ++n) _Pragma("unroll") for (int k = 0; k < 2; ++k) \
        acc[ai][bj][m][n] = __builtin_amdgcn_mfma_f32_16x16x32_bf16(Bt[n][k], At[m][k], acc[ai][bj][m][n], 0, 0, 0); __builtin_amdgcn_s_setprio(0); } while (0)
#define PG8_WAIT_V(n) asm volatile("s_waitcnt vmcnt(" #n ")" ::: "memory")
#define PG8_WAIT_L(n) asm volatile("s_waitcnt lgkmcnt(" #n ")" ::: "memory")
#define PG8_BAR __builtin_amdgcn_s_barrier()
#define PG8_SCHED __builtin_amdgcn_sched_barrier(0)
    Unit cur, nxt; int ui = 0;
    if (!S.next(0, cur)) return;
    f32x4 acc[2][2][4][2];
#pragma unroll
    for (int a = 0; a < 2; ++a)
#pragma unroll
        for (int b = 0; b < 2; ++b)
#pragma unroll
            for (int m = 0; m < 4; ++m)
#pragma unroll
                for (int n = 0; n < 2; ++n) acc[a][b][m][n] = (f32x4){0.f, 0.f, 0.f, 0.f};
    bf16x8 At[4][2], B0[2][2], B1[2][2];
    const char* cA = (const char*)g.A + (size_t)cur.pm * tstep; const char* cB = (const char*)g.Bt + (size_t)cur.pn * tstep;
    S.a_ready(cur);
    if constexpr (SP2) {
        PG8_STAGE(PG8_SB(0, 0), cB, voffB); PG8_STAGE(PG8_SB(0, 1), cB + hstep, voffB); PG8_STAGE(PG8_SA(0, 0), cA, voffA); PG8_STAGE(PG8_SA(0, 1), cA + hstep, voffA);
        if (wr == 1) PG8_BAR;
        PG8_WAIT_V(2); PG8_BAR;
        PG8_STAGE(PG8_SB(1, 0), cB + kstep, voffB); PG8_STAGE(PG8_SA(1, 0), cA + kstep, voffA); PG8_STAGE(PG8_SB(1, 1), cB + hstep + kstep, voffB);
        PG8_WAIT_V(6); PG8_BAR;
    } else {
        PG8_STAGE(PG8_SB(0, 0), cB, voffB); PG8_STAGE(PG8_SA(0, 0), cA, voffA); PG8_STAGE(PG8_SB(0, 1), cB + hstep, voffB); PG8_STAGE(PG8_SA(0, 1), cA + hstep, voffA);
        if (wr == 1) PG8_BAR;
        PG8_WAIT_V(4); PG8_BAR;
        PG8_STAGE(PG8_SB(1, 0), cB + kstep, voffB); PG8_STAGE(PG8_SA(1, 0), cA + kstep, voffA); PG8_STAGE(PG8_SB(1, 1), cB + hstep + kstep, voffB);
        PG8_WAIT_V(6); PG8_BAR;
    }
    for (;;) {
        const bool has_next = S.next(ui + 1, nxt);
        const char* nA = has_next ? (const char*)g.A + (size_t)nxt.pm * tstep : cA; const char* nB = has_next ? (const char*)g.Bt + (size_t)nxt.pn * tstep : cB;
        for (int t = 0; t < nt; t += 2) {
            const bool last = (t == nt - 2);
            const char* a1 = cA + (size_t)(t + 1) * kstep;
            const char* a2 = last ? nA : cA + (size_t)(t + 2) * kstep; const char* b2 = last ? nB : cB + (size_t)(t + 2) * kstep;
            const char* a3 = a2 + kstep; const char* b3 = b2 + kstep;
            if (last && has_next) S.a_ready(nxt);
            if constexpr (SP2) {
            PG8_LDB(B0, 0, 0); PG8_LDB(B1, 0, 1); PG8_SCHED; PG8_LDA(At, 0, 0); PG8_STAGE(PG8_SA(1, 1), a1 + hstep, voffA);
            PG8_WAIT_V(8); PG8_WAIT_L(0); PG8_BAR; PG8_MMA(0, 0, At, B0); PG8_MMA(0, 1, At, B1); PG8_BAR; PG8_SCHED;
            PG8_LDA(At, 0, 1); PG8_STAGE(PG8_SB(0, 0), b2, voffB); PG8_STAGE(PG8_SB(0, 1), b2 + hstep, voffB); PG8_STAGE(PG8_SA(0, 0), a2, voffA);
            PG8_WAIT_V(8); PG8_WAIT_L(0); PG8_BAR; PG8_MMA(1, 0, At, B0); PG8_MMA(1, 1, At, B1); PG8_BAR; PG8_SCHED;
            PG8_LDB(B0, 1, 0); PG8_LDB(B1, 1, 1); PG8_SCHED; PG8_LDA(At, 1, 0); PG8_STAGE(PG8_SA(0, 1), a2 + hstep, voffA);
            PG8_WAIT_V(8); PG8_WAIT_L(0); PG8_BAR; PG8_MMA(0, 0, At, B0); PG8_MMA(0, 1, At, B1); PG8_BAR; PG8_SCHED;
            PG8_LDA(At, 1, 1); PG8_STAGE(PG8_SB(1, 0), b3, voffB); PG8_STAGE(PG8_SB(1, 1), b3 + hstep, voffB); PG8_STAGE(PG8_SA(1, 0), a3, voffA);
            PG8_WAIT_V(8); PG8_WAIT_L(0); PG8_BAR; PG8_MMA(1, 0, At, B0); PG8_MMA(1, 1, At, B1); PG8_BAR; PG8_SCHED;
            } else {
            PG8_LDB(B0, 0, 0); PG8_SCHED; PG8_LDA(At, 0, 0); PG8_STAGE(PG8_SA(1, 1), a1 + hstep, voffA);
            PG8_WAIT_L(8); PG8_BAR; PG8_WAIT_L(0); PG8_MMA(0, 0, At, B0); PG8_BAR; PG8_SCHED;
            PG8_LDB(B1, 0, 1); PG8_STAGE(PG8_SB(0, 0), b2, voffB);
            PG8_BAR; PG8_WAIT_L(0); PG8_MMA(0, 1, At, B1); PG8_BAR;
            PG8_LDA(At, 0, 1); PG8_STAGE(PG8_SA(0, 0), a2, voffA);
            PG8_BAR; PG8_WAIT_L(0); PG8_MMA(1, 0, At, B0); PG8_BAR; PG8_SCHED;
            PG8_STAGE(PG8_SB(0, 1), b2 + hstep, voffB);
            PG8_WAIT_V(6); PG8_BAR; PG8_MMA(1, 1, At, B1); PG8_BAR;
            PG8_LDB(B0, 1, 0); PG8_SCHED; PG8_LDA(At, 1, 0); PG8_STAGE(PG8_SA(0, 1), a2 + hstep, voffA);
            PG8_WAIT_L(8); PG8_BAR; PG8_WAIT_L(0); PG8_MMA(0, 0, At, B0); PG8_BAR; PG8_SCHED;
            PG8_LDB(B1, 1, 1); PG8_STAGE(PG8_SB(1, 0), b3, voffB);
            PG8_BAR; PG8_WAIT_L(0); PG8_MMA(0, 1, At, B1); PG8_BAR;
            PG8_LDA(At, 1, 1); PG8_STAGE(PG8_SA(1, 0), a3, voffA);
            PG8_BAR; PG8_WAIT_L(0); PG8_MMA(1, 0, At, B0); PG8_BAR; PG8_SCHED;
            PG8_STAGE(PG8_SB(1, 1), b3 + hstep, voffB);
            PG8_WAIT_V(6); PG8_BAR; PG8_MMA(1, 1, At, B1); PG8_BAR;
            }
        }
        if constexpr (ALIGN_EPI) { if (wr == 0) PG8_BAR; }
        if constexpr (!Epi::AFTER_DRAIN) { E(acc, cur, wr, wc, fr, fq); S.done(cur); }
        if (!has_next) break;
#pragma unroll
        for (int a = 0; a < 2; ++a)
#pragma unroll
            for (int b = 0; b < 2; ++b)
#pragma unroll
                for (int m = 0; m < 4; ++m)
#pragma unroll
                    for (int n = 0; n < 2; ++n) acc[a][b][m][n] = (f32x4){0.f, 0.f, 0.f, 0.f};
        cur = nxt; cA = nA; cB = nB; ++ui;
        if constexpr (ALIGN_EPI) { if (wr == 1) PG8_BAR; }
    }
    PG8_WAIT_V(0);
    if constexpr (!ALIGN_EPI) { if (wr == 0) PG8_BAR; }
    PG8_BAR;
    if constexpr (Epi::AFTER_DRAIN) { E.fused(acc, cur, wr, wc, fr, fq, lds, wid, lane); S.done(cur); }
#undef PG8_SA
#undef PG8_SB
#undef PG8_STAGE
#undef PG8_LDA
#undef PG8_LDB
#undef PG8_MMA
#undef PG8_WAIT_V
#undef PG8_WAIT_L
#undef PG8_BAR
#undef PG8_SCHED
}
}

using pg8::Unit;
struct DenseSched { int nN, n, G, c;
    __device__ __forceinline__ void a_ready(const Unit&) const {}
    __device__ __forceinline__ void done(const Unit&) const {}
    __device__ __forceinline__ bool next(int i, Unit& u) const { const int L = i * G + c; if (L >= n) return false; u.pm = L / nN; u.pn = L % nN; return true; } };

template <class Sched, class Epi>
__device__ __forceinline__ void gemm_simple(const Ctx& c, const bf16* A, const bf16* Bt, int K, const Sched& S, const Epi& E) {
    float* As = (float*)c.lds;
    float* Bs = As + 32 * 256;
    const int tid = c.tid, rg = tid >> 4, cg = tid & 15;
    Unit u;
    for (int ui = 0; S.next(ui, u); ++ui) {
        float acc[8][16];
#pragma unroll
        for (int i = 0; i < 8; ++i)
#pragma unroll
            for (int j = 0; j < 16; ++j) acc[i][j] = 0.f;
        const bf16* Ab = A + (size_t)u.pm * 256 * K; const bf16* Bb = Bt + (size_t)u.pn * 256 * K;
        for (int k0 = 0; k0 < K; k0 += 32) {
            { const int row = tid >> 1, kh = tid & 1;
              const u32x4* pa = (const u32x4*)(Ab + (size_t)row * K + k0 + 16 * kh); const u32x4 a0 = pa[0], a1 = pa[1];
              const u32x4* pb = (const u32x4*)(Bb + (size_t)row * K + k0 + 16 * kh); const u32x4 b0 = pb[0], b1 = pb[1];
#pragma unroll
              for (int j = 0; j < 4; ++j) {
                  As[(16 * kh + 2 * j) * 256 + row] = __uint_as_float(a0[j] << 16); As[(16 * kh + 2 * j + 1) * 256 + row] = __uint_as_float(a0[j] & 0xffff0000u);
                  As[(16 * kh + 8 + 2 * j) * 256 + row] = __uint_as_float(a1[j] << 16); As[(16 * kh + 8 + 2 * j + 1) * 256 + row] = __uint_as_float(a1[j] & 0xffff0000u);
                  Bs[(16 * kh + 2 * j) * 256 + row] = __uint_as_float(b0[j] << 16); Bs[(16 * kh + 2 * j + 1) * 256 + row] = __uint_as_float(b0[j] & 0xffff0000u);
                  Bs[(16 * kh + 8 + 2 * j) * 256 + row] = __uint_as_float(b1[j] << 16); Bs[(16 * kh + 8 + 2 * j + 1) * 256 + row] = __uint_as_float(b1[j] & 0xffff0000u);
              } }
            __syncthreads();
#pragma unroll 4
            for (int kk = 0; kk < 32; ++kk) {
                const f32x4 a0 = *(const f32x4*)(As + kk * 256 + rg * 8), a1 = *(const f32x4*)(As + kk * 256 + rg * 8 + 4);
                f32x4 b[4];
#pragma unroll
                for (int q = 0; q < 4; ++q) b[q] = *(const f32x4*)(Bs + kk * 256 + 64 * q + 4 * cg);
#pragma unroll
                for (int i = 0; i < 8; ++i) { const float av = i < 4 ? a0[i & 3] : a1[i & 3];
#pragma unroll
                    for (int q = 0; q < 4; ++q)
#pragma unroll
                        for (int e = 0; e < 4; ++e) acc[i][4 * q + e] += av * b[q][e]; }
            }
            __syncthreads();
        }
#pragma unroll
        for (int i = 0; i < 8; ++i) { const int row = u.pm * 256 + rg * 8 + i;
#pragma unroll
            for (int q = 0; q < 2; ++q) { const int col = u.pn * 256 + 64 * q + 4 * cg;
                f32x4 v0, v1;
#pragma unroll
                for (int e = 0; e < 4; ++e) { v0[e] = acc[i][4 * q + e]; v1[e] = acc[i][4 * (q + 2) + e]; }
                E(row, col, v0, v1); } }
    }
}

struct EpiZ { bf16 *ZR, *ZS, *ZG;
    __device__ __forceinline__ void one(int row, int col, f32x4 v) const {
        if (col < RC) store4bf(ZR + (size_t)row * RC + col, v);
        else if (col < RC + 1024) { f32x4 g; for (int e = 0; e < 4; ++e) g[e] = gelu_tanh(v[e]); store4bf(ZS + (size_t)row * 1024 + (col - RC), g); }
        else { f32x4 g; for (int e = 0; e < 4; ++e) g[e] = sigmoidf_(v[e]); store4bf(ZG + (size_t)row * 2048 + (col - RC - 1024), g); } }
    __device__ __forceinline__ void operator()(int row, int col, f32x4 v0, f32x4 v1) const { one(row, col, v0); one(row, col + 128, v1); } };
struct EpiGA { const bf16* ZG; bf16* MP;
    __device__ __forceinline__ void one(int row, int col, f32x4 v) const { const f32x4 g = load4bf(ZG + (size_t)row * 2048 + col); store4bf(MP + (size_t)row * D + col, g * v); }
    __device__ __forceinline__ void operator()(int row, int col, f32x4 v0, f32x4 v1) const { one(row, col, v0); one(row, col + 128, v1); } };
struct EpiGB { const bf16* ZG; bf16* MP;
    __device__ __forceinline__ void one(int row, int col, f32x4 v) const { const f32x4 g = load4bf(ZG + (size_t)row * 2048 + 1024 + col); const f32x4 m = load4bf(MP + (size_t)row * D + col); store4bf(MP + (size_t)row * D + col, m + g * v); }
    __device__ __forceinline__ void operator()(int row, int col, f32x4 v0, f32x4 v1) const { one(row, col, v0); one(row, col + 128, v1); } };
struct EpiOut { const float* xin; float* out; const float* gate1;
    __device__ __forceinline__ void one(int row, int col, f32x4 v) const { const f32x4 x = *(const f32x4*)(xin + (size_t)row * D + col); const f32x4 g = *(const f32x4*)(gate1 + col);
        *(f32x4*)(out + (size_t)row * D + col) = ALPHA * x + (1.0f + g) * v; }
    __device__ __forceinline__ void operator()(int row, int col, f32x4 v0, f32x4 v1) const { one(row, col, v0); one(row, col + 128, v1); } };
struct EpiSwi { bf16* HID;
    __device__ __forceinline__ void operator()(int row, int col, f32x4 v0, f32x4 v1) const { const int ct = (col >> 8) & 3, cc = col & 127;
        f32x4 h; for (int e = 0; e < 4; ++e) h[e] = siluf_(v0[e]) * v1[e]; store4bf(HID + (size_t)row * FF + ct * 128 + cc, h); } };
struct EpiDown { const int* S2T; const float* TOKW; bf16* Y;
    __device__ __forceinline__ void operator()(int row, int col, f32x4 v0, f32x4 v1) const { const int st = S2T[row]; if (st < 0) return; const float w = TOKW[st]; const int cc = col & 1023;
        store4bf(Y + (size_t)st * D + cc, w * v0); store4bf(Y + (size_t)st * D + cc + 128, w * v1); } };

struct MoeSched { int ts[17]; int G, c;
    __device__ __forceinline__ void a_ready(const Unit&) const {}
    __device__ __forceinline__ void done(const Unit&) const {}
    __device__ __forceinline__ void init(const unsigned* cnt, int G_, int c_) { G = G_; c = c_; int s = 0;
#pragma unroll
        for (int e = 0; e < 16; ++e) { ts[e] = s; s += ((int)cnt[e] + 255) >> 8; } ts[16] = s; }
    __device__ __forceinline__ bool next(int i, Unit& u) const { const int L = i * G + c; if (L >= 4 * ts[16]) return false; const int rt = L >> 2, ct = L & 3; int e = 0;
#pragma unroll
        for (int j = 1; j < 16; ++j) e += (rt >= ts[j]) ? 1 : 0;
        u.pm = rt; u.pn = e * 4 + ct; return true; } };

__device__ __forceinline__ void phase_prep_simple(const Args& a, const Ctx& c, int l) {
    const bf16* ZR = (const bf16*)(a.ws + WS_ZR);
    const float* mu = a.in[I_MU] + l * RC; const float* w0 = a.in[I_W0] + l * W; const float* w2 = a.in[I_W2] + (size_t)l * 64 * W;
    const float* a0 = a.in[I_A0] + l * W; const float* a2 = a.in[I_A2] + (size_t)l * 64 * W; const float* g2 = a.in[I_G2] + (size_t)l * 128 * W;
    const float* k_k = a.in[I_KK] + l * W; const float* k_a = a.in[I_KA] + l * W;
    const float* vm0 = a.in[I_VM0]; const float* vm1 = a.in[I_VM1]; const float* vm2 = a.in[I_VM2];
    f16* R = (f16*)(a.ws + WS_R); f16* WM1 = (f16*)(a.ws + WS_WM1); f16* KP = (f16*)(a.ws + WS_KP); f16* AA = (f16*)(a.ws + WS_AA); f16* BB = (f16*)(a.ws + WS_BB); f16* V = (f16*)(a.ws + WS_V);
    bf16* G = (bf16*)(a.ws + WS_G); bf16* VF = (bf16*)(a.ws + WS_VF);
    const int lane = c.lane;
    for (int t = c.gw; t < T; t += c.ngw) {
        float z[28];
#pragma unroll
        for (int i = 0; i < 28; ++i) { const int col = lane + 64 * i; const float zc = bf2f(ZR[(size_t)t * RC + col]); const float zp = t > 0 ? bf2f(ZR[(size_t)(t - 1) * RC + col]) : 0.f; z[i] = zc + (zp - zc) * mu[col]; }
        const float tw = tanhf(z[24]), za = z[25], sg0 = sigmoidf_(z[26]), sg1 = sigmoidf_(z[27]);
        float wlo[8], alo[8], gg[8];
#pragma unroll
        for (int i = 0; i < 8; ++i) { wlo[i] = 0.f; alo[i] = 0.f; gg[i] = 0.f; }
        for (int j = 0; j < 64; ++j) { const float tj = __shfl(tw, j), aj = __shfl(za, j), s0 = __shfl(sg0, j), s1 = __shfl(sg1, j);
#pragma unroll
            for (int i = 0; i < 8; ++i) { const int n = lane + 64 * i; wlo[i] += tj * w2[j * W + n]; alo[i] += aj * a2[j * W + n]; gg[i] += s0 * g2[j * W + n] + s1 * g2[(64 + j) * W + n]; } }
        float vv[8];
#pragma unroll
        for (int i = 0; i < 8; ++i) vv[i] = z[16 + i];
        if (l == 0) {
#pragma unroll
            for (int i = 0; i < 8; ++i) VF[(size_t)t * W + lane + 64 * i] = f2bf(vv[i]);
        } else {
            float vmid = 0.f;
#pragma unroll
            for (int i = 0; i < 8; ++i)
                for (int j = 0; j < 64; ++j) { const float vc = __shfl(vv[i], j); vmid += vc * vm1[(size_t)(64 * i + j) * 32 + (lane & 31)]; }
            float vg[8];
#pragma unroll
            for (int i = 0; i < 8; ++i) vg[i] = 0.f;
            for (int m = 0; m < 32; ++m) { const float vmm = __shfl(vmid, m);
#pragma unroll
                for (int i = 0; i < 8; ++i) vg[i] += vmm * vm2[m * W + lane + 64 * i]; }
#pragma unroll
            for (int i = 0; i < 8; ++i) { const int n = lane + 64 * i; const float vf = bf2f(VF[(size_t)t * W + n]); vv[i] = vv[i] + (vf - vv[i]) * sigmoidf_(vm0[n] + vg[i]); }
        }
#pragma unroll
        for (int i = 0; i < 8; ++i) {
            const int n = lane + 64 * i; const size_t o = (size_t)t * W + n;
            const float x = w0[n] + wlo[i]; const float wl = -softplusf_(-x) - 0.5f; const float dm1 = expm1f(-__expf(wl));
            const float av = sigmoidf_(a0[n] + alo[i]);
            const float kraw = z[8 + i];
            float kk = kraw * k_k[n]; const float nrm = sqrtf(wave_sum(kk * kk)); kk = kk / fmaxf(nrm, 1e-12f);
            const float kp = kraw * (1.0f + (av - 1.0f) * k_a[n]);
            R[o] = (f16)z[i]; WM1[o] = (f16)dm1; KP[o] = (f16)kp; AA[o] = (f16)(-kk); BB[o] = (f16)(kk * av); V[o] = (f16)vv[i]; G[o] = f2bf(gg[i]);
        }
    }
}

__device__ __forceinline__ void phase_sg_simple(const Args& a, const Ctx& c, int l) {
    const bf16* ZS = (const bf16*)(a.ws + WS_ZS); bf16* YB = (bf16*)(a.ws + WS_YB);
    const float* lng = a.in[I_SGG] + l * W; const float* lnb = a.in[I_SGB] + l * W;
    float* vn = (float*)c.lds;
    float* st = vn + 128 * 64;
    for (int uidx = blockIdx.x; uidx < 128 * 8; uidx += gridDim.x) {
        const int ch = uidx >> 3, g = uidx & 7; const int tok0 = ch * 128;
        for (int i = 0; i < 16; ++i) { const int s = c.wave * 16 + i; const bf16* p = ZS + (size_t)(tok0 + s) * 1024 + 512 + c.lane * 8;
            const f32x4 x0 = load4bf(p), x1 = load4bf(p + 4);
            float sm = (x0[0] + x0[1]) + (x0[2] + x0[3]) + (x1[0] + x1[1]) + (x1[2] + x1[3]); const float mean = wave_sum(sm) * (1.f / 512.f);
            float q = 0.f; for (int e = 0; e < 4; ++e) { const float d0 = x0[e] - mean, d1 = x1[e] - mean; q += d0 * d0 + d1 * d1; }
            const float rstd = 1.0f / sqrtf(wave_sum(q) * (1.f / 512.f) + LN_EPS);
            if (c.lane == 0) { st[2 * s] = mean; st[2 * s + 1] = rstd; } }
        __syncthreads();
        for (int i = c.tid; i < 128 * 64; i += NTHREADS) { const int s = i >> 6, d = i & 63; const float x = bf2f(ZS[(size_t)(tok0 + s) * 1024 + 512 + g * 64 + d]);
            vn[i] = (x - st[2 * s]) * st[2 * s + 1] * lng[g * 64 + d] + lnb[g * 64 + d]; }
        __syncthreads();
        const int d = c.tid & 63, tq = c.tid >> 6;
        const float* Wg = a.in[I_WS] + (size_t)(l * 8 + g) * 128 * 128; const float* bs = a.in[I_BS] + (size_t)(l * 8 + g) * 128;
        for (int i = 0; i < 16; ++i) { const int t = tq + 8 * i; float acc = 0.f;
            for (int s = 0; s <= t; ++s) acc += Wg[t * 128 + s] * vn[s * 64 + d];
            const float u = bf2f(ZS[(size_t)(tok0 + t) * 1024 + g * 64 + d]);
            YB[(size_t)(tok0 + t) * W + g * 64 + d] = f2bf(u * (acc + bs[t])); }
        __syncthreads();
    }
}

__device__ __forceinline__ void phase_scan_simple(const Args& a, const Ctx& c) {
    if (c.wave != 0 || blockIdx.x >= NH) return;
    const int h = blockIdx.x, lane = c.lane;
    const f16* R = (const f16*)(a.ws + WS_R); const f16* WM1 = (const f16*)(a.ws + WS_WM1); const f16* KP = (const f16*)(a.ws + WS_KP);
    const f16* AA = (const f16*)(a.ws + WS_AA); const f16* BB = (const f16*)(a.ws + WS_BB); const f16* V = (const f16*)(a.ws + WS_V);
    bf16* YSC = (bf16*)(a.ws + WS_YSC);
    float S[64];
#pragma unroll
    for (int j = 0; j < 64; ++j) S[j] = 0.f;
    for (int t = 0; t < T; ++t) {
        const size_t base = (size_t)t * W + h * 64;
        const float vv = (float)V[base + lane];
        float sa = 0.f;
#pragma unroll
        for (int j = 0; j < 64; ++j) sa += S[j] * (float)AA[base + j];
        float y = 0.f;
#pragma unroll
        for (int j = 0; j < 64; ++j) { float s = S[j]; s = s + s * (float)WM1[base + j]; s += sa * (float)BB[base + j]; s += vv * (float)KP[base + j]; S[j] = s; y += s * (float)R[base + j]; }
        YSC[base + lane] = f2bf(y);
    }
}

__device__ __forceinline__ void phase_post(const Args& a, const Ctx& c, int l) {
    const bf16* YSC = (const bf16*)(a.ws + WS_YSC); const f16* R = (const f16*)(a.ws + WS_R); const f16* KP = (const f16*)(a.ws + WS_KP); const f16* V = (const f16*)(a.ws + WS_V);
    const bf16* G = (const bf16*)(a.ws + WS_G); bf16* YA = (bf16*)(a.ws + WS_YA);
    const float* gng = a.in[I_GNG] + l * W; const float* gnb = a.in[I_GNB] + l * W; const float* rk = a.in[I_RK] + l * W;
    for (int t = c.gw; t < T; t += c.ngw) {
#pragma unroll
        for (int i = 0; i < 8; ++i) { const int n = c.lane + 64 * i; const size_t o = (size_t)t * W + n;
            const float y = bf2f(YSC[o]); const float mean = wave_sum(y) * (1.f / 64.f); const float d = y - mean; const float var = wave_sum(d * d) * (1.f / 64.f);
            float yn = d * (1.0f / sqrtf(var + GN_EPS)) * gng[n] + gnb[n];
            const float r = (float)R[o], k = (float)KP[o], v = (float)V[o];
            const float bonus = wave_sum(r * k * rk[n]);
            yn += bonus * v;
            YA[o] = f2bf(yn * bf2f(G[o])); }
    }
}

__device__ __forceinline__ void phase_ln1(const Args& a, const Ctx& c, int l) {
    const float* MODF = (const float*)(a.ws + WS_MODF) + l * 6144;
    const float* g1 = a.in[I_LN1G] + l * D; const float* b1 = a.in[I_LN1B] + l * D;
    bf16* XN = (bf16*)(a.ws + WS_XN);
    int* TOKI = (int*)(a.ws + WS_TOKI); float* TOKW = (float*)(a.ws + WS_TOKW); int* TOKP = (int*)(a.ws + WS_TOKP);
    unsigned* cnt = (unsigned*)(a.ws + WS_CTL) + CW_CNT + 64 * l;
    const float* rw = a.in[I_RW]; const float* rb = a.in[I_RB];
    for (int m = c.gw; m < T; m += c.ngw) {
        float v[16]; load_row16(a.out + (size_t)m * D, c.lane, v);
        float mean, rstd; row_stats(v, mean, rstd);
#pragma unroll
        for (int j = 0; j < 4; ++j) { f32x4 o; const int col = 4 * c.lane + 256 * j;
#pragma unroll
            for (int e = 0; e < 4; ++e) { v[4 * j + e] = (v[4 * j + e] - mean) * rstd * g1[col + e] + b1[col + e]; o[e] = v[4 * j + e]; }
            *(f32x4*)(a.out + (size_t)m * D + col) = o; }
        row_stats(v, mean, rstd);
        float lg[16];
#pragma unroll
        for (int e = 0; e < 16; ++e) lg[e] = 0.f;
#pragma unroll
        for (int j = 0; j < 4; ++j) { f32x4 o; const int col = 4 * c.lane + 256 * j;
#pragma unroll
            for (int e = 0; e < 4; ++e) { const float h = (v[4 * j + e] - mean) * rstd * (1.0f + MODF[4096 + col + e]) + MODF[3072 + col + e]; o[e] = h;
                const f32x4* rr = (const f32x4*)(rw + (size_t)(col + e) * NE);
#pragma unroll
                for (int q = 0; q < 4; ++q) { const f32x4 r4 = rr[q]; lg[4 * q] += h * r4[0]; lg[4 * q + 1] += h * r4[1]; lg[4 * q + 2] += h * r4[2]; lg[4 * q + 3] += h * r4[3]; } }
            store4bf(XN + (size_t)m * D + col, o); }
        float sc[16], sel[16];
#pragma unroll
        for (int e = 0; e < 16; ++e) { sc[e] = 1.0f / (1.0f + expf(-wave_sum(lg[e]))); sel[e] = sc[e] + rb[e]; }
        int best = 0; float bestv = -INFINITY;
#pragma unroll
        for (int g = 0; g < 4; ++g) { float m1 = -INFINITY, m2 = -INFINITY;
#pragma unroll
            for (int q = 0; q < 4; ++q) { const float s = sel[4 * g + q]; if (s > m1) { m2 = m1; m1 = s; } else if (s > m2) m2 = s; }
            const float gs = m1 + m2; if (gs > bestv) { bestv = gs; best = g; } }
        int i1 = 0, i2 = 0; float s1 = -INFINITY, s2 = -INFINITY, w1 = 0.f, w2 = 0.f;
#pragma unroll
        for (int e = 0; e < 16; ++e) { if ((e >> 2) == best) { const float s = sel[e];
                if (s > s1) { s2 = s1; i2 = i1; w2 = w1; s1 = s; i1 = e; w1 = sc[e]; } else if (s > s2) { s2 = s; i2 = e; w2 = sc[e]; } } }
        if (c.lane == 0) { const float ws = w1 + w2;
            TOKI[2 * m] = i1; TOKI[2 * m + 1] = i2; TOKW[2 * m] = w1 / ws; TOKW[2 * m + 1] = w2 / ws;
            TOKP[2 * m] = (int)atomicAdd(cnt + i1, 1u); TOKP[2 * m + 1] = (int)atomicAdd(cnt + i2, 1u); }
    }
    float* scr = (float*)(c.lds + c.wave * 16384);
    bf16* WGU = (bf16*)(a.ws + WS_WGU); bf16* WD = (bf16*)(a.ws + WS_WD);
    constexpr int IG = (D / 64) * (FF / 32);
    constexpr int ID = (FF / 64) * (D / 32);
    for (int it = c.gw; it < NE * (2 * IG + ID); it += c.ngw) {
        const int e = it / (2 * IG + ID); int r = it % (2 * IG + ID);
        const size_t eo = ((size_t)l * NE + e) * (size_t)D * FF;
        if (r < IG) { transpose_matrix_item(a.in[I_EG] + eo, D, FF, WGU + (size_t)e * 1024 * 1024, r, scr, c.lane, RowGU{0}); continue; } r -= IG;
        if (r < IG) { transpose_matrix_item(a.in[I_EU] + eo, D, FF, WGU + (size_t)e * 1024 * 1024, r, scr, c.lane, RowGU{1}); continue; } r -= IG;
        transpose_matrix_item(a.in[I_ED] + eo, FF, D, WD + (size_t)e * 1024 * 512, r, scr, c.lane, RowId());
    }
}

__device__ __forceinline__ void phase_perm(const Args& a, const Ctx& c, int l) {
    const unsigned* cnt = (const unsigned*)(a.ws + WS_CTL) + CW_CNT + 64 * l;
    int ts[17]; { int s = 0;
#pragma unroll
        for (int e = 0; e < 16; ++e) { ts[e] = s; s += ((int)cnt[e] + 255) >> 8; } ts[16] = s; }
    const int* TOKI = (const int*)(a.ws + WS_TOKI); const int* TOKP = (const int*)(a.ws + WS_TOKP); int* S2T = (int*)(a.ws + WS_S2T);
    const bf16* XN = (const bf16*)(a.ws + WS_XN); bf16* XS = (bf16*)(a.ws + WS_XS);
    for (int as = c.gw; as < 2 * T; as += c.ngw) {
        const int e = TOKI[as]; int base = 0;
#pragma unroll
        for (int j = 0; j < 16; ++j) base = (j == e) ? ts[j] : base;
        const int slot = base * 256 + TOKP[as];
        if (c.lane == 0) S2T[slot] = as;
        const u32x4* src = (const u32x4*)(XN + (size_t)(as >> 1) * D); u32x4* dst = (u32x4*)(XS + (size_t)slot * D);
        dst[c.lane] = src[c.lane]; dst[64 + c.lane] = src[64 + c.lane];
    }
    for (int e = 0; e < 16; ++e) {
        int tse = 0, tsn = 0;
#pragma unroll
        for (int j = 0; j < 16; ++j) { tse = (j == e) ? ts[j] : tse; tsn = (j == e) ? ts[j + 1] : tsn; }
        const int lo = tse * 256 + (int)cnt[e], hi = tsn * 256;
        for (int s = lo + c.gw; s < hi; s += c.ngw) { if (c.lane == 0) S2T[s] = -1; u32x4* dst = (u32x4*)(XS + (size_t)s * D); const u32x4 zz = {0u, 0u, 0u, 0u}; dst[c.lane] = zz; dst[64 + c.lane] = zz; }
    }
}

__device__ __forceinline__ void phase_ln2(const Args& a, const Ctx& c, int l) {
    const float* MODF = (const float*)(a.ws + WS_MODF) + l * 6144;
    const float* g2 = a.in[I_LN2G] + l * D; const float* b2 = a.in[I_LN2B] + l * D;
    const bf16* Y = (const bf16*)(a.ws + WS_Y); bf16* XN = (bf16*)(a.ws + WS_XN);
    for (int m = c.gw; m < T; m += c.ngw) {
        float v[16]; load_row16(a.out + (size_t)m * D, c.lane, v);
#pragma unroll
        for (int j = 0; j < 4; ++j) { const int col = 4 * c.lane + 256 * j; const f32x4 y0 = load4bf(Y + (size_t)(2 * m) * D + col), y1 = load4bf(Y + (size_t)(2 * m + 1) * D + col);
#pragma unroll
            for (int e = 0; e < 4; ++e) v[4 * j + e] = ALPHA * v[4 * j + e] + (1.0f + MODF[5120 + col + e]) * (y0[e] + y1[e]); }
        float mean, rstd; row_stats(v, mean, rstd);
#pragma unroll
        for (int j = 0; j < 4; ++j) { f32x4 o; const int col = 4 * c.lane + 256 * j;
#pragma unroll
            for (int e = 0; e < 4; ++e) { v[4 * j + e] = (v[4 * j + e] - mean) * rstd * g2[col + e] + b2[col + e]; o[e] = v[4 * j + e]; }
            *(f32x4*)(a.out + (size_t)m * D + col) = o; }
        if (l + 1 < DEPTH) {
            const float* MN = MODF + 6144;
            row_stats(v, mean, rstd);
#pragma unroll
            for (int j = 0; j < 4; ++j) { f32x4 o; const int col = 4 * c.lane + 256 * j;
#pragma unroll
                for (int e = 0; e < 4; ++e) o[e] = (v[4 * j + e] - mean) * rstd * (1.0f + MN[1024 + col + e]) + MN[col + e];
                store4bf(XN + (size_t)m * D + col, o); }
        }
    }
}


template <class F> struct EpiAdapt {
    static constexpr bool PERM = false, AFTER_DRAIN = false; F f;
    __device__ __forceinline__ void operator()(const f32x4 (&acc)[2][2][4][2], const Unit& u, int wr, int wc, int fr, int fq) const {
#pragma unroll
        for (int ai = 0; ai < 2; ++ai)
#pragma unroll
            for (int m = 0; m < 4; ++m) { const int row = u.pm * 256 + ai * 128 + wr * 64 + m * 16 + fr;
#pragma unroll
                for (int n = 0; n < 2; ++n) { const int col = u.pn * 256 + wc * 32 + n * 16 + 4 * fq; f(row, col, acc[ai][0][m][n], acc[ai][1][m][n]); } }
    }
};

#ifndef USE_PG8
#define USE_PG8 1
#endif
template <class Sched, class F>
__device__ __forceinline__ void gemm_any(const Ctx& c, const bf16* A, const bf16* Bt, int M, int N, int K, const Sched& S, const F& f) {
#if USE_PG8
    pg8::Gemm g{A, Bt, M, N, K}; EpiAdapt<F> E{f};
    pg8::gemm_phase<EpiAdapt<F>, Sched, true, true>((PG8_LAS unsigned char*)c.lds, g, S, E);
#else
    gemm_simple(c, A, Bt, K, S, f);
#endif
}

#define LAS __attribute__((address_space(3)))
#define XB_TMO      128
#define XB_XCNT(j)  (256  + 64 * (j))
#define XB_XSUB(j)  (1280 + 64 * (j))
#define XB_XGEN(j)  (2304 + 64 * (j))
#define XB_TOP      3328
#define XB_TOPGEN   3392
#define XCD_BAR_WORDS 3456
#define XB_SPIN_CAP (1u << 24)

__device__ __forceinline__ unsigned xb_ld(unsigned* p)              { return __hip_atomic_load(p, __ATOMIC_RELAXED, __HIP_MEMORY_SCOPE_AGENT); }
__device__ __forceinline__ unsigned xb_add(unsigned* p, unsigned v) { return __hip_atomic_fetch_add(p, v, __ATOMIC_RELAXED, __HIP_MEMORY_SCOPE_AGENT); }
__device__ __forceinline__ unsigned xb_xcc_id() { return (unsigned)__builtin_amdgcn_s_getreg((3 << 11) | 20) & 0xFu; }
#define XB_SPIN(cond, bar) do { unsigned _sp = 0; while (cond) { __builtin_amdgcn_s_sleep(1); \
    if ((++_sp & 255u) == 0u) { if (xb_ld(&(bar)[XB_TMO])) break; if (_sp > XB_SPIN_CAP) { atomicAdd(&(bar)[XB_TMO], 1u); break; } } } } while (0)

struct XcdBarrier {
    unsigned* bar; unsigned x;
    volatile LAS unsigned* st;
};

__device__ __forceinline__ XcdBarrier xcd_barrier_post(unsigned* bar, volatile LAS unsigned* st) {
    XcdBarrier b; b.bar = bar; b.x = xb_xcc_id(); b.st = st;
    if (threadIdx.x == 0) (void)xb_add(&bar[XB_XCNT(b.x)], 1u);
    return b;
}
__device__ __forceinline__ void xcd_barrier_complete(unsigned* bar, unsigned x, unsigned& nloc, unsigned& nx) {
    const unsigned G = gridDim.x * gridDim.y * gridDim.z;
    unsigned sum, cnt, mine, sp = 0u;
    for (;;) {
        sum = 0u; cnt = 0u; mine = 0u;
#pragma unroll
        for (unsigned j = 0; j < 16; ++j) { const unsigned c = xb_ld(&bar[XB_XCNT(j)]); sum += c; cnt += (c > 0u) ? 1u : 0u; mine = (j == x) ? c : mine; }
        if (sum == G) break;
        __builtin_amdgcn_s_sleep(1);
        if ((++sp & 255u) == 0u) { if (xb_ld(&bar[XB_TMO])) break; if (sp > XB_SPIN_CAP) { atomicAdd(&bar[XB_TMO], 1u); break; } }
    }
    nloc = mine > 0u ? mine : 1u; nx = cnt > 0u ? cnt : 1u;
}

__device__ __forceinline__ void xcd_barrier(const XcdBarrier& b) {
    asm volatile("s_waitcnt vmcnt(0)" ::: "memory");
    __syncthreads();
    if (threadIdx.x == 0) {
        unsigned* bar = b.bar;
        __builtin_amdgcn_s_waitcnt(0);
        unsigned nloc = b.st[0], nx = b.st[1];
        if (nloc == 0u) { xcd_barrier_complete(bar, b.x, nloc, nx); b.st[0] = nloc; b.st[1] = nx; }
        const unsigned old = xb_add(&bar[XB_XSUB(b.x)], 1u);
        const unsigned gen = old / nloc;
        if (old + 1u == (gen + 1u) * nloc) {
            __builtin_amdgcn_fence(__ATOMIC_RELEASE, "agent");
            asm volatile("s_waitcnt vmcnt(0)" ::: "memory");
            const unsigned og = xb_add(&bar[XB_TOP], 1u);
            const unsigned tg = og / nx;
            if (og + 1u == (tg + 1u) * nx) xb_add(&bar[XB_TOPGEN], 1u);
            else XB_SPIN(xb_ld(&bar[XB_TOPGEN]) == tg, bar);
            __builtin_amdgcn_fence(__ATOMIC_ACQUIRE, "agent");
            xb_add(&bar[XB_XGEN(b.x)], 1u);
            asm volatile("s_waitcnt vmcnt(0)" ::: "memory");
        } else {
            XB_SPIN(xb_ld(&bar[XB_XGEN(b.x)]) == gen, bar);
            __builtin_amdgcn_fence(__ATOMIC_ACQUIRE, "agent");
            asm volatile("s_waitcnt vmcnt(0)" ::: "memory");
        }
    }
    __syncthreads();
}


constexpr int PH_PER_LAYER = 12, N_PHASES = 2 + PH_PER_LAYER * DEPTH;
constexpr int CW_BAR = 4096;
constexpr int LDS_BYTES = 147456, LDSCTL_OFF = 131072 + 8192;
#ifndef SINGLE_LAUNCH
#define SINGLE_LAUNCH 1
#endif

template <int L>
__device__ __forceinline__ void run_layer(const Args& a, const Ctx& c, const XcdBarrier& bar) {
    unsigned char* ws = a.ws;
    const int G = gridDim.x, b = blockIdx.x, lo = a.ph_lo, hi = a.ph_hi;
    constexpr int B0 = 2 + PH_PER_LAYER * L;
#define IN(k) (lo <= B0 + (k) && B0 + (k) < hi)
#define SEAM(k) do { if (SINGLE_LAUNCH && IN(k) && (B0 + (k) + 1 < hi)) xcd_barrier(bar); } while (0)
    if (IN(0)) { pg8::StaticOrder S; S.init(T, INC, G, b); EpiZ E{(bf16*)(ws + WS_ZR), (bf16*)(ws + WS_ZS), (bf16*)(ws + WS_ZG)};
        gemm_any(c, (const bf16*)(ws + WS_XN), (const bf16*)(ws + WS_WIN + (size_t)L * 10 * MiB), T, INC, D, S, E); }
    SEAM(0);
    if (IN(1)) { phase_prep_simple(a, c, L); phase_sg_simple(a, c, L); }
    SEAM(1);
    if (IN(2)) phase_scan_simple(a, c);
    SEAM(2);
    if (IN(3)) phase_post(a, c, L);
    SEAM(3);
    if (IN(4)) { pg8::StaticOrder S; S.init(T, D, G, b); EpiGA E{(const bf16*)(ws + WS_ZG), (bf16*)(ws + WS_MP)};
        gemm_any(c, (const bf16*)(ws + WS_YA), (const bf16*)(ws + WS_WA + (size_t)L * WS_WL1), T, D, W, S, E); }
    SEAM(4);
    if (IN(5)) { pg8::StaticOrder S; S.init(T, D, G, b); EpiGB E{(const bf16*)(ws + WS_ZG), (bf16*)(ws + WS_MP)};
        gemm_any(c, (const bf16*)(ws + WS_YB), (const bf16*)(ws + WS_WB + (size_t)L * WS_WL1), T, D, W, S, E); }
    SEAM(5);
    if (IN(6)) { pg8::StaticOrder S; S.init(T, D, G, b); EpiOut E{L == 0 ? a.in[I_X] : a.out, a.out, (const float*)(ws + WS_MODF) + L * 6144 + 2048};
        gemm_any(c, (const bf16*)(ws + WS_MP), (const bf16*)(ws + WS_WO + (size_t)L * WS_WL1), T, D, D, S, E); }
    SEAM(6);
    if (IN(7)) phase_ln1(a, c, L);
    SEAM(7);
    if (IN(8)) phase_perm(a, c, L);
    SEAM(8);
    if (IN(9)) { MoeSched S; S.init((const unsigned*)(ws + WS_CTL) + CW_CNT + 64 * L, G, b); EpiSwi E{(bf16*)(ws + WS_HID)};
        gemm_any(c, (const bf16*)(ws + WS_XS), (const bf16*)(ws + WS_WGU), MAXSLOT, NE * 1024, D, S, E); }
    SEAM(9);
    if (IN(10)) { MoeSched S; S.init((const unsigned*)(ws + WS_CTL) + CW_CNT + 64 * L, G, b); EpiDown E{(const int*)(ws + WS_S2T), (const float*)(ws + WS_TOKW), (bf16*)(ws + WS_Y)};
        gemm_any(c, (const bf16*)(ws + WS_HID), (const bf16*)(ws + WS_WD), MAXSLOT, NE * 1024, FF, S, E); }
    SEAM(10);
    if (IN(11)) phase_ln2(a, c, L);
    SEAM(11);
#undef IN
#undef SEAM
}

__global__ void __launch_bounds__(NTHREADS, 2) mk_fwd(Args a) {
    extern __shared__ __attribute__((aligned(16))) unsigned char lds[];
    Ctx c; c.tid = threadIdx.x; c.lane = c.tid & 63; c.wave = __builtin_amdgcn_readfirstlane(c.tid >> 6);
    c.gw = blockIdx.x * NWAVES + c.wave; c.ngw = gridDim.x * NWAVES; c.lds = lds;
    for (int u = c.tid; u < (LDS_BYTES - LDSCTL_OFF) / 4; u += NTHREADS) ((LAS unsigned*)((LAS unsigned char*)lds + LDSCTL_OFF))[u] = 0u;
    __syncthreads();
    XcdBarrier bar; bar.bar = (unsigned*)(a.ws + WS_CTL) + CW_BAR; bar.x = 0; bar.st = nullptr;
    if (SINGLE_LAUNCH) bar = xcd_barrier_post((unsigned*)(a.ws + WS_CTL) + CW_BAR, (volatile LAS unsigned*)((LAS unsigned char*)lds + LDSCTL_OFF) + 8);
    const int lo = a.ph_lo, hi = a.ph_hi;
    if (lo <= 0 && 0 < hi) { phase_p0a(a, c); if (SINGLE_LAUNCH && 1 < hi) xcd_barrier(bar); }
    if (lo <= 1 && 1 < hi) { phase_p0b(a, c); if (SINGLE_LAUNCH && 2 < hi) xcd_barrier(bar); }
    run_layer<0>(a, c, bar);
    run_layer<1>(a, c, bar);
}

extern "C" void kernel_launch(void* const* d_in, const int* in_sizes, int n_in, void* d_out, int out_size, void* d_ws, size_t ws_size, hipStream_t stream) {
    static int grid = 0;
    if (grid == 0) {
        if (n_in != N_IN || out_size != T * D || ws_size < WS_END) { fprintf(stderr, "kernel_launch: unexpected shapes: n_in %d out %d ws %zu (need %zu)\n", n_in, out_size, ws_size, (size_t)WS_END); grid = -1; return; }
        int dev = 0, cus = 0;
        (void)hipGetDevice(&dev); (void)hipDeviceGetAttribute(&cus, hipDeviceAttributeMultiprocessorCount, dev);
        if (hipFuncSetAttribute((const void*)mk_fwd, hipFuncAttributeMaxDynamicSharedMemorySize, LDS_BYTES) != hipSuccess) { fprintf(stderr, "kernel_launch: hipFuncSetAttribute failed\n"); grid = -1; return; }
        grid = cus > 0 ? cus : 256;
        fprintf(stderr, "kernel_launch: ws_size %zu grid %d\n", ws_size, grid);
    }
    if (grid < 0) return;
    (void)hipMemsetAsync((char*)d_ws + WS_CTL, 0, CTL_BYTES, stream);
    Args a{};
    for (int i = 0; i < N_IN; ++i) a.in[i] = (const float*)d_in[i];
    a.out = (float*)d_out; a.ws = (unsigned char*)d_ws;
#if SINGLE_LAUNCH
    a.ph_lo = 0; a.ph_hi = N_PHASES;
    hipLaunchKernelGGL(mk_fwd, dim3(grid), dim3(NTHREADS), LDS_BYTES, stream, a);
#else
    for (int ph = 0; ph < N_PHASES; ++ph) { a.ph_lo = ph; a.ph_hi = ph + 1; hipLaunchKernelGGL(mk_fwd, dim3(grid), dim3(NTHREADS), LDS_BYTES, stream, a); }
#endif
}
```

```cpp
#include <hip/hip_runtime.h>
#include <cstdio>
#include <cstdint>
#include <utility>

typedef unsigned short bf16;
typedef _Float16 f16;
typedef float f32x4 __attribute__((ext_vector_type(4)));
typedef unsigned u32x4 __attribute__((ext_vector_type(4)));
typedef unsigned u32x2 __attribute__((ext_vector_type(2)));

constexpr int T = 16384, D = 1024, W = 512, NH = 8, HN = 64, RC = 1792, INC = 4864;
constexpr int NE = 16, FF = 512, DEPTH = 2;
constexpr float LN_EPS = 1e-5f, GN_EPS = 64e-5f, ALPHA = 1.41421356237f;
constexpr int NTHREADS = 512, NWAVES = 8;
constexpr int MAXSLOT = 36864;

constexpr size_t MiB = 1u << 20;
constexpr size_t WS_CTL = 0, CTL_BYTES = 1 * MiB;
constexpr int CW_CNT = 16384;
constexpr size_t WS_PART = 1 * MiB;
constexpr size_t WS_MODF = 2 * MiB;
constexpr size_t WS_TOKI = 2 * MiB + 65536;
constexpr size_t WS_TOKW = WS_TOKI + 131072;
constexpr size_t WS_TOKP = WS_TOKW + 131072;
constexpr size_t WS_S2T = 3 * MiB;
constexpr size_t WS_LORA = 4 * MiB;
constexpr size_t WS_WIN = 8 * MiB;
constexpr size_t WS_WA = 28 * MiB, WS_WB = 29 * MiB, WS_WO = 30 * MiB, WS_WL1 = 4 * MiB;
constexpr size_t WS_ZG = 36 * MiB;
constexpr size_t WS_XN = 100 * MiB;
constexpr size_t WS_G = 100 * MiB, WS_YB = 116 * MiB;
constexpr size_t WS_ZR = 132 * MiB;
constexpr size_t WS_ZS = 188 * MiB;
constexpr size_t WS_YSC = 132 * MiB;
constexpr size_t WS_ST = 148 * MiB;
constexpr size_t WS_YA = 148 * MiB;
constexpr size_t WS_MP = 164 * MiB;
constexpr size_t WS_XS = 132 * MiB;
constexpr size_t WS_Y = 132 * MiB;
constexpr size_t WS_R = 224 * MiB, WS_WM1 = 240 * MiB, WS_KP = 256 * MiB, WS_AA = 272 * MiB, WS_BB = 288 * MiB, WS_V = 304 * MiB;
constexpr size_t WS_WGU = 224 * MiB;
constexpr size_t WS_WD = 256 * MiB;
constexpr size_t WS_HID = 272 * MiB;
constexpr size_t WS_VF = 320 * MiB;
constexpr size_t WS_END = 336 * MiB;

enum { I_X = 0, I_C, I_WMOD, I_BMOD, I_WIN, I_MU, I_W0, I_W2, I_A0, I_A2, I_G2, I_KK, I_KA, I_RK, I_GNG, I_GNB, I_VM0, I_VM1, I_VM2,
       I_SGG, I_SGB, I_WS, I_BS, I_WBA, I_WBB, I_WOUT, I_LN1G, I_LN1B, I_RW, I_RB, I_EG, I_EU, I_ED, I_LN2G, I_LN2B, N_IN };

struct Args { const float* in[N_IN]; float* out; unsigned char* ws; int ph_lo, ph_hi; };

__device__ __forceinline__ float bf2f(bf16 h) { return __uint_as_float(((unsigned)h) << 16); }
__device__ __forceinline__ unsigned f2bfu(float f) { unsigned u = __float_as_uint(f); return (u + 0x7fffu + ((u >> 16) & 1u)) >> 16; }
__device__ __forceinline__ bf16 f2bf(float f) { return (bf16)f2bfu(f); }
__device__ __forceinline__ unsigned pk2(float lo, float hi) { return f2bfu(lo) | (f2bfu(hi) << 16); }
__device__ __forceinline__ void store4bf(bf16* p, f32x4 v) { u32x2 w; w.x = pk2(v[0], v[1]); w.y = pk2(v[2], v[3]); *(u32x2*)p = w; }
__device__ __forceinline__ f32x4 load4bf(const bf16* p) { u32x2 w = *(const u32x2*)p; f32x4 r; r[0] = __uint_as_float(w.x << 16); r[1] = __uint_as_float(w.x & 0xffff0000u); r[2] = __uint_as_float(w.y << 16); r[3] = __uint_as_float(w.y & 0xffff0000u); return r; }
__device__ __forceinline__ float wave_sum(float v) {
#pragma unroll
    for (int o = 1; o < 64; o <<= 1) v += __shfl_xor(v, o);
    return v;
}
__device__ __forceinline__ float sigmoidf_(float x) { return 1.0f / (1.0f + __expf(-x)); }
__device__ __forceinline__ float siluf_(float x) { return x * sigmoidf_(x); }
__device__ __forceinline__ float gelu_tanh(float x) { const float u = 0.7978845608028654f * (x + 0.044715f * x * x * x); return x * (1.0f - 1.0f / (1.0f + __expf(2.0f * u))); }
__device__ __forceinline__ float softplusf_(float y) { return fmaxf(y, 0.f) + log1pf(__expf(-fabsf(y))); }

struct Ctx { int tid, lane, wave, gw, ngw; unsigned char* lds; };

__device__ __forceinline__ void transpose_item(const float* Wsrc, int N, int k0, int n0, bf16* dst, int ldk, float* scr, int lane) {
#pragma unroll 8
    for (int i = 0; i < 32; ++i) { const int kk = 2 * i + (lane >> 5); scr[kk * 33 + (lane & 31)] = Wsrc[(size_t)(k0 + kk) * N + n0 + (lane & 31)]; }
    asm volatile("s_waitcnt lgkmcnt(0)" ::: "memory");
    const int c = lane & 7;
#pragma unroll
    for (int j = 0; j < 4; ++j) { const int n = (lane >> 3) + 8 * j; const float* s = scr + (8 * c) * 33 + n;
        u32x4 o; o.x = pk2(s[0 * 33], s[1 * 33]); o.y = pk2(s[2 * 33], s[3 * 33]); o.z = pk2(s[4 * 33], s[5 * 33]); o.w = pk2(s[6 * 33], s[7 * 33]);
        *(u32x4*)(dst + (size_t)n * ldk + k0 + 8 * c) = o; }
    asm volatile("s_waitcnt lgkmcnt(0)" ::: "memory");
}
template <class RowMap>
__device__ __forceinline__ void transpose_matrix_item(const float* Wsrc, int K, int N, bf16* dst, int item, float* scr, int lane, const RowMap& rm) {
    const int nblk = N / 32, kb = item / nblk, nb = item % nblk, n0 = 32 * nb;
    transpose_item(Wsrc, N, 64 * kb, n0, dst + (size_t)rm(n0) * K, K, scr, lane);
}
struct RowId { __device__ __forceinline__ int operator()(int n) const { return n; } };
struct RowGU { int up; __device__ __forceinline__ int operator()(int n) const { return (n >> 7) * 256 + (n & 127) + up * 128; } };

__device__ __forceinline__ void phase_p0a(const Args& a, const Ctx& c) {
    float* scr = (float*)(c.lds + c.wave * 16384);
    float* PART = (float*)(a.ws + WS_PART);
    for (int it = c.gw; it < 2 * 96 * 16; it += c.ngw) {
        const int kb = it & 15, cb = (it >> 4) % 96, l = it / (16 * 96);
        const int n = cb * 64 + c.lane;
        const float* wm = a.in[I_WMOD] + (size_t)l * D * 6144;
        float acc = 0.f;
#pragma unroll 8
        for (int k = 0; k < 64; ++k) { const int kk = kb * 64 + k; acc += siluf_(a.in[I_C][kk]) * wm[(size_t)kk * 6144 + n]; }
        PART[((size_t)l * 16 + kb) * 6144 + n] = acc;
    }
    constexpr int I_WINL = (D / 64) * (INC / 32);
    constexpr int I_WAL = (W / 64) * (D / 32);
    constexpr int I_WOL = (D / 64) * (D / 32);
    constexpr int PER_L = I_WINL + 2 * I_WAL + I_WOL;
    for (int it = c.gw; it < 2 * PER_L; it += c.ngw) {
        const int l = it / PER_L; int r = it % PER_L;
        if (r < I_WINL) { transpose_matrix_item(a.in[I_WIN] + (size_t)l * D * INC, D, INC, (bf16*)(a.ws + WS_WIN + (size_t)l * 10 * MiB), r, scr, c.lane, RowId()); continue; } r -= I_WINL;
        if (r < I_WAL) { transpose_matrix_item(a.in[I_WBA] + (size_t)l * W * D, W, D, (bf16*)(a.ws + WS_WA + (size_t)l * WS_WL1), r, scr, c.lane, RowId()); continue; } r -= I_WAL;
        if (r < I_WAL) { transpose_matrix_item(a.in[I_WBB] + (size_t)l * W * D, W, D, (bf16*)(a.ws + WS_WB + (size_t)l * WS_WL1), r, scr, c.lane, RowId()); continue; } r -= I_WAL;
        transpose_matrix_item(a.in[I_WOUT] + (size_t)l * D * D, D, D, (bf16*)(a.ws + WS_WO + (size_t)l * WS_WL1), r, scr, c.lane, RowId());
    }
}

__device__ __forceinline__ void row_stats(const float (&v)[16], float& mean, float& rstd) {
    float s = 0.f;
#pragma unroll
    for (int j = 0; j < 16; ++j) s += v[j];
    mean = wave_sum(s) * (1.f / D);
    float q = 0.f;
#pragma unroll
    for (int j = 0; j < 16; ++j) { const float d = v[j] - mean; q += d * d; }
    rstd = 1.0f / sqrtf(wave_sum(q) * (1.f / D) + LN_EPS);
}
__device__ __forceinline__ void load_row16(const float* p, int lane, float (&v)[16]) {
#pragma unroll
    for (int j = 0; j < 4; ++j) { const f32x4 x = *(const f32x4*)(p + 4 * lane + 256 * j); v[4 * j] = x[0]; v[4 * j + 1] = x[1]; v[4 * j + 2] = x[2]; v[4 * j + 3] = x[3]; }
}

__device__ __forceinline__ void phase_p0b(const Args& a, const Ctx& c) {
    const float* PART = (const float*)(a.ws + WS_PART);
    float* MODF = (float*)(a.ws + WS_MODF);
    for (int i = blockIdx.x * NTHREADS + c.tid; i < 2 * 6144; i += gridDim.x * NTHREADS) {
        const int l = i / 6144, n = i % 6144; float s = a.in[I_BMOD][i];
#pragma unroll
        for (int kb = 0; kb < 16; ++kb) s += PART[((size_t)l * 16 + kb) * 6144 + n];
        MODF[i] = s;
    }
    float sh[16], sc[16];
#pragma unroll
    for (int j = 0; j < 4; ++j)
#pragma unroll
        for (int e = 0; e < 4; ++e) { const int col = 4 * c.lane + 256 * j + e; float s0 = a.in[I_BMOD][col], s1 = a.in[I_BMOD][1024 + col];
            for (int kb = 0; kb < 16; ++kb) { s0 += PART[(size_t)kb * 6144 + col]; s1 += PART[(size_t)kb * 6144 + 1024 + col]; }
            sh[4 * j + e] = s0; sc[4 * j + e] = 1.f + s1; }
    bf16* XN = (bf16*)(a.ws + WS_XN);
    for (int m = c.gw; m < T; m += c.ngw) {
        float v[16]; load_row16(a.in[I_X] + (size_t)m * D, c.lane, v);
        float mean, rstd; row_stats(v, mean, rstd);
#pragma unroll
        for (int j = 0; j < 4; ++j) { f32x4 o;
#pragma unroll
            for (int e = 0; e < 4; ++e) o[e] = (v[4 * j + e] - mean) * rstd * sc[4 * j + e] + sh[4 * j + e];
            store4bf(XN + (size_t)m * D + 4 * c.lane + 256 * j, o); }
    }
}

namespace pg8 {
#define PG8_LAS __attribute__((address_space(3)))
typedef unsigned short bf16_t;
typedef short bf16x8 __attribute__((ext_vector_type(8)));
typedef float f32x4 __attribute__((ext_vector_type(4)));
typedef unsigned u32x4 __attribute__((ext_vector_type(4)));
constexpr int BM = 256, BK = 64, HALF = 128, HTB = HALF * BK * 2  , STAGE_BYTES = 8 * HTB, NXCD = 8, WGM = 8;

__host__ __device__ __forceinline__ int lds_byte(int r, int c) { const int st = (r >> 4) * 2 + (c >> 5), rr = r & 15, cc = c & 31, ob = rr * 64 + cc * 2; return st * 1024 + (ob ^ (((ob >> 9) & 1) << 5)); }
__host__ __device__ __forceinline__ void stage_rc(int b, int& R, int& C) { const int st = b / 1024, sb = b % 1024, swz = sb ^ (((sb >> 9) & 1) << 5); R = (st >> 1) * 16 + swz / 64; C = (st & 1) * 32 + (swz % 64) / 2; }
__host__ __device__ __forceinline__ int perm32(int rho) { const int n = rho >> 4, i = rho & 15; return 8 * (i >> 2) + 4 * n + (i & 3); }

struct Unit { int pm, pn; };
struct Gemm { const bf16_t* A; const bf16_t* Bt; int M, N, K; };

struct StaticOrder {
    int nM, nN, nwg, G, c;
    __host__ __device__ void init(int M, int N, int G_, int c_) { nM = M / BM; nN = N / BM; nwg = nM * nN; G = G_; c = c_; }
    __host__ __device__ bool next(int i, Unit& u) const {
        const long L = (long)i * G + c; if (L >= nwg) return false;
        int wgid = (int)L; { const int q = nwg / NXCD, r = nwg % NXCD, xcd = wgid % NXCD, off = wgid / NXCD; wgid = (xcd < r ? xcd * (q + 1) : r * (q + 1) + (xcd - r) * q) + off; }
        const int nig = WGM * nN, gid = wgid / nig, fm = gid * WGM, gsz = (nM - fm) < WGM ? (nM - fm) : WGM;
        u.pm = fm + ((wgid % nig) % gsz); u.pn = (wgid % nig) / gsz; return true;
    }
    __device__ __forceinline__ void a_ready(const Unit&) const {}
    __device__ __forceinline__ void done(const Unit&) const {}
};


template <class Epi, class Sched, bool ALIGN_EPI = false, bool SP2 = false>
__device__ __forceinline__ void gemm_phase(PG8_LAS unsigned char* lds, const Gemm g, const Sched& S, const Epi& E) {
    const int tid = threadIdx.x, wid = __builtin_amdgcn_readfirstlane(tid >> 6), lane = tid & 63, wr = wid >> 2, wc = wid & 3, fr = lane & 15, fq = lane >> 4;
    const int K = g.K, nt = K / BK;
    unsigned voffA[2], voffB[2];
#pragma unroll
    for (int i = 0; i < 2; ++i) { int R, C; stage_rc(tid * 16 + i * 8192, R, C); const int Rb = Epi::PERM ? ((R & ~31) + perm32(R & 31)) : R;
        voffA[i] = (unsigned)(R * K + C) * 2u; voffB[i] = (unsigned)(Rb * K + C) * 2u; }
    const size_t kstep = (size_t)(BK * 2);
    const size_t hstep = (size_t)HALF * K * 2;
    const size_t tstep = 2 * hstep;
    const unsigned ldsw = (unsigned)wid * 1024u;
    const int aoff = lds_byte(wr * 64 + fr, fq * 8), boff = lds_byte(wc * 32 + fr, fq * 8);
#define PG8_SA(b, h) (((b) * 2 + (h)) * HTB)
#define PG8_SB(b, h) ((4 + (b) * 2 + (h)) * HTB)
#define PG8_STAGE(bufoff, gbase, voff) do { _Pragma("unroll") for (int _i = 0; _i < 2; ++_i) \
        __builtin_amdgcn_global_load_lds((const unsigned*)((const char*)(gbase) + (voff)[_i]), (PG8_LAS unsigned*)(lds + (bufoff) + ldsw + _i * 8192), 16, 0, 0); } while (0)
#define PG8_LDA(dst, b, h) do { _Pragma("unroll") for (int m = 0; m < 4; ++m) _Pragma("unroll") for (int k = 0; k < 2; ++k) dst[m][k] = *(const PG8_LAS bf16x8*)(lds + PG8_SA(b, h) + aoff + m * 2048 + k * 1024); } while (0)
#define PG8_LDB(dst, b, h) do { _Pragma("unroll") for (int n = 0; n < 2; ++n) _Pragma("unroll") for (int k = 0; k < 2; ++k) dst[n][k] = *(const PG8_LAS bf16x8*)(lds + PG8_SB(b, h) + boff + n * 2048 + k * 1024); } while (0)
#define PG8_MMA(ai, bj, At, Bt) do { __builtin_amdgcn_s_setprio(1); _Pragma("unroll") for (int m = 0; m < 4; ++m) _Pragma("unroll") for (int n = 0; n < 2; ++n) _Pragma("unroll") for (int k = 0; k < 2; ++k) \
        acc[ai][bj][m][n] = __builtin_amdgcn_mfma_f32_16x16x32_bf16(Bt[n][k], At[m][k], acc[ai][bj][m][n], 0, 0, 0); __builtin_amdgcn_s_setprio(0); } while (0)
#define PG8_WAIT_V(n) asm volatile("s_waitcnt vmcnt(" #n ")" ::: "memory")
#define PG8_WAIT_L(n) asm volatile("s_waitcnt lgkmcnt(" #n ")" ::: "memory")
#define PG8_BAR __builtin_amdgcn_s_barrier()
#define PG8_SCHED __builtin_amdgcn_sched_barrier(0)
    Unit cur, nxt; int ui = 0;
    if (!S.next(0, cur)) return;
    f32x4 acc[2][2][4][2];
#pragma unroll
    for (int a = 0; a < 2; ++a)
#pragma unroll
        for (int b = 0; b < 2; ++b)
#pragma unroll
            for (int m = 0; m < 4; ++m)
#pragma unroll
                for (int n = 0; n < 2; ++n) acc[a][b][m][n] = (f32x4){0.f, 0.f, 0.f, 0.f};
    bf16x8 At[4][2], B0[2][2], B1[2][2];
    const char* cA = (const char*)g.A + (size_t)cur.pm * tstep; const char* cB = (const char*)g.Bt + (size_t)cur.pn * tstep;
    S.a_ready(cur);
    if constexpr (SP2) {
        PG8_STAGE(PG8_SB(0, 0), cB, voffB); PG8_STAGE(PG8_SB(0, 1), cB + hstep, voffB); PG8_STAGE(PG8_SA(0, 0), cA, voffA); PG8_STAGE(PG8_SA(0, 1), cA + hstep, voffA);
        if (wr == 1) PG8_BAR;
        PG8_WAIT_V(2); PG8_BAR;
        PG8_STAGE(PG8_SB(1, 0), cB + kstep, voffB); PG8_STAGE(PG8_SA(1, 0), cA + kstep, voffA); PG8_STAGE(PG8_SB(1, 1), cB + hstep + kstep, voffB);
        PG8_WAIT_V(6); PG8_BAR;
    } else {
        PG8_STAGE(PG8_SB(0, 0), cB, voffB); PG8_STAGE(PG8_SA(0, 0), cA, voffA); PG8_STAGE(PG8_SB(0, 1), cB + hstep, voffB); PG8_STAGE(PG8_SA(0, 1), cA + hstep, voffA);
        if (wr == 1) PG8_BAR;
        PG8_WAIT_V(4); PG8_BAR;
        PG8_STAGE(PG8_SB(1, 0), cB + kstep, voffB); PG8_STAGE(PG8_SA(1, 0), cA + kstep, voffA); PG8_STAGE(PG8_SB(1, 1), cB + hstep + kstep, voffB);
        PG8_WAIT_V(6); PG8_BAR;
    }
    for (;;) {
        const bool has_next = S.next(ui + 1, nxt);
        const char* nA = has_next ? (const char*)g.A + (size_t)nxt.pm * tstep : cA; const char* nB = has_next ? (const char*)g.Bt + (size_t)nxt.pn * tstep : cB;
        for (int t = 0; t < nt; t += 2) {
            const bool last = (t == nt - 2);
            const char* a1 = cA + (size_t)(t + 1) * kstep;
            const char* a2 = last ? nA : cA + (size_t)(t + 2) * kstep; const char* b2 = last ? nB : cB + (size_t)(t + 2) * kstep;
            const char* a3 = a2 + kstep; const char* b3 = b2 + kstep;
            if (last && has_next) S.a_ready(nxt);
            if constexpr (SP2) {
            PG8_LDB(B0, 0, 0); PG8_LDB(B1, 0, 1); PG8_SCHED; PG8_LDA(At, 0, 0); PG8_STAGE(PG8_SA(1, 1), a1 + hstep, voffA);
            PG8_WAIT_V(8); PG8_WAIT_L(0); PG8_BAR; PG8_MMA(0, 0, At, B0); PG8_MMA(0, 1, At, B1); PG8_BAR; PG8_SCHED;
            PG8_LDA(At, 0, 1); PG8_STAGE(PG8_SB(0, 0), b2, voffB); PG8_STAGE(PG8_SB(0, 1), b2 + hstep, voffB); PG8_STAGE(PG8_SA(0, 0), a2, voffA);
            PG8_WAIT_V(8); PG8_WAIT_L(0); PG8_BAR; PG8_MMA(1, 0, At, B0); PG8_MMA(1, 1, At, B1); PG8_BAR; PG8_SCHED;
            PG8_LDB(B0, 1, 0); PG8_LDB(B1, 1, 1); PG8_SCHED; PG8_LDA(At, 1, 0); PG8_STAGE(PG8_SA(0, 1), a2 + hstep, voffA);
            PG8_WAIT_V(8); PG8_WAIT_L(0); PG8_BAR; PG8_MMA(0, 0, At, B0); PG8_MMA(0, 1, At, B1); PG8_BAR; PG8_SCHED;
            PG8_LDA(At, 1, 1); PG8_STAGE(PG8_SB(1, 0), b3, voffB); PG8_STAGE(PG8_SB(1, 1), b3 + hstep, voffB); PG8_STAGE(PG8_SA(1, 0), a3, voffA);
            PG8_WAIT_V(8); PG8_WAIT_L(0); PG8_BAR; PG8_MMA(1, 0, At, B0); PG8_MMA(1, 1, At, B1); PG8_BAR; PG8_SCHED;
            } else {
            PG8_LDB(B0, 0, 0); PG8_SCHED; PG8_LDA(At, 0, 0); PG8_STAGE(PG8_SA(1, 1), a1 + hstep, voffA);
            PG8_WAIT_L(8); PG8_BAR; PG8_WAIT_L(0); PG8_MMA(0, 0, At, B0); PG8_BAR; PG8_SCHED;
            PG8_LDB(B1, 0, 1); PG8_STAGE(PG8_SB(0, 0), b2, voffB);
            PG8_BAR; PG8_WAIT_L(0); PG8_MMA(0, 1, At, B1); PG8_BAR;
            PG8_LDA(At, 0, 1); PG8_STAGE(PG8_SA(0, 0), a2, voffA);
            PG8_BAR; PG8_WAIT_L(0); PG8_MMA(1, 0, At, B0); PG8_BAR; PG8_SCHED;
            PG8_STAGE(PG8_SB(0, 1), b2 + hstep, voffB);
            PG8_WAIT_V(6); PG8_BAR; PG8_MMA(1, 1, At, B1); PG8_BAR;
            PG8_LDB(B0, 1, 0); PG8_SCHED; PG8_LDA(At, 1, 0); PG8_STAGE(PG8_SA(0, 1), a2 + hstep, voffA);
            PG8_WAIT_L(8); PG8_BAR; PG8_WAIT_L(0); PG8_MMA(0, 0, At, B0); PG8_BAR; PG8_SCHED;
            PG8_LDB(B1, 1, 1); PG8_STAGE(PG8_SB(1, 0), b3, voffB);
            PG8_BAR; PG8_WAIT_L(0); PG8_MMA(0, 1, At, B1); PG8_BAR;
            PG8_LDA(At, 1, 1); PG8_STAGE(PG8_SA(1, 0), a3, voffA);
            PG8_BAR; PG8_WAIT_L(0); PG8_MMA(1, 0, At, B0); PG8_BAR; PG8_SCHED;
            PG8_STAGE(PG8_SB(1, 1), b3 + hstep, voffB);
            PG8_WAIT_V(6); PG8_BAR; PG8_MMA(1, 1, At, B1); PG8_BAR;
            }
        }
        if constexpr (ALIGN_EPI) { if (wr == 0) PG8_BAR; }
        if constexpr (!Epi::AFTER_DRAIN) { E(acc, cur, wr, wc, fr, fq); S.done(cur); }
        if (!has_next) break;
#pragma unroll
        for (int a = 0; a < 2; ++a)
#pragma unroll
            for (int b = 0; b < 2; ++b)
#pragma unroll
                for (int m = 0; m < 4; ++m)
#pragma unroll
                    for (int n = 0; n < 2; ++n) acc[a][b][m][n] = (f32x4){0.f, 0.f, 0.f, 0.f};
        cur = nxt; cA = nA; cB = nB; ++ui;
        if constexpr (ALIGN_EPI) { if (wr == 1) PG8_BAR; }
    }
    PG8_WAIT_V(0);
    if constexpr (!ALIGN_EPI) { if (wr == 0) PG8_BAR; }
    PG8_BAR;
    if constexpr (Epi::AFTER_DRAIN) { E.fused(acc, cur, wr, wc, fr, fq, lds, wid, lane); S.done(cur); }
#undef PG8_SA
#undef PG8_SB
#undef PG8_STAGE
#undef PG8_LDA
#undef PG8_LDB
#undef PG8_MMA
#undef PG8_WAIT_V
#undef PG8_WAIT_L
#undef PG8_BAR
#undef PG8_SCHED
}
}

using pg8::Unit;
struct DenseSched { int nN, n, G, c;
    __device__ __forceinline__ void a_ready(const Unit&) const {}
    __device__ __forceinline__ void done(const Unit&) const {}
    __device__ __forceinline__ bool next(int i, Unit& u) const { const int L = i * G + c; if (L >= n) return false; u.pm = L / nN; u.pn = L % nN; return true; } };

template <class Sched, class Epi>
__device__ __forceinline__ void gemm_simple(const Ctx& c, const bf16* A, const bf16* Bt, int K, const Sched& S, const Epi& E) {
    float* As = (float*)c.lds;
    float* Bs = As + 32 * 256;
    const int tid = c.tid, rg = tid >> 4, cg = tid & 15;
    Unit u;
    for (int ui = 0; S.next(ui, u); ++ui) {
        float acc[8][16];
#pragma unroll
        for (int i = 0; i < 8; ++i)
#pragma unroll
            for (int j = 0; j < 16; ++j) acc[i][j] = 0.f;
        const bf16* Ab = A + (size_t)u.pm * 256 * K; const bf16* Bb = Bt + (size_t)u.pn * 256 * K;
        for (int k0 = 0; k0 < K; k0 += 32) {
            { const int row = tid >> 1, kh = tid & 1;
              const u32x4* pa = (const u32x4*)(Ab + (size_t)row * K + k0 + 16 * kh); const u32x4 a0 = pa[0], a1 = pa[1];
              const u32x4* pb = (const u32x4*)(Bb + (size_t)row * K + k0 + 16 * kh); const u32x4 b0 = pb[0], b1 = pb[1];
#pragma unroll
              for (int j = 0; j < 4; ++j) {
                  As[(16 * kh + 2 * j) * 256 + row] = __uint_as_float(a0[j] << 16); As[(16 * kh + 2 * j + 1) * 256 + row] = __uint_as_float(a0[j] & 0xffff0000u);
                  As[(16 * kh + 8 + 2 * j) * 256 + row] = __uint_as_float(a1[j] << 16); As[(16 * kh + 8 + 2 * j + 1) * 256 + row] = __uint_as_float(a1[j] & 0xffff0000u);
                  Bs[(16 * kh + 2 * j) * 256 + row] = __uint_as_float(b0[j] << 16); Bs[(16 * kh + 2 * j + 1) * 256 + row] = __uint_as_float(b0[j] & 0xffff0000u);
                  Bs[(16 * kh + 8 + 2 * j) * 256 + row] = __uint_as_float(b1[j] << 16); Bs[(16 * kh + 8 + 2 * j + 1) * 256 + row] = __uint_as_float(b1[j] & 0xffff0000u);
              } }
            __syncthreads();
#pragma unroll 4
            for (int kk = 0; kk < 32; ++kk) {
                const f32x4 a0 = *(const f32x4*)(As + kk * 256 + rg * 8), a1 = *(const f32x4*)(As + kk * 256 + rg * 8 + 4);
                f32x4 b[4];
#pragma unroll
                for (int q = 0; q < 4; ++q) b[q] = *(const f32x4*)(Bs + kk * 256 + 64 * q + 4 * cg);
#pragma unroll
                for (int i = 0; i < 8; ++i) { const float av = i < 4 ? a0[i & 3] : a1[i & 3];
#pragma unroll
                    for (int q = 0; q < 4; ++q)
#pragma unroll
                        for (int e = 0; e < 4; ++e) acc[i][4 * q + e] += av * b[q][e]; }
            }
            __syncthreads();
        }
#pragma unroll
        for (int i = 0; i < 8; ++i) { const int row = u.pm * 256 + rg * 8 + i;
#pragma unroll
            for (int q = 0; q < 2; ++q) { const int col = u.pn * 256 + 64 * q + 4 * cg;
                f32x4 v0, v1;
#pragma unroll
                for (int e = 0; e < 4; ++e) { v0[e] = acc[i][4 * q + e]; v1[e] = acc[i][4 * (q + 2) + e]; }
                E(row, col, v0, v1); } }
    }
}

struct EpiZ { bf16 *ZR, *ZS, *ZG;
    __device__ __forceinline__ void one(int row, int col, f32x4 v) const {
        if (col < RC) store4bf(ZR + (size_t)row * RC + col, v);
        else if (col < RC + 1024) { f32x4 g; for (int e = 0; e < 4; ++e) g[e] = gelu_tanh(v[e]); store4bf(ZS + (size_t)row * 1024 + (col - RC), g); }
        else { f32x4 g; for (int e = 0; e < 4; ++e) g[e] = sigmoidf_(v[e]); store4bf(ZG + (size_t)row * 2048 + (col - RC - 1024), g); } }
    __device__ __forceinline__ void operator()(int row, int col, f32x4 v0, f32x4 v1) const { one(row, col, v0); one(row, col + 128, v1); } };
struct EpiGA { const bf16* ZG; bf16* MP;
    __device__ __forceinline__ void one(int row, int col, f32x4 v) const { const f32x4 g = load4bf(ZG + (size_t)row * 2048 + col); store4bf(MP + (size_t)row * D + col, g * v); }
    __device__ __forceinline__ void operator()(int row, int col, f32x4 v0, f32x4 v1) const { one(row, col, v0); one(row, col + 128, v1); } };
struct EpiGB { const bf16* ZG; bf16* MP;
    __device__ __forceinline__ void one(int row, int col, f32x4 v) const { const f32x4 g = load4bf(ZG + (size_t)row * 2048 + 1024 + col); const f32x4 m = load4bf(MP + (size_t)row * D + col); store4bf(MP + (size_t)row * D + col, m + g * v); }
    __device__ __forceinline__ void operator()(int row, int col, f32x4 v0, f32x4 v1) const { one(row, col, v0); one(row, col + 128, v1); } };
struct EpiOut { const float* xin; float* out; const float* gate1;
    __device__ __forceinline__ void one(int row, int col, f32x4 v) const { const f32x4 x = *(const f32x4*)(xin + (size_t)row * D + col); const f32x4 g = *(const f32x4*)(gate1 + col);
        *(f32x4*)(out + (size_t)row * D + col) = ALPHA * x + (1.0f + g) * v; }
    __device__ __forceinline__ void operator()(int row, int col, f32x4 v0, f32x4 v1) const { one(row, col, v0); one(row, col + 128, v1); } };
struct EpiSwi { bf16* HID;
    __device__ __forceinline__ void operator()(int row, int col, f32x4 v0, f32x4 v1) const { const int ct = (col >> 8) & 3, cc = col & 127;
        f32x4 h; for (int e = 0; e < 4; ++e) h[e] = siluf_(v0[e]) * v1[e]; store4bf(HID + (size_t)row * FF + ct * 128 + cc, h); } };
struct EpiDown { const int* S2T; const float* TOKW; bf16* Y;
    __device__ __forceinline__ void operator()(int row, int col, f32x4 v0, f32x4 v1) const { const int st = S2T[row]; if (st < 0) return; const float w = TOKW[st]; const int cc = col & 1023;
        store4bf(Y + (size_t)st * D + cc, w * v0); store4bf(Y + (size_t)st * D + cc + 128, w * v1); } };

struct MoeSched { int ts[17]; int G, c;
    __device__ __forceinline__ void a_ready(const Unit&) const {}
    __device__ __forceinline__ void done(const Unit&) const {}
    __device__ __forceinline__ void init(const unsigned* cnt, int G_, int c_) { G = G_; c = c_; int s = 0;
#pragma unroll
        for (int e = 0; e < 16; ++e) { ts[e] = s; s += ((int)cnt[e] + 255) >> 8; } ts[16] = s; }
    __device__ __forceinline__ bool next(int i, Unit& u) const { const int L = i * G + c; if (L >= 4 * ts[16]) return false; const int rt = L >> 2, ct = L & 3; int e = 0;
#pragma unroll
        for (int j = 1; j < 16; ++j) e += (rt >= ts[j]) ? 1 : 0;
        u.pm = rt; u.pn = e * 4 + ct; return true; } };

__device__ __forceinline__ void phase_prep_simple(const Args& a, const Ctx& c, int l) {
    const bf16* ZR = (const bf16*)(a.ws + WS_ZR);
    const float* mu = a.in[I_MU] + l * RC; const float* w0 = a.in[I_W0] + l * W; const float* w2 = a.in[I_W2] + (size_t)l * 64 * W;
    const float* a0 = a.in[I_A0] + l * W; const float* a2 = a.in[I_A2] + (size_t)l * 64 * W; const float* g2 = a.in[I_G2] + (size_t)l * 128 * W;
    const float* k_k = a.in[I_KK] + l * W; const float* k_a = a.in[I_KA] + l * W;
    const float* vm0 = a.in[I_VM0]; const float* vm1 = a.in[I_VM1]; const float* vm2 = a.in[I_VM2];
    f16* R = (f16*)(a.ws + WS_R); f16* WM1 = (f16*)(a.ws + WS_WM1); f16* KP = (f16*)(a.ws + WS_KP); f16* AA = (f16*)(a.ws + WS_AA); f16* BB = (f16*)(a.ws + WS_BB); f16* V = (f16*)(a.ws + WS_V);
    bf16* G = (bf16*)(a.ws + WS_G); bf16* VF = (bf16*)(a.ws + WS_VF);
    const int lane = c.lane;
    for (int t = c.gw; t < T; t += c.ngw) {
        float z[28];
#pragma unroll
        for (int i = 0; i < 28; ++i) { const int col = lane + 64 * i; const float zc = bf2f(ZR[(size_t)t * RC + col]); const float zp = t > 0 ? bf2f(ZR[(size_t)(t - 1) * RC + col]) : 0.f; z[i] = zc + (zp - zc) * mu[col]; }
        const float tw = tanhf(z[24]), za = z[25], sg0 = sigmoidf_(z[26]), sg1 = sigmoidf_(z[27]);
        float wlo[8], alo[8], gg[8];
#pragma unroll
        for (int i = 0; i < 8; ++i) { wlo[i] = 0.f; alo[i] = 0.f; gg[i] = 0.f; }
        for (int j = 0; j < 64; ++j) { const float tj = __shfl(tw, j), aj = __shfl(za, j), s0 = __shfl(sg0, j), s1 = __shfl(sg1, j);
#pragma unroll
            for (int i = 0; i < 8; ++i) { const int n = lane + 64 * i; wlo[i] += tj * w2[j * W + n]; alo[i] += aj * a2[j * W + n]; gg[i] += s0 * g2[j * W + n] + s1 * g2[(64 + j) * W + n]; } }
        float vv[8];
#pragma unroll
        for (int i = 0; i < 8; ++i) vv[i] = z[16 + i];
        if (l == 0) {
#pragma unroll
            for (int i = 0; i < 8; ++i) VF[(size_t)t * W + lane + 64 * i] = f2bf(vv[i]);
        } else {
            float vmid = 0.f;
#pragma unroll
            for (int i = 0; i < 8; ++i)
                for (int j = 0; j < 64; ++j) { const float vc = __shfl(vv[i], j); vmid += vc * vm1[(size_t)(64 * i + j) * 32 + (lane & 31)]; }
            float vg[8];
#pragma unroll
            for (int i = 0; i < 8; ++i) vg[i] = 0.f;
            for (int m = 0; m < 32; ++m) { const float vmm = __shfl(vmid, m);
#pragma unroll
                for (int i = 0; i < 8; ++i) vg[i] += vmm * vm2[m * W + lane + 64 * i]; }
#pragma unroll
            for (int i = 0; i < 8; ++i) { const int n = lane + 64 * i; const float vf = bf2f(VF[(size_t)t * W + n]); vv[i] = vv[i] + (vf - vv[i]) * sigmoidf_(vm0[n] + vg[i]); }
        }
#pragma unroll
        for (int i = 0; i < 8; ++i) {
            const int n = lane + 64 * i; const size_t o = (size_t)t * W + n;
            const float x = w0[n] + wlo[i]; const float wl = -softplusf_(-x) - 0.5f; const float dm1 = expm1f(-__expf(wl));
            const float av = sigmoidf_(a0[n] + alo[i]);
            const float kraw = z[8 + i];
            float kk = kraw * k_k[n]; const float nrm = sqrtf(wave_sum(kk * kk)); kk = kk / fmaxf(nrm, 1e-12f);
            const float kp = kraw * (1.0f + (av - 1.0f) * k_a[n]);
            R[o] = (f16)z[i]; WM1[o] = (f16)dm1; KP[o] = (f16)kp; AA[o] = (f16)(-kk); BB[o] = (f16)(kk * av); V[o] = (f16)vv[i]; G[o] = f2bf(gg[i]);
        }
    }
}

__device__ __forceinline__ void phase_sg_simple(const Args& a, const Ctx& c, int l) {
    const bf16* ZS = (const bf16*)(a.ws + WS_ZS); bf16* YB = (bf16*)(a.ws + WS_YB);
    const float* lng = a.in[I_SGG] + l * W; const float* lnb = a.in[I_SGB] + l * W;
    float* vn = (float*)c.lds;
    float* st = vn + 128 * 64;
    for (int uidx = blockIdx.x; uidx < 128 * 8; uidx += gridDim.x) {
        const int ch = uidx >> 3, g = uidx & 7; const int tok0 = ch * 128;
        for (int i = 0; i < 16; ++i) { const int s = c.wave * 16 + i; const bf16* p = ZS + (size_t)(tok0 + s) * 1024 + 512 + c.lane * 8;
            const f32x4 x0 = load4bf(p), x1 = load4bf(p + 4);
            float sm = (x0[0] + x0[1]) + (x0[2] + x0[3]) + (x1[0] + x1[1]) + (x1[2] + x1[3]); const float mean = wave_sum(sm) * (1.f / 512.f);
            float q = 0.f; for (int e = 0; e < 4; ++e) { const float d0 = x0[e] - mean, d1 = x1[e] - mean; q += d0 * d0 + d1 * d1; }
            const float rstd = 1.0f / sqrtf(wave_sum(q) * (1.f / 512.f) + LN_EPS);
            if (c.lane == 0) { st[2 * s] = mean; st[2 * s + 1] = rstd; } }
        __syncthreads();
        for (int i = c.tid; i < 128 * 64; i += NTHREADS) { const int s = i >> 6, d = i & 63; const float x = bf2f(ZS[(size_t)(tok0 + s) * 1024 + 512 + g * 64 + d]);
            vn[i] = (x - st[2 * s]) * st[2 * s + 1] * lng[g * 64 + d] + lnb[g * 64 + d]; }
        __syncthreads();
        const int d = c.tid & 63, tq = c.tid >> 6;
        const float* Wg = a.in[I_WS] + (size_t)(l * 8 + g) * 128 * 128; const float* bs = a.in[I_BS] + (size_t)(l * 8 + g) * 128;
        for (int i = 0; i < 16; ++i) { const int t = tq + 8 * i; float acc = 0.f;
            for (int s = 0; s <= t; ++s) acc += Wg[t * 128 + s] * vn[s * 64 + d];
            const float u = bf2f(ZS[(size_t)(tok0 + t) * 1024 + g * 64 + d]);
            YB[(size_t)(tok0 + t) * W + g * 64 + d] = f2bf(u * (acc + bs[t])); }
        __syncthreads();
    }
}

__device__ __forceinline__ void phase_scan_simple(const Args& a, const Ctx& c) {
    if (c.wave != 0 || blockIdx.x >= NH) return;
    const int h = blockIdx.x, lane = c.lane;
    const f16* R = (const f16*)(a.ws + WS_R); const f16* WM1 = (const f16*)(a.ws + WS_WM1); const f16* KP = (const f16*)(a.ws + WS_KP);
    const f16* AA = (const f16*)(a.ws + WS_AA); const f16* BB = (const f16*)(a.ws + WS_BB); const f16* V = (const f16*)(a.ws + WS_V);
    bf16* YSC = (bf16*)(a.ws + WS_YSC);
    float S[64];
#pragma unroll
    for (int j = 0; j < 64; ++j) S[j] = 0.f;
    for (int t = 0; t < T; ++t) {
        const size_t base = (size_t)t * W + h * 64;
        const float vv = (float)V[base + lane];
        float sa = 0.f;
#pragma unroll
        for (int j = 0; j < 64; ++j) sa += S[j] * (float)AA[base + j];
        float y = 0.f;
#pragma unroll
        for (int j = 0; j < 64; ++j) { float s = S[j]; s = s + s * (float)WM1[base + j]; s += sa * (float)BB[base + j]; s += vv * (float)KP[base + j]; S[j] = s; y += s * (float)R[base + j]; }
        YSC[base + lane] = f2bf(y);
    }
}

typedef unsigned u32x16 __attribute__((ext_vector_type(16)));
__device__ __forceinline__ void sload32(const void* p0, u32x16& a0, u32x16& a1) {
    asm volatile("s_load_dwordx16 %0, %2, 0x0 glc\n\ts_load_dwordx16 %1, %2, 0x40 glc\n\ts_waitcnt lgkmcnt(0)" : "=&s"(a0), "=&s"(a1) : "s"(p0) : "memory");
}
__device__ __forceinline__ void sload64(const void* p0, const void* p1, u32x16& a0, u32x16& a1, u32x16& b0, u32x16& b1) {
    asm volatile("s_load_dwordx16 %0, %4, 0x0 glc\n\ts_load_dwordx16 %1, %4, 0x40 glc\n\ts_load_dwordx16 %2, %5, 0x0 glc\n\ts_load_dwordx16 %3, %5, 0x40 glc\n\ts_waitcnt lgkmcnt(0)"
                 : "=&s"(a0), "=&s"(a1), "=&s"(b0), "=&s"(b1) : "s"(p0), "s"(p1) : "memory");
}
__device__ __forceinline__ float fmix_lo(unsigned sd, float x, float y) { float d; asm("v_fma_mix_f32 %0, %1, %2, %3 op_sel_hi:[1,0,0]" : "=v"(d) : "s"(sd), "v"(x), "v"(y)); return d; }
__device__ __forceinline__ float fmix_hi(unsigned sd, float x, float y) { float d; asm("v_fma_mix_f32 %0, %1, %2, %3 op_sel:[1,0,0] op_sel_hi:[1,0,0]" : "=v"(d) : "s"(sd), "v"(x), "v"(y)); return d; }
constexpr int CL = 64, NCH = T / CL;
constexpr size_t ST_Q_OFF = (size_t)NH * NCH * 64 * 64;

__device__ __forceinline__ void phase_scan1(const Args& a, const Ctx& c) {
    const f16* WM1 = (const f16*)(a.ws + WS_WM1); const f16* KP = (const f16*)(a.ws + WS_KP);
    const f16* AA = (const f16*)(a.ws + WS_AA); const f16* BB = (const f16*)(a.ws + WS_BB); const f16* V = (const f16*)(a.ws + WS_V);
    float* ST = (float*)(a.ws + WS_ST);
    const int lane = c.lane;
    for (int item = c.gw; item < NH * NCH; item += c.ngw) {
        const int h = __builtin_amdgcn_readfirstlane(item / NCH), ch = __builtin_amdgcn_readfirstlane(item % NCH);
        float Q[64], P[64];
#pragma unroll
        for (int j = 0; j < 64; ++j) { Q[j] = 0.f; P[j] = (j == lane) ? 1.f : 0.f; }
        for (int t = ch * CL; t < ch * CL + CL; ++t) {
            const size_t base = (size_t)t * W + h * 64;
            const float vv = (float)V[base + lane];
            float q0 = 0.f, q1 = 0.f, p0 = 0.f, p1 = 0.f;
            { u32x16 a0, a1; sload32(AA + base, a0, a1);
#pragma unroll
              for (int e = 0; e < 32; ++e) { const int j = 2 * e; const unsigned av = e < 16 ? a0[e & 15] : a1[e & 15];
                  q0 = fmix_lo(av, Q[j], q0); q1 = fmix_hi(av, Q[j + 1], q1); p0 = fmix_lo(av, P[j], p0); p1 = fmix_hi(av, P[j + 1], p1); } }
            const float saq = q0 + q1, sap = p0 + p1;
            { u32x16 w0, w1, b0, b1; sload64(WM1 + base, BB + base, w0, w1, b0, b1);
#pragma unroll
              for (int e = 0; e < 32; ++e) { const int j = 2 * e; const unsigned wv = e < 16 ? w0[e & 15] : w1[e & 15], bv = e < 16 ? b0[e & 15] : b1[e & 15];
                  float s = Q[j]; s = fmix_lo(wv, s, s); s = fmix_lo(bv, saq, s); Q[j] = s;
                  float s2 = Q[j + 1]; s2 = fmix_hi(wv, s2, s2); s2 = fmix_hi(bv, saq, s2); Q[j + 1] = s2;
                  float u = P[j]; u = fmix_lo(wv, u, u); u = fmix_lo(bv, sap, u); P[j] = u;
                  float u2 = P[j + 1]; u2 = fmix_hi(wv, u2, u2); u2 = fmix_hi(bv, sap, u2); P[j + 1] = u2; } }
            { u32x16 k0, k1; sload32(KP + base, k0, k1);
#pragma unroll
              for (int e = 0; e < 32; ++e) { const int j = 2 * e; const unsigned kv = e < 16 ? k0[e & 15] : k1[e & 15];
                  Q[j] = fmix_lo(kv, vv, Q[j]); Q[j + 1] = fmix_hi(kv, vv, Q[j + 1]); } }
        }
        float* Pp = ST + ((size_t)(h * NCH + ch) * 64 + lane) * 64; float* Qp = Pp + ST_Q_OFF;
#pragma unroll
        for (int j = 0; j < 64; j += 4) { *(f32x4*)(Pp + j) = (f32x4){P[j], P[j + 1], P[j + 2], P[j + 3]}; *(f32x4*)(Qp + j) = (f32x4){Q[j], Q[j + 1], Q[j + 2], Q[j + 3]}; }
    }
}
__device__ __forceinline__ void phase_scan2_simple(const Args& a, const Ctx& c) {
    float* ST = (float*)(a.ws + WS_ST);
    for (int item = c.gw; item < NH * 64; item += c.ngw) {
        const int h = item >> 6, v = item & 63;
        float S = 0.f;
        for (int ch = 0; ch < NCH; ++ch) {
            const float* Pc = ST + (size_t)(h * NCH + ch) * 4096; float* Qc = ST + ST_Q_OFF + (size_t)(h * NCH + ch) * 4096 + v * 64;
            float acc0 = Qc[c.lane], acc1 = 0.f;
#pragma unroll
            for (int k = 0; k < 64; k += 2) { acc0 += __shfl(S, k) * Pc[k * 64 + c.lane]; acc1 += __shfl(S, k + 1) * Pc[(k + 1) * 64 + c.lane]; }
            S = acc0 + acc1;
            Qc[c.lane] = S;
        }
    }
}
__device__ __forceinline__ void phase_scan3(const Args& a, const Ctx& c) {
    const f16* R = (const f16*)(a.ws + WS_R); const f16* WM1 = (const f16*)(a.ws + WS_WM1); const f16* KP = (const f16*)(a.ws + WS_KP);
    const f16* AA = (const f16*)(a.ws + WS_AA); const f16* BB = (const f16*)(a.ws + WS_BB); const f16* V = (const f16*)(a.ws + WS_V);
    const float* ST = (const float*)(a.ws + WS_ST); bf16* YSC = (bf16*)(a.ws + WS_YSC);
    const int lane = c.lane;
    for (int item = c.gw; item < NH * NCH; item += c.ngw) {
        const int h = __builtin_amdgcn_readfirstlane(item / NCH), ch = __builtin_amdgcn_readfirstlane(item % NCH);
        float S[64];
        if (ch == 0) {
#pragma unroll
            for (int j = 0; j < 64; ++j) S[j] = 0.f;
        } else { const float* Sp = ST + ST_Q_OFF + ((size_t)(h * NCH + ch - 1) * 64 + lane) * 64;
#pragma unroll
            for (int j = 0; j < 64; j += 4) { const f32x4 x = *(const f32x4*)(Sp + j); S[j] = x[0]; S[j + 1] = x[1]; S[j + 2] = x[2]; S[j + 3] = x[3]; } }
        for (int t = ch * CL; t < ch * CL + CL; ++t) {
            const size_t base = (size_t)t * W + h * 64;
            const float vv = (float)V[base + lane];
            float s0 = 0.f, s1 = 0.f;
            { u32x16 a0, a1; sload32(AA + base, a0, a1);
#pragma unroll
              for (int e = 0; e < 32; ++e) { const int j = 2 * e; const unsigned av = e < 16 ? a0[e & 15] : a1[e & 15]; s0 = fmix_lo(av, S[j], s0); s1 = fmix_hi(av, S[j + 1], s1); } }
            const float sa = s0 + s1;
            { u32x16 w0, w1, b0, b1; sload64(WM1 + base, BB + base, w0, w1, b0, b1);
#pragma unroll
              for (int e = 0; e < 32; ++e) { const int j = 2 * e; const unsigned wv = e < 16 ? w0[e & 15] : w1[e & 15], bv = e < 16 ? b0[e & 15] : b1[e & 15];
                  float s = S[j]; s = fmix_lo(wv, s, s); s = fmix_lo(bv, sa, s); S[j] = s;
                  float s2 = S[j + 1]; s2 = fmix_hi(wv, s2, s2); s2 = fmix_hi(bv, sa, s2); S[j + 1] = s2; } }
            float y0 = 0.f, y1 = 0.f;
            { u32x16 k0, k1, r0, r1; sload64(KP + base, R + base, k0, k1, r0, r1);
#pragma unroll
              for (int e = 0; e < 32; ++e) { const int j = 2 * e; const unsigned kv = e < 16 ? k0[e & 15] : k1[e & 15], rv = e < 16 ? r0[e & 15] : r1[e & 15];
                  const float s = fmix_lo(kv, vv, S[j]); S[j] = s; y0 = fmix_lo(rv, s, y0);
                  const float s2 = fmix_hi(kv, vv, S[j + 1]); S[j + 1] = s2; y1 = fmix_hi(rv, s2, y1); } }
            YSC[base + lane] = f2bf(y0 + y1);
        }
    }
}

__device__ __forceinline__ void phase_post(const Args& a, const Ctx& c, int l) {
    const bf16* YSC = (const bf16*)(a.ws + WS_YSC); const f16* R = (const f16*)(a.ws + WS_R); const f16* KP = (const f16*)(a.ws + WS_KP); const f16* V = (const f16*)(a.ws + WS_V);
    const bf16* G = (const bf16*)(a.ws + WS_G); bf16* YA = (bf16*)(a.ws + WS_YA);
    const float* gng = a.in[I_GNG] + l * W; const float* gnb = a.in[I_GNB] + l * W; const float* rk = a.in[I_RK] + l * W;
    for (int t = c.gw; t < T; t += c.ngw) {
#pragma unroll
        for (int i = 0; i < 8; ++i) { const int n = c.lane + 64 * i; const size_t o = (size_t)t * W + n;
            const float y = bf2f(YSC[o]); const float mean = wave_sum(y) * (1.f / 64.f); const float d = y - mean; const float var = wave_sum(d * d) * (1.f / 64.f);
            float yn = d * (1.0f / sqrtf(var + GN_EPS)) * gng[n] + gnb[n];
            const float r = (float)R[o], k = (float)KP[o], v = (float)V[o];
            const float bonus = wave_sum(r * k * rk[n]);
            yn += bonus * v;
            YA[o] = f2bf(yn * bf2f(G[o])); }
    }
}

__device__ __forceinline__ void phase_ln1(const Args& a, const Ctx& c, int l) {
    const float* MODF = (const float*)(a.ws + WS_MODF) + l * 6144;
    const float* g1 = a.in[I_LN1G] + l * D; const float* b1 = a.in[I_LN1B] + l * D;
    bf16* XN = (bf16*)(a.ws + WS_XN);
    int* TOKI = (int*)(a.ws + WS_TOKI); float* TOKW = (float*)(a.ws + WS_TOKW); int* TOKP = (int*)(a.ws + WS_TOKP);
    unsigned* cnt = (unsigned*)(a.ws + WS_CTL) + CW_CNT + 64 * l;
    const float* rw = a.in[I_RW]; const float* rb = a.in[I_RB];
    for (int m = c.gw; m < T; m += c.ngw) {
        float v[16]; load_row16(a.out + (size_t)m * D, c.lane, v);
        float mean, rstd; row_stats(v, mean, rstd);
#pragma unroll
        for (int j = 0; j < 4; ++j) { f32x4 o; const int col = 4 * c.lane + 256 * j;
#pragma unroll
            for (int e = 0; e < 4; ++e) { v[4 * j + e] = (v[4 * j + e] - mean) * rstd * g1[col + e] + b1[col + e]; o[e] = v[4 * j + e]; }
            *(f32x4*)(a.out + (size_t)m * D + col) = o; }
        row_stats(v, mean, rstd);
        float lg[16];
#pragma unroll
        for (int e = 0; e < 16; ++e) lg[e] = 0.f;
#pragma unroll
        for (int j = 0; j < 4; ++j) { f32x4 o; const int col = 4 * c.lane + 256 * j;
#pragma unroll
            for (int e = 0; e < 4; ++e) { const float h = (v[4 * j + e] - mean) * rstd * (1.0f + MODF[4096 + col + e]) + MODF[3072 + col + e]; o[e] = h;
                const f32x4* rr = (const f32x4*)(rw + (size_t)(col + e) * NE);
#pragma unroll
                for (int q = 0; q < 4; ++q) { const f32x4 r4 = rr[q]; lg[4 * q] += h * r4[0]; lg[4 * q + 1] += h * r4[1]; lg[4 * q + 2] += h * r4[2]; lg[4 * q + 3] += h * r4[3]; } }
            store4bf(XN + (size_t)m * D + col, o); }
        float sc[16], sel[16];
#pragma unroll
        for (int e = 0; e < 16; ++e) { sc[e] = 1.0f / (1.0f + expf(-wave_sum(lg[e]))); sel[e] = sc[e] + rb[e]; }
        int best = 0; float bestv = -INFINITY;
#pragma unroll
        for (int g = 0; g < 4; ++g) { float m1 = -INFINITY, m2 = -INFINITY;
#pragma unroll
            for (int q = 0; q < 4; ++q) { const float s = sel[4 * g + q]; if (s > m1) { m2 = m1; m1 = s; } else if (s > m2) m2 = s; }
            const float gs = m1 + m2; if (gs > bestv) { bestv = gs; best = g; } }
        int i1 = 0, i2 = 0; float s1 = -INFINITY, s2 = -INFINITY, w1 = 0.f, w2 = 0.f;
#pragma unroll
        for (int e = 0; e < 16; ++e) { if ((e >> 2) == best) { const float s = sel[e];
                if (s > s1) { s2 = s1; i2 = i1; w2 = w1; s1 = s; i1 = e; w1 = sc[e]; } else if (s > s2) { s2 = s; i2 = e; w2 = sc[e]; } } }
        if (c.lane == 0) { const float ws = w1 + w2;
            TOKI[2 * m] = i1; TOKI[2 * m + 1] = i2; TOKW[2 * m] = w1 / ws; TOKW[2 * m + 1] = w2 / ws;
            TOKP[2 * m] = (int)atomicAdd(cnt + i1, 1u); TOKP[2 * m + 1] = (int)atomicAdd(cnt + i2, 1u); }
    }
    float* scr = (float*)(c.lds + c.wave * 16384);
    bf16* WGU = (bf16*)(a.ws + WS_WGU); bf16* WD = (bf16*)(a.ws + WS_WD);
    constexpr int IG = (D / 64) * (FF / 32);
    constexpr int ID = (FF / 64) * (D / 32);
    for (int it = c.gw; it < NE * (2 * IG + ID); it += c.ngw) {
        const int e = it / (2 * IG + ID); int r = it % (2 * IG + ID);
        const size_t eo = ((size_t)l * NE + e) * (size_t)D * FF;
        if (r < IG) { transpose_matrix_item(a.in[I_EG] + eo, D, FF, WGU + (size_t)e * 1024 * 1024, r, scr, c.lane, RowGU{0}); continue; } r -= IG;
        if (r < IG) { transpose_matrix_item(a.in[I_EU] + eo, D, FF, WGU + (size_t)e * 1024 * 1024, r, scr, c.lane, RowGU{1}); continue; } r -= IG;
        transpose_matrix_item(a.in[I_ED] + eo, FF, D, WD + (size_t)e * 1024 * 512, r, scr, c.lane, RowId());
    }
}

__device__ __forceinline__ void phase_perm(const Args& a, const Ctx& c, int l) {
    const unsigned* cnt = (const unsigned*)(a.ws + WS_CTL) + CW_CNT + 64 * l;
    int ts[17]; { int s = 0;
#pragma unroll
        for (int e = 0; e < 16; ++e) { ts[e] = s; s += ((int)cnt[e] + 255) >> 8; } ts[16] = s; }
    const int* TOKI = (const int*)(a.ws + WS_TOKI); const int* TOKP = (const int*)(a.ws + WS_TOKP); int* S2T = (int*)(a.ws + WS_S2T);
    const bf16* XN = (const bf16*)(a.ws + WS_XN); bf16* XS = (bf16*)(a.ws + WS_XS);
    for (int as = c.gw; as < 2 * T; as += c.ngw) {
        const int e = TOKI[as]; int base = 0;
#pragma unroll
        for (int j = 0; j < 16; ++j) base = (j == e) ? ts[j] : base;
        const int slot = base * 256 + TOKP[as];
        if (c.lane == 0) S2T[slot] = as;
        const u32x4* src = (const u32x4*)(XN + (size_t)(as >> 1) * D); u32x4* dst = (u32x4*)(XS + (size_t)slot * D);
        dst[c.lane] = src[c.lane]; dst[64 + c.lane] = src[64 + c.lane];
    }
    for (int e = 0; e < 16; ++e) {
        int tse = 0, tsn = 0;
#pragma unroll
        for (int j = 0; j < 16; ++j) { tse = (j == e) ? ts[j] : tse; tsn = (j == e) ? ts[j + 1] : tsn; }
        const int lo = tse * 256 + (int)cnt[e], hi = tsn * 256;
        for (int s = lo + c.gw; s < hi; s += c.ngw) { if (c.lane == 0) S2T[s] = -1; u32x4* dst = (u32x4*)(XS + (size_t)s * D); const u32x4 zz = {0u, 0u, 0u, 0u}; dst[c.lane] = zz; dst[64 + c.lane] = zz; }
    }
}

__device__ __forceinline__ void phase_ln2(const Args& a, const Ctx& c, int l) {
    const float* MODF = (const float*)(a.ws + WS_MODF) + l * 6144;
    const float* g2 = a.in[I_LN2G] + l * D; const float* b2 = a.in[I_LN2B] + l * D;
    const bf16* Y = (const bf16*)(a.ws + WS_Y); bf16* XN = (bf16*)(a.ws + WS_XN);
    for (int m = c.gw; m < T; m += c.ngw) {
        float v[16]; load_row16(a.out + (size_t)m * D, c.lane, v);
#pragma unroll
        for (int j = 0; j < 4; ++j) { const int col = 4 * c.lane + 256 * j; const f32x4 y0 = load4bf(Y + (size_t)(2 * m) * D + col), y1 = load4bf(Y + (size_t)(2 * m + 1) * D + col);
#pragma unroll
            for (int e = 0; e < 4; ++e) v[4 * j + e] = ALPHA * v[4 * j + e] + (1.0f + MODF[5120 + col + e]) * (y0[e] + y1[e]); }
        float mean, rstd; row_stats(v, mean, rstd);
#pragma unroll
        for (int j = 0; j < 4; ++j) { f32x4 o; const int col = 4 * c.lane + 256 * j;
#pragma unroll
            for (int e = 0; e < 4; ++e) { v[4 * j + e] = (v[4 * j + e] - mean) * rstd * g2[col + e] + b2[col + e]; o[e] = v[4 * j + e]; }
            *(f32x4*)(a.out + (size_t)m * D + col) = o; }
        if (l + 1 < DEPTH) {
            const float* MN = MODF + 6144;
            row_stats(v, mean, rstd);
#pragma unroll
            for (int j = 0; j < 4; ++j) { f32x4 o; const int col = 4 * c.lane + 256 * j;
#pragma unroll
                for (int e = 0; e < 4; ++e) o[e] = (v[4 * j + e] - mean) * rstd * (1.0f + MN[1024 + col + e]) + MN[col + e];
                store4bf(XN + (size_t)m * D + col, o); }
        }
    }
}


template <class F> struct EpiAdapt {
    static constexpr bool PERM = false, AFTER_DRAIN = false; F f;
    __device__ __forceinline__ void operator()(const f32x4 (&acc)[2][2][4][2], const Unit& u, int wr, int wc, int fr, int fq) const {
#pragma unroll
        for (int ai = 0; ai < 2; ++ai)
#pragma unroll
            for (int m = 0; m < 4; ++m) { const int row = u.pm * 256 + ai * 128 + wr * 64 + m * 16 + fr;
#pragma unroll
                for (int n = 0; n < 2; ++n) { const int col = u.pn * 256 + wc * 32 + n * 16 + 4 * fq; f(row, col, acc[ai][0][m][n], acc[ai][1][m][n]); } }
    }
};

#ifndef USE_PG8
#define USE_PG8 1
#endif
template <class Sched, class F>
__device__ __forceinline__ void gemm_any(const Ctx& c, const bf16* A, const bf16* Bt, int M, int N, int K, const Sched& S, const F& f) {
#if USE_PG8
    pg8::Gemm g{A, Bt, M, N, K}; EpiAdapt<F> E{f};
    pg8::gemm_phase<EpiAdapt<F>, Sched, true, true>((PG8_LAS unsigned char*)c.lds, g, S, E);
#else
    gemm_simple(c, A, Bt, K, S, f);
#endif
}

#define LAS __attribute__((address_space(3)))
#define XB_TMO      128
#define XB_XCNT(j)  (256  + 64 * (j))
#define XB_XSUB(j)  (1280 + 64 * (j))
#define XB_XGEN(j)  (2304 + 64 * (j))
#define XB_TOP      3328
#define XB_TOPGEN   3392
#define XCD_BAR_WORDS 3456
#define XB_SPIN_CAP (1u << 24)

__device__ __forceinline__ unsigned xb_ld(unsigned* p)              { return __hip_atomic_load(p, __ATOMIC_RELAXED, __HIP_MEMORY_SCOPE_AGENT); }
__device__ __forceinline__ unsigned xb_add(unsigned* p, unsigned v) { return __hip_atomic_fetch_add(p, v, __ATOMIC_RELAXED, __HIP_MEMORY_SCOPE_AGENT); }
__device__ __forceinline__ unsigned xb_xcc_id() { return (unsigned)__builtin_amdgcn_s_getreg((3 << 11) | 20) & 0xFu; }
#define XB_SPIN(cond, bar) do { unsigned _sp = 0; while (cond) { __builtin_amdgcn_s_sleep(1); \
    if ((++_sp & 255u) == 0u) { if (xb_ld(&(bar)[XB_TMO])) break; if (_sp > XB_SPIN_CAP) { atomicAdd(&(bar)[XB_TMO], 1u); break; } } } } while (0)

struct XcdBarrier {
    unsigned* bar; unsigned x;
    volatile LAS unsigned* st;
};

__device__ __forceinline__ XcdBarrier xcd_barrier_post(unsigned* bar, volatile LAS unsigned* st) {
    XcdBarrier b; b.bar = bar; b.x = xb_xcc_id(); b.st = st;
    if (threadIdx.x == 0) (void)xb_add(&bar[XB_XCNT(b.x)], 1u);
    return b;
}
__device__ __forceinline__ void xcd_barrier_complete(unsigned* bar, unsigned x, unsigned& nloc, unsigned& nx) {
    const unsigned G = gridDim.x * gridDim.y * gridDim.z;
    unsigned sum, cnt, mine, sp = 0u;
    for (;;) {
        sum = 0u; cnt = 0u; mine = 0u;
#pragma unroll
        for (unsigned j = 0; j < 16; ++j) { const unsigned c = xb_ld(&bar[XB_XCNT(j)]); sum += c; cnt += (c > 0u) ? 1u : 0u; mine = (j == x) ? c : mine; }
        if (sum == G) break;
        __builtin_amdgcn_s_sleep(1);
        if ((++sp & 255u) == 0u) { if (xb_ld(&bar[XB_TMO])) break; if (sp > XB_SPIN_CAP) { atomicAdd(&bar[XB_TMO], 1u); break; } }
    }
    nloc = mine > 0u ? mine : 1u; nx = cnt > 0u ? cnt : 1u;
}

__device__ __forceinline__ void xcd_barrier(const XcdBarrier& b) {
    asm volatile("s_waitcnt vmcnt(0)" ::: "memory");
    __syncthreads();
    if (threadIdx.x == 0) {
        unsigned* bar = b.bar;
        __builtin_amdgcn_s_waitcnt(0);
        unsigned nloc = b.st[0], nx = b.st[1];
        if (nloc == 0u) { xcd_barrier_complete(bar, b.x, nloc, nx); b.st[0] = nloc; b.st[1] = nx; }
        const unsigned old = xb_add(&bar[XB_XSUB(b.x)], 1u);
        const unsigned gen = old / nloc;
        if (old + 1u == (gen + 1u) * nloc) {
            __builtin_amdgcn_fence(__ATOMIC_RELEASE, "agent");
            asm volatile("s_waitcnt vmcnt(0)" ::: "memory");
            const unsigned og = xb_add(&bar[XB_TOP], 1u);
            const unsigned tg = og / nx;
            if (og + 1u == (tg + 1u) * nx) xb_add(&bar[XB_TOPGEN], 1u);
            else XB_SPIN(xb_ld(&bar[XB_TOPGEN]) == tg, bar);
            __builtin_amdgcn_fence(__ATOMIC_ACQUIRE, "agent");
            xb_add(&bar[XB_XGEN(b.x)], 1u);
            asm volatile("s_waitcnt vmcnt(0)" ::: "memory");
        } else {
            XB_SPIN(xb_ld(&bar[XB_XGEN(b.x)]) == gen, bar);
            __builtin_amdgcn_fence(__ATOMIC_ACQUIRE, "agent");
            asm volatile("s_waitcnt vmcnt(0)" ::: "memory");
        }
    }
    __syncthreads();
}


constexpr int PH_PER_LAYER = 12, N_PHASES = 2 + PH_PER_LAYER * DEPTH;
constexpr int CW_BAR = 4096;
constexpr int LDS_BYTES = 147456, LDSCTL_OFF = 131072 + 8192;
#ifndef SINGLE_LAUNCH
#define SINGLE_LAUNCH 1
#endif

template <int L>
__device__ __forceinline__ void run_layer(const Args& a, const Ctx& c, const XcdBarrier& bar) {
    unsigned char* ws = a.ws;
    const int G = gridDim.x, b = blockIdx.x;
#define BAR() xcd_barrier(bar)
#define ON(k) (a.ph_lo <= (k) && (k) < a.ph_hi)
    if (ON(0)) { pg8::StaticOrder S; S.init(T, INC, G, b); EpiZ E{(bf16*)(ws + WS_ZR), (bf16*)(ws + WS_ZS), (bf16*)(ws + WS_ZG)};
        gemm_any(c, (const bf16*)(ws + WS_XN), (const bf16*)(ws + WS_WIN + (size_t)L * 10 * MiB), T, INC, D, S, E); }
    BAR();
    if (ON(1)) { phase_prep_simple(a, c, L); phase_sg_simple(a, c, L); }
    BAR();
    if (ON(2)) phase_scan1(a, c);
    BAR();
    if (ON(3)) phase_scan2_simple(a, c);
    BAR();
    if (ON(4)) phase_scan3(a, c);
    BAR();
    if (ON(5)) phase_post(a, c, L);
    BAR();
    if (ON(6)) { pg8::StaticOrder S; S.init(T, D, G, b); EpiGA E{(const bf16*)(ws + WS_ZG), (bf16*)(ws + WS_MP)};
        gemm_any(c, (const bf16*)(ws + WS_YA), (const bf16*)(ws + WS_WA + (size_t)L * WS_WL1), T, D, W, S, E); }
    BAR();
    if (ON(7)) { pg8::StaticOrder S; S.init(T, D, G, b); EpiGB E{(const bf16*)(ws + WS_ZG), (bf16*)(ws + WS_MP)};
        gemm_any(c, (const bf16*)(ws + WS_YB), (const bf16*)(ws + WS_WB + (size_t)L * WS_WL1), T, D, W, S, E); }
    BAR();
    if (ON(8)) { pg8::StaticOrder S; S.init(T, D, G, b); EpiOut E{L == 0 ? a.in[I_X] : a.out, a.out, (const float*)(ws + WS_MODF) + L * 6144 + 2048};
        gemm_any(c, (const bf16*)(ws + WS_MP), (const bf16*)(ws + WS_WO + (size_t)L * WS_WL1), T, D, D, S, E); }
    BAR();
    if (ON(9)) phase_ln1(a, c, L);
    BAR();
    if (ON(10)) phase_perm(a, c, L);
    BAR();
    if (ON(11)) { MoeSched S; S.init((const unsigned*)(ws + WS_CTL) + CW_CNT + 64 * L, G, b); EpiSwi E{(bf16*)(ws + WS_HID)};
        gemm_any(c, (const bf16*)(ws + WS_XS), (const bf16*)(ws + WS_WGU), MAXSLOT, NE * 1024, D, S, E); }
    BAR();
    if (ON(12)) { MoeSched S; S.init((const unsigned*)(ws + WS_CTL) + CW_CNT + 64 * L, G, b); EpiDown E{(const int*)(ws + WS_S2T), (const float*)(ws + WS_TOKW), (bf16*)(ws + WS_Y)};
        gemm_any(c, (const bf16*)(ws + WS_HID), (const bf16*)(ws + WS_WD), MAXSLOT, NE * 1024, FF, S, E); }
    BAR();
    if (ON(13)) phase_ln2(a, c, L);
    if (L + 1 < DEPTH) BAR();
#undef BAR
#undef ON
}

__global__ void __launch_bounds__(NTHREADS, 2) mk_fwd(Args a) {
    extern __shared__ __attribute__((aligned(16))) unsigned char lds[];
    Ctx c; c.tid = threadIdx.x; c.lane = c.tid & 63; c.wave = __builtin_amdgcn_readfirstlane(c.tid >> 6);
    c.gw = blockIdx.x * NWAVES + c.wave; c.ngw = gridDim.x * NWAVES; c.lds = lds;
    for (int u = c.tid; u < (LDS_BYTES - LDSCTL_OFF) / 4; u += NTHREADS) ((LAS unsigned*)((LAS unsigned char*)lds + LDSCTL_OFF))[u] = 0u;
    __syncthreads();
    const XcdBarrier bar = xcd_barrier_post((unsigned*)(a.ws + WS_CTL) + CW_BAR, (volatile LAS unsigned*)((LAS unsigned char*)lds + LDSCTL_OFF) + 8);
    if (a.ph_lo <= 0) phase_p0a(a, c);
    xcd_barrier(bar);
    if (a.ph_lo <= 1) phase_p0b(a, c);
    xcd_barrier(bar);
    run_layer<0>(a, c, bar);
    run_layer<1>(a, c, bar);
}

extern "C" void kernel_launch(void* const* d_in, const int* in_sizes, int n_in, void* d_out, int out_size, void* d_ws, size_t ws_size, hipStream_t stream) {
    static int grid = 0;
    if (grid == 0) {
        if (n_in != N_IN || out_size != T * D || ws_size < WS_END) { fprintf(stderr, "kernel_launch: unexpected shapes: n_in %d out %d ws %zu (need %zu)\n", n_in, out_size, ws_size, (size_t)WS_END); grid = -1; return; }
        int dev = 0, cus = 0;
        (void)hipGetDevice(&dev); (void)hipDeviceGetAttribute(&cus, hipDeviceAttributeMultiprocessorCount, dev);
        if (hipFuncSetAttribute((const void*)mk_fwd, hipFuncAttributeMaxDynamicSharedMemorySize, LDS_BYTES) != hipSuccess) { fprintf(stderr, "kernel_launch: hipFuncSetAttribute failed\n"); grid = -1; return; }
        grid = cus > 0 ? cus : 256;
        fprintf(stderr, "kernel_launch: ws_size %zu grid %d\n", ws_size, grid);
    }
    if (grid < 0) return;
    (void)hipMemsetAsync((char*)d_ws + WS_CTL, 0, CTL_BYTES, stream);
    Args a{};
    for (int i = 0; i < N_IN; ++i) a.in[i] = (const float*)d_in[i];
    a.out = (float*)d_out; a.ws = (unsigned char*)d_ws;
    a.ph_lo = 0; a.ph_hi = 1000;
    hipLaunchKernelGGL(mk_fwd, dim3(grid), dim3(NTHREADS), LDS_BYTES, stream, a);
}
```

```cpp
#include <hip/hip_runtime.h>
#include <cstdio>
#include <cstdint>
#include <utility>

typedef unsigned short bf16;
typedef _Float16 f16;
typedef float f32x4 __attribute__((ext_vector_type(4)));
typedef unsigned u32x4 __attribute__((ext_vector_type(4)));
typedef unsigned u32x2 __attribute__((ext_vector_type(2)));

constexpr int T = 16384, D = 1024, W = 512, NH = 8, HN = 64, RC = 1792, INC = 4864;
constexpr int NE = 16, FF = 512, DEPTH = 2;
constexpr float LN_EPS = 1e-5f, GN_EPS = 64e-5f, ALPHA = 1.41421356237f;
constexpr int NTHREADS = 512, NWAVES = 8;
constexpr int MAXSLOT = 36864;

constexpr size_t MiB = 1u << 20;
constexpr size_t WS_CTL = 0, CTL_BYTES = 1 * MiB;
constexpr int CW_CNT = 16384;
constexpr size_t WS_PART = 1 * MiB;
constexpr size_t WS_MODF = 2 * MiB;
constexpr size_t WS_TOKI = 2 * MiB + 65536;
constexpr size_t WS_TOKW = WS_TOKI + 131072;
constexpr size_t WS_TOKP = WS_TOKW + 131072;
constexpr size_t WS_S2T = 3 * MiB;
constexpr size_t WS_LORA = 4 * MiB;
constexpr size_t WS_WIN = 8 * MiB;
constexpr size_t WS_WA = 28 * MiB, WS_WB = 29 * MiB, WS_WO = 30 * MiB, WS_WL1 = 4 * MiB;
constexpr size_t WS_ZG = 36 * MiB;
constexpr size_t WS_XN = 100 * MiB;
constexpr size_t WS_G = 100 * MiB, WS_YB = 116 * MiB;
constexpr size_t WS_ZR = 132 * MiB;
constexpr size_t WS_ZS = 188 * MiB;
constexpr size_t WS_YSC = 132 * MiB;
constexpr size_t WS_ST = 148 * MiB;
constexpr size_t WS_YA = 148 * MiB;
constexpr size_t WS_MP = 164 * MiB;
constexpr size_t WS_XS = 132 * MiB;
constexpr size_t WS_Y = 132 * MiB;
constexpr size_t WS_R = 224 * MiB, WS_WM1 = 240 * MiB, WS_KP = 256 * MiB, WS_AA = 272 * MiB, WS_BB = 288 * MiB, WS_V = 304 * MiB;
constexpr size_t WS_WGU = 224 * MiB;
constexpr size_t WS_WD = 256 * MiB;
constexpr size_t WS_HID = 272 * MiB;
constexpr size_t WS_VF = 320 * MiB;
constexpr size_t WS_END = 336 * MiB;

constexpr size_t LO_W2T = 0, LO_A2T = 65536, LO_G2T = 131072, LO_VM1T = 262144, LO_VM2T = 294912, LO_STRIDE = 524288;

enum { I_X = 0, I_C, I_WMOD, I_BMOD, I_WIN, I_MU, I_W0, I_W2, I_A0, I_A2, I_G2, I_KK, I_KA, I_RK, I_GNG, I_GNB, I_VM0, I_VM1, I_VM2,
       I_SGG, I_SGB, I_WS, I_BS, I_WBA, I_WBB, I_WOUT, I_LN1G, I_LN1B, I_RW, I_RB, I_EG, I_EU, I_ED, I_LN2G, I_LN2B, N_IN };

struct Args { const float* in[N_IN]; float* out; unsigned char* ws; int ph_lo, ph_hi; };
typedef const __attribute__((address_space(4))) Args& ArgsR;

__device__ __forceinline__ float bf2f(bf16 h) { return __uint_as_float(((unsigned)h) << 16); }
__device__ __forceinline__ unsigned f2bfu(float f) { unsigned u = __float_as_uint(f); return (u + 0x7fffu + ((u >> 16) & 1u)) >> 16; }
__device__ __forceinline__ bf16 f2bf(float f) { return (bf16)f2bfu(f); }
__device__ __forceinline__ unsigned pk2(float lo, float hi) { return f2bfu(lo) | (f2bfu(hi) << 16); }
__device__ __forceinline__ void store4bf(bf16* p, f32x4 v) { u32x2 w; w.x = pk2(v[0], v[1]); w.y = pk2(v[2], v[3]); *(u32x2*)p = w; }
__device__ __forceinline__ f32x4 load4bf(const bf16* p) { u32x2 w = *(const u32x2*)p; f32x4 r; r[0] = __uint_as_float(w.x << 16); r[1] = __uint_as_float(w.x & 0xffff0000u); r[2] = __uint_as_float(w.y << 16); r[3] = __uint_as_float(w.y & 0xffff0000u); return r; }
__device__ __forceinline__ float wave_sum(float v) {
#pragma unroll
    for (int o = 1; o < 64; o <<= 1) v += __shfl_xor(v, o);
    return v;
}
__device__ __forceinline__ float sigmoidf_(float x) { return 1.0f / (1.0f + __expf(-x)); }
__device__ __forceinline__ float siluf_(float x) { return x * sigmoidf_(x); }
__device__ __forceinline__ float gelu_tanh(float x) { const float u = 0.7978845608028654f * (x + 0.044715f * x * x * x); return x * (1.0f - 1.0f / (1.0f + __expf(2.0f * u))); }
__device__ __forceinline__ float softplusf_(float y) { return fmaxf(y, 0.f) + log1pf(__expf(-fabsf(y))); }

struct Ctx { int tid, lane, wave, gw, ngw; unsigned char* lds; };

__device__ __forceinline__ void transpose_item(const float* Wsrc, int N, int k0, int n0, bf16* dst, int ldk, float* scr, int lane) {
#pragma unroll 8
    for (int i = 0; i < 32; ++i) { const int kk = 2 * i + (lane >> 5); scr[kk * 33 + (lane & 31)] = Wsrc[(size_t)(k0 + kk) * N + n0 + (lane & 31)]; }
    asm volatile("s_waitcnt lgkmcnt(0)" ::: "memory");
    const int c = lane & 7;
#pragma unroll
    for (int j = 0; j < 4; ++j) { const int n = (lane >> 3) + 8 * j; const float* s = scr + (8 * c) * 33 + n;
        u32x4 o; o.x = pk2(s[0 * 33], s[1 * 33]); o.y = pk2(s[2 * 33], s[3 * 33]); o.z = pk2(s[4 * 33], s[5 * 33]); o.w = pk2(s[6 * 33], s[7 * 33]);
        *(u32x4*)(dst + (size_t)n * ldk + k0 + 8 * c) = o; }
    asm volatile("s_waitcnt lgkmcnt(0)" ::: "memory");
}
template <class RowMap>
__device__ __forceinline__ void transpose_matrix_item(const float* Wsrc, int K, int N, bf16* dst, int item, float* scr, int lane, const RowMap& rm) {
    const int nblk = N / 32, kb = item / nblk, nb = item % nblk, n0 = 32 * nb;
    transpose_item(Wsrc, N, 64 * kb, n0, dst + (size_t)rm(n0) * K, K, scr, lane);
}
struct RowId { __device__ __forceinline__ int operator()(int n) const { return n; } };
struct RowGU { int up; __device__ __forceinline__ int operator()(int n) const { return (n >> 7) * 256 + (n & 127) + up * 128; } };

__device__ __forceinline__ void phase_p0a(ArgsR a, const Ctx& c) {
    float* scr = (float*)(c.lds + c.wave * 16384);
    float* PART = (float*)(a.ws + WS_PART);
    for (int it = c.gw; it < 2 * 96 * 16; it += c.ngw) {
        const int kb = it & 15, cb = (it >> 4) % 96, l = it / (16 * 96);
        const int n = cb * 64 + c.lane;
        const float* wm = a.in[I_WMOD] + (size_t)l * D * 6144;
        float acc = 0.f;
#pragma unroll 8
        for (int k = 0; k < 64; ++k) { const int kk = kb * 64 + k; acc += siluf_(a.in[I_C][kk]) * wm[(size_t)kk * 6144 + n]; }
        PART[((size_t)l * 16 + kb) * 6144 + n] = acc;
    }
    for (int it = c.gw; it < 2 * (16 + 16 + 32 + 8); it += c.ngw) {
        const int l = it / 72; int r = it % 72; unsigned char* lo = a.ws + WS_LORA + (size_t)l * LO_STRIDE;
        if (r < 16) { transpose_matrix_item(a.in[I_W2] + (size_t)l * 64 * W, 64, W, (bf16*)(lo + LO_W2T), r, scr, c.lane, RowId()); continue; } r -= 16;
        if (r < 16) { transpose_matrix_item(a.in[I_A2] + (size_t)l * 64 * W, 64, W, (bf16*)(lo + LO_A2T), r, scr, c.lane, RowId()); continue; } r -= 16;
        if (r < 32) { transpose_matrix_item(a.in[I_G2] + (size_t)l * 128 * W, 128, W, (bf16*)(lo + LO_G2T), r, scr, c.lane, RowId()); continue; } r -= 32;
        if (l == 1) transpose_matrix_item(a.in[I_VM1], W, 32, (bf16*)(lo + LO_VM1T), r, scr, c.lane, RowId());
    }
    for (int i = blockIdx.x * NTHREADS + c.tid; i < 32 * W; i += gridDim.x * NTHREADS) { const int n = i >> 5, k = i & 31;
        ((bf16*)(a.ws + WS_LORA + LO_STRIDE + LO_VM2T))[i] = f2bf(a.in[I_VM2][(size_t)k * W + n]); }
    constexpr int I_WINL = (D / 64) * (INC / 32);
    constexpr int I_WAL = (W / 64) * (D / 32);
    constexpr int I_WOL = (D / 64) * (D / 32);
    constexpr int PER_L = I_WINL + 2 * I_WAL + I_WOL;
    for (int it = c.gw; it < 2 * PER_L; it += c.ngw) {
        const int l = it / PER_L; int r = it % PER_L;
        if (r < I_WINL) { transpose_matrix_item(a.in[I_WIN] + (size_t)l * D * INC, D, INC, (bf16*)(a.ws + WS_WIN + (size_t)l * 10 * MiB), r, scr, c.lane, RowId()); continue; } r -= I_WINL;
        if (r < I_WAL) { transpose_matrix_item(a.in[I_WBA] + (size_t)l * W * D, W, D, (bf16*)(a.ws + WS_WA + (size_t)l * WS_WL1), r, scr, c.lane, RowId()); continue; } r -= I_WAL;
        if (r < I_WAL) { transpose_matrix_item(a.in[I_WBB] + (size_t)l * W * D, W, D, (bf16*)(a.ws + WS_WB + (size_t)l * WS_WL1), r, scr, c.lane, RowId()); continue; } r -= I_WAL;
        transpose_matrix_item(a.in[I_WOUT] + (size_t)l * D * D, D, D, (bf16*)(a.ws + WS_WO + (size_t)l * WS_WL1), r, scr, c.lane, RowId());
    }
}

__device__ __forceinline__ void row_stats(const float (&v)[16], float& mean, float& rstd) {
    float s = 0.f;
#pragma unroll
    for (int j = 0; j < 16; ++j) s += v[j];
    mean = wave_sum(s) * (1.f / D);
    float q = 0.f;
#pragma unroll
    for (int j = 0; j < 16; ++j) { const float d = v[j] - mean; q += d * d; }
    rstd = 1.0f / sqrtf(wave_sum(q) * (1.f / D) + LN_EPS);
}
__device__ __forceinline__ void load_row16(const float* p, int lane, float (&v)[16]) {
#pragma unroll
    for (int j = 0; j < 4; ++j) { const f32x4 x = *(const f32x4*)(p + 4 * lane + 256 * j); v[4 * j] = x[0]; v[4 * j + 1] = x[1]; v[4 * j + 2] = x[2]; v[4 * j + 3] = x[3]; }
}

__device__ __forceinline__ void phase_p0b(ArgsR a, const Ctx& c) {
    const float* PART = (const float*)(a.ws + WS_PART);
    float* MODF = (float*)(a.ws + WS_MODF);
    for (int i = blockIdx.x * NTHREADS + c.tid; i < 2 * 6144; i += gridDim.x * NTHREADS) {
        const int l = i / 6144, n = i % 6144; float s = a.in[I_BMOD][i];
#pragma unroll
        for (int kb = 0; kb < 16; ++kb) s += PART[((size_t)l * 16 + kb) * 6144 + n];
        MODF[i] = s;
    }
    float sh[16], sc[16];
#pragma unroll
    for (int j = 0; j < 4; ++j)
#pragma unroll
        for (int e = 0; e < 4; ++e) { const int col = 4 * c.lane + 256 * j + e; float s0 = a.in[I_BMOD][col], s1 = a.in[I_BMOD][1024 + col];
            for (int kb = 0; kb < 16; ++kb) { s0 += PART[(size_t)kb * 6144 + col]; s1 += PART[(size_t)kb * 6144 + 1024 + col]; }
            sh[4 * j + e] = s0; sc[4 * j + e] = 1.f + s1; }
    bf16* XN = (bf16*)(a.ws + WS_XN);
    for (int m = c.gw; m < T; m += c.ngw) {
        float v[16]; load_row16(a.in[I_X] + (size_t)m * D, c.lane, v);
        float mean, rstd; row_stats(v, mean, rstd);
#pragma unroll
        for (int j = 0; j < 4; ++j) { f32x4 o;
#pragma unroll
            for (int e = 0; e < 4; ++e) o[e] = (v[4 * j + e] - mean) * rstd * sc[4 * j + e] + sh[4 * j + e];
            store4bf(XN + (size_t)m * D + 4 * c.lane + 256 * j, o); }
    }
}

namespace pg8 {
#define PG8_LAS __attribute__((address_space(3)))
typedef unsigned short bf16_t;
typedef short bf16x8 __attribute__((ext_vector_type(8)));
typedef float f32x4 __attribute__((ext_vector_type(4)));
typedef unsigned u32x4 __attribute__((ext_vector_type(4)));
constexpr int BM = 256, BK = 64, HALF = 128, HTB = HALF * BK * 2  , STAGE_BYTES = 8 * HTB, NXCD = 8, WGM = 8;

__host__ __device__ __forceinline__ int lds_byte(int r, int c) { const int st = (r >> 4) * 2 + (c >> 5), rr = r & 15, cc = c & 31, ob = rr * 64 + cc * 2; return st * 1024 + (ob ^ (((ob >> 9) & 1) << 5)); }
__host__ __device__ __forceinline__ void stage_rc(int b, int& R, int& C) { const int st = b / 1024, sb = b % 1024, swz = sb ^ (((sb >> 9) & 1) << 5); R = (st >> 1) * 16 + swz / 64; C = (st & 1) * 32 + (swz % 64) / 2; }
__host__ __device__ __forceinline__ int perm32(int rho) { const int n = rho >> 4, i = rho & 15; return 8 * (i >> 2) + 4 * n + (i & 3); }

struct Unit { int pm, pn; };
struct Gemm { const bf16_t* A; const bf16_t* Bt; int M, N, K; };

struct StaticOrder {
    int nM, nN, nwg, G, c;
    __host__ __device__ void init(int M, int N, int G_, int c_) { nM = M / BM; nN = N / BM; nwg = nM * nN; G = G_; c = c_; }
    __host__ __device__ bool next(int i, Unit& u) const {
        const long L = (long)i * G + c; if (L >= nwg) return false;
        int wgid = (int)L; { const int q = nwg / NXCD, r = nwg % NXCD, xcd = wgid % NXCD, off = wgid / NXCD; wgid = (xcd < r ? xcd * (q + 1) : r * (q + 1) + (xcd - r) * q) + off; }
        const int nig = WGM * nN, gid = wgid / nig, fm = gid * WGM, gsz = (nM - fm) < WGM ? (nM - fm) : WGM;
        u.pm = fm + ((wgid % nig) % gsz); u.pn = (wgid % nig) / gsz; return true;
    }
    __device__ __forceinline__ void a_ready(const Unit&) const {}
    __device__ __forceinline__ void done(const Unit&) const {}
};


template <class Epi, class Sched, bool ALIGN_EPI = false, bool SP2 = false>
__device__ __forceinline__ void gemm_phase(PG8_LAS unsigned char* lds, const Gemm g, const Sched& S, const Epi& E) {
    const int tid = threadIdx.x, wid = __builtin_amdgcn_readfirstlane(tid >> 6), lane = tid & 63, wr = wid >> 2, wc = wid & 3, fr = lane & 15, fq = lane >> 4;
    const int K = g.K, nt = K / BK;
    unsigned voffA[2], voffB[2];
#pragma unroll
    for (int i = 0; i < 2; ++i) { int R, C; stage_rc(tid * 16 + i * 8192, R, C); const int Rb = Epi::PERM ? ((R & ~31) + perm32(R & 31)) : R;
        voffA[i] = (unsigned)(R * K + C) * 2u; voffB[i] = (unsigned)(Rb * K + C) * 2u; }
    const size_t kstep = (size_t)(BK * 2);
    const size_t hstep = (size_t)HALF * K * 2;
    const size_t tstep = 2 * hstep;
    const unsigned ldsw = (unsigned)wid * 1024u;
    const int aoff = lds_byte(wr * 64 + fr, fq * 8), boff = lds_byte(wc * 32 + fr, fq * 8);
#define PG8_SA(b, h) (((b) * 2 + (h)) * HTB)
#define PG8_SB(b, h) ((4 + (b) * 2 + (h)) * HTB)
#define PG8_STAGE(bufoff, gbase, voff) do { _Pragma("unroll") for (int _i = 0; _i < 2; ++_i) \
        __builtin_amdgcn_global_load_lds((const unsigned*)((const char*)(gbase) + (voff)[_i]), (PG8_LAS unsigned*)(lds + (bufoff) + ldsw + _i * 8192), 16, 0, 0); } while (0)
#define PG8_LDA(dst, b, h) do { _Pragma("unroll") for (int m = 0; m < 4; ++m) _Pragma("unroll") for (int k = 0; k < 2; ++k) dst[m][k] = *(const PG8_LAS bf16x8*)(lds + PG8_SA(b, h) + aoff + m * 2048 + k * 1024); } while (0)
#define PG8_LDB(dst, b, h) do { _Pragma("unroll") for (int n = 0; n < 2; ++n) _Pragma("unroll") for (int k = 0; k < 2; ++k) dst[n][k] = *(const PG8_LAS bf16x8*)(lds + PG8_SB(b, h) + boff + n * 2048 + k * 1024); } while (0)
#define PG8_MMA(ai, bj, At, Bt) do { __builtin_amdgcn_s_setprio(1); _Pragma("unroll") for (int m = 0; m < 4; ++m) _Pragma("unroll") for (int n = 0; n < 2; ++n) _Pragma("unroll") for (int k = 0; k < 2; ++k) \
        acc[ai][bj][m][n] = __builtin_amdgcn_mfma_f32_16x16x32_bf16(Bt[n][k], At[m][k], acc[ai][bj][m][n], 0, 0, 0); __builtin_amdgcn_s_setprio(0); } while (0)
#define PG8_WAIT_V(n) asm volatile("s_waitcnt vmcnt(" #n ")" ::: "memory")
#define PG8_WAIT_L(n) asm volatile("s_waitcnt lgkmcnt(" #n ")" ::: "memory")
#define PG8_BAR __builtin_amdgcn_s_barrier()
#define PG8_SCHED __builtin_amdgcn_sched_barrier(0)
    Unit cur, nxt; int ui = 0;
    if (!S.next(0, cur)) return;
    f32x4 acc[2][2][4][2];
#pragma unroll
    for (int a = 0; a < 2; ++a)
#pragma unroll
        for (int b = 0; b < 2; ++b)
#pragma unroll
            for (int m = 0; m < 4; ++m)
#pragma unroll
                for (int n = 0; n < 2; ++n) acc[a][b][m][n] = (f32x4){0.f, 0.f, 0.f, 0.f};
    bf16x8 At[4][2], B0[2][2], B1[2][2];
    const char* cA = (const char*)g.A + (size_t)cur.pm * tstep; const char* cB = (const char*)g.Bt + (size_t)cur.pn * tstep;
    S.a_ready(cur);
    if constexpr (SP2) {
        PG8_STAGE(PG8_SB(0, 0), cB, voffB); PG8_STAGE(PG8_SB(0, 1), cB + hstep, voffB); PG8_STAGE(PG8_SA(0, 0), cA, voffA); PG8_STAGE(PG8_SA(0, 1), cA + hstep, voffA);
        if (wr == 1) PG8_BAR;
        PG8_WAIT_V(2); PG8_BAR;
        PG8_STAGE(PG8_SB(1, 0), cB + kstep, voffB); PG8_STAGE(PG8_SA(1, 0), cA + kstep, voffA); PG8_STAGE(PG8_SB(1, 1), cB + hstep + kstep, voffB);
        PG8_WAIT_V(6); PG8_BAR;
    } else {
        PG8_STAGE(PG8_SB(0, 0), cB, voffB); PG8_STAGE(PG8_SA(0, 0), cA, voffA); PG8_STAGE(PG8_SB(0, 1), cB + hstep, voffB); PG8_STAGE(PG8_SA(0, 1), cA + hstep, voffA);
        if (wr == 1) PG8_BAR;
        PG8_WAIT_V(4); PG8_BAR;
        PG8_STAGE(PG8_SB(1, 0), cB + kstep, voffB); PG8_STAGE(PG8_SA(1, 0), cA + kstep, voffA); PG8_STAGE(PG8_SB(1, 1), cB + hstep + kstep, voffB);
        PG8_WAIT_V(6); PG8_BAR;
    }
    for (;;) {
        const bool has_next = S.next(ui + 1, nxt);
        const char* nA = has_next ? (const char*)g.A + (size_t)nxt.pm * tstep : cA; const char* nB = has_next ? (const char*)g.Bt + (size_t)nxt.pn * tstep : cB;
        for (int t = 0; t < nt; t += 2) {
            const bool last = (t == nt - 2);
            const char* a1 = cA + (size_t)(t + 1) * kstep;
            const char* a2 = last ? nA : cA + (size_t)(t + 2) * kstep; const char* b2 = last ? nB : cB + (size_t)(t + 2) * kstep;
            const char* a3 = a2 + kstep; const char* b3 = b2 + kstep;
            if (last && has_next) S.a_ready(nxt);
            if constexpr (SP2) {
            PG8_LDB(B0, 0, 0); PG8_LDB(B1, 0, 1); PG8_SCHED; PG8_LDA(At, 0, 0); PG8_STAGE(PG8_SA(1, 1), a1 + hstep, voffA);
            PG8_WAIT_V(8); PG8_WAIT_L(0); PG8_BAR; PG8_MMA(0, 0, At, B0); PG8_MMA(0, 1, At, B1); PG8_BAR; PG8_SCHED;
            PG8_LDA(At, 0, 1); PG8_STAGE(PG8_SB(0, 0), b2, voffB); PG8_STAGE(PG8_SB(0, 1), b2 + hstep, voffB); PG8_STAGE(PG8_SA(0, 0), a2, voffA);
            PG8_WAIT_V(8); PG8_WAIT_L(0); PG8_BAR; PG8_MMA(1, 0, At, B0); PG8_MMA(1, 1, At, B1); PG8_BAR; PG8_SCHED;
            PG8_LDB(B0, 1, 0); PG8_LDB(B1, 1, 1); PG8_SCHED; PG8_LDA(At, 1, 0); PG8_STAGE(PG8_SA(0, 1), a2 + hstep, voffA);
            PG8_WAIT_V(8); PG8_WAIT_L(0); PG8_BAR; PG8_MMA(0, 0, At, B0); PG8_MMA(0, 1, At, B1); PG8_BAR; PG8_SCHED;
            PG8_LDA(At, 1, 1); PG8_STAGE(PG8_SB(1, 0), b3, voffB); PG8_STAGE(PG8_SB(1, 1), b3 + hstep, voffB); PG8_STAGE(PG8_SA(1, 0), a3, voffA);
            PG8_WAIT_V(8); PG8_WAIT_L(0); PG8_BAR; PG8_MMA(1, 0, At, B0); PG8_MMA(1, 1, At, B1); PG8_BAR; PG8_SCHED;
            } else {
            PG8_LDB(B0, 0, 0); PG8_SCHED; PG8_LDA(At, 0, 0); PG8_STAGE(PG8_SA(1, 1), a1 + hstep, voffA);
            PG8_WAIT_L(8); PG8_BAR; PG8_WAIT_L(0); PG8_MMA(0, 0, At, B0); PG8_BAR; PG8_SCHED;
            PG8_LDB(B1, 0, 1); PG8_STAGE(PG8_SB(0, 0), b2, voffB);
            PG8_BAR; PG8_WAIT_L(0); PG8_MMA(0, 1, At, B1); PG8_BAR;
            PG8_LDA(At, 0, 1); PG8_STAGE(PG8_SA(0, 0), a2, voffA);
            PG8_BAR; PG8_WAIT_L(0); PG8_MMA(1, 0, At, B0); PG8_BAR; PG8_SCHED;
            PG8_STAGE(PG8_SB(0, 1), b2 + hstep, voffB);
            PG8_WAIT_V(6); PG8_BAR; PG8_MMA(1, 1, At, B1); PG8_BAR;
            PG8_LDB(B0, 1, 0); PG8_SCHED; PG8_LDA(At, 1, 0); PG8_STAGE(PG8_SA(0, 1), a2 + hstep, voffA);
            PG8_WAIT_L(8); PG8_BAR; PG8_WAIT_L(0); PG8_MMA(0, 0, At, B0); PG8_BAR; PG8_SCHED;
            PG8_LDB(B1, 1, 1); PG8_STAGE(PG8_SB(1, 0), b3, voffB);
            PG8_BAR; PG8_WAIT_L(0); PG8_MMA(0, 1, At, B1); PG8_BAR;
            PG8_LDA(At, 1, 1); PG8_STAGE(PG8_SA(1, 0), a3, voffA);
            PG8_BAR; PG8_WAIT_L(0); PG8_MMA(1, 0, At, B0); PG8_BAR; PG8_SCHED;
            PG8_STAGE(PG8_SB(1, 1), b3 + hstep, voffB);
            PG8_WAIT_V(6); PG8_BAR; PG8_MMA(1, 1, At, B1); PG8_BAR;
            }
        }
        if constexpr (ALIGN_EPI) { if (wr == 0) PG8_BAR; }
        if constexpr (!Epi::AFTER_DRAIN) { E(acc, cur, wr, wc, fr, fq); S.done(cur); }
        if (!has_next) break;
#pragma unroll
        for (int a = 0; a < 2; ++a)
#pragma unroll
            for (int b = 0; b < 2; ++b)
#pragma unroll
                for (int m = 0; m < 4; ++m)
#pragma unroll
                    for (int n = 0; n < 2; ++n) acc[a][b][m][n] = (f32x4){0.f, 0.f, 0.f, 0.f};
        cur = nxt; cA = nA; cB = nB; ++ui;
        if constexpr (ALIGN_EPI) { if (wr == 1) PG8_BAR; }
    }
    PG8_WAIT_V(0);
    if constexpr (!ALIGN_EPI) { if (wr == 0) PG8_BAR; }
    PG8_BAR;
    if constexpr (Epi::AFTER_DRAIN) { E.fused(acc, cur, wr, wc, fr, fq, lds, wid, lane); S.done(cur); }
#undef PG8_SA
#undef PG8_SB
#undef PG8_STAGE
#undef PG8_LDA
#undef PG8_LDB
#undef PG8_MMA
#undef PG8_WAIT_V
#undef PG8_WAIT_L
#undef PG8_BAR
#undef PG8_SCHED
}
}

using pg8::Unit;
struct DenseSched { int nN, n, G, c;
    __device__ __forceinline__ void a_ready(const Unit&) const {}
    __device__ __forceinline__ void done(const Unit&) const {}
    __device__ __forceinline__ bool next(int i, Unit& u) const { const int L = i * G + c; if (L >= n) return false; u.pm = L / nN; u.pn = L % nN; return true; } };

template <class Sched, class Epi>
__device__ __forceinline__ void gemm_simple(const Ctx& c, const bf16* A, const bf16* Bt, int K, const Sched& S, const Epi& E) {
    float* As = (float*)c.lds;
    float* Bs = As + 32 * 256;
    const int tid = c.tid, rg = tid >> 4, cg = tid & 15;
    Unit u;
    for (int ui = 0; S.next(ui, u); ++ui) {
        float acc[8][16];
#pragma unroll
        for (int i = 0; i < 8; ++i)
#pragma unroll
            for (int j = 0; j < 16; ++j) acc[i][j] = 0.f;
        const bf16* Ab = A + (size_t)u.pm * 256 * K; const bf16* Bb = Bt + (size_t)u.pn * 256 * K;
        for (int k0 = 0; k0 < K; k0 += 32) {
            { const int row = tid >> 1, kh = tid & 1;
              const u32x4* pa = (const u32x4*)(Ab + (size_t)row * K + k0 + 16 * kh); const u32x4 a0 = pa[0], a1 = pa[1];
              const u32x4* pb = (const u32x4*)(Bb + (size_t)row * K + k0 + 16 * kh); const u32x4 b0 = pb[0], b1 = pb[1];
#pragma unroll
              for (int j = 0; j < 4; ++j) {
                  As[(16 * kh + 2 * j) * 256 + row] = __uint_as_float(a0[j] << 16); As[(16 * kh + 2 * j + 1) * 256 + row] = __uint_as_float(a0[j] & 0xffff0000u);
                  As[(16 * kh + 8 + 2 * j) * 256 + row] = __uint_as_float(a1[j] << 16); As[(16 * kh + 8 + 2 * j + 1) * 256 + row] = __uint_as_float(a1[j] & 0xffff0000u);
                  Bs[(16 * kh + 2 * j) * 256 + row] = __uint_as_float(b0[j] << 16); Bs[(16 * kh + 2 * j + 1) * 256 + row] = __uint_as_float(b0[j] & 0xffff0000u);
                  Bs[(16 * kh + 8 + 2 * j) * 256 + row] = __uint_as_float(b1[j] << 16); Bs[(16 * kh + 8 + 2 * j + 1) * 256 + row] = __uint_as_float(b1[j] & 0xffff0000u);
              } }
            __syncthreads();
#pragma unroll 4
            for (int kk = 0; kk < 32; ++kk) {
                const f32x4 a0 = *(const f32x4*)(As + kk * 256 + rg * 8), a1 = *(const f32x4*)(As + kk * 256 + rg * 8 + 4);
                f32x4 b[4];
#pragma unroll
                for (int q = 0; q < 4; ++q) b[q] = *(const f32x4*)(Bs + kk * 256 + 64 * q + 4 * cg);
#pragma unroll
                for (int i = 0; i < 8; ++i) { const float av = i < 4 ? a0[i & 3] : a1[i & 3];
#pragma unroll
                    for (int q = 0; q < 4; ++q)
#pragma unroll
                        for (int e = 0; e < 4; ++e) acc[i][4 * q + e] += av * b[q][e]; }
            }
            __syncthreads();
        }
#pragma unroll
        for (int i = 0; i < 8; ++i) { const int row = u.pm * 256 + rg * 8 + i;
#pragma unroll
            for (int q = 0; q < 2; ++q) { const int col = u.pn * 256 + 64 * q + 4 * cg;
                f32x4 v0, v1;
#pragma unroll
                for (int e = 0; e < 4; ++e) { v0[e] = acc[i][4 * q + e]; v1[e] = acc[i][4 * (q + 2) + e]; }
                E(row, col, v0, v1); } }
    }
}

struct EpiZ { bf16 *ZR, *ZS, *ZG;
    __device__ __forceinline__ void one(int row, int col, f32x4 v) const {
        if (col < RC) store4bf(ZR + (size_t)row * RC + col, v);
        else if (col < RC + 1024) { f32x4 g; for (int e = 0; e < 4; ++e) g[e] = gelu_tanh(v[e]); store4bf(ZS + (size_t)row * 1024 + (col - RC), g); }
        else { f32x4 g; for (int e = 0; e < 4; ++e) g[e] = sigmoidf_(v[e]); store4bf(ZG + (size_t)row * 2048 + (col - RC - 1024), g); } }
    __device__ __forceinline__ void operator()(int row, int col, f32x4 v0, f32x4 v1) const { one(row, col, v0); one(row, col + 128, v1); } };
struct EpiGA { const bf16* ZG; bf16* MP;
    __device__ __forceinline__ void one(int row, int col, f32x4 v) const { const f32x4 g = load4bf(ZG + (size_t)row * 2048 + col); store4bf(MP + (size_t)row * D + col, g * v); }
    __device__ __forceinline__ void operator()(int row, int col, f32x4 v0, f32x4 v1) const { one(row, col, v0); one(row, col + 128, v1); } };
struct EpiGB { const bf16* ZG; bf16* MP;
    __device__ __forceinline__ void one(int row, int col, f32x4 v) const { const f32x4 g = load4bf(ZG + (size_t)row * 2048 + 1024 + col); const f32x4 m = load4bf(MP + (size_t)row * D + col); store4bf(MP + (size_t)row * D + col, m + g * v); }
    __device__ __forceinline__ void operator()(int row, int col, f32x4 v0, f32x4 v1) const { one(row, col, v0); one(row, col + 128, v1); } };
struct EpiOut { const float* xin; float* out; const float* gate1;
    __device__ __forceinline__ void one(int row, int col, f32x4 v) const { const f32x4 x = *(const f32x4*)(xin + (size_t)row * D + col); const f32x4 g = *(const f32x4*)(gate1 + col);
        *(f32x4*)(out + (size_t)row * D + col) = ALPHA * x + (1.0f + g) * v; }
    __device__ __forceinline__ void operator()(int row, int col, f32x4 v0, f32x4 v1) const { one(row, col, v0); one(row, col + 128, v1); } };
struct EpiSwi { bf16* HID;
    __device__ __forceinline__ void operator()(int row, int col, f32x4 v0, f32x4 v1) const { const int ct = (col >> 8) & 3, cc = col & 127;
        f32x4 h; for (int e = 0; e < 4; ++e) h[e] = siluf_(v0[e]) * v1[e]; store4bf(HID + (size_t)row * FF + ct * 128 + cc, h); } };
struct EpiDown { const int* S2T; const float* TOKW; bf16* Y;
    __device__ __forceinline__ void operator()(int row, int col, f32x4 v0, f32x4 v1) const { const int st = S2T[row]; if (st < 0) return; const float w = TOKW[st]; const int cc = col & 1023;
        store4bf(Y + (size_t)st * D + cc, w * v0); store4bf(Y + (size_t)st * D + cc + 128, w * v1); } };

struct MoeSched { int ts[17]; int G, c;
    __device__ __forceinline__ void a_ready(const Unit&) const {}
    __device__ __forceinline__ void done(const Unit&) const {}
    __device__ __forceinline__ void init(const unsigned* cnt, int G_, int c_) { G = G_; c = c_; int s = 0;
#pragma unroll
        for (int e = 0; e < 16; ++e) { ts[e] = s; s += ((int)cnt[e] + 255) >> 8; } ts[16] = s; }
    __device__ __forceinline__ bool next(int i, Unit& u) const { const int L = i * G + c; if (L >= 4 * ts[16]) return false; const int rt = L >> 2, ct = L & 3; int e = 0;
#pragma unroll
        for (int j = 1; j < 16; ++j) e += (rt >= ts[j]) ? 1 : 0;
        u.pm = rt; u.pn = e * 4 + ct; return true; } };

__device__ __forceinline__ void phase_prep_simple(ArgsR a, const Ctx& c, int l) {
    const bf16* ZR = (const bf16*)(a.ws + WS_ZR);
    const float* mu = a.in[I_MU] + l * RC; const float* w0 = a.in[I_W0] + l * W; const float* w2 = a.in[I_W2] + (size_t)l * 64 * W;
    const float* a0 = a.in[I_A0] + l * W; const float* a2 = a.in[I_A2] + (size_t)l * 64 * W; const float* g2 = a.in[I_G2] + (size_t)l * 128 * W;
    const float* k_k = a.in[I_KK] + l * W; const float* k_a = a.in[I_KA] + l * W;
    const float* vm0 = a.in[I_VM0]; const float* vm1 = a.in[I_VM1]; const float* vm2 = a.in[I_VM2];
    f16* R = (f16*)(a.ws + WS_R); f16* WM1 = (f16*)(a.ws + WS_WM1); f16* KP = (f16*)(a.ws + WS_KP); f16* AA = (f16*)(a.ws + WS_AA); f16* BB = (f16*)(a.ws + WS_BB); f16* V = (f16*)(a.ws + WS_V);
    bf16* G = (bf16*)(a.ws + WS_G); bf16* VF = (bf16*)(a.ws + WS_VF);
    const int lane = c.lane;
    for (int t = c.gw; t < T; t += c.ngw) {
        float z[28];
#pragma unroll
        for (int i = 0; i < 28; ++i) { const int col = lane + 64 * i; const float zc = bf2f(ZR[(size_t)t * RC + col]); const float zp = t > 0 ? bf2f(ZR[(size_t)(t - 1) * RC + col]) : 0.f; z[i] = zc + (zp - zc) * mu[col]; }
        const float tw = tanhf(z[24]), za = z[25], sg0 = sigmoidf_(z[26]), sg1 = sigmoidf_(z[27]);
        float wlo[8], alo[8], gg[8];
#pragma unroll
        for (int i = 0; i < 8; ++i) { wlo[i] = 0.f; alo[i] = 0.f; gg[i] = 0.f; }
        for (int j = 0; j < 64; ++j) { const float tj = __shfl(tw, j), aj = __shfl(za, j), s0 = __shfl(sg0, j), s1 = __shfl(sg1, j);
#pragma unroll
            for (int i = 0; i < 8; ++i) { const int n = lane + 64 * i; wlo[i] += tj * w2[j * W + n]; alo[i] += aj * a2[j * W + n]; gg[i] += s0 * g2[j * W + n] + s1 * g2[(64 + j) * W + n]; } }
        float vv[8];
#pragma unroll
        for (int i = 0; i < 8; ++i) vv[i] = z[16 + i];
        if (l == 0) {
#pragma unroll
            for (int i = 0; i < 8; ++i) VF[(size_t)t * W + lane + 64 * i] = f2bf(vv[i]);
        } else {
            float vmid = 0.f;
#pragma unroll
            for (int i = 0; i < 8; ++i)
                for (int j = 0; j < 64; ++j) { const float vc = __shfl(vv[i], j); vmid += vc * vm1[(size_t)(64 * i + j) * 32 + (lane & 31)]; }
            float vg[8];
#pragma unroll
            for (int i = 0; i < 8; ++i) vg[i] = 0.f;
            for (int m = 0; m < 32; ++m) { const float vmm = __shfl(vmid, m);
#pragma unroll
                for (int i = 0; i < 8; ++i) vg[i] += vmm * vm2[m * W + lane + 64 * i]; }
#pragma unroll
            for (int i = 0; i < 8; ++i) { const int n = lane + 64 * i; const float vf = bf2f(VF[(size_t)t * W + n]); vv[i] = vv[i] + (vf - vv[i]) * sigmoidf_(vm0[n] + vg[i]); }
        }
#pragma unroll
        for (int i = 0; i < 8; ++i) {
            const int n = lane + 64 * i; const size_t o = (size_t)t * W + n;
            const float x = w0[n] + wlo[i]; const float wl = -softplusf_(-x) - 0.5f; const float dm1 = expm1f(-__expf(wl));
            const float av = sigmoidf_(a0[n] + alo[i]);
            const float kraw = z[8 + i];
            float kk = kraw * k_k[n]; const float nrm = sqrtf(wave_sum(kk * kk)); kk = kk / fmaxf(nrm, 1e-12f);
            const float kp = kraw * (1.0f + (av - 1.0f) * k_a[n]);
            R[o] = (f16)z[i]; WM1[o] = (f16)dm1; KP[o] = (f16)kp; AA[o] = (f16)(-kk); BB[o] = (f16)(kk * av); V[o] = (f16)vv[i]; G[o] = f2bf(gg[i]);
        }
    }
}

__device__ __forceinline__ void phase_sg_simple(ArgsR a, const Ctx& c, int l) {
    const bf16* ZS = (const bf16*)(a.ws + WS_ZS); bf16* YB = (bf16*)(a.ws + WS_YB);
    const float* lng = a.in[I_SGG] + l * W; const float* lnb = a.in[I_SGB] + l * W;
    float* vn = (float*)c.lds;
    float* st = vn + 128 * 64;
    for (int uidx = blockIdx.x; uidx < 128 * 8; uidx += gridDim.x) {
        const int ch = uidx >> 3, g = uidx & 7; const int tok0 = ch * 128;
        for (int i = 0; i < 16; ++i) { const int s = c.wave * 16 + i; const bf16* p = ZS + (size_t)(tok0 + s) * 1024 + 512 + c.lane * 8;
            const f32x4 x0 = load4bf(p), x1 = load4bf(p + 4);
            float sm = (x0[0] + x0[1]) + (x0[2] + x0[3]) + (x1[0] + x1[1]) + (x1[2] + x1[3]); const float mean = wave_sum(sm) * (1.f / 512.f);
            float q = 0.f; for (int e = 0; e < 4; ++e) { const float d0 = x0[e] - mean, d1 = x1[e] - mean; q += d0 * d0 + d1 * d1; }
            const float rstd = 1.0f / sqrtf(wave_sum(q) * (1.f / 512.f) + LN_EPS);
            if (c.lane == 0) { st[2 * s] = mean; st[2 * s + 1] = rstd; } }
        __syncthreads();
        for (int i = c.tid; i < 128 * 64; i += NTHREADS) { const int s = i >> 6, d = i & 63; const float x = bf2f(ZS[(size_t)(tok0 + s) * 1024 + 512 + g * 64 + d]);
            vn[i] = (x - st[2 * s]) * st[2 * s + 1] * lng[g * 64 + d] + lnb[g * 64 + d]; }
        __syncthreads();
        const int d = c.tid & 63, tq = c.tid >> 6;
        const float* Wg = a.in[I_WS] + (size_t)(l * 8 + g) * 128 * 128; const float* bs = a.in[I_BS] + (size_t)(l * 8 + g) * 128;
        for (int i = 0; i < 16; ++i) { const int t = tq + 8 * i; float acc = 0.f;
            for (int s = 0; s <= t; ++s) acc += Wg[t * 128 + s] * vn[s * 64 + d];
            const float u = bf2f(ZS[(size_t)(tok0 + t) * 1024 + g * 64 + d]);
            YB[(size_t)(tok0 + t) * W + g * 64 + d] = f2bf(u * (acc + bs[t])); }
        __syncthreads();
    }
}

#define LAS3 __attribute__((address_space(3)))
typedef short bf16x8 __attribute__((ext_vector_type(8)));
template <int MT, int NT, int KS>
__device__ __forceinline__ void mma_lds_glob(const unsigned char* lds_base, int a_off_bytes, int lda, const bf16* Bt, int ldb, int n0, int lane, f32x4 (&acc)[MT][NT]) {
    const int fr = lane & 15, fq = lane >> 4;
    const LAS3 unsigned char* Ab = (const LAS3 unsigned char*)lds_base + a_off_bytes;
    int boff = (n0 + fr) * ldb + 8 * fq; asm volatile("" : "+v"(boff));
#pragma unroll
    for (int ks = 0; ks < KS; ++ks) {
        bf16x8 b[NT];
#pragma unroll
        for (int n = 0; n < NT; ++n) b[n] = *(const bf16x8*)(Bt + boff + 16 * n * ldb + 32 * ks);
#pragma unroll
        for (int m = 0; m < MT; ++m) { const bf16x8 av = *(const LAS3 bf16x8*)(Ab + ((16 * m + fr) * lda + 32 * ks + 8 * fq) * 2);
#pragma unroll
            for (int n = 0; n < NT; ++n) acc[m][n] = __builtin_amdgcn_mfma_f32_16x16x32_bf16(av, b[n], acc[m][n], 0, 0, 0); }
    }
}
__device__ __forceinline__ void zshift8(const bf16* ZR, int t, int col, const float* mu, float (&o)[8]) {
    const u32x4 zc = *(const u32x4*)(ZR + (size_t)t * RC + col);
    u32x4 zp = {0u, 0u, 0u, 0u}; if (t > 0) zp = *(const u32x4*)(ZR + (size_t)(t - 1) * RC + col);
    const f32x4 m0 = *(const f32x4*)(mu + col), m1 = *(const f32x4*)(mu + col + 4);
#pragma unroll
    for (int e = 0; e < 4; ++e) { const float c0 = __uint_as_float(zc[e] << 16), c1 = __uint_as_float(zc[e] & 0xffff0000u), p0 = __uint_as_float(zp[e] << 16), p1 = __uint_as_float(zp[e] & 0xffff0000u);
        const float mu0 = (2 * e < 4) ? m0[(2 * e) & 3] : m1[(2 * e) & 3], mu1 = (2 * e + 1 < 4) ? m0[(2 * e + 1) & 3] : m1[(2 * e + 1) & 3];
        o[2 * e] = c0 + (p0 - c0) * mu0; o[2 * e + 1] = c1 + (p1 - c1) * mu1; }
}
typedef _Float16 f16x8 __attribute__((ext_vector_type(8)));
__device__ __forceinline__ void store8f16(f16* p, const float (&v)[8]) { f16x8 h;
#pragma unroll
    for (int e = 0; e < 8; ++e) h[e] = (f16)v[e];
    *(f16x8*)p = h; }
__device__ __forceinline__ u32x4 pack8bf(const float (&v)[8]) { u32x4 w; w.x = pk2(v[0], v[1]); w.y = pk2(v[2], v[3]); w.z = pk2(v[4], v[5]); w.w = pk2(v[6], v[7]); return w; }


constexpr int PB_LD = 520;
constexpr int PB_BUF = 0, PB_AOP = 64 * PB_LD * 2, PB_VMID = 2 * 64 * PB_LD * 2, PB_LA_LD = 264, PB_VM_LD = 40;
__device__ __forceinline__ void phase_prep_fast(ArgsR a, const Ctx& c, int l) {
    const bf16* ZR = (const bf16*)(a.ws + WS_ZR);
    const float* mu = a.in[I_MU] + l * RC; const float* w0 = a.in[I_W0] + l * W; const float* a0 = a.in[I_A0] + l * W;
    const float* k_k = a.in[I_KK] + l * W; const float* k_a = a.in[I_KA] + l * W; const float* vm0 = a.in[I_VM0];
    f16* R = (f16*)(a.ws + WS_R); f16* WM1 = (f16*)(a.ws + WS_WM1); f16* KP = (f16*)(a.ws + WS_KP); f16* AA = (f16*)(a.ws + WS_AA); f16* BB = (f16*)(a.ws + WS_BB); f16* V = (f16*)(a.ws + WS_V);
    bf16* G = (bf16*)(a.ws + WS_G); bf16* VF = (bf16*)(a.ws + WS_VF);
    const unsigned char* lo = a.ws + WS_LORA + (size_t)l * LO_STRIDE;
    const bf16* W2T = (const bf16*)(lo + LO_W2T); const bf16* A2T = (const bf16*)(lo + LO_A2T); const bf16* G2T = (const bf16*)(lo + LO_G2T);
    const bf16* VM1T = (const bf16*)(lo + LO_VM1T); const bf16* VM2T = (const bf16*)(lo + LO_VM2T);
    LAS3 unsigned char* L = (LAS3 unsigned char*)c.lds;
    const int tid = c.tid, lane = c.lane, wv = c.wave, fr = lane & 15, fq = lane >> 4;
    const int row = tid >> 3, sub = tid & 7;
    for (int u = blockIdx.x; u < T / 64; u += gridDim.x) {
        const int t0 = u * 64, t = t0 + row;
        if (l == 0) {
#pragma unroll 1
            for (int p = 0; p < 8; ++p) { const int col = p * 64 + sub * 8; float z[8]; zshift8(ZR, t, 1024 + col, mu, z);
                store8f16(V + (size_t)t * W + col, z); *(u32x4*)(VF + (size_t)t * W + col) = pack8bf(z); }
        } else {
#pragma unroll 1
            for (int p = 0; p < 8; ++p) { const int col = p * 64 + sub * 8; float z[8]; zshift8(ZR, t, 1024 + col, mu, z);
                *(LAS3 u32x4*)(L + PB_AOP + (row * PB_LD + col) * 2) = pack8bf(z); }
            __syncthreads();
            { f32x4 acc[1][1]; acc[0][0] = (f32x4){0.f, 0.f, 0.f, 0.f}; const int m = wv >> 1, n = wv & 1;
              mma_lds_glob<1, 1, 16>(c.lds, PB_AOP + 16 * m * PB_LD * 2, PB_LD, VM1T, W, 16 * n, lane, acc);
#pragma unroll
              for (int i = 0; i < 4; ++i) *(LAS3 bf16*)(L + PB_VMID + ((16 * m + 4 * fq + i) * PB_VM_LD + 16 * n + fr) * 2) = f2bf(acc[0][0][i]); }
            __syncthreads();
            { f32x4 acc[4][4];
#pragma unroll
              for (int m = 0; m < 4; ++m)
#pragma unroll
                  for (int n = 0; n < 4; ++n) acc[m][n] = (f32x4){0.f, 0.f, 0.f, 0.f};
              mma_lds_glob<4, 4, 1>(c.lds, PB_VMID, PB_VM_LD, VM2T, 32, 64 * wv, lane, acc);
#pragma unroll
              for (int m = 0; m < 4; ++m)
#pragma unroll
                  for (int n = 0; n < 4; ++n) { const int col = 64 * wv + 16 * n + fr; const float vb = vm0[col];
#pragma unroll
                      for (int i = 0; i < 4; ++i) *(LAS3 f16*)(L + PB_BUF + ((16 * m + 4 * fq + i) * PB_LD + col) * 2) = (f16)sigmoidf_(vb + acc[m][n][i]); } }
            __syncthreads();
#pragma unroll 1
            for (int p = 0; p < 8; ++p) { const int col = p * 64 + sub * 8;
                const u32x4 vz = *(const LAS3 u32x4*)(L + PB_AOP + (row * PB_LD + col) * 2); const f16x8 gt = *(const LAS3 f16x8*)(L + PB_BUF + (row * PB_LD + col) * 2);
                const u32x4 vfw = *(const u32x4*)(VF + (size_t)t * W + col); float o[8];
#pragma unroll
                for (int e = 0; e < 4; ++e) { const float v0 = __uint_as_float(vz[e] << 16), v1 = __uint_as_float(vz[e] & 0xffff0000u), f0 = __uint_as_float(vfw[e] << 16), f1 = __uint_as_float(vfw[e] & 0xffff0000u);
                    o[2 * e] = v0 + (f0 - v0) * (float)gt[2 * e]; o[2 * e + 1] = v1 + (f1 - v1) * (float)gt[2 * e + 1]; }
                store8f16(V + (size_t)t * W + col, o); }
            __syncthreads();
        }
#pragma unroll 1
        for (int p = 0; p < 4; ++p) { const int cc = sub * 32 + p * 8; float z[8]; zshift8(ZR, t, 1536 + cc, mu, z);
#pragma unroll
            for (int e = 0; e < 8; ++e) z[e] = cc < 64 ? (1.0f - 2.0f / (1.0f + __expf(2.0f * z[e]))) : (cc < 128 ? z[e] : sigmoidf_(z[e]));
            *(LAS3 u32x4*)(L + PB_AOP + (row * PB_LA_LD + cc) * 2) = pack8bf(z); }
        __syncthreads();
        { f32x4 acc[4][4];
#pragma unroll
          for (int m = 0; m < 4; ++m)
#pragma unroll
              for (int n = 0; n < 4; ++n) acc[m][n] = (f32x4){0.f, 0.f, 0.f, 0.f};
          mma_lds_glob<4, 4, 2>(c.lds, PB_AOP + 64 * 2, PB_LA_LD, A2T, 64, 64 * wv, lane, acc);
#pragma unroll
          for (int m = 0; m < 4; ++m)
#pragma unroll
              for (int n = 0; n < 4; ++n) { const int col = 64 * wv + 16 * n + fr; const float ab = a0[col];
#pragma unroll
                  for (int i = 0; i < 4; ++i) *(LAS3 f16*)(L + PB_BUF + ((16 * m + 4 * fq + i) * PB_LD + col) * 2) = (f16)sigmoidf_(ab + acc[m][n][i]); } }
        __syncthreads();
#pragma unroll 1
        for (int p = 0; p < 8; ++p) { const int col = p * 64 + sub * 8; const size_t o = (size_t)t * W + col;
            float z[8]; zshift8(ZR, t, col, mu, z); store8f16(R + o, z);
            float kz[8]; zshift8(ZR, t, 512 + col, mu, kz);
            const f16x8 av = *(const LAS3 f16x8*)(L + PB_BUF + (row * PB_LD + col) * 2);
            const f32x4 kk0 = *(const f32x4*)(k_k + col), kk1 = *(const f32x4*)(k_k + col + 4), ka0 = *(const f32x4*)(k_a + col), ka1 = *(const f32x4*)(k_a + col + 4);
            float kk[8], kp[8], bb[8]; float ss = 0.f;
#pragma unroll
            for (int e = 0; e < 8; ++e) { const float kkw = e < 4 ? kk0[e & 3] : kk1[e & 3], kaw = e < 4 ? ka0[e & 3] : ka1[e & 3]; kk[e] = kz[e] * kkw; ss += kk[e] * kk[e]; kp[e] = kz[e] * (1.0f + ((float)av[e] - 1.0f) * kaw); }
            ss += __shfl_xor(ss, 1); ss += __shfl_xor(ss, 2); ss += __shfl_xor(ss, 4);
            const float inv = 1.0f / fmaxf(sqrtf(ss), 1e-12f);
#pragma unroll
            for (int e = 0; e < 8; ++e) { kk[e] *= inv; bb[e] = kk[e] * (float)av[e]; kk[e] = -kk[e]; }
            store8f16(KP + o, kp); store8f16(AA + o, kk); store8f16(BB + o, bb); }
        __syncthreads();
        { f32x4 acc[4][4];
#pragma unroll
          for (int m = 0; m < 4; ++m)
#pragma unroll
              for (int n = 0; n < 4; ++n) acc[m][n] = (f32x4){0.f, 0.f, 0.f, 0.f};
          mma_lds_glob<4, 4, 2>(c.lds, PB_AOP, PB_LA_LD, W2T, 64, 64 * wv, lane, acc);
#pragma unroll
          for (int m = 0; m < 4; ++m)
#pragma unroll
              for (int n = 0; n < 4; ++n) { const int col = 64 * wv + 16 * n + fr; const float wb = w0[col];
#pragma unroll
                  for (int i = 0; i < 4; ++i) { const float x = wb + acc[m][n][i]; const float wl = -softplusf_(-x) - 0.5f; *(LAS3 f16*)(L + PB_BUF + ((16 * m + 4 * fq + i) * PB_LD + col) * 2) = (f16)expm1f(-__expf(wl)); } } }
        __syncthreads();
#pragma unroll 1
        for (int p = 0; p < 8; ++p) { const int col = p * 64 + sub * 8; *(u32x4*)(WM1 + (size_t)t * W + col) = *(const LAS3 u32x4*)(L + PB_BUF + (row * PB_LD + col) * 2); }
        __syncthreads();
        { f32x4 acc[4][4];
#pragma unroll
          for (int m = 0; m < 4; ++m)
#pragma unroll
              for (int n = 0; n < 4; ++n) acc[m][n] = (f32x4){0.f, 0.f, 0.f, 0.f};
          mma_lds_glob<4, 4, 4>(c.lds, PB_AOP + 128 * 2, PB_LA_LD, G2T, 128, 64 * wv, lane, acc);
#pragma unroll
          for (int m = 0; m < 4; ++m)
#pragma unroll
              for (int n = 0; n < 4; ++n) { const int col = 64 * wv + 16 * n + fr;
#pragma unroll
                  for (int i = 0; i < 4; ++i) *(LAS3 bf16*)(L + PB_BUF + ((16 * m + 4 * fq + i) * PB_LD + col) * 2) = f2bf(acc[m][n][i]); } }
        __syncthreads();
#pragma unroll 1
        for (int p = 0; p < 8; ++p) { const int col = p * 64 + sub * 8; *(u32x4*)(G + (size_t)t * W + col) = *(const LAS3 u32x4*)(L + PB_BUF + (row * PB_LD + col) * 2); }
        __syncthreads();
    }
}

constexpr int SG_LD = 136;
constexpr int SG_VT = 0, SG_ST = 256 * SG_LD * 2;
__device__ __forceinline__ void phase_sg_fast(ArgsR a, const Ctx& c, int l) {
    const bf16* ZS = (const bf16*)(a.ws + WS_ZS); bf16* YB = (bf16*)(a.ws + WS_YB);
    const float* lng = a.in[I_SGG] + l * W; const float* lnb = a.in[I_SGB] + l * W;
    LAS3 unsigned char* L = (LAS3 unsigned char*)c.lds;
    LAS3 float* st = (LAS3 float*)(L + SG_ST);
    const int tid = c.tid, lane = c.lane, wv = c.wave, fr = lane & 15, fq = lane >> 4;
    for (int u = blockIdx.x; u < 256; u += gridDim.x) {
        const int ch = u >> 1, hf = u & 1, tok0 = ch * 128;
        for (int i = 0; i < 16; ++i) { const int sidx = wv * 16 + i; const bf16* p = ZS + (size_t)(tok0 + sidx) * 1024 + 512 + lane * 8;
            const f32x4 x0 = load4bf(p), x1 = load4bf(p + 4);
            const float sm = (x0[0] + x0[1]) + (x0[2] + x0[3]) + (x1[0] + x1[1]) + (x1[2] + x1[3]); const float mean = wave_sum(sm) * (1.f / 512.f);
            float q = 0.f;
#pragma unroll
            for (int e = 0; e < 4; ++e) { const float d0 = x0[e] - mean, d1 = x1[e] - mean; q += d0 * d0 + d1 * d1; }
            const float rstd = 1.0f / sqrtf(wave_sum(q) * (1.f / 512.f) + LN_EPS);
            if (lane == 0) { st[2 * sidx] = mean; st[2 * sidx + 1] = rstd; } }
        __syncthreads();
        { const int sidx = tid >> 2, q4 = tid & 3; const float mean = st[2 * sidx], rstd = st[2 * sidx + 1];
#pragma unroll
          for (int p = 0; p < 8; ++p) { const int cl = q4 * 64 + p * 8; const int cg = hf * 256 + cl;
              const bf16* src = ZS + (size_t)(tok0 + sidx) * 1024 + 512 + cg; const f32x4 x0 = load4bf(src), x1 = load4bf(src + 4);
              const f32x4 g0 = *(const f32x4*)(lng + cg), g1 = *(const f32x4*)(lng + cg + 4), b0 = *(const f32x4*)(lnb + cg), b1 = *(const f32x4*)(lnb + cg + 4);
#pragma unroll
              for (int e = 0; e < 8; ++e) { const float x = e < 4 ? x0[e & 3] : x1[e & 3], gg = e < 4 ? g0[e & 3] : g1[e & 3], bb = e < 4 ? b0[e & 3] : b1[e & 3];
                  *(LAS3 bf16*)(L + SG_VT + ((cl + e) * SG_LD + sidx) * 2) = f2bf((x - mean) * rstd * gg + bb); } } }
        __syncthreads();
        const int gl = wv >> 1, dh = wv & 1, g = hf * 4 + gl;
        const float* Wg = a.in[I_WS] + (size_t)(l * 8 + g) * 128 * 128; const float* bs = a.in[I_BS] + (size_t)(l * 8 + g) * 128;
        f32x4 acc[8][2];
#pragma unroll
        for (int m = 0; m < 8; ++m) { acc[m][0] = (f32x4){0.f, 0.f, 0.f, 0.f}; acc[m][1] = (f32x4){0.f, 0.f, 0.f, 0.f}; }
#pragma unroll
        for (int ks = 0; ks < 4; ++ks) {
            bf16x8 b[2];
#pragma unroll
            for (int n = 0; n < 2; ++n) b[n] = *(const LAS3 bf16x8*)(L + SG_VT + ((gl * 64 + dh * 32 + 16 * n + fr) * SG_LD + 32 * ks + 8 * fq) * 2);
#pragma unroll
            for (int m = 0; m < 8; ++m) { if (32 * ks <= 16 * m + 15) {
                const int trow = 16 * m + fr, s0 = 32 * ks + 8 * fq;
                const f32x4 w0v = *(const f32x4*)(Wg + trow * 128 + s0), w1v = *(const f32x4*)(Wg + trow * 128 + s0 + 4);
                float wf[8];
#pragma unroll
                for (int e = 0; e < 8; ++e) { const float wval = e < 4 ? w0v[e & 3] : w1v[e & 3]; wf[e] = (s0 + e <= trow) ? wval : 0.f; }
                const u32x4 wp = pack8bf(wf); const bf16x8 av = __builtin_bit_cast(bf16x8, wp);
                acc[m][0] = __builtin_amdgcn_mfma_f32_16x16x32_bf16(av, b[0], acc[m][0], 0, 0, 0);
                acc[m][1] = __builtin_amdgcn_mfma_f32_16x16x32_bf16(av, b[1], acc[m][1], 0, 0, 0); } }
        }
#pragma unroll
        for (int m = 0; m < 8; ++m)
#pragma unroll
            for (int i = 0; i < 4; ++i) { const int trow = 16 * m + 4 * fq + i; const float bsv = bs[trow];
#pragma unroll
                for (int n = 0; n < 2; ++n) { const int col = g * 64 + dh * 32 + 16 * n + fr; const float uu = bf2f(ZS[(size_t)(tok0 + trow) * 1024 + col]);
                    YB[(size_t)(tok0 + trow) * W + col] = f2bf(uu * (acc[m][n][i] + bsv)); } }
        __syncthreads();
    }
}

__device__ __forceinline__ void phase_scan_simple(ArgsR a, const Ctx& c) {
    if (c.wave != 0 || blockIdx.x >= NH) return;
    const int h = blockIdx.x, lane = c.lane;
    const f16* R = (const f16*)(a.ws + WS_R); const f16* WM1 = (const f16*)(a.ws + WS_WM1); const f16* KP = (const f16*)(a.ws + WS_KP);
    const f16* AA = (const f16*)(a.ws + WS_AA); const f16* BB = (const f16*)(a.ws + WS_BB); const f16* V = (const f16*)(a.ws + WS_V);
    bf16* YSC = (bf16*)(a.ws + WS_YSC);
    float S[64];
#pragma unroll
    for (int j = 0; j < 64; ++j) S[j] = 0.f;
    for (int t = 0; t < T; ++t) {
        const size_t base = (size_t)t * W + h * 64;
        const float vv = (float)V[base + lane];
        float sa = 0.f;
#pragma unroll
        for (int j = 0; j < 64; ++j) sa += S[j] * (float)AA[base + j];
        float y = 0.f;
#pragma unroll
        for (int j = 0; j < 64; ++j) { float s = S[j]; s = s + s * (float)WM1[base + j]; s += sa * (float)BB[base + j]; s += vv * (float)KP[base + j]; S[j] = s; y += s * (float)R[base + j]; }
        YSC[base + lane] = f2bf(y);
    }
}

typedef unsigned u32x16 __attribute__((ext_vector_type(16)));
__device__ __forceinline__ void sload32(const void* p0, u32x16& a0, u32x16& a1) {
    asm volatile("s_load_dwordx16 %0, %2, 0x0 glc\n\ts_load_dwordx16 %1, %2, 0x40 glc\n\ts_waitcnt lgkmcnt(0)" : "=&s"(a0), "=&s"(a1) : "s"(p0) : "memory");
}
__device__ __forceinline__ void sload64(const void* p0, const void* p1, u32x16& a0, u32x16& a1, u32x16& b0, u32x16& b1) {
    asm volatile("s_load_dwordx16 %0, %4, 0x0 glc\n\ts_load_dwordx16 %1, %4, 0x40 glc\n\ts_load_dwordx16 %2, %5, 0x0 glc\n\ts_load_dwordx16 %3, %5, 0x40 glc\n\ts_waitcnt lgkmcnt(0)"
                 : "=&s"(a0), "=&s"(a1), "=&s"(b0), "=&s"(b1) : "s"(p0), "s"(p1) : "memory");
}
__device__ __forceinline__ float fmix_lo(unsigned sd, float x, float y) { float d; asm("v_fma_mix_f32 %0, %1, %2, %3 op_sel_hi:[1,0,0]" : "=v"(d) : "s"(sd), "v"(x), "v"(y)); return d; }
__device__ __forceinline__ float fmix_hi(unsigned sd, float x, float y) { float d; asm("v_fma_mix_f32 %0, %1, %2, %3 op_sel:[1,0,0] op_sel_hi:[1,0,0]" : "=v"(d) : "s"(sd), "v"(x), "v"(y)); return d; }
constexpr int CL = 64, NCH = T / CL;
constexpr size_t ST_Q_OFF = (size_t)NH * NCH * 64 * 64;

__device__ __forceinline__ void phase_scan1(ArgsR a, const Ctx& c) {
    const f16* WM1 = (const f16*)(a.ws + WS_WM1); const f16* KP = (const f16*)(a.ws + WS_KP);
    const f16* AA = (const f16*)(a.ws + WS_AA); const f16* BB = (const f16*)(a.ws + WS_BB); const f16* V = (const f16*)(a.ws + WS_V);
    float* ST = (float*)(a.ws + WS_ST);
    const int lane = c.lane;
    for (int item = c.gw; item < NH * NCH; item += c.ngw) {
        const int h = __builtin_amdgcn_readfirstlane(item / NCH), ch = __builtin_amdgcn_readfirstlane(item % NCH);
        float Q[64], P[64];
#pragma unroll
        for (int j = 0; j < 64; ++j) { Q[j] = 0.f; P[j] = (j == lane) ? 1.f : 0.f; }
        for (int t = ch * CL; t < ch * CL + CL; ++t) {
            const size_t base = (size_t)t * W + h * 64;
            const float vv = (float)V[base + lane];
            float q0 = 0.f, q1 = 0.f, p0 = 0.f, p1 = 0.f;
            { u32x16 a0, a1; sload32(AA + base, a0, a1);
#pragma unroll
              for (int e = 0; e < 32; ++e) { const int j = 2 * e; const unsigned av = e < 16 ? a0[e & 15] : a1[e & 15];
                  q0 = fmix_lo(av, Q[j], q0); q1 = fmix_hi(av, Q[j + 1], q1); p0 = fmix_lo(av, P[j], p0); p1 = fmix_hi(av, P[j + 1], p1); } }
            const float saq = q0 + q1, sap = p0 + p1;
            { u32x16 w0, w1, b0, b1; sload64(WM1 + base, BB + base, w0, w1, b0, b1);
#pragma unroll
              for (int e = 0; e < 32; ++e) { const int j = 2 * e; const unsigned wv = e < 16 ? w0[e & 15] : w1[e & 15], bv = e < 16 ? b0[e & 15] : b1[e & 15];
                  float s = Q[j]; s = fmix_lo(wv, s, s); s = fmix_lo(bv, saq, s); Q[j] = s;
                  float s2 = Q[j + 1]; s2 = fmix_hi(wv, s2, s2); s2 = fmix_hi(bv, saq, s2); Q[j + 1] = s2;
                  float u = P[j]; u = fmix_lo(wv, u, u); u = fmix_lo(bv, sap, u); P[j] = u;
                  float u2 = P[j + 1]; u2 = fmix_hi(wv, u2, u2); u2 = fmix_hi(bv, sap, u2); P[j + 1] = u2; } }
            { u32x16 k0, k1; sload32(KP + base, k0, k1);
#pragma unroll
              for (int e = 0; e < 32; ++e) { const int j = 2 * e; const unsigned kv = e < 16 ? k0[e & 15] : k1[e & 15];
                  Q[j] = fmix_lo(kv, vv, Q[j]); Q[j + 1] = fmix_hi(kv, vv, Q[j + 1]); } }
        }
        float* Pp = ST + ((size_t)(h * NCH + ch) * 64 + lane) * 64; float* Qp = Pp + ST_Q_OFF;
#pragma unroll
        for (int j = 0; j < 64; j += 4) { *(f32x4*)(Pp + j) = (f32x4){P[j], P[j + 1], P[j + 2], P[j + 3]}; *(f32x4*)(Qp + j) = (f32x4){Q[j], Q[j + 1], Q[j + 2], Q[j + 3]}; }
    }
}
__device__ __forceinline__ void phase_scan2_simple(ArgsR a, const Ctx& c) {
    float* ST = (float*)(a.ws + WS_ST);
    for (int item = c.gw; item < NH * 64; item += c.ngw) {
        const int h = item >> 6, v = item & 63;
        float S = 0.f;
        for (int ch = 0; ch < NCH; ++ch) {
            const float* Pc = ST + (size_t)(h * NCH + ch) * 4096; float* Qc = ST + ST_Q_OFF + (size_t)(h * NCH + ch) * 4096 + v * 64;
            float acc0 = Qc[c.lane], acc1 = 0.f;
#pragma unroll
            for (int k = 0; k < 64; k += 2) { acc0 += __shfl(S, k) * Pc[k * 64 + c.lane]; acc1 += __shfl(S, k + 1) * Pc[(k + 1) * 64 + c.lane]; }
            S = acc0 + acc1;
            Qc[c.lane] = S;
        }
    }
}
__device__ __forceinline__ void phase_scan3(ArgsR a, const Ctx& c) {
    const f16* R = (const f16*)(a.ws + WS_R); const f16* WM1 = (const f16*)(a.ws + WS_WM1); const f16* KP = (const f16*)(a.ws + WS_KP);
    const f16* AA = (const f16*)(a.ws + WS_AA); const f16* BB = (const f16*)(a.ws + WS_BB); const f16* V = (const f16*)(a.ws + WS_V);
    const float* ST = (const float*)(a.ws + WS_ST); bf16* YSC = (bf16*)(a.ws + WS_YSC);
    const int lane = c.lane;
    for (int item = c.gw; item < NH * NCH; item += c.ngw) {
        const int h = __builtin_amdgcn_readfirstlane(item / NCH), ch = __builtin_amdgcn_readfirstlane(item % NCH);
        float S[64];
        if (ch == 0) {
#pragma unroll
            for (int j = 0; j < 64; ++j) S[j] = 0.f;
        } else { const float* Sp = ST + ST_Q_OFF + ((size_t)(h * NCH + ch - 1) * 64 + lane) * 64;
#pragma unroll
            for (int j = 0; j < 64; j += 4) { const f32x4 x = *(const f32x4*)(Sp + j); S[j] = x[0]; S[j + 1] = x[1]; S[j + 2] = x[2]; S[j + 3] = x[3]; } }
        for (int t = ch * CL; t < ch * CL + CL; ++t) {
            const size_t base = (size_t)t * W + h * 64;
            const float vv = (float)V[base + lane];
            float s0 = 0.f, s1 = 0.f;
            { u32x16 a0, a1; sload32(AA + base, a0, a1);
#pragma unroll
              for (int e = 0; e < 32; ++e) { const int j = 2 * e; const unsigned av = e < 16 ? a0[e & 15] : a1[e & 15]; s0 = fmix_lo(av, S[j], s0); s1 = fmix_hi(av, S[j + 1], s1); } }
            const float sa = s0 + s1;
            { u32x16 w0, w1, b0, b1; sload64(WM1 + base, BB + base, w0, w1, b0, b1);
#pragma unroll
              for (int e = 0; e < 32; ++e) { const int j = 2 * e; const unsigned wv = e < 16 ? w0[e & 15] : w1[e & 15], bv = e < 16 ? b0[e & 15] : b1[e & 15];
                  float s = S[j]; s = fmix_lo(wv, s, s); s = fmix_lo(bv, sa, s); S[j] = s;
                  float s2 = S[j + 1]; s2 = fmix_hi(wv, s2, s2); s2 = fmix_hi(bv, sa, s2); S[j + 1] = s2; } }
            float y0 = 0.f, y1 = 0.f;
            { u32x16 k0, k1, r0, r1; sload64(KP + base, R + base, k0, k1, r0, r1);
#pragma unroll
              for (int e = 0; e < 32; ++e) { const int j = 2 * e; const unsigned kv = e < 16 ? k0[e & 15] : k1[e & 15], rv = e < 16 ? r0[e & 15] : r1[e & 15];
                  const float s = fmix_lo(kv, vv, S[j]); S[j] = s; y0 = fmix_lo(rv, s, y0);
                  const float s2 = fmix_hi(kv, vv, S[j + 1]); S[j + 1] = s2; y1 = fmix_hi(rv, s2, y1); } }
            YSC[base + lane] = f2bf(y0 + y1);
        }
    }
}

__device__ __forceinline__ void phase_post(ArgsR a, const Ctx& c, int l) {
    const bf16* YSC = (const bf16*)(a.ws + WS_YSC); const f16* R = (const f16*)(a.ws + WS_R); const f16* KP = (const f16*)(a.ws + WS_KP); const f16* V = (const f16*)(a.ws + WS_V);
    const bf16* G = (const bf16*)(a.ws + WS_G); bf16* YA = (bf16*)(a.ws + WS_YA);
    const float* gng = a.in[I_GNG] + l * W; const float* gnb = a.in[I_GNB] + l * W; const float* rk = a.in[I_RK] + l * W;
    for (int t = c.gw; t < T; t += c.ngw) {
#pragma unroll
        for (int i = 0; i < 8; ++i) { const int n = c.lane + 64 * i; const size_t o = (size_t)t * W + n;
            const float y = bf2f(YSC[o]); const float mean = wave_sum(y) * (1.f / 64.f); const float d = y - mean; const float var = wave_sum(d * d) * (1.f / 64.f);
            float yn = d * (1.0f / sqrtf(var + GN_EPS)) * gng[n] + gnb[n];
            const float r = (float)R[o], k = (float)KP[o], v = (float)V[o];
            const float bonus = wave_sum(r * k * rk[n]);
            yn += bonus * v;
            YA[o] = f2bf(yn * bf2f(G[o])); }
    }
}

__device__ __forceinline__ void phase_ln1(ArgsR a, const Ctx& c, int l) {
    const float* MODF = (const float*)(a.ws + WS_MODF) + l * 6144;
    const float* g1 = a.in[I_LN1G] + l * D; const float* b1 = a.in[I_LN1B] + l * D;
    bf16* XN = (bf16*)(a.ws + WS_XN);
    int* TOKI = (int*)(a.ws + WS_TOKI); float* TOKW = (float*)(a.ws + WS_TOKW); int* TOKP = (int*)(a.ws + WS_TOKP);
    unsigned* cnt = (unsigned*)(a.ws + WS_CTL) + CW_CNT + 64 * l;
    const float* rw = a.in[I_RW]; const float* rb = a.in[I_RB];
    for (int m = c.gw; m < T; m += c.ngw) {
        float v[16]; load_row16(a.out + (size_t)m * D, c.lane, v);
        float mean, rstd; row_stats(v, mean, rstd);
#pragma unroll
        for (int j = 0; j < 4; ++j) { f32x4 o; const int col = 4 * c.lane + 256 * j;
#pragma unroll
            for (int e = 0; e < 4; ++e) { v[4 * j + e] = (v[4 * j + e] - mean) * rstd * g1[col + e] + b1[col + e]; o[e] = v[4 * j + e]; }
            *(f32x4*)(a.out + (size_t)m * D + col) = o; }
        row_stats(v, mean, rstd);
        float lg[16];
#pragma unroll
        for (int e = 0; e < 16; ++e) lg[e] = 0.f;
#pragma unroll
        for (int j = 0; j < 4; ++j) { f32x4 o; const int col = 4 * c.lane + 256 * j;
#pragma unroll
            for (int e = 0; e < 4; ++e) { const float h = (v[4 * j + e] - mean) * rstd * (1.0f + MODF[4096 + col + e]) + MODF[3072 + col + e]; o[e] = h;
                const f32x4* rr = (const f32x4*)(rw + (size_t)(col + e) * NE);
#pragma unroll
                for (int q = 0; q < 4; ++q) { const f32x4 r4 = rr[q]; lg[4 * q] += h * r4[0]; lg[4 * q + 1] += h * r4[1]; lg[4 * q + 2] += h * r4[2]; lg[4 * q + 3] += h * r4[3]; } }
            store4bf(XN + (size_t)m * D + col, o); }
        float sc[16], sel[16];
#pragma unroll
        for (int e = 0; e < 16; ++e) { sc[e] = 1.0f / (1.0f + expf(-wave_sum(lg[e]))); sel[e] = sc[e] + rb[e]; }
        int best = 0; float bestv = -INFINITY;
#pragma unroll
        for (int g = 0; g < 4; ++g) { float m1 = -INFINITY, m2 = -INFINITY;
#pragma unroll
            for (int q = 0; q < 4; ++q) { const float s = sel[4 * g + q]; if (s > m1) { m2 = m1; m1 = s; } else if (s > m2) m2 = s; }
            const float gs = m1 + m2; if (gs > bestv) { bestv = gs; best = g; } }
        int i1 = 0, i2 = 0; float s1 = -INFINITY, s2 = -INFINITY, w1 = 0.f, w2 = 0.f;
#pragma unroll
        for (int e = 0; e < 16; ++e) { if ((e >> 2) == best) { const float s = sel[e];
                if (s > s1) { s2 = s1; i2 = i1; w2 = w1; s1 = s; i1 = e; w1 = sc[e]; } else if (s > s2) { s2 = s; i2 = e; w2 = sc[e]; } } }
        if (c.lane == 0) { const float ws = w1 + w2;
            TOKI[2 * m] = i1; TOKI[2 * m + 1] = i2; TOKW[2 * m] = w1 / ws; TOKW[2 * m + 1] = w2 / ws;
            TOKP[2 * m] = (int)atomicAdd(cnt + i1, 1u); TOKP[2 * m + 1] = (int)atomicAdd(cnt + i2, 1u); }
    }
    float* scr = (float*)(c.lds + c.wave * 16384);
    bf16* WGU = (bf16*)(a.ws + WS_WGU); bf16* WD = (bf16*)(a.ws + WS_WD);
    constexpr int IG = (D / 64) * (FF / 32);
    constexpr int ID = (FF / 64) * (D / 32);
    for (int it = c.gw; it < NE * (2 * IG + ID); it += c.ngw) {
        const int e = it / (2 * IG + ID); int r = it % (2 * IG + ID);
        const size_t eo = ((size_t)l * NE + e) * (size_t)D * FF;
        if (r < IG) { transpose_matrix_item(a.in[I_EG] + eo, D, FF, WGU + (size_t)e * 1024 * 1024, r, scr, c.lane, RowGU{0}); continue; } r -= IG;
        if (r < IG) { transpose_matrix_item(a.in[I_EU] + eo, D, FF, WGU + (size_t)e * 1024 * 1024, r, scr, c.lane, RowGU{1}); continue; } r -= IG;
        transpose_matrix_item(a.in[I_ED] + eo, FF, D, WD + (size_t)e * 1024 * 512, r, scr, c.lane, RowId());
    }
}

__device__ __forceinline__ void phase_perm(ArgsR a, const Ctx& c, int l) {
    const unsigned* cnt = (const unsigned*)(a.ws + WS_CTL) + CW_CNT + 64 * l;
    int ts[17]; { int s = 0;
#pragma unroll
        for (int e = 0; e < 16; ++e) { ts[e] = s; s += ((int)cnt[e] + 255) >> 8; } ts[16] = s; }
    const int* TOKI = (const int*)(a.ws + WS_TOKI); const int* TOKP = (const int*)(a.ws + WS_TOKP); int* S2T = (int*)(a.ws + WS_S2T);
    const bf16* XN = (const bf16*)(a.ws + WS_XN); bf16* XS = (bf16*)(a.ws + WS_XS);
    for (int as = c.gw; as < 2 * T; as += c.ngw) {
        const int e = TOKI[as]; int base = 0;
#pragma unroll
        for (int j = 0; j < 16; ++j) base = (j == e) ? ts[j] : base;
        const int slot = base * 256 + TOKP[as];
        if (c.lane == 0) S2T[slot] = as;
        const u32x4* src = (const u32x4*)(XN + (size_t)(as >> 1) * D); u32x4* dst = (u32x4*)(XS + (size_t)slot * D);
        dst[c.lane] = src[c.lane]; dst[64 + c.lane] = src[64 + c.lane];
    }
    for (int e = 0; e < 16; ++e) {
        int tse = 0, tsn = 0;
#pragma unroll
        for (int j = 0; j < 16; ++j) { tse = (j == e) ? ts[j] : tse; tsn = (j == e) ? ts[j + 1] : tsn; }
        const int lo = tse * 256 + (int)cnt[e], hi = tsn * 256;
        for (int s = lo + c.gw; s < hi; s += c.ngw) { if (c.lane == 0) S2T[s] = -1; u32x4* dst = (u32x4*)(XS + (size_t)s * D); const u32x4 zz = {0u, 0u, 0u, 0u}; dst[c.lane] = zz; dst[64 + c.lane] = zz; }
    }
}

__device__ __forceinline__ void phase_ln2(ArgsR a, const Ctx& c, int l) {
    const float* MODF = (const float*)(a.ws + WS_MODF) + l * 6144;
    const float* g2 = a.in[I_LN2G] + l * D; const float* b2 = a.in[I_LN2B] + l * D;
    const bf16* Y = (const bf16*)(a.ws + WS_Y); bf16* XN = (bf16*)(a.ws + WS_XN);
    for (int m = c.gw; m < T; m += c.ngw) {
        float v[16]; load_row16(a.out + (size_t)m * D, c.lane, v);
#pragma unroll
        for (int j = 0; j < 4; ++j) { const int col = 4 * c.lane + 256 * j; const f32x4 y0 = load4bf(Y + (size_t)(2 * m) * D + col), y1 = load4bf(Y + (size_t)(2 * m + 1) * D + col);
#pragma unroll
            for (int e = 0; e < 4; ++e) v[4 * j + e] = ALPHA * v[4 * j + e] + (1.0f + MODF[5120 + col + e]) * (y0[e] + y1[e]); }
        float mean, rstd; row_stats(v, mean, rstd);
#pragma unroll
        for (int j = 0; j < 4; ++j) { f32x4 o; const int col = 4 * c.lane + 256 * j;
#pragma unroll
            for (int e = 0; e < 4; ++e) { v[4 * j + e] = (v[4 * j + e] - mean) * rstd * g2[col + e] + b2[col + e]; o[e] = v[4 * j + e]; }
            *(f32x4*)(a.out + (size_t)m * D + col) = o; }
        if (l + 1 < DEPTH) {
            const float* MN = MODF + 6144;
            row_stats(v, mean, rstd);
#pragma unroll
            for (int j = 0; j < 4; ++j) { f32x4 o; const int col = 4 * c.lane + 256 * j;
#pragma unroll
                for (int e = 0; e < 4; ++e) o[e] = (v[4 * j + e] - mean) * rstd * (1.0f + MN[1024 + col + e]) + MN[col + e];
                store4bf(XN + (size_t)m * D + col, o); }
        }
    }
}


template <class F> struct EpiAdapt {
    static constexpr bool PERM = false, AFTER_DRAIN = false; F f;
    __device__ __forceinline__ void operator()(const f32x4 (&acc)[2][2][4][2], const Unit& u, int wr, int wc, int fr, int fq) const {
#pragma unroll
        for (int ai = 0; ai < 2; ++ai)
#pragma unroll
            for (int m = 0; m < 4; ++m) { const int row = u.pm * 256 + ai * 128 + wr * 64 + m * 16 + fr;
#pragma unroll
                for (int n = 0; n < 2; ++n) { const int col = u.pn * 256 + wc * 32 + n * 16 + 4 * fq; f(row, col, acc[ai][0][m][n], acc[ai][1][m][n]); } }
    }
};

#ifndef USE_PG8
#define USE_PG8 1
#endif
template <class Sched, class F>
__device__ __forceinline__ void gemm_any(const Ctx& c, const bf16* A, const bf16* Bt, int M, int N, int K, const Sched& S, const F& f) {
#if USE_PG8
    pg8::Gemm g{A, Bt, M, N, K}; EpiAdapt<F> E{f};
    pg8::gemm_phase<EpiAdapt<F>, Sched, true, true>((PG8_LAS unsigned char*)c.lds, g, S, E);
#else
    gemm_simple(c, A, Bt, K, S, f);
#endif
}

#define LAS __attribute__((address_space(3)))
#define XB_TMO      128
#define XB_XCNT(j)  (256  + 64 * (j))
#define XB_XSUB(j)  (1280 + 64 * (j))
#define XB_XGEN(j)  (2304 + 64 * (j))
#define XB_TOP      3328
#define XB_TOPGEN   3392
#define XCD_BAR_WORDS 3456
#define XB_SPIN_CAP (1u << 24)

__device__ __forceinline__ unsigned xb_ld(unsigned* p)              { return __hip_atomic_load(p, __ATOMIC_RELAXED, __HIP_MEMORY_SCOPE_AGENT); }
__device__ __forceinline__ unsigned xb_add(unsigned* p, unsigned v) { return __hip_atomic_fetch_add(p, v, __ATOMIC_RELAXED, __HIP_MEMORY_SCOPE_AGENT); }
__device__ __forceinline__ unsigned xb_xcc_id() { return (unsigned)__builtin_amdgcn_s_getreg((3 << 11) | 20) & 0xFu; }
#define XB_SPIN(cond, bar) do { unsigned _sp = 0; while (cond) { __builtin_amdgcn_s_sleep(1); \
    if ((++_sp & 255u) == 0u) { if (xb_ld(&(bar)[XB_TMO])) break; if (_sp > XB_SPIN_CAP) { atomicAdd(&(bar)[XB_TMO], 1u); break; } } } } while (0)

struct XcdBarrier {
    unsigned* bar; unsigned x;
    volatile LAS unsigned* st;
};

__device__ __forceinline__ XcdBarrier xcd_barrier_post(unsigned* bar, volatile LAS unsigned* st) {
    XcdBarrier b; b.bar = bar; b.x = xb_xcc_id(); b.st = st;
    if (threadIdx.x == 0) (void)xb_add(&bar[XB_XCNT(b.x)], 1u);
    return b;
}
__device__ __forceinline__ void xcd_barrier_complete(unsigned* bar, unsigned x, unsigned& nloc, unsigned& nx) {
    const unsigned G = gridDim.x * gridDim.y * gridDim.z;
    unsigned sum, cnt, mine, sp = 0u;
    for (;;) {
        sum = 0u; cnt = 0u; mine = 0u;
#pragma unroll
        for (unsigned j = 0; j < 16; ++j) { const unsigned c = xb_ld(&bar[XB_XCNT(j)]); sum += c; cnt += (c > 0u) ? 1u : 0u; mine = (j == x) ? c : mine; }
        if (sum == G) break;
        __builtin_amdgcn_s_sleep(1);
        if ((++sp & 255u) == 0u) { if (xb_ld(&bar[XB_TMO])) break; if (sp > XB_SPIN_CAP) { atomicAdd(&bar[XB_TMO], 1u); break; } }
    }
    nloc = mine > 0u ? mine : 1u; nx = cnt > 0u ? cnt : 1u;
}

__device__ __forceinline__ void xcd_barrier(const XcdBarrier& b) {
    asm volatile("s_waitcnt vmcnt(0)" ::: "memory");
    __syncthreads();
    if (threadIdx.x == 0) {
        unsigned* bar = b.bar;
        __builtin_amdgcn_s_waitcnt(0);
        unsigned nloc = b.st[0], nx = b.st[1];
        if (nloc == 0u) { xcd_barrier_complete(bar, b.x, nloc, nx); b.st[0] = nloc; b.st[1] = nx; }
        const unsigned old = xb_add(&bar[XB_XSUB(b.x)], 1u);
        const unsigned gen = old / nloc;
        if (old + 1u == (gen + 1u) * nloc) {
            __builtin_amdgcn_fence(__ATOMIC_RELEASE, "agent");
            asm volatile("s_waitcnt vmcnt(0)" ::: "memory");
            const unsigned og = xb_add(&bar[XB_TOP], 1u);
            const unsigned tg = og / nx;
            if (og + 1u == (tg + 1u) * nx) xb_add(&bar[XB_TOPGEN], 1u);
            else XB_SPIN(xb_ld(&bar[XB_TOPGEN]) == tg, bar);
            __builtin_amdgcn_fence(__ATOMIC_ACQUIRE, "agent");
            xb_add(&bar[XB_XGEN(b.x)], 1u);
            asm volatile("s_waitcnt vmcnt(0)" ::: "memory");
        } else {
            XB_SPIN(xb_ld(&bar[XB_XGEN(b.x)]) == gen, bar);
            __builtin_amdgcn_fence(__ATOMIC_ACQUIRE, "agent");
            asm volatile("s_waitcnt vmcnt(0)" ::: "memory");
        }
    }
    __syncthreads();
}


constexpr int PH_PER_LAYER = 12, N_PHASES = 2 + PH_PER_LAYER * DEPTH;
constexpr int CW_BAR = 4096;
constexpr int LDS_BYTES = 147456, LDSCTL_OFF = 131072 + 8192;
#ifndef SINGLE_LAUNCH
#define SINGLE_LAUNCH 1
#endif

__device__ __forceinline__ const __attribute__((address_space(4))) Args* args_here() { const __attribute__((address_space(4))) Args* p = (const __attribute__((address_space(4))) Args*)__builtin_amdgcn_kernarg_segment_ptr(); asm volatile("" : "+s"(p)); return p; }
#define PHASE(k, ...) do { const __attribute__((address_space(4))) Args* ap_ = args_here(); if (ap_->ph_lo <= (k) && (k) < ap_->ph_hi) { ArgsR a = *ap_; __VA_ARGS__ } } while (0)

template <int L>
__device__ __forceinline__ void run_layer(const Ctx& c, const XcdBarrier& bar) {
    const int G = gridDim.x, b = blockIdx.x;
#define BAR() xcd_barrier(bar)
    PHASE(0, unsigned char* ws = a.ws; pg8::StaticOrder S; S.init(T, INC, G, b); EpiZ E{(bf16*)(ws + WS_ZR), (bf16*)(ws + WS_ZS), (bf16*)(ws + WS_ZG)};
        gemm_any(c, (const bf16*)(ws + WS_XN), (const bf16*)(ws + WS_WIN + (size_t)L * 10 * MiB), T, INC, D, S, E); );
    BAR();
    PHASE(1, phase_prep_fast(a, c, L); );
    PHASE(1, phase_sg_fast(a, c, L); );
    BAR();
    PHASE(2, phase_scan1(a, c); );
    BAR();
    PHASE(3, phase_scan2_simple(a, c); );
    BAR();
    PHASE(4, phase_scan3(a, c); );
    BAR();
    PHASE(5, phase_post(a, c, L); );
    BAR();
    PHASE(6, unsigned char* ws = a.ws; pg8::StaticOrder S; S.init(T, D, G, b); EpiGA E{(const bf16*)(ws + WS_ZG), (bf16*)(ws + WS_MP)};
        gemm_any(c, (const bf16*)(ws + WS_YA), (const bf16*)(ws + WS_WA + (size_t)L * WS_WL1), T, D, W, S, E); );
    BAR();
    PHASE(7, unsigned char* ws = a.ws; pg8::StaticOrder S; S.init(T, D, G, b); EpiGB E{(const bf16*)(ws + WS_ZG), (bf16*)(ws + WS_MP)};
        gemm_any(c, (const bf16*)(ws + WS_YB), (const bf16*)(ws + WS_WB + (size_t)L * WS_WL1), T, D, W, S, E); );
    BAR();
    PHASE(8, unsigned char* ws = a.ws; pg8::StaticOrder S; S.init(T, D, G, b); EpiOut E{L == 0 ? a.in[I_X] : a.out, a.out, (const float*)(ws + WS_MODF) + L * 6144 + 2048};
        gemm_any(c, (const bf16*)(ws + WS_MP), (const bf16*)(ws + WS_WO + (size_t)L * WS_WL1), T, D, D, S, E); );
    BAR();
    PHASE(9, phase_ln1(a, c, L); );
    BAR();
    PHASE(10, phase_perm(a, c, L); );
    BAR();
    PHASE(11, unsigned char* ws = a.ws; MoeSched S; S.init((const unsigned*)(ws + WS_CTL) + CW_CNT + 64 * L, G, b); EpiSwi E{(bf16*)(ws + WS_HID)};
        gemm_any(c, (const bf16*)(ws + WS_XS), (const bf16*)(ws + WS_WGU), MAXSLOT, NE * 1024, D, S, E); );
    BAR();
    PHASE(12, unsigned char* ws = a.ws; MoeSched S; S.init((const unsigned*)(ws + WS_CTL) + CW_CNT + 64 * L, G, b); EpiDown E{(const int*)(ws + WS_S2T), (const float*)(ws + WS_TOKW), (bf16*)(ws + WS_Y)};
        gemm_any(c, (const bf16*)(ws + WS_HID), (const bf16*)(ws + WS_WD), MAXSLOT, NE * 1024, FF, S, E); );
    BAR();
    PHASE(13, phase_ln2(a, c, L); );
    if (L + 1 < DEPTH) BAR();
#undef BAR
}

__global__ void __launch_bounds__(NTHREADS, 2) mk_fwd(Args a_unused) {
    extern __shared__ __attribute__((aligned(16))) unsigned char lds[];
    Ctx c; c.tid = threadIdx.x; c.lane = c.tid & 63; c.wave = __builtin_amdgcn_readfirstlane(c.tid >> 6);
    c.gw = blockIdx.x * NWAVES + c.wave; c.ngw = gridDim.x * NWAVES; c.lds = lds;
    for (int u = c.tid; u < (LDS_BYTES - LDSCTL_OFF) / 4; u += NTHREADS) ((LAS unsigned*)((LAS unsigned char*)lds + LDSCTL_OFF))[u] = 0u;
    __syncthreads();
    const XcdBarrier bar = xcd_barrier_post((unsigned*)(args_here()->ws + WS_CTL) + CW_BAR, (volatile LAS unsigned*)((LAS unsigned char*)lds + LDSCTL_OFF) + 8);
    PHASE(0, phase_p0a(a, c); );
    xcd_barrier(bar);
    PHASE(1, phase_p0b(a, c); );
    xcd_barrier(bar);
    run_layer<0>(c, bar);
    run_layer<1>(c, bar);
}

extern "C" void kernel_launch(void* const* d_in, const int* in_sizes, int n_in, void* d_out, int out_size, void* d_ws, size_t ws_size, hipStream_t stream) {
    static int grid = 0;
    if (grid == 0) {
        if (n_in != N_IN || out_size != T * D || ws_size < WS_END) { fprintf(stderr, "kernel_launch: unexpected shapes: n_in %d out %d ws %zu (need %zu)\n", n_in, out_size, ws_size, (size_t)WS_END); grid = -1; return; }
        int dev = 0, cus = 0;
        (void)hipGetDevice(&dev); (void)hipDeviceGetAttribute(&cus, hipDeviceAttributeMultiprocessorCount, dev);
        if (hipFuncSetAttribute((const void*)mk_fwd, hipFuncAttributeMaxDynamicSharedMemorySize, LDS_BYTES) != hipSuccess) { fprintf(stderr, "kernel_launch: hipFuncSetAttribute failed\n"); grid = -1; return; }
        grid = cus > 0 ? cus : 256;
        fprintf(stderr, "kernel_launch: ws_size %zu grid %d\n", ws_size, grid);
    }
    if (grid < 0) return;
    (void)hipMemsetAsync((char*)d_ws + WS_CTL, 0, CTL_BYTES, stream);
    Args a{};
    for (int i = 0; i < N_IN; ++i) a.in[i] = (const float*)d_in[i];
    a.out = (float*)d_out; a.ws = (unsigned char*)d_ws;
    a.ph_lo = 0; a.ph_hi = 1000;
    hipLaunchKernelGGL(mk_fwd, dim3(grid), dim3(NTHREADS), LDS_BYTES, stream, a);
}
```

```cpp
#include <hip/hip_runtime.h>
#include <cstdio>
#include <cstdint>
#include <utility>

typedef unsigned short bf16;
typedef _Float16 f16;
typedef float f32x4 __attribute__((ext_vector_type(4)));
typedef unsigned u32x4 __attribute__((ext_vector_type(4)));
typedef unsigned u32x2 __attribute__((ext_vector_type(2)));

constexpr int T = 16384, D = 1024, W = 512, NH = 8, HN = 64, RC = 1792, INC = 4864;
constexpr int NE = 16, FF = 512, DEPTH = 2;
constexpr float LN_EPS = 1e-5f, GN_EPS = 64e-5f, ALPHA = 1.41421356237f;
constexpr int NTHREADS = 512, NWAVES = 8;
constexpr int MAXSLOT = 36864;

constexpr size_t MiB = 1u << 20;
constexpr size_t WS_CTL = 0, CTL_BYTES = 1 * MiB;
constexpr int CW_CNT = 16384;
constexpr size_t WS_PART = 1 * MiB;
constexpr size_t WS_MODF = 2 * MiB;
constexpr size_t WS_TOKI = 2 * MiB + 65536;
constexpr size_t WS_TOKW = WS_TOKI + 131072;
constexpr size_t WS_TOKP = WS_TOKW + 131072;
constexpr size_t WS_S2T = 3 * MiB;
constexpr size_t WS_BLKCNT = 3 * MiB + 512 * 1024;
constexpr size_t WS_TOT = WS_BLKCNT + 32768;
constexpr size_t WS_LORA = 4 * MiB;
constexpr size_t WS_WIN = 8 * MiB;
constexpr size_t WS_WA = 28 * MiB, WS_WB = 29 * MiB, WS_WO = 30 * MiB, WS_WL1 = 4 * MiB;
constexpr size_t WS_ZG = 36 * MiB;
constexpr size_t WS_XN = 100 * MiB;
constexpr size_t WS_G = 100 * MiB, WS_YB = 116 * MiB;
constexpr size_t WS_ZR = 132 * MiB;
constexpr size_t WS_ZS = 188 * MiB;
constexpr size_t WS_YSC = 132 * MiB;
constexpr size_t WS_ST = 148 * MiB;
constexpr size_t WS_YA = 148 * MiB;
constexpr size_t WS_MP = 164 * MiB;
constexpr size_t WS_XS = 132 * MiB;
constexpr size_t WS_Y = 132 * MiB;
constexpr size_t WS_R = 224 * MiB, WS_WM1 = 240 * MiB, WS_KP = 256 * MiB, WS_AA = 272 * MiB, WS_BB = 288 * MiB, WS_V = 304 * MiB;
constexpr size_t WS_WGU = 224 * MiB;
constexpr size_t WS_WD = 256 * MiB;
constexpr size_t WS_HID = 272 * MiB;
constexpr size_t WS_VF = 320 * MiB;
constexpr size_t WS_END = 336 * MiB;

constexpr size_t LO_W2T = 0, LO_A2T = 65536, LO_G2T = 131072, LO_VM1T = 262144, LO_VM2T = 294912, LO_STRIDE = 524288;

enum { I_X = 0, I_C, I_WMOD, I_BMOD, I_WIN, I_MU, I_W0, I_W2, I_A0, I_A2, I_G2, I_KK, I_KA, I_RK, I_GNG, I_GNB, I_VM0, I_VM1, I_VM2,
       I_SGG, I_SGB, I_WS, I_BS, I_WBA, I_WBB, I_WOUT, I_LN1G, I_LN1B, I_RW, I_RB, I_EG, I_EU, I_ED, I_LN2G, I_LN2B, N_IN };

struct Args { const float* in[N_IN]; float* out; unsigned char* ws; int ph_lo, ph_hi; };
typedef const __attribute__((address_space(4))) Args& ArgsR;

__device__ __forceinline__ float bf2f(bf16 h) { return __uint_as_float(((unsigned)h) << 16); }
__device__ __forceinline__ unsigned f2bfu(float f) { unsigned u = __float_as_uint(f); return (u + 0x7fffu + ((u >> 16) & 1u)) >> 16; }
__device__ __forceinline__ bf16 f2bf(float f) { return (bf16)f2bfu(f); }
__device__ __forceinline__ unsigned pk2(float lo, float hi) { return f2bfu(lo) | (f2bfu(hi) << 16); }
__device__ __forceinline__ void store4bf(bf16* p, f32x4 v) { u32x2 w; w.x = pk2(v[0], v[1]); w.y = pk2(v[2], v[3]); *(u32x2*)p = w; }
__device__ __forceinline__ f32x4 load4bf(const bf16* p) { u32x2 w = *(const u32x2*)p; f32x4 r; r[0] = __uint_as_float(w.x << 16); r[1] = __uint_as_float(w.x & 0xffff0000u); r[2] = __uint_as_float(w.y << 16); r[3] = __uint_as_float(w.y & 0xffff0000u); return r; }
__device__ __forceinline__ float wave_sum(float v) {
#pragma unroll
    for (int o = 1; o < 64; o <<= 1) v += __shfl_xor(v, o);
    return v;
}
__device__ __forceinline__ float sigmoidf_(float x) { return 1.0f / (1.0f + __expf(-x)); }
__device__ __forceinline__ float siluf_(float x) { return x * sigmoidf_(x); }
__device__ __forceinline__ float gelu_tanh(float x) { const float u = 0.7978845608028654f * (x + 0.044715f * x * x * x); return x * (1.0f - 1.0f / (1.0f + __expf(2.0f * u))); }
__device__ __forceinline__ float softplusf_(float y) { return fmaxf(y, 0.f) + log1pf(__expf(-fabsf(y))); }

struct Ctx { int tid, lane, wave, gw, ngw; unsigned char* lds; };

__device__ __forceinline__ void transpose_item(const float* Wsrc, int N, int k0, int n0, bf16* dst, int ldk, float* scr, int lane) {
#pragma unroll 8
    for (int i = 0; i < 32; ++i) { const int kk = 2 * i + (lane >> 5); scr[kk * 33 + (lane & 31)] = Wsrc[(size_t)(k0 + kk) * N + n0 + (lane & 31)]; }
    asm volatile("s_waitcnt lgkmcnt(0)" ::: "memory");
    const int c = lane & 7;
#pragma unroll
    for (int j = 0; j < 4; ++j) { const int n = (lane >> 3) + 8 * j; const float* s = scr + (8 * c) * 33 + n;
        u32x4 o; o.x = pk2(s[0 * 33], s[1 * 33]); o.y = pk2(s[2 * 33], s[3 * 33]); o.z = pk2(s[4 * 33], s[5 * 33]); o.w = pk2(s[6 * 33], s[7 * 33]);
        *(u32x4*)(dst + (size_t)n * ldk + k0 + 8 * c) = o; }
    asm volatile("s_waitcnt lgkmcnt(0)" ::: "memory");
}
template <class RowMap>
__device__ __forceinline__ void transpose_matrix_item(const float* Wsrc, int K, int N, bf16* dst, int item, float* scr, int lane, const RowMap& rm) {
    const int nblk = N / 32, kb = item / nblk, nb = item % nblk, n0 = 32 * nb;
    transpose_item(Wsrc, N, 64 * kb, n0, dst + (size_t)rm(n0) * K, K, scr, lane);
}
struct RowId { __device__ __forceinline__ int operator()(int n) const { return n; } };
struct RowGU { int up; __device__ __forceinline__ int operator()(int n) const { return (n >> 7) * 256 + (n & 127) + up * 128; } };

__device__ __forceinline__ void phase_p0a(ArgsR a, const Ctx& c) {
    float* scr = (float*)(c.lds + c.wave * 16384);
    float* PART = (float*)(a.ws + WS_PART);
    for (int it = c.gw; it < 2 * 96 * 16; it += c.ngw) {
        const int kb = it & 15, cb = (it >> 4) % 96, l = it / (16 * 96);
        const int n = cb * 64 + c.lane;
        const float* wm = a.in[I_WMOD] + (size_t)l * D * 6144;
        float acc = 0.f;
#pragma unroll 8
        for (int k = 0; k < 64; ++k) { const int kk = kb * 64 + k; acc += siluf_(a.in[I_C][kk]) * wm[(size_t)kk * 6144 + n]; }
        PART[((size_t)l * 16 + kb) * 6144 + n] = acc;
    }
    for (int it = c.gw; it < 2 * (16 + 16 + 32 + 8); it += c.ngw) {
        const int l = it / 72; int r = it % 72; unsigned char* lo = a.ws + WS_LORA + (size_t)l * LO_STRIDE;
        if (r < 16) { transpose_matrix_item(a.in[I_W2] + (size_t)l * 64 * W, 64, W, (bf16*)(lo + LO_W2T), r, scr, c.lane, RowId()); continue; } r -= 16;
        if (r < 16) { transpose_matrix_item(a.in[I_A2] + (size_t)l * 64 * W, 64, W, (bf16*)(lo + LO_A2T), r, scr, c.lane, RowId()); continue; } r -= 16;
        if (r < 32) { transpose_matrix_item(a.in[I_G2] + (size_t)l * 128 * W, 128, W, (bf16*)(lo + LO_G2T), r, scr, c.lane, RowId()); continue; } r -= 32;
        if (l == 1) transpose_matrix_item(a.in[I_VM1], W, 32, (bf16*)(lo + LO_VM1T), r, scr, c.lane, RowId());
    }
    for (int i = blockIdx.x * NTHREADS + c.tid; i < 32 * W; i += gridDim.x * NTHREADS) { const int n = i >> 5, k = i & 31;
        ((bf16*)(a.ws + WS_LORA + LO_STRIDE + LO_VM2T))[i] = f2bf(a.in[I_VM2][(size_t)k * W + n]); }
    constexpr int I_WINL = (D / 64) * (INC / 32);
    constexpr int I_WAL = (W / 64) * (D / 32);
    constexpr int I_WOL = (D / 64) * (D / 32);
    constexpr int PER_L = I_WINL + 2 * I_WAL + I_WOL;
    for (int it = c.gw; it < 2 * PER_L; it += c.ngw) {
        const int l = it / PER_L; int r = it % PER_L;
        if (r < I_WINL) { transpose_matrix_item(a.in[I_WIN] + (size_t)l * D * INC, D, INC, (bf16*)(a.ws + WS_WIN + (size_t)l * 10 * MiB), r, scr, c.lane, RowId()); continue; } r -= I_WINL;
        if (r < I_WAL) { transpose_matrix_item(a.in[I_WBA] + (size_t)l * W * D, W, D, (bf16*)(a.ws + WS_WA + (size_t)l * WS_WL1), r, scr, c.lane, RowId()); continue; } r -= I_WAL;
        if (r < I_WAL) { transpose_matrix_item(a.in[I_WBB] + (size_t)l * W * D, W, D, (bf16*)(a.ws + WS_WB + (size_t)l * WS_WL1), r, scr, c.lane, RowId()); continue; } r -= I_WAL;
        transpose_matrix_item(a.in[I_WOUT] + (size_t)l * D * D, D, D, (bf16*)(a.ws + WS_WO + (size_t)l * WS_WL1), r, scr, c.lane, RowId());
    }
}

__device__ __forceinline__ void row_stats(const float (&v)[16], float& mean, float& rstd) {
    float s = 0.f;
#pragma unroll
    for (int j = 0; j < 16; ++j) s += v[j];
    mean = wave_sum(s) * (1.f / D);
    float q = 0.f;
#pragma unroll
    for (int j = 0; j < 16; ++j) { const float d = v[j] - mean; q += d * d; }
    rstd = 1.0f / sqrtf(wave_sum(q) * (1.f / D) + LN_EPS);
}
__device__ __forceinline__ void load_row16(const float* p, int lane, float (&v)[16]) {
#pragma unroll
    for (int j = 0; j < 4; ++j) { const f32x4 x = *(const f32x4*)(p + 4 * lane + 256 * j); v[4 * j] = x[0]; v[4 * j + 1] = x[1]; v[4 * j + 2] = x[2]; v[4 * j + 3] = x[3]; }
}

__device__ __forceinline__ void phase_p0b(ArgsR a, const Ctx& c) {
    const float* PART = (const float*)(a.ws + WS_PART);
    float* MODF = (float*)(a.ws + WS_MODF);
    for (int i = blockIdx.x * NTHREADS + c.tid; i < 2 * 6144; i += gridDim.x * NTHREADS) {
        const int l = i / 6144, n = i % 6144; float s = a.in[I_BMOD][i];
#pragma unroll
        for (int kb = 0; kb < 16; ++kb) s += PART[((size_t)l * 16 + kb) * 6144 + n];
        MODF[i] = s;
    }
    float sh[16], sc[16];
#pragma unroll
    for (int j = 0; j < 4; ++j)
#pragma unroll
        for (int e = 0; e < 4; ++e) { const int col = 4 * c.lane + 256 * j + e; float s0 = a.in[I_BMOD][col], s1 = a.in[I_BMOD][1024 + col];
            for (int kb = 0; kb < 16; ++kb) { s0 += PART[(size_t)kb * 6144 + col]; s1 += PART[(size_t)kb * 6144 + 1024 + col]; }
            sh[4 * j + e] = s0; sc[4 * j + e] = 1.f + s1; }
    bf16* XN = (bf16*)(a.ws + WS_XN);
    for (int m = c.gw; m < T; m += c.ngw) {
        float v[16]; load_row16(a.in[I_X] + (size_t)m * D, c.lane, v);
        float mean, rstd; row_stats(v, mean, rstd);
#pragma unroll
        for (int j = 0; j < 4; ++j) { f32x4 o;
#pragma unroll
            for (int e = 0; e < 4; ++e) o[e] = (v[4 * j + e] - mean) * rstd * sc[4 * j + e] + sh[4 * j + e];
            store4bf(XN + (size_t)m * D + 4 * c.lane + 256 * j, o); }
    }
}

namespace pg8 {
#define PG8_LAS __attribute__((address_space(3)))
typedef unsigned short bf16_t;
typedef short bf16x8 __attribute__((ext_vector_type(8)));
typedef float f32x4 __attribute__((ext_vector_type(4)));
typedef unsigned u32x4 __attribute__((ext_vector_type(4)));
constexpr int BM = 256, BK = 64, HALF = 128, HTB = HALF * BK * 2  , STAGE_BYTES = 8 * HTB, NXCD = 8, WGM = 8;

__host__ __device__ __forceinline__ int lds_byte(int r, int c) { const int st = (r >> 4) * 2 + (c >> 5), rr = r & 15, cc = c & 31, ob = rr * 64 + cc * 2; return st * 1024 + (ob ^ (((ob >> 9) & 1) << 5)); }
__host__ __device__ __forceinline__ void stage_rc(int b, int& R, int& C) { const int st = b / 1024, sb = b % 1024, swz = sb ^ (((sb >> 9) & 1) << 5); R = (st >> 1) * 16 + swz / 64; C = (st & 1) * 32 + (swz % 64) / 2; }
__host__ __device__ __forceinline__ int perm32(int rho) { const int n = rho >> 4, i = rho & 15; return 8 * (i >> 2) + 4 * n + (i & 3); }

struct Unit { int pm, pn; };
struct Gemm { const bf16_t* A; const bf16_t* Bt; int M, N, K; };

struct StaticOrder {
    int nM, nN, nwg, G, c;
    __host__ __device__ void init(int M, int N, int G_, int c_) { nM = M / BM; nN = N / BM; nwg = nM * nN; G = G_; c = c_; }
    __host__ __device__ bool next(int i, Unit& u) const {
        const long L = (long)i * G + c; if (L >= nwg) return false;
        int wgid = (int)L; { const int q = nwg / NXCD, r = nwg % NXCD, xcd = wgid % NXCD, off = wgid / NXCD; wgid = (xcd < r ? xcd * (q + 1) : r * (q + 1) + (xcd - r) * q) + off; }
        const int nig = WGM * nN, gid = wgid / nig, fm = gid * WGM, gsz = (nM - fm) < WGM ? (nM - fm) : WGM;
        u.pm = fm + ((wgid % nig) % gsz); u.pn = (wgid % nig) / gsz; return true;
    }
    __device__ __forceinline__ void a_ready(const Unit&) const {}
    __device__ __forceinline__ void done(const Unit&) const {}
};


template <class Epi, class Sched, bool ALIGN_EPI = false, bool SP2 = false>
__device__ __forceinline__ void gemm_phase(PG8_LAS unsigned char* lds, const Gemm g, const Sched& S, const Epi& E) {
    const int tid = threadIdx.x, wid = __builtin_amdgcn_readfirstlane(tid >> 6), lane = tid & 63, wr = wid >> 2, wc = wid & 3, fr = lane & 15, fq = lane >> 4;
    const int K = g.K, nt = K / BK;
    unsigned voffA[2], voffB[2];
#pragma unroll
    for (int i = 0; i < 2; ++i) { int R, C; stage_rc(tid * 16 + i * 8192, R, C); const int Rb = Epi::PERM ? ((R & ~31) + perm32(R & 31)) : R;
        voffA[i] = (unsigned)(R * K + C) * 2u; voffB[i] = (unsigned)(Rb * K + C) * 2u; }
    const size_t kstep = (size_t)(BK * 2);
    const size_t hstep = (size_t)HALF * K * 2;
    const size_t tstep = 2 * hstep;
    const unsigned ldsw = (unsigned)wid * 1024u;
    const int aoff = lds_byte(wr * 64 + fr, fq * 8), boff = lds_byte(wc * 32 + fr, fq * 8);
#define PG8_SA(b, h) (((b) * 2 + (h)) * HTB)
#define PG8_SB(b, h) ((4 + (b) * 2 + (h)) * HTB)
#define PG8_STAGE(bufoff, gbase, voff) do { _Pragma("unroll") for (int _i = 0; _i < 2; ++_i) \
        __builtin_amdgcn_global_load_lds((const unsigned*)((const char*)(gbase) + (voff)[_i]), (PG8_LAS unsigned*)(lds + (bufoff) + ldsw + _i * 8192), 16, 0, 0); } while (0)
#define PG8_LDA(dst, b, h) do { _Pragma("unroll") for (int m = 0; m < 4; ++m) _Pragma("unroll") for (int k = 0; k < 2; ++k) dst[m][k] = *(const PG8_LAS bf16x8*)(lds + PG8_SA(b, h) + aoff + m * 2048 + k * 1024); } while (0)
#define PG8_LDB(dst, b, h) do { _Pragma("unroll") for (int n = 0; n < 2; ++n) _Pragma("unroll") for (int k = 0; k < 2; ++k) dst[n][k] = *(const PG8_LAS bf16x8*)(lds + PG8_SB(b, h) + boff + n * 2048 + k * 1024); } while (0)
#define PG8_MMA(ai, bj, At, Bt) do { __builtin_amdgcn_s_setprio(1); _Pragma("unroll") for (int m = 0; m < 4; ++m) _Pragma("unroll") for (int n = 0; n < 2; ++n) _Pragma("unroll") for (int k = 0; k < 2; ++k) \
        acc[ai][bj][m][n] = __builtin_amdgcn_mfma_f32_16x16x32_bf16(Bt[n][k], At[m][k], acc[ai][bj][m][n], 0, 0, 0); __builtin_amdgcn_s_setprio(0); } while (0)
#define PG8_WAIT_V(n) asm volatile("s_waitcnt vmcnt(" #n ")" ::: "memory")
#define PG8_WAIT_L(n) asm volatile("s_waitcnt lgkmcnt(" #n ")" ::: "memory")
#define PG8_BAR __builtin_amdgcn_s_barrier()
#define PG8_SCHED __builtin_amdgcn_sched_barrier(0)
    Unit cur, nxt; int ui = 0;
    if (!S.next(0, cur)) return;
    f32x4 acc[2][2][4][2];
#pragma unroll
    for (int a = 0; a < 2; ++a)
#pragma unroll
        for (int b = 0; b < 2; ++b)
#pragma unroll
            for (int m = 0; m < 4; ++m)
#pragma unroll
                for (int n = 0; n < 2; ++n) acc[a][b][m][n] = (f32x4){0.f, 0.f, 0.f, 0.f};
    bf16x8 At[4][2], B0[2][2], B1[2][2];
    const char* cA = (const char*)g.A + (size_t)cur.pm * tstep; const char* cB = (const char*)g.Bt + (size_t)cur.pn * tstep;
    S.a_ready(cur);
    if constexpr (SP2) {
        PG8_STAGE(PG8_SB(0, 0), cB, voffB); PG8_STAGE(PG8_SB(0, 1), cB + hstep, voffB); PG8_STAGE(PG8_SA(0, 0), cA, voffA); PG8_STAGE(PG8_SA(0, 1), cA + hstep, voffA);
        if (wr == 1) PG8_BAR;
        PG8_WAIT_V(2); PG8_BAR;
        PG8_STAGE(PG8_SB(1, 0), cB + kstep, voffB); PG8_STAGE(PG8_SA(1, 0), cA + kstep, voffA); PG8_STAGE(PG8_SB(1, 1), cB + hstep + kstep, voffB);
        PG8_WAIT_V(6); PG8_BAR;
    } else {
        PG8_STAGE(PG8_SB(0, 0), cB, voffB); PG8_STAGE(PG8_SA(0, 0), cA, voffA); PG8_STAGE(PG8_SB(0, 1), cB + hstep, voffB); PG8_STAGE(PG8_SA(0, 1), cA + hstep, voffA);
        if (wr == 1) PG8_BAR;
        PG8_WAIT_V(4); PG8_BAR;
        PG8_STAGE(PG8_SB(1, 0), cB + kstep, voffB); PG8_STAGE(PG8_SA(1, 0), cA + kstep, voffA); PG8_STAGE(PG8_SB(1, 1), cB + hstep + kstep, voffB);
        PG8_WAIT_V(6); PG8_BAR;
    }
    for (;;) {
        const bool has_next = S.next(ui + 1, nxt);
        const char* nA = has_next ? (const char*)g.A + (size_t)nxt.pm * tstep : cA; const char* nB = has_next ? (const char*)g.Bt + (size_t)nxt.pn * tstep : cB;
        for (int t = 0; t < nt; t += 2) {
            const bool last = (t == nt - 2);
            const char* a1 = cA + (size_t)(t + 1) * kstep;
            const char* a2 = last ? nA : cA + (size_t)(t + 2) * kstep; const char* b2 = last ? nB : cB + (size_t)(t + 2) * kstep;
            const char* a3 = a2 + kstep; const char* b3 = b2 + kstep;
            if (last && has_next) S.a_ready(nxt);
            if constexpr (SP2) {
            PG8_LDB(B0, 0, 0); PG8_LDB(B1, 0, 1); PG8_SCHED; PG8_LDA(At, 0, 0); PG8_STAGE(PG8_SA(1, 1), a1 + hstep, voffA);
            PG8_WAIT_V(8); PG8_WAIT_L(0); PG8_BAR; PG8_MMA(0, 0, At, B0); PG8_MMA(0, 1, At, B1); PG8_BAR; PG8_SCHED;
            PG8_LDA(At, 0, 1); PG8_STAGE(PG8_SB(0, 0), b2, voffB); PG8_STAGE(PG8_SB(0, 1), b2 + hstep, voffB); PG8_STAGE(PG8_SA(0, 0), a2, voffA);
            PG8_WAIT_V(8); PG8_WAIT_L(0); PG8_BAR; PG8_MMA(1, 0, At, B0); PG8_MMA(1, 1, At, B1); PG8_BAR; PG8_SCHED;
            PG8_LDB(B0, 1, 0); PG8_LDB(B1, 1, 1); PG8_SCHED; PG8_LDA(At, 1, 0); PG8_STAGE(PG8_SA(0, 1), a2 + hstep, voffA);
            PG8_WAIT_V(8); PG8_WAIT_L(0); PG8_BAR; PG8_MMA(0, 0, At, B0); PG8_MMA(0, 1, At, B1); PG8_BAR; PG8_SCHED;
            PG8_LDA(At, 1, 1); PG8_STAGE(PG8_SB(1, 0), b3, voffB); PG8_STAGE(PG8_SB(1, 1), b3 + hstep, voffB); PG8_STAGE(PG8_SA(1, 0), a3, voffA);
            PG8_WAIT_V(8); PG8_WAIT_L(0); PG8_BAR; PG8_MMA(1, 0, At, B0); PG8_MMA(1, 1, At, B1); PG8_BAR; PG8_SCHED;
            } else {
            PG8_LDB(B0, 0, 0); PG8_SCHED; PG8_LDA(At, 0, 0); PG8_STAGE(PG8_SA(1, 1), a1 + hstep, voffA);
            PG8_WAIT_L(8); PG8_BAR; PG8_WAIT_L(0); PG8_MMA(0, 0, At, B0); PG8_BAR; PG8_SCHED;
            PG8_LDB(B1, 0, 1); PG8_STAGE(PG8_SB(0, 0), b2, voffB);
            PG8_BAR; PG8_WAIT_L(0); PG8_MMA(0, 1, At, B1); PG8_BAR;
            PG8_LDA(At, 0, 1); PG8_STAGE(PG8_SA(0, 0), a2, voffA);
            PG8_BAR; PG8_WAIT_L(0); PG8_MMA(1, 0, At, B0); PG8_BAR; PG8_SCHED;
            PG8_STAGE(PG8_SB(0, 1), b2 + hstep, voffB);
            PG8_WAIT_V(6); PG8_BAR; PG8_MMA(1, 1, At, B1); PG8_BAR;
            PG8_LDB(B0, 1, 0); PG8_SCHED; PG8_LDA(At, 1, 0); PG8_STAGE(PG8_SA(0, 1), a2 + hstep, voffA);
            PG8_WAIT_L(8); PG8_BAR; PG8_WAIT_L(0); PG8_MMA(0, 0, At, B0); PG8_BAR; PG8_SCHED;
            PG8_LDB(B1, 1, 1); PG8_STAGE(PG8_SB(1, 0), b3, voffB);
            PG8_BAR; PG8_WAIT_L(0); PG8_MMA(0, 1, At, B1); PG8_BAR;
            PG8_LDA(At, 1, 1); PG8_STAGE(PG8_SA(1, 0), a3, voffA);
            PG8_BAR; PG8_WAIT_L(0); PG8_MMA(1, 0, At, B0); PG8_BAR; PG8_SCHED;
            PG8_STAGE(PG8_SB(1, 1), b3 + hstep, voffB);
            PG8_WAIT_V(6); PG8_BAR; PG8_MMA(1, 1, At, B1); PG8_BAR;
            }
        }
        if constexpr (ALIGN_EPI) { if (wr == 0) PG8_BAR; }
        if constexpr (!Epi::AFTER_DRAIN) { E(acc, cur, wr, wc, fr, fq); S.done(cur); }
        if (!has_next) break;
#pragma unroll
        for (int a = 0; a < 2; ++a)
#pragma unroll
            for (int b = 0; b < 2; ++b)
#pragma unroll
                for (int m = 0; m < 4; ++m)
#pragma unroll
                    for (int n = 0; n < 2; ++n) acc[a][b][m][n] = (f32x4){0.f, 0.f, 0.f, 0.f};
        cur = nxt; cA = nA; cB = nB; ++ui;
        if constexpr (ALIGN_EPI) { if (wr == 1) PG8_BAR; }
    }
    PG8_WAIT_V(0);
    if constexpr (!ALIGN_EPI) { if (wr == 0) PG8_BAR; }
    PG8_BAR;
    if constexpr (Epi::AFTER_DRAIN) { E.fused(acc, cur, wr, wc, fr, fq, lds, wid, lane); S.done(cur); }
#undef PG8_SA
#undef PG8_SB
#undef PG8_STAGE
#undef PG8_LDA
#undef PG8_LDB
#undef PG8_MMA
#undef PG8_WAIT_V
#undef PG8_WAIT_L
#undef PG8_BAR
#undef PG8_SCHED
}
}

using pg8::Unit;
struct DenseSched { int nN, n, G, c;
    __device__ __forceinline__ void a_ready(const Unit&) const {}
    __device__ __forceinline__ void done(const Unit&) const {}
    __device__ __forceinline__ bool next(int i, Unit& u) const { const int L = i * G + c; if (L >= n) return false; u.pm = L / nN; u.pn = L % nN; return true; } };

template <class Sched, class Epi>
__device__ __forceinline__ void gemm_simple(const Ctx& c, const bf16* A, const bf16* Bt, int K, const Sched& S, const Epi& E) {
    float* As = (float*)c.lds;
    float* Bs = As + 32 * 256;
    const int tid = c.tid, rg = tid >> 4, cg = tid & 15;
    Unit u;
    for (int ui = 0; S.next(ui, u); ++ui) {
        float acc[8][16];
#pragma unroll
        for (int i = 0; i < 8; ++i)
#pragma unroll
            for (int j = 0; j < 16; ++j) acc[i][j] = 0.f;
        const bf16* Ab = A + (size_t)u.pm * 256 * K; const bf16* Bb = Bt + (size_t)u.pn * 256 * K;
        for (int k0 = 0; k0 < K; k0 += 32) {
            { const int row = tid >> 1, kh = tid & 1;
              const u32x4* pa = (const u32x4*)(Ab + (size_t)row * K + k0 + 16 * kh); const u32x4 a0 = pa[0], a1 = pa[1];
              const u32x4* pb = (const u32x4*)(Bb + (size_t)row * K + k0 + 16 * kh); const u32x4 b0 = pb[0], b1 = pb[1];
#pragma unroll
              for (int j = 0; j < 4; ++j) {
                  As[(16 * kh + 2 * j) * 256 + row] = __uint_as_float(a0[j] << 16); As[(16 * kh + 2 * j + 1) * 256 + row] = __uint_as_float(a0[j] & 0xffff0000u);
                  As[(16 * kh + 8 + 2 * j) * 256 + row] = __uint_as_float(a1[j] << 16); As[(16 * kh + 8 + 2 * j + 1) * 256 + row] = __uint_as_float(a1[j] & 0xffff0000u);
                  Bs[(16 * kh + 2 * j) * 256 + row] = __uint_as_float(b0[j] << 16); Bs[(16 * kh + 2 * j + 1) * 256 + row] = __uint_as_float(b0[j] & 0xffff0000u);
                  Bs[(16 * kh + 8 + 2 * j) * 256 + row] = __uint_as_float(b1[j] << 16); Bs[(16 * kh + 8 + 2 * j + 1) * 256 + row] = __uint_as_float(b1[j] & 0xffff0000u);
              } }
            __syncthreads();
#pragma unroll 4
            for (int kk = 0; kk < 32; ++kk) {
                const f32x4 a0 = *(const f32x4*)(As + kk * 256 + rg * 8), a1 = *(const f32x4*)(As + kk * 256 + rg * 8 + 4);
                f32x4 b[4];
#pragma unroll
                for (int q = 0; q < 4; ++q) b[q] = *(const f32x4*)(Bs + kk * 256 + 64 * q + 4 * cg);
#pragma unroll
                for (int i = 0; i < 8; ++i) { const float av = i < 4 ? a0[i & 3] : a1[i & 3];
#pragma unroll
                    for (int q = 0; q < 4; ++q)
#pragma unroll
                        for (int e = 0; e < 4; ++e) acc[i][4 * q + e] += av * b[q][e]; }
            }
            __syncthreads();
        }
#pragma unroll
        for (int i = 0; i < 8; ++i) { const int row = u.pm * 256 + rg * 8 + i;
#pragma unroll
            for (int q = 0; q < 2; ++q) { const int col = u.pn * 256 + 64 * q + 4 * cg;
                f32x4 v0, v1;
#pragma unroll
                for (int e = 0; e < 4; ++e) { v0[e] = acc[i][4 * q + e]; v1[e] = acc[i][4 * (q + 2) + e]; }
                E(row, col, v0, v1); } }
    }
}

struct EpiZ { bf16 *ZR, *ZS, *ZG;
    __device__ __forceinline__ void one(int row, int col, f32x4 v) const {
        if (col < RC) store4bf(ZR + (size_t)row * RC + col, v);
        else if (col < RC + 1024) { f32x4 g; for (int e = 0; e < 4; ++e) g[e] = gelu_tanh(v[e]); store4bf(ZS + (size_t)row * 1024 + (col - RC), g); }
        else { f32x4 g; for (int e = 0; e < 4; ++e) g[e] = sigmoidf_(v[e]); store4bf(ZG + (size_t)row * 2048 + (col - RC - 1024), g); } }
    __device__ __forceinline__ void operator()(int row, int col, f32x4 v0, f32x4 v1) const { one(row, col, v0); one(row, col + 128, v1); } };
struct EpiGA { const bf16* ZG; bf16* MP;
    __device__ __forceinline__ void one(int row, int col, f32x4 v) const { const f32x4 g = load4bf(ZG + (size_t)row * 2048 + col); store4bf(MP + (size_t)row * D + col, g * v); }
    __device__ __forceinline__ void operator()(int row, int col, f32x4 v0, f32x4 v1) const { one(row, col, v0); one(row, col + 128, v1); } };
struct EpiGB { const bf16* ZG; bf16* MP;
    __device__ __forceinline__ void one(int row, int col, f32x4 v) const { const f32x4 g = load4bf(ZG + (size_t)row * 2048 + 1024 + col); const f32x4 m = load4bf(MP + (size_t)row * D + col); store4bf(MP + (size_t)row * D + col, m + g * v); }
    __device__ __forceinline__ void operator()(int row, int col, f32x4 v0, f32x4 v1) const { one(row, col, v0); one(row, col + 128, v1); } };
struct EpiOut { const float* xin; float* out; const float* gate1;
    __device__ __forceinline__ void one(int row, int col, f32x4 v) const { const f32x4 x = *(const f32x4*)(xin + (size_t)row * D + col); const f32x4 g = *(const f32x4*)(gate1 + col);
        *(f32x4*)(out + (size_t)row * D + col) = ALPHA * x + (1.0f + g) * v; }
    __device__ __forceinline__ void operator()(int row, int col, f32x4 v0, f32x4 v1) const { one(row, col, v0); one(row, col + 128, v1); } };
struct EpiSwi { bf16* HID;
    __device__ __forceinline__ void operator()(int row, int col, f32x4 v0, f32x4 v1) const { const int ct = (col >> 8) & 3, cc = col & 127;
        f32x4 h; for (int e = 0; e < 4; ++e) h[e] = siluf_(v0[e]) * v1[e]; store4bf(HID + (size_t)row * FF + ct * 128 + cc, h); } };
struct EpiDown { const int* S2T; const float* TOKW; bf16* Y;
    __device__ __forceinline__ void operator()(int row, int col, f32x4 v0, f32x4 v1) const { const int st = S2T[row]; if (st < 0) return; const float w = TOKW[st]; const int cc = col & 1023;
        store4bf(Y + (size_t)st * D + cc, w * v0); store4bf(Y + (size_t)st * D + cc + 128, w * v1); } };

struct MoeSched { int ts[17]; int G, c;
    __device__ __forceinline__ void a_ready(const Unit&) const {}
    __device__ __forceinline__ void done(const Unit&) const {}
    __device__ __forceinline__ void init(const unsigned* cnt, int G_, int c_) { G = G_; c = c_; int s = 0;
#pragma unroll
        for (int e = 0; e < 16; ++e) { ts[e] = s; s += ((int)cnt[e] + 255) >> 8; } ts[16] = s; }
    __device__ __forceinline__ bool next(int i, Unit& u) const { const int L = i * G + c; if (L >= 4 * ts[16]) return false; const int rt = L >> 2, ct = L & 3; int e = 0;
#pragma unroll
        for (int j = 1; j < 16; ++j) e += (rt >= ts[j]) ? 1 : 0;
        u.pm = rt; u.pn = e * 4 + ct; return true; } };

__device__ __forceinline__ void phase_prep_simple(ArgsR a, const Ctx& c, int l) {
    const bf16* ZR = (const bf16*)(a.ws + WS_ZR);
    const float* mu = a.in[I_MU] + l * RC; const float* w0 = a.in[I_W0] + l * W; const float* w2 = a.in[I_W2] + (size_t)l * 64 * W;
    const float* a0 = a.in[I_A0] + l * W; const float* a2 = a.in[I_A2] + (size_t)l * 64 * W; const float* g2 = a.in[I_G2] + (size_t)l * 128 * W;
    const float* k_k = a.in[I_KK] + l * W; const float* k_a = a.in[I_KA] + l * W;
    const float* vm0 = a.in[I_VM0]; const float* vm1 = a.in[I_VM1]; const float* vm2 = a.in[I_VM2];
    f16* R = (f16*)(a.ws + WS_R); f16* WM1 = (f16*)(a.ws + WS_WM1); f16* KP = (f16*)(a.ws + WS_KP); f16* AA = (f16*)(a.ws + WS_AA); f16* BB = (f16*)(a.ws + WS_BB); f16* V = (f16*)(a.ws + WS_V);
    bf16* G = (bf16*)(a.ws + WS_G); bf16* VF = (bf16*)(a.ws + WS_VF);
    const int lane = c.lane;
    for (int t = c.gw; t < T; t += c.ngw) {
        float z[28];
#pragma unroll
        for (int i = 0; i < 28; ++i) { const int col = lane + 64 * i; const float zc = bf2f(ZR[(size_t)t * RC + col]); const float zp = t > 0 ? bf2f(ZR[(size_t)(t - 1) * RC + col]) : 0.f; z[i] = zc + (zp - zc) * mu[col]; }
        const float tw = tanhf(z[24]), za = z[25], sg0 = sigmoidf_(z[26]), sg1 = sigmoidf_(z[27]);
        float wlo[8], alo[8], gg[8];
#pragma unroll
        for (int i = 0; i < 8; ++i) { wlo[i] = 0.f; alo[i] = 0.f; gg[i] = 0.f; }
        for (int j = 0; j < 64; ++j) { const float tj = __shfl(tw, j), aj = __shfl(za, j), s0 = __shfl(sg0, j), s1 = __shfl(sg1, j);
#pragma unroll
            for (int i = 0; i < 8; ++i) { const int n = lane + 64 * i; wlo[i] += tj * w2[j * W + n]; alo[i] += aj * a2[j * W + n]; gg[i] += s0 * g2[j * W + n] + s1 * g2[(64 + j) * W + n]; } }
        float vv[8];
#pragma unroll
        for (int i = 0; i < 8; ++i) vv[i] = z[16 + i];
        if (l == 0) {
#pragma unroll
            for (int i = 0; i < 8; ++i) VF[(size_t)t * W + lane + 64 * i] = f2bf(vv[i]);
        } else {
            float vmid = 0.f;
#pragma unroll
            for (int i = 0; i < 8; ++i)
                for (int j = 0; j < 64; ++j) { const float vc = __shfl(vv[i], j); vmid += vc * vm1[(size_t)(64 * i + j) * 32 + (lane & 31)]; }
            float vg[8];
#pragma unroll
            for (int i = 0; i < 8; ++i) vg[i] = 0.f;
            for (int m = 0; m < 32; ++m) { const float vmm = __shfl(vmid, m);
#pragma unroll
                for (int i = 0; i < 8; ++i) vg[i] += vmm * vm2[m * W + lane + 64 * i]; }
#pragma unroll
            for (int i = 0; i < 8; ++i) { const int n = lane + 64 * i; const float vf = bf2f(VF[(size_t)t * W + n]); vv[i] = vv[i] + (vf - vv[i]) * sigmoidf_(vm0[n] + vg[i]); }
        }
#pragma unroll
        for (int i = 0; i < 8; ++i) {
            const int n = lane + 64 * i; const size_t o = (size_t)t * W + n;
            const float x = w0[n] + wlo[i]; const float wl = -softplusf_(-x) - 0.5f; const float dm1 = expm1f(-__expf(wl));
            const float av = sigmoidf_(a0[n] + alo[i]);
            const float kraw = z[8 + i];
            float kk = kraw * k_k[n]; const float nrm = sqrtf(wave_sum(kk * kk)); kk = kk / fmaxf(nrm, 1e-12f);
            const float kp = kraw * (1.0f + (av - 1.0f) * k_a[n]);
            R[o] = (f16)z[i]; WM1[o] = (f16)dm1; KP[o] = (f16)kp; AA[o] = (f16)(-kk); BB[o] = (f16)(kk * av); V[o] = (f16)vv[i]; G[o] = f2bf(gg[i]);
        }
    }
}

__device__ __forceinline__ void phase_sg_simple(ArgsR a, const Ctx& c, int l) {
    const bf16* ZS = (const bf16*)(a.ws + WS_ZS); bf16* YB = (bf16*)(a.ws + WS_YB);
    const float* lng = a.in[I_SGG] + l * W; const float* lnb = a.in[I_SGB] + l * W;
    float* vn = (float*)c.lds;
    float* st = vn + 128 * 64;
    for (int uidx = blockIdx.x; uidx < 128 * 8; uidx += gridDim.x) {
        const int ch = uidx >> 3, g = uidx & 7; const int tok0 = ch * 128;
        for (int i = 0; i < 16; ++i) { const int s = c.wave * 16 + i; const bf16* p = ZS + (size_t)(tok0 + s) * 1024 + 512 + c.lane * 8;
            const f32x4 x0 = load4bf(p), x1 = load4bf(p + 4);
            float sm = (x0[0] + x0[1]) + (x0[2] + x0[3]) + (x1[0] + x1[1]) + (x1[2] + x1[3]); const float mean = wave_sum(sm) * (1.f / 512.f);
            float q = 0.f; for (int e = 0; e < 4; ++e) { const float d0 = x0[e] - mean, d1 = x1[e] - mean; q += d0 * d0 + d1 * d1; }
            const float rstd = 1.0f / sqrtf(wave_sum(q) * (1.f / 512.f) + LN_EPS);
            if (c.lane == 0) { st[2 * s] = mean; st[2 * s + 1] = rstd; } }
        __syncthreads();
        for (int i = c.tid; i < 128 * 64; i += NTHREADS) { const int s = i >> 6, d = i & 63; const float x = bf2f(ZS[(size_t)(tok0 + s) * 1024 + 512 + g * 64 + d]);
            vn[i] = (x - st[2 * s]) * st[2 * s + 1] * lng[g * 64 + d] + lnb[g * 64 + d]; }
        __syncthreads();
        const int d = c.tid & 63, tq = c.tid >> 6;
        const float* Wg = a.in[I_WS] + (size_t)(l * 8 + g) * 128 * 128; const float* bs = a.in[I_BS] + (size_t)(l * 8 + g) * 128;
        for (int i = 0; i < 16; ++i) { const int t = tq + 8 * i; float acc = 0.f;
            for (int s = 0; s <= t; ++s) acc += Wg[t * 128 + s] * vn[s * 64 + d];
            const float u = bf2f(ZS[(size_t)(tok0 + t) * 1024 + g * 64 + d]);
            YB[(size_t)(tok0 + t) * W + g * 64 + d] = f2bf(u * (acc + bs[t])); }
        __syncthreads();
    }
}

#define LAS3 __attribute__((address_space(3)))
typedef short bf16x8 __attribute__((ext_vector_type(8)));
template <int MT, int NT, int KS>
__device__ __forceinline__ void mma_lds_glob(const unsigned char* lds_base, int a_off_bytes, int lda, const bf16* Bt, int ldb, int n0, int lane, f32x4 (&acc)[MT][NT]) {
    const int fr = lane & 15, fq = lane >> 4;
    const LAS3 unsigned char* Ab = (const LAS3 unsigned char*)lds_base + a_off_bytes;
    int boff = (n0 + fr) * ldb + 8 * fq; asm volatile("" : "+v"(boff));
#pragma unroll
    for (int ks = 0; ks < KS; ++ks) {
        bf16x8 b[NT];
#pragma unroll
        for (int n = 0; n < NT; ++n) b[n] = *(const bf16x8*)(Bt + boff + 16 * n * ldb + 32 * ks);
#pragma unroll
        for (int m = 0; m < MT; ++m) { const bf16x8 av = *(const LAS3 bf16x8*)(Ab + ((16 * m + fr) * lda + 32 * ks + 8 * fq) * 2);
#pragma unroll
            for (int n = 0; n < NT; ++n) acc[m][n] = __builtin_amdgcn_mfma_f32_16x16x32_bf16(av, b[n], acc[m][n], 0, 0, 0); }
    }
}
__device__ __forceinline__ void zshift8(const bf16* ZR, int t, int col, const float* mu, float (&o)[8]) {
    const u32x4 zc = *(const u32x4*)(ZR + (size_t)t * RC + col);
    u32x4 zp = {0u, 0u, 0u, 0u}; if (t > 0) zp = *(const u32x4*)(ZR + (size_t)(t - 1) * RC + col);
    const f32x4 m0 = *(const f32x4*)(mu + col), m1 = *(const f32x4*)(mu + col + 4);
#pragma unroll
    for (int e = 0; e < 4; ++e) { const float c0 = __uint_as_float(zc[e] << 16), c1 = __uint_as_float(zc[e] & 0xffff0000u), p0 = __uint_as_float(zp[e] << 16), p1 = __uint_as_float(zp[e] & 0xffff0000u);
        const float mu0 = (2 * e < 4) ? m0[(2 * e) & 3] : m1[(2 * e) & 3], mu1 = (2 * e + 1 < 4) ? m0[(2 * e + 1) & 3] : m1[(2 * e + 1) & 3];
        o[2 * e] = c0 + (p0 - c0) * mu0; o[2 * e + 1] = c1 + (p1 - c1) * mu1; }
}
typedef _Float16 f16x8 __attribute__((ext_vector_type(8)));
__device__ __forceinline__ void store8f16(f16* p, const float (&v)[8]) { f16x8 h;
#pragma unroll
    for (int e = 0; e < 8; ++e) h[e] = (f16)v[e];
    *(f16x8*)p = h; }
__device__ __forceinline__ u32x4 pack8bf(const float (&v)[8]) { u32x4 w; w.x = pk2(v[0], v[1]); w.y = pk2(v[2], v[3]); w.z = pk2(v[4], v[5]); w.w = pk2(v[6], v[7]); return w; }


constexpr int PB_LD = 520;
constexpr int PB_BUF = 0, PB_AOP = 64 * PB_LD * 2, PB_VMID = 2 * 64 * PB_LD * 2, PB_LA_LD = 264, PB_VM_LD = 40;
__device__ __forceinline__ void phase_prep_fast(ArgsR a, const Ctx& c, int l) {
    const bf16* ZR = (const bf16*)(a.ws + WS_ZR);
    const float* mu = a.in[I_MU] + l * RC; const float* w0 = a.in[I_W0] + l * W; const float* a0 = a.in[I_A0] + l * W;
    const float* k_k = a.in[I_KK] + l * W; const float* k_a = a.in[I_KA] + l * W; const float* vm0 = a.in[I_VM0];
    f16* R = (f16*)(a.ws + WS_R); f16* WM1 = (f16*)(a.ws + WS_WM1); f16* KP = (f16*)(a.ws + WS_KP); f16* AA = (f16*)(a.ws + WS_AA); f16* BB = (f16*)(a.ws + WS_BB); f16* V = (f16*)(a.ws + WS_V);
    bf16* G = (bf16*)(a.ws + WS_G); bf16* VF = (bf16*)(a.ws + WS_VF);
    const unsigned char* lo = a.ws + WS_LORA + (size_t)l * LO_STRIDE;
    const bf16* W2T = (const bf16*)(lo + LO_W2T); const bf16* A2T = (const bf16*)(lo + LO_A2T); const bf16* G2T = (const bf16*)(lo + LO_G2T);
    const bf16* VM1T = (const bf16*)(lo + LO_VM1T); const bf16* VM2T = (const bf16*)(lo + LO_VM2T);
    LAS3 unsigned char* L = (LAS3 unsigned char*)c.lds;
    const int tid = c.tid, lane = c.lane, wv = c.wave, fr = lane & 15, fq = lane >> 4;
    const int row = tid >> 3, sub = tid & 7;
    for (int u = blockIdx.x; u < T / 64; u += gridDim.x) {
        const int t0 = u * 64, t = t0 + row;
        if (l == 0) {
#pragma unroll 1
            for (int p = 0; p < 8; ++p) { const int col = p * 64 + sub * 8; float z[8]; zshift8(ZR, t, 1024 + col, mu, z);
                store8f16(V + (size_t)t * W + col, z); *(u32x4*)(VF + (size_t)t * W + col) = pack8bf(z); }
        } else {
#pragma unroll 1
            for (int p = 0; p < 8; ++p) { const int col = p * 64 + sub * 8; float z[8]; zshift8(ZR, t, 1024 + col, mu, z);
                *(LAS3 u32x4*)(L + PB_AOP + (row * PB_LD + col) * 2) = pack8bf(z); }
            __syncthreads();
            { f32x4 acc[1][1]; acc[0][0] = (f32x4){0.f, 0.f, 0.f, 0.f}; const int m = wv >> 1, n = wv & 1;
              mma_lds_glob<1, 1, 16>(c.lds, PB_AOP + 16 * m * PB_LD * 2, PB_LD, VM1T, W, 16 * n, lane, acc);
#pragma unroll
              for (int i = 0; i < 4; ++i) *(LAS3 bf16*)(L + PB_VMID + ((16 * m + 4 * fq + i) * PB_VM_LD + 16 * n + fr) * 2) = f2bf(acc[0][0][i]); }
            __syncthreads();
            { f32x4 acc[4][4];
#pragma unroll
              for (int m = 0; m < 4; ++m)
#pragma unroll
                  for (int n = 0; n < 4; ++n) acc[m][n] = (f32x4){0.f, 0.f, 0.f, 0.f};
              mma_lds_glob<4, 4, 1>(c.lds, PB_VMID, PB_VM_LD, VM2T, 32, 64 * wv, lane, acc);
#pragma unroll
              for (int m = 0; m < 4; ++m)
#pragma unroll
                  for (int n = 0; n < 4; ++n) { const int col = 64 * wv + 16 * n + fr; const float vb = vm0[col];
#pragma unroll
                      for (int i = 0; i < 4; ++i) *(LAS3 f16*)(L + PB_BUF + ((16 * m + 4 * fq + i) * PB_LD + col) * 2) = (f16)sigmoidf_(vb + acc[m][n][i]); } }
            __syncthreads();
#pragma unroll 1
            for (int p = 0; p < 8; ++p) { const int col = p * 64 + sub * 8;
                const u32x4 vz = *(const LAS3 u32x4*)(L + PB_AOP + (row * PB_LD + col) * 2); const f16x8 gt = *(const LAS3 f16x8*)(L + PB_BUF + (row * PB_LD + col) * 2);
                const u32x4 vfw = *(const u32x4*)(VF + (size_t)t * W + col); float o[8];
#pragma unroll
                for (int e = 0; e < 4; ++e) { const float v0 = __uint_as_float(vz[e] << 16), v1 = __uint_as_float(vz[e] & 0xffff0000u), f0 = __uint_as_float(vfw[e] << 16), f1 = __uint_as_float(vfw[e] & 0xffff0000u);
                    o[2 * e] = v0 + (f0 - v0) * (float)gt[2 * e]; o[2 * e + 1] = v1 + (f1 - v1) * (float)gt[2 * e + 1]; }
                store8f16(V + (size_t)t * W + col, o); }
            __syncthreads();
        }
#pragma unroll 1
        for (int p = 0; p < 4; ++p) { const int cc = sub * 32 + p * 8; float z[8]; zshift8(ZR, t, 1536 + cc, mu, z);
#pragma unroll
            for (int e = 0; e < 8; ++e) z[e] = cc < 64 ? (1.0f - 2.0f / (1.0f + __expf(2.0f * z[e]))) : (cc < 128 ? z[e] : sigmoidf_(z[e]));
            *(LAS3 u32x4*)(L + PB_AOP + (row * PB_LA_LD + cc) * 2) = pack8bf(z); }
        __syncthreads();
        { f32x4 acc[4][4];
#pragma unroll
          for (int m = 0; m < 4; ++m)
#pragma unroll
              for (int n = 0; n < 4; ++n) acc[m][n] = (f32x4){0.f, 0.f, 0.f, 0.f};
          mma_lds_glob<4, 4, 2>(c.lds, PB_AOP + 64 * 2, PB_LA_LD, A2T, 64, 64 * wv, lane, acc);
#pragma unroll
          for (int m = 0; m < 4; ++m)
#pragma unroll
              for (int n = 0; n < 4; ++n) { const int col = 64 * wv + 16 * n + fr; const float ab = a0[col];
#pragma unroll
                  for (int i = 0; i < 4; ++i) *(LAS3 f16*)(L + PB_BUF + ((16 * m + 4 * fq + i) * PB_LD + col) * 2) = (f16)sigmoidf_(ab + acc[m][n][i]); } }
        __syncthreads();
#pragma unroll 1
        for (int p = 0; p < 8; ++p) { const int col = p * 64 + sub * 8; const size_t o = (size_t)t * W + col;
            float z[8]; zshift8(ZR, t, col, mu, z); store8f16(R + o, z);
            float kz[8]; zshift8(ZR, t, 512 + col, mu, kz);
            const f16x8 av = *(const LAS3 f16x8*)(L + PB_BUF + (row * PB_LD + col) * 2);
            const f32x4 kk0 = *(const f32x4*)(k_k + col), kk1 = *(const f32x4*)(k_k + col + 4), ka0 = *(const f32x4*)(k_a + col), ka1 = *(const f32x4*)(k_a + col + 4);
            float kk[8], kp[8], bb[8]; float ss = 0.f;
#pragma unroll
            for (int e = 0; e < 8; ++e) { const float kkw = e < 4 ? kk0[e & 3] : kk1[e & 3], kaw = e < 4 ? ka0[e & 3] : ka1[e & 3]; kk[e] = kz[e] * kkw; ss += kk[e] * kk[e]; kp[e] = kz[e] * (1.0f + ((float)av[e] - 1.0f) * kaw); }
            ss += __shfl_xor(ss, 1); ss += __shfl_xor(ss, 2); ss += __shfl_xor(ss, 4);
            const float inv = 1.0f / fmaxf(sqrtf(ss), 1e-12f);
#pragma unroll
            for (int e = 0; e < 8; ++e) { kk[e] *= inv; bb[e] = kk[e] * (float)av[e]; kk[e] = -kk[e]; }
            store8f16(KP + o, kp); store8f16(AA + o, kk); store8f16(BB + o, bb); }
        __syncthreads();
        { f32x4 acc[4][4];
#pragma unroll
          for (int m = 0; m < 4; ++m)
#pragma unroll
              for (int n = 0; n < 4; ++n) acc[m][n] = (f32x4){0.f, 0.f, 0.f, 0.f};
          mma_lds_glob<4, 4, 2>(c.lds, PB_AOP, PB_LA_LD, W2T, 64, 64 * wv, lane, acc);
#pragma unroll
          for (int m = 0; m < 4; ++m)
#pragma unroll
              for (int n = 0; n < 4; ++n) { const int col = 64 * wv + 16 * n + fr; const float wb = w0[col];
#pragma unroll
                  for (int i = 0; i < 4; ++i) { const float x = wb + acc[m][n][i]; const float wl = -softplusf_(-x) - 0.5f; *(LAS3 f16*)(L + PB_BUF + ((16 * m + 4 * fq + i) * PB_LD + col) * 2) = (f16)expm1f(-__expf(wl)); } } }
        __syncthreads();
#pragma unroll 1
        for (int p = 0; p < 8; ++p) { const int col = p * 64 + sub * 8; *(u32x4*)(WM1 + (size_t)t * W + col) = *(const LAS3 u32x4*)(L + PB_BUF + (row * PB_LD + col) * 2); }
        __syncthreads();
        { f32x4 acc[4][4];
#pragma unroll
          for (int m = 0; m < 4; ++m)
#pragma unroll
              for (int n = 0; n < 4; ++n) acc[m][n] = (f32x4){0.f, 0.f, 0.f, 0.f};
          mma_lds_glob<4, 4, 4>(c.lds, PB_AOP + 128 * 2, PB_LA_LD, G2T, 128, 64 * wv, lane, acc);
#pragma unroll
          for (int m = 0; m < 4; ++m)
#pragma unroll
              for (int n = 0; n < 4; ++n) { const int col = 64 * wv + 16 * n + fr;
#pragma unroll
                  for (int i = 0; i < 4; ++i) *(LAS3 bf16*)(L + PB_BUF + ((16 * m + 4 * fq + i) * PB_LD + col) * 2) = f2bf(acc[m][n][i]); } }
        __syncthreads();
#pragma unroll 1
        for (int p = 0; p < 8; ++p) { const int col = p * 64 + sub * 8; *(u32x4*)(G + (size_t)t * W + col) = *(const LAS3 u32x4*)(L + PB_BUF + (row * PB_LD + col) * 2); }
        __syncthreads();
    }
}

constexpr int SG_LD = 136;
constexpr int SG_VT = 0, SG_ST = 256 * SG_LD * 2;
__device__ __forceinline__ void phase_sg_fast(ArgsR a, const Ctx& c, int l) {
    const bf16* ZS = (const bf16*)(a.ws + WS_ZS); bf16* YB = (bf16*)(a.ws + WS_YB);
    const float* lng = a.in[I_SGG] + l * W; const float* lnb = a.in[I_SGB] + l * W;
    LAS3 unsigned char* L = (LAS3 unsigned char*)c.lds;
    LAS3 float* st = (LAS3 float*)(L + SG_ST);
    const int tid = c.tid, lane = c.lane, wv = c.wave, fr = lane & 15, fq = lane >> 4;
    for (int u = blockIdx.x; u < 256; u += gridDim.x) {
        const int ch = u >> 1, hf = u & 1, tok0 = ch * 128;
        for (int i = 0; i < 16; ++i) { const int sidx = wv * 16 + i; const bf16* p = ZS + (size_t)(tok0 + sidx) * 1024 + 512 + lane * 8;
            const f32x4 x0 = load4bf(p), x1 = load4bf(p + 4);
            const float sm = (x0[0] + x0[1]) + (x0[2] + x0[3]) + (x1[0] + x1[1]) + (x1[2] + x1[3]); const float mean = wave_sum(sm) * (1.f / 512.f);
            float q = 0.f;
#pragma unroll
            for (int e = 0; e < 4; ++e) { const float d0 = x0[e] - mean, d1 = x1[e] - mean; q += d0 * d0 + d1 * d1; }
            const float rstd = 1.0f / sqrtf(wave_sum(q) * (1.f / 512.f) + LN_EPS);
            if (lane == 0) { st[2 * sidx] = mean; st[2 * sidx + 1] = rstd; } }
        __syncthreads();
        { const int sidx = tid >> 2, q4 = tid & 3; const float mean = st[2 * sidx], rstd = st[2 * sidx + 1];
#pragma unroll
          for (int p = 0; p < 8; ++p) { const int cl = q4 * 64 + p * 8; const int cg = hf * 256 + cl;
              const bf16* src = ZS + (size_t)(tok0 + sidx) * 1024 + 512 + cg; const f32x4 x0 = load4bf(src), x1 = load4bf(src + 4);
              const f32x4 g0 = *(const f32x4*)(lng + cg), g1 = *(const f32x4*)(lng + cg + 4), b0 = *(const f32x4*)(lnb + cg), b1 = *(const f32x4*)(lnb + cg + 4);
#pragma unroll
              for (int e = 0; e < 8; ++e) { const float x = e < 4 ? x0[e & 3] : x1[e & 3], gg = e < 4 ? g0[e & 3] : g1[e & 3], bb = e < 4 ? b0[e & 3] : b1[e & 3];
                  *(LAS3 bf16*)(L + SG_VT + ((cl + e) * SG_LD + sidx) * 2) = f2bf((x - mean) * rstd * gg + bb); } } }
        __syncthreads();
        const int gl = wv >> 1, dh = wv & 1, g = hf * 4 + gl;
        const float* Wg = a.in[I_WS] + (size_t)(l * 8 + g) * 128 * 128; const float* bs = a.in[I_BS] + (size_t)(l * 8 + g) * 128;
        f32x4 acc[8][2];
#pragma unroll
        for (int m = 0; m < 8; ++m) { acc[m][0] = (f32x4){0.f, 0.f, 0.f, 0.f}; acc[m][1] = (f32x4){0.f, 0.f, 0.f, 0.f}; }
#pragma unroll
        for (int ks = 0; ks < 4; ++ks) {
            bf16x8 b[2];
#pragma unroll
            for (int n = 0; n < 2; ++n) b[n] = *(const LAS3 bf16x8*)(L + SG_VT + ((gl * 64 + dh * 32 + 16 * n + fr) * SG_LD + 32 * ks + 8 * fq) * 2);
#pragma unroll
            for (int m = 0; m < 8; ++m) { if (32 * ks <= 16 * m + 15) {
                const int trow = 16 * m + fr, s0 = 32 * ks + 8 * fq;
                const f32x4 w0v = *(const f32x4*)(Wg + trow * 128 + s0), w1v = *(const f32x4*)(Wg + trow * 128 + s0 + 4);
                float wf[8];
#pragma unroll
                for (int e = 0; e < 8; ++e) { const float wval = e < 4 ? w0v[e & 3] : w1v[e & 3]; wf[e] = (s0 + e <= trow) ? wval : 0.f; }
                const u32x4 wp = pack8bf(wf); const bf16x8 av = __builtin_bit_cast(bf16x8, wp);
                acc[m][0] = __builtin_amdgcn_mfma_f32_16x16x32_bf16(av, b[0], acc[m][0], 0, 0, 0);
                acc[m][1] = __builtin_amdgcn_mfma_f32_16x16x32_bf16(av, b[1], acc[m][1], 0, 0, 0); } }
        }
#pragma unroll
        for (int m = 0; m < 8; ++m)
#pragma unroll
            for (int i = 0; i < 4; ++i) { const int trow = 16 * m + 4 * fq + i; const float bsv = bs[trow];
#pragma unroll
                for (int n = 0; n < 2; ++n) { const int col = g * 64 + dh * 32 + 16 * n + fr; const float uu = bf2f(ZS[(size_t)(tok0 + trow) * 1024 + col]);
                    YB[(size_t)(tok0 + trow) * W + col] = f2bf(uu * (acc[m][n][i] + bsv)); } }
        __syncthreads();
    }
}

__device__ __forceinline__ void phase_scan_simple(ArgsR a, const Ctx& c) {
    if (c.wave != 0 || blockIdx.x >= NH) return;
    const int h = blockIdx.x, lane = c.lane;
    const f16* R = (const f16*)(a.ws + WS_R); const f16* WM1 = (const f16*)(a.ws + WS_WM1); const f16* KP = (const f16*)(a.ws + WS_KP);
    const f16* AA = (const f16*)(a.ws + WS_AA); const f16* BB = (const f16*)(a.ws + WS_BB); const f16* V = (const f16*)(a.ws + WS_V);
    bf16* YSC = (bf16*)(a.ws + WS_YSC);
    float S[64];
#pragma unroll
    for (int j = 0; j < 64; ++j) S[j] = 0.f;
    for (int t = 0; t < T; ++t) {
        const size_t base = (size_t)t * W + h * 64;
        const float vv = (float)V[base + lane];
        float sa = 0.f;
#pragma unroll
        for (int j = 0; j < 64; ++j) sa += S[j] * (float)AA[base + j];
        float y = 0.f;
#pragma unroll
        for (int j = 0; j < 64; ++j) { float s = S[j]; s = s + s * (float)WM1[base + j]; s += sa * (float)BB[base + j]; s += vv * (float)KP[base + j]; S[j] = s; y += s * (float)R[base + j]; }
        YSC[base + lane] = f2bf(y);
    }
}

typedef unsigned u32x16 __attribute__((ext_vector_type(16)));
__device__ __forceinline__ void sload32(const void* p0, u32x16& a0, u32x16& a1) {
    asm volatile("s_load_dwordx16 %0, %2, 0x0 glc\n\ts_load_dwordx16 %1, %2, 0x40 glc\n\ts_waitcnt lgkmcnt(0)" : "=&s"(a0), "=&s"(a1) : "s"(p0) : "memory");
}
__device__ __forceinline__ void sload64(const void* p0, const void* p1, u32x16& a0, u32x16& a1, u32x16& b0, u32x16& b1) {
    asm volatile("s_load_dwordx16 %0, %4, 0x0 glc\n\ts_load_dwordx16 %1, %4, 0x40 glc\n\ts_load_dwordx16 %2, %5, 0x0 glc\n\ts_load_dwordx16 %3, %5, 0x40 glc\n\ts_waitcnt lgkmcnt(0)"
                 : "=&s"(a0), "=&s"(a1), "=&s"(b0), "=&s"(b1) : "s"(p0), "s"(p1) : "memory");
}
__device__ __forceinline__ float fmix_lo(unsigned sd, float x, float y) { float d; asm("v_fma_mix_f32 %0, %1, %2, %3 op_sel_hi:[1,0,0]" : "=v"(d) : "s"(sd), "v"(x), "v"(y)); return d; }
__device__ __forceinline__ float fmix_hi(unsigned sd, float x, float y) { float d; asm("v_fma_mix_f32 %0, %1, %2, %3 op_sel:[1,0,0] op_sel_hi:[1,0,0]" : "=v"(d) : "s"(sd), "v"(x), "v"(y)); return d; }
constexpr int CL = 64, NCH = T / CL;
constexpr size_t ST_Q_OFF = (size_t)NH * NCH * 64 * 64;
constexpr size_t ST_S_OFF = (size_t)NH * NCH * 64 * 64;

__device__ __forceinline__ void phase_scan1(ArgsR a, const Ctx& c) {
    const f16* WM1 = (const f16*)(a.ws + WS_WM1); const f16* KP = (const f16*)(a.ws + WS_KP);
    const f16* AA = (const f16*)(a.ws + WS_AA); const f16* BB = (const f16*)(a.ws + WS_BB); const f16* V = (const f16*)(a.ws + WS_V);
    float* ST = (float*)(a.ws + WS_ST);
    const int lane = c.lane;
    for (int item = c.gw; item < NH * NCH; item += c.ngw) {
        const int h = __builtin_amdgcn_readfirstlane(item / NCH), ch = __builtin_amdgcn_readfirstlane(item % NCH);
        float Q[64], P[64];
#pragma unroll
        for (int j = 0; j < 64; ++j) { Q[j] = 0.f; P[j] = (j == lane) ? 1.f : 0.f; }
        for (int t = ch * CL; t < ch * CL + CL; ++t) {
            const size_t base = (size_t)t * W + h * 64;
            const float vv = (float)V[base + lane];
            float q0 = 0.f, q1 = 0.f, p0 = 0.f, p1 = 0.f;
            { u32x16 a0, a1; sload32(AA + base, a0, a1);
#pragma unroll
              for (int e = 0; e < 32; ++e) { const int j = 2 * e; const unsigned av = e < 16 ? a0[e & 15] : a1[e & 15];
                  q0 = fmix_lo(av, Q[j], q0); q1 = fmix_hi(av, Q[j + 1], q1); p0 = fmix_lo(av, P[j], p0); p1 = fmix_hi(av, P[j + 1], p1); } }
            const float saq = q0 + q1, sap = p0 + p1;
            { u32x16 w0, w1, b0, b1; sload64(WM1 + base, BB + base, w0, w1, b0, b1);
#pragma unroll
              for (int e = 0; e < 32; ++e) { const int j = 2 * e; const unsigned wv = e < 16 ? w0[e & 15] : w1[e & 15], bv = e < 16 ? b0[e & 15] : b1[e & 15];
                  float s = Q[j]; s = fmix_lo(wv, s, s); s = fmix_lo(bv, saq, s); Q[j] = s;
                  float s2 = Q[j + 1]; s2 = fmix_hi(wv, s2, s2); s2 = fmix_hi(bv, saq, s2); Q[j + 1] = s2;
                  float u = P[j]; u = fmix_lo(wv, u, u); u = fmix_lo(bv, sap, u); P[j] = u;
                  float u2 = P[j + 1]; u2 = fmix_hi(wv, u2, u2); u2 = fmix_hi(bv, sap, u2); P[j + 1] = u2; } }
            { u32x16 k0, k1; sload32(KP + base, k0, k1);
#pragma unroll
              for (int e = 0; e < 32; ++e) { const int j = 2 * e; const unsigned kv = e < 16 ? k0[e & 15] : k1[e & 15];
                  Q[j] = fmix_lo(kv, vv, Q[j]); Q[j + 1] = fmix_hi(kv, vv, Q[j + 1]); } }
        }
        float* Qp = ST + ST_Q_OFF + ((size_t)(h * NCH + ch) * 64 + lane) * 64;
        bf16* PTp = (bf16*)ST + (size_t)(h * NCH + ch) * 4096 + lane;
#pragma unroll
        for (int j = 0; j < 64; ++j) PTp[j * 64] = f2bf(P[j]);
#pragma unroll
        for (int j = 0; j < 64; j += 4) *(f32x4*)(Qp + j) = (f32x4){Q[j], Q[j + 1], Q[j + 2], Q[j + 3]};
    }
}
__device__ __forceinline__ void phase_scan2_simple(ArgsR a, const Ctx& c) {
    float* ST = (float*)(a.ws + WS_ST);
    for (int item = c.gw; item < NH * 64; item += c.ngw) {
        const int h = item >> 6, v = item & 63;
        float S = 0.f;
        for (int ch = 0; ch < NCH; ++ch) {
            const float* Pc = ST + (size_t)(h * NCH + ch) * 4096; float* Qc = ST + ST_Q_OFF + (size_t)(h * NCH + ch) * 4096 + v * 64;
            float acc0 = Qc[c.lane], acc1 = 0.f;
#pragma unroll
            for (int k = 0; k < 64; k += 2) { acc0 += __shfl(S, k) * Pc[k * 64 + c.lane]; acc1 += __shfl(S, k + 1) * Pc[(k + 1) * 64 + c.lane]; }
            S = acc0 + acc1;
            Qc[c.lane] = S;
        }
    }
}
struct Sc2Set { bf16x8 b[2][2]; float q[2][4]; };
__device__ __forceinline__ void sc2_load(Sc2Set& s, const bf16* PTc, const float* Qc, int boff, int qoff) {
#pragma unroll
    for (int ks = 0; ks < 2; ++ks)
#pragma unroll
        for (int n = 0; n < 2; ++n) s.b[ks][n] = *(const bf16x8*)(PTc + boff + 16 * n * 64 + 32 * ks);
#pragma unroll
    for (int n = 0; n < 2; ++n)
#pragma unroll
        for (int i = 0; i < 4; ++i) s.q[n][i] = Qc[qoff + i * 64 + 16 * n];
}
__device__ __forceinline__ void sc2_step(const Sc2Set& s, bf16* Sc, const LAS3 unsigned char* img, LAS3 unsigned char* imgn, int m, int n0, int fr, int fq, int qoff) {
    constexpr int IMG_LD = 72;
    f32x4 acc[2];
#pragma unroll
    for (int n = 0; n < 2; ++n) acc[n] = (f32x4){s.q[n][0], s.q[n][1], s.q[n][2], s.q[n][3]};
#pragma unroll
    for (int ks = 0; ks < 2; ++ks) { const bf16x8 av = *(const LAS3 bf16x8*)(img + ((16 * m + fr) * IMG_LD + 32 * ks + 8 * fq) * 2);
#pragma unroll
        for (int n = 0; n < 2; ++n) acc[n] = __builtin_amdgcn_mfma_f32_16x16x32_bf16(av, s.b[ks][n], acc[n], 0, 0, 0); }
#pragma unroll
    for (int n = 0; n < 2; ++n)
#pragma unroll
        for (int i = 0; i < 4; ++i) { const bf16 sv = f2bf(acc[n][i]); Sc[qoff + i * 64 + 16 * n] = sv; *(LAS3 bf16*)(imgn + ((16 * m + 4 * fq + i) * IMG_LD + n0 + 16 * n + fr) * 2) = sv; }
    asm volatile("s_waitcnt lgkmcnt(0)" ::: "memory"); __builtin_amdgcn_s_barrier(); asm volatile("" ::: "memory");
}
__device__ __forceinline__ void phase_scan2_mfma(ArgsR a, const Ctx& c) {
    if (blockIdx.x >= NH) return;
    const int h = blockIdx.x, lane = c.lane, wv = c.wave, fr = lane & 15, fq = lane >> 4, m = wv >> 1, n0 = 32 * (wv & 1);
    const bf16* PT = (const bf16*)(a.ws + WS_ST) + (size_t)h * NCH * 4096;
    const float* QS = (const float*)(a.ws + WS_ST) + ST_Q_OFF + (size_t)h * NCH * 4096;
    bf16* SS = (bf16*)(a.ws + WS_ST) + ST_S_OFF + (size_t)h * NCH * 4096;
    LAS3 unsigned char* L = (LAS3 unsigned char*)c.lds;
    constexpr int IMG_BYTES = 64 * 72 * 2;
    for (int i = c.tid; i < IMG_BYTES / 4; i += NTHREADS) ((LAS3 unsigned*)L)[i] = 0u;
    __syncthreads();
    const int boff = (n0 + fr) * 64 + 8 * fq, qoff = (16 * m + 4 * fq) * 64 + n0 + fr;
    Sc2Set s0, s1, s2, s3;
    sc2_load(s0, PT, QS, boff, qoff); sc2_load(s1, PT + 4096, QS + 4096, boff, qoff); sc2_load(s2, PT + 2 * 4096, QS + 2 * 4096, boff, qoff); sc2_load(s3, PT + 3 * 4096, QS + 3 * 4096, boff, qoff);
    LAS3 unsigned char* i0 = L; LAS3 unsigned char* i1 = L + IMG_BYTES;
    for (int ch = 0; ch < NCH; ch += 4) {
        const int cn = (ch + 4 < NCH) ? ch + 4 : ch;
        sc2_step(s0, SS + (size_t)(ch + 0) * 4096, i0, i1, m, n0, fr, fq, qoff); sc2_load(s0, PT + (size_t)(cn + 0) * 4096, QS + (size_t)(cn + 0) * 4096, boff, qoff);
        sc2_step(s1, SS + (size_t)(ch + 1) * 4096, i1, i0, m, n0, fr, fq, qoff); sc2_load(s1, PT + (size_t)(cn + 1) * 4096, QS + (size_t)(cn + 1) * 4096, boff, qoff);
        sc2_step(s2, SS + (size_t)(ch + 2) * 4096, i0, i1, m, n0, fr, fq, qoff); sc2_load(s2, PT + (size_t)(cn + 2) * 4096, QS + (size_t)(cn + 2) * 4096, boff, qoff);
        sc2_step(s3, SS + (size_t)(ch + 3) * 4096, i1, i0, m, n0, fr, fq, qoff); sc2_load(s3, PT + (size_t)(cn + 3) * 4096, QS + (size_t)(cn + 3) * 4096, boff, qoff);
    }
}
__device__ __forceinline__ void phase_scan3(ArgsR a, const Ctx& c) {
    const f16* R = (const f16*)(a.ws + WS_R); const f16* WM1 = (const f16*)(a.ws + WS_WM1); const f16* KP = (const f16*)(a.ws + WS_KP);
    const f16* AA = (const f16*)(a.ws + WS_AA); const f16* BB = (const f16*)(a.ws + WS_BB); const f16* V = (const f16*)(a.ws + WS_V);
    const float* ST = (const float*)(a.ws + WS_ST); bf16* YSC = (bf16*)(a.ws + WS_YSC);
    const int lane = c.lane;
    for (int item = c.gw; item < NH * NCH; item += c.ngw) {
        const int h = __builtin_amdgcn_readfirstlane(item / NCH), ch = __builtin_amdgcn_readfirstlane(item % NCH);
        float S[64];
        if (ch == 0) {
#pragma unroll
            for (int j = 0; j < 64; ++j) S[j] = 0.f;
        } else { const bf16* Sp = (const bf16*)ST + ST_S_OFF + ((size_t)(h * NCH + ch - 1) * 64 + lane) * 64;
#pragma unroll
            for (int j = 0; j < 64; j += 4) { const f32x4 x = load4bf(Sp + j); S[j] = x[0]; S[j + 1] = x[1]; S[j + 2] = x[2]; S[j + 3] = x[3]; } }
        for (int t = ch * CL; t < ch * CL + CL; ++t) {
            const size_t base = (size_t)t * W + h * 64;
            const float vv = (float)V[base + lane];
            float s0 = 0.f, s1 = 0.f;
            { u32x16 a0, a1; sload32(AA + base, a0, a1);
#pragma unroll
              for (int e = 0; e < 32; ++e) { const int j = 2 * e; const unsigned av = e < 16 ? a0[e & 15] : a1[e & 15]; s0 = fmix_lo(av, S[j], s0); s1 = fmix_hi(av, S[j + 1], s1); } }
            const float sa = s0 + s1;
            { u32x16 w0, w1, b0, b1; sload64(WM1 + base, BB + base, w0, w1, b0, b1);
#pragma unroll
              for (int e = 0; e < 32; ++e) { const int j = 2 * e; const unsigned wv = e < 16 ? w0[e & 15] : w1[e & 15], bv = e < 16 ? b0[e & 15] : b1[e & 15];
                  float s = S[j]; s = fmix_lo(wv, s, s); s = fmix_lo(bv, sa, s); S[j] = s;
                  float s2 = S[j + 1]; s2 = fmix_hi(wv, s2, s2); s2 = fmix_hi(bv, sa, s2); S[j + 1] = s2; } }
            float y0 = 0.f, y1 = 0.f;
            { u32x16 k0, k1, r0, r1; sload64(KP + base, R + base, k0, k1, r0, r1);
#pragma unroll
              for (int e = 0; e < 32; ++e) { const int j = 2 * e; const unsigned kv = e < 16 ? k0[e & 15] : k1[e & 15], rv = e < 16 ? r0[e & 15] : r1[e & 15];
                  const float s = fmix_lo(kv, vv, S[j]); S[j] = s; y0 = fmix_lo(rv, s, y0);
                  const float s2 = fmix_hi(kv, vv, S[j + 1]); S[j + 1] = s2; y1 = fmix_hi(rv, s2, y1); } }
            YSC[base + lane] = f2bf(y0 + y1);
        }
    }
}

__device__ __forceinline__ void phase_post(ArgsR a, const Ctx& c, int l) {
    const bf16* YSC = (const bf16*)(a.ws + WS_YSC); const f16* R = (const f16*)(a.ws + WS_R); const f16* KP = (const f16*)(a.ws + WS_KP); const f16* V = (const f16*)(a.ws + WS_V);
    const bf16* G = (const bf16*)(a.ws + WS_G); bf16* YA = (bf16*)(a.ws + WS_YA);
    const float* gng = a.in[I_GNG] + l * W; const float* gnb = a.in[I_GNB] + l * W; const float* rk = a.in[I_RK] + l * W;
    for (int t = c.gw; t < T; t += c.ngw) {
#pragma unroll
        for (int i = 0; i < 8; ++i) { const int n = c.lane + 64 * i; const size_t o = (size_t)t * W + n;
            const float y = bf2f(YSC[o]); const float mean = wave_sum(y) * (1.f / 64.f); const float d = y - mean; const float var = wave_sum(d * d) * (1.f / 64.f);
            float yn = d * (1.0f / sqrtf(var + GN_EPS)) * gng[n] + gnb[n];
            const float r = (float)R[o], k = (float)KP[o], v = (float)V[o];
            const float bonus = wave_sum(r * k * rk[n]);
            yn += bonus * v;
            YA[o] = f2bf(yn * bf2f(G[o])); }
    }
}

__device__ __forceinline__ void phase_ln1(ArgsR a, const Ctx& c, int l, float* outw) {
    const float* MODF = (const float*)(a.ws + WS_MODF) + l * 6144;
    const float* g1 = a.in[I_LN1G] + l * D; const float* b1 = a.in[I_LN1B] + l * D;
    bf16* XN = (bf16*)(a.ws + WS_XN);
    int* TOKI = (int*)(a.ws + WS_TOKI); float* TOKW = (float*)(a.ws + WS_TOKW); int* TOKP = (int*)(a.ws + WS_TOKP);
    const float* rw = a.in[I_RW]; const float* rb = a.in[I_RB];
    unsigned* lcnt = (unsigned*)(c.lds + 131072);
    if (c.tid < NE) lcnt[c.tid] = 0u;
    __syncthreads();
    for (int m = c.gw; m < T; m += c.ngw) {
        float v[16]; load_row16(a.out + (size_t)m * D, c.lane, v);
        float mean, rstd; row_stats(v, mean, rstd);
#pragma unroll
        for (int j = 0; j < 4; ++j) { f32x4 o; const int col = 4 * c.lane + 256 * j;
#pragma unroll
            for (int e = 0; e < 4; ++e) { v[4 * j + e] = (v[4 * j + e] - mean) * rstd * g1[col + e] + b1[col + e]; o[e] = v[4 * j + e]; }
            *(f32x4*)(outw + (size_t)m * D + col) = o; }
        row_stats(v, mean, rstd);
        float lg[16];
#pragma unroll
        for (int e = 0; e < 16; ++e) lg[e] = 0.f;
#pragma unroll
        for (int j = 0; j < 4; ++j) { f32x4 o; const int col = 4 * c.lane + 256 * j;
#pragma unroll
            for (int e = 0; e < 4; ++e) { const float h = (v[4 * j + e] - mean) * rstd * (1.0f + MODF[4096 + col + e]) + MODF[3072 + col + e]; o[e] = h;
                const f32x4* rr = (const f32x4*)(rw + (size_t)(col + e) * NE);
#pragma unroll
                for (int q = 0; q < 4; ++q) { const f32x4 r4 = rr[q]; lg[4 * q] += h * r4[0]; lg[4 * q + 1] += h * r4[1]; lg[4 * q + 2] += h * r4[2]; lg[4 * q + 3] += h * r4[3]; } }
            store4bf(XN + (size_t)m * D + col, o); }
        float sc[16], sel[16];
#pragma unroll
        for (int e = 0; e < 16; ++e) { sc[e] = 1.0f / (1.0f + expf(-wave_sum(lg[e]))); sel[e] = sc[e] + rb[e]; }
        int best = 0; float bestv = -INFINITY;
#pragma unroll
        for (int g = 0; g < 4; ++g) { float m1 = -INFINITY, m2 = -INFINITY;
#pragma unroll
            for (int q = 0; q < 4; ++q) { const float s = sel[4 * g + q]; if (s > m1) { m2 = m1; m1 = s; } else if (s > m2) m2 = s; }
            const float gs = m1 + m2; if (gs > bestv) { bestv = gs; best = g; } }
        int i1 = 0, i2 = 0; float s1 = -INFINITY, s2 = -INFINITY, w1 = 0.f, w2 = 0.f;
#pragma unroll
        for (int e = 0; e < 16; ++e) { if ((e >> 2) == best) { const float s = sel[e];
                if (s > s1) { s2 = s1; i2 = i1; w2 = w1; s1 = s; i1 = e; w1 = sc[e]; } else if (s > s2) { s2 = s; i2 = e; w2 = sc[e]; } } }
        if (c.lane == 0) { const float ws = w1 + w2;
            TOKI[2 * m] = i1; TOKI[2 * m + 1] = i2; TOKW[2 * m] = w1 / ws; TOKW[2 * m + 1] = w2 / ws;
            TOKP[2 * m] = (int)atomicAdd(&lcnt[i1], 1u); TOKP[2 * m + 1] = (int)atomicAdd(&lcnt[i2], 1u); }
    }
    __syncthreads();
    if (c.tid < NE) ((int*)(a.ws + WS_BLKCNT))[blockIdx.x * NE + c.tid] = (int)lcnt[c.tid];
    __syncthreads();
    float* scr = (float*)(c.lds + c.wave * 16384);
    bf16* WGU = (bf16*)(a.ws + WS_WGU); bf16* WD = (bf16*)(a.ws + WS_WD);
    constexpr int IG = (D / 64) * (FF / 32);
    constexpr int ID = (FF / 64) * (D / 32);
    for (int it = c.gw; it < NE * (2 * IG + ID); it += c.ngw) {
        const int e = it / (2 * IG + ID); int r = it % (2 * IG + ID);
        const size_t eo = ((size_t)l * NE + e) * (size_t)D * FF;
        if (r < IG) { transpose_matrix_item(a.in[I_EG] + eo, D, FF, WGU + (size_t)e * 1024 * 1024, r, scr, c.lane, RowGU{0}); continue; } r -= IG;
        if (r < IG) { transpose_matrix_item(a.in[I_EU] + eo, D, FF, WGU + (size_t)e * 1024 * 1024, r, scr, c.lane, RowGU{1}); continue; } r -= IG;
        transpose_matrix_item(a.in[I_ED] + eo, FF, D, WD + (size_t)e * 1024 * 512, r, scr, c.lane, RowId());
    }
}

__device__ __forceinline__ void phase_perm(ArgsR a, const Ctx& c, int l) {
    const int* BLKCNT = (const int*)(a.ws + WS_BLKCNT);
    LAS3 int* pre = (LAS3 int*)c.lds;
    LAS3 int* tot = pre + 256 * NE;
    const int nb = gridDim.x;
#pragma unroll
    for (int q = 0; q < 2; ++q) { const int e = 2 * c.wave + q; int v[4]; int sum = 0;
#pragma unroll
        for (int i = 0; i < 4; ++i) { const int b = 4 * c.lane + i; v[i] = b < nb ? BLKCNT[b * NE + e] : 0; sum += v[i]; }
        int inc = sum;
#pragma unroll
        for (int o = 1; o < 64; o <<= 1) { const int t = __shfl_up(inc, o); if (c.lane >= o) inc += t; }
        int run = inc - sum;
#pragma unroll
        for (int i = 0; i < 4; ++i) { pre[(4 * c.lane + i) * NE + e] = run; run += v[i]; }
        if (c.lane == 63) tot[e] = inc; }
    __syncthreads();
    int ts[17]; { int sacc = 0;
#pragma unroll
        for (int e = 0; e < 16; ++e) { ts[e] = sacc; sacc += (tot[e] + 255) >> 8; } ts[16] = sacc; }
    if (blockIdx.x == 0 && c.tid < NE) ((int*)(a.ws + WS_TOT))[c.tid] = tot[c.tid];
    const int* TOKI = (const int*)(a.ws + WS_TOKI); const int* TOKP = (const int*)(a.ws + WS_TOKP); int* S2T = (int*)(a.ws + WS_S2T);
    const bf16* XN = (const bf16*)(a.ws + WS_XN); bf16* XS = (bf16*)(a.ws + WS_XS);
    for (int as = c.gw; as < 2 * T; as += c.ngw) {
        const int e = TOKI[as]; int base = 0;
#pragma unroll
        for (int j = 0; j < 16; ++j) base = (j == e) ? ts[j] : base;
        const int m = as >> 1, blk = (m % c.ngw) >> 3;
        const int slot = base * 256 + pre[blk * NE + e] + TOKP[as];
        if (c.lane == 0) S2T[slot] = as;
        const u32x4* src = (const u32x4*)(XN + (size_t)m * D); u32x4* dst = (u32x4*)(XS + (size_t)slot * D);
        dst[c.lane] = src[c.lane]; dst[64 + c.lane] = src[64 + c.lane];
    }
    for (int e = 0; e < 16; ++e) {
        int tse = 0, tsn = 0;
#pragma unroll
        for (int j = 0; j < 16; ++j) { tse = (j == e) ? ts[j] : tse; tsn = (j == e) ? ts[j + 1] : tsn; }
        const int lo = tse * 256 + tot[e], hi = tsn * 256;
        for (int sl = lo + c.gw; sl < hi; sl += c.ngw) { if (c.lane == 0) S2T[sl] = -1; u32x4* dst = (u32x4*)(XS + (size_t)sl * D); const u32x4 zz = {0u, 0u, 0u, 0u}; dst[c.lane] = zz; dst[64 + c.lane] = zz; }
    }
    __syncthreads();
}

__device__ __forceinline__ void phase_ln2(ArgsR a, const Ctx& c, int l, float* outw) {
    const float* MODF = (const float*)(a.ws + WS_MODF) + l * 6144;
    const float* g2 = a.in[I_LN2G] + l * D; const float* b2 = a.in[I_LN2B] + l * D;
    const bf16* Y = (const bf16*)(a.ws + WS_Y); bf16* XN = (bf16*)(a.ws + WS_XN);
    for (int m = c.gw; m < T; m += c.ngw) {
        float v[16]; load_row16(a.out + (size_t)m * D, c.lane, v);
#pragma unroll
        for (int j = 0; j < 4; ++j) { const int col = 4 * c.lane + 256 * j; const f32x4 y0 = load4bf(Y + (size_t)(2 * m) * D + col), y1 = load4bf(Y + (size_t)(2 * m + 1) * D + col);
#pragma unroll
            for (int e = 0; e < 4; ++e) v[4 * j + e] = ALPHA * v[4 * j + e] + (1.0f + MODF[5120 + col + e]) * (y0[e] + y1[e]); }
        float mean, rstd; row_stats(v, mean, rstd);
#pragma unroll
        for (int j = 0; j < 4; ++j) { f32x4 o; const int col = 4 * c.lane + 256 * j;
#pragma unroll
            for (int e = 0; e < 4; ++e) { v[4 * j + e] = (v[4 * j + e] - mean) * rstd * g2[col + e] + b2[col + e]; o[e] = v[4 * j + e]; }
            *(f32x4*)(outw + (size_t)m * D + col) = o; }
        if (l + 1 < DEPTH) {
            const float* MN = MODF + 6144;
            row_stats(v, mean, rstd);
#pragma unroll
            for (int j = 0; j < 4; ++j) { f32x4 o; const int col = 4 * c.lane + 256 * j;
#pragma unroll
                for (int e = 0; e < 4; ++e) o[e] = (v[4 * j + e] - mean) * rstd * (1.0f + MN[1024 + col + e]) + MN[col + e];
                store4bf(XN + (size_t)m * D + col, o); }
        }
    }
}


template <class F> struct EpiAdapt {
    static constexpr bool PERM = false, AFTER_DRAIN = false; F f;
    __device__ __forceinline__ void operator()(const f32x4 (&acc)[2][2][4][2], const Unit& u, int wr, int wc, int fr, int fq) const {
#pragma unroll
        for (int ai = 0; ai < 2; ++ai)
#pragma unroll
            for (int m = 0; m < 4; ++m) { const int row = u.pm * 256 + ai * 128 + wr * 64 + m * 16 + fr;
#pragma unroll
                for (int n = 0; n < 2; ++n) { const int col = u.pn * 256 + wc * 32 + n * 16 + 4 * fq; f(row, col, acc[ai][0][m][n], acc[ai][1][m][n]); } }
    }
};

#ifndef USE_PG8
#define USE_PG8 1
#endif
template <class Sched, class F>
__device__ __forceinline__ void gemm_any(const Ctx& c, const bf16* A, const bf16* Bt, int M, int N, int K, const Sched& S, const F& f) {
#if USE_PG8
    pg8::Gemm g{A, Bt, M, N, K}; EpiAdapt<F> E{f};
    pg8::gemm_phase<EpiAdapt<F>, Sched, true, true>((PG8_LAS unsigned char*)c.lds, g, S, E);
#else
    gemm_simple(c, A, Bt, K, S, f);
#endif
}

#define LAS __attribute__((address_space(3)))
#define XB_TMO      128
#define XB_XCNT(j)  (256  + 64 * (j))
#define XB_XSUB(j)  (1280 + 64 * (j))
#define XB_XGEN(j)  (2304 + 64 * (j))
#define XB_TOP      3328
#define XB_TOPGEN   3392
#define XCD_BAR_WORDS 3456
#define XB_SPIN_CAP (1u << 24)

__device__ __forceinline__ unsigned xb_ld(unsigned* p)              { return __hip_atomic_load(p, __ATOMIC_RELAXED, __HIP_MEMORY_SCOPE_AGENT); }
__device__ __forceinline__ unsigned xb_add(unsigned* p, unsigned v) { return __hip_atomic_fetch_add(p, v, __ATOMIC_RELAXED, __HIP_MEMORY_SCOPE_AGENT); }
__device__ __forceinline__ unsigned xb_xcc_id() { return (unsigned)__builtin_amdgcn_s_getreg((3 << 11) | 20) & 0xFu; }
#define XB_SPIN(cond, bar) do { unsigned _sp = 0; while (cond) { __builtin_amdgcn_s_sleep(1); \
    if ((++_sp & 255u) == 0u) { if (xb_ld(&(bar)[XB_TMO])) break; if (_sp > XB_SPIN_CAP) { atomicAdd(&(bar)[XB_TMO], 1u); break; } } } } while (0)

struct XcdBarrier {
    unsigned* bar; unsigned x;
    volatile LAS unsigned* st;
};

__device__ __forceinline__ XcdBarrier xcd_barrier_post(unsigned* bar, volatile LAS unsigned* st) {
    XcdBarrier b; b.bar = bar; b.x = xb_xcc_id(); b.st = st;
    if (threadIdx.x == 0) (void)xb_add(&bar[XB_XCNT(b.x)], 1u);
    return b;
}
__device__ __forceinline__ void xcd_barrier_complete(unsigned* bar, unsigned x, unsigned& nloc, unsigned& nx) {
    const unsigned G = gridDim.x * gridDim.y * gridDim.z;
    unsigned sum, cnt, mine, sp = 0u;
    for (;;) {
        sum = 0u; cnt = 0u; mine = 0u;
#pragma unroll
        for (unsigned j = 0; j < 16; ++j) { const unsigned c = xb_ld(&bar[XB_XCNT(j)]); sum += c; cnt += (c > 0u) ? 1u : 0u; mine = (j == x) ? c : mine; }
        if (sum == G) break;
        __builtin_amdgcn_s_sleep(1);
        if ((++sp & 255u) == 0u) { if (xb_ld(&bar[XB_TMO])) break; if (sp > XB_SPIN_CAP) { atomicAdd(&bar[XB_TMO], 1u); break; } }
    }
    nloc = mine > 0u ? mine : 1u; nx = cnt > 0u ? cnt : 1u;
}

__device__ __forceinline__ void xcd_barrier(const XcdBarrier& b) {
    asm volatile("s_waitcnt vmcnt(0)" ::: "memory");
    __syncthreads();
    if (threadIdx.x == 0) {
        unsigned* bar = b.bar;
        __builtin_amdgcn_s_waitcnt(0);
        unsigned nloc = b.st[0], nx = b.st[1];
        if (nloc == 0u) { xcd_barrier_complete(bar, b.x, nloc, nx); b.st[0] = nloc; b.st[1] = nx; }
        const unsigned old = xb_add(&bar[XB_XSUB(b.x)], 1u);
        const unsigned gen = old / nloc;
        if (old + 1u == (gen + 1u) * nloc) {
            __builtin_amdgcn_fence(__ATOMIC_RELEASE, "agent");
            asm volatile("s_waitcnt vmcnt(0)" ::: "memory");
            const unsigned og = xb_add(&bar[XB_TOP], 1u);
            const unsigned tg = og / nx;
            if (og + 1u == (tg + 1u) * nx) xb_add(&bar[XB_TOPGEN], 1u);
            else XB_SPIN(xb_ld(&bar[XB_TOPGEN]) == tg, bar);
            __builtin_amdgcn_fence(__ATOMIC_ACQUIRE, "agent");
            xb_add(&bar[XB_XGEN(b.x)], 1u);
            asm volatile("s_waitcnt vmcnt(0)" ::: "memory");
        } else {
            XB_SPIN(xb_ld(&bar[XB_XGEN(b.x)]) == gen, bar);
            __builtin_amdgcn_fence(__ATOMIC_ACQUIRE, "agent");
            asm volatile("s_waitcnt vmcnt(0)" ::: "memory");
        }
    }
    __syncthreads();
}


constexpr int PH_PER_LAYER = 12, N_PHASES = 2 + PH_PER_LAYER * DEPTH;
constexpr int CW_BAR = 4096;
constexpr int LDS_BYTES = 147456, LDSCTL_OFF = 131072 + 8192;
#ifndef SINGLE_LAUNCH
#define SINGLE_LAUNCH 1
#endif

#ifndef PROBE_A
#define PROBE_A -1
#endif
#ifndef PROBE_B
#define PROBE_B -1
#endif
constexpr size_t WS_TS = 512 * 1024;
#if PROBE_A >= 0
#define STAMP(i) do { if (blockIdx.x == 0 && threadIdx.x == 0) ((unsigned long long*)(args_here()->ws + WS_TS))[(i)] = __builtin_amdgcn_s_memrealtime(); } while (0)
#else
#define STAMP(i) do { } while (0)
#endif
__device__ __forceinline__ const __attribute__((address_space(4))) Args* args_here() { const __attribute__((address_space(4))) Args* p = (const __attribute__((address_space(4))) Args*)__builtin_amdgcn_kernarg_segment_ptr(); asm volatile("" : "+s"(p)); return p; }
#ifndef REP_K
#define REP_K -1
#endif
#define PHASE1(k, ...) do { const __attribute__((address_space(4))) Args* ap_ = args_here(); if (ap_->ph_lo <= (k) && (k) < ap_->ph_hi) { ArgsR a = *ap_; __VA_ARGS__ } } while (0)
#define PHASE(k, ...) do { PHASE1(k, __VA_ARGS__); if ((k) == REP_K) { xcd_barrier(bar); PHASE1(k, __VA_ARGS__); xcd_barrier(bar); PHASE1(k, __VA_ARGS__); } } while (0)

template <int L>
__device__ __forceinline__ void run_layer(const Ctx& c, const XcdBarrier& bar) {
    const int G = gridDim.x, b = blockIdx.x;
#define BAR() do { xcd_barrier(bar); STAMP(3 + 14 * L + (bk_++)); } while (0)
    int bk_ = 0;
    PHASE(0, unsigned char* ws = a.ws; pg8::StaticOrder S; S.init(T, INC, G, b); EpiZ E{(bf16*)(ws + WS_ZR), (bf16*)(ws + WS_ZS), (bf16*)(ws + WS_ZG)};
        gemm_any(c, (const bf16*)(ws + WS_XN), (const bf16*)(ws + WS_WIN + (size_t)L * 10 * MiB), T, INC, D, S, E); );
    BAR();
    PHASE(1, phase_prep_fast(a, c, L); );
    PHASE(1, phase_sg_fast(a, c, L); );
    BAR();
    PHASE(2, phase_scan1(a, c); );
    BAR();
    PHASE(3, phase_scan2_mfma(a, c); );
    BAR();
    PHASE(4, phase_scan3(a, c); );
    BAR();
    PHASE(5, phase_post(a, c, L); );
    BAR();
    PHASE(6, unsigned char* ws = a.ws; pg8::StaticOrder S; S.init(T, D, G, b); EpiGA E{(const bf16*)(ws + WS_ZG), (bf16*)(ws + WS_MP)};
        gemm_any(c, (const bf16*)(ws + WS_YA), (const bf16*)(ws + WS_WA + (size_t)L * WS_WL1), T, D, W, S, E); );
    BAR();
    PHASE(7, unsigned char* ws = a.ws; pg8::StaticOrder S; S.init(T, D, G, b); EpiGB E{(const bf16*)(ws + WS_ZG), (bf16*)(ws + WS_MP)};
        gemm_any(c, (const bf16*)(ws + WS_YB), (const bf16*)(ws + WS_WB + (size_t)L * WS_WL1), T, D, W, S, E); );
    BAR();
    PHASE(8, unsigned char* ws = a.ws; pg8::StaticOrder S; S.init(T, D, G, b); EpiOut E{L == 0 ? a.in[I_X] : a.out, a.out, (const float*)(ws + WS_MODF) + L * 6144 + 2048};
        gemm_any(c, (const bf16*)(ws + WS_MP), (const bf16*)(ws + WS_WO + (size_t)L * WS_WL1), T, D, D, S, E); );
    BAR();
#if REP_K == 9
    PHASE1(9, phase_ln1(a, c, L, (float*)(a.ws + WS_ZR)); ); xcd_barrier(bar); PHASE1(9, phase_ln1(a, c, L, (float*)(a.ws + WS_ZR)); ); xcd_barrier(bar);
#endif
    PHASE1(9, phase_ln1(a, c, L, a.out); );
    BAR();
    PHASE(10, phase_perm(a, c, L); );
    BAR();
    PHASE(11, unsigned char* ws = a.ws; MoeSched S; S.init((const unsigned*)(ws + WS_TOT), G, b); EpiSwi E{(bf16*)(ws + WS_HID)};
        gemm_any(c, (const bf16*)(ws + WS_XS), (const bf16*)(ws + WS_WGU), MAXSLOT, NE * 1024, D, S, E); );
    BAR();
    PHASE(12, unsigned char* ws = a.ws; MoeSched S; S.init((const unsigned*)(ws + WS_TOT), G, b); EpiDown E{(const int*)(ws + WS_S2T), (const float*)(ws + WS_TOKW), (bf16*)(ws + WS_Y)};
        gemm_any(c, (const bf16*)(ws + WS_HID), (const bf16*)(ws + WS_WD), MAXSLOT, NE * 1024, FF, S, E); );
    BAR();
#if REP_K == 13
    PHASE1(13, phase_ln2(a, c, L, (float*)(a.ws + WS_R)); ); xcd_barrier(bar); PHASE1(13, phase_ln2(a, c, L, (float*)(a.ws + WS_R)); ); xcd_barrier(bar);
#endif
    PHASE1(13, phase_ln2(a, c, L, a.out); );
    if (L + 1 < DEPTH) BAR();
    (void)bk_;
#undef BAR
}

__global__ void __launch_bounds__(NTHREADS, 2) mk_fwd(Args a_unused) {
    extern __shared__ __attribute__((aligned(16))) unsigned char lds[];
    Ctx c; c.tid = threadIdx.x; c.lane = c.tid & 63; c.wave = __builtin_amdgcn_readfirstlane(c.tid >> 6);
    c.gw = blockIdx.x * NWAVES + c.wave; c.ngw = gridDim.x * NWAVES; c.lds = lds;
    for (int u = c.tid; u < (LDS_BYTES - LDSCTL_OFF) / 4; u += NTHREADS) ((LAS unsigned*)((LAS unsigned char*)lds + LDSCTL_OFF))[u] = 0u;
    __syncthreads();
    const XcdBarrier bar = xcd_barrier_post((unsigned*)(args_here()->ws + WS_CTL) + CW_BAR, (volatile LAS unsigned*)((LAS unsigned char*)lds + LDSCTL_OFF) + 8);
    STAMP(0);
    PHASE(100, phase_p0a(a, c); );
    xcd_barrier(bar); STAMP(1);
    PHASE(101, phase_p0b(a, c); );
    xcd_barrier(bar); STAMP(2);
    run_layer<0>(c, bar);
    run_layer<1>(c, bar);
#if PROBE_A >= 0
    if (blockIdx.x == 0) {
        asm volatile("s_waitcnt vmcnt(0)" ::: "memory"); __syncthreads();
        if (c.tid == 0) ((unsigned long long*)(args_here()->ws + WS_TS))[30] = __builtin_amdgcn_s_memrealtime();
        asm volatile("s_waitcnt vmcnt(0)" ::: "memory"); __syncthreads();
        const volatile unsigned long long* ts = (const volatile unsigned long long*)(args_here()->ws + WS_TS);
        float da = 0.f, db = 0.f;
        if (PROBE_A < 14) { da = (float)(ts[3 + PROBE_A] - ts[2 + PROBE_A]) + (float)(ts[17 + PROBE_A] - ts[16 + PROBE_A]); } else if (PROBE_A == 14) da = (float)(ts[1] - ts[0]); else if (PROBE_A == 15) da = (float)(ts[2] - ts[1]); else da = (float)(ts[30] - ts[0]);
        if (PROBE_B >= 0 && PROBE_B < 14) { db = (float)(ts[3 + PROBE_B] - ts[2 + PROBE_B]) + (float)(ts[17 + PROBE_B] - ts[16 + PROBE_B]); } else if (PROBE_B == 14) db = (float)(ts[1] - ts[0]); else if (PROBE_B == 15) db = (float)(ts[2] - ts[1]);
        da *= 0.01f; db *= 0.01f;
        da = exp2f(0.25f * rintf(4.0f * log2f(fmaxf(da, 0.5f)))); db = exp2f(0.25f * rintf(4.0f * log2f(fmaxf(db, 0.5f))));
        float* out = args_here()->out;
        for (int i = c.tid; i < 16 * 1024; i += NTHREADS) { const int r = i >> 10, col = i & 1023; const int rowi = (r & 7) + 2048 * (r >> 3); out[(size_t)rowi * D + col] = da; }
        if (c.tid == 0 && PROBE_B >= 0) out[(size_t)4096 * D] = 100.0f * db;
    }
#endif
}

extern "C" void kernel_launch(void* const* d_in, const int* in_sizes, int n_in, void* d_out, int out_size, void* d_ws, size_t ws_size, hipStream_t stream) {
    static int grid = 0;
    if (grid == 0) {
        if (n_in != N_IN || out_size != T * D || ws_size < WS_END) { fprintf(stderr, "kernel_launch: unexpected shapes: n_in %d out %d ws %zu (need %zu)\n", n_in, out_size, ws_size, (size_t)WS_END); grid = -1; return; }
        int dev = 0, cus = 0;
        (void)hipGetDevice(&dev); (void)hipDeviceGetAttribute(&cus, hipDeviceAttributeMultiprocessorCount, dev);
        if (hipFuncSetAttribute((const void*)mk_fwd, hipFuncAttributeMaxDynamicSharedMemorySize, LDS_BYTES) != hipSuccess) { fprintf(stderr, "kernel_launch: hipFuncSetAttribute failed\n"); grid = -1; return; }
        grid = cus > 0 ? cus : 256;
        fprintf(stderr, "kernel_launch: ws_size %zu grid %d\n", ws_size, grid);
    }
    if (grid < 0) return;
    (void)hipMemsetAsync((char*)d_ws + WS_CTL, 0, CTL_BYTES, stream);
    Args a{};
    for (int i = 0; i < N_IN; ++i) a.in[i] = (const float*)d_in[i];
    a.out = (float*)d_out; a.ws = (unsigned char*)d_ws;
    a.ph_lo = 0; a.ph_hi = 1000;
    hipLaunchKernelGGL(mk_fwd, dim3(grid), dim3(NTHREADS), LDS_BYTES, stream, a);
}
```

```cpp
#include <hip/hip_runtime.h>
#include <cstdio>
#include <cstdint>
#include <utility>

typedef unsigned short bf16;
typedef _Float16 f16;
typedef float f32x4 __attribute__((ext_vector_type(4)));
typedef unsigned u32x4 __attribute__((ext_vector_type(4)));
typedef unsigned u32x2 __attribute__((ext_vector_type(2)));

constexpr int T = 16384, D = 1024, W = 512, NH = 8, HN = 64, RC = 1792, INC = 4864;
constexpr int NE = 16, FF = 512, DEPTH = 2;
constexpr float LN_EPS = 1e-5f, GN_EPS = 64e-5f, ALPHA = 1.41421356237f;
constexpr int NTHREADS = 512, NWAVES = 8;
constexpr int MAXSLOT = 36864;

constexpr size_t MiB = 1u << 20;
constexpr size_t WS_CTL = 0, CTL_BYTES = 1 * MiB;
constexpr int CW_CNT = 16384;
constexpr size_t WS_PART = 1 * MiB;
constexpr size_t WS_MODF = 2 * MiB;
constexpr size_t WS_TOKI = 2 * MiB + 65536;
constexpr size_t WS_TOKW = WS_TOKI + 131072;
constexpr size_t WS_TOKP = WS_TOKW + 131072;
constexpr size_t WS_S2T = 3 * MiB;
constexpr size_t WS_BLKCNT = 3 * MiB + 512 * 1024;
constexpr size_t WS_TOT = WS_BLKCNT + 32768;
constexpr size_t WS_LORA = 4 * MiB;
constexpr size_t WS_WIN = 8 * MiB;
constexpr size_t WS_WA = 28 * MiB, WS_WB = 29 * MiB, WS_WO = 30 * MiB, WS_WL1 = 4 * MiB;
constexpr size_t WS_ZG = 36 * MiB;
constexpr size_t WS_XN = 100 * MiB;
constexpr size_t WS_G = 100 * MiB, WS_YB = 116 * MiB;
constexpr size_t WS_ZR = 132 * MiB;
constexpr size_t WS_ZS = 188 * MiB;
constexpr size_t WS_YSC = 132 * MiB;
constexpr size_t WS_ST = 148 * MiB;
constexpr size_t WS_YA = 148 * MiB;
constexpr size_t WS_MP = 164 * MiB;
constexpr size_t WS_XS = 132 * MiB;
constexpr size_t WS_Y = 132 * MiB;
constexpr size_t WS_R = 224 * MiB, WS_WM1 = 240 * MiB, WS_KP = 256 * MiB, WS_AA = 272 * MiB, WS_BB = 288 * MiB, WS_V = 304 * MiB;
constexpr size_t WS_WGU = 224 * MiB;
constexpr size_t WS_WD = 256 * MiB;
constexpr size_t WS_HID = 272 * MiB;
constexpr size_t WS_VF = 320 * MiB;
constexpr size_t WS_END = 336 * MiB;

constexpr size_t LO_W2T = 0, LO_A2T = 65536, LO_G2T = 131072, LO_VM1T = 262144, LO_VM2T = 294912, LO_STRIDE = 524288;

enum { I_X = 0, I_C, I_WMOD, I_BMOD, I_WIN, I_MU, I_W0, I_W2, I_A0, I_A2, I_G2, I_KK, I_KA, I_RK, I_GNG, I_GNB, I_VM0, I_VM1, I_VM2,
       I_SGG, I_SGB, I_WS, I_BS, I_WBA, I_WBB, I_WOUT, I_LN1G, I_LN1B, I_RW, I_RB, I_EG, I_EU, I_ED, I_LN2G, I_LN2B, N_IN };

struct Args { const float* in[N_IN]; float* out; unsigned char* ws; int ph_lo, ph_hi; };
typedef const __attribute__((address_space(4))) Args& ArgsR;

__device__ __forceinline__ float bf2f(bf16 h) { return __uint_as_float(((unsigned)h) << 16); }
__device__ __forceinline__ unsigned f2bfu(float f) { unsigned u = __float_as_uint(f); return (u + 0x7fffu + ((u >> 16) & 1u)) >> 16; }
__device__ __forceinline__ bf16 f2bf(float f) { return (bf16)f2bfu(f); }
__device__ __forceinline__ unsigned pk2(float lo, float hi) { return f2bfu(lo) | (f2bfu(hi) << 16); }
__device__ __forceinline__ void store4bf(bf16* p, f32x4 v) { u32x2 w; w.x = pk2(v[0], v[1]); w.y = pk2(v[2], v[3]); *(u32x2*)p = w; }
__device__ __forceinline__ f32x4 load4bf(const bf16* p) { u32x2 w = *(const u32x2*)p; f32x4 r; r[0] = __uint_as_float(w.x << 16); r[1] = __uint_as_float(w.x & 0xffff0000u); r[2] = __uint_as_float(w.y << 16); r[3] = __uint_as_float(w.y & 0xffff0000u); return r; }
__device__ __forceinline__ float wave_sum(float v) {
#pragma unroll
    for (int o = 1; o < 64; o <<= 1) v += __shfl_xor(v, o);
    return v;
}
__device__ __forceinline__ float sigmoidf_(float x) { return 1.0f / (1.0f + __expf(-x)); }
__device__ __forceinline__ float siluf_(float x) { return x * sigmoidf_(x); }
__device__ __forceinline__ float gelu_tanh(float x) { const float u = 0.7978845608028654f * (x + 0.044715f * x * x * x); return x * (1.0f - 1.0f / (1.0f + __expf(2.0f * u))); }
__device__ __forceinline__ float softplusf_(float y) { return fmaxf(y, 0.f) + log1pf(__expf(-fabsf(y))); }

struct Ctx { int tid, lane, wave, gw, ngw; unsigned char* lds; };

__device__ __forceinline__ void transpose_item(const float* Wsrc, int N, int k0, int n0, bf16* dst, int ldk, float* scr, int lane) {
#pragma unroll 8
    for (int i = 0; i < 32; ++i) { const int kk = 2 * i + (lane >> 5); scr[kk * 33 + (lane & 31)] = Wsrc[(size_t)(k0 + kk) * N + n0 + (lane & 31)]; }
    asm volatile("s_waitcnt lgkmcnt(0)" ::: "memory");
    const int c = lane & 7;
#pragma unroll
    for (int j = 0; j < 4; ++j) { const int n = (lane >> 3) + 8 * j; const float* s = scr + (8 * c) * 33 + n;
        u32x4 o; o.x = pk2(s[0 * 33], s[1 * 33]); o.y = pk2(s[2 * 33], s[3 * 33]); o.z = pk2(s[4 * 33], s[5 * 33]); o.w = pk2(s[6 * 33], s[7 * 33]);
        *(u32x4*)(dst + (size_t)n * ldk + k0 + 8 * c) = o; }
    asm volatile("s_waitcnt lgkmcnt(0)" ::: "memory");
}
template <class RowMap>
__device__ __forceinline__ void transpose_matrix_item(const float* Wsrc, int K, int N, bf16* dst, int item, float* scr, int lane, const RowMap& rm) {
    const int nblk = N / 32, kb = item / nblk, nb = item % nblk, n0 = 32 * nb;
    transpose_item(Wsrc, N, 64 * kb, n0, dst + (size_t)rm(n0) * K, K, scr, lane);
}
struct RowId { __device__ __forceinline__ int operator()(int n) const { return n; } };
struct RowGU { int up; __device__ __forceinline__ int operator()(int n) const { return (n >> 7) * 256 + (n & 127) + up * 128; } };

__device__ __forceinline__ void phase_p0a(ArgsR a, const Ctx& c) {
    float* scr = (float*)(c.lds + c.wave * 16384);
    float* PART = (float*)(a.ws + WS_PART);
    for (int it = c.gw; it < 2 * 96 * 16; it += c.ngw) {
        const int kb = it & 15, cb = (it >> 4) % 96, l = it / (16 * 96);
        const int n = cb * 64 + c.lane;
        const float* wm = a.in[I_WMOD] + (size_t)l * D * 6144;
        float acc = 0.f;
#pragma unroll 8
        for (int k = 0; k < 64; ++k) { const int kk = kb * 64 + k; acc += siluf_(a.in[I_C][kk]) * wm[(size_t)kk * 6144 + n]; }
        PART[((size_t)l * 16 + kb) * 6144 + n] = acc;
    }
    for (int it = c.gw; it < 2 * (16 + 16 + 32 + 8); it += c.ngw) {
        const int l = it / 72; int r = it % 72; unsigned char* lo = a.ws + WS_LORA + (size_t)l * LO_STRIDE;
        if (r < 16) { transpose_matrix_item(a.in[I_W2] + (size_t)l * 64 * W, 64, W, (bf16*)(lo + LO_W2T), r, scr, c.lane, RowId()); continue; } r -= 16;
        if (r < 16) { transpose_matrix_item(a.in[I_A2] + (size_t)l * 64 * W, 64, W, (bf16*)(lo + LO_A2T), r, scr, c.lane, RowId()); continue; } r -= 16;
        if (r < 32) { transpose_matrix_item(a.in[I_G2] + (size_t)l * 128 * W, 128, W, (bf16*)(lo + LO_G2T), r, scr, c.lane, RowId()); continue; } r -= 32;
        if (l == 1) transpose_matrix_item(a.in[I_VM1], W, 32, (bf16*)(lo + LO_VM1T), r, scr, c.lane, RowId());
    }
    for (int i = blockIdx.x * NTHREADS + c.tid; i < 32 * W; i += gridDim.x * NTHREADS) { const int n = i >> 5, k = i & 31;
        ((bf16*)(a.ws + WS_LORA + LO_STRIDE + LO_VM2T))[i] = f2bf(a.in[I_VM2][(size_t)k * W + n]); }
    constexpr int I_WINL = (D / 64) * (INC / 32);
    constexpr int I_WAL = (W / 64) * (D / 32);
    constexpr int I_WOL = (D / 64) * (D / 32);
    constexpr int PER_L = I_WINL + 2 * I_WAL + I_WOL;
    for (int it = c.gw; it < 2 * PER_L; it += c.ngw) {
        const int l = it / PER_L; int r = it % PER_L;
        if (r < I_WINL) { transpose_matrix_item(a.in[I_WIN] + (size_t)l * D * INC, D, INC, (bf16*)(a.ws + WS_WIN + (size_t)l * 10 * MiB), r, scr, c.lane, RowId()); continue; } r -= I_WINL;
        if (r < I_WAL) { transpose_matrix_item(a.in[I_WBA] + (size_t)l * W * D, W, D, (bf16*)(a.ws + WS_WA + (size_t)l * WS_WL1), r, scr, c.lane, RowId()); continue; } r -= I_WAL;
        if (r < I_WAL) { transpose_matrix_item(a.in[I_WBB] + (size_t)l * W * D, W, D, (bf16*)(a.ws + WS_WB + (size_t)l * WS_WL1), r, scr, c.lane, RowId()); continue; } r -= I_WAL;
        transpose_matrix_item(a.in[I_WOUT] + (size_t)l * D * D, D, D, (bf16*)(a.ws + WS_WO + (size_t)l * WS_WL1), r, scr, c.lane, RowId());
    }
}

__device__ __forceinline__ void row_stats(const float (&v)[16], float& mean, float& rstd) {
    float s = 0.f;
#pragma unroll
    for (int j = 0; j < 16; ++j) s += v[j];
    mean = wave_sum(s) * (1.f / D);
    float q = 0.f;
#pragma unroll
    for (int j = 0; j < 16; ++j) { const float d = v[j] - mean; q += d * d; }
    rstd = 1.0f / sqrtf(wave_sum(q) * (1.f / D) + LN_EPS);
}
__device__ __forceinline__ void load_row16(const float* p, int lane, float (&v)[16]) {
#pragma unroll
    for (int j = 0; j < 4; ++j) { const f32x4 x = *(const f32x4*)(p + 4 * lane + 256 * j); v[4 * j] = x[0]; v[4 * j + 1] = x[1]; v[4 * j + 2] = x[2]; v[4 * j + 3] = x[3]; }
}

__device__ __forceinline__ void phase_p0b(ArgsR a, const Ctx& c) {
    const float* PART = (const float*)(a.ws + WS_PART);
    float* MODF = (float*)(a.ws + WS_MODF);
    for (int i = blockIdx.x * NTHREADS + c.tid; i < 2 * 6144; i += gridDim.x * NTHREADS) {
        const int l = i / 6144, n = i % 6144; float s = a.in[I_BMOD][i];
#pragma unroll
        for (int kb = 0; kb < 16; ++kb) s += PART[((size_t)l * 16 + kb) * 6144 + n];
        MODF[i] = s;
    }
    float sh[16], sc[16];
#pragma unroll
    for (int j = 0; j < 4; ++j)
#pragma unroll
        for (int e = 0; e < 4; ++e) { const int col = 4 * c.lane + 256 * j + e; float s0 = a.in[I_BMOD][col], s1 = a.in[I_BMOD][1024 + col];
            for (int kb = 0; kb < 16; ++kb) { s0 += PART[(size_t)kb * 6144 + col]; s1 += PART[(size_t)kb * 6144 + 1024 + col]; }
            sh[4 * j + e] = s0; sc[4 * j + e] = 1.f + s1; }
    bf16* XN = (bf16*)(a.ws + WS_XN);
    for (int m = c.gw; m < T; m += c.ngw) {
        float v[16]; load_row16(a.in[I_X] + (size_t)m * D, c.lane, v);
        float mean, rstd; row_stats(v, mean, rstd);
#pragma unroll
        for (int j = 0; j < 4; ++j) { f32x4 o;
#pragma unroll
            for (int e = 0; e < 4; ++e) o[e] = (v[4 * j + e] - mean) * rstd * sc[4 * j + e] + sh[4 * j + e];
            store4bf(XN + (size_t)m * D + 4 * c.lane + 256 * j, o); }
    }
}

namespace pg8 {
#define PG8_LAS __attribute__((address_space(3)))
typedef unsigned short bf16_t;
typedef short bf16x8 __attribute__((ext_vector_type(8)));
typedef float f32x4 __attribute__((ext_vector_type(4)));
typedef unsigned u32x4 __attribute__((ext_vector_type(4)));
constexpr int BM = 256, BK = 64, HALF = 128, HTB = HALF * BK * 2  , STAGE_BYTES = 8 * HTB, NXCD = 8, WGM = 8;

__host__ __device__ __forceinline__ int lds_byte(int r, int c) { const int st = (r >> 4) * 2 + (c >> 5), rr = r & 15, cc = c & 31, ob = rr * 64 + cc * 2; return st * 1024 + (ob ^ (((ob >> 9) & 1) << 5)); }
__host__ __device__ __forceinline__ void stage_rc(int b, int& R, int& C) { const int st = b / 1024, sb = b % 1024, swz = sb ^ (((sb >> 9) & 1) << 5); R = (st >> 1) * 16 + swz / 64; C = (st & 1) * 32 + (swz % 64) / 2; }
__host__ __device__ __forceinline__ int perm32(int rho) { const int n = rho >> 4, i = rho & 15; return 8 * (i >> 2) + 4 * n + (i & 3); }

struct Unit { int pm, pn; };
struct Gemm { const bf16_t* A; const bf16_t* Bt; int M, N, K; };

struct StaticOrder {
    int nM, nN, nwg, G, c;
    __host__ __device__ void init(int M, int N, int G_, int c_) { nM = M / BM; nN = N / BM; nwg = nM * nN; G = G_; c = c_; }
    __host__ __device__ bool next(int i, Unit& u) const {
        const long L = (long)i * G + c; if (L >= nwg) return false;
        int wgid = (int)L; { const int q = nwg / NXCD, r = nwg % NXCD, xcd = wgid % NXCD, off = wgid / NXCD; wgid = (xcd < r ? xcd * (q + 1) : r * (q + 1) + (xcd - r) * q) + off; }
        const int nig = WGM * nN, gid = wgid / nig, fm = gid * WGM, gsz = (nM - fm) < WGM ? (nM - fm) : WGM;
        u.pm = fm + ((wgid % nig) % gsz); u.pn = (wgid % nig) / gsz; return true;
    }
    __device__ __forceinline__ void a_ready(const Unit&) const {}
    __device__ __forceinline__ void done(const Unit&) const {}
};


template <class Epi, class Sched, bool ALIGN_EPI = false, bool SP2 = false>
__device__ __forceinline__ void gemm_phase(PG8_LAS unsigned char* lds, const Gemm g, const Sched& S, const Epi& E) {
    const int tid = threadIdx.x, wid = __builtin_amdgcn_readfirstlane(tid >> 6), lane = tid & 63, wr = wid >> 2, wc = wid & 3, fr = lane & 15, fq = lane >> 4;
    const int K = g.K, nt = K / BK;
    unsigned voffA[2], voffB[2];
#pragma unroll
    for (int i = 0; i < 2; ++i) { int R, C; stage_rc(tid * 16 + i * 8192, R, C); const int Rb = Epi::PERM ? ((R & ~31) + perm32(R & 31)) : R;
        voffA[i] = (unsigned)(R * K + C) * 2u; voffB[i] = (unsigned)(Rb * K + C) * 2u; }
    const size_t kstep = (size_t)(BK * 2);
    const size_t hstep = (size_t)HALF * K * 2;
    const size_t tstep = 2 * hstep;
    const unsigned ldsw = (unsigned)wid * 1024u;
    const int aoff = lds_byte(wr * 64 + fr, fq * 8), boff = lds_byte(wc * 32 + fr, fq * 8);
#define PG8_SA(b, h) (((b) * 2 + (h)) * HTB)
#define PG8_SB(b, h) ((4 + (b) * 2 + (h)) * HTB)
#define PG8_STAGE(bufoff, gbase, voff) do { _Pragma("unroll") for (int _i = 0; _i < 2; ++_i) \
        __builtin_amdgcn_global_load_lds((const unsigned*)((const char*)(gbase) + (voff)[_i]), (PG8_LAS unsigned*)(lds + (bufoff) + ldsw + _i * 8192), 16, 0, 0); } while (0)
#define PG8_LDA(dst, b, h) do { _Pragma("unroll") for (int m = 0; m < 4; ++m) _Pragma("unroll") for (int k = 0; k < 2; ++k) dst[m][k] = *(const PG8_LAS bf16x8*)(lds + PG8_SA(b, h) + aoff + m * 2048 + k * 1024); } while (0)
#define PG8_LDB(dst, b, h) do { _Pragma("unroll") for (int n = 0; n < 2; ++n) _Pragma("unroll") for (int k = 0; k < 2; ++k) dst[n][k] = *(const PG8_LAS bf16x8*)(lds + PG8_SB(b, h) + boff + n * 2048 + k * 1024); } while (0)
#define PG8_MMA(ai, bj, At, Bt) do { __builtin_amdgcn_s_setprio(1); _Pragma("unroll") for (int m = 0; m < 4; ++m) _Pragma("unroll") for (int n = 0; n < 2; ++n) _Pragma("unroll") for (int k = 0; k < 2; ++k) \
        acc[ai][bj][m][n] = __builtin_amdgcn_mfma_f32_16x16x32_bf16(Bt[n][k], At[m][k], acc[ai][bj][m][n], 0, 0, 0); __builtin_amdgcn_s_setprio(0); } while (0)
#define PG8_WAIT_V(n) asm volatile("s_waitcnt vmcnt(" #n ")" ::: "memory")
#define PG8_WAIT_L(n) asm volatile("s_waitcnt lgkmcnt(" #n ")" ::: "memory")
#define PG8_BAR __builtin_amdgcn_s_barrier()
#define PG8_SCHED __builtin_amdgcn_sched_barrier(0)
    Unit cur, nxt; int ui = 0;
    if (!S.next(0, cur)) return;
    f32x4 acc[2][2][4][2];
#pragma unroll
    for (int a = 0; a < 2; ++a)
#pragma unroll
        for (int b = 0; b < 2; ++b)
#pragma unroll
            for (int m = 0; m < 4; ++m)
#pragma unroll
                for (int n = 0; n < 2; ++n) acc[a][b][m][n] = (f32x4){0.f, 0.f, 0.f, 0.f};
    bf16x8 At[4][2], B0[2][2], B1[2][2];
    const char* cA = (const char*)g.A + (size_t)cur.pm * tstep; const char* cB = (const char*)g.Bt + (size_t)cur.pn * tstep;
    S.a_ready(cur);
    if constexpr (SP2) {
        PG8_STAGE(PG8_SB(0, 0), cB, voffB); PG8_STAGE(PG8_SB(0, 1), cB + hstep, voffB); PG8_STAGE(PG8_SA(0, 0), cA, voffA); PG8_STAGE(PG8_SA(0, 1), cA + hstep, voffA);
        if (wr == 1) PG8_BAR;
        PG8_WAIT_V(2); PG8_BAR;
        PG8_STAGE(PG8_SB(1, 0), cB + kstep, voffB); PG8_STAGE(PG8_SA(1, 0), cA + kstep, voffA); PG8_STAGE(PG8_SB(1, 1), cB + hstep + kstep, voffB);
        PG8_WAIT_V(6); PG8_BAR;
    } else {
        PG8_STAGE(PG8_SB(0, 0), cB, voffB); PG8_STAGE(PG8_SA(0, 0), cA, voffA); PG8_STAGE(PG8_SB(0, 1), cB + hstep, voffB); PG8_STAGE(PG8_SA(0, 1), cA + hstep, voffA);
        if (wr == 1) PG8_BAR;
        PG8_WAIT_V(4); PG8_BAR;
        PG8_STAGE(PG8_SB(1, 0), cB + kstep, voffB); PG8_STAGE(PG8_SA(1, 0), cA + kstep, voffA); PG8_STAGE(PG8_SB(1, 1), cB + hstep + kstep, voffB);
        PG8_WAIT_V(6); PG8_BAR;
    }
    for (;;) {
        const bool has_next = S.next(ui + 1, nxt);
        const char* nA = has_next ? (const char*)g.A + (size_t)nxt.pm * tstep : cA; const char* nB = has_next ? (const char*)g.Bt + (size_t)nxt.pn * tstep : cB;
        for (int t = 0; t < nt; t += 2) {
            const bool last = (t == nt - 2);
            const char* a1 = cA + (size_t)(t + 1) * kstep;
            const char* a2 = last ? nA : cA + (size_t)(t + 2) * kstep; const char* b2 = last ? nB : cB + (size_t)(t + 2) * kstep;
            const char* a3 = a2 + kstep; const char* b3 = b2 + kstep;
            if (last && has_next) S.a_ready(nxt);
            if constexpr (SP2) {
            PG8_LDB(B0, 0, 0); PG8_LDB(B1, 0, 1); PG8_SCHED; PG8_LDA(At, 0, 0); PG8_STAGE(PG8_SA(1, 1), a1 + hstep, voffA);
            PG8_WAIT_V(8); PG8_WAIT_L(0); PG8_BAR; PG8_MMA(0, 0, At, B0); PG8_MMA(0, 1, At, B1); PG8_BAR; PG8_SCHED;
            PG8_LDA(At, 0, 1); PG8_STAGE(PG8_SB(0, 0), b2, voffB); PG8_STAGE(PG8_SB(0, 1), b2 + hstep, voffB); PG8_STAGE(PG8_SA(0, 0), a2, voffA);
            PG8_WAIT_V(8); PG8_WAIT_L(0); PG8_BAR; PG8_MMA(1, 0, At, B0); PG8_MMA(1, 1, At, B1); PG8_BAR; PG8_SCHED;
            PG8_LDB(B0, 1, 0); PG8_LDB(B1, 1, 1); PG8_SCHED; PG8_LDA(At, 1, 0); PG8_STAGE(PG8_SA(0, 1), a2 + hstep, voffA);
            PG8_WAIT_V(8); PG8_WAIT_L(0); PG8_BAR; PG8_MMA(0, 0, At, B0); PG8_MMA(0, 1, At, B1); PG8_BAR; PG8_SCHED;
            PG8_LDA(At, 1, 1); PG8_STAGE(PG8_SB(1, 0), b3, voffB); PG8_STAGE(PG8_SB(1, 1), b3 + hstep, voffB); PG8_STAGE(PG8_SA(1, 0), a3, voffA);
            PG8_WAIT_V(8); PG8_WAIT_L(0); PG8_BAR; PG8_MMA(1, 0, At, B0); PG8_MMA(1, 1, At, B1); PG8_BAR; PG8_SCHED;
            } else {
            PG8_LDB(B0, 0, 0); PG8_SCHED; PG8_LDA(At, 0, 0); PG8_STAGE(PG8_SA(1, 1), a1 + hstep, voffA);
            PG8_WAIT_L(8); PG8_BAR; PG8_WAIT_L(0); PG8_MMA(0, 0, At, B0); PG8_BAR; PG8_SCHED;
            PG8_LDB(B1, 0, 1); PG8_STAGE(PG8_SB(0, 0), b2, voffB);
            PG8_BAR; PG8_WAIT_L(0); PG8_MMA(0, 1, At, B1); PG8_BAR;
            PG8_LDA(At, 0, 1); PG8_STAGE(PG8_SA(0, 0), a2, voffA);
            PG8_BAR; PG8_WAIT_L(0); PG8_MMA(1, 0, At, B0); PG8_BAR; PG8_SCHED;
            PG8_STAGE(PG8_SB(0, 1), b2 + hstep, voffB);
            PG8_WAIT_V(6); PG8_BAR; PG8_MMA(1, 1, At, B1); PG8_BAR;
            PG8_LDB(B0, 1, 0); PG8_SCHED; PG8_LDA(At, 1, 0); PG8_STAGE(PG8_SA(0, 1), a2 + hstep, voffA);
            PG8_WAIT_L(8); PG8_BAR; PG8_WAIT_L(0); PG8_MMA(0, 0, At, B0); PG8_BAR; PG8_SCHED;
            PG8_LDB(B1, 1, 1); PG8_STAGE(PG8_SB(1, 0), b3, voffB);
            PG8_BAR; PG8_WAIT_L(0); PG8_MMA(0, 1, At, B1); PG8_BAR;
            PG8_LDA(At, 1, 1); PG8_STAGE(PG8_SA(1, 0), a3, voffA);
            PG8_BAR; PG8_WAIT_L(0); PG8_MMA(1, 0, At, B0); PG8_BAR; PG8_SCHED;
            PG8_STAGE(PG8_SB(1, 1), b3 + hstep, voffB);
            PG8_WAIT_V(6); PG8_BAR; PG8_MMA(1, 1, At, B1); PG8_BAR;
            }
        }
        if constexpr (ALIGN_EPI) { if (wr == 0) PG8_BAR; }
        if constexpr (!Epi::AFTER_DRAIN) { E(acc, cur, wr, wc, fr, fq); S.done(cur); }
        if (!has_next) break;
#pragma unroll
        for (int a = 0; a < 2; ++a)
#pragma unroll
            for (int b = 0; b < 2; ++b)
#pragma unroll
                for (int m = 0; m < 4; ++m)
#pragma unroll
                    for (int n = 0; n < 2; ++n) acc[a][b][m][n] = (f32x4){0.f, 0.f, 0.f, 0.f};
        cur = nxt; cA = nA; cB = nB; ++ui;
        if constexpr (ALIGN_EPI) { if (wr == 1) PG8_BAR; }
    }
    PG8_WAIT_V(0);
    if constexpr (!ALIGN_EPI) { if (wr == 0) PG8_BAR; }
    PG8_BAR;
    if constexpr (Epi::AFTER_DRAIN) { E.fused(acc, cur, wr, wc, fr, fq, lds, wid, lane); S.done(cur); }
#undef PG8_SA
#undef PG8_SB
#undef PG8_STAGE
#undef PG8_LDA
#undef PG8_LDB
#undef PG8_MMA
#undef PG8_WAIT_V
#undef PG8_WAIT_L
#undef PG8_BAR
#undef PG8_SCHED
}
}

using pg8::Unit;
struct DenseSched { int nN, n, G, c;
    __device__ __forceinline__ void a_ready(const Unit&) const {}
    __device__ __forceinline__ void done(const Unit&) const {}
    __device__ __forceinline__ bool next(int i, Unit& u) const { const int L = i * G + c; if (L >= n) return false; u.pm = L / nN; u.pn = L % nN; return true; } };

template <class Sched, class Epi>
__device__ __forceinline__ void gemm_simple(const Ctx& c, const bf16* A, const bf16* Bt, int K, const Sched& S, const Epi& E) {
    float* As = (float*)c.lds;
    float* Bs = As + 32 * 256;
    const int tid = c.tid, rg = tid >> 4, cg = tid & 15;
    Unit u;
    for (int ui = 0; S.next(ui, u); ++ui) {
        float acc[8][16];
#pragma unroll
        for (int i = 0; i < 8; ++i)
#pragma unroll
            for (int j = 0; j < 16; ++j) acc[i][j] = 0.f;
        const bf16* Ab = A + (size_t)u.pm * 256 * K; const bf16* Bb = Bt + (size_t)u.pn * 256 * K;
        for (int k0 = 0; k0 < K; k0 += 32) {
            { const int row = tid >> 1, kh = tid & 1;
              const u32x4* pa = (const u32x4*)(Ab + (size_t)row * K + k0 + 16 * kh); const u32x4 a0 = pa[0], a1 = pa[1];
              const u32x4* pb = (const u32x4*)(Bb + (size_t)row * K + k0 + 16 * kh); const u32x4 b0 = pb[0], b1 = pb[1];
#pragma unroll
              for (int j = 0; j < 4; ++j) {
                  As[(16 * kh + 2 * j) * 256 + row] = __uint_as_float(a0[j] << 16); As[(16 * kh + 2 * j + 1) * 256 + row] = __uint_as_float(a0[j] & 0xffff0000u);
                  As[(16 * kh + 8 + 2 * j) * 256 + row] = __uint_as_float(a1[j] << 16); As[(16 * kh + 8 + 2 * j + 1) * 256 + row] = __uint_as_float(a1[j] & 0xffff0000u);
                  Bs[(16 * kh + 2 * j) * 256 + row] = __uint_as_float(b0[j] << 16); Bs[(16 * kh + 2 * j + 1) * 256 + row] = __uint_as_float(b0[j] & 0xffff0000u);
                  Bs[(16 * kh + 8 + 2 * j) * 256 + row] = __uint_as_float(b1[j] << 16); Bs[(16 * kh + 8 + 2 * j + 1) * 256 + row] = __uint_as_float(b1[j] & 0xffff0000u);
              } }
            __syncthreads();
#pragma unroll 4
            for (int kk = 0; kk < 32; ++kk) {
                const f32x4 a0 = *(const f32x4*)(As + kk * 256 + rg * 8), a1 = *(const f32x4*)(As + kk * 256 + rg * 8 + 4);
                f32x4 b[4];
#pragma unroll
                for (int q = 0; q < 4; ++q) b[q] = *(const f32x4*)(Bs + kk * 256 + 64 * q + 4 * cg);
#pragma unroll
                for (int i = 0; i < 8; ++i) { const float av = i < 4 ? a0[i & 3] : a1[i & 3];
#pragma unroll
                    for (int q = 0; q < 4; ++q)
#pragma unroll
                        for (int e = 0; e < 4; ++e) acc[i][4 * q + e] += av * b[q][e]; }
            }
            __syncthreads();
        }
#pragma unroll
        for (int i = 0; i < 8; ++i) { const int row = u.pm * 256 + rg * 8 + i;
#pragma unroll
            for (int q = 0; q < 2; ++q) { const int col = u.pn * 256 + 64 * q + 4 * cg;
                f32x4 v0, v1;
#pragma unroll
                for (int e = 0; e < 4; ++e) { v0[e] = acc[i][4 * q + e]; v1[e] = acc[i][4 * (q + 2) + e]; }
                E(row, col, v0, v1); } }
    }
}

struct EpiZ { bf16 *ZR, *ZS, *ZG;
    __device__ __forceinline__ void one(int row, int col, f32x4 v) const {
        if (col < RC) store4bf(ZR + (size_t)row * RC + col, v);
        else if (col < RC + 1024) { f32x4 g; for (int e = 0; e < 4; ++e) g[e] = gelu_tanh(v[e]); store4bf(ZS + (size_t)row * 1024 + (col - RC), g); }
        else { f32x4 g; for (int e = 0; e < 4; ++e) g[e] = sigmoidf_(v[e]); store4bf(ZG + (size_t)row * 2048 + (col - RC - 1024), g); } }
    __device__ __forceinline__ void operator()(int row, int col, f32x4 v0, f32x4 v1) const { one(row, col, v0); one(row, col + 128, v1); } };
struct EpiGA { const bf16* ZG; bf16* MP;
    __device__ __forceinline__ void one(int row, int col, f32x4 v) const { const f32x4 g = load4bf(ZG + (size_t)row * 2048 + col); store4bf(MP + (size_t)row * D + col, g * v); }
    __device__ __forceinline__ void operator()(int row, int col, f32x4 v0, f32x4 v1) const { one(row, col, v0); one(row, col + 128, v1); } };
struct EpiGB { const bf16* ZG; bf16* MP;
    __device__ __forceinline__ void one(int row, int col, f32x4 v) const { const f32x4 g = load4bf(ZG + (size_t)row * 2048 + 1024 + col); const f32x4 m = load4bf(MP + (size_t)row * D + col); store4bf(MP + (size_t)row * D + col, m + g * v); }
    __device__ __forceinline__ void operator()(int row, int col, f32x4 v0, f32x4 v1) const { one(row, col, v0); one(row, col + 128, v1); } };
struct EpiOut { const float* xin; float* out; const float* gate1;
    __device__ __forceinline__ void one(int row, int col, f32x4 v) const { const f32x4 x = *(const f32x4*)(xin + (size_t)row * D + col); const f32x4 g = *(const f32x4*)(gate1 + col);
        *(f32x4*)(out + (size_t)row * D + col) = ALPHA * x + (1.0f + g) * v; }
    __device__ __forceinline__ void operator()(int row, int col, f32x4 v0, f32x4 v1) const { one(row, col, v0); one(row, col + 128, v1); } };
struct EpiSwi { bf16* HID;
    __device__ __forceinline__ void operator()(int row, int col, f32x4 v0, f32x4 v1) const { const int ct = (col >> 8) & 3, cc = col & 127;
        f32x4 h; for (int e = 0; e < 4; ++e) h[e] = siluf_(v0[e]) * v1[e]; store4bf(HID + (size_t)row * FF + ct * 128 + cc, h); } };
struct EpiDown { const int* S2T; const float* TOKW; bf16* Y;
    __device__ __forceinline__ void operator()(int row, int col, f32x4 v0, f32x4 v1) const { const int st = S2T[row]; if (st < 0) return; const float w = TOKW[st]; const int cc = col & 1023;
        store4bf(Y + (size_t)st * D + cc, w * v0); store4bf(Y + (size_t)st * D + cc + 128, w * v1); } };

struct MoeSched { int ts[17]; int G, c;
    __device__ __forceinline__ void a_ready(const Unit&) const {}
    __device__ __forceinline__ void done(const Unit&) const {}
    __device__ __forceinline__ void init(const unsigned* cnt, int G_, int c_) { G = G_; c = c_; int s = 0;
#pragma unroll
        for (int e = 0; e < 16; ++e) { ts[e] = s; s += ((int)cnt[e] + 255) >> 8; } ts[16] = s; }
    __device__ __forceinline__ bool next(int i, Unit& u) const { const int L = i * G + c; if (L >= 4 * ts[16]) return false; const int rt = L >> 2, ct = L & 3; int e = 0;
#pragma unroll
        for (int j = 1; j < 16; ++j) e += (rt >= ts[j]) ? 1 : 0;
        u.pm = rt; u.pn = e * 4 + ct; return true; } };

__device__ __forceinline__ void phase_prep_simple(ArgsR a, const Ctx& c, int l) {
    const bf16* ZR = (const bf16*)(a.ws + WS_ZR);
    const float* mu = a.in[I_MU] + l * RC; const float* w0 = a.in[I_W0] + l * W; const float* w2 = a.in[I_W2] + (size_t)l * 64 * W;
    const float* a0 = a.in[I_A0] + l * W; const float* a2 = a.in[I_A2] + (size_t)l * 64 * W; const float* g2 = a.in[I_G2] + (size_t)l * 128 * W;
    const float* k_k = a.in[I_KK] + l * W; const float* k_a = a.in[I_KA] + l * W;
    const float* vm0 = a.in[I_VM0]; const float* vm1 = a.in[I_VM1]; const float* vm2 = a.in[I_VM2];
    f16* R = (f16*)(a.ws + WS_R); f16* WM1 = (f16*)(a.ws + WS_WM1); f16* KP = (f16*)(a.ws + WS_KP); f16* AA = (f16*)(a.ws + WS_AA); f16* BB = (f16*)(a.ws + WS_BB); f16* V = (f16*)(a.ws + WS_V);
    bf16* G = (bf16*)(a.ws + WS_G); bf16* VF = (bf16*)(a.ws + WS_VF);
    const int lane = c.lane;
    for (int t = c.gw; t < T; t += c.ngw) {
        float z[28];
#pragma unroll
        for (int i = 0; i < 28; ++i) { const int col = lane + 64 * i; const float zc = bf2f(ZR[(size_t)t * RC + col]); const float zp = t > 0 ? bf2f(ZR[(size_t)(t - 1) * RC + col]) : 0.f; z[i] = zc + (zp - zc) * mu[col]; }
        const float tw = tanhf(z[24]), za = z[25], sg0 = sigmoidf_(z[26]), sg1 = sigmoidf_(z[27]);
        float wlo[8], alo[8], gg[8];
#pragma unroll
        for (int i = 0; i < 8; ++i) { wlo[i] = 0.f; alo[i] = 0.f; gg[i] = 0.f; }
        for (int j = 0; j < 64; ++j) { const float tj = __shfl(tw, j), aj = __shfl(za, j), s0 = __shfl(sg0, j), s1 = __shfl(sg1, j);
#pragma unroll
            for (int i = 0; i < 8; ++i) { const int n = lane + 64 * i; wlo[i] += tj * w2[j * W + n]; alo[i] += aj * a2[j * W + n]; gg[i] += s0 * g2[j * W + n] + s1 * g2[(64 + j) * W + n]; } }
        float vv[8];
#pragma unroll
        for (int i = 0; i < 8; ++i) vv[i] = z[16 + i];
        if (l == 0) {
#pragma unroll
            for (int i = 0; i < 8; ++i) VF[(size_t)t * W + lane + 64 * i] = f2bf(vv[i]);
        } else {
            float vmid = 0.f;
#pragma unroll
            for (int i = 0; i < 8; ++i)
                for (int j = 0; j < 64; ++j) { const float vc = __shfl(vv[i], j); vmid += vc * vm1[(size_t)(64 * i + j) * 32 + (lane & 31)]; }
            float vg[8];
#pragma unroll
            for (int i = 0; i < 8; ++i) vg[i] = 0.f;
            for (int m = 0; m < 32; ++m) { const float vmm = __shfl(vmid, m);
#pragma unroll
                for (int i = 0; i < 8; ++i) vg[i] += vmm * vm2[m * W + lane + 64 * i]; }
#pragma unroll
            for (int i = 0; i < 8; ++i) { const int n = lane + 64 * i; const float vf = bf2f(VF[(size_t)t * W + n]); vv[i] = vv[i] + (vf - vv[i]) * sigmoidf_(vm0[n] + vg[i]); }
        }
#pragma unroll
        for (int i = 0; i < 8; ++i) {
            const int n = lane + 64 * i; const size_t o = (size_t)t * W + n;
            const float x = w0[n] + wlo[i]; const float wl = -softplusf_(-x) - 0.5f; const float dm1 = expm1f(-__expf(wl));
            const float av = sigmoidf_(a0[n] + alo[i]);
            const float kraw = z[8 + i];
            float kk = kraw * k_k[n]; const float nrm = sqrtf(wave_sum(kk * kk)); kk = kk / fmaxf(nrm, 1e-12f);
            const float kp = kraw * (1.0f + (av - 1.0f) * k_a[n]);
            R[o] = (f16)z[i]; WM1[o] = (f16)dm1; KP[o] = (f16)kp; AA[o] = (f16)(-kk); BB[o] = (f16)(kk * av); V[o] = (f16)vv[i]; G[o] = f2bf(gg[i]);
        }
    }
}

__device__ __forceinline__ void phase_sg_simple(ArgsR a, const Ctx& c, int l) {
    const bf16* ZS = (const bf16*)(a.ws + WS_ZS); bf16* YB = (bf16*)(a.ws + WS_YB);
    const float* lng = a.in[I_SGG] + l * W; const float* lnb = a.in[I_SGB] + l * W;
    float* vn = (float*)c.lds;
    float* st = vn + 128 * 64;
    for (int uidx = blockIdx.x; uidx < 128 * 8; uidx += gridDim.x) {
        const int ch = uidx >> 3, g = uidx & 7; const int tok0 = ch * 128;
        for (int i = 0; i < 16; ++i) { const int s = c.wave * 16 + i; const bf16* p = ZS + (size_t)(tok0 + s) * 1024 + 512 + c.lane * 8;
            const f32x4 x0 = load4bf(p), x1 = load4bf(p + 4);
            float sm = (x0[0] + x0[1]) + (x0[2] + x0[3]) + (x1[0] + x1[1]) + (x1[2] + x1[3]); const float mean = wave_sum(sm) * (1.f / 512.f);
            float q = 0.f; for (int e = 0; e < 4; ++e) { const float d0 = x0[e] - mean, d1 = x1[e] - mean; q += d0 * d0 + d1 * d1; }
            const float rstd = 1.0f / sqrtf(wave_sum(q) * (1.f / 512.f) + LN_EPS);
            if (c.lane == 0) { st[2 * s] = mean; st[2 * s + 1] = rstd; } }
        __syncthreads();
        for (int i = c.tid; i < 128 * 64; i += NTHREADS) { const int s = i >> 6, d = i & 63; const float x = bf2f(ZS[(size_t)(tok0 + s) * 1024 + 512 + g * 64 + d]);
            vn[i] = (x - st[2 * s]) * st[2 * s + 1] * lng[g * 64 + d] + lnb[g * 64 + d]; }
        __syncthreads();
        const int d = c.tid & 63, tq = c.tid >> 6;
        const float* Wg = a.in[I_WS] + (size_t)(l * 8 + g) * 128 * 128; const float* bs = a.in[I_BS] + (size_t)(l * 8 + g) * 128;
        for (int i = 0; i < 16; ++i) { const int t = tq + 8 * i; float acc = 0.f;
            for (int s = 0; s <= t; ++s) acc += Wg[t * 128 + s] * vn[s * 64 + d];
            const float u = bf2f(ZS[(size_t)(tok0 + t) * 1024 + g * 64 + d]);
            YB[(size_t)(tok0 + t) * W + g * 64 + d] = f2bf(u * (acc + bs[t])); }
        __syncthreads();
    }
}

#define LAS3 __attribute__((address_space(3)))
typedef short bf16x8 __attribute__((ext_vector_type(8)));
template <int MT, int NT, int KS>
__device__ __forceinline__ void mma_lds_glob(const unsigned char* lds_base, int a_off_bytes, int lda, const bf16* Bt, int ldb, int n0, int lane, f32x4 (&acc)[MT][NT]) {
    const int fr = lane & 15, fq = lane >> 4;
    const LAS3 unsigned char* Ab = (const LAS3 unsigned char*)lds_base + a_off_bytes;
    int boff = (n0 + fr) * ldb + 8 * fq; asm volatile("" : "+v"(boff));
#pragma unroll
    for (int ks = 0; ks < KS; ++ks) {
        bf16x8 b[NT];
#pragma unroll
        for (int n = 0; n < NT; ++n) b[n] = *(const bf16x8*)(Bt + boff + 16 * n * ldb + 32 * ks);
#pragma unroll
        for (int m = 0; m < MT; ++m) { const bf16x8 av = *(const LAS3 bf16x8*)(Ab + ((16 * m + fr) * lda + 32 * ks + 8 * fq) * 2);
#pragma unroll
            for (int n = 0; n < NT; ++n) acc[m][n] = __builtin_amdgcn_mfma_f32_16x16x32_bf16(av, b[n], acc[m][n], 0, 0, 0); }
    }
}
__device__ __forceinline__ void zshift8(const bf16* ZR, int t, int col, const float* mu, float (&o)[8]) {
    const u32x4 zc = *(const u32x4*)(ZR + (size_t)t * RC + col);
    u32x4 zp = {0u, 0u, 0u, 0u}; if (t > 0) zp = *(const u32x4*)(ZR + (size_t)(t - 1) * RC + col);
    const f32x4 m0 = *(const f32x4*)(mu + col), m1 = *(const f32x4*)(mu + col + 4);
#pragma unroll
    for (int e = 0; e < 4; ++e) { const float c0 = __uint_as_float(zc[e] << 16), c1 = __uint_as_float(zc[e] & 0xffff0000u), p0 = __uint_as_float(zp[e] << 16), p1 = __uint_as_float(zp[e] & 0xffff0000u);
        const float mu0 = (2 * e < 4) ? m0[(2 * e) & 3] : m1[(2 * e) & 3], mu1 = (2 * e + 1 < 4) ? m0[(2 * e + 1) & 3] : m1[(2 * e + 1) & 3];
        o[2 * e] = c0 + (p0 - c0) * mu0; o[2 * e + 1] = c1 + (p1 - c1) * mu1; }
}
typedef _Float16 f16x8 __attribute__((ext_vector_type(8)));
__device__ __forceinline__ void store8f16(f16* p, const float (&v)[8]) { f16x8 h;
#pragma unroll
    for (int e = 0; e < 8; ++e) h[e] = (f16)v[e];
    *(f16x8*)p = h; }
__device__ __forceinline__ u32x4 pack8bf(const float (&v)[8]) { u32x4 w; w.x = pk2(v[0], v[1]); w.y = pk2(v[2], v[3]); w.z = pk2(v[4], v[5]); w.w = pk2(v[6], v[7]); return w; }


constexpr int PB_LD = 520;
constexpr int PB_BUF = 0, PB_AOP = 64 * PB_LD * 2, PB_VMID = 2 * 64 * PB_LD * 2, PB_LA_LD = 264, PB_VM_LD = 40;
__device__ __forceinline__ void phase_prep_fast(ArgsR a, const Ctx& c, int l) {
    const bf16* ZR = (const bf16*)(a.ws + WS_ZR);
    const float* mu = a.in[I_MU] + l * RC; const float* w0 = a.in[I_W0] + l * W; const float* a0 = a.in[I_A0] + l * W;
    const float* k_k = a.in[I_KK] + l * W; const float* k_a = a.in[I_KA] + l * W; const float* vm0 = a.in[I_VM0];
    f16* R = (f16*)(a.ws + WS_R); f16* WM1 = (f16*)(a.ws + WS_WM1); f16* KP = (f16*)(a.ws + WS_KP); f16* AA = (f16*)(a.ws + WS_AA); f16* BB = (f16*)(a.ws + WS_BB); f16* V = (f16*)(a.ws + WS_V);
    bf16* G = (bf16*)(a.ws + WS_G); bf16* VF = (bf16*)(a.ws + WS_VF);
    const unsigned char* lo = a.ws + WS_LORA + (size_t)l * LO_STRIDE;
    const bf16* W2T = (const bf16*)(lo + LO_W2T); const bf16* A2T = (const bf16*)(lo + LO_A2T); const bf16* G2T = (const bf16*)(lo + LO_G2T);
    const bf16* VM1T = (const bf16*)(lo + LO_VM1T); const bf16* VM2T = (const bf16*)(lo + LO_VM2T);
    LAS3 unsigned char* L = (LAS3 unsigned char*)c.lds;
    const int tid = c.tid, lane = c.lane, wv = c.wave, fr = lane & 15, fq = lane >> 4;
    const int row = tid >> 3, sub = tid & 7;
    for (int u = blockIdx.x; u < T / 64; u += gridDim.x) {
        const int t0 = u * 64, t = t0 + row;
        if (l == 0) {
#pragma unroll 1
            for (int p = 0; p < 8; ++p) { const int col = p * 64 + sub * 8; float z[8]; zshift8(ZR, t, 1024 + col, mu, z);
                store8f16(V + (size_t)t * W + col, z); *(u32x4*)(VF + (size_t)t * W + col) = pack8bf(z); }
        } else {
#pragma unroll 1
            for (int p = 0; p < 8; ++p) { const int col = p * 64 + sub * 8; float z[8]; zshift8(ZR, t, 1024 + col, mu, z);
                *(LAS3 u32x4*)(L + PB_AOP + (row * PB_LD + col) * 2) = pack8bf(z); }
            __syncthreads();
            { f32x4 acc[1][1]; acc[0][0] = (f32x4){0.f, 0.f, 0.f, 0.f}; const int m = wv >> 1, n = wv & 1;
              mma_lds_glob<1, 1, 16>(c.lds, PB_AOP + 16 * m * PB_LD * 2, PB_LD, VM1T, W, 16 * n, lane, acc);
#pragma unroll
              for (int i = 0; i < 4; ++i) *(LAS3 bf16*)(L + PB_VMID + ((16 * m + 4 * fq + i) * PB_VM_LD + 16 * n + fr) * 2) = f2bf(acc[0][0][i]); }
            __syncthreads();
            { f32x4 acc[4][4];
#pragma unroll
              for (int m = 0; m < 4; ++m)
#pragma unroll
                  for (int n = 0; n < 4; ++n) acc[m][n] = (f32x4){0.f, 0.f, 0.f, 0.f};
              mma_lds_glob<4, 4, 1>(c.lds, PB_VMID, PB_VM_LD, VM2T, 32, 64 * wv, lane, acc);
#pragma unroll
              for (int m = 0; m < 4; ++m)
#pragma unroll
                  for (int n = 0; n < 4; ++n) { const int col = 64 * wv + 16 * n + fr; const float vb = vm0[col];
#pragma unroll
                      for (int i = 0; i < 4; ++i) *(LAS3 f16*)(L + PB_BUF + ((16 * m + 4 * fq + i) * PB_LD + col) * 2) = (f16)sigmoidf_(vb + acc[m][n][i]); } }
            __syncthreads();
#pragma unroll 1
            for (int p = 0; p < 8; ++p) { const int col = p * 64 + sub * 8;
                const u32x4 vz = *(const LAS3 u32x4*)(L + PB_AOP + (row * PB_LD + col) * 2); const f16x8 gt = *(const LAS3 f16x8*)(L + PB_BUF + (row * PB_LD + col) * 2);
                const u32x4 vfw = *(const u32x4*)(VF + (size_t)t * W + col); float o[8];
#pragma unroll
                for (int e = 0; e < 4; ++e) { const float v0 = __uint_as_float(vz[e] << 16), v1 = __uint_as_float(vz[e] & 0xffff0000u), f0 = __uint_as_float(vfw[e] << 16), f1 = __uint_as_float(vfw[e] & 0xffff0000u);
                    o[2 * e] = v0 + (f0 - v0) * (float)gt[2 * e]; o[2 * e + 1] = v1 + (f1 - v1) * (float)gt[2 * e + 1]; }
                store8f16(V + (size_t)t * W + col, o); }
            __syncthreads();
        }
#pragma unroll 1
        for (int p = 0; p < 4; ++p) { const int cc = sub * 32 + p * 8; float z[8]; zshift8(ZR, t, 1536 + cc, mu, z);
#pragma unroll
            for (int e = 0; e < 8; ++e) z[e] = cc < 64 ? (1.0f - 2.0f / (1.0f + __expf(2.0f * z[e]))) : (cc < 128 ? z[e] : sigmoidf_(z[e]));
            *(LAS3 u32x4*)(L + PB_AOP + (row * PB_LA_LD + cc) * 2) = pack8bf(z); }
        __syncthreads();
        { f32x4 acc[4][4];
#pragma unroll
          for (int m = 0; m < 4; ++m)
#pragma unroll
              for (int n = 0; n < 4; ++n) acc[m][n] = (f32x4){0.f, 0.f, 0.f, 0.f};
          mma_lds_glob<4, 4, 2>(c.lds, PB_AOP + 64 * 2, PB_LA_LD, A2T, 64, 64 * wv, lane, acc);
#pragma unroll
          for (int m = 0; m < 4; ++m)
#pragma unroll
              for (int n = 0; n < 4; ++n) { const int col = 64 * wv + 16 * n + fr; const float ab = a0[col];
#pragma unroll
                  for (int i = 0; i < 4; ++i) *(LAS3 f16*)(L + PB_BUF + ((16 * m + 4 * fq + i) * PB_LD + col) * 2) = (f16)sigmoidf_(ab + acc[m][n][i]); } }
        __syncthreads();
#pragma unroll 1
        for (int p = 0; p < 8; ++p) { const int col = p * 64 + sub * 8; const size_t o = (size_t)t * W + col;
            float z[8]; zshift8(ZR, t, col, mu, z); store8f16(R + o, z);
            float kz[8]; zshift8(ZR, t, 512 + col, mu, kz);
            const f16x8 av = *(const LAS3 f16x8*)(L + PB_BUF + (row * PB_LD + col) * 2);
            const f32x4 kk0 = *(const f32x4*)(k_k + col), kk1 = *(const f32x4*)(k_k + col + 4), ka0 = *(const f32x4*)(k_a + col), ka1 = *(const f32x4*)(k_a + col + 4);
            float kk[8], kp[8], bb[8]; float ss = 0.f;
#pragma unroll
            for (int e = 0; e < 8; ++e) { const float kkw = e < 4 ? kk0[e & 3] : kk1[e & 3], kaw = e < 4 ? ka0[e & 3] : ka1[e & 3]; kk[e] = kz[e] * kkw; ss += kk[e] * kk[e]; kp[e] = kz[e] * (1.0f + ((float)av[e] - 1.0f) * kaw); }
            ss += __shfl_xor(ss, 1); ss += __shfl_xor(ss, 2); ss += __shfl_xor(ss, 4);
            const float inv = 1.0f / fmaxf(sqrtf(ss), 1e-12f);
#pragma unroll
            for (int e = 0; e < 8; ++e) { kk[e] *= inv; bb[e] = kk[e] * (float)av[e]; kk[e] = -kk[e]; }
            store8f16(KP + o, kp); store8f16(AA + o, kk); store8f16(BB + o, bb); }
        __syncthreads();
        { f32x4 acc[4][4];
#pragma unroll
          for (int m = 0; m < 4; ++m)
#pragma unroll
              for (int n = 0; n < 4; ++n) acc[m][n] = (f32x4){0.f, 0.f, 0.f, 0.f};
          mma_lds_glob<4, 4, 2>(c.lds, PB_AOP, PB_LA_LD, W2T, 64, 64 * wv, lane, acc);
#pragma unroll
          for (int m = 0; m < 4; ++m)
#pragma unroll
              for (int n = 0; n < 4; ++n) { const int col = 64 * wv + 16 * n + fr; const float wb = w0[col];
#pragma unroll
                  for (int i = 0; i < 4; ++i) { const float x = wb + acc[m][n][i]; const float wl = -softplusf_(-x) - 0.5f; *(LAS3 f16*)(L + PB_BUF + ((16 * m + 4 * fq + i) * PB_LD + col) * 2) = (f16)expm1f(-__expf(wl)); } } }
        __syncthreads();
#pragma unroll 1
        for (int p = 0; p < 8; ++p) { const int col = p * 64 + sub * 8; *(u32x4*)(WM1 + (size_t)t * W + col) = *(const LAS3 u32x4*)(L + PB_BUF + (row * PB_LD + col) * 2); }
        __syncthreads();
        { f32x4 acc[4][4];
#pragma unroll
          for (int m = 0; m < 4; ++m)
#pragma unroll
              for (int n = 0; n < 4; ++n) acc[m][n] = (f32x4){0.f, 0.f, 0.f, 0.f};
          mma_lds_glob<4, 4, 4>(c.lds, PB_AOP + 128 * 2, PB_LA_LD, G2T, 128, 64 * wv, lane, acc);
#pragma unroll
          for (int m = 0; m < 4; ++m)
#pragma unroll
              for (int n = 0; n < 4; ++n) { const int col = 64 * wv + 16 * n + fr;
#pragma unroll
                  for (int i = 0; i < 4; ++i) *(LAS3 bf16*)(L + PB_BUF + ((16 * m + 4 * fq + i) * PB_LD + col) * 2) = f2bf(acc[m][n][i]); } }
        __syncthreads();
#pragma unroll 1
        for (int p = 0; p < 8; ++p) { const int col = p * 64 + sub * 8; *(u32x4*)(G + (size_t)t * W + col) = *(const LAS3 u32x4*)(L + PB_BUF + (row * PB_LD + col) * 2); }
        __syncthreads();
    }
}

constexpr int SG_LD = 136;
constexpr int SG_VT = 0, SG_ST = 256 * SG_LD * 2;
__device__ __forceinline__ void phase_sg_fast(ArgsR a, const Ctx& c, int l) {
    const bf16* ZS = (const bf16*)(a.ws + WS_ZS); bf16* YB = (bf16*)(a.ws + WS_YB);
    const float* lng = a.in[I_SGG] + l * W; const float* lnb = a.in[I_SGB] + l * W;
    LAS3 unsigned char* L = (LAS3 unsigned char*)c.lds;
    LAS3 float* st = (LAS3 float*)(L + SG_ST);
    const int tid = c.tid, lane = c.lane, wv = c.wave, fr = lane & 15, fq = lane >> 4;
    for (int u = blockIdx.x; u < 256; u += gridDim.x) {
        const int ch = u >> 1, hf = u & 1, tok0 = ch * 128;
        for (int i = 0; i < 16; ++i) { const int sidx = wv * 16 + i; const bf16* p = ZS + (size_t)(tok0 + sidx) * 1024 + 512 + lane * 8;
            const f32x4 x0 = load4bf(p), x1 = load4bf(p + 4);
            const float sm = (x0[0] + x0[1]) + (x0[2] + x0[3]) + (x1[0] + x1[1]) + (x1[2] + x1[3]); const float mean = wave_sum(sm) * (1.f / 512.f);
            float q = 0.f;
#pragma unroll
            for (int e = 0; e < 4; ++e) { const float d0 = x0[e] - mean, d1 = x1[e] - mean; q += d0 * d0 + d1 * d1; }
            const float rstd = 1.0f / sqrtf(wave_sum(q) * (1.f / 512.f) + LN_EPS);
            if (lane == 0) { st[2 * sidx] = mean; st[2 * sidx + 1] = rstd; } }
        __syncthreads();
        { const int sidx = tid >> 2, q4 = tid & 3; const float mean = st[2 * sidx], rstd = st[2 * sidx + 1];
#pragma unroll
          for (int p = 0; p < 8; ++p) { const int cl = q4 * 64 + p * 8; const int cg = hf * 256 + cl;
              const bf16* src = ZS + (size_t)(tok0 + sidx) * 1024 + 512 + cg; const f32x4 x0 = load4bf(src), x1 = load4bf(src + 4);
              const f32x4 g0 = *(const f32x4*)(lng + cg), g1 = *(const f32x4*)(lng + cg + 4), b0 = *(const f32x4*)(lnb + cg), b1 = *(const f32x4*)(lnb + cg + 4);
#pragma unroll
              for (int e = 0; e < 8; ++e) { const float x = e < 4 ? x0[e & 3] : x1[e & 3], gg = e < 4 ? g0[e & 3] : g1[e & 3], bb = e < 4 ? b0[e & 3] : b1[e & 3];
                  *(LAS3 bf16*)(L + SG_VT + ((cl + e) * SG_LD + sidx) * 2) = f2bf((x - mean) * rstd * gg + bb); } } }
        __syncthreads();
        const int gl = wv >> 1, dh = wv & 1, g = hf * 4 + gl;
        const float* Wg = a.in[I_WS] + (size_t)(l * 8 + g) * 128 * 128; const float* bs = a.in[I_BS] + (size_t)(l * 8 + g) * 128;
        f32x4 acc[8][2];
#pragma unroll
        for (int m = 0; m < 8; ++m) { acc[m][0] = (f32x4){0.f, 0.f, 0.f, 0.f}; acc[m][1] = (f32x4){0.f, 0.f, 0.f, 0.f}; }
#pragma unroll
        for (int ks = 0; ks < 4; ++ks) {
            bf16x8 b[2];
#pragma unroll
            for (int n = 0; n < 2; ++n) b[n] = *(const LAS3 bf16x8*)(L + SG_VT + ((gl * 64 + dh * 32 + 16 * n + fr) * SG_LD + 32 * ks + 8 * fq) * 2);
#pragma unroll
            for (int m = 0; m < 8; ++m) { if (32 * ks <= 16 * m + 15) {
                const int trow = 16 * m + fr, s0 = 32 * ks + 8 * fq;
                const f32x4 w0v = *(const f32x4*)(Wg + trow * 128 + s0), w1v = *(const f32x4*)(Wg + trow * 128 + s0 + 4);
                float wf[8];
#pragma unroll
                for (int e = 0; e < 8; ++e) { const float wval = e < 4 ? w0v[e & 3] : w1v[e & 3]; wf[e] = (s0 + e <= trow) ? wval : 0.f; }
                const u32x4 wp = pack8bf(wf); const bf16x8 av = __builtin_bit_cast(bf16x8, wp);
                acc[m][0] = __builtin_amdgcn_mfma_f32_16x16x32_bf16(av, b[0], acc[m][0], 0, 0, 0);
                acc[m][1] = __builtin_amdgcn_mfma_f32_16x16x32_bf16(av, b[1], acc[m][1], 0, 0, 0); } }
        }
#pragma unroll
        for (int m = 0; m < 8; ++m)
#pragma unroll
            for (int i = 0; i < 4; ++i) { const int trow = 16 * m + 4 * fq + i; const float bsv = bs[trow];
#pragma unroll
                for (int n = 0; n < 2; ++n) { const int col = g * 64 + dh * 32 + 16 * n + fr; const float uu = bf2f(ZS[(size_t)(tok0 + trow) * 1024 + col]);
                    YB[(size_t)(tok0 + trow) * W + col] = f2bf(uu * (acc[m][n][i] + bsv)); } }
        __syncthreads();
    }
}

__device__ __forceinline__ void phase_scan_simple(ArgsR a, const Ctx& c) {
    if (c.wave != 0 || blockIdx.x >= NH) return;
    const int h = blockIdx.x, lane = c.lane;
    const f16* R = (const f16*)(a.ws + WS_R); const f16* WM1 = (const f16*)(a.ws + WS_WM1); const f16* KP = (const f16*)(a.ws + WS_KP);
    const f16* AA = (const f16*)(a.ws + WS_AA); const f16* BB = (const f16*)(a.ws + WS_BB); const f16* V = (const f16*)(a.ws + WS_V);
    bf16* YSC = (bf16*)(a.ws + WS_YSC);
    float S[64];
#pragma unroll
    for (int j = 0; j < 64; ++j) S[j] = 0.f;
    for (int t = 0; t < T; ++t) {
        const size_t base = (size_t)t * W + h * 64;
        const float vv = (float)V[base + lane];
        float sa = 0.f;
#pragma unroll
        for (int j = 0; j < 64; ++j) sa += S[j] * (float)AA[base + j];
        float y = 0.f;
#pragma unroll
        for (int j = 0; j < 64; ++j) { float s = S[j]; s = s + s * (float)WM1[base + j]; s += sa * (float)BB[base + j]; s += vv * (float)KP[base + j]; S[j] = s; y += s * (float)R[base + j]; }
        YSC[base + lane] = f2bf(y);
    }
}

typedef unsigned u32x16 __attribute__((ext_vector_type(16)));
__device__ __forceinline__ void sload32(const void* p0, u32x16& a0, u32x16& a1) {
    asm volatile("s_load_dwordx16 %0, %2, 0x0 glc\n\ts_load_dwordx16 %1, %2, 0x40 glc\n\ts_waitcnt lgkmcnt(0)" : "=&s"(a0), "=&s"(a1) : "s"(p0) : "memory");
}
__device__ __forceinline__ void sload64(const void* p0, const void* p1, u32x16& a0, u32x16& a1, u32x16& b0, u32x16& b1) {
    asm volatile("s_load_dwordx16 %0, %4, 0x0 glc\n\ts_load_dwordx16 %1, %4, 0x40 glc\n\ts_load_dwordx16 %2, %5, 0x0 glc\n\ts_load_dwordx16 %3, %5, 0x40 glc\n\ts_waitcnt lgkmcnt(0)"
                 : "=&s"(a0), "=&s"(a1), "=&s"(b0), "=&s"(b1) : "s"(p0), "s"(p1) : "memory");
}
__device__ __forceinline__ float fmix_lo(unsigned sd, float x, float y) { float d; asm("v_fma_mix_f32 %0, %1, %2, %3 op_sel_hi:[1,0,0]" : "=v"(d) : "s"(sd), "v"(x), "v"(y)); return d; }
__device__ __forceinline__ float fmix_hi(unsigned sd, float x, float y) { float d; asm("v_fma_mix_f32 %0, %1, %2, %3 op_sel:[1,0,0] op_sel_hi:[1,0,0]" : "=v"(d) : "s"(sd), "v"(x), "v"(y)); return d; }
constexpr int CL = 64, NCH = T / CL;
constexpr size_t ST_Q_OFF = (size_t)NH * NCH * 64 * 64;
constexpr size_t ST_S_OFF = (size_t)NH * NCH * 64 * 64;

__device__ __forceinline__ float vmix_lo(unsigned vd, float x, float y) { float d; asm("v_fma_mix_f32 %0, %1, %2, %3 op_sel_hi:[1,0,0]" : "=v"(d) : "v"(vd), "v"(x), "v"(y)); return d; }
__device__ __forceinline__ float vmix_hi(unsigned vd, float x, float y) { float d; asm("v_fma_mix_f32 %0, %1, %2, %3 op_sel:[1,0,0] op_sel_hi:[1,0,0]" : "=v"(d) : "v"(vd), "v"(x), "v"(y)); return d; }
template <int N> __device__ __forceinline__ void fmac_bc(float& acc, float vec, float x) { asm("v_fmac_f32_dpp %0, %1, %2 row_newbcast:%3 row_mask:0xf bank_mask:0xf" : "+v"(acc) : "v"(vec), "v"(x), "n"(N)); }
template <int N> __device__ __forceinline__ float mul_bc(float vec, float x) { float d; asm("v_mul_f32_dpp %0, %1, %2 row_newbcast:%3 row_mask:0xf bank_mask:0xf" : "=v"(d) : "v"(vec), "v"(x), "n"(N)); return d; }
typedef _Float16 f16x4 __attribute__((ext_vector_type(4)));
struct SVec { float v[4]; };
__device__ __forceinline__ f16x4 sv_read(const LAS3 unsigned char* p, int lane) { return *(const LAS3 f16x4*)(p + (lane & 15) * 8); }
__device__ __forceinline__ void sv_cvt(SVec& o, f16x4 h) { o.v[0] = (float)h[0]; o.v[1] = (float)h[1]; o.v[2] = (float)h[2]; o.v[3] = (float)h[3]; }
__device__ __forceinline__ void sv_cvt1p(SVec& o, f16x4 h) { o.v[0] = 1.0f + (float)h[0]; o.v[1] = 1.0f + (float)h[1]; o.v[2] = 1.0f + (float)h[2]; o.v[3] = 1.0f + (float)h[3]; }
template <int J> __device__ __forceinline__ void sc_dot(float (&d)[4], const SVec& A, const float (&X)[64]) { fmac_bc<(J >> 2)>(d[J & 3], A.v[J & 3], X[J]); if constexpr (J + 1 < 64) sc_dot<J + 1>(d, A, X); }
template <int J> __device__ __forceinline__ void sc_upd3(float (&S)[64], float (&y)[4], const SVec& Wv, const SVec& Bv, const SVec& Kv, const SVec& Rv, float sa, float vv) {
    float sj = mul_bc<(J >> 2)>(Wv.v[J & 3], S[J]); fmac_bc<(J >> 2)>(sj, Bv.v[J & 3], sa); fmac_bc<(J >> 2)>(sj, Kv.v[J & 3], vv); S[J] = sj; fmac_bc<(J >> 2)>(y[J & 3], Rv.v[J & 3], sj);
    if constexpr (J + 1 < 64) sc_upd3<J + 1>(S, y, Wv, Bv, Kv, Rv, sa, vv); }
template <int J> __device__ __forceinline__ void sc_upd1(float (&Q)[64], float (&P)[64], const SVec& Wv, const SVec& Bv, const SVec& Kv, float saq, float sap, float vv) {
    float qj = mul_bc<(J >> 2)>(Wv.v[J & 3], Q[J]); fmac_bc<(J >> 2)>(qj, Bv.v[J & 3], saq); fmac_bc<(J >> 2)>(qj, Kv.v[J & 3], vv); Q[J] = qj;
    float pj = mul_bc<(J >> 2)>(Wv.v[J & 3], P[J]); fmac_bc<(J >> 2)>(pj, Bv.v[J & 3], sap); P[J] = pj;
    if constexpr (J + 1 < 64) sc_upd1<J + 1>(Q, P, Wv, Bv, Kv, saq, sap, vv); }
constexpr int SCB = 8;
constexpr int SC_NS = 6, SC_BUF = SC_NS * 1024, SC_WAVE = 2 * SC_BUF;
__device__ __forceinline__ void sc_dma(const f16* X, size_t eoff, LAS3 unsigned char* dst) {
    __builtin_amdgcn_global_load_lds((const unsigned*)(X + eoff), (LAS3 unsigned*)dst, 16, 0, 0);
}

__device__ __forceinline__ void phase_scan1(ArgsR a, const Ctx& c) {
    const f16* WM1 = (const f16*)(a.ws + WS_WM1); const f16* KP = (const f16*)(a.ws + WS_KP);
    const f16* AA = (const f16*)(a.ws + WS_AA); const f16* BB = (const f16*)(a.ws + WS_BB); const f16* V = (const f16*)(a.ws + WS_V);
    float* ST = (float*)(a.ws + WS_ST);
    const int lane = c.lane;
    LAS3 unsigned char* ring = (LAS3 unsigned char*)c.lds + c.wave * SC_WAVE;
    for (int item = c.gw; item < NH * NCH; item += c.ngw) {
        const int h = __builtin_amdgcn_readfirstlane(item / NCH), ch = __builtin_amdgcn_readfirstlane(item % NCH);
        float Q[64], P[64];
        int ln_ = lane; asm volatile("" : "+v"(ln_));
#pragma unroll
        for (int j = 0; j < 64; ++j) { Q[j] = 0.f; P[j] = (j == ln_) ? 1.f : 0.f; }
        const size_t lane_off = (size_t)(lane >> 3) * W + h * 64 + (lane & 7) * 8;
        { const size_t e0 = (size_t)(ch * CL) * W + lane_off;
          sc_dma(AA, e0, ring); sc_dma(WM1, e0, ring + 1024); sc_dma(BB, e0, ring + 2048); sc_dma(KP, e0, ring + 3072); sc_dma(V, e0, ring + 4096); }
#pragma unroll 1
        for (int blk = 0; blk < CL / SCB; ++blk) {
            LAS3 unsigned char* buf = ring + (blk & 1) * SC_BUF;
            if (blk + 1 < CL / SCB) { LAS3 unsigned char* nb = ring + ((blk + 1) & 1) * SC_BUF; const size_t e0 = (size_t)(ch * CL + (blk + 1) * SCB) * W + lane_off;
                sc_dma(AA, e0, nb); sc_dma(WM1, e0, nb + 1024); sc_dma(BB, e0, nb + 2048); sc_dma(KP, e0, nb + 3072); sc_dma(V, e0, nb + 4096);
                asm volatile("s_waitcnt vmcnt(5)" ::: "memory"); }
            else asm volatile("s_waitcnt vmcnt(0)" ::: "memory");
            SVec A, Wv, Bv, Kv;
            sv_cvt(A, sv_read(buf, lane)); sv_cvt1p(Wv, sv_read(buf + 1024, lane)); sv_cvt(Bv, sv_read(buf + 2048, lane)); sv_cvt(Kv, sv_read(buf + 3072, lane));
            float vv = (float)*(const LAS3 f16*)(buf + 4096 + lane * 2);
#pragma unroll 1
            for (int st = 0; st < SCB; ++st) {
                const LAS3 unsigned char* sn = buf + ((st + 1 < SCB) ? st + 1 : st) * 128;
                const f16x4 ha = sv_read(sn, lane), hw = sv_read(sn + 1024, lane), hb = sv_read(sn + 2048, lane), hk = sv_read(sn + 3072, lane);
                const f16 hv = *(const LAS3 f16*)(sn + 4096 + lane * 2);
                float dq[4] = {0.f, 0.f, 0.f, 0.f}, dp[4] = {0.f, 0.f, 0.f, 0.f};
                sc_dot<0>(dq, A, Q); sc_dot<0>(dp, A, P);
                const float saq = (dq[0] + dq[1]) + (dq[2] + dq[3]), sap = (dp[0] + dp[1]) + (dp[2] + dp[3]);
                sc_upd1<0>(Q, P, Wv, Bv, Kv, saq, sap, vv);
                sv_cvt(A, ha); sv_cvt1p(Wv, hw); sv_cvt(Bv, hb); sv_cvt(Kv, hk); vv = (float)hv;
            }
        }
        float* Qp = ST + ST_Q_OFF + (size_t)(h * NCH + ch) * 4096 + lane;
        bf16* PTp = (bf16*)ST + (size_t)(h * NCH + ch) * 4096 + lane;
#pragma unroll
        for (int j = 0; j < 64; ++j) { PTp[j * 64] = f2bf(P[j]); Qp[j * 64] = Q[j]; }
    }
}
constexpr int GS = 16, NG = NCH / GS;
constexpr size_t ST_LP_OFF = (size_t)NH * NCH * 4096;
constexpr size_t WS_SG = WS_LORA + 2 * MiB;
constexpr int HI_LD = 72, HI_BYTES = 64 * HI_LD * 2;
struct HFrag { bf16x8 b[2][2]; f32x4 q[2]; };
__device__ __forceinline__ void hload(HFrag& f, const bf16* Bt, const float* QTc, int boff, int qtoff) {
#pragma unroll
    for (int ks = 0; ks < 2; ++ks)
#pragma unroll
        for (int n = 0; n < 2; ++n) f.b[ks][n] = *(const bf16x8*)(Bt + boff + 16 * n * 64 + 32 * ks);
#pragma unroll
    for (int n = 0; n < 2; ++n) f.q[n] = *(const f32x4*)(QTc + qtoff + 16 * n * 64);
}
__device__ __forceinline__ void hmma(const LAS3 unsigned char* img, const bf16x8 (&b)[2][2], f32x4 (&acc)[2], int m, int fr, int fq) {
#pragma unroll
    for (int ks = 0; ks < 2; ++ks) { const bf16x8 av = *(const LAS3 bf16x8*)(img + ((16 * m + fr) * HI_LD + 32 * ks + 8 * fq) * 2);
#pragma unroll
        for (int n = 0; n < 2; ++n) acc[n] = __builtin_amdgcn_mfma_f32_16x16x32_bf16(av, b[ks][n], acc[n], 0, 0, 0); }
}
__device__ __forceinline__ void himg_store(LAS3 unsigned char* img, const f32x4 (&acc)[2], int m, int n0, int fr, int fq) {
#pragma unroll
    for (int n = 0; n < 2; ++n)
#pragma unroll
        for (int i = 0; i < 4; ++i) *(LAS3 bf16*)(img + ((16 * m + 4 * fq + i) * HI_LD + n0 + 16 * n + fr) * 2) = f2bf(acc[n][i]);
}
#define HBAR() do { asm volatile("s_waitcnt lgkmcnt(0)" ::: "memory"); __builtin_amdgcn_s_barrier(); asm volatile("" ::: "memory"); } while (0)

__device__ __forceinline__ void sc2a_step(const HFrag& f, bf16* LpTc, float* QTc, const LAS3 unsigned char* ip, LAS3 unsigned char* ipn, const LAS3 unsigned char* iq, LAS3 unsigned char* iqn, int m, int n0, int fr, int fq, int qtoff) {
    f32x4 ap[2], aq[2];
#pragma unroll
    for (int n = 0; n < 2; ++n) { ap[n] = (f32x4){0.f, 0.f, 0.f, 0.f}; aq[n] = f.q[n]; }
    hmma(ip, f.b, ap, m, fr, fq); hmma(iq, f.b, aq, m, fr, fq);
#pragma unroll
    for (int n = 0; n < 2; ++n) { u32x2 w; w.x = pk2(ap[n][0], ap[n][1]); w.y = pk2(ap[n][2], ap[n][3]);
        *(u32x2*)(LpTc + (n0 + 16 * n + fr) * 64 + 16 * m + 4 * fq) = w;
        *(f32x4*)(QTc + qtoff + 16 * n * 64) = aq[n]; }
    himg_store(ipn, ap, m, n0, fr, fq); himg_store(iqn, aq, m, n0, fr, fq);
    HBAR();
}
__device__ __forceinline__ void phase_scan2a(ArgsR a, const Ctx& c) {
    const int lane = c.lane, wv = c.wave, fr = lane & 15, fq = lane >> 4, m = wv >> 1, n0 = 32 * (wv & 1);
    const int boff = (n0 + fr) * 64 + 8 * fq, qtoff = (n0 + fr) * 64 + 16 * m + 4 * fq;
    LAS3 unsigned char* L = (LAS3 unsigned char*)c.lds;
    for (int item = blockIdx.x; item < NH * NG; item += gridDim.x) {
        const size_t cb = (size_t)(item / NG) * NCH + (size_t)(item % NG) * GS;
        const bf16* PT = (const bf16*)(a.ws + WS_ST) + cb * 4096; bf16* LP = (bf16*)(a.ws + WS_ST) + ST_LP_OFF + cb * 4096; float* QT = (float*)(a.ws + WS_ST) + ST_Q_OFF + cb * 4096;
        for (int i = c.tid; i < 4 * HI_BYTES / 4; i += NTHREADS) ((LAS3 unsigned*)L)[i] = 0u;
        __syncthreads();
        if (c.tid < 64) *(LAS3 bf16*)(L + (c.tid * HI_LD + c.tid) * 2) = (bf16)0x3F80;
        __syncthreads();
        HFrag f0, f1, f2, f3;
        hload(f0, PT, QT, boff, qtoff); hload(f1, PT + 4096, QT + 4096, boff, qtoff); hload(f2, PT + 2 * 4096, QT + 2 * 4096, boff, qtoff); hload(f3, PT + 3 * 4096, QT + 3 * 4096, boff, qtoff);
        LAS3 unsigned char* p0 = L; LAS3 unsigned char* p1 = L + HI_BYTES; LAS3 unsigned char* q0 = L + 2 * HI_BYTES; LAS3 unsigned char* q1 = L + 3 * HI_BYTES;
#pragma unroll 1
        for (int i = 0; i < GS; i += 4) {
            const int nx = (i + 4 < GS) ? i + 4 : i;
            sc2a_step(f0, LP + (size_t)(i + 0) * 4096, QT + (size_t)(i + 0) * 4096, p0, p1, q0, q1, m, n0, fr, fq, qtoff); hload(f0, PT + (size_t)(nx + 0) * 4096, QT + (size_t)(nx + 0) * 4096, boff, qtoff);
            sc2a_step(f1, LP + (size_t)(i + 1) * 4096, QT + (size_t)(i + 1) * 4096, p1, p0, q1, q0, m, n0, fr, fq, qtoff); hload(f1, PT + (size_t)(nx + 1) * 4096, QT + (size_t)(nx + 1) * 4096, boff, qtoff);
            sc2a_step(f2, LP + (size_t)(i + 2) * 4096, QT + (size_t)(i + 2) * 4096, p0, p1, q0, q1, m, n0, fr, fq, qtoff); hload(f2, PT + (size_t)(nx + 2) * 4096, QT + (size_t)(nx + 2) * 4096, boff, qtoff);
            sc2a_step(f3, LP + (size_t)(i + 3) * 4096, QT + (size_t)(i + 3) * 4096, p1, p0, q1, q0, m, n0, fr, fq, qtoff); hload(f3, PT + (size_t)(nx + 3) * 4096, QT + (size_t)(nx + 3) * 4096, boff, qtoff);
        }
        __syncthreads();
    }
}
__device__ __forceinline__ void phase_scan2b(ArgsR a, const Ctx& c) {
    if (blockIdx.x >= NH) return;
    const int h = blockIdx.x, lane = c.lane, wv = c.wave, fr = lane & 15, fq = lane >> 4, m = wv >> 1, n0 = 32 * (wv & 1);
    const int boff = (n0 + fr) * 64 + 8 * fq, qtoff = (n0 + fr) * 64 + 16 * m + 4 * fq;
    LAS3 unsigned char* L = (LAS3 unsigned char*)c.lds;
    const bf16* LP = (const bf16*)(a.ws + WS_ST) + ST_LP_OFF + (size_t)h * NCH * 4096; const float* QT = (const float*)(a.ws + WS_ST) + ST_Q_OFF + (size_t)h * NCH * 4096;
    bf16* SG = (bf16*)(a.ws + WS_SG) + (size_t)h * NG * 4096;
    for (int i = c.tid; i < 2 * HI_BYTES / 4; i += NTHREADS) ((LAS3 unsigned*)L)[i] = 0u;
    for (int i = c.tid; i < 4096 / 2; i += NTHREADS) ((unsigned*)SG)[i] = 0u;
    __syncthreads();
    HFrag f0, f1, f2, f3;
#define SC2B_CH(g) ((size_t)((g) * GS + GS - 1) * 4096)
    hload(f0, LP + SC2B_CH(0), QT + SC2B_CH(0), boff, qtoff); hload(f1, LP + SC2B_CH(1), QT + SC2B_CH(1), boff, qtoff); hload(f2, LP + SC2B_CH(2), QT + SC2B_CH(2), boff, qtoff); hload(f3, LP + SC2B_CH(3), QT + SC2B_CH(3), boff, qtoff);
    LAS3 unsigned char* i0 = L; LAS3 unsigned char* i1 = L + HI_BYTES;
#define SC2B_STEP(f, g, ic, in) do { f32x4 acc[2] = {f.q[0], f.q[1]}; hmma(ic, f.b, acc, m, fr, fq); bf16* So = SG + (size_t)((g) + 1) * 4096; \
        _Pragma("unroll") for (int n = 0; n < 2; ++n) _Pragma("unroll") for (int i = 0; i < 4; ++i) So[(16 * m + 4 * fq + i) * 64 + n0 + 16 * n + fr] = f2bf(acc[n][i]); \
        himg_store(in, acc, m, n0, fr, fq); HBAR(); } while (0)
#pragma unroll 1
    for (int g = 0; g < NG; g += 4) {
        const int nx = (g + 4 < NG) ? g + 4 : g;
        SC2B_STEP(f0, g + 0, i0, i1); hload(f0, LP + SC2B_CH(nx + 0), QT + SC2B_CH(nx + 0), boff, qtoff);
        SC2B_STEP(f1, g + 1, i1, i0); hload(f1, LP + SC2B_CH(nx + 1), QT + SC2B_CH(nx + 1), boff, qtoff);
        SC2B_STEP(f2, g + 2, i0, i1); hload(f2, LP + SC2B_CH(nx + 2), QT + SC2B_CH(nx + 2), boff, qtoff);
        if (g + 3 < NG - 1) SC2B_STEP(f3, g + 3, i1, i0);
        hload(f3, LP + SC2B_CH(nx + 3), QT + SC2B_CH(nx + 3), boff, qtoff);
    }
#undef SC2B_STEP
#undef SC2B_CH
}
__device__ __forceinline__ void phase_scan2c(ArgsR a, const Ctx& c) {
    const int lane = c.lane, wv = c.wave, fr = lane & 15, fq = lane >> 4, m = wv >> 1, n0 = 32 * (wv & 1);
    const int boff = (n0 + fr) * 64 + 8 * fq, qtoff = (n0 + fr) * 64 + 16 * m + 4 * fq;
    LAS3 unsigned char* L = (LAS3 unsigned char*)c.lds;
    for (int item = blockIdx.x; item < NH * NG * 2; item += gridDim.x) {
        const int hg = item >> 1, hf = item & 1;
        const size_t cb = (size_t)(hg / NG) * NCH + (size_t)(hg % NG) * GS + hf * 8;
        const bf16* LP = (const bf16*)(a.ws + WS_ST) + ST_LP_OFF + cb * 4096; const float* QT = (const float*)(a.ws + WS_ST) + ST_Q_OFF + cb * 4096; bf16* SS = (bf16*)(a.ws + WS_ST) + cb * 4096;
        { const u32x4 v = *(const u32x4*)((const bf16*)(a.ws + WS_SG) + (size_t)hg * 4096 + c.tid * 8); *(LAS3 u32x4*)(L + ((c.tid >> 3) * HI_LD + (c.tid & 7) * 8) * 2) = v; }
        __syncthreads();
#pragma unroll 2
        for (int i = 0; i < 8; ++i) { HFrag f; hload(f, LP + (size_t)i * 4096, QT + (size_t)i * 4096, boff, qtoff);
            f32x4 acc[2] = {f.q[0], f.q[1]}; hmma(L, f.b, acc, m, fr, fq); bf16* So = SS + (size_t)i * 4096;
#pragma unroll
            for (int n = 0; n < 2; ++n)
#pragma unroll
                for (int k = 0; k < 4; ++k) So[(16 * m + 4 * fq + k) * 64 + n0 + 16 * n + fr] = f2bf(acc[n][k]); }
        __syncthreads();
    }
}
__device__ __forceinline__ void phase_scan3(ArgsR a, const Ctx& c) {
    const f16* R = (const f16*)(a.ws + WS_R); const f16* WM1 = (const f16*)(a.ws + WS_WM1); const f16* KP = (const f16*)(a.ws + WS_KP);
    const f16* AA = (const f16*)(a.ws + WS_AA); const f16* BB = (const f16*)(a.ws + WS_BB); const f16* V = (const f16*)(a.ws + WS_V);
    const float* ST = (const float*)(a.ws + WS_ST); bf16* YSC = (bf16*)(a.ws + WS_YSC);
    const int lane = c.lane;
    LAS3 unsigned char* ring = (LAS3 unsigned char*)c.lds + c.wave * SC_WAVE;
    for (int item = c.gw; item < NH * NCH; item += c.ngw) {
        const int h = __builtin_amdgcn_readfirstlane(item / NCH), ch = __builtin_amdgcn_readfirstlane(item % NCH);
        const size_t lane_off = (size_t)(lane >> 3) * W + h * 64 + (lane & 7) * 8;
        { const size_t e0 = (size_t)(ch * CL) * W + lane_off;
          sc_dma(AA, e0, ring); sc_dma(WM1, e0, ring + 1024); sc_dma(BB, e0, ring + 2048); sc_dma(KP, e0, ring + 3072); sc_dma(V, e0, ring + 4096); sc_dma(R, e0, ring + 5120); }
        float S[64];
        if (ch == 0) {
#pragma unroll
            for (int j = 0; j < 64; ++j) S[j] = 0.f;
        } else { const bf16* Sp = (const bf16*)ST + ((size_t)(h * NCH + ch - 1) * 64 + lane) * 64;
#pragma unroll
            for (int j = 0; j < 64; j += 4) { const f32x4 x = load4bf(Sp + j); S[j] = x[0]; S[j + 1] = x[1]; S[j + 2] = x[2]; S[j + 3] = x[3]; } }
#pragma unroll 1
        for (int blk = 0; blk < CL / SCB; ++blk) {
            LAS3 unsigned char* buf = ring + (blk & 1) * SC_BUF;
            if (blk + 1 < CL / SCB) { LAS3 unsigned char* nb = ring + ((blk + 1) & 1) * SC_BUF; const size_t e0 = (size_t)(ch * CL + (blk + 1) * SCB) * W + lane_off;
                sc_dma(AA, e0, nb); sc_dma(WM1, e0, nb + 1024); sc_dma(BB, e0, nb + 2048); sc_dma(KP, e0, nb + 3072); sc_dma(V, e0, nb + 4096); sc_dma(R, e0, nb + 5120);
                asm volatile("s_waitcnt vmcnt(6)" ::: "memory"); }
            else asm volatile("s_waitcnt vmcnt(0)" ::: "memory");
            SVec A, Wv, Bv, Kv, Rv;
            sv_cvt(A, sv_read(buf, lane)); sv_cvt1p(Wv, sv_read(buf + 1024, lane)); sv_cvt(Bv, sv_read(buf + 2048, lane)); sv_cvt(Kv, sv_read(buf + 3072, lane)); sv_cvt(Rv, sv_read(buf + 5120, lane));
            float vv = (float)*(const LAS3 f16*)(buf + 4096 + lane * 2);
#pragma unroll 1
            for (int st = 0; st < SCB; ++st) {
                const LAS3 unsigned char* sn = buf + ((st + 1 < SCB) ? st + 1 : st) * 128;
                const f16x4 ha = sv_read(sn, lane), hw = sv_read(sn + 1024, lane), hb = sv_read(sn + 2048, lane), hk = sv_read(sn + 3072, lane), hr = sv_read(sn + 5120, lane);
                const f16 hv = *(const LAS3 f16*)(sn + 4096 + lane * 2);
                float d[4] = {0.f, 0.f, 0.f, 0.f};
                sc_dot<0>(d, A, S);
                const float sa = (d[0] + d[1]) + (d[2] + d[3]);
                float y[4] = {0.f, 0.f, 0.f, 0.f};
                sc_upd3<0>(S, y, Wv, Bv, Kv, Rv, sa, vv);
                const float yy = (y[0] + y[1]) + (y[2] + y[3]);
                sv_cvt(A, ha); sv_cvt1p(Wv, hw); sv_cvt(Bv, hb); sv_cvt(Kv, hk); sv_cvt(Rv, hr); vv = (float)hv;
                YSC[(size_t)(ch * CL + blk * SCB + st) * W + h * 64 + lane] = f2bf(yy);
            }
        }
    }
}

__device__ __forceinline__ void phase_post(ArgsR a, const Ctx& c, int l) {
    const bf16* YSC = (const bf16*)(a.ws + WS_YSC); const f16* R = (const f16*)(a.ws + WS_R); const f16* KP = (const f16*)(a.ws + WS_KP); const f16* V = (const f16*)(a.ws + WS_V);
    const bf16* G = (const bf16*)(a.ws + WS_G); bf16* YA = (bf16*)(a.ws + WS_YA);
    const float* gng = a.in[I_GNG] + l * W; const float* gnb = a.in[I_GNB] + l * W; const float* rk = a.in[I_RK] + l * W;
    for (int t = c.gw; t < T; t += c.ngw) {
#pragma unroll
        for (int i = 0; i < 8; ++i) { const int n = c.lane + 64 * i; const size_t o = (size_t)t * W + n;
            const float y = bf2f(YSC[o]); const float mean = wave_sum(y) * (1.f / 64.f); const float d = y - mean; const float var = wave_sum(d * d) * (1.f / 64.f);
            float yn = d * (1.0f / sqrtf(var + GN_EPS)) * gng[n] + gnb[n];
            const float r = (float)R[o], k = (float)KP[o], v = (float)V[o];
            const float bonus = wave_sum(r * k * rk[n]);
            yn += bonus * v;
            YA[o] = f2bf(yn * bf2f(G[o])); }
    }
}

__device__ __forceinline__ void phase_ln1(ArgsR a, const Ctx& c, int l, float* outw) {
    const float* MODF = (const float*)(a.ws + WS_MODF) + l * 6144;
    const float* g1 = a.in[I_LN1G] + l * D; const float* b1 = a.in[I_LN1B] + l * D;
    bf16* XN = (bf16*)(a.ws + WS_XN);
    int* TOKI = (int*)(a.ws + WS_TOKI); float* TOKW = (float*)(a.ws + WS_TOKW); int* TOKP = (int*)(a.ws + WS_TOKP);
    const float* rw = a.in[I_RW]; const float* rb = a.in[I_RB];
    unsigned* lcnt = (unsigned*)(c.lds + 131072);
    if (c.tid < NE) lcnt[c.tid] = 0u;
    __syncthreads();
    for (int m = c.gw; m < T; m += c.ngw) {
        float v[16]; load_row16(a.out + (size_t)m * D, c.lane, v);
        float mean, rstd; row_stats(v, mean, rstd);
#pragma unroll
        for (int j = 0; j < 4; ++j) { f32x4 o; const int col = 4 * c.lane + 256 * j;
#pragma unroll
            for (int e = 0; e < 4; ++e) { v[4 * j + e] = (v[4 * j + e] - mean) * rstd * g1[col + e] + b1[col + e]; o[e] = v[4 * j + e]; }
            *(f32x4*)(outw + (size_t)m * D + col) = o; }
        row_stats(v, mean, rstd);
        float lg[16];
#pragma unroll
        for (int e = 0; e < 16; ++e) lg[e] = 0.f;
#pragma unroll
        for (int j = 0; j < 4; ++j) { f32x4 o; const int col = 4 * c.lane + 256 * j;
#pragma unroll
            for (int e = 0; e < 4; ++e) { const float h = (v[4 * j + e] - mean) * rstd * (1.0f + MODF[4096 + col + e]) + MODF[3072 + col + e]; o[e] = h;
                const f32x4* rr = (const f32x4*)(rw + (size_t)(col + e) * NE);
#pragma unroll
                for (int q = 0; q < 4; ++q) { const f32x4 r4 = rr[q]; lg[4 * q] += h * r4[0]; lg[4 * q + 1] += h * r4[1]; lg[4 * q + 2] += h * r4[2]; lg[4 * q + 3] += h * r4[3]; } }
            store4bf(XN + (size_t)m * D + col, o); }
        float sc[16], sel[16];
#pragma unroll
        for (int e = 0; e < 16; ++e) { sc[e] = 1.0f / (1.0f + expf(-wave_sum(lg[e]))); sel[e] = sc[e] + rb[e]; }
        int best = 0; float bestv = -INFINITY;
#pragma unroll
        for (int g = 0; g < 4; ++g) { float m1 = -INFINITY, m2 = -INFINITY;
#pragma unroll
            for (int q = 0; q < 4; ++q) { const float s = sel[4 * g + q]; if (s > m1) { m2 = m1; m1 = s; } else if (s > m2) m2 = s; }
            const float gs = m1 + m2; if (gs > bestv) { bestv = gs; best = g; } }
        int i1 = 0, i2 = 0; float s1 = -INFINITY, s2 = -INFINITY, w1 = 0.f, w2 = 0.f;
#pragma unroll
        for (int e = 0; e < 16; ++e) { if ((e >> 2) == best) { const float s = sel[e];
                if (s > s1) { s2 = s1; i2 = i1; w2 = w1; s1 = s; i1 = e; w1 = sc[e]; } else if (s > s2) { s2 = s; i2 = e; w2 = sc[e]; } } }
        if (c.lane == 0) { const float ws = w1 + w2;
            TOKI[2 * m] = i1; TOKI[2 * m + 1] = i2; TOKW[2 * m] = w1 / ws; TOKW[2 * m + 1] = w2 / ws;
            TOKP[2 * m] = (int)atomicAdd(&lcnt[i1], 1u); TOKP[2 * m + 1] = (int)atomicAdd(&lcnt[i2], 1u); }
    }
    __syncthreads();
    if (c.tid < NE) ((int*)(a.ws + WS_BLKCNT))[blockIdx.x * NE + c.tid] = (int)lcnt[c.tid];
    __syncthreads();
    float* scr = (float*)(c.lds + c.wave * 16384);
    bf16* WGU = (bf16*)(a.ws + WS_WGU); bf16* WD = (bf16*)(a.ws + WS_WD);
    constexpr int IG = (D / 64) * (FF / 32);
    constexpr int ID = (FF / 64) * (D / 32);
    for (int it = c.gw; it < NE * (2 * IG + ID); it += c.ngw) {
        const int e = it / (2 * IG + ID); int r = it % (2 * IG + ID);
        const size_t eo = ((size_t)l * NE + e) * (size_t)D * FF;
        if (r < IG) { transpose_matrix_item(a.in[I_EG] + eo, D, FF, WGU + (size_t)e * 1024 * 1024, r, scr, c.lane, RowGU{0}); continue; } r -= IG;
        if (r < IG) { transpose_matrix_item(a.in[I_EU] + eo, D, FF, WGU + (size_t)e * 1024 * 1024, r, scr, c.lane, RowGU{1}); continue; } r -= IG;
        transpose_matrix_item(a.in[I_ED] + eo, FF, D, WD + (size_t)e * 1024 * 512, r, scr, c.lane, RowId());
    }
}

__device__ __forceinline__ void phase_perm(ArgsR a, const Ctx& c, int l) {
    const int* BLKCNT = (const int*)(a.ws + WS_BLKCNT);
    LAS3 int* pre = (LAS3 int*)c.lds;
    LAS3 int* tot = pre + 256 * NE;
    const int nb = gridDim.x;
#pragma unroll
    for (int q = 0; q < 2; ++q) { const int e = 2 * c.wave + q; int v[4]; int sum = 0;
#pragma unroll
        for (int i = 0; i < 4; ++i) { const int b = 4 * c.lane + i; v[i] = b < nb ? BLKCNT[b * NE + e] : 0; sum += v[i]; }
        int inc = sum;
#pragma unroll
        for (int o = 1; o < 64; o <<= 1) { const int t = __shfl_up(inc, o); if (c.lane >= o) inc += t; }
        int run = inc - sum;
#pragma unroll
        for (int i = 0; i < 4; ++i) { pre[(4 * c.lane + i) * NE + e] = run; run += v[i]; }
        if (c.lane == 63) tot[e] = inc; }
    __syncthreads();
    int ts[17]; { int sacc = 0;
#pragma unroll
        for (int e = 0; e < 16; ++e) { ts[e] = sacc; sacc += (tot[e] + 255) >> 8; } ts[16] = sacc; }
    if (blockIdx.x == 0 && c.tid < NE) ((int*)(a.ws + WS_TOT))[c.tid] = tot[c.tid];
    const int* TOKI = (const int*)(a.ws + WS_TOKI); const int* TOKP = (const int*)(a.ws + WS_TOKP); int* S2T = (int*)(a.ws + WS_S2T);
    const bf16* XN = (const bf16*)(a.ws + WS_XN); bf16* XS = (bf16*)(a.ws + WS_XS);
    for (int as = c.gw; as < 2 * T; as += c.ngw) {
        const int e = TOKI[as]; int base = 0;
#pragma unroll
        for (int j = 0; j < 16; ++j) base = (j == e) ? ts[j] : base;
        const int m = as >> 1, blk = (m % c.ngw) >> 3;
        const int slot = base * 256 + pre[blk * NE + e] + TOKP[as];
        if (c.lane == 0) S2T[slot] = as;
        const u32x4* src = (const u32x4*)(XN + (size_t)m * D); u32x4* dst = (u32x4*)(XS + (size_t)slot * D);
        dst[c.lane] = src[c.lane]; dst[64 + c.lane] = src[64 + c.lane];
    }
    for (int e = 0; e < 16; ++e) {
        int tse = 0, tsn = 0;
#pragma unroll
        for (int j = 0; j < 16; ++j) { tse = (j == e) ? ts[j] : tse; tsn = (j == e) ? ts[j + 1] : tsn; }
        const int lo = tse * 256 + tot[e], hi = tsn * 256;
        for (int sl = lo + c.gw; sl < hi; sl += c.ngw) { if (c.lane == 0) S2T[sl] = -1; u32x4* dst = (u32x4*)(XS + (size_t)sl * D); const u32x4 zz = {0u, 0u, 0u, 0u}; dst[c.lane] = zz; dst[64 + c.lane] = zz; }
    }
    __syncthreads();
}

__device__ __forceinline__ void phase_ln2(ArgsR a, const Ctx& c, int l, float* outw) {
    const float* MODF = (const float*)(a.ws + WS_MODF) + l * 6144;
    const float* g2 = a.in[I_LN2G] + l * D; const float* b2 = a.in[I_LN2B] + l * D;
    const bf16* Y = (const bf16*)(a.ws + WS_Y); bf16* XN = (bf16*)(a.ws + WS_XN);
    for (int m = c.gw; m < T; m += c.ngw) {
        float v[16]; load_row16(a.out + (size_t)m * D, c.lane, v);
#pragma unroll
        for (int j = 0; j < 4; ++j) { const int col = 4 * c.lane + 256 * j; const f32x4 y0 = load4bf(Y + (size_t)(2 * m) * D + col), y1 = load4bf(Y + (size_t)(2 * m + 1) * D + col);
#pragma unroll
            for (int e = 0; e < 4; ++e) v[4 * j + e] = ALPHA * v[4 * j + e] + (1.0f + MODF[5120 + col + e]) * (y0[e] + y1[e]); }
        float mean, rstd; row_stats(v, mean, rstd);
#pragma unroll
        for (int j = 0; j < 4; ++j) { f32x4 o; const int col = 4 * c.lane + 256 * j;
#pragma unroll
            for (int e = 0; e < 4; ++e) { v[4 * j + e] = (v[4 * j + e] - mean) * rstd * g2[col + e] + b2[col + e]; o[e] = v[4 * j + e]; }
            *(f32x4*)(outw + (size_t)m * D + col) = o; }
        if (l + 1 < DEPTH) {
            const float* MN = MODF + 6144;
            row_stats(v, mean, rstd);
#pragma unroll
            for (int j = 0; j < 4; ++j) { f32x4 o; const int col = 4 * c.lane + 256 * j;
#pragma unroll
                for (int e = 0; e < 4; ++e) o[e] = (v[4 * j + e] - mean) * rstd * (1.0f + MN[1024 + col + e]) + MN[col + e];
                store4bf(XN + (size_t)m * D + col, o); }
        }
    }
}


template <class F> struct EpiAdapt {
    static constexpr bool PERM = false, AFTER_DRAIN = false; F f;
    __device__ __forceinline__ void operator()(const f32x4 (&acc)[2][2][4][2], const Unit& u, int wr, int wc, int fr, int fq) const {
#pragma unroll
        for (int ai = 0; ai < 2; ++ai)
#pragma unroll
            for (int m = 0; m < 4; ++m) { const int row = u.pm * 256 + ai * 128 + wr * 64 + m * 16 + fr;
#pragma unroll
                for (int n = 0; n < 2; ++n) { const int col = u.pn * 256 + wc * 32 + n * 16 + 4 * fq; f(row, col, acc[ai][0][m][n], acc[ai][1][m][n]); } }
    }
};

#ifndef USE_PG8
#define USE_PG8 1
#endif
template <class Sched, class F>
__device__ __forceinline__ void gemm_any(const Ctx& c, const bf16* A, const bf16* Bt, int M, int N, int K, const Sched& S, const F& f) {
#if USE_PG8
    pg8::Gemm g{A, Bt, M, N, K}; EpiAdapt<F> E{f};
    pg8::gemm_phase<EpiAdapt<F>, Sched, true, true>((PG8_LAS unsigned char*)c.lds, g, S, E);
#else
    gemm_simple(c, A, Bt, K, S, f);
#endif
}

#define LAS __attribute__((address_space(3)))
#define XB_TMO      128
#define XB_XCNT(j)  (256  + 64 * (j))
#define XB_XSUB(j)  (1280 + 64 * (j))
#define XB_XGEN(j)  (2304 + 64 * (j))
#define XB_TOP      3328
#define XB_TOPGEN   3392
#define XCD_BAR_WORDS 3456
#define XB_SPIN_CAP (1u << 24)

__device__ __forceinline__ unsigned xb_ld(unsigned* p)              { return __hip_atomic_load(p, __ATOMIC_RELAXED, __HIP_MEMORY_SCOPE_AGENT); }
__device__ __forceinline__ unsigned xb_add(unsigned* p, unsigned v) { return __hip_atomic_fetch_add(p, v, __ATOMIC_RELAXED, __HIP_MEMORY_SCOPE_AGENT); }
__device__ __forceinline__ unsigned xb_xcc_id() { return (unsigned)__builtin_amdgcn_s_getreg((3 << 11) | 20) & 0xFu; }
#define XB_SPIN(cond, bar) do { unsigned _sp = 0; while (cond) { __builtin_amdgcn_s_sleep(1); \
    if ((++_sp & 255u) == 0u) { if (xb_ld(&(bar)[XB_TMO])) break; if (_sp > XB_SPIN_CAP) { atomicAdd(&(bar)[XB_TMO], 1u); break; } } } } while (0)

struct XcdBarrier {
    unsigned* bar; unsigned x;
    volatile LAS unsigned* st;
};

__device__ __forceinline__ XcdBarrier xcd_barrier_post(unsigned* bar, volatile LAS unsigned* st) {
    XcdBarrier b; b.bar = bar; b.x = xb_xcc_id(); b.st = st;
    if (threadIdx.x == 0) (void)xb_add(&bar[XB_XCNT(b.x)], 1u);
    return b;
}
__device__ __forceinline__ void xcd_barrier_complete(unsigned* bar, unsigned x, unsigned& nloc, unsigned& nx) {
    const unsigned G = gridDim.x * gridDim.y * gridDim.z;
    unsigned sum, cnt, mine, sp = 0u;
    for (;;) {
        sum = 0u; cnt = 0u; mine = 0u;
#pragma unroll
        for (unsigned j = 0; j < 16; ++j) { const unsigned c = xb_ld(&bar[XB_XCNT(j)]); sum += c; cnt += (c > 0u) ? 1u : 0u; mine = (j == x) ? c : mine; }
        if (sum == G) break;
        __builtin_amdgcn_s_sleep(1);
        if ((++sp & 255u) == 0u) { if (xb_ld(&bar[XB_TMO])) break; if (sp > XB_SPIN_CAP) { atomicAdd(&bar[XB_TMO], 1u); break; } }
    }
    nloc = mine > 0u ? mine : 1u; nx = cnt > 0u ? cnt : 1u;
}

__device__ __forceinline__ void xcd_barrier(const XcdBarrier& b) {
    asm volatile("s_waitcnt vmcnt(0)" ::: "memory");
    __syncthreads();
    if (threadIdx.x == 0) {
        unsigned* bar = b.bar;
        __builtin_amdgcn_s_waitcnt(0);
        unsigned nloc = b.st[0], nx = b.st[1];
        if (nloc == 0u) { xcd_barrier_complete(bar, b.x, nloc, nx); b.st[0] = nloc; b.st[1] = nx; }
        const unsigned old = xb_add(&bar[XB_XSUB(b.x)], 1u);
        const unsigned gen = old / nloc;
        if (old + 1u == (gen + 1u) * nloc) {
            __builtin_amdgcn_fence(__ATOMIC_RELEASE, "agent");
            asm volatile("s_waitcnt vmcnt(0)" ::: "memory");
            const unsigned og = xb_add(&bar[XB_TOP], 1u);
            const unsigned tg = og / nx;
            if (og + 1u == (tg + 1u) * nx) xb_add(&bar[XB_TOPGEN], 1u);
            else XB_SPIN(xb_ld(&bar[XB_TOPGEN]) == tg, bar);
            __builtin_amdgcn_fence(__ATOMIC_ACQUIRE, "agent");
            xb_add(&bar[XB_XGEN(b.x)], 1u);
            asm volatile("s_waitcnt vmcnt(0)" ::: "memory");
        } else {
            XB_SPIN(xb_ld(&bar[XB_XGEN(b.x)]) == gen, bar);
            __builtin_amdgcn_fence(__ATOMIC_ACQUIRE, "agent");
            asm volatile("s_waitcnt vmcnt(0)" ::: "memory");
        }
    }
    __syncthreads();
}


constexpr int PH_PER_LAYER = 12, N_PHASES = 2 + PH_PER_LAYER * DEPTH;
constexpr int CW_BAR = 4096;
constexpr int LDS_BYTES = 147456, LDSCTL_OFF = 131072 + 8192;
#ifndef SINGLE_LAUNCH
#define SINGLE_LAUNCH 1
#endif

#ifndef PROBE_A
#define PROBE_A -1
#endif
#ifndef PROBE_B
#define PROBE_B -1
#endif
constexpr size_t WS_TS = 512 * 1024;
#if PROBE_A >= 0
#define STAMP(i) do { if (blockIdx.x == 0 && threadIdx.x == 0) ((unsigned long long*)(args_here()->ws + WS_TS))[(i)] = __builtin_amdgcn_s_memrealtime(); } while (0)
#else
#define STAMP(i) do { } while (0)
#endif
__device__ __forceinline__ const __attribute__((address_space(4))) Args* args_here() { const __attribute__((address_space(4))) Args* p = (const __attribute__((address_space(4))) Args*)__builtin_amdgcn_kernarg_segment_ptr(); asm volatile("" : "+s"(p)); return p; }
#ifndef REP_K
#define REP_K -1
#endif
#define PHASE1(k, ...) do { const __attribute__((address_space(4))) Args* ap_ = args_here(); if (ap_->ph_lo <= (k) && (k) < ap_->ph_hi) { ArgsR a = *ap_; __VA_ARGS__ } } while (0)
#define PHASE(k, ...) do { PHASE1(k, __VA_ARGS__); if ((k) == REP_K) { xcd_barrier(bar); PHASE1(k, __VA_ARGS__); xcd_barrier(bar); PHASE1(k, __VA_ARGS__); } } while (0)

template <int L>
__device__ __forceinline__ void run_layer(const Ctx& c, const XcdBarrier& bar) {
    const int G = gridDim.x, b = blockIdx.x;
#define BAR() do { xcd_barrier(bar); STAMP(3 + 14 * L + (bk_++)); } while (0)
    int bk_ = 0;
    PHASE(0, unsigned char* ws = a.ws; pg8::StaticOrder S; S.init(T, INC, G, b); EpiZ E{(bf16*)(ws + WS_ZR), (bf16*)(ws + WS_ZS), (bf16*)(ws + WS_ZG)};
        gemm_any(c, (const bf16*)(ws + WS_XN), (const bf16*)(ws + WS_WIN + (size_t)L * 10 * MiB), T, INC, D, S, E); );
    BAR();
    PHASE(1, phase_prep_fast(a, c, L); );
    PHASE(1, phase_sg_fast(a, c, L); );
    BAR();
    PHASE(2, phase_scan1(a, c); );
    BAR();
    PHASE(3, phase_scan2a(a, c); );
    BAR();
    PHASE(31, phase_scan2b(a, c); );
    BAR();
    PHASE(32, phase_scan2c(a, c); );
    BAR();
    PHASE(4, phase_scan3(a, c); );
    BAR();
    PHASE(5, phase_post(a, c, L); );
    BAR();
    PHASE(6, unsigned char* ws = a.ws; pg8::StaticOrder S; S.init(T, D, G, b); EpiGA E{(const bf16*)(ws + WS_ZG), (bf16*)(ws + WS_MP)};
        gemm_any(c, (const bf16*)(ws + WS_YA), (const bf16*)(ws + WS_WA + (size_t)L * WS_WL1), T, D, W, S, E); );
    BAR();
    PHASE(7, unsigned char* ws = a.ws; pg8::StaticOrder S; S.init(T, D, G, b); EpiGB E{(const bf16*)(ws + WS_ZG), (bf16*)(ws + WS_MP)};
        gemm_any(c, (const bf16*)(ws + WS_YB), (const bf16*)(ws + WS_WB + (size_t)L * WS_WL1), T, D, W, S, E); );
    BAR();
    PHASE(8, unsigned char* ws = a.ws; pg8::StaticOrder S; S.init(T, D, G, b); EpiOut E{L == 0 ? a.in[I_X] : a.out, a.out, (const float*)(ws + WS_MODF) + L * 6144 + 2048};
        gemm_any(c, (const bf16*)(ws + WS_MP), (const bf16*)(ws + WS_WO + (size_t)L * WS_WL1), T, D, D, S, E); );
    BAR();
#if REP_K == 9
    PHASE1(9, phase_ln1(a, c, L, (float*)(a.ws + WS_ZR)); ); xcd_barrier(bar); PHASE1(9, phase_ln1(a, c, L, (float*)(a.ws + WS_ZR)); ); xcd_barrier(bar);
#endif
    PHASE1(9, phase_ln1(a, c, L, a.out); );
    BAR();
    PHASE(10, phase_perm(a, c, L); );
    BAR();
    PHASE(11, unsigned char* ws = a.ws; MoeSched S; S.init((const unsigned*)(ws + WS_TOT), G, b); EpiSwi E{(bf16*)(ws + WS_HID)};
        gemm_any(c, (const bf16*)(ws + WS_XS), (const bf16*)(ws + WS_WGU), MAXSLOT, NE * 1024, D, S, E); );
    BAR();
    PHASE(12, unsigned char* ws = a.ws; MoeSched S; S.init((const unsigned*)(ws + WS_TOT), G, b); EpiDown E{(const int*)(ws + WS_S2T), (const float*)(ws + WS_TOKW), (bf16*)(ws + WS_Y)};
        gemm_any(c, (const bf16*)(ws + WS_HID), (const bf16*)(ws + WS_WD), MAXSLOT, NE * 1024, FF, S, E); );
    BAR();
#if REP_K == 13
    PHASE1(13, phase_ln2(a, c, L, (float*)(a.ws + WS_R)); ); xcd_barrier(bar); PHASE1(13, phase_ln2(a, c, L, (float*)(a.ws + WS_R)); ); xcd_barrier(bar);
#endif
    PHASE1(13, phase_ln2(a, c, L, a.out); );
    if (L + 1 < DEPTH) BAR();
    (void)bk_;
#undef BAR
}

__global__ void __launch_bounds__(NTHREADS, 2) mk_fwd(Args a_unused) {
    extern __shared__ __attribute__((aligned(16))) unsigned char lds[];
    Ctx c; c.tid = threadIdx.x; c.lane = c.tid & 63; c.wave = __builtin_amdgcn_readfirstlane(c.tid >> 6);
    c.gw = blockIdx.x * NWAVES + c.wave; c.ngw = gridDim.x * NWAVES; c.lds = lds;
    for (int u = c.tid; u < (LDS_BYTES - LDSCTL_OFF) / 4; u += NTHREADS) ((LAS unsigned*)((LAS unsigned char*)lds + LDSCTL_OFF))[u] = 0u;
    __syncthreads();
    const XcdBarrier bar = xcd_barrier_post((unsigned*)(args_here()->ws + WS_CTL) + CW_BAR, (volatile LAS unsigned*)((LAS unsigned char*)lds + LDSCTL_OFF) + 8);
    STAMP(0);
    PHASE(100, phase_p0a(a, c); );
    xcd_barrier(bar); STAMP(1);
    PHASE(101, phase_p0b(a, c); );
    xcd_barrier(bar); STAMP(2);
    run_layer<0>(c, bar);
    run_layer<1>(c, bar);
#if PROBE_A >= 0
    if (blockIdx.x == 0) {
        asm volatile("s_waitcnt vmcnt(0)" ::: "memory"); __syncthreads();
        if (c.tid == 0) ((unsigned long long*)(args_here()->ws + WS_TS))[30] = __builtin_amdgcn_s_memrealtime();
        asm volatile("s_waitcnt vmcnt(0)" ::: "memory"); __syncthreads();
        const volatile unsigned long long* ts = (const volatile unsigned long long*)(args_here()->ws + WS_TS);
        float da = 0.f, db = 0.f;
        if (PROBE_A < 14) { da = (float)(ts[3 + PROBE_A] - ts[2 + PROBE_A]) + (float)(ts[17 + PROBE_A] - ts[16 + PROBE_A]); } else if (PROBE_A == 14) da = (float)(ts[1] - ts[0]); else if (PROBE_A == 15) da = (float)(ts[2] - ts[1]); else da = (float)(ts[30] - ts[0]);
        if (PROBE_B >= 0 && PROBE_B < 14) { db = (float)(ts[3 + PROBE_B] - ts[2 + PROBE_B]) + (float)(ts[17 + PROBE_B] - ts[16 + PROBE_B]); } else if (PROBE_B == 14) db = (float)(ts[1] - ts[0]); else if (PROBE_B == 15) db = (float)(ts[2] - ts[1]);
        da *= 0.01f; db *= 0.01f;
        da = exp2f(0.25f * rintf(4.0f * log2f(fmaxf(da, 0.5f)))); db = exp2f(0.25f * rintf(4.0f * log2f(fmaxf(db, 0.5f))));
        float* out = args_here()->out;
        for (int i = c.tid; i < 16 * 1024; i += NTHREADS) { const int r = i >> 10, col = i & 1023; const int rowi = (r & 7) + 2048 * (r >> 3); out[(size_t)rowi * D + col] = da; }
        if (c.tid == 0 && PROBE_B >= 0) out[(size_t)4096 * D] = 100.0f * db;
    }
#endif
}

extern "C" void kernel_launch(void* const* d_in, const int* in_sizes, int n_in, void* d_out, int out_size, void* d_ws, size_t ws_size, hipStream_t stream) {
    static int grid = 0;
    if (grid == 0) {
        if (n_in != N_IN || out_size != T * D || ws_size < WS_END) { fprintf(stderr, "kernel_launch: unexpected shapes: n_in %d out %d ws %zu (need %zu)\n", n_in, out_size, ws_size, (size_t)WS_END); grid = -1; return; }
        int dev = 0, cus = 0;
        (void)hipGetDevice(&dev); (void)hipDeviceGetAttribute(&cus, hipDeviceAttributeMultiprocessorCount, dev);
        if (hipFuncSetAttribute((const void*)mk_fwd, hipFuncAttributeMaxDynamicSharedMemorySize, LDS_BYTES) != hipSuccess) { fprintf(stderr, "kernel_launch: hipFuncSetAttribute failed\n"); grid = -1; return; }
        grid = cus > 0 ? cus : 256;
        fprintf(stderr, "kernel_launch: ws_size %zu grid %d\n", ws_size, grid);
    }
    if (grid < 0) return;
    (void)hipMemsetAsync((char*)d_ws + WS_CTL, 0, CTL_BYTES, stream);
    Args a{};
    for (int i = 0; i < N_IN; ++i) a.in[i] = (const float*)d_in[i];
    a.out = (float*)d_out; a.ws = (unsigned char*)d_ws;
    a.ph_lo = 0; a.ph_hi = 1000;
    hipLaunchKernelGGL(mk_fwd, dim3(grid), dim3(NTHREADS), LDS_BYTES, stream, a);
}
```

```cpp
#include <hip/hip_runtime.h>
#include <cstdio>
#include <cstdint>
#include <utility>

typedef unsigned short bf16;
typedef _Float16 f16;
typedef float f32x4 __attribute__((ext_vector_type(4)));
typedef unsigned u32x4 __attribute__((ext_vector_type(4)));
typedef unsigned u32x2 __attribute__((ext_vector_type(2)));

constexpr int T = 16384, D = 1024, W = 512, NH = 8, HN = 64, RC = 1792, INC = 4864;
constexpr int NE = 16, FF = 512, DEPTH = 2;
constexpr float LN_EPS = 1e-5f, GN_EPS = 64e-5f, ALPHA = 1.41421356237f;
constexpr int NTHREADS = 512, NWAVES = 8;
constexpr int MAXSLOT = 36864;

constexpr size_t MiB = 1u << 20;
constexpr size_t WS_CTL = 0, CTL_BYTES = 1 * MiB;
constexpr int CW_CNT = 16384;
constexpr size_t WS_PART = 1 * MiB;
constexpr size_t WS_MODF = 2 * MiB;
constexpr size_t WS_TOKI = 2 * MiB + 65536;
constexpr size_t WS_TOKW = WS_TOKI + 131072;
constexpr size_t WS_TOKP = WS_TOKW + 131072;
constexpr size_t WS_S2T = 3 * MiB;
constexpr size_t WS_BLKCNT = 3 * MiB + 512 * 1024;
constexpr size_t WS_TOT = WS_BLKCNT + 32768;
constexpr size_t WS_LORA = 4 * MiB;
constexpr size_t WS_WIN = 8 * MiB;
constexpr size_t WS_WA = 28 * MiB, WS_WB = 29 * MiB, WS_WO = 30 * MiB, WS_WL1 = 4 * MiB;
constexpr size_t WS_ZG = 36 * MiB;
constexpr size_t WS_XN = 100 * MiB;
constexpr size_t WS_G = 100 * MiB, WS_YB = 116 * MiB;
constexpr size_t WS_ZR = 132 * MiB;
constexpr size_t WS_ZS = 188 * MiB;
constexpr size_t WS_YSC = 132 * MiB;
constexpr size_t WS_ST = 148 * MiB;
constexpr size_t WS_YA = 148 * MiB;
constexpr size_t WS_MP = 164 * MiB;
constexpr size_t WS_XS = 132 * MiB;
constexpr size_t WS_Y = 132 * MiB;
constexpr size_t WS_R = 224 * MiB, WS_WM1 = 240 * MiB, WS_KP = 256 * MiB, WS_AA = 272 * MiB, WS_BB = 288 * MiB, WS_V = 304 * MiB;
constexpr size_t WS_WGU = 224 * MiB;
constexpr size_t WS_WD = 256 * MiB;
constexpr size_t WS_HID = 272 * MiB;
constexpr size_t WS_VF = 320 * MiB;
constexpr size_t WS_END = 336 * MiB;

constexpr size_t LO_W2T = 0, LO_A2T = 65536, LO_G2T = 131072, LO_VM1T = 262144, LO_VM2T = 294912, LO_STRIDE = 524288;

enum { I_X = 0, I_C, I_WMOD, I_BMOD, I_WIN, I_MU, I_W0, I_W2, I_A0, I_A2, I_G2, I_KK, I_KA, I_RK, I_GNG, I_GNB, I_VM0, I_VM1, I_VM2,
       I_SGG, I_SGB, I_WS, I_BS, I_WBA, I_WBB, I_WOUT, I_LN1G, I_LN1B, I_RW, I_RB, I_EG, I_EU, I_ED, I_LN2G, I_LN2B, N_IN };

struct Args { const float* in[N_IN]; float* out; unsigned char* ws; int ph_lo, ph_hi; };
typedef const __attribute__((address_space(4))) Args& ArgsR;

__device__ __forceinline__ float bf2f(bf16 h) { return __uint_as_float(((unsigned)h) << 16); }
__device__ __forceinline__ unsigned f2bfu(float f) { unsigned u = __float_as_uint(f); return (u + 0x7fffu + ((u >> 16) & 1u)) >> 16; }
__device__ __forceinline__ bf16 f2bf(float f) { return __builtin_bit_cast(unsigned short, (__bf16)f); }
typedef __bf16 bf16x2_t __attribute__((ext_vector_type(2)));
__device__ __forceinline__ unsigned pk2(float lo, float hi) { bf16x2_t v; v[0] = (__bf16)lo; v[1] = (__bf16)hi; return __builtin_bit_cast(unsigned, v); }
__device__ __forceinline__ void store4bf(bf16* p, f32x4 v) { u32x2 w; w.x = pk2(v[0], v[1]); w.y = pk2(v[2], v[3]); *(u32x2*)p = w; }
__device__ __forceinline__ f32x4 load4bf(const bf16* p) { u32x2 w = *(const u32x2*)p; f32x4 r; r[0] = __uint_as_float(w.x << 16); r[1] = __uint_as_float(w.x & 0xffff0000u); r[2] = __uint_as_float(w.y << 16); r[3] = __uint_as_float(w.y & 0xffff0000u); return r; }
__device__ __forceinline__ float wave_sum(float v) {
#pragma unroll
    for (int o = 1; o < 64; o <<= 1) v += __shfl_xor(v, o);
    return v;
}
__device__ __forceinline__ float sigmoidf_(float x) { return __builtin_amdgcn_rcpf(1.0f + __expf(-x)); }
__device__ __forceinline__ float siluf_(float x) { return x * sigmoidf_(x); }
__device__ __forceinline__ float gelu_tanh(float x) { const float u = 0.7978845608028654f * (x + 0.044715f * x * x * x); return x * (1.0f - __builtin_amdgcn_rcpf(1.0f + __expf(2.0f * u))); }
__device__ __forceinline__ float softplusf_(float y) { return fmaxf(y, 0.f) + log1pf(__expf(-fabsf(y))); }

struct Ctx { int tid, lane, wave, gw, ngw; unsigned char* lds; };

__device__ __forceinline__ void transpose_item(const float* Wsrc, int N, int k0, int n0, bf16* dst, int ldk, float* scr, int lane) {
    float tv[32];
#pragma unroll
    for (int i = 0; i < 32; ++i) tv[i] = Wsrc[(size_t)(k0 + 2 * i + (lane >> 5)) * N + n0 + (lane & 31)];
#pragma unroll
    for (int i = 0; i < 32; ++i) scr[(2 * i + (lane >> 5)) * 33 + (lane & 31)] = tv[i];
    asm volatile("s_waitcnt lgkmcnt(0)" ::: "memory");
    const int c = lane & 7;
#pragma unroll
    for (int j = 0; j < 4; ++j) { const int n = (lane >> 3) + 8 * j; const float* s = scr + (8 * c) * 33 + n;
        u32x4 o; o.x = pk2(s[0 * 33], s[1 * 33]); o.y = pk2(s[2 * 33], s[3 * 33]); o.z = pk2(s[4 * 33], s[5 * 33]); o.w = pk2(s[6 * 33], s[7 * 33]);
        *(u32x4*)(dst + (size_t)n * ldk + k0 + 8 * c) = o; }
    asm volatile("s_waitcnt lgkmcnt(0)" ::: "memory");
}
template <class RowMap>
__device__ __forceinline__ void transpose_matrix_item(const float* Wsrc, int K, int N, bf16* dst, int item, float* scr, int lane, const RowMap& rm) {
    const int nblk = N / 32, kb = item / nblk, nb = item % nblk, n0 = 32 * nb;
    transpose_item(Wsrc, N, 64 * kb, n0, dst + (size_t)rm(n0) * K, K, scr, lane);
}
struct RowId { __device__ __forceinline__ int operator()(int n) const { return n; } };
struct RowGU { int up; __device__ __forceinline__ int operator()(int n) const { return (n >> 7) * 256 + (n & 127) + up * 128; } };

__device__ __forceinline__ void phase_p0a(ArgsR a, const Ctx& c) {
    float* scr = (float*)(c.lds + c.wave * 16384);
    { float* MODF = (float*)(a.ws + WS_MODF); float* red = (float*)(c.lds + 131072);
      for (int cbk = blockIdx.x; cbk < 2 * 96; cbk += gridDim.x) {
          const int l = cbk / 96, n = (cbk % 96) * 64 + c.lane;
          const float* wm = a.in[I_WMOD] + (size_t)l * D * 6144 + (size_t)(c.wave * 128) * 6144 + n;
          float acc0 = 0.f, acc1 = 0.f;
#pragma unroll 16
          for (int k = 0; k < 128; k += 2) { acc0 += siluf_(a.in[I_C][c.wave * 128 + k]) * wm[(size_t)k * 6144]; acc1 += siluf_(a.in[I_C][c.wave * 128 + k + 1]) * wm[(size_t)(k + 1) * 6144]; }
          red[c.wave * 64 + c.lane] = acc0 + acc1;
          __syncthreads();
          if (c.wave == 0) { float sacc = a.in[I_BMOD][l * 6144 + n];
#pragma unroll
              for (int w = 0; w < 8; ++w) sacc += red[w * 64 + c.lane];
              MODF[l * 6144 + n] = sacc; }
          __syncthreads();
      } }
    for (int it = c.gw; it < 2 * (16 + 16 + 32 + 8); it += c.ngw) {
        const int l = it / 72; int r = it % 72; unsigned char* lo = a.ws + WS_LORA + (size_t)l * LO_STRIDE;
        if (r < 16) { transpose_matrix_item(a.in[I_W2] + (size_t)l * 64 * W, 64, W, (bf16*)(lo + LO_W2T), r, scr, c.lane, RowId()); continue; } r -= 16;
        if (r < 16) { transpose_matrix_item(a.in[I_A2] + (size_t)l * 64 * W, 64, W, (bf16*)(lo + LO_A2T), r, scr, c.lane, RowId()); continue; } r -= 16;
        if (r < 32) { transpose_matrix_item(a.in[I_G2] + (size_t)l * 128 * W, 128, W, (bf16*)(lo + LO_G2T), r, scr, c.lane, RowId()); continue; } r -= 32;
        if (l == 1) transpose_matrix_item(a.in[I_VM1], W, 32, (bf16*)(lo + LO_VM1T), r, scr, c.lane, RowId());
    }
    for (int i = blockIdx.x * NTHREADS + c.tid; i < 32 * W; i += gridDim.x * NTHREADS) { const int n = i >> 5, k = i & 31;
        ((bf16*)(a.ws + WS_LORA + LO_STRIDE + LO_VM2T))[i] = f2bf(a.in[I_VM2][(size_t)k * W + n]); }
    constexpr int I_WINL = (D / 64) * (INC / 32);
    constexpr int I_WAL = (W / 64) * (D / 32);
    constexpr int I_WOL = (D / 64) * (D / 32);
    constexpr int PER_L = I_WINL + 2 * I_WAL + I_WOL;
    for (int it = c.gw; it < 2 * PER_L; it += c.ngw) {
        const int l = it / PER_L; int r = it % PER_L;
        if (r < I_WINL) { transpose_matrix_item(a.in[I_WIN] + (size_t)l * D * INC, D, INC, (bf16*)(a.ws + WS_WIN + (size_t)l * 10 * MiB), r, scr, c.lane, RowId()); continue; } r -= I_WINL;
        if (r < I_WAL) { transpose_matrix_item(a.in[I_WBA] + (size_t)l * W * D, W, D, (bf16*)(a.ws + WS_WA + (size_t)l * WS_WL1), r, scr, c.lane, RowId()); continue; } r -= I_WAL;
        if (r < I_WAL) { transpose_matrix_item(a.in[I_WBB] + (size_t)l * W * D, W, D, (bf16*)(a.ws + WS_WB + (size_t)l * WS_WL1), r, scr, c.lane, RowId()); continue; } r -= I_WAL;
        transpose_matrix_item(a.in[I_WOUT] + (size_t)l * D * D, D, D, (bf16*)(a.ws + WS_WO + (size_t)l * WS_WL1), r, scr, c.lane, RowId());
    }
}

__device__ __forceinline__ void row_stats(const float (&v)[16], float& mean, float& rstd) {
    float s = 0.f;
#pragma unroll
    for (int j = 0; j < 16; ++j) s += v[j];
    mean = wave_sum(s) * (1.f / D);
    float q = 0.f;
#pragma unroll
    for (int j = 0; j < 16; ++j) { const float d = v[j] - mean; q += d * d; }
    rstd = __builtin_amdgcn_rsqf(wave_sum(q) * (1.f / D) + LN_EPS);
}
__device__ __forceinline__ void load_row16(const float* p, int lane, float (&v)[16]) {
#pragma unroll
    for (int j = 0; j < 4; ++j) { const f32x4 x = *(const f32x4*)(p + 4 * lane + 256 * j); v[4 * j] = x[0]; v[4 * j + 1] = x[1]; v[4 * j + 2] = x[2]; v[4 * j + 3] = x[3]; }
}

__device__ __forceinline__ void phase_p0b(ArgsR a, const Ctx& c) {
    const float* MODF = (const float*)(a.ws + WS_MODF);
    float sh[16], sc[16];
#pragma unroll
    for (int j = 0; j < 4; ++j) { const f32x4 s0 = *(const f32x4*)(MODF + 4 * c.lane + 256 * j), s1 = *(const f32x4*)(MODF + 1024 + 4 * c.lane + 256 * j);
#pragma unroll
        for (int e = 0; e < 4; ++e) { sh[4 * j + e] = s0[e]; sc[4 * j + e] = 1.f + s1[e]; } }
    bf16* XN = (bf16*)(a.ws + WS_XN);
    for (int m = c.gw; m < T; m += c.ngw) {
        float v[16]; load_row16(a.in[I_X] + (size_t)m * D, c.lane, v);
        float mean, rstd; row_stats(v, mean, rstd);
#pragma unroll
        for (int j = 0; j < 4; ++j) { f32x4 o;
#pragma unroll
            for (int e = 0; e < 4; ++e) o[e] = (v[4 * j + e] - mean) * rstd * sc[4 * j + e] + sh[4 * j + e];
            store4bf(XN + (size_t)m * D + 4 * c.lane + 256 * j, o); }
    }
}

namespace pg8 {
#define PG8_LAS __attribute__((address_space(3)))
typedef unsigned short bf16_t;
typedef short bf16x8 __attribute__((ext_vector_type(8)));
typedef float f32x4 __attribute__((ext_vector_type(4)));
typedef unsigned u32x4 __attribute__((ext_vector_type(4)));
constexpr int BM = 256, BK = 64, HALF = 128, HTB = HALF * BK * 2  , STAGE_BYTES = 8 * HTB, NXCD = 8, WGM = 8;

__host__ __device__ __forceinline__ int lds_byte(int r, int c) { const int st = (r >> 4) * 2 + (c >> 5), rr = r & 15, cc = c & 31, ob = rr * 64 + cc * 2; return st * 1024 + (ob ^ (((ob >> 9) & 1) << 5)); }
__host__ __device__ __forceinline__ void stage_rc(int b, int& R, int& C) { const int st = b / 1024, sb = b % 1024, swz = sb ^ (((sb >> 9) & 1) << 5); R = (st >> 1) * 16 + swz / 64; C = (st & 1) * 32 + (swz % 64) / 2; }
__host__ __device__ __forceinline__ int perm32(int rho) { const int n = rho >> 4, i = rho & 15; return 8 * (i >> 2) + 4 * n + (i & 3); }

struct Unit { int pm, pn; };
struct Gemm { const bf16_t* A; const bf16_t* Bt; int M, N, K; };

struct StaticOrder {
    int nM, nN, nwg, G, c;
    __host__ __device__ void init(int M, int N, int G_, int c_) { nM = M / BM; nN = N / BM; nwg = nM * nN; G = G_; c = c_; }
    __host__ __device__ bool next(int i, Unit& u) const {
        const long L = (long)i * G + c; if (L >= nwg) return false;
        int wgid = (int)L; { const int q = nwg / NXCD, r = nwg % NXCD, xcd = wgid % NXCD, off = wgid / NXCD; wgid = (xcd < r ? xcd * (q + 1) : r * (q + 1) + (xcd - r) * q) + off; }
        const int nig = WGM * nN, gid = wgid / nig, fm = gid * WGM, gsz = (nM - fm) < WGM ? (nM - fm) : WGM;
        u.pm = fm + ((wgid % nig) % gsz); u.pn = (wgid % nig) / gsz; return true;
    }
    __device__ __forceinline__ void a_ready(const Unit&) const {}
    __device__ __forceinline__ void done(const Unit&) const {}
};


template <class Epi, class Sched, bool ALIGN_EPI = false, bool SP2 = false>
__device__ __forceinline__ void gemm_phase(PG8_LAS unsigned char* lds, const Gemm g, const Sched& S, const Epi& E, const int tid_in) {
    const int tid = tid_in, wid = __builtin_amdgcn_readfirstlane(tid >> 6), lane = tid & 63, wr = wid >> 2, wc = wid & 3, fr = lane & 15, fq = lane >> 4;
    const int K = g.K, nt = K / BK;
    unsigned voffA[2], voffB[2];
#pragma unroll
    for (int i = 0; i < 2; ++i) { int R, C; stage_rc(tid * 16 + i * 8192, R, C); const int Rb = Epi::PERM ? ((R & ~31) + perm32(R & 31)) : R;
        voffA[i] = (unsigned)(R * K + C) * 2u; voffB[i] = (unsigned)(Rb * K + C) * 2u; }
    const size_t kstep = (size_t)(BK * 2);
    const size_t hstep = (size_t)HALF * K * 2;
    const size_t tstep = 2 * hstep;
    const unsigned ldsw = (unsigned)wid * 1024u;
    const int aoff = lds_byte(wr * 64 + fr, fq * 8), boff = lds_byte(wc * 32 + fr, fq * 8);
#define PG8_SA(b, h) (((b) * 2 + (h)) * HTB)
#define PG8_SB(b, h) ((4 + (b) * 2 + (h)) * HTB)
#define PG8_STAGE(bufoff, gbase, voff) do { _Pragma("unroll") for (int _i = 0; _i < 2; ++_i) \
        __builtin_amdgcn_global_load_lds((const unsigned*)((const char*)(gbase) + (voff)[_i]), (PG8_LAS unsigned*)(lds + (bufoff) + ldsw + _i * 8192), 16, 0, 0); } while (0)
#define PG8_LDA(dst, b, h) do { _Pragma("unroll") for (int m = 0; m < 4; ++m) _Pragma("unroll") for (int k = 0; k < 2; ++k) dst[m][k] = *(const PG8_LAS bf16x8*)(lds + PG8_SA(b, h) + aoff + m * 2048 + k * 1024); } while (0)
#define PG8_LDB(dst, b, h) do { _Pragma("unroll") for (int n = 0; n < 2; ++n) _Pragma("unroll") for (int k = 0; k < 2; ++k) dst[n][k] = *(const PG8_LAS bf16x8*)(lds + PG8_SB(b, h) + boff + n * 2048 + k * 1024); } while (0)
#define PG8_MMA(ai, bj, At, Bt) do { __builtin_amdgcn_s_setprio(1); _Pragma("unroll") for (int m = 0; m < 4; ++m) _Pragma("unroll") for (int n = 0; n < 2; ++n) _Pragma("unroll") for (int k = 0; k < 2; ++k) \
        acc[ai][bj][m][n] = __builtin_amdgcn_mfma_f32_16x16x32_bf16(Bt[n][k], At[m][k], acc[ai][bj][m][n], 0, 0, 0); __builtin_amdgcn_s_setprio(0); } while (0)
#define PG8_WAIT_V(n) asm volatile("s_waitcnt vmcnt(" #n ")" ::: "memory")
#define PG8_WAIT_L(n) asm volatile("s_waitcnt lgkmcnt(" #n ")" ::: "memory")
#define PG8_BAR __builtin_amdgcn_s_barrier()
#define PG8_SCHED __builtin_amdgcn_sched_barrier(0)
    Unit cur, nxt; int ui = 0;
    if (!S.next(0, cur)) return;
    f32x4 acc[2][2][4][2];
#pragma unroll
    for (int a = 0; a < 2; ++a)
#pragma unroll
        for (int b = 0; b < 2; ++b)
#pragma unroll
            for (int m = 0; m < 4; ++m)
#pragma unroll
                for (int n = 0; n < 2; ++n) acc[a][b][m][n] = (f32x4){0.f, 0.f, 0.f, 0.f};
    bf16x8 At[4][2], B0[2][2], B1[2][2];
    const char* cA = (const char*)g.A + (size_t)cur.pm * tstep; const char* cB = (const char*)g.Bt + (size_t)cur.pn * tstep;
    S.a_ready(cur);
    if constexpr (SP2) {
        PG8_STAGE(PG8_SB(0, 0), cB, voffB); PG8_STAGE(PG8_SB(0, 1), cB + hstep, voffB); PG8_STAGE(PG8_SA(0, 0), cA, voffA); PG8_STAGE(PG8_SA(0, 1), cA + hstep, voffA);
        if (wr == 1) PG8_BAR;
        PG8_WAIT_V(2); PG8_BAR;
        PG8_STAGE(PG8_SB(1, 0), cB + kstep, voffB); PG8_STAGE(PG8_SA(1, 0), cA + kstep, voffA); PG8_STAGE(PG8_SB(1, 1), cB + hstep + kstep, voffB);
        PG8_WAIT_V(6); PG8_BAR;
    } else {
        PG8_STAGE(PG8_SB(0, 0), cB, voffB); PG8_STAGE(PG8_SA(0, 0), cA, voffA); PG8_STAGE(PG8_SB(0, 1), cB + hstep, voffB); PG8_STAGE(PG8_SA(0, 1), cA + hstep, voffA);
        if (wr == 1) PG8_BAR;
        PG8_WAIT_V(4); PG8_BAR;
        PG8_STAGE(PG8_SB(1, 0), cB + kstep, voffB); PG8_STAGE(PG8_SA(1, 0), cA + kstep, voffA); PG8_STAGE(PG8_SB(1, 1), cB + hstep + kstep, voffB);
        PG8_WAIT_V(6); PG8_BAR;
    }
    for (;;) {
        const bool has_next = S.next(ui + 1, nxt);
        const char* nA = has_next ? (const char*)g.A + (size_t)nxt.pm * tstep : cA; const char* nB = has_next ? (const char*)g.Bt + (size_t)nxt.pn * tstep : cB;
        for (int t = 0; t < nt; t += 2) {
            const bool last = (t == nt - 2);
            const char* a1 = cA + (size_t)(t + 1) * kstep;
            const char* a2 = last ? nA : cA + (size_t)(t + 2) * kstep; const char* b2 = last ? nB : cB + (size_t)(t + 2) * kstep;
            const char* a3 = a2 + kstep; const char* b3 = b2 + kstep;
            if (last && has_next) S.a_ready(nxt);
            if constexpr (SP2) {
            PG8_LDB(B0, 0, 0); PG8_LDB(B1, 0, 1); PG8_SCHED; PG8_LDA(At, 0, 0); PG8_STAGE(PG8_SA(1, 1), a1 + hstep, voffA);
            PG8_WAIT_V(8); PG8_WAIT_L(0); PG8_BAR; PG8_MMA(0, 0, At, B0); PG8_MMA(0, 1, At, B1); PG8_BAR; PG8_SCHED;
            PG8_LDA(At, 0, 1); PG8_STAGE(PG8_SB(0, 0), b2, voffB); PG8_STAGE(PG8_SB(0, 1), b2 + hstep, voffB); PG8_STAGE(PG8_SA(0, 0), a2, voffA);
            PG8_WAIT_V(8); PG8_WAIT_L(0); PG8_BAR; PG8_MMA(1, 0, At, B0); PG8_MMA(1, 1, At, B1); PG8_BAR; PG8_SCHED;
            PG8_LDB(B0, 1, 0); PG8_LDB(B1, 1, 1); PG8_SCHED; PG8_LDA(At, 1, 0); PG8_STAGE(PG8_SA(0, 1), a2 + hstep, voffA);
            PG8_WAIT_V(8); PG8_WAIT_L(0); PG8_BAR; PG8_MMA(0, 0, At, B0); PG8_MMA(0, 1, At, B1); PG8_BAR; PG8_SCHED;
            PG8_LDA(At, 1, 1); PG8_STAGE(PG8_SB(1, 0), b3, voffB); PG8_STAGE(PG8_SB(1, 1), b3 + hstep, voffB); PG8_STAGE(PG8_SA(1, 0), a3, voffA);
            PG8_WAIT_V(8); PG8_WAIT_L(0); PG8_BAR; PG8_MMA(1, 0, At, B0); PG8_MMA(1, 1, At, B1); PG8_BAR; PG8_SCHED;
            } else {
            PG8_LDB(B0, 0, 0); PG8_SCHED; PG8_LDA(At, 0, 0); PG8_STAGE(PG8_SA(1, 1), a1 + hstep, voffA);
            PG8_WAIT_L(8); PG8_BAR; PG8_WAIT_L(0); PG8_MMA(0, 0, At, B0); PG8_BAR; PG8_SCHED;
            PG8_LDB(B1, 0, 1); PG8_STAGE(PG8_SB(0, 0), b2, voffB);
            PG8_BAR; PG8_WAIT_L(0); PG8_MMA(0, 1, At, B1); PG8_BAR;
            PG8_LDA(At, 0, 1); PG8_STAGE(PG8_SA(0, 0), a2, voffA);
            PG8_BAR; PG8_WAIT_L(0); PG8_MMA(1, 0, At, B0); PG8_BAR; PG8_SCHED;
            PG8_STAGE(PG8_SB(0, 1), b2 + hstep, voffB);
            PG8_WAIT_V(6); PG8_BAR; PG8_MMA(1, 1, At, B1); PG8_BAR;
            PG8_LDB(B0, 1, 0); PG8_SCHED; PG8_LDA(At, 1, 0); PG8_STAGE(PG8_SA(0, 1), a2 + hstep, voffA);
            PG8_WAIT_L(8); PG8_BAR; PG8_WAIT_L(0); PG8_MMA(0, 0, At, B0); PG8_BAR; PG8_SCHED;
            PG8_LDB(B1, 1, 1); PG8_STAGE(PG8_SB(1, 0), b3, voffB);
            PG8_BAR; PG8_WAIT_L(0); PG8_MMA(0, 1, At, B1); PG8_BAR;
            PG8_LDA(At, 1, 1); PG8_STAGE(PG8_SA(1, 0), a3, voffA);
            PG8_BAR; PG8_WAIT_L(0); PG8_MMA(1, 0, At, B0); PG8_BAR; PG8_SCHED;
            PG8_STAGE(PG8_SB(1, 1), b3 + hstep, voffB);
            PG8_WAIT_V(6); PG8_BAR; PG8_MMA(1, 1, At, B1); PG8_BAR;
            }
        }
        if constexpr (ALIGN_EPI) { if (wr == 0) PG8_BAR; }
        if constexpr (!Epi::AFTER_DRAIN) { E(acc, cur, wr, wc, fr, fq); S.done(cur); }
        if (!has_next) break;
#pragma unroll
        for (int a = 0; a < 2; ++a)
#pragma unroll
            for (int b = 0; b < 2; ++b)
#pragma unroll
                for (int m = 0; m < 4; ++m)
#pragma unroll
                    for (int n = 0; n < 2; ++n) acc[a][b][m][n] = (f32x4){0.f, 0.f, 0.f, 0.f};
        cur = nxt; cA = nA; cB = nB; ++ui;
        if constexpr (ALIGN_EPI) { if (wr == 1) PG8_BAR; }
    }
    PG8_WAIT_V(0);
    if constexpr (!ALIGN_EPI) { if (wr == 0) PG8_BAR; }
    PG8_BAR;
    if constexpr (Epi::AFTER_DRAIN) { E.fused(acc, cur, wr, wc, fr, fq, lds, wid, lane); S.done(cur); }
#undef PG8_SA
#undef PG8_SB
#undef PG8_STAGE
#undef PG8_LDA
#undef PG8_LDB
#undef PG8_MMA
#undef PG8_WAIT_V
#undef PG8_WAIT_L
#undef PG8_BAR
#undef PG8_SCHED
}
}

using pg8::Unit;
struct DenseSched { int nN, n, G, c;
    __device__ __forceinline__ void a_ready(const Unit&) const {}
    __device__ __forceinline__ void done(const Unit&) const {}
    __device__ __forceinline__ bool next(int i, Unit& u) const { const int L = i * G + c; if (L >= n) return false; u.pm = L / nN; u.pn = L % nN; return true; } };

template <class Sched, class Epi>
__device__ __forceinline__ void gemm_simple(const Ctx& c, const bf16* A, const bf16* Bt, int K, const Sched& S, const Epi& E) {
    float* As = (float*)c.lds;
    float* Bs = As + 32 * 256;
    const int tid = c.tid, rg = tid >> 4, cg = tid & 15;
    Unit u;
    for (int ui = 0; S.next(ui, u); ++ui) {
        float acc[8][16];
#pragma unroll
        for (int i = 0; i < 8; ++i)
#pragma unroll
            for (int j = 0; j < 16; ++j) acc[i][j] = 0.f;
        const bf16* Ab = A + (size_t)u.pm * 256 * K; const bf16* Bb = Bt + (size_t)u.pn * 256 * K;
        for (int k0 = 0; k0 < K; k0 += 32) {
            { const int row = tid >> 1, kh = tid & 1;
              const u32x4* pa = (const u32x4*)(Ab + (size_t)row * K + k0 + 16 * kh); const u32x4 a0 = pa[0], a1 = pa[1];
              const u32x4* pb = (const u32x4*)(Bb + (size_t)row * K + k0 + 16 * kh); const u32x4 b0 = pb[0], b1 = pb[1];
#pragma unroll
              for (int j = 0; j < 4; ++j) {
                  As[(16 * kh + 2 * j) * 256 + row] = __uint_as_float(a0[j] << 16); As[(16 * kh + 2 * j + 1) * 256 + row] = __uint_as_float(a0[j] & 0xffff0000u);
                  As[(16 * kh + 8 + 2 * j) * 256 + row] = __uint_as_float(a1[j] << 16); As[(16 * kh + 8 + 2 * j + 1) * 256 + row] = __uint_as_float(a1[j] & 0xffff0000u);
                  Bs[(16 * kh + 2 * j) * 256 + row] = __uint_as_float(b0[j] << 16); Bs[(16 * kh + 2 * j + 1) * 256 + row] = __uint_as_float(b0[j] & 0xffff0000u);
                  Bs[(16 * kh + 8 + 2 * j) * 256 + row] = __uint_as_float(b1[j] << 16); Bs[(16 * kh + 8 + 2 * j + 1) * 256 + row] = __uint_as_float(b1[j] & 0xffff0000u);
              } }
            __syncthreads();
#pragma unroll 4
            for (int kk = 0; kk < 32; ++kk) {
                const f32x4 a0 = *(const f32x4*)(As + kk * 256 + rg * 8), a1 = *(const f32x4*)(As + kk * 256 + rg * 8 + 4);
                f32x4 b[4];
#pragma unroll
                for (int q = 0; q < 4; ++q) b[q] = *(const f32x4*)(Bs + kk * 256 + 64 * q + 4 * cg);
#pragma unroll
                for (int i = 0; i < 8; ++i) { const float av = i < 4 ? a0[i & 3] : a1[i & 3];
#pragma unroll
                    for (int q = 0; q < 4; ++q)
#pragma unroll
                        for (int e = 0; e < 4; ++e) acc[i][4 * q + e] += av * b[q][e]; }
            }
            __syncthreads();
        }
#pragma unroll
        for (int i = 0; i < 8; ++i) { const int row = u.pm * 256 + rg * 8 + i;
#pragma unroll
            for (int q = 0; q < 2; ++q) { const int col = u.pn * 256 + 64 * q + 4 * cg;
                f32x4 v0, v1;
#pragma unroll
                for (int e = 0; e < 4; ++e) { v0[e] = acc[i][4 * q + e]; v1[e] = acc[i][4 * (q + 2) + e]; }
                E(row, col, v0, v1); } }
    }
}

struct EpiZ { bf16 *ZR, *ZS, *ZG;
    __device__ __forceinline__ void one(int row, int col, f32x4 v) const {
        if (col < RC) store4bf(ZR + (size_t)row * RC + col, v);
        else if (col < RC + 1024) { f32x4 g; for (int e = 0; e < 4; ++e) g[e] = gelu_tanh(v[e]); store4bf(ZS + (size_t)row * 1024 + (col - RC), g); }
        else { f32x4 g; for (int e = 0; e < 4; ++e) g[e] = sigmoidf_(v[e]); store4bf(ZG + (size_t)row * 2048 + (col - RC - 1024), g); } }
    __device__ __forceinline__ void operator()(int row, int col, f32x4 v0, f32x4 v1) const { one(row, col, v0); one(row, col + 128, v1); } };
struct EpiGA { const bf16* ZG; bf16* MP;
    __device__ __forceinline__ void one(int row, int col, f32x4 v) const { const f32x4 g = load4bf(ZG + (size_t)row * 2048 + col); store4bf(MP + (size_t)row * D + col, g * v); }
    __device__ __forceinline__ void operator()(int row, int col, f32x4 v0, f32x4 v1) const { one(row, col, v0); one(row, col + 128, v1); } };
struct EpiGB { const bf16* ZG; const bf16* MPin; bf16* MP;
    __device__ __forceinline__ void one(int row, int col, f32x4 v) const { const f32x4 g = load4bf(ZG + (size_t)row * 2048 + 1024 + col); const f32x4 m = load4bf(MPin + (size_t)row * D + col); store4bf(MP + (size_t)row * D + col, m + g * v); }
    __device__ __forceinline__ void operator()(int row, int col, f32x4 v0, f32x4 v1) const { one(row, col, v0); one(row, col + 128, v1); } };
struct EpiOut { const float* xin; float* out; const float* gate1;
    __device__ __forceinline__ void one(int row, int col, f32x4 v) const { const f32x4 x = *(const f32x4*)(xin + (size_t)row * D + col); const f32x4 g = *(const f32x4*)(gate1 + col);
        *(f32x4*)(out + (size_t)row * D + col) = ALPHA * x + (1.0f + g) * v; }
    __device__ __forceinline__ void operator()(int row, int col, f32x4 v0, f32x4 v1) const { one(row, col, v0); one(row, col + 128, v1); } };
struct EpiSwi { bf16* HID;
    __device__ __forceinline__ void operator()(int row, int col, f32x4 v0, f32x4 v1) const { const int ct = (col >> 8) & 3, cc = col & 127;
        f32x4 h; for (int e = 0; e < 4; ++e) h[e] = siluf_(v0[e]) * v1[e]; store4bf(HID + (size_t)row * FF + ct * 128 + cc, h); } };
struct EpiDown { const int* S2T; const float* TOKW; bf16* Y;
    __device__ __forceinline__ void operator()(int row, int col, f32x4 v0, f32x4 v1) const { const int st = S2T[row]; if (st < 0) return; const float w = TOKW[st]; const int cc = col & 1023;
        store4bf(Y + (size_t)st * D + cc, w * v0); store4bf(Y + (size_t)st * D + cc + 128, w * v1); } };

struct MoeSched { int ts[17]; int G, c;
    __device__ __forceinline__ void a_ready(const Unit&) const {}
    __device__ __forceinline__ void done(const Unit&) const {}
    __device__ __forceinline__ void init(const unsigned* cnt, int G_, int c_) { G = G_; c = c_; int s = 0;
#pragma unroll
        for (int e = 0; e < 16; ++e) { ts[e] = s; s += ((int)cnt[e] + 255) >> 8; } ts[16] = s; }
    __device__ __forceinline__ bool next(int i, Unit& u) const { const int L = i * G + c; if (L >= 4 * ts[16]) return false; const int rt = L >> 2, ct = L & 3; int e = 0;
#pragma unroll
        for (int j = 1; j < 16; ++j) e += (rt >= ts[j]) ? 1 : 0;
        u.pm = rt; u.pn = e * 4 + ct; return true; } };

__device__ __forceinline__ void phase_prep_simple(ArgsR a, const Ctx& c, int l) {
    const bf16* ZR = (const bf16*)(a.ws + WS_ZR);
    const float* mu = a.in[I_MU] + l * RC; const float* w0 = a.in[I_W0] + l * W; const float* w2 = a.in[I_W2] + (size_t)l * 64 * W;
    const float* a0 = a.in[I_A0] + l * W; const float* a2 = a.in[I_A2] + (size_t)l * 64 * W; const float* g2 = a.in[I_G2] + (size_t)l * 128 * W;
    const float* k_k = a.in[I_KK] + l * W; const float* k_a = a.in[I_KA] + l * W;
    const float* vm0 = a.in[I_VM0]; const float* vm1 = a.in[I_VM1]; const float* vm2 = a.in[I_VM2];
    f16* R = (f16*)(a.ws + WS_R); f16* WM1 = (f16*)(a.ws + WS_WM1); f16* KP = (f16*)(a.ws + WS_KP); f16* AA = (f16*)(a.ws + WS_AA); f16* BB = (f16*)(a.ws + WS_BB); f16* V = (f16*)(a.ws + WS_V);
    bf16* G = (bf16*)(a.ws + WS_G); bf16* VF = (bf16*)(a.ws + WS_VF);
    const int lane = c.lane;
    for (int t = c.gw; t < T; t += c.ngw) {
        float z[28];
#pragma unroll
        for (int i = 0; i < 28; ++i) { const int col = lane + 64 * i; const float zc = bf2f(ZR[(size_t)t * RC + col]); const float zp = t > 0 ? bf2f(ZR[(size_t)(t - 1) * RC + col]) : 0.f; z[i] = zc + (zp - zc) * mu[col]; }
        const float tw = tanhf(z[24]), za = z[25], sg0 = sigmoidf_(z[26]), sg1 = sigmoidf_(z[27]);
        float wlo[8], alo[8], gg[8];
#pragma unroll
        for (int i = 0; i < 8; ++i) { wlo[i] = 0.f; alo[i] = 0.f; gg[i] = 0.f; }
        for (int j = 0; j < 64; ++j) { const float tj = __shfl(tw, j), aj = __shfl(za, j), s0 = __shfl(sg0, j), s1 = __shfl(sg1, j);
#pragma unroll
            for (int i = 0; i < 8; ++i) { const int n = lane + 64 * i; wlo[i] += tj * w2[j * W + n]; alo[i] += aj * a2[j * W + n]; gg[i] += s0 * g2[j * W + n] + s1 * g2[(64 + j) * W + n]; } }
        float vv[8];
#pragma unroll
        for (int i = 0; i < 8; ++i) vv[i] = z[16 + i];
        if (l == 0) {
#pragma unroll
            for (int i = 0; i < 8; ++i) VF[(size_t)t * W + lane + 64 * i] = f2bf(vv[i]);
        } else {
            float vmid = 0.f;
#pragma unroll
            for (int i = 0; i < 8; ++i)
                for (int j = 0; j < 64; ++j) { const float vc = __shfl(vv[i], j); vmid += vc * vm1[(size_t)(64 * i + j) * 32 + (lane & 31)]; }
            float vg[8];
#pragma unroll
            for (int i = 0; i < 8; ++i) vg[i] = 0.f;
            for (int m = 0; m < 32; ++m) { const float vmm = __shfl(vmid, m);
#pragma unroll
                for (int i = 0; i < 8; ++i) vg[i] += vmm * vm2[m * W + lane + 64 * i]; }
#pragma unroll
            for (int i = 0; i < 8; ++i) { const int n = lane + 64 * i; const float vf = bf2f(VF[(size_t)t * W + n]); vv[i] = vv[i] + (vf - vv[i]) * sigmoidf_(vm0[n] + vg[i]); }
        }
#pragma unroll
        for (int i = 0; i < 8; ++i) {
            const int n = lane + 64 * i; const size_t o = (size_t)t * W + n;
            const float x = w0[n] + wlo[i]; const float wl = -softplusf_(-x) - 0.5f; const float dm1 = expm1f(-__expf(wl));
            const float av = sigmoidf_(a0[n] + alo[i]);
            const float kraw = z[8 + i];
            float kk = kraw * k_k[n]; const float nrm = sqrtf(wave_sum(kk * kk)); kk = kk / fmaxf(nrm, 1e-12f);
            const float kp = kraw * (1.0f + (av - 1.0f) * k_a[n]);
            R[o] = (f16)z[i]; WM1[o] = (f16)dm1; KP[o] = (f16)kp; AA[o] = (f16)(-kk); BB[o] = (f16)(kk * av); V[o] = (f16)vv[i]; G[o] = f2bf(gg[i]);
        }
    }
}

__device__ __forceinline__ void phase_sg_simple(ArgsR a, const Ctx& c, int l) {
    const bf16* ZS = (const bf16*)(a.ws + WS_ZS); bf16* YB = (bf16*)(a.ws + WS_YB);
    const float* lng = a.in[I_SGG] + l * W; const float* lnb = a.in[I_SGB] + l * W;
    float* vn = (float*)c.lds;
    float* st = vn + 128 * 64;
    for (int uidx = blockIdx.x; uidx < 128 * 8; uidx += gridDim.x) {
        const int ch = uidx >> 3, g = uidx & 7; const int tok0 = ch * 128;
        for (int i = 0; i < 16; ++i) { const int s = c.wave * 16 + i; const bf16* p = ZS + (size_t)(tok0 + s) * 1024 + 512 + c.lane * 8;
            const f32x4 x0 = load4bf(p), x1 = load4bf(p + 4);
            float sm = (x0[0] + x0[1]) + (x0[2] + x0[3]) + (x1[0] + x1[1]) + (x1[2] + x1[3]); const float mean = wave_sum(sm) * (1.f / 512.f);
            float q = 0.f; for (int e = 0; e < 4; ++e) { const float d0 = x0[e] - mean, d1 = x1[e] - mean; q += d0 * d0 + d1 * d1; }
            const float rstd = __builtin_amdgcn_rsqf(wave_sum(q) * (1.f / 512.f) + LN_EPS);
            if (c.lane == 0) { st[2 * s] = mean; st[2 * s + 1] = rstd; } }
        __syncthreads();
        for (int i = c.tid; i < 128 * 64; i += NTHREADS) { const int s = i >> 6, d = i & 63; const float x = bf2f(ZS[(size_t)(tok0 + s) * 1024 + 512 + g * 64 + d]);
            vn[i] = (x - st[2 * s]) * st[2 * s + 1] * lng[g * 64 + d] + lnb[g * 64 + d]; }
        __syncthreads();
        const int d = c.tid & 63, tq = c.tid >> 6;
        const float* Wg = a.in[I_WS] + (size_t)(l * 8 + g) * 128 * 128; const float* bs = a.in[I_BS] + (size_t)(l * 8 + g) * 128;
        for (int i = 0; i < 16; ++i) { const int t = tq + 8 * i; float acc = 0.f;
            for (int s = 0; s <= t; ++s) acc += Wg[t * 128 + s] * vn[s * 64 + d];
            const float u = bf2f(ZS[(size_t)(tok0 + t) * 1024 + g * 64 + d]);
            YB[(size_t)(tok0 + t) * W + g * 64 + d] = f2bf(u * (acc + bs[t])); }
        __syncthreads();
    }
}

#define LAS3 __attribute__((address_space(3)))
typedef short bf16x8 __attribute__((ext_vector_type(8)));
template <int MT, int NT, int KS>
__device__ __forceinline__ void mma_lds_glob(const unsigned char* lds_base, int a_off_bytes, int lda, const bf16* Bt, int ldb, int n0, int lane, f32x4 (&acc)[MT][NT]) {
    const int fr = lane & 15, fq = lane >> 4;
    const LAS3 unsigned char* Ab = (const LAS3 unsigned char*)lds_base + a_off_bytes;
    int boff = (n0 + fr) * ldb + 8 * fq; asm volatile("" : "+v"(boff));
#pragma unroll
    for (int ks = 0; ks < KS; ++ks) {
        bf16x8 b[NT];
#pragma unroll
        for (int n = 0; n < NT; ++n) b[n] = *(const bf16x8*)(Bt + boff + 16 * n * ldb + 32 * ks);
#pragma unroll
        for (int m = 0; m < MT; ++m) { const bf16x8 av = *(const LAS3 bf16x8*)(Ab + ((16 * m + fr) * lda + 32 * ks + 8 * fq) * 2);
#pragma unroll
            for (int n = 0; n < NT; ++n) acc[m][n] = __builtin_amdgcn_mfma_f32_16x16x32_bf16(av, b[n], acc[m][n], 0, 0, 0); }
    }
}
__device__ __forceinline__ void zshift8(const bf16* ZR, int t, int col, const float* mu, float (&o)[8]) {
    const u32x4 zc = *(const u32x4*)(ZR + (size_t)t * RC + col);
    u32x4 zp = {0u, 0u, 0u, 0u}; if (t > 0) zp = *(const u32x4*)(ZR + (size_t)(t - 1) * RC + col);
    const f32x4 m0 = *(const f32x4*)(mu + col), m1 = *(const f32x4*)(mu + col + 4);
#pragma unroll
    for (int e = 0; e < 4; ++e) { const float c0 = __uint_as_float(zc[e] << 16), c1 = __uint_as_float(zc[e] & 0xffff0000u), p0 = __uint_as_float(zp[e] << 16), p1 = __uint_as_float(zp[e] & 0xffff0000u);
        const float mu0 = (2 * e < 4) ? m0[(2 * e) & 3] : m1[(2 * e) & 3], mu1 = (2 * e + 1 < 4) ? m0[(2 * e + 1) & 3] : m1[(2 * e + 1) & 3];
        o[2 * e] = c0 + (p0 - c0) * mu0; o[2 * e + 1] = c1 + (p1 - c1) * mu1; }
}
typedef _Float16 f16x8 __attribute__((ext_vector_type(8)));
__device__ __forceinline__ void store8f16(f16* p, const float (&v)[8]) { f16x8 h;
#pragma unroll
    for (int e = 0; e < 8; ++e) h[e] = (f16)v[e];
    *(f16x8*)p = h; }
__device__ __forceinline__ u32x4 pack8bf(const float (&v)[8]) { u32x4 w; w.x = pk2(v[0], v[1]); w.y = pk2(v[2], v[3]); w.z = pk2(v[4], v[5]); w.w = pk2(v[6], v[7]); return w; }


constexpr int PB_LD = 520;
constexpr int PB_BUF = 0, PB_AOP = 64 * PB_LD * 2, PB_VMID = 2 * 64 * PB_LD * 2, PB_LA_LD = 264, PB_VM_LD = 40;
__device__ __forceinline__ void phase_prep_fast(ArgsR a, const Ctx& c, int l) {
    const bf16* ZR = (const bf16*)(a.ws + WS_ZR);
    const float* mu = a.in[I_MU] + l * RC; const float* w0 = a.in[I_W0] + l * W; const float* a0 = a.in[I_A0] + l * W;
    const float* k_k = a.in[I_KK] + l * W; const float* k_a = a.in[I_KA] + l * W; const float* vm0 = a.in[I_VM0];
    f16* R = (f16*)(a.ws + WS_R); f16* WM1 = (f16*)(a.ws + WS_WM1); f16* KP = (f16*)(a.ws + WS_KP); f16* AA = (f16*)(a.ws + WS_AA); f16* BB = (f16*)(a.ws + WS_BB); f16* V = (f16*)(a.ws + WS_V);
    bf16* G = (bf16*)(a.ws + WS_G); bf16* VF = (bf16*)(a.ws + WS_VF);
    const unsigned char* lo = a.ws + WS_LORA + (size_t)l * LO_STRIDE;
    const bf16* W2T = (const bf16*)(lo + LO_W2T); const bf16* A2T = (const bf16*)(lo + LO_A2T); const bf16* G2T = (const bf16*)(lo + LO_G2T);
    const bf16* VM1T = (const bf16*)(lo + LO_VM1T); const bf16* VM2T = (const bf16*)(lo + LO_VM2T);
    LAS3 unsigned char* L = (LAS3 unsigned char*)c.lds;
    const int tid = c.tid, lane = c.lane, wv = c.wave, fr = lane & 15, fq = lane >> 4;
    const int row = tid >> 3, sub_ = tid & 7;
    for (int u = blockIdx.x; u < T / 64; u += gridDim.x) {
        int sub = sub_; asm volatile("" : "+v"(sub));
        const int t0 = u * 64, t = t0 + row;
        if (l == 0) {
#pragma unroll 4
            for (int p = 0; p < 8; ++p) { const int col = p * 64 + sub * 8; float z[8]; zshift8(ZR, t, 1024 + col, mu, z);
                store8f16(V + (size_t)t * W + col, z); *(u32x4*)(VF + (size_t)t * W + col) = pack8bf(z); }
        } else {
#pragma unroll 4
            for (int p = 0; p < 8; ++p) { const int col = p * 64 + sub * 8; float z[8]; zshift8(ZR, t, 1024 + col, mu, z);
                *(LAS3 u32x4*)(L + PB_AOP + (row * PB_LD + col) * 2) = pack8bf(z); }
            __syncthreads();
            { f32x4 acc[1][1]; acc[0][0] = (f32x4){0.f, 0.f, 0.f, 0.f}; const int m = wv >> 1, n = wv & 1;
              mma_lds_glob<1, 1, 16>(c.lds, PB_AOP + 16 * m * PB_LD * 2, PB_LD, VM1T, W, 16 * n, lane, acc);
#pragma unroll
              for (int i = 0; i < 4; ++i) *(LAS3 bf16*)(L + PB_VMID + ((16 * m + 4 * fq + i) * PB_VM_LD + 16 * n + fr) * 2) = f2bf(acc[0][0][i]); }
            __syncthreads();
            { f32x4 acc[4][4];
#pragma unroll
              for (int m = 0; m < 4; ++m)
#pragma unroll
                  for (int n = 0; n < 4; ++n) acc[m][n] = (f32x4){0.f, 0.f, 0.f, 0.f};
              mma_lds_glob<4, 4, 1>(c.lds, PB_VMID, PB_VM_LD, VM2T, 32, 64 * wv, lane, acc);
#pragma unroll
              for (int m = 0; m < 4; ++m)
#pragma unroll
                  for (int n = 0; n < 4; ++n) { const int col = 64 * wv + 16 * n + fr; const float vb = vm0[col];
#pragma unroll
                      for (int i = 0; i < 4; ++i) *(LAS3 f16*)(L + PB_BUF + ((16 * m + 4 * fq + i) * PB_LD + col) * 2) = (f16)sigmoidf_(vb + acc[m][n][i]); } }
            __syncthreads();
#pragma unroll 4
            for (int p = 0; p < 8; ++p) { const int col = p * 64 + sub * 8;
                const u32x4 vz = *(const LAS3 u32x4*)(L + PB_AOP + (row * PB_LD + col) * 2); const f16x8 gt = *(const LAS3 f16x8*)(L + PB_BUF + (row * PB_LD + col) * 2);
                const u32x4 vfw = *(const u32x4*)(VF + (size_t)t * W + col); float o[8];
#pragma unroll
                for (int e = 0; e < 4; ++e) { const float v0 = __uint_as_float(vz[e] << 16), v1 = __uint_as_float(vz[e] & 0xffff0000u), f0 = __uint_as_float(vfw[e] << 16), f1 = __uint_as_float(vfw[e] & 0xffff0000u);
                    o[2 * e] = v0 + (f0 - v0) * (float)gt[2 * e]; o[2 * e + 1] = v1 + (f1 - v1) * (float)gt[2 * e + 1]; }
                store8f16(V + (size_t)t * W + col, o); }
            __syncthreads();
        }
#pragma unroll 4
        for (int p = 0; p < 4; ++p) { const int cc = sub * 32 + p * 8; float z[8]; zshift8(ZR, t, 1536 + cc, mu, z);
#pragma unroll
            for (int e = 0; e < 8; ++e) z[e] = cc < 64 ? (1.0f - 2.0f * __builtin_amdgcn_rcpf(1.0f + __expf(2.0f * z[e]))) : (cc < 128 ? z[e] : sigmoidf_(z[e]));
            *(LAS3 u32x4*)(L + PB_AOP + (row * PB_LA_LD + cc) * 2) = pack8bf(z); }
        __syncthreads();
        { f32x4 acc[4][4];
#pragma unroll
          for (int m = 0; m < 4; ++m)
#pragma unroll
              for (int n = 0; n < 4; ++n) acc[m][n] = (f32x4){0.f, 0.f, 0.f, 0.f};
          mma_lds_glob<4, 4, 2>(c.lds, PB_AOP + 64 * 2, PB_LA_LD, A2T, 64, 64 * wv, lane, acc);
#pragma unroll
          for (int m = 0; m < 4; ++m)
#pragma unroll
              for (int n = 0; n < 4; ++n) { const int col = 64 * wv + 16 * n + fr; const float ab = a0[col];
#pragma unroll
                  for (int i = 0; i < 4; ++i) *(LAS3 f16*)(L + PB_BUF + ((16 * m + 4 * fq + i) * PB_LD + col) * 2) = (f16)sigmoidf_(ab + acc[m][n][i]); } }
        __syncthreads();
#pragma unroll 4
        for (int p = 0; p < 8; ++p) { const int col = p * 64 + sub * 8; const size_t o = (size_t)t * W + col;
            float z[8]; zshift8(ZR, t, col, mu, z); store8f16(R + o, z);
            float kz[8]; zshift8(ZR, t, 512 + col, mu, kz);
            const f16x8 av = *(const LAS3 f16x8*)(L + PB_BUF + (row * PB_LD + col) * 2);
            const f32x4 kk0 = *(const f32x4*)(k_k + col), kk1 = *(const f32x4*)(k_k + col + 4), ka0 = *(const f32x4*)(k_a + col), ka1 = *(const f32x4*)(k_a + col + 4);
            float kk[8], kp[8], bb[8]; float ss = 0.f;
#pragma unroll
            for (int e = 0; e < 8; ++e) { const float kkw = e < 4 ? kk0[e & 3] : kk1[e & 3], kaw = e < 4 ? ka0[e & 3] : ka1[e & 3]; kk[e] = kz[e] * kkw; ss += kk[e] * kk[e]; kp[e] = kz[e] * (1.0f + ((float)av[e] - 1.0f) * kaw); }
            ss += __shfl_xor(ss, 1); ss += __shfl_xor(ss, 2); ss += __shfl_xor(ss, 4);
            const float inv = fminf(__builtin_amdgcn_rsqf(ss), 1e12f);
#pragma unroll
            for (int e = 0; e < 8; ++e) { kk[e] *= inv; bb[e] = kk[e] * (float)av[e]; kk[e] = -kk[e]; }
            store8f16(KP + o, kp); store8f16(AA + o, kk); store8f16(BB + o, bb); }
        __syncthreads();
        { f32x4 acc[4][4];
#pragma unroll
          for (int m = 0; m < 4; ++m)
#pragma unroll
              for (int n = 0; n < 4; ++n) acc[m][n] = (f32x4){0.f, 0.f, 0.f, 0.f};
          mma_lds_glob<4, 4, 2>(c.lds, PB_AOP, PB_LA_LD, W2T, 64, 64 * wv, lane, acc);
#pragma unroll
          for (int m = 0; m < 4; ++m)
#pragma unroll
              for (int n = 0; n < 4; ++n) { const int col = 64 * wv + 16 * n + fr; const float wb = w0[col];
#pragma unroll
                  for (int i = 0; i < 4; ++i) { const float x = wb + acc[m][n][i]; const float wl = -(fmaxf(-x, 0.f) + __logf(1.0f + __expf(-fabsf(x)))) - 0.5f;
                      *(LAS3 f16*)(L + PB_BUF + ((16 * m + 4 * fq + i) * PB_LD + col) * 2) = (f16)(__expf(-__expf(wl)) - 1.0f); } } }
        __syncthreads();
#pragma unroll 4
        for (int p = 0; p < 8; ++p) { const int col = p * 64 + sub * 8; *(u32x4*)(WM1 + (size_t)t * W + col) = *(const LAS3 u32x4*)(L + PB_BUF + (row * PB_LD + col) * 2); }
        __syncthreads();
        { f32x4 acc[4][4];
#pragma unroll
          for (int m = 0; m < 4; ++m)
#pragma unroll
              for (int n = 0; n < 4; ++n) acc[m][n] = (f32x4){0.f, 0.f, 0.f, 0.f};
          mma_lds_glob<4, 4, 4>(c.lds, PB_AOP + 128 * 2, PB_LA_LD, G2T, 128, 64 * wv, lane, acc);
#pragma unroll
          for (int m = 0; m < 4; ++m)
#pragma unroll
              for (int n = 0; n < 4; ++n) { const int col = 64 * wv + 16 * n + fr;
#pragma unroll
                  for (int i = 0; i < 4; ++i) *(LAS3 bf16*)(L + PB_BUF + ((16 * m + 4 * fq + i) * PB_LD + col) * 2) = f2bf(acc[m][n][i]); } }
        __syncthreads();
#pragma unroll 4
        for (int p = 0; p < 8; ++p) { const int col = p * 64 + sub * 8; *(u32x4*)(G + (size_t)t * W + col) = *(const LAS3 u32x4*)(L + PB_BUF + (row * PB_LD + col) * 2); }
        __syncthreads();
    }
}

constexpr int SG_LD = 136;
constexpr int SG_VT = 0, SG_ST = 256 * SG_LD * 2;
__device__ __forceinline__ void phase_sg_fast(ArgsR a, const Ctx& c, int l) {
    const bf16* ZS = (const bf16*)(a.ws + WS_ZS); bf16* YB = (bf16*)(a.ws + WS_YB);
    const float* lng = a.in[I_SGG] + l * W; const float* lnb = a.in[I_SGB] + l * W;
    LAS3 unsigned char* L = (LAS3 unsigned char*)c.lds;
    LAS3 float* st = (LAS3 float*)(L + SG_ST);
    const int tid = c.tid, lane = c.lane, wv = c.wave, fr = lane & 15, fq = lane >> 4;
    for (int u = blockIdx.x; u < 256; u += gridDim.x) {
        const int ch = u >> 1, hf = u & 1, tok0 = ch * 128;
        for (int i = 0; i < 16; ++i) { const int sidx = wv * 16 + i; const bf16* p = ZS + (size_t)(tok0 + sidx) * 1024 + 512 + lane * 8;
            const f32x4 x0 = load4bf(p), x1 = load4bf(p + 4);
            const float sm = (x0[0] + x0[1]) + (x0[2] + x0[3]) + (x1[0] + x1[1]) + (x1[2] + x1[3]); const float mean = wave_sum(sm) * (1.f / 512.f);
            float q = 0.f;
#pragma unroll
            for (int e = 0; e < 4; ++e) { const float d0 = x0[e] - mean, d1 = x1[e] - mean; q += d0 * d0 + d1 * d1; }
            const float rstd = __builtin_amdgcn_rsqf(wave_sum(q) * (1.f / 512.f) + LN_EPS);
            if (lane == 0) { st[2 * sidx] = mean; st[2 * sidx + 1] = rstd; } }
        __syncthreads();
        { const int sidx = tid >> 2, q4 = tid & 3; const float mean = st[2 * sidx], rstd = st[2 * sidx + 1];
#pragma unroll
          for (int p = 0; p < 8; ++p) { const int cl = q4 * 64 + p * 8; const int cg = hf * 256 + cl;
              const bf16* src = ZS + (size_t)(tok0 + sidx) * 1024 + 512 + cg; const f32x4 x0 = load4bf(src), x1 = load4bf(src + 4);
              const f32x4 g0 = *(const f32x4*)(lng + cg), g1 = *(const f32x4*)(lng + cg + 4), b0 = *(const f32x4*)(lnb + cg), b1 = *(const f32x4*)(lnb + cg + 4);
#pragma unroll
              for (int e = 0; e < 8; ++e) { const float x = e < 4 ? x0[e & 3] : x1[e & 3], gg = e < 4 ? g0[e & 3] : g1[e & 3], bb = e < 4 ? b0[e & 3] : b1[e & 3];
                  *(LAS3 bf16*)(L + SG_VT + ((cl + e) * SG_LD + sidx) * 2) = f2bf((x - mean) * rstd * gg + bb); } } }
        __syncthreads();
        const int gl = wv >> 1, dh = wv & 1, g = hf * 4 + gl;
        const float* Wg = a.in[I_WS] + (size_t)(l * 8 + g) * 128 * 128; const float* bs = a.in[I_BS] + (size_t)(l * 8 + g) * 128;
        f32x4 acc[8][2];
#pragma unroll
        for (int m = 0; m < 8; ++m) { acc[m][0] = (f32x4){0.f, 0.f, 0.f, 0.f}; acc[m][1] = (f32x4){0.f, 0.f, 0.f, 0.f}; }
#pragma unroll
        for (int ks = 0; ks < 4; ++ks) {
            bf16x8 b[2];
#pragma unroll
            for (int n = 0; n < 2; ++n) b[n] = *(const LAS3 bf16x8*)(L + SG_VT + ((gl * 64 + dh * 32 + 16 * n + fr) * SG_LD + 32 * ks + 8 * fq) * 2);
#pragma unroll
            for (int m = 0; m < 8; ++m) { if (32 * ks <= 16 * m + 15) {
                const int trow = 16 * m + fr, s0 = 32 * ks + 8 * fq;
                const f32x4 w0v = *(const f32x4*)(Wg + trow * 128 + s0), w1v = *(const f32x4*)(Wg + trow * 128 + s0 + 4);
                float wf[8];
#pragma unroll
                for (int e = 0; e < 8; ++e) { const float wval = e < 4 ? w0v[e & 3] : w1v[e & 3]; wf[e] = (s0 + e <= trow) ? wval : 0.f; }
                const u32x4 wp = pack8bf(wf); const bf16x8 av = __builtin_bit_cast(bf16x8, wp);
                acc[m][0] = __builtin_amdgcn_mfma_f32_16x16x32_bf16(av, b[0], acc[m][0], 0, 0, 0);
                acc[m][1] = __builtin_amdgcn_mfma_f32_16x16x32_bf16(av, b[1], acc[m][1], 0, 0, 0); } }
        }
#pragma unroll
        for (int m = 0; m < 8; ++m)
#pragma unroll
            for (int i = 0; i < 4; ++i) { const int trow = 16 * m + 4 * fq + i; const float bsv = bs[trow];
#pragma unroll
                for (int n = 0; n < 2; ++n) { const int col = g * 64 + dh * 32 + 16 * n + fr; const float uu = bf2f(ZS[(size_t)(tok0 + trow) * 1024 + col]);
                    YB[(size_t)(tok0 + trow) * W + col] = f2bf(uu * (acc[m][n][i] + bsv)); } }
        __syncthreads();
    }
}

__device__ __forceinline__ void phase_scan_simple(ArgsR a, const Ctx& c) {
    if (c.wave != 0 || blockIdx.x >= NH) return;
    const int h = blockIdx.x, lane = c.lane;
    const f16* R = (const f16*)(a.ws + WS_R); const f16* WM1 = (const f16*)(a.ws + WS_WM1); const f16* KP = (const f16*)(a.ws + WS_KP);
    const f16* AA = (const f16*)(a.ws + WS_AA); const f16* BB = (const f16*)(a.ws + WS_BB); const f16* V = (const f16*)(a.ws + WS_V);
    bf16* YSC = (bf16*)(a.ws + WS_YSC);
    float S[64];
#pragma unroll
    for (int j = 0; j < 64; ++j) S[j] = 0.f;
    for (int t = 0; t < T; ++t) {
        const size_t base = (size_t)t * W + h * 64;
        const float vv = (float)V[base + lane];
        float sa = 0.f;
#pragma unroll
        for (int j = 0; j < 64; ++j) sa += S[j] * (float)AA[base + j];
        float y = 0.f;
#pragma unroll
        for (int j = 0; j < 64; ++j) { float s = S[j]; s = s + s * (float)WM1[base + j]; s += sa * (float)BB[base + j]; s += vv * (float)KP[base + j]; S[j] = s; y += s * (float)R[base + j]; }
        YSC[base + lane] = f2bf(y);
    }
}

typedef unsigned u32x16 __attribute__((ext_vector_type(16)));
__device__ __forceinline__ void sload32(const void* p0, u32x16& a0, u32x16& a1) {
    asm volatile("s_load_dwordx16 %0, %2, 0x0 glc\n\ts_load_dwordx16 %1, %2, 0x40 glc\n\ts_waitcnt lgkmcnt(0)" : "=&s"(a0), "=&s"(a1) : "s"(p0) : "memory");
}
__device__ __forceinline__ void sload64(const void* p0, const void* p1, u32x16& a0, u32x16& a1, u32x16& b0, u32x16& b1) {
    asm volatile("s_load_dwordx16 %0, %4, 0x0 glc\n\ts_load_dwordx16 %1, %4, 0x40 glc\n\ts_load_dwordx16 %2, %5, 0x0 glc\n\ts_load_dwordx16 %3, %5, 0x40 glc\n\ts_waitcnt lgkmcnt(0)"
                 : "=&s"(a0), "=&s"(a1), "=&s"(b0), "=&s"(b1) : "s"(p0), "s"(p1) : "memory");
}
__device__ __forceinline__ float fmix_lo(unsigned sd, float x, float y) { float d; asm("v_fma_mix_f32 %0, %1, %2, %3 op_sel_hi:[1,0,0]" : "=v"(d) : "s"(sd), "v"(x), "v"(y)); return d; }
__device__ __forceinline__ float fmix_hi(unsigned sd, float x, float y) { float d; asm("v_fma_mix_f32 %0, %1, %2, %3 op_sel:[1,0,0] op_sel_hi:[1,0,0]" : "=v"(d) : "s"(sd), "v"(x), "v"(y)); return d; }
constexpr int CL = 64, NCH = T / CL;
constexpr size_t ST_Q_OFF = (size_t)NH * NCH * 64 * 64;
constexpr size_t ST_S_OFF = (size_t)NH * NCH * 64 * 64;

__device__ __forceinline__ float vmix_lo(unsigned vd, float x, float y) { float d; asm("v_fma_mix_f32 %0, %1, %2, %3 op_sel_hi:[1,0,0]" : "=v"(d) : "v"(vd), "v"(x), "v"(y)); return d; }
__device__ __forceinline__ float vmix_hi(unsigned vd, float x, float y) { float d; asm("v_fma_mix_f32 %0, %1, %2, %3 op_sel:[1,0,0] op_sel_hi:[1,0,0]" : "=v"(d) : "v"(vd), "v"(x), "v"(y)); return d; }
template <int N> __device__ __forceinline__ void fmac_bc(float& acc, float vec, float x) { asm("v_fmac_f32_dpp %0, %1, %2 row_newbcast:%3 row_mask:0xf bank_mask:0xf" : "+v"(acc) : "v"(vec), "v"(x), "n"(N)); }
template <int N> __device__ __forceinline__ float mul_bc(float vec, float x) { float d; asm("v_mul_f32_dpp %0, %1, %2 row_newbcast:%3 row_mask:0xf bank_mask:0xf" : "=v"(d) : "v"(vec), "v"(x), "n"(N)); return d; }
typedef _Float16 f16x4 __attribute__((ext_vector_type(4)));
struct SVec { float v[4]; };
__device__ __forceinline__ f16x4 sv_read(const LAS3 unsigned char* p, int lane) { return *(const LAS3 f16x4*)(p + (lane & 15) * 8); }
__device__ __forceinline__ void sv_cvt(SVec& o, f16x4 h) { o.v[0] = (float)h[0]; o.v[1] = (float)h[1]; o.v[2] = (float)h[2]; o.v[3] = (float)h[3]; }
__device__ __forceinline__ void sv_cvt1p(SVec& o, f16x4 h) { o.v[0] = 1.0f + (float)h[0]; o.v[1] = 1.0f + (float)h[1]; o.v[2] = 1.0f + (float)h[2]; o.v[3] = 1.0f + (float)h[3]; }
template <int J> __device__ __forceinline__ void sc_dot(float (&d)[4], const SVec& A, const float (&X)[64]) { fmac_bc<(J >> 2)>(d[J & 3], A.v[J & 3], X[J]); if constexpr (J + 1 < 64) sc_dot<J + 1>(d, A, X); }
template <int J> __device__ __forceinline__ void sc_upd3(float (&S)[64], float (&y)[4], const SVec& Wv, const SVec& Bv, const SVec& Kv, const SVec& Rv, float sa, float vv) {
    float sj = mul_bc<(J >> 2)>(Wv.v[J & 3], S[J]); fmac_bc<(J >> 2)>(sj, Bv.v[J & 3], sa); fmac_bc<(J >> 2)>(sj, Kv.v[J & 3], vv); S[J] = sj; fmac_bc<(J >> 2)>(y[J & 3], Rv.v[J & 3], sj);
    if constexpr (J + 1 < 64) sc_upd3<J + 1>(S, y, Wv, Bv, Kv, Rv, sa, vv); }
template <int J> __device__ __forceinline__ void sc_upd1(float (&Q)[64], float (&P)[64], const SVec& Wv, const SVec& Bv, const SVec& Kv, float saq, float sap, float vv) {
    float qj = mul_bc<(J >> 2)>(Wv.v[J & 3], Q[J]); fmac_bc<(J >> 2)>(qj, Bv.v[J & 3], saq); fmac_bc<(J >> 2)>(qj, Kv.v[J & 3], vv); Q[J] = qj;
    float pj = mul_bc<(J >> 2)>(Wv.v[J & 3], P[J]); fmac_bc<(J >> 2)>(pj, Bv.v[J & 3], sap); P[J] = pj;
    if constexpr (J + 1 < 64) sc_upd1<J + 1>(Q, P, Wv, Bv, Kv, saq, sap, vv); }
constexpr int SCB = 8;
constexpr int SC_NS = 6, SC_BUF = SC_NS * 1024, SC_WAVE = 2 * SC_BUF;
__device__ __forceinline__ void sc_dma(const f16* X, size_t eoff, LAS3 unsigned char* dst) {
    __builtin_amdgcn_global_load_lds((const unsigned*)(X + eoff), (LAS3 unsigned*)dst, 16, 0, 0);
}

__device__ __forceinline__ void phase_scan1(ArgsR a, const Ctx& c) {
    const f16* WM1 = (const f16*)(a.ws + WS_WM1); const f16* KP = (const f16*)(a.ws + WS_KP);
    const f16* AA = (const f16*)(a.ws + WS_AA); const f16* BB = (const f16*)(a.ws + WS_BB); const f16* V = (const f16*)(a.ws + WS_V);
    float* ST = (float*)(a.ws + WS_ST);
    const int lane = c.lane;
    LAS3 unsigned char* ring = (LAS3 unsigned char*)c.lds + c.wave * SC_WAVE;
    for (int item = c.gw; item < NH * NCH; item += c.ngw) {
        const int h = __builtin_amdgcn_readfirstlane(item / NCH), ch = __builtin_amdgcn_readfirstlane(item % NCH);
        float Q[64], P[64];
        int ln_ = lane; asm volatile("" : "+v"(ln_));
#pragma unroll
        for (int j = 0; j < 64; ++j) { Q[j] = 0.f; P[j] = (j == ln_) ? 1.f : 0.f; }
        const size_t lane_off = (size_t)(lane >> 3) * W + h * 64 + (lane & 7) * 8;
        { const size_t e0 = (size_t)(ch * CL) * W + lane_off;
          sc_dma(AA, e0, ring); sc_dma(WM1, e0, ring + 1024); sc_dma(BB, e0, ring + 2048); sc_dma(KP, e0, ring + 3072); sc_dma(V, e0, ring + 4096); }
#pragma unroll 1
        for (int blk = 0; blk < CL / SCB; ++blk) {
            LAS3 unsigned char* buf = ring + (blk & 1) * SC_BUF;
            if (blk + 1 < CL / SCB) { LAS3 unsigned char* nb = ring + ((blk + 1) & 1) * SC_BUF; const size_t e0 = (size_t)(ch * CL + (blk + 1) * SCB) * W + lane_off;
                sc_dma(AA, e0, nb); sc_dma(WM1, e0, nb + 1024); sc_dma(BB, e0, nb + 2048); sc_dma(KP, e0, nb + 3072); sc_dma(V, e0, nb + 4096);
                asm volatile("s_waitcnt vmcnt(5)" ::: "memory"); }
            else asm volatile("s_waitcnt vmcnt(0)" ::: "memory");
            SVec A, Wv, Bv, Kv;
            sv_cvt(A, sv_read(buf, lane)); sv_cvt1p(Wv, sv_read(buf + 1024, lane)); sv_cvt(Bv, sv_read(buf + 2048, lane)); sv_cvt(Kv, sv_read(buf + 3072, lane));
            float vv = (float)*(const LAS3 f16*)(buf + 4096 + lane * 2);
#pragma unroll 1
            for (int st = 0; st < SCB; ++st) {
                const LAS3 unsigned char* sn = buf + ((st + 1 < SCB) ? st + 1 : st) * 128;
                const f16x4 ha = sv_read(sn, lane), hw = sv_read(sn + 1024, lane), hb = sv_read(sn + 2048, lane), hk = sv_read(sn + 3072, lane);
                const f16 hv = *(const LAS3 f16*)(sn + 4096 + lane * 2);
                float dq[4] = {0.f, 0.f, 0.f, 0.f}, dp[4] = {0.f, 0.f, 0.f, 0.f};
                sc_dot<0>(dq, A, Q); sc_dot<0>(dp, A, P);
                const float saq = (dq[0] + dq[1]) + (dq[2] + dq[3]), sap = (dp[0] + dp[1]) + (dp[2] + dp[3]);
                sc_upd1<0>(Q, P, Wv, Bv, Kv, saq, sap, vv);
                sv_cvt(A, ha); sv_cvt1p(Wv, hw); sv_cvt(Bv, hb); sv_cvt(Kv, hk); vv = (float)hv;
            }
        }
        float* Qp = ST + ST_Q_OFF + (size_t)(h * NCH + ch) * 4096 + lane;
        bf16* PTp = (bf16*)ST + (size_t)(h * NCH + ch) * 4096 + lane;
#pragma unroll
        for (int j = 0; j < 64; ++j) { PTp[j * 64] = f2bf(P[j]); Qp[j * 64] = Q[j]; }
    }
}
constexpr int GS = 16, NG = NCH / GS;
constexpr size_t ST_LP_OFF = (size_t)NH * NCH * 4096;
constexpr size_t WS_SG = WS_LORA + 2 * MiB;
constexpr int HI_LD = 72, HI_BYTES = 64 * HI_LD * 2;
struct HFrag { bf16x8 b[2][2]; f32x4 q[2]; };
__device__ __forceinline__ void hload(HFrag& f, const bf16* Bt, const float* QTc, int boff, int qtoff) {
#pragma unroll
    for (int ks = 0; ks < 2; ++ks)
#pragma unroll
        for (int n = 0; n < 2; ++n) f.b[ks][n] = *(const bf16x8*)(Bt + boff + 16 * n * 64 + 32 * ks);
#pragma unroll
    for (int n = 0; n < 2; ++n) f.q[n] = *(const f32x4*)(QTc + qtoff + 16 * n * 64);
}
__device__ __forceinline__ void hmma(const LAS3 unsigned char* img, const bf16x8 (&b)[2][2], f32x4 (&acc)[2], int m, int fr, int fq) {
#pragma unroll
    for (int ks = 0; ks < 2; ++ks) { const bf16x8 av = *(const LAS3 bf16x8*)(img + ((16 * m + fr) * HI_LD + 32 * ks + 8 * fq) * 2);
#pragma unroll
        for (int n = 0; n < 2; ++n) acc[n] = __builtin_amdgcn_mfma_f32_16x16x32_bf16(av, b[ks][n], acc[n], 0, 0, 0); }
}
__device__ __forceinline__ void himg_store(LAS3 unsigned char* img, const f32x4 (&acc)[2], int m, int n0, int fr, int fq) {
#pragma unroll
    for (int n = 0; n < 2; ++n)
#pragma unroll
        for (int i = 0; i < 4; ++i) *(LAS3 bf16*)(img + ((16 * m + 4 * fq + i) * HI_LD + n0 + 16 * n + fr) * 2) = f2bf(acc[n][i]);
}
#define HBAR() do { asm volatile("s_waitcnt lgkmcnt(0)" ::: "memory"); __builtin_amdgcn_s_barrier(); asm volatile("" ::: "memory"); } while (0)

__device__ __forceinline__ void sc2a_step(const HFrag& f, bf16* LpTc, float* QTc, const LAS3 unsigned char* ip, LAS3 unsigned char* ipn, const LAS3 unsigned char* iq, LAS3 unsigned char* iqn, int m, int n0, int fr, int fq, int qtoff) {
    f32x4 ap[2], aq[2];
#pragma unroll
    for (int n = 0; n < 2; ++n) { ap[n] = (f32x4){0.f, 0.f, 0.f, 0.f}; aq[n] = f.q[n]; }
    hmma(ip, f.b, ap, m, fr, fq); hmma(iq, f.b, aq, m, fr, fq);
#pragma unroll
    for (int n = 0; n < 2; ++n) { u32x2 w; w.x = pk2(ap[n][0], ap[n][1]); w.y = pk2(ap[n][2], ap[n][3]);
        *(u32x2*)(LpTc + (n0 + 16 * n + fr) * 64 + 16 * m + 4 * fq) = w;
        *(f32x4*)(QTc + qtoff + 16 * n * 64) = aq[n]; }
    himg_store(ipn, ap, m, n0, fr, fq); himg_store(iqn, aq, m, n0, fr, fq);
    HBAR();
}
__device__ __forceinline__ void phase_scan2a(ArgsR a, const Ctx& c) {
    const int lane = c.lane, wv = c.wave, fr = lane & 15, fq = lane >> 4, m = wv >> 1, n0 = 32 * (wv & 1);
    const int boff = (n0 + fr) * 64 + 8 * fq, qtoff = (n0 + fr) * 64 + 16 * m + 4 * fq;
    LAS3 unsigned char* L = (LAS3 unsigned char*)c.lds;
    for (int item = blockIdx.x; item < NH * NG; item += gridDim.x) {
        const size_t cb = (size_t)(item / NG) * NCH + (size_t)(item % NG) * GS;
        const bf16* PT = (const bf16*)(a.ws + WS_ST) + cb * 4096; bf16* LP = (bf16*)(a.ws + WS_ST) + ST_LP_OFF + cb * 4096; float* QT = (float*)(a.ws + WS_ST) + ST_Q_OFF + cb * 4096;
        for (int i = c.tid; i < 4 * HI_BYTES / 4; i += NTHREADS) ((LAS3 unsigned*)L)[i] = 0u;
        __syncthreads();
        if (c.tid < 64) *(LAS3 bf16*)(L + (c.tid * HI_LD + c.tid) * 2) = (bf16)0x3F80;
        __syncthreads();
        HFrag f0, f1, f2, f3;
        hload(f0, PT, QT, boff, qtoff); hload(f1, PT + 4096, QT + 4096, boff, qtoff); hload(f2, PT + 2 * 4096, QT + 2 * 4096, boff, qtoff); hload(f3, PT + 3 * 4096, QT + 3 * 4096, boff, qtoff);
        LAS3 unsigned char* p0 = L; LAS3 unsigned char* p1 = L + HI_BYTES; LAS3 unsigned char* q0 = L + 2 * HI_BYTES; LAS3 unsigned char* q1 = L + 3 * HI_BYTES;
#pragma unroll 1
        for (int i = 0; i < GS; i += 4) {
            const int nx = (i + 4 < GS) ? i + 4 : i;
            sc2a_step(f0, LP + (size_t)(i + 0) * 4096, QT + (size_t)(i + 0) * 4096, p0, p1, q0, q1, m, n0, fr, fq, qtoff); hload(f0, PT + (size_t)(nx + 0) * 4096, QT + (size_t)(nx + 0) * 4096, boff, qtoff);
            sc2a_step(f1, LP + (size_t)(i + 1) * 4096, QT + (size_t)(i + 1) * 4096, p1, p0, q1, q0, m, n0, fr, fq, qtoff); hload(f1, PT + (size_t)(nx + 1) * 4096, QT + (size_t)(nx + 1) * 4096, boff, qtoff);
            sc2a_step(f2, LP + (size_t)(i + 2) * 4096, QT + (size_t)(i + 2) * 4096, p0, p1, q0, q1, m, n0, fr, fq, qtoff); hload(f2, PT + (size_t)(nx + 2) * 4096, QT + (size_t)(nx + 2) * 4096, boff, qtoff);
            sc2a_step(f3, LP + (size_t)(i + 3) * 4096, QT + (size_t)(i + 3) * 4096, p1, p0, q1, q0, m, n0, fr, fq, qtoff); hload(f3, PT + (size_t)(nx + 3) * 4096, QT + (size_t)(nx + 3) * 4096, boff, qtoff);
        }
        __syncthreads();
    }
}
__device__ __forceinline__ void phase_scan2b(ArgsR a, const Ctx& c) {
    if (blockIdx.x >= NH) return;
    const int h = blockIdx.x, lane = c.lane, wv = c.wave, fr = lane & 15, fq = lane >> 4, m = wv >> 1, n0 = 32 * (wv & 1);
    const int boff = (n0 + fr) * 64 + 8 * fq, qtoff = (n0 + fr) * 64 + 16 * m + 4 * fq;
    LAS3 unsigned char* L = (LAS3 unsigned char*)c.lds;
    const bf16* LP = (const bf16*)(a.ws + WS_ST) + ST_LP_OFF + (size_t)h * NCH * 4096; const float* QT = (const float*)(a.ws + WS_ST) + ST_Q_OFF + (size_t)h * NCH * 4096;
    bf16* SG = (bf16*)(a.ws + WS_SG) + (size_t)h * NG * 4096;
    for (int i = c.tid; i < 2 * HI_BYTES / 4; i += NTHREADS) ((LAS3 unsigned*)L)[i] = 0u;
    for (int i = c.tid; i < 4096 / 2; i += NTHREADS) ((unsigned*)SG)[i] = 0u;
    __syncthreads();
    HFrag f0, f1, f2, f3;
#define SC2B_CH(g) ((size_t)((g) * GS + GS - 1) * 4096)
    hload(f0, LP + SC2B_CH(0), QT + SC2B_CH(0), boff, qtoff); hload(f1, LP + SC2B_CH(1), QT + SC2B_CH(1), boff, qtoff); hload(f2, LP + SC2B_CH(2), QT + SC2B_CH(2), boff, qtoff); hload(f3, LP + SC2B_CH(3), QT + SC2B_CH(3), boff, qtoff);
    LAS3 unsigned char* i0 = L; LAS3 unsigned char* i1 = L + HI_BYTES;
#define SC2B_STEP(f, g, ic, in) do { f32x4 acc[2] = {f.q[0], f.q[1]}; hmma(ic, f.b, acc, m, fr, fq); bf16* So = SG + (size_t)((g) + 1) * 4096; \
        _Pragma("unroll") for (int n = 0; n < 2; ++n) _Pragma("unroll") for (int i = 0; i < 4; ++i) So[(16 * m + 4 * fq + i) * 64 + n0 + 16 * n + fr] = f2bf(acc[n][i]); \
        himg_store(in, acc, m, n0, fr, fq); HBAR(); } while (0)
#pragma unroll 1
    for (int g = 0; g < NG; g += 4) {
        const int nx = (g + 4 < NG) ? g + 4 : g;
        SC2B_STEP(f0, g + 0, i0, i1); hload(f0, LP + SC2B_CH(nx + 0), QT + SC2B_CH(nx + 0), boff, qtoff);
        SC2B_STEP(f1, g + 1, i1, i0); hload(f1, LP + SC2B_CH(nx + 1), QT + SC2B_CH(nx + 1), boff, qtoff);
        SC2B_STEP(f2, g + 2, i0, i1); hload(f2, LP + SC2B_CH(nx + 2), QT + SC2B_CH(nx + 2), boff, qtoff);
        if (g + 3 < NG - 1) SC2B_STEP(f3, g + 3, i1, i0);
        hload(f3, LP + SC2B_CH(nx + 3), QT + SC2B_CH(nx + 3), boff, qtoff);
    }
#undef SC2B_STEP
#undef SC2B_CH
}
__device__ __forceinline__ void phase_scan2c(ArgsR a, const Ctx& c) {
    const int lane = c.lane, wv = c.wave, fr = lane & 15, fq = lane >> 4, m = wv >> 1, n0 = 32 * (wv & 1);
    const int boff = (n0 + fr) * 64 + 8 * fq, qtoff = (n0 + fr) * 64 + 16 * m + 4 * fq;
    LAS3 unsigned char* L = (LAS3 unsigned char*)c.lds;
    for (int item = blockIdx.x; item < NH * NG * 2; item += gridDim.x) {
        const int hg = item >> 1, hf = item & 1;
        const size_t cb = (size_t)(hg / NG) * NCH + (size_t)(hg % NG) * GS + hf * 8;
        const bf16* LP = (const bf16*)(a.ws + WS_ST) + ST_LP_OFF + cb * 4096; const float* QT = (const float*)(a.ws + WS_ST) + ST_Q_OFF + cb * 4096; bf16* SS = (bf16*)(a.ws + WS_ST) + cb * 4096;
        { const u32x4 v = *(const u32x4*)((const bf16*)(a.ws + WS_SG) + (size_t)hg * 4096 + c.tid * 8); *(LAS3 u32x4*)(L + ((c.tid >> 3) * HI_LD + (c.tid & 7) * 8) * 2) = v; }
        __syncthreads();
#pragma unroll 2
        for (int i = 0; i < 8; ++i) { HFrag f; hload(f, LP + (size_t)i * 4096, QT + (size_t)i * 4096, boff, qtoff);
            f32x4 acc[2] = {f.q[0], f.q[1]}; hmma(L, f.b, acc, m, fr, fq); bf16* So = SS + (size_t)i * 4096;
#pragma unroll
            for (int n = 0; n < 2; ++n)
#pragma unroll
                for (int k = 0; k < 4; ++k) So[(16 * m + 4 * fq + k) * 64 + n0 + 16 * n + fr] = f2bf(acc[n][k]); }
        __syncthreads();
    }
}
__device__ __forceinline__ void phase_scan3(ArgsR a, const Ctx& c) {
    const f16* R = (const f16*)(a.ws + WS_R); const f16* WM1 = (const f16*)(a.ws + WS_WM1); const f16* KP = (const f16*)(a.ws + WS_KP);
    const f16* AA = (const f16*)(a.ws + WS_AA); const f16* BB = (const f16*)(a.ws + WS_BB); const f16* V = (const f16*)(a.ws + WS_V);
    const float* ST = (const float*)(a.ws + WS_ST); bf16* YSC = (bf16*)(a.ws + WS_YSC);
    const int lane = c.lane;
    LAS3 unsigned char* ring = (LAS3 unsigned char*)c.lds + c.wave * SC_WAVE;
    for (int item = c.gw; item < NH * NCH; item += c.ngw) {
        const int h = __builtin_amdgcn_readfirstlane(item / NCH), ch = __builtin_amdgcn_readfirstlane(item % NCH);
        const size_t lane_off = (size_t)(lane >> 3) * W + h * 64 + (lane & 7) * 8;
        { const size_t e0 = (size_t)(ch * CL) * W + lane_off;
          sc_dma(AA, e0, ring); sc_dma(WM1, e0, ring + 1024); sc_dma(BB, e0, ring + 2048); sc_dma(KP, e0, ring + 3072); sc_dma(V, e0, ring + 4096); sc_dma(R, e0, ring + 5120); }
        float S[64];
        if (ch == 0) {
#pragma unroll
            for (int j = 0; j < 64; ++j) S[j] = 0.f;
        } else { const bf16* Sp = (const bf16*)ST + ((size_t)(h * NCH + ch - 1) * 64 + lane) * 64;
#pragma unroll
            for (int j = 0; j < 64; j += 4) { const f32x4 x = load4bf(Sp + j); S[j] = x[0]; S[j + 1] = x[1]; S[j + 2] = x[2]; S[j + 3] = x[3]; } }
#pragma unroll 1
        for (int blk = 0; blk < CL / SCB; ++blk) {
            LAS3 unsigned char* buf = ring + (blk & 1) * SC_BUF;
            if (blk + 1 < CL / SCB) { LAS3 unsigned char* nb = ring + ((blk + 1) & 1) * SC_BUF; const size_t e0 = (size_t)(ch * CL + (blk + 1) * SCB) * W + lane_off;
                sc_dma(AA, e0, nb); sc_dma(WM1, e0, nb + 1024); sc_dma(BB, e0, nb + 2048); sc_dma(KP, e0, nb + 3072); sc_dma(V, e0, nb + 4096); sc_dma(R, e0, nb + 5120);
                asm volatile("s_waitcnt vmcnt(6)" ::: "memory"); }
            else asm volatile("s_waitcnt vmcnt(0)" ::: "memory");
            SVec A, Wv, Bv, Kv, Rv;
            sv_cvt(A, sv_read(buf, lane)); sv_cvt1p(Wv, sv_read(buf + 1024, lane)); sv_cvt(Bv, sv_read(buf + 2048, lane)); sv_cvt(Kv, sv_read(buf + 3072, lane)); sv_cvt(Rv, sv_read(buf + 5120, lane));
            float vv = (float)*(const LAS3 f16*)(buf + 4096 + lane * 2);
#pragma unroll 1
            for (int st = 0; st < SCB; ++st) {
                const LAS3 unsigned char* sn = buf + ((st + 1 < SCB) ? st + 1 : st) * 128;
                const f16x4 ha = sv_read(sn, lane), hw = sv_read(sn + 1024, lane), hb = sv_read(sn + 2048, lane), hk = sv_read(sn + 3072, lane), hr = sv_read(sn + 5120, lane);
                const f16 hv = *(const LAS3 f16*)(sn + 4096 + lane * 2);
                float d[4] = {0.f, 0.f, 0.f, 0.f};
                sc_dot<0>(d, A, S);
                const float sa = (d[0] + d[1]) + (d[2] + d[3]);
                float y[4] = {0.f, 0.f, 0.f, 0.f};
                sc_upd3<0>(S, y, Wv, Bv, Kv, Rv, sa, vv);
                const float yy = (y[0] + y[1]) + (y[2] + y[3]);
                sv_cvt(A, ha); sv_cvt1p(Wv, hw); sv_cvt(Bv, hb); sv_cvt(Kv, hk); sv_cvt(Rv, hr); vv = (float)hv;
                YSC[(size_t)(ch * CL + blk * SCB + st) * W + h * 64 + lane] = f2bf(yy);
            }
        }
    }
}

__device__ __forceinline__ void phase_post(ArgsR a, const Ctx& c, int l) {
    const bf16* YSC = (const bf16*)(a.ws + WS_YSC); const f16* R = (const f16*)(a.ws + WS_R); const f16* KP = (const f16*)(a.ws + WS_KP); const f16* V = (const f16*)(a.ws + WS_V);
    const bf16* G = (const bf16*)(a.ws + WS_G); bf16* YA = (bf16*)(a.ws + WS_YA);
    const float* gng = a.in[I_GNG] + l * W; const float* gnb = a.in[I_GNB] + l * W; const float* rk = a.in[I_RK] + l * W;
    for (int t = c.gw; t < T; t += c.ngw) {
#pragma unroll
        for (int i = 0; i < 8; ++i) { const int n = c.lane + 64 * i; const size_t o = (size_t)t * W + n;
            const float y = bf2f(YSC[o]); const float mean = wave_sum(y) * (1.f / 64.f); const float d = y - mean; const float var = wave_sum(d * d) * (1.f / 64.f);
            float yn = d * __builtin_amdgcn_rsqf(var + GN_EPS) * gng[n] + gnb[n];
            const float r = (float)R[o], k = (float)KP[o], v = (float)V[o];
            const float bonus = wave_sum(r * k * rk[n]);
            yn += bonus * v;
            YA[o] = f2bf(yn * bf2f(G[o])); }
    }
}

__device__ __forceinline__ void phase_ln1(ArgsR a, const Ctx& c, int l, float* outw) {
    const float* MODF = (const float*)(a.ws + WS_MODF) + l * 6144;
    const float* g1 = a.in[I_LN1G] + l * D; const float* b1 = a.in[I_LN1B] + l * D;
    bf16* XN = (bf16*)(a.ws + WS_XN);
    int* TOKI = (int*)(a.ws + WS_TOKI); float* TOKW = (float*)(a.ws + WS_TOKW); int* TOKP = (int*)(a.ws + WS_TOKP);
    const float* rw = a.in[I_RW]; const float* rb = a.in[I_RB];
    LAS3 float* rwT = (LAS3 float*)((LAS3 unsigned char*)c.lds + 69632);
    unsigned* lcnt = (unsigned*)(c.lds + 135168);
    for (int i = c.tid; i < D * NE; i += NTHREADS) rwT[(i & 15) * D + (i >> 4)] = rw[i];
    if (c.tid < NE) lcnt[c.tid] = 0u;
    __syncthreads();
    for (int m = c.gw; m < T; m += c.ngw) {
        int l4 = 4 * c.lane; asm volatile("" : "+v"(l4));
        float v[16]; load_row16(a.out + (size_t)m * D, c.lane, v);
        float mean, rstd; row_stats(v, mean, rstd);
#pragma unroll
        for (int j = 0; j < 4; ++j) { f32x4 o; const int col = l4 + 256 * j;
#pragma unroll
            for (int e = 0; e < 4; ++e) { v[4 * j + e] = (v[4 * j + e] - mean) * rstd * g1[col + e] + b1[col + e]; o[e] = v[4 * j + e]; }
            *(f32x4*)(outw + (size_t)m * D + col) = o; }
        row_stats(v, mean, rstd);
#pragma unroll
        for (int j = 0; j < 4; ++j) { f32x4 o; const int col = l4 + 256 * j;
#pragma unroll
            for (int e = 0; e < 4; ++e) { v[4 * j + e] = (v[4 * j + e] - mean) * rstd * (1.0f + MODF[4096 + col + e]) + MODF[3072 + col + e]; o[e] = v[4 * j + e]; }
            store4bf(XN + (size_t)m * D + col, o); }
        float sc[16], sel[16];
#pragma unroll
        for (int e = 0; e < 16; ++e) { float lg = 0.f;
#pragma unroll
            for (int j = 0; j < 4; ++j) { const f32x4 r4 = *(const LAS3 f32x4*)(rwT + e * D + l4 + 256 * j); lg += (v[4 * j] * r4[0] + v[4 * j + 1] * r4[1]) + (v[4 * j + 2] * r4[2] + v[4 * j + 3] * r4[3]); }
            sc[e] = 1.0f / (1.0f + expf(-wave_sum(lg))); sel[e] = sc[e] + rb[e];
            if ((e & 3) == 3) __builtin_amdgcn_sched_barrier(0); }
        int best = 0; float bestv = -INFINITY;
#pragma unroll
        for (int g = 0; g < 4; ++g) { float m1 = -INFINITY, m2 = -INFINITY;
#pragma unroll
            for (int q = 0; q < 4; ++q) { const float sv = sel[4 * g + q]; if (sv > m1) { m2 = m1; m1 = sv; } else if (sv > m2) m2 = sv; }
            const float gs = m1 + m2; if (gs > bestv) { bestv = gs; best = g; } }
        int i1 = 0, i2 = 0; float s1 = -INFINITY, s2 = -INFINITY, w1 = 0.f, w2 = 0.f;
#pragma unroll
        for (int e = 0; e < 16; ++e) { if ((e >> 2) == best) { const float sv = sel[e];
                if (sv > s1) { s2 = s1; i2 = i1; w2 = w1; s1 = sv; i1 = e; w1 = sc[e]; } else if (sv > s2) { s2 = sv; i2 = e; w2 = sc[e]; } } }
        if (c.lane == 0) { const float ws = w1 + w2;
            TOKI[2 * m] = i1; TOKI[2 * m + 1] = i2; TOKW[2 * m] = w1 / ws; TOKW[2 * m + 1] = w2 / ws;
            TOKP[2 * m] = (int)atomicAdd(&lcnt[i1], 1u); TOKP[2 * m + 1] = (int)atomicAdd(&lcnt[i2], 1u); }
    }
    __syncthreads();
    if (c.tid < NE) ((int*)(a.ws + WS_BLKCNT))[blockIdx.x * NE + c.tid] = (int)lcnt[c.tid];
    __syncthreads();
    float* scr = (float*)(c.lds + c.wave * 8704);
    bf16* WGU = (bf16*)(a.ws + WS_WGU); bf16* WD = (bf16*)(a.ws + WS_WD);
    constexpr int IG = (D / 64) * (FF / 32);
    constexpr int ID = (FF / 64) * (D / 32);
    for (int it = c.gw; it < NE * (2 * IG + ID); it += c.ngw) {
        const int e = it / (2 * IG + ID); int r = it % (2 * IG + ID);
        const size_t eo = ((size_t)l * NE + e) * (size_t)D * FF;
        if (r < IG) { transpose_matrix_item(a.in[I_EG] + eo, D, FF, WGU + (size_t)e * 1024 * 1024, r, scr, c.lane, RowGU{0}); continue; } r -= IG;
        if (r < IG) { transpose_matrix_item(a.in[I_EU] + eo, D, FF, WGU + (size_t)e * 1024 * 1024, r, scr, c.lane, RowGU{1}); continue; } r -= IG;
        transpose_matrix_item(a.in[I_ED] + eo, FF, D, WD + (size_t)e * 1024 * 512, r, scr, c.lane, RowId());
    }
}

__device__ __forceinline__ void phase_perm(ArgsR a, const Ctx& c, int l) {
    const int* BLKCNT = (const int*)(a.ws + WS_BLKCNT);
    LAS3 int* pre = (LAS3 int*)c.lds;
    LAS3 int* tot = pre + 256 * NE;
    const int nb = gridDim.x;
#pragma unroll
    for (int q = 0; q < 2; ++q) { const int e = 2 * c.wave + q; int v[4]; int sum = 0;
#pragma unroll
        for (int i = 0; i < 4; ++i) { const int b = 4 * c.lane + i; v[i] = b < nb ? BLKCNT[b * NE + e] : 0; sum += v[i]; }
        int inc = sum;
#pragma unroll
        for (int o = 1; o < 64; o <<= 1) { const int t = __shfl_up(inc, o); if (c.lane >= o) inc += t; }
        int run = inc - sum;
#pragma unroll
        for (int i = 0; i < 4; ++i) { pre[(4 * c.lane + i) * NE + e] = run; run += v[i]; }
        if (c.lane == 63) tot[e] = inc; }
    __syncthreads();
    int ts[17]; { int sacc = 0;
#pragma unroll
        for (int e = 0; e < 16; ++e) { ts[e] = sacc; sacc += (tot[e] + 255) >> 8; } ts[16] = sacc; }
    if (blockIdx.x == 0 && c.tid < NE) ((int*)(a.ws + WS_TOT))[c.tid] = tot[c.tid];
    const int* TOKI = (const int*)(a.ws + WS_TOKI); const int* TOKP = (const int*)(a.ws + WS_TOKP); int* S2T = (int*)(a.ws + WS_S2T);
    const bf16* XN = (const bf16*)(a.ws + WS_XN); bf16* XS = (bf16*)(a.ws + WS_XS);
    for (int as = c.gw; as < 2 * T; as += c.ngw) {
        const int e = TOKI[as]; int base = 0;
#pragma unroll
        for (int j = 0; j < 16; ++j) base = (j == e) ? ts[j] : base;
        const int m = as >> 1, blk = (m % c.ngw) >> 3;
        const int slot = base * 256 + pre[blk * NE + e] + TOKP[as];
        if (c.lane == 0) S2T[slot] = as;
        const u32x4* src = (const u32x4*)(XN + (size_t)m * D); u32x4* dst = (u32x4*)(XS + (size_t)slot * D);
        dst[c.lane] = src[c.lane]; dst[64 + c.lane] = src[64 + c.lane];
    }
    for (int e = 0; e < 16; ++e) {
        int tse = 0, tsn = 0;
#pragma unroll
        for (int j = 0; j < 16; ++j) { tse = (j == e) ? ts[j] : tse; tsn = (j == e) ? ts[j + 1] : tsn; }
        const int lo = tse * 256 + tot[e], hi = tsn * 256;
        for (int sl = lo + c.gw; sl < hi; sl += c.ngw) { if (c.lane == 0) S2T[sl] = -1; u32x4* dst = (u32x4*)(XS + (size_t)sl * D); const u32x4 zz = {0u, 0u, 0u, 0u}; dst[c.lane] = zz; dst[64 + c.lane] = zz; }
    }
    __syncthreads();
}

__device__ __forceinline__ void phase_ln2(ArgsR a, const Ctx& c, int l, float* outw) {
    const float* MODF = (const float*)(a.ws + WS_MODF) + l * 6144;
    const float* g2 = a.in[I_LN2G] + l * D; const float* b2 = a.in[I_LN2B] + l * D;
    const bf16* Y = (const bf16*)(a.ws + WS_Y); bf16* XN = (bf16*)(a.ws + WS_XN);
    for (int m = c.gw; m < T; m += c.ngw) {
        float v[16]; load_row16(a.out + (size_t)m * D, c.lane, v);
#pragma unroll
        for (int j = 0; j < 4; ++j) { const int col = 4 * c.lane + 256 * j; const f32x4 y0 = load4bf(Y + (size_t)(2 * m) * D + col), y1 = load4bf(Y + (size_t)(2 * m + 1) * D + col);
#pragma unroll
            for (int e = 0; e < 4; ++e) v[4 * j + e] = ALPHA * v[4 * j + e] + (1.0f + MODF[5120 + col + e]) * (y0[e] + y1[e]); }
        float mean, rstd; row_stats(v, mean, rstd);
#pragma unroll
        for (int j = 0; j < 4; ++j) { f32x4 o; const int col = 4 * c.lane + 256 * j;
#pragma unroll
            for (int e = 0; e < 4; ++e) { v[4 * j + e] = (v[4 * j + e] - mean) * rstd * g2[col + e] + b2[col + e]; o[e] = v[4 * j + e]; }
            *(f32x4*)(outw + (size_t)m * D + col) = o; }
        if (l + 1 < DEPTH) {
            const float* MN = MODF + 6144;
            row_stats(v, mean, rstd);
#pragma unroll
            for (int j = 0; j < 4; ++j) { f32x4 o; const int col = 4 * c.lane + 256 * j;
#pragma unroll
                for (int e = 0; e < 4; ++e) o[e] = (v[4 * j + e] - mean) * rstd * (1.0f + MN[1024 + col + e]) + MN[col + e];
                store4bf(XN + (size_t)m * D + col, o); }
        }
    }
}


template <class F> struct EpiAdapt {
    static constexpr bool PERM = false, AFTER_DRAIN = false; F f;
    __device__ __forceinline__ void operator()(const f32x4 (&acc)[2][2][4][2], const Unit& u, int wr, int wc, int fr, int fq) const {
#pragma unroll
        for (int ai = 0; ai < 2; ++ai)
#pragma unroll
            for (int m = 0; m < 4; ++m) { const int row = u.pm * 256 + ai * 128 + wr * 64 + m * 16 + fr;
#pragma unroll
                for (int n = 0; n < 2; ++n) { const int col = u.pn * 256 + wc * 32 + n * 16 + 4 * fq; f(row, col, acc[ai][0][m][n], acc[ai][1][m][n]); } }
    }
};

#ifndef USE_PG8
#define USE_PG8 1
#endif
template <class Sched, class F>
__device__ __forceinline__ void gemm_any(const Ctx& c, const bf16* A, const bf16* Bt, int M, int N, int K, const Sched& S, const F& f) {
#if USE_PG8
    pg8::Gemm g{A, Bt, M, N, K}; EpiAdapt<F> E{f};
    pg8::gemm_phase<EpiAdapt<F>, Sched, true, true>((PG8_LAS unsigned char*)c.lds, g, S, E, c.tid);
#else
    gemm_simple(c, A, Bt, K, S, f);
#endif
}

#define LAS __attribute__((address_space(3)))
#define XB_TMO      128
#define XB_XCNT(j)  (256  + 64 * (j))
#define XB_XSUB(j)  (1280 + 64 * (j))
#define XB_XGEN(j)  (2304 + 64 * (j))
#define XB_TOP      3328
#define XB_TOPGEN   3392
#define XCD_BAR_WORDS 3456
#define XB_SPIN_CAP (1u << 24)

__device__ __forceinline__ unsigned xb_ld(unsigned* p)              { return __hip_atomic_load(p, __ATOMIC_RELAXED, __HIP_MEMORY_SCOPE_AGENT); }
__device__ __forceinline__ unsigned xb_add(unsigned* p, unsigned v) { return __hip_atomic_fetch_add(p, v, __ATOMIC_RELAXED, __HIP_MEMORY_SCOPE_AGENT); }
__device__ __forceinline__ unsigned xb_xcc_id() { return (unsigned)__builtin_amdgcn_s_getreg((3 << 11) | 20) & 0xFu; }
#define XB_SPIN(cond, bar) do { unsigned _sp = 0; while (cond) { __builtin_amdgcn_s_sleep(1); \
    if ((++_sp & 255u) == 0u) { if (xb_ld(&(bar)[XB_TMO])) break; if (_sp > XB_SPIN_CAP) { atomicAdd(&(bar)[XB_TMO], 1u); break; } } } } while (0)

struct XcdBarrier {
    unsigned* bar; unsigned x;
    volatile LAS unsigned* st;
};

__device__ __forceinline__ XcdBarrier xcd_barrier_post(unsigned* bar, volatile LAS unsigned* st) {
    XcdBarrier b; b.bar = bar; b.x = xb_xcc_id(); b.st = st;
    if (threadIdx.x == 0) (void)xb_add(&bar[XB_XCNT(b.x)], 1u);
    return b;
}
__device__ __forceinline__ void xcd_barrier_complete(unsigned* bar, unsigned x, unsigned& nloc, unsigned& nx) {
    const unsigned G = gridDim.x * gridDim.y * gridDim.z;
    unsigned sum, cnt, mine, sp = 0u;
    for (;;) {
        sum = 0u; cnt = 0u; mine = 0u;
#pragma unroll
        for (unsigned j = 0; j < 16; ++j) { const unsigned c = xb_ld(&bar[XB_XCNT(j)]); sum += c; cnt += (c > 0u) ? 1u : 0u; mine = (j == x) ? c : mine; }
        if (sum == G) break;
        __builtin_amdgcn_s_sleep(1);
        if ((++sp & 255u) == 0u) { if (xb_ld(&bar[XB_TMO])) break; if (sp > XB_SPIN_CAP) { atomicAdd(&bar[XB_TMO], 1u); break; } }
    }
    nloc = mine > 0u ? mine : 1u; nx = cnt > 0u ? cnt : 1u;
}

__device__ __forceinline__ void xcd_barrier(const XcdBarrier& b) {
    asm volatile("s_waitcnt vmcnt(0)" ::: "memory");
    __syncthreads();
    if (threadIdx.x == 0) {
        unsigned* bar = b.bar;
        __builtin_amdgcn_s_waitcnt(0);
        unsigned nloc = b.st[0], nx = b.st[1];
        if (nloc == 0u) { xcd_barrier_complete(bar, b.x, nloc, nx); b.st[0] = nloc; b.st[1] = nx; }
        const unsigned old = xb_add(&bar[XB_XSUB(b.x)], 1u);
        const unsigned gen = old / nloc;
        if (old + 1u == (gen + 1u) * nloc) {
            __builtin_amdgcn_fence(__ATOMIC_RELEASE, "agent");
            asm volatile("s_waitcnt vmcnt(0)" ::: "memory");
            const unsigned og = xb_add(&bar[XB_TOP], 1u);
            const unsigned tg = og / nx;
            if (og + 1u == (tg + 1u) * nx) xb_add(&bar[XB_TOPGEN], 1u);
            else XB_SPIN(xb_ld(&bar[XB_TOPGEN]) == tg, bar);
            __builtin_amdgcn_fence(__ATOMIC_ACQUIRE, "agent");
            xb_add(&bar[XB_XGEN(b.x)], 1u);
            asm volatile("s_waitcnt vmcnt(0)" ::: "memory");
        } else {
            XB_SPIN(xb_ld(&bar[XB_XGEN(b.x)]) == gen, bar);
            __builtin_amdgcn_fence(__ATOMIC_ACQUIRE, "agent");
            asm volatile("s_waitcnt vmcnt(0)" ::: "memory");
        }
    }
    __syncthreads();
}


constexpr int PH_PER_LAYER = 12, N_PHASES = 2 + PH_PER_LAYER * DEPTH;
constexpr int CW_BAR = 4096;
constexpr int LDS_BYTES = 147456, LDSCTL_OFF = 131072 + 8192;
#ifndef SINGLE_LAUNCH
#define SINGLE_LAUNCH 1
#endif

#ifndef PROBE_A
#define PROBE_A -1
#endif
#ifndef PROBE_B
#define PROBE_B -1
#endif
constexpr size_t WS_TS = 512 * 1024;
#if PROBE_A >= 0
#define STAMP(i) do { if (blockIdx.x == 0 && threadIdx.x == 0) ((unsigned long long*)(args_here()->ws + WS_TS))[(i)] = __builtin_amdgcn_s_memrealtime(); } while (0)
#else
#define STAMP(i) do { } while (0)
#endif
__device__ __forceinline__ const __attribute__((address_space(4))) Args* args_here() { const __attribute__((address_space(4))) Args* p = (const __attribute__((address_space(4))) Args*)__builtin_amdgcn_kernarg_segment_ptr(); asm volatile("" : "+s"(p)); return p; }
#ifndef REP_K
#define REP_K -1
#endif
__device__ __forceinline__ Ctx mkctx(int wave_s, unsigned char* lds) { Ctx c; c.wave = wave_s; c.lane = (int)__builtin_amdgcn_mbcnt_hi(~0u, __builtin_amdgcn_mbcnt_lo(~0u, 0u)); c.tid = wave_s * 64 + c.lane;
    c.gw = blockIdx.x * NWAVES + wave_s; c.ngw = gridDim.x * NWAVES; c.lds = lds; return c; }
#define PHASE1(k, ...) do { const __attribute__((address_space(4))) Args* ap_ = args_here(); if (ap_->ph_lo <= (k) && (k) < ap_->ph_hi) { ArgsR a = *ap_; const Ctx c = mkctx(wave_s, lds); __VA_ARGS__ } } while (0)
#define PHASE(k, ...) do { PHASE1(k, __VA_ARGS__); if ((k) == REP_K) { xcd_barrier(bar); PHASE1(k, __VA_ARGS__); xcd_barrier(bar); PHASE1(k, __VA_ARGS__); } } while (0)

template <int L>
__device__ __forceinline__ void run_layer(const int wave_s, unsigned char* lds, const XcdBarrier& bar) {
    const int G = gridDim.x, b = blockIdx.x;
#define BAR() do { xcd_barrier(bar); STAMP(3 + 14 * L + (bk_++)); } while (0)
    int bk_ = 0;
    PHASE(0, unsigned char* ws = a.ws; pg8::StaticOrder S; S.init(T, INC, G, b); EpiZ E{(bf16*)(ws + WS_ZR), (bf16*)(ws + WS_ZS), (bf16*)(ws + WS_ZG)};
        gemm_any(c, (const bf16*)(ws + WS_XN), (const bf16*)(ws + WS_WIN + (size_t)L * 10 * MiB), T, INC, D, S, E); );
    BAR();
    PHASE(1, phase_prep_fast(a, c, L); );
    PHASE(14, phase_sg_fast(a, c, L); );
    BAR();
    PHASE(2, phase_scan1(a, c); );
    BAR();
    PHASE(3, phase_scan2a(a, c); );
    BAR();
    PHASE(31, phase_scan2b(a, c); );
    BAR();
    PHASE(32, phase_scan2c(a, c); );
    BAR();
    PHASE(4, phase_scan3(a, c); );
    BAR();
    PHASE(5, phase_post(a, c, L); );
    BAR();
    PHASE(6, unsigned char* ws = a.ws; pg8::StaticOrder S; S.init(T, D, G, b); EpiGA E{(const bf16*)(ws + WS_ZG), (bf16*)(ws + WS_MP)};
        gemm_any(c, (const bf16*)(ws + WS_YA), (const bf16*)(ws + WS_WA + (size_t)L * WS_WL1), T, D, W, S, E); );
    BAR();
#if REP_K == 7
    PHASE1(7, unsigned char* ws = a.ws; pg8::StaticOrder S; S.init(T, D, G, b); EpiGB E{(const bf16*)(ws + WS_ZG), (const bf16*)(ws + WS_MP), (bf16*)(ws + WS_ZR)};
        gemm_any(c, (const bf16*)(ws + WS_YB), (const bf16*)(ws + WS_WB + (size_t)L * WS_WL1), T, D, W, S, E); ); xcd_barrier(bar);
    PHASE1(7, unsigned char* ws = a.ws; pg8::StaticOrder S; S.init(T, D, G, b); EpiGB E{(const bf16*)(ws + WS_ZG), (const bf16*)(ws + WS_MP), (bf16*)(ws + WS_ZR)};
        gemm_any(c, (const bf16*)(ws + WS_YB), (const bf16*)(ws + WS_WB + (size_t)L * WS_WL1), T, D, W, S, E); ); xcd_barrier(bar);
#endif
#if REP_K == 8
    PHASE1(8, unsigned char* ws = a.ws; pg8::StaticOrder S; S.init(T, D, G, b); EpiOut E{L == 0 ? a.in[I_X] : a.out, (float*)(ws + WS_R), (const float*)(ws + WS_MODF) + L * 6144 + 2048};
        gemm_any(c, (const bf16*)(ws + WS_MP), (const bf16*)(ws + WS_WO + (size_t)L * WS_WL1), T, D, D, S, E); ); xcd_barrier(bar);
    PHASE1(8, unsigned char* ws = a.ws; pg8::StaticOrder S; S.init(T, D, G, b); EpiOut E{L == 0 ? a.in[I_X] : a.out, (float*)(ws + WS_R), (const float*)(ws + WS_MODF) + L * 6144 + 2048};
        gemm_any(c, (const bf16*)(ws + WS_MP), (const bf16*)(ws + WS_WO + (size_t)L * WS_WL1), T, D, D, S, E); ); xcd_barrier(bar);
#endif
    PHASE1(7, unsigned char* ws = a.ws; pg8::StaticOrder S; S.init(T, D, G, b); EpiGB E{(const bf16*)(ws + WS_ZG), (const bf16*)(ws + WS_MP), (bf16*)(ws + WS_MP)};
        gemm_any(c, (const bf16*)(ws + WS_YB), (const bf16*)(ws + WS_WB + (size_t)L * WS_WL1), T, D, W, S, E); );
    BAR();
    PHASE1(8, unsigned char* ws = a.ws; pg8::StaticOrder S; S.init(T, D, G, b); EpiOut E{L == 0 ? a.in[I_X] : a.out, a.out, (const float*)(ws + WS_MODF) + L * 6144 + 2048};
        gemm_any(c, (const bf16*)(ws + WS_MP), (const bf16*)(ws + WS_WO + (size_t)L * WS_WL1), T, D, D, S, E); );
    BAR();
#if REP_K == 9
    PHASE1(9, phase_ln1(a, c, L, (float*)(a.ws + WS_ZR)); ); xcd_barrier(bar); PHASE1(9, phase_ln1(a, c, L, (float*)(a.ws + WS_ZR)); ); xcd_barrier(bar);
#endif
    PHASE1(9, phase_ln1(a, c, L, a.out); );
    BAR();
    PHASE(10, phase_perm(a, c, L); );
    BAR();
    PHASE(11, unsigned char* ws = a.ws; MoeSched S; S.init((const unsigned*)(ws + WS_TOT), G, b); EpiSwi E{(bf16*)(ws + WS_HID)};
        gemm_any(c, (const bf16*)(ws + WS_XS), (const bf16*)(ws + WS_WGU), MAXSLOT, NE * 1024, D, S, E); );
    BAR();
    PHASE(12, unsigned char* ws = a.ws; MoeSched S; S.init((const unsigned*)(ws + WS_TOT), G, b); EpiDown E{(const int*)(ws + WS_S2T), (const float*)(ws + WS_TOKW), (bf16*)(ws + WS_Y)};
        gemm_any(c, (const bf16*)(ws + WS_HID), (const bf16*)(ws + WS_WD), MAXSLOT, NE * 1024, FF, S, E); );
    BAR();
#if REP_K == 13
    PHASE1(13, phase_ln2(a, c, L, (float*)(a.ws + WS_R)); ); xcd_barrier(bar); PHASE1(13, phase_ln2(a, c, L, (float*)(a.ws + WS_R)); ); xcd_barrier(bar);
#endif
    PHASE1(13, phase_ln2(a, c, L, a.out); );
    if (L + 1 < DEPTH) BAR();
    (void)bk_;
#undef BAR
}

__global__ void __launch_bounds__(NTHREADS, 2) mk_fwd(Args a_unused) {
    extern __shared__ __attribute__((aligned(16))) unsigned char lds[];
    const int wave_s = __builtin_amdgcn_readfirstlane(threadIdx.x >> 6);
    for (int u = threadIdx.x; u < (LDS_BYTES - LDSCTL_OFF) / 4; u += NTHREADS) ((LAS unsigned*)((LAS unsigned char*)lds + LDSCTL_OFF))[u] = 0u;
    __syncthreads();
    const XcdBarrier bar = xcd_barrier_post((unsigned*)(args_here()->ws + WS_CTL) + CW_BAR, (volatile LAS unsigned*)((LAS unsigned char*)lds + LDSCTL_OFF) + 8);
    STAMP(0);
    PHASE(100, phase_p0a(a, c); );
    xcd_barrier(bar); STAMP(1);
    PHASE(101, phase_p0b(a, c); );
    xcd_barrier(bar); STAMP(2);
    run_layer<0>(wave_s, lds, bar);
    run_layer<1>(wave_s, lds, bar);
#if PROBE_A >= 0
    if (blockIdx.x == 0) {
        asm volatile("s_waitcnt vmcnt(0)" ::: "memory"); __syncthreads();
        if (threadIdx.x == 0) ((unsigned long long*)(args_here()->ws + WS_TS))[30] = __builtin_amdgcn_s_memrealtime();
        asm volatile("s_waitcnt vmcnt(0)" ::: "memory"); __syncthreads();
        const volatile unsigned long long* ts = (const volatile unsigned long long*)(args_here()->ws + WS_TS);
        float da = 0.f, db = 0.f;
        if (PROBE_A < 14) { da = (float)(ts[3 + PROBE_A] - ts[2 + PROBE_A]) + (float)(ts[17 + PROBE_A] - ts[16 + PROBE_A]); } else if (PROBE_A == 14) da = (float)(ts[1] - ts[0]); else if (PROBE_A == 15) da = (float)(ts[2] - ts[1]); else da = (float)(ts[30] - ts[0]);
        if (PROBE_B >= 0 && PROBE_B < 14) { db = (float)(ts[3 + PROBE_B] - ts[2 + PROBE_B]) + (float)(ts[17 + PROBE_B] - ts[16 + PROBE_B]); } else if (PROBE_B == 14) db = (float)(ts[1] - ts[0]); else if (PROBE_B == 15) db = (float)(ts[2] - ts[1]);
        da *= 0.01f; db *= 0.01f;
        da = exp2f(0.25f * rintf(4.0f * log2f(fmaxf(da, 0.5f)))); db = exp2f(0.25f * rintf(4.0f * log2f(fmaxf(db, 0.5f))));
        float* out = args_here()->out;
        for (int i = threadIdx.x; i < 16 * 1024; i += NTHREADS) { const int r = i >> 10, col = i & 1023; const int rowi = (r & 7) + 2048 * (r >> 3); out[(size_t)rowi * D + col] = da; }
        if (threadIdx.x == 0 && PROBE_B >= 0) out[(size_t)4096 * D] = 100.0f * db;
    }
#endif
}

extern "C" void kernel_launch(void* const* d_in, const int* in_sizes, int n_in, void* d_out, int out_size, void* d_ws, size_t ws_size, hipStream_t stream) {
    static int grid = 0;
    if (grid == 0) {
        if (n_in != N_IN || out_size != T * D || ws_size < WS_END) { fprintf(stderr, "kernel_launch: unexpected shapes: n_in %d out %d ws %zu (need %zu)\n", n_in, out_size, ws_size, (size_t)WS_END); grid = -1; return; }
        int dev = 0, cus = 0;
        (void)hipGetDevice(&dev); (void)hipDeviceGetAttribute(&cus, hipDeviceAttributeMultiprocessorCount, dev);
        if (hipFuncSetAttribute((const void*)mk_fwd, hipFuncAttributeMaxDynamicSharedMemorySize, LDS_BYTES) != hipSuccess) { fprintf(stderr, "kernel_launch: hipFuncSetAttribute failed\n"); grid = -1; return; }
        grid = cus > 0 ? cus : 256;
        fprintf(stderr, "kernel_launch: ws_size %zu grid %d\n", ws_size, grid);
    }
    if (grid < 0) return;
    (void)hipMemsetAsync((char*)d_ws + WS_CTL, 0, CTL_BYTES, stream);
    Args a{};
    for (int i = 0; i < N_IN; ++i) a.in[i] = (const float*)d_in[i];
    a.out = (float*)d_out; a.ws = (unsigned char*)d_ws;
    a.ph_lo = 0; a.ph_hi = 1000;
    hipLaunchKernelGGL(mk_fwd, dim3(grid), dim3(NTHREADS), LDS_BYTES, stream, a);
}
```

```cpp
#include <hip/hip_runtime.h>
#include <cstdio>
#include <cstdint>
#include <utility>

typedef unsigned short bf16;
typedef _Float16 f16;
typedef float f32x4 __attribute__((ext_vector_type(4)));
typedef unsigned u32x4 __attribute__((ext_vector_type(4)));
typedef unsigned u32x2 __attribute__((ext_vector_type(2)));

constexpr int T = 16384, D = 1024, W = 512, NH = 8, HN = 64, RC = 1792, INC = 4864;
constexpr int NE = 16, FF = 512, DEPTH = 2;
constexpr float LN_EPS = 1e-5f, GN_EPS = 64e-5f, ALPHA = 1.41421356237f;
constexpr int NTHREADS = 512, NWAVES = 8;
constexpr int MAXSLOT = 36864;

constexpr size_t MiB = 1u << 20;
constexpr size_t WS_CTL = 0, CTL_BYTES = 1 * MiB;
constexpr int CW_CNT = 16384;
constexpr size_t WS_PART = 1 * MiB;
constexpr size_t WS_MODF = 2 * MiB;
constexpr size_t WS_TOKI = 2 * MiB + 65536;
constexpr size_t WS_TOKW = WS_TOKI + 131072;
constexpr size_t WS_TOKP = WS_TOKW + 131072;
constexpr size_t WS_S2T = 3 * MiB;
constexpr size_t WS_BLKCNT = 3 * MiB + 512 * 1024;
constexpr size_t WS_TOT = WS_BLKCNT + 32768;
constexpr size_t WS_LORA = 4 * MiB;
constexpr size_t WS_WIN = 8 * MiB;
constexpr size_t WS_WA = 28 * MiB, WS_WB = 29 * MiB, WS_WO = 30 * MiB, WS_WL1 = 4 * MiB;
constexpr size_t WS_ZG = 36 * MiB;
constexpr size_t WS_XN = 100 * MiB;
constexpr size_t WS_G = 100 * MiB, WS_YB = 116 * MiB;
constexpr size_t WS_ZR = 132 * MiB;
constexpr size_t WS_ZS = 188 * MiB;
constexpr size_t WS_YSC = 132 * MiB;
constexpr size_t WS_ST = 148 * MiB;
constexpr size_t WS_YA = 132 * MiB;
constexpr size_t WS_MP = 164 * MiB;
constexpr size_t WS_XS = 132 * MiB;
constexpr size_t WS_Y = 132 * MiB;
constexpr size_t WS_R = 224 * MiB, WS_WM1 = 240 * MiB, WS_KP = 256 * MiB, WS_AA = 272 * MiB, WS_BB = 288 * MiB, WS_V = 304 * MiB;
constexpr size_t WS_WGU = 224 * MiB;
constexpr size_t WS_WD = 256 * MiB;
constexpr size_t WS_HID = 272 * MiB;
constexpr size_t WS_VF = 320 * MiB;
constexpr size_t WS_END = 336 * MiB;

constexpr size_t LO_W2T = 0, LO_A2T = 65536, LO_G2T = 131072, LO_VM1T = 262144, LO_VM2T = 294912, LO_STRIDE = 524288;

enum { I_X = 0, I_C, I_WMOD, I_BMOD, I_WIN, I_MU, I_W0, I_W2, I_A0, I_A2, I_G2, I_KK, I_KA, I_RK, I_GNG, I_GNB, I_VM0, I_VM1, I_VM2,
       I_SGG, I_SGB, I_WS, I_BS, I_WBA, I_WBB, I_WOUT, I_LN1G, I_LN1B, I_RW, I_RB, I_EG, I_EU, I_ED, I_LN2G, I_LN2B, N_IN };

struct Args { const float* in[N_IN]; float* out; unsigned char* ws; int ph_lo, ph_hi; };
typedef const __attribute__((address_space(4))) Args& ArgsR;

__device__ __forceinline__ float bf2f(bf16 h) { return __uint_as_float(((unsigned)h) << 16); }
__device__ __forceinline__ unsigned f2bfu(float f) { unsigned u = __float_as_uint(f); return (u + 0x7fffu + ((u >> 16) & 1u)) >> 16; }
__device__ __forceinline__ bf16 f2bf(float f) { return __builtin_bit_cast(unsigned short, (__bf16)f); }
typedef __bf16 bf16x2_t __attribute__((ext_vector_type(2)));
__device__ __forceinline__ unsigned pk2(float lo, float hi) { bf16x2_t v; v[0] = (__bf16)lo; v[1] = (__bf16)hi; return __builtin_bit_cast(unsigned, v); }
__device__ __forceinline__ void store4bf(bf16* p, f32x4 v) { u32x2 w; w.x = pk2(v[0], v[1]); w.y = pk2(v[2], v[3]); *(u32x2*)p = w; }
__device__ __forceinline__ f32x4 load4bf(const bf16* p) { u32x2 w = *(const u32x2*)p; f32x4 r; r[0] = __uint_as_float(w.x << 16); r[1] = __uint_as_float(w.x & 0xffff0000u); r[2] = __uint_as_float(w.y << 16); r[3] = __uint_as_float(w.y & 0xffff0000u); return r; }
__device__ __forceinline__ float wave_sum(float v) {
#pragma unroll
    for (int o = 1; o < 64; o <<= 1) v += __shfl_xor(v, o);
    return v;
}
__device__ __forceinline__ float sigmoidf_(float x) { return __builtin_amdgcn_rcpf(1.0f + __expf(-x)); }
__device__ __forceinline__ float siluf_(float x) { return x * sigmoidf_(x); }
__device__ __forceinline__ float gelu_tanh(float x) { const float u = 0.7978845608028654f * (x + 0.044715f * x * x * x); return x * (1.0f - __builtin_amdgcn_rcpf(1.0f + __expf(2.0f * u))); }
__device__ __forceinline__ float softplusf_(float y) { return fmaxf(y, 0.f) + log1pf(__expf(-fabsf(y))); }

struct Ctx { int tid, lane, wave, gw, ngw; unsigned char* lds; };

__device__ __forceinline__ void transpose_item(const float* Wsrc, int N, int k0, int n0, bf16* dst, int ldk, float* scr, int lane) {
    float tv[32];
#pragma unroll
    for (int i = 0; i < 32; ++i) tv[i] = Wsrc[(size_t)(k0 + 2 * i + (lane >> 5)) * N + n0 + (lane & 31)];
#pragma unroll
    for (int i = 0; i < 32; ++i) scr[(2 * i + (lane >> 5)) * 33 + (lane & 31)] = tv[i];
    asm volatile("s_waitcnt lgkmcnt(0)" ::: "memory");
    const int c = lane & 7;
#pragma unroll
    for (int j = 0; j < 4; ++j) { const int n = (lane >> 3) + 8 * j; const float* s = scr + (8 * c) * 33 + n;
        u32x4 o; o.x = pk2(s[0 * 33], s[1 * 33]); o.y = pk2(s[2 * 33], s[3 * 33]); o.z = pk2(s[4 * 33], s[5 * 33]); o.w = pk2(s[6 * 33], s[7 * 33]);
        *(u32x4*)(dst + (size_t)n * ldk + k0 + 8 * c) = o; }
    asm volatile("s_waitcnt lgkmcnt(0)" ::: "memory");
}
template <class RowMap>
__device__ __forceinline__ void transpose_matrix_item(const float* Wsrc, int K, int N, bf16* dst, int item, float* scr, int lane, const RowMap& rm) {
    const int nblk = N / 32, kb = item / nblk, nb = item % nblk, n0 = 32 * nb;
    transpose_item(Wsrc, N, 64 * kb, n0, dst + (size_t)rm(n0) * K, K, scr, lane);
}
struct RowId { __device__ __forceinline__ int operator()(int n) const { return n; } };
struct RowGU { int up; __device__ __forceinline__ int operator()(int n) const { return (n >> 7) * 256 + (n & 127) + up * 128; } };

__device__ __forceinline__ void phase_p0a(ArgsR a, const Ctx& c) {
    float* scr = (float*)(c.lds + c.wave * 16384);
    { float* MODF = (float*)(a.ws + WS_MODF); float* red = (float*)(c.lds + 131072);
      for (int cbk = blockIdx.x; cbk < 2 * 96; cbk += gridDim.x) {
          const int l = cbk / 96, n = (cbk % 96) * 64 + c.lane;
          const float* wm = a.in[I_WMOD] + (size_t)l * D * 6144 + (size_t)(c.wave * 128) * 6144 + n;
          float acc0 = 0.f, acc1 = 0.f;
#pragma unroll 16
          for (int k = 0; k < 128; k += 2) { acc0 += siluf_(a.in[I_C][c.wave * 128 + k]) * wm[(size_t)k * 6144]; acc1 += siluf_(a.in[I_C][c.wave * 128 + k + 1]) * wm[(size_t)(k + 1) * 6144]; }
          red[c.wave * 64 + c.lane] = acc0 + acc1;
          __syncthreads();
          if (c.wave == 0) { float sacc = a.in[I_BMOD][l * 6144 + n];
#pragma unroll
              for (int w = 0; w < 8; ++w) sacc += red[w * 64 + c.lane];
              MODF[l * 6144 + n] = sacc; }
          __syncthreads();
      } }
    for (int it = c.gw; it < 2 * (16 + 16 + 32 + 8); it += c.ngw) {
        const int l = it / 72; int r = it % 72; unsigned char* lo = a.ws + WS_LORA + (size_t)l * LO_STRIDE;
        if (r < 16) { transpose_matrix_item(a.in[I_W2] + (size_t)l * 64 * W, 64, W, (bf16*)(lo + LO_W2T), r, scr, c.lane, RowId()); continue; } r -= 16;
        if (r < 16) { transpose_matrix_item(a.in[I_A2] + (size_t)l * 64 * W, 64, W, (bf16*)(lo + LO_A2T), r, scr, c.lane, RowId()); continue; } r -= 16;
        if (r < 32) { transpose_matrix_item(a.in[I_G2] + (size_t)l * 128 * W, 128, W, (bf16*)(lo + LO_G2T), r, scr, c.lane, RowId()); continue; } r -= 32;
        if (l == 1) transpose_matrix_item(a.in[I_VM1], W, 32, (bf16*)(lo + LO_VM1T), r, scr, c.lane, RowId());
    }
    for (int i = blockIdx.x * NTHREADS + c.tid; i < 32 * W; i += gridDim.x * NTHREADS) { const int n = i >> 5, k = i & 31;
        ((bf16*)(a.ws + WS_LORA + LO_STRIDE + LO_VM2T))[i] = f2bf(a.in[I_VM2][(size_t)k * W + n]); }
    constexpr int I_WINL = (D / 64) * (INC / 32);
    constexpr int I_WAL = (W / 64) * (D / 32);
    constexpr int I_WOL = (D / 64) * (D / 32);
    constexpr int PER_L = I_WINL + 2 * I_WAL + I_WOL;
    for (int it = c.gw; it < 2 * PER_L; it += c.ngw) {
        const int l = it / PER_L; int r = it % PER_L;
        if (r < I_WINL) { transpose_matrix_item(a.in[I_WIN] + (size_t)l * D * INC, D, INC, (bf16*)(a.ws + WS_WIN + (size_t)l * 10 * MiB), r, scr, c.lane, RowId()); continue; } r -= I_WINL;
        if (r < I_WAL) { transpose_matrix_item(a.in[I_WBA] + (size_t)l * W * D, W, D, (bf16*)(a.ws + WS_WA + (size_t)l * WS_WL1), r, scr, c.lane, RowId()); continue; } r -= I_WAL;
        if (r < I_WAL) { transpose_matrix_item(a.in[I_WBB] + (size_t)l * W * D, W, D, (bf16*)(a.ws + WS_WB + (size_t)l * WS_WL1), r, scr, c.lane, RowId()); continue; } r -= I_WAL;
        transpose_matrix_item(a.in[I_WOUT] + (size_t)l * D * D, D, D, (bf16*)(a.ws + WS_WO + (size_t)l * WS_WL1), r, scr, c.lane, RowId());
    }
}

__device__ __forceinline__ void row_stats(const float (&v)[16], float& mean, float& rstd) {
    float s = 0.f;
#pragma unroll
    for (int j = 0; j < 16; ++j) s += v[j];
    mean = wave_sum(s) * (1.f / D);
    float q = 0.f;
#pragma unroll
    for (int j = 0; j < 16; ++j) { const float d = v[j] - mean; q += d * d; }
    rstd = __builtin_amdgcn_rsqf(wave_sum(q) * (1.f / D) + LN_EPS);
}
__device__ __forceinline__ void load_row16(const float* p, int lane, float (&v)[16]) {
#pragma unroll
    for (int j = 0; j < 4; ++j) { const f32x4 x = *(const f32x4*)(p + 4 * lane + 256 * j); v[4 * j] = x[0]; v[4 * j + 1] = x[1]; v[4 * j + 2] = x[2]; v[4 * j + 3] = x[3]; }
}

__device__ __forceinline__ void phase_p0b(ArgsR a, const Ctx& c) {
    const float* MODF = (const float*)(a.ws + WS_MODF);
    float sh[16], sc[16];
#pragma unroll
    for (int j = 0; j < 4; ++j) { const f32x4 s0 = *(const f32x4*)(MODF + 4 * c.lane + 256 * j), s1 = *(const f32x4*)(MODF + 1024 + 4 * c.lane + 256 * j);
#pragma unroll
        for (int e = 0; e < 4; ++e) { sh[4 * j + e] = s0[e]; sc[4 * j + e] = 1.f + s1[e]; } }
    bf16* XN = (bf16*)(a.ws + WS_XN);
    for (int m = c.gw; m < T; m += c.ngw) {
        float v[16]; load_row16(a.in[I_X] + (size_t)m * D, c.lane, v);
        float mean, rstd; row_stats(v, mean, rstd);
#pragma unroll
        for (int j = 0; j < 4; ++j) { f32x4 o;
#pragma unroll
            for (int e = 0; e < 4; ++e) o[e] = (v[4 * j + e] - mean) * rstd * sc[4 * j + e] + sh[4 * j + e];
            store4bf(XN + (size_t)m * D + 4 * c.lane + 256 * j, o); }
    }
}

namespace pg8 {
#define PG8_LAS __attribute__((address_space(3)))
typedef unsigned short bf16_t;
typedef short bf16x8 __attribute__((ext_vector_type(8)));
typedef float f32x4 __attribute__((ext_vector_type(4)));
typedef unsigned u32x4 __attribute__((ext_vector_type(4)));
constexpr int BM = 256, BK = 64, HALF = 128, HTB = HALF * BK * 2  , STAGE_BYTES = 8 * HTB, NXCD = 8, WGM = 8;

__host__ __device__ __forceinline__ int lds_byte(int r, int c) { const int st = (r >> 4) * 2 + (c >> 5), rr = r & 15, cc = c & 31, ob = rr * 64 + cc * 2; return st * 1024 + (ob ^ (((ob >> 9) & 1) << 5)); }
__host__ __device__ __forceinline__ void stage_rc(int b, int& R, int& C) { const int st = b / 1024, sb = b % 1024, swz = sb ^ (((sb >> 9) & 1) << 5); R = (st >> 1) * 16 + swz / 64; C = (st & 1) * 32 + (swz % 64) / 2; }
__host__ __device__ __forceinline__ int perm32(int rho) { const int n = rho >> 4, i = rho & 15; return 8 * (i >> 2) + 4 * n + (i & 3); }

struct Unit { int pm, pn; };
struct Gemm { const bf16_t* A; const bf16_t* Bt; int M, N, K; };

struct StaticOrder {
    int nM, nN, nwg, G, c;
    __host__ __device__ void init(int M, int N, int G_, int c_) { nM = M / BM; nN = N / BM; nwg = nM * nN; G = G_; c = c_; }
    __host__ __device__ bool next(int i, Unit& u) const {
        const long L = (long)i * G + c; if (L >= nwg) return false;
        int wgid = (int)L; { const int q = nwg / NXCD, r = nwg % NXCD, xcd = wgid % NXCD, off = wgid / NXCD; wgid = (xcd < r ? xcd * (q + 1) : r * (q + 1) + (xcd - r) * q) + off; }
        const int nig = WGM * nN, gid = wgid / nig, fm = gid * WGM, gsz = (nM - fm) < WGM ? (nM - fm) : WGM;
        u.pm = fm + ((wgid % nig) % gsz); u.pn = (wgid % nig) / gsz; return true;
    }
    __device__ __forceinline__ void a_ready(const Unit&) const {}
    __device__ __forceinline__ void done(const Unit&) const {}
};


template <class Epi, class Sched, bool ALIGN_EPI = false, bool SP2 = false>
__device__ __forceinline__ void gemm_phase(PG8_LAS unsigned char* lds, const Gemm g, const Sched& S, const Epi& E, const int tid_in) {
    const int tid = tid_in, wid = __builtin_amdgcn_readfirstlane(tid >> 6), lane = tid & 63, wr = wid >> 2, wc = wid & 3, fr = lane & 15, fq = lane >> 4;
    const int K = g.K, nt = K / BK;
    unsigned voffA[2], voffB[2];
#pragma unroll
    for (int i = 0; i < 2; ++i) { int R, C; stage_rc(tid * 16 + i * 8192, R, C); const int Rb = Epi::PERM ? ((R & ~31) + perm32(R & 31)) : R;
        voffA[i] = (unsigned)(R * K + C) * 2u; voffB[i] = (unsigned)(Rb * K + C) * 2u; }
    const size_t kstep = (size_t)(BK * 2);
    const size_t hstep = (size_t)HALF * K * 2;
    const size_t tstep = 2 * hstep;
    const unsigned ldsw = (unsigned)wid * 1024u;
    const int aoff = lds_byte(wr * 64 + fr, fq * 8), boff = lds_byte(wc * 32 + fr, fq * 8);
#define PG8_SA(b, h) (((b) * 2 + (h)) * HTB)
#define PG8_SB(b, h) ((4 + (b) * 2 + (h)) * HTB)
#define PG8_STAGE(bufoff, gbase, voff) do { _Pragma("unroll") for (int _i = 0; _i < 2; ++_i) \
        __builtin_amdgcn_global_load_lds((const unsigned*)((const char*)(gbase) + (voff)[_i]), (PG8_LAS unsigned*)(lds + (bufoff) + ldsw + _i * 8192), 16, 0, 0); } while (0)
#define PG8_LDA(dst, b, h) do { _Pragma("unroll") for (int m = 0; m < 4; ++m) _Pragma("unroll") for (int k = 0; k < 2; ++k) dst[m][k] = *(const PG8_LAS bf16x8*)(lds + PG8_SA(b, h) + aoff + m * 2048 + k * 1024); } while (0)
#define PG8_LDB(dst, b, h) do { _Pragma("unroll") for (int n = 0; n < 2; ++n) _Pragma("unroll") for (int k = 0; k < 2; ++k) dst[n][k] = *(const PG8_LAS bf16x8*)(lds + PG8_SB(b, h) + boff + n * 2048 + k * 1024); } while (0)
#define PG8_MMA(ai, bj, At, Bt) do { __builtin_amdgcn_s_setprio(1); _Pragma("unroll") for (int m = 0; m < 4; ++m) _Pragma("unroll") for (int n = 0; n < 2; ++n) _Pragma("unroll") for (int k = 0; k < 2; ++k) \
        acc[ai][bj][m][n] = __builtin_amdgcn_mfma_f32_16x16x32_bf16(Bt[n][k], At[m][k], acc[ai][bj][m][n], 0, 0, 0); __builtin_amdgcn_s_setprio(0); } while (0)
#define PG8_WAIT_V(n) asm volatile("s_waitcnt vmcnt(" #n ")" ::: "memory")
#define PG8_WAIT_L(n) asm volatile("s_waitcnt lgkmcnt(" #n ")" ::: "memory")
#define PG8_BAR __builtin_amdgcn_s_barrier()
#define PG8_SCHED __builtin_amdgcn_sched_barrier(0)
    Unit cur, nxt; int ui = 0;
    if (!S.next(0, cur)) return;
    f32x4 acc[2][2][4][2];
#pragma unroll
    for (int a = 0; a < 2; ++a)
#pragma unroll
        for (int b = 0; b < 2; ++b)
#pragma unroll
            for (int m = 0; m < 4; ++m)
#pragma unroll
                for (int n = 0; n < 2; ++n) acc[a][b][m][n] = (f32x4){0.f, 0.f, 0.f, 0.f};
    bf16x8 At[4][2], B0[2][2], B1[2][2];
    const char* cA = (const char*)g.A + (size_t)cur.pm * tstep; const char* cB = (const char*)g.Bt + (size_t)cur.pn * tstep;
    S.a_ready(cur);
    if constexpr (SP2) {
        PG8_STAGE(PG8_SB(0, 0), cB, voffB); PG8_STAGE(PG8_SB(0, 1), cB + hstep, voffB); PG8_STAGE(PG8_SA(0, 0), cA, voffA); PG8_STAGE(PG8_SA(0, 1), cA + hstep, voffA);
        if (wr == 1) PG8_BAR;
        PG8_WAIT_V(2); PG8_BAR;
        PG8_STAGE(PG8_SB(1, 0), cB + kstep, voffB); PG8_STAGE(PG8_SA(1, 0), cA + kstep, voffA); PG8_STAGE(PG8_SB(1, 1), cB + hstep + kstep, voffB);
        PG8_WAIT_V(6); PG8_BAR;
    } else {
        PG8_STAGE(PG8_SB(0, 0), cB, voffB); PG8_STAGE(PG8_SA(0, 0), cA, voffA); PG8_STAGE(PG8_SB(0, 1), cB + hstep, voffB); PG8_STAGE(PG8_SA(0, 1), cA + hstep, voffA);
        if (wr == 1) PG8_BAR;
        PG8_WAIT_V(4); PG8_BAR;
        PG8_STAGE(PG8_SB(1, 0), cB + kstep, voffB); PG8_STAGE(PG8_SA(1, 0), cA + kstep, voffA); PG8_STAGE(PG8_SB(1, 1), cB + hstep + kstep, voffB);
        PG8_WAIT_V(6); PG8_BAR;
    }
    for (;;) {
        const bool has_next = S.next(ui + 1, nxt);
        const char* nA = has_next ? (const char*)g.A + (size_t)nxt.pm * tstep : cA; const char* nB = has_next ? (const char*)g.Bt + (size_t)nxt.pn * tstep : cB;
        for (int t = 0; t < nt; t += 2) {
            const bool last = (t == nt - 2);
            const char* a1 = cA + (size_t)(t + 1) * kstep;
            const char* a2 = last ? nA : cA + (size_t)(t + 2) * kstep; const char* b2 = last ? nB : cB + (size_t)(t + 2) * kstep;
            const char* a3 = a2 + kstep; const char* b3 = b2 + kstep;
            if (last && has_next) S.a_ready(nxt);
            if constexpr (SP2) {
            PG8_LDB(B0, 0, 0); PG8_LDB(B1, 0, 1); PG8_SCHED; PG8_LDA(At, 0, 0); PG8_STAGE(PG8_SA(1, 1), a1 + hstep, voffA);
            PG8_WAIT_V(8); PG8_WAIT_L(0); PG8_BAR; PG8_MMA(0, 0, At, B0); PG8_MMA(0, 1, At, B1); PG8_BAR; PG8_SCHED;
            PG8_LDA(At, 0, 1); PG8_STAGE(PG8_SB(0, 0), b2, voffB); PG8_STAGE(PG8_SB(0, 1), b2 + hstep, voffB); PG8_STAGE(PG8_SA(0, 0), a2, voffA);
            PG8_WAIT_V(8); PG8_WAIT_L(0); PG8_BAR; PG8_MMA(1, 0, At, B0); PG8_MMA(1, 1, At, B1); PG8_BAR; PG8_SCHED;
            PG8_LDB(B0, 1, 0); PG8_LDB(B1, 1, 1); PG8_SCHED; PG8_LDA(At, 1, 0); PG8_STAGE(PG8_SA(0, 1), a2 + hstep, voffA);
            PG8_WAIT_V(8); PG8_WAIT_L(0); PG8_BAR; PG8_MMA(0, 0, At, B0); PG8_MMA(0, 1, At, B1); PG8_BAR; PG8_SCHED;
            PG8_LDA(At, 1, 1); PG8_STAGE(PG8_SB(1, 0), b3, voffB); PG8_STAGE(PG8_SB(1, 1), b3 + hstep, voffB); PG8_STAGE(PG8_SA(1, 0), a3, voffA);
            PG8_WAIT_V(8); PG8_WAIT_L(0); PG8_BAR; PG8_MMA(1, 0, At, B0); PG8_MMA(1, 1, At, B1); PG8_BAR; PG8_SCHED;
            } else {
            PG8_LDB(B0, 0, 0); PG8_SCHED; PG8_LDA(At, 0, 0); PG8_STAGE(PG8_SA(1, 1), a1 + hstep, voffA);
            PG8_WAIT_L(8); PG8_BAR; PG8_WAIT_L(0); PG8_MMA(0, 0, At, B0); PG8_BAR; PG8_SCHED;
            PG8_LDB(B1, 0, 1); PG8_STAGE(PG8_SB(0, 0), b2, voffB);
            PG8_BAR; PG8_WAIT_L(0); PG8_MMA(0, 1, At, B1); PG8_BAR;
            PG8_LDA(At, 0, 1); PG8_STAGE(PG8_SA(0, 0), a2, voffA);
            PG8_BAR; PG8_WAIT_L(0); PG8_MMA(1, 0, At, B0); PG8_BAR; PG8_SCHED;
            PG8_STAGE(PG8_SB(0, 1), b2 + hstep, voffB);
            PG8_WAIT_V(6); PG8_BAR; PG8_MMA(1, 1, At, B1); PG8_BAR;
            PG8_LDB(B0, 1, 0); PG8_SCHED; PG8_LDA(At, 1, 0); PG8_STAGE(PG8_SA(0, 1), a2 + hstep, voffA);
            PG8_WAIT_L(8); PG8_BAR; PG8_WAIT_L(0); PG8_MMA(0, 0, At, B0); PG8_BAR; PG8_SCHED;
            PG8_LDB(B1, 1, 1); PG8_STAGE(PG8_SB(1, 0), b3, voffB);
            PG8_BAR; PG8_WAIT_L(0); PG8_MMA(0, 1, At, B1); PG8_BAR;
            PG8_LDA(At, 1, 1); PG8_STAGE(PG8_SA(1, 0), a3, voffA);
            PG8_BAR; PG8_WAIT_L(0); PG8_MMA(1, 0, At, B0); PG8_BAR; PG8_SCHED;
            PG8_STAGE(PG8_SB(1, 1), b3 + hstep, voffB);
            PG8_WAIT_V(6); PG8_BAR; PG8_MMA(1, 1, At, B1); PG8_BAR;
            }
        }
        if constexpr (ALIGN_EPI) { if (wr == 0) PG8_BAR; }
        if constexpr (!Epi::AFTER_DRAIN) { E(acc, cur, wr, wc, fr, fq); S.done(cur); }
        if (!has_next) break;
#pragma unroll
        for (int a = 0; a < 2; ++a)
#pragma unroll
            for (int b = 0; b < 2; ++b)
#pragma unroll
                for (int m = 0; m < 4; ++m)
#pragma unroll
                    for (int n = 0; n < 2; ++n) acc[a][b][m][n] = (f32x4){0.f, 0.f, 0.f, 0.f};
        cur = nxt; cA = nA; cB = nB; ++ui;
        if constexpr (ALIGN_EPI) { if (wr == 1) PG8_BAR; }
    }
    PG8_WAIT_V(0);
    if constexpr (!ALIGN_EPI) { if (wr == 0) PG8_BAR; }
    PG8_BAR;
    if constexpr (Epi::AFTER_DRAIN) { E.fused(acc, cur, wr, wc, fr, fq, lds, wid, lane); S.done(cur); }
#undef PG8_SA
#undef PG8_SB
#undef PG8_STAGE
#undef PG8_LDA
#undef PG8_LDB
#undef PG8_MMA
#undef PG8_WAIT_V
#undef PG8_WAIT_L
#undef PG8_BAR
#undef PG8_SCHED
}
}

using pg8::Unit;
struct DenseSched { int nN, n, G, c;
    __device__ __forceinline__ void a_ready(const Unit&) const {}
    __device__ __forceinline__ void done(const Unit&) const {}
    __device__ __forceinline__ bool next(int i, Unit& u) const { const int L = i * G + c; if (L >= n) return false; u.pm = L / nN; u.pn = L % nN; return true; } };

__device__ __forceinline__ void store8bf(bf16* p, f32x4 lo, f32x4 hi) { u32x4 w; w.x = pk2(lo[0], lo[1]); w.y = pk2(lo[2], lo[3]); w.z = pk2(hi[0], hi[1]); w.w = pk2(hi[2], hi[3]); *(u32x4*)p = w; }
__device__ __forceinline__ void load8bf(const bf16* p, f32x4& lo, f32x4& hi) { const u32x4 w = *(const u32x4*)p;
    lo[0] = __uint_as_float(w.x << 16); lo[1] = __uint_as_float(w.x & 0xffff0000u); lo[2] = __uint_as_float(w.y << 16); lo[3] = __uint_as_float(w.y & 0xffff0000u);
    hi[0] = __uint_as_float(w.z << 16); hi[1] = __uint_as_float(w.z & 0xffff0000u); hi[2] = __uint_as_float(w.w << 16); hi[3] = __uint_as_float(w.w & 0xffff0000u); }
struct EpiZ { bf16 *ZR, *ZS, *ZG;
    __device__ __forceinline__ void one(int row, int col, f32x4 lo, f32x4 hi) const {
        if (col < RC) store8bf(ZR + (size_t)row * RC + col, lo, hi);
        else if (col < RC + 1024) { for (int e = 0; e < 4; ++e) { lo[e] = gelu_tanh(lo[e]); hi[e] = gelu_tanh(hi[e]); } store8bf(ZS + (size_t)row * 1024 + (col - RC), lo, hi); }
        else { for (int e = 0; e < 4; ++e) { lo[e] = sigmoidf_(lo[e]); hi[e] = sigmoidf_(hi[e]); } store8bf(ZG + (size_t)row * 2048 + (col - RC - 1024), lo, hi); } }
    __device__ __forceinline__ void operator()(int row, int col, f32x4 a0, f32x4 a1, f32x4 b0, f32x4 b1) const { one(row, col, a0, a1); one(row, col + 128, b0, b1); } };
struct EpiGA { const bf16* ZG; bf16* MP;
    __device__ __forceinline__ void one(int row, int col, f32x4 lo, f32x4 hi) const { f32x4 g0, g1; load8bf(ZG + (size_t)row * 2048 + col, g0, g1); store8bf(MP + (size_t)row * D + col, g0 * lo, g1 * hi); }
    __device__ __forceinline__ void operator()(int row, int col, f32x4 a0, f32x4 a1, f32x4 b0, f32x4 b1) const { one(row, col, a0, a1); one(row, col + 128, b0, b1); } };
struct EpiGB { const bf16* ZG; const bf16* MPin; bf16* MP;
    __device__ __forceinline__ void one(int row, int col, f32x4 lo, f32x4 hi) const { f32x4 g0, g1, m0, m1; load8bf(ZG + (size_t)row * 2048 + 1024 + col, g0, g1); load8bf(MPin + (size_t)row * D + col, m0, m1);
        store8bf(MP + (size_t)row * D + col, m0 + g0 * lo, m1 + g1 * hi); }
    __device__ __forceinline__ void operator()(int row, int col, f32x4 a0, f32x4 a1, f32x4 b0, f32x4 b1) const { one(row, col, a0, a1); one(row, col + 128, b0, b1); } };
struct EpiOut { const float* xin; float* out; const float* gate1;
    __device__ __forceinline__ void one(int row, int col, f32x4 v) const { const f32x4 x = *(const f32x4*)(xin + (size_t)row * D + col); const f32x4 g = *(const f32x4*)(gate1 + col);
        *(f32x4*)(out + (size_t)row * D + col) = ALPHA * x + (1.0f + g) * v; }
    __device__ __forceinline__ void operator()(int row, int col, f32x4 a0, f32x4 a1, f32x4 b0, f32x4 b1) const { one(row, col, a0); one(row, col + 4, a1); one(row, col + 128, b0); one(row, col + 132, b1); } };
struct EpiSwi { bf16* HID;
    __device__ __forceinline__ void operator()(int row, int col, f32x4 a0, f32x4 a1, f32x4 b0, f32x4 b1) const { const int ct = (col >> 8) & 3, cc = col & 127;
        f32x4 h0, h1; for (int e = 0; e < 4; ++e) { h0[e] = siluf_(a0[e]) * b0[e]; h1[e] = siluf_(a1[e]) * b1[e]; } store8bf(HID + (size_t)row * FF + ct * 128 + cc, h0, h1); } };
struct EpiDown { const int* S2T; const float* TOKW; bf16* Y;
    __device__ __forceinline__ void operator()(int row, int col, f32x4 a0, f32x4 a1, f32x4 b0, f32x4 b1) const { const int st = S2T[row]; if (st < 0) return; const float w = TOKW[st]; const int cc = col & 1023;
        store8bf(Y + (size_t)st * D + cc, w * a0, w * a1); store8bf(Y + (size_t)st * D + cc + 128, w * b0, w * b1); } };

struct MoeSched { int ts[17]; int G, c;
    __device__ __forceinline__ void a_ready(const Unit&) const {}
    __device__ __forceinline__ void done(const Unit&) const {}
    __device__ __forceinline__ void init(const unsigned* cnt, int G_, int c_) { G = G_; c = c_; int s = 0;
#pragma unroll
        for (int e = 0; e < 16; ++e) { ts[e] = s; s += ((int)cnt[e] + 255) >> 8; } ts[16] = s; }
    __device__ __forceinline__ bool next(int i, Unit& u) const { const int L = i * G + c; if (L >= 4 * ts[16]) return false; const int rt = L >> 2, ct = L & 3; int e = 0;
#pragma unroll
        for (int j = 1; j < 16; ++j) e += (rt >= ts[j]) ? 1 : 0;
        u.pm = rt; u.pn = e * 4 + ct; return true; } };

__device__ __forceinline__ void phase_prep_simple(ArgsR a, const Ctx& c, int l) {
    const bf16* ZR = (const bf16*)(a.ws + WS_ZR);
    const float* mu = a.in[I_MU] + l * RC; const float* w0 = a.in[I_W0] + l * W; const float* w2 = a.in[I_W2] + (size_t)l * 64 * W;
    const float* a0 = a.in[I_A0] + l * W; const float* a2 = a.in[I_A2] + (size_t)l * 64 * W; const float* g2 = a.in[I_G2] + (size_t)l * 128 * W;
    const float* k_k = a.in[I_KK] + l * W; const float* k_a = a.in[I_KA] + l * W;
    const float* vm0 = a.in[I_VM0]; const float* vm1 = a.in[I_VM1]; const float* vm2 = a.in[I_VM2];
    f16* R = (f16*)(a.ws + WS_R); f16* WM1 = (f16*)(a.ws + WS_WM1); f16* KP = (f16*)(a.ws + WS_KP); f16* AA = (f16*)(a.ws + WS_AA); f16* BB = (f16*)(a.ws + WS_BB); f16* V = (f16*)(a.ws + WS_V);
    bf16* G = (bf16*)(a.ws + WS_G); bf16* VF = (bf16*)(a.ws + WS_VF);
    const int lane = c.lane;
    for (int t = c.gw; t < T; t += c.ngw) {
        float z[28];
#pragma unroll
        for (int i = 0; i < 28; ++i) { const int col = lane + 64 * i; const float zc = bf2f(ZR[(size_t)t * RC + col]); const float zp = t > 0 ? bf2f(ZR[(size_t)(t - 1) * RC + col]) : 0.f; z[i] = zc + (zp - zc) * mu[col]; }
        const float tw = tanhf(z[24]), za = z[25], sg0 = sigmoidf_(z[26]), sg1 = sigmoidf_(z[27]);
        float wlo[8], alo[8], gg[8];
#pragma unroll
        for (int i = 0; i < 8; ++i) { wlo[i] = 0.f; alo[i] = 0.f; gg[i] = 0.f; }
        for (int j = 0; j < 64; ++j) { const float tj = __shfl(tw, j), aj = __shfl(za, j), s0 = __shfl(sg0, j), s1 = __shfl(sg1, j);
#pragma unroll
            for (int i = 0; i < 8; ++i) { const int n = lane + 64 * i; wlo[i] += tj * w2[j * W + n]; alo[i] += aj * a2[j * W + n]; gg[i] += s0 * g2[j * W + n] + s1 * g2[(64 + j) * W + n]; } }
        float vv[8];
#pragma unroll
        for (int i = 0; i < 8; ++i) vv[i] = z[16 + i];
        if (l == 0) {
#pragma unroll
            for (int i = 0; i < 8; ++i) VF[(size_t)t * W + lane + 64 * i] = f2bf(vv[i]);
        } else {
            float vmid = 0.f;
#pragma unroll
            for (int i = 0; i < 8; ++i)
                for (int j = 0; j < 64; ++j) { const float vc = __shfl(vv[i], j); vmid += vc * vm1[(size_t)(64 * i + j) * 32 + (lane & 31)]; }
            float vg[8];
#pragma unroll
            for (int i = 0; i < 8; ++i) vg[i] = 0.f;
            for (int m = 0; m < 32; ++m) { const float vmm = __shfl(vmid, m);
#pragma unroll
                for (int i = 0; i < 8; ++i) vg[i] += vmm * vm2[m * W + lane + 64 * i]; }
#pragma unroll
            for (int i = 0; i < 8; ++i) { const int n = lane + 64 * i; const float vf = bf2f(VF[(size_t)t * W + n]); vv[i] = vv[i] + (vf - vv[i]) * sigmoidf_(vm0[n] + vg[i]); }
        }
#pragma unroll
        for (int i = 0; i < 8; ++i) {
            const int n = lane + 64 * i; const size_t o = (size_t)t * W + n;
            const float x = w0[n] + wlo[i]; const float wl = -softplusf_(-x) - 0.5f; const float dm1 = expm1f(-__expf(wl));
            const float av = sigmoidf_(a0[n] + alo[i]);
            const float kraw = z[8 + i];
            float kk = kraw * k_k[n]; const float nrm = sqrtf(wave_sum(kk * kk)); kk = kk / fmaxf(nrm, 1e-12f);
            const float kp = kraw * (1.0f + (av - 1.0f) * k_a[n]);
            R[o] = (f16)z[i]; WM1[o] = (f16)dm1; KP[o] = (f16)kp; AA[o] = (f16)(-kk); BB[o] = (f16)(kk * av); V[o] = (f16)vv[i]; G[o] = f2bf(gg[i]);
        }
    }
}

__device__ __forceinline__ void phase_sg_simple(ArgsR a, const Ctx& c, int l) {
    const bf16* ZS = (const bf16*)(a.ws + WS_ZS); bf16* YB = (bf16*)(a.ws + WS_YB);
    const float* lng = a.in[I_SGG] + l * W; const float* lnb = a.in[I_SGB] + l * W;
    float* vn = (float*)c.lds;
    float* st = vn + 128 * 64;
    for (int uidx = blockIdx.x; uidx < 128 * 8; uidx += gridDim.x) {
        const int ch = uidx >> 3, g = uidx & 7; const int tok0 = ch * 128;
        for (int i = 0; i < 16; ++i) { const int s = c.wave * 16 + i; const bf16* p = ZS + (size_t)(tok0 + s) * 1024 + 512 + c.lane * 8;
            const f32x4 x0 = load4bf(p), x1 = load4bf(p + 4);
            float sm = (x0[0] + x0[1]) + (x0[2] + x0[3]) + (x1[0] + x1[1]) + (x1[2] + x1[3]); const float mean = wave_sum(sm) * (1.f / 512.f);
            float q = 0.f; for (int e = 0; e < 4; ++e) { const float d0 = x0[e] - mean, d1 = x1[e] - mean; q += d0 * d0 + d1 * d1; }
            const float rstd = __builtin_amdgcn_rsqf(wave_sum(q) * (1.f / 512.f) + LN_EPS);
            if (c.lane == 0) { st[2 * s] = mean; st[2 * s + 1] = rstd; } }
        __syncthreads();
        for (int i = c.tid; i < 128 * 64; i += NTHREADS) { const int s = i >> 6, d = i & 63; const float x = bf2f(ZS[(size_t)(tok0 + s) * 1024 + 512 + g * 64 + d]);
            vn[i] = (x - st[2 * s]) * st[2 * s + 1] * lng[g * 64 + d] + lnb[g * 64 + d]; }
        __syncthreads();
        const int d = c.tid & 63, tq = c.tid >> 6;
        const float* Wg = a.in[I_WS] + (size_t)(l * 8 + g) * 128 * 128; const float* bs = a.in[I_BS] + (size_t)(l * 8 + g) * 128;
        for (int i = 0; i < 16; ++i) { const int t = tq + 8 * i; float acc = 0.f;
            for (int s = 0; s <= t; ++s) acc += Wg[t * 128 + s] * vn[s * 64 + d];
            const float u = bf2f(ZS[(size_t)(tok0 + t) * 1024 + g * 64 + d]);
            YB[(size_t)(tok0 + t) * W + g * 64 + d] = f2bf(u * (acc + bs[t])); }
        __syncthreads();
    }
}

#define LAS3 __attribute__((address_space(3)))
typedef short bf16x8 __attribute__((ext_vector_type(8)));
template <int MT, int NT, int KS>
__device__ __forceinline__ void mma_lds_glob(const unsigned char* lds_base, int a_off_bytes, int lda, const bf16* Bt, int ldb, int n0, int lane, f32x4 (&acc)[MT][NT]) {
    const int fr = lane & 15, fq = lane >> 4;
    const LAS3 unsigned char* Ab = (const LAS3 unsigned char*)lds_base + a_off_bytes;
    int boff = (n0 + fr) * ldb + 8 * fq; asm volatile("" : "+v"(boff));
#pragma unroll
    for (int ks = 0; ks < KS; ++ks) {
        bf16x8 b[NT];
#pragma unroll
        for (int n = 0; n < NT; ++n) b[n] = *(const bf16x8*)(Bt + boff + 16 * n * ldb + 32 * ks);
#pragma unroll
        for (int m = 0; m < MT; ++m) { const bf16x8 av = *(const LAS3 bf16x8*)(Ab + ((16 * m + fr) * lda + 32 * ks + 8 * fq) * 2);
#pragma unroll
            for (int n = 0; n < NT; ++n) acc[m][n] = __builtin_amdgcn_mfma_f32_16x16x32_bf16(av, b[n], acc[m][n], 0, 0, 0); }
    }
}
__device__ __forceinline__ void zshift8(const bf16* ZR, int t, int col, const float* mu, float (&o)[8]) {
    const u32x4 zc = *(const u32x4*)(ZR + (size_t)t * RC + col);
    u32x4 zp = {0u, 0u, 0u, 0u}; if (t > 0) zp = *(const u32x4*)(ZR + (size_t)(t - 1) * RC + col);
    const f32x4 m0 = *(const f32x4*)(mu + col), m1 = *(const f32x4*)(mu + col + 4);
#pragma unroll
    for (int e = 0; e < 4; ++e) { const float c0 = __uint_as_float(zc[e] << 16), c1 = __uint_as_float(zc[e] & 0xffff0000u), p0 = __uint_as_float(zp[e] << 16), p1 = __uint_as_float(zp[e] & 0xffff0000u);
        const float mu0 = (2 * e < 4) ? m0[(2 * e) & 3] : m1[(2 * e) & 3], mu1 = (2 * e + 1 < 4) ? m0[(2 * e + 1) & 3] : m1[(2 * e + 1) & 3];
        o[2 * e] = c0 + (p0 - c0) * mu0; o[2 * e + 1] = c1 + (p1 - c1) * mu1; }
}
typedef _Float16 f16x8 __attribute__((ext_vector_type(8)));
__device__ __forceinline__ void store8f16(f16* p, const float (&v)[8]) { f16x8 h;
#pragma unroll
    for (int e = 0; e < 8; ++e) h[e] = (f16)v[e];
    *(f16x8*)p = h; }
__device__ __forceinline__ u32x4 pack8bf(const float (&v)[8]) { u32x4 w; w.x = pk2(v[0], v[1]); w.y = pk2(v[2], v[3]); w.z = pk2(v[4], v[5]); w.w = pk2(v[6], v[7]); return w; }


constexpr int PB_LD = 520;
constexpr int PB_BUF = 0, PB_AOP = 64 * PB_LD * 2, PB_VMID = 2 * 64 * PB_LD * 2, PB_LA_LD = 264, PB_VM_LD = 40;
__device__ __forceinline__ void phase_prep_fast(ArgsR a, const Ctx& c, int l) {
    const bf16* ZR = (const bf16*)(a.ws + WS_ZR);
    const float* mu = a.in[I_MU] + l * RC; const float* w0 = a.in[I_W0] + l * W; const float* a0 = a.in[I_A0] + l * W;
    const float* k_k = a.in[I_KK] + l * W; const float* k_a = a.in[I_KA] + l * W; const float* vm0 = a.in[I_VM0];
    f16* R = (f16*)(a.ws + WS_R); f16* WM1 = (f16*)(a.ws + WS_WM1); f16* KP = (f16*)(a.ws + WS_KP); f16* AA = (f16*)(a.ws + WS_AA); f16* BB = (f16*)(a.ws + WS_BB); f16* V = (f16*)(a.ws + WS_V);
    bf16* G = (bf16*)(a.ws + WS_G); bf16* VF = (bf16*)(a.ws + WS_VF);
    const unsigned char* lo = a.ws + WS_LORA + (size_t)l * LO_STRIDE;
    const bf16* W2T = (const bf16*)(lo + LO_W2T); const bf16* A2T = (const bf16*)(lo + LO_A2T); const bf16* G2T = (const bf16*)(lo + LO_G2T);
    const bf16* VM1T = (const bf16*)(lo + LO_VM1T); const bf16* VM2T = (const bf16*)(lo + LO_VM2T);
    LAS3 unsigned char* L = (LAS3 unsigned char*)c.lds;
    const int tid = c.tid, lane = c.lane, wv = c.wave, fr = lane & 15, fq = lane >> 4;
    const int row = tid >> 3, sub_ = tid & 7;
    for (int u = blockIdx.x; u < T / 64; u += gridDim.x) {
        int sub = sub_; asm volatile("" : "+v"(sub));
        const int t0 = u * 64, t = t0 + row;
        if (l == 0) {
#pragma unroll 4
            for (int p = 0; p < 8; ++p) { const int col = p * 64 + sub * 8; float z[8]; zshift8(ZR, t, 1024 + col, mu, z);
                store8f16(V + (size_t)t * W + col, z); *(u32x4*)(VF + (size_t)t * W + col) = pack8bf(z); }
        } else {
#pragma unroll 4
            for (int p = 0; p < 8; ++p) { const int col = p * 64 + sub * 8; float z[8]; zshift8(ZR, t, 1024 + col, mu, z);
                *(LAS3 u32x4*)(L + PB_AOP + (row * PB_LD + col) * 2) = pack8bf(z); }
            __syncthreads();
            { f32x4 acc[1][1]; acc[0][0] = (f32x4){0.f, 0.f, 0.f, 0.f}; const int m = wv >> 1, n = wv & 1;
              mma_lds_glob<1, 1, 16>(c.lds, PB_AOP + 16 * m * PB_LD * 2, PB_LD, VM1T, W, 16 * n, lane, acc);
#pragma unroll
              for (int i = 0; i < 4; ++i) *(LAS3 bf16*)(L + PB_VMID + ((16 * m + 4 * fq + i) * PB_VM_LD + 16 * n + fr) * 2) = f2bf(acc[0][0][i]); }
            __syncthreads();
            { f32x4 acc[4][4];
#pragma unroll
              for (int m = 0; m < 4; ++m)
#pragma unroll
                  for (int n = 0; n < 4; ++n) acc[m][n] = (f32x4){0.f, 0.f, 0.f, 0.f};
              mma_lds_glob<4, 4, 1>(c.lds, PB_VMID, PB_VM_LD, VM2T, 32, 64 * wv, lane, acc);
#pragma unroll
              for (int m = 0; m < 4; ++m)
#pragma unroll
                  for (int n = 0; n < 4; ++n) { const int col = 64 * wv + 16 * n + fr; const float vb = vm0[col];
#pragma unroll
                      for (int i = 0; i < 4; ++i) *(LAS3 f16*)(L + PB_BUF + ((16 * m + 4 * fq + i) * PB_LD + col) * 2) = (f16)sigmoidf_(vb + acc[m][n][i]); } }
            __syncthreads();
#pragma unroll 4
            for (int p = 0; p < 8; ++p) { const int col = p * 64 + sub * 8;
                const u32x4 vz = *(const LAS3 u32x4*)(L + PB_AOP + (row * PB_LD + col) * 2); const f16x8 gt = *(const LAS3 f16x8*)(L + PB_BUF + (row * PB_LD + col) * 2);
                const u32x4 vfw = *(const u32x4*)(VF + (size_t)t * W + col); float o[8];
#pragma unroll
                for (int e = 0; e < 4; ++e) { const float v0 = __uint_as_float(vz[e] << 16), v1 = __uint_as_float(vz[e] & 0xffff0000u), f0 = __uint_as_float(vfw[e] << 16), f1 = __uint_as_float(vfw[e] & 0xffff0000u);
                    o[2 * e] = v0 + (f0 - v0) * (float)gt[2 * e]; o[2 * e + 1] = v1 + (f1 - v1) * (float)gt[2 * e + 1]; }
                store8f16(V + (size_t)t * W + col, o); }
            __syncthreads();
        }
#pragma unroll 4
        for (int p = 0; p < 4; ++p) { const int cc = sub * 32 + p * 8; float z[8]; zshift8(ZR, t, 1536 + cc, mu, z);
#pragma unroll
            for (int e = 0; e < 8; ++e) z[e] = cc < 64 ? (1.0f - 2.0f * __builtin_amdgcn_rcpf(1.0f + __expf(2.0f * z[e]))) : (cc < 128 ? z[e] : sigmoidf_(z[e]));
            *(LAS3 u32x4*)(L + PB_AOP + (row * PB_LA_LD + cc) * 2) = pack8bf(z); }
        __syncthreads();
        { f32x4 acc[4][4];
#pragma unroll
          for (int m = 0; m < 4; ++m)
#pragma unroll
              for (int n = 0; n < 4; ++n) acc[m][n] = (f32x4){0.f, 0.f, 0.f, 0.f};
          mma_lds_glob<4, 4, 2>(c.lds, PB_AOP + 64 * 2, PB_LA_LD, A2T, 64, 64 * wv, lane, acc);
#pragma unroll
          for (int m = 0; m < 4; ++m)
#pragma unroll
              for (int n = 0; n < 4; ++n) { const int col = 64 * wv + 16 * n + fr; const float ab = a0[col];
#pragma unroll
                  for (int i = 0; i < 4; ++i) *(LAS3 f16*)(L + PB_BUF + ((16 * m + 4 * fq + i) * PB_LD + col) * 2) = (f16)sigmoidf_(ab + acc[m][n][i]); } }
        __syncthreads();
#pragma unroll 4
        for (int p = 0; p < 8; ++p) { const int col = p * 64 + sub * 8; const size_t o = (size_t)t * W + col;
            float z[8]; zshift8(ZR, t, col, mu, z); store8f16(R + o, z);
            float kz[8]; zshift8(ZR, t, 512 + col, mu, kz);
            const f16x8 av = *(const LAS3 f16x8*)(L + PB_BUF + (row * PB_LD + col) * 2);
            const f32x4 kk0 = *(const f32x4*)(k_k + col), kk1 = *(const f32x4*)(k_k + col + 4), ka0 = *(const f32x4*)(k_a + col), ka1 = *(const f32x4*)(k_a + col + 4);
            float kk[8], kp[8], bb[8]; float ss = 0.f;
#pragma unroll
            for (int e = 0; e < 8; ++e) { const float kkw = e < 4 ? kk0[e & 3] : kk1[e & 3], kaw = e < 4 ? ka0[e & 3] : ka1[e & 3]; kk[e] = kz[e] * kkw; ss += kk[e] * kk[e]; kp[e] = kz[e] * (1.0f + ((float)av[e] - 1.0f) * kaw); }
            ss += __shfl_xor(ss, 1); ss += __shfl_xor(ss, 2); ss += __shfl_xor(ss, 4);
            const float inv = fminf(__builtin_amdgcn_rsqf(ss), 1e12f);
#pragma unroll
            for (int e = 0; e < 8; ++e) { kk[e] *= inv; bb[e] = kk[e] * (float)av[e]; kk[e] = -kk[e]; }
            store8f16(KP + o, kp); store8f16(AA + o, kk); store8f16(BB + o, bb); }
        __syncthreads();
        { f32x4 acc[4][4];
#pragma unroll
          for (int m = 0; m < 4; ++m)
#pragma unroll
              for (int n = 0; n < 4; ++n) acc[m][n] = (f32x4){0.f, 0.f, 0.f, 0.f};
          mma_lds_glob<4, 4, 2>(c.lds, PB_AOP, PB_LA_LD, W2T, 64, 64 * wv, lane, acc);
#pragma unroll
          for (int m = 0; m < 4; ++m)
#pragma unroll
              for (int n = 0; n < 4; ++n) { const int col = 64 * wv + 16 * n + fr; const float wb = w0[col];
#pragma unroll
                  for (int i = 0; i < 4; ++i) { const float x = wb + acc[m][n][i]; const float wl = -(fmaxf(-x, 0.f) + __logf(1.0f + __expf(-fabsf(x)))) - 0.5f;
                      *(LAS3 f16*)(L + PB_BUF + ((16 * m + 4 * fq + i) * PB_LD + col) * 2) = (f16)(__expf(-__expf(wl)) - 1.0f); } } }
        __syncthreads();
#pragma unroll 4
        for (int p = 0; p < 8; ++p) { const int col = p * 64 + sub * 8; *(u32x4*)(WM1 + (size_t)t * W + col) = *(const LAS3 u32x4*)(L + PB_BUF + (row * PB_LD + col) * 2); }
        __syncthreads();
        { f32x4 acc[4][4];
#pragma unroll
          for (int m = 0; m < 4; ++m)
#pragma unroll
              for (int n = 0; n < 4; ++n) acc[m][n] = (f32x4){0.f, 0.f, 0.f, 0.f};
          mma_lds_glob<4, 4, 4>(c.lds, PB_AOP + 128 * 2, PB_LA_LD, G2T, 128, 64 * wv, lane, acc);
#pragma unroll
          for (int m = 0; m < 4; ++m)
#pragma unroll
              for (int n = 0; n < 4; ++n) { const int col = 64 * wv + 16 * n + fr;
#pragma unroll
                  for (int i = 0; i < 4; ++i) *(LAS3 bf16*)(L + PB_BUF + ((16 * m + 4 * fq + i) * PB_LD + col) * 2) = f2bf(acc[m][n][i]); } }
        __syncthreads();
#pragma unroll 4
        for (int p = 0; p < 8; ++p) { const int col = p * 64 + sub * 8; *(u32x4*)(G + (size_t)t * W + col) = *(const LAS3 u32x4*)(L + PB_BUF + (row * PB_LD + col) * 2); }
        __syncthreads();
    }
}

constexpr int SG_LD = 136;
constexpr int SG_VT = 0, SG_ST = 256 * SG_LD * 2;
__device__ __forceinline__ void phase_sg_fast(ArgsR a, const Ctx& c, int l) {
    const bf16* ZS = (const bf16*)(a.ws + WS_ZS); bf16* YB = (bf16*)(a.ws + WS_YB);
    const float* lng = a.in[I_SGG] + l * W; const float* lnb = a.in[I_SGB] + l * W;
    LAS3 unsigned char* L = (LAS3 unsigned char*)c.lds;
    LAS3 float* st = (LAS3 float*)(L + SG_ST);
    const int tid = c.tid, lane = c.lane, wv = c.wave, fr = lane & 15, fq = lane >> 4;
    for (int u = blockIdx.x; u < 256; u += gridDim.x) {
        const int ch = u >> 1, hf = u & 1, tok0 = ch * 128;
        for (int i = 0; i < 16; ++i) { const int sidx = wv * 16 + i; const bf16* p = ZS + (size_t)(tok0 + sidx) * 1024 + 512 + lane * 8;
            const f32x4 x0 = load4bf(p), x1 = load4bf(p + 4);
            const float sm = (x0[0] + x0[1]) + (x0[2] + x0[3]) + (x1[0] + x1[1]) + (x1[2] + x1[3]); const float mean = wave_sum(sm) * (1.f / 512.f);
            float q = 0.f;
#pragma unroll
            for (int e = 0; e < 4; ++e) { const float d0 = x0[e] - mean, d1 = x1[e] - mean; q += d0 * d0 + d1 * d1; }
            const float rstd = __builtin_amdgcn_rsqf(wave_sum(q) * (1.f / 512.f) + LN_EPS);
            if (lane == 0) { st[2 * sidx] = mean; st[2 * sidx + 1] = rstd; } }
        __syncthreads();
        { const int sidx = tid >> 2, q4 = tid & 3; const float mean = st[2 * sidx], rstd = st[2 * sidx + 1];
#pragma unroll
          for (int p = 0; p < 8; ++p) { const int cl = q4 * 64 + p * 8; const int cg = hf * 256 + cl;
              const bf16* src = ZS + (size_t)(tok0 + sidx) * 1024 + 512 + cg; const f32x4 x0 = load4bf(src), x1 = load4bf(src + 4);
              const f32x4 g0 = *(const f32x4*)(lng + cg), g1 = *(const f32x4*)(lng + cg + 4), b0 = *(const f32x4*)(lnb + cg), b1 = *(const f32x4*)(lnb + cg + 4);
#pragma unroll
              for (int e = 0; e < 8; ++e) { const float x = e < 4 ? x0[e & 3] : x1[e & 3], gg = e < 4 ? g0[e & 3] : g1[e & 3], bb = e < 4 ? b0[e & 3] : b1[e & 3];
                  *(LAS3 bf16*)(L + SG_VT + ((cl + e) * SG_LD + sidx) * 2) = f2bf((x - mean) * rstd * gg + bb); } } }
        __syncthreads();
        const int gl = wv >> 1, dh = wv & 1, g = hf * 4 + gl;
        const float* Wg = a.in[I_WS] + (size_t)(l * 8 + g) * 128 * 128; const float* bs = a.in[I_BS] + (size_t)(l * 8 + g) * 128;
        f32x4 acc[8][2];
#pragma unroll
        for (int m = 0; m < 8; ++m) { acc[m][0] = (f32x4){0.f, 0.f, 0.f, 0.f}; acc[m][1] = (f32x4){0.f, 0.f, 0.f, 0.f}; }
#pragma unroll
        for (int ks = 0; ks < 4; ++ks) {
            bf16x8 b[2];
#pragma unroll
            for (int n = 0; n < 2; ++n) b[n] = *(const LAS3 bf16x8*)(L + SG_VT + ((gl * 64 + dh * 32 + 16 * n + fr) * SG_LD + 32 * ks + 8 * fq) * 2);
#pragma unroll
            for (int m = 0; m < 8; ++m) { if (32 * ks <= 16 * m + 15) {
                const int trow = 16 * m + fr, s0 = 32 * ks + 8 * fq;
                const f32x4 w0v = *(const f32x4*)(Wg + trow * 128 + s0), w1v = *(const f32x4*)(Wg + trow * 128 + s0 + 4);
                float wf[8];
#pragma unroll
                for (int e = 0; e < 8; ++e) { const float wval = e < 4 ? w0v[e & 3] : w1v[e & 3]; wf[e] = (s0 + e <= trow) ? wval : 0.f; }
                const u32x4 wp = pack8bf(wf); const bf16x8 av = __builtin_bit_cast(bf16x8, wp);
                acc[m][0] = __builtin_amdgcn_mfma_f32_16x16x32_bf16(av, b[0], acc[m][0], 0, 0, 0);
                acc[m][1] = __builtin_amdgcn_mfma_f32_16x16x32_bf16(av, b[1], acc[m][1], 0, 0, 0); } }
        }
#pragma unroll
        for (int m = 0; m < 8; ++m)
#pragma unroll
            for (int i = 0; i < 4; ++i) { const int trow = 16 * m + 4 * fq + i; const float bsv = bs[trow];
#pragma unroll
                for (int n = 0; n < 2; ++n) { const int col = g * 64 + dh * 32 + 16 * n + fr; const float uu = bf2f(ZS[(size_t)(tok0 + trow) * 1024 + col]);
                    YB[(size_t)(tok0 + trow) * W + col] = f2bf(uu * (acc[m][n][i] + bsv)); } }
        __syncthreads();
    }
}

__device__ __forceinline__ void phase_scan_simple(ArgsR a, const Ctx& c) {
    if (c.wave != 0 || blockIdx.x >= NH) return;
    const int h = blockIdx.x, lane = c.lane;
    const f16* R = (const f16*)(a.ws + WS_R); const f16* WM1 = (const f16*)(a.ws + WS_WM1); const f16* KP = (const f16*)(a.ws + WS_KP);
    const f16* AA = (const f16*)(a.ws + WS_AA); const f16* BB = (const f16*)(a.ws + WS_BB); const f16* V = (const f16*)(a.ws + WS_V);
    bf16* YSC = (bf16*)(a.ws + WS_YSC);
    float S[64];
#pragma unroll
    for (int j = 0; j < 64; ++j) S[j] = 0.f;
    for (int t = 0; t < T; ++t) {
        const size_t base = (size_t)t * W + h * 64;
        const float vv = (float)V[base + lane];
        float sa = 0.f;
#pragma unroll
        for (int j = 0; j < 64; ++j) sa += S[j] * (float)AA[base + j];
        float y = 0.f;
#pragma unroll
        for (int j = 0; j < 64; ++j) { float s = S[j]; s = s + s * (float)WM1[base + j]; s += sa * (float)BB[base + j]; s += vv * (float)KP[base + j]; S[j] = s; y += s * (float)R[base + j]; }
        YSC[base + lane] = f2bf(y);
    }
}

typedef unsigned u32x16 __attribute__((ext_vector_type(16)));
__device__ __forceinline__ void sload32(const void* p0, u32x16& a0, u32x16& a1) {
    asm volatile("s_load_dwordx16 %0, %2, 0x0 glc\n\ts_load_dwordx16 %1, %2, 0x40 glc\n\ts_waitcnt lgkmcnt(0)" : "=&s"(a0), "=&s"(a1) : "s"(p0) : "memory");
}
__device__ __forceinline__ void sload64(const void* p0, const void* p1, u32x16& a0, u32x16& a1, u32x16& b0, u32x16& b1) {
    asm volatile("s_load_dwordx16 %0, %4, 0x0 glc\n\ts_load_dwordx16 %1, %4, 0x40 glc\n\ts_load_dwordx16 %2, %5, 0x0 glc\n\ts_load_dwordx16 %3, %5, 0x40 glc\n\ts_waitcnt lgkmcnt(0)"
                 : "=&s"(a0), "=&s"(a1), "=&s"(b0), "=&s"(b1) : "s"(p0), "s"(p1) : "memory");
}
__device__ __forceinline__ float fmix_lo(unsigned sd, float x, float y) { float d; asm("v_fma_mix_f32 %0, %1, %2, %3 op_sel_hi:[1,0,0]" : "=v"(d) : "s"(sd), "v"(x), "v"(y)); return d; }
__device__ __forceinline__ float fmix_hi(unsigned sd, float x, float y) { float d; asm("v_fma_mix_f32 %0, %1, %2, %3 op_sel:[1,0,0] op_sel_hi:[1,0,0]" : "=v"(d) : "s"(sd), "v"(x), "v"(y)); return d; }
constexpr int CL = 64, NCH = T / CL;
constexpr size_t ST_Q_OFF = (size_t)NH * NCH * 64 * 64;
constexpr size_t ST_S_OFF = (size_t)NH * NCH * 64 * 64;

__device__ __forceinline__ float vmix_lo(unsigned vd, float x, float y) { float d; asm("v_fma_mix_f32 %0, %1, %2, %3 op_sel_hi:[1,0,0]" : "=v"(d) : "v"(vd), "v"(x), "v"(y)); return d; }
__device__ __forceinline__ float vmix_hi(unsigned vd, float x, float y) { float d; asm("v_fma_mix_f32 %0, %1, %2, %3 op_sel:[1,0,0] op_sel_hi:[1,0,0]" : "=v"(d) : "v"(vd), "v"(x), "v"(y)); return d; }
template <int N> __device__ __forceinline__ void fmac_bc(float& acc, float vec, float x) { asm("v_fmac_f32_dpp %0, %1, %2 row_newbcast:%3 row_mask:0xf bank_mask:0xf" : "+v"(acc) : "v"(vec), "v"(x), "n"(N)); }
template <int N> __device__ __forceinline__ float mul_bc(float vec, float x) { float d; asm("v_mul_f32_dpp %0, %1, %2 row_newbcast:%3 row_mask:0xf bank_mask:0xf" : "=v"(d) : "v"(vec), "v"(x), "n"(N)); return d; }
typedef _Float16 f16x4 __attribute__((ext_vector_type(4)));
struct SVec { float v[4]; };
__device__ __forceinline__ f16x4 sv_read(const LAS3 unsigned char* p, int lane) { return *(const LAS3 f16x4*)(p + (lane & 15) * 8); }
__device__ __forceinline__ void sv_cvt(SVec& o, f16x4 h) { o.v[0] = (float)h[0]; o.v[1] = (float)h[1]; o.v[2] = (float)h[2]; o.v[3] = (float)h[3]; }
__device__ __forceinline__ void sv_cvt1p(SVec& o, f16x4 h) { o.v[0] = 1.0f + (float)h[0]; o.v[1] = 1.0f + (float)h[1]; o.v[2] = 1.0f + (float)h[2]; o.v[3] = 1.0f + (float)h[3]; }
template <int J> __device__ __forceinline__ void sc_dot(float (&d)[4], const SVec& A, const float (&X)[64]) { fmac_bc<(J >> 2)>(d[J & 3], A.v[J & 3], X[J]); if constexpr (J + 1 < 64) sc_dot<J + 1>(d, A, X); }
template <int J> __device__ __forceinline__ void sc_upd3(float (&S)[64], float (&y)[4], const SVec& Wv, const SVec& Bv, const SVec& Kv, const SVec& Rv, float sa, float vv) {
    float sj = mul_bc<(J >> 2)>(Wv.v[J & 3], S[J]); fmac_bc<(J >> 2)>(sj, Bv.v[J & 3], sa); fmac_bc<(J >> 2)>(sj, Kv.v[J & 3], vv); S[J] = sj; fmac_bc<(J >> 2)>(y[J & 3], Rv.v[J & 3], sj);
    if constexpr (J + 1 < 64) sc_upd3<J + 1>(S, y, Wv, Bv, Kv, Rv, sa, vv); }
template <int J> __device__ __forceinline__ void sc_upd1(float (&Q)[64], float (&P)[64], const SVec& Wv, const SVec& Bv, const SVec& Kv, float saq, float sap, float vv) {
    float qj = mul_bc<(J >> 2)>(Wv.v[J & 3], Q[J]); fmac_bc<(J >> 2)>(qj, Bv.v[J & 3], saq); fmac_bc<(J >> 2)>(qj, Kv.v[J & 3], vv); Q[J] = qj;
    float pj = mul_bc<(J >> 2)>(Wv.v[J & 3], P[J]); fmac_bc<(J >> 2)>(pj, Bv.v[J & 3], sap); P[J] = pj;
    if constexpr (J + 1 < 64) sc_upd1<J + 1>(Q, P, Wv, Bv, Kv, saq, sap, vv); }
constexpr int SCB = 8;
constexpr int SC_NS = 7, SC_BUF = SC_NS * 1024, SC_WAVE = 2 * SC_BUF;
__device__ __forceinline__ void sc_dma(const f16* X, size_t eoff, LAS3 unsigned char* dst) {
    __builtin_amdgcn_global_load_lds((const unsigned*)(X + eoff), (LAS3 unsigned*)dst, 16, 0, 0);
}

__device__ __forceinline__ void phase_scan1(ArgsR a, const Ctx& c) {
    const f16* WM1 = (const f16*)(a.ws + WS_WM1); const f16* KP = (const f16*)(a.ws + WS_KP);
    const f16* AA = (const f16*)(a.ws + WS_AA); const f16* BB = (const f16*)(a.ws + WS_BB); const f16* V = (const f16*)(a.ws + WS_V);
    float* ST = (float*)(a.ws + WS_ST);
    const int lane = c.lane;
    LAS3 unsigned char* ring = (LAS3 unsigned char*)c.lds + c.wave * SC_WAVE;
    for (int item = c.gw; item < NH * NCH; item += c.ngw) {
        const int h = __builtin_amdgcn_readfirstlane(item / NCH), ch = __builtin_amdgcn_readfirstlane(item % NCH);
        float Q[64], P[64];
        int ln_ = lane; asm volatile("" : "+v"(ln_));
#pragma unroll
        for (int j = 0; j < 64; ++j) { Q[j] = 0.f; P[j] = (j == ln_) ? 1.f : 0.f; }
        const size_t lane_off = (size_t)(lane >> 3) * W + h * 64 + (lane & 7) * 8;
        { const size_t e0 = (size_t)(ch * CL) * W + lane_off;
          sc_dma(AA, e0, ring); sc_dma(WM1, e0, ring + 1024); sc_dma(BB, e0, ring + 2048); sc_dma(KP, e0, ring + 3072); sc_dma(V, e0, ring + 4096); }
#pragma unroll 1
        for (int blk = 0; blk < CL / SCB; ++blk) {
            LAS3 unsigned char* buf = ring + (blk & 1) * SC_BUF;
            if (blk + 1 < CL / SCB) { LAS3 unsigned char* nb = ring + ((blk + 1) & 1) * SC_BUF; const size_t e0 = (size_t)(ch * CL + (blk + 1) * SCB) * W + lane_off;
                sc_dma(AA, e0, nb); sc_dma(WM1, e0, nb + 1024); sc_dma(BB, e0, nb + 2048); sc_dma(KP, e0, nb + 3072); sc_dma(V, e0, nb + 4096);
                asm volatile("s_waitcnt vmcnt(5)" ::: "memory"); }
            else asm volatile("s_waitcnt vmcnt(0)" ::: "memory");
            SVec A, Wv, Bv, Kv;
            sv_cvt(A, sv_read(buf, lane)); sv_cvt1p(Wv, sv_read(buf + 1024, lane)); sv_cvt(Bv, sv_read(buf + 2048, lane)); sv_cvt(Kv, sv_read(buf + 3072, lane));
            float vv = (float)*(const LAS3 f16*)(buf + 4096 + lane * 2);
#pragma unroll 1
            for (int st = 0; st < SCB; ++st) {
                const LAS3 unsigned char* sn = buf + ((st + 1 < SCB) ? st + 1 : st) * 128;
                const f16x4 ha = sv_read(sn, lane), hw = sv_read(sn + 1024, lane), hb = sv_read(sn + 2048, lane), hk = sv_read(sn + 3072, lane);
                const f16 hv = *(const LAS3 f16*)(sn + 4096 + lane * 2);
                float dq[4] = {0.f, 0.f, 0.f, 0.f}, dp[4] = {0.f, 0.f, 0.f, 0.f};
                sc_dot<0>(dq, A, Q); sc_dot<0>(dp, A, P);
                const float saq = (dq[0] + dq[1]) + (dq[2] + dq[3]), sap = (dp[0] + dp[1]) + (dp[2] + dp[3]);
                sc_upd1<0>(Q, P, Wv, Bv, Kv, saq, sap, vv);
                sv_cvt(A, ha); sv_cvt1p(Wv, hw); sv_cvt(Bv, hb); sv_cvt(Kv, hk); vv = (float)hv;
            }
        }
        float* Qp = ST + ST_Q_OFF + (size_t)(h * NCH + ch) * 4096 + lane;
        bf16* PTp = (bf16*)ST + (size_t)(h * NCH + ch) * 4096 + lane;
#pragma unroll
        for (int j = 0; j < 64; ++j) { PTp[j * 64] = f2bf(P[j]); Qp[j * 64] = Q[j]; }
    }
}
constexpr int GS = 16, NG = NCH / GS;
constexpr size_t ST_LP_OFF = (size_t)NH * NCH * 4096;
constexpr size_t WS_SG = WS_LORA + 2 * MiB;
constexpr int HI_LD = 72, HI_BYTES = 64 * HI_LD * 2;
struct HFrag { bf16x8 b[2][2]; f32x4 q[2]; };
__device__ __forceinline__ void hload(HFrag& f, const bf16* Bt, const float* QTc, int boff, int qtoff) {
#pragma unroll
    for (int ks = 0; ks < 2; ++ks)
#pragma unroll
        for (int n = 0; n < 2; ++n) f.b[ks][n] = *(const bf16x8*)(Bt + boff + 16 * n * 64 + 32 * ks);
#pragma unroll
    for (int n = 0; n < 2; ++n) f.q[n] = *(const f32x4*)(QTc + qtoff + 16 * n * 64);
}
__device__ __forceinline__ void hmma(const LAS3 unsigned char* img, const bf16x8 (&b)[2][2], f32x4 (&acc)[2], int m, int fr, int fq) {
#pragma unroll
    for (int ks = 0; ks < 2; ++ks) { const bf16x8 av = *(const LAS3 bf16x8*)(img + ((16 * m + fr) * HI_LD + 32 * ks + 8 * fq) * 2);
#pragma unroll
        for (int n = 0; n < 2; ++n) acc[n] = __builtin_amdgcn_mfma_f32_16x16x32_bf16(av, b[ks][n], acc[n], 0, 0, 0); }
}
__device__ __forceinline__ void himg_store(LAS3 unsigned char* img, const f32x4 (&acc)[2], int m, int n0, int fr, int fq) {
#pragma unroll
    for (int n = 0; n < 2; ++n)
#pragma unroll
        for (int i = 0; i < 4; ++i) *(LAS3 bf16*)(img + ((16 * m + 4 * fq + i) * HI_LD + n0 + 16 * n + fr) * 2) = f2bf(acc[n][i]);
}
#define HBAR() do { asm volatile("s_waitcnt lgkmcnt(0)" ::: "memory"); __builtin_amdgcn_s_barrier(); asm volatile("" ::: "memory"); } while (0)

__device__ __forceinline__ void sc2a_step(const HFrag& f, bf16* LpTc, float* QTc, const LAS3 unsigned char* ip, LAS3 unsigned char* ipn, const LAS3 unsigned char* iq, LAS3 unsigned char* iqn, int m, int n0, int fr, int fq, int qtoff) {
    f32x4 ap[2], aq[2];
#pragma unroll
    for (int n = 0; n < 2; ++n) { ap[n] = (f32x4){0.f, 0.f, 0.f, 0.f}; aq[n] = f.q[n]; }
    hmma(ip, f.b, ap, m, fr, fq); hmma(iq, f.b, aq, m, fr, fq);
#pragma unroll
    for (int n = 0; n < 2; ++n) { u32x2 w; w.x = pk2(ap[n][0], ap[n][1]); w.y = pk2(ap[n][2], ap[n][3]);
        *(u32x2*)(LpTc + (n0 + 16 * n + fr) * 64 + 16 * m + 4 * fq) = w;
        *(f32x4*)(QTc + qtoff + 16 * n * 64) = aq[n]; }
    himg_store(ipn, ap, m, n0, fr, fq); himg_store(iqn, aq, m, n0, fr, fq);
    HBAR();
}
__device__ __forceinline__ void phase_scan2a(ArgsR a, const Ctx& c) {
    const int lane = c.lane, wv = c.wave, fr = lane & 15, fq = lane >> 4, m = wv >> 1, n0 = 32 * (wv & 1);
    const int boff = (n0 + fr) * 64 + 8 * fq, qtoff = (n0 + fr) * 64 + 16 * m + 4 * fq;
    LAS3 unsigned char* L = (LAS3 unsigned char*)c.lds;
    for (int item = blockIdx.x; item < NH * NG; item += gridDim.x) {
        const size_t cb = (size_t)(item / NG) * NCH + (size_t)(item % NG) * GS;
        const bf16* PT = (const bf16*)(a.ws + WS_ST) + cb * 4096; bf16* LP = (bf16*)(a.ws + WS_ST) + ST_LP_OFF + cb * 4096; float* QT = (float*)(a.ws + WS_ST) + ST_Q_OFF + cb * 4096;
        for (int i = c.tid; i < 4 * HI_BYTES / 4; i += NTHREADS) ((LAS3 unsigned*)L)[i] = 0u;
        __syncthreads();
        if (c.tid < 64) *(LAS3 bf16*)(L + (c.tid * HI_LD + c.tid) * 2) = (bf16)0x3F80;
        __syncthreads();
        HFrag f0, f1, f2, f3;
        hload(f0, PT, QT, boff, qtoff); hload(f1, PT + 4096, QT + 4096, boff, qtoff); hload(f2, PT + 2 * 4096, QT + 2 * 4096, boff, qtoff); hload(f3, PT + 3 * 4096, QT + 3 * 4096, boff, qtoff);
        LAS3 unsigned char* p0 = L; LAS3 unsigned char* p1 = L + HI_BYTES; LAS3 unsigned char* q0 = L + 2 * HI_BYTES; LAS3 unsigned char* q1 = L + 3 * HI_BYTES;
#pragma unroll 1
        for (int i = 0; i < GS; i += 4) {
            const int nx = (i + 4 < GS) ? i + 4 : i;
            sc2a_step(f0, LP + (size_t)(i + 0) * 4096, QT + (size_t)(i + 0) * 4096, p0, p1, q0, q1, m, n0, fr, fq, qtoff); hload(f0, PT + (size_t)(nx + 0) * 4096, QT + (size_t)(nx + 0) * 4096, boff, qtoff);
            sc2a_step(f1, LP + (size_t)(i + 1) * 4096, QT + (size_t)(i + 1) * 4096, p1, p0, q1, q0, m, n0, fr, fq, qtoff); hload(f1, PT + (size_t)(nx + 1) * 4096, QT + (size_t)(nx + 1) * 4096, boff, qtoff);
            sc2a_step(f2, LP + (size_t)(i + 2) * 4096, QT + (size_t)(i + 2) * 4096, p0, p1, q0, q1, m, n0, fr, fq, qtoff); hload(f2, PT + (size_t)(nx + 2) * 4096, QT + (size_t)(nx + 2) * 4096, boff, qtoff);
            sc2a_step(f3, LP + (size_t)(i + 3) * 4096, QT + (size_t)(i + 3) * 4096, p1, p0, q1, q0, m, n0, fr, fq, qtoff); hload(f3, PT + (size_t)(nx + 3) * 4096, QT + (size_t)(nx + 3) * 4096, boff, qtoff);
        }
        __syncthreads();
    }
}
__device__ __forceinline__ void phase_scan2b(ArgsR a, const Ctx& c) {
    if (blockIdx.x >= NH) return;
    const int h = blockIdx.x, lane = c.lane, wv = c.wave, fr = lane & 15, fq = lane >> 4, m = wv >> 1, n0 = 32 * (wv & 1);
    const int boff = (n0 + fr) * 64 + 8 * fq, qtoff = (n0 + fr) * 64 + 16 * m + 4 * fq;
    LAS3 unsigned char* L = (LAS3 unsigned char*)c.lds;
    const bf16* LP = (const bf16*)(a.ws + WS_ST) + ST_LP_OFF + (size_t)h * NCH * 4096; const float* QT = (const float*)(a.ws + WS_ST) + ST_Q_OFF + (size_t)h * NCH * 4096;
    bf16* SG = (bf16*)(a.ws + WS_SG) + (size_t)h * NG * 4096;
    for (int i = c.tid; i < 2 * HI_BYTES / 4; i += NTHREADS) ((LAS3 unsigned*)L)[i] = 0u;
    for (int i = c.tid; i < 4096 / 2; i += NTHREADS) ((unsigned*)SG)[i] = 0u;
    __syncthreads();
    HFrag f0, f1, f2, f3;
#define SC2B_CH(g) ((size_t)((g) * GS + GS - 1) * 4096)
    hload(f0, LP + SC2B_CH(0), QT + SC2B_CH(0), boff, qtoff); hload(f1, LP + SC2B_CH(1), QT + SC2B_CH(1), boff, qtoff); hload(f2, LP + SC2B_CH(2), QT + SC2B_CH(2), boff, qtoff); hload(f3, LP + SC2B_CH(3), QT + SC2B_CH(3), boff, qtoff);
    LAS3 unsigned char* i0 = L; LAS3 unsigned char* i1 = L + HI_BYTES;
#define SC2B_STEP(f, g, ic, in) do { f32x4 acc[2] = {f.q[0], f.q[1]}; hmma(ic, f.b, acc, m, fr, fq); bf16* So = SG + (size_t)((g) + 1) * 4096; \
        _Pragma("unroll") for (int n = 0; n < 2; ++n) _Pragma("unroll") for (int i = 0; i < 4; ++i) So[(16 * m + 4 * fq + i) * 64 + n0 + 16 * n + fr] = f2bf(acc[n][i]); \
        himg_store(in, acc, m, n0, fr, fq); HBAR(); } while (0)
#pragma unroll 1
    for (int g = 0; g < NG; g += 4) {
        const int nx = (g + 4 < NG) ? g + 4 : g;
        SC2B_STEP(f0, g + 0, i0, i1); hload(f0, LP + SC2B_CH(nx + 0), QT + SC2B_CH(nx + 0), boff, qtoff);
        SC2B_STEP(f1, g + 1, i1, i0); hload(f1, LP + SC2B_CH(nx + 1), QT + SC2B_CH(nx + 1), boff, qtoff);
        SC2B_STEP(f2, g + 2, i0, i1); hload(f2, LP + SC2B_CH(nx + 2), QT + SC2B_CH(nx + 2), boff, qtoff);
        if (g + 3 < NG - 1) SC2B_STEP(f3, g + 3, i1, i0);
        hload(f3, LP + SC2B_CH(nx + 3), QT + SC2B_CH(nx + 3), boff, qtoff);
    }
#undef SC2B_STEP
#undef SC2B_CH
}
__device__ __forceinline__ void phase_scan2c(ArgsR a, const Ctx& c) {
    const int lane = c.lane, wv = c.wave, fr = lane & 15, fq = lane >> 4, m = wv >> 1, n0 = 32 * (wv & 1);
    const int boff = (n0 + fr) * 64 + 8 * fq, qtoff = (n0 + fr) * 64 + 16 * m + 4 * fq;
    LAS3 unsigned char* L = (LAS3 unsigned char*)c.lds;
    for (int item = blockIdx.x; item < NH * NG * 2; item += gridDim.x) {
        const int hg = item >> 1, hf = item & 1;
        const size_t cb = (size_t)(hg / NG) * NCH + (size_t)(hg % NG) * GS + hf * 8;
        const bf16* LP = (const bf16*)(a.ws + WS_ST) + ST_LP_OFF + cb * 4096; const float* QT = (const float*)(a.ws + WS_ST) + ST_Q_OFF + cb * 4096; bf16* SS = (bf16*)(a.ws + WS_ST) + cb * 4096;
        { const u32x4 v = *(const u32x4*)((const bf16*)(a.ws + WS_SG) + (size_t)hg * 4096 + c.tid * 8); *(LAS3 u32x4*)(L + ((c.tid >> 3) * HI_LD + (c.tid & 7) * 8) * 2) = v; }
        __syncthreads();
#pragma unroll 2
        for (int i = 0; i < 8; ++i) { HFrag f; hload(f, LP + (size_t)i * 4096, QT + (size_t)i * 4096, boff, qtoff);
            f32x4 acc[2] = {f.q[0], f.q[1]}; hmma(L, f.b, acc, m, fr, fq); bf16* So = SS + (size_t)i * 4096;
#pragma unroll
            for (int n = 0; n < 2; ++n)
#pragma unroll
                for (int k = 0; k < 4; ++k) So[(16 * m + 4 * fq + k) * 64 + n0 + 16 * n + fr] = f2bf(acc[n][k]); }
        __syncthreads();
    }
}
__device__ __forceinline__ void phase_scan3(ArgsR a, const Ctx& c, int l) {
    const f16* R = (const f16*)(a.ws + WS_R); const f16* WM1 = (const f16*)(a.ws + WS_WM1); const f16* KP = (const f16*)(a.ws + WS_KP);
    const f16* AA = (const f16*)(a.ws + WS_AA); const f16* BB = (const f16*)(a.ws + WS_BB); const f16* V = (const f16*)(a.ws + WS_V);
    const float* ST = (const float*)(a.ws + WS_ST); bf16* YA = (bf16*)(a.ws + WS_YA); const f16* Gs = (const f16*)(a.ws + WS_G);
    const int lane = c.lane;
    LAS3 unsigned char* ring = (LAS3 unsigned char*)c.lds + c.wave * SC_WAVE;
    for (int item = c.gw; item < NH * NCH; item += c.ngw) {
        const int h = __builtin_amdgcn_readfirstlane(item / NCH), ch = __builtin_amdgcn_readfirstlane(item % NCH);
        const size_t lane_off = (size_t)(lane >> 3) * W + h * 64 + (lane & 7) * 8;
        const float gn_g = a.in[I_GNG][l * W + h * 64 + lane], gn_b = a.in[I_GNB][l * W + h * 64 + lane], r_k = a.in[I_RK][l * W + h * 64 + lane];
        { const size_t e0 = (size_t)(ch * CL) * W + lane_off;
          sc_dma(AA, e0, ring); sc_dma(WM1, e0, ring + 1024); sc_dma(BB, e0, ring + 2048); sc_dma(KP, e0, ring + 3072); sc_dma(V, e0, ring + 4096); sc_dma(R, e0, ring + 5120); sc_dma(Gs, e0, ring + 6144); }
        float S[64];
        if (ch == 0) {
#pragma unroll
            for (int j = 0; j < 64; ++j) S[j] = 0.f;
        } else { const bf16* Sp = (const bf16*)ST + ((size_t)(h * NCH + ch - 1) * 64 + lane) * 64;
#pragma unroll
            for (int j = 0; j < 64; j += 4) { const f32x4 x = load4bf(Sp + j); S[j] = x[0]; S[j + 1] = x[1]; S[j + 2] = x[2]; S[j + 3] = x[3]; } }
#pragma unroll 1
        for (int blk = 0; blk < CL / SCB; ++blk) {
            LAS3 unsigned char* buf = ring + (blk & 1) * SC_BUF;
            if (blk + 1 < CL / SCB) { LAS3 unsigned char* nb = ring + ((blk + 1) & 1) * SC_BUF; const size_t e0 = (size_t)(ch * CL + (blk + 1) * SCB) * W + lane_off;
                sc_dma(AA, e0, nb); sc_dma(WM1, e0, nb + 1024); sc_dma(BB, e0, nb + 2048); sc_dma(KP, e0, nb + 3072); sc_dma(V, e0, nb + 4096); sc_dma(R, e0, nb + 5120); sc_dma(Gs, e0, nb + 6144);
                asm volatile("s_waitcnt vmcnt(7)" ::: "memory"); }
            else asm volatile("s_waitcnt vmcnt(0)" ::: "memory");
            SVec A, Wv, Bv, Kv, Rv;
            sv_cvt(A, sv_read(buf, lane)); sv_cvt1p(Wv, sv_read(buf + 1024, lane)); sv_cvt(Bv, sv_read(buf + 2048, lane)); sv_cvt(Kv, sv_read(buf + 3072, lane)); sv_cvt(Rv, sv_read(buf + 5120, lane));
            float vv = (float)*(const LAS3 f16*)(buf + 4096 + lane * 2);
#pragma unroll 1
            for (int st = 0; st < SCB; ++st) {
                const LAS3 unsigned char* sn = buf + ((st + 1 < SCB) ? st + 1 : st) * 128;
                const f16x4 ha = sv_read(sn, lane), hw = sv_read(sn + 1024, lane), hb = sv_read(sn + 2048, lane), hk = sv_read(sn + 3072, lane), hr = sv_read(sn + 5120, lane);
                const f16 hv = *(const LAS3 f16*)(sn + 4096 + lane * 2);
                float d[4] = {0.f, 0.f, 0.f, 0.f};
                sc_dot<0>(d, A, S);
                const float sa = (d[0] + d[1]) + (d[2] + d[3]);
                float y[4] = {0.f, 0.f, 0.f, 0.f};
                sc_upd3<0>(S, y, Wv, Bv, Kv, Rv, sa, vv);
                const float yy = (y[0] + y[1]) + (y[2] + y[3]);
                sv_cvt(A, ha); sv_cvt1p(Wv, hw); sv_cvt(Bv, hb); sv_cvt(Kv, hk); sv_cvt(Rv, hr); vv = (float)hv;
                { const LAS3 unsigned char* sb = buf + st * 128;
                  const float rl = (float)*(const LAS3 f16*)(sb + 5120 + lane * 2), kl = (float)*(const LAS3 f16*)(sb + 3072 + lane * 2), vl = (float)*(const LAS3 f16*)(sb + 4096 + lane * 2);
                  const float gl = bf2f(*(const LAS3 bf16*)(sb + 6144 + lane * 2));
                  const float mean = wave_sum(yy) * (1.f / 64.f); const float dd = yy - mean; const float var = wave_sum(dd * dd) * (1.f / 64.f);
                  const float bonus = wave_sum(rl * kl * r_k);
                  const float yn = dd * __builtin_amdgcn_rsqf(var + GN_EPS) * gn_g + gn_b + bonus * vl;
                  YA[(size_t)(ch * CL + blk * SCB + st) * W + h * 64 + lane] = f2bf(yn * gl); }
            }
        }
    }
}

__device__ __forceinline__ void phase_post(ArgsR a, const Ctx& c, int l) {
    const bf16* YSC = (const bf16*)(a.ws + WS_YSC); const f16* R = (const f16*)(a.ws + WS_R); const f16* KP = (const f16*)(a.ws + WS_KP); const f16* V = (const f16*)(a.ws + WS_V);
    const bf16* G = (const bf16*)(a.ws + WS_G); bf16* YA = (bf16*)(a.ws + WS_YA);
    const float* gng = a.in[I_GNG] + l * W; const float* gnb = a.in[I_GNB] + l * W; const float* rk = a.in[I_RK] + l * W;
    for (int t = c.gw; t < T; t += c.ngw) {
#pragma unroll
        for (int i = 0; i < 8; ++i) { const int n = c.lane + 64 * i; const size_t o = (size_t)t * W + n;
            const float y = bf2f(YSC[o]); const float mean = wave_sum(y) * (1.f / 64.f); const float d = y - mean; const float var = wave_sum(d * d) * (1.f / 64.f);
            float yn = d * __builtin_amdgcn_rsqf(var + GN_EPS) * gng[n] + gnb[n];
            const float r = (float)R[o], k = (float)KP[o], v = (float)V[o];
            const float bonus = wave_sum(r * k * rk[n]);
            yn += bonus * v;
            YA[o] = f2bf(yn * bf2f(G[o])); }
    }
}

__device__ __forceinline__ void phase_ln1(ArgsR a, const Ctx& c, int l, float* outw) {
    const float* MODF = (const float*)(a.ws + WS_MODF) + l * 6144;
    const float* g1 = a.in[I_LN1G] + l * D; const float* b1 = a.in[I_LN1B] + l * D;
    bf16* XN = (bf16*)(a.ws + WS_XN);
    int* TOKI = (int*)(a.ws + WS_TOKI); float* TOKW = (float*)(a.ws + WS_TOKW); int* TOKP = (int*)(a.ws + WS_TOKP);
    const float* rw = a.in[I_RW]; const float* rb = a.in[I_RB];
    LAS3 float* rwT = (LAS3 float*)((LAS3 unsigned char*)c.lds + 69632);
    unsigned* lcnt = (unsigned*)(c.lds + 135168);
    for (int i = c.tid; i < D * NE; i += NTHREADS) rwT[(i & 15) * D + (i >> 4)] = rw[i];
    if (c.tid < NE) lcnt[c.tid] = 0u;
    __syncthreads();
    for (int m = c.gw; m < T; m += c.ngw) {
        int l4 = 4 * c.lane; asm volatile("" : "+v"(l4));
        float v[16]; load_row16(a.out + (size_t)m * D, c.lane, v);
        float mean, rstd; row_stats(v, mean, rstd);
#pragma unroll
        for (int j = 0; j < 4; ++j) { f32x4 o; const int col = l4 + 256 * j;
#pragma unroll
            for (int e = 0; e < 4; ++e) { v[4 * j + e] = (v[4 * j + e] - mean) * rstd * g1[col + e] + b1[col + e]; o[e] = v[4 * j + e]; }
            *(f32x4*)(outw + (size_t)m * D + col) = o; }
        row_stats(v, mean, rstd);
#pragma unroll
        for (int j = 0; j < 4; ++j) { f32x4 o; const int col = l4 + 256 * j;
#pragma unroll
            for (int e = 0; e < 4; ++e) { v[4 * j + e] = (v[4 * j + e] - mean) * rstd * (1.0f + MODF[4096 + col + e]) + MODF[3072 + col + e]; o[e] = v[4 * j + e]; }
            store4bf(XN + (size_t)m * D + col, o); }
        float sc[16], sel[16];
#pragma unroll
        for (int e = 0; e < 16; ++e) { float lg = 0.f;
#pragma unroll
            for (int j = 0; j < 4; ++j) { const f32x4 r4 = *(const LAS3 f32x4*)(rwT + e * D + l4 + 256 * j); lg += (v[4 * j] * r4[0] + v[4 * j + 1] * r4[1]) + (v[4 * j + 2] * r4[2] + v[4 * j + 3] * r4[3]); }
            sc[e] = 1.0f / (1.0f + expf(-wave_sum(lg))); sel[e] = sc[e] + rb[e];
            if ((e & 3) == 3) __builtin_amdgcn_sched_barrier(0); }
        int best = 0; float bestv = -INFINITY;
#pragma unroll
        for (int g = 0; g < 4; ++g) { float m1 = -INFINITY, m2 = -INFINITY;
#pragma unroll
            for (int q = 0; q < 4; ++q) { const float sv = sel[4 * g + q]; if (sv > m1) { m2 = m1; m1 = sv; } else if (sv > m2) m2 = sv; }
            const float gs = m1 + m2; if (gs > bestv) { bestv = gs; best = g; } }
        int i1 = 0, i2 = 0; float s1 = -INFINITY, s2 = -INFINITY, w1 = 0.f, w2 = 0.f;
#pragma unroll
        for (int e = 0; e < 16; ++e) { if ((e >> 2) == best) { const float sv = sel[e];
                if (sv > s1) { s2 = s1; i2 = i1; w2 = w1; s1 = sv; i1 = e; w1 = sc[e]; } else if (sv > s2) { s2 = sv; i2 = e; w2 = sc[e]; } } }
        if (c.lane == 0) { const float ws = w1 + w2;
            TOKI[2 * m] = i1; TOKI[2 * m + 1] = i2; TOKW[2 * m] = w1 / ws; TOKW[2 * m + 1] = w2 / ws;
            TOKP[2 * m] = (int)atomicAdd(&lcnt[i1], 1u); TOKP[2 * m + 1] = (int)atomicAdd(&lcnt[i2], 1u); }
    }
    __syncthreads();
    if (c.tid < NE) ((int*)(a.ws + WS_BLKCNT))[blockIdx.x * NE + c.tid] = (int)lcnt[c.tid];
    __syncthreads();
    float* scr = (float*)(c.lds + c.wave * 8704);
    bf16* WGU = (bf16*)(a.ws + WS_WGU); bf16* WD = (bf16*)(a.ws + WS_WD);
    constexpr int IG = (D / 64) * (FF / 32);
    constexpr int ID = (FF / 64) * (D / 32);
    for (int it = c.gw; it < NE * (2 * IG + ID); it += c.ngw) {
        const int e = it / (2 * IG + ID); int r = it % (2 * IG + ID);
        const size_t eo = ((size_t)l * NE + e) * (size_t)D * FF;
        if (r < IG) { transpose_matrix_item(a.in[I_EG] + eo, D, FF, WGU + (size_t)e * 1024 * 1024, r, scr, c.lane, RowGU{0}); continue; } r -= IG;
        if (r < IG) { transpose_matrix_item(a.in[I_EU] + eo, D, FF, WGU + (size_t)e * 1024 * 1024, r, scr, c.lane, RowGU{1}); continue; } r -= IG;
        transpose_matrix_item(a.in[I_ED] + eo, FF, D, WD + (size_t)e * 1024 * 512, r, scr, c.lane, RowId());
    }
}

__device__ __forceinline__ void phase_perm(ArgsR a, const Ctx& c, int l) {
    const int* BLKCNT = (const int*)(a.ws + WS_BLKCNT);
    LAS3 int* pre = (LAS3 int*)c.lds;
    LAS3 int* tot = pre + 256 * NE;
    const int nb = gridDim.x;
#pragma unroll
    for (int q = 0; q < 2; ++q) { const int e = 2 * c.wave + q; int v[4]; int sum = 0;
#pragma unroll
        for (int i = 0; i < 4; ++i) { const int b = 4 * c.lane + i; v[i] = b < nb ? BLKCNT[b * NE + e] : 0; sum += v[i]; }
        int inc = sum;
#pragma unroll
        for (int o = 1; o < 64; o <<= 1) { const int t = __shfl_up(inc, o); if (c.lane >= o) inc += t; }
        int run = inc - sum;
#pragma unroll
        for (int i = 0; i < 4; ++i) { pre[(4 * c.lane + i) * NE + e] = run; run += v[i]; }
        if (c.lane == 63) tot[e] = inc; }
    __syncthreads();
    int ts[17]; { int sacc = 0;
#pragma unroll
        for (int e = 0; e < 16; ++e) { ts[e] = sacc; sacc += (tot[e] + 255) >> 8; } ts[16] = sacc; }
    if (blockIdx.x == 0 && c.tid < NE) ((int*)(a.ws + WS_TOT))[c.tid] = tot[c.tid];
    const int* TOKI = (const int*)(a.ws + WS_TOKI); const int* TOKP = (const int*)(a.ws + WS_TOKP); int* S2T = (int*)(a.ws + WS_S2T);
    const bf16* XN = (const bf16*)(a.ws + WS_XN); bf16* XS = (bf16*)(a.ws + WS_XS);
    for (int as = c.gw; as < 2 * T; as += c.ngw) {
        const int e = TOKI[as]; int base = 0;
#pragma unroll
        for (int j = 0; j < 16; ++j) base = (j == e) ? ts[j] : base;
        const int m = as >> 1, blk = (m % c.ngw) >> 3;
        const int slot = base * 256 + pre[blk * NE + e] + TOKP[as];
        if (c.lane == 0) S2T[slot] = as;
        const u32x4* src = (const u32x4*)(XN + (size_t)m * D); u32x4* dst = (u32x4*)(XS + (size_t)slot * D);
        dst[c.lane] = src[c.lane]; dst[64 + c.lane] = src[64 + c.lane];
    }
    for (int e = 0; e < 16; ++e) {
        int tse = 0, tsn = 0;
#pragma unroll
        for (int j = 0; j < 16; ++j) { tse = (j == e) ? ts[j] : tse; tsn = (j == e) ? ts[j + 1] : tsn; }
        const int lo = tse * 256 + tot[e], hi = tsn * 256;
        for (int sl = lo + c.gw; sl < hi; sl += c.ngw) { if (c.lane == 0) S2T[sl] = -1; u32x4* dst = (u32x4*)(XS + (size_t)sl * D); const u32x4 zz = {0u, 0u, 0u, 0u}; dst[c.lane] = zz; dst[64 + c.lane] = zz; }
    }
    __syncthreads();
}

__device__ __forceinline__ void phase_ln2(ArgsR a, const Ctx& c, int l, float* outw) {
    const float* MODF = (const float*)(a.ws + WS_MODF) + l * 6144;
    const float* g2 = a.in[I_LN2G] + l * D; const float* b2 = a.in[I_LN2B] + l * D;
    const bf16* Y = (const bf16*)(a.ws + WS_Y); bf16* XN = (bf16*)(a.ws + WS_XN);
    for (int m = c.gw; m < T; m += c.ngw) {
        float v[16]; load_row16(a.out + (size_t)m * D, c.lane, v);
#pragma unroll
        for (int j = 0; j < 4; ++j) { const int col = 4 * c.lane + 256 * j; const f32x4 y0 = load4bf(Y + (size_t)(2 * m) * D + col), y1 = load4bf(Y + (size_t)(2 * m + 1) * D + col);
#pragma unroll
            for (int e = 0; e < 4; ++e) v[4 * j + e] = ALPHA * v[4 * j + e] + (1.0f + MODF[5120 + col + e]) * (y0[e] + y1[e]); }
        float mean, rstd; row_stats(v, mean, rstd);
#pragma unroll
        for (int j = 0; j < 4; ++j) { f32x4 o; const int col = 4 * c.lane + 256 * j;
#pragma unroll
            for (int e = 0; e < 4; ++e) { v[4 * j + e] = (v[4 * j + e] - mean) * rstd * g2[col + e] + b2[col + e]; o[e] = v[4 * j + e]; }
            *(f32x4*)(outw + (size_t)m * D + col) = o; }
        if (l + 1 < DEPTH) {
            const float* MN = MODF + 6144;
            row_stats(v, mean, rstd);
#pragma unroll
            for (int j = 0; j < 4; ++j) { f32x4 o; const int col = 4 * c.lane + 256 * j;
#pragma unroll
                for (int e = 0; e < 4; ++e) o[e] = (v[4 * j + e] - mean) * rstd * (1.0f + MN[1024 + col + e]) + MN[col + e];
                store4bf(XN + (size_t)m * D + col, o); }
        }
    }
}


template <class F> struct EpiAdapt {
    static constexpr bool PERM = true, AFTER_DRAIN = false; F f;
    __device__ __forceinline__ void operator()(const f32x4 (&acc)[2][2][4][2], const Unit& u, int wr, int wc, int fr, int fq) const {
        const int col = u.pn * 256 + wc * 32 + 8 * fq;
#pragma unroll
        for (int ai = 0; ai < 2; ++ai)
#pragma unroll
            for (int m = 0; m < 4; ++m) { const int row = u.pm * 256 + ai * 128 + wr * 64 + m * 16 + fr; f(row, col, acc[ai][0][m][0], acc[ai][0][m][1], acc[ai][1][m][0], acc[ai][1][m][1]); }
    }
};

template <class Sched, class F>
__device__ __forceinline__ void gemm_any(const Ctx& c, const bf16* A, const bf16* Bt, int M, int N, int K, const Sched& S, const F& f) {
    pg8::Gemm g{A, Bt, M, N, K}; EpiAdapt<F> E{f};
    pg8::gemm_phase<EpiAdapt<F>, Sched, true, true>((PG8_LAS unsigned char*)c.lds, g, S, E, c.tid);
}

#define LAS __attribute__((address_space(3)))
#define XB_TMO      128
#define XB_XCNT(j)  (256  + 64 * (j))
#define XB_XSUB(j)  (1280 + 64 * (j))
#define XB_XGEN(j)  (2304 + 64 * (j))
#define XB_TOP      3328
#define XB_TOPGEN   3392
#define XCD_BAR_WORDS 3456
#define XB_SPIN_CAP (1u << 24)

__device__ __forceinline__ unsigned xb_ld(unsigned* p)              { return __hip_atomic_load(p, __ATOMIC_RELAXED, __HIP_MEMORY_SCOPE_AGENT); }
__device__ __forceinline__ unsigned xb_add(unsigned* p, unsigned v) { return __hip_atomic_fetch_add(p, v, __ATOMIC_RELAXED, __HIP_MEMORY_SCOPE_AGENT); }
__device__ __forceinline__ unsigned xb_xcc_id() { return (unsigned)__builtin_amdgcn_s_getreg((3 << 11) | 20) & 0xFu; }
#define XB_SPIN(cond, bar) do { unsigned _sp = 0; while (cond) { __builtin_amdgcn_s_sleep(1); \
    if ((++_sp & 255u) == 0u) { if (xb_ld(&(bar)[XB_TMO])) break; if (_sp > XB_SPIN_CAP) { atomicAdd(&(bar)[XB_TMO], 1u); break; } } } } while (0)

struct XcdBarrier {
    unsigned* bar; unsigned x;
    volatile LAS unsigned* st;
};

__device__ __forceinline__ XcdBarrier xcd_barrier_post(unsigned* bar, volatile LAS unsigned* st) {
    XcdBarrier b; b.bar = bar; b.x = xb_xcc_id(); b.st = st;
    if (threadIdx.x == 0) (void)xb_add(&bar[XB_XCNT(b.x)], 1u);
    return b;
}
__device__ __forceinline__ void xcd_barrier_complete(unsigned* bar, unsigned x, unsigned& nloc, unsigned& nx) {
    const unsigned G = gridDim.x * gridDim.y * gridDim.z;
    unsigned sum, cnt, mine, sp = 0u;
    for (;;) {
        sum = 0u; cnt = 0u; mine = 0u;
#pragma unroll
        for (unsigned j = 0; j < 16; ++j) { const unsigned c = xb_ld(&bar[XB_XCNT(j)]); sum += c; cnt += (c > 0u) ? 1u : 0u; mine = (j == x) ? c : mine; }
        if (sum == G) break;
        __builtin_amdgcn_s_sleep(1);
        if ((++sp & 255u) == 0u) { if (xb_ld(&bar[XB_TMO])) break; if (sp > XB_SPIN_CAP) { atomicAdd(&bar[XB_TMO], 1u); break; } }
    }
    nloc = mine > 0u ? mine : 1u; nx = cnt > 0u ? cnt : 1u;
}

__device__ __forceinline__ void xcd_barrier(const XcdBarrier& b) {
    asm volatile("s_waitcnt vmcnt(0)" ::: "memory");
    __syncthreads();
    if (threadIdx.x == 0) {
        unsigned* bar = b.bar;
        __builtin_amdgcn_s_waitcnt(0);
        unsigned nloc = b.st[0], nx = b.st[1];
        if (nloc == 0u) { xcd_barrier_complete(bar, b.x, nloc, nx); b.st[0] = nloc; b.st[1] = nx; }
        const unsigned old = xb_add(&bar[XB_XSUB(b.x)], 1u);
        const unsigned gen = old / nloc;
        if (old + 1u == (gen + 1u) * nloc) {
            __builtin_amdgcn_fence(__ATOMIC_RELEASE, "agent");
            asm volatile("s_waitcnt vmcnt(0)" ::: "memory");
            const unsigned og = xb_add(&bar[XB_TOP], 1u);
            const unsigned tg = og / nx;
            if (og + 1u == (tg + 1u) * nx) xb_add(&bar[XB_TOPGEN], 1u);
            else XB_SPIN(xb_ld(&bar[XB_TOPGEN]) == tg, bar);
            __builtin_amdgcn_fence(__ATOMIC_ACQUIRE, "agent");
            xb_add(&bar[XB_XGEN(b.x)], 1u);
            asm volatile("s_waitcnt vmcnt(0)" ::: "memory");
        } else {
            XB_SPIN(xb_ld(&bar[XB_XGEN(b.x)]) == gen, bar);
            __builtin_amdgcn_fence(__ATOMIC_ACQUIRE, "agent");
            asm volatile("s_waitcnt vmcnt(0)" ::: "memory");
        }
    }
    __syncthreads();
}


constexpr int PH_PER_LAYER = 12, N_PHASES = 2 + PH_PER_LAYER * DEPTH;
constexpr int CW_BAR = 4096;
constexpr int LDS_BYTES = 147456, LDSCTL_OFF = 131072 + 8192;
#ifndef SINGLE_LAUNCH
#define SINGLE_LAUNCH 1
#endif

#ifndef PROBE_A
#define PROBE_A -1
#endif
#ifndef PROBE_B
#define PROBE_B -1
#endif
constexpr size_t WS_TS = 512 * 1024;
#if PROBE_A >= 0
#define STAMP(i) do { if (blockIdx.x == 0 && threadIdx.x == 0) ((unsigned long long*)(args_here()->ws + WS_TS))[(i)] = __builtin_amdgcn_s_memrealtime(); } while (0)
#else
#define STAMP(i) do { } while (0)
#endif
__device__ __forceinline__ const __attribute__((address_space(4))) Args* args_here() { const __attribute__((address_space(4))) Args* p = (const __attribute__((address_space(4))) Args*)__builtin_amdgcn_kernarg_segment_ptr(); asm volatile("" : "+s"(p)); return p; }
#ifndef REP_K
#define REP_K -1
#endif
__device__ __forceinline__ Ctx mkctx(int wave_s, unsigned char* lds) { Ctx c; c.wave = wave_s; c.lane = (int)__builtin_amdgcn_mbcnt_hi(~0u, __builtin_amdgcn_mbcnt_lo(~0u, 0u)); c.tid = wave_s * 64 + c.lane;
    c.gw = blockIdx.x * NWAVES + wave_s; c.ngw = gridDim.x * NWAVES; c.lds = lds; return c; }
#define PHASE1(k, ...) do { const __attribute__((address_space(4))) Args* ap_ = args_here(); if (ap_->ph_lo <= (k) && (k) < ap_->ph_hi) { ArgsR a = *ap_; const Ctx c = mkctx(wave_s, lds); __VA_ARGS__ } } while (0)
#define PHASE(k, ...) do { PHASE1(k, __VA_ARGS__); if ((k) == REP_K) { xcd_barrier(bar); PHASE1(k, __VA_ARGS__); xcd_barrier(bar); PHASE1(k, __VA_ARGS__); } } while (0)

template <int L>
__device__ __forceinline__ void run_layer(const int wave_s, unsigned char* lds, const XcdBarrier& bar) {
    const int G = gridDim.x, b = blockIdx.x;
#define BAR() do { xcd_barrier(bar); STAMP(3 + 14 * L + (bk_++)); } while (0)
    int bk_ = 0;
    PHASE(0, unsigned char* ws = a.ws; pg8::StaticOrder S; S.init(T, INC, G, b); EpiZ E{(bf16*)(ws + WS_ZR), (bf16*)(ws + WS_ZS), (bf16*)(ws + WS_ZG)};
        gemm_any(c, (const bf16*)(ws + WS_XN), (const bf16*)(ws + WS_WIN + (size_t)L * 10 * MiB), T, INC, D, S, E); );
    BAR();
    PHASE(1, phase_prep_fast(a, c, L); );
    PHASE(14, phase_sg_fast(a, c, L); );
    BAR();
    PHASE(2, phase_scan1(a, c); );
    BAR();
    PHASE(3, phase_scan2a(a, c); );
    BAR();
    PHASE(31, phase_scan2b(a, c); );
    BAR();
    PHASE(32, phase_scan2c(a, c); );
    BAR();
    PHASE(4, phase_scan3(a, c, L); );
    BAR();
    PHASE(6, unsigned char* ws = a.ws; pg8::StaticOrder S; S.init(T, D, G, b); EpiGA E{(const bf16*)(ws + WS_ZG), (bf16*)(ws + WS_MP)};
        gemm_any(c, (const bf16*)(ws + WS_YA), (const bf16*)(ws + WS_WA + (size_t)L * WS_WL1), T, D, W, S, E); );
    BAR();
#if REP_K == 7
    PHASE1(7, unsigned char* ws = a.ws; pg8::StaticOrder S; S.init(T, D, G, b); EpiGB E{(const bf16*)(ws + WS_ZG), (const bf16*)(ws + WS_MP), (bf16*)(ws + WS_ZR)};
        gemm_any(c, (const bf16*)(ws + WS_YB), (const bf16*)(ws + WS_WB + (size_t)L * WS_WL1), T, D, W, S, E); ); xcd_barrier(bar);
    PHASE1(7, unsigned char* ws = a.ws; pg8::StaticOrder S; S.init(T, D, G, b); EpiGB E{(const bf16*)(ws + WS_ZG), (const bf16*)(ws + WS_MP), (bf16*)(ws + WS_ZR)};
        gemm_any(c, (const bf16*)(ws + WS_YB), (const bf16*)(ws + WS_WB + (size_t)L * WS_WL1), T, D, W, S, E); ); xcd_barrier(bar);
#endif
#if REP_K == 8
    PHASE1(8, unsigned char* ws = a.ws; pg8::StaticOrder S; S.init(T, D, G, b); EpiOut E{L == 0 ? a.in[I_X] : a.out, (float*)(ws + WS_R), (const float*)(ws + WS_MODF) + L * 6144 + 2048};
        gemm_any(c, (const bf16*)(ws + WS_MP), (const bf16*)(ws + WS_WO + (size_t)L * WS_WL1), T, D, D, S, E); ); xcd_barrier(bar);
    PHASE1(8, unsigned char* ws = a.ws; pg8::StaticOrder S; S.init(T, D, G, b); EpiOut E{L == 0 ? a.in[I_X] : a.out, (float*)(ws + WS_R), (const float*)(ws + WS_MODF) + L * 6144 + 2048};
        gemm_any(c, (const bf16*)(ws + WS_MP), (const bf16*)(ws + WS_WO + (size_t)L * WS_WL1), T, D, D, S, E); ); xcd_barrier(bar);
#endif
    PHASE1(7, unsigned char* ws = a.ws; pg8::StaticOrder S; S.init(T, D, G, b); EpiGB E{(const bf16*)(ws + WS_ZG), (const bf16*)(ws + WS_MP), (bf16*)(ws + WS_MP)};
        gemm_any(c, (const bf16*)(ws + WS_YB), (const bf16*)(ws + WS_WB + (size_t)L * WS_WL1), T, D, W, S, E); );
    BAR();
    PHASE1(8, unsigned char* ws = a.ws; pg8::StaticOrder S; S.init(T, D, G, b); EpiOut E{L == 0 ? a.in[I_X] : a.out, a.out, (const float*)(ws + WS_MODF) + L * 6144 + 2048};
        gemm_any(c, (const bf16*)(ws + WS_MP), (const bf16*)(ws + WS_WO + (size_t)L * WS_WL1), T, D, D, S, E); );
    BAR();
#if REP_K == 9
    PHASE1(9, phase_ln1(a, c, L, (float*)(a.ws + WS_ZR)); ); xcd_barrier(bar); PHASE1(9, phase_ln1(a, c, L, (float*)(a.ws + WS_ZR)); ); xcd_barrier(bar);
#endif
    PHASE1(9, phase_ln1(a, c, L, a.out); );
    BAR();
    PHASE(10, phase_perm(a, c, L); );
    BAR();
    PHASE(11, unsigned char* ws = a.ws; MoeSched S; S.init((const unsigned*)(ws + WS_TOT), G, b); EpiSwi E{(bf16*)(ws + WS_HID)};
        gemm_any(c, (const bf16*)(ws + WS_XS), (const bf16*)(ws + WS_WGU), MAXSLOT, NE * 1024, D, S, E); );
    BAR();
    PHASE(12, unsigned char* ws = a.ws; MoeSched S; S.init((const unsigned*)(ws + WS_TOT), G, b); EpiDown E{(const int*)(ws + WS_S2T), (const float*)(ws + WS_TOKW), (bf16*)(ws + WS_Y)};
        gemm_any(c, (const bf16*)(ws + WS_HID), (const bf16*)(ws + WS_WD), MAXSLOT, NE * 1024, FF, S, E); );
    BAR();
#if REP_K == 13
    PHASE1(13, phase_ln2(a, c, L, (float*)(a.ws + WS_R)); ); xcd_barrier(bar); PHASE1(13, phase_ln2(a, c, L, (float*)(a.ws + WS_R)); ); xcd_barrier(bar);
#endif
    PHASE1(13, phase_ln2(a, c, L, a.out); );
    if (L + 1 < DEPTH) BAR();
    (void)bk_;
#undef BAR
}

__global__ void __launch_bounds__(NTHREADS, 2) mk_fwd(Args a_unused) {
    extern __shared__ __attribute__((aligned(16))) unsigned char lds[];
    const int wave_s = __builtin_amdgcn_readfirstlane(threadIdx.x >> 6);
    for (int u = threadIdx.x; u < (LDS_BYTES - LDSCTL_OFF) / 4; u += NTHREADS) ((LAS unsigned*)((LAS unsigned char*)lds + LDSCTL_OFF))[u] = 0u;
    __syncthreads();
    const XcdBarrier bar = xcd_barrier_post((unsigned*)(args_here()->ws + WS_CTL) + CW_BAR, (volatile LAS unsigned*)((LAS unsigned char*)lds + LDSCTL_OFF) + 8);
    STAMP(0);
    PHASE(100, phase_p0a(a, c); );
    xcd_barrier(bar); STAMP(1);
    PHASE(101, phase_p0b(a, c); );
    xcd_barrier(bar); STAMP(2);
    run_layer<0>(wave_s, lds, bar);
    run_layer<1>(wave_s, lds, bar);
#if PROBE_A >= 0
    if (blockIdx.x == 0) {
        asm volatile("s_waitcnt vmcnt(0)" ::: "memory"); __syncthreads();
        if (threadIdx.x == 0) ((unsigned long long*)(args_here()->ws + WS_TS))[30] = __builtin_amdgcn_s_memrealtime();
        asm volatile("s_waitcnt vmcnt(0)" ::: "memory"); __syncthreads();
        const volatile unsigned long long* ts = (const volatile unsigned long long*)(args_here()->ws + WS_TS);
        float da = 0.f, db = 0.f;
        if (PROBE_A < 14) { da = (float)(ts[3 + PROBE_A] - ts[2 + PROBE_A]) + (float)(ts[17 + PROBE_A] - ts[16 + PROBE_A]); } else if (PROBE_A == 14) da = (float)(ts[1] - ts[0]); else if (PROBE_A == 15) da = (float)(ts[2] - ts[1]); else da = (float)(ts[30] - ts[0]);
        if (PROBE_B >= 0 && PROBE_B < 14) { db = (float)(ts[3 + PROBE_B] - ts[2 + PROBE_B]) + (float)(ts[17 + PROBE_B] - ts[16 + PROBE_B]); } else if (PROBE_B == 14) db = (float)(ts[1] - ts[0]); else if (PROBE_B == 15) db = (float)(ts[2] - ts[1]);
        da *= 0.01f; db *= 0.01f;
        da = exp2f(0.25f * rintf(4.0f * log2f(fmaxf(da, 0.5f)))); db = exp2f(0.25f * rintf(4.0f * log2f(fmaxf(db, 0.5f))));
        float* out = args_here()->out;
        for (int i = threadIdx.x; i < 16 * 1024; i += NTHREADS) { const int r = i >> 10, col = i & 1023; const int rowi = (r & 7) + 2048 * (r >> 3); out[(size_t)rowi * D + col] = da; }
        if (threadIdx.x == 0 && PROBE_B >= 0) out[(size_t)4096 * D] = 100.0f * db;
    }
#endif
}

extern "C" void kernel_launch(void* const* d_in, const int* in_sizes, int n_in, void* d_out, int out_size, void* d_ws, size_t ws_size, hipStream_t stream) {
    static int grid = 0;
    if (grid == 0) {
        if (n_in != N_IN || out_size != T * D || ws_size < WS_END) { fprintf(stderr, "kernel_launch: unexpected shapes: n_in %d out %d ws %zu (need %zu)\n", n_in, out_size, ws_size, (size_t)WS_END); grid = -1; return; }
        int dev = 0, cus = 0;
        (void)hipGetDevice(&dev); (void)hipDeviceGetAttribute(&cus, hipDeviceAttributeMultiprocessorCount, dev);
        if (hipFuncSetAttribute((const void*)mk_fwd, hipFuncAttributeMaxDynamicSharedMemorySize, LDS_BYTES) != hipSuccess) { fprintf(stderr, "kernel_launch: hipFuncSetAttribute failed\n"); grid = -1; return; }
        grid = cus > 0 ? cus : 256;
        fprintf(stderr, "kernel_launch: ws_size %zu grid %d\n", ws_size, grid);
    }
    if (grid < 0) return;
    (void)hipMemsetAsync((char*)d_ws + WS_CTL, 0, CTL_BYTES, stream);
    Args a{};
    for (int i = 0; i < N_IN; ++i) a.in[i] = (const float*)d_in[i];
    a.out = (float*)d_out; a.ws = (unsigned char*)d_ws;
    a.ph_lo = 0; a.ph_hi = 1000;
    hipLaunchKernelGGL(mk_fwd, dim3(grid), dim3(NTHREADS), LDS_BYTES, stream, a);
}
```

```cpp
#include <hip/hip_runtime.h>
#include <cstdio>
#include <cstdint>
#include <utility>

typedef unsigned short bf16;
typedef _Float16 f16;
typedef float f32x4 __attribute__((ext_vector_type(4)));
typedef unsigned u32x4 __attribute__((ext_vector_type(4)));
typedef unsigned u32x2 __attribute__((ext_vector_type(2)));

constexpr int T = 16384, D = 1024, W = 512, NH = 8, HN = 64, RC = 1792, INC = 4864;
constexpr int NE = 16, FF = 512, DEPTH = 2;
constexpr float LN_EPS = 1e-5f, GN_EPS = 64e-5f, ALPHA = 1.41421356237f;
constexpr int NTHREADS = 512, NWAVES = 8;
constexpr int MAXSLOT = 36864;

constexpr size_t MiB = 1u << 20;
constexpr size_t WS_CTL = 0, CTL_BYTES = 1 * MiB;
constexpr int CW_CNT = 16384;
constexpr size_t WS_PART = 1 * MiB;
constexpr size_t WS_MODF = 2 * MiB;
constexpr size_t WS_TOKI = 2 * MiB + 65536;
constexpr size_t WS_TOKW = WS_TOKI + 131072;
constexpr size_t WS_TOKP = WS_TOKW + 131072;
constexpr size_t WS_S2T = 3 * MiB;
constexpr size_t WS_BLKCNT = 3 * MiB + 512 * 1024;
constexpr size_t WS_TOT = WS_BLKCNT + 32768;
constexpr size_t WS_LORA = 4 * MiB;
constexpr size_t WS_WIN = 8 * MiB;
constexpr size_t WS_WA = 28 * MiB, WS_WB = 29 * MiB, WS_WO = 30 * MiB, WS_WL1 = 4 * MiB;
constexpr size_t WS_ZG = 36 * MiB;
constexpr size_t WS_XN = 100 * MiB;
constexpr size_t WS_G = 100 * MiB, WS_YB = 116 * MiB;
constexpr size_t WS_ZR = 132 * MiB;
constexpr size_t WS_ZS = 188 * MiB;
constexpr size_t WS_YSC = 132 * MiB;
constexpr size_t WS_ST = 148 * MiB;
constexpr size_t WS_YA = 132 * MiB;
constexpr size_t WS_MP = 164 * MiB;
constexpr size_t WS_XS = 132 * MiB;
constexpr size_t WS_Y = 132 * MiB;
constexpr size_t WS_R = 224 * MiB, WS_WM1 = 240 * MiB, WS_KP = 256 * MiB, WS_AA = 272 * MiB, WS_BB = 288 * MiB, WS_V = 304 * MiB;
constexpr size_t WS_WGU = 224 * MiB;
constexpr size_t WS_WD = 256 * MiB;
constexpr size_t WS_HID = 272 * MiB;
constexpr size_t WS_VF = 320 * MiB;
constexpr size_t WS_END = 336 * MiB;

constexpr size_t LO_W2T = 0, LO_A2T = 65536, LO_G2T = 131072, LO_VM1T = 262144, LO_VM2T = 294912, LO_STRIDE = 524288;

enum { I_X = 0, I_C, I_WMOD, I_BMOD, I_WIN, I_MU, I_W0, I_W2, I_A0, I_A2, I_G2, I_KK, I_KA, I_RK, I_GNG, I_GNB, I_VM0, I_VM1, I_VM2,
       I_SGG, I_SGB, I_WS, I_BS, I_WBA, I_WBB, I_WOUT, I_LN1G, I_LN1B, I_RW, I_RB, I_EG, I_EU, I_ED, I_LN2G, I_LN2B, N_IN };

struct Args { const float* in[N_IN]; float* out; unsigned char* ws; int ph_lo, ph_hi; };
typedef const __attribute__((address_space(4))) Args& ArgsR;

__device__ __forceinline__ float bf2f(bf16 h) { return __uint_as_float(((unsigned)h) << 16); }
__device__ __forceinline__ unsigned f2bfu(float f) { unsigned u = __float_as_uint(f); return (u + 0x7fffu + ((u >> 16) & 1u)) >> 16; }
__device__ __forceinline__ bf16 f2bf(float f) { return __builtin_bit_cast(unsigned short, (__bf16)f); }
typedef __bf16 bf16x2_t __attribute__((ext_vector_type(2)));
__device__ __forceinline__ unsigned pk2(float lo, float hi) { bf16x2_t v; v[0] = (__bf16)lo; v[1] = (__bf16)hi; return __builtin_bit_cast(unsigned, v); }
__device__ __forceinline__ void store4bf(bf16* p, f32x4 v) { u32x2 w; w.x = pk2(v[0], v[1]); w.y = pk2(v[2], v[3]); *(u32x2*)p = w; }
__device__ __forceinline__ f32x4 load4bf(const bf16* p) { u32x2 w = *(const u32x2*)p; f32x4 r; r[0] = __uint_as_float(w.x << 16); r[1] = __uint_as_float(w.x & 0xffff0000u); r[2] = __uint_as_float(w.y << 16); r[3] = __uint_as_float(w.y & 0xffff0000u); return r; }
__device__ __forceinline__ float wave_sum(float v) {
#pragma unroll
    for (int o = 1; o < 64; o <<= 1) v += __shfl_xor(v, o);
    return v;
}
__device__ __forceinline__ float sigmoidf_(float x) { return __builtin_amdgcn_rcpf(1.0f + __expf(-x)); }
__device__ __forceinline__ float siluf_(float x) { return x * sigmoidf_(x); }
__device__ __forceinline__ float gelu_tanh(float x) { const float u = 0.7978845608028654f * (x + 0.044715f * x * x * x); return x * (1.0f - __builtin_amdgcn_rcpf(1.0f + __expf(2.0f * u))); }
__device__ __forceinline__ float softplusf_(float y) { return fmaxf(y, 0.f) + log1pf(__expf(-fabsf(y))); }

struct Ctx { int tid, lane, wave, gw, ngw; unsigned char* lds; };

__device__ __forceinline__ void transpose_item(const float* Wsrc, int N, int k0, int n0, bf16* dst, int ldk, float* scr, int lane) {
    float tv[32];
#pragma unroll
    for (int i = 0; i < 32; ++i) tv[i] = Wsrc[(size_t)(k0 + 2 * i + (lane >> 5)) * N + n0 + (lane & 31)];
#pragma unroll
    for (int i = 0; i < 32; ++i) scr[(2 * i + (lane >> 5)) * 33 + (lane & 31)] = tv[i];
    asm volatile("s_waitcnt lgkmcnt(0)" ::: "memory");
    const int c = lane & 7;
#pragma unroll
    for (int j = 0; j < 4; ++j) { const int n = (lane >> 3) + 8 * j; const float* s = scr + (8 * c) * 33 + n;
        u32x4 o; o.x = pk2(s[0 * 33], s[1 * 33]); o.y = pk2(s[2 * 33], s[3 * 33]); o.z = pk2(s[4 * 33], s[5 * 33]); o.w = pk2(s[6 * 33], s[7 * 33]);
        *(u32x4*)(dst + (size_t)n * ldk + k0 + 8 * c) = o; }
    asm volatile("s_waitcnt lgkmcnt(0)" ::: "memory");
}
template <class RowMap>
__device__ __forceinline__ void transpose_matrix_item(const float* Wsrc, int K, int N, bf16* dst, int item, float* scr, int lane, const RowMap& rm) {
    const int nblk = N / 32, kb = item / nblk, nb = item % nblk, n0 = 32 * nb;
    transpose_item(Wsrc, N, 64 * kb, n0, dst + (size_t)rm(n0) * K, K, scr, lane);
}
struct RowId { __device__ __forceinline__ int operator()(int n) const { return n; } };
struct RowGU { int up; __device__ __forceinline__ int operator()(int n) const { return (n >> 7) * 256 + (n & 127) + up * 128; } };

__device__ __forceinline__ void phase_p0a(ArgsR a, const Ctx& c) {
    float* scr = (float*)(c.lds + c.wave * 16384);
    { float* MODF = (float*)(a.ws + WS_MODF); float* red = (float*)(c.lds + 131072);
      for (int cbk = blockIdx.x; cbk < 2 * 96; cbk += gridDim.x) {
          const int l = cbk / 96, n = (cbk % 96) * 64 + c.lane;
          const float* wm = a.in[I_WMOD] + (size_t)l * D * 6144 + (size_t)(c.wave * 128) * 6144 + n;
          float acc0 = 0.f, acc1 = 0.f;
#pragma unroll 16
          for (int k = 0; k < 128; k += 2) { acc0 += siluf_(a.in[I_C][c.wave * 128 + k]) * wm[(size_t)k * 6144]; acc1 += siluf_(a.in[I_C][c.wave * 128 + k + 1]) * wm[(size_t)(k + 1) * 6144]; }
          red[c.wave * 64 + c.lane] = acc0 + acc1;
          __syncthreads();
          if (c.wave == 0) { float sacc = a.in[I_BMOD][l * 6144 + n];
#pragma unroll
              for (int w = 0; w < 8; ++w) sacc += red[w * 64 + c.lane];
              MODF[l * 6144 + n] = sacc; }
          __syncthreads();
      } }
    for (int it = c.gw; it < 2 * (16 + 16 + 32 + 8); it += c.ngw) {
        const int l = it / 72; int r = it % 72; unsigned char* lo = a.ws + WS_LORA + (size_t)l * LO_STRIDE;
        if (r < 16) { transpose_matrix_item(a.in[I_W2] + (size_t)l * 64 * W, 64, W, (bf16*)(lo + LO_W2T), r, scr, c.lane, RowId()); continue; } r -= 16;
        if (r < 16) { transpose_matrix_item(a.in[I_A2] + (size_t)l * 64 * W, 64, W, (bf16*)(lo + LO_A2T), r, scr, c.lane, RowId()); continue; } r -= 16;
        if (r < 32) { transpose_matrix_item(a.in[I_G2] + (size_t)l * 128 * W, 128, W, (bf16*)(lo + LO_G2T), r, scr, c.lane, RowId()); continue; } r -= 32;
        if (l == 1) transpose_matrix_item(a.in[I_VM1], W, 32, (bf16*)(lo + LO_VM1T), r, scr, c.lane, RowId());
    }
    for (int i = blockIdx.x * NTHREADS + c.tid; i < 32 * W; i += gridDim.x * NTHREADS) { const int n = i >> 5, k = i & 31;
        ((bf16*)(a.ws + WS_LORA + LO_STRIDE + LO_VM2T))[i] = f2bf(a.in[I_VM2][(size_t)k * W + n]); }
    constexpr int I_WINL = (D / 64) * (INC / 32);
    constexpr int I_WAL = (W / 64) * (D / 32);
    constexpr int I_WOL = (D / 64) * (D / 32);
    constexpr int PER_L = I_WINL + 2 * I_WAL + I_WOL;
    for (int it = c.gw; it < 2 * PER_L; it += c.ngw) {
        const int l = it / PER_L; int r = it % PER_L;
        if (r < I_WINL) { transpose_matrix_item(a.in[I_WIN] + (size_t)l * D * INC, D, INC, (bf16*)(a.ws + WS_WIN + (size_t)l * 10 * MiB), r, scr, c.lane, RowId()); continue; } r -= I_WINL;
        if (r < I_WAL) { transpose_matrix_item(a.in[I_WBA] + (size_t)l * W * D, W, D, (bf16*)(a.ws + WS_WA + (size_t)l * WS_WL1), r, scr, c.lane, RowId()); continue; } r -= I_WAL;
        if (r < I_WAL) { transpose_matrix_item(a.in[I_WBB] + (size_t)l * W * D, W, D, (bf16*)(a.ws + WS_WB + (size_t)l * WS_WL1), r, scr, c.lane, RowId()); continue; } r -= I_WAL;
        transpose_matrix_item(a.in[I_WOUT] + (size_t)l * D * D, D, D, (bf16*)(a.ws + WS_WO + (size_t)l * WS_WL1), r, scr, c.lane, RowId());
    }
}

__device__ __forceinline__ void row_stats(const float (&v)[16], float& mean, float& rstd) {
    float s = 0.f;
#pragma unroll
    for (int j = 0; j < 16; ++j) s += v[j];
    mean = wave_sum(s) * (1.f / D);
    float q = 0.f;
#pragma unroll
    for (int j = 0; j < 16; ++j) { const float d = v[j] - mean; q += d * d; }
    rstd = __builtin_amdgcn_rsqf(wave_sum(q) * (1.f / D) + LN_EPS);
}
__device__ __forceinline__ void load_row16(const float* p, int lane, float (&v)[16]) {
#pragma unroll
    for (int j = 0; j < 4; ++j) { const f32x4 x = *(const f32x4*)(p + 4 * lane + 256 * j); v[4 * j] = x[0]; v[4 * j + 1] = x[1]; v[4 * j + 2] = x[2]; v[4 * j + 3] = x[3]; }
}

__device__ __forceinline__ void phase_p0b(ArgsR a, const Ctx& c) {
    const float* MODF = (const float*)(a.ws + WS_MODF);
    float sh[16], sc[16];
#pragma unroll
    for (int j = 0; j < 4; ++j) { const f32x4 s0 = *(const f32x4*)(MODF + 4 * c.lane + 256 * j), s1 = *(const f32x4*)(MODF + 1024 + 4 * c.lane + 256 * j);
#pragma unroll
        for (int e = 0; e < 4; ++e) { sh[4 * j + e] = s0[e]; sc[4 * j + e] = 1.f + s1[e]; } }
    bf16* XN = (bf16*)(a.ws + WS_XN);
    for (int m = c.gw; m < T; m += c.ngw) {
        float v[16]; load_row16(a.in[I_X] + (size_t)m * D, c.lane, v);
        float mean, rstd; row_stats(v, mean, rstd);
#pragma unroll
        for (int j = 0; j < 4; ++j) { f32x4 o;
#pragma unroll
            for (int e = 0; e < 4; ++e) o[e] = (v[4 * j + e] - mean) * rstd * sc[4 * j + e] + sh[4 * j + e];
            store4bf(XN + (size_t)m * D + 4 * c.lane + 256 * j, o); }
    }
}

namespace pg8 {
#define PG8_LAS __attribute__((address_space(3)))
typedef unsigned short bf16_t;
typedef short bf16x8 __attribute__((ext_vector_type(8)));
typedef float f32x4 __attribute__((ext_vector_type(4)));
typedef unsigned u32x4 __attribute__((ext_vector_type(4)));
constexpr int BM = 256, BK = 64, HALF = 128, HTB = HALF * BK * 2  , STAGE_BYTES = 8 * HTB, NXCD = 8, WGM = 8;

__host__ __device__ __forceinline__ int lds_byte(int r, int c) { const int st = (r >> 4) * 2 + (c >> 5), rr = r & 15, cc = c & 31, ob = rr * 64 + cc * 2; return st * 1024 + (ob ^ (((ob >> 9) & 1) << 5)); }
__host__ __device__ __forceinline__ void stage_rc(int b, int& R, int& C) { const int st = b / 1024, sb = b % 1024, swz = sb ^ (((sb >> 9) & 1) << 5); R = (st >> 1) * 16 + swz / 64; C = (st & 1) * 32 + (swz % 64) / 2; }
__host__ __device__ __forceinline__ int perm32(int rho) { const int n = rho >> 4, i = rho & 15; return 8 * (i >> 2) + 4 * n + (i & 3); }

struct Unit { int pm, pn; };
struct Gemm { const bf16_t* A; const bf16_t* Bt; int M, N, K; };

struct StaticOrder {
    int nM, nN, nwg, G, c;
    __host__ __device__ void init(int M, int N, int G_, int c_) { nM = M / BM; nN = N / BM; nwg = nM * nN; G = G_; c = c_; }
    __host__ __device__ bool next(int i, Unit& u) const {
        const long L = (long)i * G + c; if (L >= nwg) return false;
        int wgid = (int)L; { const int q = nwg / NXCD, r = nwg % NXCD, xcd = wgid % NXCD, off = wgid / NXCD; wgid = (xcd < r ? xcd * (q + 1) : r * (q + 1) + (xcd - r) * q) + off; }
        const int nig = WGM * nN, gid = wgid / nig, fm = gid * WGM, gsz = (nM - fm) < WGM ? (nM - fm) : WGM;
        u.pm = fm + ((wgid % nig) % gsz); u.pn = (wgid % nig) / gsz; return true;
    }
    __device__ __forceinline__ void a_ready(const Unit&) const {}
    __device__ __forceinline__ void done(const Unit&) const {}
};


template <class Epi, class Sched, bool ALIGN_EPI = false, bool SP2 = false>
__device__ __forceinline__ void gemm_phase(PG8_LAS unsigned char* lds, const Gemm g, const Sched& S, const Epi& E, const int tid_in) {
    const int tid = tid_in, wid = __builtin_amdgcn_readfirstlane(tid >> 6), lane = tid & 63, wr = wid >> 2, wc = wid & 3, fr = lane & 15, fq = lane >> 4;
    const int K = g.K, nt = K / BK;
    unsigned voffA[2], voffB[2];
#pragma unroll
    for (int i = 0; i < 2; ++i) { int R, C; stage_rc(tid * 16 + i * 8192, R, C); const int Rb = Epi::PERM ? ((R & ~31) + perm32(R & 31)) : R;
        voffA[i] = (unsigned)(R * K + C) * 2u; voffB[i] = (unsigned)(Rb * K + C) * 2u; }
    const size_t kstep = (size_t)(BK * 2);
    const size_t hstep = (size_t)HALF * K * 2;
    const size_t tstep = 2 * hstep;
    const unsigned ldsw = (unsigned)wid * 1024u;
    const int aoff = lds_byte(wr * 64 + fr, fq * 8), boff = lds_byte(wc * 32 + fr, fq * 8);
#define PG8_SA(b, h) (((b) * 2 + (h)) * HTB)
#define PG8_SB(b, h) ((4 + (b) * 2 + (h)) * HTB)
#define PG8_STAGE(bufoff, gbase, voff) do { _Pragma("unroll") for (int _i = 0; _i < 2; ++_i) \
        __builtin_amdgcn_global_load_lds((const unsigned*)((const char*)(gbase) + (voff)[_i]), (PG8_LAS unsigned*)(lds + (bufoff) + ldsw + _i * 8192), 16, 0, 0); } while (0)
#define PG8_LDA(dst, b, h) do { _Pragma("unroll") for (int m = 0; m < 4; ++m) _Pragma("unroll") for (int k = 0; k < 2; ++k) dst[m][k] = *(const PG8_LAS bf16x8*)(lds + PG8_SA(b, h) + aoff + m * 2048 + k * 1024); } while (0)
#define PG8_LDB(dst, b, h) do { _Pragma("unroll") for (int n = 0; n < 2; ++n) _Pragma("unroll") for (int k = 0; k < 2; ++k) dst[n][k] = *(const PG8_LAS bf16x8*)(lds + PG8_SB(b, h) + boff + n * 2048 + k * 1024); } while (0)
#define PG8_MMA(ai, bj, At, Bt) do { __builtin_amdgcn_s_setprio(1); _Pragma("unroll") for (int m = 0; m < 4; ++m) _Pragma("unroll") for (int n = 0; n < 2; ++n) _Pragma("unroll") for (int k = 0; k < 2; ++k) \
        acc[ai][bj][m][n] = __builtin_amdgcn_mfma_f32_16x16x32_bf16(Bt[n][k], At[m][k], acc[ai][bj][m][n], 0, 0, 0); __builtin_amdgcn_s_setprio(0); } while (0)
#define PG8_WAIT_V(n) asm volatile("s_waitcnt vmcnt(" #n ")" ::: "memory")
#define PG8_WAIT_L(n) asm volatile("s_waitcnt lgkmcnt(" #n ")" ::: "memory")
#define PG8_BAR __builtin_amdgcn_s_barrier()
#define PG8_SCHED __builtin_amdgcn_sched_barrier(0)
    Unit cur, nxt; int ui = 0;
    if (!S.next(0, cur)) return;
    f32x4 acc[2][2][4][2];
#pragma unroll
    for (int a = 0; a < 2; ++a)
#pragma unroll
        for (int b = 0; b < 2; ++b)
#pragma unroll
            for (int m = 0; m < 4; ++m)
#pragma unroll
                for (int n = 0; n < 2; ++n) acc[a][b][m][n] = (f32x4){0.f, 0.f, 0.f, 0.f};
    bf16x8 At[4][2], B0[2][2], B1[2][2];
    const char* cA = (const char*)g.A + (size_t)cur.pm * tstep; const char* cB = (const char*)g.Bt + (size_t)cur.pn * tstep;
    S.a_ready(cur);
    if constexpr (SP2) {
        PG8_STAGE(PG8_SB(0, 0), cB, voffB); PG8_STAGE(PG8_SB(0, 1), cB + hstep, voffB); PG8_STAGE(PG8_SA(0, 0), cA, voffA); PG8_STAGE(PG8_SA(0, 1), cA + hstep, voffA);
        if (wr == 1) PG8_BAR;
        PG8_WAIT_V(2); PG8_BAR;
        PG8_STAGE(PG8_SB(1, 0), cB + kstep, voffB); PG8_STAGE(PG8_SA(1, 0), cA + kstep, voffA); PG8_STAGE(PG8_SB(1, 1), cB + hstep + kstep, voffB);
        PG8_WAIT_V(6); PG8_BAR;
    } else {
        PG8_STAGE(PG8_SB(0, 0), cB, voffB); PG8_STAGE(PG8_SA(0, 0), cA, voffA); PG8_STAGE(PG8_SB(0, 1), cB + hstep, voffB); PG8_STAGE(PG8_SA(0, 1), cA + hstep, voffA);
        if (wr == 1) PG8_BAR;
        PG8_WAIT_V(4); PG8_BAR;
        PG8_STAGE(PG8_SB(1, 0), cB + kstep, voffB); PG8_STAGE(PG8_SA(1, 0), cA + kstep, voffA); PG8_STAGE(PG8_SB(1, 1), cB + hstep + kstep, voffB);
        PG8_WAIT_V(6); PG8_BAR;
    }
    for (;;) {
        const bool has_next = S.next(ui + 1, nxt);
        const char* nA = has_next ? (const char*)g.A + (size_t)nxt.pm * tstep : cA; const char* nB = has_next ? (const char*)g.Bt + (size_t)nxt.pn * tstep : cB;
        for (int t = 0; t < nt; t += 2) {
            const bool last = (t == nt - 2);
            const char* a1 = cA + (size_t)(t + 1) * kstep;
            const char* a2 = last ? nA : cA + (size_t)(t + 2) * kstep; const char* b2 = last ? nB : cB + (size_t)(t + 2) * kstep;
            const char* a3 = a2 + kstep; const char* b3 = b2 + kstep;
            if (last && has_next) S.a_ready(nxt);
            if constexpr (SP2) {
            PG8_LDB(B0, 0, 0); PG8_LDB(B1, 0, 1); PG8_SCHED; PG8_LDA(At, 0, 0); PG8_STAGE(PG8_SA(1, 1), a1 + hstep, voffA);
            PG8_WAIT_V(8); PG8_WAIT_L(0); PG8_BAR; PG8_MMA(0, 0, At, B0); PG8_MMA(0, 1, At, B1); PG8_BAR; PG8_SCHED;
            PG8_LDA(At, 0, 1); PG8_STAGE(PG8_SB(0, 0), b2, voffB); PG8_STAGE(PG8_SB(0, 1), b2 + hstep, voffB); PG8_STAGE(PG8_SA(0, 0), a2, voffA);
            PG8_WAIT_V(8); PG8_WAIT_L(0); PG8_BAR; PG8_MMA(1, 0, At, B0); PG8_MMA(1, 1, At, B1); PG8_BAR; PG8_SCHED;
            PG8_LDB(B0, 1, 0); PG8_LDB(B1, 1, 1); PG8_SCHED; PG8_LDA(At, 1, 0); PG8_STAGE(PG8_SA(0, 1), a2 + hstep, voffA);
            PG8_WAIT_V(8); PG8_WAIT_L(0); PG8_BAR; PG8_MMA(0, 0, At, B0); PG8_MMA(0, 1, At, B1); PG8_BAR; PG8_SCHED;
            PG8_LDA(At, 1, 1); PG8_STAGE(PG8_SB(1, 0), b3, voffB); PG8_STAGE(PG8_SB(1, 1), b3 + hstep, voffB); PG8_STAGE(PG8_SA(1, 0), a3, voffA);
            PG8_WAIT_V(8); PG8_WAIT_L(0); PG8_BAR; PG8_MMA(1, 0, At, B0); PG8_MMA(1, 1, At, B1); PG8_BAR; PG8_SCHED;
            } else {
            PG8_LDB(B0, 0, 0); PG8_SCHED; PG8_LDA(At, 0, 0); PG8_STAGE(PG8_SA(1, 1), a1 + hstep, voffA);
            PG8_WAIT_L(8); PG8_BAR; PG8_WAIT_L(0); PG8_MMA(0, 0, At, B0); PG8_BAR; PG8_SCHED;
            PG8_LDB(B1, 0, 1); PG8_STAGE(PG8_SB(0, 0), b2, voffB);
            PG8_BAR; PG8_WAIT_L(0); PG8_MMA(0, 1, At, B1); PG8_BAR;
            PG8_LDA(At, 0, 1); PG8_STAGE(PG8_SA(0, 0), a2, voffA);
            PG8_BAR; PG8_WAIT_L(0); PG8_MMA(1, 0, At, B0); PG8_BAR; PG8_SCHED;
            PG8_STAGE(PG8_SB(0, 1), b2 + hstep, voffB);
            PG8_WAIT_V(6); PG8_BAR; PG8_MMA(1, 1, At, B1); PG8_BAR;
            PG8_LDB(B0, 1, 0); PG8_SCHED; PG8_LDA(At, 1, 0); PG8_STAGE(PG8_SA(0, 1), a2 + hstep, voffA);
            PG8_WAIT_L(8); PG8_BAR; PG8_WAIT_L(0); PG8_MMA(0, 0, At, B0); PG8_BAR; PG8_SCHED;
            PG8_LDB(B1, 1, 1); PG8_STAGE(PG8_SB(1, 0), b3, voffB);
            PG8_BAR; PG8_WAIT_L(0); PG8_MMA(0, 1, At, B1); PG8_BAR;
            PG8_LDA(At, 1, 1); PG8_STAGE(PG8_SA(1, 0), a3, voffA);
            PG8_BAR; PG8_WAIT_L(0); PG8_MMA(1, 0, At, B0); PG8_BAR; PG8_SCHED;
            PG8_STAGE(PG8_SB(1, 1), b3 + hstep, voffB);
            PG8_WAIT_V(6); PG8_BAR; PG8_MMA(1, 1, At, B1); PG8_BAR;
            }
        }
        if constexpr (ALIGN_EPI) { if (wr == 0) PG8_BAR; }
        if constexpr (!Epi::AFTER_DRAIN) { E(acc, cur, wr, wc, fr, fq); S.done(cur); }
        if (!has_next) break;
#pragma unroll
        for (int a = 0; a < 2; ++a)
#pragma unroll
            for (int b = 0; b < 2; ++b)
#pragma unroll
                for (int m = 0; m < 4; ++m)
#pragma unroll
                    for (int n = 0; n < 2; ++n) acc[a][b][m][n] = (f32x4){0.f, 0.f, 0.f, 0.f};
        cur = nxt; cA = nA; cB = nB; ++ui;
        if constexpr (ALIGN_EPI) { if (wr == 1) PG8_BAR; }
    }
    PG8_WAIT_V(0);
    if constexpr (!ALIGN_EPI) { if (wr == 0) PG8_BAR; }
    PG8_BAR;
    if constexpr (Epi::AFTER_DRAIN) { E.fused(acc, cur, wr, wc, fr, fq, lds, wid, lane); S.done(cur); }
#undef PG8_SA
#undef PG8_SB
#undef PG8_STAGE
#undef PG8_LDA
#undef PG8_LDB
#undef PG8_MMA
#undef PG8_WAIT_V
#undef PG8_WAIT_L
#undef PG8_BAR
#undef PG8_SCHED
}
}

using pg8::Unit;
struct DenseSched { int nN, n, G, c;
    __device__ __forceinline__ void a_ready(const Unit&) const {}
    __device__ __forceinline__ void done(const Unit&) const {}
    __device__ __forceinline__ bool next(int i, Unit& u) const { const int L = i * G + c; if (L >= n) return false; u.pm = L / nN; u.pn = L % nN; return true; } };

__device__ __forceinline__ void store8bf(bf16* p, f32x4 lo, f32x4 hi) { u32x4 w; w.x = pk2(lo[0], lo[1]); w.y = pk2(lo[2], lo[3]); w.z = pk2(hi[0], hi[1]); w.w = pk2(hi[2], hi[3]); *(u32x4*)p = w; }
__device__ __forceinline__ void load8bf(const bf16* p, f32x4& lo, f32x4& hi) { const u32x4 w = *(const u32x4*)p;
    lo[0] = __uint_as_float(w.x << 16); lo[1] = __uint_as_float(w.x & 0xffff0000u); lo[2] = __uint_as_float(w.y << 16); lo[3] = __uint_as_float(w.y & 0xffff0000u);
    hi[0] = __uint_as_float(w.z << 16); hi[1] = __uint_as_float(w.z & 0xffff0000u); hi[2] = __uint_as_float(w.w << 16); hi[3] = __uint_as_float(w.w & 0xffff0000u); }
struct EpiZ { bf16 *ZR, *ZS, *ZG;
    __device__ __forceinline__ void one(int row, int col, f32x4 lo, f32x4 hi) const {
        if (col < RC) store8bf(ZR + (size_t)row * RC + col, lo, hi);
        else if (col < RC + 1024) { for (int e = 0; e < 4; ++e) { lo[e] = gelu_tanh(lo[e]); hi[e] = gelu_tanh(hi[e]); } store8bf(ZS + (size_t)row * 1024 + (col - RC), lo, hi); }
        else { for (int e = 0; e < 4; ++e) { lo[e] = sigmoidf_(lo[e]); hi[e] = sigmoidf_(hi[e]); } store8bf(ZG + (size_t)row * 2048 + (col - RC - 1024), lo, hi); } }
    __device__ __forceinline__ void operator()(int row, int col, f32x4 a0, f32x4 a1, f32x4 b0, f32x4 b1) const { one(row, col, a0, a1); one(row, col + 128, b0, b1); } };
struct EpiGA { const bf16* ZG; bf16* MP;
    __device__ __forceinline__ void one(int row, int col, f32x4 lo, f32x4 hi) const { f32x4 g0, g1; load8bf(ZG + (size_t)row * 2048 + col, g0, g1); store8bf(MP + (size_t)row * D + col, g0 * lo, g1 * hi); }
    __device__ __forceinline__ void operator()(int row, int col, f32x4 a0, f32x4 a1, f32x4 b0, f32x4 b1) const { one(row, col, a0, a1); one(row, col + 128, b0, b1); } };
struct EpiGB { const bf16* ZG; const bf16* MPin; bf16* MP;
    __device__ __forceinline__ void one(int row, int col, f32x4 lo, f32x4 hi) const { f32x4 g0, g1, m0, m1; load8bf(ZG + (size_t)row * 2048 + 1024 + col, g0, g1); load8bf(MPin + (size_t)row * D + col, m0, m1);
        store8bf(MP + (size_t)row * D + col, m0 + g0 * lo, m1 + g1 * hi); }
    __device__ __forceinline__ void operator()(int row, int col, f32x4 a0, f32x4 a1, f32x4 b0, f32x4 b1) const { one(row, col, a0, a1); one(row, col + 128, b0, b1); } };
struct EpiOut { const float* xin; float* out; const float* gate1;
    __device__ __forceinline__ void one(int row, int col, f32x4 v) const { const f32x4 x = *(const f32x4*)(xin + (size_t)row * D + col); const f32x4 g = *(const f32x4*)(gate1 + col);
        *(f32x4*)(out + (size_t)row * D + col) = ALPHA * x + (1.0f + g) * v; }
    __device__ __forceinline__ void operator()(int row, int col, f32x4 a0, f32x4 a1, f32x4 b0, f32x4 b1) const { one(row, col, a0); one(row, col + 4, a1); one(row, col + 128, b0); one(row, col + 132, b1); } };
struct EpiSwi { bf16* HID;
    __device__ __forceinline__ void operator()(int row, int col, f32x4 a0, f32x4 a1, f32x4 b0, f32x4 b1) const { const int ct = (col >> 8) & 3, cc = col & 127;
        f32x4 h0, h1; for (int e = 0; e < 4; ++e) { h0[e] = siluf_(a0[e]) * b0[e]; h1[e] = siluf_(a1[e]) * b1[e]; } store8bf(HID + (size_t)row * FF + ct * 128 + cc, h0, h1); } };
struct EpiDown { const int* S2T; const float* TOKW; bf16* Y;
    __device__ __forceinline__ void operator()(int row, int col, f32x4 a0, f32x4 a1, f32x4 b0, f32x4 b1) const { const int st = S2T[row]; if (st < 0) return; const float w = TOKW[st]; const int cc = col & 1023;
        store8bf(Y + (size_t)st * D + cc, w * a0, w * a1); store8bf(Y + (size_t)st * D + cc + 128, w * b0, w * b1); } };

struct MoeSched { int ts[17]; int G, c;
    __device__ __forceinline__ void a_ready(const Unit&) const {}
    __device__ __forceinline__ void done(const Unit&) const {}
    __device__ __forceinline__ void init(const unsigned* cnt, int G_, int c_) { G = G_; c = c_; int s = 0;
#pragma unroll
        for (int e = 0; e < 16; ++e) { ts[e] = s; s += ((int)cnt[e] + 255) >> 8; } ts[16] = s; }
    __device__ __forceinline__ bool next(int i, Unit& u) const { const int L = i * G + c; if (L >= 4 * ts[16]) return false; const int rt = L >> 2, ct = L & 3; int e = 0;
#pragma unroll
        for (int j = 1; j < 16; ++j) e += (rt >= ts[j]) ? 1 : 0;
        u.pm = rt; u.pn = e * 4 + ct; return true; } };

__device__ __forceinline__ void phase_prep_simple(ArgsR a, const Ctx& c, int l) {
    const bf16* ZR = (const bf16*)(a.ws + WS_ZR);
    const float* mu = a.in[I_MU] + l * RC; const float* w0 = a.in[I_W0] + l * W; const float* w2 = a.in[I_W2] + (size_t)l * 64 * W;
    const float* a0 = a.in[I_A0] + l * W; const float* a2 = a.in[I_A2] + (size_t)l * 64 * W; const float* g2 = a.in[I_G2] + (size_t)l * 128 * W;
    const float* k_k = a.in[I_KK] + l * W; const float* k_a = a.in[I_KA] + l * W;
    const float* vm0 = a.in[I_VM0]; const float* vm1 = a.in[I_VM1]; const float* vm2 = a.in[I_VM2];
    f16* R = (f16*)(a.ws + WS_R); f16* WM1 = (f16*)(a.ws + WS_WM1); f16* KP = (f16*)(a.ws + WS_KP); f16* AA = (f16*)(a.ws + WS_AA); f16* BB = (f16*)(a.ws + WS_BB); f16* V = (f16*)(a.ws + WS_V);
    bf16* G = (bf16*)(a.ws + WS_G); bf16* VF = (bf16*)(a.ws + WS_VF);
    const int lane = c.lane;
    for (int t = c.gw; t < T; t += c.ngw) {
        float z[28];
#pragma unroll
        for (int i = 0; i < 28; ++i) { const int col = lane + 64 * i; const float zc = bf2f(ZR[(size_t)t * RC + col]); const float zp = t > 0 ? bf2f(ZR[(size_t)(t - 1) * RC + col]) : 0.f; z[i] = zc + (zp - zc) * mu[col]; }
        const float tw = tanhf(z[24]), za = z[25], sg0 = sigmoidf_(z[26]), sg1 = sigmoidf_(z[27]);
        float wlo[8], alo[8], gg[8];
#pragma unroll
        for (int i = 0; i < 8; ++i) { wlo[i] = 0.f; alo[i] = 0.f; gg[i] = 0.f; }
        for (int j = 0; j < 64; ++j) { const float tj = __shfl(tw, j), aj = __shfl(za, j), s0 = __shfl(sg0, j), s1 = __shfl(sg1, j);
#pragma unroll
            for (int i = 0; i < 8; ++i) { const int n = lane + 64 * i; wlo[i] += tj * w2[j * W + n]; alo[i] += aj * a2[j * W + n]; gg[i] += s0 * g2[j * W + n] + s1 * g2[(64 + j) * W + n]; } }
        float vv[8];
#pragma unroll
        for (int i = 0; i < 8; ++i) vv[i] = z[16 + i];
        if (l == 0) {
#pragma unroll
            for (int i = 0; i < 8; ++i) VF[(size_t)t * W + lane + 64 * i] = f2bf(vv[i]);
        } else {
            float vmid = 0.f;
#pragma unroll
            for (int i = 0; i < 8; ++i)
                for (int j = 0; j < 64; ++j) { const float vc = __shfl(vv[i], j); vmid += vc * vm1[(size_t)(64 * i + j) * 32 + (lane & 31)]; }
            float vg[8];
#pragma unroll
            for (int i = 0; i < 8; ++i) vg[i] = 0.f;
            for (int m = 0; m < 32; ++m) { const float vmm = __shfl(vmid, m);
#pragma unroll
                for (int i = 0; i < 8; ++i) vg[i] += vmm * vm2[m * W + lane + 64 * i]; }
#pragma unroll
            for (int i = 0; i < 8; ++i) { const int n = lane + 64 * i; const float vf = bf2f(VF[(size_t)t * W + n]); vv[i] = vv[i] + (vf - vv[i]) * sigmoidf_(vm0[n] + vg[i]); }
        }
#pragma unroll
        for (int i = 0; i < 8; ++i) {
            const int n = lane + 64 * i; const size_t o = (size_t)t * W + n;
            const float x = w0[n] + wlo[i]; const float wl = -softplusf_(-x) - 0.5f; const float dm1 = expm1f(-__expf(wl));
            const float av = sigmoidf_(a0[n] + alo[i]);
            const float kraw = z[8 + i];
            float kk = kraw * k_k[n]; const float nrm = sqrtf(wave_sum(kk * kk)); kk = kk / fmaxf(nrm, 1e-12f);
            const float kp = kraw * (1.0f + (av - 1.0f) * k_a[n]);
            R[o] = (f16)z[i]; WM1[o] = (f16)dm1; KP[o] = (f16)kp; AA[o] = (f16)(-kk); BB[o] = (f16)(kk * av); V[o] = (f16)vv[i]; G[o] = f2bf(gg[i]);
        }
    }
}

__device__ __forceinline__ void phase_sg_simple(ArgsR a, const Ctx& c, int l) {
    const bf16* ZS = (const bf16*)(a.ws + WS_ZS); bf16* YB = (bf16*)(a.ws + WS_YB);
    const float* lng = a.in[I_SGG] + l * W; const float* lnb = a.in[I_SGB] + l * W;
    float* vn = (float*)c.lds;
    float* st = vn + 128 * 64;
    for (int uidx = blockIdx.x; uidx < 128 * 8; uidx += gridDim.x) {
        const int ch = uidx >> 3, g = uidx & 7; const int tok0 = ch * 128;
        for (int i = 0; i < 16; ++i) { const int s = c.wave * 16 + i; const bf16* p = ZS + (size_t)(tok0 + s) * 1024 + 512 + c.lane * 8;
            const f32x4 x0 = load4bf(p), x1 = load4bf(p + 4);
            float sm = (x0[0] + x0[1]) + (x0[2] + x0[3]) + (x1[0] + x1[1]) + (x1[2] + x1[3]); const float mean = wave_sum(sm) * (1.f / 512.f);
            float q = 0.f; for (int e = 0; e < 4; ++e) { const float d0 = x0[e] - mean, d1 = x1[e] - mean; q += d0 * d0 + d1 * d1; }
            const float rstd = __builtin_amdgcn_rsqf(wave_sum(q) * (1.f / 512.f) + LN_EPS);
            if (c.lane == 0) { st[2 * s] = mean; st[2 * s + 1] = rstd; } }
        __syncthreads();
        for (int i = c.tid; i < 128 * 64; i += NTHREADS) { const int s = i >> 6, d = i & 63; const float x = bf2f(ZS[(size_t)(tok0 + s) * 1024 + 512 + g * 64 + d]);
            vn[i] = (x - st[2 * s]) * st[2 * s + 1] * lng[g * 64 + d] + lnb[g * 64 + d]; }
        __syncthreads();
        const int d = c.tid & 63, tq = c.tid >> 6;
        const float* Wg = a.in[I_WS] + (size_t)(l * 8 + g) * 128 * 128; const float* bs = a.in[I_BS] + (size_t)(l * 8 + g) * 128;
        for (int i = 0; i < 16; ++i) { const int t = tq + 8 * i; float acc = 0.f;
            for (int s = 0; s <= t; ++s) acc += Wg[t * 128 + s] * vn[s * 64 + d];
            const float u = bf2f(ZS[(size_t)(tok0 + t) * 1024 + g * 64 + d]);
            YB[(size_t)(tok0 + t) * W + g * 64 + d] = f2bf(u * (acc + bs[t])); }
        __syncthreads();
    }
}

#define LAS3 __attribute__((address_space(3)))
typedef short bf16x8 __attribute__((ext_vector_type(8)));
template <int MT, int NT, int KS>
__device__ __forceinline__ void mma_lds_glob(const unsigned char* lds_base, int a_off_bytes, int lda, const bf16* Bt, int ldb, int n0, int lane, f32x4 (&acc)[MT][NT]) {
    const int fr = lane & 15, fq = lane >> 4;
    const LAS3 unsigned char* Ab = (const LAS3 unsigned char*)lds_base + a_off_bytes;
    int boff = (n0 + fr) * ldb + 8 * fq; asm volatile("" : "+v"(boff));
#pragma unroll
    for (int ks = 0; ks < KS; ++ks) {
        bf16x8 b[NT];
#pragma unroll
        for (int n = 0; n < NT; ++n) b[n] = *(const bf16x8*)(Bt + boff + 16 * n * ldb + 32 * ks);
#pragma unroll
        for (int m = 0; m < MT; ++m) { const bf16x8 av = *(const LAS3 bf16x8*)(Ab + ((16 * m + fr) * lda + 32 * ks + 8 * fq) * 2);
#pragma unroll
            for (int n = 0; n < NT; ++n) acc[m][n] = __builtin_amdgcn_mfma_f32_16x16x32_bf16(av, b[n], acc[m][n], 0, 0, 0); }
    }
}
__device__ __forceinline__ void zshift8(const bf16* ZR, int t, int col, const float* mu, float (&o)[8]) {
    const u32x4 zc = *(const u32x4*)(ZR + (size_t)t * RC + col);
    u32x4 zp = {0u, 0u, 0u, 0u}; if (t > 0) zp = *(const u32x4*)(ZR + (size_t)(t - 1) * RC + col);
    const f32x4 m0 = *(const f32x4*)(mu + col), m1 = *(const f32x4*)(mu + col + 4);
#pragma unroll
    for (int e = 0; e < 4; ++e) { const float c0 = __uint_as_float(zc[e] << 16), c1 = __uint_as_float(zc[e] & 0xffff0000u), p0 = __uint_as_float(zp[e] << 16), p1 = __uint_as_float(zp[e] & 0xffff0000u);
        const float mu0 = (2 * e < 4) ? m0[(2 * e) & 3] : m1[(2 * e) & 3], mu1 = (2 * e + 1 < 4) ? m0[(2 * e + 1) & 3] : m1[(2 * e + 1) & 3];
        o[2 * e] = c0 + (p0 - c0) * mu0; o[2 * e + 1] = c1 + (p1 - c1) * mu1; }
}
typedef _Float16 f16x8 __attribute__((ext_vector_type(8)));
__device__ __forceinline__ void store8f16(f16* p, const float (&v)[8]) { f16x8 h;
#pragma unroll
    for (int e = 0; e < 8; ++e) h[e] = (f16)v[e];
    *(f16x8*)p = h; }
__device__ __forceinline__ u32x4 pack8bf(const float (&v)[8]) { u32x4 w; w.x = pk2(v[0], v[1]); w.y = pk2(v[2], v[3]); w.z = pk2(v[4], v[5]); w.w = pk2(v[6], v[7]); return w; }


constexpr int PB_LD = 520;
constexpr int PB_BUF = 0, PB_AOP = 64 * PB_LD * 2, PB_VMID = 2 * 64 * PB_LD * 2, PB_LA_LD = 264, PB_VM_LD = 40;
__device__ __forceinline__ void phase_prep_fast(ArgsR a, const Ctx& c, int l) {
    const bf16* ZR = (const bf16*)(a.ws + WS_ZR);
    const float* mu = a.in[I_MU] + l * RC; const float* w0 = a.in[I_W0] + l * W; const float* a0 = a.in[I_A0] + l * W;
    const float* k_k = a.in[I_KK] + l * W; const float* k_a = a.in[I_KA] + l * W; const float* vm0 = a.in[I_VM0];
    f16* R = (f16*)(a.ws + WS_R); f16* WM1 = (f16*)(a.ws + WS_WM1); f16* KP = (f16*)(a.ws + WS_KP); f16* AA = (f16*)(a.ws + WS_AA); f16* BB = (f16*)(a.ws + WS_BB); f16* V = (f16*)(a.ws + WS_V);
    bf16* G = (bf16*)(a.ws + WS_G); bf16* VF = (bf16*)(a.ws + WS_VF);
    const unsigned char* lo = a.ws + WS_LORA + (size_t)l * LO_STRIDE;
    const bf16* W2T = (const bf16*)(lo + LO_W2T); const bf16* A2T = (const bf16*)(lo + LO_A2T); const bf16* G2T = (const bf16*)(lo + LO_G2T);
    const bf16* VM1T = (const bf16*)(lo + LO_VM1T); const bf16* VM2T = (const bf16*)(lo + LO_VM2T);
    LAS3 unsigned char* L = (LAS3 unsigned char*)c.lds;
    const int tid = c.tid, lane = c.lane, wv = c.wave, fr = lane & 15, fq = lane >> 4;
    const int row = tid >> 3, sub_ = tid & 7;
    for (int u = blockIdx.x; u < T / 64; u += gridDim.x) {
        int sub = sub_; asm volatile("" : "+v"(sub));
        const int t0 = u * 64, t = t0 + row;
        if (l == 0) {
#pragma unroll 4
            for (int p = 0; p < 8; ++p) { const int col = p * 64 + sub * 8; float z[8]; zshift8(ZR, t, 1024 + col, mu, z);
                store8f16(V + (size_t)t * W + col, z); *(u32x4*)(VF + (size_t)t * W + col) = pack8bf(z); }
        } else {
#pragma unroll 4
            for (int p = 0; p < 8; ++p) { const int col = p * 64 + sub * 8; float z[8]; zshift8(ZR, t, 1024 + col, mu, z);
                *(LAS3 u32x4*)(L + PB_AOP + (row * PB_LD + col) * 2) = pack8bf(z); }
            __syncthreads();
            { f32x4 acc[1][1]; acc[0][0] = (f32x4){0.f, 0.f, 0.f, 0.f}; const int m = wv >> 1, n = wv & 1;
              mma_lds_glob<1, 1, 16>(c.lds, PB_AOP + 16 * m * PB_LD * 2, PB_LD, VM1T, W, 16 * n, lane, acc);
#pragma unroll
              for (int i = 0; i < 4; ++i) *(LAS3 bf16*)(L + PB_VMID + ((16 * m + 4 * fq + i) * PB_VM_LD + 16 * n + fr) * 2) = f2bf(acc[0][0][i]); }
            __syncthreads();
            { f32x4 acc[4][4];
#pragma unroll
              for (int m = 0; m < 4; ++m)
#pragma unroll
                  for (int n = 0; n < 4; ++n) acc[m][n] = (f32x4){0.f, 0.f, 0.f, 0.f};
              mma_lds_glob<4, 4, 1>(c.lds, PB_VMID, PB_VM_LD, VM2T, 32, 64 * wv, lane, acc);
#pragma unroll
              for (int m = 0; m < 4; ++m)
#pragma unroll
                  for (int n = 0; n < 4; ++n) { const int col = 64 * wv + 16 * n + fr; const float vb = vm0[col];
#pragma unroll
                      for (int i = 0; i < 4; ++i) *(LAS3 f16*)(L + PB_BUF + ((16 * m + 4 * fq + i) * PB_LD + col) * 2) = (f16)sigmoidf_(vb + acc[m][n][i]); } }
            __syncthreads();
#pragma unroll 4
            for (int p = 0; p < 8; ++p) { const int col = p * 64 + sub * 8;
                const u32x4 vz = *(const LAS3 u32x4*)(L + PB_AOP + (row * PB_LD + col) * 2); const f16x8 gt = *(const LAS3 f16x8*)(L + PB_BUF + (row * PB_LD + col) * 2);
                const u32x4 vfw = *(const u32x4*)(VF + (size_t)t * W + col); float o[8];
#pragma unroll
                for (int e = 0; e < 4; ++e) { const float v0 = __uint_as_float(vz[e] << 16), v1 = __uint_as_float(vz[e] & 0xffff0000u), f0 = __uint_as_float(vfw[e] << 16), f1 = __uint_as_float(vfw[e] & 0xffff0000u);
                    o[2 * e] = v0 + (f0 - v0) * (float)gt[2 * e]; o[2 * e + 1] = v1 + (f1 - v1) * (float)gt[2 * e + 1]; }
                store8f16(V + (size_t)t * W + col, o); }
            __syncthreads();
        }
#pragma unroll 4
        for (int p = 0; p < 4; ++p) { const int cc = sub * 32 + p * 8; float z[8]; zshift8(ZR, t, 1536 + cc, mu, z);
#pragma unroll
            for (int e = 0; e < 8; ++e) z[e] = cc < 64 ? (1.0f - 2.0f * __builtin_amdgcn_rcpf(1.0f + __expf(2.0f * z[e]))) : (cc < 128 ? z[e] : sigmoidf_(z[e]));
            *(LAS3 u32x4*)(L + PB_AOP + (row * PB_LA_LD + cc) * 2) = pack8bf(z); }
        __syncthreads();
        { f32x4 acc[4][4];
#pragma unroll
          for (int m = 0; m < 4; ++m)
#pragma unroll
              for (int n = 0; n < 4; ++n) acc[m][n] = (f32x4){0.f, 0.f, 0.f, 0.f};
          mma_lds_glob<4, 4, 2>(c.lds, PB_AOP + 64 * 2, PB_LA_LD, A2T, 64, 64 * wv, lane, acc);
#pragma unroll
          for (int m = 0; m < 4; ++m)
#pragma unroll
              for (int n = 0; n < 4; ++n) { const int col = 64 * wv + 16 * n + fr; const float ab = a0[col];
#pragma unroll
                  for (int i = 0; i < 4; ++i) *(LAS3 f16*)(L + PB_BUF + ((16 * m + 4 * fq + i) * PB_LD + col) * 2) = (f16)sigmoidf_(ab + acc[m][n][i]); } }
        __syncthreads();
#pragma unroll 4
        for (int p = 0; p < 8; ++p) { const int col = p * 64 + sub * 8; const size_t o = (size_t)t * W + col;
            float z[8]; zshift8(ZR, t, col, mu, z); store8f16(R + o, z);
            float kz[8]; zshift8(ZR, t, 512 + col, mu, kz);
            const f16x8 av = *(const LAS3 f16x8*)(L + PB_BUF + (row * PB_LD + col) * 2);
            const f32x4 kk0 = *(const f32x4*)(k_k + col), kk1 = *(const f32x4*)(k_k + col + 4), ka0 = *(const f32x4*)(k_a + col), ka1 = *(const f32x4*)(k_a + col + 4);
            float kk[8], kp[8], bb[8]; float ss = 0.f;
#pragma unroll
            for (int e = 0; e < 8; ++e) { const float kkw = e < 4 ? kk0[e & 3] : kk1[e & 3], kaw = e < 4 ? ka0[e & 3] : ka1[e & 3]; kk[e] = kz[e] * kkw; ss += kk[e] * kk[e]; kp[e] = kz[e] * (1.0f + ((float)av[e] - 1.0f) * kaw); }
            ss += __shfl_xor(ss, 1); ss += __shfl_xor(ss, 2); ss += __shfl_xor(ss, 4);
            const float inv = fminf(__builtin_amdgcn_rsqf(ss), 1e12f);
#pragma unroll
            for (int e = 0; e < 8; ++e) { kk[e] *= inv; bb[e] = kk[e] * (float)av[e]; kk[e] = -kk[e]; }
            store8f16(KP + o, kp); store8f16(AA + o, kk); store8f16(BB + o, bb); }
        __syncthreads();
        { f32x4 acc[4][4];
#pragma unroll
          for (int m = 0; m < 4; ++m)
#pragma unroll
              for (int n = 0; n < 4; ++n) acc[m][n] = (f32x4){0.f, 0.f, 0.f, 0.f};
          mma_lds_glob<4, 4, 2>(c.lds, PB_AOP, PB_LA_LD, W2T, 64, 64 * wv, lane, acc);
#pragma unroll
          for (int m = 0; m < 4; ++m)
#pragma unroll
              for (int n = 0; n < 4; ++n) { const int col = 64 * wv + 16 * n + fr; const float wb = w0[col];
#pragma unroll
                  for (int i = 0; i < 4; ++i) { const float x = wb + acc[m][n][i]; const float wl = -(fmaxf(-x, 0.f) + __logf(1.0f + __expf(-fabsf(x)))) - 0.5f;
                      *(LAS3 f16*)(L + PB_BUF + ((16 * m + 4 * fq + i) * PB_LD + col) * 2) = (f16)(__expf(-__expf(wl)) - 1.0f); } } }
        __syncthreads();
#pragma unroll 4
        for (int p = 0; p < 8; ++p) { const int col = p * 64 + sub * 8; *(u32x4*)(WM1 + (size_t)t * W + col) = *(const LAS3 u32x4*)(L + PB_BUF + (row * PB_LD + col) * 2); }
        __syncthreads();
        { f32x4 acc[4][4];
#pragma unroll
          for (int m = 0; m < 4; ++m)
#pragma unroll
              for (int n = 0; n < 4; ++n) acc[m][n] = (f32x4){0.f, 0.f, 0.f, 0.f};
          mma_lds_glob<4, 4, 4>(c.lds, PB_AOP + 128 * 2, PB_LA_LD, G2T, 128, 64 * wv, lane, acc);
#pragma unroll
          for (int m = 0; m < 4; ++m)
#pragma unroll
              for (int n = 0; n < 4; ++n) { const int col = 64 * wv + 16 * n + fr;
#pragma unroll
                  for (int i = 0; i < 4; ++i) *(LAS3 bf16*)(L + PB_BUF + ((16 * m + 4 * fq + i) * PB_LD + col) * 2) = f2bf(acc[m][n][i]); } }
        __syncthreads();
#pragma unroll 4
        for (int p = 0; p < 8; ++p) { const int col = p * 64 + sub * 8; *(u32x4*)(G + (size_t)t * W + col) = *(const LAS3 u32x4*)(L + PB_BUF + (row * PB_LD + col) * 2); }
        __syncthreads();
    }
}

constexpr int SG_LD = 136;
constexpr int SG_VT = 0, SG_ST = 256 * SG_LD * 2;
__device__ __forceinline__ void phase_sg_fast(ArgsR a, const Ctx& c, int l) {
    const bf16* ZS = (const bf16*)(a.ws + WS_ZS); bf16* YB = (bf16*)(a.ws + WS_YB);
    const float* lng = a.in[I_SGG] + l * W; const float* lnb = a.in[I_SGB] + l * W;
    LAS3 unsigned char* L = (LAS3 unsigned char*)c.lds;
    LAS3 float* st = (LAS3 float*)(L + SG_ST);
    const int tid = c.tid, lane = c.lane, wv = c.wave, fr = lane & 15, fq = lane >> 4;
    for (int u = blockIdx.x; u < 256; u += gridDim.x) {
        const int ch = u >> 1, hf = u & 1, tok0 = ch * 128;
        for (int i = 0; i < 16; ++i) { const int sidx = wv * 16 + i; const bf16* p = ZS + (size_t)(tok0 + sidx) * 1024 + 512 + lane * 8;
            const f32x4 x0 = load4bf(p), x1 = load4bf(p + 4);
            const float sm = (x0[0] + x0[1]) + (x0[2] + x0[3]) + (x1[0] + x1[1]) + (x1[2] + x1[3]); const float mean = wave_sum(sm) * (1.f / 512.f);
            float q = 0.f;
#pragma unroll
            for (int e = 0; e < 4; ++e) { const float d0 = x0[e] - mean, d1 = x1[e] - mean; q += d0 * d0 + d1 * d1; }
            const float rstd = __builtin_amdgcn_rsqf(wave_sum(q) * (1.f / 512.f) + LN_EPS);
            if (lane == 0) { st[2 * sidx] = mean; st[2 * sidx + 1] = rstd; } }
        __syncthreads();
        { const int sidx = tid >> 2, q4 = tid & 3; const float mean = st[2 * sidx], rstd = st[2 * sidx + 1];
#pragma unroll
          for (int p = 0; p < 8; ++p) { const int cl = q4 * 64 + p * 8; const int cg = hf * 256 + cl;
              const bf16* src = ZS + (size_t)(tok0 + sidx) * 1024 + 512 + cg; const f32x4 x0 = load4bf(src), x1 = load4bf(src + 4);
              const f32x4 g0 = *(const f32x4*)(lng + cg), g1 = *(const f32x4*)(lng + cg + 4), b0 = *(const f32x4*)(lnb + cg), b1 = *(const f32x4*)(lnb + cg + 4);
#pragma unroll
              for (int e = 0; e < 8; ++e) { const float x = e < 4 ? x0[e & 3] : x1[e & 3], gg = e < 4 ? g0[e & 3] : g1[e & 3], bb = e < 4 ? b0[e & 3] : b1[e & 3];
                  *(LAS3 bf16*)(L + SG_VT + ((cl + e) * SG_LD + sidx) * 2) = f2bf((x - mean) * rstd * gg + bb); } } }
        __syncthreads();
        const int gl = wv >> 1, dh = wv & 1, g = hf * 4 + gl;
        const float* Wg = a.in[I_WS] + (size_t)(l * 8 + g) * 128 * 128; const float* bs = a.in[I_BS] + (size_t)(l * 8 + g) * 128;
        f32x4 acc[8][2];
#pragma unroll
        for (int m = 0; m < 8; ++m) { acc[m][0] = (f32x4){0.f, 0.f, 0.f, 0.f}; acc[m][1] = (f32x4){0.f, 0.f, 0.f, 0.f}; }
#pragma unroll
        for (int ks = 0; ks < 4; ++ks) {
            bf16x8 b[2];
#pragma unroll
            for (int n = 0; n < 2; ++n) b[n] = *(const LAS3 bf16x8*)(L + SG_VT + ((gl * 64 + dh * 32 + 16 * n + fr) * SG_LD + 32 * ks + 8 * fq) * 2);
#pragma unroll
            for (int m = 0; m < 8; ++m) { if (32 * ks <= 16 * m + 15) {
                const int trow = 16 * m + fr, s0 = 32 * ks + 8 * fq;
                const f32x4 w0v = *(const f32x4*)(Wg + trow * 128 + s0), w1v = *(const f32x4*)(Wg + trow * 128 + s0 + 4);
                float wf[8];
#pragma unroll
                for (int e = 0; e < 8; ++e) { const float wval = e < 4 ? w0v[e & 3] : w1v[e & 3]; wf[e] = (s0 + e <= trow) ? wval : 0.f; }
                const u32x4 wp = pack8bf(wf); const bf16x8 av = __builtin_bit_cast(bf16x8, wp);
                acc[m][0] = __builtin_amdgcn_mfma_f32_16x16x32_bf16(av, b[0], acc[m][0], 0, 0, 0);
                acc[m][1] = __builtin_amdgcn_mfma_f32_16x16x32_bf16(av, b[1], acc[m][1], 0, 0, 0); } }
        }
#pragma unroll
        for (int m = 0; m < 8; ++m)
#pragma unroll
            for (int i = 0; i < 4; ++i) { const int trow = 16 * m + 4 * fq + i; const float bsv = bs[trow];
#pragma unroll
                for (int n = 0; n < 2; ++n) { const int col = g * 64 + dh * 32 + 16 * n + fr; const float uu = bf2f(ZS[(size_t)(tok0 + trow) * 1024 + col]);
                    YB[(size_t)(tok0 + trow) * W + col] = f2bf(uu * (acc[m][n][i] + bsv)); } }
        __syncthreads();
    }
}

__device__ __forceinline__ void phase_scan_simple(ArgsR a, const Ctx& c) {
    if (c.wave != 0 || blockIdx.x >= NH) return;
    const int h = blockIdx.x, lane = c.lane;
    const f16* R = (const f16*)(a.ws + WS_R); const f16* WM1 = (const f16*)(a.ws + WS_WM1); const f16* KP = (const f16*)(a.ws + WS_KP);
    const f16* AA = (const f16*)(a.ws + WS_AA); const f16* BB = (const f16*)(a.ws + WS_BB); const f16* V = (const f16*)(a.ws + WS_V);
    bf16* YSC = (bf16*)(a.ws + WS_YSC);
    float S[64];
#pragma unroll
    for (int j = 0; j < 64; ++j) S[j] = 0.f;
    for (int t = 0; t < T; ++t) {
        const size_t base = (size_t)t * W + h * 64;
        const float vv = (float)V[base + lane];
        float sa = 0.f;
#pragma unroll
        for (int j = 0; j < 64; ++j) sa += S[j] * (float)AA[base + j];
        float y = 0.f;
#pragma unroll
        for (int j = 0; j < 64; ++j) { float s = S[j]; s = s + s * (float)WM1[base + j]; s += sa * (float)BB[base + j]; s += vv * (float)KP[base + j]; S[j] = s; y += s * (float)R[base + j]; }
        YSC[base + lane] = f2bf(y);
    }
}

typedef unsigned u32x16 __attribute__((ext_vector_type(16)));
__device__ __forceinline__ void sload32(const void* p0, u32x16& a0, u32x16& a1) {
    asm volatile("s_load_dwordx16 %0, %2, 0x0 glc\n\ts_load_dwordx16 %1, %2, 0x40 glc\n\ts_waitcnt lgkmcnt(0)" : "=&s"(a0), "=&s"(a1) : "s"(p0) : "memory");
}
__device__ __forceinline__ void sload64(const void* p0, const void* p1, u32x16& a0, u32x16& a1, u32x16& b0, u32x16& b1) {
    asm volatile("s_load_dwordx16 %0, %4, 0x0 glc\n\ts_load_dwordx16 %1, %4, 0x40 glc\n\ts_load_dwordx16 %2, %5, 0x0 glc\n\ts_load_dwordx16 %3, %5, 0x40 glc\n\ts_waitcnt lgkmcnt(0)"
                 : "=&s"(a0), "=&s"(a1), "=&s"(b0), "=&s"(b1) : "s"(p0), "s"(p1) : "memory");
}
__device__ __forceinline__ float fmix_lo(unsigned sd, float x, float y) { float d; asm("v_fma_mix_f32 %0, %1, %2, %3 op_sel_hi:[1,0,0]" : "=v"(d) : "s"(sd), "v"(x), "v"(y)); return d; }
__device__ __forceinline__ float fmix_hi(unsigned sd, float x, float y) { float d; asm("v_fma_mix_f32 %0, %1, %2, %3 op_sel:[1,0,0] op_sel_hi:[1,0,0]" : "=v"(d) : "s"(sd), "v"(x), "v"(y)); return d; }
constexpr int CL = 64, NCH = T / CL;
constexpr size_t ST_Q_OFF = (size_t)NH * NCH * 64 * 64;
constexpr size_t ST_S_OFF = (size_t)NH * NCH * 64 * 64;

__device__ __forceinline__ float vmix_lo(unsigned vd, float x, float y) { float d; asm("v_fma_mix_f32 %0, %1, %2, %3 op_sel_hi:[1,0,0]" : "=v"(d) : "v"(vd), "v"(x), "v"(y)); return d; }
__device__ __forceinline__ float vmix_hi(unsigned vd, float x, float y) { float d; asm("v_fma_mix_f32 %0, %1, %2, %3 op_sel:[1,0,0] op_sel_hi:[1,0,0]" : "=v"(d) : "v"(vd), "v"(x), "v"(y)); return d; }
template <int N> __device__ __forceinline__ void fmac_bc(float& acc, float vec, float x) { asm("v_fmac_f32_dpp %0, %1, %2 row_newbcast:%3 row_mask:0xf bank_mask:0xf" : "+v"(acc) : "v"(vec), "v"(x), "n"(N)); }
template <int N> __device__ __forceinline__ float mul_bc(float vec, float x) { float d; asm("v_mul_f32_dpp %0, %1, %2 row_newbcast:%3 row_mask:0xf bank_mask:0xf" : "=v"(d) : "v"(vec), "v"(x), "n"(N)); return d; }
typedef _Float16 f16x4 __attribute__((ext_vector_type(4)));
struct SVec { float v[4]; };
__device__ __forceinline__ f16x4 sv_read(const LAS3 unsigned char* p, int lane) { return *(const LAS3 f16x4*)(p + (lane & 15) * 8); }
__device__ __forceinline__ void sv_cvt(SVec& o, f16x4 h) { o.v[0] = (float)h[0]; o.v[1] = (float)h[1]; o.v[2] = (float)h[2]; o.v[3] = (float)h[3]; }
__device__ __forceinline__ void sv_cvt1p(SVec& o, f16x4 h) { o.v[0] = 1.0f + (float)h[0]; o.v[1] = 1.0f + (float)h[1]; o.v[2] = 1.0f + (float)h[2]; o.v[3] = 1.0f + (float)h[3]; }
template <int J> __device__ __forceinline__ void sc_dot(float (&d)[4], const SVec& A, const float (&X)[64]) { fmac_bc<(J >> 2)>(d[J & 3], A.v[J & 3], X[J]); if constexpr (J + 1 < 64) sc_dot<J + 1>(d, A, X); }
template <int J> __device__ __forceinline__ void sc_upd3(float (&S)[64], float (&y)[4], const SVec& Wv, const SVec& Bv, const SVec& Kv, const SVec& Rv, float sa, float vv) {
    float sj = mul_bc<(J >> 2)>(Wv.v[J & 3], S[J]); fmac_bc<(J >> 2)>(sj, Bv.v[J & 3], sa); fmac_bc<(J >> 2)>(sj, Kv.v[J & 3], vv); S[J] = sj; fmac_bc<(J >> 2)>(y[J & 3], Rv.v[J & 3], sj);
    if constexpr (J + 1 < 64) sc_upd3<J + 1>(S, y, Wv, Bv, Kv, Rv, sa, vv); }
template <int J> __device__ __forceinline__ void sc_upd1(float (&Q)[64], float (&P)[64], const SVec& Wv, const SVec& Bv, const SVec& Kv, float saq, float sap, float vv) {
    float qj = mul_bc<(J >> 2)>(Wv.v[J & 3], Q[J]); fmac_bc<(J >> 2)>(qj, Bv.v[J & 3], saq); fmac_bc<(J >> 2)>(qj, Kv.v[J & 3], vv); Q[J] = qj;
    float pj = mul_bc<(J >> 2)>(Wv.v[J & 3], P[J]); fmac_bc<(J >> 2)>(pj, Bv.v[J & 3], sap); P[J] = pj;
    if constexpr (J + 1 < 64) sc_upd1<J + 1>(Q, P, Wv, Bv, Kv, saq, sap, vv); }
constexpr int SCB = 8;
constexpr int SC_NS = 7, SC_BUF = SC_NS * 1024, SC_WAVE = 2 * SC_BUF;
__device__ __forceinline__ void sc_dma(const f16* X, size_t eoff, LAS3 unsigned char* dst) {
    __builtin_amdgcn_global_load_lds((const unsigned*)(X + eoff), (LAS3 unsigned*)dst, 16, 0, 0);
}

__device__ __forceinline__ void phase_scan1(ArgsR a, const Ctx& c) {
    const f16* WM1 = (const f16*)(a.ws + WS_WM1); const f16* KP = (const f16*)(a.ws + WS_KP);
    const f16* AA = (const f16*)(a.ws + WS_AA); const f16* BB = (const f16*)(a.ws + WS_BB); const f16* V = (const f16*)(a.ws + WS_V);
    float* ST = (float*)(a.ws + WS_ST);
    const int lane = c.lane;
    LAS3 unsigned char* ring = (LAS3 unsigned char*)c.lds + c.wave * SC_WAVE;
    for (int item = c.gw; item < NH * NCH; item += c.ngw) {
        const int h = __builtin_amdgcn_readfirstlane(item / NCH), ch = __builtin_amdgcn_readfirstlane(item % NCH);
        float Q[64], P[64];
        int ln_ = lane; asm volatile("" : "+v"(ln_));
#pragma unroll
        for (int j = 0; j < 64; ++j) { Q[j] = 0.f; P[j] = (j == ln_) ? 1.f : 0.f; }
        const size_t lane_off = (size_t)(lane >> 3) * W + h * 64 + (lane & 7) * 8;
        { const size_t e0 = (size_t)(ch * CL) * W + lane_off;
          sc_dma(AA, e0, ring); sc_dma(WM1, e0, ring + 1024); sc_dma(BB, e0, ring + 2048); sc_dma(KP, e0, ring + 3072); sc_dma(V, e0, ring + 4096); }
#pragma unroll 1
        for (int blk = 0; blk < CL / SCB; ++blk) {
            LAS3 unsigned char* buf = ring + (blk & 1) * SC_BUF;
            if (blk + 1 < CL / SCB) { LAS3 unsigned char* nb = ring + ((blk + 1) & 1) * SC_BUF; const size_t e0 = (size_t)(ch * CL + (blk + 1) * SCB) * W + lane_off;
                sc_dma(AA, e0, nb); sc_dma(WM1, e0, nb + 1024); sc_dma(BB, e0, nb + 2048); sc_dma(KP, e0, nb + 3072); sc_dma(V, e0, nb + 4096);
                asm volatile("s_waitcnt vmcnt(5)" ::: "memory"); }
            else asm volatile("s_waitcnt vmcnt(0)" ::: "memory");
            SVec A, Wv, Bv, Kv;
            sv_cvt(A, sv_read(buf, lane)); sv_cvt1p(Wv, sv_read(buf + 1024, lane)); sv_cvt(Bv, sv_read(buf + 2048, lane)); sv_cvt(Kv, sv_read(buf + 3072, lane));
            float vv = (float)*(const LAS3 f16*)(buf + 4096 + lane * 2);
#pragma unroll 1
            for (int st = 0; st < SCB; ++st) {
                const LAS3 unsigned char* sn = buf + ((st + 1 < SCB) ? st + 1 : st) * 128;
                const f16x4 ha = sv_read(sn, lane), hw = sv_read(sn + 1024, lane), hb = sv_read(sn + 2048, lane), hk = sv_read(sn + 3072, lane);
                const f16 hv = *(const LAS3 f16*)(sn + 4096 + lane * 2);
                float dq[4] = {0.f, 0.f, 0.f, 0.f}, dp[4] = {0.f, 0.f, 0.f, 0.f};
                sc_dot<0>(dq, A, Q); sc_dot<0>(dp, A, P);
                const float saq = (dq[0] + dq[1]) + (dq[2] + dq[3]), sap = (dp[0] + dp[1]) + (dp[2] + dp[3]);
                sc_upd1<0>(Q, P, Wv, Bv, Kv, saq, sap, vv);
                sv_cvt(A, ha); sv_cvt1p(Wv, hw); sv_cvt(Bv, hb); sv_cvt(Kv, hk); vv = (float)hv;
            }
        }
        float* Qp = ST + ST_Q_OFF + (size_t)(h * NCH + ch) * 4096 + lane;
        bf16* PTp = (bf16*)ST + (size_t)(h * NCH + ch) * 4096 + lane;
#pragma unroll
        for (int j = 0; j < 64; ++j) { PTp[j * 64] = f2bf(P[j]); Qp[j * 64] = Q[j]; }
    }
}
constexpr int GS = 16, NG = NCH / GS;
constexpr size_t ST_LP_OFF = (size_t)NH * NCH * 4096;
constexpr size_t WS_SG = WS_LORA + 2 * MiB;
constexpr int HI_LD = 72, HI_BYTES = 64 * HI_LD * 2;
struct HFrag { bf16x8 b[2][2]; f32x4 q[2]; };
__device__ __forceinline__ void hload(HFrag& f, const bf16* Bt, const float* QTc, int boff, int qtoff) {
#pragma unroll
    for (int ks = 0; ks < 2; ++ks)
#pragma unroll
        for (int n = 0; n < 2; ++n) f.b[ks][n] = *(const bf16x8*)(Bt + boff + 16 * n * 64 + 32 * ks);
#pragma unroll
    for (int n = 0; n < 2; ++n) f.q[n] = *(const f32x4*)(QTc + qtoff + 16 * n * 64);
}
__device__ __forceinline__ void hmma(const LAS3 unsigned char* img, const bf16x8 (&b)[2][2], f32x4 (&acc)[2], int m, int fr, int fq) {
#pragma unroll
    for (int ks = 0; ks < 2; ++ks) { const bf16x8 av = *(const LAS3 bf16x8*)(img + ((16 * m + fr) * HI_LD + 32 * ks + 8 * fq) * 2);
#pragma unroll
        for (int n = 0; n < 2; ++n) acc[n] = __builtin_amdgcn_mfma_f32_16x16x32_bf16(av, b[ks][n], acc[n], 0, 0, 0); }
}
__device__ __forceinline__ void himg_store(LAS3 unsigned char* img, const f32x4 (&acc)[2], int m, int n0, int fr, int fq) {
#pragma unroll
    for (int n = 0; n < 2; ++n)
#pragma unroll
        for (int i = 0; i < 4; ++i) *(LAS3 bf16*)(img + ((16 * m + 4 * fq + i) * HI_LD + n0 + 16 * n + fr) * 2) = f2bf(acc[n][i]);
}
#define HBAR() do { asm volatile("s_waitcnt lgkmcnt(0)" ::: "memory"); __builtin_amdgcn_s_barrier(); asm volatile("" ::: "memory"); } while (0)

__device__ __forceinline__ void sc2a_step(const HFrag& f, bf16* LpTc, float* QTc, const LAS3 unsigned char* ip, LAS3 unsigned char* ipn, const LAS3 unsigned char* iq, LAS3 unsigned char* iqn, int m, int n0, int fr, int fq, int qtoff) {
    f32x4 ap[2], aq[2];
#pragma unroll
    for (int n = 0; n < 2; ++n) { ap[n] = (f32x4){0.f, 0.f, 0.f, 0.f}; aq[n] = f.q[n]; }
    hmma(ip, f.b, ap, m, fr, fq); hmma(iq, f.b, aq, m, fr, fq);
#pragma unroll
    for (int n = 0; n < 2; ++n) { u32x2 w; w.x = pk2(ap[n][0], ap[n][1]); w.y = pk2(ap[n][2], ap[n][3]);
        *(u32x2*)(LpTc + (n0 + 16 * n + fr) * 64 + 16 * m + 4 * fq) = w;
        *(f32x4*)(QTc + qtoff + 16 * n * 64) = aq[n]; }
    himg_store(ipn, ap, m, n0, fr, fq); himg_store(iqn, aq, m, n0, fr, fq);
    HBAR();
}
__device__ __forceinline__ void phase_scan2a(ArgsR a, const Ctx& c) {
    const int lane = c.lane, wv = c.wave, fr = lane & 15, fq = lane >> 4, m = wv >> 1, n0 = 32 * (wv & 1);
    const int boff = (n0 + fr) * 64 + 8 * fq, qtoff = (n0 + fr) * 64 + 16 * m + 4 * fq;
    LAS3 unsigned char* L = (LAS3 unsigned char*)c.lds;
    for (int item = blockIdx.x; item < NH * NG; item += gridDim.x) {
        const size_t cb = (size_t)(item / NG) * NCH + (size_t)(item % NG) * GS;
        const bf16* PT = (const bf16*)(a.ws + WS_ST) + cb * 4096; bf16* LP = (bf16*)(a.ws + WS_ST) + ST_LP_OFF + cb * 4096; float* QT = (float*)(a.ws + WS_ST) + ST_Q_OFF + cb * 4096;
        for (int i = c.tid; i < 4 * HI_BYTES / 4; i += NTHREADS) ((LAS3 unsigned*)L)[i] = 0u;
        __syncthreads();
        if (c.tid < 64) *(LAS3 bf16*)(L + (c.tid * HI_LD + c.tid) * 2) = (bf16)0x3F80;
        __syncthreads();
        HFrag f0, f1, f2, f3;
        hload(f0, PT, QT, boff, qtoff); hload(f1, PT + 4096, QT + 4096, boff, qtoff); hload(f2, PT + 2 * 4096, QT + 2 * 4096, boff, qtoff); hload(f3, PT + 3 * 4096, QT + 3 * 4096, boff, qtoff);
        LAS3 unsigned char* p0 = L; LAS3 unsigned char* p1 = L + HI_BYTES; LAS3 unsigned char* q0 = L + 2 * HI_BYTES; LAS3 unsigned char* q1 = L + 3 * HI_BYTES;
#pragma unroll 1
        for (int i = 0; i < GS; i += 4) {
            const int nx = (i + 4 < GS) ? i + 4 : i;
            sc2a_step(f0, LP + (size_t)(i + 0) * 4096, QT + (size_t)(i + 0) * 4096, p0, p1, q0, q1, m, n0, fr, fq, qtoff); hload(f0, PT + (size_t)(nx + 0) * 4096, QT + (size_t)(nx + 0) * 4096, boff, qtoff);
            sc2a_step(f1, LP + (size_t)(i + 1) * 4096, QT + (size_t)(i + 1) * 4096, p1, p0, q1, q0, m, n0, fr, fq, qtoff); hload(f1, PT + (size_t)(nx + 1) * 4096, QT + (size_t)(nx + 1) * 4096, boff, qtoff);
            sc2a_step(f2, LP + (size_t)(i + 2) * 4096, QT + (size_t)(i + 2) * 4096, p0, p1, q0, q1, m, n0, fr, fq, qtoff); hload(f2, PT + (size_t)(nx + 2) * 4096, QT + (size_t)(nx + 2) * 4096, boff, qtoff);
            sc2a_step(f3, LP + (size_t)(i + 3) * 4096, QT + (size_t)(i + 3) * 4096, p1, p0, q1, q0, m, n0, fr, fq, qtoff); hload(f3, PT + (size_t)(nx + 3) * 4096, QT + (size_t)(nx + 3) * 4096, boff, qtoff);
        }
        __syncthreads();
    }
}
__device__ __forceinline__ void phase_scan2b(ArgsR a, const Ctx& c) {
    if (blockIdx.x >= NH) return;
    const int h = blockIdx.x, lane = c.lane, wv = c.wave, fr = lane & 15, fq = lane >> 4, m = wv >> 1, n0 = 32 * (wv & 1);
    const int boff = (n0 + fr) * 64 + 8 * fq, qtoff = (n0 + fr) * 64 + 16 * m + 4 * fq;
    LAS3 unsigned char* L = (LAS3 unsigned char*)c.lds;
    const bf16* LP = (const bf16*)(a.ws + WS_ST) + ST_LP_OFF + (size_t)h * NCH * 4096; const float* QT = (const float*)(a.ws + WS_ST) + ST_Q_OFF + (size_t)h * NCH * 4096;
    bf16* SG = (bf16*)(a.ws + WS_SG) + (size_t)h * NG * 4096;
    for (int i = c.tid; i < 2 * HI_BYTES / 4; i += NTHREADS) ((LAS3 unsigned*)L)[i] = 0u;
    for (int i = c.tid; i < 4096 / 2; i += NTHREADS) ((unsigned*)SG)[i] = 0u;
    __syncthreads();
    HFrag f0, f1, f2, f3;
#define SC2B_CH(g) ((size_t)((g) * GS + GS - 1) * 4096)
    hload(f0, LP + SC2B_CH(0), QT + SC2B_CH(0), boff, qtoff); hload(f1, LP + SC2B_CH(1), QT + SC2B_CH(1), boff, qtoff); hload(f2, LP + SC2B_CH(2), QT + SC2B_CH(2), boff, qtoff); hload(f3, LP + SC2B_CH(3), QT + SC2B_CH(3), boff, qtoff);
    LAS3 unsigned char* i0 = L; LAS3 unsigned char* i1 = L + HI_BYTES;
#define SC2B_STEP(f, g, ic, in) do { f32x4 acc[2] = {f.q[0], f.q[1]}; hmma(ic, f.b, acc, m, fr, fq); bf16* So = SG + (size_t)((g) + 1) * 4096; \
        _Pragma("unroll") for (int n = 0; n < 2; ++n) _Pragma("unroll") for (int i = 0; i < 4; ++i) So[(16 * m + 4 * fq + i) * 64 + n0 + 16 * n + fr] = f2bf(acc[n][i]); \
        himg_store(in, acc, m, n0, fr, fq); HBAR(); } while (0)
#pragma unroll 1
    for (int g = 0; g < NG; g += 4) {
        const int nx = (g + 4 < NG) ? g + 4 : g;
        SC2B_STEP(f0, g + 0, i0, i1); hload(f0, LP + SC2B_CH(nx + 0), QT + SC2B_CH(nx + 0), boff, qtoff);
        SC2B_STEP(f1, g + 1, i1, i0); hload(f1, LP + SC2B_CH(nx + 1), QT + SC2B_CH(nx + 1), boff, qtoff);
        SC2B_STEP(f2, g + 2, i0, i1); hload(f2, LP + SC2B_CH(nx + 2), QT + SC2B_CH(nx + 2), boff, qtoff);
        if (g + 3 < NG - 1) SC2B_STEP(f3, g + 3, i1, i0);
        hload(f3, LP + SC2B_CH(nx + 3), QT + SC2B_CH(nx + 3), boff, qtoff);
    }
#undef SC2B_STEP
#undef SC2B_CH
}
__device__ __forceinline__ void phase_scan2c(ArgsR a, const Ctx& c) {
    const int lane = c.lane, wv = c.wave, fr = lane & 15, fq = lane >> 4, m = wv >> 1, n0 = 32 * (wv & 1);
    const int boff = (n0 + fr) * 64 + 8 * fq, qtoff = (n0 + fr) * 64 + 16 * m + 4 * fq;
    LAS3 unsigned char* L = (LAS3 unsigned char*)c.lds;
    for (int item = blockIdx.x; item < NH * NG * 2; item += gridDim.x) {
        const int hg = item >> 1, hf = item & 1;
        const size_t cb = (size_t)(hg / NG) * NCH + (size_t)(hg % NG) * GS + hf * 8;
        const bf16* LP = (const bf16*)(a.ws + WS_ST) + ST_LP_OFF + cb * 4096; const float* QT = (const float*)(a.ws + WS_ST) + ST_Q_OFF + cb * 4096; bf16* SS = (bf16*)(a.ws + WS_ST) + cb * 4096;
        { const u32x4 v = *(const u32x4*)((const bf16*)(a.ws + WS_SG) + (size_t)hg * 4096 + c.tid * 8); *(LAS3 u32x4*)(L + ((c.tid >> 3) * HI_LD + (c.tid & 7) * 8) * 2) = v; }
        __syncthreads();
#pragma unroll 2
        for (int i = 0; i < 8; ++i) { HFrag f; hload(f, LP + (size_t)i * 4096, QT + (size_t)i * 4096, boff, qtoff);
            f32x4 acc[2] = {f.q[0], f.q[1]}; hmma(L, f.b, acc, m, fr, fq); bf16* So = SS + (size_t)i * 4096;
#pragma unroll
            for (int n = 0; n < 2; ++n)
#pragma unroll
                for (int k = 0; k < 4; ++k) So[(16 * m + 4 * fq + k) * 64 + n0 + 16 * n + fr] = f2bf(acc[n][k]); }
        __syncthreads();
    }
}
constexpr int WI_LD = 72, WI_B = 64 * WI_LD * 2, WI_GAM = 9 * WI_B, WI_GL = 15 * WI_B;
constexpr size_t WS_GM0 = 352 * MiB, WS_GM1 = 212 * MiB, WS_Y0 = 336 * MiB, WS_END2 = 360 * MiB;
__device__ __forceinline__ bf16* gm_ptr(unsigned char* ws, int h, int ch) { return (bf16*)(ws + (h < 4 ? WS_GM0 : WS_GM1)) + (size_t)((h & 3) * NCH + ch) * 4096; }
__device__ __forceinline__ void wi_mma(f32x4 (&acc)[2], const LAS3 unsigned char* A, const LAS3 unsigned char* Bt, int m, int n0, int fr, int fq) {
#pragma unroll
    for (int ks = 0; ks < 2; ++ks) { const bf16x8 av = *(const LAS3 bf16x8*)(A + ((16 * m + fr) * WI_LD + 32 * ks + 8 * fq) * 2);
#pragma unroll
        for (int n = 0; n < 2; ++n) { const bf16x8 bv = *(const LAS3 bf16x8*)(Bt + ((n0 + 16 * n + fr) * WI_LD + 32 * ks + 8 * fq) * 2); acc[n] = __builtin_amdgcn_mfma_f32_16x16x32_bf16(av, bv, acc[n], 0, 0, 0); } }
}
__device__ __forceinline__ void wi_st_nat(LAS3 unsigned char* X, const f32x4 (&acc)[2], int m, int n0, int fr, int fq) {
#pragma unroll
    for (int n = 0; n < 2; ++n)
#pragma unroll
        for (int i = 0; i < 4; ++i) *(LAS3 bf16*)(X + ((16 * m + 4 * fq + i) * WI_LD + n0 + 16 * n + fr) * 2) = f2bf(acc[n][i]);
}
__device__ __forceinline__ void wi_st_tr(LAS3 unsigned char* XT, const f32x4 (&acc)[2], int m, int n0, int fr, int fq) {
#pragma unroll
    for (int n = 0; n < 2; ++n) { u32x2 w; w.x = pk2(acc[n][0], acc[n][1]); w.y = pk2(acc[n][2], acc[n][3]); *(LAS3 u32x2*)(XT + ((n0 + 16 * n + fr) * WI_LD + 16 * m + 4 * fq) * 2) = w; }
}
__device__ __forceinline__ void wi_ld_nat(f32x4 (&acc)[2], const LAS3 unsigned char* X, int m, int n0, int fr, int fq) {
#pragma unroll
    for (int n = 0; n < 2; ++n)
#pragma unroll
        for (int i = 0; i < 4; ++i) acc[n][i] = bf2f(*(const LAS3 bf16*)(X + ((16 * m + 4 * fq + i) * WI_LD + n0 + 16 * n + fr) * 2));
}
__device__ __forceinline__ void phase_scan1m(ArgsR a, const Ctx& c) {
    const f16* WM1 = (const f16*)(a.ws + WS_WM1); const f16* KP = (const f16*)(a.ws + WS_KP);
    const f16* AA = (const f16*)(a.ws + WS_AA); const f16* BB = (const f16*)(a.ws + WS_BB); const f16* V = (const f16*)(a.ws + WS_V); const f16* R = (const f16*)(a.ws + WS_R);
    float* ST = (float*)(a.ws + WS_ST);
    LAS3 unsigned char* L = (LAS3 unsigned char*)c.lds;
    LAS3 float* GAM = (LAS3 float*)(L + WI_GAM); LAS3 float* GL = (LAS3 float*)(L + WI_GL);
    const int lane = c.lane, wv = c.wave, fr = lane & 15, fq = lane >> 4, m = wv >> 1, n0 = 32 * (wv & 1), tid = c.tid;
#define SLOT(i) (L + (i) * WI_B)
    for (int item = blockIdx.x; item < NH * NCH; item += gridDim.x) {
        const int h = item / NCH, ch = item % NCH; const size_t e0 = (size_t)(ch * CL) * W + h * 64;
        if (wv == 0) { float wl[64];
#pragma unroll
            for (int t = 0; t < 64; ++t) wl[t] = 1.0f + (float)WM1[e0 + (size_t)t * W + lane];
            float g = 1.0f;
#pragma unroll
            for (int t = 0; t < 64; ++t) { g *= wl[t]; GAM[t * 64 + lane] = g; } }
        HBAR();
        { const int t = tid >> 3, cc = (tid & 7) * 8; const size_t eo = e0 + (size_t)t * W + cc;
          const f16x8 av = *(const f16x8*)(AA + eo), bv = *(const f16x8*)(BB + eo), kv = *(const f16x8*)(KP + eo), vv = *(const f16x8*)(V + eo), rv = *(const f16x8*)(R + eo);
          float fa[8], fb[8], fk[8], fv[8], frr[8];
#pragma unroll
          for (int e = 0; e < 8; ++e) { const float g = GAM[t * 64 + cc + e], gp = t > 0 ? GAM[(t - 1) * 64 + cc + e] : 1.0f, ig = __builtin_amdgcn_rcpf(g);
              fa[e] = (float)av[e] * gp; fb[e] = (float)bv[e] * ig; fk[e] = (float)kv[e] * ig; fv[e] = (float)vv[e]; frr[e] = (float)rv[e] * g; if (t == 63) GL[cc + e] = g; }
          *(LAS3 u32x4*)(SLOT(0) + (t * WI_LD + cc) * 2) = pack8bf(fa); *(LAS3 u32x4*)(SLOT(2) + (t * WI_LD + cc) * 2) = pack8bf(fb); *(LAS3 u32x4*)(SLOT(4) + (t * WI_LD + cc) * 2) = pack8bf(fk); *(LAS3 u32x4*)(SLOT(12) + (t * WI_LD + cc) * 2) = pack8bf(frr);
#pragma unroll
          for (int e = 0; e < 8; ++e) { *(LAS3 bf16*)(SLOT(1) + ((cc + e) * WI_LD + t) * 2) = f2bf(fa[e]); *(LAS3 bf16*)(SLOT(3) + ((cc + e) * WI_LD + t) * 2) = f2bf(fb[e]); *(LAS3 bf16*)(SLOT(5) + ((cc + e) * WI_LD + t) * 2) = f2bf(fv[e]); } }
        HBAR();
        { f32x4 an[2] = {{0.f, 0.f, 0.f, 0.f}, {0.f, 0.f, 0.f, 0.f}}, ak[2] = {{0.f, 0.f, 0.f, 0.f}, {0.f, 0.f, 0.f, 0.f}};
          wi_mma(an, SLOT(2), SLOT(0), m, n0, fr, fq); wi_mma(ak, SLOT(4), SLOT(0), m, n0, fr, fq);
#pragma unroll
          for (int n = 0; n < 2; ++n)
#pragma unroll
              for (int i = 0; i < 4; ++i) { const int row = 16 * m + 4 * fq + i, col = n0 + 16 * n + fr; if (!(row < col)) { an[n][i] = 0.f; ak[n][i] = 0.f; } }
          wi_st_nat(SLOT(7), an, m, n0, fr, fq); wi_st_tr(SLOT(8), an, m, n0, fr, fq); wi_st_nat(SLOT(6), ak, m, n0, fr, fq);
#pragma unroll
          for (int n = 0; n < 2; ++n)
#pragma unroll
              for (int i = 0; i < 4; ++i) { const int row = 16 * m + 4 * fq + i, col = n0 + 16 * n + fr; if (row == col) an[n][i] += 1.0f; }
          wi_st_nat(SLOT(11), an, m, n0, fr, fq);
          f32x4 am[2] = {{0.f, 0.f, 0.f, 0.f}, {0.f, 0.f, 0.f, 0.f}}, amk[2] = {{0.f, 0.f, 0.f, 0.f}, {0.f, 0.f, 0.f, 0.f}};
          wi_mma(am, SLOT(2), SLOT(12), m, n0, fr, fq); wi_mma(amk, SLOT(4), SLOT(12), m, n0, fr, fq);
#pragma unroll
          for (int n = 0; n < 2; ++n)
#pragma unroll
              for (int i = 0; i < 4; ++i) { const int row = 16 * m + 4 * fq + i, col = n0 + 16 * n + fr; if (row > col) { am[n][i] = 0.f; amk[n][i] = 0.f; } }
          wi_st_tr(SLOT(13), am, m, n0, fr, fq); wi_st_nat(SLOT(14), amk, m, n0, fr, fq); }
        HBAR();
        { f32x4 a2[2] = {{0.f, 0.f, 0.f, 0.f}, {0.f, 0.f, 0.f, 0.f}}; wi_mma(a2, SLOT(7), SLOT(8), m, n0, fr, fq); wi_st_nat(SLOT(9), a2, m, n0, fr, fq); wi_st_tr(SLOT(10), a2, m, n0, fr, fq); }
        HBAR();
#define WI_LEVEL(XS, XD, NS, NST, ND, NDT, LAST) do { f32x4 ax[2]; wi_ld_nat(ax, SLOT(XS), m, n0, fr, fq); wi_mma(ax, SLOT(XS), SLOT(NST), m, n0, fr, fq); \
            if (LAST) wi_st_tr(SLOT(XD), ax, m, n0, fr, fq); else { wi_st_nat(SLOT(XD), ax, m, n0, fr, fq); \
                f32x4 aq[2] = {{0.f, 0.f, 0.f, 0.f}, {0.f, 0.f, 0.f, 0.f}}; wi_mma(aq, SLOT(NS), SLOT(NST), m, n0, fr, fq); wi_st_nat(SLOT(ND), aq, m, n0, fr, fq); wi_st_tr(SLOT(NDT), aq, m, n0, fr, fq); } \
            HBAR(); } while (0)
        WI_LEVEL(11, 0, 9, 10, 7, 8, false);
        WI_LEVEL(0, 11, 7, 8, 9, 10, false);
        WI_LEVEL(11, 0, 9, 10, 7, 8, false);
        WI_LEVEL(0, 11, 7, 8, 9, 10, false);
        WI_LEVEL(11, 0, 9, 10, 7, 8, true);
#undef WI_LEVEL
        { f32x4 aw[2] = {{0.f, 0.f, 0.f, 0.f}, {0.f, 0.f, 0.f, 0.f}}, aa[2] = {{0.f, 0.f, 0.f, 0.f}, {0.f, 0.f, 0.f, 0.f}};
          wi_mma(aw, SLOT(6), SLOT(0), m, n0, fr, fq); wi_mma(aa, SLOT(1), SLOT(0), m, n0, fr, fq); wi_st_nat(SLOT(2), aw, m, n0, fr, fq); wi_st_nat(SLOT(7), aa, m, n0, fr, fq); }
        HBAR();
        { f32x4 ap[2] = {{0.f, 0.f, 0.f, 0.f}, {0.f, 0.f, 0.f, 0.f}}, az[2]; wi_ld_nat(az, SLOT(4), m, n0, fr, fq);
          wi_mma(ap, SLOT(7), SLOT(3), m, n0, fr, fq); wi_mma(az, SLOT(2), SLOT(3), m, n0, fr, fq);
          wi_st_tr(SLOT(8), az, m, n0, fr, fq);
          bf16* PTp = (bf16*)ST + (size_t)(h * NCH + ch) * 4096;
#pragma unroll
          for (int n = 0; n < 2; ++n) { const int col = n0 + 16 * n + fr; const float gl = GL[col]; f32x4 pv = ap[n];
#pragma unroll
              for (int i = 0; i < 4; ++i) { if (16 * m + 4 * fq + i == col) pv[i] += 1.0f; pv[i] *= gl; }
              u32x2 w; w.x = pk2(pv[0], pv[1]); w.y = pk2(pv[2], pv[3]); *(u32x2*)(PTp + col * 64 + 16 * m + 4 * fq) = w; }
          f32x4 ag[2], az2[2]; wi_ld_nat(az2, SLOT(14), m, n0, fr, fq);
#pragma unroll
          for (int n = 0; n < 2; ++n)
#pragma unroll
              for (int i = 0; i < 4; ++i) ag[n][i] = bf2f(*(const LAS3 bf16*)(SLOT(12) + ((n0 + 16 * n + fr) * WI_LD + 16 * m + 4 * fq + i) * 2));
          wi_mma(ag, SLOT(7), SLOT(13), m, n0, fr, fq); wi_mma(az2, SLOT(2), SLOT(13), m, n0, fr, fq);
          wi_st_tr(SLOT(9), az2, m, n0, fr, fq);
          bf16* GMp = gm_ptr(a.ws, h, ch);
#pragma unroll
          for (int n = 0; n < 2; ++n) { u32x2 w; w.x = pk2(ag[n][0], ag[n][1]); w.y = pk2(ag[n][2], ag[n][3]); *(u32x2*)(GMp + (n0 + 16 * n + fr) * 64 + 16 * m + 4 * fq) = w; } }
        HBAR();
        { f32x4 aq[2] = {{0.f, 0.f, 0.f, 0.f}, {0.f, 0.f, 0.f, 0.f}}; wi_mma(aq, SLOT(5), SLOT(8), m, n0, fr, fq);
          float* QTp = ST + ST_Q_OFF + (size_t)(h * NCH + ch) * 4096;
#pragma unroll
          for (int n = 0; n < 2; ++n) { const int col = n0 + 16 * n + fr; const float gl = GL[col]; *(f32x4*)(QTp + col * 64 + 16 * m + 4 * fq) = aq[n] * gl; }
          f32x4 ay[2] = {{0.f, 0.f, 0.f, 0.f}, {0.f, 0.f, 0.f, 0.f}}; wi_mma(ay, SLOT(5), SLOT(9), m, n0, fr, fq);
          bf16* Y0p = (bf16*)(a.ws + WS_Y0) + (size_t)(h * NCH + ch) * 4096;
#pragma unroll
          for (int n = 0; n < 2; ++n) { u32x2 w; w.x = pk2(ay[n][0], ay[n][1]); w.y = pk2(ay[n][2], ay[n][3]); *(u32x2*)(Y0p + (n0 + 16 * n + fr) * 64 + 16 * m + 4 * fq) = w; } }
        HBAR();
    }
#undef SLOT
}

__device__ __forceinline__ void phase_scan3m(ArgsR a, const Ctx& c, int l) {
    const f16* R = (const f16*)(a.ws + WS_R); const f16* KP = (const f16*)(a.ws + WS_KP); const f16* V = (const f16*)(a.ws + WS_V); const bf16* G = (const bf16*)(a.ws + WS_G);
    bf16* YA = (bf16*)(a.ws + WS_YA);
    LAS3 unsigned char* L = (LAS3 unsigned char*)c.lds;
    LAS3 float* YL = (LAS3 float*)(L + WI_B);
    const int lane = c.lane, wv = c.wave, fr = lane & 15, fq = lane >> 4, m = wv >> 1, n0 = 32 * (wv & 1), tid = c.tid;
    for (int item = blockIdx.x; item < NH * NCH; item += gridDim.x) {
        const int h = item / NCH, ch = item % NCH;
        { u32x4 v = {0u, 0u, 0u, 0u}; if (ch > 0) v = *(const u32x4*)((const bf16*)(a.ws + WS_ST) + (size_t)(h * NCH + ch - 1) * 4096 + tid * 8);
          *(LAS3 u32x4*)(L + ((tid >> 3) * WI_LD + (tid & 7) * 8) * 2) = v; }
        const bf16* GMp = gm_ptr(a.ws, h, ch); const bf16* Y0p = (const bf16*)(a.ws + WS_Y0) + (size_t)(h * NCH + ch) * 4096;
        bf16x8 bfr[2][2]; f32x4 acc[2];
#pragma unroll
        for (int ks = 0; ks < 2; ++ks)
#pragma unroll
            for (int n = 0; n < 2; ++n) bfr[ks][n] = *(const bf16x8*)(GMp + (n0 + 16 * n + fr) * 64 + 32 * ks + 8 * fq);
#pragma unroll
        for (int n = 0; n < 2; ++n) acc[n] = load4bf(Y0p + (n0 + 16 * n + fr) * 64 + 16 * m + 4 * fq);
        HBAR();
#pragma unroll
        for (int ks = 0; ks < 2; ++ks) { const bf16x8 av = *(const LAS3 bf16x8*)(L + ((16 * m + fr) * WI_LD + 32 * ks + 8 * fq) * 2);
#pragma unroll
            for (int n = 0; n < 2; ++n) acc[n] = __builtin_amdgcn_mfma_f32_16x16x32_bf16(av, bfr[ks][n], acc[n], 0, 0, 0); }
#pragma unroll
        for (int n = 0; n < 2; ++n)
#pragma unroll
            for (int i = 0; i < 4; ++i) YL[(n0 + 16 * n + fr) * 65 + 16 * m + 4 * fq + i] = acc[n][i];
        HBAR();
        { const float gn_g = a.in[I_GNG][l * W + h * 64 + lane], gn_b = a.in[I_GNB][l * W + h * 64 + lane], r_k = a.in[I_RK][l * W + h * 64 + lane];
#pragma unroll 2
          for (int i = 0; i < 8; ++i) { const int t = 8 * wv + i; const size_t o = (size_t)(ch * CL + t) * W + h * 64 + lane;
              const float yy = YL[t * 65 + lane]; const float rl = (float)R[o], kl = (float)KP[o], vl = (float)V[o], gl = bf2f(G[o]);
              const float mean = wave_sum(yy) * (1.f / 64.f); const float dd = yy - mean; const float var = wave_sum(dd * dd) * (1.f / 64.f);
              const float bonus = wave_sum(rl * kl * r_k);
              const float yn = dd * __builtin_amdgcn_rsqf(var + GN_EPS) * gn_g + gn_b + bonus * vl;
              YA[o] = f2bf(yn * gl); } }
        HBAR();
    }
}

__device__ __forceinline__ void phase_scan3(ArgsR a, const Ctx& c, int l) {
    const f16* R = (const f16*)(a.ws + WS_R); const f16* WM1 = (const f16*)(a.ws + WS_WM1); const f16* KP = (const f16*)(a.ws + WS_KP);
    const f16* AA = (const f16*)(a.ws + WS_AA); const f16* BB = (const f16*)(a.ws + WS_BB); const f16* V = (const f16*)(a.ws + WS_V);
    const float* ST = (const float*)(a.ws + WS_ST); bf16* YA = (bf16*)(a.ws + WS_YA); const f16* Gs = (const f16*)(a.ws + WS_G);
    const int lane = c.lane;
    LAS3 unsigned char* ring = (LAS3 unsigned char*)c.lds + c.wave * SC_WAVE;
    for (int item = c.gw; item < NH * NCH; item += c.ngw) {
        const int h = __builtin_amdgcn_readfirstlane(item / NCH), ch = __builtin_amdgcn_readfirstlane(item % NCH);
        const size_t lane_off = (size_t)(lane >> 3) * W + h * 64 + (lane & 7) * 8;
        const float gn_g = a.in[I_GNG][l * W + h * 64 + lane], gn_b = a.in[I_GNB][l * W + h * 64 + lane], r_k = a.in[I_RK][l * W + h * 64 + lane];
        { const size_t e0 = (size_t)(ch * CL) * W + lane_off;
          sc_dma(AA, e0, ring); sc_dma(WM1, e0, ring + 1024); sc_dma(BB, e0, ring + 2048); sc_dma(KP, e0, ring + 3072); sc_dma(V, e0, ring + 4096); sc_dma(R, e0, ring + 5120); sc_dma(Gs, e0, ring + 6144); }
        float S[64];
        if (ch == 0) {
#pragma unroll
            for (int j = 0; j < 64; ++j) S[j] = 0.f;
        } else { const bf16* Sp = (const bf16*)ST + ((size_t)(h * NCH + ch - 1) * 64 + lane) * 64;
#pragma unroll
            for (int j = 0; j < 64; j += 4) { const f32x4 x = load4bf(Sp + j); S[j] = x[0]; S[j + 1] = x[1]; S[j + 2] = x[2]; S[j + 3] = x[3]; } }
#pragma unroll 1
        for (int blk = 0; blk < CL / SCB; ++blk) {
            LAS3 unsigned char* buf = ring + (blk & 1) * SC_BUF;
            if (blk + 1 < CL / SCB) { LAS3 unsigned char* nb = ring + ((blk + 1) & 1) * SC_BUF; const size_t e0 = (size_t)(ch * CL + (blk + 1) * SCB) * W + lane_off;
                sc_dma(AA, e0, nb); sc_dma(WM1, e0, nb + 1024); sc_dma(BB, e0, nb + 2048); sc_dma(KP, e0, nb + 3072); sc_dma(V, e0, nb + 4096); sc_dma(R, e0, nb + 5120); sc_dma(Gs, e0, nb + 6144);
                asm volatile("s_waitcnt vmcnt(7)" ::: "memory"); }
            else asm volatile("s_waitcnt vmcnt(0)" ::: "memory");
            SVec A, Wv, Bv, Kv, Rv;
            sv_cvt(A, sv_read(buf, lane)); sv_cvt1p(Wv, sv_read(buf + 1024, lane)); sv_cvt(Bv, sv_read(buf + 2048, lane)); sv_cvt(Kv, sv_read(buf + 3072, lane)); sv_cvt(Rv, sv_read(buf + 5120, lane));
            float vv = (float)*(const LAS3 f16*)(buf + 4096 + lane * 2);
#pragma unroll 1
            for (int st = 0; st < SCB; ++st) {
                const LAS3 unsigned char* sn = buf + ((st + 1 < SCB) ? st + 1 : st) * 128;
                const f16x4 ha = sv_read(sn, lane), hw = sv_read(sn + 1024, lane), hb = sv_read(sn + 2048, lane), hk = sv_read(sn + 3072, lane), hr = sv_read(sn + 5120, lane);
                const f16 hv = *(const LAS3 f16*)(sn + 4096 + lane * 2);
                float d[4] = {0.f, 0.f, 0.f, 0.f};
                sc_dot<0>(d, A, S);
                const float sa = (d[0] + d[1]) + (d[2] + d[3]);
                float y[4] = {0.f, 0.f, 0.f, 0.f};
                sc_upd3<0>(S, y, Wv, Bv, Kv, Rv, sa, vv);
                const float yy = (y[0] + y[1]) + (y[2] + y[3]);
                sv_cvt(A, ha); sv_cvt1p(Wv, hw); sv_cvt(Bv, hb); sv_cvt(Kv, hk); sv_cvt(Rv, hr); vv = (float)hv;
                { const LAS3 unsigned char* sb = buf + st * 128;
                  const float rl = (float)*(const LAS3 f16*)(sb + 5120 + lane * 2), kl = (float)*(const LAS3 f16*)(sb + 3072 + lane * 2), vl = (float)*(const LAS3 f16*)(sb + 4096 + lane * 2);
                  const float gl = bf2f(*(const LAS3 bf16*)(sb + 6144 + lane * 2));
                  const float mean = wave_sum(yy) * (1.f / 64.f); const float dd = yy - mean; const float var = wave_sum(dd * dd) * (1.f / 64.f);
                  const float bonus = wave_sum(rl * kl * r_k);
                  const float yn = dd * __builtin_amdgcn_rsqf(var + GN_EPS) * gn_g + gn_b + bonus * vl;
                  YA[(size_t)(ch * CL + blk * SCB + st) * W + h * 64 + lane] = f2bf(yn * gl); }
            }
        }
    }
}

__device__ __forceinline__ void phase_post(ArgsR a, const Ctx& c, int l) {
    const bf16* YSC = (const bf16*)(a.ws + WS_YSC); const f16* R = (const f16*)(a.ws + WS_R); const f16* KP = (const f16*)(a.ws + WS_KP); const f16* V = (const f16*)(a.ws + WS_V);
    const bf16* G = (const bf16*)(a.ws + WS_G); bf16* YA = (bf16*)(a.ws + WS_YA);
    const float* gng = a.in[I_GNG] + l * W; const float* gnb = a.in[I_GNB] + l * W; const float* rk = a.in[I_RK] + l * W;
    for (int t = c.gw; t < T; t += c.ngw) {
#pragma unroll
        for (int i = 0; i < 8; ++i) { const int n = c.lane + 64 * i; const size_t o = (size_t)t * W + n;
            const float y = bf2f(YSC[o]); const float mean = wave_sum(y) * (1.f / 64.f); const float d = y - mean; const float var = wave_sum(d * d) * (1.f / 64.f);
            float yn = d * __builtin_amdgcn_rsqf(var + GN_EPS) * gng[n] + gnb[n];
            const float r = (float)R[o], k = (float)KP[o], v = (float)V[o];
            const float bonus = wave_sum(r * k * rk[n]);
            yn += bonus * v;
            YA[o] = f2bf(yn * bf2f(G[o])); }
    }
}

__device__ __forceinline__ void phase_ln1(ArgsR a, const Ctx& c, int l, float* outw) {
    const float* MODF = (const float*)(a.ws + WS_MODF) + l * 6144;
    const float* g1 = a.in[I_LN1G] + l * D; const float* b1 = a.in[I_LN1B] + l * D;
    bf16* XN = (bf16*)(a.ws + WS_XN);
    int* TOKI = (int*)(a.ws + WS_TOKI); float* TOKW = (float*)(a.ws + WS_TOKW); int* TOKP = (int*)(a.ws + WS_TOKP);
    const float* rw = a.in[I_RW]; const float* rb = a.in[I_RB];
    LAS3 float* rwT = (LAS3 float*)((LAS3 unsigned char*)c.lds + 69632);
    unsigned* lcnt = (unsigned*)(c.lds + 135168);
    for (int i = c.tid; i < D * NE; i += NTHREADS) rwT[(i & 15) * D + (i >> 4)] = rw[i];
    if (c.tid < NE) lcnt[c.tid] = 0u;
    __syncthreads();
    for (int m = c.gw; m < T; m += c.ngw) {
        int l4 = 4 * c.lane; asm volatile("" : "+v"(l4));
        float v[16]; load_row16(a.out + (size_t)m * D, c.lane, v);
        float mean, rstd; row_stats(v, mean, rstd);
#pragma unroll
        for (int j = 0; j < 4; ++j) { f32x4 o; const int col = l4 + 256 * j;
#pragma unroll
            for (int e = 0; e < 4; ++e) { v[4 * j + e] = (v[4 * j + e] - mean) * rstd * g1[col + e] + b1[col + e]; o[e] = v[4 * j + e]; }
            *(f32x4*)(outw + (size_t)m * D + col) = o; }
        row_stats(v, mean, rstd);
#pragma unroll
        for (int j = 0; j < 4; ++j) { f32x4 o; const int col = l4 + 256 * j;
#pragma unroll
            for (int e = 0; e < 4; ++e) { v[4 * j + e] = (v[4 * j + e] - mean) * rstd * (1.0f + MODF[4096 + col + e]) + MODF[3072 + col + e]; o[e] = v[4 * j + e]; }
            store4bf(XN + (size_t)m * D + col, o); }
        float sc[16], sel[16];
#pragma unroll
        for (int e = 0; e < 16; ++e) { float lg = 0.f;
#pragma unroll
            for (int j = 0; j < 4; ++j) { const f32x4 r4 = *(const LAS3 f32x4*)(rwT + e * D + l4 + 256 * j); lg += (v[4 * j] * r4[0] + v[4 * j + 1] * r4[1]) + (v[4 * j + 2] * r4[2] + v[4 * j + 3] * r4[3]); }
            sc[e] = 1.0f / (1.0f + expf(-wave_sum(lg))); sel[e] = sc[e] + rb[e];
            if ((e & 3) == 3) __builtin_amdgcn_sched_barrier(0); }
        int best = 0; float bestv = -INFINITY;
#pragma unroll
        for (int g = 0; g < 4; ++g) { float m1 = -INFINITY, m2 = -INFINITY;
#pragma unroll
            for (int q = 0; q < 4; ++q) { const float sv = sel[4 * g + q]; if (sv > m1) { m2 = m1; m1 = sv; } else if (sv > m2) m2 = sv; }
            const float gs = m1 + m2; if (gs > bestv) { bestv = gs; best = g; } }
        int i1 = 0, i2 = 0; float s1 = -INFINITY, s2 = -INFINITY, w1 = 0.f, w2 = 0.f;
#pragma unroll
        for (int e = 0; e < 16; ++e) { if ((e >> 2) == best) { const float sv = sel[e];
                if (sv > s1) { s2 = s1; i2 = i1; w2 = w1; s1 = sv; i1 = e; w1 = sc[e]; } else if (sv > s2) { s2 = sv; i2 = e; w2 = sc[e]; } } }
        if (c.lane == 0) { const float ws = w1 + w2;
            TOKI[2 * m] = i1; TOKI[2 * m + 1] = i2; TOKW[2 * m] = w1 / ws; TOKW[2 * m + 1] = w2 / ws;
            TOKP[2 * m] = (int)atomicAdd(&lcnt[i1], 1u); TOKP[2 * m + 1] = (int)atomicAdd(&lcnt[i2], 1u); }
    }
    __syncthreads();
    if (c.tid < NE) ((int*)(a.ws + WS_BLKCNT))[blockIdx.x * NE + c.tid] = (int)lcnt[c.tid];
    __syncthreads();
    float* scr = (float*)(c.lds + c.wave * 8704);
    bf16* WGU = (bf16*)(a.ws + WS_WGU); bf16* WD = (bf16*)(a.ws + WS_WD);
    constexpr int IG = (D / 64) * (FF / 32);
    constexpr int ID = (FF / 64) * (D / 32);
    for (int it = c.gw; it < NE * (2 * IG + ID); it += c.ngw) {
        const int e = it / (2 * IG + ID); int r = it % (2 * IG + ID);
        const size_t eo = ((size_t)l * NE + e) * (size_t)D * FF;
        if (r < IG) { transpose_matrix_item(a.in[I_EG] + eo, D, FF, WGU + (size_t)e * 1024 * 1024, r, scr, c.lane, RowGU{0}); continue; } r -= IG;
        if (r < IG) { transpose_matrix_item(a.in[I_EU] + eo, D, FF, WGU + (size_t)e * 1024 * 1024, r, scr, c.lane, RowGU{1}); continue; } r -= IG;
        transpose_matrix_item(a.in[I_ED] + eo, FF, D, WD + (size_t)e * 1024 * 512, r, scr, c.lane, RowId());
    }
}

__device__ __forceinline__ void phase_perm(ArgsR a, const Ctx& c, int l) {
    const int* BLKCNT = (const int*)(a.ws + WS_BLKCNT);
    LAS3 int* pre = (LAS3 int*)c.lds;
    LAS3 int* tot = pre + 256 * NE;
    const int nb = gridDim.x;
#pragma unroll
    for (int q = 0; q < 2; ++q) { const int e = 2 * c.wave + q; int v[4]; int sum = 0;
#pragma unroll
        for (int i = 0; i < 4; ++i) { const int b = 4 * c.lane + i; v[i] = b < nb ? BLKCNT[b * NE + e] : 0; sum += v[i]; }
        int inc = sum;
#pragma unroll
        for (int o = 1; o < 64; o <<= 1) { const int t = __shfl_up(inc, o); if (c.lane >= o) inc += t; }
        int run = inc - sum;
#pragma unroll
        for (int i = 0; i < 4; ++i) { pre[(4 * c.lane + i) * NE + e] = run; run += v[i]; }
        if (c.lane == 63) tot[e] = inc; }
    __syncthreads();
    int ts[17]; { int sacc = 0;
#pragma unroll
        for (int e = 0; e < 16; ++e) { ts[e] = sacc; sacc += (tot[e] + 255) >> 8; } ts[16] = sacc; }
    if (blockIdx.x == 0 && c.tid < NE) ((int*)(a.ws + WS_TOT))[c.tid] = tot[c.tid];
    const int* TOKI = (const int*)(a.ws + WS_TOKI); const int* TOKP = (const int*)(a.ws + WS_TOKP); int* S2T = (int*)(a.ws + WS_S2T);
    const bf16* XN = (const bf16*)(a.ws + WS_XN); bf16* XS = (bf16*)(a.ws + WS_XS);
    for (int as = c.gw; as < 2 * T; as += c.ngw) {
        const int e = TOKI[as]; int base = 0;
#pragma unroll
        for (int j = 0; j < 16; ++j) base = (j == e) ? ts[j] : base;
        const int m = as >> 1, blk = (m % c.ngw) >> 3;
        const int slot = base * 256 + pre[blk * NE + e] + TOKP[as];
        if (c.lane == 0) S2T[slot] = as;
        const u32x4* src = (const u32x4*)(XN + (size_t)m * D); u32x4* dst = (u32x4*)(XS + (size_t)slot * D);
        dst[c.lane] = src[c.lane]; dst[64 + c.lane] = src[64 + c.lane];
    }
    for (int e = 0; e < 16; ++e) {
        int tse = 0, tsn = 0;
#pragma unroll
        for (int j = 0; j < 16; ++j) { tse = (j == e) ? ts[j] : tse; tsn = (j == e) ? ts[j + 1] : tsn; }
        const int lo = tse * 256 + tot[e], hi = tsn * 256;
        for (int sl = lo + c.gw; sl < hi; sl += c.ngw) { if (c.lane == 0) S2T[sl] = -1; u32x4* dst = (u32x4*)(XS + (size_t)sl * D); const u32x4 zz = {0u, 0u, 0u, 0u}; dst[c.lane] = zz; dst[64 + c.lane] = zz; }
    }
    __syncthreads();
}

__device__ __forceinline__ void phase_ln2(ArgsR a, const Ctx& c, int l, float* outw) {
    const float* MODF = (const float*)(a.ws + WS_MODF) + l * 6144;
    const float* g2 = a.in[I_LN2G] + l * D; const float* b2 = a.in[I_LN2B] + l * D;
    const bf16* Y = (const bf16*)(a.ws + WS_Y); bf16* XN = (bf16*)(a.ws + WS_XN);
    for (int m = c.gw; m < T; m += c.ngw) {
        float v[16]; load_row16(a.out + (size_t)m * D, c.lane, v);
#pragma unroll
        for (int j = 0; j < 4; ++j) { const int col = 4 * c.lane + 256 * j; const f32x4 y0 = load4bf(Y + (size_t)(2 * m) * D + col), y1 = load4bf(Y + (size_t)(2 * m + 1) * D + col);
#pragma unroll
            for (int e = 0; e < 4; ++e) v[4 * j + e] = ALPHA * v[4 * j + e] + (1.0f + MODF[5120 + col + e]) * (y0[e] + y1[e]); }
        float mean, rstd; row_stats(v, mean, rstd);
#pragma unroll
        for (int j = 0; j < 4; ++j) { f32x4 o; const int col = 4 * c.lane + 256 * j;
#pragma unroll
            for (int e = 0; e < 4; ++e) { v[4 * j + e] = (v[4 * j + e] - mean) * rstd * g2[col + e] + b2[col + e]; o[e] = v[4 * j + e]; }
            *(f32x4*)(outw + (size_t)m * D + col) = o; }
        if (l + 1 < DEPTH) {
            const float* MN = MODF + 6144;
            row_stats(v, mean, rstd);
#pragma unroll
            for (int j = 0; j < 4; ++j) { f32x4 o; const int col = 4 * c.lane + 256 * j;
#pragma unroll
                for (int e = 0; e < 4; ++e) o[e] = (v[4 * j + e] - mean) * rstd * (1.0f + MN[1024 + col + e]) + MN[col + e];
                store4bf(XN + (size_t)m * D + col, o); }
        }
    }
}


template <class F> struct EpiAdapt {
    static constexpr bool PERM = true, AFTER_DRAIN = false; F f;
    __device__ __forceinline__ void operator()(const f32x4 (&acc)[2][2][4][2], const Unit& u, int wr, int wc, int fr, int fq) const {
        const int col = u.pn * 256 + wc * 32 + 8 * fq;
#pragma unroll
        for (int ai = 0; ai < 2; ++ai)
#pragma unroll
            for (int m = 0; m < 4; ++m) { const int row = u.pm * 256 + ai * 128 + wr * 64 + m * 16 + fr; f(row, col, acc[ai][0][m][0], acc[ai][0][m][1], acc[ai][1][m][0], acc[ai][1][m][1]); }
    }
};

template <class Sched, class F>
__device__ __forceinline__ void gemm_any(const Ctx& c, const bf16* A, const bf16* Bt, int M, int N, int K, const Sched& S, const F& f) {
    pg8::Gemm g{A, Bt, M, N, K}; EpiAdapt<F> E{f};
    pg8::gemm_phase<EpiAdapt<F>, Sched, true, true>((PG8_LAS unsigned char*)c.lds, g, S, E, c.tid);
}

#define LAS __attribute__((address_space(3)))
#define XB_TMO      128
#define XB_XCNT(j)  (256  + 64 * (j))
#define XB_XSUB(j)  (1280 + 64 * (j))
#define XB_XGEN(j)  (2304 + 64 * (j))
#define XB_TOP      3328
#define XB_TOPGEN   3392
#define XCD_BAR_WORDS 3456
#define XB_SPIN_CAP (1u << 24)

__device__ __forceinline__ unsigned xb_ld(unsigned* p)              { return __hip_atomic_load(p, __ATOMIC_RELAXED, __HIP_MEMORY_SCOPE_AGENT); }
__device__ __forceinline__ unsigned xb_add(unsigned* p, unsigned v) { return __hip_atomic_fetch_add(p, v, __ATOMIC_RELAXED, __HIP_MEMORY_SCOPE_AGENT); }
__device__ __forceinline__ unsigned xb_xcc_id() { return (unsigned)__builtin_amdgcn_s_getreg((3 << 11) | 20) & 0xFu; }
#define XB_SPIN(cond, bar) do { unsigned _sp = 0; while (cond) { __builtin_amdgcn_s_sleep(1); \
    if ((++_sp & 255u) == 0u) { if (xb_ld(&(bar)[XB_TMO])) break; if (_sp > XB_SPIN_CAP) { atomicAdd(&(bar)[XB_TMO], 1u); break; } } } } while (0)

struct XcdBarrier {
    unsigned* bar; unsigned x;
    volatile LAS unsigned* st;
};

__device__ __forceinline__ XcdBarrier xcd_barrier_post(unsigned* bar, volatile LAS unsigned* st) {
    XcdBarrier b; b.bar = bar; b.x = xb_xcc_id(); b.st = st;
    if (threadIdx.x == 0) (void)xb_add(&bar[XB_XCNT(b.x)], 1u);
    return b;
}
__device__ __forceinline__ void xcd_barrier_complete(unsigned* bar, unsigned x, unsigned& nloc, unsigned& nx) {
    const unsigned G = gridDim.x * gridDim.y * gridDim.z;
    unsigned sum, cnt, mine, sp = 0u;
    for (;;) {
        sum = 0u; cnt = 0u; mine = 0u;
#pragma unroll
        for (unsigned j = 0; j < 16; ++j) { const unsigned c = xb_ld(&bar[XB_XCNT(j)]); sum += c; cnt += (c > 0u) ? 1u : 0u; mine = (j == x) ? c : mine; }
        if (sum == G) break;
        __builtin_amdgcn_s_sleep(1);
        if ((++sp & 255u) == 0u) { if (xb_ld(&bar[XB_TMO])) break; if (sp > XB_SPIN_CAP) { atomicAdd(&bar[XB_TMO], 1u); break; } }
    }
    nloc = mine > 0u ? mine : 1u; nx = cnt > 0u ? cnt : 1u;
}

__device__ __forceinline__ void xcd_barrier(const XcdBarrier& b) {
    asm volatile("s_waitcnt vmcnt(0)" ::: "memory");
    __syncthreads();
    if (threadIdx.x == 0) {
        unsigned* bar = b.bar;
        __builtin_amdgcn_s_waitcnt(0);
        unsigned nloc = b.st[0], nx = b.st[1];
        if (nloc == 0u) { xcd_barrier_complete(bar, b.x, nloc, nx); b.st[0] = nloc; b.st[1] = nx; }
        const unsigned old = xb_add(&bar[XB_XSUB(b.x)], 1u);
        const unsigned gen = old / nloc;
        if (old + 1u == (gen + 1u) * nloc) {
            __builtin_amdgcn_fence(__ATOMIC_RELEASE, "agent");
            asm volatile("s_waitcnt vmcnt(0)" ::: "memory");
            const unsigned og = xb_add(&bar[XB_TOP], 1u);
            const unsigned tg = og / nx;
            if (og + 1u == (tg + 1u) * nx) xb_add(&bar[XB_TOPGEN], 1u);
            else XB_SPIN(xb_ld(&bar[XB_TOPGEN]) == tg, bar);
            __builtin_amdgcn_fence(__ATOMIC_ACQUIRE, "agent");
            xb_add(&bar[XB_XGEN(b.x)], 1u);
            asm volatile("s_waitcnt vmcnt(0)" ::: "memory");
        } else {
            XB_SPIN(xb_ld(&bar[XB_XGEN(b.x)]) == gen, bar);
            __builtin_amdgcn_fence(__ATOMIC_ACQUIRE, "agent");
            asm volatile("s_waitcnt vmcnt(0)" ::: "memory");
        }
    }
    __syncthreads();
}


constexpr int PH_PER_LAYER = 12, N_PHASES = 2 + PH_PER_LAYER * DEPTH;
constexpr int CW_BAR = 4096;
constexpr int LDS_BYTES = 147456, LDSCTL_OFF = 131072 + 8192;
#ifndef SINGLE_LAUNCH
#define SINGLE_LAUNCH 1
#endif

#ifndef PROBE_A
#define PROBE_A -1
#endif
#ifndef PROBE_B
#define PROBE_B -1
#endif
constexpr size_t WS_TS = 512 * 1024;
#if PROBE_A >= 0
#define STAMP(i) do { if (blockIdx.x == 0 && threadIdx.x == 0) ((unsigned long long*)(args_here()->ws + WS_TS))[(i)] = __builtin_amdgcn_s_memrealtime(); } while (0)
#else
#define STAMP(i) do { } while (0)
#endif
__device__ __forceinline__ const __attribute__((address_space(4))) Args* args_here() { const __attribute__((address_space(4))) Args* p = (const __attribute__((address_space(4))) Args*)__builtin_amdgcn_kernarg_segment_ptr(); asm volatile("" : "+s"(p)); return p; }
#ifndef REP_K
#define REP_K -1
#endif
__device__ __forceinline__ Ctx mkctx(int wave_s, unsigned char* lds) { Ctx c; c.wave = wave_s; c.lane = (int)__builtin_amdgcn_mbcnt_hi(~0u, __builtin_amdgcn_mbcnt_lo(~0u, 0u)); c.tid = wave_s * 64 + c.lane;
    c.gw = blockIdx.x * NWAVES + wave_s; c.ngw = gridDim.x * NWAVES; c.lds = lds; return c; }
#define PHASE1(k, ...) do { const __attribute__((address_space(4))) Args* ap_ = args_here(); if (ap_->ph_lo <= (k) && (k) < ap_->ph_hi) { ArgsR a = *ap_; const Ctx c = mkctx(wave_s, lds); __VA_ARGS__ } } while (0)
#define PHASE(k, ...) do { PHASE1(k, __VA_ARGS__); if ((k) == REP_K) { xcd_barrier(bar); PHASE1(k, __VA_ARGS__); xcd_barrier(bar); PHASE1(k, __VA_ARGS__); } } while (0)

template <int L>
__device__ __forceinline__ void run_layer(const int wave_s, unsigned char* lds, const XcdBarrier& bar) {
    const int G = gridDim.x, b = blockIdx.x;
#define BAR() do { xcd_barrier(bar); STAMP(3 + 14 * L + (bk_++)); } while (0)
    int bk_ = 0;
    PHASE(0, unsigned char* ws = a.ws; pg8::StaticOrder S; S.init(T, INC, G, b); EpiZ E{(bf16*)(ws + WS_ZR), (bf16*)(ws + WS_ZS), (bf16*)(ws + WS_ZG)};
        gemm_any(c, (const bf16*)(ws + WS_XN), (const bf16*)(ws + WS_WIN + (size_t)L * 10 * MiB), T, INC, D, S, E); );
    BAR();
    PHASE(1, phase_prep_fast(a, c, L); );
    PHASE(14, phase_sg_fast(a, c, L); );
    BAR();
    PHASE(2, phase_scan1m(a, c); );
    BAR();
    PHASE(3, phase_scan2a(a, c); );
    BAR();
    PHASE(31, phase_scan2b(a, c); );
    BAR();
    PHASE(32, phase_scan2c(a, c); );
    BAR();
    PHASE(4, phase_scan3m(a, c, L); );
    BAR();
    PHASE(6, unsigned char* ws = a.ws; pg8::StaticOrder S; S.init(T, D, G, b); EpiGA E{(const bf16*)(ws + WS_ZG), (bf16*)(ws + WS_MP)};
        gemm_any(c, (const bf16*)(ws + WS_YA), (const bf16*)(ws + WS_WA + (size_t)L * WS_WL1), T, D, W, S, E); );
    BAR();
#if REP_K == 7
    PHASE1(7, unsigned char* ws = a.ws; pg8::StaticOrder S; S.init(T, D, G, b); EpiGB E{(const bf16*)(ws + WS_ZG), (const bf16*)(ws + WS_MP), (bf16*)(ws + WS_ZR)};
        gemm_any(c, (const bf16*)(ws + WS_YB), (const bf16*)(ws + WS_WB + (size_t)L * WS_WL1), T, D, W, S, E); ); xcd_barrier(bar);
    PHASE1(7, unsigned char* ws = a.ws; pg8::StaticOrder S; S.init(T, D, G, b); EpiGB E{(const bf16*)(ws + WS_ZG), (const bf16*)(ws + WS_MP), (bf16*)(ws + WS_ZR)};
        gemm_any(c, (const bf16*)(ws + WS_YB), (const bf16*)(ws + WS_WB + (size_t)L * WS_WL1), T, D, W, S, E); ); xcd_barrier(bar);
#endif
#if REP_K == 8
    PHASE1(8, unsigned char* ws = a.ws; pg8::StaticOrder S; S.init(T, D, G, b); EpiOut E{L == 0 ? a.in[I_X] : a.out, (float*)(ws + WS_R), (const float*)(ws + WS_MODF) + L * 6144 + 2048};
        gemm_any(c, (const bf16*)(ws + WS_MP), (const bf16*)(ws + WS_WO + (size_t)L * WS_WL1), T, D, D, S, E); ); xcd_barrier(bar);
    PHASE1(8, unsigned char* ws = a.ws; pg8::StaticOrder S; S.init(T, D, G, b); EpiOut E{L == 0 ? a.in[I_X] : a.out, (float*)(ws + WS_R), (const float*)(ws + WS_MODF) + L * 6144 + 2048};
        gemm_any(c, (const bf16*)(ws + WS_MP), (const bf16*)(ws + WS_WO + (size_t)L * WS_WL1), T, D, D, S, E); ); xcd_barrier(bar);
#endif
    PHASE1(7, unsigned char* ws = a.ws; pg8::StaticOrder S; S.init(T, D, G, b); EpiGB E{(const bf16*)(ws + WS_ZG), (const bf16*)(ws + WS_MP), (bf16*)(ws + WS_MP)};
        gemm_any(c, (const bf16*)(ws + WS_YB), (const bf16*)(ws + WS_WB + (size_t)L * WS_WL1), T, D, W, S, E); );
    BAR();
    PHASE1(8, unsigned char* ws = a.ws; pg8::StaticOrder S; S.init(T, D, G, b); EpiOut E{L == 0 ? a.in[I_X] : a.out, a.out, (const float*)(ws + WS_MODF) + L * 6144 + 2048};
        gemm_any(c, (const bf16*)(ws + WS_MP), (const bf16*)(ws + WS_WO + (size_t)L * WS_WL1), T, D, D, S, E); );
    BAR();
#if REP_K == 9
    PHASE1(9, phase_ln1(a, c, L, (float*)(a.ws + WS_ZR)); ); xcd_barrier(bar); PHASE1(9, phase_ln1(a, c, L, (float*)(a.ws + WS_ZR)); ); xcd_barrier(bar);
#endif
    PHASE1(9, phase_ln1(a, c, L, a.out); );
    BAR();
    PHASE(10, phase_perm(a, c, L); );
    BAR();
    PHASE(11, unsigned char* ws = a.ws; MoeSched S; S.init((const unsigned*)(ws + WS_TOT), G, b); EpiSwi E{(bf16*)(ws + WS_HID)};
        gemm_any(c, (const bf16*)(ws + WS_XS), (const bf16*)(ws + WS_WGU), MAXSLOT, NE * 1024, D, S, E); );
    BAR();
    PHASE(12, unsigned char* ws = a.ws; MoeSched S; S.init((const unsigned*)(ws + WS_TOT), G, b); EpiDown E{(const int*)(ws + WS_S2T), (const float*)(ws + WS_TOKW), (bf16*)(ws + WS_Y)};
        gemm_any(c, (const bf16*)(ws + WS_HID), (const bf16*)(ws + WS_WD), MAXSLOT, NE * 1024, FF, S, E); );
    BAR();
#if REP_K == 13
    PHASE1(13, phase_ln2(a, c, L, (float*)(a.ws + WS_R)); ); xcd_barrier(bar); PHASE1(13, phase_ln2(a, c, L, (float*)(a.ws + WS_R)); ); xcd_barrier(bar);
#endif
    PHASE1(13, phase_ln2(a, c, L, a.out); );
    if (L + 1 < DEPTH) BAR();
    (void)bk_;
#undef BAR
}

__global__ void __launch_bounds__(NTHREADS, 2) mk_fwd(Args a_unused) {
    extern __shared__ __attribute__((aligned(16))) unsigned char lds[];
    const int wave_s = __builtin_amdgcn_readfirstlane(threadIdx.x >> 6);
    for (int u = threadIdx.x; u < (LDS_BYTES - LDSCTL_OFF) / 4; u += NTHREADS) ((LAS unsigned*)((LAS unsigned char*)lds + LDSCTL_OFF))[u] = 0u;
    __syncthreads();
    const XcdBarrier bar = xcd_barrier_post((unsigned*)(args_here()->ws + WS_CTL) + CW_BAR, (volatile LAS unsigned*)((LAS unsigned char*)lds + LDSCTL_OFF) + 8);
    STAMP(0);
    PHASE(100, phase_p0a(a, c); );
    xcd_barrier(bar); STAMP(1);
    PHASE(101, phase_p0b(a, c); );
    xcd_barrier(bar); STAMP(2);
    run_layer<0>(wave_s, lds, bar);
    run_layer<1>(wave_s, lds, bar);
#if PROBE_A >= 0
    if (blockIdx.x == 0) {
        asm volatile("s_waitcnt vmcnt(0)" ::: "memory"); __syncthreads();
        if (threadIdx.x == 0) ((unsigned long long*)(args_here()->ws + WS_TS))[30] = __builtin_amdgcn_s_memrealtime();
        asm volatile("s_waitcnt vmcnt(0)" ::: "memory"); __syncthreads();
        const volatile unsigned long long* ts = (const volatile unsigned long long*)(args_here()->ws + WS_TS);
        float da = 0.f, db = 0.f;
        if (PROBE_A < 14) { da = (float)(ts[3 + PROBE_A] - ts[2 + PROBE_A]) + (float)(ts[17 + PROBE_A] - ts[16 + PROBE_A]); } else if (PROBE_A == 14) da = (float)(ts[1] - ts[0]); else if (PROBE_A == 15) da = (float)(ts[2] - ts[1]); else da = (float)(ts[30] - ts[0]);
        if (PROBE_B >= 0 && PROBE_B < 14) { db = (float)(ts[3 + PROBE_B] - ts[2 + PROBE_B]) + (float)(ts[17 + PROBE_B] - ts[16 + PROBE_B]); } else if (PROBE_B == 14) db = (float)(ts[1] - ts[0]); else if (PROBE_B == 15) db = (float)(ts[2] - ts[1]);
        da *= 0.01f; db *= 0.01f;
        da = exp2f(0.25f * rintf(4.0f * log2f(fmaxf(da, 0.5f)))); db = exp2f(0.25f * rintf(4.0f * log2f(fmaxf(db, 0.5f))));
        float* out = args_here()->out;
        for (int i = threadIdx.x; i < 16 * 1024; i += NTHREADS) { const int r = i >> 10, col = i & 1023; const int rowi = (r & 7) + 2048 * (r >> 3); out[(size_t)rowi * D + col] = da; }
        if (threadIdx.x == 0 && PROBE_B >= 0) out[(size_t)4096 * D] = 100.0f * db;
    }
#endif
}

extern "C" void kernel_launch(void* const* d_in, const int* in_sizes, int n_in, void* d_out, int out_size, void* d_ws, size_t ws_size, hipStream_t stream) {
    static int grid = 0;
    if (grid == 0) {
        if (n_in != N_IN || out_size != T * D || ws_size < WS_END2) { fprintf(stderr, "kernel_launch: unexpected shapes: n_in %d out %d ws %zu (need %zu)\n", n_in, out_size, ws_size, (size_t)WS_END2); grid = -1; return; }
        int dev = 0, cus = 0;
        (void)hipGetDevice(&dev); (void)hipDeviceGetAttribute(&cus, hipDeviceAttributeMultiprocessorCount, dev);
        if (hipFuncSetAttribute((const void*)mk_fwd, hipFuncAttributeMaxDynamicSharedMemorySize, LDS_BYTES) != hipSuccess) { fprintf(stderr, "kernel_launch: hipFuncSetAttribute failed\n"); grid = -1; return; }
        grid = cus > 0 ? cus : 256;
        fprintf(stderr, "kernel_launch: ws_size %zu grid %d\n", ws_size, grid);
    }
    if (grid < 0) return;
    (void)hipMemsetAsync((char*)d_ws + WS_CTL, 0, CTL_BYTES, stream);
    Args a{};
    for (int i = 0; i < N_IN; ++i) a.in[i] = (const float*)d_in[i];
    a.out = (float*)d_out; a.ws = (unsigned char*)d_ws;
    a.ph_lo = 0; a.ph_hi = 1000;
    hipLaunchKernelGGL(mk_fwd, dim3(grid), dim3(NTHREADS), LDS_BYTES, stream, a);
}
```

```cpp
#include <hip/hip_runtime.h>
#include <cstdio>
#include <cstdint>
#include <utility>

typedef unsigned short bf16;
typedef _Float16 f16;
typedef float f32x4 __attribute__((ext_vector_type(4)));
typedef unsigned u32x4 __attribute__((ext_vector_type(4)));
typedef unsigned u32x2 __attribute__((ext_vector_type(2)));

constexpr int T = 16384, D = 1024, W = 512, NH = 8, HN = 64, RC = 1792, INC = 4864;
constexpr int NE = 16, FF = 512, DEPTH = 2;
constexpr float LN_EPS = 1e-5f, GN_EPS = 64e-5f, ALPHA = 1.41421356237f;
constexpr int NTHREADS = 512, NWAVES = 8;
constexpr int MAXSLOT = 36864;

constexpr size_t MiB = 1u << 20;
constexpr size_t WS_CTL = 0, CTL_BYTES = 1 * MiB;
constexpr int CW_CNT = 16384;
constexpr size_t WS_PART = 1 * MiB;
constexpr size_t WS_MODF = 2 * MiB;
constexpr size_t WS_TOKI = 2 * MiB + 65536;
constexpr size_t WS_TOKW = WS_TOKI + 131072;
constexpr size_t WS_TOKP = WS_TOKW + 131072;
constexpr size_t WS_S2T = 3 * MiB;
constexpr size_t WS_BLKCNT = 3 * MiB + 512 * 1024;
constexpr size_t WS_TOT = WS_BLKCNT + 32768;
constexpr size_t WS_LORA = 4 * MiB;
constexpr size_t WS_WIN = 8 * MiB;
constexpr size_t WS_WA = 28 * MiB, WS_WB = 29 * MiB, WS_WO = 30 * MiB, WS_WL1 = 4 * MiB;
constexpr size_t WS_ZG = 36 * MiB;
constexpr size_t WS_XN = 100 * MiB;
constexpr size_t WS_G = 100 * MiB, WS_YB = 116 * MiB;
constexpr size_t WS_ZR = 132 * MiB;
constexpr size_t WS_ZS = 188 * MiB;
constexpr size_t WS_YSC = 132 * MiB;
constexpr size_t WS_ST = 148 * MiB;
constexpr size_t WS_YA = 132 * MiB;
constexpr size_t WS_MP = 164 * MiB;
constexpr size_t WS_XS = 132 * MiB;
constexpr size_t WS_Y = 132 * MiB;
constexpr size_t WS_R = 224 * MiB, WS_WM1 = 240 * MiB, WS_KP = 256 * MiB, WS_AA = 272 * MiB, WS_BB = 288 * MiB, WS_V = 304 * MiB;
constexpr size_t WS_WGU = 224 * MiB;
constexpr size_t WS_WD = 256 * MiB;
constexpr size_t WS_HID = 272 * MiB;
constexpr size_t WS_VF = 320 * MiB;
constexpr size_t WS_END = 336 * MiB;

constexpr size_t LO_W2T = 0, LO_A2T = 65536, LO_G2T = 131072, LO_VM1T = 262144, LO_VM2T = 294912, LO_STRIDE = 524288;

enum { I_X = 0, I_C, I_WMOD, I_BMOD, I_WIN, I_MU, I_W0, I_W2, I_A0, I_A2, I_G2, I_KK, I_KA, I_RK, I_GNG, I_GNB, I_VM0, I_VM1, I_VM2,
       I_SGG, I_SGB, I_WS, I_BS, I_WBA, I_WBB, I_WOUT, I_LN1G, I_LN1B, I_RW, I_RB, I_EG, I_EU, I_ED, I_LN2G, I_LN2B, N_IN };

struct Args { const float* in[N_IN]; float* out; unsigned char* ws; int ph_lo, ph_hi; };
typedef const __attribute__((address_space(4))) Args& ArgsR;

__device__ __forceinline__ float bf2f(bf16 h) { return __uint_as_float(((unsigned)h) << 16); }
__device__ __forceinline__ unsigned f2bfu(float f) { unsigned u = __float_as_uint(f); return (u + 0x7fffu + ((u >> 16) & 1u)) >> 16; }
__device__ __forceinline__ bf16 f2bf(float f) { return __builtin_bit_cast(unsigned short, (__bf16)f); }
typedef __bf16 bf16x2_t __attribute__((ext_vector_type(2)));
__device__ __forceinline__ unsigned pk2(float lo, float hi) { bf16x2_t v; v[0] = (__bf16)lo; v[1] = (__bf16)hi; return __builtin_bit_cast(unsigned, v); }
__device__ __forceinline__ void store4bf(bf16* p, f32x4 v) { u32x2 w; w.x = pk2(v[0], v[1]); w.y = pk2(v[2], v[3]); *(u32x2*)p = w; }
__device__ __forceinline__ f32x4 load4bf(const bf16* p) { u32x2 w = *(const u32x2*)p; f32x4 r; r[0] = __uint_as_float(w.x << 16); r[1] = __uint_as_float(w.x & 0xffff0000u); r[2] = __uint_as_float(w.y << 16); r[3] = __uint_as_float(w.y & 0xffff0000u); return r; }
__device__ __forceinline__ float wave_sum(float v) {
#pragma unroll
    for (int o = 1; o < 64; o <<= 1) v += __shfl_xor(v, o);
    return v;
}
__device__ __forceinline__ float sigmoidf_(float x) { return __builtin_amdgcn_rcpf(1.0f + __expf(-x)); }
__device__ __forceinline__ float siluf_(float x) { return x * sigmoidf_(x); }
__device__ __forceinline__ float gelu_tanh(float x) { const float u = 0.7978845608028654f * (x + 0.044715f * x * x * x); return x * (1.0f - __builtin_amdgcn_rcpf(1.0f + __expf(2.0f * u))); }
__device__ __forceinline__ float softplusf_(float y) { return fmaxf(y, 0.f) + log1pf(__expf(-fabsf(y))); }

struct Ctx { int tid, lane, wave, gw, ngw; unsigned char* lds; };

__device__ __forceinline__ void transpose_item(const float* Wsrc, int N, int k0, int n0, bf16* dst, int ldk, float* scr, int lane) {
    float tv[32];
#pragma unroll
    for (int i = 0; i < 32; ++i) tv[i] = Wsrc[(size_t)(k0 + 2 * i + (lane >> 5)) * N + n0 + (lane & 31)];
#pragma unroll
    for (int i = 0; i < 32; ++i) scr[(2 * i + (lane >> 5)) * 33 + (lane & 31)] = tv[i];
    asm volatile("s_waitcnt lgkmcnt(0)" ::: "memory");
    const int c = lane & 7;
#pragma unroll
    for (int j = 0; j < 4; ++j) { const int n = (lane >> 3) + 8 * j; const float* s = scr + (8 * c) * 33 + n;
        u32x4 o; o.x = pk2(s[0 * 33], s[1 * 33]); o.y = pk2(s[2 * 33], s[3 * 33]); o.z = pk2(s[4 * 33], s[5 * 33]); o.w = pk2(s[6 * 33], s[7 * 33]);
        *(u32x4*)(dst + (size_t)n * ldk + k0 + 8 * c) = o; }
    asm volatile("s_waitcnt lgkmcnt(0)" ::: "memory");
}
template <class RowMap>
__device__ __forceinline__ void transpose_matrix_item(const float* Wsrc, int K, int N, bf16* dst, int item, float* scr, int lane, const RowMap& rm) {
    const int nblk = N / 32, kb = item / nblk, nb = item % nblk, n0 = 32 * nb;
    transpose_item(Wsrc, N, 64 * kb, n0, dst + (size_t)rm(n0) * K, K, scr, lane);
}
struct RowId { __device__ __forceinline__ int operator()(int n) const { return n; } };
struct RowGU { int up; __device__ __forceinline__ int operator()(int n) const { return (n >> 7) * 256 + (n & 127) + up * 128; } };

__device__ __forceinline__ void phase_p0a(ArgsR a, const Ctx& c) {
    float* scr = (float*)(c.lds + c.wave * 16384);
    { float* MODF = (float*)(a.ws + WS_MODF); float* red = (float*)(c.lds + 131072);
      for (int cbk = blockIdx.x; cbk < 2 * 96; cbk += gridDim.x) {
          const int l = cbk / 96, n = (cbk % 96) * 64 + c.lane;
          const float* wm = a.in[I_WMOD] + (size_t)l * D * 6144 + (size_t)(c.wave * 128) * 6144 + n;
          float acc0 = 0.f, acc1 = 0.f;
#pragma unroll 16
          for (int k = 0; k < 128; k += 2) { acc0 += siluf_(a.in[I_C][c.wave * 128 + k]) * wm[(size_t)k * 6144]; acc1 += siluf_(a.in[I_C][c.wave * 128 + k + 1]) * wm[(size_t)(k + 1) * 6144]; }
          red[c.wave * 64 + c.lane] = acc0 + acc1;
          __syncthreads();
          if (c.wave == 0) { float sacc = a.in[I_BMOD][l * 6144 + n];
#pragma unroll
              for (int w = 0; w < 8; ++w) sacc += red[w * 64 + c.lane];
              MODF[l * 6144 + n] = sacc; }
          __syncthreads();
      } }
    for (int it = c.gw; it < 2 * (16 + 16 + 32 + 8); it += c.ngw) {
        const int l = it / 72; int r = it % 72; unsigned char* lo = a.ws + WS_LORA + (size_t)l * LO_STRIDE;
        if (r < 16) { transpose_matrix_item(a.in[I_W2] + (size_t)l * 64 * W, 64, W, (bf16*)(lo + LO_W2T), r, scr, c.lane, RowId()); continue; } r -= 16;
        if (r < 16) { transpose_matrix_item(a.in[I_A2] + (size_t)l * 64 * W, 64, W, (bf16*)(lo + LO_A2T), r, scr, c.lane, RowId()); continue; } r -= 16;
        if (r < 32) { transpose_matrix_item(a.in[I_G2] + (size_t)l * 128 * W, 128, W, (bf16*)(lo + LO_G2T), r, scr, c.lane, RowId()); continue; } r -= 32;
        if (l == 1) transpose_matrix_item(a.in[I_VM1], W, 32, (bf16*)(lo + LO_VM1T), r, scr, c.lane, RowId());
    }
    for (int i = blockIdx.x * NTHREADS + c.tid; i < 32 * W; i += gridDim.x * NTHREADS) { const int n = i >> 5, k = i & 31;
        ((bf16*)(a.ws + WS_LORA + LO_STRIDE + LO_VM2T))[i] = f2bf(a.in[I_VM2][(size_t)k * W + n]); }
    constexpr int I_WINL = (D / 64) * (INC / 32);
    constexpr int I_WAL = (W / 64) * (D / 32);
    constexpr int I_WOL = (D / 64) * (D / 32);
    constexpr int PER_L = I_WINL + 2 * I_WAL + I_WOL;
    for (int it = c.gw; it < 2 * PER_L; it += c.ngw) {
        const int l = it / PER_L; int r = it % PER_L;
        if (r < I_WINL) { transpose_matrix_item(a.in[I_WIN] + (size_t)l * D * INC, D, INC, (bf16*)(a.ws + WS_WIN + (size_t)l * 10 * MiB), r, scr, c.lane, RowId()); continue; } r -= I_WINL;
        if (r < I_WAL) { transpose_matrix_item(a.in[I_WBA] + (size_t)l * W * D, W, D, (bf16*)(a.ws + WS_WA + (size_t)l * WS_WL1), r, scr, c.lane, RowId()); continue; } r -= I_WAL;
        if (r < I_WAL) { transpose_matrix_item(a.in[I_WBB] + (size_t)l * W * D, W, D, (bf16*)(a.ws + WS_WB + (size_t)l * WS_WL1), r, scr, c.lane, RowId()); continue; } r -= I_WAL;
        transpose_matrix_item(a.in[I_WOUT] + (size_t)l * D * D, D, D, (bf16*)(a.ws + WS_WO + (size_t)l * WS_WL1), r, scr, c.lane, RowId());
    }
}

__device__ __forceinline__ void row_stats(const float (&v)[16], float& mean, float& rstd) {
    float s = 0.f;
#pragma unroll
    for (int j = 0; j < 16; ++j) s += v[j];
    mean = wave_sum(s) * (1.f / D);
    float q = 0.f;
#pragma unroll
    for (int j = 0; j < 16; ++j) { const float d = v[j] - mean; q += d * d; }
    rstd = __builtin_amdgcn_rsqf(wave_sum(q) * (1.f / D) + LN_EPS);
}
__device__ __forceinline__ void load_row16(const float* p, int lane, float (&v)[16]) {
#pragma unroll
    for (int j = 0; j < 4; ++j) { const f32x4 x = *(const f32x4*)(p + 4 * lane + 256 * j); v[4 * j] = x[0]; v[4 * j + 1] = x[1]; v[4 * j + 2] = x[2]; v[4 * j + 3] = x[3]; }
}

__device__ __forceinline__ void phase_p0b(ArgsR a, const Ctx& c) {
    const float* MODF = (const float*)(a.ws + WS_MODF);
    float sh[16], sc[16];
#pragma unroll
    for (int j = 0; j < 4; ++j) { const f32x4 s0 = *(const f32x4*)(MODF + 4 * c.lane + 256 * j), s1 = *(const f32x4*)(MODF + 1024 + 4 * c.lane + 256 * j);
#pragma unroll
        for (int e = 0; e < 4; ++e) { sh[4 * j + e] = s0[e]; sc[4 * j + e] = 1.f + s1[e]; } }
    bf16* XN = (bf16*)(a.ws + WS_XN);
    for (int m = c.gw; m < T; m += c.ngw) {
        float v[16]; load_row16(a.in[I_X] + (size_t)m * D, c.lane, v);
        float mean, rstd; row_stats(v, mean, rstd);
#pragma unroll
        for (int j = 0; j < 4; ++j) { f32x4 o;
#pragma unroll
            for (int e = 0; e < 4; ++e) o[e] = (v[4 * j + e] - mean) * rstd * sc[4 * j + e] + sh[4 * j + e];
            store4bf(XN + (size_t)m * D + 4 * c.lane + 256 * j, o); }
    }
}

namespace pg8 {
#define PG8_LAS __attribute__((address_space(3)))
typedef unsigned short bf16_t;
typedef short bf16x8 __attribute__((ext_vector_type(8)));
typedef float f32x4 __attribute__((ext_vector_type(4)));
typedef unsigned u32x4 __attribute__((ext_vector_type(4)));
constexpr int BM = 256, BK = 64, HALF = 128, HTB = HALF * BK * 2  , STAGE_BYTES = 8 * HTB, NXCD = 8, WGM = 8;

__host__ __device__ __forceinline__ int lds_byte(int r, int c) { const int st = (r >> 4) * 2 + (c >> 5), rr = r & 15, cc = c & 31, ob = rr * 64 + cc * 2; return st * 1024 + (ob ^ (((ob >> 9) & 1) << 5)); }
__host__ __device__ __forceinline__ void stage_rc(int b, int& R, int& C) { const int st = b / 1024, sb = b % 1024, swz = sb ^ (((sb >> 9) & 1) << 5); R = (st >> 1) * 16 + swz / 64; C = (st & 1) * 32 + (swz % 64) / 2; }
__host__ __device__ __forceinline__ int perm32(int rho) { const int n = rho >> 4, i = rho & 15; return 8 * (i >> 2) + 4 * n + (i & 3); }

struct Unit { int pm, pn; };
struct Gemm { const bf16_t* A; const bf16_t* Bt; int M, N, K; };

struct StaticOrder {
    int nM, nN, nwg, G, c;
    __host__ __device__ void init(int M, int N, int G_, int c_) { nM = M / BM; nN = N / BM; nwg = nM * nN; G = G_; c = c_; }
    __host__ __device__ bool next(int i, Unit& u) const {
        const long L = (long)i * G + c; if (L >= nwg) return false;
        int wgid = (int)L; { const int q = nwg / NXCD, r = nwg % NXCD, xcd = wgid % NXCD, off = wgid / NXCD; wgid = (xcd < r ? xcd * (q + 1) : r * (q + 1) + (xcd - r) * q) + off; }
        const int nig = WGM * nN, gid = wgid / nig, fm = gid * WGM, gsz = (nM - fm) < WGM ? (nM - fm) : WGM;
        u.pm = fm + ((wgid % nig) % gsz); u.pn = (wgid % nig) / gsz; return true;
    }
    __device__ __forceinline__ void a_ready(const Unit&) const {}
    __device__ __forceinline__ void done(const Unit&) const {}
};


template <class Epi, class Sched, bool ALIGN_EPI = false, bool SP2 = false>
__device__ __forceinline__ void gemm_phase(PG8_LAS unsigned char* lds, const Gemm g, const Sched& S, const Epi& E, const int tid_in) {
    const int tid = tid_in, wid = __builtin_amdgcn_readfirstlane(tid >> 6), lane = tid & 63, wr = wid >> 2, wc = wid & 3, fr = lane & 15, fq = lane >> 4;
    const int K = g.K, nt = K / BK;
    unsigned voffA[2], voffB[2];
#pragma unroll
    for (int i = 0; i < 2; ++i) { int R, C; stage_rc(tid * 16 + i * 8192, R, C); const int Rb = Epi::PERM ? ((R & ~31) + perm32(R & 31)) : R;
        voffA[i] = (unsigned)(R * K + C) * 2u; voffB[i] = (unsigned)(Rb * K + C) * 2u; }
    const size_t kstep = (size_t)(BK * 2);
    const size_t hstep = (size_t)HALF * K * 2;
    const size_t tstep = 2 * hstep;
    const unsigned ldsw = (unsigned)wid * 1024u;
    const int aoff = lds_byte(wr * 64 + fr, fq * 8), boff = lds_byte(wc * 32 + fr, fq * 8);
#define PG8_SA(b, h) (((b) * 2 + (h)) * HTB)
#define PG8_SB(b, h) ((4 + (b) * 2 + (h)) * HTB)
#define PG8_STAGE(bufoff, gbase, voff) do { _Pragma("unroll") for (int _i = 0; _i < 2; ++_i) \
        __builtin_amdgcn_global_load_lds((const unsigned*)((const char*)(gbase) + (voff)[_i]), (PG8_LAS unsigned*)(lds + (bufoff) + ldsw + _i * 8192), 16, 0, 0); } while (0)
#define PG8_LDA(dst, b, h) do { _Pragma("unroll") for (int m = 0; m < 4; ++m) _Pragma("unroll") for (int k = 0; k < 2; ++k) dst[m][k] = *(const PG8_LAS bf16x8*)(lds + PG8_SA(b, h) + aoff + m * 2048 + k * 1024); } while (0)
#define PG8_LDB(dst, b, h) do { _Pragma("unroll") for (int n = 0; n < 2; ++n) _Pragma("unroll") for (int k = 0; k < 2; ++k) dst[n][k] = *(const PG8_LAS bf16x8*)(lds + PG8_SB(b, h) + boff + n * 2048 + k * 1024); } while (0)
#define PG8_MMA(ai, bj, At, Bt) do { __builtin_amdgcn_s_setprio(1); _Pragma("unroll") for (int m = 0; m < 4; ++m) _Pragma("unroll") for (int n = 0; n < 2; ++n) _Pragma("unroll") for (int k = 0; k < 2; ++k) \
        acc[ai][bj][m][n] = __builtin_amdgcn_mfma_f32_16x16x32_bf16(Bt[n][k], At[m][k], acc[ai][bj][m][n], 0, 0, 0); __builtin_amdgcn_s_setprio(0); } while (0)
#define PG8_WAIT_V(n) asm volatile("s_waitcnt vmcnt(" #n ")" ::: "memory")
#define PG8_WAIT_L(n) asm volatile("s_waitcnt lgkmcnt(" #n ")" ::: "memory")
#define PG8_BAR __builtin_amdgcn_s_barrier()
#define PG8_SCHED __builtin_amdgcn_sched_barrier(0)
    Unit cur, nxt; int ui = 0;
    if (!S.next(0, cur)) return;
    f32x4 acc[2][2][4][2];
#pragma unroll
    for (int a = 0; a < 2; ++a)
#pragma unroll
        for (int b = 0; b < 2; ++b)
#pragma unroll
            for (int m = 0; m < 4; ++m)
#pragma unroll
                for (int n = 0; n < 2; ++n) acc[a][b][m][n] = (f32x4){0.f, 0.f, 0.f, 0.f};
    bf16x8 At[4][2], B0[2][2], B1[2][2];
    const char* cA = (const char*)g.A + (size_t)cur.pm * tstep; const char* cB = (const char*)g.Bt + (size_t)cur.pn * tstep;
    S.a_ready(cur);
    if constexpr (SP2) {
        PG8_STAGE(PG8_SB(0, 0), cB, voffB); PG8_STAGE(PG8_SB(0, 1), cB + hstep, voffB); PG8_STAGE(PG8_SA(0, 0), cA, voffA); PG8_STAGE(PG8_SA(0, 1), cA + hstep, voffA);
        if (wr == 1) PG8_BAR;
        PG8_WAIT_V(2); PG8_BAR;
        PG8_STAGE(PG8_SB(1, 0), cB + kstep, voffB); PG8_STAGE(PG8_SA(1, 0), cA + kstep, voffA); PG8_STAGE(PG8_SB(1, 1), cB + hstep + kstep, voffB);
        PG8_WAIT_V(6); PG8_BAR;
    } else {
        PG8_STAGE(PG8_SB(0, 0), cB, voffB); PG8_STAGE(PG8_SA(0, 0), cA, voffA); PG8_STAGE(PG8_SB(0, 1), cB + hstep, voffB); PG8_STAGE(PG8_SA(0, 1), cA + hstep, voffA);
        if (wr == 1) PG8_BAR;
        PG8_WAIT_V(4); PG8_BAR;
        PG8_STAGE(PG8_SB(1, 0), cB + kstep, voffB); PG8_STAGE(PG8_SA(1, 0), cA + kstep, voffA); PG8_STAGE(PG8_SB(1, 1), cB + hstep + kstep, voffB);
        PG8_WAIT_V(6); PG8_BAR;
    }
    for (;;) {
        const bool has_next = S.next(ui + 1, nxt);
        const char* nA = has_next ? (const char*)g.A + (size_t)nxt.pm * tstep : cA; const char* nB = has_next ? (const char*)g.Bt + (size_t)nxt.pn * tstep : cB;
        for (int t = 0; t < nt; t += 2) {
            const bool last = (t == nt - 2);
            const char* a1 = cA + (size_t)(t + 1) * kstep;
            const char* a2 = last ? nA : cA + (size_t)(t + 2) * kstep; const char* b2 = last ? nB : cB + (size_t)(t + 2) * kstep;
            const char* a3 = a2 + kstep; const char* b3 = b2 + kstep;
            if (last && has_next) S.a_ready(nxt);
            if constexpr (SP2) {
            PG8_LDB(B0, 0, 0); PG8_LDB(B1, 0, 1); PG8_SCHED; PG8_LDA(At, 0, 0); PG8_STAGE(PG8_SA(1, 1), a1 + hstep, voffA);
            PG8_WAIT_V(8); PG8_WAIT_L(0); PG8_BAR; PG8_MMA(0, 0, At, B0); PG8_MMA(0, 1, At, B1); PG8_BAR; PG8_SCHED;
            PG8_LDA(At, 0, 1); PG8_STAGE(PG8_SB(0, 0), b2, voffB); PG8_STAGE(PG8_SB(0, 1), b2 + hstep, voffB); PG8_STAGE(PG8_SA(0, 0), a2, voffA);
            PG8_WAIT_V(8); PG8_WAIT_L(0); PG8_BAR; PG8_MMA(1, 0, At, B0); PG8_MMA(1, 1, At, B1); PG8_BAR; PG8_SCHED;
            PG8_LDB(B0, 1, 0); PG8_LDB(B1, 1, 1); PG8_SCHED; PG8_LDA(At, 1, 0); PG8_STAGE(PG8_SA(0, 1), a2 + hstep, voffA);
            PG8_WAIT_V(8); PG8_WAIT_L(0); PG8_BAR; PG8_MMA(0, 0, At, B0); PG8_MMA(0, 1, At, B1); PG8_BAR; PG8_SCHED;
            PG8_LDA(At, 1, 1); PG8_STAGE(PG8_SB(1, 0), b3, voffB); PG8_STAGE(PG8_SB(1, 1), b3 + hstep, voffB); PG8_STAGE(PG8_SA(1, 0), a3, voffA);
            PG8_WAIT_V(8); PG8_WAIT_L(0); PG8_BAR; PG8_MMA(1, 0, At, B0); PG8_MMA(1, 1, At, B1); PG8_BAR; PG8_SCHED;
            } else {
            PG8_LDB(B0, 0, 0); PG8_SCHED; PG8_LDA(At, 0, 0); PG8_STAGE(PG8_SA(1, 1), a1 + hstep, voffA);
            PG8_WAIT_L(8); PG8_BAR; PG8_WAIT_L(0); PG8_MMA(0, 0, At, B0); PG8_BAR; PG8_SCHED;
            PG8_LDB(B1, 0, 1); PG8_STAGE(PG8_SB(0, 0), b2, voffB);
            PG8_BAR; PG8_WAIT_L(0); PG8_MMA(0, 1, At, B1); PG8_BAR;
            PG8_LDA(At, 0, 1); PG8_STAGE(PG8_SA(0, 0), a2, voffA);
            PG8_BAR; PG8_WAIT_L(0); PG8_MMA(1, 0, At, B0); PG8_BAR; PG8_SCHED;
            PG8_STAGE(PG8_SB(0, 1), b2 + hstep, voffB);
            PG8_WAIT_V(6); PG8_BAR; PG8_MMA(1, 1, At, B1); PG8_BAR;
            PG8_LDB(B0, 1, 0); PG8_SCHED; PG8_LDA(At, 1, 0); PG8_STAGE(PG8_SA(0, 1), a2 + hstep, voffA);
            PG8_WAIT_L(8); PG8_BAR; PG8_WAIT_L(0); PG8_MMA(0, 0, At, B0); PG8_BAR; PG8_SCHED;
            PG8_LDB(B1, 1, 1); PG8_STAGE(PG8_SB(1, 0), b3, voffB);
            PG8_BAR; PG8_WAIT_L(0); PG8_MMA(0, 1, At, B1); PG8_BAR;
            PG8_LDA(At, 1, 1); PG8_STAGE(PG8_SA(1, 0), a3, voffA);
            PG8_BAR; PG8_WAIT_L(0); PG8_MMA(1, 0, At, B0); PG8_BAR; PG8_SCHED;
            PG8_STAGE(PG8_SB(1, 1), b3 + hstep, voffB);
            PG8_WAIT_V(6); PG8_BAR; PG8_MMA(1, 1, At, B1); PG8_BAR;
            }
        }
        if constexpr (ALIGN_EPI) { if (wr == 0) PG8_BAR; }
        if constexpr (!Epi::AFTER_DRAIN) { E(acc, cur, wr, wc, fr, fq); S.done(cur); }
        if (!has_next) break;
#pragma unroll
        for (int a = 0; a < 2; ++a)
#pragma unroll
            for (int b = 0; b < 2; ++b)
#pragma unroll
                for (int m = 0; m < 4; ++m)
#pragma unroll
                    for (int n = 0; n < 2; ++n) acc[a][b][m][n] = (f32x4){0.f, 0.f, 0.f, 0.f};
        cur = nxt; cA = nA; cB = nB; ++ui;
        if constexpr (ALIGN_EPI) { if (wr == 1) PG8_BAR; }
    }
    PG8_WAIT_V(0);
    if constexpr (!ALIGN_EPI) { if (wr == 0) PG8_BAR; }
    PG8_BAR;
    if constexpr (Epi::AFTER_DRAIN) { E.fused(acc, cur, wr, wc, fr, fq, lds, wid, lane); S.done(cur); }
#undef PG8_SA
#undef PG8_SB
#undef PG8_STAGE
#undef PG8_LDA
#undef PG8_LDB
#undef PG8_MMA
#undef PG8_WAIT_V
#undef PG8_WAIT_L
#undef PG8_BAR
#undef PG8_SCHED
}
}

using pg8::Unit;
struct DenseSched { int nN, n, G, c;
    __device__ __forceinline__ void a_ready(const Unit&) const {}
    __device__ __forceinline__ void done(const Unit&) const {}
    __device__ __forceinline__ bool next(int i, Unit& u) const { const int L = i * G + c; if (L >= n) return false; u.pm = L / nN; u.pn = L % nN; return true; } };

__device__ __forceinline__ void store8bf(bf16* p, f32x4 lo, f32x4 hi) { u32x4 w; w.x = pk2(lo[0], lo[1]); w.y = pk2(lo[2], lo[3]); w.z = pk2(hi[0], hi[1]); w.w = pk2(hi[2], hi[3]); *(u32x4*)p = w; }
__device__ __forceinline__ void load8bf(const bf16* p, f32x4& lo, f32x4& hi) { const u32x4 w = *(const u32x4*)p;
    lo[0] = __uint_as_float(w.x << 16); lo[1] = __uint_as_float(w.x & 0xffff0000u); lo[2] = __uint_as_float(w.y << 16); lo[3] = __uint_as_float(w.y & 0xffff0000u);
    hi[0] = __uint_as_float(w.z << 16); hi[1] = __uint_as_float(w.z & 0xffff0000u); hi[2] = __uint_as_float(w.w << 16); hi[3] = __uint_as_float(w.w & 0xffff0000u); }
struct EpiZ { bf16 *ZR, *ZS, *ZG;
    __device__ __forceinline__ void one(int row, int col, f32x4 lo, f32x4 hi) const {
        if (col < RC) store8bf(ZR + (size_t)row * RC + col, lo, hi);
        else if (col < RC + 1024) { for (int e = 0; e < 4; ++e) { lo[e] = gelu_tanh(lo[e]); hi[e] = gelu_tanh(hi[e]); } store8bf(ZS + (size_t)row * 1024 + (col - RC), lo, hi); }
        else { for (int e = 0; e < 4; ++e) { lo[e] = sigmoidf_(lo[e]); hi[e] = sigmoidf_(hi[e]); } store8bf(ZG + (size_t)row * 2048 + (col - RC - 1024), lo, hi); } }
    __device__ __forceinline__ void operator()(int row, int col, f32x4 a0, f32x4 a1, f32x4 b0, f32x4 b1) const { one(row, col, a0, a1); one(row, col + 128, b0, b1); } };
struct EpiGA { const bf16* ZG; bf16* MP;
    __device__ __forceinline__ void one(int row, int col, f32x4 lo, f32x4 hi) const { f32x4 g0, g1; load8bf(ZG + (size_t)row * 2048 + col, g0, g1); store8bf(MP + (size_t)row * D + col, g0 * lo, g1 * hi); }
    __device__ __forceinline__ void operator()(int row, int col, f32x4 a0, f32x4 a1, f32x4 b0, f32x4 b1) const { one(row, col, a0, a1); one(row, col + 128, b0, b1); } };
struct EpiGB { const bf16* ZG; const bf16* MPin; bf16* MP;
    __device__ __forceinline__ void one(int row, int col, f32x4 lo, f32x4 hi) const { f32x4 g0, g1, m0, m1; load8bf(ZG + (size_t)row * 2048 + 1024 + col, g0, g1); load8bf(MPin + (size_t)row * D + col, m0, m1);
        store8bf(MP + (size_t)row * D + col, m0 + g0 * lo, m1 + g1 * hi); }
    __device__ __forceinline__ void operator()(int row, int col, f32x4 a0, f32x4 a1, f32x4 b0, f32x4 b1) const { one(row, col, a0, a1); one(row, col + 128, b0, b1); } };
struct EpiOut { const float* xin; float* out; const float* gate1;
    __device__ __forceinline__ void one(int row, int col, f32x4 v) const { const f32x4 x = *(const f32x4*)(xin + (size_t)row * D + col); const f32x4 g = *(const f32x4*)(gate1 + col);
        *(f32x4*)(out + (size_t)row * D + col) = ALPHA * x + (1.0f + g) * v; }
    __device__ __forceinline__ void operator()(int row, int col, f32x4 a0, f32x4 a1, f32x4 b0, f32x4 b1) const { one(row, col, a0); one(row, col + 4, a1); one(row, col + 128, b0); one(row, col + 132, b1); } };
struct EpiSwi { bf16* HID;
    __device__ __forceinline__ void operator()(int row, int col, f32x4 a0, f32x4 a1, f32x4 b0, f32x4 b1) const { const int ct = (col >> 8) & 3, cc = col & 127;
        f32x4 h0, h1; for (int e = 0; e < 4; ++e) { h0[e] = siluf_(a0[e]) * b0[e]; h1[e] = siluf_(a1[e]) * b1[e]; } store8bf(HID + (size_t)row * FF + ct * 128 + cc, h0, h1); } };
struct EpiDown { const int* S2T; const float* TOKW; bf16* Y;
    __device__ __forceinline__ void operator()(int row, int col, f32x4 a0, f32x4 a1, f32x4 b0, f32x4 b1) const { const int st = S2T[row]; if (st < 0) return; const float w = TOKW[st]; const int cc = col & 1023;
        store8bf(Y + (size_t)st * D + cc, w * a0, w * a1); store8bf(Y + (size_t)st * D + cc + 128, w * b0, w * b1); } };

struct MoeSched { int ts[17]; int G, c;
    __device__ __forceinline__ void a_ready(const Unit&) const {}
    __device__ __forceinline__ void done(const Unit&) const {}
    __device__ __forceinline__ void init(const unsigned* cnt, int G_, int c_) { G = G_; c = c_; int s = 0;
#pragma unroll
        for (int e = 0; e < 16; ++e) { ts[e] = s; s += ((int)cnt[e] + 255) >> 8; } ts[16] = s; }
    __device__ __forceinline__ bool next(int i, Unit& u) const { const int L = i * G + c; if (L >= 4 * ts[16]) return false; const int rt = L >> 2, ct = L & 3; int e = 0;
#pragma unroll
        for (int j = 1; j < 16; ++j) e += (rt >= ts[j]) ? 1 : 0;
        u.pm = rt; u.pn = e * 4 + ct; return true; } };

__device__ __forceinline__ void phase_prep_simple(ArgsR a, const Ctx& c, int l) {
    const bf16* ZR = (const bf16*)(a.ws + WS_ZR);
    const float* mu = a.in[I_MU] + l * RC; const float* w0 = a.in[I_W0] + l * W; const float* w2 = a.in[I_W2] + (size_t)l * 64 * W;
    const float* a0 = a.in[I_A0] + l * W; const float* a2 = a.in[I_A2] + (size_t)l * 64 * W; const float* g2 = a.in[I_G2] + (size_t)l * 128 * W;
    const float* k_k = a.in[I_KK] + l * W; const float* k_a = a.in[I_KA] + l * W;
    const float* vm0 = a.in[I_VM0]; const float* vm1 = a.in[I_VM1]; const float* vm2 = a.in[I_VM2];
    f16* R = (f16*)(a.ws + WS_R); f16* WM1 = (f16*)(a.ws + WS_WM1); f16* KP = (f16*)(a.ws + WS_KP); f16* AA = (f16*)(a.ws + WS_AA); f16* BB = (f16*)(a.ws + WS_BB); f16* V = (f16*)(a.ws + WS_V);
    bf16* G = (bf16*)(a.ws + WS_G); bf16* VF = (bf16*)(a.ws + WS_VF);
    const int lane = c.lane;
    for (int t = c.gw; t < T; t += c.ngw) {
        float z[28];
#pragma unroll
        for (int i = 0; i < 28; ++i) { const int col = lane + 64 * i; const float zc = bf2f(ZR[(size_t)t * RC + col]); const float zp = t > 0 ? bf2f(ZR[(size_t)(t - 1) * RC + col]) : 0.f; z[i] = zc + (zp - zc) * mu[col]; }
        const float tw = tanhf(z[24]), za = z[25], sg0 = sigmoidf_(z[26]), sg1 = sigmoidf_(z[27]);
        float wlo[8], alo[8], gg[8];
#pragma unroll
        for (int i = 0; i < 8; ++i) { wlo[i] = 0.f; alo[i] = 0.f; gg[i] = 0.f; }
        for (int j = 0; j < 64; ++j) { const float tj = __shfl(tw, j), aj = __shfl(za, j), s0 = __shfl(sg0, j), s1 = __shfl(sg1, j);
#pragma unroll
            for (int i = 0; i < 8; ++i) { const int n = lane + 64 * i; wlo[i] += tj * w2[j * W + n]; alo[i] += aj * a2[j * W + n]; gg[i] += s0 * g2[j * W + n] + s1 * g2[(64 + j) * W + n]; } }
        float vv[8];
#pragma unroll
        for (int i = 0; i < 8; ++i) vv[i] = z[16 + i];
        if (l == 0) {
#pragma unroll
            for (int i = 0; i < 8; ++i) VF[(size_t)t * W + lane + 64 * i] = f2bf(vv[i]);
        } else {
            float vmid = 0.f;
#pragma unroll
            for (int i = 0; i < 8; ++i)
                for (int j = 0; j < 64; ++j) { const float vc = __shfl(vv[i], j); vmid += vc * vm1[(size_t)(64 * i + j) * 32 + (lane & 31)]; }
            float vg[8];
#pragma unroll
            for (int i = 0; i < 8; ++i) vg[i] = 0.f;
            for (int m = 0; m < 32; ++m) { const float vmm = __shfl(vmid, m);
#pragma unroll
                for (int i = 0; i < 8; ++i) vg[i] += vmm * vm2[m * W + lane + 64 * i]; }
#pragma unroll
            for (int i = 0; i < 8; ++i) { const int n = lane + 64 * i; const float vf = bf2f(VF[(size_t)t * W + n]); vv[i] = vv[i] + (vf - vv[i]) * sigmoidf_(vm0[n] + vg[i]); }
        }
#pragma unroll
        for (int i = 0; i < 8; ++i) {
            const int n = lane + 64 * i; const size_t o = (size_t)t * W + n;
            const float x = w0[n] + wlo[i]; const float wl = -softplusf_(-x) - 0.5f; const float dm1 = expm1f(-__expf(wl));
            const float av = sigmoidf_(a0[n] + alo[i]);
            const float kraw = z[8 + i];
            float kk = kraw * k_k[n]; const float nrm = sqrtf(wave_sum(kk * kk)); kk = kk / fmaxf(nrm, 1e-12f);
            const float kp = kraw * (1.0f + (av - 1.0f) * k_a[n]);
            R[o] = (f16)z[i]; WM1[o] = (f16)dm1; KP[o] = (f16)kp; AA[o] = (f16)(-kk); BB[o] = (f16)(kk * av); V[o] = (f16)vv[i]; G[o] = f2bf(gg[i]);
        }
    }
}

__device__ __forceinline__ void phase_sg_simple(ArgsR a, const Ctx& c, int l) {
    const bf16* ZS = (const bf16*)(a.ws + WS_ZS); bf16* YB = (bf16*)(a.ws + WS_YB);
    const float* lng = a.in[I_SGG] + l * W; const float* lnb = a.in[I_SGB] + l * W;
    float* vn = (float*)c.lds;
    float* st = vn + 128 * 64;
    for (int uidx = blockIdx.x; uidx < 128 * 8; uidx += gridDim.x) {
        const int ch = uidx >> 3, g = uidx & 7; const int tok0 = ch * 128;
        for (int i = 0; i < 16; ++i) { const int s = c.wave * 16 + i; const bf16* p = ZS + (size_t)(tok0 + s) * 1024 + 512 + c.lane * 8;
            const f32x4 x0 = load4bf(p), x1 = load4bf(p + 4);
            float sm = (x0[0] + x0[1]) + (x0[2] + x0[3]) + (x1[0] + x1[1]) + (x1[2] + x1[3]); const float mean = wave_sum(sm) * (1.f / 512.f);
            float q = 0.f; for (int e = 0; e < 4; ++e) { const float d0 = x0[e] - mean, d1 = x1[e] - mean; q += d0 * d0 + d1 * d1; }
            const float rstd = __builtin_amdgcn_rsqf(wave_sum(q) * (1.f / 512.f) + LN_EPS);
            if (c.lane == 0) { st[2 * s] = mean; st[2 * s + 1] = rstd; } }
        __syncthreads();
        for (int i = c.tid; i < 128 * 64; i += NTHREADS) { const int s = i >> 6, d = i & 63; const float x = bf2f(ZS[(size_t)(tok0 + s) * 1024 + 512 + g * 64 + d]);
            vn[i] = (x - st[2 * s]) * st[2 * s + 1] * lng[g * 64 + d] + lnb[g * 64 + d]; }
        __syncthreads();
        const int d = c.tid & 63, tq = c.tid >> 6;
        const float* Wg = a.in[I_WS] + (size_t)(l * 8 + g) * 128 * 128; const float* bs = a.in[I_BS] + (size_t)(l * 8 + g) * 128;
        for (int i = 0; i < 16; ++i) { const int t = tq + 8 * i; float acc = 0.f;
            for (int s = 0; s <= t; ++s) acc += Wg[t * 128 + s] * vn[s * 64 + d];
            const float u = bf2f(ZS[(size_t)(tok0 + t) * 1024 + g * 64 + d]);
            YB[(size_t)(tok0 + t) * W + g * 64 + d] = f2bf(u * (acc + bs[t])); }
        __syncthreads();
    }
}

#define LAS3 __attribute__((address_space(3)))
typedef short bf16x8 __attribute__((ext_vector_type(8)));
template <int MT, int NT, int KS>
__device__ __forceinline__ void mma_lds_glob(const unsigned char* lds_base, int a_off_bytes, int lda, const bf16* Bt, int ldb, int n0, int lane, f32x4 (&acc)[MT][NT]) {
    const int fr = lane & 15, fq = lane >> 4;
    const LAS3 unsigned char* Ab = (const LAS3 unsigned char*)lds_base + a_off_bytes;
    int boff = (n0 + fr) * ldb + 8 * fq; asm volatile("" : "+v"(boff));
#pragma unroll
    for (int ks = 0; ks < KS; ++ks) {
        bf16x8 b[NT];
#pragma unroll
        for (int n = 0; n < NT; ++n) b[n] = *(const bf16x8*)(Bt + boff + 16 * n * ldb + 32 * ks);
#pragma unroll
        for (int m = 0; m < MT; ++m) { const bf16x8 av = *(const LAS3 bf16x8*)(Ab + ((16 * m + fr) * lda + 32 * ks + 8 * fq) * 2);
#pragma unroll
            for (int n = 0; n < NT; ++n) acc[m][n] = __builtin_amdgcn_mfma_f32_16x16x32_bf16(av, b[n], acc[m][n], 0, 0, 0); }
    }
}
__device__ __forceinline__ void zshift8(const bf16* ZR, int t, int col, const float* mu, float (&o)[8]) {
    const u32x4 zc = *(const u32x4*)(ZR + (size_t)t * RC + col);
    u32x4 zp = {0u, 0u, 0u, 0u}; if (t > 0) zp = *(const u32x4*)(ZR + (size_t)(t - 1) * RC + col);
    const f32x4 m0 = *(const f32x4*)(mu + col), m1 = *(const f32x4*)(mu + col + 4);
#pragma unroll
    for (int e = 0; e < 4; ++e) { const float c0 = __uint_as_float(zc[e] << 16), c1 = __uint_as_float(zc[e] & 0xffff0000u), p0 = __uint_as_float(zp[e] << 16), p1 = __uint_as_float(zp[e] & 0xffff0000u);
        const float mu0 = (2 * e < 4) ? m0[(2 * e) & 3] : m1[(2 * e) & 3], mu1 = (2 * e + 1 < 4) ? m0[(2 * e + 1) & 3] : m1[(2 * e + 1) & 3];
        o[2 * e] = c0 + (p0 - c0) * mu0; o[2 * e + 1] = c1 + (p1 - c1) * mu1; }
}
typedef _Float16 f16x8 __attribute__((ext_vector_type(8)));
__device__ __forceinline__ void store8f16(f16* p, const float (&v)[8]) { f16x8 h;
#pragma unroll
    for (int e = 0; e < 8; ++e) h[e] = (f16)v[e];
    *(f16x8*)p = h; }
__device__ __forceinline__ u32x4 pack8bf(const float (&v)[8]) { u32x4 w; w.x = pk2(v[0], v[1]); w.y = pk2(v[2], v[3]); w.z = pk2(v[4], v[5]); w.w = pk2(v[6], v[7]); return w; }


constexpr int PB_LD = 520;
constexpr int PB_BUF = 0, PB_AOP = 64 * PB_LD * 2, PB_VMID = 2 * 64 * PB_LD * 2, PB_LA_LD = 264, PB_VM_LD = 40;
__device__ __forceinline__ void phase_prep_fast(ArgsR a, const Ctx& c, int l) {
    const bf16* ZR = (const bf16*)(a.ws + WS_ZR);
    const float* mu = a.in[I_MU] + l * RC; const float* w0 = a.in[I_W0] + l * W; const float* a0 = a.in[I_A0] + l * W;
    const float* k_k = a.in[I_KK] + l * W; const float* k_a = a.in[I_KA] + l * W; const float* vm0 = a.in[I_VM0];
    f16* R = (f16*)(a.ws + WS_R); f16* WM1 = (f16*)(a.ws + WS_WM1); f16* KP = (f16*)(a.ws + WS_KP); f16* AA = (f16*)(a.ws + WS_AA); f16* BB = (f16*)(a.ws + WS_BB); f16* V = (f16*)(a.ws + WS_V);
    bf16* G = (bf16*)(a.ws + WS_G); bf16* VF = (bf16*)(a.ws + WS_VF);
    const unsigned char* lo = a.ws + WS_LORA + (size_t)l * LO_STRIDE;
    const bf16* W2T = (const bf16*)(lo + LO_W2T); const bf16* A2T = (const bf16*)(lo + LO_A2T); const bf16* G2T = (const bf16*)(lo + LO_G2T);
    const bf16* VM1T = (const bf16*)(lo + LO_VM1T); const bf16* VM2T = (const bf16*)(lo + LO_VM2T);
    LAS3 unsigned char* L = (LAS3 unsigned char*)c.lds;
    const int tid = c.tid, lane = c.lane, wv = c.wave, fr = lane & 15, fq = lane >> 4;
    const int row = tid >> 3, sub_ = tid & 7;
    for (int u = blockIdx.x; u < T / 64; u += gridDim.x) {
        int sub = sub_; asm volatile("" : "+v"(sub));
        const int t0 = u * 64, t = t0 + row;
        if (l == 0) {
#pragma unroll 4
            for (int p = 0; p < 8; ++p) { const int col = p * 64 + sub * 8; float z[8]; zshift8(ZR, t, 1024 + col, mu, z);
                store8f16(V + (size_t)t * W + col, z); *(u32x4*)(VF + (size_t)t * W + col) = pack8bf(z); }
        } else {
#pragma unroll 4
            for (int p = 0; p < 8; ++p) { const int col = p * 64 + sub * 8; float z[8]; zshift8(ZR, t, 1024 + col, mu, z);
                *(LAS3 u32x4*)(L + PB_AOP + (row * PB_LD + col) * 2) = pack8bf(z); }
            __syncthreads();
            { f32x4 acc[1][1]; acc[0][0] = (f32x4){0.f, 0.f, 0.f, 0.f}; const int m = wv >> 1, n = wv & 1;
              mma_lds_glob<1, 1, 16>(c.lds, PB_AOP + 16 * m * PB_LD * 2, PB_LD, VM1T, W, 16 * n, lane, acc);
#pragma unroll
              for (int i = 0; i < 4; ++i) *(LAS3 bf16*)(L + PB_VMID + ((16 * m + 4 * fq + i) * PB_VM_LD + 16 * n + fr) * 2) = f2bf(acc[0][0][i]); }
            __syncthreads();
            { f32x4 acc[4][4];
#pragma unroll
              for (int m = 0; m < 4; ++m)
#pragma unroll
                  for (int n = 0; n < 4; ++n) acc[m][n] = (f32x4){0.f, 0.f, 0.f, 0.f};
              mma_lds_glob<4, 4, 1>(c.lds, PB_VMID, PB_VM_LD, VM2T, 32, 64 * wv, lane, acc);
#pragma unroll
              for (int m = 0; m < 4; ++m)
#pragma unroll
                  for (int n = 0; n < 4; ++n) { const int col = 64 * wv + 16 * n + fr; const float vb = vm0[col];
#pragma unroll
                      for (int i = 0; i < 4; ++i) *(LAS3 f16*)(L + PB_BUF + ((16 * m + 4 * fq + i) * PB_LD + col) * 2) = (f16)sigmoidf_(vb + acc[m][n][i]); } }
            __syncthreads();
#pragma unroll 4
            for (int p = 0; p < 8; ++p) { const int col = p * 64 + sub * 8;
                const u32x4 vz = *(const LAS3 u32x4*)(L + PB_AOP + (row * PB_LD + col) * 2); const f16x8 gt = *(const LAS3 f16x8*)(L + PB_BUF + (row * PB_LD + col) * 2);
                const u32x4 vfw = *(const u32x4*)(VF + (size_t)t * W + col); float o[8];
#pragma unroll
                for (int e = 0; e < 4; ++e) { const float v0 = __uint_as_float(vz[e] << 16), v1 = __uint_as_float(vz[e] & 0xffff0000u), f0 = __uint_as_float(vfw[e] << 16), f1 = __uint_as_float(vfw[e] & 0xffff0000u);
                    o[2 * e] = v0 + (f0 - v0) * (float)gt[2 * e]; o[2 * e + 1] = v1 + (f1 - v1) * (float)gt[2 * e + 1]; }
                store8f16(V + (size_t)t * W + col, o); }
            __syncthreads();
        }
#pragma unroll 4
        for (int p = 0; p < 4; ++p) { const int cc = sub * 32 + p * 8; float z[8]; zshift8(ZR, t, 1536 + cc, mu, z);
#pragma unroll
            for (int e = 0; e < 8; ++e) z[e] = cc < 64 ? (1.0f - 2.0f * __builtin_amdgcn_rcpf(1.0f + __expf(2.0f * z[e]))) : (cc < 128 ? z[e] : sigmoidf_(z[e]));
            *(LAS3 u32x4*)(L + PB_AOP + (row * PB_LA_LD + cc) * 2) = pack8bf(z); }
        __syncthreads();
        { f32x4 acc[4][4];
#pragma unroll
          for (int m = 0; m < 4; ++m)
#pragma unroll
              for (int n = 0; n < 4; ++n) acc[m][n] = (f32x4){0.f, 0.f, 0.f, 0.f};
          mma_lds_glob<4, 4, 2>(c.lds, PB_AOP + 64 * 2, PB_LA_LD, A2T, 64, 64 * wv, lane, acc);
#pragma unroll
          for (int m = 0; m < 4; ++m)
#pragma unroll
              for (int n = 0; n < 4; ++n) { const int col = 64 * wv + 16 * n + fr; const float ab = a0[col];
#pragma unroll
                  for (int i = 0; i < 4; ++i) *(LAS3 f16*)(L + PB_BUF + ((16 * m + 4 * fq + i) * PB_LD + col) * 2) = (f16)sigmoidf_(ab + acc[m][n][i]); } }
        __syncthreads();
#pragma unroll 4
        for (int p = 0; p < 8; ++p) { const int col = p * 64 + sub * 8; const size_t o = (size_t)t * W + col;
            float z[8]; zshift8(ZR, t, col, mu, z); store8f16(R + o, z);
            float kz[8]; zshift8(ZR, t, 512 + col, mu, kz);
            const f16x8 av = *(const LAS3 f16x8*)(L + PB_BUF + (row * PB_LD + col) * 2);
            const f32x4 kk0 = *(const f32x4*)(k_k + col), kk1 = *(const f32x4*)(k_k + col + 4), ka0 = *(const f32x4*)(k_a + col), ka1 = *(const f32x4*)(k_a + col + 4);
            float kk[8], kp[8], bb[8]; float ss = 0.f;
#pragma unroll
            for (int e = 0; e < 8; ++e) { const float kkw = e < 4 ? kk0[e & 3] : kk1[e & 3], kaw = e < 4 ? ka0[e & 3] : ka1[e & 3]; kk[e] = kz[e] * kkw; ss += kk[e] * kk[e]; kp[e] = kz[e] * (1.0f + ((float)av[e] - 1.0f) * kaw); }
            ss += __shfl_xor(ss, 1); ss += __shfl_xor(ss, 2); ss += __shfl_xor(ss, 4);
            const float inv = fminf(__builtin_amdgcn_rsqf(ss), 1e12f);
#pragma unroll
            for (int e = 0; e < 8; ++e) { kk[e] *= inv; bb[e] = kk[e] * (float)av[e]; kk[e] = -kk[e]; }
            store8f16(KP + o, kp); store8f16(AA + o, kk); store8f16(BB + o, bb); }
        __syncthreads();
        { f32x4 acc[4][4];
#pragma unroll
          for (int m = 0; m < 4; ++m)
#pragma unroll
              for (int n = 0; n < 4; ++n) acc[m][n] = (f32x4){0.f, 0.f, 0.f, 0.f};
          mma_lds_glob<4, 4, 2>(c.lds, PB_AOP, PB_LA_LD, W2T, 64, 64 * wv, lane, acc);
#pragma unroll
          for (int m = 0; m < 4; ++m)
#pragma unroll
              for (int n = 0; n < 4; ++n) { const int col = 64 * wv + 16 * n + fr; const float wb = w0[col];
#pragma unroll
                  for (int i = 0; i < 4; ++i) { const float x = wb + acc[m][n][i]; const float wl = -(fmaxf(-x, 0.f) + __logf(1.0f + __expf(-fabsf(x)))) - 0.5f;
                      *(LAS3 f16*)(L + PB_BUF + ((16 * m + 4 * fq + i) * PB_LD + col) * 2) = (f16)(__expf(-__expf(wl)) - 1.0f); } } }
        __syncthreads();
#pragma unroll 4
        for (int p = 0; p < 8; ++p) { const int col = p * 64 + sub * 8; *(u32x4*)(WM1 + (size_t)t * W + col) = *(const LAS3 u32x4*)(L + PB_BUF + (row * PB_LD + col) * 2); }
        __syncthreads();
        { f32x4 acc[4][4];
#pragma unroll
          for (int m = 0; m < 4; ++m)
#pragma unroll
              for (int n = 0; n < 4; ++n) acc[m][n] = (f32x4){0.f, 0.f, 0.f, 0.f};
          mma_lds_glob<4, 4, 4>(c.lds, PB_AOP + 128 * 2, PB_LA_LD, G2T, 128, 64 * wv, lane, acc);
#pragma unroll
          for (int m = 0; m < 4; ++m)
#pragma unroll
              for (int n = 0; n < 4; ++n) { const int col = 64 * wv + 16 * n + fr;
#pragma unroll
                  for (int i = 0; i < 4; ++i) *(LAS3 bf16*)(L + PB_BUF + ((16 * m + 4 * fq + i) * PB_LD + col) * 2) = f2bf(acc[m][n][i]); } }
        __syncthreads();
#pragma unroll 4
        for (int p = 0; p < 8; ++p) { const int col = p * 64 + sub * 8; *(u32x4*)(G + (size_t)t * W + col) = *(const LAS3 u32x4*)(L + PB_BUF + (row * PB_LD + col) * 2); }
        __syncthreads();
    }
}

constexpr int SG_LD = 136;
constexpr int SG_VT = 0, SG_ST = 256 * SG_LD * 2;
__device__ __forceinline__ void phase_sg_fast(ArgsR a, const Ctx& c, int l) {
    const bf16* ZS = (const bf16*)(a.ws + WS_ZS); bf16* YB = (bf16*)(a.ws + WS_YB);
    const float* lng = a.in[I_SGG] + l * W; const float* lnb = a.in[I_SGB] + l * W;
    LAS3 unsigned char* L = (LAS3 unsigned char*)c.lds;
    LAS3 float* st = (LAS3 float*)(L + SG_ST);
    const int tid = c.tid, lane = c.lane, wv = c.wave, fr = lane & 15, fq = lane >> 4;
    for (int u = blockIdx.x; u < 256; u += gridDim.x) {
        const int ch = u >> 1, hf = u & 1, tok0 = ch * 128;
        for (int i = 0; i < 16; ++i) { const int sidx = wv * 16 + i; const bf16* p = ZS + (size_t)(tok0 + sidx) * 1024 + 512 + lane * 8;
            const f32x4 x0 = load4bf(p), x1 = load4bf(p + 4);
            const float sm = (x0[0] + x0[1]) + (x0[2] + x0[3]) + (x1[0] + x1[1]) + (x1[2] + x1[3]); const float mean = wave_sum(sm) * (1.f / 512.f);
            float q = 0.f;
#pragma unroll
            for (int e = 0; e < 4; ++e) { const float d0 = x0[e] - mean, d1 = x1[e] - mean; q += d0 * d0 + d1 * d1; }
            const float rstd = __builtin_amdgcn_rsqf(wave_sum(q) * (1.f / 512.f) + LN_EPS);
            if (lane == 0) { st[2 * sidx] = mean; st[2 * sidx + 1] = rstd; } }
        __syncthreads();
        { const int sidx = tid >> 2, q4 = tid & 3; const float mean = st[2 * sidx], rstd = st[2 * sidx + 1];
#pragma unroll
          for (int p = 0; p < 8; ++p) { const int cl = q4 * 64 + p * 8; const int cg = hf * 256 + cl;
              const bf16* src = ZS + (size_t)(tok0 + sidx) * 1024 + 512 + cg; const f32x4 x0 = load4bf(src), x1 = load4bf(src + 4);
              const f32x4 g0 = *(const f32x4*)(lng + cg), g1 = *(const f32x4*)(lng + cg + 4), b0 = *(const f32x4*)(lnb + cg), b1 = *(const f32x4*)(lnb + cg + 4);
#pragma unroll
              for (int e = 0; e < 8; ++e) { const float x = e < 4 ? x0[e & 3] : x1[e & 3], gg = e < 4 ? g0[e & 3] : g1[e & 3], bb = e < 4 ? b0[e & 3] : b1[e & 3];
                  *(LAS3 bf16*)(L + SG_VT + ((cl + e) * SG_LD + sidx) * 2) = f2bf((x - mean) * rstd * gg + bb); } } }
        __syncthreads();
        const int gl = wv >> 1, dh = wv & 1, g = hf * 4 + gl;
        const float* Wg = a.in[I_WS] + (size_t)(l * 8 + g) * 128 * 128; const float* bs = a.in[I_BS] + (size_t)(l * 8 + g) * 128;
        f32x4 acc[8][2];
#pragma unroll
        for (int m = 0; m < 8; ++m) { acc[m][0] = (f32x4){0.f, 0.f, 0.f, 0.f}; acc[m][1] = (f32x4){0.f, 0.f, 0.f, 0.f}; }
#pragma unroll
        for (int ks = 0; ks < 4; ++ks) {
            bf16x8 b[2];
#pragma unroll
            for (int n = 0; n < 2; ++n) b[n] = *(const LAS3 bf16x8*)(L + SG_VT + ((gl * 64 + dh * 32 + 16 * n + fr) * SG_LD + 32 * ks + 8 * fq) * 2);
#pragma unroll
            for (int m = 0; m < 8; ++m) { if (32 * ks <= 16 * m + 15) {
                const int trow = 16 * m + fr, s0 = 32 * ks + 8 * fq;
                const f32x4 w0v = *(const f32x4*)(Wg + trow * 128 + s0), w1v = *(const f32x4*)(Wg + trow * 128 + s0 + 4);
                float wf[8];
#pragma unroll
                for (int e = 0; e < 8; ++e) { const float wval = e < 4 ? w0v[e & 3] : w1v[e & 3]; wf[e] = (s0 + e <= trow) ? wval : 0.f; }
                const u32x4 wp = pack8bf(wf); const bf16x8 av = __builtin_bit_cast(bf16x8, wp);
                acc[m][0] = __builtin_amdgcn_mfma_f32_16x16x32_bf16(av, b[0], acc[m][0], 0, 0, 0);
                acc[m][1] = __builtin_amdgcn_mfma_f32_16x16x32_bf16(av, b[1], acc[m][1], 0, 0, 0); } }
        }
#pragma unroll
        for (int m = 0; m < 8; ++m)
#pragma unroll
            for (int i = 0; i < 4; ++i) { const int trow = 16 * m + 4 * fq + i; const float bsv = bs[trow];
#pragma unroll
                for (int n = 0; n < 2; ++n) { const int col = g * 64 + dh * 32 + 16 * n + fr; const float uu = bf2f(ZS[(size_t)(tok0 + trow) * 1024 + col]);
                    YB[(size_t)(tok0 + trow) * W + col] = f2bf(uu * (acc[m][n][i] + bsv)); } }
        __syncthreads();
    }
}

__device__ __forceinline__ void phase_scan_simple(ArgsR a, const Ctx& c) {
    if (c.wave != 0 || blockIdx.x >= NH) return;
    const int h = blockIdx.x, lane = c.lane;
    const f16* R = (const f16*)(a.ws + WS_R); const f16* WM1 = (const f16*)(a.ws + WS_WM1); const f16* KP = (const f16*)(a.ws + WS_KP);
    const f16* AA = (const f16*)(a.ws + WS_AA); const f16* BB = (const f16*)(a.ws + WS_BB); const f16* V = (const f16*)(a.ws + WS_V);
    bf16* YSC = (bf16*)(a.ws + WS_YSC);
    float S[64];
#pragma unroll
    for (int j = 0; j < 64; ++j) S[j] = 0.f;
    for (int t = 0; t < T; ++t) {
        const size_t base = (size_t)t * W + h * 64;
        const float vv = (float)V[base + lane];
        float sa = 0.f;
#pragma unroll
        for (int j = 0; j < 64; ++j) sa += S[j] * (float)AA[base + j];
        float y = 0.f;
#pragma unroll
        for (int j = 0; j < 64; ++j) { float s = S[j]; s = s + s * (float)WM1[base + j]; s += sa * (float)BB[base + j]; s += vv * (float)KP[base + j]; S[j] = s; y += s * (float)R[base + j]; }
        YSC[base + lane] = f2bf(y);
    }
}

typedef unsigned u32x16 __attribute__((ext_vector_type(16)));
__device__ __forceinline__ void sload32(const void* p0, u32x16& a0, u32x16& a1) {
    asm volatile("s_load_dwordx16 %0, %2, 0x0 glc\n\ts_load_dwordx16 %1, %2, 0x40 glc\n\ts_waitcnt lgkmcnt(0)" : "=&s"(a0), "=&s"(a1) : "s"(p0) : "memory");
}
__device__ __forceinline__ void sload64(const void* p0, const void* p1, u32x16& a0, u32x16& a1, u32x16& b0, u32x16& b1) {
    asm volatile("s_load_dwordx16 %0, %4, 0x0 glc\n\ts_load_dwordx16 %1, %4, 0x40 glc\n\ts_load_dwordx16 %2, %5, 0x0 glc\n\ts_load_dwordx16 %3, %5, 0x40 glc\n\ts_waitcnt lgkmcnt(0)"
                 : "=&s"(a0), "=&s"(a1), "=&s"(b0), "=&s"(b1) : "s"(p0), "s"(p1) : "memory");
}
__device__ __forceinline__ float fmix_lo(unsigned sd, float x, float y) { float d; asm("v_fma_mix_f32 %0, %1, %2, %3 op_sel_hi:[1,0,0]" : "=v"(d) : "s"(sd), "v"(x), "v"(y)); return d; }
__device__ __forceinline__ float fmix_hi(unsigned sd, float x, float y) { float d; asm("v_fma_mix_f32 %0, %1, %2, %3 op_sel:[1,0,0] op_sel_hi:[1,0,0]" : "=v"(d) : "s"(sd), "v"(x), "v"(y)); return d; }
constexpr int CL = 64, NCH = T / CL;
constexpr size_t ST_Q_OFF = (size_t)NH * NCH * 64 * 64;
constexpr size_t ST_S_OFF = (size_t)NH * NCH * 64 * 64;

__device__ __forceinline__ float vmix_lo(unsigned vd, float x, float y) { float d; asm("v_fma_mix_f32 %0, %1, %2, %3 op_sel_hi:[1,0,0]" : "=v"(d) : "v"(vd), "v"(x), "v"(y)); return d; }
__device__ __forceinline__ float vmix_hi(unsigned vd, float x, float y) { float d; asm("v_fma_mix_f32 %0, %1, %2, %3 op_sel:[1,0,0] op_sel_hi:[1,0,0]" : "=v"(d) : "v"(vd), "v"(x), "v"(y)); return d; }
template <int N> __device__ __forceinline__ void fmac_bc(float& acc, float vec, float x) { asm("v_fmac_f32_dpp %0, %1, %2 row_newbcast:%3 row_mask:0xf bank_mask:0xf" : "+v"(acc) : "v"(vec), "v"(x), "n"(N)); }
template <int N> __device__ __forceinline__ float mul_bc(float vec, float x) { float d; asm("v_mul_f32_dpp %0, %1, %2 row_newbcast:%3 row_mask:0xf bank_mask:0xf" : "=v"(d) : "v"(vec), "v"(x), "n"(N)); return d; }
typedef _Float16 f16x4 __attribute__((ext_vector_type(4)));
struct SVec { float v[4]; };
__device__ __forceinline__ f16x4 sv_read(const LAS3 unsigned char* p, int lane) { return *(const LAS3 f16x4*)(p + (lane & 15) * 8); }
__device__ __forceinline__ void sv_cvt(SVec& o, f16x4 h) { o.v[0] = (float)h[0]; o.v[1] = (float)h[1]; o.v[2] = (float)h[2]; o.v[3] = (float)h[3]; }
__device__ __forceinline__ void sv_cvt1p(SVec& o, f16x4 h) { o.v[0] = 1.0f + (float)h[0]; o.v[1] = 1.0f + (float)h[1]; o.v[2] = 1.0f + (float)h[2]; o.v[3] = 1.0f + (float)h[3]; }
template <int J> __device__ __forceinline__ void sc_dot(float (&d)[4], const SVec& A, const float (&X)[64]) { fmac_bc<(J >> 2)>(d[J & 3], A.v[J & 3], X[J]); if constexpr (J + 1 < 64) sc_dot<J + 1>(d, A, X); }
template <int J> __device__ __forceinline__ void sc_upd3(float (&S)[64], float (&y)[4], const SVec& Wv, const SVec& Bv, const SVec& Kv, const SVec& Rv, float sa, float vv) {
    float sj = mul_bc<(J >> 2)>(Wv.v[J & 3], S[J]); fmac_bc<(J >> 2)>(sj, Bv.v[J & 3], sa); fmac_bc<(J >> 2)>(sj, Kv.v[J & 3], vv); S[J] = sj; fmac_bc<(J >> 2)>(y[J & 3], Rv.v[J & 3], sj);
    if constexpr (J + 1 < 64) sc_upd3<J + 1>(S, y, Wv, Bv, Kv, Rv, sa, vv); }
template <int J> __device__ __forceinline__ void sc_upd1(float (&Q)[64], float (&P)[64], const SVec& Wv, const SVec& Bv, const SVec& Kv, float saq, float sap, float vv) {
    float qj = mul_bc<(J >> 2)>(Wv.v[J & 3], Q[J]); fmac_bc<(J >> 2)>(qj, Bv.v[J & 3], saq); fmac_bc<(J >> 2)>(qj, Kv.v[J & 3], vv); Q[J] = qj;
    float pj = mul_bc<(J >> 2)>(Wv.v[J & 3], P[J]); fmac_bc<(J >> 2)>(pj, Bv.v[J & 3], sap); P[J] = pj;
    if constexpr (J + 1 < 64) sc_upd1<J + 1>(Q, P, Wv, Bv, Kv, saq, sap, vv); }
constexpr int SCB = 8;
constexpr int SC_NS = 7, SC_BUF = SC_NS * 1024, SC_WAVE = 2 * SC_BUF;
__device__ __forceinline__ void sc_dma(const f16* X, size_t eoff, LAS3 unsigned char* dst) {
    __builtin_amdgcn_global_load_lds((const unsigned*)(X + eoff), (LAS3 unsigned*)dst, 16, 0, 0);
}

__device__ __forceinline__ void phase_scan1(ArgsR a, const Ctx& c) {
    const f16* WM1 = (const f16*)(a.ws + WS_WM1); const f16* KP = (const f16*)(a.ws + WS_KP);
    const f16* AA = (const f16*)(a.ws + WS_AA); const f16* BB = (const f16*)(a.ws + WS_BB); const f16* V = (const f16*)(a.ws + WS_V);
    float* ST = (float*)(a.ws + WS_ST);
    const int lane = c.lane;
    LAS3 unsigned char* ring = (LAS3 unsigned char*)c.lds + c.wave * SC_WAVE;
    for (int item = c.gw; item < NH * NCH; item += c.ngw) {
        const int h = __builtin_amdgcn_readfirstlane(item / NCH), ch = __builtin_amdgcn_readfirstlane(item % NCH);
        float Q[64], P[64];
        int ln_ = lane; asm volatile("" : "+v"(ln_));
#pragma unroll
        for (int j = 0; j < 64; ++j) { Q[j] = 0.f; P[j] = (j == ln_) ? 1.f : 0.f; }
        const size_t lane_off = (size_t)(lane >> 3) * W + h * 64 + (lane & 7) * 8;
        { const size_t e0 = (size_t)(ch * CL) * W + lane_off;
          sc_dma(AA, e0, ring); sc_dma(WM1, e0, ring + 1024); sc_dma(BB, e0, ring + 2048); sc_dma(KP, e0, ring + 3072); sc_dma(V, e0, ring + 4096); }
#pragma unroll 1
        for (int blk = 0; blk < CL / SCB; ++blk) {
            LAS3 unsigned char* buf = ring + (blk & 1) * SC_BUF;
            if (blk + 1 < CL / SCB) { LAS3 unsigned char* nb = ring + ((blk + 1) & 1) * SC_BUF; const size_t e0 = (size_t)(ch * CL + (blk + 1) * SCB) * W + lane_off;
                sc_dma(AA, e0, nb); sc_dma(WM1, e0, nb + 1024); sc_dma(BB, e0, nb + 2048); sc_dma(KP, e0, nb + 3072); sc_dma(V, e0, nb + 4096);
                asm volatile("s_waitcnt vmcnt(5)" ::: "memory"); }
            else asm volatile("s_waitcnt vmcnt(0)" ::: "memory");
            SVec A, Wv, Bv, Kv;
            sv_cvt(A, sv_read(buf, lane)); sv_cvt1p(Wv, sv_read(buf + 1024, lane)); sv_cvt(Bv, sv_read(buf + 2048, lane)); sv_cvt(Kv, sv_read(buf + 3072, lane));
            float vv = (float)*(const LAS3 f16*)(buf + 4096 + lane * 2);
#pragma unroll 1
            for (int st = 0; st < SCB; ++st) {
                const LAS3 unsigned char* sn = buf + ((st + 1 < SCB) ? st + 1 : st) * 128;
                const f16x4 ha = sv_read(sn, lane), hw = sv_read(sn + 1024, lane), hb = sv_read(sn + 2048, lane), hk = sv_read(sn + 3072, lane);
                const f16 hv = *(const LAS3 f16*)(sn + 4096 + lane * 2);
                float dq[4] = {0.f, 0.f, 0.f, 0.f}, dp[4] = {0.f, 0.f, 0.f, 0.f};
                sc_dot<0>(dq, A, Q); sc_dot<0>(dp, A, P);
                const float saq = (dq[0] + dq[1]) + (dq[2] + dq[3]), sap = (dp[0] + dp[1]) + (dp[2] + dp[3]);
                sc_upd1<0>(Q, P, Wv, Bv, Kv, saq, sap, vv);
                sv_cvt(A, ha); sv_cvt1p(Wv, hw); sv_cvt(Bv, hb); sv_cvt(Kv, hk); vv = (float)hv;
            }
        }
        float* Qp = ST + ST_Q_OFF + (size_t)(h * NCH + ch) * 4096 + lane;
        bf16* PTp = (bf16*)ST + (size_t)(h * NCH + ch) * 4096 + lane;
#pragma unroll
        for (int j = 0; j < 64; ++j) { PTp[j * 64] = f2bf(P[j]); Qp[j * 64] = Q[j]; }
    }
}
constexpr int GS = 16, NG = NCH / GS;
constexpr size_t ST_LP_OFF = (size_t)NH * NCH * 4096;
constexpr size_t WS_SG = WS_LORA + 2 * MiB;
constexpr int HI_LD = 72, HI_BYTES = 64 * HI_LD * 2;
struct HFrag { bf16x8 b[2][2]; f32x4 q[2]; };
__device__ __forceinline__ void hload(HFrag& f, const bf16* Bt, const float* QTc, int boff, int qtoff) {
#pragma unroll
    for (int ks = 0; ks < 2; ++ks)
#pragma unroll
        for (int n = 0; n < 2; ++n) f.b[ks][n] = *(const bf16x8*)(Bt + boff + 16 * n * 64 + 32 * ks);
#pragma unroll
    for (int n = 0; n < 2; ++n) f.q[n] = *(const f32x4*)(QTc + qtoff + 16 * n * 64);
}
__device__ __forceinline__ void hmma(const LAS3 unsigned char* img, const bf16x8 (&b)[2][2], f32x4 (&acc)[2], int m, int fr, int fq) {
#pragma unroll
    for (int ks = 0; ks < 2; ++ks) { const bf16x8 av = *(const LAS3 bf16x8*)(img + ((16 * m + fr) * HI_LD + 32 * ks + 8 * fq) * 2);
#pragma unroll
        for (int n = 0; n < 2; ++n) acc[n] = __builtin_amdgcn_mfma_f32_16x16x32_bf16(av, b[ks][n], acc[n], 0, 0, 0); }
}
__device__ __forceinline__ void himg_store(LAS3 unsigned char* img, const f32x4 (&acc)[2], int m, int n0, int fr, int fq) {
#pragma unroll
    for (int n = 0; n < 2; ++n)
#pragma unroll
        for (int i = 0; i < 4; ++i) *(LAS3 bf16*)(img + ((16 * m + 4 * fq + i) * HI_LD + n0 + 16 * n + fr) * 2) = f2bf(acc[n][i]);
}
#define HBAR() do { asm volatile("s_waitcnt lgkmcnt(0)" ::: "memory"); __builtin_amdgcn_s_barrier(); asm volatile("" ::: "memory"); } while (0)

__device__ __forceinline__ void sc2a_step(const HFrag& f, bf16* LpTc, float* QTc, const LAS3 unsigned char* ip, LAS3 unsigned char* ipn, const LAS3 unsigned char* iq, LAS3 unsigned char* iqn, int m, int n0, int fr, int fq, int qtoff) {
    f32x4 ap[2], aq[2];
#pragma unroll
    for (int n = 0; n < 2; ++n) { ap[n] = (f32x4){0.f, 0.f, 0.f, 0.f}; aq[n] = f.q[n]; }
    hmma(ip, f.b, ap, m, fr, fq); hmma(iq, f.b, aq, m, fr, fq);
#pragma unroll
    for (int n = 0; n < 2; ++n) { u32x2 w; w.x = pk2(ap[n][0], ap[n][1]); w.y = pk2(ap[n][2], ap[n][3]);
        *(u32x2*)(LpTc + (n0 + 16 * n + fr) * 64 + 16 * m + 4 * fq) = w;
        *(f32x4*)(QTc + qtoff + 16 * n * 64) = aq[n]; }
    himg_store(ipn, ap, m, n0, fr, fq); himg_store(iqn, aq, m, n0, fr, fq);
    HBAR();
}
__device__ __forceinline__ void phase_scan2a(ArgsR a, const Ctx& c) {
    const int lane = c.lane, wv = c.wave, fr = lane & 15, fq = lane >> 4, m = wv >> 1, n0 = 32 * (wv & 1);
    const int boff = (n0 + fr) * 64 + 8 * fq, qtoff = (n0 + fr) * 64 + 16 * m + 4 * fq;
    LAS3 unsigned char* L = (LAS3 unsigned char*)c.lds;
    for (int item = blockIdx.x; item < NH * NG; item += gridDim.x) {
        const size_t cb = (size_t)(item / NG) * NCH + (size_t)(item % NG) * GS;
        const bf16* PT = (const bf16*)(a.ws + WS_ST) + cb * 4096; bf16* LP = (bf16*)(a.ws + WS_ST) + ST_LP_OFF + cb * 4096; float* QT = (float*)(a.ws + WS_ST) + ST_Q_OFF + cb * 4096;
        for (int i = c.tid; i < 4 * HI_BYTES / 4; i += NTHREADS) ((LAS3 unsigned*)L)[i] = 0u;
        __syncthreads();
        if (c.tid < 64) *(LAS3 bf16*)(L + (c.tid * HI_LD + c.tid) * 2) = (bf16)0x3F80;
        __syncthreads();
        HFrag f0, f1, f2, f3;
        hload(f0, PT, QT, boff, qtoff); hload(f1, PT + 4096, QT + 4096, boff, qtoff); hload(f2, PT + 2 * 4096, QT + 2 * 4096, boff, qtoff); hload(f3, PT + 3 * 4096, QT + 3 * 4096, boff, qtoff);
        LAS3 unsigned char* p0 = L; LAS3 unsigned char* p1 = L + HI_BYTES; LAS3 unsigned char* q0 = L + 2 * HI_BYTES; LAS3 unsigned char* q1 = L + 3 * HI_BYTES;
#pragma unroll 1
        for (int i = 0; i < GS; i += 4) {
            const int nx = (i + 4 < GS) ? i + 4 : i;
            sc2a_step(f0, LP + (size_t)(i + 0) * 4096, QT + (size_t)(i + 0) * 4096, p0, p1, q0, q1, m, n0, fr, fq, qtoff); hload(f0, PT + (size_t)(nx + 0) * 4096, QT + (size_t)(nx + 0) * 4096, boff, qtoff);
            sc2a_step(f1, LP + (size_t)(i + 1) * 4096, QT + (size_t)(i + 1) * 4096, p1, p0, q1, q0, m, n0, fr, fq, qtoff); hload(f1, PT + (size_t)(nx + 1) * 4096, QT + (size_t)(nx + 1) * 4096, boff, qtoff);
            sc2a_step(f2, LP + (size_t)(i + 2) * 4096, QT + (size_t)(i + 2) * 4096, p0, p1, q0, q1, m, n0, fr, fq, qtoff); hload(f2, PT + (size_t)(nx + 2) * 4096, QT + (size_t)(nx + 2) * 4096, boff, qtoff);
            sc2a_step(f3, LP + (size_t)(i + 3) * 4096, QT + (size_t)(i + 3) * 4096, p1, p0, q1, q0, m, n0, fr, fq, qtoff); hload(f3, PT + (size_t)(nx + 3) * 4096, QT + (size_t)(nx + 3) * 4096, boff, qtoff);
        }
        __syncthreads();
    }
}
__device__ __forceinline__ void phase_scan2b(ArgsR a, const Ctx& c) {
    if (blockIdx.x >= NH) return;
    const int h = blockIdx.x, lane = c.lane, wv = c.wave, fr = lane & 15, fq = lane >> 4, m = wv >> 1, n0 = 32 * (wv & 1);
    const int boff = (n0 + fr) * 64 + 8 * fq, qtoff = (n0 + fr) * 64 + 16 * m + 4 * fq;
    LAS3 unsigned char* L = (LAS3 unsigned char*)c.lds;
    const bf16* LP = (const bf16*)(a.ws + WS_ST) + ST_LP_OFF + (size_t)h * NCH * 4096; const float* QT = (const float*)(a.ws + WS_ST) + ST_Q_OFF + (size_t)h * NCH * 4096;
    bf16* SG = (bf16*)(a.ws + WS_SG) + (size_t)h * NG * 4096;
    for (int i = c.tid; i < 2 * HI_BYTES / 4; i += NTHREADS) ((LAS3 unsigned*)L)[i] = 0u;
    for (int i = c.tid; i < 4096 / 2; i += NTHREADS) ((LAS3 unsigned*)(L + 2 * HI_BYTES))[i] = 0u;
    __syncthreads();
    HFrag f0, f1, f2, f3;
#define SC2B_CH(g) ((size_t)((g) * GS + GS - 1) * 4096)
    hload(f0, LP + SC2B_CH(0), QT + SC2B_CH(0), boff, qtoff); hload(f1, LP + SC2B_CH(1), QT + SC2B_CH(1), boff, qtoff); hload(f2, LP + SC2B_CH(2), QT + SC2B_CH(2), boff, qtoff); hload(f3, LP + SC2B_CH(3), QT + SC2B_CH(3), boff, qtoff);
    LAS3 unsigned char* i0 = L; LAS3 unsigned char* i1 = L + HI_BYTES;
#define SC2B_STEP(f, g, ic, in) do { f32x4 acc[2] = {f.q[0], f.q[1]}; hmma(ic, f.b, acc, m, fr, fq); LAS3 bf16* So = (LAS3 bf16*)(L + 2 * HI_BYTES) + (((g) + 1) & 7) * 4096; \
        _Pragma("unroll") for (int n = 0; n < 2; ++n) _Pragma("unroll") for (int i = 0; i < 4; ++i) So[(16 * m + 4 * fq + i) * 64 + n0 + 16 * n + fr] = f2bf(acc[n][i]); \
        himg_store(in, acc, m, n0, fr, fq); HBAR(); } while (0)
#pragma unroll 1
    for (int g = 0; g < NG; g += 4) {
        const int nx = (g + 4 < NG) ? g + 4 : g;
        SC2B_STEP(f0, g + 0, i0, i1); hload(f0, LP + SC2B_CH(nx + 0), QT + SC2B_CH(nx + 0), boff, qtoff);
        SC2B_STEP(f1, g + 1, i1, i0); hload(f1, LP + SC2B_CH(nx + 1), QT + SC2B_CH(nx + 1), boff, qtoff);
        SC2B_STEP(f2, g + 2, i0, i1); hload(f2, LP + SC2B_CH(nx + 2), QT + SC2B_CH(nx + 2), boff, qtoff);
        if ((g & 7) == 4) {
            for (int i = c.tid; i < 8 * 4096 / 8; i += NTHREADS) ((u32x4*)(SG + (size_t)(g >> 3) * 8 * 4096))[i] = ((const LAS3 u32x4*)(L + 2 * HI_BYTES))[i];
            HBAR(); }
        if (g + 3 < NG - 1) SC2B_STEP(f3, g + 3, i1, i0);
        hload(f3, LP + SC2B_CH(nx + 3), QT + SC2B_CH(nx + 3), boff, qtoff);
    }
#undef SC2B_STEP
#undef SC2B_CH
}
__device__ __forceinline__ void phase_scan2c(ArgsR a, const Ctx& c) {
    const int lane = c.lane, wv = c.wave, fr = lane & 15, fq = lane >> 4, m = wv >> 1, n0 = 32 * (wv & 1);
    const int boff = (n0 + fr) * 64 + 8 * fq, qtoff = (n0 + fr) * 64 + 16 * m + 4 * fq;
    LAS3 unsigned char* L = (LAS3 unsigned char*)c.lds;
    for (int item = blockIdx.x; item < NH * NG * 2; item += gridDim.x) {
        const int hg = item >> 1, hf = item & 1;
        const size_t cb = (size_t)(hg / NG) * NCH + (size_t)(hg % NG) * GS + hf * 8;
        const bf16* LP = (const bf16*)(a.ws + WS_ST) + ST_LP_OFF + cb * 4096; const float* QT = (const float*)(a.ws + WS_ST) + ST_Q_OFF + cb * 4096; bf16* SS = (bf16*)(a.ws + WS_ST) + cb * 4096;
        { const u32x4 v = *(const u32x4*)((const bf16*)(a.ws + WS_SG) + (size_t)hg * 4096 + c.tid * 8); *(LAS3 u32x4*)(L + ((c.tid >> 3) * HI_LD + (c.tid & 7) * 8) * 2) = v; }
        __syncthreads();
#pragma unroll 2
        for (int i = 0; i < 8; ++i) { HFrag f; hload(f, LP + (size_t)i * 4096, QT + (size_t)i * 4096, boff, qtoff);
            f32x4 acc[2] = {f.q[0], f.q[1]}; hmma(L, f.b, acc, m, fr, fq); bf16* So = SS + (size_t)i * 4096;
#pragma unroll
            for (int n = 0; n < 2; ++n)
#pragma unroll
                for (int k = 0; k < 4; ++k) So[(16 * m + 4 * fq + k) * 64 + n0 + 16 * n + fr] = f2bf(acc[n][k]); }
        __syncthreads();
    }
}
constexpr int WI_LD = 72, WI_B = 64 * WI_LD * 2, WI_GAM = 9 * WI_B, WI_GL = 15 * WI_B;
constexpr size_t WS_GM0 = 352 * MiB, WS_GM1 = 212 * MiB, WS_Y0 = 336 * MiB, WS_END2 = 360 * MiB;
__device__ __forceinline__ bf16* gm_ptr(unsigned char* ws, int h, int ch) { return (bf16*)(ws + (h < 4 ? WS_GM0 : WS_GM1)) + (size_t)((h & 3) * NCH + ch) * 4096; }
__device__ __forceinline__ void wi_mma(f32x4 (&acc)[2], const LAS3 unsigned char* A, const LAS3 unsigned char* Bt, int m, int n0, int fr, int fq) {
#pragma unroll
    for (int ks = 0; ks < 2; ++ks) { const bf16x8 av = *(const LAS3 bf16x8*)(A + ((16 * m + fr) * WI_LD + 32 * ks + 8 * fq) * 2);
#pragma unroll
        for (int n = 0; n < 2; ++n) { const bf16x8 bv = *(const LAS3 bf16x8*)(Bt + ((n0 + 16 * n + fr) * WI_LD + 32 * ks + 8 * fq) * 2); acc[n] = __builtin_amdgcn_mfma_f32_16x16x32_bf16(av, bv, acc[n], 0, 0, 0); } }
}
struct WiA { bf16x8 a[2]; }; struct WiB { bf16x8 b[2][2]; };
__device__ __forceinline__ void wi_lda(WiA& f, const LAS3 unsigned char* A, int m, int fr, int fq) {
#pragma unroll
    for (int ks = 0; ks < 2; ++ks) f.a[ks] = *(const LAS3 bf16x8*)(A + ((16 * m + fr) * WI_LD + 32 * ks + 8 * fq) * 2);
}
__device__ __forceinline__ void wi_ldb(WiB& f, const LAS3 unsigned char* Bt, int n0, int fr, int fq) {
#pragma unroll
    for (int ks = 0; ks < 2; ++ks)
#pragma unroll
        for (int n = 0; n < 2; ++n) f.b[ks][n] = *(const LAS3 bf16x8*)(Bt + ((n0 + 16 * n + fr) * WI_LD + 32 * ks + 8 * fq) * 2);
}
__device__ __forceinline__ void wi_fma(f32x4 (&acc)[2], const WiA& A, const WiB& B) {
#pragma unroll
    for (int ks = 0; ks < 2; ++ks)
#pragma unroll
        for (int n = 0; n < 2; ++n) acc[n] = __builtin_amdgcn_mfma_f32_16x16x32_bf16(A.a[ks], B.b[ks][n], acc[n], 0, 0, 0);
}
__device__ __forceinline__ void wi_fma_s(f32x4 (&acc)[2], const WiA& A, const WiB& B) {
#pragma unroll
    for (int ks = 0; ks < 2; ++ks)
#pragma unroll
        for (int n = 0; n < 2; ++n) acc[n] = __builtin_amdgcn_mfma_f32_16x16x32_bf16(B.b[ks][n], A.a[ks], acc[n], 0, 0, 0);
}
__device__ __forceinline__ void wi_st_nat_s(LAS3 unsigned char* X, const f32x4 (&acc)[2], int m, int n0, int fr, int fq) {
#pragma unroll
    for (int n = 0; n < 2; ++n) { u32x2 w; w.x = pk2(acc[n][0], acc[n][1]); w.y = pk2(acc[n][2], acc[n][3]); *(LAS3 u32x2*)(X + ((16 * m + fr) * WI_LD + n0 + 16 * n + 4 * fq) * 2) = w; }
}
__device__ __forceinline__ void wi_ld_nat_s(f32x4 (&acc)[2], const LAS3 unsigned char* X, int m, int n0, int fr, int fq) {
#pragma unroll
    for (int n = 0; n < 2; ++n) { const u32x2 w = *(const LAS3 u32x2*)(X + ((16 * m + fr) * WI_LD + n0 + 16 * n + 4 * fq) * 2);
        acc[n][0] = __uint_as_float(w.x << 16); acc[n][1] = __uint_as_float(w.x & 0xffff0000u); acc[n][2] = __uint_as_float(w.y << 16); acc[n][3] = __uint_as_float(w.y & 0xffff0000u); }
}
__device__ __forceinline__ void wi_ld_tr(f32x4 (&acc)[2], const LAS3 unsigned char* XT, int m, int n0, int fr, int fq) {
#pragma unroll
    for (int n = 0; n < 2; ++n) { const u32x2 w = *(const LAS3 u32x2*)(XT + ((n0 + 16 * n + fr) * WI_LD + 16 * m + 4 * fq) * 2);
        acc[n][0] = __uint_as_float(w.x << 16); acc[n][1] = __uint_as_float(w.x & 0xffff0000u); acc[n][2] = __uint_as_float(w.y << 16); acc[n][3] = __uint_as_float(w.y & 0xffff0000u); }
}
#define WI_PIN() __builtin_amdgcn_sched_barrier(0)
__device__ __forceinline__ void wi_st_nat(LAS3 unsigned char* X, const f32x4 (&acc)[2], int m, int n0, int fr, int fq) {
#pragma unroll
    for (int n = 0; n < 2; ++n)
#pragma unroll
        for (int i = 0; i < 4; ++i) *(LAS3 bf16*)(X + ((16 * m + 4 * fq + i) * WI_LD + n0 + 16 * n + fr) * 2) = f2bf(acc[n][i]);
}
__device__ __forceinline__ void wi_st_tr(LAS3 unsigned char* XT, const f32x4 (&acc)[2], int m, int n0, int fr, int fq) {
#pragma unroll
    for (int n = 0; n < 2; ++n) { u32x2 w; w.x = pk2(acc[n][0], acc[n][1]); w.y = pk2(acc[n][2], acc[n][3]); *(LAS3 u32x2*)(XT + ((n0 + 16 * n + fr) * WI_LD + 16 * m + 4 * fq) * 2) = w; }
}
__device__ __forceinline__ void wi_ld_nat(f32x4 (&acc)[2], const LAS3 unsigned char* X, int m, int n0, int fr, int fq) {
#pragma unroll
    for (int n = 0; n < 2; ++n)
#pragma unroll
        for (int i = 0; i < 4; ++i) acc[n][i] = bf2f(*(const LAS3 bf16*)(X + ((16 * m + 4 * fq + i) * WI_LD + n0 + 16 * n + fr) * 2));
}
__device__ __forceinline__ void phase_scan1m(ArgsR a, const Ctx& c, const int skip = 0) {
    const f16* WM1 = (const f16*)(a.ws + WS_WM1); const f16* KP = (const f16*)(a.ws + WS_KP);
    const f16* AA = (const f16*)(a.ws + WS_AA); const f16* BB = (const f16*)(a.ws + WS_BB); const f16* V = (const f16*)(a.ws + WS_V); const f16* R = (const f16*)(a.ws + WS_R);
    float* ST = (float*)(a.ws + WS_ST);
    LAS3 unsigned char* L = (LAS3 unsigned char*)c.lds;
    LAS3 float* GAM = (LAS3 float*)(L + WI_GAM); LAS3 float* GL = (LAS3 float*)(L + WI_GL);
    const int lane = c.lane, wv = c.wave, fr = lane & 15, fq = lane >> 4, m = wv >> 1, n0 = 32 * (wv & 1), tid = c.tid;
#define SLOT(i) (L + (i) * WI_B)
    const int t = tid >> 3, cc = (tid & 7) * 8;
    f16x8 pav, pbv, pkv, pvv, prv, pwv;
#define WI_FETCH(it) do { const int h_ = (it) / NCH, ch_ = (it) % NCH; const size_t eo_ = (size_t)(ch_ * CL + t) * W + h_ * 64 + cc; \
        pav = *(const f16x8*)(AA + eo_); pbv = *(const f16x8*)(BB + eo_); pkv = *(const f16x8*)(KP + eo_); pvv = *(const f16x8*)(V + eo_); prv = *(const f16x8*)(R + eo_); pwv = *(const f16x8*)(WM1 + eo_); } while (0)
    if (blockIdx.x < NH * NCH) WI_FETCH(blockIdx.x);
    for (int item = blockIdx.x; item < NH * NCH; item += gridDim.x) {
        const int h = item / NCH, ch = item % NCH;
        const f16x8 av = pav, bv = pbv, kv = pkv, vv = pvv, rv = prv, wv8 = pwv;
        if (item + (int)gridDim.x < NH * NCH) WI_FETCH(item + (int)gridDim.x);
        float g[8], gp[8];
        { float wloc[8];
#pragma unroll
          for (int e = 0; e < 8; ++e) wloc[e] = 1.0f + (float)wv8[e];
#pragma unroll
          for (int e = 0; e < 8; ++e) { float x = wloc[e];
              { const float y = __shfl_up(x, 8); if (lane >= 8) x *= y; } { const float y = __shfl_up(x, 16); if (lane >= 16) x *= y; } { const float y = __shfl_up(x, 32); if (lane >= 32) x *= y; }
              g[e] = x; }
          if (lane >= 56) {
#pragma unroll
              for (int e = 0; e < 8; ++e) GAM[wv * 64 + cc + e] = g[e]; }
          HBAR();
#pragma unroll
          for (int e = 0; e < 8; ++e) { float pre = 1.0f;
#pragma unroll
              for (int w = 0; w < 7; ++w) if (w < wv) pre *= GAM[w * 64 + cc + e];
              g[e] *= pre; gp[e] = g[e] * __builtin_amdgcn_rcpf(wloc[e]); } }
        { float fa[8], fb[8], fk[8], fv[8], frr[8];
#pragma unroll
          for (int e = 0; e < 8; ++e) { const float ig = __builtin_amdgcn_rcpf(g[e]);
              fa[e] = (float)av[e] * gp[e]; fb[e] = (float)bv[e] * ig; fk[e] = (float)kv[e] * ig; fv[e] = (float)vv[e]; frr[e] = (float)rv[e] * g[e]; if (t == 63) GL[cc + e] = g[e]; }
          *(LAS3 u32x4*)(SLOT(0) + (t * WI_LD + cc) * 2) = pack8bf(fa); *(LAS3 u32x4*)(SLOT(2) + (t * WI_LD + cc) * 2) = pack8bf(fb); *(LAS3 u32x4*)(SLOT(4) + (t * WI_LD + cc) * 2) = pack8bf(fk); *(LAS3 u32x4*)(SLOT(12) + (t * WI_LD + cc) * 2) = pack8bf(frr);
#pragma unroll
          for (int e = 0; e < 8; ++e) { *(LAS3 bf16*)(SLOT(1) + ((cc + e) * WI_LD + t) * 2) = f2bf(fa[e]); *(LAS3 bf16*)(SLOT(3) + ((cc + e) * WI_LD + t) * 2) = f2bf(fb[e]); *(LAS3 bf16*)(SLOT(5) + ((cc + e) * WI_LD + t) * 2) = f2bf(fv[e]); } }
        HBAR();
        { WiA aB, aK; WiB bA, bR; wi_lda(aB, SLOT(2), m, fr, fq); wi_lda(aK, SLOT(4), m, fr, fq); wi_ldb(bA, SLOT(0), n0, fr, fq); wi_ldb(bR, SLOT(12), n0, fr, fq);
          WI_PIN();
          f32x4 ans[2] = {{0.f, 0.f, 0.f, 0.f}, {0.f, 0.f, 0.f, 0.f}}, ant[2] = {{0.f, 0.f, 0.f, 0.f}, {0.f, 0.f, 0.f, 0.f}}, aks[2] = {{0.f, 0.f, 0.f, 0.f}, {0.f, 0.f, 0.f, 0.f}}, am[2] = {{0.f, 0.f, 0.f, 0.f}, {0.f, 0.f, 0.f, 0.f}}, amk[2] = {{0.f, 0.f, 0.f, 0.f}, {0.f, 0.f, 0.f, 0.f}};
          wi_fma_s(ans, aB, bA); wi_fma(ant, aB, bA); wi_fma_s(aks, aK, bA); wi_fma(am, aB, bR); wi_fma(amk, aK, bR);
          WI_PIN();
          f32x4 axs[2];
#pragma unroll
          for (int n = 0; n < 2; ++n)
#pragma unroll
              for (int i = 0; i < 4; ++i) { const int rs = 16 * m + fr, cs = n0 + 16 * n + 4 * fq + i;
                  if (!(rs < cs)) { ans[n][i] = 0.f; aks[n][i] = 0.f; } axs[n][i] = ans[n][i] + (rs == cs ? 1.0f : 0.f);
                  const int rn = 16 * m + 4 * fq + i, cn = n0 + 16 * n + fr;
                  if (!(rn < cn)) ant[n][i] = 0.f; if (rn > cn) { am[n][i] = 0.f; amk[n][i] = 0.f; } }
          wi_st_nat_s(SLOT(7), ans, m, n0, fr, fq); wi_st_tr(SLOT(8), ant, m, n0, fr, fq); wi_st_nat_s(SLOT(6), aks, m, n0, fr, fq); wi_st_nat_s(SLOT(11), axs, m, n0, fr, fq);
          wi_st_tr(SLOT(13), am, m, n0, fr, fq); wi_st_tr(SLOT(14), amk, m, n0, fr, fq); }
        HBAR();
        { WiA aN; WiB bN; wi_lda(aN, SLOT(7), m, fr, fq); wi_ldb(bN, SLOT(8), n0, fr, fq); WI_PIN();
          f32x4 a2s[2] = {{0.f, 0.f, 0.f, 0.f}, {0.f, 0.f, 0.f, 0.f}}, a2t[2] = {{0.f, 0.f, 0.f, 0.f}, {0.f, 0.f, 0.f, 0.f}}; wi_fma_s(a2s, aN, bN); wi_fma(a2t, aN, bN); WI_PIN();
          wi_st_nat_s(SLOT(9), a2s, m, n0, fr, fq); wi_st_tr(SLOT(10), a2t, m, n0, fr, fq); }
        HBAR();
#define WI_LEVEL(XS, XD, NS, NST, ND, NDT) do { WiA aX, aN; WiB bN; f32x4 ax[2]; wi_lda(aX, SLOT(XS), m, fr, fq); wi_ldb(bN, SLOT(NST), n0, fr, fq); wi_lda(aN, SLOT(NS), m, fr, fq); wi_ld_nat_s(ax, SLOT(XS), m, n0, fr, fq); \
            WI_PIN(); f32x4 aqs[2] = {{0.f, 0.f, 0.f, 0.f}, {0.f, 0.f, 0.f, 0.f}}, aqt[2] = {{0.f, 0.f, 0.f, 0.f}, {0.f, 0.f, 0.f, 0.f}}; wi_fma_s(ax, aX, bN); wi_fma_s(aqs, aN, bN); wi_fma(aqt, aN, bN); WI_PIN(); \
            wi_st_nat_s(SLOT(XD), ax, m, n0, fr, fq); wi_st_nat_s(SLOT(ND), aqs, m, n0, fr, fq); wi_st_tr(SLOT(NDT), aqt, m, n0, fr, fq); \
            HBAR(); } while (0)
        WI_LEVEL(11, 0, 9, 10, 7, 8);
        WI_LEVEL(0, 11, 7, 8, 9, 10);
        WI_LEVEL(11, 0, 9, 10, 7, 8);
        WI_LEVEL(0, 11, 7, 8, 9, 10);
#undef WI_LEVEL
        { WiA aX; WiB bN; f32x4 ax[2]; wi_lda(aX, SLOT(11), m, fr, fq); wi_ldb(bN, SLOT(10), n0, fr, fq); wi_ld_nat(ax, SLOT(11), m, n0, fr, fq); WI_PIN();
          wi_fma(ax, aX, bN); WI_PIN(); wi_st_tr(SLOT(0), ax, m, n0, fr, fq); }
        HBAR();
        { WiA aNk, aAt; WiB bT; wi_lda(aNk, SLOT(6), m, fr, fq); wi_lda(aAt, SLOT(1), m, fr, fq); wi_ldb(bT, SLOT(0), n0, fr, fq); WI_PIN();
          f32x4 aw[2] = {{0.f, 0.f, 0.f, 0.f}, {0.f, 0.f, 0.f, 0.f}}, aa[2] = {{0.f, 0.f, 0.f, 0.f}, {0.f, 0.f, 0.f, 0.f}}; wi_fma_s(aw, aNk, bT); wi_fma_s(aa, aAt, bT); WI_PIN();
          wi_st_nat_s(SLOT(2), aw, m, n0, fr, fq); wi_st_nat_s(SLOT(7), aa, m, n0, fr, fq); }
        HBAR();
        { WiA aAT, aW1; WiB bB, bM; f32x4 ap[2] = {{0.f, 0.f, 0.f, 0.f}, {0.f, 0.f, 0.f, 0.f}}, az[2], ag[2], az2[2]; float gl[2];
          wi_lda(aAT, SLOT(7), m, fr, fq); wi_lda(aW1, SLOT(2), m, fr, fq); wi_ldb(bB, SLOT(3), n0, fr, fq); wi_ldb(bM, SLOT(13), n0, fr, fq);
          wi_ld_nat(az, SLOT(4), m, n0, fr, fq); wi_ld_tr(az2, SLOT(14), m, n0, fr, fq); wi_ld_tr(ag, SLOT(12), m, n0, fr, fq);
#pragma unroll
          for (int n = 0; n < 2; ++n) gl[n] = GL[n0 + 16 * n + fr];
          WI_PIN();
          wi_fma(ap, aAT, bB); wi_fma(az, aW1, bB); wi_fma(ag, aAT, bM); wi_fma(az2, aW1, bM);
          WI_PIN();
          wi_st_tr(SLOT(8), az, m, n0, fr, fq); wi_st_tr(SLOT(9), az2, m, n0, fr, fq);
          bf16* PTp = (bf16*)ST + (size_t)(h * NCH + ch) * 4096; bf16* GMp = gm_ptr(a.ws, h, ch);
#pragma unroll
          for (int n = 0; n < 2; ++n) { const int col = n0 + 16 * n + fr; f32x4 pv = ap[n];
#pragma unroll
              for (int i = 0; i < 4; ++i) { if (16 * m + 4 * fq + i == col) pv[i] += 1.0f; pv[i] *= gl[n]; }
              u32x2 w; w.x = pk2(pv[0], pv[1]); w.y = pk2(pv[2], pv[3]); *(u32x2*)(PTp + col * 64 + 16 * m + 4 * fq) = w;
              u32x2 w2; w2.x = pk2(ag[n][0], ag[n][1]); w2.y = pk2(ag[n][2], ag[n][3]); *(u32x2*)(GMp + col * 64 + 16 * m + 4 * fq) = w2; } }
        HBAR();
        { WiA aV; WiB bZ1, bZ2; float gl[2]; wi_lda(aV, SLOT(5), m, fr, fq); wi_ldb(bZ1, SLOT(8), n0, fr, fq); wi_ldb(bZ2, SLOT(9), n0, fr, fq); gl[0] = GL[n0 + fr]; gl[1] = GL[n0 + 16 + fr]; WI_PIN();
          f32x4 aq[2] = {{0.f, 0.f, 0.f, 0.f}, {0.f, 0.f, 0.f, 0.f}}, ay[2] = {{0.f, 0.f, 0.f, 0.f}, {0.f, 0.f, 0.f, 0.f}}; wi_fma(aq, aV, bZ1); wi_fma(ay, aV, bZ2); WI_PIN();
          float* QTp = ST + ST_Q_OFF + (size_t)(h * NCH + ch) * 4096; bf16* Y0p = (bf16*)(a.ws + WS_Y0) + (size_t)(h * NCH + ch) * 4096;
#pragma unroll
          for (int n = 0; n < 2; ++n) { const int col = n0 + 16 * n + fr; *(f32x4*)(QTp + col * 64 + 16 * m + 4 * fq) = aq[n] * gl[n];
              u32x2 w; w.x = pk2(ay[n][0], ay[n][1]); w.y = pk2(ay[n][2], ay[n][3]); *(u32x2*)(Y0p + col * 64 + 16 * m + 4 * fq) = w; } }
        HBAR();
    }
#undef SLOT
#undef WI_FETCH
}

__device__ __forceinline__ void phase_scan3m(ArgsR a, const Ctx& c, int l) {
    const f16* R = (const f16*)(a.ws + WS_R); const f16* KP = (const f16*)(a.ws + WS_KP); const f16* V = (const f16*)(a.ws + WS_V); const bf16* G = (const bf16*)(a.ws + WS_G);
    bf16* YA = (bf16*)(a.ws + WS_YA);
    LAS3 unsigned char* L = (LAS3 unsigned char*)c.lds;
    LAS3 float* YL = (LAS3 float*)(L + WI_B);
    const int lane = c.lane, wv = c.wave, fr = lane & 15, fq = lane >> 4, m = wv >> 1, n0 = 32 * (wv & 1), tid = c.tid;
    for (int item = blockIdx.x; item < NH * NCH; item += gridDim.x) {
        const int h = item / NCH, ch = item % NCH;
        { u32x4 v = {0u, 0u, 0u, 0u}; if (ch > 0) v = *(const u32x4*)((const bf16*)(a.ws + WS_ST) + (size_t)(h * NCH + ch - 1) * 4096 + tid * 8);
          *(LAS3 u32x4*)(L + ((tid >> 3) * WI_LD + (tid & 7) * 8) * 2) = v; }
        const bf16* GMp = gm_ptr(a.ws, h, ch); const bf16* Y0p = (const bf16*)(a.ws + WS_Y0) + (size_t)(h * NCH + ch) * 4096;
        bf16x8 bfr[2][2]; f32x4 acc[2];
#pragma unroll
        for (int ks = 0; ks < 2; ++ks)
#pragma unroll
            for (int n = 0; n < 2; ++n) bfr[ks][n] = *(const bf16x8*)(GMp + (n0 + 16 * n + fr) * 64 + 32 * ks + 8 * fq);
#pragma unroll
        for (int n = 0; n < 2; ++n) acc[n] = load4bf(Y0p + (n0 + 16 * n + fr) * 64 + 16 * m + 4 * fq);
        HBAR();
#pragma unroll
        for (int ks = 0; ks < 2; ++ks) { const bf16x8 av = *(const LAS3 bf16x8*)(L + ((16 * m + fr) * WI_LD + 32 * ks + 8 * fq) * 2);
#pragma unroll
            for (int n = 0; n < 2; ++n) acc[n] = __builtin_amdgcn_mfma_f32_16x16x32_bf16(av, bfr[ks][n], acc[n], 0, 0, 0); }
#pragma unroll
        for (int n = 0; n < 2; ++n)
#pragma unroll
            for (int i = 0; i < 4; ++i) YL[(n0 + 16 * n + fr) * 65 + 16 * m + 4 * fq + i] = acc[n][i];
        HBAR();
        { const float gn_g = a.in[I_GNG][l * W + h * 64 + lane], gn_b = a.in[I_GNB][l * W + h * 64 + lane], r_k = a.in[I_RK][l * W + h * 64 + lane];
#pragma unroll 2
          for (int i = 0; i < 8; ++i) { const int t = 8 * wv + i; const size_t o = (size_t)(ch * CL + t) * W + h * 64 + lane;
              const float yy = YL[t * 65 + lane]; const float rl = (float)R[o], kl = (float)KP[o], vl = (float)V[o], gl = bf2f(G[o]);
              const float mean = wave_sum(yy) * (1.f / 64.f); const float dd = yy - mean; const float var = wave_sum(dd * dd) * (1.f / 64.f);
              const float bonus = wave_sum(rl * kl * r_k);
              const float yn = dd * __builtin_amdgcn_rsqf(var + GN_EPS) * gn_g + gn_b + bonus * vl;
              YA[o] = f2bf(yn * gl); } }
        HBAR();
    }
}

__device__ __forceinline__ void phase_scan3(ArgsR a, const Ctx& c, int l) {
    const f16* R = (const f16*)(a.ws + WS_R); const f16* WM1 = (const f16*)(a.ws + WS_WM1); const f16* KP = (const f16*)(a.ws + WS_KP);
    const f16* AA = (const f16*)(a.ws + WS_AA); const f16* BB = (const f16*)(a.ws + WS_BB); const f16* V = (const f16*)(a.ws + WS_V);
    const float* ST = (const float*)(a.ws + WS_ST); bf16* YA = (bf16*)(a.ws + WS_YA); const f16* Gs = (const f16*)(a.ws + WS_G);
    const int lane = c.lane;
    LAS3 unsigned char* ring = (LAS3 unsigned char*)c.lds + c.wave * SC_WAVE;
    for (int item = c.gw; item < NH * NCH; item += c.ngw) {
        const int h = __builtin_amdgcn_readfirstlane(item / NCH), ch = __builtin_amdgcn_readfirstlane(item % NCH);
        const size_t lane_off = (size_t)(lane >> 3) * W + h * 64 + (lane & 7) * 8;
        const float gn_g = a.in[I_GNG][l * W + h * 64 + lane], gn_b = a.in[I_GNB][l * W + h * 64 + lane], r_k = a.in[I_RK][l * W + h * 64 + lane];
        { const size_t e0 = (size_t)(ch * CL) * W + lane_off;
          sc_dma(AA, e0, ring); sc_dma(WM1, e0, ring + 1024); sc_dma(BB, e0, ring + 2048); sc_dma(KP, e0, ring + 3072); sc_dma(V, e0, ring + 4096); sc_dma(R, e0, ring + 5120); sc_dma(Gs, e0, ring + 6144); }
        float S[64];
        if (ch == 0) {
#pragma unroll
            for (int j = 0; j < 64; ++j) S[j] = 0.f;
        } else { const bf16* Sp = (const bf16*)ST + ((size_t)(h * NCH + ch - 1) * 64 + lane) * 64;
#pragma unroll
            for (int j = 0; j < 64; j += 4) { const f32x4 x = load4bf(Sp + j); S[j] = x[0]; S[j + 1] = x[1]; S[j + 2] = x[2]; S[j + 3] = x[3]; } }
#pragma unroll 1
        for (int blk = 0; blk < CL / SCB; ++blk) {
            LAS3 unsigned char* buf = ring + (blk & 1) * SC_BUF;
            if (blk + 1 < CL / SCB) { LAS3 unsigned char* nb = ring + ((blk + 1) & 1) * SC_BUF; const size_t e0 = (size_t)(ch * CL + (blk + 1) * SCB) * W + lane_off;
                sc_dma(AA, e0, nb); sc_dma(WM1, e0, nb + 1024); sc_dma(BB, e0, nb + 2048); sc_dma(KP, e0, nb + 3072); sc_dma(V, e0, nb + 4096); sc_dma(R, e0, nb + 5120); sc_dma(Gs, e0, nb + 6144);
                asm volatile("s_waitcnt vmcnt(7)" ::: "memory"); }
            else asm volatile("s_waitcnt vmcnt(0)" ::: "memory");
            SVec A, Wv, Bv, Kv, Rv;
            sv_cvt(A, sv_read(buf, lane)); sv_cvt1p(Wv, sv_read(buf + 1024, lane)); sv_cvt(Bv, sv_read(buf + 2048, lane)); sv_cvt(Kv, sv_read(buf + 3072, lane)); sv_cvt(Rv, sv_read(buf + 5120, lane));
            float vv = (float)*(const LAS3 f16*)(buf + 4096 + lane * 2);
#pragma unroll 1
            for (int st = 0; st < SCB; ++st) {
                const LAS3 unsigned char* sn = buf + ((st + 1 < SCB) ? st + 1 : st) * 128;
                const f16x4 ha = sv_read(sn, lane), hw = sv_read(sn + 1024, lane), hb = sv_read(sn + 2048, lane), hk = sv_read(sn + 3072, lane), hr = sv_read(sn + 5120, lane);
                const f16 hv = *(const LAS3 f16*)(sn + 4096 + lane * 2);
                float d[4] = {0.f, 0.f, 0.f, 0.f};
                sc_dot<0>(d, A, S);
                const float sa = (d[0] + d[1]) + (d[2] + d[3]);
                float y[4] = {0.f, 0.f, 0.f, 0.f};
                sc_upd3<0>(S, y, Wv, Bv, Kv, Rv, sa, vv);
                const float yy = (y[0] + y[1]) + (y[2] + y[3]);
                sv_cvt(A, ha); sv_cvt1p(Wv, hw); sv_cvt(Bv, hb); sv_cvt(Kv, hk); sv_cvt(Rv, hr); vv = (float)hv;
                { const LAS3 unsigned char* sb = buf + st * 128;
                  const float rl = (float)*(const LAS3 f16*)(sb + 5120 + lane * 2), kl = (float)*(const LAS3 f16*)(sb + 3072 + lane * 2), vl = (float)*(const LAS3 f16*)(sb + 4096 + lane * 2);
                  const float gl = bf2f(*(const LAS3 bf16*)(sb + 6144 + lane * 2));
                  const float mean = wave_sum(yy) * (1.f / 64.f); const float dd = yy - mean; const float var = wave_sum(dd * dd) * (1.f / 64.f);
                  const float bonus = wave_sum(rl * kl * r_k);
                  const float yn = dd * __builtin_amdgcn_rsqf(var + GN_EPS) * gn_g + gn_b + bonus * vl;
                  YA[(size_t)(ch * CL + blk * SCB + st) * W + h * 64 + lane] = f2bf(yn * gl); }
            }
        }
    }
}

__device__ __forceinline__ void phase_post(ArgsR a, const Ctx& c, int l) {
    const bf16* YSC = (const bf16*)(a.ws + WS_YSC); const f16* R = (const f16*)(a.ws + WS_R); const f16* KP = (const f16*)(a.ws + WS_KP); const f16* V = (const f16*)(a.ws + WS_V);
    const bf16* G = (const bf16*)(a.ws + WS_G); bf16* YA = (bf16*)(a.ws + WS_YA);
    const float* gng = a.in[I_GNG] + l * W; const float* gnb = a.in[I_GNB] + l * W; const float* rk = a.in[I_RK] + l * W;
    for (int t = c.gw; t < T; t += c.ngw) {
#pragma unroll
        for (int i = 0; i < 8; ++i) { const int n = c.lane + 64 * i; const size_t o = (size_t)t * W + n;
            const float y = bf2f(YSC[o]); const float mean = wave_sum(y) * (1.f / 64.f); const float d = y - mean; const float var = wave_sum(d * d) * (1.f / 64.f);
            float yn = d * __builtin_amdgcn_rsqf(var + GN_EPS) * gng[n] + gnb[n];
            const float r = (float)R[o], k = (float)KP[o], v = (float)V[o];
            const float bonus = wave_sum(r * k * rk[n]);
            yn += bonus * v;
            YA[o] = f2bf(yn * bf2f(G[o])); }
    }
}

__device__ __forceinline__ void phase_ln1(ArgsR a, const Ctx& c, int l, float* outw, int mode = 3) {
    const float* MODF = (const float*)(a.ws + WS_MODF) + l * 6144;
    const float* g1 = a.in[I_LN1G] + l * D; const float* b1 = a.in[I_LN1B] + l * D;
    bf16* XN = (bf16*)(a.ws + WS_XN);
    int* TOKI = (int*)(a.ws + WS_TOKI); float* TOKW = (float*)(a.ws + WS_TOKW); int* TOKP = (int*)(a.ws + WS_TOKP);
    const float* rw = a.in[I_RW]; const float* rb = a.in[I_RB];
    LAS3 float* rwT = (LAS3 float*)((LAS3 unsigned char*)c.lds + 69632);
    unsigned* lcnt = (unsigned*)(c.lds + 135168);
    if (mode & 1) {
    for (int i = c.tid; i < D * NE; i += NTHREADS) rwT[(i & 15) * D + (i >> 4)] = rw[i];
    if (c.tid < NE) lcnt[c.tid] = 0u;
    __syncthreads();
    float vn[16]; if (c.gw < T) load_row16(a.out + (size_t)c.gw * D, c.lane, vn);
    for (int m = c.gw; m < T; m += c.ngw) {
        int l4 = 4 * c.lane; asm volatile("" : "+v"(l4));
        float v[16];
#pragma unroll
        for (int j = 0; j < 16; ++j) v[j] = vn[j];
        if (m + c.ngw < T) load_row16(a.out + (size_t)(m + c.ngw) * D, c.lane, vn);
        float mean, rstd; row_stats(v, mean, rstd);
#pragma unroll
        for (int j = 0; j < 4; ++j) { f32x4 o; const int col = l4 + 256 * j;
#pragma unroll
            for (int e = 0; e < 4; ++e) { v[4 * j + e] = (v[4 * j + e] - mean) * rstd * g1[col + e] + b1[col + e]; o[e] = v[4 * j + e]; }
            *(f32x4*)(outw + (size_t)m * D + col) = o; }
        row_stats(v, mean, rstd);
#pragma unroll
        for (int j = 0; j < 4; ++j) { f32x4 o; const int col = l4 + 256 * j;
#pragma unroll
            for (int e = 0; e < 4; ++e) { v[4 * j + e] = (v[4 * j + e] - mean) * rstd * (1.0f + MODF[4096 + col + e]) + MODF[3072 + col + e]; o[e] = v[4 * j + e]; }
            store4bf(XN + (size_t)m * D + col, o); }
        float lg[16];
#pragma unroll
        for (int e = 0; e < 16; ++e) { float x = 0.f;
#pragma unroll
            for (int j = 0; j < 4; ++j) { const f32x4 r4 = *(const LAS3 f32x4*)(rwT + e * D + l4 + 256 * j); x += (v[4 * j] * r4[0] + v[4 * j + 1] * r4[1]) + (v[4 * j + 2] * r4[2] + v[4 * j + 3] * r4[3]); }
            lg[e] = x;
            if ((e & 3) == 3) __builtin_amdgcn_sched_barrier(0); }
        float r8[8], r4v[4], r2[2], r1;
        { const bool b5 = (c.lane & 32) != 0, b4 = (c.lane & 16) != 0, b3 = (c.lane & 8) != 0, b2 = (c.lane & 4) != 0;
#pragma unroll
          for (int i = 0; i < 8; ++i) { const float snd = b5 ? lg[i] : lg[i + 8], kp = b5 ? lg[i + 8] : lg[i]; r8[i] = kp + __shfl_xor(snd, 32); }
#pragma unroll
          for (int i = 0; i < 4; ++i) { const float snd = b4 ? r8[i] : r8[i + 4], kp = b4 ? r8[i + 4] : r8[i]; r4v[i] = kp + __shfl_xor(snd, 16); }
#pragma unroll
          for (int i = 0; i < 2; ++i) { const float snd = b3 ? r4v[i] : r4v[i + 2], kp = b3 ? r4v[i + 2] : r4v[i]; r2[i] = kp + __shfl_xor(snd, 8); }
          { const float snd = b2 ? r2[0] : r2[1], kp = b2 ? r2[1] : r2[0]; r1 = kp + __shfl_xor(snd, 4); }
          r1 += __shfl_xor(r1, 2); r1 += __shfl_xor(r1, 1); }
        float sc[16], sel[16];
#pragma unroll
        for (int e = 0; e < 16; ++e) { const float lgt = __shfl(r1, 4 * e); sc[e] = __builtin_amdgcn_rcpf(1.0f + __expf(-lgt)); sel[e] = sc[e] + rb[e]; }
        int best = 0; float bestv = -INFINITY;
#pragma unroll
        for (int g = 0; g < 4; ++g) { float m1 = -INFINITY, m2 = -INFINITY;
#pragma unroll
            for (int q = 0; q < 4; ++q) { const float sv = sel[4 * g + q]; if (sv > m1) { m2 = m1; m1 = sv; } else if (sv > m2) m2 = sv; }
            const float gs = m1 + m2; if (gs > bestv) { bestv = gs; best = g; } }
        int i1 = 0, i2 = 0; float s1 = -INFINITY, s2 = -INFINITY, w1 = 0.f, w2 = 0.f;
#pragma unroll
        for (int e = 0; e < 16; ++e) { if ((e >> 2) == best) { const float sv = sel[e];
                if (sv > s1) { s2 = s1; i2 = i1; w2 = w1; s1 = sv; i1 = e; w1 = sc[e]; } else if (sv > s2) { s2 = sv; i2 = e; w2 = sc[e]; } } }
        if (c.lane == 0) { const float ws = w1 + w2;
            TOKI[2 * m] = i1; TOKI[2 * m + 1] = i2; TOKW[2 * m] = w1 / ws; TOKW[2 * m + 1] = w2 / ws;
            TOKP[2 * m] = (int)atomicAdd(&lcnt[i1], 1u); TOKP[2 * m + 1] = (int)atomicAdd(&lcnt[i2], 1u); }
    }
    __syncthreads();
    if (c.tid < NE) ((int*)(a.ws + WS_BLKCNT))[blockIdx.x * NE + c.tid] = (int)lcnt[c.tid];
    __syncthreads();
    }
    if (!(mode & 2)) return;
    float* scr = (float*)(c.lds + c.wave * 8704);
    bf16* WGU = (bf16*)(a.ws + WS_WGU); bf16* WD = (bf16*)(a.ws + WS_WD);
    constexpr int IG = (D / 64) * (FF / 32);
    constexpr int ID = (FF / 64) * (D / 32);
    for (int it = c.gw; it < NE * (2 * IG + ID); it += c.ngw) {
        const int e = it / (2 * IG + ID); int r = it % (2 * IG + ID);
        const size_t eo = ((size_t)l * NE + e) * (size_t)D * FF;
        if (r < IG) { transpose_matrix_item(a.in[I_EG] + eo, D, FF, WGU + (size_t)e * 1024 * 1024, r, scr, c.lane, RowGU{0}); continue; } r -= IG;
        if (r < IG) { transpose_matrix_item(a.in[I_EU] + eo, D, FF, WGU + (size_t)e * 1024 * 1024, r, scr, c.lane, RowGU{1}); continue; } r -= IG;
        transpose_matrix_item(a.in[I_ED] + eo, FF, D, WD + (size_t)e * 1024 * 512, r, scr, c.lane, RowId());
    }
}

__device__ __forceinline__ void phase_perm(ArgsR a, const Ctx& c, int l) {
    const int* BLKCNT = (const int*)(a.ws + WS_BLKCNT);
    LAS3 int* pre = (LAS3 int*)c.lds;
    LAS3 int* tot = pre + 256 * NE;
    const int nb = gridDim.x;
#pragma unroll
    for (int q = 0; q < 2; ++q) { const int e = 2 * c.wave + q; int v[4]; int sum = 0;
#pragma unroll
        for (int i = 0; i < 4; ++i) { const int b = 4 * c.lane + i; v[i] = b < nb ? BLKCNT[b * NE + e] : 0; sum += v[i]; }
        int inc = sum;
#pragma unroll
        for (int o = 1; o < 64; o <<= 1) { const int t = __shfl_up(inc, o); if (c.lane >= o) inc += t; }
        int run = inc - sum;
#pragma unroll
        for (int i = 0; i < 4; ++i) { pre[(4 * c.lane + i) * NE + e] = run; run += v[i]; }
        if (c.lane == 63) tot[e] = inc; }
    __syncthreads();
    int ts[17]; { int sacc = 0;
#pragma unroll
        for (int e = 0; e < 16; ++e) { ts[e] = sacc; sacc += (tot[e] + 255) >> 8; } ts[16] = sacc; }
    if (blockIdx.x == 0 && c.tid < NE) ((int*)(a.ws + WS_TOT))[c.tid] = tot[c.tid];
    const int* TOKI = (const int*)(a.ws + WS_TOKI); const int* TOKP = (const int*)(a.ws + WS_TOKP); int* S2T = (int*)(a.ws + WS_S2T);
    const bf16* XN = (const bf16*)(a.ws + WS_XN); bf16* XS = (bf16*)(a.ws + WS_XS);
    for (int as = c.gw; as < 2 * T; as += c.ngw) {
        const int e = TOKI[as]; int base = 0;
#pragma unroll
        for (int j = 0; j < 16; ++j) base = (j == e) ? ts[j] : base;
        const int m = as >> 1, blk = (m % c.ngw) >> 3;
        const int slot = base * 256 + pre[blk * NE + e] + TOKP[as];
        if (c.lane == 0) S2T[slot] = as;
        const u32x4* src = (const u32x4*)(XN + (size_t)m * D); u32x4* dst = (u32x4*)(XS + (size_t)slot * D);
        dst[c.lane] = src[c.lane]; dst[64 + c.lane] = src[64 + c.lane];
    }
    for (int e = 0; e < 16; ++e) {
        int tse = 0, tsn = 0;
#pragma unroll
        for (int j = 0; j < 16; ++j) { tse = (j == e) ? ts[j] : tse; tsn = (j == e) ? ts[j + 1] : tsn; }
        const int lo = tse * 256 + tot[e], hi = tsn * 256;
        for (int sl = lo + c.gw; sl < hi; sl += c.ngw) { if (c.lane == 0) S2T[sl] = -1; u32x4* dst = (u32x4*)(XS + (size_t)sl * D); const u32x4 zz = {0u, 0u, 0u, 0u}; dst[c.lane] = zz; dst[64 + c.lane] = zz; }
    }
    __syncthreads();
}

__device__ __forceinline__ void phase_ln2(ArgsR a, const Ctx& c, int l, float* outw) {
    const float* MODF = (const float*)(a.ws + WS_MODF) + l * 6144;
    const float* g2 = a.in[I_LN2G] + l * D; const float* b2 = a.in[I_LN2B] + l * D;
    const bf16* Y = (const bf16*)(a.ws + WS_Y); bf16* XN = (bf16*)(a.ws + WS_XN);
    float vn[16]; u32x2 y0n[4], y1n[4];
    if (c.gw < T) { load_row16(a.out + (size_t)c.gw * D, c.lane, vn);
#pragma unroll
        for (int j = 0; j < 4; ++j) { y0n[j] = *(const u32x2*)(Y + (size_t)(2 * c.gw) * D + 4 * c.lane + 256 * j); y1n[j] = *(const u32x2*)(Y + (size_t)(2 * c.gw + 1) * D + 4 * c.lane + 256 * j); } }
    for (int m = c.gw; m < T; m += c.ngw) {
        float v[16]; u32x2 y0[4], y1[4];
#pragma unroll
        for (int j = 0; j < 16; ++j) v[j] = vn[j];
#pragma unroll
        for (int j = 0; j < 4; ++j) { y0[j] = y0n[j]; y1[j] = y1n[j]; }
        if (m + c.ngw < T) { const int mn = m + c.ngw; load_row16(a.out + (size_t)mn * D, c.lane, vn);
#pragma unroll
            for (int j = 0; j < 4; ++j) { y0n[j] = *(const u32x2*)(Y + (size_t)(2 * mn) * D + 4 * c.lane + 256 * j); y1n[j] = *(const u32x2*)(Y + (size_t)(2 * mn + 1) * D + 4 * c.lane + 256 * j); } }
#pragma unroll
        for (int j = 0; j < 4; ++j) { const int col = 4 * c.lane + 256 * j;
            const float a0 = __uint_as_float(y0[j].x << 16) + __uint_as_float(y1[j].x << 16), a1 = __uint_as_float(y0[j].x & 0xffff0000u) + __uint_as_float(y1[j].x & 0xffff0000u);
            const float a2 = __uint_as_float(y0[j].y << 16) + __uint_as_float(y1[j].y << 16), a3 = __uint_as_float(y0[j].y & 0xffff0000u) + __uint_as_float(y1[j].y & 0xffff0000u);
            const f32x4 gt = *(const f32x4*)(MODF + 5120 + col);
            v[4 * j] = ALPHA * v[4 * j] + (1.0f + gt[0]) * a0; v[4 * j + 1] = ALPHA * v[4 * j + 1] + (1.0f + gt[1]) * a1; v[4 * j + 2] = ALPHA * v[4 * j + 2] + (1.0f + gt[2]) * a2; v[4 * j + 3] = ALPHA * v[4 * j + 3] + (1.0f + gt[3]) * a3; }
        float mean, rstd; row_stats(v, mean, rstd);
#pragma unroll
        for (int j = 0; j < 4; ++j) { f32x4 o; const int col = 4 * c.lane + 256 * j;
#pragma unroll
            for (int e = 0; e < 4; ++e) { v[4 * j + e] = (v[4 * j + e] - mean) * rstd * g2[col + e] + b2[col + e]; o[e] = v[4 * j + e]; }
            *(f32x4*)(outw + (size_t)m * D + col) = o; }
        if (l + 1 < DEPTH) {
            const float* MN = MODF + 6144;
            row_stats(v, mean, rstd);
#pragma unroll
            for (int j = 0; j < 4; ++j) { f32x4 o; const int col = 4 * c.lane + 256 * j;
#pragma unroll
                for (int e = 0; e < 4; ++e) o[e] = (v[4 * j + e] - mean) * rstd * (1.0f + MN[1024 + col + e]) + MN[col + e];
                store4bf(XN + (size_t)m * D + col, o); }
        }
    }
}


template <class F> struct EpiAdapt {
    static constexpr bool PERM = true, AFTER_DRAIN = false; F f;
    __device__ __forceinline__ void operator()(const f32x4 (&acc)[2][2][4][2], const Unit& u, int wr, int wc, int fr, int fq) const {
        const int col = u.pn * 256 + wc * 32 + 8 * fq;
#pragma unroll
        for (int ai = 0; ai < 2; ++ai)
#pragma unroll
            for (int m = 0; m < 4; ++m) { const int row = u.pm * 256 + ai * 128 + wr * 64 + m * 16 + fr; f(row, col, acc[ai][0][m][0], acc[ai][0][m][1], acc[ai][1][m][0], acc[ai][1][m][1]); }
    }
};

template <class Sched, class F>
__device__ __forceinline__ void gemm_any(const Ctx& c, const bf16* A, const bf16* Bt, int M, int N, int K, const Sched& S, const F& f) {
    pg8::Gemm g{A, Bt, M, N, K}; EpiAdapt<F> E{f};
    pg8::gemm_phase<EpiAdapt<F>, Sched, true, true>((PG8_LAS unsigned char*)c.lds, g, S, E, c.tid);
}

#define LAS __attribute__((address_space(3)))
#define XB_TMO      128
#define XB_XCNT(j)  (256  + 64 * (j))
#define XB_XSUB(j)  (1280 + 64 * (j))
#define XB_XGEN(j)  (2304 + 64 * (j))
#define XB_TOP      3328
#define XB_TOPGEN   3392
#define XCD_BAR_WORDS 3456
#define XB_SPIN_CAP (1u << 24)

__device__ __forceinline__ unsigned xb_ld(unsigned* p)              { return __hip_atomic_load(p, __ATOMIC_RELAXED, __HIP_MEMORY_SCOPE_AGENT); }
__device__ __forceinline__ unsigned xb_add(unsigned* p, unsigned v) { return __hip_atomic_fetch_add(p, v, __ATOMIC_RELAXED, __HIP_MEMORY_SCOPE_AGENT); }
__device__ __forceinline__ unsigned xb_xcc_id() { return (unsigned)__builtin_amdgcn_s_getreg((3 << 11) | 20) & 0xFu; }
#define XB_SPIN(cond, bar) do { unsigned _sp = 0; while (cond) { __builtin_amdgcn_s_sleep(1); \
    if ((++_sp & 255u) == 0u) { if (xb_ld(&(bar)[XB_TMO])) break; if (_sp > XB_SPIN_CAP) { atomicAdd(&(bar)[XB_TMO], 1u); break; } } } } while (0)

struct XcdBarrier {
    unsigned* bar; unsigned x;
    volatile LAS unsigned* st;
};

__device__ __forceinline__ XcdBarrier xcd_barrier_post(unsigned* bar, volatile LAS unsigned* st) {
    XcdBarrier b; b.bar = bar; b.x = xb_xcc_id(); b.st = st;
    if (threadIdx.x == 0) (void)xb_add(&bar[XB_XCNT(b.x)], 1u);
    return b;
}
__device__ __forceinline__ void xcd_barrier_complete(unsigned* bar, unsigned x, unsigned& nloc, unsigned& nx) {
    const unsigned G = gridDim.x * gridDim.y * gridDim.z;
    unsigned sum, cnt, mine, sp = 0u;
    for (;;) {
        sum = 0u; cnt = 0u; mine = 0u;
#pragma unroll
        for (unsigned j = 0; j < 16; ++j) { const unsigned c = xb_ld(&bar[XB_XCNT(j)]); sum += c; cnt += (c > 0u) ? 1u : 0u; mine = (j == x) ? c : mine; }
        if (sum == G) break;
        __builtin_amdgcn_s_sleep(1);
        if ((++sp & 255u) == 0u) { if (xb_ld(&bar[XB_TMO])) break; if (sp > XB_SPIN_CAP) { atomicAdd(&bar[XB_TMO], 1u); break; } }
    }
    nloc = mine > 0u ? mine : 1u; nx = cnt > 0u ? cnt : 1u;
}

__device__ __forceinline__ void xcd_barrier(const XcdBarrier& b) {
    asm volatile("s_waitcnt vmcnt(0)" ::: "memory");
    __syncthreads();
    if (threadIdx.x == 0) {
        unsigned* bar = b.bar;
        __builtin_amdgcn_s_waitcnt(0);
        unsigned nloc = b.st[0], nx = b.st[1];
        if (nloc == 0u) { xcd_barrier_complete(bar, b.x, nloc, nx); b.st[0] = nloc; b.st[1] = nx; }
        const unsigned old = xb_add(&bar[XB_XSUB(b.x)], 1u);
        const unsigned gen = old / nloc;
        if (old + 1u == (gen + 1u) * nloc) {
            __builtin_amdgcn_fence(__ATOMIC_RELEASE, "agent");
            asm volatile("s_waitcnt vmcnt(0)" ::: "memory");
            const unsigned og = xb_add(&bar[XB_TOP], 1u);
            const unsigned tg = og / nx;
            if (og + 1u == (tg + 1u) * nx) xb_add(&bar[XB_TOPGEN], 1u);
            else XB_SPIN(xb_ld(&bar[XB_TOPGEN]) == tg, bar);
            __builtin_amdgcn_fence(__ATOMIC_ACQUIRE, "agent");
            xb_add(&bar[XB_XGEN(b.x)], 1u);
            asm volatile("s_waitcnt vmcnt(0)" ::: "memory");
        } else {
            XB_SPIN(xb_ld(&bar[XB_XGEN(b.x)]) == gen, bar);
            __builtin_amdgcn_fence(__ATOMIC_ACQUIRE, "agent");
            asm volatile("s_waitcnt vmcnt(0)" ::: "memory");
        }
    }
    __syncthreads();
}


constexpr int PH_PER_LAYER = 12, N_PHASES = 2 + PH_PER_LAYER * DEPTH;
constexpr int CW_BAR = 4096;
constexpr int LDS_BYTES = 147456, LDSCTL_OFF = 131072 + 8192;
#ifndef SINGLE_LAUNCH
#define SINGLE_LAUNCH 1
#endif

#ifndef PROBE_A
#define PROBE_A -1
#endif
#ifndef PROBE_B
#define PROBE_B -1
#endif
constexpr size_t WS_TS = 512 * 1024;
#if PROBE_A >= 0
#define STAMP(i) do { if (blockIdx.x == 0 && threadIdx.x == 0) ((unsigned long long*)(args_here()->ws + WS_TS))[(i)] = __builtin_amdgcn_s_memrealtime(); } while (0)
#else
#define STAMP(i) do { } while (0)
#endif
__device__ __forceinline__ const __attribute__((address_space(4))) Args* args_here() { const __attribute__((address_space(4))) Args* p = (const __attribute__((address_space(4))) Args*)__builtin_amdgcn_kernarg_segment_ptr(); asm volatile("" : "+s"(p)); return p; }
#ifndef REP_K
#define REP_K -1
#endif
__device__ __forceinline__ Ctx mkctx(int wave_s, unsigned char* lds) { Ctx c; c.wave = wave_s; c.lane = (int)__builtin_amdgcn_mbcnt_hi(~0u, __builtin_amdgcn_mbcnt_lo(~0u, 0u)); c.tid = wave_s * 64 + c.lane;
    c.gw = blockIdx.x * NWAVES + wave_s; c.ngw = gridDim.x * NWAVES; c.lds = lds; return c; }
#define PHASE1(k, ...) do { const __attribute__((address_space(4))) Args* ap_ = args_here(); if (ap_->ph_lo <= (k) && (k) < ap_->ph_hi) { ArgsR a = *ap_; const Ctx c = mkctx(wave_s, lds); __VA_ARGS__ } } while (0)
#define PHASE(k, ...) do { PHASE1(k, __VA_ARGS__); if ((k) == REP_K) { xcd_barrier(bar); PHASE1(k, __VA_ARGS__); xcd_barrier(bar); PHASE1(k, __VA_ARGS__); } } while (0)

template <int L>
__device__ __forceinline__ void run_layer(const int wave_s, unsigned char* lds, const XcdBarrier& bar) {
    const int G = gridDim.x, b = blockIdx.x;
#define BAR() do { xcd_barrier(bar); STAMP(3 + 14 * L + (bk_++)); } while (0)
    int bk_ = 0;
    PHASE(0, unsigned char* ws = a.ws; pg8::StaticOrder S; S.init(T, INC, G, b); EpiZ E{(bf16*)(ws + WS_ZR), (bf16*)(ws + WS_ZS), (bf16*)(ws + WS_ZG)};
        gemm_any(c, (const bf16*)(ws + WS_XN), (const bf16*)(ws + WS_WIN + (size_t)L * 10 * MiB), T, INC, D, S, E); );
    BAR();
    PHASE(1, phase_prep_fast(a, c, L); );
    PHASE(14, phase_sg_fast(a, c, L); );
    BAR();
#if REP_K == 21
    PHASE1(2, phase_scan1m(a, c, 1); ); xcd_barrier(bar); PHASE1(2, phase_scan1m(a, c, 1); ); xcd_barrier(bar);
#endif
    PHASE(2, phase_scan1m(a, c); );
    BAR();
    PHASE(3, phase_scan2a(a, c); );
    BAR();
    PHASE(31, phase_scan2b(a, c); );
    BAR();
    PHASE(32, phase_scan2c(a, c); );
    BAR();
    PHASE(4, phase_scan3m(a, c, L); );
    BAR();
    PHASE(6, unsigned char* ws = a.ws; pg8::StaticOrder S; S.init(T, D, G, b); EpiGA E{(const bf16*)(ws + WS_ZG), (bf16*)(ws + WS_MP)};
        gemm_any(c, (const bf16*)(ws + WS_YA), (const bf16*)(ws + WS_WA + (size_t)L * WS_WL1), T, D, W, S, E); );
    BAR();
#if REP_K == 7
    PHASE1(7, unsigned char* ws = a.ws; pg8::StaticOrder S; S.init(T, D, G, b); EpiGB E{(const bf16*)(ws + WS_ZG), (const bf16*)(ws + WS_MP), (bf16*)(ws + WS_ZR)};
        gemm_any(c, (const bf16*)(ws + WS_YB), (const bf16*)(ws + WS_WB + (size_t)L * WS_WL1), T, D, W, S, E); ); xcd_barrier(bar);
    PHASE1(7, unsigned char* ws = a.ws; pg8::StaticOrder S; S.init(T, D, G, b); EpiGB E{(const bf16*)(ws + WS_ZG), (const bf16*)(ws + WS_MP), (bf16*)(ws + WS_ZR)};
        gemm_any(c, (const bf16*)(ws + WS_YB), (const bf16*)(ws + WS_WB + (size_t)L * WS_WL1), T, D, W, S, E); ); xcd_barrier(bar);
#endif
#if REP_K == 8
    PHASE1(8, unsigned char* ws = a.ws; pg8::StaticOrder S; S.init(T, D, G, b); EpiOut E{L == 0 ? a.in[I_X] : a.out, (float*)(ws + WS_R), (const float*)(ws + WS_MODF) + L * 6144 + 2048};
        gemm_any(c, (const bf16*)(ws + WS_MP), (const bf16*)(ws + WS_WO + (size_t)L * WS_WL1), T, D, D, S, E); ); xcd_barrier(bar);
    PHASE1(8, unsigned char* ws = a.ws; pg8::StaticOrder S; S.init(T, D, G, b); EpiOut E{L == 0 ? a.in[I_X] : a.out, (float*)(ws + WS_R), (const float*)(ws + WS_MODF) + L * 6144 + 2048};
        gemm_any(c, (const bf16*)(ws + WS_MP), (const bf16*)(ws + WS_WO + (size_t)L * WS_WL1), T, D, D, S, E); ); xcd_barrier(bar);
#endif
    PHASE1(7, unsigned char* ws = a.ws; pg8::StaticOrder S; S.init(T, D, G, b); EpiGB E{(const bf16*)(ws + WS_ZG), (const bf16*)(ws + WS_MP), (bf16*)(ws + WS_MP)};
        gemm_any(c, (const bf16*)(ws + WS_YB), (const bf16*)(ws + WS_WB + (size_t)L * WS_WL1), T, D, W, S, E); );
    BAR();
    PHASE1(8, unsigned char* ws = a.ws; pg8::StaticOrder S; S.init(T, D, G, b); EpiOut E{L == 0 ? a.in[I_X] : a.out, a.out, (const float*)(ws + WS_MODF) + L * 6144 + 2048};
        gemm_any(c, (const bf16*)(ws + WS_MP), (const bf16*)(ws + WS_WO + (size_t)L * WS_WL1), T, D, D, S, E); );
    BAR();
#if REP_K == 9
    PHASE1(9, phase_ln1(a, c, L, (float*)(a.ws + WS_ZR)); ); xcd_barrier(bar); PHASE1(9, phase_ln1(a, c, L, (float*)(a.ws + WS_ZR)); ); xcd_barrier(bar);
#endif
#if REP_K == 91
    PHASE1(9, phase_ln1(a, c, L, (float*)(a.ws + WS_ZR), 1); ); xcd_barrier(bar); PHASE1(9, phase_ln1(a, c, L, (float*)(a.ws + WS_ZR), 1); ); xcd_barrier(bar);
#endif
#if REP_K == 92
    PHASE1(9, phase_ln1(a, c, L, (float*)(a.ws + WS_ZR), 2); ); xcd_barrier(bar); PHASE1(9, phase_ln1(a, c, L, (float*)(a.ws + WS_ZR), 2); ); xcd_barrier(bar);
#endif
    PHASE1(9, phase_ln1(a, c, L, a.out); );
    BAR();
    PHASE(10, phase_perm(a, c, L); );
    BAR();
    PHASE(11, unsigned char* ws = a.ws; MoeSched S; S.init((const unsigned*)(ws + WS_TOT), G, b); EpiSwi E{(bf16*)(ws + WS_HID)};
        gemm_any(c, (const bf16*)(ws + WS_XS), (const bf16*)(ws + WS_WGU), MAXSLOT, NE * 1024, D, S, E); );
    BAR();
    PHASE(12, unsigned char* ws = a.ws; MoeSched S; S.init((const unsigned*)(ws + WS_TOT), G, b); EpiDown E{(const int*)(ws + WS_S2T), (const float*)(ws + WS_TOKW), (bf16*)(ws + WS_Y)};
        gemm_any(c, (const bf16*)(ws + WS_HID), (const bf16*)(ws + WS_WD), MAXSLOT, NE * 1024, FF, S, E); );
    BAR();
#if REP_K == 13
    PHASE1(13, phase_ln2(a, c, L, (float*)(a.ws + WS_R)); ); xcd_barrier(bar); PHASE1(13, phase_ln2(a, c, L, (float*)(a.ws + WS_R)); ); xcd_barrier(bar);
#endif
    PHASE1(13, phase_ln2(a, c, L, a.out); );
    if (L + 1 < DEPTH) BAR();
    (void)bk_;
#undef BAR
}

__global__ void __launch_bounds__(NTHREADS, 2) mk_fwd(Args a_unused) {
    extern __shared__ __attribute__((aligned(16))) unsigned char lds[];
    const int wave_s = __builtin_amdgcn_readfirstlane(threadIdx.x >> 6);
    for (int u = threadIdx.x; u < (LDS_BYTES - LDSCTL_OFF) / 4; u += NTHREADS) ((LAS unsigned*)((LAS unsigned char*)lds + LDSCTL_OFF))[u] = 0u;
    __syncthreads();
    const XcdBarrier bar = xcd_barrier_post((unsigned*)(args_here()->ws + WS_CTL) + CW_BAR, (volatile LAS unsigned*)((LAS unsigned char*)lds + LDSCTL_OFF) + 8);
    STAMP(0);
    PHASE(100, phase_p0a(a, c); );
    xcd_barrier(bar); STAMP(1);
    PHASE(101, phase_p0b(a, c); );
    xcd_barrier(bar); STAMP(2);
    run_layer<0>(wave_s, lds, bar);
    run_layer<1>(wave_s, lds, bar);
#if PROBE_A >= 0
    if (blockIdx.x == 0) {
        asm volatile("s_waitcnt vmcnt(0)" ::: "memory"); __syncthreads();
        if (threadIdx.x == 0) ((unsigned long long*)(args_here()->ws + WS_TS))[30] = __builtin_amdgcn_s_memrealtime();
        asm volatile("s_waitcnt vmcnt(0)" ::: "memory"); __syncthreads();
        const volatile unsigned long long* ts = (const volatile unsigned long long*)(args_here()->ws + WS_TS);
        float da = 0.f, db = 0.f;
        if (PROBE_A < 14) { da = (float)(ts[3 + PROBE_A] - ts[2 + PROBE_A]) + (float)(ts[17 + PROBE_A] - ts[16 + PROBE_A]); } else if (PROBE_A == 14) da = (float)(ts[1] - ts[0]); else if (PROBE_A == 15) da = (float)(ts[2] - ts[1]); else da = (float)(ts[30] - ts[0]);
        if (PROBE_B >= 0 && PROBE_B < 14) { db = (float)(ts[3 + PROBE_B] - ts[2 + PROBE_B]) + (float)(ts[17 + PROBE_B] - ts[16 + PROBE_B]); } else if (PROBE_B == 14) db = (float)(ts[1] - ts[0]); else if (PROBE_B == 15) db = (float)(ts[2] - ts[1]);
        da *= 0.01f; db *= 0.01f;
        da = exp2f(0.25f * rintf(4.0f * log2f(fmaxf(da, 0.5f)))); db = exp2f(0.25f * rintf(4.0f * log2f(fmaxf(db, 0.5f))));
        float* out = args_here()->out;
        for (int i = threadIdx.x; i < 16 * 1024; i += NTHREADS) { const int r = i >> 10, col = i & 1023; const int rowi = (r & 7) + 2048 * (r >> 3); out[(size_t)rowi * D + col] = da; }
        if (threadIdx.x == 0 && PROBE_B >= 0) out[(size_t)4096 * D] = 100.0f * db;
    }
#endif
}

extern "C" void kernel_launch(void* const* d_in, const int* in_sizes, int n_in, void* d_out, int out_size, void* d_ws, size_t ws_size, hipStream_t stream) {
    static int grid = 0;
    if (grid == 0) {
        if (n_in != N_IN || out_size != T * D || ws_size < WS_END2) { fprintf(stderr, "kernel_launch: unexpected shapes: n_in %d out %d ws %zu (need %zu)\n", n_in, out_size, ws_size, (size_t)WS_END2); grid = -1; return; }
        int dev = 0, cus = 0;
        (void)hipGetDevice(&dev); (void)hipDeviceGetAttribute(&cus, hipDeviceAttributeMultiprocessorCount, dev);
        if (hipFuncSetAttribute((const void*)mk_fwd, hipFuncAttributeMaxDynamicSharedMemorySize, LDS_BYTES) != hipSuccess) { fprintf(stderr, "kernel_launch: hipFuncSetAttribute failed\n"); grid = -1; return; }
        grid = cus > 0 ? cus : 256;
        fprintf(stderr, "kernel_launch: ws_size %zu grid %d\n", ws_size, grid);
    }
    if (grid < 0) return;
    (void)hipMemsetAsync((char*)d_ws + WS_CTL, 0, CTL_BYTES, stream);
    Args a{};
    for (int i = 0; i < N_IN; ++i) a.in[i] = (const float*)d_in[i];
    a.out = (float*)d_out; a.ws = (unsigned char*)d_ws;
    a.ph_lo = 0; a.ph_hi = 1000;
    hipLaunchKernelGGL(mk_fwd, dim3(grid), dim3(NTHREADS), LDS_BYTES, stream, a);
}
```

```cpp
#include <hip/hip_runtime.h>
#include <cstdio>
#include <cstdint>
#include <utility>

typedef unsigned short bf16;
typedef _Float16 f16;
typedef float f32x4 __attribute__((ext_vector_type(4)));
typedef unsigned u32x4 __attribute__((ext_vector_type(4)));
typedef unsigned u32x2 __attribute__((ext_vector_type(2)));

constexpr int T = 16384, D = 1024, W = 512, NH = 8, HN = 64, RC = 1792, INC = 4864;
constexpr int NE = 16, FF = 512, DEPTH = 2;
constexpr float LN_EPS = 1e-5f, GN_EPS = 64e-5f, ALPHA = 1.41421356237f;
constexpr int NTHREADS = 512, NWAVES = 8;
constexpr int MAXSLOT = 36864;

constexpr size_t MiB = 1u << 20;
constexpr size_t WS_CTL = 0, CTL_BYTES = 1 * MiB;
constexpr int CW_CNT = 16384;
constexpr size_t WS_PART = 1 * MiB;
constexpr size_t WS_MODF = 2 * MiB;
constexpr size_t WS_TOKI = 2 * MiB + 65536;
constexpr size_t WS_TOKW = WS_TOKI + 131072;
constexpr size_t WS_TOKP = WS_TOKW + 131072;
constexpr size_t WS_S2T = 3 * MiB;
constexpr size_t WS_BLKCNT = 3 * MiB + 512 * 1024;
constexpr size_t WS_TOT = WS_BLKCNT + 32768;
constexpr size_t WS_LORA = 4 * MiB;
constexpr size_t WS_WIN = 8 * MiB;
constexpr size_t WS_WA = 28 * MiB, WS_WB = 29 * MiB, WS_WO = 30 * MiB, WS_WL1 = 4 * MiB;
constexpr size_t WS_ZG = 36 * MiB;
constexpr size_t WS_XN = 100 * MiB;
constexpr size_t WS_G = 100 * MiB, WS_YB = 116 * MiB;
constexpr size_t WS_ZR = 132 * MiB;
constexpr size_t WS_ZS = 188 * MiB;
constexpr size_t WS_YSC = 132 * MiB;
constexpr size_t WS_ST = 148 * MiB;
constexpr size_t WS_YA = 132 * MiB;
constexpr size_t WS_MP = 164 * MiB;
constexpr size_t WS_XS = 132 * MiB;
constexpr size_t WS_Y = 132 * MiB;
constexpr size_t WS_AA = 224 * MiB, WS_BB = 240 * MiB, WS_WM1 = 256 * MiB, WS_R = 272 * MiB, WS_KP = 288 * MiB, WS_V = 304 * MiB;
constexpr size_t WS_WGU = 224 * MiB;
constexpr size_t WS_WD = 256 * MiB;
constexpr size_t WS_HID = 272 * MiB;
constexpr size_t WS_VF = 320 * MiB;
constexpr size_t WS_END = 336 * MiB;

constexpr size_t LO_W2T = 0, LO_A2T = 65536, LO_G2T = 131072, LO_VM1T = 262144, LO_VM2T = 294912, LO_STRIDE = 524288;

enum { I_X = 0, I_C, I_WMOD, I_BMOD, I_WIN, I_MU, I_W0, I_W2, I_A0, I_A2, I_G2, I_KK, I_KA, I_RK, I_GNG, I_GNB, I_VM0, I_VM1, I_VM2,
       I_SGG, I_SGB, I_WS, I_BS, I_WBA, I_WBB, I_WOUT, I_LN1G, I_LN1B, I_RW, I_RB, I_EG, I_EU, I_ED, I_LN2G, I_LN2B, N_IN };

struct Args { const float* in[N_IN]; float* out; unsigned char* ws; int ph_lo, ph_hi; };
typedef const __attribute__((address_space(4))) Args& ArgsR;

__device__ __forceinline__ float bf2f(bf16 h) { return __uint_as_float(((unsigned)h) << 16); }
__device__ __forceinline__ unsigned f2bfu(float f) { unsigned u = __float_as_uint(f); return (u + 0x7fffu + ((u >> 16) & 1u)) >> 16; }
__device__ __forceinline__ bf16 f2bf(float f) { return __builtin_bit_cast(unsigned short, (__bf16)f); }
typedef __bf16 bf16x2_t __attribute__((ext_vector_type(2)));
__device__ __forceinline__ unsigned pk2(float lo, float hi) { bf16x2_t v; v[0] = (__bf16)lo; v[1] = (__bf16)hi; return __builtin_bit_cast(unsigned, v); }
__device__ __forceinline__ void store4bf(bf16* p, f32x4 v) { u32x2 w; w.x = pk2(v[0], v[1]); w.y = pk2(v[2], v[3]); *(u32x2*)p = w; }
__device__ __forceinline__ f32x4 load4bf(const bf16* p) { u32x2 w = *(const u32x2*)p; f32x4 r; r[0] = __uint_as_float(w.x << 16); r[1] = __uint_as_float(w.x & 0xffff0000u); r[2] = __uint_as_float(w.y << 16); r[3] = __uint_as_float(w.y & 0xffff0000u); return r; }
__device__ __forceinline__ float wave_sum(float v) {
#pragma unroll
    for (int o = 1; o < 64; o <<= 1) v += __shfl_xor(v, o);
    return v;
}
__device__ __forceinline__ float sigmoidf_(float x) { return __builtin_amdgcn_rcpf(1.0f + __expf(-x)); }
__device__ __forceinline__ float siluf_(float x) { return x * sigmoidf_(x); }
__device__ __forceinline__ float gelu_tanh(float x) { const float u = 0.7978845608028654f * (x + 0.044715f * x * x * x); return x * (1.0f - __builtin_amdgcn_rcpf(1.0f + __expf(2.0f * u))); }
__device__ __forceinline__ float softplusf_(float y) { return fmaxf(y, 0.f) + log1pf(__expf(-fabsf(y))); }

struct Ctx { int tid, lane, wave, gw, ngw; unsigned char* lds; };

__device__ __forceinline__ void transpose_item(const float* Wsrc, int N, int k0, int n0, bf16* dst, int ldk, float* scr, int lane) {
    float tv[32];
#pragma unroll
    for (int i = 0; i < 32; ++i) tv[i] = Wsrc[(size_t)(k0 + 2 * i + (lane >> 5)) * N + n0 + (lane & 31)];
#pragma unroll
    for (int i = 0; i < 32; ++i) scr[(2 * i + (lane >> 5)) * 33 + (lane & 31)] = tv[i];
    asm volatile("s_waitcnt lgkmcnt(0)" ::: "memory");
    const int c = lane & 7;
#pragma unroll
    for (int j = 0; j < 4; ++j) { const int n = (lane >> 3) + 8 * j; const float* s = scr + (8 * c) * 33 + n;
        u32x4 o; o.x = pk2(s[0 * 33], s[1 * 33]); o.y = pk2(s[2 * 33], s[3 * 33]); o.z = pk2(s[4 * 33], s[5 * 33]); o.w = pk2(s[6 * 33], s[7 * 33]);
        *(u32x4*)(dst + (size_t)n * ldk + k0 + 8 * c) = o; }
    asm volatile("s_waitcnt lgkmcnt(0)" ::: "memory");
}
template <class RowMap>
__device__ __forceinline__ void transpose_matrix_item(const float* Wsrc, int K, int N, bf16* dst, int item, float* scr, int lane, const RowMap& rm) {
    const int nblk = N / 32, kb = item / nblk, nb = item % nblk, n0 = 32 * nb;
    transpose_item(Wsrc, N, 64 * kb, n0, dst + (size_t)rm(n0) * K, K, scr, lane);
}
struct RowId { __device__ __forceinline__ int operator()(int n) const { return n; } };
struct RowGU { int up; __device__ __forceinline__ int operator()(int n) const { return (n >> 7) * 256 + (n & 127) + up * 128; } };

__device__ __forceinline__ void phase_p0a(ArgsR a, const Ctx& c) {
    float* scr = (float*)(c.lds + c.wave * 16384);
    { float* MODF = (float*)(a.ws + WS_MODF); float* red = (float*)(c.lds + 131072);
      for (int cbk = blockIdx.x; cbk < 2 * 96; cbk += gridDim.x) {
          const int l = cbk / 96, n = (cbk % 96) * 64 + c.lane;
          const float* wm = a.in[I_WMOD] + (size_t)l * D * 6144 + (size_t)(c.wave * 128) * 6144 + n;
          float acc0 = 0.f, acc1 = 0.f;
#pragma unroll 16
          for (int k = 0; k < 128; k += 2) { acc0 += siluf_(a.in[I_C][c.wave * 128 + k]) * wm[(size_t)k * 6144]; acc1 += siluf_(a.in[I_C][c.wave * 128 + k + 1]) * wm[(size_t)(k + 1) * 6144]; }
          red[c.wave * 64 + c.lane] = acc0 + acc1;
          __syncthreads();
          if (c.wave == 0) { float sacc = a.in[I_BMOD][l * 6144 + n];
#pragma unroll
              for (int w = 0; w < 8; ++w) sacc += red[w * 64 + c.lane];
              MODF[l * 6144 + n] = sacc; }
          __syncthreads();
      } }
    for (int it = c.gw; it < 2 * (16 + 16 + 32 + 8); it += c.ngw) {
        const int l = it / 72; int r = it % 72; unsigned char* lo = a.ws + WS_LORA + (size_t)l * LO_STRIDE;
        if (r < 16) { transpose_matrix_item(a.in[I_W2] + (size_t)l * 64 * W, 64, W, (bf16*)(lo + LO_W2T), r, scr, c.lane, RowId()); continue; } r -= 16;
        if (r < 16) { transpose_matrix_item(a.in[I_A2] + (size_t)l * 64 * W, 64, W, (bf16*)(lo + LO_A2T), r, scr, c.lane, RowId()); continue; } r -= 16;
        if (r < 32) { transpose_matrix_item(a.in[I_G2] + (size_t)l * 128 * W, 128, W, (bf16*)(lo + LO_G2T), r, scr, c.lane, RowId()); continue; } r -= 32;
        if (l == 1) transpose_matrix_item(a.in[I_VM1], W, 32, (bf16*)(lo + LO_VM1T), r, scr, c.lane, RowId());
    }
    for (int i = blockIdx.x * NTHREADS + c.tid; i < 32 * W; i += gridDim.x * NTHREADS) { const int n = i >> 5, k = i & 31;
        ((bf16*)(a.ws + WS_LORA + LO_STRIDE + LO_VM2T))[i] = f2bf(a.in[I_VM2][(size_t)k * W + n]); }
    constexpr int I_WINL = (D / 64) * (INC / 32);
    constexpr int I_WAL = (W / 64) * (D / 32);
    constexpr int I_WOL = (D / 64) * (D / 32);
    constexpr int PER_L = I_WINL + 2 * I_WAL + I_WOL;
    for (int it = c.gw; it < 2 * PER_L; it += c.ngw) {
        const int l = it / PER_L; int r = it % PER_L;
        if (r < I_WINL) { transpose_matrix_item(a.in[I_WIN] + (size_t)l * D * INC, D, INC, (bf16*)(a.ws + WS_WIN + (size_t)l * 10 * MiB), r, scr, c.lane, RowId()); continue; } r -= I_WINL;
        if (r < I_WAL) { transpose_matrix_item(a.in[I_WBA] + (size_t)l * W * D, W, D, (bf16*)(a.ws + WS_WA + (size_t)l * WS_WL1), r, scr, c.lane, RowId()); continue; } r -= I_WAL;
        if (r < I_WAL) { transpose_matrix_item(a.in[I_WBB] + (size_t)l * W * D, W, D, (bf16*)(a.ws + WS_WB + (size_t)l * WS_WL1), r, scr, c.lane, RowId()); continue; } r -= I_WAL;
        transpose_matrix_item(a.in[I_WOUT] + (size_t)l * D * D, D, D, (bf16*)(a.ws + WS_WO + (size_t)l * WS_WL1), r, scr, c.lane, RowId());
    }
}

__device__ __forceinline__ void row_stats(const float (&v)[16], float& mean, float& rstd) {
    float s = 0.f;
#pragma unroll
    for (int j = 0; j < 16; ++j) s += v[j];
    mean = wave_sum(s) * (1.f / D);
    float q = 0.f;
#pragma unroll
    for (int j = 0; j < 16; ++j) { const float d = v[j] - mean; q += d * d; }
    rstd = __builtin_amdgcn_rsqf(wave_sum(q) * (1.f / D) + LN_EPS);
}
__device__ __forceinline__ void load_row16(const float* p, int lane, float (&v)[16]) {
#pragma unroll
    for (int j = 0; j < 4; ++j) { const f32x4 x = *(const f32x4*)(p + 4 * lane + 256 * j); v[4 * j] = x[0]; v[4 * j + 1] = x[1]; v[4 * j + 2] = x[2]; v[4 * j + 3] = x[3]; }
}

__device__ __forceinline__ void phase_p0b(ArgsR a, const Ctx& c) {
    const float* MODF = (const float*)(a.ws + WS_MODF);
    float sh[16], sc[16];
#pragma unroll
    for (int j = 0; j < 4; ++j) { const f32x4 s0 = *(const f32x4*)(MODF + 4 * c.lane + 256 * j), s1 = *(const f32x4*)(MODF + 1024 + 4 * c.lane + 256 * j);
#pragma unroll
        for (int e = 0; e < 4; ++e) { sh[4 * j + e] = s0[e]; sc[4 * j + e] = 1.f + s1[e]; } }
    bf16* XN = (bf16*)(a.ws + WS_XN);
    for (int m = c.gw; m < T; m += c.ngw) {
        float v[16]; load_row16(a.in[I_X] + (size_t)m * D, c.lane, v);
        float mean, rstd; row_stats(v, mean, rstd);
#pragma unroll
        for (int j = 0; j < 4; ++j) { f32x4 o;
#pragma unroll
            for (int e = 0; e < 4; ++e) o[e] = (v[4 * j + e] - mean) * rstd * sc[4 * j + e] + sh[4 * j + e];
            store4bf(XN + (size_t)m * D + 4 * c.lane + 256 * j, o); }
    }
}

namespace pg8 {
#define PG8_LAS __attribute__((address_space(3)))
typedef unsigned short bf16_t;
typedef short bf16x8 __attribute__((ext_vector_type(8)));
typedef float f32x4 __attribute__((ext_vector_type(4)));
typedef unsigned u32x4 __attribute__((ext_vector_type(4)));
constexpr int BM = 256, BK = 64, HALF = 128, HTB = HALF * BK * 2  , STAGE_BYTES = 8 * HTB, NXCD = 8, WGM = 8;

__host__ __device__ __forceinline__ int lds_byte(int r, int c) { const int st = (r >> 4) * 2 + (c >> 5), rr = r & 15, cc = c & 31, ob = rr * 64 + cc * 2; return st * 1024 + (ob ^ (((ob >> 9) & 1) << 5)); }
__host__ __device__ __forceinline__ void stage_rc(int b, int& R, int& C) { const int st = b / 1024, sb = b % 1024, swz = sb ^ (((sb >> 9) & 1) << 5); R = (st >> 1) * 16 + swz / 64; C = (st & 1) * 32 + (swz % 64) / 2; }
__host__ __device__ __forceinline__ int perm32(int rho) { const int n = rho >> 4, i = rho & 15; return 8 * (i >> 2) + 4 * n + (i & 3); }

struct Unit { int pm, pn; };
struct Gemm { const bf16_t* A; const bf16_t* Bt; int M, N, K; };

struct StaticOrder {
    int nM, nN, nwg, G, c;
    __host__ __device__ void init(int M, int N, int G_, int c_) { nM = M / BM; nN = N / BM; nwg = nM * nN; G = G_; c = c_; }
    __host__ __device__ bool next(int i, Unit& u) const {
        const long L = (long)i * G + c; if (L >= nwg) return false;
        int wgid = (int)L; { const int q = nwg / NXCD, r = nwg % NXCD, xcd = wgid % NXCD, off = wgid / NXCD; wgid = (xcd < r ? xcd * (q + 1) : r * (q + 1) + (xcd - r) * q) + off; }
        const int nig = WGM * nN, gid = wgid / nig, fm = gid * WGM, gsz = (nM - fm) < WGM ? (nM - fm) : WGM;
        u.pm = fm + ((wgid % nig) % gsz); u.pn = (wgid % nig) / gsz; return true;
    }
    __device__ __forceinline__ void a_ready(const Unit&) const {}
    __device__ __forceinline__ void done(const Unit&) const {}
};


template <class Epi, class Sched, bool ALIGN_EPI = false, bool SP2 = false>
__device__ __forceinline__ void gemm_phase(PG8_LAS unsigned char* lds, const Gemm g, const Sched& S, const Epi& E, const int tid_in) {
    const int tid = tid_in, wid = __builtin_amdgcn_readfirstlane(tid >> 6), lane = tid & 63, wr = wid >> 2, wc = wid & 3, fr = lane & 15, fq = lane >> 4;
    const int K = g.K, nt = K / BK;
    unsigned voffA[2], voffB[2];
#pragma unroll
    for (int i = 0; i < 2; ++i) { int R, C; stage_rc(tid * 16 + i * 8192, R, C); const int Rb = Epi::PERM ? ((R & ~31) + perm32(R & 31)) : R;
        voffA[i] = (unsigned)(R * K + C) * 2u; voffB[i] = (unsigned)(Rb * K + C) * 2u; }
    const size_t kstep = (size_t)(BK * 2);
    const size_t hstep = (size_t)HALF * K * 2;
    const size_t tstep = 2 * hstep;
    const unsigned ldsw = (unsigned)wid * 1024u;
    const int aoff = lds_byte(wr * 64 + fr, fq * 8), boff = lds_byte(wc * 32 + fr, fq * 8);
#define PG8_SA(b, h) (((b) * 2 + (h)) * HTB)
#define PG8_SB(b, h) ((4 + (b) * 2 + (h)) * HTB)
#define PG8_STAGE(bufoff, gbase, voff) do { _Pragma("unroll") for (int _i = 0; _i < 2; ++_i) \
        __builtin_amdgcn_global_load_lds((const unsigned*)((const char*)(gbase) + (voff)[_i]), (PG8_LAS unsigned*)(lds + (bufoff) + ldsw + _i * 8192), 16, 0, 0); } while (0)
#define PG8_LDA(dst, b, h) do { _Pragma("unroll") for (int m = 0; m < 4; ++m) _Pragma("unroll") for (int k = 0; k < 2; ++k) dst[m][k] = *(const PG8_LAS bf16x8*)(lds + PG8_SA(b, h) + aoff + m * 2048 + k * 1024); } while (0)
#define PG8_LDB(dst, b, h) do { _Pragma("unroll") for (int n = 0; n < 2; ++n) _Pragma("unroll") for (int k = 0; k < 2; ++k) dst[n][k] = *(const PG8_LAS bf16x8*)(lds + PG8_SB(b, h) + boff + n * 2048 + k * 1024); } while (0)
#define PG8_MMA(ai, bj, At, Bt) do { __builtin_amdgcn_s_setprio(1); _Pragma("unroll") for (int m = 0; m < 4; ++m) _Pragma("unroll") for (int n = 0; n < 2; ++n) _Pragma("unroll") for (int k = 0; k < 2; ++k) \
        acc[ai][bj][m][n] = __builtin_amdgcn_mfma_f32_16x16x32_bf16(Bt[n][k], At[m][k], acc[ai][bj][m][n], 0, 0, 0); __builtin_amdgcn_s_setprio(0); } while (0)
#define PG8_WAIT_V(n) asm volatile("s_waitcnt vmcnt(" #n ")" ::: "memory")
#define PG8_WAIT_L(n) asm volatile("s_waitcnt lgkmcnt(" #n ")" ::: "memory")
#define PG8_BAR __builtin_amdgcn_s_barrier()
#define PG8_SCHED __builtin_amdgcn_sched_barrier(0)
    Unit cur, nxt; int ui = 0;
    if (!S.next(0, cur)) return;
    f32x4 acc[2][2][4][2];
#pragma unroll
    for (int a = 0; a < 2; ++a)
#pragma unroll
        for (int b = 0; b < 2; ++b)
#pragma unroll
            for (int m = 0; m < 4; ++m)
#pragma unroll
                for (int n = 0; n < 2; ++n) acc[a][b][m][n] = (f32x4){0.f, 0.f, 0.f, 0.f};
    bf16x8 At[4][2], B0[2][2], B1[2][2];
    const char* cA = (const char*)g.A + (size_t)cur.pm * tstep; const char* cB = (const char*)g.Bt + (size_t)cur.pn * tstep;
    S.a_ready(cur);
    if constexpr (SP2) {
        PG8_STAGE(PG8_SB(0, 0), cB, voffB); PG8_STAGE(PG8_SB(0, 1), cB + hstep, voffB); PG8_STAGE(PG8_SA(0, 0), cA, voffA); PG8_STAGE(PG8_SA(0, 1), cA + hstep, voffA);
        if (wr == 1) PG8_BAR;
        PG8_WAIT_V(2); PG8_BAR;
        PG8_STAGE(PG8_SB(1, 0), cB + kstep, voffB); PG8_STAGE(PG8_SA(1, 0), cA + kstep, voffA); PG8_STAGE(PG8_SB(1, 1), cB + hstep + kstep, voffB);
        PG8_WAIT_V(6); PG8_BAR;
    } else {
        PG8_STAGE(PG8_SB(0, 0), cB, voffB); PG8_STAGE(PG8_SA(0, 0), cA, voffA); PG8_STAGE(PG8_SB(0, 1), cB + hstep, voffB); PG8_STAGE(PG8_SA(0, 1), cA + hstep, voffA);
        if (wr == 1) PG8_BAR;
        PG8_WAIT_V(4); PG8_BAR;
        PG8_STAGE(PG8_SB(1, 0), cB + kstep, voffB); PG8_STAGE(PG8_SA(1, 0), cA + kstep, voffA); PG8_STAGE(PG8_SB(1, 1), cB + hstep + kstep, voffB);
        PG8_WAIT_V(6); PG8_BAR;
    }
    for (;;) {
        const bool has_next = S.next(ui + 1, nxt);
        const char* nA = has_next ? (const char*)g.A + (size_t)nxt.pm * tstep : cA; const char* nB = has_next ? (const char*)g.Bt + (size_t)nxt.pn * tstep : cB;
        for (int t = 0; t < nt; t += 2) {
            const bool last = (t == nt - 2);
            const char* a1 = cA + (size_t)(t + 1) * kstep;
            const char* a2 = last ? nA : cA + (size_t)(t + 2) * kstep; const char* b2 = last ? nB : cB + (size_t)(t + 2) * kstep;
            const char* a3 = a2 + kstep; const char* b3 = b2 + kstep;
            if (last && has_next) S.a_ready(nxt);
            if constexpr (SP2) {
            PG8_LDB(B0, 0, 0); PG8_LDB(B1, 0, 1); PG8_SCHED; PG8_LDA(At, 0, 0); PG8_STAGE(PG8_SA(1, 1), a1 + hstep, voffA);
            PG8_WAIT_V(8); PG8_WAIT_L(0); PG8_BAR; PG8_MMA(0, 0, At, B0); PG8_MMA(0, 1, At, B1); PG8_BAR; PG8_SCHED;
            PG8_LDA(At, 0, 1); PG8_STAGE(PG8_SB(0, 0), b2, voffB); PG8_STAGE(PG8_SB(0, 1), b2 + hstep, voffB); PG8_STAGE(PG8_SA(0, 0), a2, voffA);
            PG8_WAIT_V(8); PG8_WAIT_L(0); PG8_BAR; PG8_MMA(1, 0, At, B0); PG8_MMA(1, 1, At, B1); PG8_BAR; PG8_SCHED;
            PG8_LDB(B0, 1, 0); PG8_LDB(B1, 1, 1); PG8_SCHED; PG8_LDA(At, 1, 0); PG8_STAGE(PG8_SA(0, 1), a2 + hstep, voffA);
            PG8_WAIT_V(8); PG8_WAIT_L(0); PG8_BAR; PG8_MMA(0, 0, At, B0); PG8_MMA(0, 1, At, B1); PG8_BAR; PG8_SCHED;
            PG8_LDA(At, 1, 1); PG8_STAGE(PG8_SB(1, 0), b3, voffB); PG8_STAGE(PG8_SB(1, 1), b3 + hstep, voffB); PG8_STAGE(PG8_SA(1, 0), a3, voffA);
            PG8_WAIT_V(8); PG8_WAIT_L(0); PG8_BAR; PG8_MMA(1, 0, At, B0); PG8_MMA(1, 1, At, B1); PG8_BAR; PG8_SCHED;
            } else {
            PG8_LDB(B0, 0, 0); PG8_SCHED; PG8_LDA(At, 0, 0); PG8_STAGE(PG8_SA(1, 1), a1 + hstep, voffA);
            PG8_WAIT_L(8); PG8_BAR; PG8_WAIT_L(0); PG8_MMA(0, 0, At, B0); PG8_BAR; PG8_SCHED;
            PG8_LDB(B1, 0, 1); PG8_STAGE(PG8_SB(0, 0), b2, voffB);
            PG8_BAR; PG8_WAIT_L(0); PG8_MMA(0, 1, At, B1); PG8_BAR;
            PG8_LDA(At, 0, 1); PG8_STAGE(PG8_SA(0, 0), a2, voffA);
            PG8_BAR; PG8_WAIT_L(0); PG8_MMA(1, 0, At, B0); PG8_BAR; PG8_SCHED;
            PG8_STAGE(PG8_SB(0, 1), b2 + hstep, voffB);
            PG8_WAIT_V(6); PG8_BAR; PG8_MMA(1, 1, At, B1); PG8_BAR;
            PG8_LDB(B0, 1, 0); PG8_SCHED; PG8_LDA(At, 1, 0); PG8_STAGE(PG8_SA(0, 1), a2 + hstep, voffA);
            PG8_WAIT_L(8); PG8_BAR; PG8_WAIT_L(0); PG8_MMA(0, 0, At, B0); PG8_BAR; PG8_SCHED;
            PG8_LDB(B1, 1, 1); PG8_STAGE(PG8_SB(1, 0), b3, voffB);
            PG8_BAR; PG8_WAIT_L(0); PG8_MMA(0, 1, At, B1); PG8_BAR;
            PG8_LDA(At, 1, 1); PG8_STAGE(PG8_SA(1, 0), a3, voffA);
            PG8_BAR; PG8_WAIT_L(0); PG8_MMA(1, 0, At, B0); PG8_BAR; PG8_SCHED;
            PG8_STAGE(PG8_SB(1, 1), b3 + hstep, voffB);
            PG8_WAIT_V(6); PG8_BAR; PG8_MMA(1, 1, At, B1); PG8_BAR;
            }
        }
        if constexpr (ALIGN_EPI) { if (wr == 0) PG8_BAR; }
        if constexpr (!Epi::AFTER_DRAIN) { E(acc, cur, wr, wc, fr, fq); S.done(cur); }
        if (!has_next) break;
#pragma unroll
        for (int a = 0; a < 2; ++a)
#pragma unroll
            for (int b = 0; b < 2; ++b)
#pragma unroll
                for (int m = 0; m < 4; ++m)
#pragma unroll
                    for (int n = 0; n < 2; ++n) acc[a][b][m][n] = (f32x4){0.f, 0.f, 0.f, 0.f};
        cur = nxt; cA = nA; cB = nB; ++ui;
        if constexpr (ALIGN_EPI) { if (wr == 1) PG8_BAR; }
    }
    PG8_WAIT_V(0);
    if constexpr (!ALIGN_EPI) { if (wr == 0) PG8_BAR; }
    PG8_BAR;
    if constexpr (Epi::AFTER_DRAIN) { E.fused(acc, cur, wr, wc, fr, fq, lds, wid, lane); S.done(cur); }
#undef PG8_SA
#undef PG8_SB
#undef PG8_STAGE
#undef PG8_LDA
#undef PG8_LDB
#undef PG8_MMA
#undef PG8_WAIT_V
#undef PG8_WAIT_L
#undef PG8_BAR
#undef PG8_SCHED
}
}

using pg8::Unit;
struct DenseSched { int nN, n, G, c;
    __device__ __forceinline__ void a_ready(const Unit&) const {}
    __device__ __forceinline__ void done(const Unit&) const {}
    __device__ __forceinline__ bool next(int i, Unit& u) const { const int L = i * G + c; if (L >= n) return false; u.pm = L / nN; u.pn = L % nN; return true; } };

__device__ __forceinline__ void store8bf(bf16* p, f32x4 lo, f32x4 hi) { u32x4 w; w.x = pk2(lo[0], lo[1]); w.y = pk2(lo[2], lo[3]); w.z = pk2(hi[0], hi[1]); w.w = pk2(hi[2], hi[3]); *(u32x4*)p = w; }
__device__ __forceinline__ void load8bf(const bf16* p, f32x4& lo, f32x4& hi) { const u32x4 w = *(const u32x4*)p;
    lo[0] = __uint_as_float(w.x << 16); lo[1] = __uint_as_float(w.x & 0xffff0000u); lo[2] = __uint_as_float(w.y << 16); lo[3] = __uint_as_float(w.y & 0xffff0000u);
    hi[0] = __uint_as_float(w.z << 16); hi[1] = __uint_as_float(w.z & 0xffff0000u); hi[2] = __uint_as_float(w.w << 16); hi[3] = __uint_as_float(w.w & 0xffff0000u); }
struct EpiZ { bf16 *ZR, *ZS, *ZG;
    __device__ __forceinline__ void one(int row, int col, f32x4 lo, f32x4 hi) const {
        if (col < RC) store8bf(ZR + (size_t)row * RC + col, lo, hi);
        else if (col < RC + 1024) { for (int e = 0; e < 4; ++e) { lo[e] = gelu_tanh(lo[e]); hi[e] = gelu_tanh(hi[e]); } store8bf(ZS + (size_t)row * 1024 + (col - RC), lo, hi); }
        else { for (int e = 0; e < 4; ++e) { lo[e] = sigmoidf_(lo[e]); hi[e] = sigmoidf_(hi[e]); } store8bf(ZG + (size_t)row * 2048 + (col - RC - 1024), lo, hi); } }
    __device__ __forceinline__ void operator()(int row, int col, f32x4 a0, f32x4 a1, f32x4 b0, f32x4 b1) const { one(row, col, a0, a1); one(row, col + 128, b0, b1); } };
struct EpiGA { const bf16* ZG; bf16* MP;
    __device__ __forceinline__ void one(int row, int col, f32x4 lo, f32x4 hi) const { f32x4 g0, g1; load8bf(ZG + (size_t)row * 2048 + col, g0, g1); store8bf(MP + (size_t)row * D + col, g0 * lo, g1 * hi); }
    __device__ __forceinline__ void operator()(int row, int col, f32x4 a0, f32x4 a1, f32x4 b0, f32x4 b1) const { one(row, col, a0, a1); one(row, col + 128, b0, b1); } };
struct EpiGB { const bf16* ZG; const bf16* MPin; bf16* MP;
    __device__ __forceinline__ void one(int row, int col, f32x4 lo, f32x4 hi) const { f32x4 g0, g1, m0, m1; load8bf(ZG + (size_t)row * 2048 + 1024 + col, g0, g1); load8bf(MPin + (size_t)row * D + col, m0, m1);
        store8bf(MP + (size_t)row * D + col, m0 + g0 * lo, m1 + g1 * hi); }
    __device__ __forceinline__ void operator()(int row, int col, f32x4 a0, f32x4 a1, f32x4 b0, f32x4 b1) const { one(row, col, a0, a1); one(row, col + 128, b0, b1); } };
struct EpiOut { const float* xin; float* out; const float* gate1;
    __device__ __forceinline__ void one(int row, int col, f32x4 v) const { const f32x4 x = *(const f32x4*)(xin + (size_t)row * D + col); const f32x4 g = *(const f32x4*)(gate1 + col);
        *(f32x4*)(out + (size_t)row * D + col) = ALPHA * x + (1.0f + g) * v; }
    __device__ __forceinline__ void operator()(int row, int col, f32x4 a0, f32x4 a1, f32x4 b0, f32x4 b1) const { one(row, col, a0); one(row, col + 4, a1); one(row, col + 128, b0); one(row, col + 132, b1); } };
struct EpiSwi { bf16* HID;
    __device__ __forceinline__ void operator()(int row, int col, f32x4 a0, f32x4 a1, f32x4 b0, f32x4 b1) const { const int ct = (col >> 8) & 3, cc = col & 127;
        f32x4 h0, h1; for (int e = 0; e < 4; ++e) { h0[e] = siluf_(a0[e]) * b0[e]; h1[e] = siluf_(a1[e]) * b1[e]; } store8bf(HID + (size_t)row * FF + ct * 128 + cc, h0, h1); } };
struct EpiDown { const int* S2T; const float* TOKW; bf16* Y;
    __device__ __forceinline__ void operator()(int row, int col, f32x4 a0, f32x4 a1, f32x4 b0, f32x4 b1) const { const int st = S2T[row]; if (st < 0) return; const float w = TOKW[st]; const int cc = col & 1023;
        store8bf(Y + (size_t)st * D + cc, w * a0, w * a1); store8bf(Y + (size_t)st * D + cc + 128, w * b0, w * b1); } };

struct MoeSched { int ts[17]; int G, c;
    __device__ __forceinline__ void a_ready(const Unit&) const {}
    __device__ __forceinline__ void done(const Unit&) const {}
    __device__ __forceinline__ void init(const unsigned* cnt, int G_, int c_) { G = G_; c = c_; int s = 0;
#pragma unroll
        for (int e = 0; e < 16; ++e) { ts[e] = s; s += ((int)cnt[e] + 255) >> 8; } ts[16] = s; }
    __device__ __forceinline__ bool next(int i, Unit& u) const { const int L = i * G + c; if (L >= 4 * ts[16]) return false; const int rt = L >> 2, ct = L & 3; int e = 0;
#pragma unroll
        for (int j = 1; j < 16; ++j) e += (rt >= ts[j]) ? 1 : 0;
        u.pm = rt; u.pn = e * 4 + ct; return true; } };

__device__ __forceinline__ void phase_prep_simple(ArgsR a, const Ctx& c, int l) {
    const bf16* ZR = (const bf16*)(a.ws + WS_ZR);
    const float* mu = a.in[I_MU] + l * RC; const float* w0 = a.in[I_W0] + l * W; const float* w2 = a.in[I_W2] + (size_t)l * 64 * W;
    const float* a0 = a.in[I_A0] + l * W; const float* a2 = a.in[I_A2] + (size_t)l * 64 * W; const float* g2 = a.in[I_G2] + (size_t)l * 128 * W;
    const float* k_k = a.in[I_KK] + l * W; const float* k_a = a.in[I_KA] + l * W;
    const float* vm0 = a.in[I_VM0]; const float* vm1 = a.in[I_VM1]; const float* vm2 = a.in[I_VM2];
    f16* R = (f16*)(a.ws + WS_R); f16* WM1 = (f16*)(a.ws + WS_WM1); f16* KP = (f16*)(a.ws + WS_KP); f16* AA = (f16*)(a.ws + WS_AA); f16* BB = (f16*)(a.ws + WS_BB); f16* V = (f16*)(a.ws + WS_V);
    bf16* G = (bf16*)(a.ws + WS_G); bf16* VF = (bf16*)(a.ws + WS_VF);
    const int lane = c.lane;
    for (int t = c.gw; t < T; t += c.ngw) {
        float z[28];
#pragma unroll
        for (int i = 0; i < 28; ++i) { const int col = lane + 64 * i; const float zc = bf2f(ZR[(size_t)t * RC + col]); const float zp = t > 0 ? bf2f(ZR[(size_t)(t - 1) * RC + col]) : 0.f; z[i] = zc + (zp - zc) * mu[col]; }
        const float tw = tanhf(z[24]), za = z[25], sg0 = sigmoidf_(z[26]), sg1 = sigmoidf_(z[27]);
        float wlo[8], alo[8], gg[8];
#pragma unroll
        for (int i = 0; i < 8; ++i) { wlo[i] = 0.f; alo[i] = 0.f; gg[i] = 0.f; }
        for (int j = 0; j < 64; ++j) { const float tj = __shfl(tw, j), aj = __shfl(za, j), s0 = __shfl(sg0, j), s1 = __shfl(sg1, j);
#pragma unroll
            for (int i = 0; i < 8; ++i) { const int n = lane + 64 * i; wlo[i] += tj * w2[j * W + n]; alo[i] += aj * a2[j * W + n]; gg[i] += s0 * g2[j * W + n] + s1 * g2[(64 + j) * W + n]; } }
        float vv[8];
#pragma unroll
        for (int i = 0; i < 8; ++i) vv[i] = z[16 + i];
        if (l == 0) {
#pragma unroll
            for (int i = 0; i < 8; ++i) VF[(size_t)t * W + lane + 64 * i] = f2bf(vv[i]);
        } else {
            float vmid = 0.f;
#pragma unroll
            for (int i = 0; i < 8; ++i)
                for (int j = 0; j < 64; ++j) { const float vc = __shfl(vv[i], j); vmid += vc * vm1[(size_t)(64 * i + j) * 32 + (lane & 31)]; }
            float vg[8];
#pragma unroll
            for (int i = 0; i < 8; ++i) vg[i] = 0.f;
            for (int m = 0; m < 32; ++m) { const float vmm = __shfl(vmid, m);
#pragma unroll
                for (int i = 0; i < 8; ++i) vg[i] += vmm * vm2[m * W + lane + 64 * i]; }
#pragma unroll
            for (int i = 0; i < 8; ++i) { const int n = lane + 64 * i; const float vf = bf2f(VF[(size_t)t * W + n]); vv[i] = vv[i] + (vf - vv[i]) * sigmoidf_(vm0[n] + vg[i]); }
        }
#pragma unroll
        for (int i = 0; i < 8; ++i) {
            const int n = lane + 64 * i; const size_t o = (size_t)t * W + n;
            const float x = w0[n] + wlo[i]; const float wl = -softplusf_(-x) - 0.5f; const float dm1 = expm1f(-__expf(wl));
            const float av = sigmoidf_(a0[n] + alo[i]);
            const float kraw = z[8 + i];
            float kk = kraw * k_k[n]; const float nrm = sqrtf(wave_sum(kk * kk)); kk = kk / fmaxf(nrm, 1e-12f);
            const float kp = kraw * (1.0f + (av - 1.0f) * k_a[n]);
            R[o] = (f16)z[i]; WM1[o] = (f16)dm1; KP[o] = (f16)kp; AA[o] = (f16)(-kk); BB[o] = (f16)(kk * av); V[o] = (f16)vv[i]; G[o] = f2bf(gg[i]);
        }
    }
}

__device__ __forceinline__ void phase_sg_simple(ArgsR a, const Ctx& c, int l) {
    const bf16* ZS = (const bf16*)(a.ws + WS_ZS); bf16* YB = (bf16*)(a.ws + WS_YB);
    const float* lng = a.in[I_SGG] + l * W; const float* lnb = a.in[I_SGB] + l * W;
    float* vn = (float*)c.lds;
    float* st = vn + 128 * 64;
    for (int uidx = blockIdx.x; uidx < 128 * 8; uidx += gridDim.x) {
        const int ch = uidx >> 3, g = uidx & 7; const int tok0 = ch * 128;
        for (int i = 0; i < 16; ++i) { const int s = c.wave * 16 + i; const bf16* p = ZS + (size_t)(tok0 + s) * 1024 + 512 + c.lane * 8;
            const f32x4 x0 = load4bf(p), x1 = load4bf(p + 4);
            float sm = (x0[0] + x0[1]) + (x0[2] + x0[3]) + (x1[0] + x1[1]) + (x1[2] + x1[3]); const float mean = wave_sum(sm) * (1.f / 512.f);
            float q = 0.f; for (int e = 0; e < 4; ++e) { const float d0 = x0[e] - mean, d1 = x1[e] - mean; q += d0 * d0 + d1 * d1; }
            const float rstd = __builtin_amdgcn_rsqf(wave_sum(q) * (1.f / 512.f) + LN_EPS);
            if (c.lane == 0) { st[2 * s] = mean; st[2 * s + 1] = rstd; } }
        __syncthreads();
        for (int i = c.tid; i < 128 * 64; i += NTHREADS) { const int s = i >> 6, d = i & 63; const float x = bf2f(ZS[(size_t)(tok0 + s) * 1024 + 512 + g * 64 + d]);
            vn[i] = (x - st[2 * s]) * st[2 * s + 1] * lng[g * 64 + d] + lnb[g * 64 + d]; }
        __syncthreads();
        const int d = c.tid & 63, tq = c.tid >> 6;
        const float* Wg = a.in[I_WS] + (size_t)(l * 8 + g) * 128 * 128; const float* bs = a.in[I_BS] + (size_t)(l * 8 + g) * 128;
        for (int i = 0; i < 16; ++i) { const int t = tq + 8 * i; float acc = 0.f;
            for (int s = 0; s <= t; ++s) acc += Wg[t * 128 + s] * vn[s * 64 + d];
            const float u = bf2f(ZS[(size_t)(tok0 + t) * 1024 + g * 64 + d]);
            YB[(size_t)(tok0 + t) * W + g * 64 + d] = f2bf(u * (acc + bs[t])); }
        __syncthreads();
    }
}

#define LAS3 __attribute__((address_space(3)))
typedef short bf16x8 __attribute__((ext_vector_type(8)));
template <int MT, int NT, int KS, bool SWAP = false>
__device__ __forceinline__ void mma_lds_glob(const unsigned char* lds_base, int a_off_bytes, int lda, const bf16* Bt, int ldb, int n0, int lane, f32x4 (&acc)[MT][NT]) {
    const int fr = lane & 15, fq = lane >> 4;
    const LAS3 unsigned char* Ab = (const LAS3 unsigned char*)lds_base + a_off_bytes;
    int boff = (n0 + fr) * ldb + 8 * fq; asm volatile("" : "+v"(boff));
#pragma unroll
    for (int ks = 0; ks < KS; ++ks) {
        bf16x8 b[NT];
#pragma unroll
        for (int n = 0; n < NT; ++n) b[n] = *(const bf16x8*)(Bt + boff + 16 * n * ldb + 32 * ks);
#pragma unroll
        for (int m = 0; m < MT; ++m) { const bf16x8 av = *(const LAS3 bf16x8*)(Ab + ((16 * m + fr) * lda + 32 * ks + 8 * fq) * 2);
#pragma unroll
            for (int n = 0; n < NT; ++n) acc[m][n] = SWAP ? __builtin_amdgcn_mfma_f32_16x16x32_bf16(b[n], av, acc[m][n], 0, 0, 0) : __builtin_amdgcn_mfma_f32_16x16x32_bf16(av, b[n], acc[m][n], 0, 0, 0); }
    }
}
__device__ __forceinline__ void zshift8(const bf16* ZR, int t, int col, const float* mu, float (&o)[8]) {
    const u32x4 zc = *(const u32x4*)(ZR + (size_t)t * RC + col);
    u32x4 zp = {0u, 0u, 0u, 0u}; if (t > 0) zp = *(const u32x4*)(ZR + (size_t)(t - 1) * RC + col);
    const f32x4 m0 = *(const f32x4*)(mu + col), m1 = *(const f32x4*)(mu + col + 4);
#pragma unroll
    for (int e = 0; e < 4; ++e) { const float c0 = __uint_as_float(zc[e] << 16), c1 = __uint_as_float(zc[e] & 0xffff0000u), p0 = __uint_as_float(zp[e] << 16), p1 = __uint_as_float(zp[e] & 0xffff0000u);
        const float mu0 = (2 * e < 4) ? m0[(2 * e) & 3] : m1[(2 * e) & 3], mu1 = (2 * e + 1 < 4) ? m0[(2 * e + 1) & 3] : m1[(2 * e + 1) & 3];
        o[2 * e] = c0 + (p0 - c0) * mu0; o[2 * e + 1] = c1 + (p1 - c1) * mu1; }
}
typedef _Float16 f16x8 __attribute__((ext_vector_type(8)));
typedef _Float16 f16x4 __attribute__((ext_vector_type(4)));
__device__ __forceinline__ void store8f16(f16* p, const float (&v)[8]) { f16x8 h;
#pragma unroll
    for (int e = 0; e < 8; ++e) h[e] = (f16)v[e];
    *(f16x8*)p = h; }
__device__ __forceinline__ u32x4 pack8bf(const float (&v)[8]) { u32x4 w; w.x = pk2(v[0], v[1]); w.y = pk2(v[2], v[3]); w.z = pk2(v[4], v[5]); w.w = pk2(v[6], v[7]); return w; }


constexpr int PB_LD = 520;
constexpr int PB_BUF = 0, PB_AOP = 64 * PB_LD * 2, PB_VMID = 2 * 64 * PB_LD * 2, PB_LA_LD = 264, PB_VM_LD = 40;
__device__ __forceinline__ void phase_prep_fast(ArgsR a, const Ctx& c, int l) {
    const bf16* ZR = (const bf16*)(a.ws + WS_ZR);
    const float* mu = a.in[I_MU] + l * RC; const float* w0 = a.in[I_W0] + l * W; const float* a0 = a.in[I_A0] + l * W;
    const float* k_k = a.in[I_KK] + l * W; const float* k_a = a.in[I_KA] + l * W; const float* vm0 = a.in[I_VM0];
    f16* R = (f16*)(a.ws + WS_R); f16* WM1 = (f16*)(a.ws + WS_WM1); f16* KP = (f16*)(a.ws + WS_KP); f16* AA = (f16*)(a.ws + WS_AA); f16* BB = (f16*)(a.ws + WS_BB); f16* V = (f16*)(a.ws + WS_V);
    bf16* G = (bf16*)(a.ws + WS_G); bf16* VF = (bf16*)(a.ws + WS_VF);
    const unsigned char* lo = a.ws + WS_LORA + (size_t)l * LO_STRIDE;
    const bf16* W2T = (const bf16*)(lo + LO_W2T); const bf16* A2T = (const bf16*)(lo + LO_A2T); const bf16* G2T = (const bf16*)(lo + LO_G2T);
    const bf16* VM1T = (const bf16*)(lo + LO_VM1T); const bf16* VM2T = (const bf16*)(lo + LO_VM2T);
    LAS3 unsigned char* L = (LAS3 unsigned char*)c.lds;
    const int tid = c.tid, lane = c.lane, wv = c.wave, fr = lane & 15, fq = lane >> 4;
    const int row = tid >> 3, sub_ = tid & 7;
    for (int u = blockIdx.x; u < T / 64; u += gridDim.x) {
        int sub = sub_; asm volatile("" : "+v"(sub));
        const int t0 = u * 64, t = t0 + row;
        if (l == 0) {
#pragma unroll 4
            for (int p = 0; p < 8; ++p) { const int col = p * 64 + sub * 8; float z[8]; zshift8(ZR, t, 1024 + col, mu, z);
                store8f16(V + (size_t)t * W + col, z); *(u32x4*)(VF + (size_t)t * W + col) = pack8bf(z); }
        } else {
#pragma unroll 4
            for (int p = 0; p < 8; ++p) { const int col = p * 64 + sub * 8; float z[8]; zshift8(ZR, t, 1024 + col, mu, z);
                *(LAS3 u32x4*)(L + PB_AOP + (row * PB_LD + col) * 2) = pack8bf(z); }
            __syncthreads();
            { f32x4 acc[1][1]; acc[0][0] = (f32x4){0.f, 0.f, 0.f, 0.f}; const int m = wv >> 1, n = wv & 1;
              mma_lds_glob<1, 1, 16>(c.lds, PB_AOP + 16 * m * PB_LD * 2, PB_LD, VM1T, W, 16 * n, lane, acc);
#pragma unroll
              for (int i = 0; i < 4; ++i) *(LAS3 bf16*)(L + PB_VMID + ((16 * m + 4 * fq + i) * PB_VM_LD + 16 * n + fr) * 2) = f2bf(acc[0][0][i]); }
            __syncthreads();
            { f32x4 acc[4][4];
#pragma unroll
              for (int m = 0; m < 4; ++m)
#pragma unroll
                  for (int n = 0; n < 4; ++n) acc[m][n] = (f32x4){0.f, 0.f, 0.f, 0.f};
              mma_lds_glob<4, 4, 1, true>(c.lds, PB_VMID, PB_VM_LD, VM2T, 32, 64 * wv, lane, acc);
#pragma unroll
              for (int m = 0; m < 4; ++m)
#pragma unroll
                  for (int n = 0; n < 4; ++n) { const int col = 64 * wv + 16 * n + 4 * fq; const f32x4 vb = *(const f32x4*)(vm0 + col); f16x4 hv;
#pragma unroll
                      for (int i = 0; i < 4; ++i) hv[i] = (f16)sigmoidf_(vb[i] + acc[m][n][i]);
                      *(LAS3 f16x4*)(L + PB_BUF + ((16 * m + fr) * PB_LD + col) * 2) = hv; } }
            __syncthreads();
#pragma unroll 4
            for (int p = 0; p < 8; ++p) { const int col = p * 64 + sub * 8;
                const u32x4 vz = *(const LAS3 u32x4*)(L + PB_AOP + (row * PB_LD + col) * 2); const f16x8 gt = *(const LAS3 f16x8*)(L + PB_BUF + (row * PB_LD + col) * 2);
                const u32x4 vfw = *(const u32x4*)(VF + (size_t)t * W + col); float o[8];
#pragma unroll
                for (int e = 0; e < 4; ++e) { const float v0 = __uint_as_float(vz[e] << 16), v1 = __uint_as_float(vz[e] & 0xffff0000u), f0 = __uint_as_float(vfw[e] << 16), f1 = __uint_as_float(vfw[e] & 0xffff0000u);
                    o[2 * e] = v0 + (f0 - v0) * (float)gt[2 * e]; o[2 * e + 1] = v1 + (f1 - v1) * (float)gt[2 * e + 1]; }
                store8f16(V + (size_t)t * W + col, o); }
            __syncthreads();
        }
#pragma unroll 4
        for (int p = 0; p < 4; ++p) { const int cc = sub * 32 + p * 8; float z[8]; zshift8(ZR, t, 1536 + cc, mu, z);
#pragma unroll
            for (int e = 0; e < 8; ++e) z[e] = cc < 64 ? (1.0f - 2.0f * __builtin_amdgcn_rcpf(1.0f + __expf(2.0f * z[e]))) : (cc < 128 ? z[e] : sigmoidf_(z[e]));
            *(LAS3 u32x4*)(L + PB_AOP + (row * PB_LA_LD + cc) * 2) = pack8bf(z); }
        __syncthreads();
        { f32x4 acc[4][4];
#pragma unroll
          for (int m = 0; m < 4; ++m)
#pragma unroll
              for (int n = 0; n < 4; ++n) acc[m][n] = (f32x4){0.f, 0.f, 0.f, 0.f};
          mma_lds_glob<4, 4, 2, true>(c.lds, PB_AOP + 64 * 2, PB_LA_LD, A2T, 64, 64 * wv, lane, acc);
#pragma unroll
          for (int m = 0; m < 4; ++m)
#pragma unroll
              for (int n = 0; n < 4; ++n) { const int col = 64 * wv + 16 * n + 4 * fq; const f32x4 ab = *(const f32x4*)(a0 + col); f16x4 hv;
#pragma unroll
                  for (int i = 0; i < 4; ++i) hv[i] = (f16)sigmoidf_(ab[i] + acc[m][n][i]);
                  *(LAS3 f16x4*)(L + PB_BUF + ((16 * m + fr) * PB_LD + col) * 2) = hv; } }
        __syncthreads();
#pragma unroll 4
        for (int p = 0; p < 8; ++p) { const int col = p * 64 + sub * 8; const size_t o = (size_t)t * W + col;
            float z[8]; zshift8(ZR, t, col, mu, z); store8f16(R + o, z);
            float kz[8]; zshift8(ZR, t, 512 + col, mu, kz);
            const f16x8 av = *(const LAS3 f16x8*)(L + PB_BUF + (row * PB_LD + col) * 2);
            const f32x4 kk0 = *(const f32x4*)(k_k + col), kk1 = *(const f32x4*)(k_k + col + 4), ka0 = *(const f32x4*)(k_a + col), ka1 = *(const f32x4*)(k_a + col + 4);
            float kk[8], kp[8], bb[8]; float ss = 0.f;
#pragma unroll
            for (int e = 0; e < 8; ++e) { const float kkw = e < 4 ? kk0[e & 3] : kk1[e & 3], kaw = e < 4 ? ka0[e & 3] : ka1[e & 3]; kk[e] = kz[e] * kkw; ss += kk[e] * kk[e]; kp[e] = kz[e] * (1.0f + ((float)av[e] - 1.0f) * kaw); }
            ss += __shfl_xor(ss, 1); ss += __shfl_xor(ss, 2); ss += __shfl_xor(ss, 4);
            const float inv = fminf(__builtin_amdgcn_rsqf(ss), 1e12f);
#pragma unroll
            for (int e = 0; e < 8; ++e) { kk[e] *= inv; bb[e] = kk[e] * (float)av[e]; kk[e] = -kk[e]; }
            store8f16(KP + o, kp); store8f16(AA + o, kk); store8f16(BB + o, bb); }
        __syncthreads();
        { f32x4 acc[4][4];
#pragma unroll
          for (int m = 0; m < 4; ++m)
#pragma unroll
              for (int n = 0; n < 4; ++n) acc[m][n] = (f32x4){0.f, 0.f, 0.f, 0.f};
          mma_lds_glob<4, 4, 2, true>(c.lds, PB_AOP, PB_LA_LD, W2T, 64, 64 * wv, lane, acc);
#pragma unroll
          for (int m = 0; m < 4; ++m)
#pragma unroll
              for (int n = 0; n < 4; ++n) { const int col = 64 * wv + 16 * n + 4 * fq; const f32x4 wb = *(const f32x4*)(w0 + col); f16x4 hv;
#pragma unroll
                  for (int i = 0; i < 4; ++i) { const float x = wb[i] + acc[m][n][i]; const float wl = -(fmaxf(-x, 0.f) + __logf(1.0f + __expf(-fabsf(x)))) - 0.5f;
                      hv[i] = (f16)(__expf(-__expf(wl)) - 1.0f); }
                  *(LAS3 f16x4*)(L + PB_BUF + ((16 * m + fr) * PB_LD + col) * 2) = hv; } }
        __syncthreads();
#pragma unroll 4
        for (int p = 0; p < 8; ++p) { const int col = p * 64 + sub * 8; *(u32x4*)(WM1 + (size_t)t * W + col) = *(const LAS3 u32x4*)(L + PB_BUF + (row * PB_LD + col) * 2); }
        __syncthreads();
        { f32x4 acc[4][4];
#pragma unroll
          for (int m = 0; m < 4; ++m)
#pragma unroll
              for (int n = 0; n < 4; ++n) acc[m][n] = (f32x4){0.f, 0.f, 0.f, 0.f};
          mma_lds_glob<4, 4, 4, true>(c.lds, PB_AOP + 128 * 2, PB_LA_LD, G2T, 128, 64 * wv, lane, acc);
#pragma unroll
          for (int m = 0; m < 4; ++m)
#pragma unroll
              for (int n = 0; n < 4; ++n) { const int col = 64 * wv + 16 * n + 4 * fq; u32x2 w; w.x = pk2(acc[m][n][0], acc[m][n][1]); w.y = pk2(acc[m][n][2], acc[m][n][3]);
                  *(LAS3 u32x2*)(L + PB_BUF + ((16 * m + fr) * PB_LD + col) * 2) = w; } }
        __syncthreads();
#pragma unroll 4
        for (int p = 0; p < 8; ++p) { const int col = p * 64 + sub * 8; *(u32x4*)(G + (size_t)t * W + col) = *(const LAS3 u32x4*)(L + PB_BUF + (row * PB_LD + col) * 2); }
        __syncthreads();
    }
}

constexpr int SG_LD = 136;
constexpr int SG_VT = 0, SG_ST = 256 * SG_LD * 2;
__device__ __forceinline__ void phase_sg_fast(ArgsR a, const Ctx& c, int l) {
    const bf16* ZS = (const bf16*)(a.ws + WS_ZS); bf16* YB = (bf16*)(a.ws + WS_YB);
    const float* lng = a.in[I_SGG] + l * W; const float* lnb = a.in[I_SGB] + l * W;
    LAS3 unsigned char* L = (LAS3 unsigned char*)c.lds;
    LAS3 float* st = (LAS3 float*)(L + SG_ST);
    const int tid = c.tid, lane = c.lane, wv = c.wave, fr = lane & 15, fq = lane >> 4;
    for (int u = blockIdx.x; u < 256; u += gridDim.x) {
        const int ch = u >> 1, hf = u & 1, tok0 = ch * 128;
        { u32x4 raw[16];
#pragma unroll
          for (int i = 0; i < 16; ++i) raw[i] = *(const u32x4*)(ZS + (size_t)(tok0 + wv * 16 + i) * 1024 + 512 + lane * 8);
#pragma unroll
          for (int i = 0; i < 16; ++i) { const int sidx = wv * 16 + i; float x[8];
#pragma unroll
              for (int e = 0; e < 4; ++e) { x[2 * e] = __uint_as_float(raw[i][e] << 16); x[2 * e + 1] = __uint_as_float(raw[i][e] & 0xffff0000u); }
              const float sm = ((x[0] + x[1]) + (x[2] + x[3])) + ((x[4] + x[5]) + (x[6] + x[7])); const float mean = wave_sum(sm) * (1.f / 512.f);
              float q = 0.f;
#pragma unroll
              for (int e = 0; e < 8; ++e) { const float d0 = x[e] - mean; q += d0 * d0; }
              const float rstd = __builtin_amdgcn_rsqf(wave_sum(q) * (1.f / 512.f) + LN_EPS);
              if (lane == 0) { st[2 * sidx] = mean; st[2 * sidx + 1] = rstd; } } }
        __syncthreads();
        { const int sidx = tid >> 2, q4 = tid & 3; const float mean = st[2 * sidx], rstd = st[2 * sidx + 1];
#pragma unroll
          for (int p = 0; p < 8; ++p) { const int cl = q4 * 64 + p * 8; const int cg = hf * 256 + cl;
              const bf16* src = ZS + (size_t)(tok0 + sidx) * 1024 + 512 + cg; const f32x4 x0 = load4bf(src), x1 = load4bf(src + 4);
              const f32x4 g0 = *(const f32x4*)(lng + cg), g1 = *(const f32x4*)(lng + cg + 4), b0 = *(const f32x4*)(lnb + cg), b1 = *(const f32x4*)(lnb + cg + 4);
#pragma unroll
              for (int e = 0; e < 8; ++e) { const float x = e < 4 ? x0[e & 3] : x1[e & 3], gg = e < 4 ? g0[e & 3] : g1[e & 3], bb = e < 4 ? b0[e & 3] : b1[e & 3];
                  *(LAS3 bf16*)(L + SG_VT + ((cl + e) * SG_LD + sidx) * 2) = f2bf((x - mean) * rstd * gg + bb); } } }
        __syncthreads();
        const int gl = wv >> 1, dh = wv & 1, g = hf * 4 + gl;
        const float* Wg = a.in[I_WS] + (size_t)(l * 8 + g) * 128 * 128; const float* bs = a.in[I_BS] + (size_t)(l * 8 + g) * 128;
        f32x4 acc[8][2];
#pragma unroll
        for (int m = 0; m < 8; ++m) { acc[m][0] = (f32x4){0.f, 0.f, 0.f, 0.f}; acc[m][1] = (f32x4){0.f, 0.f, 0.f, 0.f}; }
#pragma unroll
        for (int ks = 0; ks < 4; ++ks) {
            bf16x8 b[2];
#pragma unroll
            for (int n = 0; n < 2; ++n) b[n] = *(const LAS3 bf16x8*)(L + SG_VT + ((gl * 64 + dh * 32 + 16 * n + fr) * SG_LD + 32 * ks + 8 * fq) * 2);
#pragma unroll
            for (int m = 0; m < 8; ++m) { if (32 * ks <= 16 * m + 15) {
                const int trow = 16 * m + fr, s0 = 32 * ks + 8 * fq;
                const f32x4 w0v = *(const f32x4*)(Wg + trow * 128 + s0), w1v = *(const f32x4*)(Wg + trow * 128 + s0 + 4);
                float wf[8];
#pragma unroll
                for (int e = 0; e < 8; ++e) { const float wval = e < 4 ? w0v[e & 3] : w1v[e & 3]; wf[e] = (s0 + e <= trow) ? wval : 0.f; }
                const u32x4 wp = pack8bf(wf); const bf16x8 av = __builtin_bit_cast(bf16x8, wp);
                acc[m][0] = __builtin_amdgcn_mfma_f32_16x16x32_bf16(b[0], av, acc[m][0], 0, 0, 0);
                acc[m][1] = __builtin_amdgcn_mfma_f32_16x16x32_bf16(b[1], av, acc[m][1], 0, 0, 0); } }
        }
#pragma unroll
        for (int m = 0; m < 8; ++m) { const int trow = 16 * m + fr; const float bsv = bs[trow];
#pragma unroll
            for (int n = 0; n < 2; ++n) { const int col = g * 64 + dh * 32 + 16 * n + 4 * fq; const f32x4 uu = load4bf(ZS + (size_t)(tok0 + trow) * 1024 + col);
                store4bf(YB + (size_t)(tok0 + trow) * W + col, uu * (acc[m][n] + bsv)); } }
        __syncthreads();
    }
}

__device__ __forceinline__ void phase_scan_simple(ArgsR a, const Ctx& c) {
    if (c.wave != 0 || blockIdx.x >= NH) return;
    const int h = blockIdx.x, lane = c.lane;
    const f16* R = (const f16*)(a.ws + WS_R); const f16* WM1 = (const f16*)(a.ws + WS_WM1); const f16* KP = (const f16*)(a.ws + WS_KP);
    const f16* AA = (const f16*)(a.ws + WS_AA); const f16* BB = (const f16*)(a.ws + WS_BB); const f16* V = (const f16*)(a.ws + WS_V);
    bf16* YSC = (bf16*)(a.ws + WS_YSC);
    float S[64];
#pragma unroll
    for (int j = 0; j < 64; ++j) S[j] = 0.f;
    for (int t = 0; t < T; ++t) {
        const size_t base = (size_t)t * W + h * 64;
        const float vv = (float)V[base + lane];
        float sa = 0.f;
#pragma unroll
        for (int j = 0; j < 64; ++j) sa += S[j] * (float)AA[base + j];
        float y = 0.f;
#pragma unroll
        for (int j = 0; j < 64; ++j) { float s = S[j]; s = s + s * (float)WM1[base + j]; s += sa * (float)BB[base + j]; s += vv * (float)KP[base + j]; S[j] = s; y += s * (float)R[base + j]; }
        YSC[base + lane] = f2bf(y);
    }
}

typedef unsigned u32x16 __attribute__((ext_vector_type(16)));
__device__ __forceinline__ void sload32(const void* p0, u32x16& a0, u32x16& a1) {
    asm volatile("s_load_dwordx16 %0, %2, 0x0 glc\n\ts_load_dwordx16 %1, %2, 0x40 glc\n\ts_waitcnt lgkmcnt(0)" : "=&s"(a0), "=&s"(a1) : "s"(p0) : "memory");
}
__device__ __forceinline__ void sload64(const void* p0, const void* p1, u32x16& a0, u32x16& a1, u32x16& b0, u32x16& b1) {
    asm volatile("s_load_dwordx16 %0, %4, 0x0 glc\n\ts_load_dwordx16 %1, %4, 0x40 glc\n\ts_load_dwordx16 %2, %5, 0x0 glc\n\ts_load_dwordx16 %3, %5, 0x40 glc\n\ts_waitcnt lgkmcnt(0)"
                 : "=&s"(a0), "=&s"(a1), "=&s"(b0), "=&s"(b1) : "s"(p0), "s"(p1) : "memory");
}
__device__ __forceinline__ float fmix_lo(unsigned sd, float x, float y) { float d; asm("v_fma_mix_f32 %0, %1, %2, %3 op_sel_hi:[1,0,0]" : "=v"(d) : "s"(sd), "v"(x), "v"(y)); return d; }
__device__ __forceinline__ float fmix_hi(unsigned sd, float x, float y) { float d; asm("v_fma_mix_f32 %0, %1, %2, %3 op_sel:[1,0,0] op_sel_hi:[1,0,0]" : "=v"(d) : "s"(sd), "v"(x), "v"(y)); return d; }
constexpr int CL = 64, NCH = T / CL;
constexpr size_t ST_Q_OFF = (size_t)NH * NCH * 64 * 64;
constexpr size_t ST_S_OFF = (size_t)NH * NCH * 64 * 64;

__device__ __forceinline__ float vmix_lo(unsigned vd, float x, float y) { float d; asm("v_fma_mix_f32 %0, %1, %2, %3 op_sel_hi:[1,0,0]" : "=v"(d) : "v"(vd), "v"(x), "v"(y)); return d; }
__device__ __forceinline__ float vmix_hi(unsigned vd, float x, float y) { float d; asm("v_fma_mix_f32 %0, %1, %2, %3 op_sel:[1,0,0] op_sel_hi:[1,0,0]" : "=v"(d) : "v"(vd), "v"(x), "v"(y)); return d; }
template <int N> __device__ __forceinline__ void fmac_bc(float& acc, float vec, float x) { asm("v_fmac_f32_dpp %0, %1, %2 row_newbcast:%3 row_mask:0xf bank_mask:0xf" : "+v"(acc) : "v"(vec), "v"(x), "n"(N)); }
template <int N> __device__ __forceinline__ float mul_bc(float vec, float x) { float d; asm("v_mul_f32_dpp %0, %1, %2 row_newbcast:%3 row_mask:0xf bank_mask:0xf" : "=v"(d) : "v"(vec), "v"(x), "n"(N)); return d; }
struct SVec { float v[4]; };
__device__ __forceinline__ f16x4 sv_read(const LAS3 unsigned char* p, int lane) { return *(const LAS3 f16x4*)(p + (lane & 15) * 8); }
__device__ __forceinline__ void sv_cvt(SVec& o, f16x4 h) { o.v[0] = (float)h[0]; o.v[1] = (float)h[1]; o.v[2] = (float)h[2]; o.v[3] = (float)h[3]; }
__device__ __forceinline__ void sv_cvt1p(SVec& o, f16x4 h) { o.v[0] = 1.0f + (float)h[0]; o.v[1] = 1.0f + (float)h[1]; o.v[2] = 1.0f + (float)h[2]; o.v[3] = 1.0f + (float)h[3]; }
template <int J> __device__ __forceinline__ void sc_dot(float (&d)[4], const SVec& A, const float (&X)[64]) { fmac_bc<(J >> 2)>(d[J & 3], A.v[J & 3], X[J]); if constexpr (J + 1 < 64) sc_dot<J + 1>(d, A, X); }
template <int J> __device__ __forceinline__ void sc_upd3(float (&S)[64], float (&y)[4], const SVec& Wv, const SVec& Bv, const SVec& Kv, const SVec& Rv, float sa, float vv) {
    float sj = mul_bc<(J >> 2)>(Wv.v[J & 3], S[J]); fmac_bc<(J >> 2)>(sj, Bv.v[J & 3], sa); fmac_bc<(J >> 2)>(sj, Kv.v[J & 3], vv); S[J] = sj; fmac_bc<(J >> 2)>(y[J & 3], Rv.v[J & 3], sj);
    if constexpr (J + 1 < 64) sc_upd3<J + 1>(S, y, Wv, Bv, Kv, Rv, sa, vv); }
template <int J> __device__ __forceinline__ void sc_upd1(float (&Q)[64], float (&P)[64], const SVec& Wv, const SVec& Bv, const SVec& Kv, float saq, float sap, float vv) {
    float qj = mul_bc<(J >> 2)>(Wv.v[J & 3], Q[J]); fmac_bc<(J >> 2)>(qj, Bv.v[J & 3], saq); fmac_bc<(J >> 2)>(qj, Kv.v[J & 3], vv); Q[J] = qj;
    float pj = mul_bc<(J >> 2)>(Wv.v[J & 3], P[J]); fmac_bc<(J >> 2)>(pj, Bv.v[J & 3], sap); P[J] = pj;
    if constexpr (J + 1 < 64) sc_upd1<J + 1>(Q, P, Wv, Bv, Kv, saq, sap, vv); }
constexpr int SCB = 8;
constexpr int SC_NS = 7, SC_BUF = SC_NS * 1024, SC_WAVE = 2 * SC_BUF;
__device__ __forceinline__ void sc_dma(const f16* X, size_t eoff, LAS3 unsigned char* dst) {
    __builtin_amdgcn_global_load_lds((const unsigned*)(X + eoff), (LAS3 unsigned*)dst, 16, 0, 0);
}

__device__ __forceinline__ void phase_scan1(ArgsR a, const Ctx& c) {
    const f16* WM1 = (const f16*)(a.ws + WS_WM1); const f16* KP = (const f16*)(a.ws + WS_KP);
    const f16* AA = (const f16*)(a.ws + WS_AA); const f16* BB = (const f16*)(a.ws + WS_BB); const f16* V = (const f16*)(a.ws + WS_V);
    float* ST = (float*)(a.ws + WS_ST);
    const int lane = c.lane;
    LAS3 unsigned char* ring = (LAS3 unsigned char*)c.lds + c.wave * SC_WAVE;
    for (int item = c.gw; item < NH * NCH; item += c.ngw) {
        const int h = __builtin_amdgcn_readfirstlane(item / NCH), ch = __builtin_amdgcn_readfirstlane(item % NCH);
        float Q[64], P[64];
        int ln_ = lane; asm volatile("" : "+v"(ln_));
#pragma unroll
        for (int j = 0; j < 64; ++j) { Q[j] = 0.f; P[j] = (j == ln_) ? 1.f : 0.f; }
        const size_t lane_off = (size_t)(lane >> 3) * W + h * 64 + (lane & 7) * 8;
        { const size_t e0 = (size_t)(ch * CL) * W + lane_off;
          sc_dma(AA, e0, ring); sc_dma(WM1, e0, ring + 1024); sc_dma(BB, e0, ring + 2048); sc_dma(KP, e0, ring + 3072); sc_dma(V, e0, ring + 4096); }
#pragma unroll 1
        for (int blk = 0; blk < CL / SCB; ++blk) {
            LAS3 unsigned char* buf = ring + (blk & 1) * SC_BUF;
            if (blk + 1 < CL / SCB) { LAS3 unsigned char* nb = ring + ((blk + 1) & 1) * SC_BUF; const size_t e0 = (size_t)(ch * CL + (blk + 1) * SCB) * W + lane_off;
                sc_dma(AA, e0, nb); sc_dma(WM1, e0, nb + 1024); sc_dma(BB, e0, nb + 2048); sc_dma(KP, e0, nb + 3072); sc_dma(V, e0, nb + 4096);
                asm volatile("s_waitcnt vmcnt(5)" ::: "memory"); }
            else asm volatile("s_waitcnt vmcnt(0)" ::: "memory");
            SVec A, Wv, Bv, Kv;
            sv_cvt(A, sv_read(buf, lane)); sv_cvt1p(Wv, sv_read(buf + 1024, lane)); sv_cvt(Bv, sv_read(buf + 2048, lane)); sv_cvt(Kv, sv_read(buf + 3072, lane));
            float vv = (float)*(const LAS3 f16*)(buf + 4096 + lane * 2);
#pragma unroll 1
            for (int st = 0; st < SCB; ++st) {
                const LAS3 unsigned char* sn = buf + ((st + 1 < SCB) ? st + 1 : st) * 128;
                const f16x4 ha = sv_read(sn, lane), hw = sv_read(sn + 1024, lane), hb = sv_read(sn + 2048, lane), hk = sv_read(sn + 3072, lane);
                const f16 hv = *(const LAS3 f16*)(sn + 4096 + lane * 2);
                float dq[4] = {0.f, 0.f, 0.f, 0.f}, dp[4] = {0.f, 0.f, 0.f, 0.f};
                sc_dot<0>(dq, A, Q); sc_dot<0>(dp, A, P);
                const float saq = (dq[0] + dq[1]) + (dq[2] + dq[3]), sap = (dp[0] + dp[1]) + (dp[2] + dp[3]);
                sc_upd1<0>(Q, P, Wv, Bv, Kv, saq, sap, vv);
                sv_cvt(A, ha); sv_cvt1p(Wv, hw); sv_cvt(Bv, hb); sv_cvt(Kv, hk); vv = (float)hv;
            }
        }
        float* Qp = ST + ST_Q_OFF + (size_t)(h * NCH + ch) * 4096 + lane;
        bf16* PTp = (bf16*)ST + (size_t)(h * NCH + ch) * 4096 + lane;
#pragma unroll
        for (int j = 0; j < 64; ++j) { PTp[j * 64] = f2bf(P[j]); Qp[j * 64] = Q[j]; }
    }
}
constexpr int GS = 16, NG = NCH / GS;
constexpr size_t ST_LP_OFF = (size_t)NH * NCH * 4096;
constexpr size_t WS_SG = WS_LORA + 2 * MiB;
constexpr int HI_LD = 72, HI_BYTES = 64 * HI_LD * 2;
struct HFrag { bf16x8 b[2][2]; f32x4 q[2]; };
__device__ __forceinline__ void hload(HFrag& f, const bf16* Bt, const float* QTc, int boff, int qtoff) {
#pragma unroll
    for (int ks = 0; ks < 2; ++ks)
#pragma unroll
        for (int n = 0; n < 2; ++n) f.b[ks][n] = *(const bf16x8*)(Bt + boff + 16 * n * 64 + 32 * ks);
#pragma unroll
    for (int n = 0; n < 2; ++n) f.q[n] = *(const f32x4*)(QTc + qtoff + 16 * n * 64);
}
__device__ __forceinline__ void hmma(const LAS3 unsigned char* img, const bf16x8 (&b)[2][2], f32x4 (&acc)[2], int m, int fr, int fq) {
#pragma unroll
    for (int ks = 0; ks < 2; ++ks) { const bf16x8 av = *(const LAS3 bf16x8*)(img + ((16 * m + fr) * HI_LD + 32 * ks + 8 * fq) * 2);
#pragma unroll
        for (int n = 0; n < 2; ++n) acc[n] = __builtin_amdgcn_mfma_f32_16x16x32_bf16(av, b[ks][n], acc[n], 0, 0, 0); }
}
__device__ __forceinline__ void himg_store(LAS3 unsigned char* img, const f32x4 (&acc)[2], int m, int n0, int fr, int fq) {
#pragma unroll
    for (int n = 0; n < 2; ++n)
#pragma unroll
        for (int i = 0; i < 4; ++i) *(LAS3 bf16*)(img + ((16 * m + 4 * fq + i) * HI_LD + n0 + 16 * n + fr) * 2) = f2bf(acc[n][i]);
}
#define HBAR() do { asm volatile("s_waitcnt lgkmcnt(0)" ::: "memory"); __builtin_amdgcn_s_barrier(); asm volatile("" ::: "memory"); } while (0)

__device__ __forceinline__ void sc2a_step(const HFrag& f, bf16* LpTc, float* QTc, const LAS3 unsigned char* ip, LAS3 unsigned char* ipn, const LAS3 unsigned char* iq, LAS3 unsigned char* iqn, int m, int n0, int fr, int fq, int qtoff) {
    f32x4 ap[2], aq[2];
#pragma unroll
    for (int n = 0; n < 2; ++n) { ap[n] = (f32x4){0.f, 0.f, 0.f, 0.f}; aq[n] = f.q[n]; }
    hmma(ip, f.b, ap, m, fr, fq); hmma(iq, f.b, aq, m, fr, fq);
#pragma unroll
    for (int n = 0; n < 2; ++n) { u32x2 w; w.x = pk2(ap[n][0], ap[n][1]); w.y = pk2(ap[n][2], ap[n][3]);
        *(u32x2*)(LpTc + (n0 + 16 * n + fr) * 64 + 16 * m + 4 * fq) = w;
        *(f32x4*)(QTc + qtoff + 16 * n * 64) = aq[n]; }
    himg_store(ipn, ap, m, n0, fr, fq); himg_store(iqn, aq, m, n0, fr, fq);
    HBAR();
}
__device__ __forceinline__ void phase_scan2a(ArgsR a, const Ctx& c) {
    const int lane = c.lane, wv = c.wave, fr = lane & 15, fq = lane >> 4, m = wv >> 1, n0 = 32 * (wv & 1);
    const int boff = (n0 + fr) * 64 + 8 * fq, qtoff = (n0 + fr) * 64 + 16 * m + 4 * fq;
    LAS3 unsigned char* L = (LAS3 unsigned char*)c.lds;
    for (int item = blockIdx.x; item < NH * NG; item += gridDim.x) {
        const size_t cb = (size_t)(item / NG) * NCH + (size_t)(item % NG) * GS;
        const bf16* PT = (const bf16*)(a.ws + WS_ST) + cb * 4096; bf16* LP = (bf16*)(a.ws + WS_ST) + ST_LP_OFF + cb * 4096; float* QT = (float*)(a.ws + WS_ST) + ST_Q_OFF + cb * 4096;
        for (int i = c.tid; i < 4 * HI_BYTES / 4; i += NTHREADS) ((LAS3 unsigned*)L)[i] = 0u;
        __syncthreads();
        if (c.tid < 64) *(LAS3 bf16*)(L + (c.tid * HI_LD + c.tid) * 2) = (bf16)0x3F80;
        __syncthreads();
        HFrag f0, f1, f2, f3;
        hload(f0, PT, QT, boff, qtoff); hload(f1, PT + 4096, QT + 4096, boff, qtoff); hload(f2, PT + 2 * 4096, QT + 2 * 4096, boff, qtoff); hload(f3, PT + 3 * 4096, QT + 3 * 4096, boff, qtoff);
        LAS3 unsigned char* p0 = L; LAS3 unsigned char* p1 = L + HI_BYTES; LAS3 unsigned char* q0 = L + 2 * HI_BYTES; LAS3 unsigned char* q1 = L + 3 * HI_BYTES;
#pragma unroll 1
        for (int i = 0; i < GS; i += 4) {
            const int nx = (i + 4 < GS) ? i + 4 : i;
            sc2a_step(f0, LP + (size_t)(i + 0) * 4096, QT + (size_t)(i + 0) * 4096, p0, p1, q0, q1, m, n0, fr, fq, qtoff); hload(f0, PT + (size_t)(nx + 0) * 4096, QT + (size_t)(nx + 0) * 4096, boff, qtoff);
            sc2a_step(f1, LP + (size_t)(i + 1) * 4096, QT + (size_t)(i + 1) * 4096, p1, p0, q1, q0, m, n0, fr, fq, qtoff); hload(f1, PT + (size_t)(nx + 1) * 4096, QT + (size_t)(nx + 1) * 4096, boff, qtoff);
            sc2a_step(f2, LP + (size_t)(i + 2) * 4096, QT + (size_t)(i + 2) * 4096, p0, p1, q0, q1, m, n0, fr, fq, qtoff); hload(f2, PT + (size_t)(nx + 2) * 4096, QT + (size_t)(nx + 2) * 4096, boff, qtoff);
            sc2a_step(f3, LP + (size_t)(i + 3) * 4096, QT + (size_t)(i + 3) * 4096, p1, p0, q1, q0, m, n0, fr, fq, qtoff); hload(f3, PT + (size_t)(nx + 3) * 4096, QT + (size_t)(nx + 3) * 4096, boff, qtoff);
        }
        __syncthreads();
    }
}
__device__ __forceinline__ void phase_scan2b(ArgsR a, const Ctx& c) {
    if (blockIdx.x >= NH) return;
    const int h = blockIdx.x, lane = c.lane, wv = c.wave, fr = lane & 15, fq = lane >> 4, m = wv >> 1, n0 = 32 * (wv & 1);
    const int boff = (n0 + fr) * 64 + 8 * fq, qtoff = (n0 + fr) * 64 + 16 * m + 4 * fq;
    LAS3 unsigned char* L = (LAS3 unsigned char*)c.lds;
    const bf16* LP = (const bf16*)(a.ws + WS_ST) + ST_LP_OFF + (size_t)h * NCH * 4096; const float* QT = (const float*)(a.ws + WS_ST) + ST_Q_OFF + (size_t)h * NCH * 4096;
    bf16* SG = (bf16*)(a.ws + WS_SG) + (size_t)h * NG * 4096;
    for (int i = c.tid; i < 2 * HI_BYTES / 4; i += NTHREADS) ((LAS3 unsigned*)L)[i] = 0u;
    for (int i = c.tid; i < 4096 / 2; i += NTHREADS) ((LAS3 unsigned*)(L + 2 * HI_BYTES))[i] = 0u;
    __syncthreads();
    HFrag f0, f1, f2, f3;
#define SC2B_CH(g) ((size_t)((g) * GS + GS - 1) * 4096)
    hload(f0, LP + SC2B_CH(0), QT + SC2B_CH(0), boff, qtoff); hload(f1, LP + SC2B_CH(1), QT + SC2B_CH(1), boff, qtoff); hload(f2, LP + SC2B_CH(2), QT + SC2B_CH(2), boff, qtoff); hload(f3, LP + SC2B_CH(3), QT + SC2B_CH(3), boff, qtoff);
    LAS3 unsigned char* i0 = L; LAS3 unsigned char* i1 = L + HI_BYTES;
#define SC2B_STEP(f, g, ic, in) do { f32x4 acc[2] = {f.q[0], f.q[1]}; hmma(ic, f.b, acc, m, fr, fq); LAS3 bf16* So = (LAS3 bf16*)(L + 2 * HI_BYTES) + (((g) + 1) & 7) * 4096; \
        _Pragma("unroll") for (int n = 0; n < 2; ++n) _Pragma("unroll") for (int i = 0; i < 4; ++i) So[(16 * m + 4 * fq + i) * 64 + n0 + 16 * n + fr] = f2bf(acc[n][i]); \
        himg_store(in, acc, m, n0, fr, fq); HBAR(); } while (0)
#pragma unroll 1
    for (int g = 0; g < NG; g += 4) {
        const int nx = (g + 4 < NG) ? g + 4 : g;
        SC2B_STEP(f0, g + 0, i0, i1); hload(f0, LP + SC2B_CH(nx + 0), QT + SC2B_CH(nx + 0), boff, qtoff);
        SC2B_STEP(f1, g + 1, i1, i0); hload(f1, LP + SC2B_CH(nx + 1), QT + SC2B_CH(nx + 1), boff, qtoff);
        SC2B_STEP(f2, g + 2, i0, i1); hload(f2, LP + SC2B_CH(nx + 2), QT + SC2B_CH(nx + 2), boff, qtoff);
        if ((g & 7) == 4) {
            for (int i = c.tid; i < 8 * 4096 / 8; i += NTHREADS) ((u32x4*)(SG + (size_t)(g >> 3) * 8 * 4096))[i] = ((const LAS3 u32x4*)(L + 2 * HI_BYTES))[i];
            HBAR(); }
        if (g + 3 < NG - 1) SC2B_STEP(f3, g + 3, i1, i0);
        hload(f3, LP + SC2B_CH(nx + 3), QT + SC2B_CH(nx + 3), boff, qtoff);
    }
#undef SC2B_STEP
#undef SC2B_CH
}
__device__ __forceinline__ void phase_scan2c(ArgsR a, const Ctx& c) {
    const int lane = c.lane, wv = c.wave, fr = lane & 15, fq = lane >> 4, m = wv >> 1, n0 = 32 * (wv & 1);
    const int boff = (n0 + fr) * 64 + 8 * fq, qtoff = (n0 + fr) * 64 + 16 * m + 4 * fq;
    LAS3 unsigned char* L = (LAS3 unsigned char*)c.lds;
    for (int item = blockIdx.x; item < NH * NG * 2; item += gridDim.x) {
        const int hg = item >> 1, hf = item & 1;
        const size_t cb = (size_t)(hg / NG) * NCH + (size_t)(hg % NG) * GS + hf * 8;
        const bf16* LP = (const bf16*)(a.ws + WS_ST) + ST_LP_OFF + cb * 4096; const float* QT = (const float*)(a.ws + WS_ST) + ST_Q_OFF + cb * 4096; bf16* SS = (bf16*)(a.ws + WS_ST) + cb * 4096;
        { const u32x4 v = *(const u32x4*)((const bf16*)(a.ws + WS_SG) + (size_t)hg * 4096 + c.tid * 8); *(LAS3 u32x4*)(L + ((c.tid >> 3) * HI_LD + (c.tid & 7) * 8) * 2) = v; }
        __syncthreads();
#pragma unroll 2
        for (int i = 0; i < 8; ++i) { HFrag f; hload(f, LP + (size_t)i * 4096, QT + (size_t)i * 4096, boff, qtoff);
            f32x4 acc[2] = {f.q[0], f.q[1]}; hmma(L, f.b, acc, m, fr, fq); bf16* So = SS + (size_t)i * 4096;
#pragma unroll
            for (int n = 0; n < 2; ++n)
#pragma unroll
                for (int k = 0; k < 4; ++k) So[(16 * m + 4 * fq + k) * 64 + n0 + 16 * n + fr] = f2bf(acc[n][k]); }
        __syncthreads();
    }
}
constexpr int WI_LD = 72, WI_B = 64 * WI_LD * 2, WI_GAM = 9 * WI_B, WI_GL = 15 * WI_B;
constexpr size_t WS_GM0 = 352 * MiB, WS_GM1 = 212 * MiB, WS_Y0 = 336 * MiB, WS_END2 = 360 * MiB;
__device__ __forceinline__ bf16* gm_ptr(unsigned char* ws, int h, int ch) { return (bf16*)(ws + (h < 4 ? WS_GM0 : WS_GM1)) + (size_t)((h & 3) * NCH + ch) * 4096; }
__device__ __forceinline__ void wi_mma(f32x4 (&acc)[2], const LAS3 unsigned char* A, const LAS3 unsigned char* Bt, int m, int n0, int fr, int fq) {
#pragma unroll
    for (int ks = 0; ks < 2; ++ks) { const bf16x8 av = *(const LAS3 bf16x8*)(A + ((16 * m + fr) * WI_LD + 32 * ks + 8 * fq) * 2);
#pragma unroll
        for (int n = 0; n < 2; ++n) { const bf16x8 bv = *(const LAS3 bf16x8*)(Bt + ((n0 + 16 * n + fr) * WI_LD + 32 * ks + 8 * fq) * 2); acc[n] = __builtin_amdgcn_mfma_f32_16x16x32_bf16(av, bv, acc[n], 0, 0, 0); } }
}
struct WiA { bf16x8 a[2]; }; struct WiB { bf16x8 b[2][2]; };
__device__ __forceinline__ void wi_lda(WiA& f, const LAS3 unsigned char* A, int m, int fr, int fq) {
#pragma unroll
    for (int ks = 0; ks < 2; ++ks) f.a[ks] = *(const LAS3 bf16x8*)(A + ((16 * m + fr) * WI_LD + 32 * ks + 8 * fq) * 2);
}
__device__ __forceinline__ void wi_ldb(WiB& f, const LAS3 unsigned char* Bt, int n0, int fr, int fq) {
#pragma unroll
    for (int ks = 0; ks < 2; ++ks)
#pragma unroll
        for (int n = 0; n < 2; ++n) f.b[ks][n] = *(const LAS3 bf16x8*)(Bt + ((n0 + 16 * n + fr) * WI_LD + 32 * ks + 8 * fq) * 2);
}
__device__ __forceinline__ void wi_fma(f32x4 (&acc)[2], const WiA& A, const WiB& B) {
#pragma unroll
    for (int ks = 0; ks < 2; ++ks)
#pragma unroll
        for (int n = 0; n < 2; ++n) acc[n] = __builtin_amdgcn_mfma_f32_16x16x32_bf16(A.a[ks], B.b[ks][n], acc[n], 0, 0, 0);
}
__device__ __forceinline__ void wi_fma_s(f32x4 (&acc)[2], const WiA& A, const WiB& B) {
#pragma unroll
    for (int ks = 0; ks < 2; ++ks)
#pragma unroll
        for (int n = 0; n < 2; ++n) acc[n] = __builtin_amdgcn_mfma_f32_16x16x32_bf16(B.b[ks][n], A.a[ks], acc[n], 0, 0, 0);
}
__device__ __forceinline__ void wi_st_nat_s(LAS3 unsigned char* X, const f32x4 (&acc)[2], int m, int n0, int fr, int fq) {
#pragma unroll
    for (int n = 0; n < 2; ++n) { u32x2 w; w.x = pk2(acc[n][0], acc[n][1]); w.y = pk2(acc[n][2], acc[n][3]); *(LAS3 u32x2*)(X + ((16 * m + fr) * WI_LD + n0 + 16 * n + 4 * fq) * 2) = w; }
}
__device__ __forceinline__ void wi_ld_nat_s(f32x4 (&acc)[2], const LAS3 unsigned char* X, int m, int n0, int fr, int fq) {
#pragma unroll
    for (int n = 0; n < 2; ++n) { const u32x2 w = *(const LAS3 u32x2*)(X + ((16 * m + fr) * WI_LD + n0 + 16 * n + 4 * fq) * 2);
        acc[n][0] = __uint_as_float(w.x << 16); acc[n][1] = __uint_as_float(w.x & 0xffff0000u); acc[n][2] = __uint_as_float(w.y << 16); acc[n][3] = __uint_as_float(w.y & 0xffff0000u); }
}
__device__ __forceinline__ void wi_ld_tr(f32x4 (&acc)[2], const LAS3 unsigned char* XT, int m, int n0, int fr, int fq) {
#pragma unroll
    for (int n = 0; n < 2; ++n) { const u32x2 w = *(const LAS3 u32x2*)(XT + ((n0 + 16 * n + fr) * WI_LD + 16 * m + 4 * fq) * 2);
        acc[n][0] = __uint_as_float(w.x << 16); acc[n][1] = __uint_as_float(w.x & 0xffff0000u); acc[n][2] = __uint_as_float(w.y << 16); acc[n][3] = __uint_as_float(w.y & 0xffff0000u); }
}
#define WI_PIN() __builtin_amdgcn_sched_barrier(0)
__device__ __forceinline__ void wi_st_nat(LAS3 unsigned char* X, const f32x4 (&acc)[2], int m, int n0, int fr, int fq) {
#pragma unroll
    for (int n = 0; n < 2; ++n)
#pragma unroll
        for (int i = 0; i < 4; ++i) *(LAS3 bf16*)(X + ((16 * m + 4 * fq + i) * WI_LD + n0 + 16 * n + fr) * 2) = f2bf(acc[n][i]);
}
__device__ __forceinline__ void wi_st_tr(LAS3 unsigned char* XT, const f32x4 (&acc)[2], int m, int n0, int fr, int fq) {
#pragma unroll
    for (int n = 0; n < 2; ++n) { u32x2 w; w.x = pk2(acc[n][0], acc[n][1]); w.y = pk2(acc[n][2], acc[n][3]); *(LAS3 u32x2*)(XT + ((n0 + 16 * n + fr) * WI_LD + 16 * m + 4 * fq) * 2) = w; }
}
__device__ __forceinline__ void wi_ld_nat(f32x4 (&acc)[2], const LAS3 unsigned char* X, int m, int n0, int fr, int fq) {
#pragma unroll
    for (int n = 0; n < 2; ++n)
#pragma unroll
        for (int i = 0; i < 4; ++i) acc[n][i] = bf2f(*(const LAS3 bf16*)(X + ((16 * m + 4 * fq + i) * WI_LD + n0 + 16 * n + fr) * 2));
}
__device__ __forceinline__ void phase_scan1m(ArgsR a, const Ctx& c, const int skip = 0) {
    const f16* WM1 = (const f16*)(a.ws + WS_WM1); const f16* KP = (const f16*)(a.ws + WS_KP);
    const f16* AA = (const f16*)(a.ws + WS_AA); const f16* BB = (const f16*)(a.ws + WS_BB); const f16* V = (const f16*)(a.ws + WS_V); const f16* R = (const f16*)(a.ws + WS_R);
    float* ST = (float*)(a.ws + WS_ST);
    LAS3 unsigned char* L = (LAS3 unsigned char*)c.lds;
    LAS3 float* GAM = (LAS3 float*)(L + WI_GAM); LAS3 float* GL = (LAS3 float*)(L + WI_GL);
    const int lane = c.lane, wv = c.wave, fr = lane & 15, fq = lane >> 4, m = wv >> 1, n0 = 32 * (wv & 1), tid = c.tid;
#define SLOT(i) (L + (i) * WI_B)
    const int t = tid >> 3, cc = (tid & 7) * 8;
    f16x8 pav, pbv, pkv, pvv, prv, pwv;
#define WI_FETCH(it) do { const int h_ = (it) / NCH, ch_ = (it) % NCH; const size_t eo_ = (size_t)(ch_ * CL + t) * W + h_ * 64 + cc; \
        pav = *(const f16x8*)(AA + eo_); pbv = *(const f16x8*)(BB + eo_); pkv = *(const f16x8*)(KP + eo_); pvv = *(const f16x8*)(V + eo_); prv = *(const f16x8*)(R + eo_); pwv = *(const f16x8*)(WM1 + eo_); } while (0)
    if (blockIdx.x < NH * NCH) WI_FETCH(blockIdx.x);
    for (int item = blockIdx.x; item < NH * NCH; item += gridDim.x) {
        const int h = item / NCH, ch = item % NCH;
        const f16x8 av = pav, bv = pbv, kv = pkv, vv = pvv, rv = prv, wv8 = pwv;
        if (item + (int)gridDim.x < NH * NCH) WI_FETCH(item + (int)gridDim.x);
        float g[8], gp[8];
        { float wloc[8];
#pragma unroll
          for (int e = 0; e < 8; ++e) wloc[e] = 1.0f + (float)wv8[e];
#pragma unroll
          for (int e = 0; e < 8; ++e) { float x = wloc[e];
              { const float y = __shfl_up(x, 8); if (lane >= 8) x *= y; } { const float y = __shfl_up(x, 16); if (lane >= 16) x *= y; } { const float y = __shfl_up(x, 32); if (lane >= 32) x *= y; }
              g[e] = x; }
          if (lane >= 56) {
#pragma unroll
              for (int e = 0; e < 8; ++e) GAM[wv * 64 + cc + e] = g[e]; }
          HBAR();
#pragma unroll
          for (int e = 0; e < 8; ++e) { float pre = 1.0f;
#pragma unroll
              for (int w = 0; w < 7; ++w) if (w < wv) pre *= GAM[w * 64 + cc + e];
              g[e] *= pre; gp[e] = g[e] * __builtin_amdgcn_rcpf(wloc[e]); } }
        { float fa[8], fb[8], fk[8], fv[8], frr[8];
#pragma unroll
          for (int e = 0; e < 8; ++e) { const float ig = __builtin_amdgcn_rcpf(g[e]);
              fa[e] = (float)av[e] * gp[e]; fb[e] = (float)bv[e] * ig; fk[e] = (float)kv[e] * ig; fv[e] = (float)vv[e]; frr[e] = (float)rv[e] * g[e]; if (t == 63) GL[cc + e] = g[e]; }
          *(LAS3 u32x4*)(SLOT(0) + (t * WI_LD + cc) * 2) = pack8bf(fa); *(LAS3 u32x4*)(SLOT(2) + (t * WI_LD + cc) * 2) = pack8bf(fb); *(LAS3 u32x4*)(SLOT(4) + (t * WI_LD + cc) * 2) = pack8bf(fk); *(LAS3 u32x4*)(SLOT(12) + (t * WI_LD + cc) * 2) = pack8bf(frr);
#pragma unroll
          for (int e = 0; e < 8; ++e) { *(LAS3 bf16*)(SLOT(1) + ((cc + e) * WI_LD + t) * 2) = f2bf(fa[e]); *(LAS3 bf16*)(SLOT(3) + ((cc + e) * WI_LD + t) * 2) = f2bf(fb[e]); *(LAS3 bf16*)(SLOT(5) + ((cc + e) * WI_LD + t) * 2) = f2bf(fv[e]); } }
        HBAR();
        { WiA aB, aK; WiB bA, bR; wi_lda(aB, SLOT(2), m, fr, fq); wi_lda(aK, SLOT(4), m, fr, fq); wi_ldb(bA, SLOT(0), n0, fr, fq); wi_ldb(bR, SLOT(12), n0, fr, fq);
          WI_PIN();
          f32x4 ans[2] = {{0.f, 0.f, 0.f, 0.f}, {0.f, 0.f, 0.f, 0.f}}, ant[2] = {{0.f, 0.f, 0.f, 0.f}, {0.f, 0.f, 0.f, 0.f}}, aks[2] = {{0.f, 0.f, 0.f, 0.f}, {0.f, 0.f, 0.f, 0.f}}, am[2] = {{0.f, 0.f, 0.f, 0.f}, {0.f, 0.f, 0.f, 0.f}}, amk[2] = {{0.f, 0.f, 0.f, 0.f}, {0.f, 0.f, 0.f, 0.f}};
          wi_fma_s(ans, aB, bA); wi_fma(ant, aB, bA); wi_fma_s(aks, aK, bA); wi_fma(am, aB, bR); wi_fma(amk, aK, bR);
          WI_PIN();
          f32x4 axs[2];
#pragma unroll
          for (int n = 0; n < 2; ++n)
#pragma unroll
              for (int i = 0; i < 4; ++i) { const int rs = 16 * m + fr, cs = n0 + 16 * n + 4 * fq + i;
                  if (!(rs < cs)) { ans[n][i] = 0.f; aks[n][i] = 0.f; } axs[n][i] = ans[n][i] + (rs == cs ? 1.0f : 0.f);
                  const int rn = 16 * m + 4 * fq + i, cn = n0 + 16 * n + fr;
                  if (!(rn < cn)) ant[n][i] = 0.f; if (rn > cn) { am[n][i] = 0.f; amk[n][i] = 0.f; } }
          wi_st_nat_s(SLOT(7), ans, m, n0, fr, fq); wi_st_tr(SLOT(8), ant, m, n0, fr, fq); wi_st_nat_s(SLOT(6), aks, m, n0, fr, fq); wi_st_nat_s(SLOT(11), axs, m, n0, fr, fq);
          wi_st_tr(SLOT(13), am, m, n0, fr, fq); wi_st_tr(SLOT(14), amk, m, n0, fr, fq); }
        HBAR();
        { WiA aN; WiB bN; wi_lda(aN, SLOT(7), m, fr, fq); wi_ldb(bN, SLOT(8), n0, fr, fq); WI_PIN();
          f32x4 a2s[2] = {{0.f, 0.f, 0.f, 0.f}, {0.f, 0.f, 0.f, 0.f}}, a2t[2] = {{0.f, 0.f, 0.f, 0.f}, {0.f, 0.f, 0.f, 0.f}}; wi_fma_s(a2s, aN, bN); wi_fma(a2t, aN, bN); WI_PIN();
          wi_st_nat_s(SLOT(9), a2s, m, n0, fr, fq); wi_st_tr(SLOT(10), a2t, m, n0, fr, fq); }
        HBAR();
#define WI_LEVEL(XS, XD, NS, NST, ND, NDT) do { WiA aX, aN; WiB bN; f32x4 ax[2]; wi_lda(aX, SLOT(XS), m, fr, fq); wi_ldb(bN, SLOT(NST), n0, fr, fq); wi_lda(aN, SLOT(NS), m, fr, fq); wi_ld_nat_s(ax, SLOT(XS), m, n0, fr, fq); \
            WI_PIN(); f32x4 aqs[2] = {{0.f, 0.f, 0.f, 0.f}, {0.f, 0.f, 0.f, 0.f}}, aqt[2] = {{0.f, 0.f, 0.f, 0.f}, {0.f, 0.f, 0.f, 0.f}}; wi_fma_s(ax, aX, bN); wi_fma_s(aqs, aN, bN); wi_fma(aqt, aN, bN); WI_PIN(); \
            wi_st_nat_s(SLOT(XD), ax, m, n0, fr, fq); wi_st_nat_s(SLOT(ND), aqs, m, n0, fr, fq); wi_st_tr(SLOT(NDT), aqt, m, n0, fr, fq); \
            HBAR(); } while (0)
        WI_LEVEL(11, 0, 9, 10, 7, 8);
        WI_LEVEL(0, 11, 7, 8, 9, 10);
        WI_LEVEL(11, 0, 9, 10, 7, 8);
        WI_LEVEL(0, 11, 7, 8, 9, 10);
#undef WI_LEVEL
        { WiA aX; WiB bN; f32x4 ax[2]; wi_lda(aX, SLOT(11), m, fr, fq); wi_ldb(bN, SLOT(10), n0, fr, fq); wi_ld_nat(ax, SLOT(11), m, n0, fr, fq); WI_PIN();
          wi_fma(ax, aX, bN); WI_PIN(); wi_st_tr(SLOT(0), ax, m, n0, fr, fq); }
        HBAR();
        { WiA aNk, aAt; WiB bT; wi_lda(aNk, SLOT(6), m, fr, fq); wi_lda(aAt, SLOT(1), m, fr, fq); wi_ldb(bT, SLOT(0), n0, fr, fq); WI_PIN();
          f32x4 aw[2] = {{0.f, 0.f, 0.f, 0.f}, {0.f, 0.f, 0.f, 0.f}}, aa[2] = {{0.f, 0.f, 0.f, 0.f}, {0.f, 0.f, 0.f, 0.f}}; wi_fma_s(aw, aNk, bT); wi_fma_s(aa, aAt, bT); WI_PIN();
          wi_st_nat_s(SLOT(2), aw, m, n0, fr, fq); wi_st_nat_s(SLOT(7), aa, m, n0, fr, fq); }
        HBAR();
        { WiA aAT, aW1; WiB bB, bM; f32x4 ap[2] = {{0.f, 0.f, 0.f, 0.f}, {0.f, 0.f, 0.f, 0.f}}, az[2], ag[2], az2[2]; float gl[2];
          wi_lda(aAT, SLOT(7), m, fr, fq); wi_lda(aW1, SLOT(2), m, fr, fq); wi_ldb(bB, SLOT(3), n0, fr, fq); wi_ldb(bM, SLOT(13), n0, fr, fq);
          wi_ld_nat(az, SLOT(4), m, n0, fr, fq); wi_ld_tr(az2, SLOT(14), m, n0, fr, fq); wi_ld_tr(ag, SLOT(12), m, n0, fr, fq);
#pragma unroll
          for (int n = 0; n < 2; ++n) gl[n] = GL[n0 + 16 * n + fr];
          WI_PIN();
          wi_fma(ap, aAT, bB); wi_fma(az, aW1, bB); wi_fma(ag, aAT, bM); wi_fma(az2, aW1, bM);
          WI_PIN();
          wi_st_tr(SLOT(8), az, m, n0, fr, fq); wi_st_tr(SLOT(9), az2, m, n0, fr, fq);
          bf16* PTp = (bf16*)ST + (size_t)(h * NCH + ch) * 4096; bf16* GMp = gm_ptr(a.ws, h, ch);
#pragma unroll
          for (int n = 0; n < 2; ++n) { const int col = n0 + 16 * n + fr; f32x4 pv = ap[n];
#pragma unroll
              for (int i = 0; i < 4; ++i) { if (16 * m + 4 * fq + i == col) pv[i] += 1.0f; pv[i] *= gl[n]; }
              u32x2 w; w.x = pk2(pv[0], pv[1]); w.y = pk2(pv[2], pv[3]); *(u32x2*)(PTp + col * 64 + 16 * m + 4 * fq) = w;
              u32x2 w2; w2.x = pk2(ag[n][0], ag[n][1]); w2.y = pk2(ag[n][2], ag[n][3]); *(u32x2*)(GMp + col * 64 + 16 * m + 4 * fq) = w2; } }
        HBAR();
        { WiA aV; WiB bZ1, bZ2; float gl[2]; wi_lda(aV, SLOT(5), m, fr, fq); wi_ldb(bZ1, SLOT(8), n0, fr, fq); wi_ldb(bZ2, SLOT(9), n0, fr, fq); gl[0] = GL[n0 + fr]; gl[1] = GL[n0 + 16 + fr]; WI_PIN();
          f32x4 aq[2] = {{0.f, 0.f, 0.f, 0.f}, {0.f, 0.f, 0.f, 0.f}}, ay[2] = {{0.f, 0.f, 0.f, 0.f}, {0.f, 0.f, 0.f, 0.f}}; wi_fma(aq, aV, bZ1); wi_fma(ay, aV, bZ2); WI_PIN();
          float* QTp = ST + ST_Q_OFF + (size_t)(h * NCH + ch) * 4096; bf16* Y0p = (bf16*)(a.ws + WS_Y0) + (size_t)(h * NCH + ch) * 4096;
#pragma unroll
          for (int n = 0; n < 2; ++n) { const int col = n0 + 16 * n + fr; *(f32x4*)(QTp + col * 64 + 16 * m + 4 * fq) = aq[n] * gl[n];
              u32x2 w; w.x = pk2(ay[n][0], ay[n][1]); w.y = pk2(ay[n][2], ay[n][3]); *(u32x2*)(Y0p + col * 64 + 16 * m + 4 * fq) = w; } }
        HBAR();
    }
#undef SLOT
#undef WI_FETCH
}

__device__ __forceinline__ void phase_scan3m(ArgsR a, const Ctx& c, int l) {
    const f16* R = (const f16*)(a.ws + WS_R); const f16* KP = (const f16*)(a.ws + WS_KP); const f16* V = (const f16*)(a.ws + WS_V); const bf16* G = (const bf16*)(a.ws + WS_G);
    bf16* YA = (bf16*)(a.ws + WS_YA);
    LAS3 unsigned char* L = (LAS3 unsigned char*)c.lds;
    LAS3 float* YL = (LAS3 float*)(L + WI_B);
    const int lane = c.lane, wv = c.wave, fr = lane & 15, fq = lane >> 4, m = wv >> 1, n0 = 32 * (wv & 1), tid = c.tid;
    for (int item = blockIdx.x; item < NH * NCH; item += gridDim.x) {
        const int h = item / NCH, ch = item % NCH;
        { u32x4 v = {0u, 0u, 0u, 0u}; if (ch > 0) v = *(const u32x4*)((const bf16*)(a.ws + WS_ST) + (size_t)(h * NCH + ch - 1) * 4096 + tid * 8);
          *(LAS3 u32x4*)(L + ((tid >> 3) * WI_LD + (tid & 7) * 8) * 2) = v; }
        const bf16* GMp = gm_ptr(a.ws, h, ch); const bf16* Y0p = (const bf16*)(a.ws + WS_Y0) + (size_t)(h * NCH + ch) * 4096;
        bf16x8 bfr[2][2]; f32x4 acc[2];
#pragma unroll
        for (int ks = 0; ks < 2; ++ks)
#pragma unroll
            for (int n = 0; n < 2; ++n) bfr[ks][n] = *(const bf16x8*)(GMp + (n0 + 16 * n + fr) * 64 + 32 * ks + 8 * fq);
#pragma unroll
        for (int n = 0; n < 2; ++n) acc[n] = load4bf(Y0p + (n0 + 16 * n + fr) * 64 + 16 * m + 4 * fq);
        HBAR();
#pragma unroll
        for (int ks = 0; ks < 2; ++ks) { const bf16x8 av = *(const LAS3 bf16x8*)(L + ((16 * m + fr) * WI_LD + 32 * ks + 8 * fq) * 2);
#pragma unroll
            for (int n = 0; n < 2; ++n) acc[n] = __builtin_amdgcn_mfma_f32_16x16x32_bf16(av, bfr[ks][n], acc[n], 0, 0, 0); }
#pragma unroll
        for (int n = 0; n < 2; ++n)
#pragma unroll
            for (int i = 0; i < 4; ++i) YL[(n0 + 16 * n + fr) * 65 + 16 * m + 4 * fq + i] = acc[n][i];
        HBAR();
        { const float gn_g = a.in[I_GNG][l * W + h * 64 + lane], gn_b = a.in[I_GNB][l * W + h * 64 + lane], r_k = a.in[I_RK][l * W + h * 64 + lane];
#pragma unroll 2
          for (int i = 0; i < 8; ++i) { const int t = 8 * wv + i; const size_t o = (size_t)(ch * CL + t) * W + h * 64 + lane;
              const float yy = YL[t * 65 + lane]; const float rl = (float)R[o], kl = (float)KP[o], vl = (float)V[o], gl = bf2f(G[o]);
              const float mean = wave_sum(yy) * (1.f / 64.f); const float dd = yy - mean; const float var = wave_sum(dd * dd) * (1.f / 64.f);
              const float bonus = wave_sum(rl * kl * r_k);
              const float yn = dd * __builtin_amdgcn_rsqf(var + GN_EPS) * gn_g + gn_b + bonus * vl;
              YA[o] = f2bf(yn * gl); } }
        HBAR();
    }
}

__device__ __forceinline__ void phase_scan3(ArgsR a, const Ctx& c, int l) {
    const f16* R = (const f16*)(a.ws + WS_R); const f16* WM1 = (const f16*)(a.ws + WS_WM1); const f16* KP = (const f16*)(a.ws + WS_KP);
    const f16* AA = (const f16*)(a.ws + WS_AA); const f16* BB = (const f16*)(a.ws + WS_BB); const f16* V = (const f16*)(a.ws + WS_V);
    const float* ST = (const float*)(a.ws + WS_ST); bf16* YA = (bf16*)(a.ws + WS_YA); const f16* Gs = (const f16*)(a.ws + WS_G);
    const int lane = c.lane;
    LAS3 unsigned char* ring = (LAS3 unsigned char*)c.lds + c.wave * SC_WAVE;
    for (int item = c.gw; item < NH * NCH; item += c.ngw) {
        const int h = __builtin_amdgcn_readfirstlane(item / NCH), ch = __builtin_amdgcn_readfirstlane(item % NCH);
        const size_t lane_off = (size_t)(lane >> 3) * W + h * 64 + (lane & 7) * 8;
        const float gn_g = a.in[I_GNG][l * W + h * 64 + lane], gn_b = a.in[I_GNB][l * W + h * 64 + lane], r_k = a.in[I_RK][l * W + h * 64 + lane];
        { const size_t e0 = (size_t)(ch * CL) * W + lane_off;
          sc_dma(AA, e0, ring); sc_dma(WM1, e0, ring + 1024); sc_dma(BB, e0, ring + 2048); sc_dma(KP, e0, ring + 3072); sc_dma(V, e0, ring + 4096); sc_dma(R, e0, ring + 5120); sc_dma(Gs, e0, ring + 6144); }
        float S[64];
        if (ch == 0) {
#pragma unroll
            for (int j = 0; j < 64; ++j) S[j] = 0.f;
        } else { const bf16* Sp = (const bf16*)ST + ((size_t)(h * NCH + ch - 1) * 64 + lane) * 64;
#pragma unroll
            for (int j = 0; j < 64; j += 4) { const f32x4 x = load4bf(Sp + j); S[j] = x[0]; S[j + 1] = x[1]; S[j + 2] = x[2]; S[j + 3] = x[3]; } }
#pragma unroll 1
        for (int blk = 0; blk < CL / SCB; ++blk) {
            LAS3 unsigned char* buf = ring + (blk & 1) * SC_BUF;
            if (blk + 1 < CL / SCB) { LAS3 unsigned char* nb = ring + ((blk + 1) & 1) * SC_BUF; const size_t e0 = (size_t)(ch * CL + (blk + 1) * SCB) * W + lane_off;
                sc_dma(AA, e0, nb); sc_dma(WM1, e0, nb + 1024); sc_dma(BB, e0, nb + 2048); sc_dma(KP, e0, nb + 3072); sc_dma(V, e0, nb + 4096); sc_dma(R, e0, nb + 5120); sc_dma(Gs, e0, nb + 6144);
                asm volatile("s_waitcnt vmcnt(7)" ::: "memory"); }
            else asm volatile("s_waitcnt vmcnt(0)" ::: "memory");
            SVec A, Wv, Bv, Kv, Rv;
            sv_cvt(A, sv_read(buf, lane)); sv_cvt1p(Wv, sv_read(buf + 1024, lane)); sv_cvt(Bv, sv_read(buf + 2048, lane)); sv_cvt(Kv, sv_read(buf + 3072, lane)); sv_cvt(Rv, sv_read(buf + 5120, lane));
            float vv = (float)*(const LAS3 f16*)(buf + 4096 + lane * 2);
#pragma unroll 1
            for (int st = 0; st < SCB; ++st) {
                const LAS3 unsigned char* sn = buf + ((st + 1 < SCB) ? st + 1 : st) * 128;
                const f16x4 ha = sv_read(sn, lane), hw = sv_read(sn + 1024, lane), hb = sv_read(sn + 2048, lane), hk = sv_read(sn + 3072, lane), hr = sv_read(sn + 5120, lane);
                const f16 hv = *(const LAS3 f16*)(sn + 4096 + lane * 2);
                float d[4] = {0.f, 0.f, 0.f, 0.f};
                sc_dot<0>(d, A, S);
                const float sa = (d[0] + d[1]) + (d[2] + d[3]);
                float y[4] = {0.f, 0.f, 0.f, 0.f};
                sc_upd3<0>(S, y, Wv, Bv, Kv, Rv, sa, vv);
                const float yy = (y[0] + y[1]) + (y[2] + y[3]);
                sv_cvt(A, ha); sv_cvt1p(Wv, hw); sv_cvt(Bv, hb); sv_cvt(Kv, hk); sv_cvt(Rv, hr); vv = (float)hv;
                { const LAS3 unsigned char* sb = buf + st * 128;
                  const float rl = (float)*(const LAS3 f16*)(sb + 5120 + lane * 2), kl = (float)*(const LAS3 f16*)(sb + 3072 + lane * 2), vl = (float)*(const LAS3 f16*)(sb + 4096 + lane * 2);
                  const float gl = bf2f(*(const LAS3 bf16*)(sb + 6144 + lane * 2));
                  const float mean = wave_sum(yy) * (1.f / 64.f); const float dd = yy - mean; const float var = wave_sum(dd * dd) * (1.f / 64.f);
                  const float bonus = wave_sum(rl * kl * r_k);
                  const float yn = dd * __builtin_amdgcn_rsqf(var + GN_EPS) * gn_g + gn_b + bonus * vl;
                  YA[(size_t)(ch * CL + blk * SCB + st) * W + h * 64 + lane] = f2bf(yn * gl); }
            }
        }
    }
}

__device__ __forceinline__ void phase_post(ArgsR a, const Ctx& c, int l) {
    const bf16* YSC = (const bf16*)(a.ws + WS_YSC); const f16* R = (const f16*)(a.ws + WS_R); const f16* KP = (const f16*)(a.ws + WS_KP); const f16* V = (const f16*)(a.ws + WS_V);
    const bf16* G = (const bf16*)(a.ws + WS_G); bf16* YA = (bf16*)(a.ws + WS_YA);
    const float* gng = a.in[I_GNG] + l * W; const float* gnb = a.in[I_GNB] + l * W; const float* rk = a.in[I_RK] + l * W;
    for (int t = c.gw; t < T; t += c.ngw) {
#pragma unroll
        for (int i = 0; i < 8; ++i) { const int n = c.lane + 64 * i; const size_t o = (size_t)t * W + n;
            const float y = bf2f(YSC[o]); const float mean = wave_sum(y) * (1.f / 64.f); const float d = y - mean; const float var = wave_sum(d * d) * (1.f / 64.f);
            float yn = d * __builtin_amdgcn_rsqf(var + GN_EPS) * gng[n] + gnb[n];
            const float r = (float)R[o], k = (float)KP[o], v = (float)V[o];
            const float bonus = wave_sum(r * k * rk[n]);
            yn += bonus * v;
            YA[o] = f2bf(yn * bf2f(G[o])); }
    }
}

__device__ __forceinline__ void phase_ln1(ArgsR a, const Ctx& c, int l, float* outw, int mode = 3) {
    const float* MODF = (const float*)(a.ws + WS_MODF) + l * 6144;
    const float* g1 = a.in[I_LN1G] + l * D; const float* b1 = a.in[I_LN1B] + l * D;
    bf16* XN = (bf16*)(a.ws + WS_XN);
    int* TOKI = (int*)(a.ws + WS_TOKI); float* TOKW = (float*)(a.ws + WS_TOKW); int* TOKP = (int*)(a.ws + WS_TOKP);
    const float* rw = a.in[I_RW]; const float* rb = a.in[I_RB];
    LAS3 float* rwT = (LAS3 float*)((LAS3 unsigned char*)c.lds + 69632);
    unsigned* lcnt = (unsigned*)(c.lds + 135168);
    if (mode & 1) {
    for (int i = c.tid; i < D * NE; i += NTHREADS) rwT[(i & 15) * D + (i >> 4)] = rw[i];
    if (c.tid < NE) lcnt[c.tid] = 0u;
    __syncthreads();
    float vn[16]; if (c.gw < T) load_row16(a.out + (size_t)c.gw * D, c.lane, vn);
    for (int m = c.gw; m < T; m += c.ngw) {
        int l4 = 4 * c.lane; asm volatile("" : "+v"(l4));
        float v[16];
#pragma unroll
        for (int j = 0; j < 16; ++j) v[j] = vn[j];
        if (m + c.ngw < T) load_row16(a.out + (size_t)(m + c.ngw) * D, c.lane, vn);
        float mean, rstd; row_stats(v, mean, rstd);
#pragma unroll
        for (int j = 0; j < 4; ++j) { f32x4 o; const int col = l4 + 256 * j;
#pragma unroll
            for (int e = 0; e < 4; ++e) { v[4 * j + e] = (v[4 * j + e] - mean) * rstd * g1[col + e] + b1[col + e]; o[e] = v[4 * j + e]; }
            *(f32x4*)(outw + (size_t)m * D + col) = o; }
        row_stats(v, mean, rstd);
#pragma unroll
        for (int j = 0; j < 4; ++j) { f32x4 o; const int col = l4 + 256 * j;
#pragma unroll
            for (int e = 0; e < 4; ++e) { v[4 * j + e] = (v[4 * j + e] - mean) * rstd * (1.0f + MODF[4096 + col + e]) + MODF[3072 + col + e]; o[e] = v[4 * j + e]; }
            store4bf(XN + (size_t)m * D + col, o); }
        float lg[16];
#pragma unroll
        for (int e = 0; e < 16; ++e) { float x = 0.f;
#pragma unroll
            for (int j = 0; j < 4; ++j) { const f32x4 r4 = *(const LAS3 f32x4*)(rwT + e * D + l4 + 256 * j); x += (v[4 * j] * r4[0] + v[4 * j + 1] * r4[1]) + (v[4 * j + 2] * r4[2] + v[4 * j + 3] * r4[3]); }
            lg[e] = x;
            if ((e & 3) == 3) __builtin_amdgcn_sched_barrier(0); }
        float r8[8], r4v[4], r2[2], r1;
        { const bool b5 = (c.lane & 32) != 0, b4 = (c.lane & 16) != 0, b3 = (c.lane & 8) != 0, b2 = (c.lane & 4) != 0;
#pragma unroll
          for (int i = 0; i < 8; ++i) { const float snd = b5 ? lg[i] : lg[i + 8], kp = b5 ? lg[i + 8] : lg[i]; r8[i] = kp + __shfl_xor(snd, 32); }
#pragma unroll
          for (int i = 0; i < 4; ++i) { const float snd = b4 ? r8[i] : r8[i + 4], kp = b4 ? r8[i + 4] : r8[i]; r4v[i] = kp + __shfl_xor(snd, 16); }
#pragma unroll
          for (int i = 0; i < 2; ++i) { const float snd = b3 ? r4v[i] : r4v[i + 2], kp = b3 ? r4v[i + 2] : r4v[i]; r2[i] = kp + __shfl_xor(snd, 8); }
          { const float snd = b2 ? r2[0] : r2[1], kp = b2 ? r2[1] : r2[0]; r1 = kp + __shfl_xor(snd, 4); }
          r1 += __shfl_xor(r1, 2); r1 += __shfl_xor(r1, 1); }
        float sc[16], sel[16];
#pragma unroll
        for (int e = 0; e < 16; ++e) { const float lgt = __shfl(r1, 4 * e); sc[e] = __builtin_amdgcn_rcpf(1.0f + __expf(-lgt)); sel[e] = sc[e] + rb[e]; }
        int best = 0; float bestv = -INFINITY;
#pragma unroll
        for (int g = 0; g < 4; ++g) { float m1 = -INFINITY, m2 = -INFINITY;
#pragma unroll
            for (int q = 0; q < 4; ++q) { const float sv = sel[4 * g + q]; if (sv > m1) { m2 = m1; m1 = sv; } else if (sv > m2) m2 = sv; }
            const float gs = m1 + m2; if (gs > bestv) { bestv = gs; best = g; } }
        int i1 = 0, i2 = 0; float s1 = -INFINITY, s2 = -INFINITY, w1 = 0.f, w2 = 0.f;
#pragma unroll
        for (int e = 0; e < 16; ++e) { if ((e >> 2) == best) { const float sv = sel[e];
                if (sv > s1) { s2 = s1; i2 = i1; w2 = w1; s1 = sv; i1 = e; w1 = sc[e]; } else if (sv > s2) { s2 = sv; i2 = e; w2 = sc[e]; } } }
        if (c.lane == 0) { const float ws = w1 + w2;
            TOKI[2 * m] = i1; TOKI[2 * m + 1] = i2; TOKW[2 * m] = w1 / ws; TOKW[2 * m + 1] = w2 / ws;
            TOKP[2 * m] = (int)atomicAdd(&lcnt[i1], 1u); TOKP[2 * m + 1] = (int)atomicAdd(&lcnt[i2], 1u); }
    }
    __syncthreads();
    if (c.tid < NE) ((int*)(a.ws + WS_BLKCNT))[blockIdx.x * NE + c.tid] = (int)lcnt[c.tid];
    __syncthreads();
    }
}

__device__ __forceinline__ void expert_convert(ArgsR a, const Ctx& c, int l, int b0) {
    if ((int)blockIdx.x < b0) return;
    float* scr = (float*)(c.lds + c.wave * 8704);
    bf16* WGU = (bf16*)(a.ws + WS_WGU); bf16* WD = (bf16*)(a.ws + WS_WD);
    constexpr int IG = (D / 64) * (FF / 32);
    constexpr int ID = (FF / 64) * (D / 32);
    const int gw0 = ((int)blockIdx.x - b0) * NWAVES + c.wave, ngw0 = ((int)gridDim.x - b0) * NWAVES;
    for (int it = gw0; it < NE * (2 * IG + ID); it += ngw0) {
        const int e = it / (2 * IG + ID); int r = it % (2 * IG + ID);
        const size_t eo = ((size_t)l * NE + e) * (size_t)D * FF;
        if (r < IG) { transpose_matrix_item(a.in[I_EG] + eo, D, FF, WGU + (size_t)e * 1024 * 1024, r, scr, c.lane, RowGU{0}); continue; } r -= IG;
        if (r < IG) { transpose_matrix_item(a.in[I_EU] + eo, D, FF, WGU + (size_t)e * 1024 * 1024, r, scr, c.lane, RowGU{1}); continue; } r -= IG;
        transpose_matrix_item(a.in[I_ED] + eo, FF, D, WD + (size_t)e * 1024 * 512, r, scr, c.lane, RowId());
    }
}

__device__ __forceinline__ void phase_perm(ArgsR a, const Ctx& c, int l) {
    const int* BLKCNT = (const int*)(a.ws + WS_BLKCNT);
    LAS3 int* pre = (LAS3 int*)c.lds;
    LAS3 int* tot = pre + 256 * NE;
    const int nb = gridDim.x;
#pragma unroll
    for (int q = 0; q < 2; ++q) { const int e = 2 * c.wave + q; int v[4]; int sum = 0;
#pragma unroll
        for (int i = 0; i < 4; ++i) { const int b = 4 * c.lane + i; v[i] = b < nb ? BLKCNT[b * NE + e] : 0; sum += v[i]; }
        int inc = sum;
#pragma unroll
        for (int o = 1; o < 64; o <<= 1) { const int t = __shfl_up(inc, o); if (c.lane >= o) inc += t; }
        int run = inc - sum;
#pragma unroll
        for (int i = 0; i < 4; ++i) { pre[(4 * c.lane + i) * NE + e] = run; run += v[i]; }
        if (c.lane == 63) tot[e] = inc; }
    __syncthreads();
    int ts[17]; { int sacc = 0;
#pragma unroll
        for (int e = 0; e < 16; ++e) { ts[e] = sacc; sacc += (tot[e] + 255) >> 8; } ts[16] = sacc; }
    if (blockIdx.x == 0 && c.tid < NE) ((int*)(a.ws + WS_TOT))[c.tid] = tot[c.tid];
    const int* TOKI = (const int*)(a.ws + WS_TOKI); const int* TOKP = (const int*)(a.ws + WS_TOKP); int* S2T = (int*)(a.ws + WS_S2T);
    const bf16* XN = (const bf16*)(a.ws + WS_XN); bf16* XS = (bf16*)(a.ws + WS_XS);
    for (int as = c.gw; as < 2 * T; as += c.ngw) {
        const int e = TOKI[as]; int base = 0;
#pragma unroll
        for (int j = 0; j < 16; ++j) base = (j == e) ? ts[j] : base;
        const int m = as >> 1, blk = (m % c.ngw) >> 3;
        const int slot = base * 256 + pre[blk * NE + e] + TOKP[as];
        if (c.lane == 0) S2T[slot] = as;
        const u32x4* src = (const u32x4*)(XN + (size_t)m * D); u32x4* dst = (u32x4*)(XS + (size_t)slot * D);
        dst[c.lane] = src[c.lane]; dst[64 + c.lane] = src[64 + c.lane];
    }
    for (int e = 0; e < 16; ++e) {
        int tse = 0, tsn = 0;
#pragma unroll
        for (int j = 0; j < 16; ++j) { tse = (j == e) ? ts[j] : tse; tsn = (j == e) ? ts[j + 1] : tsn; }
        const int lo = tse * 256 + tot[e], hi = tsn * 256;
        for (int sl = lo + c.gw; sl < hi; sl += c.ngw) { if (c.lane == 0) S2T[sl] = -1; u32x4* dst = (u32x4*)(XS + (size_t)sl * D); const u32x4 zz = {0u, 0u, 0u, 0u}; dst[c.lane] = zz; dst[64 + c.lane] = zz; }
    }
    __syncthreads();
}

__device__ __forceinline__ void phase_ln2(ArgsR a, const Ctx& c, int l, float* outw) {
    const float* MODF = (const float*)(a.ws + WS_MODF) + l * 6144;
    const float* g2 = a.in[I_LN2G] + l * D; const float* b2 = a.in[I_LN2B] + l * D;
    const bf16* Y = (const bf16*)(a.ws + WS_Y); bf16* XN = (bf16*)(a.ws + WS_XN);
    float vn[16]; u32x2 y0n[4], y1n[4];
    if (c.gw < T) { load_row16(a.out + (size_t)c.gw * D, c.lane, vn);
#pragma unroll
        for (int j = 0; j < 4; ++j) { y0n[j] = *(const u32x2*)(Y + (size_t)(2 * c.gw) * D + 4 * c.lane + 256 * j); y1n[j] = *(const u32x2*)(Y + (size_t)(2 * c.gw + 1) * D + 4 * c.lane + 256 * j); } }
    for (int m = c.gw; m < T; m += c.ngw) {
        float v[16]; u32x2 y0[4], y1[4];
#pragma unroll
        for (int j = 0; j < 16; ++j) v[j] = vn[j];
#pragma unroll
        for (int j = 0; j < 4; ++j) { y0[j] = y0n[j]; y1[j] = y1n[j]; }
        if (m + c.ngw < T) { const int mn = m + c.ngw; load_row16(a.out + (size_t)mn * D, c.lane, vn);
#pragma unroll
            for (int j = 0; j < 4; ++j) { y0n[j] = *(const u32x2*)(Y + (size_t)(2 * mn) * D + 4 * c.lane + 256 * j); y1n[j] = *(const u32x2*)(Y + (size_t)(2 * mn + 1) * D + 4 * c.lane + 256 * j); } }
#pragma unroll
        for (int j = 0; j < 4; ++j) { const int col = 4 * c.lane + 256 * j;
            const float a0 = __uint_as_float(y0[j].x << 16) + __uint_as_float(y1[j].x << 16), a1 = __uint_as_float(y0[j].x & 0xffff0000u) + __uint_as_float(y1[j].x & 0xffff0000u);
            const float a2 = __uint_as_float(y0[j].y << 16) + __uint_as_float(y1[j].y << 16), a3 = __uint_as_float(y0[j].y & 0xffff0000u) + __uint_as_float(y1[j].y & 0xffff0000u);
            const f32x4 gt = *(const f32x4*)(MODF + 5120 + col);
            v[4 * j] = ALPHA * v[4 * j] + (1.0f + gt[0]) * a0; v[4 * j + 1] = ALPHA * v[4 * j + 1] + (1.0f + gt[1]) * a1; v[4 * j + 2] = ALPHA * v[4 * j + 2] + (1.0f + gt[2]) * a2; v[4 * j + 3] = ALPHA * v[4 * j + 3] + (1.0f + gt[3]) * a3; }
        float mean, rstd; row_stats(v, mean, rstd);
#pragma unroll
        for (int j = 0; j < 4; ++j) { f32x4 o; const int col = 4 * c.lane + 256 * j;
#pragma unroll
            for (int e = 0; e < 4; ++e) { v[4 * j + e] = (v[4 * j + e] - mean) * rstd * g2[col + e] + b2[col + e]; o[e] = v[4 * j + e]; }
            *(f32x4*)(outw + (size_t)m * D + col) = o; }
        if (l + 1 < DEPTH) {
            const float* MN = MODF + 6144;
            row_stats(v, mean, rstd);
#pragma unroll
            for (int j = 0; j < 4; ++j) { f32x4 o; const int col = 4 * c.lane + 256 * j;
#pragma unroll
                for (int e = 0; e < 4; ++e) o[e] = (v[4 * j + e] - mean) * rstd * (1.0f + MN[1024 + col + e]) + MN[col + e];
                store4bf(XN + (size_t)m * D + col, o); }
        }
    }
}


template <class F> struct EpiAdapt {
    static constexpr bool PERM = true, AFTER_DRAIN = false; F f;
    __device__ __forceinline__ void operator()(const f32x4 (&acc)[2][2][4][2], const Unit& u, int wr, int wc, int fr, int fq) const {
        const int col = u.pn * 256 + wc * 32 + 8 * fq;
#pragma unroll
        for (int ai = 0; ai < 2; ++ai)
#pragma unroll
            for (int m = 0; m < 4; ++m) { const int row = u.pm * 256 + ai * 128 + wr * 64 + m * 16 + fr; f(row, col, acc[ai][0][m][0], acc[ai][0][m][1], acc[ai][1][m][0], acc[ai][1][m][1]); }
    }
};

template <class Sched, class F>
__device__ __forceinline__ void gemm_any(const Ctx& c, const bf16* A, const bf16* Bt, int M, int N, int K, const Sched& S, const F& f) {
    pg8::Gemm g{A, Bt, M, N, K}; EpiAdapt<F> E{f};
    pg8::gemm_phase<EpiAdapt<F>, Sched, true, true>((PG8_LAS unsigned char*)c.lds, g, S, E, c.tid);
}

#define LAS __attribute__((address_space(3)))
#define XB_TMO      128
#define XB_XCNT(j)  (256  + 64 * (j))
#define XB_XSUB(j)  (1280 + 64 * (j))
#define XB_XGEN(j)  (2304 + 64 * (j))
#define XB_TOP      3328
#define XB_TOPGEN   3392
#define XCD_BAR_WORDS 3456
#define XB_SPIN_CAP (1u << 24)

__device__ __forceinline__ unsigned xb_ld(unsigned* p)              { return __hip_atomic_load(p, __ATOMIC_RELAXED, __HIP_MEMORY_SCOPE_AGENT); }
__device__ __forceinline__ unsigned xb_add(unsigned* p, unsigned v) { return __hip_atomic_fetch_add(p, v, __ATOMIC_RELAXED, __HIP_MEMORY_SCOPE_AGENT); }
__device__ __forceinline__ unsigned xb_xcc_id() { return (unsigned)__builtin_amdgcn_s_getreg((3 << 11) | 20) & 0xFu; }
#define XB_SPIN(cond, bar) do { unsigned _sp = 0; while (cond) { __builtin_amdgcn_s_sleep(1); \
    if ((++_sp & 255u) == 0u) { if (xb_ld(&(bar)[XB_TMO])) break; if (_sp > XB_SPIN_CAP) { atomicAdd(&(bar)[XB_TMO], 1u); break; } } } } while (0)

struct XcdBarrier {
    unsigned* bar; unsigned x;
    volatile LAS unsigned* st;
};

__device__ __forceinline__ XcdBarrier xcd_barrier_post(unsigned* bar, volatile LAS unsigned* st) {
    XcdBarrier b; b.bar = bar; b.x = xb_xcc_id(); b.st = st;
    if (threadIdx.x == 0) (void)xb_add(&bar[XB_XCNT(b.x)], 1u);
    return b;
}
__device__ __forceinline__ void xcd_barrier_complete(unsigned* bar, unsigned x, unsigned& nloc, unsigned& nx) {
    const unsigned G = gridDim.x * gridDim.y * gridDim.z;
    unsigned sum, cnt, mine, sp = 0u;
    for (;;) {
        sum = 0u; cnt = 0u; mine = 0u;
#pragma unroll
        for (unsigned j = 0; j < 16; ++j) { const unsigned c = xb_ld(&bar[XB_XCNT(j)]); sum += c; cnt += (c > 0u) ? 1u : 0u; mine = (j == x) ? c : mine; }
        if (sum == G) break;
        __builtin_amdgcn_s_sleep(1);
        if ((++sp & 255u) == 0u) { if (xb_ld(&bar[XB_TMO])) break; if (sp > XB_SPIN_CAP) { atomicAdd(&bar[XB_TMO], 1u); break; } }
    }
    nloc = mine > 0u ? mine : 1u; nx = cnt > 0u ? cnt : 1u;
}

__device__ __forceinline__ void xcd_barrier(const XcdBarrier& b) {
    asm volatile("s_waitcnt vmcnt(0)" ::: "memory");
    __syncthreads();
    if (threadIdx.x == 0) {
        unsigned* bar = b.bar;
        __builtin_amdgcn_s_waitcnt(0);
        unsigned nloc = b.st[0], nx = b.st[1];
        if (nloc == 0u) { xcd_barrier_complete(bar, b.x, nloc, nx); b.st[0] = nloc; b.st[1] = nx; }
        const unsigned old = xb_add(&bar[XB_XSUB(b.x)], 1u);
        const unsigned gen = old / nloc;
        if (old + 1u == (gen + 1u) * nloc) {
            __builtin_amdgcn_fence(__ATOMIC_RELEASE, "agent");
            asm volatile("s_waitcnt vmcnt(0)" ::: "memory");
            const unsigned og = xb_add(&bar[XB_TOP], 1u);
            const unsigned tg = og / nx;
            if (og + 1u == (tg + 1u) * nx) xb_add(&bar[XB_TOPGEN], 1u);
            else XB_SPIN(xb_ld(&bar[XB_TOPGEN]) == tg, bar);
            __builtin_amdgcn_fence(__ATOMIC_ACQUIRE, "agent");
            xb_add(&bar[XB_XGEN(b.x)], 1u);
            asm volatile("s_waitcnt vmcnt(0)" ::: "memory");
        } else {
            XB_SPIN(xb_ld(&bar[XB_XGEN(b.x)]) == gen, bar);
            __builtin_amdgcn_fence(__ATOMIC_ACQUIRE, "agent");
            asm volatile("s_waitcnt vmcnt(0)" ::: "memory");
        }
    }
    __syncthreads();
}


constexpr int PH_PER_LAYER = 12, N_PHASES = 2 + PH_PER_LAYER * DEPTH;
constexpr int CW_BAR = 4096;
constexpr int LDS_BYTES = 147456, LDSCTL_OFF = 131072 + 8192;
#ifndef SINGLE_LAUNCH
#define SINGLE_LAUNCH 1
#endif

#ifndef PROBE_A
#define PROBE_A -1
#endif
#ifndef PROBE_B
#define PROBE_B -1
#endif
constexpr size_t WS_TS = 512 * 1024;
#if PROBE_A >= 0
#define STAMP(i) do { if (blockIdx.x == 0 && threadIdx.x == 0) ((unsigned long long*)(args_here()->ws + WS_TS))[(i)] = __builtin_amdgcn_s_memrealtime(); } while (0)
#else
#define STAMP(i) do { } while (0)
#endif
__device__ __forceinline__ const __attribute__((address_space(4))) Args* args_here() { const __attribute__((address_space(4))) Args* p = (const __attribute__((address_space(4))) Args*)__builtin_amdgcn_kernarg_segment_ptr(); asm volatile("" : "+s"(p)); return p; }
#ifndef REP_K
#define REP_K -1
#endif
__device__ __forceinline__ Ctx mkctx(int wave_s, unsigned char* lds) { Ctx c; c.wave = wave_s; c.lane = (int)__builtin_amdgcn_mbcnt_hi(~0u, __builtin_amdgcn_mbcnt_lo(~0u, 0u)); c.tid = wave_s * 64 + c.lane;
    c.gw = blockIdx.x * NWAVES + wave_s; c.ngw = gridDim.x * NWAVES; c.lds = lds; return c; }
#define PHASE1(k, ...) do { const __attribute__((address_space(4))) Args* ap_ = args_here(); if (ap_->ph_lo <= (k) && (k) < ap_->ph_hi) { ArgsR a = *ap_; const Ctx c = mkctx(wave_s, lds); __VA_ARGS__ } } while (0)
#define PHASE(k, ...) do { PHASE1(k, __VA_ARGS__); if ((k) == REP_K) { xcd_barrier(bar); PHASE1(k, __VA_ARGS__); xcd_barrier(bar); PHASE1(k, __VA_ARGS__); } } while (0)

template <int L>
__device__ __forceinline__ void run_layer(const int wave_s, unsigned char* lds, const XcdBarrier& bar) {
    const int G = gridDim.x, b = blockIdx.x;
#define BAR() do { xcd_barrier(bar); STAMP(3 + 14 * L + (bk_++)); } while (0)
    int bk_ = 0;
    PHASE(0, unsigned char* ws = a.ws; pg8::StaticOrder S; S.init(T, INC, G, b); EpiZ E{(bf16*)(ws + WS_ZR), (bf16*)(ws + WS_ZS), (bf16*)(ws + WS_ZG)};
        gemm_any(c, (const bf16*)(ws + WS_XN), (const bf16*)(ws + WS_WIN + (size_t)L * 10 * MiB), T, INC, D, S, E); );
    BAR();
    PHASE(1, phase_prep_fast(a, c, L); );
    PHASE(14, phase_sg_fast(a, c, L); );
    BAR();
#if REP_K == 21
    PHASE1(2, phase_scan1m(a, c, 1); ); xcd_barrier(bar); PHASE1(2, phase_scan1m(a, c, 1); ); xcd_barrier(bar);
#endif
    PHASE(2, phase_scan1m(a, c); );
    BAR();
    PHASE(3, phase_scan2a(a, c); );
    BAR();
    PHASE(31, phase_scan2b(a, c); );
    PHASE(33, expert_convert(a, c, L, NH); );
    BAR();
    PHASE(32, phase_scan2c(a, c); );
    BAR();
    PHASE(4, phase_scan3m(a, c, L); );
    BAR();
    PHASE(6, unsigned char* ws = a.ws; pg8::StaticOrder S; S.init(T, D, G, b); EpiGA E{(const bf16*)(ws + WS_ZG), (bf16*)(ws + WS_MP)};
        gemm_any(c, (const bf16*)(ws + WS_YA), (const bf16*)(ws + WS_WA + (size_t)L * WS_WL1), T, D, W, S, E); );
    BAR();
#if REP_K == 7
    PHASE1(7, unsigned char* ws = a.ws; pg8::StaticOrder S; S.init(T, D, G, b); EpiGB E{(const bf16*)(ws + WS_ZG), (const bf16*)(ws + WS_MP), (bf16*)(ws + WS_ZR)};
        gemm_any(c, (const bf16*)(ws + WS_YB), (const bf16*)(ws + WS_WB + (size_t)L * WS_WL1), T, D, W, S, E); ); xcd_barrier(bar);
    PHASE1(7, unsigned char* ws = a.ws; pg8::StaticOrder S; S.init(T, D, G, b); EpiGB E{(const bf16*)(ws + WS_ZG), (const bf16*)(ws + WS_MP), (bf16*)(ws + WS_ZR)};
        gemm_any(c, (const bf16*)(ws + WS_YB), (const bf16*)(ws + WS_WB + (size_t)L * WS_WL1), T, D, W, S, E); ); xcd_barrier(bar);
#endif
#if REP_K == 8
    PHASE1(8, unsigned char* ws = a.ws; pg8::StaticOrder S; S.init(T, D, G, b); EpiOut E{L == 0 ? a.in[I_X] : a.out, (float*)(ws + WS_R), (const float*)(ws + WS_MODF) + L * 6144 + 2048};
        gemm_any(c, (const bf16*)(ws + WS_MP), (const bf16*)(ws + WS_WO + (size_t)L * WS_WL1), T, D, D, S, E); ); xcd_barrier(bar);
    PHASE1(8, unsigned char* ws = a.ws; pg8::StaticOrder S; S.init(T, D, G, b); EpiOut E{L == 0 ? a.in[I_X] : a.out, (float*)(ws + WS_R), (const float*)(ws + WS_MODF) + L * 6144 + 2048};
        gemm_any(c, (const bf16*)(ws + WS_MP), (const bf16*)(ws + WS_WO + (size_t)L * WS_WL1), T, D, D, S, E); ); xcd_barrier(bar);
#endif
    PHASE1(7, unsigned char* ws = a.ws; pg8::StaticOrder S; S.init(T, D, G, b); EpiGB E{(const bf16*)(ws + WS_ZG), (const bf16*)(ws + WS_MP), (bf16*)(ws + WS_MP)};
        gemm_any(c, (const bf16*)(ws + WS_YB), (const bf16*)(ws + WS_WB + (size_t)L * WS_WL1), T, D, W, S, E); );
    BAR();
    PHASE1(8, unsigned char* ws = a.ws; pg8::StaticOrder S; S.init(T, D, G, b); EpiOut E{L == 0 ? a.in[I_X] : a.out, a.out, (const float*)(ws + WS_MODF) + L * 6144 + 2048};
        gemm_any(c, (const bf16*)(ws + WS_MP), (const bf16*)(ws + WS_WO + (size_t)L * WS_WL1), T, D, D, S, E); );
    BAR();
#if REP_K == 9
    PHASE1(9, phase_ln1(a, c, L, (float*)(a.ws + WS_ZR)); ); xcd_barrier(bar); PHASE1(9, phase_ln1(a, c, L, (float*)(a.ws + WS_ZR)); ); xcd_barrier(bar);
#endif
#if REP_K == 91
    PHASE1(9, phase_ln1(a, c, L, (float*)(a.ws + WS_ZR), 1); ); xcd_barrier(bar); PHASE1(9, phase_ln1(a, c, L, (float*)(a.ws + WS_ZR), 1); ); xcd_barrier(bar);
#endif
#if REP_K == 92
    PHASE1(9, phase_ln1(a, c, L, (float*)(a.ws + WS_ZR), 2); ); xcd_barrier(bar); PHASE1(9, phase_ln1(a, c, L, (float*)(a.ws + WS_ZR), 2); ); xcd_barrier(bar);
#endif
    PHASE1(9, phase_ln1(a, c, L, a.out); );
    BAR();
    PHASE(10, phase_perm(a, c, L); );
    BAR();
    PHASE(11, unsigned char* ws = a.ws; MoeSched S; S.init((const unsigned*)(ws + WS_TOT), G, b); EpiSwi E{(bf16*)(ws + WS_HID)};
        gemm_any(c, (const bf16*)(ws + WS_XS), (const bf16*)(ws + WS_WGU), MAXSLOT, NE * 1024, D, S, E); );
    BAR();
    PHASE(12, unsigned char* ws = a.ws; MoeSched S; S.init((const unsigned*)(ws + WS_TOT), G, b); EpiDown E{(const int*)(ws + WS_S2T), (const float*)(ws + WS_TOKW), (bf16*)(ws + WS_Y)};
        gemm_any(c, (const bf16*)(ws + WS_HID), (const bf16*)(ws + WS_WD), MAXSLOT, NE * 1024, FF, S, E); );
    BAR();
#if REP_K == 13
    PHASE1(13, phase_ln2(a, c, L, (float*)(a.ws + WS_R)); ); xcd_barrier(bar); PHASE1(13, phase_ln2(a, c, L, (float*)(a.ws + WS_R)); ); xcd_barrier(bar);
#endif
    PHASE1(13, phase_ln2(a, c, L, a.out); );
    if (L + 1 < DEPTH) BAR();
    (void)bk_;
#undef BAR
}

__global__ void __launch_bounds__(NTHREADS, 2) mk_fwd(Args a_unused) {
    extern __shared__ __attribute__((aligned(16))) unsigned char lds[];
    const int wave_s = __builtin_amdgcn_readfirstlane(threadIdx.x >> 6);
    for (int u = threadIdx.x; u < (LDS_BYTES - LDSCTL_OFF) / 4; u += NTHREADS) ((LAS unsigned*)((LAS unsigned char*)lds + LDSCTL_OFF))[u] = 0u;
    __syncthreads();
    const XcdBarrier bar = xcd_barrier_post((unsigned*)(args_here()->ws + WS_CTL) + CW_BAR, (volatile LAS unsigned*)((LAS unsigned char*)lds + LDSCTL_OFF) + 8);
    STAMP(0);
    PHASE(100, phase_p0a(a, c); );
    xcd_barrier(bar); STAMP(1);
    PHASE(101, phase_p0b(a, c); );
    xcd_barrier(bar); STAMP(2);
    run_layer<0>(wave_s, lds, bar);
    run_layer<1>(wave_s, lds, bar);
#if PROBE_A >= 0
    if (blockIdx.x == 0) {
        asm volatile("s_waitcnt vmcnt(0)" ::: "memory"); __syncthreads();
        if (threadIdx.x == 0) ((unsigned long long*)(args_here()->ws + WS_TS))[30] = __builtin_amdgcn_s_memrealtime();
        asm volatile("s_waitcnt vmcnt(0)" ::: "memory"); __syncthreads();
        const volatile unsigned long long* ts = (const volatile unsigned long long*)(args_here()->ws + WS_TS);
        float da = 0.f, db = 0.f;
        if (PROBE_A < 14) { da = (float)(ts[3 + PROBE_A] - ts[2 + PROBE_A]) + (float)(ts[17 + PROBE_A] - ts[16 + PROBE_A]); } else if (PROBE_A == 14) da = (float)(ts[1] - ts[0]); else if (PROBE_A == 15) da = (float)(ts[2] - ts[1]); else da = (float)(ts[30] - ts[0]);
        if (PROBE_B >= 0 && PROBE_B < 14) { db = (float)(ts[3 + PROBE_B] - ts[2 + PROBE_B]) + (float)(ts[17 + PROBE_B] - ts[16 + PROBE_B]); } else if (PROBE_B == 14) db = (float)(ts[1] - ts[0]); else if (PROBE_B == 15) db = (float)(ts[2] - ts[1]);
        da *= 0.01f; db *= 0.01f;
        da = exp2f(0.25f * rintf(4.0f * log2f(fmaxf(da, 0.5f)))); db = exp2f(0.25f * rintf(4.0f * log2f(fmaxf(db, 0.5f))));
        float* out = args_here()->out;
        for (int i = threadIdx.x; i < 16 * 1024; i += NTHREADS) { const int r = i >> 10, col = i & 1023; const int rowi = (r & 7) + 2048 * (r >> 3); out[(size_t)rowi * D + col] = da; }
        if (threadIdx.x == 0 && PROBE_B >= 0) out[(size_t)4096 * D] = 100.0f * db;
    }
#endif
}

extern "C" void kernel_launch(void* const* d_in, const int* in_sizes, int n_in, void* d_out, int out_size, void* d_ws, size_t ws_size, hipStream_t stream) {
    static int grid = 0;
    if (grid == 0) {
        if (n_in != N_IN || out_size != T * D || ws_size < WS_END2) { fprintf(stderr, "kernel_launch: unexpected shapes: n_in %d out %d ws %zu (need %zu)\n", n_in, out_size, ws_size, (size_t)WS_END2); grid = -1; return; }
        int dev = 0, cus = 0;
        (void)hipGetDevice(&dev); (void)hipDeviceGetAttribute(&cus, hipDeviceAttributeMultiprocessorCount, dev);
        if (hipFuncSetAttribute((const void*)mk_fwd, hipFuncAttributeMaxDynamicSharedMemorySize, LDS_BYTES) != hipSuccess) { fprintf(stderr, "kernel_launch: hipFuncSetAttribute failed\n"); grid = -1; return; }
        grid = cus > 0 ? cus : 256;
        fprintf(stderr, "kernel_launch: ws_size %zu grid %d\n", ws_size, grid);
    }
    if (grid < 0) return;
    (void)hipMemsetAsync((char*)d_ws + WS_CTL, 0, CTL_BYTES, stream);
    Args a{};
    for (int i = 0; i < N_IN; ++i) a.in[i] = (const float*)d_in[i];
    a.out = (float*)d_out; a.ws = (unsigned char*)d_ws;
    a.ph_lo = 0; a.ph_hi = 1000;
    hipLaunchKernelGGL(mk_fwd, dim3(grid), dim3(NTHREADS), LDS_BYTES, stream, a);
}
```

```cpp
#include <hip/hip_runtime.h>
#include <cstdio>
#include <cstdint>
#include <utility>

typedef unsigned short bf16;
typedef _Float16 f16;
typedef float f32x4 __attribute__((ext_vector_type(4)));
typedef unsigned u32x4 __attribute__((ext_vector_type(4)));
typedef unsigned u32x2 __attribute__((ext_vector_type(2)));

constexpr int T = 16384, D = 1024, W = 512, NH = 8, HN = 64, RC = 1792, INC = 4864;
constexpr int NE = 16, FF = 512, DEPTH = 2;
constexpr float LN_EPS = 1e-5f, GN_EPS = 64e-5f, ALPHA = 1.41421356237f;
constexpr int NTHREADS = 512, NWAVES = 8;
constexpr int MAXSLOT = 36864;

constexpr size_t MiB = 1u << 20;
constexpr size_t WS_CTL = 0, CTL_BYTES = 1 * MiB;
constexpr int CW_CNT = 16384;
constexpr size_t WS_PART = 1 * MiB;
constexpr size_t WS_MODF = 2 * MiB;
constexpr size_t WS_TOKI = 2 * MiB + 65536;
constexpr size_t WS_TOKW = WS_TOKI + 131072;
constexpr size_t WS_TOKP = WS_TOKW + 131072;
constexpr size_t WS_S2T = 3 * MiB;
constexpr size_t WS_BLKCNT = 3 * MiB + 512 * 1024;
constexpr size_t WS_TOT = WS_BLKCNT + 32768;
constexpr size_t WS_LORA = 4 * MiB;
constexpr size_t WS_WIN = 8 * MiB;
constexpr size_t WS_WA = 28 * MiB, WS_WB = 29 * MiB, WS_WO = 30 * MiB, WS_WL1 = 4 * MiB;
constexpr size_t WS_ZG = 36 * MiB;
constexpr size_t WS_XN = 100 * MiB;
constexpr size_t WS_G = 100 * MiB, WS_YB = 116 * MiB;
constexpr size_t WS_ZR = 132 * MiB;
constexpr size_t WS_ZS = 188 * MiB;
constexpr size_t WS_YSC = 132 * MiB;
constexpr size_t WS_ST = 148 * MiB;
constexpr size_t WS_YA = 132 * MiB;
constexpr size_t WS_MP = 164 * MiB;
constexpr size_t WS_XS = 132 * MiB;
constexpr size_t WS_Y = 132 * MiB;
constexpr size_t WS_AA = 224 * MiB, WS_BB = 240 * MiB, WS_WM1 = 256 * MiB, WS_R = 272 * MiB, WS_KP = 288 * MiB, WS_V = 304 * MiB;
constexpr size_t WS_WGU = 224 * MiB;
constexpr size_t WS_WD = 256 * MiB;
constexpr size_t WS_HID = 272 * MiB;
constexpr size_t WS_VF = 320 * MiB;
constexpr size_t WS_END = 336 * MiB;

constexpr size_t LO_W2T = 0, LO_A2T = 65536, LO_G2T = 131072, LO_VM1T = 262144, LO_VM2T = 294912, LO_STRIDE = 524288;

enum { I_X = 0, I_C, I_WMOD, I_BMOD, I_WIN, I_MU, I_W0, I_W2, I_A0, I_A2, I_G2, I_KK, I_KA, I_RK, I_GNG, I_GNB, I_VM0, I_VM1, I_VM2,
       I_SGG, I_SGB, I_WS, I_BS, I_WBA, I_WBB, I_WOUT, I_LN1G, I_LN1B, I_RW, I_RB, I_EG, I_EU, I_ED, I_LN2G, I_LN2B, N_IN };

struct Args { const float* in[N_IN]; float* out; unsigned char* ws; int ph_lo, ph_hi; };
typedef const __attribute__((address_space(4))) Args& ArgsR;

__device__ __forceinline__ float bf2f(bf16 h) { return __uint_as_float(((unsigned)h) << 16); }
__device__ __forceinline__ unsigned f2bfu(float f) { unsigned u = __float_as_uint(f); return (u + 0x7fffu + ((u >> 16) & 1u)) >> 16; }
__device__ __forceinline__ bf16 f2bf(float f) { return __builtin_bit_cast(unsigned short, (__bf16)f); }
typedef __bf16 bf16x2_t __attribute__((ext_vector_type(2)));
__device__ __forceinline__ unsigned pk2(float lo, float hi) { bf16x2_t v; v[0] = (__bf16)lo; v[1] = (__bf16)hi; return __builtin_bit_cast(unsigned, v); }
__device__ __forceinline__ void store4bf(bf16* p, f32x4 v) { u32x2 w; w.x = pk2(v[0], v[1]); w.y = pk2(v[2], v[3]); *(u32x2*)p = w; }
__device__ __forceinline__ f32x4 load4bf(const bf16* p) { u32x2 w = *(const u32x2*)p; f32x4 r; r[0] = __uint_as_float(w.x << 16); r[1] = __uint_as_float(w.x & 0xffff0000u); r[2] = __uint_as_float(w.y << 16); r[3] = __uint_as_float(w.y & 0xffff0000u); return r; }
__device__ __forceinline__ float wave_sum(float v) {
#pragma unroll
    for (int o = 1; o < 64; o <<= 1) v += __shfl_xor(v, o);
    return v;
}
__device__ __forceinline__ float sigmoidf_(float x) { return __builtin_amdgcn_rcpf(1.0f + __expf(-x)); }
__device__ __forceinline__ float siluf_(float x) { return x * sigmoidf_(x); }
__device__ __forceinline__ float gelu_tanh(float x) { const float u = 0.7978845608028654f * (x + 0.044715f * x * x * x); return x * (1.0f - __builtin_amdgcn_rcpf(1.0f + __expf(2.0f * u))); }
__device__ __forceinline__ float softplusf_(float y) { return fmaxf(y, 0.f) + log1pf(__expf(-fabsf(y))); }

struct Ctx { int tid, lane, wave, gw, ngw; unsigned char* lds; };

__device__ __forceinline__ void transpose_item(const float* Wsrc, int N, int k0, int n0, bf16* dst, int ldk, float* scr, int lane) {
    float tv[32];
#pragma unroll
    for (int i = 0; i < 32; ++i) tv[i] = Wsrc[(size_t)(k0 + 2 * i + (lane >> 5)) * N + n0 + (lane & 31)];
#pragma unroll
    for (int i = 0; i < 32; ++i) scr[(2 * i + (lane >> 5)) * 33 + (lane & 31)] = tv[i];
    asm volatile("s_waitcnt lgkmcnt(0)" ::: "memory");
    const int c = lane & 7;
#pragma unroll
    for (int j = 0; j < 4; ++j) { const int n = (lane >> 3) + 8 * j; const float* s = scr + (8 * c) * 33 + n;
        u32x4 o; o.x = pk2(s[0 * 33], s[1 * 33]); o.y = pk2(s[2 * 33], s[3 * 33]); o.z = pk2(s[4 * 33], s[5 * 33]); o.w = pk2(s[6 * 33], s[7 * 33]);
        *(u32x4*)(dst + (size_t)n * ldk + k0 + 8 * c) = o; }
    asm volatile("s_waitcnt lgkmcnt(0)" ::: "memory");
}
template <class RowMap>
__device__ __forceinline__ void transpose_matrix_item(const float* Wsrc, int K, int N, bf16* dst, int item, float* scr, int lane, const RowMap& rm) {
    const int nblk = N / 32, kb = item / nblk, nb = item % nblk, n0 = 32 * nb;
    transpose_item(Wsrc, N, 64 * kb, n0, dst + (size_t)rm(n0) * K, K, scr, lane);
}
struct RowId { __device__ __forceinline__ int operator()(int n) const { return n; } };
struct RowGU { int up; __device__ __forceinline__ int operator()(int n) const { return (n >> 7) * 256 + (n & 127) + up * 128; } };

__device__ __forceinline__ void phase_p0a(ArgsR a, const Ctx& c) {
    float* scr = (float*)(c.lds + c.wave * 16384);
    { float* MODF = (float*)(a.ws + WS_MODF); float* red = (float*)(c.lds + 131072);
      for (int cbk = blockIdx.x; cbk < 2 * 96; cbk += gridDim.x) {
          const int l = cbk / 96, n = (cbk % 96) * 64 + c.lane;
          const float* wm = a.in[I_WMOD] + (size_t)l * D * 6144 + (size_t)(c.wave * 128) * 6144 + n;
          float acc0 = 0.f, acc1 = 0.f;
#pragma unroll 16
          for (int k = 0; k < 128; k += 2) { acc0 += siluf_(a.in[I_C][c.wave * 128 + k]) * wm[(size_t)k * 6144]; acc1 += siluf_(a.in[I_C][c.wave * 128 + k + 1]) * wm[(size_t)(k + 1) * 6144]; }
          red[c.wave * 64 + c.lane] = acc0 + acc1;
          __syncthreads();
          if (c.wave == 0) { float sacc = a.in[I_BMOD][l * 6144 + n];
#pragma unroll
              for (int w = 0; w < 8; ++w) sacc += red[w * 64 + c.lane];
              MODF[l * 6144 + n] = sacc; }
          __syncthreads();
      } }
    for (int it = c.gw; it < 2 * (16 + 16 + 32 + 8); it += c.ngw) {
        const int l = it / 72; int r = it % 72; unsigned char* lo = a.ws + WS_LORA + (size_t)l * LO_STRIDE;
        if (r < 16) { transpose_matrix_item(a.in[I_W2] + (size_t)l * 64 * W, 64, W, (bf16*)(lo + LO_W2T), r, scr, c.lane, RowId()); continue; } r -= 16;
        if (r < 16) { transpose_matrix_item(a.in[I_A2] + (size_t)l * 64 * W, 64, W, (bf16*)(lo + LO_A2T), r, scr, c.lane, RowId()); continue; } r -= 16;
        if (r < 32) { transpose_matrix_item(a.in[I_G2] + (size_t)l * 128 * W, 128, W, (bf16*)(lo + LO_G2T), r, scr, c.lane, RowId()); continue; } r -= 32;
        if (l == 1) transpose_matrix_item(a.in[I_VM1], W, 32, (bf16*)(lo + LO_VM1T), r, scr, c.lane, RowId());
    }
    for (int i = blockIdx.x * NTHREADS + c.tid; i < 32 * W; i += gridDim.x * NTHREADS) { const int n = i >> 5, k = i & 31;
        ((bf16*)(a.ws + WS_LORA + LO_STRIDE + LO_VM2T))[i] = f2bf(a.in[I_VM2][(size_t)k * W + n]); }
    constexpr int I_WINL = (D / 64) * (INC / 32);
    constexpr int I_WAL = (W / 64) * (D / 32);
    constexpr int I_WOL = (D / 64) * (D / 32);
    constexpr int PER_L = I_WINL + 2 * I_WAL + I_WOL;
    for (int it = c.gw; it < 2 * PER_L; it += c.ngw) {
        const int l = it / PER_L; int r = it % PER_L;
        if (r < I_WINL) { transpose_matrix_item(a.in[I_WIN] + (size_t)l * D * INC, D, INC, (bf16*)(a.ws + WS_WIN + (size_t)l * 10 * MiB), r, scr, c.lane, RowId()); continue; } r -= I_WINL;
        if (r < I_WAL) { transpose_matrix_item(a.in[I_WBA] + (size_t)l * W * D, W, D, (bf16*)(a.ws + WS_WA + (size_t)l * WS_WL1), r, scr, c.lane, RowId()); continue; } r -= I_WAL;
        if (r < I_WAL) { transpose_matrix_item(a.in[I_WBB] + (size_t)l * W * D, W, D, (bf16*)(a.ws + WS_WB + (size_t)l * WS_WL1), r, scr, c.lane, RowId()); continue; } r -= I_WAL;
        transpose_matrix_item(a.in[I_WOUT] + (size_t)l * D * D, D, D, (bf16*)(a.ws + WS_WO + (size_t)l * WS_WL1), r, scr, c.lane, RowId());
    }
}

__device__ __forceinline__ void row_stats(const float (&v)[16], float& mean, float& rstd) {
    float s = 0.f;
#pragma unroll
    for (int j = 0; j < 16; ++j) s += v[j];
    mean = wave_sum(s) * (1.f / D);
    float q = 0.f;
#pragma unroll
    for (int j = 0; j < 16; ++j) { const float d = v[j] - mean; q += d * d; }
    rstd = __builtin_amdgcn_rsqf(wave_sum(q) * (1.f / D) + LN_EPS);
}
__device__ __forceinline__ void load_row16(const float* p, int lane, float (&v)[16]) {
#pragma unroll
    for (int j = 0; j < 4; ++j) { const f32x4 x = *(const f32x4*)(p + 4 * lane + 256 * j); v[4 * j] = x[0]; v[4 * j + 1] = x[1]; v[4 * j + 2] = x[2]; v[4 * j + 3] = x[3]; }
}

__device__ __forceinline__ void phase_p0b(ArgsR a, const Ctx& c) {
    const float* MODF = (const float*)(a.ws + WS_MODF);
    float sh[16], sc[16];
#pragma unroll
    for (int j = 0; j < 4; ++j) { const f32x4 s0 = *(const f32x4*)(MODF + 4 * c.lane + 256 * j), s1 = *(const f32x4*)(MODF + 1024 + 4 * c.lane + 256 * j);
#pragma unroll
        for (int e = 0; e < 4; ++e) { sh[4 * j + e] = s0[e]; sc[4 * j + e] = 1.f + s1[e]; } }
    bf16* XN = (bf16*)(a.ws + WS_XN);
    for (int m = c.gw; m < T; m += c.ngw) {
        float v[16]; load_row16(a.in[I_X] + (size_t)m * D, c.lane, v);
        float mean, rstd; row_stats(v, mean, rstd);
#pragma unroll
        for (int j = 0; j < 4; ++j) { f32x4 o;
#pragma unroll
            for (int e = 0; e < 4; ++e) o[e] = (v[4 * j + e] - mean) * rstd * sc[4 * j + e] + sh[4 * j + e];
            store4bf(XN + (size_t)m * D + 4 * c.lane + 256 * j, o); }
    }
}

namespace pg8 {
#define PG8_LAS __attribute__((address_space(3)))
typedef unsigned short bf16_t;
typedef short bf16x8 __attribute__((ext_vector_type(8)));
typedef float f32x4 __attribute__((ext_vector_type(4)));
typedef unsigned u32x4 __attribute__((ext_vector_type(4)));
constexpr int BM = 256, BK = 64, HALF = 128, HTB = HALF * BK * 2  , STAGE_BYTES = 8 * HTB, NXCD = 8, WGM = 8;

__host__ __device__ __forceinline__ int lds_byte(int r, int c) { const int st = (r >> 4) * 2 + (c >> 5), rr = r & 15, cc = c & 31, ob = rr * 64 + cc * 2; return st * 1024 + (ob ^ (((ob >> 9) & 1) << 5)); }
__host__ __device__ __forceinline__ void stage_rc(int b, int& R, int& C) { const int st = b / 1024, sb = b % 1024, swz = sb ^ (((sb >> 9) & 1) << 5); R = (st >> 1) * 16 + swz / 64; C = (st & 1) * 32 + (swz % 64) / 2; }
__host__ __device__ __forceinline__ int perm32(int rho) { const int n = rho >> 4, i = rho & 15; return 8 * (i >> 2) + 4 * n + (i & 3); }

struct Unit { int pm, pn; };
struct Gemm { const bf16_t* A; const bf16_t* Bt; int M, N, K; };

struct StaticOrder {
    int nM, nN, nwg, G, c;
    __host__ __device__ void init(int M, int N, int G_, int c_) { nM = M / BM; nN = N / BM; nwg = nM * nN; G = G_; c = c_; }
    __host__ __device__ bool next(int i, Unit& u) const {
        const long L = (long)i * G + c; if (L >= nwg) return false;
        int wgid = (int)L; { const int q = nwg / NXCD, r = nwg % NXCD, xcd = wgid % NXCD, off = wgid / NXCD; wgid = (xcd < r ? xcd * (q + 1) : r * (q + 1) + (xcd - r) * q) + off; }
        const int nig = WGM * nN, gid = wgid / nig, fm = gid * WGM, gsz = (nM - fm) < WGM ? (nM - fm) : WGM;
        u.pm = fm + ((wgid % nig) % gsz); u.pn = (wgid % nig) / gsz; return true;
    }
    __device__ __forceinline__ void a_ready(const Unit&) const {}
    __device__ __forceinline__ void done(const Unit&) const {}
};


template <class Epi, class Sched, bool ALIGN_EPI = false, bool SP2 = false, bool GATHER = false>
__device__ __forceinline__ void gemm_phase(PG8_LAS unsigned char* lds, const Gemm g, const Sched& S, const Epi& E, const int tid_in, const int* s2t = nullptr) {
    const int tid = tid_in, wid = __builtin_amdgcn_readfirstlane(tid >> 6), lane = tid & 63, wr = wid >> 2, wc = wid & 3, fr = lane & 15, fq = lane >> 4;
    const int K = g.K, nt = K / BK;
    unsigned voffA[2], voffB[2];
#pragma unroll
    for (int i = 0; i < 2; ++i) { int R, C; stage_rc(tid * 16 + i * 8192, R, C); const int Rb = Epi::PERM ? ((R & ~31) + perm32(R & 31)) : R;
        voffA[i] = (unsigned)(R * K + C) * 2u; voffB[i] = (unsigned)(Rb * K + C) * 2u; }
    unsigned pc0 = 0u, pc1 = 0u, pn0 = 0u, pn1 = 0u, cvoff = 0u; int R0g = 0;
    if constexpr (GATHER) { int R, C; stage_rc(tid * 16, R, C); R0g = R; cvoff = (unsigned)C * 2u; }
#define PG8_TOKPACK(pm_, h_) ([&]() -> unsigned { const int r0_ = (pm_) * BM + (h_) * HALF + R0g; const int a0_ = s2t[r0_], a1_ = s2t[r0_ + 64]; return (unsigned)(a0_ < 0 ? 0 : (a0_ >> 1)) | ((unsigned)(a1_ < 0 ? 0 : (a1_ >> 1)) << 16); }())
#define PG8_STAGE_A(bufoff, base, h, usen) do { if constexpr (GATHER) { const unsigned pk_ = (usen) ? ((h) ? pn1 : pn0) : ((h) ? pc1 : pc0); \
        unsigned vt_[2] = {(pk_ & 0xffffu) * (unsigned)(K * 2) + cvoff, (pk_ >> 16) * (unsigned)(K * 2) + cvoff}; PG8_STAGE(bufoff, base, vt_); } \
    else PG8_STAGE(bufoff, (base) + ((h) ? hstep : (size_t)0), voffA); } while (0)
    const size_t kstep = (size_t)(BK * 2);
    const size_t hstep = (size_t)HALF * K * 2;
    const size_t tstep = 2 * hstep;
    const unsigned ldsw = (unsigned)wid * 1024u;
    const int aoff = lds_byte(wr * 64 + fr, fq * 8), boff = lds_byte(wc * 32 + fr, fq * 8);
#define PG8_SA(b, h) (((b) * 2 + (h)) * HTB)
#define PG8_SB(b, h) ((4 + (b) * 2 + (h)) * HTB)
#define PG8_STAGE(bufoff, gbase, voff) do { _Pragma("unroll") for (int _i = 0; _i < 2; ++_i) \
        __builtin_amdgcn_global_load_lds((const unsigned*)((const char*)(gbase) + (voff)[_i]), (PG8_LAS unsigned*)(lds + (bufoff) + ldsw + _i * 8192), 16, 0, 0); } while (0)
#define PG8_LDA(dst, b, h) do { _Pragma("unroll") for (int m = 0; m < 4; ++m) _Pragma("unroll") for (int k = 0; k < 2; ++k) dst[m][k] = *(const PG8_LAS bf16x8*)(lds + PG8_SA(b, h) + aoff + m * 2048 + k * 1024); } while (0)
#define PG8_LDB(dst, b, h) do { _Pragma("unroll") for (int n = 0; n < 2; ++n) _Pragma("unroll") for (int k = 0; k < 2; ++k) dst[n][k] = *(const PG8_LAS bf16x8*)(lds + PG8_SB(b, h) + boff + n * 2048 + k * 1024); } while (0)
#define PG8_MMA(ai, bj, At, Bt) do { __builtin_amdgcn_s_setprio(1); _Pragma("unroll") for (int m = 0; m < 4; ++m) _Pragma("unroll") for (int n = 0; n < 2; ++n) _Pragma("unroll") for (int k = 0; k < 2; ++k) \
        acc[ai][bj][m][n] = __builtin_amdgcn_mfma_f32_16x16x32_bf16(Bt[n][k], At[m][k], acc[ai][bj][m][n], 0, 0, 0); __builtin_amdgcn_s_setprio(0); } while (0)
#define PG8_WAIT_V(n) asm volatile("s_waitcnt vmcnt(" #n ")" ::: "memory")
#define PG8_WAIT_L(n) asm volatile("s_waitcnt lgkmcnt(" #n ")" ::: "memory")
#define PG8_BAR __builtin_amdgcn_s_barrier()
#define PG8_SCHED __builtin_amdgcn_sched_barrier(0)
    Unit cur, nxt; int ui = 0;
    if (!S.next(0, cur)) return;
    f32x4 acc[2][2][4][2];
#pragma unroll
    for (int a = 0; a < 2; ++a)
#pragma unroll
        for (int b = 0; b < 2; ++b)
#pragma unroll
            for (int m = 0; m < 4; ++m)
#pragma unroll
                for (int n = 0; n < 2; ++n) acc[a][b][m][n] = (f32x4){0.f, 0.f, 0.f, 0.f};
    bf16x8 At[4][2], B0[2][2], B1[2][2];
    const char* cA = (const char*)g.A + (GATHER ? (size_t)0 : (size_t)cur.pm * tstep); const char* cB = (const char*)g.Bt + (size_t)cur.pn * tstep;
    if constexpr (GATHER) { pc0 = PG8_TOKPACK(cur.pm, 0); pc1 = PG8_TOKPACK(cur.pm, 1); }
    S.a_ready(cur);
    if constexpr (SP2) {
        PG8_STAGE(PG8_SB(0, 0), cB, voffB); PG8_STAGE(PG8_SB(0, 1), cB + hstep, voffB); PG8_STAGE_A(PG8_SA(0, 0), cA, 0, false); PG8_STAGE_A(PG8_SA(0, 1), cA, 1, false);
        if (wr == 1) PG8_BAR;
        PG8_WAIT_V(2); PG8_BAR;
        PG8_STAGE(PG8_SB(1, 0), cB + kstep, voffB); PG8_STAGE_A(PG8_SA(1, 0), cA + kstep, 0, false); PG8_STAGE(PG8_SB(1, 1), cB + hstep + kstep, voffB);
        PG8_WAIT_V(6); PG8_BAR;
    } else {
        PG8_STAGE(PG8_SB(0, 0), cB, voffB); PG8_STAGE(PG8_SA(0, 0), cA, voffA); PG8_STAGE(PG8_SB(0, 1), cB + hstep, voffB); PG8_STAGE(PG8_SA(0, 1), cA + hstep, voffA);
        if (wr == 1) PG8_BAR;
        PG8_WAIT_V(4); PG8_BAR;
        PG8_STAGE(PG8_SB(1, 0), cB + kstep, voffB); PG8_STAGE(PG8_SA(1, 0), cA + kstep, voffA); PG8_STAGE(PG8_SB(1, 1), cB + hstep + kstep, voffB);
        PG8_WAIT_V(6); PG8_BAR;
    }
    for (;;) {
        const bool has_next = S.next(ui + 1, nxt);
        const char* nA = (has_next && !GATHER) ? (const char*)g.A + (size_t)nxt.pm * tstep : cA; const char* nB = has_next ? (const char*)g.Bt + (size_t)nxt.pn * tstep : cB;
        if constexpr (GATHER) { if (has_next) { pn0 = PG8_TOKPACK(nxt.pm, 0); pn1 = PG8_TOKPACK(nxt.pm, 1); } else { pn0 = pc0; pn1 = pc1; } }
        for (int t = 0; t < nt; t += 2) {
            const bool last = (t == nt - 2);
            const char* a1 = cA + (size_t)(t + 1) * kstep;
            const char* a2 = last ? nA : cA + (size_t)(t + 2) * kstep; const char* b2 = last ? nB : cB + (size_t)(t + 2) * kstep;
            const char* a3 = a2 + kstep; const char* b3 = b2 + kstep;
            if (last && has_next) S.a_ready(nxt);
            if constexpr (SP2) {
            PG8_LDB(B0, 0, 0); PG8_LDB(B1, 0, 1); PG8_SCHED; PG8_LDA(At, 0, 0); PG8_STAGE_A(PG8_SA(1, 1), a1, 1, false);
            PG8_WAIT_V(8); PG8_WAIT_L(0); PG8_BAR; PG8_MMA(0, 0, At, B0); PG8_MMA(0, 1, At, B1); PG8_BAR; PG8_SCHED;
            PG8_LDA(At, 0, 1); PG8_STAGE(PG8_SB(0, 0), b2, voffB); PG8_STAGE(PG8_SB(0, 1), b2 + hstep, voffB); PG8_STAGE_A(PG8_SA(0, 0), a2, 0, last);
            PG8_WAIT_V(8); PG8_WAIT_L(0); PG8_BAR; PG8_MMA(1, 0, At, B0); PG8_MMA(1, 1, At, B1); PG8_BAR; PG8_SCHED;
            PG8_LDB(B0, 1, 0); PG8_LDB(B1, 1, 1); PG8_SCHED; PG8_LDA(At, 1, 0); PG8_STAGE_A(PG8_SA(0, 1), a2, 1, last);
            PG8_WAIT_V(8); PG8_WAIT_L(0); PG8_BAR; PG8_MMA(0, 0, At, B0); PG8_MMA(0, 1, At, B1); PG8_BAR; PG8_SCHED;
            PG8_LDA(At, 1, 1); PG8_STAGE(PG8_SB(1, 0), b3, voffB); PG8_STAGE(PG8_SB(1, 1), b3 + hstep, voffB); PG8_STAGE_A(PG8_SA(1, 0), a3, 0, last);
            PG8_WAIT_V(8); PG8_WAIT_L(0); PG8_BAR; PG8_MMA(1, 0, At, B0); PG8_MMA(1, 1, At, B1); PG8_BAR; PG8_SCHED;
            } else {
            PG8_LDB(B0, 0, 0); PG8_SCHED; PG8_LDA(At, 0, 0); PG8_STAGE(PG8_SA(1, 1), a1 + hstep, voffA);
            PG8_WAIT_L(8); PG8_BAR; PG8_WAIT_L(0); PG8_MMA(0, 0, At, B0); PG8_BAR; PG8_SCHED;
            PG8_LDB(B1, 0, 1); PG8_STAGE(PG8_SB(0, 0), b2, voffB);
            PG8_BAR; PG8_WAIT_L(0); PG8_MMA(0, 1, At, B1); PG8_BAR;
            PG8_LDA(At, 0, 1); PG8_STAGE(PG8_SA(0, 0), a2, voffA);
            PG8_BAR; PG8_WAIT_L(0); PG8_MMA(1, 0, At, B0); PG8_BAR; PG8_SCHED;
            PG8_STAGE(PG8_SB(0, 1), b2 + hstep, voffB);
            PG8_WAIT_V(6); PG8_BAR; PG8_MMA(1, 1, At, B1); PG8_BAR;
            PG8_LDB(B0, 1, 0); PG8_SCHED; PG8_LDA(At, 1, 0); PG8_STAGE(PG8_SA(0, 1), a2 + hstep, voffA);
            PG8_WAIT_L(8); PG8_BAR; PG8_WAIT_L(0); PG8_MMA(0, 0, At, B0); PG8_BAR; PG8_SCHED;
            PG8_LDB(B1, 1, 1); PG8_STAGE(PG8_SB(1, 0), b3, voffB);
            PG8_BAR; PG8_WAIT_L(0); PG8_MMA(0, 1, At, B1); PG8_BAR;
            PG8_LDA(At, 1, 1); PG8_STAGE(PG8_SA(1, 0), a3, voffA);
            PG8_BAR; PG8_WAIT_L(0); PG8_MMA(1, 0, At, B0); PG8_BAR; PG8_SCHED;
            PG8_STAGE(PG8_SB(1, 1), b3 + hstep, voffB);
            PG8_WAIT_V(6); PG8_BAR; PG8_MMA(1, 1, At, B1); PG8_BAR;
            }
        }
        if constexpr (ALIGN_EPI) { if (wr == 0) PG8_BAR; }
        if constexpr (!Epi::AFTER_DRAIN) { E(acc, cur, wr, wc, fr, fq); S.done(cur); }
        if (!has_next) break;
#pragma unroll
        for (int a = 0; a < 2; ++a)
#pragma unroll
            for (int b = 0; b < 2; ++b)
#pragma unroll
                for (int m = 0; m < 4; ++m)
#pragma unroll
                    for (int n = 0; n < 2; ++n) acc[a][b][m][n] = (f32x4){0.f, 0.f, 0.f, 0.f};
        cur = nxt; cA = nA; cB = nB; ++ui; if constexpr (GATHER) { pc0 = pn0; pc1 = pn1; }
        if constexpr (ALIGN_EPI) { if (wr == 1) PG8_BAR; }
    }
    PG8_WAIT_V(0);
    if constexpr (!ALIGN_EPI) { if (wr == 0) PG8_BAR; }
    PG8_BAR;
    if constexpr (Epi::AFTER_DRAIN) { E.fused(acc, cur, wr, wc, fr, fq, lds, wid, lane); S.done(cur); }
#undef PG8_SA
#undef PG8_SB
#undef PG8_STAGE
#undef PG8_STAGE_A
#undef PG8_TOKPACK
#undef PG8_LDA
#undef PG8_LDB
#undef PG8_MMA
#undef PG8_WAIT_V
#undef PG8_WAIT_L
#undef PG8_BAR
#undef PG8_SCHED
}
}

using pg8::Unit;
struct DenseSched { int nN, n, G, c;
    __device__ __forceinline__ void a_ready(const Unit&) const {}
    __device__ __forceinline__ void done(const Unit&) const {}
    __device__ __forceinline__ bool next(int i, Unit& u) const { const int L = i * G + c; if (L >= n) return false; u.pm = L / nN; u.pn = L % nN; return true; } };

__device__ __forceinline__ void store8bf(bf16* p, f32x4 lo, f32x4 hi) { u32x4 w; w.x = pk2(lo[0], lo[1]); w.y = pk2(lo[2], lo[3]); w.z = pk2(hi[0], hi[1]); w.w = pk2(hi[2], hi[3]); *(u32x4*)p = w; }
__device__ __forceinline__ void load8bf(const bf16* p, f32x4& lo, f32x4& hi) { const u32x4 w = *(const u32x4*)p;
    lo[0] = __uint_as_float(w.x << 16); lo[1] = __uint_as_float(w.x & 0xffff0000u); lo[2] = __uint_as_float(w.y << 16); lo[3] = __uint_as_float(w.y & 0xffff0000u);
    hi[0] = __uint_as_float(w.z << 16); hi[1] = __uint_as_float(w.z & 0xffff0000u); hi[2] = __uint_as_float(w.w << 16); hi[3] = __uint_as_float(w.w & 0xffff0000u); }
struct EpiZ { bf16 *ZR, *ZS, *ZG;
    __device__ __forceinline__ void one(int row, int col, f32x4 lo, f32x4 hi) const {
        if (col < RC) store8bf(ZR + (size_t)row * RC + col, lo, hi);
        else if (col < RC + 1024) { for (int e = 0; e < 4; ++e) { lo[e] = gelu_tanh(lo[e]); hi[e] = gelu_tanh(hi[e]); } store8bf(ZS + (size_t)row * 1024 + (col - RC), lo, hi); }
        else { for (int e = 0; e < 4; ++e) { lo[e] = sigmoidf_(lo[e]); hi[e] = sigmoidf_(hi[e]); } store8bf(ZG + (size_t)row * 2048 + (col - RC - 1024), lo, hi); } }
    __device__ __forceinline__ void operator()(int row, int col, f32x4 a0, f32x4 a1, f32x4 b0, f32x4 b1) const { one(row, col, a0, a1); one(row, col + 128, b0, b1); } };
struct EpiGA { const bf16* ZG; bf16* MP;
    __device__ __forceinline__ void one(int row, int col, f32x4 lo, f32x4 hi) const { f32x4 g0, g1; load8bf(ZG + (size_t)row * 2048 + col, g0, g1); store8bf(MP + (size_t)row * D + col, g0 * lo, g1 * hi); }
    __device__ __forceinline__ void operator()(int row, int col, f32x4 a0, f32x4 a1, f32x4 b0, f32x4 b1) const { one(row, col, a0, a1); one(row, col + 128, b0, b1); } };
struct EpiGB { const bf16* ZG; const bf16* MPin; bf16* MP;
    __device__ __forceinline__ void one(int row, int col, f32x4 lo, f32x4 hi) const { f32x4 g0, g1, m0, m1; load8bf(ZG + (size_t)row * 2048 + 1024 + col, g0, g1); load8bf(MPin + (size_t)row * D + col, m0, m1);
        store8bf(MP + (size_t)row * D + col, m0 + g0 * lo, m1 + g1 * hi); }
    __device__ __forceinline__ void operator()(int row, int col, f32x4 a0, f32x4 a1, f32x4 b0, f32x4 b1) const { one(row, col, a0, a1); one(row, col + 128, b0, b1); } };
struct EpiOut { const float* xin; float* out; const float* gate1;
    __device__ __forceinline__ void one(int row, int col, f32x4 v) const { const f32x4 x = *(const f32x4*)(xin + (size_t)row * D + col); const f32x4 g = *(const f32x4*)(gate1 + col);
        *(f32x4*)(out + (size_t)row * D + col) = ALPHA * x + (1.0f + g) * v; }
    __device__ __forceinline__ void operator()(int row, int col, f32x4 a0, f32x4 a1, f32x4 b0, f32x4 b1) const { one(row, col, a0); one(row, col + 4, a1); one(row, col + 128, b0); one(row, col + 132, b1); } };
struct EpiSwi { bf16* HID;
    __device__ __forceinline__ void operator()(int row, int col, f32x4 a0, f32x4 a1, f32x4 b0, f32x4 b1) const { const int ct = (col >> 8) & 3, cc = col & 127;
        f32x4 h0, h1; for (int e = 0; e < 4; ++e) { h0[e] = siluf_(a0[e]) * b0[e]; h1[e] = siluf_(a1[e]) * b1[e]; } store8bf(HID + (size_t)row * FF + ct * 128 + cc, h0, h1); } };
struct EpiDown { const int* S2T; const float* TOKW; bf16* Y;
    __device__ __forceinline__ void operator()(int row, int col, f32x4 a0, f32x4 a1, f32x4 b0, f32x4 b1) const { const int st = S2T[row]; if (st < 0) return; const float w = TOKW[st]; const int cc = col & 1023;
        store8bf(Y + (size_t)st * D + cc, w * a0, w * a1); store8bf(Y + (size_t)st * D + cc + 128, w * b0, w * b1); } };

struct MoeSched { int ts[17]; int G, c;
    __device__ __forceinline__ void a_ready(const Unit&) const {}
    __device__ __forceinline__ void done(const Unit&) const {}
    __device__ __forceinline__ void init(const unsigned* cnt, int G_, int c_) { G = G_; c = c_; int s = 0;
#pragma unroll
        for (int e = 0; e < 16; ++e) { ts[e] = s; s += ((int)cnt[e] + 255) >> 8; } ts[16] = s; }
    __device__ __forceinline__ bool next(int i, Unit& u) const { const int L = i * G + c; if (L >= 4 * ts[16]) return false; const int rt = L >> 2, ct = L & 3; int e = 0;
#pragma unroll
        for (int j = 1; j < 16; ++j) e += (rt >= ts[j]) ? 1 : 0;
        u.pm = rt; u.pn = e * 4 + ct; return true; } };

__device__ __forceinline__ void phase_prep_simple(ArgsR a, const Ctx& c, int l) {
    const bf16* ZR = (const bf16*)(a.ws + WS_ZR);
    const float* mu = a.in[I_MU] + l * RC; const float* w0 = a.in[I_W0] + l * W; const float* w2 = a.in[I_W2] + (size_t)l * 64 * W;
    const float* a0 = a.in[I_A0] + l * W; const float* a2 = a.in[I_A2] + (size_t)l * 64 * W; const float* g2 = a.in[I_G2] + (size_t)l * 128 * W;
    const float* k_k = a.in[I_KK] + l * W; const float* k_a = a.in[I_KA] + l * W;
    const float* vm0 = a.in[I_VM0]; const float* vm1 = a.in[I_VM1]; const float* vm2 = a.in[I_VM2];
    f16* R = (f16*)(a.ws + WS_R); f16* WM1 = (f16*)(a.ws + WS_WM1); f16* KP = (f16*)(a.ws + WS_KP); f16* AA = (f16*)(a.ws + WS_AA); f16* BB = (f16*)(a.ws + WS_BB); f16* V = (f16*)(a.ws + WS_V);
    bf16* G = (bf16*)(a.ws + WS_G); bf16* VF = (bf16*)(a.ws + WS_VF);
    const int lane = c.lane;
    for (int t = c.gw; t < T; t += c.ngw) {
        float z[28];
#pragma unroll
        for (int i = 0; i < 28; ++i) { const int col = lane + 64 * i; const float zc = bf2f(ZR[(size_t)t * RC + col]); const float zp = t > 0 ? bf2f(ZR[(size_t)(t - 1) * RC + col]) : 0.f; z[i] = zc + (zp - zc) * mu[col]; }
        const float tw = tanhf(z[24]), za = z[25], sg0 = sigmoidf_(z[26]), sg1 = sigmoidf_(z[27]);
        float wlo[8], alo[8], gg[8];
#pragma unroll
        for (int i = 0; i < 8; ++i) { wlo[i] = 0.f; alo[i] = 0.f; gg[i] = 0.f; }
        for (int j = 0; j < 64; ++j) { const float tj = __shfl(tw, j), aj = __shfl(za, j), s0 = __shfl(sg0, j), s1 = __shfl(sg1, j);
#pragma unroll
            for (int i = 0; i < 8; ++i) { const int n = lane + 64 * i; wlo[i] += tj * w2[j * W + n]; alo[i] += aj * a2[j * W + n]; gg[i] += s0 * g2[j * W + n] + s1 * g2[(64 + j) * W + n]; } }
        float vv[8];
#pragma unroll
        for (int i = 0; i < 8; ++i) vv[i] = z[16 + i];
        if (l == 0) {
#pragma unroll
            for (int i = 0; i < 8; ++i) VF[(size_t)t * W + lane + 64 * i] = f2bf(vv[i]);
        } else {
            float vmid = 0.f;
#pragma unroll
            for (int i = 0; i < 8; ++i)
                for (int j = 0; j < 64; ++j) { const float vc = __shfl(vv[i], j); vmid += vc * vm1[(size_t)(64 * i + j) * 32 + (lane & 31)]; }
            float vg[8];
#pragma unroll
            for (int i = 0; i < 8; ++i) vg[i] = 0.f;
            for (int m = 0; m < 32; ++m) { const float vmm = __shfl(vmid, m);
#pragma unroll
                for (int i = 0; i < 8; ++i) vg[i] += vmm * vm2[m * W + lane + 64 * i]; }
#pragma unroll
            for (int i = 0; i < 8; ++i) { const int n = lane + 64 * i; const float vf = bf2f(VF[(size_t)t * W + n]); vv[i] = vv[i] + (vf - vv[i]) * sigmoidf_(vm0[n] + vg[i]); }
        }
#pragma unroll
        for (int i = 0; i < 8; ++i) {
            const int n = lane + 64 * i; const size_t o = (size_t)t * W + n;
            const float x = w0[n] + wlo[i]; const float wl = -softplusf_(-x) - 0.5f; const float dm1 = expm1f(-__expf(wl));
            const float av = sigmoidf_(a0[n] + alo[i]);
            const float kraw = z[8 + i];
            float kk = kraw * k_k[n]; const float nrm = sqrtf(wave_sum(kk * kk)); kk = kk / fmaxf(nrm, 1e-12f);
            const float kp = kraw * (1.0f + (av - 1.0f) * k_a[n]);
            R[o] = (f16)z[i]; WM1[o] = (f16)dm1; KP[o] = (f16)kp; AA[o] = (f16)(-kk); BB[o] = (f16)(kk * av); V[o] = (f16)vv[i]; G[o] = f2bf(gg[i]);
        }
    }
}

__device__ __forceinline__ void phase_sg_simple(ArgsR a, const Ctx& c, int l) {
    const bf16* ZS = (const bf16*)(a.ws + WS_ZS); bf16* YB = (bf16*)(a.ws + WS_YB);
    const float* lng = a.in[I_SGG] + l * W; const float* lnb = a.in[I_SGB] + l * W;
    float* vn = (float*)c.lds;
    float* st = vn + 128 * 64;
    for (int uidx = blockIdx.x; uidx < 128 * 8; uidx += gridDim.x) {
        const int ch = uidx >> 3, g = uidx & 7; const int tok0 = ch * 128;
        for (int i = 0; i < 16; ++i) { const int s = c.wave * 16 + i; const bf16* p = ZS + (size_t)(tok0 + s) * 1024 + 512 + c.lane * 8;
            const f32x4 x0 = load4bf(p), x1 = load4bf(p + 4);
            float sm = (x0[0] + x0[1]) + (x0[2] + x0[3]) + (x1[0] + x1[1]) + (x1[2] + x1[3]); const float mean = wave_sum(sm) * (1.f / 512.f);
            float q = 0.f; for (int e = 0; e < 4; ++e) { const float d0 = x0[e] - mean, d1 = x1[e] - mean; q += d0 * d0 + d1 * d1; }
            const float rstd = __builtin_amdgcn_rsqf(wave_sum(q) * (1.f / 512.f) + LN_EPS);
            if (c.lane == 0) { st[2 * s] = mean; st[2 * s + 1] = rstd; } }
        __syncthreads();
        for (int i = c.tid; i < 128 * 64; i += NTHREADS) { const int s = i >> 6, d = i & 63; const float x = bf2f(ZS[(size_t)(tok0 + s) * 1024 + 512 + g * 64 + d]);
            vn[i] = (x - st[2 * s]) * st[2 * s + 1] * lng[g * 64 + d] + lnb[g * 64 + d]; }
        __syncthreads();
        const int d = c.tid & 63, tq = c.tid >> 6;
        const float* Wg = a.in[I_WS] + (size_t)(l * 8 + g) * 128 * 128; const float* bs = a.in[I_BS] + (size_t)(l * 8 + g) * 128;
        for (int i = 0; i < 16; ++i) { const int t = tq + 8 * i; float acc = 0.f;
            for (int s = 0; s <= t; ++s) acc += Wg[t * 128 + s] * vn[s * 64 + d];
            const float u = bf2f(ZS[(size_t)(tok0 + t) * 1024 + g * 64 + d]);
            YB[(size_t)(tok0 + t) * W + g * 64 + d] = f2bf(u * (acc + bs[t])); }
        __syncthreads();
    }
}

#define LAS3 __attribute__((address_space(3)))
typedef short bf16x8 __attribute__((ext_vector_type(8)));
template <int MT, int NT, int KS, bool SWAP = false>
__device__ __forceinline__ void mma_lds_glob(const unsigned char* lds_base, int a_off_bytes, int lda, const bf16* Bt, int ldb, int n0, int lane, f32x4 (&acc)[MT][NT]) {
    const int fr = lane & 15, fq = lane >> 4;
    const LAS3 unsigned char* Ab = (const LAS3 unsigned char*)lds_base + a_off_bytes;
    int boff = (n0 + fr) * ldb + 8 * fq; asm volatile("" : "+v"(boff));
#pragma unroll
    for (int ks = 0; ks < KS; ++ks) {
        bf16x8 b[NT];
#pragma unroll
        for (int n = 0; n < NT; ++n) b[n] = *(const bf16x8*)(Bt + boff + 16 * n * ldb + 32 * ks);
#pragma unroll
        for (int m = 0; m < MT; ++m) { const bf16x8 av = *(const LAS3 bf16x8*)(Ab + ((16 * m + fr) * lda + 32 * ks + 8 * fq) * 2);
#pragma unroll
            for (int n = 0; n < NT; ++n) acc[m][n] = SWAP ? __builtin_amdgcn_mfma_f32_16x16x32_bf16(b[n], av, acc[m][n], 0, 0, 0) : __builtin_amdgcn_mfma_f32_16x16x32_bf16(av, b[n], acc[m][n], 0, 0, 0); }
    }
}
__device__ __forceinline__ void zshift8(const bf16* ZR, int t, int col, const float* mu, float (&o)[8]) {
    const u32x4 zc = *(const u32x4*)(ZR + (size_t)t * RC + col);
    u32x4 zp = {0u, 0u, 0u, 0u}; if (t > 0) zp = *(const u32x4*)(ZR + (size_t)(t - 1) * RC + col);
    const f32x4 m0 = *(const f32x4*)(mu + col), m1 = *(const f32x4*)(mu + col + 4);
#pragma unroll
    for (int e = 0; e < 4; ++e) { const float c0 = __uint_as_float(zc[e] << 16), c1 = __uint_as_float(zc[e] & 0xffff0000u), p0 = __uint_as_float(zp[e] << 16), p1 = __uint_as_float(zp[e] & 0xffff0000u);
        const float mu0 = (2 * e < 4) ? m0[(2 * e) & 3] : m1[(2 * e) & 3], mu1 = (2 * e + 1 < 4) ? m0[(2 * e + 1) & 3] : m1[(2 * e + 1) & 3];
        o[2 * e] = c0 + (p0 - c0) * mu0; o[2 * e + 1] = c1 + (p1 - c1) * mu1; }
}
typedef _Float16 f16x8 __attribute__((ext_vector_type(8)));
typedef _Float16 f16x4 __attribute__((ext_vector_type(4)));
__device__ __forceinline__ void store8f16(f16* p, const float (&v)[8]) { f16x8 h;
#pragma unroll
    for (int e = 0; e < 8; ++e) h[e] = (f16)v[e];
    *(f16x8*)p = h; }
__device__ __forceinline__ u32x4 pack8bf(const float (&v)[8]) { u32x4 w; w.x = pk2(v[0], v[1]); w.y = pk2(v[2], v[3]); w.z = pk2(v[4], v[5]); w.w = pk2(v[6], v[7]); return w; }


constexpr int PB_LD = 520;
constexpr int PB_BUF = 0, PB_AOP = 64 * PB_LD * 2, PB_VMID = 2 * 64 * PB_LD * 2, PB_LA_LD = 264, PB_VM_LD = 40;
__device__ __forceinline__ void phase_prep_fast(ArgsR a, const Ctx& c, int l) {
    const bf16* ZR = (const bf16*)(a.ws + WS_ZR);
    const float* mu = a.in[I_MU] + l * RC; const float* w0 = a.in[I_W0] + l * W; const float* a0 = a.in[I_A0] + l * W;
    const float* k_k = a.in[I_KK] + l * W; const float* k_a = a.in[I_KA] + l * W; const float* vm0 = a.in[I_VM0];
    f16* R = (f16*)(a.ws + WS_R); f16* WM1 = (f16*)(a.ws + WS_WM1); f16* KP = (f16*)(a.ws + WS_KP); f16* AA = (f16*)(a.ws + WS_AA); f16* BB = (f16*)(a.ws + WS_BB); f16* V = (f16*)(a.ws + WS_V);
    bf16* G = (bf16*)(a.ws + WS_G); bf16* VF = (bf16*)(a.ws + WS_VF);
    const unsigned char* lo = a.ws + WS_LORA + (size_t)l * LO_STRIDE;
    const bf16* W2T = (const bf16*)(lo + LO_W2T); const bf16* A2T = (const bf16*)(lo + LO_A2T); const bf16* G2T = (const bf16*)(lo + LO_G2T);
    const bf16* VM1T = (const bf16*)(lo + LO_VM1T); const bf16* VM2T = (const bf16*)(lo + LO_VM2T);
    LAS3 unsigned char* L = (LAS3 unsigned char*)c.lds;
    const int tid = c.tid, lane = c.lane, wv = c.wave, fr = lane & 15, fq = lane >> 4;
    const int row = tid >> 3, sub_ = tid & 7;
    for (int u = blockIdx.x; u < T / 64; u += gridDim.x) {
        int sub = sub_; asm volatile("" : "+v"(sub));
        const int t0 = u * 64, t = t0 + row;
        if (l == 0) {
#pragma unroll 4
            for (int p = 0; p < 8; ++p) { const int col = p * 64 + sub * 8; float z[8]; zshift8(ZR, t, 1024 + col, mu, z);
                store8f16(V + (size_t)t * W + col, z); *(u32x4*)(VF + (size_t)t * W + col) = pack8bf(z); }
        } else {
#pragma unroll 4
            for (int p = 0; p < 8; ++p) { const int col = p * 64 + sub * 8; float z[8]; zshift8(ZR, t, 1024 + col, mu, z);
                *(LAS3 u32x4*)(L + PB_AOP + (row * PB_LD + col) * 2) = pack8bf(z); }
            __syncthreads();
            { f32x4 acc[1][1]; acc[0][0] = (f32x4){0.f, 0.f, 0.f, 0.f}; const int m = wv >> 1, n = wv & 1;
              mma_lds_glob<1, 1, 16>(c.lds, PB_AOP + 16 * m * PB_LD * 2, PB_LD, VM1T, W, 16 * n, lane, acc);
#pragma unroll
              for (int i = 0; i < 4; ++i) *(LAS3 bf16*)(L + PB_VMID + ((16 * m + 4 * fq + i) * PB_VM_LD + 16 * n + fr) * 2) = f2bf(acc[0][0][i]); }
            __syncthreads();
            { f32x4 acc[4][4];
#pragma unroll
              for (int m = 0; m < 4; ++m)
#pragma unroll
                  for (int n = 0; n < 4; ++n) acc[m][n] = (f32x4){0.f, 0.f, 0.f, 0.f};
              mma_lds_glob<4, 4, 1, true>(c.lds, PB_VMID, PB_VM_LD, VM2T, 32, 64 * wv, lane, acc);
#pragma unroll
              for (int m = 0; m < 4; ++m)
#pragma unroll
                  for (int n = 0; n < 4; ++n) { const int col = 64 * wv + 16 * n + 4 * fq; const f32x4 vb = *(const f32x4*)(vm0 + col); f16x4 hv;
#pragma unroll
                      for (int i = 0; i < 4; ++i) hv[i] = (f16)sigmoidf_(vb[i] + acc[m][n][i]);
                      *(LAS3 f16x4*)(L + PB_BUF + ((16 * m + fr) * PB_LD + col) * 2) = hv; } }
            __syncthreads();
#pragma unroll 4
            for (int p = 0; p < 8; ++p) { const int col = p * 64 + sub * 8;
                const u32x4 vz = *(const LAS3 u32x4*)(L + PB_AOP + (row * PB_LD + col) * 2); const f16x8 gt = *(const LAS3 f16x8*)(L + PB_BUF + (row * PB_LD + col) * 2);
                const u32x4 vfw = *(const u32x4*)(VF + (size_t)t * W + col); float o[8];
#pragma unroll
                for (int e = 0; e < 4; ++e) { const float v0 = __uint_as_float(vz[e] << 16), v1 = __uint_as_float(vz[e] & 0xffff0000u), f0 = __uint_as_float(vfw[e] << 16), f1 = __uint_as_float(vfw[e] & 0xffff0000u);
                    o[2 * e] = v0 + (f0 - v0) * (float)gt[2 * e]; o[2 * e + 1] = v1 + (f1 - v1) * (float)gt[2 * e + 1]; }
                store8f16(V + (size_t)t * W + col, o); }
            __syncthreads();
        }
#pragma unroll 4
        for (int p = 0; p < 4; ++p) { const int cc = sub * 32 + p * 8; float z[8]; zshift8(ZR, t, 1536 + cc, mu, z);
#pragma unroll
            for (int e = 0; e < 8; ++e) z[e] = cc < 64 ? (1.0f - 2.0f * __builtin_amdgcn_rcpf(1.0f + __expf(2.0f * z[e]))) : (cc < 128 ? z[e] : sigmoidf_(z[e]));
            *(LAS3 u32x4*)(L + PB_AOP + (row * PB_LA_LD + cc) * 2) = pack8bf(z); }
        __syncthreads();
        { f32x4 acc[4][4];
#pragma unroll
          for (int m = 0; m < 4; ++m)
#pragma unroll
              for (int n = 0; n < 4; ++n) acc[m][n] = (f32x4){0.f, 0.f, 0.f, 0.f};
          mma_lds_glob<4, 4, 2, true>(c.lds, PB_AOP + 64 * 2, PB_LA_LD, A2T, 64, 64 * wv, lane, acc);
#pragma unroll
          for (int m = 0; m < 4; ++m)
#pragma unroll
              for (int n = 0; n < 4; ++n) { const int col = 64 * wv + 16 * n + 4 * fq; const f32x4 ab = *(const f32x4*)(a0 + col); f16x4 hv;
#pragma unroll
                  for (int i = 0; i < 4; ++i) hv[i] = (f16)sigmoidf_(ab[i] + acc[m][n][i]);
                  *(LAS3 f16x4*)(L + PB_BUF + ((16 * m + fr) * PB_LD + col) * 2) = hv; } }
        __syncthreads();
#pragma unroll 4
        for (int p = 0; p < 8; ++p) { const int col = p * 64 + sub * 8; const size_t o = (size_t)t * W + col;
            float z[8]; zshift8(ZR, t, col, mu, z); store8f16(R + o, z);
            float kz[8]; zshift8(ZR, t, 512 + col, mu, kz);
            const f16x8 av = *(const LAS3 f16x8*)(L + PB_BUF + (row * PB_LD + col) * 2);
            const f32x4 kk0 = *(const f32x4*)(k_k + col), kk1 = *(const f32x4*)(k_k + col + 4), ka0 = *(const f32x4*)(k_a + col), ka1 = *(const f32x4*)(k_a + col + 4);
            float kk[8], kp[8], bb[8]; float ss = 0.f;
#pragma unroll
            for (int e = 0; e < 8; ++e) { const float kkw = e < 4 ? kk0[e & 3] : kk1[e & 3], kaw = e < 4 ? ka0[e & 3] : ka1[e & 3]; kk[e] = kz[e] * kkw; ss += kk[e] * kk[e]; kp[e] = kz[e] * (1.0f + ((float)av[e] - 1.0f) * kaw); }
            ss += __shfl_xor(ss, 1); ss += __shfl_xor(ss, 2); ss += __shfl_xor(ss, 4);
            const float inv = fminf(__builtin_amdgcn_rsqf(ss), 1e12f);
#pragma unroll
            for (int e = 0; e < 8; ++e) { kk[e] *= inv; bb[e] = kk[e] * (float)av[e]; kk[e] = -kk[e]; }
            store8f16(KP + o, kp); store8f16(AA + o, kk); store8f16(BB + o, bb); }
        __syncthreads();
        { f32x4 acc[4][4];
#pragma unroll
          for (int m = 0; m < 4; ++m)
#pragma unroll
              for (int n = 0; n < 4; ++n) acc[m][n] = (f32x4){0.f, 0.f, 0.f, 0.f};
          mma_lds_glob<4, 4, 2, true>(c.lds, PB_AOP, PB_LA_LD, W2T, 64, 64 * wv, lane, acc);
#pragma unroll
          for (int m = 0; m < 4; ++m)
#pragma unroll
              for (int n = 0; n < 4; ++n) { const int col = 64 * wv + 16 * n + 4 * fq; const f32x4 wb = *(const f32x4*)(w0 + col); f16x4 hv;
#pragma unroll
                  for (int i = 0; i < 4; ++i) { const float x = wb[i] + acc[m][n][i]; const float wl = -(fmaxf(-x, 0.f) + __logf(1.0f + __expf(-fabsf(x)))) - 0.5f;
                      hv[i] = (f16)(__expf(-__expf(wl)) - 1.0f); }
                  *(LAS3 f16x4*)(L + PB_BUF + ((16 * m + fr) * PB_LD + col) * 2) = hv; } }
        __syncthreads();
#pragma unroll 4
        for (int p = 0; p < 8; ++p) { const int col = p * 64 + sub * 8; *(u32x4*)(WM1 + (size_t)t * W + col) = *(const LAS3 u32x4*)(L + PB_BUF + (row * PB_LD + col) * 2); }
        __syncthreads();
        { f32x4 acc[4][4];
#pragma unroll
          for (int m = 0; m < 4; ++m)
#pragma unroll
              for (int n = 0; n < 4; ++n) acc[m][n] = (f32x4){0.f, 0.f, 0.f, 0.f};
          mma_lds_glob<4, 4, 4, true>(c.lds, PB_AOP + 128 * 2, PB_LA_LD, G2T, 128, 64 * wv, lane, acc);
#pragma unroll
          for (int m = 0; m < 4; ++m)
#pragma unroll
              for (int n = 0; n < 4; ++n) { const int col = 64 * wv + 16 * n + 4 * fq; u32x2 w; w.x = pk2(acc[m][n][0], acc[m][n][1]); w.y = pk2(acc[m][n][2], acc[m][n][3]);
                  *(LAS3 u32x2*)(L + PB_BUF + ((16 * m + fr) * PB_LD + col) * 2) = w; } }
        __syncthreads();
#pragma unroll 4
        for (int p = 0; p < 8; ++p) { const int col = p * 64 + sub * 8; *(u32x4*)(G + (size_t)t * W + col) = *(const LAS3 u32x4*)(L + PB_BUF + (row * PB_LD + col) * 2); }
        __syncthreads();
    }
}

constexpr int SG_LD = 136;
constexpr int SG_VT = 0, SG_ST = 256 * SG_LD * 2;
__device__ __forceinline__ void phase_sg_fast(ArgsR a, const Ctx& c, int l) {
    const bf16* ZS = (const bf16*)(a.ws + WS_ZS); bf16* YB = (bf16*)(a.ws + WS_YB);
    const float* lng = a.in[I_SGG] + l * W; const float* lnb = a.in[I_SGB] + l * W;
    LAS3 unsigned char* L = (LAS3 unsigned char*)c.lds;
    LAS3 float* st = (LAS3 float*)(L + SG_ST);
    const int tid = c.tid, lane = c.lane, wv = c.wave, fr = lane & 15, fq = lane >> 4;
    for (int u = blockIdx.x; u < 256; u += gridDim.x) {
        const int ch = u >> 1, hf = u & 1, tok0 = ch * 128;
        { u32x4 raw[16];
#pragma unroll
          for (int i = 0; i < 16; ++i) raw[i] = *(const u32x4*)(ZS + (size_t)(tok0 + wv * 16 + i) * 1024 + 512 + lane * 8);
#pragma unroll
          for (int i = 0; i < 16; ++i) { const int sidx = wv * 16 + i; float x[8];
#pragma unroll
              for (int e = 0; e < 4; ++e) { x[2 * e] = __uint_as_float(raw[i][e] << 16); x[2 * e + 1] = __uint_as_float(raw[i][e] & 0xffff0000u); }
              const float sm = ((x[0] + x[1]) + (x[2] + x[3])) + ((x[4] + x[5]) + (x[6] + x[7])); const float mean = wave_sum(sm) * (1.f / 512.f);
              float q = 0.f;
#pragma unroll
              for (int e = 0; e < 8; ++e) { const float d0 = x[e] - mean; q += d0 * d0; }
              const float rstd = __builtin_amdgcn_rsqf(wave_sum(q) * (1.f / 512.f) + LN_EPS);
              if (lane == 0) { st[2 * sidx] = mean; st[2 * sidx + 1] = rstd; } } }
        __syncthreads();
        { const int sidx = tid >> 2, q4 = tid & 3; const float mean = st[2 * sidx], rstd = st[2 * sidx + 1];
#pragma unroll
          for (int p = 0; p < 8; ++p) { const int cl = q4 * 64 + p * 8; const int cg = hf * 256 + cl;
              const bf16* src = ZS + (size_t)(tok0 + sidx) * 1024 + 512 + cg; const f32x4 x0 = load4bf(src), x1 = load4bf(src + 4);
              const f32x4 g0 = *(const f32x4*)(lng + cg), g1 = *(const f32x4*)(lng + cg + 4), b0 = *(const f32x4*)(lnb + cg), b1 = *(const f32x4*)(lnb + cg + 4);
#pragma unroll
              for (int e = 0; e < 8; ++e) { const float x = e < 4 ? x0[e & 3] : x1[e & 3], gg = e < 4 ? g0[e & 3] : g1[e & 3], bb = e < 4 ? b0[e & 3] : b1[e & 3];
                  *(LAS3 bf16*)(L + SG_VT + ((cl + e) * SG_LD + sidx) * 2) = f2bf((x - mean) * rstd * gg + bb); } } }
        __syncthreads();
        const int gl = wv >> 1, dh = wv & 1, g = hf * 4 + gl;
        const float* Wg = a.in[I_WS] + (size_t)(l * 8 + g) * 128 * 128; const float* bs = a.in[I_BS] + (size_t)(l * 8 + g) * 128;
        f32x4 acc[8][2];
#pragma unroll
        for (int m = 0; m < 8; ++m) { acc[m][0] = (f32x4){0.f, 0.f, 0.f, 0.f}; acc[m][1] = (f32x4){0.f, 0.f, 0.f, 0.f}; }
#pragma unroll
        for (int ks = 0; ks < 4; ++ks) {
            bf16x8 b[2];
#pragma unroll
            for (int n = 0; n < 2; ++n) b[n] = *(const LAS3 bf16x8*)(L + SG_VT + ((gl * 64 + dh * 32 + 16 * n + fr) * SG_LD + 32 * ks + 8 * fq) * 2);
#pragma unroll
            for (int m = 0; m < 8; ++m) { if (32 * ks <= 16 * m + 15) {
                const int trow = 16 * m + fr, s0 = 32 * ks + 8 * fq;
                const f32x4 w0v = *(const f32x4*)(Wg + trow * 128 + s0), w1v = *(const f32x4*)(Wg + trow * 128 + s0 + 4);
                float wf[8];
#pragma unroll
                for (int e = 0; e < 8; ++e) { const float wval = e < 4 ? w0v[e & 3] : w1v[e & 3]; wf[e] = (s0 + e <= trow) ? wval : 0.f; }
                const u32x4 wp = pack8bf(wf); const bf16x8 av = __builtin_bit_cast(bf16x8, wp);
                acc[m][0] = __builtin_amdgcn_mfma_f32_16x16x32_bf16(b[0], av, acc[m][0], 0, 0, 0);
                acc[m][1] = __builtin_amdgcn_mfma_f32_16x16x32_bf16(b[1], av, acc[m][1], 0, 0, 0); } }
        }
#pragma unroll
        for (int m = 0; m < 8; ++m) { const int trow = 16 * m + fr; const float bsv = bs[trow];
#pragma unroll
            for (int n = 0; n < 2; ++n) { const int col = g * 64 + dh * 32 + 16 * n + 4 * fq; const f32x4 uu = load4bf(ZS + (size_t)(tok0 + trow) * 1024 + col);
                store4bf(YB + (size_t)(tok0 + trow) * W + col, uu * (acc[m][n] + bsv)); } }
        __syncthreads();
    }
}

__device__ __forceinline__ void phase_scan_simple(ArgsR a, const Ctx& c) {
    if (c.wave != 0 || blockIdx.x >= NH) return;
    const int h = blockIdx.x, lane = c.lane;
    const f16* R = (const f16*)(a.ws + WS_R); const f16* WM1 = (const f16*)(a.ws + WS_WM1); const f16* KP = (const f16*)(a.ws + WS_KP);
    const f16* AA = (const f16*)(a.ws + WS_AA); const f16* BB = (const f16*)(a.ws + WS_BB); const f16* V = (const f16*)(a.ws + WS_V);
    bf16* YSC = (bf16*)(a.ws + WS_YSC);
    float S[64];
#pragma unroll
    for (int j = 0; j < 64; ++j) S[j] = 0.f;
    for (int t = 0; t < T; ++t) {
        const size_t base = (size_t)t * W + h * 64;
        const float vv = (float)V[base + lane];
        float sa = 0.f;
#pragma unroll
        for (int j = 0; j < 64; ++j) sa += S[j] * (float)AA[base + j];
        float y = 0.f;
#pragma unroll
        for (int j = 0; j < 64; ++j) { float s = S[j]; s = s + s * (float)WM1[base + j]; s += sa * (float)BB[base + j]; s += vv * (float)KP[base + j]; S[j] = s; y += s * (float)R[base + j]; }
        YSC[base + lane] = f2bf(y);
    }
}

typedef unsigned u32x16 __attribute__((ext_vector_type(16)));
__device__ __forceinline__ void sload32(const void* p0, u32x16& a0, u32x16& a1) {
    asm volatile("s_load_dwordx16 %0, %2, 0x0 glc\n\ts_load_dwordx16 %1, %2, 0x40 glc\n\ts_waitcnt lgkmcnt(0)" : "=&s"(a0), "=&s"(a1) : "s"(p0) : "memory");
}
__device__ __forceinline__ void sload64(const void* p0, const void* p1, u32x16& a0, u32x16& a1, u32x16& b0, u32x16& b1) {
    asm volatile("s_load_dwordx16 %0, %4, 0x0 glc\n\ts_load_dwordx16 %1, %4, 0x40 glc\n\ts_load_dwordx16 %2, %5, 0x0 glc\n\ts_load_dwordx16 %3, %5, 0x40 glc\n\ts_waitcnt lgkmcnt(0)"
                 : "=&s"(a0), "=&s"(a1), "=&s"(b0), "=&s"(b1) : "s"(p0), "s"(p1) : "memory");
}
__device__ __forceinline__ float fmix_lo(unsigned sd, float x, float y) { float d; asm("v_fma_mix_f32 %0, %1, %2, %3 op_sel_hi:[1,0,0]" : "=v"(d) : "s"(sd), "v"(x), "v"(y)); return d; }
__device__ __forceinline__ float fmix_hi(unsigned sd, float x, float y) { float d; asm("v_fma_mix_f32 %0, %1, %2, %3 op_sel:[1,0,0] op_sel_hi:[1,0,0]" : "=v"(d) : "s"(sd), "v"(x), "v"(y)); return d; }
constexpr int CL = 64, NCH = T / CL;
constexpr size_t ST_Q_OFF = (size_t)NH * NCH * 64 * 64;
constexpr size_t ST_S_OFF = (size_t)NH * NCH * 64 * 64;

__device__ __forceinline__ float vmix_lo(unsigned vd, float x, float y) { float d; asm("v_fma_mix_f32 %0, %1, %2, %3 op_sel_hi:[1,0,0]" : "=v"(d) : "v"(vd), "v"(x), "v"(y)); return d; }
__device__ __forceinline__ float vmix_hi(unsigned vd, float x, float y) { float d; asm("v_fma_mix_f32 %0, %1, %2, %3 op_sel:[1,0,0] op_sel_hi:[1,0,0]" : "=v"(d) : "v"(vd), "v"(x), "v"(y)); return d; }
template <int N> __device__ __forceinline__ void fmac_bc(float& acc, float vec, float x) { asm("v_fmac_f32_dpp %0, %1, %2 row_newbcast:%3 row_mask:0xf bank_mask:0xf" : "+v"(acc) : "v"(vec), "v"(x), "n"(N)); }
template <int N> __device__ __forceinline__ float mul_bc(float vec, float x) { float d; asm("v_mul_f32_dpp %0, %1, %2 row_newbcast:%3 row_mask:0xf bank_mask:0xf" : "=v"(d) : "v"(vec), "v"(x), "n"(N)); return d; }
struct SVec { float v[4]; };
__device__ __forceinline__ f16x4 sv_read(const LAS3 unsigned char* p, int lane) { return *(const LAS3 f16x4*)(p + (lane & 15) * 8); }
__device__ __forceinline__ void sv_cvt(SVec& o, f16x4 h) { o.v[0] = (float)h[0]; o.v[1] = (float)h[1]; o.v[2] = (float)h[2]; o.v[3] = (float)h[3]; }
__device__ __forceinline__ void sv_cvt1p(SVec& o, f16x4 h) { o.v[0] = 1.0f + (float)h[0]; o.v[1] = 1.0f + (float)h[1]; o.v[2] = 1.0f + (float)h[2]; o.v[3] = 1.0f + (float)h[3]; }
template <int J> __device__ __forceinline__ void sc_dot(float (&d)[4], const SVec& A, const float (&X)[64]) { fmac_bc<(J >> 2)>(d[J & 3], A.v[J & 3], X[J]); if constexpr (J + 1 < 64) sc_dot<J + 1>(d, A, X); }
template <int J> __device__ __forceinline__ void sc_upd3(float (&S)[64], float (&y)[4], const SVec& Wv, const SVec& Bv, const SVec& Kv, const SVec& Rv, float sa, float vv) {
    float sj = mul_bc<(J >> 2)>(Wv.v[J & 3], S[J]); fmac_bc<(J >> 2)>(sj, Bv.v[J & 3], sa); fmac_bc<(J >> 2)>(sj, Kv.v[J & 3], vv); S[J] = sj; fmac_bc<(J >> 2)>(y[J & 3], Rv.v[J & 3], sj);
    if constexpr (J + 1 < 64) sc_upd3<J + 1>(S, y, Wv, Bv, Kv, Rv, sa, vv); }
template <int J> __device__ __forceinline__ void sc_upd1(float (&Q)[64], float (&P)[64], const SVec& Wv, const SVec& Bv, const SVec& Kv, float saq, float sap, float vv) {
    float qj = mul_bc<(J >> 2)>(Wv.v[J & 3], Q[J]); fmac_bc<(J >> 2)>(qj, Bv.v[J & 3], saq); fmac_bc<(J >> 2)>(qj, Kv.v[J & 3], vv); Q[J] = qj;
    float pj = mul_bc<(J >> 2)>(Wv.v[J & 3], P[J]); fmac_bc<(J >> 2)>(pj, Bv.v[J & 3], sap); P[J] = pj;
    if constexpr (J + 1 < 64) sc_upd1<J + 1>(Q, P, Wv, Bv, Kv, saq, sap, vv); }
constexpr int SCB = 8;
constexpr int SC_NS = 7, SC_BUF = SC_NS * 1024, SC_WAVE = 2 * SC_BUF;
__device__ __forceinline__ void sc_dma(const f16* X, size_t eoff, LAS3 unsigned char* dst) {
    __builtin_amdgcn_global_load_lds((const unsigned*)(X + eoff), (LAS3 unsigned*)dst, 16, 0, 0);
}

__device__ __forceinline__ void phase_scan1(ArgsR a, const Ctx& c) {
    const f16* WM1 = (const f16*)(a.ws + WS_WM1); const f16* KP = (const f16*)(a.ws + WS_KP);
    const f16* AA = (const f16*)(a.ws + WS_AA); const f16* BB = (const f16*)(a.ws + WS_BB); const f16* V = (const f16*)(a.ws + WS_V);
    float* ST = (float*)(a.ws + WS_ST);
    const int lane = c.lane;
    LAS3 unsigned char* ring = (LAS3 unsigned char*)c.lds + c.wave * SC_WAVE;
    for (int item = c.gw; item < NH * NCH; item += c.ngw) {
        const int h = __builtin_amdgcn_readfirstlane(item / NCH), ch = __builtin_amdgcn_readfirstlane(item % NCH);
        float Q[64], P[64];
        int ln_ = lane; asm volatile("" : "+v"(ln_));
#pragma unroll
        for (int j = 0; j < 64; ++j) { Q[j] = 0.f; P[j] = (j == ln_) ? 1.f : 0.f; }
        const size_t lane_off = (size_t)(lane >> 3) * W + h * 64 + (lane & 7) * 8;
        { const size_t e0 = (size_t)(ch * CL) * W + lane_off;
          sc_dma(AA, e0, ring); sc_dma(WM1, e0, ring + 1024); sc_dma(BB, e0, ring + 2048); sc_dma(KP, e0, ring + 3072); sc_dma(V, e0, ring + 4096); }
#pragma unroll 1
        for (int blk = 0; blk < CL / SCB; ++blk) {
            LAS3 unsigned char* buf = ring + (blk & 1) * SC_BUF;
            if (blk + 1 < CL / SCB) { LAS3 unsigned char* nb = ring + ((blk + 1) & 1) * SC_BUF; const size_t e0 = (size_t)(ch * CL + (blk + 1) * SCB) * W + lane_off;
                sc_dma(AA, e0, nb); sc_dma(WM1, e0, nb + 1024); sc_dma(BB, e0, nb + 2048); sc_dma(KP, e0, nb + 3072); sc_dma(V, e0, nb + 4096);
                asm volatile("s_waitcnt vmcnt(5)" ::: "memory"); }
            else asm volatile("s_waitcnt vmcnt(0)" ::: "memory");
            SVec A, Wv, Bv, Kv;
            sv_cvt(A, sv_read(buf, lane)); sv_cvt1p(Wv, sv_read(buf + 1024, lane)); sv_cvt(Bv, sv_read(buf + 2048, lane)); sv_cvt(Kv, sv_read(buf + 3072, lane));
            float vv = (float)*(const LAS3 f16*)(buf + 4096 + lane * 2);
#pragma unroll 1
            for (int st = 0; st < SCB; ++st) {
                const LAS3 unsigned char* sn = buf + ((st + 1 < SCB) ? st + 1 : st) * 128;
                const f16x4 ha = sv_read(sn, lane), hw = sv_read(sn + 1024, lane), hb = sv_read(sn + 2048, lane), hk = sv_read(sn + 3072, lane);
                const f16 hv = *(const LAS3 f16*)(sn + 4096 + lane * 2);
                float dq[4] = {0.f, 0.f, 0.f, 0.f}, dp[4] = {0.f, 0.f, 0.f, 0.f};
                sc_dot<0>(dq, A, Q); sc_dot<0>(dp, A, P);
                const float saq = (dq[0] + dq[1]) + (dq[2] + dq[3]), sap = (dp[0] + dp[1]) + (dp[2] + dp[3]);
                sc_upd1<0>(Q, P, Wv, Bv, Kv, saq, sap, vv);
                sv_cvt(A, ha); sv_cvt1p(Wv, hw); sv_cvt(Bv, hb); sv_cvt(Kv, hk); vv = (float)hv;
            }
        }
        float* Qp = ST + ST_Q_OFF + (size_t)(h * NCH + ch) * 4096 + lane;
        bf16* PTp = (bf16*)ST + (size_t)(h * NCH + ch) * 4096 + lane;
#pragma unroll
        for (int j = 0; j < 64; ++j) { PTp[j * 64] = f2bf(P[j]); Qp[j * 64] = Q[j]; }
    }
}
constexpr int GS = 16, NG = NCH / GS;
constexpr size_t ST_LP_OFF = (size_t)NH * NCH * 4096;
constexpr size_t WS_SG = WS_LORA + 2 * MiB;
constexpr int HI_LD = 72, HI_BYTES = 64 * HI_LD * 2;
struct HFrag { bf16x8 b[2][2]; f32x4 q[2]; };
__device__ __forceinline__ void hload(HFrag& f, const bf16* Bt, const float* QTc, int boff, int qtoff) {
#pragma unroll
    for (int ks = 0; ks < 2; ++ks)
#pragma unroll
        for (int n = 0; n < 2; ++n) f.b[ks][n] = *(const bf16x8*)(Bt + boff + 16 * n * 64 + 32 * ks);
#pragma unroll
    for (int n = 0; n < 2; ++n) f.q[n] = *(const f32x4*)(QTc + qtoff + 16 * n * 64);
}
__device__ __forceinline__ void hmma(const LAS3 unsigned char* img, const bf16x8 (&b)[2][2], f32x4 (&acc)[2], int m, int fr, int fq) {
#pragma unroll
    for (int ks = 0; ks < 2; ++ks) { const bf16x8 av = *(const LAS3 bf16x8*)(img + ((16 * m + fr) * HI_LD + 32 * ks + 8 * fq) * 2);
#pragma unroll
        for (int n = 0; n < 2; ++n) acc[n] = __builtin_amdgcn_mfma_f32_16x16x32_bf16(av, b[ks][n], acc[n], 0, 0, 0); }
}
__device__ __forceinline__ void himg_store(LAS3 unsigned char* img, const f32x4 (&acc)[2], int m, int n0, int fr, int fq) {
#pragma unroll
    for (int n = 0; n < 2; ++n)
#pragma unroll
        for (int i = 0; i < 4; ++i) *(LAS3 bf16*)(img + ((16 * m + 4 * fq + i) * HI_LD + n0 + 16 * n + fr) * 2) = f2bf(acc[n][i]);
}
#define HBAR() do { asm volatile("s_waitcnt lgkmcnt(0)" ::: "memory"); __builtin_amdgcn_s_barrier(); asm volatile("" ::: "memory"); } while (0)

__device__ __forceinline__ void sc2a_step(const HFrag& f, bf16* LpTc, float* QTc, const LAS3 unsigned char* ip, LAS3 unsigned char* ipn, const LAS3 unsigned char* iq, LAS3 unsigned char* iqn, int m, int n0, int fr, int fq, int qtoff) {
    f32x4 ap[2], aq[2];
#pragma unroll
    for (int n = 0; n < 2; ++n) { ap[n] = (f32x4){0.f, 0.f, 0.f, 0.f}; aq[n] = f.q[n]; }
    hmma(ip, f.b, ap, m, fr, fq); hmma(iq, f.b, aq, m, fr, fq);
#pragma unroll
    for (int n = 0; n < 2; ++n) { u32x2 w; w.x = pk2(ap[n][0], ap[n][1]); w.y = pk2(ap[n][2], ap[n][3]);
        *(u32x2*)(LpTc + (n0 + 16 * n + fr) * 64 + 16 * m + 4 * fq) = w;
        *(f32x4*)(QTc + qtoff + 16 * n * 64) = aq[n]; }
    himg_store(ipn, ap, m, n0, fr, fq); himg_store(iqn, aq, m, n0, fr, fq);
    HBAR();
}
__device__ __forceinline__ void phase_scan2a(ArgsR a, const Ctx& c) {
    const int lane = c.lane, wv = c.wave, fr = lane & 15, fq = lane >> 4, m = wv >> 1, n0 = 32 * (wv & 1);
    const int boff = (n0 + fr) * 64 + 8 * fq, qtoff = (n0 + fr) * 64 + 16 * m + 4 * fq;
    LAS3 unsigned char* L = (LAS3 unsigned char*)c.lds;
    for (int item = blockIdx.x; item < NH * NG; item += gridDim.x) {
        const size_t cb = (size_t)(item / NG) * NCH + (size_t)(item % NG) * GS;
        const bf16* PT = (const bf16*)(a.ws + WS_ST) + cb * 4096; bf16* LP = (bf16*)(a.ws + WS_ST) + ST_LP_OFF + cb * 4096; float* QT = (float*)(a.ws + WS_ST) + ST_Q_OFF + cb * 4096;
        for (int i = c.tid; i < 4 * HI_BYTES / 4; i += NTHREADS) ((LAS3 unsigned*)L)[i] = 0u;
        __syncthreads();
        if (c.tid < 64) *(LAS3 bf16*)(L + (c.tid * HI_LD + c.tid) * 2) = (bf16)0x3F80;
        __syncthreads();
        HFrag f0, f1, f2, f3;
        hload(f0, PT, QT, boff, qtoff); hload(f1, PT + 4096, QT + 4096, boff, qtoff); hload(f2, PT + 2 * 4096, QT + 2 * 4096, boff, qtoff); hload(f3, PT + 3 * 4096, QT + 3 * 4096, boff, qtoff);
        LAS3 unsigned char* p0 = L; LAS3 unsigned char* p1 = L + HI_BYTES; LAS3 unsigned char* q0 = L + 2 * HI_BYTES; LAS3 unsigned char* q1 = L + 3 * HI_BYTES;
#pragma unroll 1
        for (int i = 0; i < GS; i += 4) {
            const int nx = (i + 4 < GS) ? i + 4 : i;
            sc2a_step(f0, LP + (size_t)(i + 0) * 4096, QT + (size_t)(i + 0) * 4096, p0, p1, q0, q1, m, n0, fr, fq, qtoff); hload(f0, PT + (size_t)(nx + 0) * 4096, QT + (size_t)(nx + 0) * 4096, boff, qtoff);
            sc2a_step(f1, LP + (size_t)(i + 1) * 4096, QT + (size_t)(i + 1) * 4096, p1, p0, q1, q0, m, n0, fr, fq, qtoff); hload(f1, PT + (size_t)(nx + 1) * 4096, QT + (size_t)(nx + 1) * 4096, boff, qtoff);
            sc2a_step(f2, LP + (size_t)(i + 2) * 4096, QT + (size_t)(i + 2) * 4096, p0, p1, q0, q1, m, n0, fr, fq, qtoff); hload(f2, PT + (size_t)(nx + 2) * 4096, QT + (size_t)(nx + 2) * 4096, boff, qtoff);
            sc2a_step(f3, LP + (size_t)(i + 3) * 4096, QT + (size_t)(i + 3) * 4096, p1, p0, q1, q0, m, n0, fr, fq, qtoff); hload(f3, PT + (size_t)(nx + 3) * 4096, QT + (size_t)(nx + 3) * 4096, boff, qtoff);
        }
        __syncthreads();
    }
}
__device__ __forceinline__ void phase_scan2b(ArgsR a, const Ctx& c) {
    if (blockIdx.x >= NH) return;
    const int h = blockIdx.x, lane = c.lane, wv = c.wave, fr = lane & 15, fq = lane >> 4, m = wv >> 1, n0 = 32 * (wv & 1);
    const int boff = (n0 + fr) * 64 + 8 * fq, qtoff = (n0 + fr) * 64 + 16 * m + 4 * fq;
    LAS3 unsigned char* L = (LAS3 unsigned char*)c.lds;
    const bf16* LP = (const bf16*)(a.ws + WS_ST) + ST_LP_OFF + (size_t)h * NCH * 4096; const float* QT = (const float*)(a.ws + WS_ST) + ST_Q_OFF + (size_t)h * NCH * 4096;
    bf16* SG = (bf16*)(a.ws + WS_SG) + (size_t)h * NG * 4096;
    for (int i = c.tid; i < 2 * HI_BYTES / 4; i += NTHREADS) ((LAS3 unsigned*)L)[i] = 0u;
    for (int i = c.tid; i < 4096 / 2; i += NTHREADS) ((LAS3 unsigned*)(L + 2 * HI_BYTES))[i] = 0u;
    __syncthreads();
    HFrag f0, f1, f2, f3;
#define SC2B_CH(g) ((size_t)((g) * GS + GS - 1) * 4096)
    hload(f0, LP + SC2B_CH(0), QT + SC2B_CH(0), boff, qtoff); hload(f1, LP + SC2B_CH(1), QT + SC2B_CH(1), boff, qtoff); hload(f2, LP + SC2B_CH(2), QT + SC2B_CH(2), boff, qtoff); hload(f3, LP + SC2B_CH(3), QT + SC2B_CH(3), boff, qtoff);
    LAS3 unsigned char* i0 = L; LAS3 unsigned char* i1 = L + HI_BYTES;
#define SC2B_STEP(f, g, ic, in) do { f32x4 acc[2] = {f.q[0], f.q[1]}; hmma(ic, f.b, acc, m, fr, fq); LAS3 bf16* So = (LAS3 bf16*)(L + 2 * HI_BYTES) + (((g) + 1) & 7) * 4096; \
        _Pragma("unroll") for (int n = 0; n < 2; ++n) _Pragma("unroll") for (int i = 0; i < 4; ++i) So[(16 * m + 4 * fq + i) * 64 + n0 + 16 * n + fr] = f2bf(acc[n][i]); \
        himg_store(in, acc, m, n0, fr, fq); HBAR(); } while (0)
#pragma unroll 1
    for (int g = 0; g < NG; g += 4) {
        const int nx = (g + 4 < NG) ? g + 4 : g;
        SC2B_STEP(f0, g + 0, i0, i1); hload(f0, LP + SC2B_CH(nx + 0), QT + SC2B_CH(nx + 0), boff, qtoff);
        SC2B_STEP(f1, g + 1, i1, i0); hload(f1, LP + SC2B_CH(nx + 1), QT + SC2B_CH(nx + 1), boff, qtoff);
        SC2B_STEP(f2, g + 2, i0, i1); hload(f2, LP + SC2B_CH(nx + 2), QT + SC2B_CH(nx + 2), boff, qtoff);
        if ((g & 7) == 4) {
            for (int i = c.tid; i < 8 * 4096 / 8; i += NTHREADS) ((u32x4*)(SG + (size_t)(g >> 3) * 8 * 4096))[i] = ((const LAS3 u32x4*)(L + 2 * HI_BYTES))[i];
            HBAR(); }
        if (g + 3 < NG - 1) SC2B_STEP(f3, g + 3, i1, i0);
        hload(f3, LP + SC2B_CH(nx + 3), QT + SC2B_CH(nx + 3), boff, qtoff);
    }
#undef SC2B_STEP
#undef SC2B_CH
}
__device__ __forceinline__ void phase_scan2c(ArgsR a, const Ctx& c) {
    const int lane = c.lane, wv = c.wave, fr = lane & 15, fq = lane >> 4, m = wv >> 1, n0 = 32 * (wv & 1);
    const int boff = (n0 + fr) * 64 + 8 * fq, qtoff = (n0 + fr) * 64 + 16 * m + 4 * fq;
    LAS3 unsigned char* L = (LAS3 unsigned char*)c.lds;
    for (int item = blockIdx.x; item < NH * NG * 2; item += gridDim.x) {
        const int hg = item >> 1, hf = item & 1;
        const size_t cb = (size_t)(hg / NG) * NCH + (size_t)(hg % NG) * GS + hf * 8;
        const bf16* LP = (const bf16*)(a.ws + WS_ST) + ST_LP_OFF + cb * 4096; const float* QT = (const float*)(a.ws + WS_ST) + ST_Q_OFF + cb * 4096; bf16* SS = (bf16*)(a.ws + WS_ST) + cb * 4096;
        { const u32x4 v = *(const u32x4*)((const bf16*)(a.ws + WS_SG) + (size_t)hg * 4096 + c.tid * 8); *(LAS3 u32x4*)(L + ((c.tid >> 3) * HI_LD + (c.tid & 7) * 8) * 2) = v; }
        __syncthreads();
#pragma unroll 2
        for (int i = 0; i < 8; ++i) { HFrag f; hload(f, LP + (size_t)i * 4096, QT + (size_t)i * 4096, boff, qtoff);
            f32x4 acc[2] = {f.q[0], f.q[1]}; hmma(L, f.b, acc, m, fr, fq); bf16* So = SS + (size_t)i * 4096;
#pragma unroll
            for (int n = 0; n < 2; ++n)
#pragma unroll
                for (int k = 0; k < 4; ++k) So[(16 * m + 4 * fq + k) * 64 + n0 + 16 * n + fr] = f2bf(acc[n][k]); }
        __syncthreads();
    }
}
constexpr int WI_LD = 72, WI_B = 64 * WI_LD * 2, WI_GAM = 9 * WI_B, WI_GL = 15 * WI_B;
constexpr size_t WS_GM0 = 352 * MiB, WS_GM1 = 212 * MiB, WS_Y0 = 336 * MiB, WS_END2 = 360 * MiB;
__device__ __forceinline__ bf16* gm_ptr(unsigned char* ws, int h, int ch) { return (bf16*)(ws + (h < 4 ? WS_GM0 : WS_GM1)) + (size_t)((h & 3) * NCH + ch) * 4096; }
__device__ __forceinline__ void wi_mma(f32x4 (&acc)[2], const LAS3 unsigned char* A, const LAS3 unsigned char* Bt, int m, int n0, int fr, int fq) {
#pragma unroll
    for (int ks = 0; ks < 2; ++ks) { const bf16x8 av = *(const LAS3 bf16x8*)(A + ((16 * m + fr) * WI_LD + 32 * ks + 8 * fq) * 2);
#pragma unroll
        for (int n = 0; n < 2; ++n) { const bf16x8 bv = *(const LAS3 bf16x8*)(Bt + ((n0 + 16 * n + fr) * WI_LD + 32 * ks + 8 * fq) * 2); acc[n] = __builtin_amdgcn_mfma_f32_16x16x32_bf16(av, bv, acc[n], 0, 0, 0); } }
}
struct WiA { bf16x8 a[2]; }; struct WiB { bf16x8 b[2][2]; };
__device__ __forceinline__ void wi_lda(WiA& f, const LAS3 unsigned char* A, int m, int fr, int fq) {
#pragma unroll
    for (int ks = 0; ks < 2; ++ks) f.a[ks] = *(const LAS3 bf16x8*)(A + ((16 * m + fr) * WI_LD + 32 * ks + 8 * fq) * 2);
}
__device__ __forceinline__ void wi_ldb(WiB& f, const LAS3 unsigned char* Bt, int n0, int fr, int fq) {
#pragma unroll
    for (int ks = 0; ks < 2; ++ks)
#pragma unroll
        for (int n = 0; n < 2; ++n) f.b[ks][n] = *(const LAS3 bf16x8*)(Bt + ((n0 + 16 * n + fr) * WI_LD + 32 * ks + 8 * fq) * 2);
}
__device__ __forceinline__ void wi_fma(f32x4 (&acc)[2], const WiA& A, const WiB& B) {
#pragma unroll
    for (int ks = 0; ks < 2; ++ks)
#pragma unroll
        for (int n = 0; n < 2; ++n) acc[n] = __builtin_amdgcn_mfma_f32_16x16x32_bf16(A.a[ks], B.b[ks][n], acc[n], 0, 0, 0);
}
__device__ __forceinline__ void wi_fma_s(f32x4 (&acc)[2], const WiA& A, const WiB& B) {
#pragma unroll
    for (int ks = 0; ks < 2; ++ks)
#pragma unroll
        for (int n = 0; n < 2; ++n) acc[n] = __builtin_amdgcn_mfma_f32_16x16x32_bf16(B.b[ks][n], A.a[ks], acc[n], 0, 0, 0);
}
__device__ __forceinline__ void wi_st_nat_s(LAS3 unsigned char* X, const f32x4 (&acc)[2], int m, int n0, int fr, int fq) {
#pragma unroll
    for (int n = 0; n < 2; ++n) { u32x2 w; w.x = pk2(acc[n][0], acc[n][1]); w.y = pk2(acc[n][2], acc[n][3]); *(LAS3 u32x2*)(X + ((16 * m + fr) * WI_LD + n0 + 16 * n + 4 * fq) * 2) = w; }
}
__device__ __forceinline__ void wi_ld_nat_s(f32x4 (&acc)[2], const LAS3 unsigned char* X, int m, int n0, int fr, int fq) {
#pragma unroll
    for (int n = 0; n < 2; ++n) { const u32x2 w = *(const LAS3 u32x2*)(X + ((16 * m + fr) * WI_LD + n0 + 16 * n + 4 * fq) * 2);
        acc[n][0] = __uint_as_float(w.x << 16); acc[n][1] = __uint_as_float(w.x & 0xffff0000u); acc[n][2] = __uint_as_float(w.y << 16); acc[n][3] = __uint_as_float(w.y & 0xffff0000u); }
}
__device__ __forceinline__ void wi_ld_tr(f32x4 (&acc)[2], const LAS3 unsigned char* XT, int m, int n0, int fr, int fq) {
#pragma unroll
    for (int n = 0; n < 2; ++n) { const u32x2 w = *(const LAS3 u32x2*)(XT + ((n0 + 16 * n + fr) * WI_LD + 16 * m + 4 * fq) * 2);
        acc[n][0] = __uint_as_float(w.x << 16); acc[n][1] = __uint_as_float(w.x & 0xffff0000u); acc[n][2] = __uint_as_float(w.y << 16); acc[n][3] = __uint_as_float(w.y & 0xffff0000u); }
}
#define WI_PIN() __builtin_amdgcn_sched_barrier(0)
__device__ __forceinline__ void wi_st_nat(LAS3 unsigned char* X, const f32x4 (&acc)[2], int m, int n0, int fr, int fq) {
#pragma unroll
    for (int n = 0; n < 2; ++n)
#pragma unroll
        for (int i = 0; i < 4; ++i) *(LAS3 bf16*)(X + ((16 * m + 4 * fq + i) * WI_LD + n0 + 16 * n + fr) * 2) = f2bf(acc[n][i]);
}
__device__ __forceinline__ void wi_st_tr(LAS3 unsigned char* XT, const f32x4 (&acc)[2], int m, int n0, int fr, int fq) {
#pragma unroll
    for (int n = 0; n < 2; ++n) { u32x2 w; w.x = pk2(acc[n][0], acc[n][1]); w.y = pk2(acc[n][2], acc[n][3]); *(LAS3 u32x2*)(XT + ((n0 + 16 * n + fr) * WI_LD + 16 * m + 4 * fq) * 2) = w; }
}
__device__ __forceinline__ void wi_ld_nat(f32x4 (&acc)[2], const LAS3 unsigned char* X, int m, int n0, int fr, int fq) {
#pragma unroll
    for (int n = 0; n < 2; ++n)
#pragma unroll
        for (int i = 0; i < 4; ++i) acc[n][i] = bf2f(*(const LAS3 bf16*)(X + ((16 * m + 4 * fq + i) * WI_LD + n0 + 16 * n + fr) * 2));
}
__device__ __forceinline__ void phase_scan1m(ArgsR a, const Ctx& c, const int skip = 0) {
    const f16* WM1 = (const f16*)(a.ws + WS_WM1); const f16* KP = (const f16*)(a.ws + WS_KP);
    const f16* AA = (const f16*)(a.ws + WS_AA); const f16* BB = (const f16*)(a.ws + WS_BB); const f16* V = (const f16*)(a.ws + WS_V); const f16* R = (const f16*)(a.ws + WS_R);
    float* ST = (float*)(a.ws + WS_ST);
    LAS3 unsigned char* L = (LAS3 unsigned char*)c.lds;
    LAS3 float* GAM = (LAS3 float*)(L + WI_GAM); LAS3 float* GL = (LAS3 float*)(L + WI_GL);
    const int lane = c.lane, wv = c.wave, fr = lane & 15, fq = lane >> 4, m = wv >> 1, n0 = 32 * (wv & 1), tid = c.tid;
#define SLOT(i) (L + (i) * WI_B)
    const int t = tid >> 3, cc = (tid & 7) * 8;
    f16x8 pav, pbv, pkv, pvv, prv, pwv;
#define WI_FETCH(it) do { const int h_ = (it) / NCH, ch_ = (it) % NCH; const size_t eo_ = (size_t)(ch_ * CL + t) * W + h_ * 64 + cc; \
        pav = *(const f16x8*)(AA + eo_); pbv = *(const f16x8*)(BB + eo_); pkv = *(const f16x8*)(KP + eo_); pvv = *(const f16x8*)(V + eo_); prv = *(const f16x8*)(R + eo_); pwv = *(const f16x8*)(WM1 + eo_); } while (0)
    if (blockIdx.x < NH * NCH) WI_FETCH(blockIdx.x);
    for (int item = blockIdx.x; item < NH * NCH; item += gridDim.x) {
        const int h = item / NCH, ch = item % NCH;
        const f16x8 av = pav, bv = pbv, kv = pkv, vv = pvv, rv = prv, wv8 = pwv;
        if (item + (int)gridDim.x < NH * NCH) WI_FETCH(item + (int)gridDim.x);
        float g[8], gp[8];
        { float wloc[8];
#pragma unroll
          for (int e = 0; e < 8; ++e) wloc[e] = 1.0f + (float)wv8[e];
#pragma unroll
          for (int e = 0; e < 8; ++e) { float x = wloc[e];
              { const float y = __shfl_up(x, 8); if (lane >= 8) x *= y; } { const float y = __shfl_up(x, 16); if (lane >= 16) x *= y; } { const float y = __shfl_up(x, 32); if (lane >= 32) x *= y; }
              g[e] = x; }
          if (lane >= 56) {
#pragma unroll
              for (int e = 0; e < 8; ++e) GAM[wv * 64 + cc + e] = g[e]; }
          HBAR();
#pragma unroll
          for (int e = 0; e < 8; ++e) { float pre = 1.0f;
#pragma unroll
              for (int w = 0; w < 7; ++w) if (w < wv) pre *= GAM[w * 64 + cc + e];
              g[e] *= pre; gp[e] = g[e] * __builtin_amdgcn_rcpf(wloc[e]); } }
        { float fa[8], fb[8], fk[8], fv[8], frr[8];
#pragma unroll
          for (int e = 0; e < 8; ++e) { const float ig = __builtin_amdgcn_rcpf(g[e]);
              fa[e] = (float)av[e] * gp[e]; fb[e] = (float)bv[e] * ig; fk[e] = (float)kv[e] * ig; fv[e] = (float)vv[e]; frr[e] = (float)rv[e] * g[e]; if (t == 63) GL[cc + e] = g[e]; }
          *(LAS3 u32x4*)(SLOT(0) + (t * WI_LD + cc) * 2) = pack8bf(fa); *(LAS3 u32x4*)(SLOT(2) + (t * WI_LD + cc) * 2) = pack8bf(fb); *(LAS3 u32x4*)(SLOT(4) + (t * WI_LD + cc) * 2) = pack8bf(fk); *(LAS3 u32x4*)(SLOT(12) + (t * WI_LD + cc) * 2) = pack8bf(frr);
#pragma unroll
          for (int e = 0; e < 8; ++e) { *(LAS3 bf16*)(SLOT(1) + ((cc + e) * WI_LD + t) * 2) = f2bf(fa[e]); *(LAS3 bf16*)(SLOT(3) + ((cc + e) * WI_LD + t) * 2) = f2bf(fb[e]); *(LAS3 bf16*)(SLOT(5) + ((cc + e) * WI_LD + t) * 2) = f2bf(fv[e]); } }
        HBAR();
        { WiA aB, aK; WiB bA, bR; wi_lda(aB, SLOT(2), m, fr, fq); wi_lda(aK, SLOT(4), m, fr, fq); wi_ldb(bA, SLOT(0), n0, fr, fq); wi_ldb(bR, SLOT(12), n0, fr, fq);
          WI_PIN();
          f32x4 ans[2] = {{0.f, 0.f, 0.f, 0.f}, {0.f, 0.f, 0.f, 0.f}}, ant[2] = {{0.f, 0.f, 0.f, 0.f}, {0.f, 0.f, 0.f, 0.f}}, aks[2] = {{0.f, 0.f, 0.f, 0.f}, {0.f, 0.f, 0.f, 0.f}}, am[2] = {{0.f, 0.f, 0.f, 0.f}, {0.f, 0.f, 0.f, 0.f}}, amk[2] = {{0.f, 0.f, 0.f, 0.f}, {0.f, 0.f, 0.f, 0.f}};
          wi_fma_s(ans, aB, bA); wi_fma(ant, aB, bA); wi_fma_s(aks, aK, bA); wi_fma(am, aB, bR); wi_fma(amk, aK, bR);
          WI_PIN();
          f32x4 axs[2];
#pragma unroll
          for (int n = 0; n < 2; ++n)
#pragma unroll
              for (int i = 0; i < 4; ++i) { const int rs = 16 * m + fr, cs = n0 + 16 * n + 4 * fq + i;
                  if (!(rs < cs)) { ans[n][i] = 0.f; aks[n][i] = 0.f; } axs[n][i] = ans[n][i] + (rs == cs ? 1.0f : 0.f);
                  const int rn = 16 * m + 4 * fq + i, cn = n0 + 16 * n + fr;
                  if (!(rn < cn)) ant[n][i] = 0.f; if (rn > cn) { am[n][i] = 0.f; amk[n][i] = 0.f; } }
          wi_st_nat_s(SLOT(7), ans, m, n0, fr, fq); wi_st_tr(SLOT(8), ant, m, n0, fr, fq); wi_st_nat_s(SLOT(6), aks, m, n0, fr, fq); wi_st_nat_s(SLOT(11), axs, m, n0, fr, fq);
          wi_st_tr(SLOT(13), am, m, n0, fr, fq); wi_st_tr(SLOT(14), amk, m, n0, fr, fq); }
        HBAR();
        { WiA aN; WiB bN; wi_lda(aN, SLOT(7), m, fr, fq); wi_ldb(bN, SLOT(8), n0, fr, fq); WI_PIN();
          f32x4 a2s[2] = {{0.f, 0.f, 0.f, 0.f}, {0.f, 0.f, 0.f, 0.f}}, a2t[2] = {{0.f, 0.f, 0.f, 0.f}, {0.f, 0.f, 0.f, 0.f}}; wi_fma_s(a2s, aN, bN); wi_fma(a2t, aN, bN); WI_PIN();
          wi_st_nat_s(SLOT(9), a2s, m, n0, fr, fq); wi_st_tr(SLOT(10), a2t, m, n0, fr, fq); }
        HBAR();
#define WI_LEVEL(XS, XD, NS, NST, ND, NDT) do { WiA aX, aN; WiB bN; f32x4 ax[2]; wi_lda(aX, SLOT(XS), m, fr, fq); wi_ldb(bN, SLOT(NST), n0, fr, fq); wi_lda(aN, SLOT(NS), m, fr, fq); wi_ld_nat_s(ax, SLOT(XS), m, n0, fr, fq); \
            WI_PIN(); f32x4 aqs[2] = {{0.f, 0.f, 0.f, 0.f}, {0.f, 0.f, 0.f, 0.f}}, aqt[2] = {{0.f, 0.f, 0.f, 0.f}, {0.f, 0.f, 0.f, 0.f}}; wi_fma_s(ax, aX, bN); wi_fma_s(aqs, aN, bN); wi_fma(aqt, aN, bN); WI_PIN(); \
            wi_st_nat_s(SLOT(XD), ax, m, n0, fr, fq); wi_st_nat_s(SLOT(ND), aqs, m, n0, fr, fq); wi_st_tr(SLOT(NDT), aqt, m, n0, fr, fq); \
            HBAR(); } while (0)
        WI_LEVEL(11, 0, 9, 10, 7, 8);
        WI_LEVEL(0, 11, 7, 8, 9, 10);
        WI_LEVEL(11, 0, 9, 10, 7, 8);
        WI_LEVEL(0, 11, 7, 8, 9, 10);
#undef WI_LEVEL
        { WiA aX; WiB bN; f32x4 ax[2]; wi_lda(aX, SLOT(11), m, fr, fq); wi_ldb(bN, SLOT(10), n0, fr, fq); wi_ld_nat(ax, SLOT(11), m, n0, fr, fq); WI_PIN();
          wi_fma(ax, aX, bN); WI_PIN(); wi_st_tr(SLOT(0), ax, m, n0, fr, fq); }
        HBAR();
        { WiA aNk, aAt; WiB bT; wi_lda(aNk, SLOT(6), m, fr, fq); wi_lda(aAt, SLOT(1), m, fr, fq); wi_ldb(bT, SLOT(0), n0, fr, fq); WI_PIN();
          f32x4 aw[2] = {{0.f, 0.f, 0.f, 0.f}, {0.f, 0.f, 0.f, 0.f}}, aa[2] = {{0.f, 0.f, 0.f, 0.f}, {0.f, 0.f, 0.f, 0.f}}; wi_fma_s(aw, aNk, bT); wi_fma_s(aa, aAt, bT); WI_PIN();
          wi_st_nat_s(SLOT(2), aw, m, n0, fr, fq); wi_st_nat_s(SLOT(7), aa, m, n0, fr, fq); }
        HBAR();
        { WiA aAT, aW1; WiB bB, bM; f32x4 ap[2] = {{0.f, 0.f, 0.f, 0.f}, {0.f, 0.f, 0.f, 0.f}}, az[2], ag[2], az2[2]; float gl[2];
          wi_lda(aAT, SLOT(7), m, fr, fq); wi_lda(aW1, SLOT(2), m, fr, fq); wi_ldb(bB, SLOT(3), n0, fr, fq); wi_ldb(bM, SLOT(13), n0, fr, fq);
          wi_ld_nat(az, SLOT(4), m, n0, fr, fq); wi_ld_tr(az2, SLOT(14), m, n0, fr, fq); wi_ld_tr(ag, SLOT(12), m, n0, fr, fq);
#pragma unroll
          for (int n = 0; n < 2; ++n) gl[n] = GL[n0 + 16 * n + fr];
          WI_PIN();
          wi_fma(ap, aAT, bB); wi_fma(az, aW1, bB); wi_fma(ag, aAT, bM); wi_fma(az2, aW1, bM);
          WI_PIN();
          wi_st_tr(SLOT(8), az, m, n0, fr, fq); wi_st_tr(SLOT(9), az2, m, n0, fr, fq);
          bf16* PTp = (bf16*)ST + (size_t)(h * NCH + ch) * 4096; bf16* GMp = gm_ptr(a.ws, h, ch);
#pragma unroll
          for (int n = 0; n < 2; ++n) { const int col = n0 + 16 * n + fr; f32x4 pv = ap[n];
#pragma unroll
              for (int i = 0; i < 4; ++i) { if (16 * m + 4 * fq + i == col) pv[i] += 1.0f; pv[i] *= gl[n]; }
              u32x2 w; w.x = pk2(pv[0], pv[1]); w.y = pk2(pv[2], pv[3]); *(u32x2*)(PTp + col * 64 + 16 * m + 4 * fq) = w;
              u32x2 w2; w2.x = pk2(ag[n][0], ag[n][1]); w2.y = pk2(ag[n][2], ag[n][3]); *(u32x2*)(GMp + col * 64 + 16 * m + 4 * fq) = w2; } }
        HBAR();
        { WiA aV; WiB bZ1, bZ2; float gl[2]; wi_lda(aV, SLOT(5), m, fr, fq); wi_ldb(bZ1, SLOT(8), n0, fr, fq); wi_ldb(bZ2, SLOT(9), n0, fr, fq); gl[0] = GL[n0 + fr]; gl[1] = GL[n0 + 16 + fr]; WI_PIN();
          f32x4 aq[2] = {{0.f, 0.f, 0.f, 0.f}, {0.f, 0.f, 0.f, 0.f}}, ay[2] = {{0.f, 0.f, 0.f, 0.f}, {0.f, 0.f, 0.f, 0.f}}; wi_fma(aq, aV, bZ1); wi_fma(ay, aV, bZ2); WI_PIN();
          float* QTp = ST + ST_Q_OFF + (size_t)(h * NCH + ch) * 4096; bf16* Y0p = (bf16*)(a.ws + WS_Y0) + (size_t)(h * NCH + ch) * 4096;
#pragma unroll
          for (int n = 0; n < 2; ++n) { const int col = n0 + 16 * n + fr; *(f32x4*)(QTp + col * 64 + 16 * m + 4 * fq) = aq[n] * gl[n];
              u32x2 w; w.x = pk2(ay[n][0], ay[n][1]); w.y = pk2(ay[n][2], ay[n][3]); *(u32x2*)(Y0p + col * 64 + 16 * m + 4 * fq) = w; } }
        HBAR();
    }
#undef SLOT
#undef WI_FETCH
}

__device__ __forceinline__ void phase_scan3m(ArgsR a, const Ctx& c, int l) {
    const f16* R = (const f16*)(a.ws + WS_R); const f16* KP = (const f16*)(a.ws + WS_KP); const f16* V = (const f16*)(a.ws + WS_V); const bf16* G = (const bf16*)(a.ws + WS_G);
    bf16* YA = (bf16*)(a.ws + WS_YA);
    LAS3 unsigned char* L = (LAS3 unsigned char*)c.lds;
    LAS3 float* YL = (LAS3 float*)(L + WI_B);
    const int lane = c.lane, wv = c.wave, fr = lane & 15, fq = lane >> 4, m = wv >> 1, n0 = 32 * (wv & 1), tid = c.tid;
    u32x4 pS; bf16x8 pB[2][2]; u32x2 pY[2];
#define S3_FETCH(it) do { const int h_ = (it) / NCH, ch_ = (it) % NCH; pS = (u32x4){0u, 0u, 0u, 0u}; if (ch_ > 0) pS = *(const u32x4*)((const bf16*)(a.ws + WS_ST) + (size_t)(h_ * NCH + ch_ - 1) * 4096 + tid * 8); \
        const bf16* G_ = gm_ptr(a.ws, h_, ch_); const bf16* Y_ = (const bf16*)(a.ws + WS_Y0) + (size_t)(h_ * NCH + ch_) * 4096; \
        _Pragma("unroll") for (int ks = 0; ks < 2; ++ks) _Pragma("unroll") for (int n = 0; n < 2; ++n) pB[ks][n] = *(const bf16x8*)(G_ + (n0 + 16 * n + fr) * 64 + 32 * ks + 8 * fq); \
        _Pragma("unroll") for (int n = 0; n < 2; ++n) pY[n] = *(const u32x2*)(Y_ + (n0 + 16 * n + fr) * 64 + 16 * m + 4 * fq); } while (0)
    if (blockIdx.x < NH * NCH) S3_FETCH(blockIdx.x);
    for (int item = blockIdx.x; item < NH * NCH; item += gridDim.x) {
        const int h = item / NCH, ch = item % NCH;
        *(LAS3 u32x4*)(L + ((tid >> 3) * WI_LD + (tid & 7) * 8) * 2) = pS;
        bf16x8 bfr[2][2]; f32x4 acc[2];
#pragma unroll
        for (int ks = 0; ks < 2; ++ks)
#pragma unroll
            for (int n = 0; n < 2; ++n) bfr[ks][n] = pB[ks][n];
#pragma unroll
        for (int n = 0; n < 2; ++n) { acc[n][0] = __uint_as_float(pY[n].x << 16); acc[n][1] = __uint_as_float(pY[n].x & 0xffff0000u); acc[n][2] = __uint_as_float(pY[n].y << 16); acc[n][3] = __uint_as_float(pY[n].y & 0xffff0000u); }
        if (item + (int)gridDim.x < NH * NCH) S3_FETCH(item + (int)gridDim.x);
        HBAR();
#pragma unroll
        for (int ks = 0; ks < 2; ++ks) { const bf16x8 av = *(const LAS3 bf16x8*)(L + ((16 * m + fr) * WI_LD + 32 * ks + 8 * fq) * 2);
#pragma unroll
            for (int n = 0; n < 2; ++n) acc[n] = __builtin_amdgcn_mfma_f32_16x16x32_bf16(av, bfr[ks][n], acc[n], 0, 0, 0); }
#pragma unroll
        for (int n = 0; n < 2; ++n)
#pragma unroll
            for (int i = 0; i < 4; ++i) YL[(n0 + 16 * n + fr) * 65 + 16 * m + 4 * fq + i] = acc[n][i];
        HBAR();
        { const float gn_g = a.in[I_GNG][l * W + h * 64 + lane], gn_b = a.in[I_GNB][l * W + h * 64 + lane], r_k = a.in[I_RK][l * W + h * 64 + lane];
          f16 rl8[8], kl8[8], vl8[8]; bf16 gl8[8];
#pragma unroll
          for (int i = 0; i < 8; ++i) { const size_t o = (size_t)(ch * CL + 8 * wv + i) * W + h * 64 + lane; rl8[i] = R[o]; kl8[i] = KP[o]; vl8[i] = V[o]; gl8[i] = G[o]; }
#pragma unroll
          for (int i = 0; i < 8; ++i) { const int t = 8 * wv + i; const size_t o = (size_t)(ch * CL + t) * W + h * 64 + lane;
              const float yy = YL[t * 65 + lane]; const float rl = (float)rl8[i], kl = (float)kl8[i], vl = (float)vl8[i], gl = bf2f(gl8[i]);
              const float mean = wave_sum(yy) * (1.f / 64.f); const float dd = yy - mean; const float var = wave_sum(dd * dd) * (1.f / 64.f);
              const float bonus = wave_sum(rl * kl * r_k);
              const float yn = dd * __builtin_amdgcn_rsqf(var + GN_EPS) * gn_g + gn_b + bonus * vl;
              YA[o] = f2bf(yn * gl); } }
        HBAR();
    }
}

__device__ __forceinline__ void phase_scan3(ArgsR a, const Ctx& c, int l) {
    const f16* R = (const f16*)(a.ws + WS_R); const f16* WM1 = (const f16*)(a.ws + WS_WM1); const f16* KP = (const f16*)(a.ws + WS_KP);
    const f16* AA = (const f16*)(a.ws + WS_AA); const f16* BB = (const f16*)(a.ws + WS_BB); const f16* V = (const f16*)(a.ws + WS_V);
    const float* ST = (const float*)(a.ws + WS_ST); bf16* YA = (bf16*)(a.ws + WS_YA); const f16* Gs = (const f16*)(a.ws + WS_G);
    const int lane = c.lane;
    LAS3 unsigned char* ring = (LAS3 unsigned char*)c.lds + c.wave * SC_WAVE;
    for (int item = c.gw; item < NH * NCH; item += c.ngw) {
        const int h = __builtin_amdgcn_readfirstlane(item / NCH), ch = __builtin_amdgcn_readfirstlane(item % NCH);
        const size_t lane_off = (size_t)(lane >> 3) * W + h * 64 + (lane & 7) * 8;
        const float gn_g = a.in[I_GNG][l * W + h * 64 + lane], gn_b = a.in[I_GNB][l * W + h * 64 + lane], r_k = a.in[I_RK][l * W + h * 64 + lane];
        { const size_t e0 = (size_t)(ch * CL) * W + lane_off;
          sc_dma(AA, e0, ring); sc_dma(WM1, e0, ring + 1024); sc_dma(BB, e0, ring + 2048); sc_dma(KP, e0, ring + 3072); sc_dma(V, e0, ring + 4096); sc_dma(R, e0, ring + 5120); sc_dma(Gs, e0, ring + 6144); }
        float S[64];
        if (ch == 0) {
#pragma unroll
            for (int j = 0; j < 64; ++j) S[j] = 0.f;
        } else { const bf16* Sp = (const bf16*)ST + ((size_t)(h * NCH + ch - 1) * 64 + lane) * 64;
#pragma unroll
            for (int j = 0; j < 64; j += 4) { const f32x4 x = load4bf(Sp + j); S[j] = x[0]; S[j + 1] = x[1]; S[j + 2] = x[2]; S[j + 3] = x[3]; } }
#pragma unroll 1
        for (int blk = 0; blk < CL / SCB; ++blk) {
            LAS3 unsigned char* buf = ring + (blk & 1) * SC_BUF;
            if (blk + 1 < CL / SCB) { LAS3 unsigned char* nb = ring + ((blk + 1) & 1) * SC_BUF; const size_t e0 = (size_t)(ch * CL + (blk + 1) * SCB) * W + lane_off;
                sc_dma(AA, e0, nb); sc_dma(WM1, e0, nb + 1024); sc_dma(BB, e0, nb + 2048); sc_dma(KP, e0, nb + 3072); sc_dma(V, e0, nb + 4096); sc_dma(R, e0, nb + 5120); sc_dma(Gs, e0, nb + 6144);
                asm volatile("s_waitcnt vmcnt(7)" ::: "memory"); }
            else asm volatile("s_waitcnt vmcnt(0)" ::: "memory");
            SVec A, Wv, Bv, Kv, Rv;
            sv_cvt(A, sv_read(buf, lane)); sv_cvt1p(Wv, sv_read(buf + 1024, lane)); sv_cvt(Bv, sv_read(buf + 2048, lane)); sv_cvt(Kv, sv_read(buf + 3072, lane)); sv_cvt(Rv, sv_read(buf + 5120, lane));
            float vv = (float)*(const LAS3 f16*)(buf + 4096 + lane * 2);
#pragma unroll 1
            for (int st = 0; st < SCB; ++st) {
                const LAS3 unsigned char* sn = buf + ((st + 1 < SCB) ? st + 1 : st) * 128;
                const f16x4 ha = sv_read(sn, lane), hw = sv_read(sn + 1024, lane), hb = sv_read(sn + 2048, lane), hk = sv_read(sn + 3072, lane), hr = sv_read(sn + 5120, lane);
                const f16 hv = *(const LAS3 f16*)(sn + 4096 + lane * 2);
                float d[4] = {0.f, 0.f, 0.f, 0.f};
                sc_dot<0>(d, A, S);
                const float sa = (d[0] + d[1]) + (d[2] + d[3]);
                float y[4] = {0.f, 0.f, 0.f, 0.f};
                sc_upd3<0>(S, y, Wv, Bv, Kv, Rv, sa, vv);
                const float yy = (y[0] + y[1]) + (y[2] + y[3]);
                sv_cvt(A, ha); sv_cvt1p(Wv, hw); sv_cvt(Bv, hb); sv_cvt(Kv, hk); sv_cvt(Rv, hr); vv = (float)hv;
                { const LAS3 unsigned char* sb = buf + st * 128;
                  const float rl = (float)*(const LAS3 f16*)(sb + 5120 + lane * 2), kl = (float)*(const LAS3 f16*)(sb + 3072 + lane * 2), vl = (float)*(const LAS3 f16*)(sb + 4096 + lane * 2);
                  const float gl = bf2f(*(const LAS3 bf16*)(sb + 6144 + lane * 2));
                  const float mean = wave_sum(yy) * (1.f / 64.f); const float dd = yy - mean; const float var = wave_sum(dd * dd) * (1.f / 64.f);
                  const float bonus = wave_sum(rl * kl * r_k);
                  const float yn = dd * __builtin_amdgcn_rsqf(var + GN_EPS) * gn_g + gn_b + bonus * vl;
                  YA[(size_t)(ch * CL + blk * SCB + st) * W + h * 64 + lane] = f2bf(yn * gl); }
            }
        }
    }
}
#undef S3_FETCH

__device__ __forceinline__ void phase_post(ArgsR a, const Ctx& c, int l) {
    const bf16* YSC = (const bf16*)(a.ws + WS_YSC); const f16* R = (const f16*)(a.ws + WS_R); const f16* KP = (const f16*)(a.ws + WS_KP); const f16* V = (const f16*)(a.ws + WS_V);
    const bf16* G = (const bf16*)(a.ws + WS_G); bf16* YA = (bf16*)(a.ws + WS_YA);
    const float* gng = a.in[I_GNG] + l * W; const float* gnb = a.in[I_GNB] + l * W; const float* rk = a.in[I_RK] + l * W;
    for (int t = c.gw; t < T; t += c.ngw) {
#pragma unroll
        for (int i = 0; i < 8; ++i) { const int n = c.lane + 64 * i; const size_t o = (size_t)t * W + n;
            const float y = bf2f(YSC[o]); const float mean = wave_sum(y) * (1.f / 64.f); const float d = y - mean; const float var = wave_sum(d * d) * (1.f / 64.f);
            float yn = d * __builtin_amdgcn_rsqf(var + GN_EPS) * gng[n] + gnb[n];
            const float r = (float)R[o], k = (float)KP[o], v = (float)V[o];
            const float bonus = wave_sum(r * k * rk[n]);
            yn += bonus * v;
            YA[o] = f2bf(yn * bf2f(G[o])); }
    }
}

__device__ __forceinline__ void phase_ln1(ArgsR a, const Ctx& c, int l, float* outw, int mode = 3) {
    const float* MODF = (const float*)(a.ws + WS_MODF) + l * 6144;
    const float* g1 = a.in[I_LN1G] + l * D; const float* b1 = a.in[I_LN1B] + l * D;
    bf16* XN = (bf16*)(a.ws + WS_XN);
    int* TOKI = (int*)(a.ws + WS_TOKI); float* TOKW = (float*)(a.ws + WS_TOKW); int* TOKP = (int*)(a.ws + WS_TOKP);
    const float* rw = a.in[I_RW]; const float* rb = a.in[I_RB];
    LAS3 float* rwT = (LAS3 float*)((LAS3 unsigned char*)c.lds + 69632);
    unsigned* lcnt = (unsigned*)(c.lds + 135168);
    if (mode & 1) {
    for (int i = c.tid; i < D * NE; i += NTHREADS) rwT[(i & 15) * D + (i >> 4)] = rw[i];
    if (c.tid < NE) lcnt[c.tid] = 0u;
    __syncthreads();
    float vn[16]; if (c.gw < T) load_row16(a.out + (size_t)c.gw * D, c.lane, vn);
    for (int m = c.gw; m < T; m += c.ngw) {
        int l4 = 4 * c.lane; asm volatile("" : "+v"(l4));
        float v[16];
#pragma unroll
        for (int j = 0; j < 16; ++j) v[j] = vn[j];
        if (m + c.ngw < T) load_row16(a.out + (size_t)(m + c.ngw) * D, c.lane, vn);
        float mean, rstd; row_stats(v, mean, rstd);
#pragma unroll
        for (int j = 0; j < 4; ++j) { f32x4 o; const int col = l4 + 256 * j;
#pragma unroll
            for (int e = 0; e < 4; ++e) { v[4 * j + e] = (v[4 * j + e] - mean) * rstd * g1[col + e] + b1[col + e]; o[e] = v[4 * j + e]; }
            *(f32x4*)(outw + (size_t)m * D + col) = o; }
        row_stats(v, mean, rstd);
#pragma unroll
        for (int j = 0; j < 4; ++j) { f32x4 o; const int col = l4 + 256 * j;
#pragma unroll
            for (int e = 0; e < 4; ++e) { v[4 * j + e] = (v[4 * j + e] - mean) * rstd * (1.0f + MODF[4096 + col + e]) + MODF[3072 + col + e]; o[e] = v[4 * j + e]; }
            store4bf(XN + (size_t)m * D + col, o); }
        float lg[16];
#pragma unroll
        for (int e = 0; e < 16; ++e) { float x = 0.f;
#pragma unroll
            for (int j = 0; j < 4; ++j) { const f32x4 r4 = *(const LAS3 f32x4*)(rwT + e * D + l4 + 256 * j); x += (v[4 * j] * r4[0] + v[4 * j + 1] * r4[1]) + (v[4 * j + 2] * r4[2] + v[4 * j + 3] * r4[3]); }
            lg[e] = x;
            if ((e & 3) == 3) __builtin_amdgcn_sched_barrier(0); }
        float r8[8], r4v[4], r2[2], r1;
        { const bool b5 = (c.lane & 32) != 0, b4 = (c.lane & 16) != 0, b3 = (c.lane & 8) != 0, b2 = (c.lane & 4) != 0;
#pragma unroll
          for (int i = 0; i < 8; ++i) { const float snd = b5 ? lg[i] : lg[i + 8], kp = b5 ? lg[i + 8] : lg[i]; r8[i] = kp + __shfl_xor(snd, 32); }
#pragma unroll
          for (int i = 0; i < 4; ++i) { const float snd = b4 ? r8[i] : r8[i + 4], kp = b4 ? r8[i + 4] : r8[i]; r4v[i] = kp + __shfl_xor(snd, 16); }
#pragma unroll
          for (int i = 0; i < 2; ++i) { const float snd = b3 ? r4v[i] : r4v[i + 2], kp = b3 ? r4v[i + 2] : r4v[i]; r2[i] = kp + __shfl_xor(snd, 8); }
          { const float snd = b2 ? r2[0] : r2[1], kp = b2 ? r2[1] : r2[0]; r1 = kp + __shfl_xor(snd, 4); }
          r1 += __shfl_xor(r1, 2); r1 += __shfl_xor(r1, 1); }
        float sc[16], sel[16];
#pragma unroll
        for (int e = 0; e < 16; ++e) { const float lgt = __shfl(r1, 4 * e); sc[e] = __builtin_amdgcn_rcpf(1.0f + __expf(-lgt)); sel[e] = sc[e] + rb[e]; }
        int best = 0; float bestv = -INFINITY;
#pragma unroll
        for (int g = 0; g < 4; ++g) { float m1 = -INFINITY, m2 = -INFINITY;
#pragma unroll
            for (int q = 0; q < 4; ++q) { const float sv = sel[4 * g + q]; if (sv > m1) { m2 = m1; m1 = sv; } else if (sv > m2) m2 = sv; }
            const float gs = m1 + m2; if (gs > bestv) { bestv = gs; best = g; } }
        int i1 = 0, i2 = 0; float s1 = -INFINITY, s2 = -INFINITY, w1 = 0.f, w2 = 0.f;
#pragma unroll
        for (int e = 0; e < 16; ++e) { if ((e >> 2) == best) { const float sv = sel[e];
                if (sv > s1) { s2 = s1; i2 = i1; w2 = w1; s1 = sv; i1 = e; w1 = sc[e]; } else if (sv > s2) { s2 = sv; i2 = e; w2 = sc[e]; } } }
        if (c.lane == 0) { const float ws = w1 + w2;
            TOKI[2 * m] = i1; TOKI[2 * m + 1] = i2; TOKW[2 * m] = w1 / ws; TOKW[2 * m + 1] = w2 / ws;
            TOKP[2 * m] = (int)atomicAdd(&lcnt[i1], 1u); TOKP[2 * m + 1] = (int)atomicAdd(&lcnt[i2], 1u); }
    }
    __syncthreads();
    if (c.tid < NE) ((int*)(a.ws + WS_BLKCNT))[blockIdx.x * NE + c.tid] = (int)lcnt[c.tid];
    __syncthreads();
    }
}

__device__ __forceinline__ void expert_convert(ArgsR a, const Ctx& c, int l, int b0) {
    if ((int)blockIdx.x < b0) return;
    float* scr = (float*)(c.lds + c.wave * 8704);
    bf16* WGU = (bf16*)(a.ws + WS_WGU); bf16* WD = (bf16*)(a.ws + WS_WD);
    constexpr int IG = (D / 64) * (FF / 32);
    constexpr int ID = (FF / 64) * (D / 32);
    const int gw0 = ((int)blockIdx.x - b0) * NWAVES + c.wave, ngw0 = ((int)gridDim.x - b0) * NWAVES;
    for (int it = gw0; it < NE * (2 * IG + ID); it += ngw0) {
        const int e = it / (2 * IG + ID); int r = it % (2 * IG + ID);
        const size_t eo = ((size_t)l * NE + e) * (size_t)D * FF;
        if (r < IG) { transpose_matrix_item(a.in[I_EG] + eo, D, FF, WGU + (size_t)e * 1024 * 1024, r, scr, c.lane, RowGU{0}); continue; } r -= IG;
        if (r < IG) { transpose_matrix_item(a.in[I_EU] + eo, D, FF, WGU + (size_t)e * 1024 * 1024, r, scr, c.lane, RowGU{1}); continue; } r -= IG;
        transpose_matrix_item(a.in[I_ED] + eo, FF, D, WD + (size_t)e * 1024 * 512, r, scr, c.lane, RowId());
    }
}

__device__ __forceinline__ void phase_perm(ArgsR a, const Ctx& c, int l) {
    const int* BLKCNT = (const int*)(a.ws + WS_BLKCNT);
    LAS3 int* pre = (LAS3 int*)c.lds;
    LAS3 int* tot = pre + 256 * NE;
    const int nb = gridDim.x;
#pragma unroll
    for (int q = 0; q < 2; ++q) { const int e = 2 * c.wave + q; int v[4]; int sum = 0;
#pragma unroll
        for (int i = 0; i < 4; ++i) { const int b = 4 * c.lane + i; v[i] = b < nb ? BLKCNT[b * NE + e] : 0; sum += v[i]; }
        int inc = sum;
#pragma unroll
        for (int o = 1; o < 64; o <<= 1) { const int t = __shfl_up(inc, o); if (c.lane >= o) inc += t; }
        int run = inc - sum;
#pragma unroll
        for (int i = 0; i < 4; ++i) { pre[(4 * c.lane + i) * NE + e] = run; run += v[i]; }
        if (c.lane == 63) tot[e] = inc; }
    __syncthreads();
    int ts[17]; { int sacc = 0;
#pragma unroll
        for (int e = 0; e < 16; ++e) { ts[e] = sacc; sacc += (tot[e] + 255) >> 8; } ts[16] = sacc; }
    if (blockIdx.x == 0 && c.tid < NE) ((int*)(a.ws + WS_TOT))[c.tid] = tot[c.tid];
    const int* TOKI = (const int*)(a.ws + WS_TOKI); const int* TOKP = (const int*)(a.ws + WS_TOKP); int* S2T = (int*)(a.ws + WS_S2T);
    const bf16* XN = (const bf16*)(a.ws + WS_XN); bf16* XS = (bf16*)(a.ws + WS_XS);
    for (int as = blockIdx.x * NTHREADS + c.tid; as < 2 * T; as += gridDim.x * NTHREADS) {
        const int e = TOKI[as]; int base = 0;
#pragma unroll
        for (int j = 0; j < 16; ++j) base = (j == e) ? ts[j] : base;
        const int m = as >> 1, blk = (m % c.ngw) >> 3;
        S2T[base * 256 + pre[blk * NE + e] + TOKP[as]] = as;
    }
    for (int e = 0; e < 16; ++e) {
        int tse = 0, tsn = 0;
#pragma unroll
        for (int j = 0; j < 16; ++j) { tse = (j == e) ? ts[j] : tse; tsn = (j == e) ? ts[j + 1] : tsn; }
        const int lo = tse * 256 + tot[e], hi = tsn * 256;
        for (int sl = lo + blockIdx.x * NTHREADS + c.tid; sl < hi; sl += gridDim.x * NTHREADS) S2T[sl] = -1;
    }
    __syncthreads();
}

__device__ __forceinline__ void phase_ln2(ArgsR a, const Ctx& c, int l, float* outw) {
    const float* MODF = (const float*)(a.ws + WS_MODF) + l * 6144;
    const float* g2 = a.in[I_LN2G] + l * D; const float* b2 = a.in[I_LN2B] + l * D;
    const bf16* Y = (const bf16*)(a.ws + WS_Y); bf16* XN = (bf16*)(a.ws + WS_XN);
    float vn[16]; u32x2 y0n[4], y1n[4];
    if (c.gw < T) { load_row16(a.out + (size_t)c.gw * D, c.lane, vn);
#pragma unroll
        for (int j = 0; j < 4; ++j) { y0n[j] = *(const u32x2*)(Y + (size_t)(2 * c.gw) * D + 4 * c.lane + 256 * j); y1n[j] = *(const u32x2*)(Y + (size_t)(2 * c.gw + 1) * D + 4 * c.lane + 256 * j); } }
    for (int m = c.gw; m < T; m += c.ngw) {
        float v[16]; u32x2 y0[4], y1[4];
#pragma unroll
        for (int j = 0; j < 16; ++j) v[j] = vn[j];
#pragma unroll
        for (int j = 0; j < 4; ++j) { y0[j] = y0n[j]; y1[j] = y1n[j]; }
        if (m + c.ngw < T) { const int mn = m + c.ngw; load_row16(a.out + (size_t)mn * D, c.lane, vn);
#pragma unroll
            for (int j = 0; j < 4; ++j) { y0n[j] = *(const u32x2*)(Y + (size_t)(2 * mn) * D + 4 * c.lane + 256 * j); y1n[j] = *(const u32x2*)(Y + (size_t)(2 * mn + 1) * D + 4 * c.lane + 256 * j); } }
#pragma unroll
        for (int j = 0; j < 4; ++j) { const int col = 4 * c.lane + 256 * j;
            const float a0 = __uint_as_float(y0[j].x << 16) + __uint_as_float(y1[j].x << 16), a1 = __uint_as_float(y0[j].x & 0xffff0000u) + __uint_as_float(y1[j].x & 0xffff0000u);
            const float a2 = __uint_as_float(y0[j].y << 16) + __uint_as_float(y1[j].y << 16), a3 = __uint_as_float(y0[j].y & 0xffff0000u) + __uint_as_float(y1[j].y & 0xffff0000u);
            const f32x4 gt = *(const f32x4*)(MODF + 5120 + col);
            v[4 * j] = ALPHA * v[4 * j] + (1.0f + gt[0]) * a0; v[4 * j + 1] = ALPHA * v[4 * j + 1] + (1.0f + gt[1]) * a1; v[4 * j + 2] = ALPHA * v[4 * j + 2] + (1.0f + gt[2]) * a2; v[4 * j + 3] = ALPHA * v[4 * j + 3] + (1.0f + gt[3]) * a3; }
        float mean, rstd; row_stats(v, mean, rstd);
#pragma unroll
        for (int j = 0; j < 4; ++j) { f32x4 o; const int col = 4 * c.lane + 256 * j;
#pragma unroll
            for (int e = 0; e < 4; ++e) { v[4 * j + e] = (v[4 * j + e] - mean) * rstd * g2[col + e] + b2[col + e]; o[e] = v[4 * j + e]; }
            *(f32x4*)(outw + (size_t)m * D + col) = o; }
        if (l + 1 < DEPTH) {
            const float* MN = MODF + 6144;
            row_stats(v, mean, rstd);
#pragma unroll
            for (int j = 0; j < 4; ++j) { f32x4 o; const int col = 4 * c.lane + 256 * j;
#pragma unroll
                for (int e = 0; e < 4; ++e) o[e] = (v[4 * j + e] - mean) * rstd * (1.0f + MN[1024 + col + e]) + MN[col + e];
                store4bf(XN + (size_t)m * D + col, o); }
        }
    }
}


template <class F> struct EpiAdapt {
    static constexpr bool PERM = true, AFTER_DRAIN = false; F f;
    __device__ __forceinline__ void operator()(const f32x4 (&acc)[2][2][4][2], const Unit& u, int wr, int wc, int fr, int fq) const {
        const int col = u.pn * 256 + wc * 32 + 8 * fq;
#pragma unroll
        for (int ai = 0; ai < 2; ++ai)
#pragma unroll
            for (int m = 0; m < 4; ++m) { const int row = u.pm * 256 + ai * 128 + wr * 64 + m * 16 + fr; f(row, col, acc[ai][0][m][0], acc[ai][0][m][1], acc[ai][1][m][0], acc[ai][1][m][1]); }
    }
};

template <class Sched, class F>
__device__ __forceinline__ void gemm_gather(const Ctx& c, const bf16* A, const int* s2t, const bf16* Bt, int M, int N, int K, const Sched& S, const F& f) {
    pg8::Gemm g{A, Bt, M, N, K}; EpiAdapt<F> E{f};
    pg8::gemm_phase<EpiAdapt<F>, Sched, true, true, true>((PG8_LAS unsigned char*)c.lds, g, S, E, c.tid, s2t);
}
template <class Sched, class F>
__device__ __forceinline__ void gemm_any(const Ctx& c, const bf16* A, const bf16* Bt, int M, int N, int K, const Sched& S, const F& f) {
    pg8::Gemm g{A, Bt, M, N, K}; EpiAdapt<F> E{f};
    pg8::gemm_phase<EpiAdapt<F>, Sched, true, true>((PG8_LAS unsigned char*)c.lds, g, S, E, c.tid);
}

#define LAS __attribute__((address_space(3)))
#define XB_TMO      128
#define XB_XCNT(j)  (256  + 64 * (j))
#define XB_XSUB(j)  (1280 + 64 * (j))
#define XB_XGEN(j)  (2304 + 64 * (j))
#define XB_TOP      3328
#define XB_TOPGEN   3392
#define XCD_BAR_WORDS 3456
#define XB_SPIN_CAP (1u << 24)

__device__ __forceinline__ unsigned xb_ld(unsigned* p)              { return __hip_atomic_load(p, __ATOMIC_RELAXED, __HIP_MEMORY_SCOPE_AGENT); }
__device__ __forceinline__ unsigned xb_add(unsigned* p, unsigned v) { return __hip_atomic_fetch_add(p, v, __ATOMIC_RELAXED, __HIP_MEMORY_SCOPE_AGENT); }
__device__ __forceinline__ unsigned xb_xcc_id() { return (unsigned)__builtin_amdgcn_s_getreg((3 << 11) | 20) & 0xFu; }
#define XB_SPIN(cond, bar) do { unsigned _sp = 0; while (cond) { __builtin_amdgcn_s_sleep(1); \
    if ((++_sp & 255u) == 0u) { if (xb_ld(&(bar)[XB_TMO])) break; if (_sp > XB_SPIN_CAP) { atomicAdd(&(bar)[XB_TMO], 1u); break; } } } } while (0)

struct XcdBarrier {
    unsigned* bar; unsigned x;
    volatile LAS unsigned* st;
};

__device__ __forceinline__ XcdBarrier xcd_barrier_post(unsigned* bar, volatile LAS unsigned* st) {
    XcdBarrier b; b.bar = bar; b.x = xb_xcc_id(); b.st = st;
    if (threadIdx.x == 0) (void)xb_add(&bar[XB_XCNT(b.x)], 1u);
    return b;
}
__device__ __forceinline__ void xcd_barrier_complete(unsigned* bar, unsigned x, unsigned& nloc, unsigned& nx) {
    const unsigned G = gridDim.x * gridDim.y * gridDim.z;
    unsigned sum, cnt, mine, sp = 0u;
    for (;;) {
        sum = 0u; cnt = 0u; mine = 0u;
#pragma unroll
        for (unsigned j = 0; j < 16; ++j) { const unsigned c = xb_ld(&bar[XB_XCNT(j)]); sum += c; cnt += (c > 0u) ? 1u : 0u; mine = (j == x) ? c : mine; }
        if (sum == G) break;
        __builtin_amdgcn_s_sleep(1);
        if ((++sp & 255u) == 0u) { if (xb_ld(&bar[XB_TMO])) break; if (sp > XB_SPIN_CAP) { atomicAdd(&bar[XB_TMO], 1u); break; } }
    }
    nloc = mine > 0u ? mine : 1u; nx = cnt > 0u ? cnt : 1u;
}

__device__ __forceinline__ void xcd_barrier(const XcdBarrier& b) {
    asm volatile("s_waitcnt vmcnt(0)" ::: "memory");
    __syncthreads();
    if (threadIdx.x == 0) {
        unsigned* bar = b.bar;
        __builtin_amdgcn_s_waitcnt(0);
        unsigned nloc = b.st[0], nx = b.st[1];
        if (nloc == 0u) { xcd_barrier_complete(bar, b.x, nloc, nx); b.st[0] = nloc; b.st[1] = nx; }
        const unsigned old = xb_add(&bar[XB_XSUB(b.x)], 1u);
        const unsigned gen = old / nloc;
        if (old + 1u == (gen + 1u) * nloc) {
            __builtin_amdgcn_fence(__ATOMIC_RELEASE, "agent");
            asm volatile("s_waitcnt vmcnt(0)" ::: "memory");
            const unsigned og = xb_add(&bar[XB_TOP], 1u);
            const unsigned tg = og / nx;
            if (og + 1u == (tg + 1u) * nx) xb_add(&bar[XB_TOPGEN], 1u);
            else XB_SPIN(xb_ld(&bar[XB_TOPGEN]) == tg, bar);
            __builtin_amdgcn_fence(__ATOMIC_ACQUIRE, "agent");
            xb_add(&bar[XB_XGEN(b.x)], 1u);
            asm volatile("s_waitcnt vmcnt(0)" ::: "memory");
        } else {
            XB_SPIN(xb_ld(&bar[XB_XGEN(b.x)]) == gen, bar);
            __builtin_amdgcn_fence(__ATOMIC_ACQUIRE, "agent");
            asm volatile("s_waitcnt vmcnt(0)" ::: "memory");
        }
    }
    __syncthreads();
}


constexpr int PH_PER_LAYER = 12, N_PHASES = 2 + PH_PER_LAYER * DEPTH;
constexpr int CW_BAR = 4096;
constexpr int LDS_BYTES = 147456, LDSCTL_OFF = 131072 + 8192;
#ifndef SINGLE_LAUNCH
#define SINGLE_LAUNCH 1
#endif

#ifndef PROBE_A
#define PROBE_A -1
#endif
#ifndef PROBE_B
#define PROBE_B -1
#endif
constexpr size_t WS_TS = 512 * 1024;
#if PROBE_A >= 0
#define STAMP(i) do { if (blockIdx.x == 0 && threadIdx.x == 0) ((unsigned long long*)(args_here()->ws + WS_TS))[(i)] = __builtin_amdgcn_s_memrealtime(); } while (0)
#else
#define STAMP(i) do { } while (0)
#endif
__device__ __forceinline__ const __attribute__((address_space(4))) Args* args_here() { const __attribute__((address_space(4))) Args* p = (const __attribute__((address_space(4))) Args*)__builtin_amdgcn_kernarg_segment_ptr(); asm volatile("" : "+s"(p)); return p; }
#ifndef REP_K
#define REP_K -1
#endif
__device__ __forceinline__ Ctx mkctx(int wave_s, unsigned char* lds) { Ctx c; c.wave = wave_s; c.lane = (int)__builtin_amdgcn_mbcnt_hi(~0u, __builtin_amdgcn_mbcnt_lo(~0u, 0u)); c.tid = wave_s * 64 + c.lane;
    c.gw = blockIdx.x * NWAVES + wave_s; c.ngw = gridDim.x * NWAVES; c.lds = lds; return c; }
#define PHASE1(k, ...) do { const __attribute__((address_space(4))) Args* ap_ = args_here(); if (ap_->ph_lo <= (k) && (k) < ap_->ph_hi) { ArgsR a = *ap_; const Ctx c = mkctx(wave_s, lds); __VA_ARGS__ } } while (0)
#define PHASE(k, ...) do { PHASE1(k, __VA_ARGS__); if ((k) == REP_K) { xcd_barrier(bar); PHASE1(k, __VA_ARGS__); xcd_barrier(bar); PHASE1(k, __VA_ARGS__); } } while (0)

template <int L>
__device__ __forceinline__ void run_layer(const int wave_s, unsigned char* lds, const XcdBarrier& bar) {
    const int G = gridDim.x, b = blockIdx.x;
#define BAR() do { xcd_barrier(bar); STAMP(3 + 14 * L + (bk_++)); } while (0)
    int bk_ = 0;
    PHASE(0, unsigned char* ws = a.ws; pg8::StaticOrder S; S.init(T, INC, G, b); EpiZ E{(bf16*)(ws + WS_ZR), (bf16*)(ws + WS_ZS), (bf16*)(ws + WS_ZG)};
        gemm_any(c, (const bf16*)(ws + WS_XN), (const bf16*)(ws + WS_WIN + (size_t)L * 10 * MiB), T, INC, D, S, E); );
    BAR();
    PHASE(1, phase_prep_fast(a, c, L); );
    PHASE(14, phase_sg_fast(a, c, L); );
    BAR();
#if REP_K == 21
    PHASE1(2, phase_scan1m(a, c, 1); ); xcd_barrier(bar); PHASE1(2, phase_scan1m(a, c, 1); ); xcd_barrier(bar);
#endif
    PHASE(2, phase_scan1m(a, c); );
    BAR();
    PHASE(3, phase_scan2a(a, c); );
    BAR();
    PHASE(31, phase_scan2b(a, c); );
    PHASE(33, expert_convert(a, c, L, NH); );
    BAR();
    PHASE(32, phase_scan2c(a, c); );
    BAR();
    PHASE(4, phase_scan3m(a, c, L); );
    BAR();
    PHASE(6, unsigned char* ws = a.ws; pg8::StaticOrder S; S.init(T, D, G, b); EpiGA E{(const bf16*)(ws + WS_ZG), (bf16*)(ws + WS_MP)};
        gemm_any(c, (const bf16*)(ws + WS_YA), (const bf16*)(ws + WS_WA + (size_t)L * WS_WL1), T, D, W, S, E); );
    BAR();
#if REP_K == 7
    PHASE1(7, unsigned char* ws = a.ws; pg8::StaticOrder S; S.init(T, D, G, b); EpiGB E{(const bf16*)(ws + WS_ZG), (const bf16*)(ws + WS_MP), (bf16*)(ws + WS_ZR)};
        gemm_any(c, (const bf16*)(ws + WS_YB), (const bf16*)(ws + WS_WB + (size_t)L * WS_WL1), T, D, W, S, E); ); xcd_barrier(bar);
    PHASE1(7, unsigned char* ws = a.ws; pg8::StaticOrder S; S.init(T, D, G, b); EpiGB E{(const bf16*)(ws + WS_ZG), (const bf16*)(ws + WS_MP), (bf16*)(ws + WS_ZR)};
        gemm_any(c, (const bf16*)(ws + WS_YB), (const bf16*)(ws + WS_WB + (size_t)L * WS_WL1), T, D, W, S, E); ); xcd_barrier(bar);
#endif
#if REP_K == 8
    PHASE1(8, unsigned char* ws = a.ws; pg8::StaticOrder S; S.init(T, D, G, b); EpiOut E{L == 0 ? a.in[I_X] : a.out, (float*)(ws + WS_R), (const float*)(ws + WS_MODF) + L * 6144 + 2048};
        gemm_any(c, (const bf16*)(ws + WS_MP), (const bf16*)(ws + WS_WO + (size_t)L * WS_WL1), T, D, D, S, E); ); xcd_barrier(bar);
    PHASE1(8, unsigned char* ws = a.ws; pg8::StaticOrder S; S.init(T, D, G, b); EpiOut E{L == 0 ? a.in[I_X] : a.out, (float*)(ws + WS_R), (const float*)(ws + WS_MODF) + L * 6144 + 2048};
        gemm_any(c, (const bf16*)(ws + WS_MP), (const bf16*)(ws + WS_WO + (size_t)L * WS_WL1), T, D, D, S, E); ); xcd_barrier(bar);
#endif
    PHASE1(7, unsigned char* ws = a.ws; pg8::StaticOrder S; S.init(T, D, G, b); EpiGB E{(const bf16*)(ws + WS_ZG), (const bf16*)(ws + WS_MP), (bf16*)(ws + WS_MP)};
        gemm_any(c, (const bf16*)(ws + WS_YB), (const bf16*)(ws + WS_WB + (size_t)L * WS_WL1), T, D, W, S, E); );
    BAR();
    PHASE1(8, unsigned char* ws = a.ws; pg8::StaticOrder S; S.init(T, D, G, b); EpiOut E{L == 0 ? a.in[I_X] : a.out, a.out, (const float*)(ws + WS_MODF) + L * 6144 + 2048};
        gemm_any(c, (const bf16*)(ws + WS_MP), (const bf16*)(ws + WS_WO + (size_t)L * WS_WL1), T, D, D, S, E); );
    BAR();
#if REP_K == 9
    PHASE1(9, phase_ln1(a, c, L, (float*)(a.ws + WS_ZR)); ); xcd_barrier(bar); PHASE1(9, phase_ln1(a, c, L, (float*)(a.ws + WS_ZR)); ); xcd_barrier(bar);
#endif
#if REP_K == 91
    PHASE1(9, phase_ln1(a, c, L, (float*)(a.ws + WS_ZR), 1); ); xcd_barrier(bar); PHASE1(9, phase_ln1(a, c, L, (float*)(a.ws + WS_ZR), 1); ); xcd_barrier(bar);
#endif
#if REP_K == 92
    PHASE1(9, phase_ln1(a, c, L, (float*)(a.ws + WS_ZR), 2); ); xcd_barrier(bar); PHASE1(9, phase_ln1(a, c, L, (float*)(a.ws + WS_ZR), 2); ); xcd_barrier(bar);
#endif
    PHASE1(9, phase_ln1(a, c, L, a.out); );
    BAR();
    PHASE(10, phase_perm(a, c, L); );
    BAR();
    PHASE(11, unsigned char* ws = a.ws; MoeSched S; S.init((const unsigned*)(ws + WS_TOT), G, b); EpiSwi E{(bf16*)(ws + WS_HID)};
        gemm_gather(c, (const bf16*)(ws + WS_XN), (const int*)(ws + WS_S2T), (const bf16*)(ws + WS_WGU), MAXSLOT, NE * 1024, D, S, E); );
    BAR();
    PHASE(12, unsigned char* ws = a.ws; MoeSched S; S.init((const unsigned*)(ws + WS_TOT), G, b); EpiDown E{(const int*)(ws + WS_S2T), (const float*)(ws + WS_TOKW), (bf16*)(ws + WS_Y)};
        gemm_any(c, (const bf16*)(ws + WS_HID), (const bf16*)(ws + WS_WD), MAXSLOT, NE * 1024, FF, S, E); );
    BAR();
#if REP_K == 13
    PHASE1(13, phase_ln2(a, c, L, (float*)(a.ws + WS_R)); ); xcd_barrier(bar); PHASE1(13, phase_ln2(a, c, L, (float*)(a.ws + WS_R)); ); xcd_barrier(bar);
#endif
    PHASE1(13, phase_ln2(a, c, L, a.out); );
    if (L + 1 < DEPTH) BAR();
    (void)bk_;
#undef BAR
}

__global__ void __launch_bounds__(NTHREADS, 2) mk_fwd(Args a_unused) {
    extern __shared__ __attribute__((aligned(16))) unsigned char lds[];
    const int wave_s = __builtin_amdgcn_readfirstlane(threadIdx.x >> 6);
    for (int u = threadIdx.x; u < (LDS_BYTES - LDSCTL_OFF) / 4; u += NTHREADS) ((LAS unsigned*)((LAS unsigned char*)lds + LDSCTL_OFF))[u] = 0u;
    __syncthreads();
    const XcdBarrier bar = xcd_barrier_post((unsigned*)(args_here()->ws + WS_CTL) + CW_BAR, (volatile LAS unsigned*)((LAS unsigned char*)lds + LDSCTL_OFF) + 8);
    STAMP(0);
    PHASE(100, phase_p0a(a, c); );
    xcd_barrier(bar); STAMP(1);
    PHASE(101, phase_p0b(a, c); );
    xcd_barrier(bar); STAMP(2);
    run_layer<0>(wave_s, lds, bar);
    run_layer<1>(wave_s, lds, bar);
#if PROBE_A >= 0
    if (blockIdx.x == 0) {
        asm volatile("s_waitcnt vmcnt(0)" ::: "memory"); __syncthreads();
        if (threadIdx.x == 0) ((unsigned long long*)(args_here()->ws + WS_TS))[30] = __builtin_amdgcn_s_memrealtime();
        asm volatile("s_waitcnt vmcnt(0)" ::: "memory"); __syncthreads();
        const volatile unsigned long long* ts = (const volatile unsigned long long*)(args_here()->ws + WS_TS);
        float da = 0.f, db = 0.f;
        if (PROBE_A < 14) { da = (float)(ts[3 + PROBE_A] - ts[2 + PROBE_A]) + (float)(ts[17 + PROBE_A] - ts[16 + PROBE_A]); } else if (PROBE_A == 14) da = (float)(ts[1] - ts[0]); else if (PROBE_A == 15) da = (float)(ts[2] - ts[1]); else da = (float)(ts[30] - ts[0]);
        if (PROBE_B >= 0 && PROBE_B < 14) { db = (float)(ts[3 + PROBE_B] - ts[2 + PROBE_B]) + (float)(ts[17 + PROBE_B] - ts[16 + PROBE_B]); } else if (PROBE_B == 14) db = (float)(ts[1] - ts[0]); else if (PROBE_B == 15) db = (float)(ts[2] - ts[1]);
        da *= 0.01f; db *= 0.01f;
        da = exp2f(0.25f * rintf(4.0f * log2f(fmaxf(da, 0.5f)))); db = exp2f(0.25f * rintf(4.0f * log2f(fmaxf(db, 0.5f))));
        float* out = args_here()->out;
        for (int i = threadIdx.x; i < 16 * 1024; i += NTHREADS) { const int r = i >> 10, col = i & 1023; const int rowi = (r & 7) + 2048 * (r >> 3); out[(size_t)rowi * D + col] = da; }
        if (threadIdx.x == 0 && PROBE_B >= 0) out[(size_t)4096 * D] = 100.0f * db;
    }
#endif
}

extern "C" void kernel_launch(void* const* d_in, const int* in_sizes, int n_in, void* d_out, int out_size, void* d_ws, size_t ws_size, hipStream_t stream) {
    static int grid = 0;
    if (grid == 0) {
        if (n_in != N_IN || out_size != T * D || ws_size < WS_END2) { fprintf(stderr, "kernel_launch: unexpected shapes: n_in %d out %d ws %zu (need %zu)\n", n_in, out_size, ws_size, (size_t)WS_END2); grid = -1; return; }
        int dev = 0, cus = 0;
        (void)hipGetDevice(&dev); (void)hipDeviceGetAttribute(&cus, hipDeviceAttributeMultiprocessorCount, dev);
        if (hipFuncSetAttribute((const void*)mk_fwd, hipFuncAttributeMaxDynamicSharedMemorySize, LDS_BYTES) != hipSuccess) { fprintf(stderr, "kernel_launch: hipFuncSetAttribute failed\n"); grid = -1; return; }
        grid = cus > 0 ? cus : 256;
        fprintf(stderr, "kernel_launch: ws_size %zu grid %d\n", ws_size, grid);
    }
    if (grid < 0) return;
    (void)hipMemsetAsync((char*)d_ws + WS_CTL, 0, CTL_BYTES, stream);
    Args a{};
    for (int i = 0; i < N_IN; ++i) a.in[i] = (const float*)d_in[i];
    a.out = (float*)d_out; a.ws = (unsigned char*)d_ws;
    a.ph_lo = 0; a.ph_hi = 1000;
    hipLaunchKernelGGL(mk_fwd, dim3(grid), dim3(NTHREADS), LDS_BYTES, stream, a);
}
```

```cpp
#include <hip/hip_runtime.h>
#include <cstdio>
#include <cstdint>
#include <utility>

typedef unsigned short bf16;
typedef _Float16 f16;
typedef float f32x4 __attribute__((ext_vector_type(4)));
typedef unsigned u32x4 __attribute__((ext_vector_type(4)));
typedef unsigned u32x2 __attribute__((ext_vector_type(2)));

constexpr int T = 16384, D = 1024, W = 512, NH = 8, HN = 64, RC = 1792, INC = 4864;
constexpr int NE = 16, FF = 512, DEPTH = 2;
constexpr float LN_EPS = 1e-5f, GN_EPS = 64e-5f, ALPHA = 1.41421356237f;
constexpr int NTHREADS = 512, NWAVES = 8;
constexpr int MAXSLOT = 36864;

constexpr size_t MiB = 1u << 20;
constexpr size_t WS_CTL = 0, CTL_BYTES = 1 * MiB;
constexpr int CW_CNT = 16384;
constexpr size_t WS_PART = 1 * MiB;
constexpr size_t WS_MODF = 2 * MiB;
constexpr size_t WS_TOKI = 2 * MiB + 65536;
constexpr size_t WS_TOKW = WS_TOKI + 131072;
constexpr size_t WS_TOKP = WS_TOKW + 131072;
constexpr size_t WS_S2T = 3 * MiB;
constexpr size_t WS_BLKCNT = 3 * MiB + 512 * 1024;
constexpr size_t WS_TOT = WS_BLKCNT + 32768;
constexpr size_t WS_LORA = 4 * MiB;
constexpr size_t WS_WIN = 8 * MiB;
constexpr size_t WS_WA = 28 * MiB, WS_WB = 29 * MiB, WS_WO = 30 * MiB, WS_WL1 = 4 * MiB;
constexpr size_t WS_ZG = 36 * MiB;
constexpr size_t WS_XN = 100 * MiB;
constexpr size_t WS_G = 100 * MiB, WS_YB = 116 * MiB;
constexpr size_t WS_ZR = 132 * MiB;
constexpr size_t WS_ZS = 188 * MiB;
constexpr size_t WS_YSC = 132 * MiB;
constexpr size_t WS_ST = 148 * MiB;
constexpr size_t WS_YA = 132 * MiB;
constexpr size_t WS_MP = 164 * MiB;
constexpr size_t WS_XS = 132 * MiB;
constexpr size_t WS_Y = 132 * MiB;
constexpr size_t WS_AA = 224 * MiB, WS_BB = 240 * MiB, WS_WM1 = 256 * MiB, WS_R = 272 * MiB, WS_KP = 288 * MiB, WS_V = 304 * MiB;
constexpr size_t WS_WGU = 224 * MiB;
constexpr size_t WS_WD = 256 * MiB;
constexpr size_t WS_HID = 272 * MiB;
constexpr size_t WS_VF = 320 * MiB;
constexpr size_t WS_END = 336 * MiB;

constexpr size_t LO_W2T = 0, LO_A2T = 65536, LO_G2T = 131072, LO_VM1T = 262144, LO_VM2T = 294912, LO_STRIDE = 524288;

enum { I_X = 0, I_C, I_WMOD, I_BMOD, I_WIN, I_MU, I_W0, I_W2, I_A0, I_A2, I_G2, I_KK, I_KA, I_RK, I_GNG, I_GNB, I_VM0, I_VM1, I_VM2,
       I_SGG, I_SGB, I_WS, I_BS, I_WBA, I_WBB, I_WOUT, I_LN1G, I_LN1B, I_RW, I_RB, I_EG, I_EU, I_ED, I_LN2G, I_LN2B, N_IN };

struct Args { const float* in[N_IN]; float* out; unsigned char* ws; int ph_lo, ph_hi; };
typedef const __attribute__((address_space(4))) Args& ArgsR;

__device__ __forceinline__ float bf2f(bf16 h) { return __uint_as_float(((unsigned)h) << 16); }
__device__ __forceinline__ unsigned f2bfu(float f) { unsigned u = __float_as_uint(f); return (u + 0x7fffu + ((u >> 16) & 1u)) >> 16; }
__device__ __forceinline__ bf16 f2bf(float f) { return __builtin_bit_cast(unsigned short, (__bf16)f); }
typedef __bf16 bf16x2_t __attribute__((ext_vector_type(2)));
__device__ __forceinline__ unsigned pk2(float lo, float hi) { bf16x2_t v; v[0] = (__bf16)lo; v[1] = (__bf16)hi; return __builtin_bit_cast(unsigned, v); }
__device__ __forceinline__ void store4bf(bf16* p, f32x4 v) { u32x2 w; w.x = pk2(v[0], v[1]); w.y = pk2(v[2], v[3]); *(u32x2*)p = w; }
__device__ __forceinline__ f32x4 load4bf(const bf16* p) { u32x2 w = *(const u32x2*)p; f32x4 r; r[0] = __uint_as_float(w.x << 16); r[1] = __uint_as_float(w.x & 0xffff0000u); r[2] = __uint_as_float(w.y << 16); r[3] = __uint_as_float(w.y & 0xffff0000u); return r; }
__device__ __forceinline__ float wave_sum(float v) {
#pragma unroll
    for (int o = 1; o < 64; o <<= 1) v += __shfl_xor(v, o);
    return v;
}
__device__ __forceinline__ float sigmoidf_(float x) { return __builtin_amdgcn_rcpf(1.0f + __expf(-x)); }
__device__ __forceinline__ float siluf_(float x) { return x * sigmoidf_(x); }
__device__ __forceinline__ float gelu_tanh(float x) { const float u = 0.7978845608028654f * (x + 0.044715f * x * x * x); return x * (1.0f - __builtin_amdgcn_rcpf(1.0f + __expf(2.0f * u))); }
__device__ __forceinline__ float softplusf_(float y) { return fmaxf(y, 0.f) + log1pf(__expf(-fabsf(y))); }

struct Ctx { int tid, lane, wave, gw, ngw; unsigned char* lds; };

__device__ __forceinline__ void transpose_item(const float* Wsrc, int N, int k0, int n0, bf16* dst, int ldk, float* scr, int lane) {
    float tv[32];
#pragma unroll
    for (int i = 0; i < 32; ++i) tv[i] = Wsrc[(size_t)(k0 + 2 * i + (lane >> 5)) * N + n0 + (lane & 31)];
#pragma unroll
    for (int i = 0; i < 32; ++i) scr[(2 * i + (lane >> 5)) * 33 + (lane & 31)] = tv[i];
    asm volatile("s_waitcnt lgkmcnt(0)" ::: "memory");
    const int c = lane & 7;
#pragma unroll
    for (int j = 0; j < 4; ++j) { const int n = (lane >> 3) + 8 * j; const float* s = scr + (8 * c) * 33 + n;
        u32x4 o; o.x = pk2(s[0 * 33], s[1 * 33]); o.y = pk2(s[2 * 33], s[3 * 33]); o.z = pk2(s[4 * 33], s[5 * 33]); o.w = pk2(s[6 * 33], s[7 * 33]);
        *(u32x4*)(dst + (size_t)n * ldk + k0 + 8 * c) = o; }
    asm volatile("s_waitcnt lgkmcnt(0)" ::: "memory");
}
template <class RowMap>
__device__ __forceinline__ void transpose_matrix_item(const float* Wsrc, int K, int N, bf16* dst, int item, float* scr, int lane, const RowMap& rm) {
    const int nblk = N / 32, kb = item / nblk, nb = item % nblk, n0 = 32 * nb;
    transpose_item(Wsrc, N, 64 * kb, n0, dst + (size_t)rm(n0) * K, K, scr, lane);
}
struct RowId { __device__ __forceinline__ int operator()(int n) const { return n; } };
struct RowGU { int up; __device__ __forceinline__ int operator()(int n) const { return (n >> 7) * 256 + (n & 127) + up * 128; } };

__device__ __forceinline__ void phase_p0a(ArgsR a, const Ctx& c) {
    float* scr = (float*)(c.lds + c.wave * 16384);
    { float* MODF = (float*)(a.ws + WS_MODF); float* red = (float*)(c.lds + 131072);
      for (int cbk = blockIdx.x; cbk < 2 * 96; cbk += gridDim.x) {
          const int l = cbk / 96, n = (cbk % 96) * 64 + c.lane;
          const float* wm = a.in[I_WMOD] + (size_t)l * D * 6144 + (size_t)(c.wave * 128) * 6144 + n;
          float acc0 = 0.f, acc1 = 0.f;
#pragma unroll 16
          for (int k = 0; k < 128; k += 2) { acc0 += siluf_(a.in[I_C][c.wave * 128 + k]) * wm[(size_t)k * 6144]; acc1 += siluf_(a.in[I_C][c.wave * 128 + k + 1]) * wm[(size_t)(k + 1) * 6144]; }
          red[c.wave * 64 + c.lane] = acc0 + acc1;
          __syncthreads();
          if (c.wave == 0) { float sacc = a.in[I_BMOD][l * 6144 + n];
#pragma unroll
              for (int w = 0; w < 8; ++w) sacc += red[w * 64 + c.lane];
              MODF[l * 6144 + n] = sacc; }
          __syncthreads();
      } }
    for (int it = c.gw; it < 2 * (16 + 16 + 32 + 8); it += c.ngw) {
        const int l = it / 72; int r = it % 72; unsigned char* lo = a.ws + WS_LORA + (size_t)l * LO_STRIDE;
        if (r < 16) { transpose_matrix_item(a.in[I_W2] + (size_t)l * 64 * W, 64, W, (bf16*)(lo + LO_W2T), r, scr, c.lane, RowId()); continue; } r -= 16;
        if (r < 16) { transpose_matrix_item(a.in[I_A2] + (size_t)l * 64 * W, 64, W, (bf16*)(lo + LO_A2T), r, scr, c.lane, RowId()); continue; } r -= 16;
        if (r < 32) { transpose_matrix_item(a.in[I_G2] + (size_t)l * 128 * W, 128, W, (bf16*)(lo + LO_G2T), r, scr, c.lane, RowId()); continue; } r -= 32;
        if (l == 1) transpose_matrix_item(a.in[I_VM1], W, 32, (bf16*)(lo + LO_VM1T), r, scr, c.lane, RowId());
    }
    for (int i = blockIdx.x * NTHREADS + c.tid; i < 32 * W; i += gridDim.x * NTHREADS) { const int n = i >> 5, k = i & 31;
        ((bf16*)(a.ws + WS_LORA + LO_STRIDE + LO_VM2T))[i] = f2bf(a.in[I_VM2][(size_t)k * W + n]); }
    constexpr int I_WINL = (D / 64) * (INC / 32);
    constexpr int I_WAL = (W / 64) * (D / 32);
    constexpr int I_WOL = (D / 64) * (D / 32);
    constexpr int PER_L = I_WINL + 2 * I_WAL + I_WOL;
    for (int it = c.gw; it < 2 * PER_L; it += c.ngw) {
        const int l = it / PER_L; int r = it % PER_L;
        if (r < I_WINL) { transpose_matrix_item(a.in[I_WIN] + (size_t)l * D * INC, D, INC, (bf16*)(a.ws + WS_WIN + (size_t)l * 10 * MiB), r, scr, c.lane, RowId()); continue; } r -= I_WINL;
        if (r < I_WAL) { transpose_matrix_item(a.in[I_WBA] + (size_t)l * W * D, W, D, (bf16*)(a.ws + WS_WA + (size_t)l * WS_WL1), r, scr, c.lane, RowId()); continue; } r -= I_WAL;
        if (r < I_WAL) { transpose_matrix_item(a.in[I_WBB] + (size_t)l * W * D, W, D, (bf16*)(a.ws + WS_WB + (size_t)l * WS_WL1), r, scr, c.lane, RowId()); continue; } r -= I_WAL;
        transpose_matrix_item(a.in[I_WOUT] + (size_t)l * D * D, D, D, (bf16*)(a.ws + WS_WO + (size_t)l * WS_WL1), r, scr, c.lane, RowId());
    }
}

__device__ __forceinline__ void row_stats(const float (&v)[16], float& mean, float& rstd) {
    float s = 0.f;
#pragma unroll
    for (int j = 0; j < 16; ++j) s += v[j];
    mean = wave_sum(s) * (1.f / D);
    float q = 0.f;
#pragma unroll
    for (int j = 0; j < 16; ++j) { const float d = v[j] - mean; q += d * d; }
    rstd = __builtin_amdgcn_rsqf(wave_sum(q) * (1.f / D) + LN_EPS);
}
__device__ __forceinline__ void load_row16(const float* p, int lane, float (&v)[16]) {
#pragma unroll
    for (int j = 0; j < 4; ++j) { const f32x4 x = *(const f32x4*)(p + 4 * lane + 256 * j); v[4 * j] = x[0]; v[4 * j + 1] = x[1]; v[4 * j + 2] = x[2]; v[4 * j + 3] = x[3]; }
}

__device__ __forceinline__ void phase_p0b(ArgsR a, const Ctx& c) {
    const float* MODF = (const float*)(a.ws + WS_MODF);
    float sh[16], sc[16];
#pragma unroll
    for (int j = 0; j < 4; ++j) { const f32x4 s0 = *(const f32x4*)(MODF + 4 * c.lane + 256 * j), s1 = *(const f32x4*)(MODF + 1024 + 4 * c.lane + 256 * j);
#pragma unroll
        for (int e = 0; e < 4; ++e) { sh[4 * j + e] = s0[e]; sc[4 * j + e] = 1.f + s1[e]; } }
    bf16* XN = (bf16*)(a.ws + WS_XN);
    for (int m = c.gw; m < T; m += c.ngw) {
        float v[16]; load_row16(a.in[I_X] + (size_t)m * D, c.lane, v);
        float mean, rstd; row_stats(v, mean, rstd);
#pragma unroll
        for (int j = 0; j < 4; ++j) { f32x4 o;
#pragma unroll
            for (int e = 0; e < 4; ++e) o[e] = (v[4 * j + e] - mean) * rstd * sc[4 * j + e] + sh[4 * j + e];
            store4bf(XN + (size_t)m * D + 4 * c.lane + 256 * j, o); }
    }
}

namespace pg8 {
#define PG8_LAS __attribute__((address_space(3)))
typedef unsigned short bf16_t;
typedef short bf16x8 __attribute__((ext_vector_type(8)));
typedef float f32x4 __attribute__((ext_vector_type(4)));
typedef unsigned u32x4 __attribute__((ext_vector_type(4)));
constexpr int BM = 256, BK = 64, HALF = 128, HTB = HALF * BK * 2  , STAGE_BYTES = 8 * HTB, NXCD = 8, WGM = 8;

__host__ __device__ __forceinline__ int lds_byte(int r, int c) { const int st = (r >> 4) * 2 + (c >> 5), rr = r & 15, cc = c & 31, ob = rr * 64 + cc * 2; return st * 1024 + (ob ^ (((ob >> 9) & 1) << 5)); }
__host__ __device__ __forceinline__ void stage_rc(int b, int& R, int& C) { const int st = b / 1024, sb = b % 1024, swz = sb ^ (((sb >> 9) & 1) << 5); R = (st >> 1) * 16 + swz / 64; C = (st & 1) * 32 + (swz % 64) / 2; }
__host__ __device__ __forceinline__ int perm32(int rho) { const int n = rho >> 4, i = rho & 15; return 8 * (i >> 2) + 4 * n + (i & 3); }

struct Unit { int pm, pn; };
struct Gemm { const bf16_t* A; const bf16_t* Bt; int M, N, K; };

struct StaticOrder {
    int nM, nN, nwg, G, c;
    __host__ __device__ void init(int M, int N, int G_, int c_) { nM = M / BM; nN = N / BM; nwg = nM * nN; G = G_; c = c_; }
    __host__ __device__ bool next(int i, Unit& u) const {
        const long L = (long)i * G + c; if (L >= nwg) return false;
        int wgid = (int)L; { const int q = nwg / NXCD, r = nwg % NXCD, xcd = wgid % NXCD, off = wgid / NXCD; wgid = (xcd < r ? xcd * (q + 1) : r * (q + 1) + (xcd - r) * q) + off; }
        const int nig = WGM * nN, gid = wgid / nig, fm = gid * WGM, gsz = (nM - fm) < WGM ? (nM - fm) : WGM;
        u.pm = fm + ((wgid % nig) % gsz); u.pn = (wgid % nig) / gsz; return true;
    }
    __device__ __forceinline__ void a_ready(const Unit&) const {}
    __device__ __forceinline__ void done(const Unit&) const {}
};


template <class Epi, class Sched, bool ALIGN_EPI = false, bool SP2 = false, bool GATHER = false>
__device__ __forceinline__ void gemm_phase(PG8_LAS unsigned char* lds, const Gemm g, const Sched& S, const Epi& E, const int tid_in, const int* s2t = nullptr) {
    const int tid = tid_in, wid = __builtin_amdgcn_readfirstlane(tid >> 6), lane = tid & 63, wr = wid >> 2, wc = wid & 3, fr = lane & 15, fq = lane >> 4;
    const int K = g.K, nt = K / BK;
    unsigned voffA[2], voffB[2];
#pragma unroll
    for (int i = 0; i < 2; ++i) { int R, C; stage_rc(tid * 16 + i * 8192, R, C); const int Rb = Epi::PERM ? ((R & ~31) + perm32(R & 31)) : R;
        voffA[i] = (unsigned)(R * K + C) * 2u; voffB[i] = (unsigned)(Rb * K + C) * 2u; }
    unsigned pc0 = 0u, pc1 = 0u, pn0 = 0u, pn1 = 0u, cvoff = 0u; int R0g = 0;
    if constexpr (GATHER) { int R, C; stage_rc(tid * 16, R, C); R0g = R; cvoff = (unsigned)C * 2u; }
#define PG8_TOKPACK(pm_, h_) ([&]() -> unsigned { const int r0_ = (pm_) * BM + (h_) * HALF + R0g; const int a0_ = s2t[2 * r0_], a1_ = s2t[2 * (r0_ + 64)]; return (unsigned)(a0_ < 0 ? 0 : (a0_ >> 1)) | ((unsigned)(a1_ < 0 ? 0 : (a1_ >> 1)) << 16); }())
#define PG8_STAGE_A(bufoff, base, h, usen) do { if constexpr (GATHER) { const unsigned pk_ = (usen) ? ((h) ? pn1 : pn0) : ((h) ? pc1 : pc0); \
        unsigned vt_[2] = {(pk_ & 0xffffu) * (unsigned)(K * 2) + cvoff, (pk_ >> 16) * (unsigned)(K * 2) + cvoff}; PG8_STAGE(bufoff, base, vt_); } \
    else PG8_STAGE(bufoff, (base) + ((h) ? hstep : (size_t)0), voffA); } while (0)
    const size_t kstep = (size_t)(BK * 2);
    const size_t hstep = (size_t)HALF * K * 2;
    const size_t tstep = 2 * hstep;
    const unsigned ldsw = (unsigned)wid * 1024u;
    const int aoff = lds_byte(wr * 64 + fr, fq * 8), boff = lds_byte(wc * 32 + fr, fq * 8);
#define PG8_SA(b, h) (((b) * 2 + (h)) * HTB)
#define PG8_SB(b, h) ((4 + (b) * 2 + (h)) * HTB)
#define PG8_STAGE(bufoff, gbase, voff) do { _Pragma("unroll") for (int _i = 0; _i < 2; ++_i) \
        __builtin_amdgcn_global_load_lds((const unsigned*)((const char*)(gbase) + (voff)[_i]), (PG8_LAS unsigned*)(lds + (bufoff) + ldsw + _i * 8192), 16, 0, 0); } while (0)
#define PG8_LDA(dst, b, h) do { _Pragma("unroll") for (int m = 0; m < 4; ++m) _Pragma("unroll") for (int k = 0; k < 2; ++k) dst[m][k] = *(const PG8_LAS bf16x8*)(lds + PG8_SA(b, h) + aoff + m * 2048 + k * 1024); } while (0)
#define PG8_LDB(dst, b, h) do { _Pragma("unroll") for (int n = 0; n < 2; ++n) _Pragma("unroll") for (int k = 0; k < 2; ++k) dst[n][k] = *(const PG8_LAS bf16x8*)(lds + PG8_SB(b, h) + boff + n * 2048 + k * 1024); } while (0)
#define PG8_MMA(ai, bj, At, Bt) do { __builtin_amdgcn_s_setprio(1); _Pragma("unroll") for (int m = 0; m < 4; ++m) _Pragma("unroll") for (int n = 0; n < 2; ++n) _Pragma("unroll") for (int k = 0; k < 2; ++k) \
        acc[ai][bj][m][n] = __builtin_amdgcn_mfma_f32_16x16x32_bf16(Bt[n][k], At[m][k], acc[ai][bj][m][n], 0, 0, 0); __builtin_amdgcn_s_setprio(0); } while (0)
#define PG8_WAIT_V(n) asm volatile("s_waitcnt vmcnt(" #n ")" ::: "memory")
#define PG8_WAIT_L(n) asm volatile("s_waitcnt lgkmcnt(" #n ")" ::: "memory")
#define PG8_BAR __builtin_amdgcn_s_barrier()
#define PG8_SCHED __builtin_amdgcn_sched_barrier(0)
    Unit cur, nxt; int ui = 0;
    if (!S.next(0, cur)) return;
    f32x4 acc[2][2][4][2];
#pragma unroll
    for (int a = 0; a < 2; ++a)
#pragma unroll
        for (int b = 0; b < 2; ++b)
#pragma unroll
            for (int m = 0; m < 4; ++m)
#pragma unroll
                for (int n = 0; n < 2; ++n) acc[a][b][m][n] = (f32x4){0.f, 0.f, 0.f, 0.f};
    bf16x8 At[4][2], B0[2][2], B1[2][2];
    const char* cA = (const char*)g.A + (GATHER ? (size_t)0 : (size_t)cur.pm * tstep); const char* cB = (const char*)g.Bt + (size_t)cur.pn * tstep;
    if constexpr (GATHER) { pc0 = PG8_TOKPACK(cur.pm, 0); pc1 = PG8_TOKPACK(cur.pm, 1); }
    S.a_ready(cur);
    if constexpr (SP2) {
        PG8_STAGE(PG8_SB(0, 0), cB, voffB); PG8_STAGE(PG8_SB(0, 1), cB + hstep, voffB); PG8_STAGE_A(PG8_SA(0, 0), cA, 0, false); PG8_STAGE_A(PG8_SA(0, 1), cA, 1, false);
        if (wr == 1) PG8_BAR;
        PG8_WAIT_V(2); PG8_BAR;
        PG8_STAGE(PG8_SB(1, 0), cB + kstep, voffB); PG8_STAGE_A(PG8_SA(1, 0), cA + kstep, 0, false); PG8_STAGE(PG8_SB(1, 1), cB + hstep + kstep, voffB);
        PG8_WAIT_V(6); PG8_BAR;
    } else {
        PG8_STAGE(PG8_SB(0, 0), cB, voffB); PG8_STAGE(PG8_SA(0, 0), cA, voffA); PG8_STAGE(PG8_SB(0, 1), cB + hstep, voffB); PG8_STAGE(PG8_SA(0, 1), cA + hstep, voffA);
        if (wr == 1) PG8_BAR;
        PG8_WAIT_V(4); PG8_BAR;
        PG8_STAGE(PG8_SB(1, 0), cB + kstep, voffB); PG8_STAGE(PG8_SA(1, 0), cA + kstep, voffA); PG8_STAGE(PG8_SB(1, 1), cB + hstep + kstep, voffB);
        PG8_WAIT_V(6); PG8_BAR;
    }
    for (;;) {
        const bool has_next = S.next(ui + 1, nxt);
        const char* nA = (has_next && !GATHER) ? (const char*)g.A + (size_t)nxt.pm * tstep : cA; const char* nB = has_next ? (const char*)g.Bt + (size_t)nxt.pn * tstep : cB;
        if constexpr (GATHER) { if (has_next) { pn0 = PG8_TOKPACK(nxt.pm, 0); pn1 = PG8_TOKPACK(nxt.pm, 1); } else { pn0 = pc0; pn1 = pc1; } }
        for (int t = 0; t < nt; t += 2) {
            const bool last = (t == nt - 2);
            const char* a1 = cA + (size_t)(t + 1) * kstep;
            const char* a2 = last ? nA : cA + (size_t)(t + 2) * kstep; const char* b2 = last ? nB : cB + (size_t)(t + 2) * kstep;
            const char* a3 = a2 + kstep; const char* b3 = b2 + kstep;
            if (last && has_next) S.a_ready(nxt);
            if constexpr (SP2) {
            PG8_LDB(B0, 0, 0); PG8_LDB(B1, 0, 1); PG8_SCHED; PG8_LDA(At, 0, 0); PG8_STAGE_A(PG8_SA(1, 1), a1, 1, false);
            PG8_WAIT_V(8); PG8_WAIT_L(0); PG8_BAR; PG8_MMA(0, 0, At, B0); PG8_MMA(0, 1, At, B1); PG8_BAR; PG8_SCHED;
            PG8_LDA(At, 0, 1); PG8_STAGE(PG8_SB(0, 0), b2, voffB); PG8_STAGE(PG8_SB(0, 1), b2 + hstep, voffB); PG8_STAGE_A(PG8_SA(0, 0), a2, 0, last);
            PG8_WAIT_V(8); PG8_WAIT_L(0); PG8_BAR; PG8_MMA(1, 0, At, B0); PG8_MMA(1, 1, At, B1); PG8_BAR; PG8_SCHED;
            PG8_LDB(B0, 1, 0); PG8_LDB(B1, 1, 1); PG8_SCHED; PG8_LDA(At, 1, 0); PG8_STAGE_A(PG8_SA(0, 1), a2, 1, last);
            PG8_WAIT_V(8); PG8_WAIT_L(0); PG8_BAR; PG8_MMA(0, 0, At, B0); PG8_MMA(0, 1, At, B1); PG8_BAR; PG8_SCHED;
            PG8_LDA(At, 1, 1); PG8_STAGE(PG8_SB(1, 0), b3, voffB); PG8_STAGE(PG8_SB(1, 1), b3 + hstep, voffB); PG8_STAGE_A(PG8_SA(1, 0), a3, 0, last);
            PG8_WAIT_V(8); PG8_WAIT_L(0); PG8_BAR; PG8_MMA(1, 0, At, B0); PG8_MMA(1, 1, At, B1); PG8_BAR; PG8_SCHED;
            } else {
            PG8_LDB(B0, 0, 0); PG8_SCHED; PG8_LDA(At, 0, 0); PG8_STAGE(PG8_SA(1, 1), a1 + hstep, voffA);
            PG8_WAIT_L(8); PG8_BAR; PG8_WAIT_L(0); PG8_MMA(0, 0, At, B0); PG8_BAR; PG8_SCHED;
            PG8_LDB(B1, 0, 1); PG8_STAGE(PG8_SB(0, 0), b2, voffB);
            PG8_BAR; PG8_WAIT_L(0); PG8_MMA(0, 1, At, B1); PG8_BAR;
            PG8_LDA(At, 0, 1); PG8_STAGE(PG8_SA(0, 0), a2, voffA);
            PG8_BAR; PG8_WAIT_L(0); PG8_MMA(1, 0, At, B0); PG8_BAR; PG8_SCHED;
            PG8_STAGE(PG8_SB(0, 1), b2 + hstep, voffB);
            PG8_WAIT_V(6); PG8_BAR; PG8_MMA(1, 1, At, B1); PG8_BAR;
            PG8_LDB(B0, 1, 0); PG8_SCHED; PG8_LDA(At, 1, 0); PG8_STAGE(PG8_SA(0, 1), a2 + hstep, voffA);
            PG8_WAIT_L(8); PG8_BAR; PG8_WAIT_L(0); PG8_MMA(0, 0, At, B0); PG8_BAR; PG8_SCHED;
            PG8_LDB(B1, 1, 1); PG8_STAGE(PG8_SB(1, 0), b3, voffB);
            PG8_BAR; PG8_WAIT_L(0); PG8_MMA(0, 1, At, B1); PG8_BAR;
            PG8_LDA(At, 1, 1); PG8_STAGE(PG8_SA(1, 0), a3, voffA);
            PG8_BAR; PG8_WAIT_L(0); PG8_MMA(1, 0, At, B0); PG8_BAR; PG8_SCHED;
            PG8_STAGE(PG8_SB(1, 1), b3 + hstep, voffB);
            PG8_WAIT_V(6); PG8_BAR; PG8_MMA(1, 1, At, B1); PG8_BAR;
            }
        }
        if constexpr (ALIGN_EPI) { if (wr == 0) PG8_BAR; }
        if constexpr (!Epi::AFTER_DRAIN) { E(acc, cur, wr, wc, fr, fq); S.done(cur); }
        if (!has_next) break;
#pragma unroll
        for (int a = 0; a < 2; ++a)
#pragma unroll
            for (int b = 0; b < 2; ++b)
#pragma unroll
                for (int m = 0; m < 4; ++m)
#pragma unroll
                    for (int n = 0; n < 2; ++n) acc[a][b][m][n] = (f32x4){0.f, 0.f, 0.f, 0.f};
        cur = nxt; cA = nA; cB = nB; ++ui; if constexpr (GATHER) { pc0 = pn0; pc1 = pn1; }
        if constexpr (ALIGN_EPI) { if (wr == 1) PG8_BAR; }
    }
    PG8_WAIT_V(0);
    if constexpr (!ALIGN_EPI) { if (wr == 0) PG8_BAR; }
    PG8_BAR;
    if constexpr (Epi::AFTER_DRAIN) { E.fused(acc, cur, wr, wc, fr, fq, lds, wid, lane); S.done(cur); }
#undef PG8_SA
#undef PG8_SB
#undef PG8_STAGE
#undef PG8_STAGE_A
#undef PG8_TOKPACK
#undef PG8_LDA
#undef PG8_LDB
#undef PG8_MMA
#undef PG8_WAIT_V
#undef PG8_WAIT_L
#undef PG8_BAR
#undef PG8_SCHED
}
}

using pg8::Unit;
struct DenseSched { int nN, n, G, c;
    __device__ __forceinline__ void a_ready(const Unit&) const {}
    __device__ __forceinline__ void done(const Unit&) const {}
    __device__ __forceinline__ bool next(int i, Unit& u) const { const int L = i * G + c; if (L >= n) return false; u.pm = L / nN; u.pn = L % nN; return true; } };

__device__ __forceinline__ void store8bf(bf16* p, f32x4 lo, f32x4 hi) { u32x4 w; w.x = pk2(lo[0], lo[1]); w.y = pk2(lo[2], lo[3]); w.z = pk2(hi[0], hi[1]); w.w = pk2(hi[2], hi[3]); *(u32x4*)p = w; }
__device__ __forceinline__ void load8bf(const bf16* p, f32x4& lo, f32x4& hi) { const u32x4 w = *(const u32x4*)p;
    lo[0] = __uint_as_float(w.x << 16); lo[1] = __uint_as_float(w.x & 0xffff0000u); lo[2] = __uint_as_float(w.y << 16); lo[3] = __uint_as_float(w.y & 0xffff0000u);
    hi[0] = __uint_as_float(w.z << 16); hi[1] = __uint_as_float(w.z & 0xffff0000u); hi[2] = __uint_as_float(w.w << 16); hi[3] = __uint_as_float(w.w & 0xffff0000u); }
struct EpiZ { bf16 *ZR, *ZS, *ZG;
    __device__ __forceinline__ void one(int row, int col, f32x4 lo, f32x4 hi) const {
        if (col < RC) store8bf(ZR + (size_t)row * RC + col, lo, hi);
        else if (col < RC + 1024) { for (int e = 0; e < 4; ++e) { lo[e] = gelu_tanh(lo[e]); hi[e] = gelu_tanh(hi[e]); } store8bf(ZS + (size_t)row * 1024 + (col - RC), lo, hi); }
        else { for (int e = 0; e < 4; ++e) { lo[e] = sigmoidf_(lo[e]); hi[e] = sigmoidf_(hi[e]); } store8bf(ZG + (size_t)row * 2048 + (col - RC - 1024), lo, hi); } }
    __device__ __forceinline__ void operator()(int row, int col, f32x4 a0, f32x4 a1, f32x4 b0, f32x4 b1) const { one(row, col, a0, a1); one(row, col + 128, b0, b1); } };
struct EpiGA { const bf16* ZG; bf16* MP;
    __device__ __forceinline__ void one(int row, int col, f32x4 lo, f32x4 hi) const { f32x4 g0, g1; load8bf(ZG + (size_t)row * 2048 + col, g0, g1); store8bf(MP + (size_t)row * D + col, g0 * lo, g1 * hi); }
    __device__ __forceinline__ void operator()(int row, int col, f32x4 a0, f32x4 a1, f32x4 b0, f32x4 b1) const { one(row, col, a0, a1); one(row, col + 128, b0, b1); } };
struct EpiGB { const bf16* ZG; const bf16* MPin; bf16* MP;
    __device__ __forceinline__ void one(int row, int col, f32x4 lo, f32x4 hi) const { f32x4 g0, g1, m0, m1; load8bf(ZG + (size_t)row * 2048 + 1024 + col, g0, g1); load8bf(MPin + (size_t)row * D + col, m0, m1);
        store8bf(MP + (size_t)row * D + col, m0 + g0 * lo, m1 + g1 * hi); }
    __device__ __forceinline__ void operator()(int row, int col, f32x4 a0, f32x4 a1, f32x4 b0, f32x4 b1) const { one(row, col, a0, a1); one(row, col + 128, b0, b1); } };
struct EpiOut { const float* xin; float* out; const float* gate1;
    __device__ __forceinline__ void one(int row, int col, f32x4 v) const { const f32x4 x = *(const f32x4*)(xin + (size_t)row * D + col); const f32x4 g = *(const f32x4*)(gate1 + col);
        *(f32x4*)(out + (size_t)row * D + col) = ALPHA * x + (1.0f + g) * v; }
    __device__ __forceinline__ void operator()(int row, int col, f32x4 a0, f32x4 a1, f32x4 b0, f32x4 b1) const { one(row, col, a0); one(row, col + 4, a1); one(row, col + 128, b0); one(row, col + 132, b1); } };
struct EpiSwi { bf16* HID;
    __device__ __forceinline__ void operator()(int row, int col, f32x4 a0, f32x4 a1, f32x4 b0, f32x4 b1) const { const int ct = (col >> 8) & 3, cc = col & 127;
        f32x4 h0, h1; for (int e = 0; e < 4; ++e) { h0[e] = siluf_(a0[e]) * b0[e]; h1[e] = siluf_(a1[e]) * b1[e]; } store8bf(HID + (size_t)row * FF + ct * 128 + cc, h0, h1); } };
struct EpiDown { const int* S2T; const float* TOKW; bf16* Y;
    __device__ __forceinline__ void operator()(int row, int col, f32x4 a0, f32x4 a1, f32x4 b0, f32x4 b1) const { const u32x2 sw = *(const u32x2*)(S2T + 2 * row); const int st = (int)sw.x; if (st < 0) return; const float w = __uint_as_float(sw.y); const int cc = col & 1023;
        store8bf(Y + (size_t)st * D + cc, w * a0, w * a1); store8bf(Y + (size_t)st * D + cc + 128, w * b0, w * b1); } };

struct MoeSched { int ts[17]; int G, c;
    __device__ __forceinline__ void a_ready(const Unit&) const {}
    __device__ __forceinline__ void done(const Unit&) const {}
    __device__ __forceinline__ void init(const unsigned* cnt, int G_, int c_) { G = G_; c = c_; int s = 0;
#pragma unroll
        for (int e = 0; e < 16; ++e) { ts[e] = s; s += ((int)cnt[e] + 255) >> 8; } ts[16] = s; }
    __device__ __forceinline__ bool next(int i, Unit& u) const { const int L = i * G + c; if (L >= 4 * ts[16]) return false; const int rt = L >> 2, ct = L & 3; int e = 0;
#pragma unroll
        for (int j = 1; j < 16; ++j) e += (rt >= ts[j]) ? 1 : 0;
        u.pm = rt; u.pn = e * 4 + ct; return true; } };

__device__ __forceinline__ void phase_prep_simple(ArgsR a, const Ctx& c, int l) {
    const bf16* ZR = (const bf16*)(a.ws + WS_ZR);
    const float* mu = a.in[I_MU] + l * RC; const float* w0 = a.in[I_W0] + l * W; const float* w2 = a.in[I_W2] + (size_t)l * 64 * W;
    const float* a0 = a.in[I_A0] + l * W; const float* a2 = a.in[I_A2] + (size_t)l * 64 * W; const float* g2 = a.in[I_G2] + (size_t)l * 128 * W;
    const float* k_k = a.in[I_KK] + l * W; const float* k_a = a.in[I_KA] + l * W;
    const float* vm0 = a.in[I_VM0]; const float* vm1 = a.in[I_VM1]; const float* vm2 = a.in[I_VM2];
    f16* R = (f16*)(a.ws + WS_R); f16* WM1 = (f16*)(a.ws + WS_WM1); f16* KP = (f16*)(a.ws + WS_KP); f16* AA = (f16*)(a.ws + WS_AA); f16* BB = (f16*)(a.ws + WS_BB); f16* V = (f16*)(a.ws + WS_V);
    bf16* G = (bf16*)(a.ws + WS_G); bf16* VF = (bf16*)(a.ws + WS_VF);
    const int lane = c.lane;
    for (int t = c.gw; t < T; t += c.ngw) {
        float z[28];
#pragma unroll
        for (int i = 0; i < 28; ++i) { const int col = lane + 64 * i; const float zc = bf2f(ZR[(size_t)t * RC + col]); const float zp = t > 0 ? bf2f(ZR[(size_t)(t - 1) * RC + col]) : 0.f; z[i] = zc + (zp - zc) * mu[col]; }
        const float tw = tanhf(z[24]), za = z[25], sg0 = sigmoidf_(z[26]), sg1 = sigmoidf_(z[27]);
        float wlo[8], alo[8], gg[8];
#pragma unroll
        for (int i = 0; i < 8; ++i) { wlo[i] = 0.f; alo[i] = 0.f; gg[i] = 0.f; }
        for (int j = 0; j < 64; ++j) { const float tj = __shfl(tw, j), aj = __shfl(za, j), s0 = __shfl(sg0, j), s1 = __shfl(sg1, j);
#pragma unroll
            for (int i = 0; i < 8; ++i) { const int n = lane + 64 * i; wlo[i] += tj * w2[j * W + n]; alo[i] += aj * a2[j * W + n]; gg[i] += s0 * g2[j * W + n] + s1 * g2[(64 + j) * W + n]; } }
        float vv[8];
#pragma unroll
        for (int i = 0; i < 8; ++i) vv[i] = z[16 + i];
        if (l == 0) {
#pragma unroll
            for (int i = 0; i < 8; ++i) VF[(size_t)t * W + lane + 64 * i] = f2bf(vv[i]);
        } else {
            float vmid = 0.f;
#pragma unroll
            for (int i = 0; i < 8; ++i)
                for (int j = 0; j < 64; ++j) { const float vc = __shfl(vv[i], j); vmid += vc * vm1[(size_t)(64 * i + j) * 32 + (lane & 31)]; }
            float vg[8];
#pragma unroll
            for (int i = 0; i < 8; ++i) vg[i] = 0.f;
            for (int m = 0; m < 32; ++m) { const float vmm = __shfl(vmid, m);
#pragma unroll
                for (int i = 0; i < 8; ++i) vg[i] += vmm * vm2[m * W + lane + 64 * i]; }
#pragma unroll
            for (int i = 0; i < 8; ++i) { const int n = lane + 64 * i; const float vf = bf2f(VF[(size_t)t * W + n]); vv[i] = vv[i] + (vf - vv[i]) * sigmoidf_(vm0[n] + vg[i]); }
        }
#pragma unroll
        for (int i = 0; i < 8; ++i) {
            const int n = lane + 64 * i; const size_t o = (size_t)t * W + n;
            const float x = w0[n] + wlo[i]; const float wl = -softplusf_(-x) - 0.5f; const float dm1 = expm1f(-__expf(wl));
            const float av = sigmoidf_(a0[n] + alo[i]);
            const float kraw = z[8 + i];
            float kk = kraw * k_k[n]; const float nrm = sqrtf(wave_sum(kk * kk)); kk = kk / fmaxf(nrm, 1e-12f);
            const float kp = kraw * (1.0f + (av - 1.0f) * k_a[n]);
            R[o] = (f16)z[i]; WM1[o] = (f16)dm1; KP[o] = (f16)kp; AA[o] = (f16)(-kk); BB[o] = (f16)(kk * av); V[o] = (f16)vv[i]; G[o] = f2bf(gg[i]);
        }
    }
}

__device__ __forceinline__ void phase_sg_simple(ArgsR a, const Ctx& c, int l) {
    const bf16* ZS = (const bf16*)(a.ws + WS_ZS); bf16* YB = (bf16*)(a.ws + WS_YB);
    const float* lng = a.in[I_SGG] + l * W; const float* lnb = a.in[I_SGB] + l * W;
    float* vn = (float*)c.lds;
    float* st = vn + 128 * 64;
    for (int uidx = blockIdx.x; uidx < 128 * 8; uidx += gridDim.x) {
        const int ch = uidx >> 3, g = uidx & 7; const int tok0 = ch * 128;
        for (int i = 0; i < 16; ++i) { const int s = c.wave * 16 + i; const bf16* p = ZS + (size_t)(tok0 + s) * 1024 + 512 + c.lane * 8;
            const f32x4 x0 = load4bf(p), x1 = load4bf(p + 4);
            float sm = (x0[0] + x0[1]) + (x0[2] + x0[3]) + (x1[0] + x1[1]) + (x1[2] + x1[3]); const float mean = wave_sum(sm) * (1.f / 512.f);
            float q = 0.f; for (int e = 0; e < 4; ++e) { const float d0 = x0[e] - mean, d1 = x1[e] - mean; q += d0 * d0 + d1 * d1; }
            const float rstd = __builtin_amdgcn_rsqf(wave_sum(q) * (1.f / 512.f) + LN_EPS);
            if (c.lane == 0) { st[2 * s] = mean; st[2 * s + 1] = rstd; } }
        __syncthreads();
        for (int i = c.tid; i < 128 * 64; i += NTHREADS) { const int s = i >> 6, d = i & 63; const float x = bf2f(ZS[(size_t)(tok0 + s) * 1024 + 512 + g * 64 + d]);
            vn[i] = (x - st[2 * s]) * st[2 * s + 1] * lng[g * 64 + d] + lnb[g * 64 + d]; }
        __syncthreads();
        const int d = c.tid & 63, tq = c.tid >> 6;
        const float* Wg = a.in[I_WS] + (size_t)(l * 8 + g) * 128 * 128; const float* bs = a.in[I_BS] + (size_t)(l * 8 + g) * 128;
        for (int i = 0; i < 16; ++i) { const int t = tq + 8 * i; float acc = 0.f;
            for (int s = 0; s <= t; ++s) acc += Wg[t * 128 + s] * vn[s * 64 + d];
            const float u = bf2f(ZS[(size_t)(tok0 + t) * 1024 + g * 64 + d]);
            YB[(size_t)(tok0 + t) * W + g * 64 + d] = f2bf(u * (acc + bs[t])); }
        __syncthreads();
    }
}

#define LAS3 __attribute__((address_space(3)))
typedef short bf16x8 __attribute__((ext_vector_type(8)));
template <int MT, int NT, int KS, bool SWAP = false>
__device__ __forceinline__ void mma_lds_glob(const unsigned char* lds_base, int a_off_bytes, int lda, const bf16* Bt, int ldb, int n0, int lane, f32x4 (&acc)[MT][NT]) {
    const int fr = lane & 15, fq = lane >> 4;
    const LAS3 unsigned char* Ab = (const LAS3 unsigned char*)lds_base + a_off_bytes;
    int boff = (n0 + fr) * ldb + 8 * fq; asm volatile("" : "+v"(boff));
#pragma unroll
    for (int ks = 0; ks < KS; ++ks) {
        bf16x8 b[NT];
#pragma unroll
        for (int n = 0; n < NT; ++n) b[n] = *(const bf16x8*)(Bt + boff + 16 * n * ldb + 32 * ks);
#pragma unroll
        for (int m = 0; m < MT; ++m) { const bf16x8 av = *(const LAS3 bf16x8*)(Ab + ((16 * m + fr) * lda + 32 * ks + 8 * fq) * 2);
#pragma unroll
            for (int n = 0; n < NT; ++n) acc[m][n] = SWAP ? __builtin_amdgcn_mfma_f32_16x16x32_bf16(b[n], av, acc[m][n], 0, 0, 0) : __builtin_amdgcn_mfma_f32_16x16x32_bf16(av, b[n], acc[m][n], 0, 0, 0); }
    }
}
__device__ __forceinline__ void zshift8(const bf16* ZR, int t, int col, const float* mu, float (&o)[8]) {
    const u32x4 zc = *(const u32x4*)(ZR + (size_t)t * RC + col);
    u32x4 zp = {0u, 0u, 0u, 0u}; if (t > 0) zp = *(const u32x4*)(ZR + (size_t)(t - 1) * RC + col);
    const f32x4 m0 = *(const f32x4*)(mu + col), m1 = *(const f32x4*)(mu + col + 4);
#pragma unroll
    for (int e = 0; e < 4; ++e) { const float c0 = __uint_as_float(zc[e] << 16), c1 = __uint_as_float(zc[e] & 0xffff0000u), p0 = __uint_as_float(zp[e] << 16), p1 = __uint_as_float(zp[e] & 0xffff0000u);
        const float mu0 = (2 * e < 4) ? m0[(2 * e) & 3] : m1[(2 * e) & 3], mu1 = (2 * e + 1 < 4) ? m0[(2 * e + 1) & 3] : m1[(2 * e + 1) & 3];
        o[2 * e] = c0 + (p0 - c0) * mu0; o[2 * e + 1] = c1 + (p1 - c1) * mu1; }
}
typedef _Float16 f16x8 __attribute__((ext_vector_type(8)));
typedef _Float16 f16x4 __attribute__((ext_vector_type(4)));
__device__ __forceinline__ void store8f16(f16* p, const float (&v)[8]) { f16x8 h;
#pragma unroll
    for (int e = 0; e < 8; ++e) h[e] = (f16)v[e];
    *(f16x8*)p = h; }
__device__ __forceinline__ u32x4 pack8bf(const float (&v)[8]) { u32x4 w; w.x = pk2(v[0], v[1]); w.y = pk2(v[2], v[3]); w.z = pk2(v[4], v[5]); w.w = pk2(v[6], v[7]); return w; }


constexpr int PB_LD = 520;
constexpr int PB_BUF = 0, PB_AOP = 64 * PB_LD * 2, PB_VMID = 2 * 64 * PB_LD * 2, PB_LA_LD = 264, PB_VM_LD = 40;
__device__ __forceinline__ void phase_prep_fast(ArgsR a, const Ctx& c, int l) {
    const bf16* ZR = (const bf16*)(a.ws + WS_ZR);
    const float* mu = a.in[I_MU] + l * RC; const float* w0 = a.in[I_W0] + l * W; const float* a0 = a.in[I_A0] + l * W;
    const float* k_k = a.in[I_KK] + l * W; const float* k_a = a.in[I_KA] + l * W; const float* vm0 = a.in[I_VM0];
    f16* R = (f16*)(a.ws + WS_R); f16* WM1 = (f16*)(a.ws + WS_WM1); f16* KP = (f16*)(a.ws + WS_KP); f16* AA = (f16*)(a.ws + WS_AA); f16* BB = (f16*)(a.ws + WS_BB); f16* V = (f16*)(a.ws + WS_V);
    bf16* G = (bf16*)(a.ws + WS_G); bf16* VF = (bf16*)(a.ws + WS_VF);
    const unsigned char* lo = a.ws + WS_LORA + (size_t)l * LO_STRIDE;
    const bf16* W2T = (const bf16*)(lo + LO_W2T); const bf16* A2T = (const bf16*)(lo + LO_A2T); const bf16* G2T = (const bf16*)(lo + LO_G2T);
    const bf16* VM1T = (const bf16*)(lo + LO_VM1T); const bf16* VM2T = (const bf16*)(lo + LO_VM2T);
    LAS3 unsigned char* L = (LAS3 unsigned char*)c.lds;
    const int tid = c.tid, lane = c.lane, wv = c.wave, fr = lane & 15, fq = lane >> 4;
    const int row = tid >> 3, sub_ = tid & 7;
    for (int u = blockIdx.x; u < T / 64; u += gridDim.x) {
        int sub = sub_; asm volatile("" : "+v"(sub));
        const int t0 = u * 64, t = t0 + row;
        if (l == 0) {
#pragma unroll 4
            for (int p = 0; p < 8; ++p) { const int col = p * 64 + sub * 8; float z[8]; zshift8(ZR, t, 1024 + col, mu, z);
                store8f16(V + (size_t)t * W + col, z); *(u32x4*)(VF + (size_t)t * W + col) = pack8bf(z); }
        } else {
#pragma unroll 4
            for (int p = 0; p < 8; ++p) { const int col = p * 64 + sub * 8; float z[8]; zshift8(ZR, t, 1024 + col, mu, z);
                *(LAS3 u32x4*)(L + PB_AOP + (row * PB_LD + col) * 2) = pack8bf(z); }
            __syncthreads();
            { f32x4 acc[1][1]; acc[0][0] = (f32x4){0.f, 0.f, 0.f, 0.f}; const int m = wv >> 1, n = wv & 1;
              mma_lds_glob<1, 1, 16>(c.lds, PB_AOP + 16 * m * PB_LD * 2, PB_LD, VM1T, W, 16 * n, lane, acc);
#pragma unroll
              for (int i = 0; i < 4; ++i) *(LAS3 bf16*)(L + PB_VMID + ((16 * m + 4 * fq + i) * PB_VM_LD + 16 * n + fr) * 2) = f2bf(acc[0][0][i]); }
            __syncthreads();
            { f32x4 acc[4][4];
#pragma unroll
              for (int m = 0; m < 4; ++m)
#pragma unroll
                  for (int n = 0; n < 4; ++n) acc[m][n] = (f32x4){0.f, 0.f, 0.f, 0.f};
              mma_lds_glob<4, 4, 1, true>(c.lds, PB_VMID, PB_VM_LD, VM2T, 32, 64 * wv, lane, acc);
#pragma unroll
              for (int m = 0; m < 4; ++m)
#pragma unroll
                  for (int n = 0; n < 4; ++n) { const int col = 64 * wv + 16 * n + 4 * fq; const f32x4 vb = *(const f32x4*)(vm0 + col); f16x4 hv;
#pragma unroll
                      for (int i = 0; i < 4; ++i) hv[i] = (f16)sigmoidf_(vb[i] + acc[m][n][i]);
                      *(LAS3 f16x4*)(L + PB_BUF + ((16 * m + fr) * PB_LD + col) * 2) = hv; } }
            __syncthreads();
#pragma unroll 4
            for (int p = 0; p < 8; ++p) { const int col = p * 64 + sub * 8;
                const u32x4 vz = *(const LAS3 u32x4*)(L + PB_AOP + (row * PB_LD + col) * 2); const f16x8 gt = *(const LAS3 f16x8*)(L + PB_BUF + (row * PB_LD + col) * 2);
                const u32x4 vfw = *(const u32x4*)(VF + (size_t)t * W + col); float o[8];
#pragma unroll
                for (int e = 0; e < 4; ++e) { const float v0 = __uint_as_float(vz[e] << 16), v1 = __uint_as_float(vz[e] & 0xffff0000u), f0 = __uint_as_float(vfw[e] << 16), f1 = __uint_as_float(vfw[e] & 0xffff0000u);
                    o[2 * e] = v0 + (f0 - v0) * (float)gt[2 * e]; o[2 * e + 1] = v1 + (f1 - v1) * (float)gt[2 * e + 1]; }
                store8f16(V + (size_t)t * W + col, o); }
            __syncthreads();
        }
#pragma unroll 4
        for (int p = 0; p < 4; ++p) { const int cc = sub * 32 + p * 8; float z[8]; zshift8(ZR, t, 1536 + cc, mu, z);
#pragma unroll
            for (int e = 0; e < 8; ++e) z[e] = cc < 64 ? (1.0f - 2.0f * __builtin_amdgcn_rcpf(1.0f + __expf(2.0f * z[e]))) : (cc < 128 ? z[e] : sigmoidf_(z[e]));
            *(LAS3 u32x4*)(L + PB_AOP + (row * PB_LA_LD + cc) * 2) = pack8bf(z); }
        __syncthreads();
        { f32x4 acc[4][4];
#pragma unroll
          for (int m = 0; m < 4; ++m)
#pragma unroll
              for (int n = 0; n < 4; ++n) acc[m][n] = (f32x4){0.f, 0.f, 0.f, 0.f};
          mma_lds_glob<4, 4, 2, true>(c.lds, PB_AOP + 64 * 2, PB_LA_LD, A2T, 64, 64 * wv, lane, acc);
#pragma unroll
          for (int m = 0; m < 4; ++m)
#pragma unroll
              for (int n = 0; n < 4; ++n) { const int col = 64 * wv + 16 * n + 4 * fq; const f32x4 ab = *(const f32x4*)(a0 + col); f16x4 hv;
#pragma unroll
                  for (int i = 0; i < 4; ++i) hv[i] = (f16)sigmoidf_(ab[i] + acc[m][n][i]);
                  *(LAS3 f16x4*)(L + PB_BUF + ((16 * m + fr) * PB_LD + col) * 2) = hv; } }
        __syncthreads();
#pragma unroll 4
        for (int p = 0; p < 8; ++p) { const int col = p * 64 + sub * 8; const size_t o = (size_t)t * W + col;
            float z[8]; zshift8(ZR, t, col, mu, z); store8f16(R + o, z);
            float kz[8]; zshift8(ZR, t, 512 + col, mu, kz);
            const f16x8 av = *(const LAS3 f16x8*)(L + PB_BUF + (row * PB_LD + col) * 2);
            const f32x4 kk0 = *(const f32x4*)(k_k + col), kk1 = *(const f32x4*)(k_k + col + 4), ka0 = *(const f32x4*)(k_a + col), ka1 = *(const f32x4*)(k_a + col + 4);
            float kk[8], kp[8], bb[8]; float ss = 0.f;
#pragma unroll
            for (int e = 0; e < 8; ++e) { const float kkw = e < 4 ? kk0[e & 3] : kk1[e & 3], kaw = e < 4 ? ka0[e & 3] : ka1[e & 3]; kk[e] = kz[e] * kkw; ss += kk[e] * kk[e]; kp[e] = kz[e] * (1.0f + ((float)av[e] - 1.0f) * kaw); }
            ss += __shfl_xor(ss, 1); ss += __shfl_xor(ss, 2); ss += __shfl_xor(ss, 4);
            const float inv = fminf(__builtin_amdgcn_rsqf(ss), 1e12f);
#pragma unroll
            for (int e = 0; e < 8; ++e) { kk[e] *= inv; bb[e] = kk[e] * (float)av[e]; kk[e] = -kk[e]; }
            store8f16(KP + o, kp); store8f16(AA + o, kk); store8f16(BB + o, bb); }
        __syncthreads();
        { f32x4 acc[4][4];
#pragma unroll
          for (int m = 0; m < 4; ++m)
#pragma unroll
              for (int n = 0; n < 4; ++n) acc[m][n] = (f32x4){0.f, 0.f, 0.f, 0.f};
          mma_lds_glob<4, 4, 2, true>(c.lds, PB_AOP, PB_LA_LD, W2T, 64, 64 * wv, lane, acc);
#pragma unroll
          for (int m = 0; m < 4; ++m)
#pragma unroll
              for (int n = 0; n < 4; ++n) { const int col = 64 * wv + 16 * n + 4 * fq; const f32x4 wb = *(const f32x4*)(w0 + col); f16x4 hv;
#pragma unroll
                  for (int i = 0; i < 4; ++i) { const float x = wb[i] + acc[m][n][i]; const float wl = -(fmaxf(-x, 0.f) + __logf(1.0f + __expf(-fabsf(x)))) - 0.5f;
                      hv[i] = (f16)(__expf(-__expf(wl)) - 1.0f); }
                  *(LAS3 f16x4*)(L + PB_BUF + ((16 * m + fr) * PB_LD + col) * 2) = hv; } }
        __syncthreads();
#pragma unroll 4
        for (int p = 0; p < 8; ++p) { const int col = p * 64 + sub * 8; *(u32x4*)(WM1 + (size_t)t * W + col) = *(const LAS3 u32x4*)(L + PB_BUF + (row * PB_LD + col) * 2); }
        __syncthreads();
        { f32x4 acc[4][4];
#pragma unroll
          for (int m = 0; m < 4; ++m)
#pragma unroll
              for (int n = 0; n < 4; ++n) acc[m][n] = (f32x4){0.f, 0.f, 0.f, 0.f};
          mma_lds_glob<4, 4, 4, true>(c.lds, PB_AOP + 128 * 2, PB_LA_LD, G2T, 128, 64 * wv, lane, acc);
#pragma unroll
          for (int m = 0; m < 4; ++m)
#pragma unroll
              for (int n = 0; n < 4; ++n) { const int col = 64 * wv + 16 * n + 4 * fq; u32x2 w; w.x = pk2(acc[m][n][0], acc[m][n][1]); w.y = pk2(acc[m][n][2], acc[m][n][3]);
                  *(LAS3 u32x2*)(L + PB_BUF + ((16 * m + fr) * PB_LD + col) * 2) = w; } }
        __syncthreads();
#pragma unroll 4
        for (int p = 0; p < 8; ++p) { const int col = p * 64 + sub * 8; *(u32x4*)(G + (size_t)t * W + col) = *(const LAS3 u32x4*)(L + PB_BUF + (row * PB_LD + col) * 2); }
        __syncthreads();
    }
}

constexpr int SG_LD = 136;
constexpr int SG_VT = 0, SG_ST = 256 * SG_LD * 2;
__device__ __forceinline__ void phase_sg_fast(ArgsR a, const Ctx& c, int l) {
    const bf16* ZS = (const bf16*)(a.ws + WS_ZS); bf16* YB = (bf16*)(a.ws + WS_YB);
    const float* lng = a.in[I_SGG] + l * W; const float* lnb = a.in[I_SGB] + l * W;
    LAS3 unsigned char* L = (LAS3 unsigned char*)c.lds;
    LAS3 float* st = (LAS3 float*)(L + SG_ST);
    const int tid = c.tid, lane = c.lane, wv = c.wave, fr = lane & 15, fq = lane >> 4;
    for (int u = blockIdx.x; u < 256; u += gridDim.x) {
        const int ch = u >> 1, hf = u & 1, tok0 = ch * 128;
        { u32x4 raw[16];
#pragma unroll
          for (int i = 0; i < 16; ++i) raw[i] = *(const u32x4*)(ZS + (size_t)(tok0 + wv * 16 + i) * 1024 + 512 + lane * 8);
#pragma unroll
          for (int i = 0; i < 16; ++i) { const int sidx = wv * 16 + i; float x[8];
#pragma unroll
              for (int e = 0; e < 4; ++e) { x[2 * e] = __uint_as_float(raw[i][e] << 16); x[2 * e + 1] = __uint_as_float(raw[i][e] & 0xffff0000u); }
              const float sm = ((x[0] + x[1]) + (x[2] + x[3])) + ((x[4] + x[5]) + (x[6] + x[7])); const float mean = wave_sum(sm) * (1.f / 512.f);
              float q = 0.f;
#pragma unroll
              for (int e = 0; e < 8; ++e) { const float d0 = x[e] - mean; q += d0 * d0; }
              const float rstd = __builtin_amdgcn_rsqf(wave_sum(q) * (1.f / 512.f) + LN_EPS);
              if (lane == 0) { st[2 * sidx] = mean; st[2 * sidx + 1] = rstd; } } }
        __syncthreads();
        { const int sidx = tid >> 2, q4 = tid & 3; const float mean = st[2 * sidx], rstd = st[2 * sidx + 1];
#pragma unroll
          for (int p = 0; p < 8; ++p) { const int cl = q4 * 64 + p * 8; const int cg = hf * 256 + cl;
              const bf16* src = ZS + (size_t)(tok0 + sidx) * 1024 + 512 + cg; const f32x4 x0 = load4bf(src), x1 = load4bf(src + 4);
              const f32x4 g0 = *(const f32x4*)(lng + cg), g1 = *(const f32x4*)(lng + cg + 4), b0 = *(const f32x4*)(lnb + cg), b1 = *(const f32x4*)(lnb + cg + 4);
#pragma unroll
              for (int e = 0; e < 8; ++e) { const float x = e < 4 ? x0[e & 3] : x1[e & 3], gg = e < 4 ? g0[e & 3] : g1[e & 3], bb = e < 4 ? b0[e & 3] : b1[e & 3];
                  *(LAS3 bf16*)(L + SG_VT + ((cl + e) * SG_LD + sidx) * 2) = f2bf((x - mean) * rstd * gg + bb); } } }
        __syncthreads();
        const int gl = wv >> 1, dh = wv & 1, g = hf * 4 + gl;
        const float* Wg = a.in[I_WS] + (size_t)(l * 8 + g) * 128 * 128; const float* bs = a.in[I_BS] + (size_t)(l * 8 + g) * 128;
        f32x4 acc[8][2];
#pragma unroll
        for (int m = 0; m < 8; ++m) { acc[m][0] = (f32x4){0.f, 0.f, 0.f, 0.f}; acc[m][1] = (f32x4){0.f, 0.f, 0.f, 0.f}; }
#pragma unroll
        for (int ks = 0; ks < 4; ++ks) {
            bf16x8 b[2];
#pragma unroll
            for (int n = 0; n < 2; ++n) b[n] = *(const LAS3 bf16x8*)(L + SG_VT + ((gl * 64 + dh * 32 + 16 * n + fr) * SG_LD + 32 * ks + 8 * fq) * 2);
#pragma unroll
            for (int m = 0; m < 8; ++m) { if (32 * ks <= 16 * m + 15) {
                const int trow = 16 * m + fr, s0 = 32 * ks + 8 * fq;
                const f32x4 w0v = *(const f32x4*)(Wg + trow * 128 + s0), w1v = *(const f32x4*)(Wg + trow * 128 + s0 + 4);
                float wf[8];
#pragma unroll
                for (int e = 0; e < 8; ++e) { const float wval = e < 4 ? w0v[e & 3] : w1v[e & 3]; wf[e] = (s0 + e <= trow) ? wval : 0.f; }
                const u32x4 wp = pack8bf(wf); const bf16x8 av = __builtin_bit_cast(bf16x8, wp);
                acc[m][0] = __builtin_amdgcn_mfma_f32_16x16x32_bf16(b[0], av, acc[m][0], 0, 0, 0);
                acc[m][1] = __builtin_amdgcn_mfma_f32_16x16x32_bf16(b[1], av, acc[m][1], 0, 0, 0); } }
        }
#pragma unroll
        for (int m = 0; m < 8; ++m) { const int trow = 16 * m + fr; const float bsv = bs[trow];
#pragma unroll
            for (int n = 0; n < 2; ++n) { const int col = g * 64 + dh * 32 + 16 * n + 4 * fq; const f32x4 uu = load4bf(ZS + (size_t)(tok0 + trow) * 1024 + col);
                store4bf(YB + (size_t)(tok0 + trow) * W + col, uu * (acc[m][n] + bsv)); } }
        __syncthreads();
    }
}

__device__ __forceinline__ void phase_scan_simple(ArgsR a, const Ctx& c) {
    if (c.wave != 0 || blockIdx.x >= NH) return;
    const int h = blockIdx.x, lane = c.lane;
    const f16* R = (const f16*)(a.ws + WS_R); const f16* WM1 = (const f16*)(a.ws + WS_WM1); const f16* KP = (const f16*)(a.ws + WS_KP);
    const f16* AA = (const f16*)(a.ws + WS_AA); const f16* BB = (const f16*)(a.ws + WS_BB); const f16* V = (const f16*)(a.ws + WS_V);
    bf16* YSC = (bf16*)(a.ws + WS_YSC);
    float S[64];
#pragma unroll
    for (int j = 0; j < 64; ++j) S[j] = 0.f;
    for (int t = 0; t < T; ++t) {
        const size_t base = (size_t)t * W + h * 64;
        const float vv = (float)V[base + lane];
        float sa = 0.f;
#pragma unroll
        for (int j = 0; j < 64; ++j) sa += S[j] * (float)AA[base + j];
        float y = 0.f;
#pragma unroll
        for (int j = 0; j < 64; ++j) { float s = S[j]; s = s + s * (float)WM1[base + j]; s += sa * (float)BB[base + j]; s += vv * (float)KP[base + j]; S[j] = s; y += s * (float)R[base + j]; }
        YSC[base + lane] = f2bf(y);
    }
}

typedef unsigned u32x16 __attribute__((ext_vector_type(16)));
__device__ __forceinline__ void sload32(const void* p0, u32x16& a0, u32x16& a1) {
    asm volatile("s_load_dwordx16 %0, %2, 0x0 glc\n\ts_load_dwordx16 %1, %2, 0x40 glc\n\ts_waitcnt lgkmcnt(0)" : "=&s"(a0), "=&s"(a1) : "s"(p0) : "memory");
}
__device__ __forceinline__ void sload64(const void* p0, const void* p1, u32x16& a0, u32x16& a1, u32x16& b0, u32x16& b1) {
    asm volatile("s_load_dwordx16 %0, %4, 0x0 glc\n\ts_load_dwordx16 %1, %4, 0x40 glc\n\ts_load_dwordx16 %2, %5, 0x0 glc\n\ts_load_dwordx16 %3, %5, 0x40 glc\n\ts_waitcnt lgkmcnt(0)"
                 : "=&s"(a0), "=&s"(a1), "=&s"(b0), "=&s"(b1) : "s"(p0), "s"(p1) : "memory");
}
__device__ __forceinline__ float fmix_lo(unsigned sd, float x, float y) { float d; asm("v_fma_mix_f32 %0, %1, %2, %3 op_sel_hi:[1,0,0]" : "=v"(d) : "s"(sd), "v"(x), "v"(y)); return d; }
__device__ __forceinline__ float fmix_hi(unsigned sd, float x, float y) { float d; asm("v_fma_mix_f32 %0, %1, %2, %3 op_sel:[1,0,0] op_sel_hi:[1,0,0]" : "=v"(d) : "s"(sd), "v"(x), "v"(y)); return d; }
constexpr int CL = 64, NCH = T / CL;
constexpr size_t ST_Q_OFF = (size_t)NH * NCH * 64 * 64;
constexpr size_t ST_S_OFF = (size_t)NH * NCH * 64 * 64;

__device__ __forceinline__ float vmix_lo(unsigned vd, float x, float y) { float d; asm("v_fma_mix_f32 %0, %1, %2, %3 op_sel_hi:[1,0,0]" : "=v"(d) : "v"(vd), "v"(x), "v"(y)); return d; }
__device__ __forceinline__ float vmix_hi(unsigned vd, float x, float y) { float d; asm("v_fma_mix_f32 %0, %1, %2, %3 op_sel:[1,0,0] op_sel_hi:[1,0,0]" : "=v"(d) : "v"(vd), "v"(x), "v"(y)); return d; }
template <int N> __device__ __forceinline__ void fmac_bc(float& acc, float vec, float x) { asm("v_fmac_f32_dpp %0, %1, %2 row_newbcast:%3 row_mask:0xf bank_mask:0xf" : "+v"(acc) : "v"(vec), "v"(x), "n"(N)); }
template <int N> __device__ __forceinline__ float mul_bc(float vec, float x) { float d; asm("v_mul_f32_dpp %0, %1, %2 row_newbcast:%3 row_mask:0xf bank_mask:0xf" : "=v"(d) : "v"(vec), "v"(x), "n"(N)); return d; }
struct SVec { float v[4]; };
__device__ __forceinline__ f16x4 sv_read(const LAS3 unsigned char* p, int lane) { return *(const LAS3 f16x4*)(p + (lane & 15) * 8); }
__device__ __forceinline__ void sv_cvt(SVec& o, f16x4 h) { o.v[0] = (float)h[0]; o.v[1] = (float)h[1]; o.v[2] = (float)h[2]; o.v[3] = (float)h[3]; }
__device__ __forceinline__ void sv_cvt1p(SVec& o, f16x4 h) { o.v[0] = 1.0f + (float)h[0]; o.v[1] = 1.0f + (float)h[1]; o.v[2] = 1.0f + (float)h[2]; o.v[3] = 1.0f + (float)h[3]; }
template <int J> __device__ __forceinline__ void sc_dot(float (&d)[4], const SVec& A, const float (&X)[64]) { fmac_bc<(J >> 2)>(d[J & 3], A.v[J & 3], X[J]); if constexpr (J + 1 < 64) sc_dot<J + 1>(d, A, X); }
template <int J> __device__ __forceinline__ void sc_upd3(float (&S)[64], float (&y)[4], const SVec& Wv, const SVec& Bv, const SVec& Kv, const SVec& Rv, float sa, float vv) {
    float sj = mul_bc<(J >> 2)>(Wv.v[J & 3], S[J]); fmac_bc<(J >> 2)>(sj, Bv.v[J & 3], sa); fmac_bc<(J >> 2)>(sj, Kv.v[J & 3], vv); S[J] = sj; fmac_bc<(J >> 2)>(y[J & 3], Rv.v[J & 3], sj);
    if constexpr (J + 1 < 64) sc_upd3<J + 1>(S, y, Wv, Bv, Kv, Rv, sa, vv); }
template <int J> __device__ __forceinline__ void sc_upd1(float (&Q)[64], float (&P)[64], const SVec& Wv, const SVec& Bv, const SVec& Kv, float saq, float sap, float vv) {
    float qj = mul_bc<(J >> 2)>(Wv.v[J & 3], Q[J]); fmac_bc<(J >> 2)>(qj, Bv.v[J & 3], saq); fmac_bc<(J >> 2)>(qj, Kv.v[J & 3], vv); Q[J] = qj;
    float pj = mul_bc<(J >> 2)>(Wv.v[J & 3], P[J]); fmac_bc<(J >> 2)>(pj, Bv.v[J & 3], sap); P[J] = pj;
    if constexpr (J + 1 < 64) sc_upd1<J + 1>(Q, P, Wv, Bv, Kv, saq, sap, vv); }
constexpr int SCB = 8;
constexpr int SC_NS = 7, SC_BUF = SC_NS * 1024, SC_WAVE = 2 * SC_BUF;
__device__ __forceinline__ void sc_dma(const f16* X, size_t eoff, LAS3 unsigned char* dst) {
    __builtin_amdgcn_global_load_lds((const unsigned*)(X + eoff), (LAS3 unsigned*)dst, 16, 0, 0);
}

__device__ __forceinline__ void phase_scan1(ArgsR a, const Ctx& c) {
    const f16* WM1 = (const f16*)(a.ws + WS_WM1); const f16* KP = (const f16*)(a.ws + WS_KP);
    const f16* AA = (const f16*)(a.ws + WS_AA); const f16* BB = (const f16*)(a.ws + WS_BB); const f16* V = (const f16*)(a.ws + WS_V);
    float* ST = (float*)(a.ws + WS_ST);
    const int lane = c.lane;
    LAS3 unsigned char* ring = (LAS3 unsigned char*)c.lds + c.wave * SC_WAVE;
    for (int item = c.gw; item < NH * NCH; item += c.ngw) {
        const int h = __builtin_amdgcn_readfirstlane(item / NCH), ch = __builtin_amdgcn_readfirstlane(item % NCH);
        float Q[64], P[64];
        int ln_ = lane; asm volatile("" : "+v"(ln_));
#pragma unroll
        for (int j = 0; j < 64; ++j) { Q[j] = 0.f; P[j] = (j == ln_) ? 1.f : 0.f; }
        const size_t lane_off = (size_t)(lane >> 3) * W + h * 64 + (lane & 7) * 8;
        { const size_t e0 = (size_t)(ch * CL) * W + lane_off;
          sc_dma(AA, e0, ring); sc_dma(WM1, e0, ring + 1024); sc_dma(BB, e0, ring + 2048); sc_dma(KP, e0, ring + 3072); sc_dma(V, e0, ring + 4096); }
#pragma unroll 1
        for (int blk = 0; blk < CL / SCB; ++blk) {
            LAS3 unsigned char* buf = ring + (blk & 1) * SC_BUF;
            if (blk + 1 < CL / SCB) { LAS3 unsigned char* nb = ring + ((blk + 1) & 1) * SC_BUF; const size_t e0 = (size_t)(ch * CL + (blk + 1) * SCB) * W + lane_off;
                sc_dma(AA, e0, nb); sc_dma(WM1, e0, nb + 1024); sc_dma(BB, e0, nb + 2048); sc_dma(KP, e0, nb + 3072); sc_dma(V, e0, nb + 4096);
                asm volatile("s_waitcnt vmcnt(5)" ::: "memory"); }
            else asm volatile("s_waitcnt vmcnt(0)" ::: "memory");
            SVec A, Wv, Bv, Kv;
            sv_cvt(A, sv_read(buf, lane)); sv_cvt1p(Wv, sv_read(buf + 1024, lane)); sv_cvt(Bv, sv_read(buf + 2048, lane)); sv_cvt(Kv, sv_read(buf + 3072, lane));
            float vv = (float)*(const LAS3 f16*)(buf + 4096 + lane * 2);
#pragma unroll 1
            for (int st = 0; st < SCB; ++st) {
                const LAS3 unsigned char* sn = buf + ((st + 1 < SCB) ? st + 1 : st) * 128;
                const f16x4 ha = sv_read(sn, lane), hw = sv_read(sn + 1024, lane), hb = sv_read(sn + 2048, lane), hk = sv_read(sn + 3072, lane);
                const f16 hv = *(const LAS3 f16*)(sn + 4096 + lane * 2);
                float dq[4] = {0.f, 0.f, 0.f, 0.f}, dp[4] = {0.f, 0.f, 0.f, 0.f};
                sc_dot<0>(dq, A, Q); sc_dot<0>(dp, A, P);
                const float saq = (dq[0] + dq[1]) + (dq[2] + dq[3]), sap = (dp[0] + dp[1]) + (dp[2] + dp[3]);
                sc_upd1<0>(Q, P, Wv, Bv, Kv, saq, sap, vv);
                sv_cvt(A, ha); sv_cvt1p(Wv, hw); sv_cvt(Bv, hb); sv_cvt(Kv, hk); vv = (float)hv;
            }
        }
        float* Qp = ST + ST_Q_OFF + (size_t)(h * NCH + ch) * 4096 + lane;
        bf16* PTp = (bf16*)ST + (size_t)(h * NCH + ch) * 4096 + lane;
#pragma unroll
        for (int j = 0; j < 64; ++j) { PTp[j * 64] = f2bf(P[j]); Qp[j * 64] = Q[j]; }
    }
}
constexpr int GS = 16, NG = NCH / GS;
constexpr size_t ST_LP_OFF = (size_t)NH * NCH * 4096;
constexpr size_t WS_SG = WS_LORA + 2 * MiB;
constexpr int HI_LD = 72, HI_BYTES = 64 * HI_LD * 2;
struct HFrag { bf16x8 b[2][2]; f32x4 q[2]; };
__device__ __forceinline__ void hload(HFrag& f, const bf16* Bt, const float* QTc, int boff, int qtoff) {
#pragma unroll
    for (int ks = 0; ks < 2; ++ks)
#pragma unroll
        for (int n = 0; n < 2; ++n) f.b[ks][n] = *(const bf16x8*)(Bt + boff + 16 * n * 64 + 32 * ks);
#pragma unroll
    for (int n = 0; n < 2; ++n) f.q[n] = *(const f32x4*)(QTc + qtoff + 16 * n * 64);
}
__device__ __forceinline__ void hmma(const LAS3 unsigned char* img, const bf16x8 (&b)[2][2], f32x4 (&acc)[2], int m, int fr, int fq) {
#pragma unroll
    for (int ks = 0; ks < 2; ++ks) { const bf16x8 av = *(const LAS3 bf16x8*)(img + ((16 * m + fr) * HI_LD + 32 * ks + 8 * fq) * 2);
#pragma unroll
        for (int n = 0; n < 2; ++n) acc[n] = __builtin_amdgcn_mfma_f32_16x16x32_bf16(av, b[ks][n], acc[n], 0, 0, 0); }
}
__device__ __forceinline__ void himg_store(LAS3 unsigned char* img, const f32x4 (&acc)[2], int m, int n0, int fr, int fq) {
#pragma unroll
    for (int n = 0; n < 2; ++n)
#pragma unroll
        for (int i = 0; i < 4; ++i) *(LAS3 bf16*)(img + ((16 * m + 4 * fq + i) * HI_LD + n0 + 16 * n + fr) * 2) = f2bf(acc[n][i]);
}
#define HBAR() do { asm volatile("s_waitcnt lgkmcnt(0)" ::: "memory"); __builtin_amdgcn_s_barrier(); asm volatile("" ::: "memory"); } while (0)

__device__ __forceinline__ void sc2a_step(const HFrag& f, bf16* LpTc, float* QTc, const LAS3 unsigned char* ip, LAS3 unsigned char* ipn, const LAS3 unsigned char* iq, LAS3 unsigned char* iqn, int m, int n0, int fr, int fq, int qtoff) {
    f32x4 ap[2], aq[2];
#pragma unroll
    for (int n = 0; n < 2; ++n) { ap[n] = (f32x4){0.f, 0.f, 0.f, 0.f}; aq[n] = f.q[n]; }
    hmma(ip, f.b, ap, m, fr, fq); hmma(iq, f.b, aq, m, fr, fq);
#pragma unroll
    for (int n = 0; n < 2; ++n) { u32x2 w; w.x = pk2(ap[n][0], ap[n][1]); w.y = pk2(ap[n][2], ap[n][3]);
        *(u32x2*)(LpTc + (n0 + 16 * n + fr) * 64 + 16 * m + 4 * fq) = w;
        *(f32x4*)(QTc + qtoff + 16 * n * 64) = aq[n]; }
    himg_store(ipn, ap, m, n0, fr, fq); himg_store(iqn, aq, m, n0, fr, fq);
    HBAR();
}
__device__ __forceinline__ void phase_scan2a(ArgsR a, const Ctx& c) {
    const int lane = c.lane, wv = c.wave, fr = lane & 15, fq = lane >> 4, m = wv >> 1, n0 = 32 * (wv & 1);
    const int boff = (n0 + fr) * 64 + 8 * fq, qtoff = (n0 + fr) * 64 + 16 * m + 4 * fq;
    LAS3 unsigned char* L = (LAS3 unsigned char*)c.lds;
    for (int item = blockIdx.x; item < NH * NG; item += gridDim.x) {
        const size_t cb = (size_t)(item / NG) * NCH + (size_t)(item % NG) * GS;
        const bf16* PT = (const bf16*)(a.ws + WS_ST) + cb * 4096; bf16* LP = (bf16*)(a.ws + WS_ST) + ST_LP_OFF + cb * 4096; float* QT = (float*)(a.ws + WS_ST) + ST_Q_OFF + cb * 4096;
        for (int i = c.tid; i < 4 * HI_BYTES / 4; i += NTHREADS) ((LAS3 unsigned*)L)[i] = 0u;
        __syncthreads();
        if (c.tid < 64) *(LAS3 bf16*)(L + (c.tid * HI_LD + c.tid) * 2) = (bf16)0x3F80;
        __syncthreads();
        HFrag f0, f1, f2, f3;
        hload(f0, PT, QT, boff, qtoff); hload(f1, PT + 4096, QT + 4096, boff, qtoff); hload(f2, PT + 2 * 4096, QT + 2 * 4096, boff, qtoff); hload(f3, PT + 3 * 4096, QT + 3 * 4096, boff, qtoff);
        LAS3 unsigned char* p0 = L; LAS3 unsigned char* p1 = L + HI_BYTES; LAS3 unsigned char* q0 = L + 2 * HI_BYTES; LAS3 unsigned char* q1 = L + 3 * HI_BYTES;
#pragma unroll 1
        for (int i = 0; i < GS; i += 4) {
            const int nx = (i + 4 < GS) ? i + 4 : i;
            sc2a_step(f0, LP + (size_t)(i + 0) * 4096, QT + (size_t)(i + 0) * 4096, p0, p1, q0, q1, m, n0, fr, fq, qtoff); hload(f0, PT + (size_t)(nx + 0) * 4096, QT + (size_t)(nx + 0) * 4096, boff, qtoff);
            sc2a_step(f1, LP + (size_t)(i + 1) * 4096, QT + (size_t)(i + 1) * 4096, p1, p0, q1, q0, m, n0, fr, fq, qtoff); hload(f1, PT + (size_t)(nx + 1) * 4096, QT + (size_t)(nx + 1) * 4096, boff, qtoff);
            sc2a_step(f2, LP + (size_t)(i + 2) * 4096, QT + (size_t)(i + 2) * 4096, p0, p1, q0, q1, m, n0, fr, fq, qtoff); hload(f2, PT + (size_t)(nx + 2) * 4096, QT + (size_t)(nx + 2) * 4096, boff, qtoff);
            sc2a_step(f3, LP + (size_t)(i + 3) * 4096, QT + (size_t)(i + 3) * 4096, p1, p0, q1, q0, m, n0, fr, fq, qtoff); hload(f3, PT + (size_t)(nx + 3) * 4096, QT + (size_t)(nx + 3) * 4096, boff, qtoff);
        }
        __syncthreads();
    }
}
__device__ __forceinline__ void phase_scan2b(ArgsR a, const Ctx& c) {
    if (blockIdx.x >= NH) return;
    const int h = blockIdx.x, lane = c.lane, wv = c.wave, fr = lane & 15, fq = lane >> 4, m = wv >> 1, n0 = 32 * (wv & 1);
    const int boff = (n0 + fr) * 64 + 8 * fq, qtoff = (n0 + fr) * 64 + 16 * m + 4 * fq;
    LAS3 unsigned char* L = (LAS3 unsigned char*)c.lds;
    const bf16* LP = (const bf16*)(a.ws + WS_ST) + ST_LP_OFF + (size_t)h * NCH * 4096; const float* QT = (const float*)(a.ws + WS_ST) + ST_Q_OFF + (size_t)h * NCH * 4096;
    bf16* SG = (bf16*)(a.ws + WS_SG) + (size_t)h * NG * 4096;
    for (int i = c.tid; i < 2 * HI_BYTES / 4; i += NTHREADS) ((LAS3 unsigned*)L)[i] = 0u;
    for (int i = c.tid; i < 4096 / 2; i += NTHREADS) ((LAS3 unsigned*)(L + 2 * HI_BYTES))[i] = 0u;
    __syncthreads();
    HFrag f0, f1, f2, f3;
#define SC2B_CH(g) ((size_t)((g) * GS + GS - 1) * 4096)
    hload(f0, LP + SC2B_CH(0), QT + SC2B_CH(0), boff, qtoff); hload(f1, LP + SC2B_CH(1), QT + SC2B_CH(1), boff, qtoff); hload(f2, LP + SC2B_CH(2), QT + SC2B_CH(2), boff, qtoff); hload(f3, LP + SC2B_CH(3), QT + SC2B_CH(3), boff, qtoff);
    LAS3 unsigned char* i0 = L; LAS3 unsigned char* i1 = L + HI_BYTES;
#define SC2B_STEP(f, g, ic, in) do { f32x4 acc[2] = {f.q[0], f.q[1]}; hmma(ic, f.b, acc, m, fr, fq); LAS3 bf16* So = (LAS3 bf16*)(L + 2 * HI_BYTES) + (((g) + 1) & 7) * 4096; \
        _Pragma("unroll") for (int n = 0; n < 2; ++n) _Pragma("unroll") for (int i = 0; i < 4; ++i) So[(16 * m + 4 * fq + i) * 64 + n0 + 16 * n + fr] = f2bf(acc[n][i]); \
        himg_store(in, acc, m, n0, fr, fq); HBAR(); } while (0)
#pragma unroll 1
    for (int g = 0; g < NG; g += 4) {
        const int nx = (g + 4 < NG) ? g + 4 : g;
        SC2B_STEP(f0, g + 0, i0, i1); hload(f0, LP + SC2B_CH(nx + 0), QT + SC2B_CH(nx + 0), boff, qtoff);
        SC2B_STEP(f1, g + 1, i1, i0); hload(f1, LP + SC2B_CH(nx + 1), QT + SC2B_CH(nx + 1), boff, qtoff);
        SC2B_STEP(f2, g + 2, i0, i1); hload(f2, LP + SC2B_CH(nx + 2), QT + SC2B_CH(nx + 2), boff, qtoff);
        if ((g & 7) == 4) {
            for (int i = c.tid; i < 8 * 4096 / 8; i += NTHREADS) ((u32x4*)(SG + (size_t)(g >> 3) * 8 * 4096))[i] = ((const LAS3 u32x4*)(L + 2 * HI_BYTES))[i];
            HBAR(); }
        if (g + 3 < NG - 1) SC2B_STEP(f3, g + 3, i1, i0);
        hload(f3, LP + SC2B_CH(nx + 3), QT + SC2B_CH(nx + 3), boff, qtoff);
    }
#undef SC2B_STEP
#undef SC2B_CH
}
__device__ __forceinline__ void phase_scan2c(ArgsR a, const Ctx& c) {
    const int lane = c.lane, wv = c.wave, fr = lane & 15, fq = lane >> 4, m = wv >> 1, n0 = 32 * (wv & 1);
    const int boff = (n0 + fr) * 64 + 8 * fq, qtoff = (n0 + fr) * 64 + 16 * m + 4 * fq;
    LAS3 unsigned char* L = (LAS3 unsigned char*)c.lds;
    for (int item = blockIdx.x; item < NH * NG * 2; item += gridDim.x) {
        const int hg = item >> 1, hf = item & 1;
        const size_t cb = (size_t)(hg / NG) * NCH + (size_t)(hg % NG) * GS + hf * 8;
        const bf16* LP = (const bf16*)(a.ws + WS_ST) + ST_LP_OFF + cb * 4096; const float* QT = (const float*)(a.ws + WS_ST) + ST_Q_OFF + cb * 4096; bf16* SS = (bf16*)(a.ws + WS_ST) + cb * 4096;
        { const u32x4 v = *(const u32x4*)((const bf16*)(a.ws + WS_SG) + (size_t)hg * 4096 + c.tid * 8); *(LAS3 u32x4*)(L + ((c.tid >> 3) * HI_LD + (c.tid & 7) * 8) * 2) = v; }
        __syncthreads();
#pragma unroll 2
        for (int i = 0; i < 8; ++i) { HFrag f; hload(f, LP + (size_t)i * 4096, QT + (size_t)i * 4096, boff, qtoff);
            f32x4 acc[2] = {f.q[0], f.q[1]}; hmma(L, f.b, acc, m, fr, fq); bf16* So = SS + (size_t)i * 4096;
#pragma unroll
            for (int n = 0; n < 2; ++n)
#pragma unroll
                for (int k = 0; k < 4; ++k) So[(16 * m + 4 * fq + k) * 64 + n0 + 16 * n + fr] = f2bf(acc[n][k]); }
        __syncthreads();
    }
}
constexpr int WI_LD = 72, WI_B = 64 * WI_LD * 2, WI_GAM = 9 * WI_B, WI_GL = 15 * WI_B;
constexpr size_t WS_GM0 = 352 * MiB, WS_GM1 = 212 * MiB, WS_Y0 = 336 * MiB, WS_END2 = 360 * MiB;
__device__ __forceinline__ bf16* gm_ptr(unsigned char* ws, int h, int ch) { return (bf16*)(ws + (h < 4 ? WS_GM0 : WS_GM1)) + (size_t)((h & 3) * NCH + ch) * 4096; }
__device__ __forceinline__ void wi_mma(f32x4 (&acc)[2], const LAS3 unsigned char* A, const LAS3 unsigned char* Bt, int m, int n0, int fr, int fq) {
#pragma unroll
    for (int ks = 0; ks < 2; ++ks) { const bf16x8 av = *(const LAS3 bf16x8*)(A + ((16 * m + fr) * WI_LD + 32 * ks + 8 * fq) * 2);
#pragma unroll
        for (int n = 0; n < 2; ++n) { const bf16x8 bv = *(const LAS3 bf16x8*)(Bt + ((n0 + 16 * n + fr) * WI_LD + 32 * ks + 8 * fq) * 2); acc[n] = __builtin_amdgcn_mfma_f32_16x16x32_bf16(av, bv, acc[n], 0, 0, 0); } }
}
struct WiA { bf16x8 a[2]; }; struct WiB { bf16x8 b[2][2]; };
__device__ __forceinline__ void wi_lda(WiA& f, const LAS3 unsigned char* A, int m, int fr, int fq) {
#pragma unroll
    for (int ks = 0; ks < 2; ++ks) f.a[ks] = *(const LAS3 bf16x8*)(A + ((16 * m + fr) * WI_LD + 32 * ks + 8 * fq) * 2);
}
__device__ __forceinline__ void wi_ldb(WiB& f, const LAS3 unsigned char* Bt, int n0, int fr, int fq) {
#pragma unroll
    for (int ks = 0; ks < 2; ++ks)
#pragma unroll
        for (int n = 0; n < 2; ++n) f.b[ks][n] = *(const LAS3 bf16x8*)(Bt + ((n0 + 16 * n + fr) * WI_LD + 32 * ks + 8 * fq) * 2);
}
__device__ __forceinline__ void wi_fma(f32x4 (&acc)[2], const WiA& A, const WiB& B) {
#pragma unroll
    for (int ks = 0; ks < 2; ++ks)
#pragma unroll
        for (int n = 0; n < 2; ++n) acc[n] = __builtin_amdgcn_mfma_f32_16x16x32_bf16(A.a[ks], B.b[ks][n], acc[n], 0, 0, 0);
}
__device__ __forceinline__ void wi_fma_s(f32x4 (&acc)[2], const WiA& A, const WiB& B) {
#pragma unroll
    for (int ks = 0; ks < 2; ++ks)
#pragma unroll
        for (int n = 0; n < 2; ++n) acc[n] = __builtin_amdgcn_mfma_f32_16x16x32_bf16(B.b[ks][n], A.a[ks], acc[n], 0, 0, 0);
}
__device__ __forceinline__ void wi_st_nat_s(LAS3 unsigned char* X, const f32x4 (&acc)[2], int m, int n0, int fr, int fq) {
#pragma unroll
    for (int n = 0; n < 2; ++n) { u32x2 w; w.x = pk2(acc[n][0], acc[n][1]); w.y = pk2(acc[n][2], acc[n][3]); *(LAS3 u32x2*)(X + ((16 * m + fr) * WI_LD + n0 + 16 * n + 4 * fq) * 2) = w; }
}
__device__ __forceinline__ void wi_ld_nat_s(f32x4 (&acc)[2], const LAS3 unsigned char* X, int m, int n0, int fr, int fq) {
#pragma unroll
    for (int n = 0; n < 2; ++n) { const u32x2 w = *(const LAS3 u32x2*)(X + ((16 * m + fr) * WI_LD + n0 + 16 * n + 4 * fq) * 2);
        acc[n][0] = __uint_as_float(w.x << 16); acc[n][1] = __uint_as_float(w.x & 0xffff0000u); acc[n][2] = __uint_as_float(w.y << 16); acc[n][3] = __uint_as_float(w.y & 0xffff0000u); }
}
__device__ __forceinline__ void wi_ld_tr(f32x4 (&acc)[2], const LAS3 unsigned char* XT, int m, int n0, int fr, int fq) {
#pragma unroll
    for (int n = 0; n < 2; ++n) { const u32x2 w = *(const LAS3 u32x2*)(XT + ((n0 + 16 * n + fr) * WI_LD + 16 * m + 4 * fq) * 2);
        acc[n][0] = __uint_as_float(w.x << 16); acc[n][1] = __uint_as_float(w.x & 0xffff0000u); acc[n][2] = __uint_as_float(w.y << 16); acc[n][3] = __uint_as_float(w.y & 0xffff0000u); }
}
#define WI_PIN() __builtin_amdgcn_sched_barrier(0)
__device__ __forceinline__ void wi_st_nat(LAS3 unsigned char* X, const f32x4 (&acc)[2], int m, int n0, int fr, int fq) {
#pragma unroll
    for (int n = 0; n < 2; ++n)
#pragma unroll
        for (int i = 0; i < 4; ++i) *(LAS3 bf16*)(X + ((16 * m + 4 * fq + i) * WI_LD + n0 + 16 * n + fr) * 2) = f2bf(acc[n][i]);
}
__device__ __forceinline__ void wi_st_tr(LAS3 unsigned char* XT, const f32x4 (&acc)[2], int m, int n0, int fr, int fq) {
#pragma unroll
    for (int n = 0; n < 2; ++n) { u32x2 w; w.x = pk2(acc[n][0], acc[n][1]); w.y = pk2(acc[n][2], acc[n][3]); *(LAS3 u32x2*)(XT + ((n0 + 16 * n + fr) * WI_LD + 16 * m + 4 * fq) * 2) = w; }
}
__device__ __forceinline__ void wi_ld_nat(f32x4 (&acc)[2], const LAS3 unsigned char* X, int m, int n0, int fr, int fq) {
#pragma unroll
    for (int n = 0; n < 2; ++n)
#pragma unroll
        for (int i = 0; i < 4; ++i) acc[n][i] = bf2f(*(const LAS3 bf16*)(X + ((16 * m + 4 * fq + i) * WI_LD + n0 + 16 * n + fr) * 2));
}
__device__ __forceinline__ void phase_scan1m(ArgsR a, const Ctx& c, const int skip = 0) {
    const f16* WM1 = (const f16*)(a.ws + WS_WM1); const f16* KP = (const f16*)(a.ws + WS_KP);
    const f16* AA = (const f16*)(a.ws + WS_AA); const f16* BB = (const f16*)(a.ws + WS_BB); const f16* V = (const f16*)(a.ws + WS_V); const f16* R = (const f16*)(a.ws + WS_R);
    float* ST = (float*)(a.ws + WS_ST);
    LAS3 unsigned char* L = (LAS3 unsigned char*)c.lds;
    LAS3 float* GAM = (LAS3 float*)(L + WI_GAM); LAS3 float* GL = (LAS3 float*)(L + WI_GL);
    const int lane = c.lane, wv = c.wave, fr = lane & 15, fq = lane >> 4, m = wv >> 1, n0 = 32 * (wv & 1), tid = c.tid;
#define SLOT(i) (L + (i) * WI_B)
    const int t = tid >> 3, cc = (tid & 7) * 8;
    f16x8 pav, pbv, pkv, pvv, prv, pwv;
#define WI_FETCH(it) do { const int h_ = (it) / NCH, ch_ = (it) % NCH; const size_t eo_ = (size_t)(ch_ * CL + t) * W + h_ * 64 + cc; \
        pav = *(const f16x8*)(AA + eo_); pbv = *(const f16x8*)(BB + eo_); pkv = *(const f16x8*)(KP + eo_); pvv = *(const f16x8*)(V + eo_); prv = *(const f16x8*)(R + eo_); pwv = *(const f16x8*)(WM1 + eo_); } while (0)
    if (blockIdx.x < NH * NCH) WI_FETCH(blockIdx.x);
    for (int item = blockIdx.x; item < NH * NCH; item += gridDim.x) {
        const int h = item / NCH, ch = item % NCH;
        const f16x8 av = pav, bv = pbv, kv = pkv, vv = pvv, rv = prv, wv8 = pwv;
        if (item + (int)gridDim.x < NH * NCH) WI_FETCH(item + (int)gridDim.x);
        float g[8], gp[8];
        { float wloc[8];
#pragma unroll
          for (int e = 0; e < 8; ++e) wloc[e] = 1.0f + (float)wv8[e];
#pragma unroll
          for (int e = 0; e < 8; ++e) { float x = wloc[e];
              { const float y = __shfl_up(x, 8); if (lane >= 8) x *= y; } { const float y = __shfl_up(x, 16); if (lane >= 16) x *= y; } { const float y = __shfl_up(x, 32); if (lane >= 32) x *= y; }
              g[e] = x; }
          if (lane >= 56) {
#pragma unroll
              for (int e = 0; e < 8; ++e) GAM[wv * 64 + cc + e] = g[e]; }
          HBAR();
#pragma unroll
          for (int e = 0; e < 8; ++e) { float pre = 1.0f;
#pragma unroll
              for (int w = 0; w < 7; ++w) if (w < wv) pre *= GAM[w * 64 + cc + e];
              g[e] *= pre; gp[e] = g[e] * __builtin_amdgcn_rcpf(wloc[e]); } }
        { float fa[8], fb[8], fk[8], fv[8], frr[8];
#pragma unroll
          for (int e = 0; e < 8; ++e) { const float ig = __builtin_amdgcn_rcpf(g[e]);
              fa[e] = (float)av[e] * gp[e]; fb[e] = (float)bv[e] * ig; fk[e] = (float)kv[e] * ig; fv[e] = (float)vv[e]; frr[e] = (float)rv[e] * g[e]; if (t == 63) GL[cc + e] = g[e]; }
          *(LAS3 u32x4*)(SLOT(0) + (t * WI_LD + cc) * 2) = pack8bf(fa); *(LAS3 u32x4*)(SLOT(2) + (t * WI_LD + cc) * 2) = pack8bf(fb); *(LAS3 u32x4*)(SLOT(4) + (t * WI_LD + cc) * 2) = pack8bf(fk); *(LAS3 u32x4*)(SLOT(12) + (t * WI_LD + cc) * 2) = pack8bf(frr);
#pragma unroll
          for (int e = 0; e < 8; ++e) { *(LAS3 bf16*)(SLOT(1) + ((cc + e) * WI_LD + t) * 2) = f2bf(fa[e]); *(LAS3 bf16*)(SLOT(3) + ((cc + e) * WI_LD + t) * 2) = f2bf(fb[e]); *(LAS3 bf16*)(SLOT(5) + ((cc + e) * WI_LD + t) * 2) = f2bf(fv[e]); } }
        HBAR();
        { WiA aB, aK; WiB bA, bR; wi_lda(aB, SLOT(2), m, fr, fq); wi_lda(aK, SLOT(4), m, fr, fq); wi_ldb(bA, SLOT(0), n0, fr, fq); wi_ldb(bR, SLOT(12), n0, fr, fq);
          WI_PIN();
          f32x4 ans[2] = {{0.f, 0.f, 0.f, 0.f}, {0.f, 0.f, 0.f, 0.f}}, ant[2] = {{0.f, 0.f, 0.f, 0.f}, {0.f, 0.f, 0.f, 0.f}}, aks[2] = {{0.f, 0.f, 0.f, 0.f}, {0.f, 0.f, 0.f, 0.f}}, am[2] = {{0.f, 0.f, 0.f, 0.f}, {0.f, 0.f, 0.f, 0.f}}, amk[2] = {{0.f, 0.f, 0.f, 0.f}, {0.f, 0.f, 0.f, 0.f}};
          wi_fma_s(ans, aB, bA); wi_fma(ant, aB, bA); wi_fma_s(aks, aK, bA); wi_fma(am, aB, bR); wi_fma(amk, aK, bR);
          WI_PIN();
          f32x4 axs[2];
#pragma unroll
          for (int n = 0; n < 2; ++n)
#pragma unroll
              for (int i = 0; i < 4; ++i) { const int rs = 16 * m + fr, cs = n0 + 16 * n + 4 * fq + i;
                  if (!(rs < cs)) { ans[n][i] = 0.f; aks[n][i] = 0.f; } axs[n][i] = ans[n][i] + (rs == cs ? 1.0f : 0.f);
                  const int rn = 16 * m + 4 * fq + i, cn = n0 + 16 * n + fr;
                  if (!(rn < cn)) ant[n][i] = 0.f; if (rn > cn) { am[n][i] = 0.f; amk[n][i] = 0.f; } }
          wi_st_nat_s(SLOT(7), ans, m, n0, fr, fq); wi_st_tr(SLOT(8), ant, m, n0, fr, fq); wi_st_nat_s(SLOT(6), aks, m, n0, fr, fq); wi_st_nat_s(SLOT(11), axs, m, n0, fr, fq);
          wi_st_tr(SLOT(13), am, m, n0, fr, fq); wi_st_tr(SLOT(14), amk, m, n0, fr, fq); }
        HBAR();
        { WiA aN; WiB bN; wi_lda(aN, SLOT(7), m, fr, fq); wi_ldb(bN, SLOT(8), n0, fr, fq); WI_PIN();
          f32x4 a2s[2] = {{0.f, 0.f, 0.f, 0.f}, {0.f, 0.f, 0.f, 0.f}}, a2t[2] = {{0.f, 0.f, 0.f, 0.f}, {0.f, 0.f, 0.f, 0.f}}; wi_fma_s(a2s, aN, bN); wi_fma(a2t, aN, bN); WI_PIN();
          wi_st_nat_s(SLOT(9), a2s, m, n0, fr, fq); wi_st_tr(SLOT(10), a2t, m, n0, fr, fq); }
        HBAR();
#define WI_LEVEL(XS, XD, NS, NST, ND, NDT) do { WiA aX, aN; WiB bN; f32x4 ax[2]; wi_lda(aX, SLOT(XS), m, fr, fq); wi_ldb(bN, SLOT(NST), n0, fr, fq); wi_lda(aN, SLOT(NS), m, fr, fq); wi_ld_nat_s(ax, SLOT(XS), m, n0, fr, fq); \
            WI_PIN(); f32x4 aqs[2] = {{0.f, 0.f, 0.f, 0.f}, {0.f, 0.f, 0.f, 0.f}}, aqt[2] = {{0.f, 0.f, 0.f, 0.f}, {0.f, 0.f, 0.f, 0.f}}; wi_fma_s(ax, aX, bN); wi_fma_s(aqs, aN, bN); wi_fma(aqt, aN, bN); WI_PIN(); \
            wi_st_nat_s(SLOT(XD), ax, m, n0, fr, fq); wi_st_nat_s(SLOT(ND), aqs, m, n0, fr, fq); wi_st_tr(SLOT(NDT), aqt, m, n0, fr, fq); \
            HBAR(); } while (0)
        WI_LEVEL(11, 0, 9, 10, 7, 8);
        WI_LEVEL(0, 11, 7, 8, 9, 10);
        WI_LEVEL(11, 0, 9, 10, 7, 8);
        WI_LEVEL(0, 11, 7, 8, 9, 10);
#undef WI_LEVEL
        { WiA aX; WiB bN; f32x4 ax[2]; wi_lda(aX, SLOT(11), m, fr, fq); wi_ldb(bN, SLOT(10), n0, fr, fq); wi_ld_nat(ax, SLOT(11), m, n0, fr, fq); WI_PIN();
          wi_fma(ax, aX, bN); WI_PIN(); wi_st_tr(SLOT(0), ax, m, n0, fr, fq); }
        HBAR();
        { WiA aNk, aAt; WiB bT; wi_lda(aNk, SLOT(6), m, fr, fq); wi_lda(aAt, SLOT(1), m, fr, fq); wi_ldb(bT, SLOT(0), n0, fr, fq); WI_PIN();
          f32x4 aw[2] = {{0.f, 0.f, 0.f, 0.f}, {0.f, 0.f, 0.f, 0.f}}, aa[2] = {{0.f, 0.f, 0.f, 0.f}, {0.f, 0.f, 0.f, 0.f}}; wi_fma_s(aw, aNk, bT); wi_fma_s(aa, aAt, bT); WI_PIN();
          wi_st_nat_s(SLOT(2), aw, m, n0, fr, fq); wi_st_nat_s(SLOT(7), aa, m, n0, fr, fq); }
        HBAR();
        { WiA aAT, aW1; WiB bB, bM; f32x4 ap[2] = {{0.f, 0.f, 0.f, 0.f}, {0.f, 0.f, 0.f, 0.f}}, az[2], ag[2], az2[2]; float gl[2];
          wi_lda(aAT, SLOT(7), m, fr, fq); wi_lda(aW1, SLOT(2), m, fr, fq); wi_ldb(bB, SLOT(3), n0, fr, fq); wi_ldb(bM, SLOT(13), n0, fr, fq);
          wi_ld_nat(az, SLOT(4), m, n0, fr, fq); wi_ld_tr(az2, SLOT(14), m, n0, fr, fq); wi_ld_tr(ag, SLOT(12), m, n0, fr, fq);
#pragma unroll
          for (int n = 0; n < 2; ++n) gl[n] = GL[n0 + 16 * n + fr];
          WI_PIN();
          wi_fma(ap, aAT, bB); wi_fma(az, aW1, bB); wi_fma(ag, aAT, bM); wi_fma(az2, aW1, bM);
          WI_PIN();
          wi_st_tr(SLOT(8), az, m, n0, fr, fq); wi_st_tr(SLOT(9), az2, m, n0, fr, fq);
          bf16* PTp = (bf16*)ST + (size_t)(h * NCH + ch) * 4096; bf16* GMp = gm_ptr(a.ws, h, ch);
#pragma unroll
          for (int n = 0; n < 2; ++n) { const int col = n0 + 16 * n + fr; f32x4 pv = ap[n];
#pragma unroll
              for (int i = 0; i < 4; ++i) { if (16 * m + 4 * fq + i == col) pv[i] += 1.0f; pv[i] *= gl[n]; }
              u32x2 w; w.x = pk2(pv[0], pv[1]); w.y = pk2(pv[2], pv[3]); *(u32x2*)(PTp + col * 64 + 16 * m + 4 * fq) = w;
              u32x2 w2; w2.x = pk2(ag[n][0], ag[n][1]); w2.y = pk2(ag[n][2], ag[n][3]); *(u32x2*)(GMp + col * 64 + 16 * m + 4 * fq) = w2; } }
        HBAR();
        { WiA aV; WiB bZ1, bZ2; float gl[2]; wi_lda(aV, SLOT(5), m, fr, fq); wi_ldb(bZ1, SLOT(8), n0, fr, fq); wi_ldb(bZ2, SLOT(9), n0, fr, fq); gl[0] = GL[n0 + fr]; gl[1] = GL[n0 + 16 + fr]; WI_PIN();
          f32x4 aq[2] = {{0.f, 0.f, 0.f, 0.f}, {0.f, 0.f, 0.f, 0.f}}, ay[2] = {{0.f, 0.f, 0.f, 0.f}, {0.f, 0.f, 0.f, 0.f}}; wi_fma(aq, aV, bZ1); wi_fma(ay, aV, bZ2); WI_PIN();
          float* QTp = ST + ST_Q_OFF + (size_t)(h * NCH + ch) * 4096; bf16* Y0p = (bf16*)(a.ws + WS_Y0) + (size_t)(h * NCH + ch) * 4096;
#pragma unroll
          for (int n = 0; n < 2; ++n) { const int col = n0 + 16 * n + fr; *(f32x4*)(QTp + col * 64 + 16 * m + 4 * fq) = aq[n] * gl[n];
              u32x2 w; w.x = pk2(ay[n][0], ay[n][1]); w.y = pk2(ay[n][2], ay[n][3]); *(u32x2*)(Y0p + col * 64 + 16 * m + 4 * fq) = w; } }
        HBAR();
    }
#undef SLOT
#undef WI_FETCH
}

__device__ __forceinline__ void phase_scan3m(ArgsR a, const Ctx& c, int l) {
    const f16* R = (const f16*)(a.ws + WS_R); const f16* KP = (const f16*)(a.ws + WS_KP); const f16* V = (const f16*)(a.ws + WS_V); const bf16* G = (const bf16*)(a.ws + WS_G);
    bf16* YA = (bf16*)(a.ws + WS_YA);
    LAS3 unsigned char* L = (LAS3 unsigned char*)c.lds;
    LAS3 float* YL = (LAS3 float*)(L + WI_B);
    const int lane = c.lane, wv = c.wave, fr = lane & 15, fq = lane >> 4, m = wv >> 1, n0 = 32 * (wv & 1), tid = c.tid;
    u32x4 pS; bf16x8 pB[2][2]; u32x2 pY[2];
#define S3_FETCH(it) do { const int h_ = (it) / NCH, ch_ = (it) % NCH; pS = (u32x4){0u, 0u, 0u, 0u}; if (ch_ > 0) pS = *(const u32x4*)((const bf16*)(a.ws + WS_ST) + (size_t)(h_ * NCH + ch_ - 1) * 4096 + tid * 8); \
        const bf16* G_ = gm_ptr(a.ws, h_, ch_); const bf16* Y_ = (const bf16*)(a.ws + WS_Y0) + (size_t)(h_ * NCH + ch_) * 4096; \
        _Pragma("unroll") for (int ks = 0; ks < 2; ++ks) _Pragma("unroll") for (int n = 0; n < 2; ++n) pB[ks][n] = *(const bf16x8*)(G_ + (n0 + 16 * n + fr) * 64 + 32 * ks + 8 * fq); \
        _Pragma("unroll") for (int n = 0; n < 2; ++n) pY[n] = *(const u32x2*)(Y_ + (n0 + 16 * n + fr) * 64 + 16 * m + 4 * fq); } while (0)
    if (blockIdx.x < NH * NCH) S3_FETCH(blockIdx.x);
    for (int item = blockIdx.x; item < NH * NCH; item += gridDim.x) {
        const int h = item / NCH, ch = item % NCH;
        *(LAS3 u32x4*)(L + ((tid >> 3) * WI_LD + (tid & 7) * 8) * 2) = pS;
        bf16x8 bfr[2][2]; f32x4 acc[2];
#pragma unroll
        for (int ks = 0; ks < 2; ++ks)
#pragma unroll
            for (int n = 0; n < 2; ++n) bfr[ks][n] = pB[ks][n];
#pragma unroll
        for (int n = 0; n < 2; ++n) { acc[n][0] = __uint_as_float(pY[n].x << 16); acc[n][1] = __uint_as_float(pY[n].x & 0xffff0000u); acc[n][2] = __uint_as_float(pY[n].y << 16); acc[n][3] = __uint_as_float(pY[n].y & 0xffff0000u); }
        if (item + (int)gridDim.x < NH * NCH) S3_FETCH(item + (int)gridDim.x);
        HBAR();
#pragma unroll
        for (int ks = 0; ks < 2; ++ks) { const bf16x8 av = *(const LAS3 bf16x8*)(L + ((16 * m + fr) * WI_LD + 32 * ks + 8 * fq) * 2);
#pragma unroll
            for (int n = 0; n < 2; ++n) acc[n] = __builtin_amdgcn_mfma_f32_16x16x32_bf16(av, bfr[ks][n], acc[n], 0, 0, 0); }
#pragma unroll
        for (int n = 0; n < 2; ++n)
#pragma unroll
            for (int i = 0; i < 4; ++i) YL[(n0 + 16 * n + fr) * 65 + 16 * m + 4 * fq + i] = acc[n][i];
        HBAR();
        { const float gn_g = a.in[I_GNG][l * W + h * 64 + lane], gn_b = a.in[I_GNB][l * W + h * 64 + lane], r_k = a.in[I_RK][l * W + h * 64 + lane];
          f16 rl8[8], kl8[8], vl8[8]; bf16 gl8[8];
#pragma unroll
          for (int i = 0; i < 8; ++i) { const size_t o = (size_t)(ch * CL + 8 * wv + i) * W + h * 64 + lane; rl8[i] = R[o]; kl8[i] = KP[o]; vl8[i] = V[o]; gl8[i] = G[o]; }
#pragma unroll
          for (int i = 0; i < 8; ++i) { const int t = 8 * wv + i; const size_t o = (size_t)(ch * CL + t) * W + h * 64 + lane;
              const float yy = YL[t * 65 + lane]; const float rl = (float)rl8[i], kl = (float)kl8[i], vl = (float)vl8[i], gl = bf2f(gl8[i]);
              const float mean = wave_sum(yy) * (1.f / 64.f); const float dd = yy - mean; const float var = wave_sum(dd * dd) * (1.f / 64.f);
              const float bonus = wave_sum(rl * kl * r_k);
              const float yn = dd * __builtin_amdgcn_rsqf(var + GN_EPS) * gn_g + gn_b + bonus * vl;
              YA[o] = f2bf(yn * gl); } }
        HBAR();
    }
}

__device__ __forceinline__ void phase_scan3(ArgsR a, const Ctx& c, int l) {
    const f16* R = (const f16*)(a.ws + WS_R); const f16* WM1 = (const f16*)(a.ws + WS_WM1); const f16* KP = (const f16*)(a.ws + WS_KP);
    const f16* AA = (const f16*)(a.ws + WS_AA); const f16* BB = (const f16*)(a.ws + WS_BB); const f16* V = (const f16*)(a.ws + WS_V);
    const float* ST = (const float*)(a.ws + WS_ST); bf16* YA = (bf16*)(a.ws + WS_YA); const f16* Gs = (const f16*)(a.ws + WS_G);
    const int lane = c.lane;
    LAS3 unsigned char* ring = (LAS3 unsigned char*)c.lds + c.wave * SC_WAVE;
    for (int item = c.gw; item < NH * NCH; item += c.ngw) {
        const int h = __builtin_amdgcn_readfirstlane(item / NCH), ch = __builtin_amdgcn_readfirstlane(item % NCH);
        const size_t lane_off = (size_t)(lane >> 3) * W + h * 64 + (lane & 7) * 8;
        const float gn_g = a.in[I_GNG][l * W + h * 64 + lane], gn_b = a.in[I_GNB][l * W + h * 64 + lane], r_k = a.in[I_RK][l * W + h * 64 + lane];
        { const size_t e0 = (size_t)(ch * CL) * W + lane_off;
          sc_dma(AA, e0, ring); sc_dma(WM1, e0, ring + 1024); sc_dma(BB, e0, ring + 2048); sc_dma(KP, e0, ring + 3072); sc_dma(V, e0, ring + 4096); sc_dma(R, e0, ring + 5120); sc_dma(Gs, e0, ring + 6144); }
        float S[64];
        if (ch == 0) {
#pragma unroll
            for (int j = 0; j < 64; ++j) S[j] = 0.f;
        } else { const bf16* Sp = (const bf16*)ST + ((size_t)(h * NCH + ch - 1) * 64 + lane) * 64;
#pragma unroll
            for (int j = 0; j < 64; j += 4) { const f32x4 x = load4bf(Sp + j); S[j] = x[0]; S[j + 1] = x[1]; S[j + 2] = x[2]; S[j + 3] = x[3]; } }
#pragma unroll 1
        for (int blk = 0; blk < CL / SCB; ++blk) {
            LAS3 unsigned char* buf = ring + (blk & 1) * SC_BUF;
            if (blk + 1 < CL / SCB) { LAS3 unsigned char* nb = ring + ((blk + 1) & 1) * SC_BUF; const size_t e0 = (size_t)(ch * CL + (blk + 1) * SCB) * W + lane_off;
                sc_dma(AA, e0, nb); sc_dma(WM1, e0, nb + 1024); sc_dma(BB, e0, nb + 2048); sc_dma(KP, e0, nb + 3072); sc_dma(V, e0, nb + 4096); sc_dma(R, e0, nb + 5120); sc_dma(Gs, e0, nb + 6144);
                asm volatile("s_waitcnt vmcnt(7)" ::: "memory"); }
            else asm volatile("s_waitcnt vmcnt(0)" ::: "memory");
            SVec A, Wv, Bv, Kv, Rv;
            sv_cvt(A, sv_read(buf, lane)); sv_cvt1p(Wv, sv_read(buf + 1024, lane)); sv_cvt(Bv, sv_read(buf + 2048, lane)); sv_cvt(Kv, sv_read(buf + 3072, lane)); sv_cvt(Rv, sv_read(buf + 5120, lane));
            float vv = (float)*(const LAS3 f16*)(buf + 4096 + lane * 2);
#pragma unroll 1
            for (int st = 0; st < SCB; ++st) {
                const LAS3 unsigned char* sn = buf + ((st + 1 < SCB) ? st + 1 : st) * 128;
                const f16x4 ha = sv_read(sn, lane), hw = sv_read(sn + 1024, lane), hb = sv_read(sn + 2048, lane), hk = sv_read(sn + 3072, lane), hr = sv_read(sn + 5120, lane);
                const f16 hv = *(const LAS3 f16*)(sn + 4096 + lane * 2);
                float d[4] = {0.f, 0.f, 0.f, 0.f};
                sc_dot<0>(d, A, S);
                const float sa = (d[0] + d[1]) + (d[2] + d[3]);
                float y[4] = {0.f, 0.f, 0.f, 0.f};
                sc_upd3<0>(S, y, Wv, Bv, Kv, Rv, sa, vv);
                const float yy = (y[0] + y[1]) + (y[2] + y[3]);
                sv_cvt(A, ha); sv_cvt1p(Wv, hw); sv_cvt(Bv, hb); sv_cvt(Kv, hk); sv_cvt(Rv, hr); vv = (float)hv;
                { const LAS3 unsigned char* sb = buf + st * 128;
                  const float rl = (float)*(const LAS3 f16*)(sb + 5120 + lane * 2), kl = (float)*(const LAS3 f16*)(sb + 3072 + lane * 2), vl = (float)*(const LAS3 f16*)(sb + 4096 + lane * 2);
                  const float gl = bf2f(*(const LAS3 bf16*)(sb + 6144 + lane * 2));
                  const float mean = wave_sum(yy) * (1.f / 64.f); const float dd = yy - mean; const float var = wave_sum(dd * dd) * (1.f / 64.f);
                  const float bonus = wave_sum(rl * kl * r_k);
                  const float yn = dd * __builtin_amdgcn_rsqf(var + GN_EPS) * gn_g + gn_b + bonus * vl;
                  YA[(size_t)(ch * CL + blk * SCB + st) * W + h * 64 + lane] = f2bf(yn * gl); }
            }
        }
    }
}
#undef S3_FETCH

__device__ __forceinline__ void phase_post(ArgsR a, const Ctx& c, int l) {
    const bf16* YSC = (const bf16*)(a.ws + WS_YSC); const f16* R = (const f16*)(a.ws + WS_R); const f16* KP = (const f16*)(a.ws + WS_KP); const f16* V = (const f16*)(a.ws + WS_V);
    const bf16* G = (const bf16*)(a.ws + WS_G); bf16* YA = (bf16*)(a.ws + WS_YA);
    const float* gng = a.in[I_GNG] + l * W; const float* gnb = a.in[I_GNB] + l * W; const float* rk = a.in[I_RK] + l * W;
    for (int t = c.gw; t < T; t += c.ngw) {
#pragma unroll
        for (int i = 0; i < 8; ++i) { const int n = c.lane + 64 * i; const size_t o = (size_t)t * W + n;
            const float y = bf2f(YSC[o]); const float mean = wave_sum(y) * (1.f / 64.f); const float d = y - mean; const float var = wave_sum(d * d) * (1.f / 64.f);
            float yn = d * __builtin_amdgcn_rsqf(var + GN_EPS) * gng[n] + gnb[n];
            const float r = (float)R[o], k = (float)KP[o], v = (float)V[o];
            const float bonus = wave_sum(r * k * rk[n]);
            yn += bonus * v;
            YA[o] = f2bf(yn * bf2f(G[o])); }
    }
}

__device__ __forceinline__ void phase_ln1(ArgsR a, const Ctx& c, int l, float* outw, int mode = 3) {
    const float* MODF = (const float*)(a.ws + WS_MODF) + l * 6144;
    const float* g1 = a.in[I_LN1G] + l * D; const float* b1 = a.in[I_LN1B] + l * D;
    bf16* XN = (bf16*)(a.ws + WS_XN);
    int* TOKI = (int*)(a.ws + WS_TOKI); float* TOKW = (float*)(a.ws + WS_TOKW); int* TOKP = (int*)(a.ws + WS_TOKP);
    const float* rw = a.in[I_RW]; const float* rb = a.in[I_RB];
    LAS3 float* rwT = (LAS3 float*)((LAS3 unsigned char*)c.lds + 69632);
    unsigned* lcnt = (unsigned*)(c.lds + 135168);
    if (mode & 1) {
    for (int i = c.tid; i < D * NE; i += NTHREADS) rwT[(i & 15) * D + (i >> 4)] = rw[i];
    if (c.tid < NE) lcnt[c.tid] = 0u;
    __syncthreads();
    float vn[16]; if (c.gw < T) load_row16(a.out + (size_t)c.gw * D, c.lane, vn);
    for (int m = c.gw; m < T; m += c.ngw) {
        int l4 = 4 * c.lane; asm volatile("" : "+v"(l4));
        float v[16];
#pragma unroll
        for (int j = 0; j < 16; ++j) v[j] = vn[j];
        if (m + c.ngw < T) load_row16(a.out + (size_t)(m + c.ngw) * D, c.lane, vn);
        float mean, rstd; row_stats(v, mean, rstd);
#pragma unroll
        for (int j = 0; j < 4; ++j) { f32x4 o; const int col = l4 + 256 * j;
#pragma unroll
            for (int e = 0; e < 4; ++e) { v[4 * j + e] = (v[4 * j + e] - mean) * rstd * g1[col + e] + b1[col + e]; o[e] = v[4 * j + e]; }
            *(f32x4*)(outw + (size_t)m * D + col) = o; }
        row_stats(v, mean, rstd);
#pragma unroll
        for (int j = 0; j < 4; ++j) { f32x4 o; const int col = l4 + 256 * j;
#pragma unroll
            for (int e = 0; e < 4; ++e) { v[4 * j + e] = (v[4 * j + e] - mean) * rstd * (1.0f + MODF[4096 + col + e]) + MODF[3072 + col + e]; o[e] = v[4 * j + e]; }
            store4bf(XN + (size_t)m * D + col, o); }
        float lg[16];
#pragma unroll
        for (int e = 0; e < 16; ++e) { float x = 0.f;
#pragma unroll
            for (int j = 0; j < 4; ++j) { const f32x4 r4 = *(const LAS3 f32x4*)(rwT + e * D + l4 + 256 * j); x += (v[4 * j] * r4[0] + v[4 * j + 1] * r4[1]) + (v[4 * j + 2] * r4[2] + v[4 * j + 3] * r4[3]); }
            lg[e] = x;
            if ((e & 3) == 3) __builtin_amdgcn_sched_barrier(0); }
        float r8[8], r4v[4], r2[2], r1;
        { const bool b5 = (c.lane & 32) != 0, b4 = (c.lane & 16) != 0, b3 = (c.lane & 8) != 0, b2 = (c.lane & 4) != 0;
#pragma unroll
          for (int i = 0; i < 8; ++i) { const float snd = b5 ? lg[i] : lg[i + 8], kp = b5 ? lg[i + 8] : lg[i]; r8[i] = kp + __shfl_xor(snd, 32); }
#pragma unroll
          for (int i = 0; i < 4; ++i) { const float snd = b4 ? r8[i] : r8[i + 4], kp = b4 ? r8[i + 4] : r8[i]; r4v[i] = kp + __shfl_xor(snd, 16); }
#pragma unroll
          for (int i = 0; i < 2; ++i) { const float snd = b3 ? r4v[i] : r4v[i + 2], kp = b3 ? r4v[i + 2] : r4v[i]; r2[i] = kp + __shfl_xor(snd, 8); }
          { const float snd = b2 ? r2[0] : r2[1], kp = b2 ? r2[1] : r2[0]; r1 = kp + __shfl_xor(snd, 4); }
          r1 += __shfl_xor(r1, 2); r1 += __shfl_xor(r1, 1); }
        float sc[16], sel[16];
#pragma unroll
        for (int e = 0; e < 16; ++e) { const float lgt = __shfl(r1, 4 * e); sc[e] = __builtin_amdgcn_rcpf(1.0f + __expf(-lgt)); sel[e] = sc[e] + rb[e]; }
        int best = 0; float bestv = -INFINITY;
#pragma unroll
        for (int g = 0; g < 4; ++g) { float m1 = -INFINITY, m2 = -INFINITY;
#pragma unroll
            for (int q = 0; q < 4; ++q) { const float sv = sel[4 * g + q]; if (sv > m1) { m2 = m1; m1 = sv; } else if (sv > m2) m2 = sv; }
            const float gs = m1 + m2; if (gs > bestv) { bestv = gs; best = g; } }
        int i1 = 0, i2 = 0; float s1 = -INFINITY, s2 = -INFINITY, w1 = 0.f, w2 = 0.f;
#pragma unroll
        for (int e = 0; e < 16; ++e) { if ((e >> 2) == best) { const float sv = sel[e];
                if (sv > s1) { s2 = s1; i2 = i1; w2 = w1; s1 = sv; i1 = e; w1 = sc[e]; } else if (sv > s2) { s2 = sv; i2 = e; w2 = sc[e]; } } }
        if (c.lane == 0) { const float ws = w1 + w2;
            TOKI[2 * m] = i1; TOKI[2 * m + 1] = i2; TOKW[2 * m] = w1 / ws; TOKW[2 * m + 1] = w2 / ws;
            TOKP[2 * m] = (int)atomicAdd(&lcnt[i1], 1u); TOKP[2 * m + 1] = (int)atomicAdd(&lcnt[i2], 1u); }
    }
    __syncthreads();
    if (c.tid < NE) ((int*)(a.ws + WS_BLKCNT))[blockIdx.x * NE + c.tid] = (int)lcnt[c.tid];
    __syncthreads();
    }
}

__device__ __forceinline__ void expert_convert(ArgsR a, const Ctx& c, int l, int b0) {
    if ((int)blockIdx.x < b0) return;
    float* scr = (float*)(c.lds + c.wave * 8704);
    bf16* WGU = (bf16*)(a.ws + WS_WGU); bf16* WD = (bf16*)(a.ws + WS_WD);
    constexpr int IG = (D / 64) * (FF / 32);
    constexpr int ID = (FF / 64) * (D / 32);
    const int gw0 = ((int)blockIdx.x - b0) * NWAVES + c.wave, ngw0 = ((int)gridDim.x - b0) * NWAVES;
    for (int it = gw0; it < NE * (2 * IG + ID); it += ngw0) {
        const int e = it / (2 * IG + ID); int r = it % (2 * IG + ID);
        const size_t eo = ((size_t)l * NE + e) * (size_t)D * FF;
        if (r < IG) { transpose_matrix_item(a.in[I_EG] + eo, D, FF, WGU + (size_t)e * 1024 * 1024, r, scr, c.lane, RowGU{0}); continue; } r -= IG;
        if (r < IG) { transpose_matrix_item(a.in[I_EU] + eo, D, FF, WGU + (size_t)e * 1024 * 1024, r, scr, c.lane, RowGU{1}); continue; } r -= IG;
        transpose_matrix_item(a.in[I_ED] + eo, FF, D, WD + (size_t)e * 1024 * 512, r, scr, c.lane, RowId());
    }
}

__device__ __forceinline__ void phase_perm(ArgsR a, const Ctx& c, int l) {
    const int* BLKCNT = (const int*)(a.ws + WS_BLKCNT);
    LAS3 int* pre = (LAS3 int*)c.lds;
    LAS3 int* tot = pre + 256 * NE;
    const int nb = gridDim.x;
#pragma unroll
    for (int q = 0; q < 2; ++q) { const int e = 2 * c.wave + q; int v[4]; int sum = 0;
#pragma unroll
        for (int i = 0; i < 4; ++i) { const int b = 4 * c.lane + i; v[i] = b < nb ? BLKCNT[b * NE + e] : 0; sum += v[i]; }
        int inc = sum;
#pragma unroll
        for (int o = 1; o < 64; o <<= 1) { const int t = __shfl_up(inc, o); if (c.lane >= o) inc += t; }
        int run = inc - sum;
#pragma unroll
        for (int i = 0; i < 4; ++i) { pre[(4 * c.lane + i) * NE + e] = run; run += v[i]; }
        if (c.lane == 63) tot[e] = inc; }
    __syncthreads();
    int ts[17]; { int sacc = 0;
#pragma unroll
        for (int e = 0; e < 16; ++e) { ts[e] = sacc; sacc += (tot[e] + 255) >> 8; } ts[16] = sacc; }
    if (blockIdx.x == 0 && c.tid < NE) ((int*)(a.ws + WS_TOT))[c.tid] = tot[c.tid];
    const int* TOKI = (const int*)(a.ws + WS_TOKI); const int* TOKP = (const int*)(a.ws + WS_TOKP); int* S2T = (int*)(a.ws + WS_S2T); const float* TOKW = (const float*)(a.ws + WS_TOKW);
    const bf16* XN = (const bf16*)(a.ws + WS_XN); bf16* XS = (bf16*)(a.ws + WS_XS);
    for (int as = blockIdx.x * NTHREADS + c.tid; as < 2 * T; as += gridDim.x * NTHREADS) {
        const int e = TOKI[as]; int base = 0;
#pragma unroll
        for (int j = 0; j < 16; ++j) base = (j == e) ? ts[j] : base;
        const int m = as >> 1, blk = (m % c.ngw) >> 3;
        const u32x2 sw = {(unsigned)as, __float_as_uint(TOKW[as])};
        *(u32x2*)(S2T + 2 * (base * 256 + pre[blk * NE + e] + TOKP[as])) = sw;
    }
    for (int e = 0; e < 16; ++e) {
        int tse = 0, tsn = 0;
#pragma unroll
        for (int j = 0; j < 16; ++j) { tse = (j == e) ? ts[j] : tse; tsn = (j == e) ? ts[j + 1] : tsn; }
        const int lo = tse * 256 + tot[e], hi = tsn * 256;
        for (int sl = lo + blockIdx.x * NTHREADS + c.tid; sl < hi; sl += gridDim.x * NTHREADS) S2T[2 * sl] = -1;
    }
    __syncthreads();
}

__device__ __forceinline__ void phase_ln2(ArgsR a, const Ctx& c, int l, float* outw) {
    const float* MODF = (const float*)(a.ws + WS_MODF) + l * 6144;
    const float* g2 = a.in[I_LN2G] + l * D; const float* b2 = a.in[I_LN2B] + l * D;
    const bf16* Y = (const bf16*)(a.ws + WS_Y); bf16* XN = (bf16*)(a.ws + WS_XN);
    float vn[16]; u32x2 y0n[4], y1n[4];
    if (c.gw < T) { load_row16(a.out + (size_t)c.gw * D, c.lane, vn);
#pragma unroll
        for (int j = 0; j < 4; ++j) { y0n[j] = *(const u32x2*)(Y + (size_t)(2 * c.gw) * D + 4 * c.lane + 256 * j); y1n[j] = *(const u32x2*)(Y + (size_t)(2 * c.gw + 1) * D + 4 * c.lane + 256 * j); } }
    for (int m = c.gw; m < T; m += c.ngw) {
        float v[16]; u32x2 y0[4], y1[4];
#pragma unroll
        for (int j = 0; j < 16; ++j) v[j] = vn[j];
#pragma unroll
        for (int j = 0; j < 4; ++j) { y0[j] = y0n[j]; y1[j] = y1n[j]; }
        if (m + c.ngw < T) { const int mn = m + c.ngw; load_row16(a.out + (size_t)mn * D, c.lane, vn);
#pragma unroll
            for (int j = 0; j < 4; ++j) { y0n[j] = *(const u32x2*)(Y + (size_t)(2 * mn) * D + 4 * c.lane + 256 * j); y1n[j] = *(const u32x2*)(Y + (size_t)(2 * mn + 1) * D + 4 * c.lane + 256 * j); } }
#pragma unroll
        for (int j = 0; j < 4; ++j) { const int col = 4 * c.lane + 256 * j;
            const float a0 = __uint_as_float(y0[j].x << 16) + __uint_as_float(y1[j].x << 16), a1 = __uint_as_float(y0[j].x & 0xffff0000u) + __uint_as_float(y1[j].x & 0xffff0000u);
            const float a2 = __uint_as_float(y0[j].y << 16) + __uint_as_float(y1[j].y << 16), a3 = __uint_as_float(y0[j].y & 0xffff0000u) + __uint_as_float(y1[j].y & 0xffff0000u);
            const f32x4 gt = *(const f32x4*)(MODF + 5120 + col);
            v[4 * j] = ALPHA * v[4 * j] + (1.0f + gt[0]) * a0; v[4 * j + 1] = ALPHA * v[4 * j + 1] + (1.0f + gt[1]) * a1; v[4 * j + 2] = ALPHA * v[4 * j + 2] + (1.0f + gt[2]) * a2; v[4 * j + 3] = ALPHA * v[4 * j + 3] + (1.0f + gt[3]) * a3; }
        float mean, rstd; row_stats(v, mean, rstd);
#pragma unroll
        for (int j = 0; j < 4; ++j) { f32x4 o; const int col = 4 * c.lane + 256 * j;
#pragma unroll
            for (int e = 0; e < 4; ++e) { v[4 * j + e] = (v[4 * j + e] - mean) * rstd * g2[col + e] + b2[col + e]; o[e] = v[4 * j + e]; }
            *(f32x4*)(outw + (size_t)m * D + col) = o; }
        if (l + 1 < DEPTH) {
            const float* MN = MODF + 6144;
            row_stats(v, mean, rstd);
#pragma unroll
            for (int j = 0; j < 4; ++j) { f32x4 o; const int col = 4 * c.lane + 256 * j;
#pragma unroll
                for (int e = 0; e < 4; ++e) o[e] = (v[4 * j + e] - mean) * rstd * (1.0f + MN[1024 + col + e]) + MN[col + e];
                store4bf(XN + (size_t)m * D + col, o); }
        }
    }
}


template <class F> struct EpiAdapt {
    static constexpr bool PERM = true, AFTER_DRAIN = false; F f;
    __device__ __forceinline__ void operator()(const f32x4 (&acc)[2][2][4][2], const Unit& u, int wr, int wc, int fr, int fq) const {
        const int col = u.pn * 256 + wc * 32 + 8 * fq;
#pragma unroll
        for (int ai = 0; ai < 2; ++ai)
#pragma unroll
            for (int m = 0; m < 4; ++m) { const int row = u.pm * 256 + ai * 128 + wr * 64 + m * 16 + fr; f(row, col, acc[ai][0][m][0], acc[ai][0][m][1], acc[ai][1][m][0], acc[ai][1][m][1]); }
    }
};

template <class Sched, class F>
__device__ __forceinline__ void gemm_gather(const Ctx& c, const bf16* A, const int* s2t, const bf16* Bt, int M, int N, int K, const Sched& S, const F& f) {
    pg8::Gemm g{A, Bt, M, N, K}; EpiAdapt<F> E{f};
    pg8::gemm_phase<EpiAdapt<F>, Sched, true, true, true>((PG8_LAS unsigned char*)c.lds, g, S, E, c.tid, s2t);
}
template <class Sched, class F>
__device__ __forceinline__ void gemm_any(const Ctx& c, const bf16* A, const bf16* Bt, int M, int N, int K, const Sched& S, const F& f) {
    pg8::Gemm g{A, Bt, M, N, K}; EpiAdapt<F> E{f};
    pg8::gemm_phase<EpiAdapt<F>, Sched, true, true>((PG8_LAS unsigned char*)c.lds, g, S, E, c.tid);
}

#define LAS __attribute__((address_space(3)))
#define XB_TMO      128
#define XB_XCNT(j)  (256  + 64 * (j))
#define XB_XSUB(j)  (1280 + 64 * (j))
#define XB_XGEN(j)  (2304 + 64 * (j))
#define XB_TOP      3328
#define XB_TOPGEN   3392
#define XCD_BAR_WORDS 3456
#define XB_SPIN_CAP (1u << 24)

__device__ __forceinline__ unsigned xb_ld(unsigned* p)              { return __hip_atomic_load(p, __ATOMIC_RELAXED, __HIP_MEMORY_SCOPE_AGENT); }
__device__ __forceinline__ unsigned xb_add(unsigned* p, unsigned v) { return __hip_atomic_fetch_add(p, v, __ATOMIC_RELAXED, __HIP_MEMORY_SCOPE_AGENT); }
__device__ __forceinline__ unsigned xb_xcc_id() { return (unsigned)__builtin_amdgcn_s_getreg((3 << 11) | 20) & 0xFu; }
#define XB_SPIN(cond, bar) do { unsigned _sp = 0; while (cond) { __builtin_amdgcn_s_sleep(1); \
    if ((++_sp & 255u) == 0u) { if (xb_ld(&(bar)[XB_TMO])) break; if (_sp > XB_SPIN_CAP) { atomicAdd(&(bar)[XB_TMO], 1u); break; } } } } while (0)

struct XcdBarrier {
    unsigned* bar; unsigned x;
    volatile LAS unsigned* st;
};

__device__ __forceinline__ XcdBarrier xcd_barrier_post(unsigned* bar, volatile LAS unsigned* st) {
    XcdBarrier b; b.bar = bar; b.x = xb_xcc_id(); b.st = st;
    if (threadIdx.x == 0) (void)xb_add(&bar[XB_XCNT(b.x)], 1u);
    return b;
}
__device__ __forceinline__ void xcd_barrier_complete(unsigned* bar, unsigned x, unsigned& nloc, unsigned& nx) {
    const unsigned G = gridDim.x * gridDim.y * gridDim.z;
    unsigned sum, cnt, mine, sp = 0u;
    for (;;) {
        sum = 0u; cnt = 0u; mine = 0u;
#pragma unroll
        for (unsigned j = 0; j < 16; ++j) { const unsigned c = xb_ld(&bar[XB_XCNT(j)]); sum += c; cnt += (c > 0u) ? 1u : 0u; mine = (j == x) ? c : mine; }
        if (sum == G) break;
        __builtin_amdgcn_s_sleep(1);
        if ((++sp & 255u) == 0u) { if (xb_ld(&bar[XB_TMO])) break; if (sp > XB_SPIN_CAP) { atomicAdd(&bar[XB_TMO], 1u); break; } }
    }
    nloc = mine > 0u ? mine : 1u; nx = cnt > 0u ? cnt : 1u;
}

__device__ __forceinline__ void xcd_barrier(const XcdBarrier& b) {
    asm volatile("s_waitcnt vmcnt(0)" ::: "memory");
    __syncthreads();
    if (threadIdx.x == 0) {
        unsigned* bar = b.bar;
        __builtin_amdgcn_s_waitcnt(0);
        unsigned nloc = b.st[0], nx = b.st[1];
        if (nloc == 0u) { xcd_barrier_complete(bar, b.x, nloc, nx); b.st[0] = nloc; b.st[1] = nx; }
        const unsigned old = xb_add(&bar[XB_XSUB(b.x)], 1u);
        const unsigned gen = old / nloc;
        if (old + 1u == (gen + 1u) * nloc) {
            __builtin_amdgcn_fence(__ATOMIC_RELEASE, "agent");
            asm volatile("s_waitcnt vmcnt(0)" ::: "memory");
            const unsigned og = xb_add(&bar[XB_TOP], 1u);
            const unsigned tg = og / nx;
            if (og + 1u == (tg + 1u) * nx) xb_add(&bar[XB_TOPGEN], 1u);
            else XB_SPIN(xb_ld(&bar[XB_TOPGEN]) == tg, bar);
            __builtin_amdgcn_fence(__ATOMIC_ACQUIRE, "agent");
            xb_add(&bar[XB_XGEN(b.x)], 1u);
            asm volatile("s_waitcnt vmcnt(0)" ::: "memory");
        } else {
            XB_SPIN(xb_ld(&bar[XB_XGEN(b.x)]) == gen, bar);
            __builtin_amdgcn_fence(__ATOMIC_ACQUIRE, "agent");
            asm volatile("s_waitcnt vmcnt(0)" ::: "memory");
        }
    }
    __syncthreads();
}


constexpr int PH_PER_LAYER = 12, N_PHASES = 2 + PH_PER_LAYER * DEPTH;
constexpr int CW_BAR = 4096;
constexpr int LDS_BYTES = 147456, LDSCTL_OFF = 131072 + 8192;
#ifndef SINGLE_LAUNCH
#define SINGLE_LAUNCH 1
#endif

#ifndef PROBE_A
#define PROBE_A -1
#endif
#ifndef PROBE_B
#define PROBE_B -1
#endif
constexpr size_t WS_TS = 512 * 1024;
#if PROBE_A >= 0
#define STAMP(i) do { if (blockIdx.x == 0 && threadIdx.x == 0) ((unsigned long long*)(args_here()->ws + WS_TS))[(i)] = __builtin_amdgcn_s_memrealtime(); } while (0)
#else
#define STAMP(i) do { } while (0)
#endif
__device__ __forceinline__ const __attribute__((address_space(4))) Args* args_here() { const __attribute__((address_space(4))) Args* p = (const __attribute__((address_space(4))) Args*)__builtin_amdgcn_kernarg_segment_ptr(); asm volatile("" : "+s"(p)); return p; }
#ifndef REP_K
#define REP_K -1
#endif
__device__ __forceinline__ Ctx mkctx(int wave_s, unsigned char* lds) { Ctx c; c.wave = wave_s; c.lane = (int)__builtin_amdgcn_mbcnt_hi(~0u, __builtin_amdgcn_mbcnt_lo(~0u, 0u)); c.tid = wave_s * 64 + c.lane;
    c.gw = blockIdx.x * NWAVES + wave_s; c.ngw = gridDim.x * NWAVES; c.lds = lds; return c; }
#define PHASE1(k, ...) do { const __attribute__((address_space(4))) Args* ap_ = args_here(); if (ap_->ph_lo <= (k) && (k) < ap_->ph_hi) { ArgsR a = *ap_; const Ctx c = mkctx(wave_s, lds); __VA_ARGS__ } } while (0)
#define PHASE(k, ...) do { PHASE1(k, __VA_ARGS__); if ((k) == REP_K) { xcd_barrier(bar); PHASE1(k, __VA_ARGS__); xcd_barrier(bar); PHASE1(k, __VA_ARGS__); } } while (0)

template <int L>
__device__ __forceinline__ void run_layer(const int wave_s, unsigned char* lds, const XcdBarrier& bar) {
    const int G = gridDim.x, b = blockIdx.x;
#define BAR() do { xcd_barrier(bar); STAMP(3 + 14 * L + (bk_++)); } while (0)
    int bk_ = 0;
    PHASE(0, unsigned char* ws = a.ws; pg8::StaticOrder S; S.init(T, INC, G, b); EpiZ E{(bf16*)(ws + WS_ZR), (bf16*)(ws + WS_ZS), (bf16*)(ws + WS_ZG)};
        gemm_any(c, (const bf16*)(ws + WS_XN), (const bf16*)(ws + WS_WIN + (size_t)L * 10 * MiB), T, INC, D, S, E); );
    BAR();
    PHASE(1, phase_prep_fast(a, c, L); );
    PHASE(14, phase_sg_fast(a, c, L); );
    BAR();
#if REP_K == 21
    PHASE1(2, phase_scan1m(a, c, 1); ); xcd_barrier(bar); PHASE1(2, phase_scan1m(a, c, 1); ); xcd_barrier(bar);
#endif
    PHASE(2, phase_scan1m(a, c); );
    BAR();
    PHASE(3, phase_scan2a(a, c); );
    BAR();
    PHASE(31, phase_scan2b(a, c); );
    PHASE(33, expert_convert(a, c, L, NH); );
    BAR();
    PHASE(32, phase_scan2c(a, c); );
    BAR();
    PHASE(4, phase_scan3m(a, c, L); );
    BAR();
    PHASE(6, unsigned char* ws = a.ws; pg8::StaticOrder S; S.init(T, D, G, b); EpiGA E{(const bf16*)(ws + WS_ZG), (bf16*)(ws + WS_MP)};
        gemm_any(c, (const bf16*)(ws + WS_YA), (const bf16*)(ws + WS_WA + (size_t)L * WS_WL1), T, D, W, S, E); );
    BAR();
#if REP_K == 7
    PHASE1(7, unsigned char* ws = a.ws; pg8::StaticOrder S; S.init(T, D, G, b); EpiGB E{(const bf16*)(ws + WS_ZG), (const bf16*)(ws + WS_MP), (bf16*)(ws + WS_ZR)};
        gemm_any(c, (const bf16*)(ws + WS_YB), (const bf16*)(ws + WS_WB + (size_t)L * WS_WL1), T, D, W, S, E); ); xcd_barrier(bar);
    PHASE1(7, unsigned char* ws = a.ws; pg8::StaticOrder S; S.init(T, D, G, b); EpiGB E{(const bf16*)(ws + WS_ZG), (const bf16*)(ws + WS_MP), (bf16*)(ws + WS_ZR)};
        gemm_any(c, (const bf16*)(ws + WS_YB), (const bf16*)(ws + WS_WB + (size_t)L * WS_WL1), T, D, W, S, E); ); xcd_barrier(bar);
#endif
#if REP_K == 8
    PHASE1(8, unsigned char* ws = a.ws; pg8::StaticOrder S; S.init(T, D, G, b); EpiOut E{L == 0 ? a.in[I_X] : a.out, (float*)(ws + WS_R), (const float*)(ws + WS_MODF) + L * 6144 + 2048};
        gemm_any(c, (const bf16*)(ws + WS_MP), (const bf16*)(ws + WS_WO + (size_t)L * WS_WL1), T, D, D, S, E); ); xcd_barrier(bar);
    PHASE1(8, unsigned char* ws = a.ws; pg8::StaticOrder S; S.init(T, D, G, b); EpiOut E{L == 0 ? a.in[I_X] : a.out, (float*)(ws + WS_R), (const float*)(ws + WS_MODF) + L * 6144 + 2048};
        gemm_any(c, (const bf16*)(ws + WS_MP), (const bf16*)(ws + WS_WO + (size_t)L * WS_WL1), T, D, D, S, E); ); xcd_barrier(bar);
#endif
    PHASE1(7, unsigned char* ws = a.ws; pg8::StaticOrder S; S.init(T, D, G, b); EpiGB E{(const bf16*)(ws + WS_ZG), (const bf16*)(ws + WS_MP), (bf16*)(ws + WS_MP)};
        gemm_any(c, (const bf16*)(ws + WS_YB), (const bf16*)(ws + WS_WB + (size_t)L * WS_WL1), T, D, W, S, E); );
    BAR();
    PHASE1(8, unsigned char* ws = a.ws; pg8::StaticOrder S; S.init(T, D, G, b); EpiOut E{L == 0 ? a.in[I_X] : a.out, a.out, (const float*)(ws + WS_MODF) + L * 6144 + 2048};
        gemm_any(c, (const bf16*)(ws + WS_MP), (const bf16*)(ws + WS_WO + (size_t)L * WS_WL1), T, D, D, S, E); );
    BAR();
#if REP_K == 9
    PHASE1(9, phase_ln1(a, c, L, (float*)(a.ws + WS_ZR)); ); xcd_barrier(bar); PHASE1(9, phase_ln1(a, c, L, (float*)(a.ws + WS_ZR)); ); xcd_barrier(bar);
#endif
#if REP_K == 91
    PHASE1(9, phase_ln1(a, c, L, (float*)(a.ws + WS_ZR), 1); ); xcd_barrier(bar); PHASE1(9, phase_ln1(a, c, L, (float*)(a.ws + WS_ZR), 1); ); xcd_barrier(bar);
#endif
#if REP_K == 92
    PHASE1(9, phase_ln1(a, c, L, (float*)(a.ws + WS_ZR), 2); ); xcd_barrier(bar); PHASE1(9, phase_ln1(a, c, L, (float*)(a.ws + WS_ZR), 2); ); xcd_barrier(bar);
#endif
    PHASE1(9, phase_ln1(a, c, L, a.out); );
    BAR();
    PHASE(10, phase_perm(a, c, L); );
    BAR();
    PHASE(11, unsigned char* ws = a.ws; MoeSched S; S.init((const unsigned*)(ws + WS_TOT), G, b); EpiSwi E{(bf16*)(ws + WS_HID)};
        gemm_gather(c, (const bf16*)(ws + WS_XN), (const int*)(ws + WS_S2T), (const bf16*)(ws + WS_WGU), MAXSLOT, NE * 1024, D, S, E); );
    BAR();
    PHASE(12, unsigned char* ws = a.ws; MoeSched S; S.init((const unsigned*)(ws + WS_TOT), G, b); EpiDown E{(const int*)(ws + WS_S2T), (const float*)(ws + WS_TOKW), (bf16*)(ws + WS_Y)};
        gemm_any(c, (const bf16*)(ws + WS_HID), (const bf16*)(ws + WS_WD), MAXSLOT, NE * 1024, FF, S, E); );
    BAR();
#if REP_K == 13
    PHASE1(13, phase_ln2(a, c, L, (float*)(a.ws + WS_R)); ); xcd_barrier(bar); PHASE1(13, phase_ln2(a, c, L, (float*)(a.ws + WS_R)); ); xcd_barrier(bar);
#endif
    PHASE1(13, phase_ln2(a, c, L, a.out); );
    if (L + 1 < DEPTH) BAR();
    (void)bk_;
#undef BAR
}

__global__ void __launch_bounds__(NTHREADS, 2) mk_fwd(Args a_unused) {
    extern __shared__ __attribute__((aligned(16))) unsigned char lds[];
    const int wave_s = __builtin_amdgcn_readfirstlane(threadIdx.x >> 6);
    for (int u = threadIdx.x; u < (LDS_BYTES - LDSCTL_OFF) / 4; u += NTHREADS) ((LAS unsigned*)((LAS unsigned char*)lds + LDSCTL_OFF))[u] = 0u;
    __syncthreads();
    const XcdBarrier bar = xcd_barrier_post((unsigned*)(args_here()->ws + WS_CTL) + CW_BAR, (volatile LAS unsigned*)((LAS unsigned char*)lds + LDSCTL_OFF) + 8);
    STAMP(0);
    PHASE(100, phase_p0a(a, c); );
    xcd_barrier(bar); STAMP(1);
    PHASE(101, phase_p0b(a, c); );
    xcd_barrier(bar); STAMP(2);
    run_layer<0>(wave_s, lds, bar);
    run_layer<1>(wave_s, lds, bar);
#if PROBE_A >= 0
    if (blockIdx.x == 0) {
        asm volatile("s_waitcnt vmcnt(0)" ::: "memory"); __syncthreads();
        if (threadIdx.x == 0) ((unsigned long long*)(args_here()->ws + WS_TS))[30] = __builtin_amdgcn_s_memrealtime();
        asm volatile("s_waitcnt vmcnt(0)" ::: "memory"); __syncthreads();
        const volatile unsigned long long* ts = (const volatile unsigned long long*)(args_here()->ws + WS_TS);
        float da = 0.f, db = 0.f;
        if (PROBE_A < 14) { da = (float)(ts[3 + PROBE_A] - ts[2 + PROBE_A]) + (float)(ts[17 + PROBE_A] - ts[16 + PROBE_A]); } else if (PROBE_A == 14) da = (float)(ts[1] - ts[0]); else if (PROBE_A == 15) da = (float)(ts[2] - ts[1]); else da = (float)(ts[30] - ts[0]);
        if (PROBE_B >= 0 && PROBE_B < 14) { db = (float)(ts[3 + PROBE_B] - ts[2 + PROBE_B]) + (float)(ts[17 + PROBE_B] - ts[16 + PROBE_B]); } else if (PROBE_B == 14) db = (float)(ts[1] - ts[0]); else if (PROBE_B == 15) db = (float)(ts[2] - ts[1]);
        da *= 0.01f; db *= 0.01f;
        da = exp2f(0.25f * rintf(4.0f * log2f(fmaxf(da, 0.5f)))); db = exp2f(0.25f * rintf(4.0f * log2f(fmaxf(db, 0.5f))));
        float* out = args_here()->out;
        for (int i = threadIdx.x; i < 16 * 1024; i += NTHREADS) { const int r = i >> 10, col = i & 1023; const int rowi = (r & 7) + 2048 * (r >> 3); out[(size_t)rowi * D + col] = da; }
        if (threadIdx.x == 0 && PROBE_B >= 0) out[(size_t)4096 * D] = 100.0f * db;
    }
#endif
}

extern "C" void kernel_launch(void* const* d_in, const int* in_sizes, int n_in, void* d_out, int out_size, void* d_ws, size_t ws_size, hipStream_t stream) {
    static int grid = 0;
    if (grid == 0) {
        if (n_in != N_IN || out_size != T * D || ws_size < WS_END2) { fprintf(stderr, "kernel_launch: unexpected shapes: n_in %d out %d ws %zu (need %zu)\n", n_in, out_size, ws_size, (size_t)WS_END2); grid = -1; return; }
        int dev = 0, cus = 0;
        (void)hipGetDevice(&dev); (void)hipDeviceGetAttribute(&cus, hipDeviceAttributeMultiprocessorCount, dev);
        if (hipFuncSetAttribute((const void*)mk_fwd, hipFuncAttributeMaxDynamicSharedMemorySize, LDS_BYTES) != hipSuccess) { fprintf(stderr, "kernel_launch: hipFuncSetAttribute failed\n"); grid = -1; return; }
        grid = cus > 0 ? cus : 256;
        fprintf(stderr, "kernel_launch: ws_size %zu grid %d\n", ws_size, grid);
    }
    if (grid < 0) return;
    (void)hipMemsetAsync((char*)d_ws + WS_CTL, 0, CTL_BYTES, stream);
    Args a{};
    for (int i = 0; i < N_IN; ++i) a.in[i] = (const float*)d_in[i];
    a.out = (float*)d_out; a.ws = (unsigned char*)d_ws;
    a.ph_lo = 0; a.ph_hi = 1000;
    hipLaunchKernelGGL(mk_fwd, dim3(grid), dim3(NTHREADS), LDS_BYTES, stream, a);
}
```

```cpp
#include <hip/hip_runtime.h>
#include <cstdio>
#include <cstdint>
#include <utility>

typedef unsigned short bf16;
typedef _Float16 f16;
typedef float f32x4 __attribute__((ext_vector_type(4)));
typedef unsigned u32x4 __attribute__((ext_vector_type(4)));
typedef unsigned u32x2 __attribute__((ext_vector_type(2)));

constexpr int T = 16384, D = 1024, W = 512, NH = 8, HN = 64, RC = 1792, INC = 4864;
constexpr int NE = 16, FF = 512, DEPTH = 2;
constexpr float LN_EPS = 1e-5f, GN_EPS = 64e-5f, ALPHA = 1.41421356237f;
constexpr int NTHREADS = 512, NWAVES = 8;
constexpr int MAXSLOT = 36864;

constexpr size_t MiB = 1u << 20;
constexpr size_t WS_CTL = 0, CTL_BYTES = 1 * MiB;
constexpr int CW_CNT = 16384;
constexpr size_t WS_PART = 1 * MiB;
constexpr size_t WS_MODF = 2 * MiB;
constexpr size_t WS_TOKI = 2 * MiB + 65536;
constexpr size_t WS_TOKW = WS_TOKI + 131072;
constexpr size_t WS_TOKP = WS_TOKW + 131072;
constexpr size_t WS_S2T = 3 * MiB;
constexpr size_t WS_BLKCNT = 3 * MiB + 512 * 1024;
constexpr size_t WS_TOT = WS_BLKCNT + 32768;
constexpr size_t WS_LORA = 4 * MiB;
constexpr size_t WS_WIN = 8 * MiB;
constexpr size_t WS_WA = 28 * MiB, WS_WB = 29 * MiB, WS_WO = 30 * MiB, WS_WL1 = 4 * MiB;
constexpr size_t WS_ZG = 36 * MiB;
constexpr size_t WS_XN = 100 * MiB;
constexpr size_t WS_G = 100 * MiB, WS_YB = 116 * MiB;
constexpr size_t WS_ZR = 132 * MiB;
constexpr size_t WS_ZS = 188 * MiB;
constexpr size_t WS_YSC = 132 * MiB;
constexpr size_t WS_ST = 148 * MiB;
constexpr size_t WS_YA = 132 * MiB;
constexpr size_t WS_MP = 164 * MiB;
constexpr size_t WS_XS = 132 * MiB;
constexpr size_t WS_Y = 132 * MiB;
constexpr size_t WS_AA = 224 * MiB, WS_BB = 240 * MiB, WS_WM1 = 256 * MiB, WS_R = 272 * MiB, WS_KP = 288 * MiB, WS_V = 304 * MiB;
constexpr size_t WS_WGU = 224 * MiB;
constexpr size_t WS_WD = 256 * MiB;
constexpr size_t WS_HID = 272 * MiB;
constexpr size_t WS_VF = 320 * MiB;
constexpr size_t WS_END = 336 * MiB;

constexpr size_t LO_W2T = 0, LO_A2T = 65536, LO_G2T = 131072, LO_VM1T = 262144, LO_VM2T = 294912, LO_STRIDE = 524288;

enum { I_X = 0, I_C, I_WMOD, I_BMOD, I_WIN, I_MU, I_W0, I_W2, I_A0, I_A2, I_G2, I_KK, I_KA, I_RK, I_GNG, I_GNB, I_VM0, I_VM1, I_VM2,
       I_SGG, I_SGB, I_WS, I_BS, I_WBA, I_WBB, I_WOUT, I_LN1G, I_LN1B, I_RW, I_RB, I_EG, I_EU, I_ED, I_LN2G, I_LN2B, N_IN };

struct Args { const float* in[N_IN]; float* out; unsigned char* ws; int ph_lo, ph_hi; };
typedef const __attribute__((address_space(4))) Args& ArgsR;

__device__ __forceinline__ float bf2f(bf16 h) { return __uint_as_float(((unsigned)h) << 16); }
__device__ __forceinline__ unsigned f2bfu(float f) { unsigned u = __float_as_uint(f); return (u + 0x7fffu + ((u >> 16) & 1u)) >> 16; }
__device__ __forceinline__ bf16 f2bf(float f) { return __builtin_bit_cast(unsigned short, (__bf16)f); }
typedef __bf16 bf16x2_t __attribute__((ext_vector_type(2)));
__device__ __forceinline__ unsigned pk2(float lo, float hi) { bf16x2_t v; v[0] = (__bf16)lo; v[1] = (__bf16)hi; return __builtin_bit_cast(unsigned, v); }
__device__ __forceinline__ void store4bf(bf16* p, f32x4 v) { u32x2 w; w.x = pk2(v[0], v[1]); w.y = pk2(v[2], v[3]); *(u32x2*)p = w; }
__device__ __forceinline__ f32x4 load4bf(const bf16* p) { u32x2 w = *(const u32x2*)p; f32x4 r; r[0] = __uint_as_float(w.x << 16); r[1] = __uint_as_float(w.x & 0xffff0000u); r[2] = __uint_as_float(w.y << 16); r[3] = __uint_as_float(w.y & 0xffff0000u); return r; }
__device__ __forceinline__ float wave_sum(float v) {
#pragma unroll
    for (int o = 1; o < 64; o <<= 1) v += __shfl_xor(v, o);
    return v;
}
__device__ __forceinline__ float sigmoidf_(float x) { return __builtin_amdgcn_rcpf(1.0f + __expf(-x)); }
__device__ __forceinline__ float siluf_(float x) { return x * sigmoidf_(x); }
__device__ __forceinline__ float gelu_tanh(float x) { const float u = 0.7978845608028654f * (x + 0.044715f * x * x * x); return x * (1.0f - __builtin_amdgcn_rcpf(1.0f + __expf(2.0f * u))); }
__device__ __forceinline__ float softplusf_(float y) { return fmaxf(y, 0.f) + log1pf(__expf(-fabsf(y))); }

struct Ctx { int tid, lane, wave, gw, ngw; unsigned char* lds; };

__device__ __forceinline__ void transpose_item(const float* Wsrc, int N, int k0, int n0, bf16* dst, int ldk, float* scr, int lane) {
    float tv[32];
#pragma unroll
    for (int i = 0; i < 32; ++i) tv[i] = Wsrc[(size_t)(k0 + 2 * i + (lane >> 5)) * N + n0 + (lane & 31)];
#pragma unroll
    for (int i = 0; i < 32; ++i) scr[(2 * i + (lane >> 5)) * 33 + (lane & 31)] = tv[i];
    asm volatile("s_waitcnt lgkmcnt(0)" ::: "memory");
    const int c = lane & 7;
#pragma unroll
    for (int j = 0; j < 4; ++j) { const int n = (lane >> 3) + 8 * j; const float* s = scr + (8 * c) * 33 + n;
        u32x4 o; o.x = pk2(s[0 * 33], s[1 * 33]); o.y = pk2(s[2 * 33], s[3 * 33]); o.z = pk2(s[4 * 33], s[5 * 33]); o.w = pk2(s[6 * 33], s[7 * 33]);
        *(u32x4*)(dst + (size_t)n * ldk + k0 + 8 * c) = o; }
    asm volatile("s_waitcnt lgkmcnt(0)" ::: "memory");
}
template <class RowMap>
__device__ __forceinline__ void transpose_matrix_item(const float* Wsrc, int K, int N, bf16* dst, int item, float* scr, int lane, const RowMap& rm) {
    const int nblk = N / 32, kb = item / nblk, nb = item % nblk, n0 = 32 * nb;
    transpose_item(Wsrc, N, 64 * kb, n0, dst + (size_t)rm(n0) * K, K, scr, lane);
}
struct RowId { __device__ __forceinline__ int operator()(int n) const { return n; } };
struct RowGU { int up; __device__ __forceinline__ int operator()(int n) const { return (n >> 7) * 256 + (n & 127) + up * 128; } };

__device__ __forceinline__ void phase_p0a(ArgsR a, const Ctx& c) {
    float* scr = (float*)(c.lds + c.wave * 16384);
    { float* MODF = (float*)(a.ws + WS_MODF); float* red = (float*)(c.lds + 131072);
      for (int cbk = blockIdx.x; cbk < 2 * 96; cbk += gridDim.x) {
          const int l = cbk / 96, n = (cbk % 96) * 64 + c.lane;
          const float* wm = a.in[I_WMOD] + (size_t)l * D * 6144 + (size_t)(c.wave * 128) * 6144 + n;
          float acc0 = 0.f, acc1 = 0.f;
#pragma unroll 16
          for (int k = 0; k < 128; k += 2) { acc0 += siluf_(a.in[I_C][c.wave * 128 + k]) * wm[(size_t)k * 6144]; acc1 += siluf_(a.in[I_C][c.wave * 128 + k + 1]) * wm[(size_t)(k + 1) * 6144]; }
          red[c.wave * 64 + c.lane] = acc0 + acc1;
          __syncthreads();
          if (c.wave == 0) { float sacc = a.in[I_BMOD][l * 6144 + n];
#pragma unroll
              for (int w = 0; w < 8; ++w) sacc += red[w * 64 + c.lane];
              MODF[l * 6144 + n] = sacc; }
          __syncthreads();
      } }
    for (int it = c.gw; it < 2 * (16 + 16 + 32 + 8); it += c.ngw) {
        const int l = it / 72; int r = it % 72; unsigned char* lo = a.ws + WS_LORA + (size_t)l * LO_STRIDE;
        if (r < 16) { transpose_matrix_item(a.in[I_W2] + (size_t)l * 64 * W, 64, W, (bf16*)(lo + LO_W2T), r, scr, c.lane, RowId()); continue; } r -= 16;
        if (r < 16) { transpose_matrix_item(a.in[I_A2] + (size_t)l * 64 * W, 64, W, (bf16*)(lo + LO_A2T), r, scr, c.lane, RowId()); continue; } r -= 16;
        if (r < 32) { transpose_matrix_item(a.in[I_G2] + (size_t)l * 128 * W, 128, W, (bf16*)(lo + LO_G2T), r, scr, c.lane, RowId()); continue; } r -= 32;
        if (l == 1) transpose_matrix_item(a.in[I_VM1], W, 32, (bf16*)(lo + LO_VM1T), r, scr, c.lane, RowId());
    }
    for (int i = blockIdx.x * NTHREADS + c.tid; i < 32 * W; i += gridDim.x * NTHREADS) { const int n = i >> 5, k = i & 31;
        ((bf16*)(a.ws + WS_LORA + LO_STRIDE + LO_VM2T))[i] = f2bf(a.in[I_VM2][(size_t)k * W + n]); }
    constexpr int I_WINL = (D / 64) * (INC / 32);
    constexpr int I_WAL = (W / 64) * (D / 32);
    constexpr int I_WOL = (D / 64) * (D / 32);
    constexpr int PER_L = I_WINL + 2 * I_WAL + I_WOL;
    for (int it = c.gw; it < 2 * PER_L; it += c.ngw) {
        const int l = it / PER_L; int r = it % PER_L;
        if (r < I_WINL) { transpose_matrix_item(a.in[I_WIN] + (size_t)l * D * INC, D, INC, (bf16*)(a.ws + WS_WIN + (size_t)l * 10 * MiB), r, scr, c.lane, RowId()); continue; } r -= I_WINL;
        if (r < I_WAL) { transpose_matrix_item(a.in[I_WBA] + (size_t)l * W * D, W, D, (bf16*)(a.ws + WS_WA + (size_t)l * WS_WL1), r, scr, c.lane, RowId()); continue; } r -= I_WAL;
        if (r < I_WAL) { transpose_matrix_item(a.in[I_WBB] + (size_t)l * W * D, W, D, (bf16*)(a.ws + WS_WB + (size_t)l * WS_WL1), r, scr, c.lane, RowId()); continue; } r -= I_WAL;
        transpose_matrix_item(a.in[I_WOUT] + (size_t)l * D * D, D, D, (bf16*)(a.ws + WS_WO + (size_t)l * WS_WL1), r, scr, c.lane, RowId());
    }
}

__device__ __forceinline__ void row_stats(const float (&v)[16], float& mean, float& rstd) {
    float s = 0.f;
#pragma unroll
    for (int j = 0; j < 16; ++j) s += v[j];
    mean = wave_sum(s) * (1.f / D);
    float q = 0.f;
#pragma unroll
    for (int j = 0; j < 16; ++j) { const float d = v[j] - mean; q += d * d; }
    rstd = __builtin_amdgcn_rsqf(wave_sum(q) * (1.f / D) + LN_EPS);
}
__device__ __forceinline__ void load_row16(const float* p, int lane, float (&v)[16]) {
#pragma unroll
    for (int j = 0; j < 4; ++j) { const f32x4 x = *(const f32x4*)(p + 4 * lane + 256 * j); v[4 * j] = x[0]; v[4 * j + 1] = x[1]; v[4 * j + 2] = x[2]; v[4 * j + 3] = x[3]; }
}

__device__ __forceinline__ void phase_p0b(ArgsR a, const Ctx& c) {
    const float* MODF = (const float*)(a.ws + WS_MODF);
    float sh[16], sc[16];
#pragma unroll
    for (int j = 0; j < 4; ++j) { const f32x4 s0 = *(const f32x4*)(MODF + 4 * c.lane + 256 * j), s1 = *(const f32x4*)(MODF + 1024 + 4 * c.lane + 256 * j);
#pragma unroll
        for (int e = 0; e < 4; ++e) { sh[4 * j + e] = s0[e]; sc[4 * j + e] = 1.f + s1[e]; } }
    bf16* XN = (bf16*)(a.ws + WS_XN);
    for (int m = c.gw; m < T; m += c.ngw) {
        float v[16]; load_row16(a.in[I_X] + (size_t)m * D, c.lane, v);
        float mean, rstd; row_stats(v, mean, rstd);
#pragma unroll
        for (int j = 0; j < 4; ++j) { f32x4 o;
#pragma unroll
            for (int e = 0; e < 4; ++e) o[e] = (v[4 * j + e] - mean) * rstd * sc[4 * j + e] + sh[4 * j + e];
            store4bf(XN + (size_t)m * D + 4 * c.lane + 256 * j, o); }
    }
}

namespace pg8 {
#define PG8_LAS __attribute__((address_space(3)))
typedef unsigned short bf16_t;
typedef short bf16x8 __attribute__((ext_vector_type(8)));
typedef float f32x4 __attribute__((ext_vector_type(4)));
typedef unsigned u32x4 __attribute__((ext_vector_type(4)));
constexpr int BM = 256, BK = 64, HALF = 128, HTB = HALF * BK * 2  , STAGE_BYTES = 8 * HTB, NXCD = 8, WGM = 8;

__host__ __device__ __forceinline__ int lds_byte(int r, int c) { const int st = (r >> 4) * 2 + (c >> 5), rr = r & 15, cc = c & 31, ob = rr * 64 + cc * 2; return st * 1024 + (ob ^ (((ob >> 9) & 1) << 5)); }
__host__ __device__ __forceinline__ void stage_rc(int b, int& R, int& C) { const int st = b / 1024, sb = b % 1024, swz = sb ^ (((sb >> 9) & 1) << 5); R = (st >> 1) * 16 + swz / 64; C = (st & 1) * 32 + (swz % 64) / 2; }
__host__ __device__ __forceinline__ int perm32(int rho) { const int n = rho >> 4, i = rho & 15; return 8 * (i >> 2) + 4 * n + (i & 3); }

struct Unit { int pm, pn; };
struct Gemm { const bf16_t* A; const bf16_t* Bt; int M, N, K; };

struct StaticOrder {
    int nM, nN, nwg, G, c;
    __host__ __device__ void init(int M, int N, int G_, int c_) { nM = M / BM; nN = N / BM; nwg = nM * nN; G = G_; c = c_; }
    __host__ __device__ bool next(int i, Unit& u) const {
        const long L = (long)i * G + c; if (L >= nwg) return false;
        int wgid = (int)L; { const int q = nwg / NXCD, r = nwg % NXCD, xcd = wgid % NXCD, off = wgid / NXCD; wgid = (xcd < r ? xcd * (q + 1) : r * (q + 1) + (xcd - r) * q) + off; }
        const int nig = WGM * nN, gid = wgid / nig, fm = gid * WGM, gsz = (nM - fm) < WGM ? (nM - fm) : WGM;
        u.pm = fm + ((wgid % nig) % gsz); u.pn = (wgid % nig) / gsz; return true;
    }
    __device__ __forceinline__ void a_ready(const Unit&) const {}
    __device__ __forceinline__ void done(const Unit&) const {}
};


template <class Epi, class Sched, bool ALIGN_EPI = false, bool SP2 = false, bool GATHER = false>
__device__ __forceinline__ void gemm_phase(PG8_LAS unsigned char* lds, const Gemm g, const Sched& S, const Epi& E, const int tid_in, const int* s2t = nullptr) {
    const int tid = tid_in, wid = __builtin_amdgcn_readfirstlane(tid >> 6), lane = tid & 63, wr = wid >> 2, wc = wid & 3, fr = lane & 15, fq = lane >> 4;
    const int K = g.K, nt = K / BK;
    unsigned voffA[2], voffB[2];
#pragma unroll
    for (int i = 0; i < 2; ++i) { int R, C; stage_rc(tid * 16 + i * 8192, R, C); const int Rb = Epi::PERM ? ((R & ~31) + perm32(R & 31)) : R;
        voffA[i] = (unsigned)(R * K + C) * 2u; voffB[i] = (unsigned)(Rb * K + C) * 2u; }
    unsigned pc0 = 0u, pc1 = 0u, pn0 = 0u, pn1 = 0u, cvoff = 0u; int R0g = 0;
    if constexpr (GATHER) { int R, C; stage_rc(tid * 16, R, C); R0g = R; cvoff = (unsigned)C * 2u; }
#define PG8_TOKPACK(pm_, h_) ([&]() -> unsigned { const int r0_ = (pm_) * BM + (h_) * HALF + R0g; const int a0_ = s2t[2 * r0_], a1_ = s2t[2 * (r0_ + 64)]; return (unsigned)(a0_ < 0 ? 0 : (a0_ >> 1)) | ((unsigned)(a1_ < 0 ? 0 : (a1_ >> 1)) << 16); }())
#define PG8_STAGE_A(bufoff, base, h, usen) do { if constexpr (GATHER) { const unsigned pk_ = (usen) ? ((h) ? pn1 : pn0) : ((h) ? pc1 : pc0); \
        unsigned vt_[2] = {(pk_ & 0xffffu) * (unsigned)(K * 2) + cvoff, (pk_ >> 16) * (unsigned)(K * 2) + cvoff}; PG8_STAGE(bufoff, base, vt_); } \
    else PG8_STAGE(bufoff, (base) + ((h) ? hstep : (size_t)0), voffA); } while (0)
    const size_t kstep = (size_t)(BK * 2);
    const size_t hstep = (size_t)HALF * K * 2;
    const size_t tstep = 2 * hstep;
    const unsigned ldsw = (unsigned)wid * 1024u;
    const int aoff = lds_byte(wr * 64 + fr, fq * 8), boff = lds_byte(wc * 32 + fr, fq * 8);
#define PG8_SA(b, h) (((b) * 2 + (h)) * HTB)
#define PG8_SB(b, h) ((4 + (b) * 2 + (h)) * HTB)
#define PG8_STAGE(bufoff, gbase, voff) do { _Pragma("unroll") for (int _i = 0; _i < 2; ++_i) \
        __builtin_amdgcn_global_load_lds((const unsigned*)((const char*)(gbase) + (voff)[_i]), (PG8_LAS unsigned*)(lds + (bufoff) + ldsw + _i * 8192), 16, 0, 0); } while (0)
#define PG8_LDA(dst, b, h) do { _Pragma("unroll") for (int m = 0; m < 4; ++m) _Pragma("unroll") for (int k = 0; k < 2; ++k) dst[m][k] = *(const PG8_LAS bf16x8*)(lds + PG8_SA(b, h) + aoff + m * 2048 + k * 1024); } while (0)
#define PG8_LDB(dst, b, h) do { _Pragma("unroll") for (int n = 0; n < 2; ++n) _Pragma("unroll") for (int k = 0; k < 2; ++k) dst[n][k] = *(const PG8_LAS bf16x8*)(lds + PG8_SB(b, h) + boff + n * 2048 + k * 1024); } while (0)
#define PG8_MMA(ai, bj, At, Bt) do { __builtin_amdgcn_s_setprio(1); _Pragma("unroll") for (int m = 0; m < 4; ++m) _Pragma("unroll") for (int n = 0; n < 2; ++n) _Pragma("unroll") for (int k = 0; k < 2; ++k) \
        acc[ai][bj][m][n] = __builtin_amdgcn_mfma_f32_16x16x32_bf16(Bt[n][k], At[m][k], acc[ai][bj][m][n], 0, 0, 0); __builtin_amdgcn_s_setprio(0); } while (0)
#define PG8_WAIT_V(n) asm volatile("s_waitcnt vmcnt(" #n ")" ::: "memory")
#define PG8_WAIT_L(n) asm volatile("s_waitcnt lgkmcnt(" #n ")" ::: "memory")
#define PG8_BAR __builtin_amdgcn_s_barrier()
#define PG8_SCHED __builtin_amdgcn_sched_barrier(0)
    Unit cur, nxt; int ui = 0;
    if (!S.next(0, cur)) return;
    f32x4 acc[2][2][4][2];
#pragma unroll
    for (int a = 0; a < 2; ++a)
#pragma unroll
        for (int b = 0; b < 2; ++b)
#pragma unroll
            for (int m = 0; m < 4; ++m)
#pragma unroll
                for (int n = 0; n < 2; ++n) acc[a][b][m][n] = (f32x4){0.f, 0.f, 0.f, 0.f};
    bf16x8 At[4][2], B0[2][2], B1[2][2];
    const char* cA = (const char*)g.A + (GATHER ? (size_t)0 : (size_t)cur.pm * tstep); const char* cB = (const char*)g.Bt + (size_t)cur.pn * tstep;
    if constexpr (GATHER) { pc0 = PG8_TOKPACK(cur.pm, 0); pc1 = PG8_TOKPACK(cur.pm, 1); }
    S.a_ready(cur);
    if constexpr (SP2) {
        PG8_STAGE(PG8_SB(0, 0), cB, voffB); PG8_STAGE(PG8_SB(0, 1), cB + hstep, voffB); PG8_STAGE_A(PG8_SA(0, 0), cA, 0, false); PG8_STAGE_A(PG8_SA(0, 1), cA, 1, false);
        if (wr == 1) PG8_BAR;
        PG8_WAIT_V(2); PG8_BAR;
        PG8_STAGE(PG8_SB(1, 0), cB + kstep, voffB); PG8_STAGE_A(PG8_SA(1, 0), cA + kstep, 0, false); PG8_STAGE(PG8_SB(1, 1), cB + hstep + kstep, voffB);
        PG8_WAIT_V(6); PG8_BAR;
    } else {
        PG8_STAGE(PG8_SB(0, 0), cB, voffB); PG8_STAGE(PG8_SA(0, 0), cA, voffA); PG8_STAGE(PG8_SB(0, 1), cB + hstep, voffB); PG8_STAGE(PG8_SA(0, 1), cA + hstep, voffA);
        if (wr == 1) PG8_BAR;
        PG8_WAIT_V(4); PG8_BAR;
        PG8_STAGE(PG8_SB(1, 0), cB + kstep, voffB); PG8_STAGE(PG8_SA(1, 0), cA + kstep, voffA); PG8_STAGE(PG8_SB(1, 1), cB + hstep + kstep, voffB);
        PG8_WAIT_V(6); PG8_BAR;
    }
    for (;;) {
        const bool has_next = S.next(ui + 1, nxt);
        const char* nA = (has_next && !GATHER) ? (const char*)g.A + (size_t)nxt.pm * tstep : cA; const char* nB = has_next ? (const char*)g.Bt + (size_t)nxt.pn * tstep : cB;
        if constexpr (GATHER) { if (has_next) { pn0 = PG8_TOKPACK(nxt.pm, 0); pn1 = PG8_TOKPACK(nxt.pm, 1); } else { pn0 = pc0; pn1 = pc1; } }
        for (int t = 0; t < nt; t += 2) {
            const bool last = (t == nt - 2);
            const char* a1 = cA + (size_t)(t + 1) * kstep;
            const char* a2 = last ? nA : cA + (size_t)(t + 2) * kstep; const char* b2 = last ? nB : cB + (size_t)(t + 2) * kstep;
            const char* a3 = a2 + kstep; const char* b3 = b2 + kstep;
            if (last && has_next) S.a_ready(nxt);
            if constexpr (SP2) {
            PG8_LDB(B0, 0, 0); PG8_LDB(B1, 0, 1); PG8_SCHED; PG8_LDA(At, 0, 0); PG8_STAGE_A(PG8_SA(1, 1), a1, 1, false);
            PG8_WAIT_V(8); PG8_WAIT_L(0); PG8_BAR; PG8_MMA(0, 0, At, B0); PG8_MMA(0, 1, At, B1); PG8_BAR; PG8_SCHED;
            PG8_LDA(At, 0, 1); PG8_STAGE(PG8_SB(0, 0), b2, voffB); PG8_STAGE(PG8_SB(0, 1), b2 + hstep, voffB); PG8_STAGE_A(PG8_SA(0, 0), a2, 0, last);
            PG8_WAIT_V(8); PG8_WAIT_L(0); PG8_BAR; PG8_MMA(1, 0, At, B0); PG8_MMA(1, 1, At, B1); PG8_BAR; PG8_SCHED;
            PG8_LDB(B0, 1, 0); PG8_LDB(B1, 1, 1); PG8_SCHED; PG8_LDA(At, 1, 0); PG8_STAGE_A(PG8_SA(0, 1), a2, 1, last);
            PG8_WAIT_V(8); PG8_WAIT_L(0); PG8_BAR; PG8_MMA(0, 0, At, B0); PG8_MMA(0, 1, At, B1); PG8_BAR; PG8_SCHED;
            PG8_LDA(At, 1, 1); PG8_STAGE(PG8_SB(1, 0), b3, voffB); PG8_STAGE(PG8_SB(1, 1), b3 + hstep, voffB); PG8_STAGE_A(PG8_SA(1, 0), a3, 0, last);
            PG8_WAIT_V(8); PG8_WAIT_L(0); PG8_BAR; PG8_MMA(1, 0, At, B0); PG8_MMA(1, 1, At, B1); PG8_BAR; PG8_SCHED;
            } else {
            PG8_LDB(B0, 0, 0); PG8_SCHED; PG8_LDA(At, 0, 0); PG8_STAGE(PG8_SA(1, 1), a1 + hstep, voffA);
            PG8_WAIT_L(8); PG8_BAR; PG8_WAIT_L(0); PG8_MMA(0, 0, At, B0); PG8_BAR; PG8_SCHED;
            PG8_LDB(B1, 0, 1); PG8_STAGE(PG8_SB(0, 0), b2, voffB);
            PG8_BAR; PG8_WAIT_L(0); PG8_MMA(0, 1, At, B1); PG8_BAR;
            PG8_LDA(At, 0, 1); PG8_STAGE(PG8_SA(0, 0), a2, voffA);
            PG8_BAR; PG8_WAIT_L(0); PG8_MMA(1, 0, At, B0); PG8_BAR; PG8_SCHED;
            PG8_STAGE(PG8_SB(0, 1), b2 + hstep, voffB);
            PG8_WAIT_V(6); PG8_BAR; PG8_MMA(1, 1, At, B1); PG8_BAR;
            PG8_LDB(B0, 1, 0); PG8_SCHED; PG8_LDA(At, 1, 0); PG8_STAGE(PG8_SA(0, 1), a2 + hstep, voffA);
            PG8_WAIT_L(8); PG8_BAR; PG8_WAIT_L(0); PG8_MMA(0, 0, At, B0); PG8_BAR; PG8_SCHED;
            PG8_LDB(B1, 1, 1); PG8_STAGE(PG8_SB(1, 0), b3, voffB);
            PG8_BAR; PG8_WAIT_L(0); PG8_MMA(0, 1, At, B1); PG8_BAR;
            PG8_LDA(At, 1, 1); PG8_STAGE(PG8_SA(1, 0), a3, voffA);
            PG8_BAR; PG8_WAIT_L(0); PG8_MMA(1, 0, At, B0); PG8_BAR; PG8_SCHED;
            PG8_STAGE(PG8_SB(1, 1), b3 + hstep, voffB);
            PG8_WAIT_V(6); PG8_BAR; PG8_MMA(1, 1, At, B1); PG8_BAR;
            }
        }
        if constexpr (ALIGN_EPI) { if (wr == 0) PG8_BAR; }
        if constexpr (!Epi::AFTER_DRAIN) { E(acc, cur, wr, wc, fr, fq); S.done(cur); }
        if (!has_next) break;
#pragma unroll
        for (int a = 0; a < 2; ++a)
#pragma unroll
            for (int b = 0; b < 2; ++b)
#pragma unroll
                for (int m = 0; m < 4; ++m)
#pragma unroll
                    for (int n = 0; n < 2; ++n) acc[a][b][m][n] = (f32x4){0.f, 0.f, 0.f, 0.f};
        cur = nxt; cA = nA; cB = nB; ++ui; if constexpr (GATHER) { pc0 = pn0; pc1 = pn1; }
        if constexpr (ALIGN_EPI) { if (wr == 1) PG8_BAR; }
    }
    PG8_WAIT_V(0);
    if constexpr (!ALIGN_EPI) { if (wr == 0) PG8_BAR; }
    PG8_BAR;
    if constexpr (Epi::AFTER_DRAIN) { E.fused(acc, cur, wr, wc, fr, fq, lds, wid, lane); S.done(cur); }
#undef PG8_SA
#undef PG8_SB
#undef PG8_STAGE
#undef PG8_STAGE_A
#undef PG8_TOKPACK
#undef PG8_LDA
#undef PG8_LDB
#undef PG8_MMA
#undef PG8_WAIT_V
#undef PG8_WAIT_L
#undef PG8_BAR
#undef PG8_SCHED
}
}

using pg8::Unit;
struct DenseSched { int nN, n, G, c;
    __device__ __forceinline__ void a_ready(const Unit&) const {}
    __device__ __forceinline__ void done(const Unit&) const {}
    __device__ __forceinline__ bool next(int i, Unit& u) const { const int L = i * G + c; if (L >= n) return false; u.pm = L / nN; u.pn = L % nN; return true; } };

__device__ __forceinline__ void store8bf(bf16* p, f32x4 lo, f32x4 hi) { u32x4 w; w.x = pk2(lo[0], lo[1]); w.y = pk2(lo[2], lo[3]); w.z = pk2(hi[0], hi[1]); w.w = pk2(hi[2], hi[3]); *(u32x4*)p = w; }
__device__ __forceinline__ void load8bf(const bf16* p, f32x4& lo, f32x4& hi) { const u32x4 w = *(const u32x4*)p;
    lo[0] = __uint_as_float(w.x << 16); lo[1] = __uint_as_float(w.x & 0xffff0000u); lo[2] = __uint_as_float(w.y << 16); lo[3] = __uint_as_float(w.y & 0xffff0000u);
    hi[0] = __uint_as_float(w.z << 16); hi[1] = __uint_as_float(w.z & 0xffff0000u); hi[2] = __uint_as_float(w.w << 16); hi[3] = __uint_as_float(w.w & 0xffff0000u); }
struct EpiZ { bf16 *ZR, *ZS, *ZG;
    __device__ __forceinline__ void one(int row, int col, f32x4 lo, f32x4 hi) const {
        if (col < RC) store8bf(ZR + (size_t)row * RC + col, lo, hi);
        else if (col < RC + 1024) { for (int e = 0; e < 4; ++e) { lo[e] = gelu_tanh(lo[e]); hi[e] = gelu_tanh(hi[e]); } store8bf(ZS + (size_t)row * 1024 + (col - RC), lo, hi); }
        else { for (int e = 0; e < 4; ++e) { lo[e] = sigmoidf_(lo[e]); hi[e] = sigmoidf_(hi[e]); } store8bf(ZG + (size_t)row * 2048 + (col - RC - 1024), lo, hi); } }
    __device__ __forceinline__ void operator()(int row, int col, f32x4 a0, f32x4 a1, f32x4 b0, f32x4 b1) const { one(row, col, a0, a1); one(row, col + 128, b0, b1); } };
struct EpiGA { const bf16* ZG; bf16* MP;
    __device__ __forceinline__ void one(int row, int col, f32x4 lo, f32x4 hi) const { f32x4 g0, g1; load8bf(ZG + (size_t)row * 2048 + col, g0, g1); store8bf(MP + (size_t)row * D + col, g0 * lo, g1 * hi); }
    __device__ __forceinline__ void operator()(int row, int col, f32x4 a0, f32x4 a1, f32x4 b0, f32x4 b1) const { one(row, col, a0, a1); one(row, col + 128, b0, b1); } };
struct EpiGB { const bf16* ZG; const bf16* MPin; bf16* MP;
    __device__ __forceinline__ void one(int row, int col, f32x4 lo, f32x4 hi) const { f32x4 g0, g1, m0, m1; load8bf(ZG + (size_t)row * 2048 + 1024 + col, g0, g1); load8bf(MPin + (size_t)row * D + col, m0, m1);
        store8bf(MP + (size_t)row * D + col, m0 + g0 * lo, m1 + g1 * hi); }
    __device__ __forceinline__ void operator()(int row, int col, f32x4 a0, f32x4 a1, f32x4 b0, f32x4 b1) const { one(row, col, a0, a1); one(row, col + 128, b0, b1); } };
struct EpiOut { const float* xin; float* out; const float* gate1;
    __device__ __forceinline__ void one(int row, int col, f32x4 v) const { const f32x4 x = *(const f32x4*)(xin + (size_t)row * D + col); const f32x4 g = *(const f32x4*)(gate1 + col);
        *(f32x4*)(out + (size_t)row * D + col) = ALPHA * x + (1.0f + g) * v; }
    __device__ __forceinline__ void operator()(int row, int col, f32x4 a0, f32x4 a1, f32x4 b0, f32x4 b1) const { one(row, col, a0); one(row, col + 4, a1); one(row, col + 128, b0); one(row, col + 132, b1); } };
struct EpiSwi { bf16* HID;
    __device__ __forceinline__ void operator()(int row, int col, f32x4 a0, f32x4 a1, f32x4 b0, f32x4 b1) const { const int ct = (col >> 8) & 3, cc = col & 127;
        f32x4 h0, h1; for (int e = 0; e < 4; ++e) { h0[e] = siluf_(a0[e]) * b0[e]; h1[e] = siluf_(a1[e]) * b1[e]; } store8bf(HID + (size_t)row * FF + ct * 128 + cc, h0, h1); } };
struct EpiDown { const int* S2T; const float* TOKW; bf16* Y;
    __device__ __forceinline__ void operator()(int row, int col, f32x4 a0, f32x4 a1, f32x4 b0, f32x4 b1) const { const u32x2 sw = *(const u32x2*)(S2T + 2 * row); const int st = (int)sw.x; if (st < 0) return; const float w = __uint_as_float(sw.y); const int cc = col & 1023;
        store8bf(Y + (size_t)st * D + cc, w * a0, w * a1); store8bf(Y + (size_t)st * D + cc + 128, w * b0, w * b1); } };

struct MoeSched { int ts[17]; int G, c;
    __device__ __forceinline__ void a_ready(const Unit&) const {}
    __device__ __forceinline__ void done(const Unit&) const {}
    __device__ __forceinline__ void init(const unsigned* cnt, int G_, int c_) { G = G_; c = c_; int s = 0;
#pragma unroll
        for (int e = 0; e < 16; ++e) { ts[e] = s; s += ((int)cnt[e] + 255) >> 8; } ts[16] = s; }
    __device__ __forceinline__ bool next(int i, Unit& u) const { const int L = i * G + c; if (L >= 4 * ts[16]) return false; const int rt = L >> 2, ct = L & 3; int e = 0;
#pragma unroll
        for (int j = 1; j < 16; ++j) e += (rt >= ts[j]) ? 1 : 0;
        u.pm = rt; u.pn = e * 4 + ct; return true; } };

__device__ __forceinline__ void phase_prep_simple(ArgsR a, const Ctx& c, int l) {
    const bf16* ZR = (const bf16*)(a.ws + WS_ZR);
    const float* mu = a.in[I_MU] + l * RC; const float* w0 = a.in[I_W0] + l * W; const float* w2 = a.in[I_W2] + (size_t)l * 64 * W;
    const float* a0 = a.in[I_A0] + l * W; const float* a2 = a.in[I_A2] + (size_t)l * 64 * W; const float* g2 = a.in[I_G2] + (size_t)l * 128 * W;
    const float* k_k = a.in[I_KK] + l * W; const float* k_a = a.in[I_KA] + l * W;
    const float* vm0 = a.in[I_VM0]; const float* vm1 = a.in[I_VM1]; const float* vm2 = a.in[I_VM2];
    f16* R = (f16*)(a.ws + WS_R); f16* WM1 = (f16*)(a.ws + WS_WM1); f16* KP = (f16*)(a.ws + WS_KP); f16* AA = (f16*)(a.ws + WS_AA); f16* BB = (f16*)(a.ws + WS_BB); f16* V = (f16*)(a.ws + WS_V);
    bf16* G = (bf16*)(a.ws + WS_G); bf16* VF = (bf16*)(a.ws + WS_VF);
    const int lane = c.lane;
    for (int t = c.gw; t < T; t += c.ngw) {
        float z[28];
#pragma unroll
        for (int i = 0; i < 28; ++i) { const int col = lane + 64 * i; const float zc = bf2f(ZR[(size_t)t * RC + col]); const float zp = t > 0 ? bf2f(ZR[(size_t)(t - 1) * RC + col]) : 0.f; z[i] = zc + (zp - zc) * mu[col]; }
        const float tw = tanhf(z[24]), za = z[25], sg0 = sigmoidf_(z[26]), sg1 = sigmoidf_(z[27]);
        float wlo[8], alo[8], gg[8];
#pragma unroll
        for (int i = 0; i < 8; ++i) { wlo[i] = 0.f; alo[i] = 0.f; gg[i] = 0.f; }
        for (int j = 0; j < 64; ++j) { const float tj = __shfl(tw, j), aj = __shfl(za, j), s0 = __shfl(sg0, j), s1 = __shfl(sg1, j);
#pragma unroll
            for (int i = 0; i < 8; ++i) { const int n = lane + 64 * i; wlo[i] += tj * w2[j * W + n]; alo[i] += aj * a2[j * W + n]; gg[i] += s0 * g2[j * W + n] + s1 * g2[(64 + j) * W + n]; } }
        float vv[8];
#pragma unroll
        for (int i = 0; i < 8; ++i) vv[i] = z[16 + i];
        if (l == 0) {
#pragma unroll
            for (int i = 0; i < 8; ++i) VF[(size_t)t * W + lane + 64 * i] = f2bf(vv[i]);
        } else {
            float vmid = 0.f;
#pragma unroll
            for (int i = 0; i < 8; ++i)
                for (int j = 0; j < 64; ++j) { const float vc = __shfl(vv[i], j); vmid += vc * vm1[(size_t)(64 * i + j) * 32 + (lane & 31)]; }
            float vg[8];
#pragma unroll
            for (int i = 0; i < 8; ++i) vg[i] = 0.f;
            for (int m = 0; m < 32; ++m) { const float vmm = __shfl(vmid, m);
#pragma unroll
                for (int i = 0; i < 8; ++i) vg[i] += vmm * vm2[m * W + lane + 64 * i]; }
#pragma unroll
            for (int i = 0; i < 8; ++i) { const int n = lane + 64 * i; const float vf = bf2f(VF[(size_t)t * W + n]); vv[i] = vv[i] + (vf - vv[i]) * sigmoidf_(vm0[n] + vg[i]); }
        }
#pragma unroll
        for (int i = 0; i < 8; ++i) {
            const int n = lane + 64 * i; const size_t o = (size_t)t * W + n;
            const float x = w0[n] + wlo[i]; const float wl = -softplusf_(-x) - 0.5f; const float dm1 = expm1f(-__expf(wl));
            const float av = sigmoidf_(a0[n] + alo[i]);
            const float kraw = z[8 + i];
            float kk = kraw * k_k[n]; const float nrm = sqrtf(wave_sum(kk * kk)); kk = kk / fmaxf(nrm, 1e-12f);
            const float kp = kraw * (1.0f + (av - 1.0f) * k_a[n]);
            R[o] = (f16)z[i]; WM1[o] = (f16)dm1; KP[o] = (f16)kp; AA[o] = (f16)(-kk); BB[o] = (f16)(kk * av); V[o] = (f16)vv[i]; G[o] = f2bf(gg[i]);
        }
    }
}

__device__ __forceinline__ void phase_sg_simple(ArgsR a, const Ctx& c, int l) {
    const bf16* ZS = (const bf16*)(a.ws + WS_ZS); bf16* YB = (bf16*)(a.ws + WS_YB);
    const float* lng = a.in[I_SGG] + l * W; const float* lnb = a.in[I_SGB] + l * W;
    float* vn = (float*)c.lds;
    float* st = vn + 128 * 64;
    for (int uidx = blockIdx.x; uidx < 128 * 8; uidx += gridDim.x) {
        const int ch = uidx >> 3, g = uidx & 7; const int tok0 = ch * 128;
        for (int i = 0; i < 16; ++i) { const int s = c.wave * 16 + i; const bf16* p = ZS + (size_t)(tok0 + s) * 1024 + 512 + c.lane * 8;
            const f32x4 x0 = load4bf(p), x1 = load4bf(p + 4);
            float sm = (x0[0] + x0[1]) + (x0[2] + x0[3]) + (x1[0] + x1[1]) + (x1[2] + x1[3]); const float mean = wave_sum(sm) * (1.f / 512.f);
            float q = 0.f; for (int e = 0; e < 4; ++e) { const float d0 = x0[e] - mean, d1 = x1[e] - mean; q += d0 * d0 + d1 * d1; }
            const float rstd = __builtin_amdgcn_rsqf(wave_sum(q) * (1.f / 512.f) + LN_EPS);
            if (c.lane == 0) { st[2 * s] = mean; st[2 * s + 1] = rstd; } }
        __syncthreads();
        for (int i = c.tid; i < 128 * 64; i += NTHREADS) { const int s = i >> 6, d = i & 63; const float x = bf2f(ZS[(size_t)(tok0 + s) * 1024 + 512 + g * 64 + d]);
            vn[i] = (x - st[2 * s]) * st[2 * s + 1] * lng[g * 64 + d] + lnb[g * 64 + d]; }
        __syncthreads();
        const int d = c.tid & 63, tq = c.tid >> 6;
        const float* Wg = a.in[I_WS] + (size_t)(l * 8 + g) * 128 * 128; const float* bs = a.in[I_BS] + (size_t)(l * 8 + g) * 128;
        for (int i = 0; i < 16; ++i) { const int t = tq + 8 * i; float acc = 0.f;
            for (int s = 0; s <= t; ++s) acc += Wg[t * 128 + s] * vn[s * 64 + d];
            const float u = bf2f(ZS[(size_t)(tok0 + t) * 1024 + g * 64 + d]);
            YB[(size_t)(tok0 + t) * W + g * 64 + d] = f2bf(u * (acc + bs[t])); }
        __syncthreads();
    }
}

#define LAS3 __attribute__((address_space(3)))
typedef short bf16x8 __attribute__((ext_vector_type(8)));
template <int MT, int NT, int KS, bool SWAP = false>
__device__ __forceinline__ void mma_lds_glob(const unsigned char* lds_base, int a_off_bytes, int lda, const bf16* Bt, int ldb, int n0, int lane, f32x4 (&acc)[MT][NT]) {
    const int fr = lane & 15, fq = lane >> 4;
    const LAS3 unsigned char* Ab = (const LAS3 unsigned char*)lds_base + a_off_bytes;
    int boff = (n0 + fr) * ldb + 8 * fq; asm volatile("" : "+v"(boff));
#pragma unroll
    for (int ks = 0; ks < KS; ++ks) {
        bf16x8 b[NT];
#pragma unroll
        for (int n = 0; n < NT; ++n) b[n] = *(const bf16x8*)(Bt + boff + 16 * n * ldb + 32 * ks);
#pragma unroll
        for (int m = 0; m < MT; ++m) { const bf16x8 av = *(const LAS3 bf16x8*)(Ab + ((16 * m + fr) * lda + 32 * ks + 8 * fq) * 2);
#pragma unroll
            for (int n = 0; n < NT; ++n) acc[m][n] = SWAP ? __builtin_amdgcn_mfma_f32_16x16x32_bf16(b[n], av, acc[m][n], 0, 0, 0) : __builtin_amdgcn_mfma_f32_16x16x32_bf16(av, b[n], acc[m][n], 0, 0, 0); }
    }
}
__device__ __forceinline__ void zshift8(const bf16* ZR, int t, int col, const float* mu, float (&o)[8]) {
    const u32x4 zc = *(const u32x4*)(ZR + (size_t)t * RC + col);
    u32x4 zp = {0u, 0u, 0u, 0u}; if (t > 0) zp = *(const u32x4*)(ZR + (size_t)(t - 1) * RC + col);
    const f32x4 m0 = *(const f32x4*)(mu + col), m1 = *(const f32x4*)(mu + col + 4);
#pragma unroll
    for (int e = 0; e < 4; ++e) { const float c0 = __uint_as_float(zc[e] << 16), c1 = __uint_as_float(zc[e] & 0xffff0000u), p0 = __uint_as_float(zp[e] << 16), p1 = __uint_as_float(zp[e] & 0xffff0000u);
        const float mu0 = (2 * e < 4) ? m0[(2 * e) & 3] : m1[(2 * e) & 3], mu1 = (2 * e + 1 < 4) ? m0[(2 * e + 1) & 3] : m1[(2 * e + 1) & 3];
        o[2 * e] = c0 + (p0 - c0) * mu0; o[2 * e + 1] = c1 + (p1 - c1) * mu1; }
}
typedef _Float16 f16x8 __attribute__((ext_vector_type(8)));
typedef _Float16 f16x4 __attribute__((ext_vector_type(4)));
__device__ __forceinline__ void store8f16(f16* p, const float (&v)[8]) { f16x8 h;
#pragma unroll
    for (int e = 0; e < 8; ++e) h[e] = (f16)v[e];
    *(f16x8*)p = h; }
__device__ __forceinline__ u32x4 pack8bf(const float (&v)[8]) { u32x4 w; w.x = pk2(v[0], v[1]); w.y = pk2(v[2], v[3]); w.z = pk2(v[4], v[5]); w.w = pk2(v[6], v[7]); return w; }


constexpr int PB_LD = 520;
constexpr int PB_BUF = 0, PB_AOP = 64 * PB_LD * 2, PB_VMID = 2 * 64 * PB_LD * 2, PB_LA_LD = 264, PB_VM_LD = 40;
__device__ __forceinline__ void phase_prep_fast(ArgsR a, const Ctx& c, int l) {
    const bf16* ZR = (const bf16*)(a.ws + WS_ZR);
    const float* mu = a.in[I_MU] + l * RC; const float* w0 = a.in[I_W0] + l * W; const float* a0 = a.in[I_A0] + l * W;
    const float* k_k = a.in[I_KK] + l * W; const float* k_a = a.in[I_KA] + l * W; const float* vm0 = a.in[I_VM0];
    f16* R = (f16*)(a.ws + WS_R); f16* WM1 = (f16*)(a.ws + WS_WM1); f16* KP = (f16*)(a.ws + WS_KP); f16* AA = (f16*)(a.ws + WS_AA); f16* BB = (f16*)(a.ws + WS_BB); f16* V = (f16*)(a.ws + WS_V);
    bf16* G = (bf16*)(a.ws + WS_G); bf16* VF = (bf16*)(a.ws + WS_VF);
    const unsigned char* lo = a.ws + WS_LORA + (size_t)l * LO_STRIDE;
    const bf16* W2T = (const bf16*)(lo + LO_W2T); const bf16* A2T = (const bf16*)(lo + LO_A2T); const bf16* G2T = (const bf16*)(lo + LO_G2T);
    const bf16* VM1T = (const bf16*)(lo + LO_VM1T); const bf16* VM2T = (const bf16*)(lo + LO_VM2T);
    LAS3 unsigned char* L = (LAS3 unsigned char*)c.lds;
    const int tid = c.tid, lane = c.lane, wv = c.wave, fr = lane & 15, fq = lane >> 4;
    const int row = tid >> 3, sub_ = tid & 7;
    for (int u = blockIdx.x; u < T / 64; u += gridDim.x) {
        int sub = sub_; asm volatile("" : "+v"(sub));
        const int t0 = u * 64, t = t0 + row;
        if (l == 0) {
#pragma unroll 4
            for (int p = 0; p < 8; ++p) { const int col = p * 64 + sub * 8; float z[8]; zshift8(ZR, t, 1024 + col, mu, z);
                store8f16(V + (size_t)t * W + col, z); *(u32x4*)(VF + (size_t)t * W + col) = pack8bf(z); }
        } else {
#pragma unroll 4
            for (int p = 0; p < 8; ++p) { const int col = p * 64 + sub * 8; float z[8]; zshift8(ZR, t, 1024 + col, mu, z);
                *(LAS3 u32x4*)(L + PB_AOP + (row * PB_LD + col) * 2) = pack8bf(z); }
            __syncthreads();
            { f32x4 acc[1][1]; acc[0][0] = (f32x4){0.f, 0.f, 0.f, 0.f}; const int m = wv >> 1, n = wv & 1;
              mma_lds_glob<1, 1, 16>(c.lds, PB_AOP + 16 * m * PB_LD * 2, PB_LD, VM1T, W, 16 * n, lane, acc);
#pragma unroll
              for (int i = 0; i < 4; ++i) *(LAS3 bf16*)(L + PB_VMID + ((16 * m + 4 * fq + i) * PB_VM_LD + 16 * n + fr) * 2) = f2bf(acc[0][0][i]); }
            __syncthreads();
            { f32x4 acc[4][4];
#pragma unroll
              for (int m = 0; m < 4; ++m)
#pragma unroll
                  for (int n = 0; n < 4; ++n) acc[m][n] = (f32x4){0.f, 0.f, 0.f, 0.f};
              mma_lds_glob<4, 4, 1, true>(c.lds, PB_VMID, PB_VM_LD, VM2T, 32, 64 * wv, lane, acc);
#pragma unroll
              for (int m = 0; m < 4; ++m)
#pragma unroll
                  for (int n = 0; n < 4; ++n) { const int col = 64 * wv + 16 * n + 4 * fq; const f32x4 vb = *(const f32x4*)(vm0 + col); f16x4 hv;
#pragma unroll
                      for (int i = 0; i < 4; ++i) hv[i] = (f16)sigmoidf_(vb[i] + acc[m][n][i]);
                      *(LAS3 f16x4*)(L + PB_BUF + ((16 * m + fr) * PB_LD + col) * 2) = hv; } }
            __syncthreads();
#pragma unroll 4
            for (int p = 0; p < 8; ++p) { const int col = p * 64 + sub * 8;
                const u32x4 vz = *(const LAS3 u32x4*)(L + PB_AOP + (row * PB_LD + col) * 2); const f16x8 gt = *(const LAS3 f16x8*)(L + PB_BUF + (row * PB_LD + col) * 2);
                const u32x4 vfw = *(const u32x4*)(VF + (size_t)t * W + col); float o[8];
#pragma unroll
                for (int e = 0; e < 4; ++e) { const float v0 = __uint_as_float(vz[e] << 16), v1 = __uint_as_float(vz[e] & 0xffff0000u), f0 = __uint_as_float(vfw[e] << 16), f1 = __uint_as_float(vfw[e] & 0xffff0000u);
                    o[2 * e] = v0 + (f0 - v0) * (float)gt[2 * e]; o[2 * e + 1] = v1 + (f1 - v1) * (float)gt[2 * e + 1]; }
                store8f16(V + (size_t)t * W + col, o); }
            __syncthreads();
        }
#pragma unroll 4
        for (int p = 0; p < 4; ++p) { const int cc = sub * 32 + p * 8; float z[8]; zshift8(ZR, t, 1536 + cc, mu, z);
#pragma unroll
            for (int e = 0; e < 8; ++e) z[e] = cc < 64 ? (1.0f - 2.0f * __builtin_amdgcn_rcpf(1.0f + __expf(2.0f * z[e]))) : (cc < 128 ? z[e] : sigmoidf_(z[e]));
            *(LAS3 u32x4*)(L + PB_AOP + (row * PB_LA_LD + cc) * 2) = pack8bf(z); }
        __syncthreads();
        { f32x4 acc[4][4];
#pragma unroll
          for (int m = 0; m < 4; ++m)
#pragma unroll
              for (int n = 0; n < 4; ++n) acc[m][n] = (f32x4){0.f, 0.f, 0.f, 0.f};
          mma_lds_glob<4, 4, 2, true>(c.lds, PB_AOP + 64 * 2, PB_LA_LD, A2T, 64, 64 * wv, lane, acc);
#pragma unroll
          for (int m = 0; m < 4; ++m)
#pragma unroll
              for (int n = 0; n < 4; ++n) { const int col = 64 * wv + 16 * n + 4 * fq; const f32x4 ab = *(const f32x4*)(a0 + col); f16x4 hv;
#pragma unroll
                  for (int i = 0; i < 4; ++i) hv[i] = (f16)sigmoidf_(ab[i] + acc[m][n][i]);
                  *(LAS3 f16x4*)(L + PB_BUF + ((16 * m + fr) * PB_LD + col) * 2) = hv; } }
        __syncthreads();
#pragma unroll 4
        for (int p = 0; p < 8; ++p) { const int col = p * 64 + sub * 8; const size_t o = (size_t)t * W + col;
            float z[8]; zshift8(ZR, t, col, mu, z); store8f16(R + o, z);
            float kz[8]; zshift8(ZR, t, 512 + col, mu, kz);
            const f16x8 av = *(const LAS3 f16x8*)(L + PB_BUF + (row * PB_LD + col) * 2);
            const f32x4 kk0 = *(const f32x4*)(k_k + col), kk1 = *(const f32x4*)(k_k + col + 4), ka0 = *(const f32x4*)(k_a + col), ka1 = *(const f32x4*)(k_a + col + 4);
            float kk[8], kp[8], bb[8]; float ss = 0.f;
#pragma unroll
            for (int e = 0; e < 8; ++e) { const float kkw = e < 4 ? kk0[e & 3] : kk1[e & 3], kaw = e < 4 ? ka0[e & 3] : ka1[e & 3]; kk[e] = kz[e] * kkw; ss += kk[e] * kk[e]; kp[e] = kz[e] * (1.0f + ((float)av[e] - 1.0f) * kaw); }
            ss += __shfl_xor(ss, 1); ss += __shfl_xor(ss, 2); ss += __shfl_xor(ss, 4);
            const float inv = fminf(__builtin_amdgcn_rsqf(ss), 1e12f);
#pragma unroll
            for (int e = 0; e < 8; ++e) { kk[e] *= inv; bb[e] = kk[e] * (float)av[e]; kk[e] = -kk[e]; }
            store8f16(KP + o, kp); store8f16(AA + o, kk); store8f16(BB + o, bb); }
        __syncthreads();
        { f32x4 acc[4][4];
#pragma unroll
          for (int m = 0; m < 4; ++m)
#pragma unroll
              for (int n = 0; n < 4; ++n) acc[m][n] = (f32x4){0.f, 0.f, 0.f, 0.f};
          mma_lds_glob<4, 4, 2, true>(c.lds, PB_AOP, PB_LA_LD, W2T, 64, 64 * wv, lane, acc);
#pragma unroll
          for (int m = 0; m < 4; ++m)
#pragma unroll
              for (int n = 0; n < 4; ++n) { const int col = 64 * wv + 16 * n + 4 * fq; const f32x4 wb = *(const f32x4*)(w0 + col); f16x4 hv;
#pragma unroll
                  for (int i = 0; i < 4; ++i) { const float x = wb[i] + acc[m][n][i]; const float wl = -(fmaxf(-x, 0.f) + __logf(1.0f + __expf(-fabsf(x)))) - 0.5f;
                      hv[i] = (f16)(__expf(-__expf(wl)) - 1.0f); }
                  *(LAS3 f16x4*)(L + PB_BUF + ((16 * m + fr) * PB_LD + col) * 2) = hv; } }
        __syncthreads();
#pragma unroll 4
        for (int p = 0; p < 8; ++p) { const int col = p * 64 + sub * 8; *(u32x4*)(WM1 + (size_t)t * W + col) = *(const LAS3 u32x4*)(L + PB_BUF + (row * PB_LD + col) * 2); }
        __syncthreads();
        { f32x4 acc[4][4];
#pragma unroll
          for (int m = 0; m < 4; ++m)
#pragma unroll
              for (int n = 0; n < 4; ++n) acc[m][n] = (f32x4){0.f, 0.f, 0.f, 0.f};
          mma_lds_glob<4, 4, 4, true>(c.lds, PB_AOP + 128 * 2, PB_LA_LD, G2T, 128, 64 * wv, lane, acc);
#pragma unroll
          for (int m = 0; m < 4; ++m)
#pragma unroll
              for (int n = 0; n < 4; ++n) { const int col = 64 * wv + 16 * n + 4 * fq; u32x2 w; w.x = pk2(acc[m][n][0], acc[m][n][1]); w.y = pk2(acc[m][n][2], acc[m][n][3]);
                  *(LAS3 u32x2*)(L + PB_BUF + ((16 * m + fr) * PB_LD + col) * 2) = w; } }
        __syncthreads();
#pragma unroll 4
        for (int p = 0; p < 8; ++p) { const int col = p * 64 + sub * 8; *(u32x4*)(G + (size_t)t * W + col) = *(const LAS3 u32x4*)(L + PB_BUF + (row * PB_LD + col) * 2); }
        __syncthreads();
    }
}

constexpr int SG_LD = 136;
constexpr int SG_VT = 0, SG_ST = 256 * SG_LD * 2;
__device__ __forceinline__ void phase_sg_fast(ArgsR a, const Ctx& c, int l) {
    const bf16* ZS = (const bf16*)(a.ws + WS_ZS); bf16* YB = (bf16*)(a.ws + WS_YB);
    const float* lng = a.in[I_SGG] + l * W; const float* lnb = a.in[I_SGB] + l * W;
    LAS3 unsigned char* L = (LAS3 unsigned char*)c.lds;
    LAS3 float* st = (LAS3 float*)(L + SG_ST);
    const int tid = c.tid, lane = c.lane, wv = c.wave, fr = lane & 15, fq = lane >> 4;
    for (int u = blockIdx.x; u < 256; u += gridDim.x) {
        const int ch = u >> 1, hf = u & 1, tok0 = ch * 128;
        { u32x4 raw[16];
#pragma unroll
          for (int i = 0; i < 16; ++i) raw[i] = *(const u32x4*)(ZS + (size_t)(tok0 + wv * 16 + i) * 1024 + 512 + lane * 8);
#pragma unroll
          for (int i = 0; i < 16; ++i) { const int sidx = wv * 16 + i; float x[8];
#pragma unroll
              for (int e = 0; e < 4; ++e) { x[2 * e] = __uint_as_float(raw[i][e] << 16); x[2 * e + 1] = __uint_as_float(raw[i][e] & 0xffff0000u); }
              const float sm = ((x[0] + x[1]) + (x[2] + x[3])) + ((x[4] + x[5]) + (x[6] + x[7])); const float mean = wave_sum(sm) * (1.f / 512.f);
              float q = 0.f;
#pragma unroll
              for (int e = 0; e < 8; ++e) { const float d0 = x[e] - mean; q += d0 * d0; }
              const float rstd = __builtin_amdgcn_rsqf(wave_sum(q) * (1.f / 512.f) + LN_EPS);
              if (lane == 0) { st[2 * sidx] = mean; st[2 * sidx + 1] = rstd; } } }
        __syncthreads();
        { const int sidx = tid >> 2, q4 = tid & 3; const float mean = st[2 * sidx], rstd = st[2 * sidx + 1];
#pragma unroll
          for (int p = 0; p < 8; ++p) { const int cl = q4 * 64 + p * 8; const int cg = hf * 256 + cl;
              const bf16* src = ZS + (size_t)(tok0 + sidx) * 1024 + 512 + cg; const f32x4 x0 = load4bf(src), x1 = load4bf(src + 4);
              const f32x4 g0 = *(const f32x4*)(lng + cg), g1 = *(const f32x4*)(lng + cg + 4), b0 = *(const f32x4*)(lnb + cg), b1 = *(const f32x4*)(lnb + cg + 4);
#pragma unroll
              for (int e = 0; e < 8; ++e) { const float x = e < 4 ? x0[e & 3] : x1[e & 3], gg = e < 4 ? g0[e & 3] : g1[e & 3], bb = e < 4 ? b0[e & 3] : b1[e & 3];
                  *(LAS3 bf16*)(L + SG_VT + ((cl + e) * SG_LD + sidx) * 2) = f2bf((x - mean) * rstd * gg + bb); } } }
        __syncthreads();
        const int gl = wv >> 1, dh = wv & 1, g = hf * 4 + gl;
        const float* Wg = a.in[I_WS] + (size_t)(l * 8 + g) * 128 * 128; const float* bs = a.in[I_BS] + (size_t)(l * 8 + g) * 128;
        f32x4 acc[8][2];
#pragma unroll
        for (int m = 0; m < 8; ++m) { acc[m][0] = (f32x4){0.f, 0.f, 0.f, 0.f}; acc[m][1] = (f32x4){0.f, 0.f, 0.f, 0.f}; }
#pragma unroll
        for (int ks = 0; ks < 4; ++ks) {
            bf16x8 b[2];
#pragma unroll
            for (int n = 0; n < 2; ++n) b[n] = *(const LAS3 bf16x8*)(L + SG_VT + ((gl * 64 + dh * 32 + 16 * n + fr) * SG_LD + 32 * ks + 8 * fq) * 2);
#pragma unroll
            for (int m = 0; m < 8; ++m) { if (32 * ks <= 16 * m + 15) {
                const int trow = 16 * m + fr, s0 = 32 * ks + 8 * fq;
                const f32x4 w0v = *(const f32x4*)(Wg + trow * 128 + s0), w1v = *(const f32x4*)(Wg + trow * 128 + s0 + 4);
                float wf[8];
#pragma unroll
                for (int e = 0; e < 8; ++e) { const float wval = e < 4 ? w0v[e & 3] : w1v[e & 3]; wf[e] = (s0 + e <= trow) ? wval : 0.f; }
                const u32x4 wp = pack8bf(wf); const bf16x8 av = __builtin_bit_cast(bf16x8, wp);
                acc[m][0] = __builtin_amdgcn_mfma_f32_16x16x32_bf16(b[0], av, acc[m][0], 0, 0, 0);
                acc[m][1] = __builtin_amdgcn_mfma_f32_16x16x32_bf16(b[1], av, acc[m][1], 0, 0, 0); } }
        }
#pragma unroll
        for (int m = 0; m < 8; ++m) { const int trow = 16 * m + fr; const float bsv = bs[trow];
#pragma unroll
            for (int n = 0; n < 2; ++n) { const int col = g * 64 + dh * 32 + 16 * n + 4 * fq; const f32x4 uu = load4bf(ZS + (size_t)(tok0 + trow) * 1024 + col);
                store4bf(YB + (size_t)(tok0 + trow) * W + col, uu * (acc[m][n] + bsv)); } }
        __syncthreads();
    }
}

__device__ __forceinline__ void phase_scan_simple(ArgsR a, const Ctx& c) {
    if (c.wave != 0 || blockIdx.x >= NH) return;
    const int h = blockIdx.x, lane = c.lane;
    const f16* R = (const f16*)(a.ws + WS_R); const f16* WM1 = (const f16*)(a.ws + WS_WM1); const f16* KP = (const f16*)(a.ws + WS_KP);
    const f16* AA = (const f16*)(a.ws + WS_AA); const f16* BB = (const f16*)(a.ws + WS_BB); const f16* V = (const f16*)(a.ws + WS_V);
    bf16* YSC = (bf16*)(a.ws + WS_YSC);
    float S[64];
#pragma unroll
    for (int j = 0; j < 64; ++j) S[j] = 0.f;
    for (int t = 0; t < T; ++t) {
        const size_t base = (size_t)t * W + h * 64;
        const float vv = (float)V[base + lane];
        float sa = 0.f;
#pragma unroll
        for (int j = 0; j < 64; ++j) sa += S[j] * (float)AA[base + j];
        float y = 0.f;
#pragma unroll
        for (int j = 0; j < 64; ++j) { float s = S[j]; s = s + s * (float)WM1[base + j]; s += sa * (float)BB[base + j]; s += vv * (float)KP[base + j]; S[j] = s; y += s * (float)R[base + j]; }
        YSC[base + lane] = f2bf(y);
    }
}

typedef unsigned u32x16 __attribute__((ext_vector_type(16)));
__device__ __forceinline__ void sload32(const void* p0, u32x16& a0, u32x16& a1) {
    asm volatile("s_load_dwordx16 %0, %2, 0x0 glc\n\ts_load_dwordx16 %1, %2, 0x40 glc\n\ts_waitcnt lgkmcnt(0)" : "=&s"(a0), "=&s"(a1) : "s"(p0) : "memory");
}
__device__ __forceinline__ void sload64(const void* p0, const void* p1, u32x16& a0, u32x16& a1, u32x16& b0, u32x16& b1) {
    asm volatile("s_load_dwordx16 %0, %4, 0x0 glc\n\ts_load_dwordx16 %1, %4, 0x40 glc\n\ts_load_dwordx16 %2, %5, 0x0 glc\n\ts_load_dwordx16 %3, %5, 0x40 glc\n\ts_waitcnt lgkmcnt(0)"
                 : "=&s"(a0), "=&s"(a1), "=&s"(b0), "=&s"(b1) : "s"(p0), "s"(p1) : "memory");
}
__device__ __forceinline__ float fmix_lo(unsigned sd, float x, float y) { float d; asm("v_fma_mix_f32 %0, %1, %2, %3 op_sel_hi:[1,0,0]" : "=v"(d) : "s"(sd), "v"(x), "v"(y)); return d; }
__device__ __forceinline__ float fmix_hi(unsigned sd, float x, float y) { float d; asm("v_fma_mix_f32 %0, %1, %2, %3 op_sel:[1,0,0] op_sel_hi:[1,0,0]" : "=v"(d) : "s"(sd), "v"(x), "v"(y)); return d; }
constexpr int CL = 64, NCH = T / CL;
constexpr size_t ST_Q_OFF = (size_t)NH * NCH * 64 * 64;
constexpr size_t ST_S_OFF = (size_t)NH * NCH * 64 * 64;

__device__ __forceinline__ float vmix_lo(unsigned vd, float x, float y) { float d; asm("v_fma_mix_f32 %0, %1, %2, %3 op_sel_hi:[1,0,0]" : "=v"(d) : "v"(vd), "v"(x), "v"(y)); return d; }
__device__ __forceinline__ float vmix_hi(unsigned vd, float x, float y) { float d; asm("v_fma_mix_f32 %0, %1, %2, %3 op_sel:[1,0,0] op_sel_hi:[1,0,0]" : "=v"(d) : "v"(vd), "v"(x), "v"(y)); return d; }
template <int N> __device__ __forceinline__ void fmac_bc(float& acc, float vec, float x) { asm("v_fmac_f32_dpp %0, %1, %2 row_newbcast:%3 row_mask:0xf bank_mask:0xf" : "+v"(acc) : "v"(vec), "v"(x), "n"(N)); }
template <int N> __device__ __forceinline__ float mul_bc(float vec, float x) { float d; asm("v_mul_f32_dpp %0, %1, %2 row_newbcast:%3 row_mask:0xf bank_mask:0xf" : "=v"(d) : "v"(vec), "v"(x), "n"(N)); return d; }
struct SVec { float v[4]; };
__device__ __forceinline__ f16x4 sv_read(const LAS3 unsigned char* p, int lane) { return *(const LAS3 f16x4*)(p + (lane & 15) * 8); }
__device__ __forceinline__ void sv_cvt(SVec& o, f16x4 h) { o.v[0] = (float)h[0]; o.v[1] = (float)h[1]; o.v[2] = (float)h[2]; o.v[3] = (float)h[3]; }
__device__ __forceinline__ void sv_cvt1p(SVec& o, f16x4 h) { o.v[0] = 1.0f + (float)h[0]; o.v[1] = 1.0f + (float)h[1]; o.v[2] = 1.0f + (float)h[2]; o.v[3] = 1.0f + (float)h[3]; }
template <int J> __device__ __forceinline__ void sc_dot(float (&d)[4], const SVec& A, const float (&X)[64]) { fmac_bc<(J >> 2)>(d[J & 3], A.v[J & 3], X[J]); if constexpr (J + 1 < 64) sc_dot<J + 1>(d, A, X); }
template <int J> __device__ __forceinline__ void sc_upd3(float (&S)[64], float (&y)[4], const SVec& Wv, const SVec& Bv, const SVec& Kv, const SVec& Rv, float sa, float vv) {
    float sj = mul_bc<(J >> 2)>(Wv.v[J & 3], S[J]); fmac_bc<(J >> 2)>(sj, Bv.v[J & 3], sa); fmac_bc<(J >> 2)>(sj, Kv.v[J & 3], vv); S[J] = sj; fmac_bc<(J >> 2)>(y[J & 3], Rv.v[J & 3], sj);
    if constexpr (J + 1 < 64) sc_upd3<J + 1>(S, y, Wv, Bv, Kv, Rv, sa, vv); }
template <int J> __device__ __forceinline__ void sc_upd1(float (&Q)[64], float (&P)[64], const SVec& Wv, const SVec& Bv, const SVec& Kv, float saq, float sap, float vv) {
    float qj = mul_bc<(J >> 2)>(Wv.v[J & 3], Q[J]); fmac_bc<(J >> 2)>(qj, Bv.v[J & 3], saq); fmac_bc<(J >> 2)>(qj, Kv.v[J & 3], vv); Q[J] = qj;
    float pj = mul_bc<(J >> 2)>(Wv.v[J & 3], P[J]); fmac_bc<(J >> 2)>(pj, Bv.v[J & 3], sap); P[J] = pj;
    if constexpr (J + 1 < 64) sc_upd1<J + 1>(Q, P, Wv, Bv, Kv, saq, sap, vv); }
constexpr int SCB = 8;
constexpr int SC_NS = 7, SC_BUF = SC_NS * 1024, SC_WAVE = 2 * SC_BUF;
__device__ __forceinline__ void sc_dma(const f16* X, size_t eoff, LAS3 unsigned char* dst) {
    __builtin_amdgcn_global_load_lds((const unsigned*)(X + eoff), (LAS3 unsigned*)dst, 16, 0, 0);
}

__device__ __forceinline__ void phase_scan1(ArgsR a, const Ctx& c) {
    const f16* WM1 = (const f16*)(a.ws + WS_WM1); const f16* KP = (const f16*)(a.ws + WS_KP);
    const f16* AA = (const f16*)(a.ws + WS_AA); const f16* BB = (const f16*)(a.ws + WS_BB); const f16* V = (const f16*)(a.ws + WS_V);
    float* ST = (float*)(a.ws + WS_ST);
    const int lane = c.lane;
    LAS3 unsigned char* ring = (LAS3 unsigned char*)c.lds + c.wave * SC_WAVE;
    for (int item = c.gw; item < NH * NCH; item += c.ngw) {
        const int h = __builtin_amdgcn_readfirstlane(item / NCH), ch = __builtin_amdgcn_readfirstlane(item % NCH);
        float Q[64], P[64];
        int ln_ = lane; asm volatile("" : "+v"(ln_));
#pragma unroll
        for (int j = 0; j < 64; ++j) { Q[j] = 0.f; P[j] = (j == ln_) ? 1.f : 0.f; }
        const size_t lane_off = (size_t)(lane >> 3) * W + h * 64 + (lane & 7) * 8;
        { const size_t e0 = (size_t)(ch * CL) * W + lane_off;
          sc_dma(AA, e0, ring); sc_dma(WM1, e0, ring + 1024); sc_dma(BB, e0, ring + 2048); sc_dma(KP, e0, ring + 3072); sc_dma(V, e0, ring + 4096); }
#pragma unroll 1
        for (int blk = 0; blk < CL / SCB; ++blk) {
            LAS3 unsigned char* buf = ring + (blk & 1) * SC_BUF;
            if (blk + 1 < CL / SCB) { LAS3 unsigned char* nb = ring + ((blk + 1) & 1) * SC_BUF; const size_t e0 = (size_t)(ch * CL + (blk + 1) * SCB) * W + lane_off;
                sc_dma(AA, e0, nb); sc_dma(WM1, e0, nb + 1024); sc_dma(BB, e0, nb + 2048); sc_dma(KP, e0, nb + 3072); sc_dma(V, e0, nb + 4096);
                asm volatile("s_waitcnt vmcnt(5)" ::: "memory"); }
            else asm volatile("s_waitcnt vmcnt(0)" ::: "memory");
            SVec A, Wv, Bv, Kv;
            sv_cvt(A, sv_read(buf, lane)); sv_cvt1p(Wv, sv_read(buf + 1024, lane)); sv_cvt(Bv, sv_read(buf + 2048, lane)); sv_cvt(Kv, sv_read(buf + 3072, lane));
            float vv = (float)*(const LAS3 f16*)(buf + 4096 + lane * 2);
#pragma unroll 1
            for (int st = 0; st < SCB; ++st) {
                const LAS3 unsigned char* sn = buf + ((st + 1 < SCB) ? st + 1 : st) * 128;
                const f16x4 ha = sv_read(sn, lane), hw = sv_read(sn + 1024, lane), hb = sv_read(sn + 2048, lane), hk = sv_read(sn + 3072, lane);
                const f16 hv = *(const LAS3 f16*)(sn + 4096 + lane * 2);
                float dq[4] = {0.f, 0.f, 0.f, 0.f}, dp[4] = {0.f, 0.f, 0.f, 0.f};
                sc_dot<0>(dq, A, Q); sc_dot<0>(dp, A, P);
                const float saq = (dq[0] + dq[1]) + (dq[2] + dq[3]), sap = (dp[0] + dp[1]) + (dp[2] + dp[3]);
                sc_upd1<0>(Q, P, Wv, Bv, Kv, saq, sap, vv);
                sv_cvt(A, ha); sv_cvt1p(Wv, hw); sv_cvt(Bv, hb); sv_cvt(Kv, hk); vv = (float)hv;
            }
        }
        float* Qp = ST + ST_Q_OFF + (size_t)(h * NCH + ch) * 4096 + lane;
        bf16* PTp = (bf16*)ST + (size_t)(h * NCH + ch) * 4096 + lane;
#pragma unroll
        for (int j = 0; j < 64; ++j) { PTp[j * 64] = f2bf(P[j]); Qp[j * 64] = Q[j]; }
    }
}
constexpr int GS = 16, NG = NCH / GS;
constexpr size_t ST_LP_OFF = (size_t)NH * NCH * 4096;
constexpr size_t WS_SG = WS_LORA + 2 * MiB;
constexpr int HI_LD = 72, HI_BYTES = 64 * HI_LD * 2;
struct HFrag { bf16x8 b[2][2]; f32x4 q[2]; };
__device__ __forceinline__ void hload(HFrag& f, const bf16* Bt, const float* QTc, int boff, int qtoff) {
#pragma unroll
    for (int ks = 0; ks < 2; ++ks)
#pragma unroll
        for (int n = 0; n < 2; ++n) f.b[ks][n] = *(const bf16x8*)(Bt + boff + 16 * n * 64 + 32 * ks);
#pragma unroll
    for (int n = 0; n < 2; ++n) f.q[n] = *(const f32x4*)(QTc + qtoff + 16 * n * 64);
}
__device__ __forceinline__ void hmma(const LAS3 unsigned char* img, const bf16x8 (&b)[2][2], f32x4 (&acc)[2], int m, int fr, int fq) {
#pragma unroll
    for (int ks = 0; ks < 2; ++ks) { const bf16x8 av = *(const LAS3 bf16x8*)(img + ((16 * m + fr) * HI_LD + 32 * ks + 8 * fq) * 2);
#pragma unroll
        for (int n = 0; n < 2; ++n) acc[n] = __builtin_amdgcn_mfma_f32_16x16x32_bf16(av, b[ks][n], acc[n], 0, 0, 0); }
}
__device__ __forceinline__ void himg_store(LAS3 unsigned char* img, const f32x4 (&acc)[2], int m, int n0, int fr, int fq) {
#pragma unroll
    for (int n = 0; n < 2; ++n)
#pragma unroll
        for (int i = 0; i < 4; ++i) *(LAS3 bf16*)(img + ((16 * m + 4 * fq + i) * HI_LD + n0 + 16 * n + fr) * 2) = f2bf(acc[n][i]);
}
#define HBAR() do { asm volatile("s_waitcnt lgkmcnt(0)" ::: "memory"); __builtin_amdgcn_s_barrier(); asm volatile("" ::: "memory"); } while (0)

__device__ __forceinline__ void sc2a_step(const HFrag& f, bf16* LpTc, float* QTc, const LAS3 unsigned char* ip, LAS3 unsigned char* ipn, const LAS3 unsigned char* iq, LAS3 unsigned char* iqn, int m, int n0, int fr, int fq, int qtoff) {
    f32x4 ap[2], aq[2];
#pragma unroll
    for (int n = 0; n < 2; ++n) { ap[n] = (f32x4){0.f, 0.f, 0.f, 0.f}; aq[n] = f.q[n]; }
    hmma(ip, f.b, ap, m, fr, fq); hmma(iq, f.b, aq, m, fr, fq);
#pragma unroll
    for (int n = 0; n < 2; ++n) { u32x2 w; w.x = pk2(ap[n][0], ap[n][1]); w.y = pk2(ap[n][2], ap[n][3]);
        *(u32x2*)(LpTc + (n0 + 16 * n + fr) * 64 + 16 * m + 4 * fq) = w;
        *(f32x4*)(QTc + qtoff + 16 * n * 64) = aq[n]; }
    himg_store(ipn, ap, m, n0, fr, fq); himg_store(iqn, aq, m, n0, fr, fq);
    HBAR();
}
__device__ __forceinline__ void phase_scan2a(ArgsR a, const Ctx& c) {
    const int lane = c.lane, wv = c.wave, fr = lane & 15, fq = lane >> 4, m = wv >> 1, n0 = 32 * (wv & 1);
    const int boff = (n0 + fr) * 64 + 8 * fq, qtoff = (n0 + fr) * 64 + 16 * m + 4 * fq;
    LAS3 unsigned char* L = (LAS3 unsigned char*)c.lds;
    for (int item = blockIdx.x; item < NH * NG; item += gridDim.x) {
        const size_t cb = (size_t)(item / NG) * NCH + (size_t)(item % NG) * GS;
        const bf16* PT = (const bf16*)(a.ws + WS_ST) + cb * 4096; bf16* LP = (bf16*)(a.ws + WS_ST) + ST_LP_OFF + cb * 4096; float* QT = (float*)(a.ws + WS_ST) + ST_Q_OFF + cb * 4096;
        for (int i = c.tid; i < 4 * HI_BYTES / 4; i += NTHREADS) ((LAS3 unsigned*)L)[i] = 0u;
        __syncthreads();
        if (c.tid < 64) *(LAS3 bf16*)(L + (c.tid * HI_LD + c.tid) * 2) = (bf16)0x3F80;
        __syncthreads();
        HFrag f0, f1, f2, f3;
        hload(f0, PT, QT, boff, qtoff); hload(f1, PT + 4096, QT + 4096, boff, qtoff); hload(f2, PT + 2 * 4096, QT + 2 * 4096, boff, qtoff); hload(f3, PT + 3 * 4096, QT + 3 * 4096, boff, qtoff);
        LAS3 unsigned char* p0 = L; LAS3 unsigned char* p1 = L + HI_BYTES; LAS3 unsigned char* q0 = L + 2 * HI_BYTES; LAS3 unsigned char* q1 = L + 3 * HI_BYTES;
#pragma unroll 1
        for (int i = 0; i < GS; i += 4) {
            const int nx = (i + 4 < GS) ? i + 4 : i;
            sc2a_step(f0, LP + (size_t)(i + 0) * 4096, QT + (size_t)(i + 0) * 4096, p0, p1, q0, q1, m, n0, fr, fq, qtoff); hload(f0, PT + (size_t)(nx + 0) * 4096, QT + (size_t)(nx + 0) * 4096, boff, qtoff);
            sc2a_step(f1, LP + (size_t)(i + 1) * 4096, QT + (size_t)(i + 1) * 4096, p1, p0, q1, q0, m, n0, fr, fq, qtoff); hload(f1, PT + (size_t)(nx + 1) * 4096, QT + (size_t)(nx + 1) * 4096, boff, qtoff);
            sc2a_step(f2, LP + (size_t)(i + 2) * 4096, QT + (size_t)(i + 2) * 4096, p0, p1, q0, q1, m, n0, fr, fq, qtoff); hload(f2, PT + (size_t)(nx + 2) * 4096, QT + (size_t)(nx + 2) * 4096, boff, qtoff);
            sc2a_step(f3, LP + (size_t)(i + 3) * 4096, QT + (size_t)(i + 3) * 4096, p1, p0, q1, q0, m, n0, fr, fq, qtoff); hload(f3, PT + (size_t)(nx + 3) * 4096, QT + (size_t)(nx + 3) * 4096, boff, qtoff);
        }
        __syncthreads();
    }
}
__device__ __forceinline__ void phase_scan2b(ArgsR a, const Ctx& c) {
    if (blockIdx.x >= NH) return;
    const int h = blockIdx.x, lane = c.lane, wv = c.wave, fr = lane & 15, fq = lane >> 4, m = wv >> 1, n0 = 32 * (wv & 1);
    const int boff = (n0 + fr) * 64 + 8 * fq, qtoff = (n0 + fr) * 64 + 16 * m + 4 * fq;
    LAS3 unsigned char* L = (LAS3 unsigned char*)c.lds;
    const bf16* LP = (const bf16*)(a.ws + WS_ST) + ST_LP_OFF + (size_t)h * NCH * 4096; const float* QT = (const float*)(a.ws + WS_ST) + ST_Q_OFF + (size_t)h * NCH * 4096;
    bf16* SG = (bf16*)(a.ws + WS_SG) + (size_t)h * NG * 4096;
    for (int i = c.tid; i < 2 * HI_BYTES / 4; i += NTHREADS) ((LAS3 unsigned*)L)[i] = 0u;
    for (int i = c.tid; i < 4096 / 2; i += NTHREADS) ((LAS3 unsigned*)(L + 2 * HI_BYTES))[i] = 0u;
    __syncthreads();
    HFrag f0, f1, f2, f3;
#define SC2B_CH(g) ((size_t)((g) * GS + GS - 1) * 4096)
    hload(f0, LP + SC2B_CH(0), QT + SC2B_CH(0), boff, qtoff); hload(f1, LP + SC2B_CH(1), QT + SC2B_CH(1), boff, qtoff); hload(f2, LP + SC2B_CH(2), QT + SC2B_CH(2), boff, qtoff); hload(f3, LP + SC2B_CH(3), QT + SC2B_CH(3), boff, qtoff);
    LAS3 unsigned char* i0 = L; LAS3 unsigned char* i1 = L + HI_BYTES;
#define SC2B_STEP(f, g, ic, in) do { f32x4 acc[2] = {f.q[0], f.q[1]}; hmma(ic, f.b, acc, m, fr, fq); LAS3 bf16* So = (LAS3 bf16*)(L + 2 * HI_BYTES) + (((g) + 1) & 7) * 4096; \
        _Pragma("unroll") for (int n = 0; n < 2; ++n) _Pragma("unroll") for (int i = 0; i < 4; ++i) So[(16 * m + 4 * fq + i) * 64 + n0 + 16 * n + fr] = f2bf(acc[n][i]); \
        himg_store(in, acc, m, n0, fr, fq); HBAR(); } while (0)
#pragma unroll 1
    for (int g = 0; g < NG; g += 4) {
        const int nx = (g + 4 < NG) ? g + 4 : g;
        SC2B_STEP(f0, g + 0, i0, i1); hload(f0, LP + SC2B_CH(nx + 0), QT + SC2B_CH(nx + 0), boff, qtoff);
        SC2B_STEP(f1, g + 1, i1, i0); hload(f1, LP + SC2B_CH(nx + 1), QT + SC2B_CH(nx + 1), boff, qtoff);
        SC2B_STEP(f2, g + 2, i0, i1); hload(f2, LP + SC2B_CH(nx + 2), QT + SC2B_CH(nx + 2), boff, qtoff);
        if ((g & 7) == 4) {
            for (int i = c.tid; i < 8 * 4096 / 8; i += NTHREADS) ((u32x4*)(SG + (size_t)(g >> 3) * 8 * 4096))[i] = ((const LAS3 u32x4*)(L + 2 * HI_BYTES))[i];
            HBAR(); }
        if (g + 3 < NG - 1) SC2B_STEP(f3, g + 3, i1, i0);
        hload(f3, LP + SC2B_CH(nx + 3), QT + SC2B_CH(nx + 3), boff, qtoff);
    }
#undef SC2B_STEP
#undef SC2B_CH
}
__device__ __forceinline__ void phase_scan2c(ArgsR a, const Ctx& c) {
    const int lane = c.lane, wv = c.wave, fr = lane & 15, fq = lane >> 4, m = wv >> 1, n0 = 32 * (wv & 1);
    const int boff = (n0 + fr) * 64 + 8 * fq, qtoff = (n0 + fr) * 64 + 16 * m + 4 * fq;
    LAS3 unsigned char* L = (LAS3 unsigned char*)c.lds;
    for (int item = blockIdx.x; item < NH * NG * 2; item += gridDim.x) {
        const int hg = item >> 1, hf = item & 1;
        const size_t cb = (size_t)(hg / NG) * NCH + (size_t)(hg % NG) * GS + hf * 8;
        const bf16* LP = (const bf16*)(a.ws + WS_ST) + ST_LP_OFF + cb * 4096; const float* QT = (const float*)(a.ws + WS_ST) + ST_Q_OFF + cb * 4096; bf16* SS = (bf16*)(a.ws + WS_ST) + cb * 4096;
        { const u32x4 v = *(const u32x4*)((const bf16*)(a.ws + WS_SG) + (size_t)hg * 4096 + c.tid * 8); *(LAS3 u32x4*)(L + ((c.tid >> 3) * HI_LD + (c.tid & 7) * 8) * 2) = v; }
        __syncthreads();
#pragma unroll 2
        for (int i = 0; i < 8; ++i) { HFrag f; hload(f, LP + (size_t)i * 4096, QT + (size_t)i * 4096, boff, qtoff);
            f32x4 acc[2] = {f.q[0], f.q[1]}; hmma(L, f.b, acc, m, fr, fq); bf16* So = SS + (size_t)i * 4096;
#pragma unroll
            for (int n = 0; n < 2; ++n)
#pragma unroll
                for (int k = 0; k < 4; ++k) So[(16 * m + 4 * fq + k) * 64 + n0 + 16 * n + fr] = f2bf(acc[n][k]); }
        __syncthreads();
    }
}
constexpr int WI_LD = 72, WI_B = 64 * WI_LD * 2, WI_GAM = 9 * WI_B, WI_GL = 15 * WI_B;
constexpr size_t WS_GM0 = 352 * MiB, WS_GM1 = 212 * MiB, WS_Y0 = 336 * MiB, WS_END2 = 360 * MiB;
__device__ __forceinline__ bf16* gm_ptr(unsigned char* ws, int h, int ch) { return (bf16*)(ws + (h < 4 ? WS_GM0 : WS_GM1)) + (size_t)((h & 3) * NCH + ch) * 4096; }
__device__ __forceinline__ void wi_mma(f32x4 (&acc)[2], const LAS3 unsigned char* A, const LAS3 unsigned char* Bt, int m, int n0, int fr, int fq) {
#pragma unroll
    for (int ks = 0; ks < 2; ++ks) { const bf16x8 av = *(const LAS3 bf16x8*)(A + ((16 * m + fr) * WI_LD + 32 * ks + 8 * fq) * 2);
#pragma unroll
        for (int n = 0; n < 2; ++n) { const bf16x8 bv = *(const LAS3 bf16x8*)(Bt + ((n0 + 16 * n + fr) * WI_LD + 32 * ks + 8 * fq) * 2); acc[n] = __builtin_amdgcn_mfma_f32_16x16x32_bf16(av, bv, acc[n], 0, 0, 0); } }
}
struct WiA { bf16x8 a[2]; }; struct WiB { bf16x8 b[2][2]; };
__device__ __forceinline__ void wi_lda(WiA& f, const LAS3 unsigned char* A, int m, int fr, int fq) {
#pragma unroll
    for (int ks = 0; ks < 2; ++ks) f.a[ks] = *(const LAS3 bf16x8*)(A + ((16 * m + fr) * WI_LD + 32 * ks + 8 * fq) * 2);
}
__device__ __forceinline__ void wi_ldb(WiB& f, const LAS3 unsigned char* Bt, int n0, int fr, int fq) {
#pragma unroll
    for (int ks = 0; ks < 2; ++ks)
#pragma unroll
        for (int n = 0; n < 2; ++n) f.b[ks][n] = *(const LAS3 bf16x8*)(Bt + ((n0 + 16 * n + fr) * WI_LD + 32 * ks + 8 * fq) * 2);
}
__device__ __forceinline__ void wi_fma(f32x4 (&acc)[2], const WiA& A, const WiB& B) {
#pragma unroll
    for (int ks = 0; ks < 2; ++ks)
#pragma unroll
        for (int n = 0; n < 2; ++n) acc[n] = __builtin_amdgcn_mfma_f32_16x16x32_bf16(A.a[ks], B.b[ks][n], acc[n], 0, 0, 0);
}
__device__ __forceinline__ void wi_fma_s(f32x4 (&acc)[2], const WiA& A, const WiB& B) {
#pragma unroll
    for (int ks = 0; ks < 2; ++ks)
#pragma unroll
        for (int n = 0; n < 2; ++n) acc[n] = __builtin_amdgcn_mfma_f32_16x16x32_bf16(B.b[ks][n], A.a[ks], acc[n], 0, 0, 0);
}
__device__ __forceinline__ void wi_st_nat_s(LAS3 unsigned char* X, const f32x4 (&acc)[2], int m, int n0, int fr, int fq) {
#pragma unroll
    for (int n = 0; n < 2; ++n) { u32x2 w; w.x = pk2(acc[n][0], acc[n][1]); w.y = pk2(acc[n][2], acc[n][3]); *(LAS3 u32x2*)(X + ((16 * m + fr) * WI_LD + n0 + 16 * n + 4 * fq) * 2) = w; }
}
__device__ __forceinline__ void wi_ld_nat_s(f32x4 (&acc)[2], const LAS3 unsigned char* X, int m, int n0, int fr, int fq) {
#pragma unroll
    for (int n = 0; n < 2; ++n) { const u32x2 w = *(const LAS3 u32x2*)(X + ((16 * m + fr) * WI_LD + n0 + 16 * n + 4 * fq) * 2);
        acc[n][0] = __uint_as_float(w.x << 16); acc[n][1] = __uint_as_float(w.x & 0xffff0000u); acc[n][2] = __uint_as_float(w.y << 16); acc[n][3] = __uint_as_float(w.y & 0xffff0000u); }
}
__device__ __forceinline__ void wi_ld_tr(f32x4 (&acc)[2], const LAS3 unsigned char* XT, int m, int n0, int fr, int fq) {
#pragma unroll
    for (int n = 0; n < 2; ++n) { const u32x2 w = *(const LAS3 u32x2*)(XT + ((n0 + 16 * n + fr) * WI_LD + 16 * m + 4 * fq) * 2);
        acc[n][0] = __uint_as_float(w.x << 16); acc[n][1] = __uint_as_float(w.x & 0xffff0000u); acc[n][2] = __uint_as_float(w.y << 16); acc[n][3] = __uint_as_float(w.y & 0xffff0000u); }
}
#define WI_PIN() __builtin_amdgcn_sched_barrier(0)
__device__ __forceinline__ void wi_st_nat(LAS3 unsigned char* X, const f32x4 (&acc)[2], int m, int n0, int fr, int fq) {
#pragma unroll
    for (int n = 0; n < 2; ++n)
#pragma unroll
        for (int i = 0; i < 4; ++i) *(LAS3 bf16*)(X + ((16 * m + 4 * fq + i) * WI_LD + n0 + 16 * n + fr) * 2) = f2bf(acc[n][i]);
}
__device__ __forceinline__ void wi_st_tr(LAS3 unsigned char* XT, const f32x4 (&acc)[2], int m, int n0, int fr, int fq) {
#pragma unroll
    for (int n = 0; n < 2; ++n) { u32x2 w; w.x = pk2(acc[n][0], acc[n][1]); w.y = pk2(acc[n][2], acc[n][3]); *(LAS3 u32x2*)(XT + ((n0 + 16 * n + fr) * WI_LD + 16 * m + 4 * fq) * 2) = w; }
}
__device__ __forceinline__ void wi_ld_nat(f32x4 (&acc)[2], const LAS3 unsigned char* X, int m, int n0, int fr, int fq) {
#pragma unroll
    for (int n = 0; n < 2; ++n)
#pragma unroll
        for (int i = 0; i < 4; ++i) acc[n][i] = bf2f(*(const LAS3 bf16*)(X + ((16 * m + 4 * fq + i) * WI_LD + n0 + 16 * n + fr) * 2));
}
__device__ __forceinline__ void phase_scan1m(ArgsR a, const Ctx& c, const int skip = 0) {
    const f16* WM1 = (const f16*)(a.ws + WS_WM1); const f16* KP = (const f16*)(a.ws + WS_KP);
    const f16* AA = (const f16*)(a.ws + WS_AA); const f16* BB = (const f16*)(a.ws + WS_BB); const f16* V = (const f16*)(a.ws + WS_V); const f16* R = (const f16*)(a.ws + WS_R);
    float* ST = (float*)(a.ws + WS_ST);
    LAS3 unsigned char* L = (LAS3 unsigned char*)c.lds;
    LAS3 float* GAM = (LAS3 float*)(L + WI_GAM); LAS3 float* GL = (LAS3 float*)(L + WI_GL);
    const int lane = c.lane, wv = c.wave, fr = lane & 15, fq = lane >> 4, m = wv >> 1, n0 = 32 * (wv & 1), tid = c.tid;
#define SLOT(i) (L + (i) * WI_B)
    const int t = tid >> 3, cc = (tid & 7) * 8;
    f16x8 pav, pbv, pkv, pvv, prv, pwv;
#define WI_FETCH(it) do { const int h_ = (it) / NCH, ch_ = (it) % NCH; const size_t eo_ = (size_t)(ch_ * CL + t) * W + h_ * 64 + cc; \
        pav = *(const f16x8*)(AA + eo_); pbv = *(const f16x8*)(BB + eo_); pkv = *(const f16x8*)(KP + eo_); pvv = *(const f16x8*)(V + eo_); prv = *(const f16x8*)(R + eo_); pwv = *(const f16x8*)(WM1 + eo_); } while (0)
    if (blockIdx.x < NH * NCH) WI_FETCH(blockIdx.x);
    for (int item = blockIdx.x; item < NH * NCH; item += gridDim.x) {
        const int h = item / NCH, ch = item % NCH;
        const f16x8 av = pav, bv = pbv, kv = pkv, vv = pvv, rv = prv, wv8 = pwv;
        if (item + (int)gridDim.x < NH * NCH) WI_FETCH(item + (int)gridDim.x);
        float g[8], gp[8];
        { float wloc[8];
#pragma unroll
          for (int e = 0; e < 8; ++e) wloc[e] = 1.0f + (float)wv8[e];
#pragma unroll
          for (int e = 0; e < 8; ++e) { float x = wloc[e];
              { const float y = __shfl_up(x, 8); if (lane >= 8) x *= y; } { const float y = __shfl_up(x, 16); if (lane >= 16) x *= y; } { const float y = __shfl_up(x, 32); if (lane >= 32) x *= y; }
              g[e] = x; }
          if (lane >= 56) {
#pragma unroll
              for (int e = 0; e < 8; ++e) GAM[wv * 64 + cc + e] = g[e]; }
          HBAR();
#pragma unroll
          for (int e = 0; e < 8; ++e) { float pre = 1.0f;
#pragma unroll
              for (int w = 0; w < 7; ++w) if (w < wv) pre *= GAM[w * 64 + cc + e];
              g[e] *= pre; gp[e] = g[e] * __builtin_amdgcn_rcpf(wloc[e]); } }
        { float fa[8], fb[8], fk[8], fv[8], frr[8];
#pragma unroll
          for (int e = 0; e < 8; ++e) { const float ig = __builtin_amdgcn_rcpf(g[e]);
              fa[e] = (float)av[e] * gp[e]; fb[e] = (float)bv[e] * ig; fk[e] = (float)kv[e] * ig; fv[e] = (float)vv[e]; frr[e] = (float)rv[e] * g[e]; if (t == 63) GL[cc + e] = g[e]; }
          *(LAS3 u32x4*)(SLOT(0) + (t * WI_LD + cc) * 2) = pack8bf(fa); *(LAS3 u32x4*)(SLOT(2) + (t * WI_LD + cc) * 2) = pack8bf(fb); *(LAS3 u32x4*)(SLOT(4) + (t * WI_LD + cc) * 2) = pack8bf(fk); *(LAS3 u32x4*)(SLOT(12) + (t * WI_LD + cc) * 2) = pack8bf(frr);
#pragma unroll
          for (int e = 0; e < 8; ++e) { *(LAS3 bf16*)(SLOT(1) + ((cc + e) * WI_LD + t) * 2) = f2bf(fa[e]); *(LAS3 bf16*)(SLOT(3) + ((cc + e) * WI_LD + t) * 2) = f2bf(fb[e]); *(LAS3 bf16*)(SLOT(5) + ((cc + e) * WI_LD + t) * 2) = f2bf(fv[e]); } }
        HBAR();
        { WiA aB, aK; WiB bA, bR; wi_lda(aB, SLOT(2), m, fr, fq); wi_lda(aK, SLOT(4), m, fr, fq); wi_ldb(bA, SLOT(0), n0, fr, fq); wi_ldb(bR, SLOT(12), n0, fr, fq);
          WI_PIN();
          f32x4 ans[2] = {{0.f, 0.f, 0.f, 0.f}, {0.f, 0.f, 0.f, 0.f}}, ant[2] = {{0.f, 0.f, 0.f, 0.f}, {0.f, 0.f, 0.f, 0.f}}, aks[2] = {{0.f, 0.f, 0.f, 0.f}, {0.f, 0.f, 0.f, 0.f}}, am[2] = {{0.f, 0.f, 0.f, 0.f}, {0.f, 0.f, 0.f, 0.f}}, amk[2] = {{0.f, 0.f, 0.f, 0.f}, {0.f, 0.f, 0.f, 0.f}};
          wi_fma_s(ans, aB, bA); wi_fma(ant, aB, bA); wi_fma_s(aks, aK, bA); wi_fma(am, aB, bR); wi_fma(amk, aK, bR);
          WI_PIN();
          f32x4 axs[2];
#pragma unroll
          for (int n = 0; n < 2; ++n)
#pragma unroll
              for (int i = 0; i < 4; ++i) { const int rs = 16 * m + fr, cs = n0 + 16 * n + 4 * fq + i;
                  if (!(rs < cs)) { ans[n][i] = 0.f; aks[n][i] = 0.f; } axs[n][i] = ans[n][i] + (rs == cs ? 1.0f : 0.f);
                  const int rn = 16 * m + 4 * fq + i, cn = n0 + 16 * n + fr;
                  if (!(rn < cn)) ant[n][i] = 0.f; if (rn > cn) { am[n][i] = 0.f; amk[n][i] = 0.f; } }
          wi_st_nat_s(SLOT(7), ans, m, n0, fr, fq); wi_st_tr(SLOT(8), ant, m, n0, fr, fq); wi_st_nat_s(SLOT(6), aks, m, n0, fr, fq); wi_st_nat_s(SLOT(11), axs, m, n0, fr, fq);
          wi_st_tr(SLOT(13), am, m, n0, fr, fq); wi_st_tr(SLOT(14), amk, m, n0, fr, fq); }
        HBAR();
        { WiA aN; WiB bN; wi_lda(aN, SLOT(7), m, fr, fq); wi_ldb(bN, SLOT(8), n0, fr, fq); WI_PIN();
          f32x4 a2s[2] = {{0.f, 0.f, 0.f, 0.f}, {0.f, 0.f, 0.f, 0.f}}, a2t[2] = {{0.f, 0.f, 0.f, 0.f}, {0.f, 0.f, 0.f, 0.f}}; wi_fma_s(a2s, aN, bN); wi_fma(a2t, aN, bN); WI_PIN();
          wi_st_nat_s(SLOT(9), a2s, m, n0, fr, fq); wi_st_tr(SLOT(10), a2t, m, n0, fr, fq); }
        HBAR();
#define WI_LEVEL(XS, XD, NS, NST, ND, NDT) do { WiA aX, aN; WiB bN; f32x4 ax[2]; wi_lda(aX, SLOT(XS), m, fr, fq); wi_ldb(bN, SLOT(NST), n0, fr, fq); wi_lda(aN, SLOT(NS), m, fr, fq); wi_ld_nat_s(ax, SLOT(XS), m, n0, fr, fq); \
            WI_PIN(); f32x4 aqs[2] = {{0.f, 0.f, 0.f, 0.f}, {0.f, 0.f, 0.f, 0.f}}, aqt[2] = {{0.f, 0.f, 0.f, 0.f}, {0.f, 0.f, 0.f, 0.f}}; wi_fma_s(ax, aX, bN); wi_fma_s(aqs, aN, bN); wi_fma(aqt, aN, bN); WI_PIN(); \
            wi_st_nat_s(SLOT(XD), ax, m, n0, fr, fq); wi_st_nat_s(SLOT(ND), aqs, m, n0, fr, fq); wi_st_tr(SLOT(NDT), aqt, m, n0, fr, fq); \
            HBAR(); } while (0)
        WI_LEVEL(11, 0, 9, 10, 7, 8);
        WI_LEVEL(0, 11, 7, 8, 9, 10);
        WI_LEVEL(11, 0, 9, 10, 7, 8);
        WI_LEVEL(0, 11, 7, 8, 9, 10);
#undef WI_LEVEL
        { WiA aX; WiB bN; f32x4 ax[2]; wi_lda(aX, SLOT(11), m, fr, fq); wi_ldb(bN, SLOT(10), n0, fr, fq); wi_ld_nat(ax, SLOT(11), m, n0, fr, fq); WI_PIN();
          wi_fma(ax, aX, bN); WI_PIN(); wi_st_tr(SLOT(0), ax, m, n0, fr, fq); }
        HBAR();
        { WiA aNk, aAt; WiB bT; wi_lda(aNk, SLOT(6), m, fr, fq); wi_lda(aAt, SLOT(1), m, fr, fq); wi_ldb(bT, SLOT(0), n0, fr, fq); WI_PIN();
          f32x4 aw[2] = {{0.f, 0.f, 0.f, 0.f}, {0.f, 0.f, 0.f, 0.f}}, aa[2] = {{0.f, 0.f, 0.f, 0.f}, {0.f, 0.f, 0.f, 0.f}}; wi_fma_s(aw, aNk, bT); wi_fma_s(aa, aAt, bT); WI_PIN();
          wi_st_nat_s(SLOT(2), aw, m, n0, fr, fq); wi_st_nat_s(SLOT(7), aa, m, n0, fr, fq); }
        HBAR();
        { WiA aAT, aW1; WiB bB, bM; f32x4 ap[2] = {{0.f, 0.f, 0.f, 0.f}, {0.f, 0.f, 0.f, 0.f}}, az[2], ag[2], az2[2]; float gl[2];
          wi_lda(aAT, SLOT(7), m, fr, fq); wi_lda(aW1, SLOT(2), m, fr, fq); wi_ldb(bB, SLOT(3), n0, fr, fq); wi_ldb(bM, SLOT(13), n0, fr, fq);
          wi_ld_nat(az, SLOT(4), m, n0, fr, fq); wi_ld_tr(az2, SLOT(14), m, n0, fr, fq); wi_ld_tr(ag, SLOT(12), m, n0, fr, fq);
#pragma unroll
          for (int n = 0; n < 2; ++n) gl[n] = GL[n0 + 16 * n + fr];
          WI_PIN();
          wi_fma(ap, aAT, bB); wi_fma(az, aW1, bB); wi_fma(ag, aAT, bM); wi_fma(az2, aW1, bM);
          WI_PIN();
          wi_st_tr(SLOT(8), az, m, n0, fr, fq); wi_st_tr(SLOT(9), az2, m, n0, fr, fq);
          bf16* PTp = (bf16*)ST + (size_t)(h * NCH + ch) * 4096; bf16* GMp = gm_ptr(a.ws, h, ch);
#pragma unroll
          for (int n = 0; n < 2; ++n) { const int col = n0 + 16 * n + fr; f32x4 pv = ap[n];
#pragma unroll
              for (int i = 0; i < 4; ++i) { if (16 * m + 4 * fq + i == col) pv[i] += 1.0f; pv[i] *= gl[n]; }
              u32x2 w; w.x = pk2(pv[0], pv[1]); w.y = pk2(pv[2], pv[3]); *(u32x2*)(PTp + col * 64 + 16 * m + 4 * fq) = w;
              u32x2 w2; w2.x = pk2(ag[n][0], ag[n][1]); w2.y = pk2(ag[n][2], ag[n][3]); *(u32x2*)(GMp + col * 64 + 16 * m + 4 * fq) = w2; } }
        HBAR();
        { WiA aV; WiB bZ1, bZ2; float gl[2]; wi_lda(aV, SLOT(5), m, fr, fq); wi_ldb(bZ1, SLOT(8), n0, fr, fq); wi_ldb(bZ2, SLOT(9), n0, fr, fq); gl[0] = GL[n0 + fr]; gl[1] = GL[n0 + 16 + fr]; WI_PIN();
          f32x4 aq[2] = {{0.f, 0.f, 0.f, 0.f}, {0.f, 0.f, 0.f, 0.f}}, ay[2] = {{0.f, 0.f, 0.f, 0.f}, {0.f, 0.f, 0.f, 0.f}}; wi_fma(aq, aV, bZ1); wi_fma(ay, aV, bZ2); WI_PIN();
          float* QTp = ST + ST_Q_OFF + (size_t)(h * NCH + ch) * 4096; bf16* Y0p = (bf16*)(a.ws + WS_Y0) + (size_t)(h * NCH + ch) * 4096;
#pragma unroll
          for (int n = 0; n < 2; ++n) { const int col = n0 + 16 * n + fr; *(f32x4*)(QTp + col * 64 + 16 * m + 4 * fq) = aq[n] * gl[n];
              u32x2 w; w.x = pk2(ay[n][0], ay[n][1]); w.y = pk2(ay[n][2], ay[n][3]); *(u32x2*)(Y0p + col * 64 + 16 * m + 4 * fq) = w; } }
        HBAR();
    }
#undef SLOT
#undef WI_FETCH
}

__device__ __forceinline__ void phase_scan3m(ArgsR a, const Ctx& c, int l) {
    const f16* R = (const f16*)(a.ws + WS_R); const f16* KP = (const f16*)(a.ws + WS_KP); const f16* V = (const f16*)(a.ws + WS_V); const bf16* G = (const bf16*)(a.ws + WS_G);
    bf16* YA = (bf16*)(a.ws + WS_YA);
    LAS3 unsigned char* L = (LAS3 unsigned char*)c.lds;
    LAS3 float* YL = (LAS3 float*)(L + WI_B);
    LAS3 unsigned char* S0I = L + 3 * WI_B;
    const int lane = c.lane, wv = c.wave, fr = lane & 15, fq = lane >> 4, m = wv >> 1, n0 = 32 * (wv & 1), tid = c.tid;
    const int boff = (n0 + fr) * 64 + 8 * fq, qtoff = (n0 + fr) * 64 + 16 * m + 4 * fq;
    u32x4 pS; bf16x8 pL[2][2]; f32x4 pQ[2]; bf16x8 pB[2][2]; u32x2 pY[2];
#define S3_FETCH(it) do { const int h_ = (it) / NCH, ch_ = (it) % NCH; pS = (u32x4){0u, 0u, 0u, 0u}; \
        _Pragma("unroll") for (int ks = 0; ks < 2; ++ks) _Pragma("unroll") for (int n = 0; n < 2; ++n) pL[ks][n] = (bf16x8){0, 0, 0, 0, 0, 0, 0, 0}; \
        pQ[0] = (f32x4){0.f, 0.f, 0.f, 0.f}; pQ[1] = (f32x4){0.f, 0.f, 0.f, 0.f}; \
        if (ch_ > 0) { const int c1_ = ch_ - 1; pS = *(const u32x4*)((const bf16*)(a.ws + WS_SG) + (size_t)(h_ * NG + c1_ / GS) * 4096 + tid * 8); \
            const bf16* LP_ = (const bf16*)(a.ws + WS_ST) + ST_LP_OFF + (size_t)(h_ * NCH + c1_) * 4096; const float* QT_ = (const float*)(a.ws + WS_ST) + ST_Q_OFF + (size_t)(h_ * NCH + c1_) * 4096; \
            _Pragma("unroll") for (int ks = 0; ks < 2; ++ks) _Pragma("unroll") for (int n = 0; n < 2; ++n) pL[ks][n] = *(const bf16x8*)(LP_ + boff + 16 * n * 64 + 32 * ks); \
            _Pragma("unroll") for (int n = 0; n < 2; ++n) pQ[n] = *(const f32x4*)(QT_ + qtoff + 16 * n * 64); } \
        const bf16* G_ = gm_ptr(a.ws, h_, ch_); const bf16* Y_ = (const bf16*)(a.ws + WS_Y0) + (size_t)(h_ * NCH + ch_) * 4096; \
        _Pragma("unroll") for (int ks = 0; ks < 2; ++ks) _Pragma("unroll") for (int n = 0; n < 2; ++n) pB[ks][n] = *(const bf16x8*)(G_ + (n0 + 16 * n + fr) * 64 + 32 * ks + 8 * fq); \
        _Pragma("unroll") for (int n = 0; n < 2; ++n) pY[n] = *(const u32x2*)(Y_ + (n0 + 16 * n + fr) * 64 + 16 * m + 4 * fq); } while (0)
    if (blockIdx.x < NH * NCH) S3_FETCH(blockIdx.x);
    for (int item = blockIdx.x; item < NH * NCH; item += gridDim.x) {
        const int h = item / NCH, ch = item % NCH;
        *(LAS3 u32x4*)(L + ((tid >> 3) * WI_LD + (tid & 7) * 8) * 2) = pS;
        bf16x8 lfr[2][2], bfr[2][2]; f32x4 as0[2], acc[2];
#pragma unroll
        for (int ks = 0; ks < 2; ++ks)
#pragma unroll
            for (int n = 0; n < 2; ++n) { lfr[ks][n] = pL[ks][n]; bfr[ks][n] = pB[ks][n]; }
#pragma unroll
        for (int n = 0; n < 2; ++n) { as0[n] = pQ[n]; acc[n][0] = __uint_as_float(pY[n].x << 16); acc[n][1] = __uint_as_float(pY[n].x & 0xffff0000u); acc[n][2] = __uint_as_float(pY[n].y << 16); acc[n][3] = __uint_as_float(pY[n].y & 0xffff0000u); }
        if (item + (int)gridDim.x < NH * NCH) S3_FETCH(item + (int)gridDim.x);
        HBAR();
        hmma(L, lfr, as0, m, fr, fq);
        himg_store(S0I, as0, m, n0, fr, fq);
        HBAR();
#pragma unroll
        for (int ks = 0; ks < 2; ++ks) { const bf16x8 av = *(const LAS3 bf16x8*)(S0I + ((16 * m + fr) * WI_LD + 32 * ks + 8 * fq) * 2);
#pragma unroll
            for (int n = 0; n < 2; ++n) acc[n] = __builtin_amdgcn_mfma_f32_16x16x32_bf16(av, bfr[ks][n], acc[n], 0, 0, 0); }
#pragma unroll
        for (int n = 0; n < 2; ++n)
#pragma unroll
            for (int i = 0; i < 4; ++i) YL[(n0 + 16 * n + fr) * 65 + 16 * m + 4 * fq + i] = acc[n][i];
        HBAR();
        { const float gn_g = a.in[I_GNG][l * W + h * 64 + lane], gn_b = a.in[I_GNB][l * W + h * 64 + lane], r_k = a.in[I_RK][l * W + h * 64 + lane];
          f16 rl8[8], kl8[8], vl8[8]; bf16 gl8[8];
#pragma unroll
          for (int i = 0; i < 8; ++i) { const size_t o = (size_t)(ch * CL + 8 * wv + i) * W + h * 64 + lane; rl8[i] = R[o]; kl8[i] = KP[o]; vl8[i] = V[o]; gl8[i] = G[o]; }
#pragma unroll
          for (int i = 0; i < 8; ++i) { const int t = 8 * wv + i; const size_t o = (size_t)(ch * CL + t) * W + h * 64 + lane;
              const float yy = YL[t * 65 + lane]; const float rl = (float)rl8[i], kl = (float)kl8[i], vl = (float)vl8[i], gl = bf2f(gl8[i]);
              const float mean = wave_sum(yy) * (1.f / 64.f); const float dd = yy - mean; const float var = wave_sum(dd * dd) * (1.f / 64.f);
              const float bonus = wave_sum(rl * kl * r_k);
              const float yn = dd * __builtin_amdgcn_rsqf(var + GN_EPS) * gn_g + gn_b + bonus * vl;
              YA[o] = f2bf(yn * gl); } }
        HBAR();
    }
#undef S3_FETCH
}

__device__ __forceinline__ void phase_scan3(ArgsR a, const Ctx& c, int l) {
    const f16* R = (const f16*)(a.ws + WS_R); const f16* WM1 = (const f16*)(a.ws + WS_WM1); const f16* KP = (const f16*)(a.ws + WS_KP);
    const f16* AA = (const f16*)(a.ws + WS_AA); const f16* BB = (const f16*)(a.ws + WS_BB); const f16* V = (const f16*)(a.ws + WS_V);
    const float* ST = (const float*)(a.ws + WS_ST); bf16* YA = (bf16*)(a.ws + WS_YA); const f16* Gs = (const f16*)(a.ws + WS_G);
    const int lane = c.lane;
    LAS3 unsigned char* ring = (LAS3 unsigned char*)c.lds + c.wave * SC_WAVE;
    for (int item = c.gw; item < NH * NCH; item += c.ngw) {
        const int h = __builtin_amdgcn_readfirstlane(item / NCH), ch = __builtin_amdgcn_readfirstlane(item % NCH);
        const size_t lane_off = (size_t)(lane >> 3) * W + h * 64 + (lane & 7) * 8;
        const float gn_g = a.in[I_GNG][l * W + h * 64 + lane], gn_b = a.in[I_GNB][l * W + h * 64 + lane], r_k = a.in[I_RK][l * W + h * 64 + lane];
        { const size_t e0 = (size_t)(ch * CL) * W + lane_off;
          sc_dma(AA, e0, ring); sc_dma(WM1, e0, ring + 1024); sc_dma(BB, e0, ring + 2048); sc_dma(KP, e0, ring + 3072); sc_dma(V, e0, ring + 4096); sc_dma(R, e0, ring + 5120); sc_dma(Gs, e0, ring + 6144); }
        float S[64];
        if (ch == 0) {
#pragma unroll
            for (int j = 0; j < 64; ++j) S[j] = 0.f;
        } else { const bf16* Sp = (const bf16*)ST + ((size_t)(h * NCH + ch - 1) * 64 + lane) * 64;
#pragma unroll
            for (int j = 0; j < 64; j += 4) { const f32x4 x = load4bf(Sp + j); S[j] = x[0]; S[j + 1] = x[1]; S[j + 2] = x[2]; S[j + 3] = x[3]; } }
#pragma unroll 1
        for (int blk = 0; blk < CL / SCB; ++blk) {
            LAS3 unsigned char* buf = ring + (blk & 1) * SC_BUF;
            if (blk + 1 < CL / SCB) { LAS3 unsigned char* nb = ring + ((blk + 1) & 1) * SC_BUF; const size_t e0 = (size_t)(ch * CL + (blk + 1) * SCB) * W + lane_off;
                sc_dma(AA, e0, nb); sc_dma(WM1, e0, nb + 1024); sc_dma(BB, e0, nb + 2048); sc_dma(KP, e0, nb + 3072); sc_dma(V, e0, nb + 4096); sc_dma(R, e0, nb + 5120); sc_dma(Gs, e0, nb + 6144);
                asm volatile("s_waitcnt vmcnt(7)" ::: "memory"); }
            else asm volatile("s_waitcnt vmcnt(0)" ::: "memory");
            SVec A, Wv, Bv, Kv, Rv;
            sv_cvt(A, sv_read(buf, lane)); sv_cvt1p(Wv, sv_read(buf + 1024, lane)); sv_cvt(Bv, sv_read(buf + 2048, lane)); sv_cvt(Kv, sv_read(buf + 3072, lane)); sv_cvt(Rv, sv_read(buf + 5120, lane));
            float vv = (float)*(const LAS3 f16*)(buf + 4096 + lane * 2);
#pragma unroll 1
            for (int st = 0; st < SCB; ++st) {
                const LAS3 unsigned char* sn = buf + ((st + 1 < SCB) ? st + 1 : st) * 128;
                const f16x4 ha = sv_read(sn, lane), hw = sv_read(sn + 1024, lane), hb = sv_read(sn + 2048, lane), hk = sv_read(sn + 3072, lane), hr = sv_read(sn + 5120, lane);
                const f16 hv = *(const LAS3 f16*)(sn + 4096 + lane * 2);
                float d[4] = {0.f, 0.f, 0.f, 0.f};
                sc_dot<0>(d, A, S);
                const float sa = (d[0] + d[1]) + (d[2] + d[3]);
                float y[4] = {0.f, 0.f, 0.f, 0.f};
                sc_upd3<0>(S, y, Wv, Bv, Kv, Rv, sa, vv);
                const float yy = (y[0] + y[1]) + (y[2] + y[3]);
                sv_cvt(A, ha); sv_cvt1p(Wv, hw); sv_cvt(Bv, hb); sv_cvt(Kv, hk); sv_cvt(Rv, hr); vv = (float)hv;
                { const LAS3 unsigned char* sb = buf + st * 128;
                  const float rl = (float)*(const LAS3 f16*)(sb + 5120 + lane * 2), kl = (float)*(const LAS3 f16*)(sb + 3072 + lane * 2), vl = (float)*(const LAS3 f16*)(sb + 4096 + lane * 2);
                  const float gl = bf2f(*(const LAS3 bf16*)(sb + 6144 + lane * 2));
                  const float mean = wave_sum(yy) * (1.f / 64.f); const float dd = yy - mean; const float var = wave_sum(dd * dd) * (1.f / 64.f);
                  const float bonus = wave_sum(rl * kl * r_k);
                  const float yn = dd * __builtin_amdgcn_rsqf(var + GN_EPS) * gn_g + gn_b + bonus * vl;
                  YA[(size_t)(ch * CL + blk * SCB + st) * W + h * 64 + lane] = f2bf(yn * gl); }
            }
        }
    }
}

__device__ __forceinline__ void phase_post(ArgsR a, const Ctx& c, int l) {
    const bf16* YSC = (const bf16*)(a.ws + WS_YSC); const f16* R = (const f16*)(a.ws + WS_R); const f16* KP = (const f16*)(a.ws + WS_KP); const f16* V = (const f16*)(a.ws + WS_V);
    const bf16* G = (const bf16*)(a.ws + WS_G); bf16* YA = (bf16*)(a.ws + WS_YA);
    const float* gng = a.in[I_GNG] + l * W; const float* gnb = a.in[I_GNB] + l * W; const float* rk = a.in[I_RK] + l * W;
    for (int t = c.gw; t < T; t += c.ngw) {
#pragma unroll
        for (int i = 0; i < 8; ++i) { const int n = c.lane + 64 * i; const size_t o = (size_t)t * W + n;
            const float y = bf2f(YSC[o]); const float mean = wave_sum(y) * (1.f / 64.f); const float d = y - mean; const float var = wave_sum(d * d) * (1.f / 64.f);
            float yn = d * __builtin_amdgcn_rsqf(var + GN_EPS) * gng[n] + gnb[n];
            const float r = (float)R[o], k = (float)KP[o], v = (float)V[o];
            const float bonus = wave_sum(r * k * rk[n]);
            yn += bonus * v;
            YA[o] = f2bf(yn * bf2f(G[o])); }
    }
}

__device__ __forceinline__ void phase_ln1(ArgsR a, const Ctx& c, int l, float* outw, int mode = 3) {
    const float* MODF = (const float*)(a.ws + WS_MODF) + l * 6144;
    const float* g1 = a.in[I_LN1G] + l * D; const float* b1 = a.in[I_LN1B] + l * D;
    bf16* XN = (bf16*)(a.ws + WS_XN);
    int* TOKI = (int*)(a.ws + WS_TOKI); float* TOKW = (float*)(a.ws + WS_TOKW); int* TOKP = (int*)(a.ws + WS_TOKP);
    const float* rw = a.in[I_RW]; const float* rb = a.in[I_RB];
    LAS3 float* rwT = (LAS3 float*)((LAS3 unsigned char*)c.lds + 69632);
    unsigned* lcnt = (unsigned*)(c.lds + 135168);
    if (mode & 1) {
    for (int i = c.tid; i < D * NE; i += NTHREADS) rwT[(i & 15) * D + (i >> 4)] = rw[i];
    if (c.tid < NE) lcnt[c.tid] = 0u;
    __syncthreads();
    float vn[16]; if (c.gw < T) load_row16(a.out + (size_t)c.gw * D, c.lane, vn);
    for (int m = c.gw; m < T; m += c.ngw) {
        int l4 = 4 * c.lane; asm volatile("" : "+v"(l4));
        float v[16];
#pragma unroll
        for (int j = 0; j < 16; ++j) v[j] = vn[j];
        if (m + c.ngw < T) load_row16(a.out + (size_t)(m + c.ngw) * D, c.lane, vn);
        float mean, rstd; row_stats(v, mean, rstd);
#pragma unroll
        for (int j = 0; j < 4; ++j) { f32x4 o; const int col = l4 + 256 * j;
#pragma unroll
            for (int e = 0; e < 4; ++e) { v[4 * j + e] = (v[4 * j + e] - mean) * rstd * g1[col + e] + b1[col + e]; o[e] = v[4 * j + e]; }
            *(f32x4*)(outw + (size_t)m * D + col) = o; }
        row_stats(v, mean, rstd);
#pragma unroll
        for (int j = 0; j < 4; ++j) { f32x4 o; const int col = l4 + 256 * j;
#pragma unroll
            for (int e = 0; e < 4; ++e) { v[4 * j + e] = (v[4 * j + e] - mean) * rstd * (1.0f + MODF[4096 + col + e]) + MODF[3072 + col + e]; o[e] = v[4 * j + e]; }
            store4bf(XN + (size_t)m * D + col, o); }
        float lg[16];
#pragma unroll
        for (int e = 0; e < 16; ++e) { float x = 0.f;
#pragma unroll
            for (int j = 0; j < 4; ++j) { const f32x4 r4 = *(const LAS3 f32x4*)(rwT + e * D + l4 + 256 * j); x += (v[4 * j] * r4[0] + v[4 * j + 1] * r4[1]) + (v[4 * j + 2] * r4[2] + v[4 * j + 3] * r4[3]); }
            lg[e] = x;
            if ((e & 3) == 3) __builtin_amdgcn_sched_barrier(0); }
        float r8[8], r4v[4], r2[2], r1;
        { const bool b5 = (c.lane & 32) != 0, b4 = (c.lane & 16) != 0, b3 = (c.lane & 8) != 0, b2 = (c.lane & 4) != 0;
#pragma unroll
          for (int i = 0; i < 8; ++i) { const float snd = b5 ? lg[i] : lg[i + 8], kp = b5 ? lg[i + 8] : lg[i]; r8[i] = kp + __shfl_xor(snd, 32); }
#pragma unroll
          for (int i = 0; i < 4; ++i) { const float snd = b4 ? r8[i] : r8[i + 4], kp = b4 ? r8[i + 4] : r8[i]; r4v[i] = kp + __shfl_xor(snd, 16); }
#pragma unroll
          for (int i = 0; i < 2; ++i) { const float snd = b3 ? r4v[i] : r4v[i + 2], kp = b3 ? r4v[i + 2] : r4v[i]; r2[i] = kp + __shfl_xor(snd, 8); }
          { const float snd = b2 ? r2[0] : r2[1], kp = b2 ? r2[1] : r2[0]; r1 = kp + __shfl_xor(snd, 4); }
          r1 += __shfl_xor(r1, 2); r1 += __shfl_xor(r1, 1); }
        float sc[16], sel[16];
#pragma unroll
        for (int e = 0; e < 16; ++e) { const float lgt = __shfl(r1, 4 * e); sc[e] = __builtin_amdgcn_rcpf(1.0f + __expf(-lgt)); sel[e] = sc[e] + rb[e]; }
        int best = 0; float bestv = -INFINITY;
#pragma unroll
        for (int g = 0; g < 4; ++g) { float m1 = -INFINITY, m2 = -INFINITY;
#pragma unroll
            for (int q = 0; q < 4; ++q) { const float sv = sel[4 * g + q]; if (sv > m1) { m2 = m1; m1 = sv; } else if (sv > m2) m2 = sv; }
            const float gs = m1 + m2; if (gs > bestv) { bestv = gs; best = g; } }
        int i1 = 0, i2 = 0; float s1 = -INFINITY, s2 = -INFINITY, w1 = 0.f, w2 = 0.f;
#pragma unroll
        for (int e = 0; e < 16; ++e) { if ((e >> 2) == best) { const float sv = sel[e];
                if (sv > s1) { s2 = s1; i2 = i1; w2 = w1; s1 = sv; i1 = e; w1 = sc[e]; } else if (sv > s2) { s2 = sv; i2 = e; w2 = sc[e]; } } }
        if (c.lane == 0) { const float ws = w1 + w2;
            TOKI[2 * m] = i1; TOKI[2 * m + 1] = i2; TOKW[2 * m] = w1 / ws; TOKW[2 * m + 1] = w2 / ws;
            TOKP[2 * m] = (int)atomicAdd(&lcnt[i1], 1u); TOKP[2 * m + 1] = (int)atomicAdd(&lcnt[i2], 1u); }
    }
    __syncthreads();
    if (c.tid < NE) ((int*)(a.ws + WS_BLKCNT))[blockIdx.x * NE + c.tid] = (int)lcnt[c.tid];
    __syncthreads();
    }
}

__device__ __forceinline__ void expert_convert(ArgsR a, const Ctx& c, int l, int b0) {
    if ((int)blockIdx.x < b0) return;
    float* scr = (float*)(c.lds + c.wave * 8704);
    bf16* WGU = (bf16*)(a.ws + WS_WGU); bf16* WD = (bf16*)(a.ws + WS_WD);
    constexpr int IG = (D / 64) * (FF / 32);
    constexpr int ID = (FF / 64) * (D / 32);
    const int gw0 = ((int)blockIdx.x - b0) * NWAVES + c.wave, ngw0 = ((int)gridDim.x - b0) * NWAVES;
    for (int it = gw0; it < NE * (2 * IG + ID); it += ngw0) {
        const int e = it / (2 * IG + ID); int r = it % (2 * IG + ID);
        const size_t eo = ((size_t)l * NE + e) * (size_t)D * FF;
        if (r < IG) { transpose_matrix_item(a.in[I_EG] + eo, D, FF, WGU + (size_t)e * 1024 * 1024, r, scr, c.lane, RowGU{0}); continue; } r -= IG;
        if (r < IG) { transpose_matrix_item(a.in[I_EU] + eo, D, FF, WGU + (size_t)e * 1024 * 1024, r, scr, c.lane, RowGU{1}); continue; } r -= IG;
        transpose_matrix_item(a.in[I_ED] + eo, FF, D, WD + (size_t)e * 1024 * 512, r, scr, c.lane, RowId());
    }
}

__device__ __forceinline__ void phase_perm(ArgsR a, const Ctx& c, int l) {
    const int* BLKCNT = (const int*)(a.ws + WS_BLKCNT);
    LAS3 int* pre = (LAS3 int*)c.lds;
    LAS3 int* tot = pre + 256 * NE;
    const int nb = gridDim.x;
#pragma unroll
    for (int q = 0; q < 2; ++q) { const int e = 2 * c.wave + q; int v[4]; int sum = 0;
#pragma unroll
        for (int i = 0; i < 4; ++i) { const int b = 4 * c.lane + i; v[i] = b < nb ? BLKCNT[b * NE + e] : 0; sum += v[i]; }
        int inc = sum;
#pragma unroll
        for (int o = 1; o < 64; o <<= 1) { const int t = __shfl_up(inc, o); if (c.lane >= o) inc += t; }
        int run = inc - sum;
#pragma unroll
        for (int i = 0; i < 4; ++i) { pre[(4 * c.lane + i) * NE + e] = run; run += v[i]; }
        if (c.lane == 63) tot[e] = inc; }
    __syncthreads();
    int ts[17]; { int sacc = 0;
#pragma unroll
        for (int e = 0; e < 16; ++e) { ts[e] = sacc; sacc += (tot[e] + 255) >> 8; } ts[16] = sacc; }
    if (blockIdx.x == 0 && c.tid < NE) ((int*)(a.ws + WS_TOT))[c.tid] = tot[c.tid];
    const int* TOKI = (const int*)(a.ws + WS_TOKI); const int* TOKP = (const int*)(a.ws + WS_TOKP); int* S2T = (int*)(a.ws + WS_S2T); const float* TOKW = (const float*)(a.ws + WS_TOKW);
    const bf16* XN = (const bf16*)(a.ws + WS_XN); bf16* XS = (bf16*)(a.ws + WS_XS);
    for (int as = blockIdx.x * NTHREADS + c.tid; as < 2 * T; as += gridDim.x * NTHREADS) {
        const int e = TOKI[as]; int base = 0;
#pragma unroll
        for (int j = 0; j < 16; ++j) base = (j == e) ? ts[j] : base;
        const int m = as >> 1, blk = (m % c.ngw) >> 3;
        const u32x2 sw = {(unsigned)as, __float_as_uint(TOKW[as])};
        *(u32x2*)(S2T + 2 * (base * 256 + pre[blk * NE + e] + TOKP[as])) = sw;
    }
    for (int e = 0; e < 16; ++e) {
        int tse = 0, tsn = 0;
#pragma unroll
        for (int j = 0; j < 16; ++j) { tse = (j == e) ? ts[j] : tse; tsn = (j == e) ? ts[j + 1] : tsn; }
        const int lo = tse * 256 + tot[e], hi = tsn * 256;
        for (int sl = lo + blockIdx.x * NTHREADS + c.tid; sl < hi; sl += gridDim.x * NTHREADS) S2T[2 * sl] = -1;
    }
    __syncthreads();
}

__device__ __forceinline__ void phase_ln2(ArgsR a, const Ctx& c, int l, float* outw) {
    const float* MODF = (const float*)(a.ws + WS_MODF) + l * 6144;
    const float* g2 = a.in[I_LN2G] + l * D; const float* b2 = a.in[I_LN2B] + l * D;
    const bf16* Y = (const bf16*)(a.ws + WS_Y); bf16* XN = (bf16*)(a.ws + WS_XN);
    float vn[16]; u32x2 y0n[4], y1n[4];
    if (c.gw < T) { load_row16(a.out + (size_t)c.gw * D, c.lane, vn);
#pragma unroll
        for (int j = 0; j < 4; ++j) { y0n[j] = *(const u32x2*)(Y + (size_t)(2 * c.gw) * D + 4 * c.lane + 256 * j); y1n[j] = *(const u32x2*)(Y + (size_t)(2 * c.gw + 1) * D + 4 * c.lane + 256 * j); } }
    for (int m = c.gw; m < T; m += c.ngw) {
        float v[16]; u32x2 y0[4], y1[4];
#pragma unroll
        for (int j = 0; j < 16; ++j) v[j] = vn[j];
#pragma unroll
        for (int j = 0; j < 4; ++j) { y0[j] = y0n[j]; y1[j] = y1n[j]; }
        if (m + c.ngw < T) { const int mn = m + c.ngw; load_row16(a.out + (size_t)mn * D, c.lane, vn);
#pragma unroll
            for (int j = 0; j < 4; ++j) { y0n[j] = *(const u32x2*)(Y + (size_t)(2 * mn) * D + 4 * c.lane + 256 * j); y1n[j] = *(const u32x2*)(Y + (size_t)(2 * mn + 1) * D + 4 * c.lane + 256 * j); } }
#pragma unroll
        for (int j = 0; j < 4; ++j) { const int col = 4 * c.lane + 256 * j;
            const float a0 = __uint_as_float(y0[j].x << 16) + __uint_as_float(y1[j].x << 16), a1 = __uint_as_float(y0[j].x & 0xffff0000u) + __uint_as_float(y1[j].x & 0xffff0000u);
            const float a2 = __uint_as_float(y0[j].y << 16) + __uint_as_float(y1[j].y << 16), a3 = __uint_as_float(y0[j].y & 0xffff0000u) + __uint_as_float(y1[j].y & 0xffff0000u);
            const f32x4 gt = *(const f32x4*)(MODF + 5120 + col);
            v[4 * j] = ALPHA * v[4 * j] + (1.0f + gt[0]) * a0; v[4 * j + 1] = ALPHA * v[4 * j + 1] + (1.0f + gt[1]) * a1; v[4 * j + 2] = ALPHA * v[4 * j + 2] + (1.0f + gt[2]) * a2; v[4 * j + 3] = ALPHA * v[4 * j + 3] + (1.0f + gt[3]) * a3; }
        float mean, rstd; row_stats(v, mean, rstd);
#pragma unroll
        for (int j = 0; j < 4; ++j) { f32x4 o; const int col = 4 * c.lane + 256 * j;
#pragma unroll
            for (int e = 0; e < 4; ++e) { v[4 * j + e] = (v[4 * j + e] - mean) * rstd * g2[col + e] + b2[col + e]; o[e] = v[4 * j + e]; }
            *(f32x4*)(outw + (size_t)m * D + col) = o; }
        if (l + 1 < DEPTH) {
            const float* MN = MODF + 6144;
            row_stats(v, mean, rstd);
#pragma unroll
            for (int j = 0; j < 4; ++j) { f32x4 o; const int col = 4 * c.lane + 256 * j;
#pragma unroll
                for (int e = 0; e < 4; ++e) o[e] = (v[4 * j + e] - mean) * rstd * (1.0f + MN[1024 + col + e]) + MN[col + e];
                store4bf(XN + (size_t)m * D + col, o); }
        }
    }
}


template <class F> struct EpiAdapt {
    static constexpr bool PERM = true, AFTER_DRAIN = false; F f;
    __device__ __forceinline__ void operator()(const f32x4 (&acc)[2][2][4][2], const Unit& u, int wr, int wc, int fr, int fq) const {
        const int col = u.pn * 256 + wc * 32 + 8 * fq;
#pragma unroll
        for (int ai = 0; ai < 2; ++ai)
#pragma unroll
            for (int m = 0; m < 4; ++m) { const int row = u.pm * 256 + ai * 128 + wr * 64 + m * 16 + fr; f(row, col, acc[ai][0][m][0], acc[ai][0][m][1], acc[ai][1][m][0], acc[ai][1][m][1]); }
    }
};

template <class Sched, class F>
__device__ __forceinline__ void gemm_gather(const Ctx& c, const bf16* A, const int* s2t, const bf16* Bt, int M, int N, int K, const Sched& S, const F& f) {
    pg8::Gemm g{A, Bt, M, N, K}; EpiAdapt<F> E{f};
    pg8::gemm_phase<EpiAdapt<F>, Sched, true, true, true>((PG8_LAS unsigned char*)c.lds, g, S, E, c.tid, s2t);
}
template <class Sched, class F>
__device__ __forceinline__ void gemm_any(const Ctx& c, const bf16* A, const bf16* Bt, int M, int N, int K, const Sched& S, const F& f) {
    pg8::Gemm g{A, Bt, M, N, K}; EpiAdapt<F> E{f};
    pg8::gemm_phase<EpiAdapt<F>, Sched, true, true>((PG8_LAS unsigned char*)c.lds, g, S, E, c.tid);
}

#define LAS __attribute__((address_space(3)))
#define XB_TMO      128
#define XB_XCNT(j)  (256  + 64 * (j))
#define XB_XSUB(j)  (1280 + 64 * (j))
#define XB_XGEN(j)  (2304 + 64 * (j))
#define XB_TOP      3328
#define XB_TOPGEN   3392
#define XCD_BAR_WORDS 3456
#define XB_SPIN_CAP (1u << 24)

__device__ __forceinline__ unsigned xb_ld(unsigned* p)              { return __hip_atomic_load(p, __ATOMIC_RELAXED, __HIP_MEMORY_SCOPE_AGENT); }
__device__ __forceinline__ unsigned xb_add(unsigned* p, unsigned v) { return __hip_atomic_fetch_add(p, v, __ATOMIC_RELAXED, __HIP_MEMORY_SCOPE_AGENT); }
__device__ __forceinline__ unsigned xb_xcc_id() { return (unsigned)__builtin_amdgcn_s_getreg((3 << 11) | 20) & 0xFu; }
#define XB_SPIN(cond, bar) do { unsigned _sp = 0; while (cond) { __builtin_amdgcn_s_sleep(1); \
    if ((++_sp & 255u) == 0u) { if (xb_ld(&(bar)[XB_TMO])) break; if (_sp > XB_SPIN_CAP) { atomicAdd(&(bar)[XB_TMO], 1u); break; } } } } while (0)

struct XcdBarrier {
    unsigned* bar; unsigned x;
    volatile LAS unsigned* st;
};

__device__ __forceinline__ XcdBarrier xcd_barrier_post(unsigned* bar, volatile LAS unsigned* st) {
    XcdBarrier b; b.bar = bar; b.x = xb_xcc_id(); b.st = st;
    if (threadIdx.x == 0) (void)xb_add(&bar[XB_XCNT(b.x)], 1u);
    return b;
}
__device__ __forceinline__ void xcd_barrier_complete(unsigned* bar, unsigned x, unsigned& nloc, unsigned& nx) {
    const unsigned G = gridDim.x * gridDim.y * gridDim.z;
    unsigned sum, cnt, mine, sp = 0u;
    for (;;) {
        sum = 0u; cnt = 0u; mine = 0u;
#pragma unroll
        for (unsigned j = 0; j < 16; ++j) { const unsigned c = xb_ld(&bar[XB_XCNT(j)]); sum += c; cnt += (c > 0u) ? 1u : 0u; mine = (j == x) ? c : mine; }
        if (sum == G) break;
        __builtin_amdgcn_s_sleep(1);
        if ((++sp & 255u) == 0u) { if (xb_ld(&bar[XB_TMO])) break; if (sp > XB_SPIN_CAP) { atomicAdd(&bar[XB_TMO], 1u); break; } }
    }
    nloc = mine > 0u ? mine : 1u; nx = cnt > 0u ? cnt : 1u;
}

__device__ __forceinline__ void xcd_barrier(const XcdBarrier& b) {
    asm volatile("s_waitcnt vmcnt(0)" ::: "memory");
    __syncthreads();
    if (threadIdx.x == 0) {
        unsigned* bar = b.bar;
        __builtin_amdgcn_s_waitcnt(0);
        unsigned nloc = b.st[0], nx = b.st[1];
        if (nloc == 0u) { xcd_barrier_complete(bar, b.x, nloc, nx); b.st[0] = nloc; b.st[1] = nx; }
        const unsigned old = xb_add(&bar[XB_XSUB(b.x)], 1u);
        const unsigned gen = old / nloc;
        if (old + 1u == (gen + 1u) * nloc) {
            __builtin_amdgcn_fence(__ATOMIC_RELEASE, "agent");
            asm volatile("s_waitcnt vmcnt(0)" ::: "memory");
            const unsigned og = xb_add(&bar[XB_TOP], 1u);
            const unsigned tg = og / nx;
            if (og + 1u == (tg + 1u) * nx) xb_add(&bar[XB_TOPGEN], 1u);
            else XB_SPIN(xb_ld(&bar[XB_TOPGEN]) == tg, bar);
            __builtin_amdgcn_fence(__ATOMIC_ACQUIRE, "agent");
            xb_add(&bar[XB_XGEN(b.x)], 1u);
            asm volatile("s_waitcnt vmcnt(0)" ::: "memory");
        } else {
            XB_SPIN(xb_ld(&bar[XB_XGEN(b.x)]) == gen, bar);
            __builtin_amdgcn_fence(__ATOMIC_ACQUIRE, "agent");
            asm volatile("s_waitcnt vmcnt(0)" ::: "memory");
        }
    }
    __syncthreads();
}


constexpr int PH_PER_LAYER = 12, N_PHASES = 2 + PH_PER_LAYER * DEPTH;
constexpr int CW_BAR = 4096;
constexpr int LDS_BYTES = 147456, LDSCTL_OFF = 131072 + 8192;
#ifndef SINGLE_LAUNCH
#define SINGLE_LAUNCH 1
#endif

#ifndef PROBE_A
#define PROBE_A -1
#endif
#ifndef PROBE_B
#define PROBE_B -1
#endif
constexpr size_t WS_TS = 512 * 1024;
#if PROBE_A >= 0
#define STAMP(i) do { if (blockIdx.x == 0 && threadIdx.x == 0) ((unsigned long long*)(args_here()->ws + WS_TS))[(i)] = __builtin_amdgcn_s_memrealtime(); } while (0)
#else
#define STAMP(i) do { } while (0)
#endif
__device__ __forceinline__ const __attribute__((address_space(4))) Args* args_here() { const __attribute__((address_space(4))) Args* p = (const __attribute__((address_space(4))) Args*)__builtin_amdgcn_kernarg_segment_ptr(); asm volatile("" : "+s"(p)); return p; }
#ifndef REP_K
#define REP_K -1
#endif
__device__ __forceinline__ Ctx mkctx(int wave_s, unsigned char* lds) { Ctx c; c.wave = wave_s; c.lane = (int)__builtin_amdgcn_mbcnt_hi(~0u, __builtin_amdgcn_mbcnt_lo(~0u, 0u)); c.tid = wave_s * 64 + c.lane;
    c.gw = blockIdx.x * NWAVES + wave_s; c.ngw = gridDim.x * NWAVES; c.lds = lds; return c; }
#define PHASE1(k, ...) do { const __attribute__((address_space(4))) Args* ap_ = args_here(); if (ap_->ph_lo <= (k) && (k) < ap_->ph_hi) { ArgsR a = *ap_; const Ctx c = mkctx(wave_s, lds); __VA_ARGS__ } } while (0)
#define PHASE(k, ...) do { PHASE1(k, __VA_ARGS__); if ((k) == REP_K) { xcd_barrier(bar); PHASE1(k, __VA_ARGS__); xcd_barrier(bar); PHASE1(k, __VA_ARGS__); } } while (0)

template <int L>
__device__ __forceinline__ void run_layer(const int wave_s, unsigned char* lds, const XcdBarrier& bar) {
    const int G = gridDim.x, b = blockIdx.x;
#define BAR() do { xcd_barrier(bar); STAMP(3 + 14 * L + (bk_++)); } while (0)
    int bk_ = 0;
    PHASE(0, unsigned char* ws = a.ws; pg8::StaticOrder S; S.init(T, INC, G, b); EpiZ E{(bf16*)(ws + WS_ZR), (bf16*)(ws + WS_ZS), (bf16*)(ws + WS_ZG)};
        gemm_any(c, (const bf16*)(ws + WS_XN), (const bf16*)(ws + WS_WIN + (size_t)L * 10 * MiB), T, INC, D, S, E); );
    BAR();
    PHASE(1, phase_prep_fast(a, c, L); );
    PHASE(14, phase_sg_fast(a, c, L); );
    BAR();
#if REP_K == 21
    PHASE1(2, phase_scan1m(a, c, 1); ); xcd_barrier(bar); PHASE1(2, phase_scan1m(a, c, 1); ); xcd_barrier(bar);
#endif
    PHASE(2, phase_scan1m(a, c); );
    BAR();
    PHASE(3, phase_scan2a(a, c); );
    BAR();
    PHASE(31, phase_scan2b(a, c); );
    PHASE(33, expert_convert(a, c, L, NH); );
    BAR();
    PHASE(4, phase_scan3m(a, c, L); );
    BAR();
    PHASE(6, unsigned char* ws = a.ws; pg8::StaticOrder S; S.init(T, D, G, b); EpiGA E{(const bf16*)(ws + WS_ZG), (bf16*)(ws + WS_MP)};
        gemm_any(c, (const bf16*)(ws + WS_YA), (const bf16*)(ws + WS_WA + (size_t)L * WS_WL1), T, D, W, S, E); );
    BAR();
#if REP_K == 7
    PHASE1(7, unsigned char* ws = a.ws; pg8::StaticOrder S; S.init(T, D, G, b); EpiGB E{(const bf16*)(ws + WS_ZG), (const bf16*)(ws + WS_MP), (bf16*)(ws + WS_ZR)};
        gemm_any(c, (const bf16*)(ws + WS_YB), (const bf16*)(ws + WS_WB + (size_t)L * WS_WL1), T, D, W, S, E); ); xcd_barrier(bar);
    PHASE1(7, unsigned char* ws = a.ws; pg8::StaticOrder S; S.init(T, D, G, b); EpiGB E{(const bf16*)(ws + WS_ZG), (const bf16*)(ws + WS_MP), (bf16*)(ws + WS_ZR)};
        gemm_any(c, (const bf16*)(ws + WS_YB), (const bf16*)(ws + WS_WB + (size_t)L * WS_WL1), T, D, W, S, E); ); xcd_barrier(bar);
#endif
#if REP_K == 8
    PHASE1(8, unsigned char* ws = a.ws; pg8::StaticOrder S; S.init(T, D, G, b); EpiOut E{L == 0 ? a.in[I_X] : a.out, (float*)(ws + WS_R), (const float*)(ws + WS_MODF) + L * 6144 + 2048};
        gemm_any(c, (const bf16*)(ws + WS_MP), (const bf16*)(ws + WS_WO + (size_t)L * WS_WL1), T, D, D, S, E); ); xcd_barrier(bar);
    PHASE1(8, unsigned char* ws = a.ws; pg8::StaticOrder S; S.init(T, D, G, b); EpiOut E{L == 0 ? a.in[I_X] : a.out, (float*)(ws + WS_R), (const float*)(ws + WS_MODF) + L * 6144 + 2048};
        gemm_any(c, (const bf16*)(ws + WS_MP), (const bf16*)(ws + WS_WO + (size_t)L * WS_WL1), T, D, D, S, E); ); xcd_barrier(bar);
#endif
    PHASE1(7, unsigned char* ws = a.ws; pg8::StaticOrder S; S.init(T, D, G, b); EpiGB E{(const bf16*)(ws + WS_ZG), (const bf16*)(ws + WS_MP), (bf16*)(ws + WS_MP)};
        gemm_any(c, (const bf16*)(ws + WS_YB), (const bf16*)(ws + WS_WB + (size_t)L * WS_WL1), T, D, W, S, E); );
    BAR();
    PHASE1(8, unsigned char* ws = a.ws; pg8::StaticOrder S; S.init(T, D, G, b); EpiOut E{L == 0 ? a.in[I_X] : a.out, a.out, (const float*)(ws + WS_MODF) + L * 6144 + 2048};
        gemm_any(c, (const bf16*)(ws + WS_MP), (const bf16*)(ws + WS_WO + (size_t)L * WS_WL1), T, D, D, S, E); );
    BAR();
#if REP_K == 9
    PHASE1(9, phase_ln1(a, c, L, (float*)(a.ws + WS_ZR)); ); xcd_barrier(bar); PHASE1(9, phase_ln1(a, c, L, (float*)(a.ws + WS_ZR)); ); xcd_barrier(bar);
#endif
#if REP_K == 91
    PHASE1(9, phase_ln1(a, c, L, (float*)(a.ws + WS_ZR), 1); ); xcd_barrier(bar); PHASE1(9, phase_ln1(a, c, L, (float*)(a.ws + WS_ZR), 1); ); xcd_barrier(bar);
#endif
#if REP_K == 92
    PHASE1(9, phase_ln1(a, c, L, (float*)(a.ws + WS_ZR), 2); ); xcd_barrier(bar); PHASE1(9, phase_ln1(a, c, L, (float*)(a.ws + WS_ZR), 2); ); xcd_barrier(bar);
#endif
    PHASE1(9, phase_ln1(a, c, L, a.out); );
    BAR();
    PHASE(10, phase_perm(a, c, L); );
    BAR();
    PHASE(11, unsigned char* ws = a.ws; MoeSched S; S.init((const unsigned*)(ws + WS_TOT), G, b); EpiSwi E{(bf16*)(ws + WS_HID)};
        gemm_gather(c, (const bf16*)(ws + WS_XN), (const int*)(ws + WS_S2T), (const bf16*)(ws + WS_WGU), MAXSLOT, NE * 1024, D, S, E); );
    BAR();
    PHASE(12, unsigned char* ws = a.ws; MoeSched S; S.init((const unsigned*)(ws + WS_TOT), G, b); EpiDown E{(const int*)(ws + WS_S2T), (const float*)(ws + WS_TOKW), (bf16*)(ws + WS_Y)};
        gemm_any(c, (const bf16*)(ws + WS_HID), (const bf16*)(ws + WS_WD), MAXSLOT, NE * 1024, FF, S, E); );
    BAR();
#if REP_K == 13
    PHASE1(13, phase_ln2(a, c, L, (float*)(a.ws + WS_R)); ); xcd_barrier(bar); PHASE1(13, phase_ln2(a, c, L, (float*)(a.ws + WS_R)); ); xcd_barrier(bar);
#endif
    PHASE1(13, phase_ln2(a, c, L, a.out); );
    if (L + 1 < DEPTH) BAR();
    (void)bk_;
#undef BAR
}

__global__ void __launch_bounds__(NTHREADS, 2) mk_fwd(Args a_unused) {
    extern __shared__ __attribute__((aligned(16))) unsigned char lds[];
    const int wave_s = __builtin_amdgcn_readfirstlane(threadIdx.x >> 6);
    for (int u = threadIdx.x; u < (LDS_BYTES - LDSCTL_OFF) / 4; u += NTHREADS) ((LAS unsigned*)((LAS unsigned char*)lds + LDSCTL_OFF))[u] = 0u;
    __syncthreads();
    const XcdBarrier bar = xcd_barrier_post((unsigned*)(args_here()->ws + WS_CTL) + CW_BAR, (volatile LAS unsigned*)((LAS unsigned char*)lds + LDSCTL_OFF) + 8);
    STAMP(0);
    PHASE(100, phase_p0a(a, c); );
    xcd_barrier(bar); STAMP(1);
    PHASE(101, phase_p0b(a, c); );
    xcd_barrier(bar); STAMP(2);
    run_layer<0>(wave_s, lds, bar);
    run_layer<1>(wave_s, lds, bar);
#if PROBE_A >= 0
    if (blockIdx.x == 0) {
        asm volatile("s_waitcnt vmcnt(0)" ::: "memory"); __syncthreads();
        if (threadIdx.x == 0) ((unsigned long long*)(args_here()->ws + WS_TS))[30] = __builtin_amdgcn_s_memrealtime();
        asm volatile("s_waitcnt vmcnt(0)" ::: "memory"); __syncthreads();
        const volatile unsigned long long* ts = (const volatile unsigned long long*)(args_here()->ws + WS_TS);
        float da = 0.f, db = 0.f;
        if (PROBE_A < 14) { da = (float)(ts[3 + PROBE_A] - ts[2 + PROBE_A]) + (float)(ts[17 + PROBE_A] - ts[16 + PROBE_A]); } else if (PROBE_A == 14) da = (float)(ts[1] - ts[0]); else if (PROBE_A == 15) da = (float)(ts[2] - ts[1]); else da = (float)(ts[30] - ts[0]);
        if (PROBE_B >= 0 && PROBE_B < 14) { db = (float)(ts[3 + PROBE_B] - ts[2 + PROBE_B]) + (float)(ts[17 + PROBE_B] - ts[16 + PROBE_B]); } else if (PROBE_B == 14) db = (float)(ts[1] - ts[0]); else if (PROBE_B == 15) db = (float)(ts[2] - ts[1]);
        da *= 0.01f; db *= 0.01f;
        da = exp2f(0.25f * rintf(4.0f * log2f(fmaxf(da, 0.5f)))); db = exp2f(0.25f * rintf(4.0f * log2f(fmaxf(db, 0.5f))));
        float* out = args_here()->out;
        for (int i = threadIdx.x; i < 16 * 1024; i += NTHREADS) { const int r = i >> 10, col = i & 1023; const int rowi = (r & 7) + 2048 * (r >> 3); out[(size_t)rowi * D + col] = da; }
        if (threadIdx.x == 0 && PROBE_B >= 0) out[(size_t)4096 * D] = 100.0f * db;
    }
#endif
}

extern "C" void kernel_launch(void* const* d_in, const int* in_sizes, int n_in, void* d_out, int out_size, void* d_ws, size_t ws_size, hipStream_t stream) {
    static int grid = 0;
    if (grid == 0) {
        if (n_in != N_IN || out_size != T * D || ws_size < WS_END2) { fprintf(stderr, "kernel_launch: unexpected shapes: n_in %d out %d ws %zu (need %zu)\n", n_in, out_size, ws_size, (size_t)WS_END2); grid = -1; return; }
        int dev = 0, cus = 0;
        (void)hipGetDevice(&dev); (void)hipDeviceGetAttribute(&cus, hipDeviceAttributeMultiprocessorCount, dev);
        if (hipFuncSetAttribute((const void*)mk_fwd, hipFuncAttributeMaxDynamicSharedMemorySize, LDS_BYTES) != hipSuccess) { fprintf(stderr, "kernel_launch: hipFuncSetAttribute failed\n"); grid = -1; return; }
        grid = cus > 0 ? cus : 256;
        fprintf(stderr, "kernel_launch: ws_size %zu grid %d\n", ws_size, grid);
    }
    if (grid < 0) return;
    (void)hipMemsetAsync((char*)d_ws + WS_CTL, 0, CTL_BYTES, stream);
    Args a{};
    for (int i = 0; i < N_IN; ++i) a.in[i] = (const float*)d_in[i];
    a.out = (float*)d_out; a.ws = (unsigned char*)d_ws;
    a.ph_lo = 0; a.ph_hi = 1000;
    hipLaunchKernelGGL(mk_fwd, dim3(grid), dim3(NTHREADS), LDS_BYTES, stream, a);
}
```

```cpp
#include <hip/hip_runtime.h>
#include <cstdio>
#include <cstdint>
#include <utility>

typedef unsigned short bf16;
typedef _Float16 f16;
typedef float f32x4 __attribute__((ext_vector_type(4)));
typedef unsigned u32x4 __attribute__((ext_vector_type(4)));
typedef unsigned u32x2 __attribute__((ext_vector_type(2)));

constexpr int T = 16384, D = 1024, W = 512, NH = 8, HN = 64, RC = 1792, INC = 4864;
constexpr int NE = 16, FF = 512, DEPTH = 2;
constexpr float LN_EPS = 1e-5f, GN_EPS = 64e-5f, ALPHA = 1.41421356237f;
constexpr int NTHREADS = 512, NWAVES = 8;
constexpr int MAXSLOT = 36864;

constexpr size_t MiB = 1u << 20;
constexpr size_t WS_CTL = 0, CTL_BYTES = 1 * MiB;
constexpr int CW_CNT = 16384;
constexpr size_t WS_PART = 1 * MiB;
constexpr size_t WS_MODF = 2 * MiB;
constexpr size_t WS_TOKI = 2 * MiB + 65536;
constexpr size_t WS_TOKW = WS_TOKI + 131072;
constexpr size_t WS_TOKP = WS_TOKW + 131072;
constexpr size_t WS_S2T = 3 * MiB;
constexpr size_t WS_BLKCNT = 3 * MiB + 512 * 1024;
constexpr size_t WS_TOT = WS_BLKCNT + 32768;
constexpr size_t WS_LORA = 4 * MiB;
constexpr size_t WS_WIN = 8 * MiB;
constexpr size_t WS_WA = 28 * MiB, WS_WB = 29 * MiB, WS_WO = 30 * MiB, WS_WL1 = 4 * MiB;
constexpr size_t WS_ZG = 36 * MiB;
constexpr size_t WS_XN = 100 * MiB;
constexpr size_t WS_G = 100 * MiB, WS_YB = 116 * MiB;
constexpr size_t WS_ZR = 132 * MiB;
constexpr size_t WS_ZS = 188 * MiB;
constexpr size_t WS_YSC = 132 * MiB;
constexpr size_t WS_ST = 148 * MiB;
constexpr size_t WS_YA = 132 * MiB;
constexpr size_t WS_MP = 164 * MiB;
constexpr size_t WS_XS = 132 * MiB;
constexpr size_t WS_Y = 132 * MiB;
constexpr size_t WS_AA = 224 * MiB, WS_BB = 240 * MiB, WS_WM1 = 256 * MiB, WS_R = 272 * MiB, WS_KP = 288 * MiB, WS_V = 304 * MiB;
constexpr size_t WS_WGU = 224 * MiB;
constexpr size_t WS_WD = 256 * MiB;
constexpr size_t WS_HID = 272 * MiB;
constexpr size_t WS_VF = 320 * MiB;
constexpr size_t WS_END = 336 * MiB;

constexpr size_t LO_W2T = 0, LO_A2T = 65536, LO_G2T = 131072, LO_VM1T = 262144, LO_VM2T = 294912, LO_STRIDE = 524288;

enum { I_X = 0, I_C, I_WMOD, I_BMOD, I_WIN, I_MU, I_W0, I_W2, I_A0, I_A2, I_G2, I_KK, I_KA, I_RK, I_GNG, I_GNB, I_VM0, I_VM1, I_VM2,
       I_SGG, I_SGB, I_WS, I_BS, I_WBA, I_WBB, I_WOUT, I_LN1G, I_LN1B, I_RW, I_RB, I_EG, I_EU, I_ED, I_LN2G, I_LN2B, N_IN };

struct Args { const float* in[N_IN]; float* out; unsigned char* ws; int ph_lo, ph_hi; };
typedef const __attribute__((address_space(4))) Args& ArgsR;

__device__ __forceinline__ float bf2f(bf16 h) { return __uint_as_float(((unsigned)h) << 16); }
__device__ __forceinline__ unsigned f2bfu(float f) { unsigned u = __float_as_uint(f); return (u + 0x7fffu + ((u >> 16) & 1u)) >> 16; }
__device__ __forceinline__ bf16 f2bf(float f) { return __builtin_bit_cast(unsigned short, (__bf16)f); }
typedef __bf16 bf16x2_t __attribute__((ext_vector_type(2)));
__device__ __forceinline__ unsigned pk2(float lo, float hi) { bf16x2_t v; v[0] = (__bf16)lo; v[1] = (__bf16)hi; return __builtin_bit_cast(unsigned, v); }
__device__ __forceinline__ void store4bf(bf16* p, f32x4 v) { u32x2 w; w.x = pk2(v[0], v[1]); w.y = pk2(v[2], v[3]); *(u32x2*)p = w; }
__device__ __forceinline__ f32x4 load4bf(const bf16* p) { u32x2 w = *(const u32x2*)p; f32x4 r; r[0] = __uint_as_float(w.x << 16); r[1] = __uint_as_float(w.x & 0xffff0000u); r[2] = __uint_as_float(w.y << 16); r[3] = __uint_as_float(w.y & 0xffff0000u); return r; }
__device__ __forceinline__ float wave_sum(float v) {
    v += __builtin_bit_cast(float, __builtin_amdgcn_update_dpp(0, __builtin_bit_cast(int, v), 0xB1, 0xF, 0xF, true));
    v += __builtin_bit_cast(float, __builtin_amdgcn_update_dpp(0, __builtin_bit_cast(int, v), 0x4E, 0xF, 0xF, true));
    v += __builtin_bit_cast(float, __builtin_amdgcn_update_dpp(0, __builtin_bit_cast(int, v), 0x141, 0xF, 0xF, true));
    v += __builtin_bit_cast(float, __builtin_amdgcn_update_dpp(0, __builtin_bit_cast(int, v), 0x140, 0xF, 0xF, true));
    v += __builtin_bit_cast(float, __builtin_amdgcn_update_dpp(0, __builtin_bit_cast(int, v), 0x142, 0xA, 0xF, false));
    v += __builtin_bit_cast(float, __builtin_amdgcn_update_dpp(0, __builtin_bit_cast(int, v), 0x143, 0xC, 0xF, false));
    return __builtin_bit_cast(float, __builtin_amdgcn_readlane(__builtin_bit_cast(int, v), 63));
}
__device__ __forceinline__ float sigmoidf_(float x) { return __builtin_amdgcn_rcpf(1.0f + __expf(-x)); }
__device__ __forceinline__ float siluf_(float x) { return x * sigmoidf_(x); }
__device__ __forceinline__ float gelu_tanh(float x) { const float u = 0.7978845608028654f * (x + 0.044715f * x * x * x); return x * (1.0f - __builtin_amdgcn_rcpf(1.0f + __expf(2.0f * u))); }
__device__ __forceinline__ float softplusf_(float y) { return fmaxf(y, 0.f) + log1pf(__expf(-fabsf(y))); }

struct Ctx { int tid, lane, wave, gw, ngw; unsigned char* lds; };

__device__ __forceinline__ void transpose_item(const float* Wsrc, int N, int k0, int n0, bf16* dst, int ldk, float* scr, int lane) {
    float tv[32];
#pragma unroll
    for (int i = 0; i < 32; ++i) tv[i] = Wsrc[(size_t)(k0 + 2 * i + (lane >> 5)) * N + n0 + (lane & 31)];
#pragma unroll
    for (int i = 0; i < 32; ++i) scr[(2 * i + (lane >> 5)) * 33 + (lane & 31)] = tv[i];
    asm volatile("s_waitcnt lgkmcnt(0)" ::: "memory");
    const int c = lane & 7;
#pragma unroll
    for (int j = 0; j < 4; ++j) { const int n = (lane >> 3) + 8 * j; const float* s = scr + (8 * c) * 33 + n;
        u32x4 o; o.x = pk2(s[0 * 33], s[1 * 33]); o.y = pk2(s[2 * 33], s[3 * 33]); o.z = pk2(s[4 * 33], s[5 * 33]); o.w = pk2(s[6 * 33], s[7 * 33]);
        *(u32x4*)(dst + (size_t)n * ldk + k0 + 8 * c) = o; }
    asm volatile("s_waitcnt lgkmcnt(0)" ::: "memory");
}
template <class RowMap>
__device__ __forceinline__ void transpose_matrix_item(const float* Wsrc, int K, int N, bf16* dst, int item, float* scr, int lane, const RowMap& rm) {
    const int nblk = N / 32, kb = item / nblk, nb = item % nblk, n0 = 32 * nb;
    transpose_item(Wsrc, N, 64 * kb, n0, dst + (size_t)rm(n0) * K, K, scr, lane);
}
struct RowId { __device__ __forceinline__ int operator()(int n) const { return n; } };
struct RowGU { int up; __device__ __forceinline__ int operator()(int n) const { return (n >> 7) * 256 + (n & 127) + up * 128; } };

__device__ __forceinline__ void phase_p0a(ArgsR a, const Ctx& c) {
    float* scr = (float*)(c.lds + c.wave * 16384);
    { float* MODF = (float*)(a.ws + WS_MODF); float* red = (float*)(c.lds + 131072);
      for (int cbk = blockIdx.x; cbk < 2 * 96; cbk += gridDim.x) {
          const int l = cbk / 96, n = (cbk % 96) * 64 + c.lane;
          const float* wm = a.in[I_WMOD] + (size_t)l * D * 6144 + (size_t)(c.wave * 128) * 6144 + n;
          float acc0 = 0.f, acc1 = 0.f;
#pragma unroll 16
          for (int k = 0; k < 128; k += 2) { acc0 += siluf_(a.in[I_C][c.wave * 128 + k]) * wm[(size_t)k * 6144]; acc1 += siluf_(a.in[I_C][c.wave * 128 + k + 1]) * wm[(size_t)(k + 1) * 6144]; }
          red[c.wave * 64 + c.lane] = acc0 + acc1;
          __syncthreads();
          if (c.wave == 0) { float sacc = a.in[I_BMOD][l * 6144 + n];
#pragma unroll
              for (int w = 0; w < 8; ++w) sacc += red[w * 64 + c.lane];
              MODF[l * 6144 + n] = sacc; }
          __syncthreads();
      } }
    for (int it = c.gw; it < 2 * (16 + 16 + 32 + 8); it += c.ngw) {
        const int l = it / 72; int r = it % 72; unsigned char* lo = a.ws + WS_LORA + (size_t)l * LO_STRIDE;
        if (r < 16) { transpose_matrix_item(a.in[I_W2] + (size_t)l * 64 * W, 64, W, (bf16*)(lo + LO_W2T), r, scr, c.lane, RowId()); continue; } r -= 16;
        if (r < 16) { transpose_matrix_item(a.in[I_A2] + (size_t)l * 64 * W, 64, W, (bf16*)(lo + LO_A2T), r, scr, c.lane, RowId()); continue; } r -= 16;
        if (r < 32) { transpose_matrix_item(a.in[I_G2] + (size_t)l * 128 * W, 128, W, (bf16*)(lo + LO_G2T), r, scr, c.lane, RowId()); continue; } r -= 32;
        if (l == 1) transpose_matrix_item(a.in[I_VM1], W, 32, (bf16*)(lo + LO_VM1T), r, scr, c.lane, RowId());
    }
    for (int i = blockIdx.x * NTHREADS + c.tid; i < 32 * W; i += gridDim.x * NTHREADS) { const int n = i >> 5, k = i & 31;
        ((bf16*)(a.ws + WS_LORA + LO_STRIDE + LO_VM2T))[i] = f2bf(a.in[I_VM2][(size_t)k * W + n]); }
    constexpr int I_WINL = (D / 64) * (INC / 32);
    constexpr int I_WAL = (W / 64) * (D / 32);
    constexpr int I_WOL = (D / 64) * (D / 32);
    constexpr int PER_L = I_WINL + 2 * I_WAL + I_WOL;
    for (int it = c.gw; it < 2 * PER_L; it += c.ngw) {
        const int l = it / PER_L; int r = it % PER_L;
        if (r < I_WINL) { transpose_matrix_item(a.in[I_WIN] + (size_t)l * D * INC, D, INC, (bf16*)(a.ws + WS_WIN + (size_t)l * 10 * MiB), r, scr, c.lane, RowId()); continue; } r -= I_WINL;
        if (r < I_WAL) { transpose_matrix_item(a.in[I_WBA] + (size_t)l * W * D, W, D, (bf16*)(a.ws + WS_WA + (size_t)l * WS_WL1), r, scr, c.lane, RowId()); continue; } r -= I_WAL;
        if (r < I_WAL) { transpose_matrix_item(a.in[I_WBB] + (size_t)l * W * D, W, D, (bf16*)(a.ws + WS_WB + (size_t)l * WS_WL1), r, scr, c.lane, RowId()); continue; } r -= I_WAL;
        transpose_matrix_item(a.in[I_WOUT] + (size_t)l * D * D, D, D, (bf16*)(a.ws + WS_WO + (size_t)l * WS_WL1), r, scr, c.lane, RowId());
    }
}

__device__ __forceinline__ void row_stats(const float (&v)[16], float& mean, float& rstd) {
    float s = 0.f;
#pragma unroll
    for (int j = 0; j < 16; ++j) s += v[j];
    mean = wave_sum(s) * (1.f / D);
    float q = 0.f;
#pragma unroll
    for (int j = 0; j < 16; ++j) { const float d = v[j] - mean; q += d * d; }
    rstd = __builtin_amdgcn_rsqf(wave_sum(q) * (1.f / D) + LN_EPS);
}
__device__ __forceinline__ void load_row16(const float* p, int lane, float (&v)[16]) {
#pragma unroll
    for (int j = 0; j < 4; ++j) { const f32x4 x = *(const f32x4*)(p + 4 * lane + 256 * j); v[4 * j] = x[0]; v[4 * j + 1] = x[1]; v[4 * j + 2] = x[2]; v[4 * j + 3] = x[3]; }
}

__device__ __forceinline__ void phase_p0b(ArgsR a, const Ctx& c) {
    const float* MODF = (const float*)(a.ws + WS_MODF);
    float sh[16], sc[16];
#pragma unroll
    for (int j = 0; j < 4; ++j) { const f32x4 s0 = *(const f32x4*)(MODF + 4 * c.lane + 256 * j), s1 = *(const f32x4*)(MODF + 1024 + 4 * c.lane + 256 * j);
#pragma unroll
        for (int e = 0; e < 4; ++e) { sh[4 * j + e] = s0[e]; sc[4 * j + e] = 1.f + s1[e]; } }
    bf16* XN = (bf16*)(a.ws + WS_XN);
    for (int m = c.gw; m < T; m += c.ngw) {
        float v[16]; load_row16(a.in[I_X] + (size_t)m * D, c.lane, v);
        float mean, rstd; row_stats(v, mean, rstd);
#pragma unroll
        for (int j = 0; j < 4; ++j) { f32x4 o;
#pragma unroll
            for (int e = 0; e < 4; ++e) o[e] = (v[4 * j + e] - mean) * rstd * sc[4 * j + e] + sh[4 * j + e];
            store4bf(XN + (size_t)m * D + 4 * c.lane + 256 * j, o); }
    }
}

namespace pg8 {
#define PG8_LAS __attribute__((address_space(3)))
typedef unsigned short bf16_t;
typedef short bf16x8 __attribute__((ext_vector_type(8)));
typedef float f32x4 __attribute__((ext_vector_type(4)));
typedef unsigned u32x4 __attribute__((ext_vector_type(4)));
constexpr int BM = 256, BK = 64, HALF = 128, HTB = HALF * BK * 2  , STAGE_BYTES = 8 * HTB, NXCD = 8, WGM = 8;

__host__ __device__ __forceinline__ int lds_byte(int r, int c) { const int st = (r >> 4) * 2 + (c >> 5), rr = r & 15, cc = c & 31, ob = rr * 64 + cc * 2; return st * 1024 + (ob ^ (((ob >> 9) & 1) << 5)); }
__host__ __device__ __forceinline__ void stage_rc(int b, int& R, int& C) { const int st = b / 1024, sb = b % 1024, swz = sb ^ (((sb >> 9) & 1) << 5); R = (st >> 1) * 16 + swz / 64; C = (st & 1) * 32 + (swz % 64) / 2; }
__host__ __device__ __forceinline__ int perm32(int rho) { const int n = rho >> 4, i = rho & 15; return 8 * (i >> 2) + 4 * n + (i & 3); }

struct Unit { int pm, pn; };
struct Gemm { const bf16_t* A; const bf16_t* Bt; int M, N, K; };

struct StaticOrder {
    int nM, nN, nwg, G, c;
    __host__ __device__ void init(int M, int N, int G_, int c_) { nM = M / BM; nN = N / BM; nwg = nM * nN; G = G_; c = c_; }
    __host__ __device__ bool next(int i, Unit& u) const {
        const long L = (long)i * G + c; if (L >= nwg) return false;
        int wgid = (int)L; { const int q = nwg / NXCD, r = nwg % NXCD, xcd = wgid % NXCD, off = wgid / NXCD; wgid = (xcd < r ? xcd * (q + 1) : r * (q + 1) + (xcd - r) * q) + off; }
        const int nig = WGM * nN, gid = wgid / nig, fm = gid * WGM, gsz = (nM - fm) < WGM ? (nM - fm) : WGM;
        u.pm = fm + ((wgid % nig) % gsz); u.pn = (wgid % nig) / gsz; return true;
    }
    __device__ __forceinline__ void a_ready(const Unit&) const {}
    __device__ __forceinline__ void done(const Unit&) const {}
};


template <class Epi, class Sched, bool ALIGN_EPI = false, bool SP2 = false, bool GATHER = false>
__device__ __forceinline__ void gemm_phase(PG8_LAS unsigned char* lds, const Gemm g, const Sched& S, const Epi& E, const int tid_in, const int* s2t = nullptr) {
    const int tid = tid_in, wid = __builtin_amdgcn_readfirstlane(tid >> 6), lane = tid & 63, wr = wid >> 2, wc = wid & 3, fr = lane & 15, fq = lane >> 4;
    const int K = g.K, nt = K / BK;
    unsigned voffA[2], voffB[2];
#pragma unroll
    for (int i = 0; i < 2; ++i) { int R, C; stage_rc(tid * 16 + i * 8192, R, C); const int Rb = Epi::PERM ? ((R & ~31) + perm32(R & 31)) : R;
        voffA[i] = (unsigned)(R * K + C) * 2u; voffB[i] = (unsigned)(Rb * K + C) * 2u; }
    unsigned pc0 = 0u, pc1 = 0u, pn0 = 0u, pn1 = 0u, cvoff = 0u; int R0g = 0;
    if constexpr (GATHER) { int R, C; stage_rc(tid * 16, R, C); R0g = R; cvoff = (unsigned)C * 2u; }
#define PG8_TOKPACK(pm_, h_) ([&]() -> unsigned { const int r0_ = (pm_) * BM + (h_) * HALF + R0g; const int a0_ = s2t[2 * r0_], a1_ = s2t[2 * (r0_ + 64)]; return (unsigned)(a0_ < 0 ? 0 : (a0_ >> 1)) | ((unsigned)(a1_ < 0 ? 0 : (a1_ >> 1)) << 16); }())
#define PG8_STAGE_A(bufoff, base, h, usen) do { if constexpr (GATHER) { const unsigned pk_ = (usen) ? ((h) ? pn1 : pn0) : ((h) ? pc1 : pc0); \
        unsigned vt_[2] = {(pk_ & 0xffffu) * (unsigned)(K * 2) + cvoff, (pk_ >> 16) * (unsigned)(K * 2) + cvoff}; PG8_STAGE(bufoff, base, vt_); } \
    else PG8_STAGE(bufoff, (base) + ((h) ? hstep : (size_t)0), voffA); } while (0)
    const size_t kstep = (size_t)(BK * 2);
    const size_t hstep = (size_t)HALF * K * 2;
    const size_t tstep = 2 * hstep;
    const unsigned ldsw = (unsigned)wid * 1024u;
    const int aoff = lds_byte(wr * 64 + fr, fq * 8), boff = lds_byte(wc * 32 + fr, fq * 8);
#define PG8_SA(b, h) (((b) * 2 + (h)) * HTB)
#define PG8_SB(b, h) ((4 + (b) * 2 + (h)) * HTB)
#define PG8_STAGE(bufoff, gbase, voff) do { _Pragma("unroll") for (int _i = 0; _i < 2; ++_i) \
        __builtin_amdgcn_global_load_lds((const unsigned*)((const char*)(gbase) + (voff)[_i]), (PG8_LAS unsigned*)(lds + (bufoff) + ldsw + _i * 8192), 16, 0, 0); } while (0)
#define PG8_LDA(dst, b, h) do { _Pragma("unroll") for (int m = 0; m < 4; ++m) _Pragma("unroll") for (int k = 0; k < 2; ++k) dst[m][k] = *(const PG8_LAS bf16x8*)(lds + PG8_SA(b, h) + aoff + m * 2048 + k * 1024); } while (0)
#define PG8_LDB(dst, b, h) do { _Pragma("unroll") for (int n = 0; n < 2; ++n) _Pragma("unroll") for (int k = 0; k < 2; ++k) dst[n][k] = *(const PG8_LAS bf16x8*)(lds + PG8_SB(b, h) + boff + n * 2048 + k * 1024); } while (0)
#define PG8_MMA(ai, bj, At, Bt) do { __builtin_amdgcn_s_setprio(1); _Pragma("unroll") for (int m = 0; m < 4; ++m) _Pragma("unroll") for (int n = 0; n < 2; ++n) _Pragma("unroll") for (int k = 0; k < 2; ++k) \
        acc[ai][bj][m][n] = __builtin_amdgcn_mfma_f32_16x16x32_bf16(Bt[n][k], At[m][k], acc[ai][bj][m][n], 0, 0, 0); __builtin_amdgcn_s_setprio(0); } while (0)
#define PG8_WAIT_V(n) asm volatile("s_waitcnt vmcnt(" #n ")" ::: "memory")
#define PG8_WAIT_L(n) asm volatile("s_waitcnt lgkmcnt(" #n ")" ::: "memory")
#define PG8_BAR __builtin_amdgcn_s_barrier()
#define PG8_SCHED __builtin_amdgcn_sched_barrier(0)
    Unit cur, nxt; int ui = 0;
    if (!S.next(0, cur)) return;
    f32x4 acc[2][2][4][2];
#pragma unroll
    for (int a = 0; a < 2; ++a)
#pragma unroll
        for (int b = 0; b < 2; ++b)
#pragma unroll
            for (int m = 0; m < 4; ++m)
#pragma unroll
                for (int n = 0; n < 2; ++n) acc[a][b][m][n] = (f32x4){0.f, 0.f, 0.f, 0.f};
    bf16x8 At[4][2], B0[2][2], B1[2][2];
    const char* cA = (const char*)g.A + (GATHER ? (size_t)0 : (size_t)cur.pm * tstep); const char* cB = (const char*)g.Bt + (size_t)cur.pn * tstep;
    if constexpr (GATHER) { pc0 = PG8_TOKPACK(cur.pm, 0); pc1 = PG8_TOKPACK(cur.pm, 1); }
    S.a_ready(cur);
    if constexpr (SP2) {
        PG8_STAGE(PG8_SB(0, 0), cB, voffB); PG8_STAGE(PG8_SB(0, 1), cB + hstep, voffB); PG8_STAGE_A(PG8_SA(0, 0), cA, 0, false); PG8_STAGE_A(PG8_SA(0, 1), cA, 1, false);
        if (wr == 1) PG8_BAR;
        PG8_WAIT_V(2); PG8_BAR;
        PG8_STAGE(PG8_SB(1, 0), cB + kstep, voffB); PG8_STAGE_A(PG8_SA(1, 0), cA + kstep, 0, false); PG8_STAGE(PG8_SB(1, 1), cB + hstep + kstep, voffB);
        PG8_WAIT_V(6); PG8_BAR;
    } else {
        PG8_STAGE(PG8_SB(0, 0), cB, voffB); PG8_STAGE(PG8_SA(0, 0), cA, voffA); PG8_STAGE(PG8_SB(0, 1), cB + hstep, voffB); PG8_STAGE(PG8_SA(0, 1), cA + hstep, voffA);
        if (wr == 1) PG8_BAR;
        PG8_WAIT_V(4); PG8_BAR;
        PG8_STAGE(PG8_SB(1, 0), cB + kstep, voffB); PG8_STAGE(PG8_SA(1, 0), cA + kstep, voffA); PG8_STAGE(PG8_SB(1, 1), cB + hstep + kstep, voffB);
        PG8_WAIT_V(6); PG8_BAR;
    }
    for (;;) {
        const bool has_next = S.next(ui + 1, nxt);
        const char* nA = (has_next && !GATHER) ? (const char*)g.A + (size_t)nxt.pm * tstep : cA; const char* nB = has_next ? (const char*)g.Bt + (size_t)nxt.pn * tstep : cB;
        if constexpr (GATHER) { if (has_next) { pn0 = PG8_TOKPACK(nxt.pm, 0); pn1 = PG8_TOKPACK(nxt.pm, 1); } else { pn0 = pc0; pn1 = pc1; } }
        for (int t = 0; t < nt; t += 2) {
            const bool last = (t == nt - 2);
            const char* a1 = cA + (size_t)(t + 1) * kstep;
            const char* a2 = last ? nA : cA + (size_t)(t + 2) * kstep; const char* b2 = last ? nB : cB + (size_t)(t + 2) * kstep;
            const char* a3 = a2 + kstep; const char* b3 = b2 + kstep;
            if (last && has_next) S.a_ready(nxt);
            if constexpr (SP2) {
            PG8_LDB(B0, 0, 0); PG8_LDB(B1, 0, 1); PG8_SCHED; PG8_LDA(At, 0, 0); PG8_STAGE_A(PG8_SA(1, 1), a1, 1, false);
            PG8_WAIT_V(8); PG8_WAIT_L(0); PG8_BAR; PG8_MMA(0, 0, At, B0); PG8_MMA(0, 1, At, B1); PG8_BAR; PG8_SCHED;
            PG8_LDA(At, 0, 1); PG8_STAGE(PG8_SB(0, 0), b2, voffB); PG8_STAGE(PG8_SB(0, 1), b2 + hstep, voffB); PG8_STAGE_A(PG8_SA(0, 0), a2, 0, last);
            PG8_WAIT_V(8); PG8_WAIT_L(0); PG8_BAR; PG8_MMA(1, 0, At, B0); PG8_MMA(1, 1, At, B1); PG8_BAR; PG8_SCHED;
            PG8_LDB(B0, 1, 0); PG8_LDB(B1, 1, 1); PG8_SCHED; PG8_LDA(At, 1, 0); PG8_STAGE_A(PG8_SA(0, 1), a2, 1, last);
            PG8_WAIT_V(8); PG8_WAIT_L(0); PG8_BAR; PG8_MMA(0, 0, At, B0); PG8_MMA(0, 1, At, B1); PG8_BAR; PG8_SCHED;
            PG8_LDA(At, 1, 1); PG8_STAGE(PG8_SB(1, 0), b3, voffB); PG8_STAGE(PG8_SB(1, 1), b3 + hstep, voffB); PG8_STAGE_A(PG8_SA(1, 0), a3, 0, last);
            PG8_WAIT_V(8); PG8_WAIT_L(0); PG8_BAR; PG8_MMA(1, 0, At, B0); PG8_MMA(1, 1, At, B1); PG8_BAR; PG8_SCHED;
            } else {
            PG8_LDB(B0, 0, 0); PG8_SCHED; PG8_LDA(At, 0, 0); PG8_STAGE(PG8_SA(1, 1), a1 + hstep, voffA);
            PG8_WAIT_L(8); PG8_BAR; PG8_WAIT_L(0); PG8_MMA(0, 0, At, B0); PG8_BAR; PG8_SCHED;
            PG8_LDB(B1, 0, 1); PG8_STAGE(PG8_SB(0, 0), b2, voffB);
            PG8_BAR; PG8_WAIT_L(0); PG8_MMA(0, 1, At, B1); PG8_BAR;
            PG8_LDA(At, 0, 1); PG8_STAGE(PG8_SA(0, 0), a2, voffA);
            PG8_BAR; PG8_WAIT_L(0); PG8_MMA(1, 0, At, B0); PG8_BAR; PG8_SCHED;
            PG8_STAGE(PG8_SB(0, 1), b2 + hstep, voffB);
            PG8_WAIT_V(6); PG8_BAR; PG8_MMA(1, 1, At, B1); PG8_BAR;
            PG8_LDB(B0, 1, 0); PG8_SCHED; PG8_LDA(At, 1, 0); PG8_STAGE(PG8_SA(0, 1), a2 + hstep, voffA);
            PG8_WAIT_L(8); PG8_BAR; PG8_WAIT_L(0); PG8_MMA(0, 0, At, B0); PG8_BAR; PG8_SCHED;
            PG8_LDB(B1, 1, 1); PG8_STAGE(PG8_SB(1, 0), b3, voffB);
            PG8_BAR; PG8_WAIT_L(0); PG8_MMA(0, 1, At, B1); PG8_BAR;
            PG8_LDA(At, 1, 1); PG8_STAGE(PG8_SA(1, 0), a3, voffA);
            PG8_BAR; PG8_WAIT_L(0); PG8_MMA(1, 0, At, B0); PG8_BAR; PG8_SCHED;
            PG8_STAGE(PG8_SB(1, 1), b3 + hstep, voffB);
            PG8_WAIT_V(6); PG8_BAR; PG8_MMA(1, 1, At, B1); PG8_BAR;
            }
        }
        if constexpr (ALIGN_EPI) { if (wr == 0) PG8_BAR; }
        if constexpr (!Epi::AFTER_DRAIN) { E(acc, cur, wr, wc, fr, fq); S.done(cur); }
        if (!has_next) break;
#pragma unroll
        for (int a = 0; a < 2; ++a)
#pragma unroll
            for (int b = 0; b < 2; ++b)
#pragma unroll
                for (int m = 0; m < 4; ++m)
#pragma unroll
                    for (int n = 0; n < 2; ++n) acc[a][b][m][n] = (f32x4){0.f, 0.f, 0.f, 0.f};
        cur = nxt; cA = nA; cB = nB; ++ui; if constexpr (GATHER) { pc0 = pn0; pc1 = pn1; }
        if constexpr (ALIGN_EPI) { if (wr == 1) PG8_BAR; }
    }
    PG8_WAIT_V(0);
    if constexpr (!ALIGN_EPI) { if (wr == 0) PG8_BAR; }
    PG8_BAR;
    if constexpr (Epi::AFTER_DRAIN) { E.fused(acc, cur, wr, wc, fr, fq, lds, wid, lane); S.done(cur); }
#undef PG8_SA
#undef PG8_SB
#undef PG8_STAGE
#undef PG8_STAGE_A
#undef PG8_TOKPACK
#undef PG8_LDA
#undef PG8_LDB
#undef PG8_MMA
#undef PG8_WAIT_V
#undef PG8_WAIT_L
#undef PG8_BAR
#undef PG8_SCHED
}
}

using pg8::Unit;
struct DenseSched { int nN, n, G, c;
    __device__ __forceinline__ void a_ready(const Unit&) const {}
    __device__ __forceinline__ void done(const Unit&) const {}
    __device__ __forceinline__ bool next(int i, Unit& u) const { const int L = i * G + c; if (L >= n) return false; u.pm = L / nN; u.pn = L % nN; return true; } };

__device__ __forceinline__ void store8bf(bf16* p, f32x4 lo, f32x4 hi) { u32x4 w; w.x = pk2(lo[0], lo[1]); w.y = pk2(lo[2], lo[3]); w.z = pk2(hi[0], hi[1]); w.w = pk2(hi[2], hi[3]); *(u32x4*)p = w; }
__device__ __forceinline__ void load8bf(const bf16* p, f32x4& lo, f32x4& hi) { const u32x4 w = *(const u32x4*)p;
    lo[0] = __uint_as_float(w.x << 16); lo[1] = __uint_as_float(w.x & 0xffff0000u); lo[2] = __uint_as_float(w.y << 16); lo[3] = __uint_as_float(w.y & 0xffff0000u);
    hi[0] = __uint_as_float(w.z << 16); hi[1] = __uint_as_float(w.z & 0xffff0000u); hi[2] = __uint_as_float(w.w << 16); hi[3] = __uint_as_float(w.w & 0xffff0000u); }
struct EpiZ { bf16 *ZR, *ZS, *ZG;
    __device__ __forceinline__ void one(int row, int col, f32x4 lo, f32x4 hi) const {
        if (col < RC) store8bf(ZR + (size_t)row * RC + col, lo, hi);
        else if (col < RC + 1024) { for (int e = 0; e < 4; ++e) { lo[e] = gelu_tanh(lo[e]); hi[e] = gelu_tanh(hi[e]); } store8bf(ZS + (size_t)row * 1024 + (col - RC), lo, hi); }
        else { for (int e = 0; e < 4; ++e) { lo[e] = sigmoidf_(lo[e]); hi[e] = sigmoidf_(hi[e]); } store8bf(ZG + (size_t)row * 2048 + (col - RC - 1024), lo, hi); } }
    __device__ __forceinline__ void operator()(int row, int col, f32x4 a0, f32x4 a1, f32x4 b0, f32x4 b1) const { one(row, col, a0, a1); one(row, col + 128, b0, b1); } };
struct EpiGA { const bf16* ZG; bf16* MP;
    __device__ __forceinline__ void one(int row, int col, f32x4 lo, f32x4 hi) const { f32x4 g0, g1; load8bf(ZG + (size_t)row * 2048 + col, g0, g1); store8bf(MP + (size_t)row * D + col, g0 * lo, g1 * hi); }
    __device__ __forceinline__ void operator()(int row, int col, f32x4 a0, f32x4 a1, f32x4 b0, f32x4 b1) const { one(row, col, a0, a1); one(row, col + 128, b0, b1); } };
struct EpiGB { const bf16* ZG; const bf16* MPin; bf16* MP;
    __device__ __forceinline__ void one(int row, int col, f32x4 lo, f32x4 hi) const { f32x4 g0, g1, m0, m1; load8bf(ZG + (size_t)row * 2048 + 1024 + col, g0, g1); load8bf(MPin + (size_t)row * D + col, m0, m1);
        store8bf(MP + (size_t)row * D + col, m0 + g0 * lo, m1 + g1 * hi); }
    __device__ __forceinline__ void operator()(int row, int col, f32x4 a0, f32x4 a1, f32x4 b0, f32x4 b1) const { one(row, col, a0, a1); one(row, col + 128, b0, b1); } };
struct EpiOut { const float* xin; float* out; const float* gate1;
    __device__ __forceinline__ void one(int row, int col, f32x4 v) const { const f32x4 x = *(const f32x4*)(xin + (size_t)row * D + col); const f32x4 g = *(const f32x4*)(gate1 + col);
        *(f32x4*)(out + (size_t)row * D + col) = ALPHA * x + (1.0f + g) * v; }
    __device__ __forceinline__ void operator()(int row, int col, f32x4 a0, f32x4 a1, f32x4 b0, f32x4 b1) const { one(row, col, a0); one(row, col + 4, a1); one(row, col + 128, b0); one(row, col + 132, b1); } };
struct EpiSwi { bf16* HID;
    __device__ __forceinline__ void operator()(int row, int col, f32x4 a0, f32x4 a1, f32x4 b0, f32x4 b1) const { const int ct = (col >> 8) & 3, cc = col & 127;
        f32x4 h0, h1; for (int e = 0; e < 4; ++e) { h0[e] = siluf_(a0[e]) * b0[e]; h1[e] = siluf_(a1[e]) * b1[e]; } store8bf(HID + (size_t)row * FF + ct * 128 + cc, h0, h1); } };
struct EpiDown { const int* S2T; const float* TOKW; bf16* Y;
    __device__ __forceinline__ void operator()(int row, int col, f32x4 a0, f32x4 a1, f32x4 b0, f32x4 b1) const { const u32x2 sw = *(const u32x2*)(S2T + 2 * row); const int st = (int)sw.x; if (st < 0) return; const float w = __uint_as_float(sw.y); const int cc = col & 1023;
        store8bf(Y + (size_t)st * D + cc, w * a0, w * a1); store8bf(Y + (size_t)st * D + cc + 128, w * b0, w * b1); } };

struct MoeSched { int ts[17]; int G, c;
    __device__ __forceinline__ void a_ready(const Unit&) const {}
    __device__ __forceinline__ void done(const Unit&) const {}
    __device__ __forceinline__ void init(const unsigned* cnt, int G_, int c_) { G = G_; c = c_; int s = 0;
#pragma unroll
        for (int e = 0; e < 16; ++e) { ts[e] = s; s += ((int)cnt[e] + 255) >> 8; } ts[16] = s; }
    __device__ __forceinline__ bool next(int i, Unit& u) const { const int L = i * G + c; if (L >= 4 * ts[16]) return false; const int rt = L >> 2, ct = L & 3; int e = 0;
#pragma unroll
        for (int j = 1; j < 16; ++j) e += (rt >= ts[j]) ? 1 : 0;
        u.pm = rt; u.pn = e * 4 + ct; return true; } };

__device__ __forceinline__ void phase_prep_simple(ArgsR a, const Ctx& c, int l) {
    const bf16* ZR = (const bf16*)(a.ws + WS_ZR);
    const float* mu = a.in[I_MU] + l * RC; const float* w0 = a.in[I_W0] + l * W; const float* w2 = a.in[I_W2] + (size_t)l * 64 * W;
    const float* a0 = a.in[I_A0] + l * W; const float* a2 = a.in[I_A2] + (size_t)l * 64 * W; const float* g2 = a.in[I_G2] + (size_t)l * 128 * W;
    const float* k_k = a.in[I_KK] + l * W; const float* k_a = a.in[I_KA] + l * W;
    const float* vm0 = a.in[I_VM0]; const float* vm1 = a.in[I_VM1]; const float* vm2 = a.in[I_VM2];
    f16* R = (f16*)(a.ws + WS_R); f16* WM1 = (f16*)(a.ws + WS_WM1); f16* KP = (f16*)(a.ws + WS_KP); f16* AA = (f16*)(a.ws + WS_AA); f16* BB = (f16*)(a.ws + WS_BB); f16* V = (f16*)(a.ws + WS_V);
    bf16* G = (bf16*)(a.ws + WS_G); bf16* VF = (bf16*)(a.ws + WS_VF);
    const int lane = c.lane;
    for (int t = c.gw; t < T; t += c.ngw) {
        float z[28];
#pragma unroll
        for (int i = 0; i < 28; ++i) { const int col = lane + 64 * i; const float zc = bf2f(ZR[(size_t)t * RC + col]); const float zp = t > 0 ? bf2f(ZR[(size_t)(t - 1) * RC + col]) : 0.f; z[i] = zc + (zp - zc) * mu[col]; }
        const float tw = tanhf(z[24]), za = z[25], sg0 = sigmoidf_(z[26]), sg1 = sigmoidf_(z[27]);
        float wlo[8], alo[8], gg[8];
#pragma unroll
        for (int i = 0; i < 8; ++i) { wlo[i] = 0.f; alo[i] = 0.f; gg[i] = 0.f; }
        for (int j = 0; j < 64; ++j) { const float tj = __shfl(tw, j), aj = __shfl(za, j), s0 = __shfl(sg0, j), s1 = __shfl(sg1, j);
#pragma unroll
            for (int i = 0; i < 8; ++i) { const int n = lane + 64 * i; wlo[i] += tj * w2[j * W + n]; alo[i] += aj * a2[j * W + n]; gg[i] += s0 * g2[j * W + n] + s1 * g2[(64 + j) * W + n]; } }
        float vv[8];
#pragma unroll
        for (int i = 0; i < 8; ++i) vv[i] = z[16 + i];
        if (l == 0) {
#pragma unroll
            for (int i = 0; i < 8; ++i) VF[(size_t)t * W + lane + 64 * i] = f2bf(vv[i]);
        } else {
            float vmid = 0.f;
#pragma unroll
            for (int i = 0; i < 8; ++i)
                for (int j = 0; j < 64; ++j) { const float vc = __shfl(vv[i], j); vmid += vc * vm1[(size_t)(64 * i + j) * 32 + (lane & 31)]; }
            float vg[8];
#pragma unroll
            for (int i = 0; i < 8; ++i) vg[i] = 0.f;
            for (int m = 0; m < 32; ++m) { const float vmm = __shfl(vmid, m);
#pragma unroll
                for (int i = 0; i < 8; ++i) vg[i] += vmm * vm2[m * W + lane + 64 * i]; }
#pragma unroll
            for (int i = 0; i < 8; ++i) { const int n = lane + 64 * i; const float vf = bf2f(VF[(size_t)t * W + n]); vv[i] = vv[i] + (vf - vv[i]) * sigmoidf_(vm0[n] + vg[i]); }
        }
#pragma unroll
        for (int i = 0; i < 8; ++i) {
            const int n = lane + 64 * i; const size_t o = (size_t)t * W + n;
            const float x = w0[n] + wlo[i]; const float wl = -softplusf_(-x) - 0.5f; const float dm1 = expm1f(-__expf(wl));
            const float av = sigmoidf_(a0[n] + alo[i]);
            const float kraw = z[8 + i];
            float kk = kraw * k_k[n]; const float nrm = sqrtf(wave_sum(kk * kk)); kk = kk / fmaxf(nrm, 1e-12f);
            const float kp = kraw * (1.0f + (av - 1.0f) * k_a[n]);
            R[o] = (f16)z[i]; WM1[o] = (f16)dm1; KP[o] = (f16)kp; AA[o] = (f16)(-kk); BB[o] = (f16)(kk * av); V[o] = (f16)vv[i]; G[o] = f2bf(gg[i]);
        }
    }
}

__device__ __forceinline__ void phase_sg_simple(ArgsR a, const Ctx& c, int l) {
    const bf16* ZS = (const bf16*)(a.ws + WS_ZS); bf16* YB = (bf16*)(a.ws + WS_YB);
    const float* lng = a.in[I_SGG] + l * W; const float* lnb = a.in[I_SGB] + l * W;
    float* vn = (float*)c.lds;
    float* st = vn + 128 * 64;
    for (int uidx = blockIdx.x; uidx < 128 * 8; uidx += gridDim.x) {
        const int ch = uidx >> 3, g = uidx & 7; const int tok0 = ch * 128;
        for (int i = 0; i < 16; ++i) { const int s = c.wave * 16 + i; const bf16* p = ZS + (size_t)(tok0 + s) * 1024 + 512 + c.lane * 8;
            const f32x4 x0 = load4bf(p), x1 = load4bf(p + 4);
            float sm = (x0[0] + x0[1]) + (x0[2] + x0[3]) + (x1[0] + x1[1]) + (x1[2] + x1[3]); const float mean = wave_sum(sm) * (1.f / 512.f);
            float q = 0.f; for (int e = 0; e < 4; ++e) { const float d0 = x0[e] - mean, d1 = x1[e] - mean; q += d0 * d0 + d1 * d1; }
            const float rstd = __builtin_amdgcn_rsqf(wave_sum(q) * (1.f / 512.f) + LN_EPS);
            if (c.lane == 0) { st[2 * s] = mean; st[2 * s + 1] = rstd; } }
        __syncthreads();
        for (int i = c.tid; i < 128 * 64; i += NTHREADS) { const int s = i >> 6, d = i & 63; const float x = bf2f(ZS[(size_t)(tok0 + s) * 1024 + 512 + g * 64 + d]);
            vn[i] = (x - st[2 * s]) * st[2 * s + 1] * lng[g * 64 + d] + lnb[g * 64 + d]; }
        __syncthreads();
        const int d = c.tid & 63, tq = c.tid >> 6;
        const float* Wg = a.in[I_WS] + (size_t)(l * 8 + g) * 128 * 128; const float* bs = a.in[I_BS] + (size_t)(l * 8 + g) * 128;
        for (int i = 0; i < 16; ++i) { const int t = tq + 8 * i; float acc = 0.f;
            for (int s = 0; s <= t; ++s) acc += Wg[t * 128 + s] * vn[s * 64 + d];
            const float u = bf2f(ZS[(size_t)(tok0 + t) * 1024 + g * 64 + d]);
            YB[(size_t)(tok0 + t) * W + g * 64 + d] = f2bf(u * (acc + bs[t])); }
        __syncthreads();
    }
}

#define LAS3 __attribute__((address_space(3)))
typedef short bf16x8 __attribute__((ext_vector_type(8)));
template <int MT, int NT, int KS, bool SWAP = false>
__device__ __forceinline__ void mma_lds_glob(const unsigned char* lds_base, int a_off_bytes, int lda, const bf16* Bt, int ldb, int n0, int lane, f32x4 (&acc)[MT][NT]) {
    const int fr = lane & 15, fq = lane >> 4;
    const LAS3 unsigned char* Ab = (const LAS3 unsigned char*)lds_base + a_off_bytes;
    int boff = (n0 + fr) * ldb + 8 * fq; asm volatile("" : "+v"(boff));
#pragma unroll
    for (int ks = 0; ks < KS; ++ks) {
        bf16x8 b[NT];
#pragma unroll
        for (int n = 0; n < NT; ++n) b[n] = *(const bf16x8*)(Bt + boff + 16 * n * ldb + 32 * ks);
#pragma unroll
        for (int m = 0; m < MT; ++m) { const bf16x8 av = *(const LAS3 bf16x8*)(Ab + ((16 * m + fr) * lda + 32 * ks + 8 * fq) * 2);
#pragma unroll
            for (int n = 0; n < NT; ++n) acc[m][n] = SWAP ? __builtin_amdgcn_mfma_f32_16x16x32_bf16(b[n], av, acc[m][n], 0, 0, 0) : __builtin_amdgcn_mfma_f32_16x16x32_bf16(av, b[n], acc[m][n], 0, 0, 0); }
    }
}
__device__ __forceinline__ void zshift8(const bf16* ZR, int t, int col, const float* mu, float (&o)[8]) {
    const u32x4 zc = *(const u32x4*)(ZR + (size_t)t * RC + col);
    u32x4 zp = {0u, 0u, 0u, 0u}; if (t > 0) zp = *(const u32x4*)(ZR + (size_t)(t - 1) * RC + col);
    const f32x4 m0 = *(const f32x4*)(mu + col), m1 = *(const f32x4*)(mu + col + 4);
#pragma unroll
    for (int e = 0; e < 4; ++e) { const float c0 = __uint_as_float(zc[e] << 16), c1 = __uint_as_float(zc[e] & 0xffff0000u), p0 = __uint_as_float(zp[e] << 16), p1 = __uint_as_float(zp[e] & 0xffff0000u);
        const float mu0 = (2 * e < 4) ? m0[(2 * e) & 3] : m1[(2 * e) & 3], mu1 = (2 * e + 1 < 4) ? m0[(2 * e + 1) & 3] : m1[(2 * e + 1) & 3];
        o[2 * e] = c0 + (p0 - c0) * mu0; o[2 * e + 1] = c1 + (p1 - c1) * mu1; }
}
typedef _Float16 f16x8 __attribute__((ext_vector_type(8)));
typedef _Float16 f16x4 __attribute__((ext_vector_type(4)));
__device__ __forceinline__ void store8f16(f16* p, const float (&v)[8]) { f16x8 h;
#pragma unroll
    for (int e = 0; e < 8; ++e) h[e] = (f16)v[e];
    *(f16x8*)p = h; }
__device__ __forceinline__ u32x4 pack8bf(const float (&v)[8]) { u32x4 w; w.x = pk2(v[0], v[1]); w.y = pk2(v[2], v[3]); w.z = pk2(v[4], v[5]); w.w = pk2(v[6], v[7]); return w; }


constexpr int PB_LD = 520;
constexpr int PB_BUF = 0, PB_AOP = 64 * PB_LD * 2, PB_VMID = 2 * 64 * PB_LD * 2, PB_LA_LD = 264, PB_VM_LD = 40;
__device__ __forceinline__ void phase_prep_fast(ArgsR a, const Ctx& c, int l) {
    const bf16* ZR = (const bf16*)(a.ws + WS_ZR);
    const float* mu = a.in[I_MU] + l * RC; const float* w0 = a.in[I_W0] + l * W; const float* a0 = a.in[I_A0] + l * W;
    const float* k_k = a.in[I_KK] + l * W; const float* k_a = a.in[I_KA] + l * W; const float* vm0 = a.in[I_VM0];
    f16* R = (f16*)(a.ws + WS_R); f16* WM1 = (f16*)(a.ws + WS_WM1); f16* KP = (f16*)(a.ws + WS_KP); f16* AA = (f16*)(a.ws + WS_AA); f16* BB = (f16*)(a.ws + WS_BB); f16* V = (f16*)(a.ws + WS_V);
    bf16* G = (bf16*)(a.ws + WS_G); bf16* VF = (bf16*)(a.ws + WS_VF);
    const unsigned char* lo = a.ws + WS_LORA + (size_t)l * LO_STRIDE;
    const bf16* W2T = (const bf16*)(lo + LO_W2T); const bf16* A2T = (const bf16*)(lo + LO_A2T); const bf16* G2T = (const bf16*)(lo + LO_G2T);
    const bf16* VM1T = (const bf16*)(lo + LO_VM1T); const bf16* VM2T = (const bf16*)(lo + LO_VM2T);
    LAS3 unsigned char* L = (LAS3 unsigned char*)c.lds;
    const int tid = c.tid, lane = c.lane, wv = c.wave, fr = lane & 15, fq = lane >> 4;
    const int row = tid >> 3, sub_ = tid & 7;
    for (int u = blockIdx.x; u < T / 64; u += gridDim.x) {
        int sub = sub_; asm volatile("" : "+v"(sub));
        const int t0 = u * 64, t = t0 + row;
        if (l == 0) {
#pragma unroll 4
            for (int p = 0; p < 8; ++p) { const int col = p * 64 + sub * 8; float z[8]; zshift8(ZR, t, 1024 + col, mu, z);
                store8f16(V + (size_t)t * W + col, z); *(u32x4*)(VF + (size_t)t * W + col) = pack8bf(z); }
        } else {
#pragma unroll 4
            for (int p = 0; p < 8; ++p) { const int col = p * 64 + sub * 8; float z[8]; zshift8(ZR, t, 1024 + col, mu, z);
                *(LAS3 u32x4*)(L + PB_AOP + (row * PB_LD + col) * 2) = pack8bf(z); }
            __syncthreads();
            { f32x4 acc[1][1]; acc[0][0] = (f32x4){0.f, 0.f, 0.f, 0.f}; const int m = wv >> 1, n = wv & 1;
              mma_lds_glob<1, 1, 16>(c.lds, PB_AOP + 16 * m * PB_LD * 2, PB_LD, VM1T, W, 16 * n, lane, acc);
#pragma unroll
              for (int i = 0; i < 4; ++i) *(LAS3 bf16*)(L + PB_VMID + ((16 * m + 4 * fq + i) * PB_VM_LD + 16 * n + fr) * 2) = f2bf(acc[0][0][i]); }
            __syncthreads();
            { f32x4 acc[4][4];
#pragma unroll
              for (int m = 0; m < 4; ++m)
#pragma unroll
                  for (int n = 0; n < 4; ++n) acc[m][n] = (f32x4){0.f, 0.f, 0.f, 0.f};
              mma_lds_glob<4, 4, 1, true>(c.lds, PB_VMID, PB_VM_LD, VM2T, 32, 64 * wv, lane, acc);
#pragma unroll
              for (int m = 0; m < 4; ++m)
#pragma unroll
                  for (int n = 0; n < 4; ++n) { const int col = 64 * wv + 16 * n + 4 * fq; const f32x4 vb = *(const f32x4*)(vm0 + col); f16x4 hv;
#pragma unroll
                      for (int i = 0; i < 4; ++i) hv[i] = (f16)sigmoidf_(vb[i] + acc[m][n][i]);
                      *(LAS3 f16x4*)(L + PB_BUF + ((16 * m + fr) * PB_LD + col) * 2) = hv; } }
            __syncthreads();
#pragma unroll 4
            for (int p = 0; p < 8; ++p) { const int col = p * 64 + sub * 8;
                const u32x4 vz = *(const LAS3 u32x4*)(L + PB_AOP + (row * PB_LD + col) * 2); const f16x8 gt = *(const LAS3 f16x8*)(L + PB_BUF + (row * PB_LD + col) * 2);
                const u32x4 vfw = *(const u32x4*)(VF + (size_t)t * W + col); float o[8];
#pragma unroll
                for (int e = 0; e < 4; ++e) { const float v0 = __uint_as_float(vz[e] << 16), v1 = __uint_as_float(vz[e] & 0xffff0000u), f0 = __uint_as_float(vfw[e] << 16), f1 = __uint_as_float(vfw[e] & 0xffff0000u);
                    o[2 * e] = v0 + (f0 - v0) * (float)gt[2 * e]; o[2 * e + 1] = v1 + (f1 - v1) * (float)gt[2 * e + 1]; }
                store8f16(V + (size_t)t * W + col, o); }
            __syncthreads();
        }
#pragma unroll 4
        for (int p = 0; p < 4; ++p) { const int cc = sub * 32 + p * 8; float z[8]; zshift8(ZR, t, 1536 + cc, mu, z);
#pragma unroll
            for (int e = 0; e < 8; ++e) z[e] = cc < 64 ? (1.0f - 2.0f * __builtin_amdgcn_rcpf(1.0f + __expf(2.0f * z[e]))) : (cc < 128 ? z[e] : sigmoidf_(z[e]));
            *(LAS3 u32x4*)(L + PB_AOP + (row * PB_LA_LD + cc) * 2) = pack8bf(z); }
        __syncthreads();
        { f32x4 acc[4][4];
#pragma unroll
          for (int m = 0; m < 4; ++m)
#pragma unroll
              for (int n = 0; n < 4; ++n) acc[m][n] = (f32x4){0.f, 0.f, 0.f, 0.f};
          mma_lds_glob<4, 4, 2, true>(c.lds, PB_AOP + 64 * 2, PB_LA_LD, A2T, 64, 64 * wv, lane, acc);
#pragma unroll
          for (int m = 0; m < 4; ++m)
#pragma unroll
              for (int n = 0; n < 4; ++n) { const int col = 64 * wv + 16 * n + 4 * fq; const f32x4 ab = *(const f32x4*)(a0 + col); f16x4 hv;
#pragma unroll
                  for (int i = 0; i < 4; ++i) hv[i] = (f16)sigmoidf_(ab[i] + acc[m][n][i]);
                  *(LAS3 f16x4*)(L + PB_BUF + ((16 * m + fr) * PB_LD + col) * 2) = hv; } }
        __syncthreads();
#pragma unroll 4
        for (int p = 0; p < 8; ++p) { const int col = p * 64 + sub * 8; const size_t o = (size_t)t * W + col;
            float z[8]; zshift8(ZR, t, col, mu, z); store8f16(R + o, z);
            float kz[8]; zshift8(ZR, t, 512 + col, mu, kz);
            const f16x8 av = *(const LAS3 f16x8*)(L + PB_BUF + (row * PB_LD + col) * 2);
            const f32x4 kk0 = *(const f32x4*)(k_k + col), kk1 = *(const f32x4*)(k_k + col + 4), ka0 = *(const f32x4*)(k_a + col), ka1 = *(const f32x4*)(k_a + col + 4);
            float kk[8], kp[8], bb[8]; float ss = 0.f;
#pragma unroll
            for (int e = 0; e < 8; ++e) { const float kkw = e < 4 ? kk0[e & 3] : kk1[e & 3], kaw = e < 4 ? ka0[e & 3] : ka1[e & 3]; kk[e] = kz[e] * kkw; ss += kk[e] * kk[e]; kp[e] = kz[e] * (1.0f + ((float)av[e] - 1.0f) * kaw); }
            ss += __shfl_xor(ss, 1); ss += __shfl_xor(ss, 2); ss += __shfl_xor(ss, 4);
            const float inv = fminf(__builtin_amdgcn_rsqf(ss), 1e12f);
#pragma unroll
            for (int e = 0; e < 8; ++e) { kk[e] *= inv; bb[e] = kk[e] * (float)av[e]; kk[e] = -kk[e]; }
            store8f16(KP + o, kp); store8f16(AA + o, kk); store8f16(BB + o, bb); }
        __syncthreads();
        { f32x4 acc[4][4];
#pragma unroll
          for (int m = 0; m < 4; ++m)
#pragma unroll
              for (int n = 0; n < 4; ++n) acc[m][n] = (f32x4){0.f, 0.f, 0.f, 0.f};
          mma_lds_glob<4, 4, 2, true>(c.lds, PB_AOP, PB_LA_LD, W2T, 64, 64 * wv, lane, acc);
#pragma unroll
          for (int m = 0; m < 4; ++m)
#pragma unroll
              for (int n = 0; n < 4; ++n) { const int col = 64 * wv + 16 * n + 4 * fq; const f32x4 wb = *(const f32x4*)(w0 + col); f16x4 hv;
#pragma unroll
                  for (int i = 0; i < 4; ++i) { const float x = wb[i] + acc[m][n][i]; const float wl = -(fmaxf(-x, 0.f) + __logf(1.0f + __expf(-fabsf(x)))) - 0.5f;
                      hv[i] = (f16)(__expf(-__expf(wl)) - 1.0f); }
                  *(LAS3 f16x4*)(L + PB_BUF + ((16 * m + fr) * PB_LD + col) * 2) = hv; } }
        __syncthreads();
#pragma unroll 4
        for (int p = 0; p < 8; ++p) { const int col = p * 64 + sub * 8; *(u32x4*)(WM1 + (size_t)t * W + col) = *(const LAS3 u32x4*)(L + PB_BUF + (row * PB_LD + col) * 2); }
        __syncthreads();
        { f32x4 acc[4][4];
#pragma unroll
          for (int m = 0; m < 4; ++m)
#pragma unroll
              for (int n = 0; n < 4; ++n) acc[m][n] = (f32x4){0.f, 0.f, 0.f, 0.f};
          mma_lds_glob<4, 4, 4, true>(c.lds, PB_AOP + 128 * 2, PB_LA_LD, G2T, 128, 64 * wv, lane, acc);
#pragma unroll
          for (int m = 0; m < 4; ++m)
#pragma unroll
              for (int n = 0; n < 4; ++n) { const int col = 64 * wv + 16 * n + 4 * fq; u32x2 w; w.x = pk2(acc[m][n][0], acc[m][n][1]); w.y = pk2(acc[m][n][2], acc[m][n][3]);
                  *(LAS3 u32x2*)(L + PB_BUF + ((16 * m + fr) * PB_LD + col) * 2) = w; } }
        __syncthreads();
#pragma unroll 4
        for (int p = 0; p < 8; ++p) { const int col = p * 64 + sub * 8; *(u32x4*)(G + (size_t)t * W + col) = *(const LAS3 u32x4*)(L + PB_BUF + (row * PB_LD + col) * 2); }
        __syncthreads();
    }
}

constexpr int SG_LD = 136;
constexpr int SG_VT = 0, SG_ST = 256 * SG_LD * 2;
__device__ __forceinline__ void phase_sg_fast(ArgsR a, const Ctx& c, int l) {
    const bf16* ZS = (const bf16*)(a.ws + WS_ZS); bf16* YB = (bf16*)(a.ws + WS_YB);
    const float* lng = a.in[I_SGG] + l * W; const float* lnb = a.in[I_SGB] + l * W;
    LAS3 unsigned char* L = (LAS3 unsigned char*)c.lds;
    LAS3 float* st = (LAS3 float*)(L + SG_ST);
    const int tid = c.tid, lane = c.lane, wv = c.wave, fr = lane & 15, fq = lane >> 4;
    for (int u = blockIdx.x; u < 256; u += gridDim.x) {
        const int ch = u >> 1, hf = u & 1, tok0 = ch * 128;
        { u32x4 raw[16];
#pragma unroll
          for (int i = 0; i < 16; ++i) raw[i] = *(const u32x4*)(ZS + (size_t)(tok0 + wv * 16 + i) * 1024 + 512 + lane * 8);
#pragma unroll
          for (int i = 0; i < 16; ++i) { const int sidx = wv * 16 + i; float x[8];
#pragma unroll
              for (int e = 0; e < 4; ++e) { x[2 * e] = __uint_as_float(raw[i][e] << 16); x[2 * e + 1] = __uint_as_float(raw[i][e] & 0xffff0000u); }
              const float sm = ((x[0] + x[1]) + (x[2] + x[3])) + ((x[4] + x[5]) + (x[6] + x[7])); const float mean = wave_sum(sm) * (1.f / 512.f);
              float q = 0.f;
#pragma unroll
              for (int e = 0; e < 8; ++e) { const float d0 = x[e] - mean; q += d0 * d0; }
              const float rstd = __builtin_amdgcn_rsqf(wave_sum(q) * (1.f / 512.f) + LN_EPS);
              if (lane == 0) { st[2 * sidx] = mean; st[2 * sidx + 1] = rstd; } } }
        __syncthreads();
        { const int sidx = tid >> 2, q4 = tid & 3; const float mean = st[2 * sidx], rstd = st[2 * sidx + 1];
#pragma unroll
          for (int p = 0; p < 8; ++p) { const int cl = q4 * 64 + p * 8; const int cg = hf * 256 + cl;
              const bf16* src = ZS + (size_t)(tok0 + sidx) * 1024 + 512 + cg; const f32x4 x0 = load4bf(src), x1 = load4bf(src + 4);
              const f32x4 g0 = *(const f32x4*)(lng + cg), g1 = *(const f32x4*)(lng + cg + 4), b0 = *(const f32x4*)(lnb + cg), b1 = *(const f32x4*)(lnb + cg + 4);
#pragma unroll
              for (int e = 0; e < 8; ++e) { const float x = e < 4 ? x0[e & 3] : x1[e & 3], gg = e < 4 ? g0[e & 3] : g1[e & 3], bb = e < 4 ? b0[e & 3] : b1[e & 3];
                  *(LAS3 bf16*)(L + SG_VT + ((cl + e) * SG_LD + sidx) * 2) = f2bf((x - mean) * rstd * gg + bb); } } }
        __syncthreads();
        const int gl = wv >> 1, dh = wv & 1, g = hf * 4 + gl;
        const float* Wg = a.in[I_WS] + (size_t)(l * 8 + g) * 128 * 128; const float* bs = a.in[I_BS] + (size_t)(l * 8 + g) * 128;
        f32x4 acc[8][2];
#pragma unroll
        for (int m = 0; m < 8; ++m) { acc[m][0] = (f32x4){0.f, 0.f, 0.f, 0.f}; acc[m][1] = (f32x4){0.f, 0.f, 0.f, 0.f}; }
#pragma unroll
        for (int ks = 0; ks < 4; ++ks) {
            bf16x8 b[2];
#pragma unroll
            for (int n = 0; n < 2; ++n) b[n] = *(const LAS3 bf16x8*)(L + SG_VT + ((gl * 64 + dh * 32 + 16 * n + fr) * SG_LD + 32 * ks + 8 * fq) * 2);
#pragma unroll
            for (int m = 0; m < 8; ++m) { if (32 * ks <= 16 * m + 15) {
                const int trow = 16 * m + fr, s0 = 32 * ks + 8 * fq;
                const f32x4 w0v = *(const f32x4*)(Wg + trow * 128 + s0), w1v = *(const f32x4*)(Wg + trow * 128 + s0 + 4);
                float wf[8];
#pragma unroll
                for (int e = 0; e < 8; ++e) { const float wval = e < 4 ? w0v[e & 3] : w1v[e & 3]; wf[e] = (s0 + e <= trow) ? wval : 0.f; }
                const u32x4 wp = pack8bf(wf); const bf16x8 av = __builtin_bit_cast(bf16x8, wp);
                acc[m][0] = __builtin_amdgcn_mfma_f32_16x16x32_bf16(b[0], av, acc[m][0], 0, 0, 0);
                acc[m][1] = __builtin_amdgcn_mfma_f32_16x16x32_bf16(b[1], av, acc[m][1], 0, 0, 0); } }
        }
#pragma unroll
        for (int m = 0; m < 8; ++m) { const int trow = 16 * m + fr; const float bsv = bs[trow];
#pragma unroll
            for (int n = 0; n < 2; ++n) { const int col = g * 64 + dh * 32 + 16 * n + 4 * fq; const f32x4 uu = load4bf(ZS + (size_t)(tok0 + trow) * 1024 + col);
                store4bf(YB + (size_t)(tok0 + trow) * W + col, uu * (acc[m][n] + bsv)); } }
        __syncthreads();
    }
}

__device__ __forceinline__ void phase_scan_simple(ArgsR a, const Ctx& c) {
    if (c.wave != 0 || blockIdx.x >= NH) return;
    const int h = blockIdx.x, lane = c.lane;
    const f16* R = (const f16*)(a.ws + WS_R); const f16* WM1 = (const f16*)(a.ws + WS_WM1); const f16* KP = (const f16*)(a.ws + WS_KP);
    const f16* AA = (const f16*)(a.ws + WS_AA); const f16* BB = (const f16*)(a.ws + WS_BB); const f16* V = (const f16*)(a.ws + WS_V);
    bf16* YSC = (bf16*)(a.ws + WS_YSC);
    float S[64];
#pragma unroll
    for (int j = 0; j < 64; ++j) S[j] = 0.f;
    for (int t = 0; t < T; ++t) {
        const size_t base = (size_t)t * W + h * 64;
        const float vv = (float)V[base + lane];
        float sa = 0.f;
#pragma unroll
        for (int j = 0; j < 64; ++j) sa += S[j] * (float)AA[base + j];
        float y = 0.f;
#pragma unroll
        for (int j = 0; j < 64; ++j) { float s = S[j]; s = s + s * (float)WM1[base + j]; s += sa * (float)BB[base + j]; s += vv * (float)KP[base + j]; S[j] = s; y += s * (float)R[base + j]; }
        YSC[base + lane] = f2bf(y);
    }
}

typedef unsigned u32x16 __attribute__((ext_vector_type(16)));
__device__ __forceinline__ void sload32(const void* p0, u32x16& a0, u32x16& a1) {
    asm volatile("s_load_dwordx16 %0, %2, 0x0 glc\n\ts_load_dwordx16 %1, %2, 0x40 glc\n\ts_waitcnt lgkmcnt(0)" : "=&s"(a0), "=&s"(a1) : "s"(p0) : "memory");
}
__device__ __forceinline__ void sload64(const void* p0, const void* p1, u32x16& a0, u32x16& a1, u32x16& b0, u32x16& b1) {
    asm volatile("s_load_dwordx16 %0, %4, 0x0 glc\n\ts_load_dwordx16 %1, %4, 0x40 glc\n\ts_load_dwordx16 %2, %5, 0x0 glc\n\ts_load_dwordx16 %3, %5, 0x40 glc\n\ts_waitcnt lgkmcnt(0)"
                 : "=&s"(a0), "=&s"(a1), "=&s"(b0), "=&s"(b1) : "s"(p0), "s"(p1) : "memory");
}
__device__ __forceinline__ float fmix_lo(unsigned sd, float x, float y) { float d; asm("v_fma_mix_f32 %0, %1, %2, %3 op_sel_hi:[1,0,0]" : "=v"(d) : "s"(sd), "v"(x), "v"(y)); return d; }
__device__ __forceinline__ float fmix_hi(unsigned sd, float x, float y) { float d; asm("v_fma_mix_f32 %0, %1, %2, %3 op_sel:[1,0,0] op_sel_hi:[1,0,0]" : "=v"(d) : "s"(sd), "v"(x), "v"(y)); return d; }
constexpr int CL = 64, NCH = T / CL;
constexpr size_t ST_Q_OFF = (size_t)NH * NCH * 64 * 64;
constexpr size_t ST_S_OFF = (size_t)NH * NCH * 64 * 64;

__device__ __forceinline__ float vmix_lo(unsigned vd, float x, float y) { float d; asm("v_fma_mix_f32 %0, %1, %2, %3 op_sel_hi:[1,0,0]" : "=v"(d) : "v"(vd), "v"(x), "v"(y)); return d; }
__device__ __forceinline__ float vmix_hi(unsigned vd, float x, float y) { float d; asm("v_fma_mix_f32 %0, %1, %2, %3 op_sel:[1,0,0] op_sel_hi:[1,0,0]" : "=v"(d) : "v"(vd), "v"(x), "v"(y)); return d; }
template <int N> __device__ __forceinline__ void fmac_bc(float& acc, float vec, float x) { asm("v_fmac_f32_dpp %0, %1, %2 row_newbcast:%3 row_mask:0xf bank_mask:0xf" : "+v"(acc) : "v"(vec), "v"(x), "n"(N)); }
template <int N> __device__ __forceinline__ float mul_bc(float vec, float x) { float d; asm("v_mul_f32_dpp %0, %1, %2 row_newbcast:%3 row_mask:0xf bank_mask:0xf" : "=v"(d) : "v"(vec), "v"(x), "n"(N)); return d; }
struct SVec { float v[4]; };
__device__ __forceinline__ f16x4 sv_read(const LAS3 unsigned char* p, int lane) { return *(const LAS3 f16x4*)(p + (lane & 15) * 8); }
__device__ __forceinline__ void sv_cvt(SVec& o, f16x4 h) { o.v[0] = (float)h[0]; o.v[1] = (float)h[1]; o.v[2] = (float)h[2]; o.v[3] = (float)h[3]; }
__device__ __forceinline__ void sv_cvt1p(SVec& o, f16x4 h) { o.v[0] = 1.0f + (float)h[0]; o.v[1] = 1.0f + (float)h[1]; o.v[2] = 1.0f + (float)h[2]; o.v[3] = 1.0f + (float)h[3]; }
template <int J> __device__ __forceinline__ void sc_dot(float (&d)[4], const SVec& A, const float (&X)[64]) { fmac_bc<(J >> 2)>(d[J & 3], A.v[J & 3], X[J]); if constexpr (J + 1 < 64) sc_dot<J + 1>(d, A, X); }
template <int J> __device__ __forceinline__ void sc_upd3(float (&S)[64], float (&y)[4], const SVec& Wv, const SVec& Bv, const SVec& Kv, const SVec& Rv, float sa, float vv) {
    float sj = mul_bc<(J >> 2)>(Wv.v[J & 3], S[J]); fmac_bc<(J >> 2)>(sj, Bv.v[J & 3], sa); fmac_bc<(J >> 2)>(sj, Kv.v[J & 3], vv); S[J] = sj; fmac_bc<(J >> 2)>(y[J & 3], Rv.v[J & 3], sj);
    if constexpr (J + 1 < 64) sc_upd3<J + 1>(S, y, Wv, Bv, Kv, Rv, sa, vv); }
template <int J> __device__ __forceinline__ void sc_upd1(float (&Q)[64], float (&P)[64], const SVec& Wv, const SVec& Bv, const SVec& Kv, float saq, float sap, float vv) {
    float qj = mul_bc<(J >> 2)>(Wv.v[J & 3], Q[J]); fmac_bc<(J >> 2)>(qj, Bv.v[J & 3], saq); fmac_bc<(J >> 2)>(qj, Kv.v[J & 3], vv); Q[J] = qj;
    float pj = mul_bc<(J >> 2)>(Wv.v[J & 3], P[J]); fmac_bc<(J >> 2)>(pj, Bv.v[J & 3], sap); P[J] = pj;
    if constexpr (J + 1 < 64) sc_upd1<J + 1>(Q, P, Wv, Bv, Kv, saq, sap, vv); }
constexpr int SCB = 8;
constexpr int SC_NS = 7, SC_BUF = SC_NS * 1024, SC_WAVE = 2 * SC_BUF;
__device__ __forceinline__ void sc_dma(const f16* X, size_t eoff, LAS3 unsigned char* dst) {
    __builtin_amdgcn_global_load_lds((const unsigned*)(X + eoff), (LAS3 unsigned*)dst, 16, 0, 0);
}

__device__ __forceinline__ void phase_scan1(ArgsR a, const Ctx& c) {
    const f16* WM1 = (const f16*)(a.ws + WS_WM1); const f16* KP = (const f16*)(a.ws + WS_KP);
    const f16* AA = (const f16*)(a.ws + WS_AA); const f16* BB = (const f16*)(a.ws + WS_BB); const f16* V = (const f16*)(a.ws + WS_V);
    float* ST = (float*)(a.ws + WS_ST);
    const int lane = c.lane;
    LAS3 unsigned char* ring = (LAS3 unsigned char*)c.lds + c.wave * SC_WAVE;
    for (int item = c.gw; item < NH * NCH; item += c.ngw) {
        const int h = __builtin_amdgcn_readfirstlane(item / NCH), ch = __builtin_amdgcn_readfirstlane(item % NCH);
        float Q[64], P[64];
        int ln_ = lane; asm volatile("" : "+v"(ln_));
#pragma unroll
        for (int j = 0; j < 64; ++j) { Q[j] = 0.f; P[j] = (j == ln_) ? 1.f : 0.f; }
        const size_t lane_off = (size_t)(lane >> 3) * W + h * 64 + (lane & 7) * 8;
        { const size_t e0 = (size_t)(ch * CL) * W + lane_off;
          sc_dma(AA, e0, ring); sc_dma(WM1, e0, ring + 1024); sc_dma(BB, e0, ring + 2048); sc_dma(KP, e0, ring + 3072); sc_dma(V, e0, ring + 4096); }
#pragma unroll 1
        for (int blk = 0; blk < CL / SCB; ++blk) {
            LAS3 unsigned char* buf = ring + (blk & 1) * SC_BUF;
            if (blk + 1 < CL / SCB) { LAS3 unsigned char* nb = ring + ((blk + 1) & 1) * SC_BUF; const size_t e0 = (size_t)(ch * CL + (blk + 1) * SCB) * W + lane_off;
                sc_dma(AA, e0, nb); sc_dma(WM1, e0, nb + 1024); sc_dma(BB, e0, nb + 2048); sc_dma(KP, e0, nb + 3072); sc_dma(V, e0, nb + 4096);
                asm volatile("s_waitcnt vmcnt(5)" ::: "memory"); }
            else asm volatile("s_waitcnt vmcnt(0)" ::: "memory");
            SVec A, Wv, Bv, Kv;
            sv_cvt(A, sv_read(buf, lane)); sv_cvt1p(Wv, sv_read(buf + 1024, lane)); sv_cvt(Bv, sv_read(buf + 2048, lane)); sv_cvt(Kv, sv_read(buf + 3072, lane));
            float vv = (float)*(const LAS3 f16*)(buf + 4096 + lane * 2);
#pragma unroll 1
            for (int st = 0; st < SCB; ++st) {
                const LAS3 unsigned char* sn = buf + ((st + 1 < SCB) ? st + 1 : st) * 128;
                const f16x4 ha = sv_read(sn, lane), hw = sv_read(sn + 1024, lane), hb = sv_read(sn + 2048, lane), hk = sv_read(sn + 3072, lane);
                const f16 hv = *(const LAS3 f16*)(sn + 4096 + lane * 2);
                float dq[4] = {0.f, 0.f, 0.f, 0.f}, dp[4] = {0.f, 0.f, 0.f, 0.f};
                sc_dot<0>(dq, A, Q); sc_dot<0>(dp, A, P);
                const float saq = (dq[0] + dq[1]) + (dq[2] + dq[3]), sap = (dp[0] + dp[1]) + (dp[2] + dp[3]);
                sc_upd1<0>(Q, P, Wv, Bv, Kv, saq, sap, vv);
                sv_cvt(A, ha); sv_cvt1p(Wv, hw); sv_cvt(Bv, hb); sv_cvt(Kv, hk); vv = (float)hv;
            }
        }
        float* Qp = ST + ST_Q_OFF + (size_t)(h * NCH + ch) * 4096 + lane;
        bf16* PTp = (bf16*)ST + (size_t)(h * NCH + ch) * 4096 + lane;
#pragma unroll
        for (int j = 0; j < 64; ++j) { PTp[j * 64] = f2bf(P[j]); Qp[j * 64] = Q[j]; }
    }
}
constexpr int GS = 16, NG = NCH / GS;
constexpr size_t ST_LP_OFF = (size_t)NH * NCH * 4096;
constexpr size_t WS_SG = WS_LORA + 2 * MiB;
constexpr int HI_LD = 72, HI_BYTES = 64 * HI_LD * 2;
struct HFrag { bf16x8 b[2][2]; f32x4 q[2]; };
__device__ __forceinline__ void hload(HFrag& f, const bf16* Bt, const float* QTc, int boff, int qtoff) {
#pragma unroll
    for (int ks = 0; ks < 2; ++ks)
#pragma unroll
        for (int n = 0; n < 2; ++n) f.b[ks][n] = *(const bf16x8*)(Bt + boff + 16 * n * 64 + 32 * ks);
#pragma unroll
    for (int n = 0; n < 2; ++n) f.q[n] = *(const f32x4*)(QTc + qtoff + 16 * n * 64);
}
__device__ __forceinline__ void hmma(const LAS3 unsigned char* img, const bf16x8 (&b)[2][2], f32x4 (&acc)[2], int m, int fr, int fq) {
#pragma unroll
    for (int ks = 0; ks < 2; ++ks) { const bf16x8 av = *(const LAS3 bf16x8*)(img + ((16 * m + fr) * HI_LD + 32 * ks + 8 * fq) * 2);
#pragma unroll
        for (int n = 0; n < 2; ++n) acc[n] = __builtin_amdgcn_mfma_f32_16x16x32_bf16(av, b[ks][n], acc[n], 0, 0, 0); }
}
__device__ __forceinline__ void himg_store(LAS3 unsigned char* img, const f32x4 (&acc)[2], int m, int n0, int fr, int fq) {
#pragma unroll
    for (int n = 0; n < 2; ++n)
#pragma unroll
        for (int i = 0; i < 4; ++i) *(LAS3 bf16*)(img + ((16 * m + 4 * fq + i) * HI_LD + n0 + 16 * n + fr) * 2) = f2bf(acc[n][i]);
}
#define HBAR() do { asm volatile("s_waitcnt lgkmcnt(0)" ::: "memory"); __builtin_amdgcn_s_barrier(); asm volatile("" ::: "memory"); } while (0)

__device__ __forceinline__ void sc2a_step(const HFrag& f, bf16* LpTc, float* QTc, const LAS3 unsigned char* ip, LAS3 unsigned char* ipn, const LAS3 unsigned char* iq, LAS3 unsigned char* iqn, int m, int n0, int fr, int fq, int qtoff) {
    f32x4 ap[2], aq[2];
#pragma unroll
    for (int n = 0; n < 2; ++n) { ap[n] = (f32x4){0.f, 0.f, 0.f, 0.f}; aq[n] = f.q[n]; }
    hmma(ip, f.b, ap, m, fr, fq); hmma(iq, f.b, aq, m, fr, fq);
#pragma unroll
    for (int n = 0; n < 2; ++n) { u32x2 w; w.x = pk2(ap[n][0], ap[n][1]); w.y = pk2(ap[n][2], ap[n][3]);
        *(u32x2*)(LpTc + (n0 + 16 * n + fr) * 64 + 16 * m + 4 * fq) = w;
        *(f32x4*)(QTc + qtoff + 16 * n * 64) = aq[n]; }
    himg_store(ipn, ap, m, n0, fr, fq); himg_store(iqn, aq, m, n0, fr, fq);
    HBAR();
}
__device__ __forceinline__ void phase_scan2a(ArgsR a, const Ctx& c) {
    const int lane = c.lane, wv = c.wave, fr = lane & 15, fq = lane >> 4, m = wv >> 1, n0 = 32 * (wv & 1);
    const int boff = (n0 + fr) * 64 + 8 * fq, qtoff = (n0 + fr) * 64 + 16 * m + 4 * fq;
    LAS3 unsigned char* L = (LAS3 unsigned char*)c.lds;
    for (int item = blockIdx.x; item < NH * NG; item += gridDim.x) {
        const size_t cb = (size_t)(item / NG) * NCH + (size_t)(item % NG) * GS;
        const bf16* PT = (const bf16*)(a.ws + WS_ST) + cb * 4096; bf16* LP = (bf16*)(a.ws + WS_ST) + ST_LP_OFF + cb * 4096; float* QT = (float*)(a.ws + WS_ST) + ST_Q_OFF + cb * 4096;
        for (int i = c.tid; i < 4 * HI_BYTES / 4; i += NTHREADS) ((LAS3 unsigned*)L)[i] = 0u;
        __syncthreads();
        if (c.tid < 64) *(LAS3 bf16*)(L + (c.tid * HI_LD + c.tid) * 2) = (bf16)0x3F80;
        __syncthreads();
        HFrag f0, f1, f2, f3;
        hload(f0, PT, QT, boff, qtoff); hload(f1, PT + 4096, QT + 4096, boff, qtoff); hload(f2, PT + 2 * 4096, QT + 2 * 4096, boff, qtoff); hload(f3, PT + 3 * 4096, QT + 3 * 4096, boff, qtoff);
        LAS3 unsigned char* p0 = L; LAS3 unsigned char* p1 = L + HI_BYTES; LAS3 unsigned char* q0 = L + 2 * HI_BYTES; LAS3 unsigned char* q1 = L + 3 * HI_BYTES;
#pragma unroll 1
        for (int i = 0; i < GS; i += 4) {
            const int nx = (i + 4 < GS) ? i + 4 : i;
            sc2a_step(f0, LP + (size_t)(i + 0) * 4096, QT + (size_t)(i + 0) * 4096, p0, p1, q0, q1, m, n0, fr, fq, qtoff); hload(f0, PT + (size_t)(nx + 0) * 4096, QT + (size_t)(nx + 0) * 4096, boff, qtoff);
            sc2a_step(f1, LP + (size_t)(i + 1) * 4096, QT + (size_t)(i + 1) * 4096, p1, p0, q1, q0, m, n0, fr, fq, qtoff); hload(f1, PT + (size_t)(nx + 1) * 4096, QT + (size_t)(nx + 1) * 4096, boff, qtoff);
            sc2a_step(f2, LP + (size_t)(i + 2) * 4096, QT + (size_t)(i + 2) * 4096, p0, p1, q0, q1, m, n0, fr, fq, qtoff); hload(f2, PT + (size_t)(nx + 2) * 4096, QT + (size_t)(nx + 2) * 4096, boff, qtoff);
            sc2a_step(f3, LP + (size_t)(i + 3) * 4096, QT + (size_t)(i + 3) * 4096, p1, p0, q1, q0, m, n0, fr, fq, qtoff); hload(f3, PT + (size_t)(nx + 3) * 4096, QT + (size_t)(nx + 3) * 4096, boff, qtoff);
        }
        __syncthreads();
    }
}
__device__ __forceinline__ void phase_scan2b(ArgsR a, const Ctx& c) {
    if (blockIdx.x >= NH) return;
    const int h = blockIdx.x, lane = c.lane, wv = c.wave, fr = lane & 15, fq = lane >> 4, m = wv >> 1, n0 = 32 * (wv & 1);
    const int boff = (n0 + fr) * 64 + 8 * fq, qtoff = (n0 + fr) * 64 + 16 * m + 4 * fq;
    LAS3 unsigned char* L = (LAS3 unsigned char*)c.lds;
    const bf16* LP = (const bf16*)(a.ws + WS_ST) + ST_LP_OFF + (size_t)h * NCH * 4096; const float* QT = (const float*)(a.ws + WS_ST) + ST_Q_OFF + (size_t)h * NCH * 4096;
    bf16* SG = (bf16*)(a.ws + WS_SG) + (size_t)h * NG * 4096;
    for (int i = c.tid; i < 2 * HI_BYTES / 4; i += NTHREADS) ((LAS3 unsigned*)L)[i] = 0u;
    for (int i = c.tid; i < 4096 / 2; i += NTHREADS) ((LAS3 unsigned*)(L + 2 * HI_BYTES))[i] = 0u;
    __syncthreads();
    HFrag f0, f1, f2, f3;
#define SC2B_CH(g) ((size_t)((g) * GS + GS - 1) * 4096)
    hload(f0, LP + SC2B_CH(0), QT + SC2B_CH(0), boff, qtoff); hload(f1, LP + SC2B_CH(1), QT + SC2B_CH(1), boff, qtoff); hload(f2, LP + SC2B_CH(2), QT + SC2B_CH(2), boff, qtoff); hload(f3, LP + SC2B_CH(3), QT + SC2B_CH(3), boff, qtoff);
    LAS3 unsigned char* i0 = L; LAS3 unsigned char* i1 = L + HI_BYTES;
#define SC2B_STEP(f, g, ic, in) do { f32x4 acc[2] = {f.q[0], f.q[1]}; hmma(ic, f.b, acc, m, fr, fq); LAS3 bf16* So = (LAS3 bf16*)(L + 2 * HI_BYTES) + (((g) + 1) & 7) * 4096; \
        _Pragma("unroll") for (int n = 0; n < 2; ++n) _Pragma("unroll") for (int i = 0; i < 4; ++i) So[(16 * m + 4 * fq + i) * 64 + n0 + 16 * n + fr] = f2bf(acc[n][i]); \
        himg_store(in, acc, m, n0, fr, fq); HBAR(); } while (0)
#pragma unroll 1
    for (int g = 0; g < NG; g += 4) {
        const int nx = (g + 4 < NG) ? g + 4 : g;
        SC2B_STEP(f0, g + 0, i0, i1); hload(f0, LP + SC2B_CH(nx + 0), QT + SC2B_CH(nx + 0), boff, qtoff);
        SC2B_STEP(f1, g + 1, i1, i0); hload(f1, LP + SC2B_CH(nx + 1), QT + SC2B_CH(nx + 1), boff, qtoff);
        SC2B_STEP(f2, g + 2, i0, i1); hload(f2, LP + SC2B_CH(nx + 2), QT + SC2B_CH(nx + 2), boff, qtoff);
        if ((g & 7) == 4) {
            for (int i = c.tid; i < 8 * 4096 / 8; i += NTHREADS) ((u32x4*)(SG + (size_t)(g >> 3) * 8 * 4096))[i] = ((const LAS3 u32x4*)(L + 2 * HI_BYTES))[i];
            HBAR(); }
        if (g + 3 < NG - 1) SC2B_STEP(f3, g + 3, i1, i0);
        hload(f3, LP + SC2B_CH(nx + 3), QT + SC2B_CH(nx + 3), boff, qtoff);
    }
#undef SC2B_STEP
#undef SC2B_CH
}
__device__ __forceinline__ void phase_scan2c(ArgsR a, const Ctx& c) {
    const int lane = c.lane, wv = c.wave, fr = lane & 15, fq = lane >> 4, m = wv >> 1, n0 = 32 * (wv & 1);
    const int boff = (n0 + fr) * 64 + 8 * fq, qtoff = (n0 + fr) * 64 + 16 * m + 4 * fq;
    LAS3 unsigned char* L = (LAS3 unsigned char*)c.lds;
    for (int item = blockIdx.x; item < NH * NG * 2; item += gridDim.x) {
        const int hg = item >> 1, hf = item & 1;
        const size_t cb = (size_t)(hg / NG) * NCH + (size_t)(hg % NG) * GS + hf * 8;
        const bf16* LP = (const bf16*)(a.ws + WS_ST) + ST_LP_OFF + cb * 4096; const float* QT = (const float*)(a.ws + WS_ST) + ST_Q_OFF + cb * 4096; bf16* SS = (bf16*)(a.ws + WS_ST) + cb * 4096;
        { const u32x4 v = *(const u32x4*)((const bf16*)(a.ws + WS_SG) + (size_t)hg * 4096 + c.tid * 8); *(LAS3 u32x4*)(L + ((c.tid >> 3) * HI_LD + (c.tid & 7) * 8) * 2) = v; }
        __syncthreads();
#pragma unroll 2
        for (int i = 0; i < 8; ++i) { HFrag f; hload(f, LP + (size_t)i * 4096, QT + (size_t)i * 4096, boff, qtoff);
            f32x4 acc[2] = {f.q[0], f.q[1]}; hmma(L, f.b, acc, m, fr, fq); bf16* So = SS + (size_t)i * 4096;
#pragma unroll
            for (int n = 0; n < 2; ++n)
#pragma unroll
                for (int k = 0; k < 4; ++k) So[(16 * m + 4 * fq + k) * 64 + n0 + 16 * n + fr] = f2bf(acc[n][k]); }
        __syncthreads();
    }
}
constexpr int WI_LD = 72, WI_B = 64 * WI_LD * 2, WI_GAM = 9 * WI_B, WI_GL = 15 * WI_B;
constexpr size_t WS_GM0 = 352 * MiB, WS_GM1 = 212 * MiB, WS_Y0 = 336 * MiB, WS_END2 = 360 * MiB;
__device__ __forceinline__ bf16* gm_ptr(unsigned char* ws, int h, int ch) { return (bf16*)(ws + (h < 4 ? WS_GM0 : WS_GM1)) + (size_t)((h & 3) * NCH + ch) * 4096; }
__device__ __forceinline__ void wi_mma(f32x4 (&acc)[2], const LAS3 unsigned char* A, const LAS3 unsigned char* Bt, int m, int n0, int fr, int fq) {
#pragma unroll
    for (int ks = 0; ks < 2; ++ks) { const bf16x8 av = *(const LAS3 bf16x8*)(A + ((16 * m + fr) * WI_LD + 32 * ks + 8 * fq) * 2);
#pragma unroll
        for (int n = 0; n < 2; ++n) { const bf16x8 bv = *(const LAS3 bf16x8*)(Bt + ((n0 + 16 * n + fr) * WI_LD + 32 * ks + 8 * fq) * 2); acc[n] = __builtin_amdgcn_mfma_f32_16x16x32_bf16(av, bv, acc[n], 0, 0, 0); } }
}
struct WiA { bf16x8 a[2]; }; struct WiB { bf16x8 b[2][2]; };
__device__ __forceinline__ void wi_lda(WiA& f, const LAS3 unsigned char* A, int m, int fr, int fq) {
#pragma unroll
    for (int ks = 0; ks < 2; ++ks) f.a[ks] = *(const LAS3 bf16x8*)(A + ((16 * m + fr) * WI_LD + 32 * ks + 8 * fq) * 2);
}
__device__ __forceinline__ void wi_ldb(WiB& f, const LAS3 unsigned char* Bt, int n0, int fr, int fq) {
#pragma unroll
    for (int ks = 0; ks < 2; ++ks)
#pragma unroll
        for (int n = 0; n < 2; ++n) f.b[ks][n] = *(const LAS3 bf16x8*)(Bt + ((n0 + 16 * n + fr) * WI_LD + 32 * ks + 8 * fq) * 2);
}
__device__ __forceinline__ void wi_fma(f32x4 (&acc)[2], const WiA& A, const WiB& B) {
#pragma unroll
    for (int ks = 0; ks < 2; ++ks)
#pragma unroll
        for (int n = 0; n < 2; ++n) acc[n] = __builtin_amdgcn_mfma_f32_16x16x32_bf16(A.a[ks], B.b[ks][n], acc[n], 0, 0, 0);
}
__device__ __forceinline__ void wi_fma_s(f32x4 (&acc)[2], const WiA& A, const WiB& B) {
#pragma unroll
    for (int ks = 0; ks < 2; ++ks)
#pragma unroll
        for (int n = 0; n < 2; ++n) acc[n] = __builtin_amdgcn_mfma_f32_16x16x32_bf16(B.b[ks][n], A.a[ks], acc[n], 0, 0, 0);
}
__device__ __forceinline__ void wi_st_nat_s(LAS3 unsigned char* X, const f32x4 (&acc)[2], int m, int n0, int fr, int fq) {
#pragma unroll
    for (int n = 0; n < 2; ++n) { u32x2 w; w.x = pk2(acc[n][0], acc[n][1]); w.y = pk2(acc[n][2], acc[n][3]); *(LAS3 u32x2*)(X + ((16 * m + fr) * WI_LD + n0 + 16 * n + 4 * fq) * 2) = w; }
}
__device__ __forceinline__ void wi_ld_nat_s(f32x4 (&acc)[2], const LAS3 unsigned char* X, int m, int n0, int fr, int fq) {
#pragma unroll
    for (int n = 0; n < 2; ++n) { const u32x2 w = *(const LAS3 u32x2*)(X + ((16 * m + fr) * WI_LD + n0 + 16 * n + 4 * fq) * 2);
        acc[n][0] = __uint_as_float(w.x << 16); acc[n][1] = __uint_as_float(w.x & 0xffff0000u); acc[n][2] = __uint_as_float(w.y << 16); acc[n][3] = __uint_as_float(w.y & 0xffff0000u); }
}
__device__ __forceinline__ void wi_ld_tr(f32x4 (&acc)[2], const LAS3 unsigned char* XT, int m, int n0, int fr, int fq) {
#pragma unroll
    for (int n = 0; n < 2; ++n) { const u32x2 w = *(const LAS3 u32x2*)(XT + ((n0 + 16 * n + fr) * WI_LD + 16 * m + 4 * fq) * 2);
        acc[n][0] = __uint_as_float(w.x << 16); acc[n][1] = __uint_as_float(w.x & 0xffff0000u); acc[n][2] = __uint_as_float(w.y << 16); acc[n][3] = __uint_as_float(w.y & 0xffff0000u); }
}
#define WI_PIN() __builtin_amdgcn_sched_barrier(0)
__device__ __forceinline__ void wi_st_nat(LAS3 unsigned char* X, const f32x4 (&acc)[2], int m, int n0, int fr, int fq) {
#pragma unroll
    for (int n = 0; n < 2; ++n)
#pragma unroll
        for (int i = 0; i < 4; ++i) *(LAS3 bf16*)(X + ((16 * m + 4 * fq + i) * WI_LD + n0 + 16 * n + fr) * 2) = f2bf(acc[n][i]);
}
__device__ __forceinline__ void wi_st_tr(LAS3 unsigned char* XT, const f32x4 (&acc)[2], int m, int n0, int fr, int fq) {
#pragma unroll
    for (int n = 0; n < 2; ++n) { u32x2 w; w.x = pk2(acc[n][0], acc[n][1]); w.y = pk2(acc[n][2], acc[n][3]); *(LAS3 u32x2*)(XT + ((n0 + 16 * n + fr) * WI_LD + 16 * m + 4 * fq) * 2) = w; }
}
__device__ __forceinline__ void wi_ld_nat(f32x4 (&acc)[2], const LAS3 unsigned char* X, int m, int n0, int fr, int fq) {
#pragma unroll
    for (int n = 0; n < 2; ++n)
#pragma unroll
        for (int i = 0; i < 4; ++i) acc[n][i] = bf2f(*(const LAS3 bf16*)(X + ((16 * m + 4 * fq + i) * WI_LD + n0 + 16 * n + fr) * 2));
}
__device__ __forceinline__ void phase_scan1m(ArgsR a, const Ctx& c, const int skip = 0) {
    const f16* WM1 = (const f16*)(a.ws + WS_WM1); const f16* KP = (const f16*)(a.ws + WS_KP);
    const f16* AA = (const f16*)(a.ws + WS_AA); const f16* BB = (const f16*)(a.ws + WS_BB); const f16* V = (const f16*)(a.ws + WS_V); const f16* R = (const f16*)(a.ws + WS_R);
    float* ST = (float*)(a.ws + WS_ST);
    LAS3 unsigned char* L = (LAS3 unsigned char*)c.lds;
    LAS3 float* GAM = (LAS3 float*)(L + WI_GAM); LAS3 float* GL = (LAS3 float*)(L + WI_GL);
    const int lane = c.lane, wv = c.wave, fr = lane & 15, fq = lane >> 4, m = wv >> 1, n0 = 32 * (wv & 1), tid = c.tid;
#define SLOT(i) (L + (i) * WI_B)
    const int t = tid >> 3, cc = (tid & 7) * 8;
    f16x8 pav, pbv, pkv, pvv, prv, pwv;
#define WI_FETCH(it) do { const int h_ = (it) / NCH, ch_ = (it) % NCH; const size_t eo_ = (size_t)(ch_ * CL + t) * W + h_ * 64 + cc; \
        pav = *(const f16x8*)(AA + eo_); pbv = *(const f16x8*)(BB + eo_); pkv = *(const f16x8*)(KP + eo_); pvv = *(const f16x8*)(V + eo_); prv = *(const f16x8*)(R + eo_); pwv = *(const f16x8*)(WM1 + eo_); } while (0)
    if (blockIdx.x < NH * NCH) WI_FETCH(blockIdx.x);
    for (int item = blockIdx.x; item < NH * NCH; item += gridDim.x) {
        const int h = item / NCH, ch = item % NCH;
        const f16x8 av = pav, bv = pbv, kv = pkv, vv = pvv, rv = prv, wv8 = pwv;
        if (item + (int)gridDim.x < NH * NCH) WI_FETCH(item + (int)gridDim.x);
        float g[8], gp[8];
        { float wloc[8];
#pragma unroll
          for (int e = 0; e < 8; ++e) wloc[e] = 1.0f + (float)wv8[e];
#pragma unroll
          for (int e = 0; e < 8; ++e) { float x = wloc[e];
              { const float y = __shfl_up(x, 8); if (lane >= 8) x *= y; } { const float y = __shfl_up(x, 16); if (lane >= 16) x *= y; } { const float y = __shfl_up(x, 32); if (lane >= 32) x *= y; }
              g[e] = x; }
          if (lane >= 56) {
#pragma unroll
              for (int e = 0; e < 8; ++e) GAM[wv * 64 + cc + e] = g[e]; }
          HBAR();
#pragma unroll
          for (int e = 0; e < 8; ++e) { float pre = 1.0f;
#pragma unroll
              for (int w = 0; w < 7; ++w) if (w < wv) pre *= GAM[w * 64 + cc + e];
              g[e] *= pre; gp[e] = g[e] * __builtin_amdgcn_rcpf(wloc[e]); } }
        { float fa[8], fb[8], fk[8], fv[8], frr[8];
#pragma unroll
          for (int e = 0; e < 8; ++e) { const float ig = __builtin_amdgcn_rcpf(g[e]);
              fa[e] = (float)av[e] * gp[e]; fb[e] = (float)bv[e] * ig; fk[e] = (float)kv[e] * ig; fv[e] = (float)vv[e]; frr[e] = (float)rv[e] * g[e]; if (t == 63) GL[cc + e] = g[e]; }
          *(LAS3 u32x4*)(SLOT(0) + (t * WI_LD + cc) * 2) = pack8bf(fa); *(LAS3 u32x4*)(SLOT(2) + (t * WI_LD + cc) * 2) = pack8bf(fb); *(LAS3 u32x4*)(SLOT(4) + (t * WI_LD + cc) * 2) = pack8bf(fk); *(LAS3 u32x4*)(SLOT(12) + (t * WI_LD + cc) * 2) = pack8bf(frr);
#pragma unroll
          for (int e = 0; e < 8; ++e) { *(LAS3 bf16*)(SLOT(1) + ((cc + e) * WI_LD + t) * 2) = f2bf(fa[e]); *(LAS3 bf16*)(SLOT(3) + ((cc + e) * WI_LD + t) * 2) = f2bf(fb[e]); *(LAS3 bf16*)(SLOT(5) + ((cc + e) * WI_LD + t) * 2) = f2bf(fv[e]); } }
        HBAR();
        { WiA aB, aK; WiB bA, bR; wi_lda(aB, SLOT(2), m, fr, fq); wi_lda(aK, SLOT(4), m, fr, fq); wi_ldb(bA, SLOT(0), n0, fr, fq); wi_ldb(bR, SLOT(12), n0, fr, fq);
          WI_PIN();
          f32x4 ans[2] = {{0.f, 0.f, 0.f, 0.f}, {0.f, 0.f, 0.f, 0.f}}, ant[2] = {{0.f, 0.f, 0.f, 0.f}, {0.f, 0.f, 0.f, 0.f}}, aks[2] = {{0.f, 0.f, 0.f, 0.f}, {0.f, 0.f, 0.f, 0.f}}, am[2] = {{0.f, 0.f, 0.f, 0.f}, {0.f, 0.f, 0.f, 0.f}}, amk[2] = {{0.f, 0.f, 0.f, 0.f}, {0.f, 0.f, 0.f, 0.f}};
          wi_fma_s(ans, aB, bA); wi_fma(ant, aB, bA); wi_fma_s(aks, aK, bA); wi_fma(am, aB, bR); wi_fma(amk, aK, bR);
          WI_PIN();
          f32x4 axs[2];
#pragma unroll
          for (int n = 0; n < 2; ++n)
#pragma unroll
              for (int i = 0; i < 4; ++i) { const int rs = 16 * m + fr, cs = n0 + 16 * n + 4 * fq + i;
                  if (!(rs < cs)) { ans[n][i] = 0.f; aks[n][i] = 0.f; } axs[n][i] = ans[n][i] + (rs == cs ? 1.0f : 0.f);
                  const int rn = 16 * m + 4 * fq + i, cn = n0 + 16 * n + fr;
                  if (!(rn < cn)) ant[n][i] = 0.f; if (rn > cn) { am[n][i] = 0.f; amk[n][i] = 0.f; } }
          wi_st_nat_s(SLOT(7), ans, m, n0, fr, fq); wi_st_tr(SLOT(8), ant, m, n0, fr, fq); wi_st_nat_s(SLOT(6), aks, m, n0, fr, fq); wi_st_nat_s(SLOT(11), axs, m, n0, fr, fq);
          wi_st_tr(SLOT(13), am, m, n0, fr, fq); wi_st_tr(SLOT(14), amk, m, n0, fr, fq); }
        HBAR();
        { WiA aN; WiB bN; wi_lda(aN, SLOT(7), m, fr, fq); wi_ldb(bN, SLOT(8), n0, fr, fq); WI_PIN();
          f32x4 a2s[2] = {{0.f, 0.f, 0.f, 0.f}, {0.f, 0.f, 0.f, 0.f}}, a2t[2] = {{0.f, 0.f, 0.f, 0.f}, {0.f, 0.f, 0.f, 0.f}}; wi_fma_s(a2s, aN, bN); wi_fma(a2t, aN, bN); WI_PIN();
          wi_st_nat_s(SLOT(9), a2s, m, n0, fr, fq); wi_st_tr(SLOT(10), a2t, m, n0, fr, fq); }
        HBAR();
#define WI_LEVEL(XS, XD, NS, NST, ND, NDT) do { WiA aX, aN; WiB bN; f32x4 ax[2]; wi_lda(aX, SLOT(XS), m, fr, fq); wi_ldb(bN, SLOT(NST), n0, fr, fq); wi_lda(aN, SLOT(NS), m, fr, fq); wi_ld_nat_s(ax, SLOT(XS), m, n0, fr, fq); \
            WI_PIN(); f32x4 aqs[2] = {{0.f, 0.f, 0.f, 0.f}, {0.f, 0.f, 0.f, 0.f}}, aqt[2] = {{0.f, 0.f, 0.f, 0.f}, {0.f, 0.f, 0.f, 0.f}}; wi_fma_s(ax, aX, bN); wi_fma_s(aqs, aN, bN); wi_fma(aqt, aN, bN); WI_PIN(); \
            wi_st_nat_s(SLOT(XD), ax, m, n0, fr, fq); wi_st_nat_s(SLOT(ND), aqs, m, n0, fr, fq); wi_st_tr(SLOT(NDT), aqt, m, n0, fr, fq); \
            HBAR(); } while (0)
        WI_LEVEL(11, 0, 9, 10, 7, 8);
        WI_LEVEL(0, 11, 7, 8, 9, 10);
        WI_LEVEL(11, 0, 9, 10, 7, 8);
        WI_LEVEL(0, 11, 7, 8, 9, 10);
#undef WI_LEVEL
        { WiA aX; WiB bN; f32x4 ax[2]; wi_lda(aX, SLOT(11), m, fr, fq); wi_ldb(bN, SLOT(10), n0, fr, fq); wi_ld_nat(ax, SLOT(11), m, n0, fr, fq); WI_PIN();
          wi_fma(ax, aX, bN); WI_PIN(); wi_st_tr(SLOT(0), ax, m, n0, fr, fq); }
        HBAR();
        { WiA aNk, aAt; WiB bT; wi_lda(aNk, SLOT(6), m, fr, fq); wi_lda(aAt, SLOT(1), m, fr, fq); wi_ldb(bT, SLOT(0), n0, fr, fq); WI_PIN();
          f32x4 aw[2] = {{0.f, 0.f, 0.f, 0.f}, {0.f, 0.f, 0.f, 0.f}}, aa[2] = {{0.f, 0.f, 0.f, 0.f}, {0.f, 0.f, 0.f, 0.f}}; wi_fma_s(aw, aNk, bT); wi_fma_s(aa, aAt, bT); WI_PIN();
          wi_st_nat_s(SLOT(2), aw, m, n0, fr, fq); wi_st_nat_s(SLOT(7), aa, m, n0, fr, fq); }
        HBAR();
        { WiA aAT, aW1; WiB bB, bM; f32x4 ap[2] = {{0.f, 0.f, 0.f, 0.f}, {0.f, 0.f, 0.f, 0.f}}, az[2], ag[2], az2[2]; float gl[2];
          wi_lda(aAT, SLOT(7), m, fr, fq); wi_lda(aW1, SLOT(2), m, fr, fq); wi_ldb(bB, SLOT(3), n0, fr, fq); wi_ldb(bM, SLOT(13), n0, fr, fq);
          wi_ld_nat(az, SLOT(4), m, n0, fr, fq); wi_ld_tr(az2, SLOT(14), m, n0, fr, fq); wi_ld_tr(ag, SLOT(12), m, n0, fr, fq);
#pragma unroll
          for (int n = 0; n < 2; ++n) gl[n] = GL[n0 + 16 * n + fr];
          WI_PIN();
          wi_fma(ap, aAT, bB); wi_fma(az, aW1, bB); wi_fma(ag, aAT, bM); wi_fma(az2, aW1, bM);
          WI_PIN();
          wi_st_tr(SLOT(8), az, m, n0, fr, fq); wi_st_tr(SLOT(9), az2, m, n0, fr, fq);
          bf16* PTp = (bf16*)ST + (size_t)(h * NCH + ch) * 4096; bf16* GMp = gm_ptr(a.ws, h, ch);
#pragma unroll
          for (int n = 0; n < 2; ++n) { const int col = n0 + 16 * n + fr; f32x4 pv = ap[n];
#pragma unroll
              for (int i = 0; i < 4; ++i) { if (16 * m + 4 * fq + i == col) pv[i] += 1.0f; pv[i] *= gl[n]; }
              u32x2 w; w.x = pk2(pv[0], pv[1]); w.y = pk2(pv[2], pv[3]); *(u32x2*)(PTp + col * 64 + 16 * m + 4 * fq) = w;
              u32x2 w2; w2.x = pk2(ag[n][0], ag[n][1]); w2.y = pk2(ag[n][2], ag[n][3]); *(u32x2*)(GMp + col * 64 + 16 * m + 4 * fq) = w2; } }
        HBAR();
        { WiA aV; WiB bZ1, bZ2; float gl[2]; wi_lda(aV, SLOT(5), m, fr, fq); wi_ldb(bZ1, SLOT(8), n0, fr, fq); wi_ldb(bZ2, SLOT(9), n0, fr, fq); gl[0] = GL[n0 + fr]; gl[1] = GL[n0 + 16 + fr]; WI_PIN();
          f32x4 aq[2] = {{0.f, 0.f, 0.f, 0.f}, {0.f, 0.f, 0.f, 0.f}}, ay[2] = {{0.f, 0.f, 0.f, 0.f}, {0.f, 0.f, 0.f, 0.f}}; wi_fma(aq, aV, bZ1); wi_fma(ay, aV, bZ2); WI_PIN();
          float* QTp = ST + ST_Q_OFF + (size_t)(h * NCH + ch) * 4096; bf16* Y0p = (bf16*)(a.ws + WS_Y0) + (size_t)(h * NCH + ch) * 4096;
#pragma unroll
          for (int n = 0; n < 2; ++n) { const int col = n0 + 16 * n + fr; *(f32x4*)(QTp + col * 64 + 16 * m + 4 * fq) = aq[n] * gl[n];
              u32x2 w; w.x = pk2(ay[n][0], ay[n][1]); w.y = pk2(ay[n][2], ay[n][3]); *(u32x2*)(Y0p + col * 64 + 16 * m + 4 * fq) = w; } }
        HBAR();
    }
#undef SLOT
#undef WI_FETCH
}

__device__ __forceinline__ void phase_scan3m(ArgsR a, const Ctx& c, int l) {
    const f16* R = (const f16*)(a.ws + WS_R); const f16* KP = (const f16*)(a.ws + WS_KP); const f16* V = (const f16*)(a.ws + WS_V); const bf16* G = (const bf16*)(a.ws + WS_G);
    bf16* YA = (bf16*)(a.ws + WS_YA);
    LAS3 unsigned char* L = (LAS3 unsigned char*)c.lds;
    LAS3 float* YL = (LAS3 float*)(L + WI_B);
    LAS3 unsigned char* S0I = L + 3 * WI_B;
    const int lane = c.lane, wv = c.wave, fr = lane & 15, fq = lane >> 4, m = wv >> 1, n0 = 32 * (wv & 1), tid = c.tid;
    const int boff = (n0 + fr) * 64 + 8 * fq, qtoff = (n0 + fr) * 64 + 16 * m + 4 * fq;
    u32x4 pS; bf16x8 pL[2][2]; f32x4 pQ[2]; bf16x8 pB[2][2]; u32x2 pY[2];
#define S3_FETCH(it) do { const int h_ = (it) / NCH, ch_ = (it) % NCH; pS = (u32x4){0u, 0u, 0u, 0u}; \
        _Pragma("unroll") for (int ks = 0; ks < 2; ++ks) _Pragma("unroll") for (int n = 0; n < 2; ++n) pL[ks][n] = (bf16x8){0, 0, 0, 0, 0, 0, 0, 0}; \
        pQ[0] = (f32x4){0.f, 0.f, 0.f, 0.f}; pQ[1] = (f32x4){0.f, 0.f, 0.f, 0.f}; \
        if (ch_ > 0) { const int c1_ = ch_ - 1; pS = *(const u32x4*)((const bf16*)(a.ws + WS_SG) + (size_t)(h_ * NG + c1_ / GS) * 4096 + tid * 8); \
            const bf16* LP_ = (const bf16*)(a.ws + WS_ST) + ST_LP_OFF + (size_t)(h_ * NCH + c1_) * 4096; const float* QT_ = (const float*)(a.ws + WS_ST) + ST_Q_OFF + (size_t)(h_ * NCH + c1_) * 4096; \
            _Pragma("unroll") for (int ks = 0; ks < 2; ++ks) _Pragma("unroll") for (int n = 0; n < 2; ++n) pL[ks][n] = *(const bf16x8*)(LP_ + boff + 16 * n * 64 + 32 * ks); \
            _Pragma("unroll") for (int n = 0; n < 2; ++n) pQ[n] = *(const f32x4*)(QT_ + qtoff + 16 * n * 64); } \
        const bf16* G_ = gm_ptr(a.ws, h_, ch_); const bf16* Y_ = (const bf16*)(a.ws + WS_Y0) + (size_t)(h_ * NCH + ch_) * 4096; \
        _Pragma("unroll") for (int ks = 0; ks < 2; ++ks) _Pragma("unroll") for (int n = 0; n < 2; ++n) pB[ks][n] = *(const bf16x8*)(G_ + (n0 + 16 * n + fr) * 64 + 32 * ks + 8 * fq); \
        _Pragma("unroll") for (int n = 0; n < 2; ++n) pY[n] = *(const u32x2*)(Y_ + (n0 + 16 * n + fr) * 64 + 16 * m + 4 * fq); } while (0)
    if (blockIdx.x < NH * NCH) S3_FETCH(blockIdx.x);
    for (int item = blockIdx.x; item < NH * NCH; item += gridDim.x) {
        const int h = item / NCH, ch = item % NCH;
        *(LAS3 u32x4*)(L + ((tid >> 3) * WI_LD + (tid & 7) * 8) * 2) = pS;
        bf16x8 lfr[2][2], bfr[2][2]; f32x4 as0[2], acc[2];
#pragma unroll
        for (int ks = 0; ks < 2; ++ks)
#pragma unroll
            for (int n = 0; n < 2; ++n) { lfr[ks][n] = pL[ks][n]; bfr[ks][n] = pB[ks][n]; }
#pragma unroll
        for (int n = 0; n < 2; ++n) { as0[n] = pQ[n]; acc[n][0] = __uint_as_float(pY[n].x << 16); acc[n][1] = __uint_as_float(pY[n].x & 0xffff0000u); acc[n][2] = __uint_as_float(pY[n].y << 16); acc[n][3] = __uint_as_float(pY[n].y & 0xffff0000u); }
        if (item + (int)gridDim.x < NH * NCH) S3_FETCH(item + (int)gridDim.x);
        HBAR();
        hmma(L, lfr, as0, m, fr, fq);
        himg_store(S0I, as0, m, n0, fr, fq);
        HBAR();
#pragma unroll
        for (int ks = 0; ks < 2; ++ks) { const bf16x8 av = *(const LAS3 bf16x8*)(S0I + ((16 * m + fr) * WI_LD + 32 * ks + 8 * fq) * 2);
#pragma unroll
            for (int n = 0; n < 2; ++n) acc[n] = __builtin_amdgcn_mfma_f32_16x16x32_bf16(av, bfr[ks][n], acc[n], 0, 0, 0); }
#pragma unroll
        for (int n = 0; n < 2; ++n)
#pragma unroll
            for (int i = 0; i < 4; ++i) YL[(n0 + 16 * n + fr) * 65 + 16 * m + 4 * fq + i] = acc[n][i];
        HBAR();
        { const float gn_g = a.in[I_GNG][l * W + h * 64 + lane], gn_b = a.in[I_GNB][l * W + h * 64 + lane], r_k = a.in[I_RK][l * W + h * 64 + lane];
          f16 rl8[8], kl8[8], vl8[8]; bf16 gl8[8];
#pragma unroll
          for (int i = 0; i < 8; ++i) { const size_t o = (size_t)(ch * CL + 8 * wv + i) * W + h * 64 + lane; rl8[i] = R[o]; kl8[i] = KP[o]; vl8[i] = V[o]; gl8[i] = G[o]; }
#pragma unroll
          for (int i = 0; i < 8; ++i) { const int t = 8 * wv + i; const size_t o = (size_t)(ch * CL + t) * W + h * 64 + lane;
              const float yy = YL[t * 65 + lane]; const float rl = (float)rl8[i], kl = (float)kl8[i], vl = (float)vl8[i], gl = bf2f(gl8[i]);
              const float mean = wave_sum(yy) * (1.f / 64.f); const float dd = yy - mean; const float var = wave_sum(dd * dd) * (1.f / 64.f);
              const float bonus = wave_sum(rl * kl * r_k);
              const float yn = dd * __builtin_amdgcn_rsqf(var + GN_EPS) * gn_g + gn_b + bonus * vl;
              YA[o] = f2bf(yn * gl); } }
        HBAR();
    }
#undef S3_FETCH
}

__device__ __forceinline__ void phase_scan3(ArgsR a, const Ctx& c, int l) {
    const f16* R = (const f16*)(a.ws + WS_R); const f16* WM1 = (const f16*)(a.ws + WS_WM1); const f16* KP = (const f16*)(a.ws + WS_KP);
    const f16* AA = (const f16*)(a.ws + WS_AA); const f16* BB = (const f16*)(a.ws + WS_BB); const f16* V = (const f16*)(a.ws + WS_V);
    const float* ST = (const float*)(a.ws + WS_ST); bf16* YA = (bf16*)(a.ws + WS_YA); const f16* Gs = (const f16*)(a.ws + WS_G);
    const int lane = c.lane;
    LAS3 unsigned char* ring = (LAS3 unsigned char*)c.lds + c.wave * SC_WAVE;
    for (int item = c.gw; item < NH * NCH; item += c.ngw) {
        const int h = __builtin_amdgcn_readfirstlane(item / NCH), ch = __builtin_amdgcn_readfirstlane(item % NCH);
        const size_t lane_off = (size_t)(lane >> 3) * W + h * 64 + (lane & 7) * 8;
        const float gn_g = a.in[I_GNG][l * W + h * 64 + lane], gn_b = a.in[I_GNB][l * W + h * 64 + lane], r_k = a.in[I_RK][l * W + h * 64 + lane];
        { const size_t e0 = (size_t)(ch * CL) * W + lane_off;
          sc_dma(AA, e0, ring); sc_dma(WM1, e0, ring + 1024); sc_dma(BB, e0, ring + 2048); sc_dma(KP, e0, ring + 3072); sc_dma(V, e0, ring + 4096); sc_dma(R, e0, ring + 5120); sc_dma(Gs, e0, ring + 6144); }
        float S[64];
        if (ch == 0) {
#pragma unroll
            for (int j = 0; j < 64; ++j) S[j] = 0.f;
        } else { const bf16* Sp = (const bf16*)ST + ((size_t)(h * NCH + ch - 1) * 64 + lane) * 64;
#pragma unroll
            for (int j = 0; j < 64; j += 4) { const f32x4 x = load4bf(Sp + j); S[j] = x[0]; S[j + 1] = x[1]; S[j + 2] = x[2]; S[j + 3] = x[3]; } }
#pragma unroll 1
        for (int blk = 0; blk < CL / SCB; ++blk) {
            LAS3 unsigned char* buf = ring + (blk & 1) * SC_BUF;
            if (blk + 1 < CL / SCB) { LAS3 unsigned char* nb = ring + ((blk + 1) & 1) * SC_BUF; const size_t e0 = (size_t)(ch * CL + (blk + 1) * SCB) * W + lane_off;
                sc_dma(AA, e0, nb); sc_dma(WM1, e0, nb + 1024); sc_dma(BB, e0, nb + 2048); sc_dma(KP, e0, nb + 3072); sc_dma(V, e0, nb + 4096); sc_dma(R, e0, nb + 5120); sc_dma(Gs, e0, nb + 6144);
                asm volatile("s_waitcnt vmcnt(7)" ::: "memory"); }
            else asm volatile("s_waitcnt vmcnt(0)" ::: "memory");
            SVec A, Wv, Bv, Kv, Rv;
            sv_cvt(A, sv_read(buf, lane)); sv_cvt1p(Wv, sv_read(buf + 1024, lane)); sv_cvt(Bv, sv_read(buf + 2048, lane)); sv_cvt(Kv, sv_read(buf + 3072, lane)); sv_cvt(Rv, sv_read(buf + 5120, lane));
            float vv = (float)*(const LAS3 f16*)(buf + 4096 + lane * 2);
#pragma unroll 1
            for (int st = 0; st < SCB; ++st) {
                const LAS3 unsigned char* sn = buf + ((st + 1 < SCB) ? st + 1 : st) * 128;
                const f16x4 ha = sv_read(sn, lane), hw = sv_read(sn + 1024, lane), hb = sv_read(sn + 2048, lane), hk = sv_read(sn + 3072, lane), hr = sv_read(sn + 5120, lane);
                const f16 hv = *(const LAS3 f16*)(sn + 4096 + lane * 2);
                float d[4] = {0.f, 0.f, 0.f, 0.f};
                sc_dot<0>(d, A, S);
                const float sa = (d[0] + d[1]) + (d[2] + d[3]);
                float y[4] = {0.f, 0.f, 0.f, 0.f};
                sc_upd3<0>(S, y, Wv, Bv, Kv, Rv, sa, vv);
                const float yy = (y[0] + y[1]) + (y[2] + y[3]);
                sv_cvt(A, ha); sv_cvt1p(Wv, hw); sv_cvt(Bv, hb); sv_cvt(Kv, hk); sv_cvt(Rv, hr); vv = (float)hv;
                { const LAS3 unsigned char* sb = buf + st * 128;
                  const float rl = (float)*(const LAS3 f16*)(sb + 5120 + lane * 2), kl = (float)*(const LAS3 f16*)(sb + 3072 + lane * 2), vl = (float)*(const LAS3 f16*)(sb + 4096 + lane * 2);
                  const float gl = bf2f(*(const LAS3 bf16*)(sb + 6144 + lane * 2));
                  const float mean = wave_sum(yy) * (1.f / 64.f); const float dd = yy - mean; const float var = wave_sum(dd * dd) * (1.f / 64.f);
                  const float bonus = wave_sum(rl * kl * r_k);
                  const float yn = dd * __builtin_amdgcn_rsqf(var + GN_EPS) * gn_g + gn_b + bonus * vl;
                  YA[(size_t)(ch * CL + blk * SCB + st) * W + h * 64 + lane] = f2bf(yn * gl); }
            }
        }
    }
}

__device__ __forceinline__ void phase_post(ArgsR a, const Ctx& c, int l) {
    const bf16* YSC = (const bf16*)(a.ws + WS_YSC); const f16* R = (const f16*)(a.ws + WS_R); const f16* KP = (const f16*)(a.ws + WS_KP); const f16* V = (const f16*)(a.ws + WS_V);
    const bf16* G = (const bf16*)(a.ws + WS_G); bf16* YA = (bf16*)(a.ws + WS_YA);
    const float* gng = a.in[I_GNG] + l * W; const float* gnb = a.in[I_GNB] + l * W; const float* rk = a.in[I_RK] + l * W;
    for (int t = c.gw; t < T; t += c.ngw) {
#pragma unroll
        for (int i = 0; i < 8; ++i) { const int n = c.lane + 64 * i; const size_t o = (size_t)t * W + n;
            const float y = bf2f(YSC[o]); const float mean = wave_sum(y) * (1.f / 64.f); const float d = y - mean; const float var = wave_sum(d * d) * (1.f / 64.f);
            float yn = d * __builtin_amdgcn_rsqf(var + GN_EPS) * gng[n] + gnb[n];
            const float r = (float)R[o], k = (float)KP[o], v = (float)V[o];
            const float bonus = wave_sum(r * k * rk[n]);
            yn += bonus * v;
            YA[o] = f2bf(yn * bf2f(G[o])); }
    }
}

__device__ __forceinline__ void phase_ln1(ArgsR a, const Ctx& c, int l, float* outw, int mode = 3) {
    const float* MODF = (const float*)(a.ws + WS_MODF) + l * 6144;
    const float* g1 = a.in[I_LN1G] + l * D; const float* b1 = a.in[I_LN1B] + l * D;
    bf16* XN = (bf16*)(a.ws + WS_XN);
    int* TOKI = (int*)(a.ws + WS_TOKI); float* TOKW = (float*)(a.ws + WS_TOKW); int* TOKP = (int*)(a.ws + WS_TOKP);
    const float* rw = a.in[I_RW]; const float* rb = a.in[I_RB];
    LAS3 float* rwT = (LAS3 float*)((LAS3 unsigned char*)c.lds + 69632);
    constexpr int RW_LD = D + 4;
    unsigned* lcnt = (unsigned*)(c.lds + 135488);
    if (mode & 1) {
    for (int i = c.tid; i < D * NE; i += NTHREADS) rwT[(i & 15) * RW_LD + (i >> 4)] = rw[i];
    if (c.tid < NE) lcnt[c.tid] = 0u;
    __syncthreads();
    float vn[16]; if (c.gw < T) load_row16(a.out + (size_t)c.gw * D, c.lane, vn);
    for (int m = c.gw; m < T; m += c.ngw) {
        int l4 = 4 * c.lane; asm volatile("" : "+v"(l4));
        float v[16];
#pragma unroll
        for (int j = 0; j < 16; ++j) v[j] = vn[j];
        if (m + c.ngw < T) load_row16(a.out + (size_t)(m + c.ngw) * D, c.lane, vn);
        float mean, rstd; row_stats(v, mean, rstd);
#pragma unroll
        for (int j = 0; j < 4; ++j) { f32x4 o; const int col = l4 + 256 * j;
#pragma unroll
            for (int e = 0; e < 4; ++e) { v[4 * j + e] = (v[4 * j + e] - mean) * rstd * g1[col + e] + b1[col + e]; o[e] = v[4 * j + e]; }
            *(f32x4*)(outw + (size_t)m * D + col) = o; }
        row_stats(v, mean, rstd);
#pragma unroll
        for (int j = 0; j < 4; ++j) { f32x4 o; const int col = l4 + 256 * j;
#pragma unroll
            for (int e = 0; e < 4; ++e) { v[4 * j + e] = (v[4 * j + e] - mean) * rstd * (1.0f + MODF[4096 + col + e]) + MODF[3072 + col + e]; o[e] = v[4 * j + e]; }
            store4bf(XN + (size_t)m * D + col, o); }
        float lg[16];
#pragma unroll
        for (int e = 0; e < 16; ++e) { float x = 0.f;
#pragma unroll
            for (int j = 0; j < 4; ++j) { const f32x4 r4 = *(const LAS3 f32x4*)(rwT + e * RW_LD + l4 + 256 * j); x += (v[4 * j] * r4[0] + v[4 * j + 1] * r4[1]) + (v[4 * j + 2] * r4[2] + v[4 * j + 3] * r4[3]); }
            lg[e] = x;
            if ((e & 3) == 3) __builtin_amdgcn_sched_barrier(0); }
        float r8[8], r4v[4], r2[2], r1;
        { const bool b5 = (c.lane & 32) != 0, b4 = (c.lane & 16) != 0, b3 = (c.lane & 8) != 0, b2 = (c.lane & 4) != 0;
#pragma unroll
          for (int i = 0; i < 8; ++i) { const float snd = b5 ? lg[i] : lg[i + 8], kp = b5 ? lg[i + 8] : lg[i]; r8[i] = kp + __shfl_xor(snd, 32); }
#pragma unroll
          for (int i = 0; i < 4; ++i) { const float snd = b4 ? r8[i] : r8[i + 4], kp = b4 ? r8[i + 4] : r8[i]; r4v[i] = kp + __shfl_xor(snd, 16); }
#pragma unroll
          for (int i = 0; i < 2; ++i) { const float snd = b3 ? r4v[i] : r4v[i + 2], kp = b3 ? r4v[i + 2] : r4v[i]; r2[i] = kp + __shfl_xor(snd, 8); }
          { const float snd = b2 ? r2[0] : r2[1], kp = b2 ? r2[1] : r2[0]; r1 = kp + __shfl_xor(snd, 4); }
          r1 += __shfl_xor(r1, 2); r1 += __shfl_xor(r1, 1); }
        float sc[16], sel[16];
#pragma unroll
        for (int e = 0; e < 16; ++e) { const float lgt = __shfl(r1, 4 * e); sc[e] = __builtin_amdgcn_rcpf(1.0f + __expf(-lgt)); sel[e] = sc[e] + rb[e]; }
        int best = 0; float bestv = -INFINITY;
#pragma unroll
        for (int g = 0; g < 4; ++g) { float m1 = -INFINITY, m2 = -INFINITY;
#pragma unroll
            for (int q = 0; q < 4; ++q) { const float sv = sel[4 * g + q]; if (sv > m1) { m2 = m1; m1 = sv; } else if (sv > m2) m2 = sv; }
            const float gs = m1 + m2; if (gs > bestv) { bestv = gs; best = g; } }
        int i1 = 0, i2 = 0; float s1 = -INFINITY, s2 = -INFINITY, w1 = 0.f, w2 = 0.f;
#pragma unroll
        for (int e = 0; e < 16; ++e) { if ((e >> 2) == best) { const float sv = sel[e];
                if (sv > s1) { s2 = s1; i2 = i1; w2 = w1; s1 = sv; i1 = e; w1 = sc[e]; } else if (sv > s2) { s2 = sv; i2 = e; w2 = sc[e]; } } }
        if (c.lane == 0) { const float ws = w1 + w2;
            TOKI[2 * m] = i1; TOKI[2 * m + 1] = i2; TOKW[2 * m] = w1 / ws; TOKW[2 * m + 1] = w2 / ws;
            TOKP[2 * m] = (int)atomicAdd(&lcnt[i1], 1u); TOKP[2 * m + 1] = (int)atomicAdd(&lcnt[i2], 1u); }
    }
    __syncthreads();
    if (c.tid < NE) ((int*)(a.ws + WS_BLKCNT))[blockIdx.x * NE + c.tid] = (int)lcnt[c.tid];
    __syncthreads();
    }
}

__device__ __forceinline__ void expert_convert(ArgsR a, const Ctx& c, int l, int b0) {
    if ((int)blockIdx.x < b0) return;
    float* scr = (float*)(c.lds + c.wave * 8704);
    bf16* WGU = (bf16*)(a.ws + WS_WGU); bf16* WD = (bf16*)(a.ws + WS_WD);
    constexpr int IG = (D / 64) * (FF / 32);
    constexpr int ID = (FF / 64) * (D / 32);
    const int gw0 = ((int)blockIdx.x - b0) * NWAVES + c.wave, ngw0 = ((int)gridDim.x - b0) * NWAVES;
    for (int it = gw0; it < NE * (2 * IG + ID); it += ngw0) {
        const int e = it / (2 * IG + ID); int r = it % (2 * IG + ID);
        const size_t eo = ((size_t)l * NE + e) * (size_t)D * FF;
        if (r < IG) { transpose_matrix_item(a.in[I_EG] + eo, D, FF, WGU + (size_t)e * 1024 * 1024, r, scr, c.lane, RowGU{0}); continue; } r -= IG;
        if (r < IG) { transpose_matrix_item(a.in[I_EU] + eo, D, FF, WGU + (size_t)e * 1024 * 1024, r, scr, c.lane, RowGU{1}); continue; } r -= IG;
        transpose_matrix_item(a.in[I_ED] + eo, FF, D, WD + (size_t)e * 1024 * 512, r, scr, c.lane, RowId());
    }
}

__device__ __forceinline__ void phase_perm(ArgsR a, const Ctx& c, int l) {
    const int* BLKCNT = (const int*)(a.ws + WS_BLKCNT);
    LAS3 int* pre = (LAS3 int*)c.lds;
    LAS3 int* tot = pre + 256 * NE;
    const int nb = gridDim.x;
#pragma unroll
    for (int q = 0; q < 2; ++q) { const int e = 2 * c.wave + q; int v[4]; int sum = 0;
#pragma unroll
        for (int i = 0; i < 4; ++i) { const int b = 4 * c.lane + i; v[i] = b < nb ? BLKCNT[b * NE + e] : 0; sum += v[i]; }
        int inc = sum;
#pragma unroll
        for (int o = 1; o < 64; o <<= 1) { const int t = __shfl_up(inc, o); if (c.lane >= o) inc += t; }
        int run = inc - sum;
#pragma unroll
        for (int i = 0; i < 4; ++i) { pre[(4 * c.lane + i) * NE + e] = run; run += v[i]; }
        if (c.lane == 63) tot[e] = inc; }
    __syncthreads();
    int ts[17]; { int sacc = 0;
#pragma unroll
        for (int e = 0; e < 16; ++e) { ts[e] = sacc; sacc += (tot[e] + 255) >> 8; } ts[16] = sacc; }
    if (blockIdx.x == 0 && c.tid < NE) ((int*)(a.ws + WS_TOT))[c.tid] = tot[c.tid];
    const int* TOKI = (const int*)(a.ws + WS_TOKI); const int* TOKP = (const int*)(a.ws + WS_TOKP); int* S2T = (int*)(a.ws + WS_S2T); const float* TOKW = (const float*)(a.ws + WS_TOKW);
    const bf16* XN = (const bf16*)(a.ws + WS_XN); bf16* XS = (bf16*)(a.ws + WS_XS);
    for (int as = blockIdx.x * NTHREADS + c.tid; as < 2 * T; as += gridDim.x * NTHREADS) {
        const int e = TOKI[as]; int base = 0;
#pragma unroll
        for (int j = 0; j < 16; ++j) base = (j == e) ? ts[j] : base;
        const int m = as >> 1, blk = (m % c.ngw) >> 3;
        const u32x2 sw = {(unsigned)as, __float_as_uint(TOKW[as])};
        *(u32x2*)(S2T + 2 * (base * 256 + pre[blk * NE + e] + TOKP[as])) = sw;
    }
    for (int e = 0; e < 16; ++e) {
        int tse = 0, tsn = 0;
#pragma unroll
        for (int j = 0; j < 16; ++j) { tse = (j == e) ? ts[j] : tse; tsn = (j == e) ? ts[j + 1] : tsn; }
        const int lo = tse * 256 + tot[e], hi = tsn * 256;
        for (int sl = lo + blockIdx.x * NTHREADS + c.tid; sl < hi; sl += gridDim.x * NTHREADS) S2T[2 * sl] = -1;
    }
    __syncthreads();
}

__device__ __forceinline__ void phase_ln2(ArgsR a, const Ctx& c, int l, float* outw) {
    const float* MODF = (const float*)(a.ws + WS_MODF) + l * 6144;
    const float* g2 = a.in[I_LN2G] + l * D; const float* b2 = a.in[I_LN2B] + l * D;
    const bf16* Y = (const bf16*)(a.ws + WS_Y); bf16* XN = (bf16*)(a.ws + WS_XN);
    float vn[16]; u32x2 y0n[4], y1n[4];
    if (c.gw < T) { load_row16(a.out + (size_t)c.gw * D, c.lane, vn);
#pragma unroll
        for (int j = 0; j < 4; ++j) { y0n[j] = *(const u32x2*)(Y + (size_t)(2 * c.gw) * D + 4 * c.lane + 256 * j); y1n[j] = *(const u32x2*)(Y + (size_t)(2 * c.gw + 1) * D + 4 * c.lane + 256 * j); } }
    for (int m = c.gw; m < T; m += c.ngw) {
        float v[16]; u32x2 y0[4], y1[4];
#pragma unroll
        for (int j = 0; j < 16; ++j) v[j] = vn[j];
#pragma unroll
        for (int j = 0; j < 4; ++j) { y0[j] = y0n[j]; y1[j] = y1n[j]; }
        if (m + c.ngw < T) { const int mn = m + c.ngw; load_row16(a.out + (size_t)mn * D, c.lane, vn);
#pragma unroll
            for (int j = 0; j < 4; ++j) { y0n[j] = *(const u32x2*)(Y + (size_t)(2 * mn) * D + 4 * c.lane + 256 * j); y1n[j] = *(const u32x2*)(Y + (size_t)(2 * mn + 1) * D + 4 * c.lane + 256 * j); } }
#pragma unroll
        for (int j = 0; j < 4; ++j) { const int col = 4 * c.lane + 256 * j;
            const float a0 = __uint_as_float(y0[j].x << 16) + __uint_as_float(y1[j].x << 16), a1 = __uint_as_float(y0[j].x & 0xffff0000u) + __uint_as_float(y1[j].x & 0xffff0000u);
            const float a2 = __uint_as_float(y0[j].y << 16) + __uint_as_float(y1[j].y << 16), a3 = __uint_as_float(y0[j].y & 0xffff0000u) + __uint_as_float(y1[j].y & 0xffff0000u);
            const f32x4 gt = *(const f32x4*)(MODF + 5120 + col);
            v[4 * j] = ALPHA * v[4 * j] + (1.0f + gt[0]) * a0; v[4 * j + 1] = ALPHA * v[4 * j + 1] + (1.0f + gt[1]) * a1; v[4 * j + 2] = ALPHA * v[4 * j + 2] + (1.0f + gt[2]) * a2; v[4 * j + 3] = ALPHA * v[4 * j + 3] + (1.0f + gt[3]) * a3; }
        float mean, rstd; row_stats(v, mean, rstd);
#pragma unroll
        for (int j = 0; j < 4; ++j) { f32x4 o; const int col = 4 * c.lane + 256 * j;
#pragma unroll
            for (int e = 0; e < 4; ++e) { v[4 * j + e] = (v[4 * j + e] - mean) * rstd * g2[col + e] + b2[col + e]; o[e] = v[4 * j + e]; }
            *(f32x4*)(outw + (size_t)m * D + col) = o; }
        if (l + 1 < DEPTH) {
            const float* MN = MODF + 6144;
            row_stats(v, mean, rstd);
#pragma unroll
            for (int j = 0; j < 4; ++j) { f32x4 o; const int col = 4 * c.lane + 256 * j;
#pragma unroll
                for (int e = 0; e < 4; ++e) o[e] = (v[4 * j + e] - mean) * rstd * (1.0f + MN[1024 + col + e]) + MN[col + e];
                store4bf(XN + (size_t)m * D + col, o); }
        }
    }
}


template <class F> struct EpiAdapt {
    static constexpr bool PERM = true, AFTER_DRAIN = false; F f;
    __device__ __forceinline__ void operator()(const f32x4 (&acc)[2][2][4][2], const Unit& u, int wr, int wc, int fr, int fq) const {
        const int col = u.pn * 256 + wc * 32 + 8 * fq;
#pragma unroll
        for (int ai = 0; ai < 2; ++ai)
#pragma unroll
            for (int m = 0; m < 4; ++m) { const int row = u.pm * 256 + ai * 128 + wr * 64 + m * 16 + fr; f(row, col, acc[ai][0][m][0], acc[ai][0][m][1], acc[ai][1][m][0], acc[ai][1][m][1]); }
    }
};

template <class Sched, class F>
__device__ __forceinline__ void gemm_gather(const Ctx& c, const bf16* A, const int* s2t, const bf16* Bt, int M, int N, int K, const Sched& S, const F& f) {
    pg8::Gemm g{A, Bt, M, N, K}; EpiAdapt<F> E{f};
    pg8::gemm_phase<EpiAdapt<F>, Sched, true, true, true>((PG8_LAS unsigned char*)c.lds, g, S, E, c.tid, s2t);
}
template <class Sched, class F>
__device__ __forceinline__ void gemm_any(const Ctx& c, const bf16* A, const bf16* Bt, int M, int N, int K, const Sched& S, const F& f) {
    pg8::Gemm g{A, Bt, M, N, K}; EpiAdapt<F> E{f};
    pg8::gemm_phase<EpiAdapt<F>, Sched, true, true>((PG8_LAS unsigned char*)c.lds, g, S, E, c.tid);
}

#define LAS __attribute__((address_space(3)))
#define XB_TMO      128
#define XB_XCNT(j)  (256  + 64 * (j))
#define XB_XSUB(j)  (1280 + 64 * (j))
#define XB_XGEN(j)  (2304 + 64 * (j))
#define XB_TOP      3328
#define XB_TOPGEN   3392
#define XCD_BAR_WORDS 3456
#define XB_SPIN_CAP (1u << 24)

__device__ __forceinline__ unsigned xb_ld(unsigned* p)              { return __hip_atomic_load(p, __ATOMIC_RELAXED, __HIP_MEMORY_SCOPE_AGENT); }
__device__ __forceinline__ unsigned xb_add(unsigned* p, unsigned v) { return __hip_atomic_fetch_add(p, v, __ATOMIC_RELAXED, __HIP_MEMORY_SCOPE_AGENT); }
__device__ __forceinline__ unsigned xb_xcc_id() { return (unsigned)__builtin_amdgcn_s_getreg((3 << 11) | 20) & 0xFu; }
#define XB_SPIN(cond, bar) do { unsigned _sp = 0; while (cond) { __builtin_amdgcn_s_sleep(1); \
    if ((++_sp & 255u) == 0u) { if (xb_ld(&(bar)[XB_TMO])) break; if (_sp > XB_SPIN_CAP) { atomicAdd(&(bar)[XB_TMO], 1u); break; } } } } while (0)

struct XcdBarrier {
    unsigned* bar; unsigned x;
    volatile LAS unsigned* st;
};

__device__ __forceinline__ XcdBarrier xcd_barrier_post(unsigned* bar, volatile LAS unsigned* st) {
    XcdBarrier b; b.bar = bar; b.x = xb_xcc_id(); b.st = st;
    if (threadIdx.x == 0) (void)xb_add(&bar[XB_XCNT(b.x)], 1u);
    return b;
}
__device__ __forceinline__ void xcd_barrier_complete(unsigned* bar, unsigned x, unsigned& nloc, unsigned& nx) {
    const unsigned G = gridDim.x * gridDim.y * gridDim.z;
    unsigned sum, cnt, mine, sp = 0u;
    for (;;) {
        sum = 0u; cnt = 0u; mine = 0u;
#pragma unroll
        for (unsigned j = 0; j < 16; ++j) { const unsigned c = xb_ld(&bar[XB_XCNT(j)]); sum += c; cnt += (c > 0u) ? 1u : 0u; mine = (j == x) ? c : mine; }
        if (sum == G) break;
        __builtin_amdgcn_s_sleep(1);
        if ((++sp & 255u) == 0u) { if (xb_ld(&bar[XB_TMO])) break; if (sp > XB_SPIN_CAP) { atomicAdd(&bar[XB_TMO], 1u); break; } }
    }
    nloc = mine > 0u ? mine : 1u; nx = cnt > 0u ? cnt : 1u;
}

__device__ __forceinline__ void xcd_barrier(const XcdBarrier& b) {
    asm volatile("s_waitcnt vmcnt(0)" ::: "memory");
    __syncthreads();
    if (threadIdx.x == 0) {
        unsigned* bar = b.bar;
        __builtin_amdgcn_s_waitcnt(0);
        unsigned nloc = b.st[0], nx = b.st[1];
        if (nloc == 0u) { xcd_barrier_complete(bar, b.x, nloc, nx); b.st[0] = nloc; b.st[1] = nx; }
        const unsigned old = xb_add(&bar[XB_XSUB(b.x)], 1u);
        const unsigned gen = old / nloc;
        if (old + 1u == (gen + 1u) * nloc) {
            __builtin_amdgcn_fence(__ATOMIC_RELEASE, "agent");
            asm volatile("s_waitcnt vmcnt(0)" ::: "memory");
            const unsigned og = xb_add(&bar[XB_TOP], 1u);
            const unsigned tg = og / nx;
            if (og + 1u == (tg + 1u) * nx) xb_add(&bar[XB_TOPGEN], 1u);
            else XB_SPIN(xb_ld(&bar[XB_TOPGEN]) == tg, bar);
            __builtin_amdgcn_fence(__ATOMIC_ACQUIRE, "agent");
            xb_add(&bar[XB_XGEN(b.x)], 1u);
            asm volatile("s_waitcnt vmcnt(0)" ::: "memory");
        } else {
            XB_SPIN(xb_ld(&bar[XB_XGEN(b.x)]) == gen, bar);
            __builtin_amdgcn_fence(__ATOMIC_ACQUIRE, "agent");
            asm volatile("s_waitcnt vmcnt(0)" ::: "memory");
        }
    }
    __syncthreads();
}


constexpr int PH_PER_LAYER = 12, N_PHASES = 2 + PH_PER_LAYER * DEPTH;
constexpr int CW_BAR = 4096;
constexpr int LDS_BYTES = 147456, LDSCTL_OFF = 131072 + 8192;
#ifndef SINGLE_LAUNCH
#define SINGLE_LAUNCH 1
#endif

#ifndef PROBE_A
#define PROBE_A -1
#endif
#ifndef PROBE_B
#define PROBE_B -1
#endif
constexpr size_t WS_TS = 512 * 1024;
#if PROBE_A >= 0
#define STAMP(i) do { if (blockIdx.x == 0 && threadIdx.x == 0) ((unsigned long long*)(args_here()->ws + WS_TS))[(i)] = __builtin_amdgcn_s_memrealtime(); } while (0)
#else
#define STAMP(i) do { } while (0)
#endif
__device__ __forceinline__ const __attribute__((address_space(4))) Args* args_here() { const __attribute__((address_space(4))) Args* p = (const __attribute__((address_space(4))) Args*)__builtin_amdgcn_kernarg_segment_ptr(); asm volatile("" : "+s"(p)); return p; }
#ifndef REP_K
#define REP_K -1
#endif
__device__ __forceinline__ Ctx mkctx(int wave_s, unsigned char* lds) { Ctx c; c.wave = wave_s; c.lane = (int)__builtin_amdgcn_mbcnt_hi(~0u, __builtin_amdgcn_mbcnt_lo(~0u, 0u)); c.tid = wave_s * 64 + c.lane;
    c.gw = blockIdx.x * NWAVES + wave_s; c.ngw = gridDim.x * NWAVES; c.lds = lds; return c; }
#define PHASE1(k, ...) do { const __attribute__((address_space(4))) Args* ap_ = args_here(); if (ap_->ph_lo <= (k) && (k) < ap_->ph_hi) { ArgsR a = *ap_; const Ctx c = mkctx(wave_s, lds); __VA_ARGS__ } } while (0)
#define PHASE(k, ...) do { PHASE1(k, __VA_ARGS__); if ((k) == REP_K) { xcd_barrier(bar); PHASE1(k, __VA_ARGS__); xcd_barrier(bar); PHASE1(k, __VA_ARGS__); } } while (0)

template <int L>
__device__ __forceinline__ void run_layer(const int wave_s, unsigned char* lds, const XcdBarrier& bar) {
    const int G = gridDim.x, b = blockIdx.x;
#define BAR() do { xcd_barrier(bar); STAMP(3 + 14 * L + (bk_++)); } while (0)
    int bk_ = 0;
    PHASE(0, unsigned char* ws = a.ws; pg8::StaticOrder S; S.init(T, INC, G, b); EpiZ E{(bf16*)(ws + WS_ZR), (bf16*)(ws + WS_ZS), (bf16*)(ws + WS_ZG)};
        gemm_any(c, (const bf16*)(ws + WS_XN), (const bf16*)(ws + WS_WIN + (size_t)L * 10 * MiB), T, INC, D, S, E); );
    BAR();
    PHASE(1, phase_prep_fast(a, c, L); );
    PHASE(14, phase_sg_fast(a, c, L); );
    BAR();
#if REP_K == 21
    PHASE1(2, phase_scan1m(a, c, 1); ); xcd_barrier(bar); PHASE1(2, phase_scan1m(a, c, 1); ); xcd_barrier(bar);
#endif
    PHASE(2, phase_scan1m(a, c); );
    BAR();
    PHASE(3, phase_scan2a(a, c); );
    BAR();
    PHASE(31, phase_scan2b(a, c); );
    PHASE(33, expert_convert(a, c, L, NH); );
    BAR();
    PHASE(4, phase_scan3m(a, c, L); );
    BAR();
    PHASE(6, unsigned char* ws = a.ws; pg8::StaticOrder S; S.init(T, D, G, b); EpiGA E{(const bf16*)(ws + WS_ZG), (bf16*)(ws + WS_MP)};
        gemm_any(c, (const bf16*)(ws + WS_YA), (const bf16*)(ws + WS_WA + (size_t)L * WS_WL1), T, D, W, S, E); );
    BAR();
#if REP_K == 7
    PHASE1(7, unsigned char* ws = a.ws; pg8::StaticOrder S; S.init(T, D, G, b); EpiGB E{(const bf16*)(ws + WS_ZG), (const bf16*)(ws + WS_MP), (bf16*)(ws + WS_ZR)};
        gemm_any(c, (const bf16*)(ws + WS_YB), (const bf16*)(ws + WS_WB + (size_t)L * WS_WL1), T, D, W, S, E); ); xcd_barrier(bar);
    PHASE1(7, unsigned char* ws = a.ws; pg8::StaticOrder S; S.init(T, D, G, b); EpiGB E{(const bf16*)(ws + WS_ZG), (const bf16*)(ws + WS_MP), (bf16*)(ws + WS_ZR)};
        gemm_any(c, (const bf16*)(ws + WS_YB), (const bf16*)(ws + WS_WB + (size_t)L * WS_WL1), T, D, W, S, E); ); xcd_barrier(bar);
#endif
#if REP_K == 8
    PHASE1(8, unsigned char* ws = a.ws; pg8::StaticOrder S; S.init(T, D, G, b); EpiOut E{L == 0 ? a.in[I_X] : a.out, (float*)(ws + WS_R), (const float*)(ws + WS_MODF) + L * 6144 + 2048};
        gemm_any(c, (const bf16*)(ws + WS_MP), (const bf16*)(ws + WS_WO + (size_t)L * WS_WL1), T, D, D, S, E); ); xcd_barrier(bar);
    PHASE1(8, unsigned char* ws = a.ws; pg8::StaticOrder S; S.init(T, D, G, b); EpiOut E{L == 0 ? a.in[I_X] : a.out, (float*)(ws + WS_R), (const float*)(ws + WS_MODF) + L * 6144 + 2048};
        gemm_any(c, (const bf16*)(ws + WS_MP), (const bf16*)(ws + WS_WO + (size_t)L * WS_WL1), T, D, D, S, E); ); xcd_barrier(bar);
#endif
    PHASE1(7, unsigned char* ws = a.ws; pg8::StaticOrder S; S.init(T, D, G, b); EpiGB E{(const bf16*)(ws + WS_ZG), (const bf16*)(ws + WS_MP), (bf16*)(ws + WS_MP)};
        gemm_any(c, (const bf16*)(ws + WS_YB), (const bf16*)(ws + WS_WB + (size_t)L * WS_WL1), T, D, W, S, E); );
    BAR();
    PHASE1(8, unsigned char* ws = a.ws; pg8::StaticOrder S; S.init(T, D, G, b); EpiOut E{L == 0 ? a.in[I_X] : a.out, a.out, (const float*)(ws + WS_MODF) + L * 6144 + 2048};
        gemm_any(c, (const bf16*)(ws + WS_MP), (const bf16*)(ws + WS_WO + (size_t)L * WS_WL1), T, D, D, S, E); );
    BAR();
#if REP_K == 9
    PHASE1(9, phase_ln1(a, c, L, (float*)(a.ws + WS_ZR)); ); xcd_barrier(bar); PHASE1(9, phase_ln1(a, c, L, (float*)(a.ws + WS_ZR)); ); xcd_barrier(bar);
#endif
#if REP_K == 91
    PHASE1(9, phase_ln1(a, c, L, (float*)(a.ws + WS_ZR), 1); ); xcd_barrier(bar); PHASE1(9, phase_ln1(a, c, L, (float*)(a.ws + WS_ZR), 1); ); xcd_barrier(bar);
#endif
#if REP_K == 92
    PHASE1(9, phase_ln1(a, c, L, (float*)(a.ws + WS_ZR), 2); ); xcd_barrier(bar); PHASE1(9, phase_ln1(a, c, L, (float*)(a.ws + WS_ZR), 2); ); xcd_barrier(bar);
#endif
    PHASE1(9, phase_ln1(a, c, L, a.out); );
    BAR();
    PHASE(10, phase_perm(a, c, L); );
    BAR();
    PHASE(11, unsigned char* ws = a.ws; MoeSched S; S.init((const unsigned*)(ws + WS_TOT), G, b); EpiSwi E{(bf16*)(ws + WS_HID)};
        gemm_gather(c, (const bf16*)(ws + WS_XN), (const int*)(ws + WS_S2T), (const bf16*)(ws + WS_WGU), MAXSLOT, NE * 1024, D, S, E); );
    BAR();
    PHASE(12, unsigned char* ws = a.ws; MoeSched S; S.init((const unsigned*)(ws + WS_TOT), G, b); EpiDown E{(const int*)(ws + WS_S2T), (const float*)(ws + WS_TOKW), (bf16*)(ws + WS_Y)};
        gemm_any(c, (const bf16*)(ws + WS_HID), (const bf16*)(ws + WS_WD), MAXSLOT, NE * 1024, FF, S, E); );
    BAR();
#if REP_K == 13
    PHASE1(13, phase_ln2(a, c, L, (float*)(a.ws + WS_R)); ); xcd_barrier(bar); PHASE1(13, phase_ln2(a, c, L, (float*)(a.ws + WS_R)); ); xcd_barrier(bar);
#endif
    PHASE1(13, phase_ln2(a, c, L, a.out); );
    if (L + 1 < DEPTH) BAR();
    (void)bk_;
#undef BAR
}

__global__ void __launch_bounds__(NTHREADS, 2) mk_fwd(Args a_unused) {
    extern __shared__ __attribute__((aligned(16))) unsigned char lds[];
    const int wave_s = __builtin_amdgcn_readfirstlane(threadIdx.x >> 6);
    for (int u = threadIdx.x; u < (LDS_BYTES - LDSCTL_OFF) / 4; u += NTHREADS) ((LAS unsigned*)((LAS unsigned char*)lds + LDSCTL_OFF))[u] = 0u;
    __syncthreads();
    const XcdBarrier bar = xcd_barrier_post((unsigned*)(args_here()->ws + WS_CTL) + CW_BAR, (volatile LAS unsigned*)((LAS unsigned char*)lds + LDSCTL_OFF) + 8);
    STAMP(0);
    PHASE(100, phase_p0a(a, c); );
    xcd_barrier(bar); STAMP(1);
    PHASE(101, phase_p0b(a, c); );
    xcd_barrier(bar); STAMP(2);
    run_layer<0>(wave_s, lds, bar);
    run_layer<1>(wave_s, lds, bar);
#if PROBE_A >= 0
    if (blockIdx.x == 0) {
        asm volatile("s_waitcnt vmcnt(0)" ::: "memory"); __syncthreads();
        if (threadIdx.x == 0) ((unsigned long long*)(args_here()->ws + WS_TS))[30] = __builtin_amdgcn_s_memrealtime();
        asm volatile("s_waitcnt vmcnt(0)" ::: "memory"); __syncthreads();
        const volatile unsigned long long* ts = (const volatile unsigned long long*)(args_here()->ws + WS_TS);
        float da = 0.f, db = 0.f;
        if (PROBE_A < 14) { da = (float)(ts[3 + PROBE_A] - ts[2 + PROBE_A]) + (float)(ts[17 + PROBE_A] - ts[16 + PROBE_A]); } else if (PROBE_A == 14) da = (float)(ts[1] - ts[0]); else if (PROBE_A == 15) da = (float)(ts[2] - ts[1]); else da = (float)(ts[30] - ts[0]);
        if (PROBE_B >= 0 && PROBE_B < 14) { db = (float)(ts[3 + PROBE_B] - ts[2 + PROBE_B]) + (float)(ts[17 + PROBE_B] - ts[16 + PROBE_B]); } else if (PROBE_B == 14) db = (float)(ts[1] - ts[0]); else if (PROBE_B == 15) db = (float)(ts[2] - ts[1]);
        da *= 0.01f; db *= 0.01f;
        da = exp2f(0.25f * rintf(4.0f * log2f(fmaxf(da, 0.5f)))); db = exp2f(0.25f * rintf(4.0f * log2f(fmaxf(db, 0.5f))));
        float* out = args_here()->out;
        for (int i = threadIdx.x; i < 16 * 1024; i += NTHREADS) { const int r = i >> 10, col = i & 1023; const int rowi = (r & 7) + 2048 * (r >> 3); out[(size_t)rowi * D + col] = da; }
        if (threadIdx.x == 0 && PROBE_B >= 0) out[(size_t)4096 * D] = 100.0f * db;
    }
#endif
}

extern "C" void kernel_launch(void* const* d_in, const int* in_sizes, int n_in, void* d_out, int out_size, void* d_ws, size_t ws_size, hipStream_t stream) {
    static int grid = 0;
    if (grid == 0) {
        if (n_in != N_IN || out_size != T * D || ws_size < WS_END2) { fprintf(stderr, "kernel_launch: unexpected shapes: n_in %d out %d ws %zu (need %zu)\n", n_in, out_size, ws_size, (size_t)WS_END2); grid = -1; return; }
        int dev = 0, cus = 0;
        (void)hipGetDevice(&dev); (void)hipDeviceGetAttribute(&cus, hipDeviceAttributeMultiprocessorCount, dev);
        if (hipFuncSetAttribute((const void*)mk_fwd, hipFuncAttributeMaxDynamicSharedMemorySize, LDS_BYTES) != hipSuccess) { fprintf(stderr, "kernel_launch: hipFuncSetAttribute failed\n"); grid = -1; return; }
        grid = cus > 0 ? cus : 256;
        fprintf(stderr, "kernel_launch: ws_size %zu grid %d\n", ws_size, grid);
    }
    if (grid < 0) return;
    (void)hipMemsetAsync((char*)d_ws + WS_CTL, 0, CTL_BYTES, stream);
    Args a{};
    for (int i = 0; i < N_IN; ++i) a.in[i] = (const float*)d_in[i];
    a.out = (float*)d_out; a.ws = (unsigned char*)d_ws;
    a.ph_lo = 0; a.ph_hi = 1000;
    hipLaunchKernelGGL(mk_fwd, dim3(grid), dim3(NTHREADS), LDS_BYTES, stream, a);
}
```

```cpp
#include <hip/hip_runtime.h>
#include <cstdio>
#include <cstdint>
#include <utility>

typedef unsigned short bf16;
typedef _Float16 f16;
typedef float f32x4 __attribute__((ext_vector_type(4)));
typedef unsigned u32x4 __attribute__((ext_vector_type(4)));
typedef unsigned u32x2 __attribute__((ext_vector_type(2)));

constexpr int T = 16384, D = 1024, W = 512, NH = 8, HN = 64, RC = 1792, INC = 4864;
constexpr int NE = 16, FF = 512, DEPTH = 2;
constexpr float LN_EPS = 1e-5f, GN_EPS = 64e-5f, ALPHA = 1.41421356237f;
constexpr int NTHREADS = 512, NWAVES = 8;
constexpr int MAXSLOT = 36864;

constexpr size_t MiB = 1u << 20;
constexpr size_t WS_CTL = 0, CTL_BYTES = 1 * MiB;
constexpr int CW_CNT = 16384;
constexpr size_t WS_PART = 1 * MiB;
constexpr size_t WS_MODF = 2 * MiB;
constexpr size_t WS_TOKI = 2 * MiB + 65536;
constexpr size_t WS_TOKW = WS_TOKI + 131072;
constexpr size_t WS_TOKP = WS_TOKW + 131072;
constexpr size_t WS_S2T = 3 * MiB;
constexpr size_t WS_BLKCNT = 3 * MiB + 512 * 1024;
constexpr size_t WS_TOT = WS_BLKCNT + 32768;
constexpr size_t WS_LORA = 4 * MiB;
constexpr size_t WS_WIN = 8 * MiB;
constexpr size_t WS_WA = 28 * MiB, WS_WB = 29 * MiB, WS_WO = 30 * MiB, WS_WL1 = 4 * MiB;
constexpr size_t WS_ZG = 36 * MiB;
constexpr size_t WS_XN = 100 * MiB;
constexpr size_t WS_G = 100 * MiB, WS_YB = 116 * MiB;
constexpr size_t WS_ZR = 132 * MiB;
constexpr size_t WS_ZS = 188 * MiB;
constexpr size_t WS_YSC = 132 * MiB;
constexpr size_t WS_ST = 148 * MiB;
constexpr size_t WS_YA = 132 * MiB;
constexpr size_t WS_MP = 164 * MiB;
constexpr size_t WS_XS = 132 * MiB;
constexpr size_t WS_Y = 132 * MiB;
constexpr size_t WS_AA = 224 * MiB, WS_BB = 240 * MiB, WS_WM1 = 256 * MiB, WS_R = 272 * MiB, WS_KP = 288 * MiB, WS_V = 304 * MiB;
constexpr size_t WS_WGU = 224 * MiB;
constexpr size_t WS_WD = 256 * MiB;
constexpr size_t WS_HID = 272 * MiB;
constexpr size_t WS_VF = 320 * MiB;
constexpr size_t WS_END = 336 * MiB;

constexpr size_t LO_W2T = 0, LO_A2T = 65536, LO_G2T = 131072, LO_VM1T = 262144, LO_VM2T = 294912, LO_STRIDE = 524288;

enum { I_X = 0, I_C, I_WMOD, I_BMOD, I_WIN, I_MU, I_W0, I_W2, I_A0, I_A2, I_G2, I_KK, I_KA, I_RK, I_GNG, I_GNB, I_VM0, I_VM1, I_VM2,
       I_SGG, I_SGB, I_WS, I_BS, I_WBA, I_WBB, I_WOUT, I_LN1G, I_LN1B, I_RW, I_RB, I_EG, I_EU, I_ED, I_LN2G, I_LN2B, N_IN };

struct Args { const float* in[N_IN]; float* out; unsigned char* ws; int ph_lo, ph_hi; };
typedef const __attribute__((address_space(4))) Args& ArgsR;

__device__ __forceinline__ float bf2f(bf16 h) { return __uint_as_float(((unsigned)h) << 16); }
__device__ __forceinline__ unsigned f2bfu(float f) { unsigned u = __float_as_uint(f); return (u + 0x7fffu + ((u >> 16) & 1u)) >> 16; }
__device__ __forceinline__ bf16 f2bf(float f) { return __builtin_bit_cast(unsigned short, (__bf16)f); }
typedef __bf16 bf16x2_t __attribute__((ext_vector_type(2)));
__device__ __forceinline__ unsigned pk2(float lo, float hi) { bf16x2_t v; v[0] = (__bf16)lo; v[1] = (__bf16)hi; return __builtin_bit_cast(unsigned, v); }
__device__ __forceinline__ void store4bf(bf16* p, f32x4 v) { u32x2 w; w.x = pk2(v[0], v[1]); w.y = pk2(v[2], v[3]); *(u32x2*)p = w; }
__device__ __forceinline__ f32x4 load4bf(const bf16* p) { u32x2 w = *(const u32x2*)p; f32x4 r; r[0] = __uint_as_float(w.x << 16); r[1] = __uint_as_float(w.x & 0xffff0000u); r[2] = __uint_as_float(w.y << 16); r[3] = __uint_as_float(w.y & 0xffff0000u); return r; }
__device__ __forceinline__ float wave_sum(float v) {
    v += __builtin_bit_cast(float, __builtin_amdgcn_update_dpp(0, __builtin_bit_cast(int, v), 0xB1, 0xF, 0xF, true));
    v += __builtin_bit_cast(float, __builtin_amdgcn_update_dpp(0, __builtin_bit_cast(int, v), 0x4E, 0xF, 0xF, true));
    v += __builtin_bit_cast(float, __builtin_amdgcn_update_dpp(0, __builtin_bit_cast(int, v), 0x141, 0xF, 0xF, true));
    v += __builtin_bit_cast(float, __builtin_amdgcn_update_dpp(0, __builtin_bit_cast(int, v), 0x140, 0xF, 0xF, true));
    v += __builtin_bit_cast(float, __builtin_amdgcn_update_dpp(0, __builtin_bit_cast(int, v), 0x142, 0xA, 0xF, false));
    v += __builtin_bit_cast(float, __builtin_amdgcn_update_dpp(0, __builtin_bit_cast(int, v), 0x143, 0xC, 0xF, false));
    return __builtin_bit_cast(float, __builtin_amdgcn_readlane(__builtin_bit_cast(int, v), 63));
}
__device__ __forceinline__ float sigmoidf_(float x) { return __builtin_amdgcn_rcpf(1.0f + __expf(-x)); }
__device__ __forceinline__ float siluf_(float x) { return x * sigmoidf_(x); }
__device__ __forceinline__ float gelu_tanh(float x) { const float u = 0.7978845608028654f * (x + 0.044715f * x * x * x); return x * (1.0f - __builtin_amdgcn_rcpf(1.0f + __expf(2.0f * u))); }
__device__ __forceinline__ float softplusf_(float y) { return fmaxf(y, 0.f) + log1pf(__expf(-fabsf(y))); }

struct Ctx { int tid, lane, wave, gw, ngw; unsigned char* lds; };

__device__ __forceinline__ void transpose_item(const float* Wsrc, int N, int k0, int n0, bf16* dst, int ldk, float* scr, int lane) {
    float tv[32];
#pragma unroll
    for (int i = 0; i < 32; ++i) tv[i] = Wsrc[(size_t)(k0 + 2 * i + (lane >> 5)) * N + n0 + (lane & 31)];
#pragma unroll
    for (int i = 0; i < 32; ++i) scr[(2 * i + (lane >> 5)) * 33 + (lane & 31)] = tv[i];
    asm volatile("s_waitcnt lgkmcnt(0)" ::: "memory");
    const int c = lane & 7;
#pragma unroll
    for (int j = 0; j < 4; ++j) { const int n = (lane >> 3) + 8 * j; const float* s = scr + (8 * c) * 33 + n;
        u32x4 o; o.x = pk2(s[0 * 33], s[1 * 33]); o.y = pk2(s[2 * 33], s[3 * 33]); o.z = pk2(s[4 * 33], s[5 * 33]); o.w = pk2(s[6 * 33], s[7 * 33]);
        *(u32x4*)(dst + (size_t)n * ldk + k0 + 8 * c) = o; }
    asm volatile("s_waitcnt lgkmcnt(0)" ::: "memory");
}
template <class RowMap>
__device__ __forceinline__ void transpose_matrix_item(const float* Wsrc, int K, int N, bf16* dst, int item, float* scr, int lane, const RowMap& rm) {
    const int nblk = N / 32, kb = item / nblk, nb = item % nblk, n0 = 32 * nb;
    transpose_item(Wsrc, N, 64 * kb, n0, dst + (size_t)rm(n0) * K, K, scr, lane);
}
struct RowId { __device__ __forceinline__ int operator()(int n) const { return n; } };
struct RowGU { int up; __device__ __forceinline__ int operator()(int n) const { return (n >> 7) * 256 + (n & 127) + up * 128; } };

__device__ __forceinline__ void phase_p0a(ArgsR a, const Ctx& c) {
    float* scr = (float*)(c.lds + c.wave * 16384);
    { float* MODF = (float*)(a.ws + WS_MODF); float* red = (float*)(c.lds + 131072);
      for (int cbk = blockIdx.x; cbk < 2 * 96; cbk += gridDim.x) {
          const int l = cbk / 96, n = (cbk % 96) * 64 + c.lane;
          const float* wm = a.in[I_WMOD] + (size_t)l * D * 6144 + (size_t)(c.wave * 128) * 6144 + n;
          float acc0 = 0.f, acc1 = 0.f;
#pragma unroll 16
          for (int k = 0; k < 128; k += 2) { acc0 += siluf_(a.in[I_C][c.wave * 128 + k]) * wm[(size_t)k * 6144]; acc1 += siluf_(a.in[I_C][c.wave * 128 + k + 1]) * wm[(size_t)(k + 1) * 6144]; }
          red[c.wave * 64 + c.lane] = acc0 + acc1;
          __syncthreads();
          if (c.wave == 0) { float sacc = a.in[I_BMOD][l * 6144 + n];
#pragma unroll
              for (int w = 0; w < 8; ++w) sacc += red[w * 64 + c.lane];
              MODF[l * 6144 + n] = sacc; }
          __syncthreads();
      } }
    for (int it = c.gw; it < 2 * (16 + 16 + 32 + 8); it += c.ngw) {
        const int l = it / 72; int r = it % 72; unsigned char* lo = a.ws + WS_LORA + (size_t)l * LO_STRIDE;
        if (r < 16) { transpose_matrix_item(a.in[I_W2] + (size_t)l * 64 * W, 64, W, (bf16*)(lo + LO_W2T), r, scr, c.lane, RowId()); continue; } r -= 16;
        if (r < 16) { transpose_matrix_item(a.in[I_A2] + (size_t)l * 64 * W, 64, W, (bf16*)(lo + LO_A2T), r, scr, c.lane, RowId()); continue; } r -= 16;
        if (r < 32) { transpose_matrix_item(a.in[I_G2] + (size_t)l * 128 * W, 128, W, (bf16*)(lo + LO_G2T), r, scr, c.lane, RowId()); continue; } r -= 32;
        if (l == 1) transpose_matrix_item(a.in[I_VM1], W, 32, (bf16*)(lo + LO_VM1T), r, scr, c.lane, RowId());
    }
    for (int i = blockIdx.x * NTHREADS + c.tid; i < 32 * W; i += gridDim.x * NTHREADS) { const int n = i >> 5, k = i & 31;
        ((bf16*)(a.ws + WS_LORA + LO_STRIDE + LO_VM2T))[i] = f2bf(a.in[I_VM2][(size_t)k * W + n]); }
    constexpr int I_WINL = (D / 64) * (INC / 32);
    constexpr int I_WAL = (W / 64) * (D / 32);
    constexpr int I_WOL = (D / 64) * (D / 32);
    constexpr int PER_L = I_WINL + 2 * I_WAL + I_WOL;
    for (int it = c.gw; it < 2 * PER_L; it += c.ngw) {
        const int l = it / PER_L; int r = it % PER_L;
        if (r < I_WINL) { transpose_matrix_item(a.in[I_WIN] + (size_t)l * D * INC, D, INC, (bf16*)(a.ws + WS_WIN + (size_t)l * 10 * MiB), r, scr, c.lane, RowId()); continue; } r -= I_WINL;
        if (r < I_WAL) { transpose_matrix_item(a.in[I_WBA] + (size_t)l * W * D, W, D, (bf16*)(a.ws + WS_WA + (size_t)l * WS_WL1), r, scr, c.lane, RowId()); continue; } r -= I_WAL;
        if (r < I_WAL) { transpose_matrix_item(a.in[I_WBB] + (size_t)l * W * D, W, D, (bf16*)(a.ws + WS_WB + (size_t)l * WS_WL1), r, scr, c.lane, RowId()); continue; } r -= I_WAL;
        transpose_matrix_item(a.in[I_WOUT] + (size_t)l * D * D, D, D, (bf16*)(a.ws + WS_WO + (size_t)l * WS_WL1), r, scr, c.lane, RowId());
    }
}

__device__ __forceinline__ void row_stats(const float (&v)[16], float& mean, float& rstd) {
    float s = 0.f;
#pragma unroll
    for (int j = 0; j < 16; ++j) s += v[j];
    mean = wave_sum(s) * (1.f / D);
    float q = 0.f;
#pragma unroll
    for (int j = 0; j < 16; ++j) { const float d = v[j] - mean; q += d * d; }
    rstd = __builtin_amdgcn_rsqf(wave_sum(q) * (1.f / D) + LN_EPS);
}
__device__ __forceinline__ void load_row16(const float* p, int lane, float (&v)[16]) {
#pragma unroll
    for (int j = 0; j < 4; ++j) { const f32x4 x = *(const f32x4*)(p + 4 * lane + 256 * j); v[4 * j] = x[0]; v[4 * j + 1] = x[1]; v[4 * j + 2] = x[2]; v[4 * j + 3] = x[3]; }
}

__device__ __forceinline__ void phase_p0b(ArgsR a, const Ctx& c) {
    const float* MODF = (const float*)(a.ws + WS_MODF);
    float sh[16], sc[16];
#pragma unroll
    for (int j = 0; j < 4; ++j) { const f32x4 s0 = *(const f32x4*)(MODF + 4 * c.lane + 256 * j), s1 = *(const f32x4*)(MODF + 1024 + 4 * c.lane + 256 * j);
#pragma unroll
        for (int e = 0; e < 4; ++e) { sh[4 * j + e] = s0[e]; sc[4 * j + e] = 1.f + s1[e]; } }
    bf16* XN = (bf16*)(a.ws + WS_XN);
    for (int m = c.gw; m < T; m += c.ngw) {
        float v[16]; load_row16(a.in[I_X] + (size_t)m * D, c.lane, v);
        float mean, rstd; row_stats(v, mean, rstd);
#pragma unroll
        for (int j = 0; j < 4; ++j) { f32x4 o;
#pragma unroll
            for (int e = 0; e < 4; ++e) o[e] = (v[4 * j + e] - mean) * rstd * sc[4 * j + e] + sh[4 * j + e];
            store4bf(XN + (size_t)m * D + 4 * c.lane + 256 * j, o); }
    }
}

namespace pg8 {
#define PG8_LAS __attribute__((address_space(3)))
typedef unsigned short bf16_t;
typedef short bf16x8 __attribute__((ext_vector_type(8)));
typedef float f32x4 __attribute__((ext_vector_type(4)));
typedef unsigned u32x4 __attribute__((ext_vector_type(4)));
constexpr int BM = 256, BK = 64, HALF = 128, HTB = HALF * BK * 2  , STAGE_BYTES = 8 * HTB, NXCD = 8, WGM = 8;

__host__ __device__ __forceinline__ int lds_byte(int r, int c) { const int st = (r >> 4) * 2 + (c >> 5), rr = r & 15, cc = c & 31, ob = rr * 64 + cc * 2; return st * 1024 + (ob ^ (((ob >> 9) & 1) << 5)); }
__host__ __device__ __forceinline__ void stage_rc(int b, int& R, int& C) { const int st = b / 1024, sb = b % 1024, swz = sb ^ (((sb >> 9) & 1) << 5); R = (st >> 1) * 16 + swz / 64; C = (st & 1) * 32 + (swz % 64) / 2; }
__host__ __device__ __forceinline__ int perm32(int rho) { const int n = rho >> 4, i = rho & 15; return 8 * (i >> 2) + 4 * n + (i & 3); }

struct Unit { int pm, pn; };
struct Gemm { const bf16_t* A; const bf16_t* Bt; int M, N, K; };

struct StaticOrder {
    int nM, nN, nwg, G, c;
    __host__ __device__ void init(int M, int N, int G_, int c_) { nM = M / BM; nN = N / BM; nwg = nM * nN; G = G_; c = c_; }
    __host__ __device__ bool next(int i, Unit& u) const {
        const long L = (long)i * G + c; if (L >= nwg) return false;
        int wgid = (int)L; { const int q = nwg / NXCD, r = nwg % NXCD, xcd = wgid % NXCD, off = wgid / NXCD; wgid = (xcd < r ? xcd * (q + 1) : r * (q + 1) + (xcd - r) * q) + off; }
        const int nig = WGM * nN, gid = wgid / nig, fm = gid * WGM, gsz = (nM - fm) < WGM ? (nM - fm) : WGM;
        u.pm = fm + ((wgid % nig) % gsz); u.pn = (wgid % nig) / gsz; return true;
    }
    __device__ __forceinline__ void a_ready(const Unit&) const {}
    __device__ __forceinline__ void done(const Unit&) const {}
};


template <class Epi, class Sched, bool ALIGN_EPI = false, bool SP2 = false, bool GATHER = false>
__device__ __forceinline__ void gemm_phase(PG8_LAS unsigned char* lds, const Gemm g, const Sched& S, const Epi& E, const int tid_in, const int* s2t = nullptr) {
    const int tid = tid_in, wid = __builtin_amdgcn_readfirstlane(tid >> 6), lane = tid & 63, wr = wid >> 2, wc = wid & 3, fr = lane & 15, fq = lane >> 4;
    const int K = g.K, nt = K / BK;
    unsigned voffA[2], voffB[2];
#pragma unroll
    for (int i = 0; i < 2; ++i) { int R, C; stage_rc(tid * 16 + i * 8192, R, C); const int Rb = Epi::PERM ? ((R & ~31) + perm32(R & 31)) : R;
        voffA[i] = (unsigned)(R * K + C) * 2u; voffB[i] = (unsigned)(Rb * K + C) * 2u; }
    unsigned pc0 = 0u, pc1 = 0u, pn0 = 0u, pn1 = 0u, cvoff = 0u; int R0g = 0;
    if constexpr (GATHER) { int R, C; stage_rc(tid * 16, R, C); R0g = R; cvoff = (unsigned)C * 2u; }
#define PG8_TOKPACK(pm_, h_) ([&]() -> unsigned { const int r0_ = (pm_) * BM + (h_) * HALF + R0g; const int a0_ = s2t[2 * r0_], a1_ = s2t[2 * (r0_ + 64)]; return (unsigned)(a0_ < 0 ? 0 : (a0_ >> 1)) | ((unsigned)(a1_ < 0 ? 0 : (a1_ >> 1)) << 16); }())
#define PG8_STAGE_A(bufoff, base, h, usen) do { if constexpr (GATHER) { const unsigned pk_ = (usen) ? ((h) ? pn1 : pn0) : ((h) ? pc1 : pc0); \
        unsigned vt_[2] = {(pk_ & 0xffffu) * (unsigned)(K * 2) + cvoff, (pk_ >> 16) * (unsigned)(K * 2) + cvoff}; PG8_STAGE(bufoff, base, vt_); } \
    else PG8_STAGE(bufoff, (base) + ((h) ? hstep : (size_t)0), voffA); } while (0)
    const size_t kstep = (size_t)(BK * 2);
    const size_t hstep = (size_t)HALF * K * 2;
    const size_t tstep = 2 * hstep;
    const unsigned ldsw = (unsigned)wid * 1024u;
    const int aoff = lds_byte(wr * 64 + fr, fq * 8), boff = lds_byte(wc * 32 + fr, fq * 8);
#define PG8_SA(b, h) (((b) * 2 + (h)) * HTB)
#define PG8_SB(b, h) ((4 + (b) * 2 + (h)) * HTB)
#define PG8_STAGE(bufoff, gbase, voff) do { _Pragma("unroll") for (int _i = 0; _i < 2; ++_i) \
        __builtin_amdgcn_global_load_lds((const unsigned*)((const char*)(gbase) + (voff)[_i]), (PG8_LAS unsigned*)(lds + (bufoff) + ldsw + _i * 8192), 16, 0, 0); } while (0)
#define PG8_LDA(dst, b, h) do { _Pragma("unroll") for (int m = 0; m < 4; ++m) _Pragma("unroll") for (int k = 0; k < 2; ++k) dst[m][k] = *(const PG8_LAS bf16x8*)(lds + PG8_SA(b, h) + aoff + m * 2048 + k * 1024); } while (0)
#define PG8_LDB(dst, b, h) do { _Pragma("unroll") for (int n = 0; n < 2; ++n) _Pragma("unroll") for (int k = 0; k < 2; ++k) dst[n][k] = *(const PG8_LAS bf16x8*)(lds + PG8_SB(b, h) + boff + n * 2048 + k * 1024); } while (0)
#define PG8_MMA(ai, bj, At, Bt) do { __builtin_amdgcn_s_setprio(1); _Pragma("unroll") for (int m = 0; m < 4; ++m) _Pragma("unroll") for (int n = 0; n < 2; ++n) _Pragma("unroll") for (int k = 0; k < 2; ++k) \
        acc[ai][bj][m][n] = __builtin_amdgcn_mfma_f32_16x16x32_bf16(Bt[n][k], At[m][k], acc[ai][bj][m][n], 0, 0, 0); __builtin_amdgcn_s_setprio(0); } while (0)
#define PG8_WAIT_V(n) asm volatile("s_waitcnt vmcnt(" #n ")" ::: "memory")
#define PG8_WAIT_L(n) asm volatile("s_waitcnt lgkmcnt(" #n ")" ::: "memory")
#define PG8_BAR __builtin_amdgcn_s_barrier()
#define PG8_SCHED __builtin_amdgcn_sched_barrier(0)
    Unit cur, nxt; int ui = 0;
    if (!S.next(0, cur)) return;
    f32x4 acc[2][2][4][2];
#pragma unroll
    for (int a = 0; a < 2; ++a)
#pragma unroll
        for (int b = 0; b < 2; ++b)
#pragma unroll
            for (int m = 0; m < 4; ++m)
#pragma unroll
                for (int n = 0; n < 2; ++n) acc[a][b][m][n] = (f32x4){0.f, 0.f, 0.f, 0.f};
    bf16x8 At[4][2], B0[2][2], B1[2][2];
    const char* cA = (const char*)g.A + (GATHER ? (size_t)0 : (size_t)cur.pm * tstep); const char* cB = (const char*)g.Bt + (size_t)cur.pn * tstep;
    if constexpr (GATHER) { pc0 = PG8_TOKPACK(cur.pm, 0); pc1 = PG8_TOKPACK(cur.pm, 1); }
    S.a_ready(cur);
    if constexpr (SP2) {
        PG8_STAGE(PG8_SB(0, 0), cB, voffB); PG8_STAGE(PG8_SB(0, 1), cB + hstep, voffB); PG8_STAGE_A(PG8_SA(0, 0), cA, 0, false); PG8_STAGE_A(PG8_SA(0, 1), cA, 1, false);
        if (wr == 1) PG8_BAR;
        PG8_WAIT_V(2); PG8_BAR;
        PG8_STAGE(PG8_SB(1, 0), cB + kstep, voffB); PG8_STAGE_A(PG8_SA(1, 0), cA + kstep, 0, false); PG8_STAGE(PG8_SB(1, 1), cB + hstep + kstep, voffB);
        PG8_WAIT_V(6); PG8_BAR;
    } else {
        PG8_STAGE(PG8_SB(0, 0), cB, voffB); PG8_STAGE(PG8_SA(0, 0), cA, voffA); PG8_STAGE(PG8_SB(0, 1), cB + hstep, voffB); PG8_STAGE(PG8_SA(0, 1), cA + hstep, voffA);
        if (wr == 1) PG8_BAR;
        PG8_WAIT_V(4); PG8_BAR;
        PG8_STAGE(PG8_SB(1, 0), cB + kstep, voffB); PG8_STAGE(PG8_SA(1, 0), cA + kstep, voffA); PG8_STAGE(PG8_SB(1, 1), cB + hstep + kstep, voffB);
        PG8_WAIT_V(6); PG8_BAR;
    }
    for (;;) {
        const bool has_next = S.next(ui + 1, nxt);
        const char* nA = (has_next && !GATHER) ? (const char*)g.A + (size_t)nxt.pm * tstep : cA; const char* nB = has_next ? (const char*)g.Bt + (size_t)nxt.pn * tstep : cB;
        if constexpr (GATHER) { if (has_next) { pn0 = PG8_TOKPACK(nxt.pm, 0); pn1 = PG8_TOKPACK(nxt.pm, 1); } else { pn0 = pc0; pn1 = pc1; } }
        for (int t = 0; t < nt; t += 2) {
            const bool last = (t == nt - 2);
            const char* a1 = cA + (size_t)(t + 1) * kstep;
            const char* a2 = last ? nA : cA + (size_t)(t + 2) * kstep; const char* b2 = last ? nB : cB + (size_t)(t + 2) * kstep;
            const char* a3 = a2 + kstep; const char* b3 = b2 + kstep;
            if (last && has_next) S.a_ready(nxt);
            if constexpr (SP2) {
            PG8_LDB(B0, 0, 0); PG8_LDB(B1, 0, 1); PG8_SCHED; PG8_LDA(At, 0, 0); PG8_STAGE_A(PG8_SA(1, 1), a1, 1, false);
            PG8_WAIT_V(8); PG8_WAIT_L(0); PG8_BAR; PG8_MMA(0, 0, At, B0); PG8_MMA(0, 1, At, B1); PG8_BAR; PG8_SCHED;
            PG8_LDA(At, 0, 1); PG8_STAGE(PG8_SB(0, 0), b2, voffB); PG8_STAGE(PG8_SB(0, 1), b2 + hstep, voffB); PG8_STAGE_A(PG8_SA(0, 0), a2, 0, last);
            PG8_WAIT_V(8); PG8_WAIT_L(0); PG8_BAR; PG8_MMA(1, 0, At, B0); PG8_MMA(1, 1, At, B1); PG8_BAR; PG8_SCHED;
            PG8_LDB(B0, 1, 0); PG8_LDB(B1, 1, 1); PG8_SCHED; PG8_LDA(At, 1, 0); PG8_STAGE_A(PG8_SA(0, 1), a2, 1, last);
            PG8_WAIT_V(8); PG8_WAIT_L(0); PG8_BAR; PG8_MMA(0, 0, At, B0); PG8_MMA(0, 1, At, B1); PG8_BAR; PG8_SCHED;
            PG8_LDA(At, 1, 1); PG8_STAGE(PG8_SB(1, 0), b3, voffB); PG8_STAGE(PG8_SB(1, 1), b3 + hstep, voffB); PG8_STAGE_A(PG8_SA(1, 0), a3, 0, last);
            PG8_WAIT_V(8); PG8_WAIT_L(0); PG8_BAR; PG8_MMA(1, 0, At, B0); PG8_MMA(1, 1, At, B1); PG8_BAR; PG8_SCHED;
            } else {
            PG8_LDB(B0, 0, 0); PG8_SCHED; PG8_LDA(At, 0, 0); PG8_STAGE(PG8_SA(1, 1), a1 + hstep, voffA);
            PG8_WAIT_L(8); PG8_BAR; PG8_WAIT_L(0); PG8_MMA(0, 0, At, B0); PG8_BAR; PG8_SCHED;
            PG8_LDB(B1, 0, 1); PG8_STAGE(PG8_SB(0, 0), b2, voffB);
            PG8_BAR; PG8_WAIT_L(0); PG8_MMA(0, 1, At, B1); PG8_BAR;
            PG8_LDA(At, 0, 1); PG8_STAGE(PG8_SA(0, 0), a2, voffA);
            PG8_BAR; PG8_WAIT_L(0); PG8_MMA(1, 0, At, B0); PG8_BAR; PG8_SCHED;
            PG8_STAGE(PG8_SB(0, 1), b2 + hstep, voffB);
            PG8_WAIT_V(6); PG8_BAR; PG8_MMA(1, 1, At, B1); PG8_BAR;
            PG8_LDB(B0, 1, 0); PG8_SCHED; PG8_LDA(At, 1, 0); PG8_STAGE(PG8_SA(0, 1), a2 + hstep, voffA);
            PG8_WAIT_L(8); PG8_BAR; PG8_WAIT_L(0); PG8_MMA(0, 0, At, B0); PG8_BAR; PG8_SCHED;
            PG8_LDB(B1, 1, 1); PG8_STAGE(PG8_SB(1, 0), b3, voffB);
            PG8_BAR; PG8_WAIT_L(0); PG8_MMA(0, 1, At, B1); PG8_BAR;
            PG8_LDA(At, 1, 1); PG8_STAGE(PG8_SA(1, 0), a3, voffA);
            PG8_BAR; PG8_WAIT_L(0); PG8_MMA(1, 0, At, B0); PG8_BAR; PG8_SCHED;
            PG8_STAGE(PG8_SB(1, 1), b3 + hstep, voffB);
            PG8_WAIT_V(6); PG8_BAR; PG8_MMA(1, 1, At, B1); PG8_BAR;
            }
        }
        if constexpr (ALIGN_EPI) { if (wr == 0) PG8_BAR; }
        if constexpr (!Epi::AFTER_DRAIN) { E(acc, cur, wr, wc, fr, fq); S.done(cur); }
        if (!has_next) break;
#pragma unroll
        for (int a = 0; a < 2; ++a)
#pragma unroll
            for (int b = 0; b < 2; ++b)
#pragma unroll
                for (int m = 0; m < 4; ++m)
#pragma unroll
                    for (int n = 0; n < 2; ++n) acc[a][b][m][n] = (f32x4){0.f, 0.f, 0.f, 0.f};
        cur = nxt; cA = nA; cB = nB; ++ui; if constexpr (GATHER) { pc0 = pn0; pc1 = pn1; }
        if constexpr (ALIGN_EPI) { if (wr == 1) PG8_BAR; }
    }
    PG8_WAIT_V(0);
    if constexpr (!ALIGN_EPI) { if (wr == 0) PG8_BAR; }
    PG8_BAR;
    if constexpr (Epi::AFTER_DRAIN) { E.fused(acc, cur, wr, wc, fr, fq, lds, wid, lane); S.done(cur); }
#undef PG8_SA
#undef PG8_SB
#undef PG8_STAGE
#undef PG8_STAGE_A
#undef PG8_TOKPACK
#undef PG8_LDA
#undef PG8_LDB
#undef PG8_MMA
#undef PG8_WAIT_V
#undef PG8_WAIT_L
#undef PG8_BAR
#undef PG8_SCHED
}
}

using pg8::Unit;
struct DenseSched { int nN, n, G, c;
    __device__ __forceinline__ void a_ready(const Unit&) const {}
    __device__ __forceinline__ void done(const Unit&) const {}
    __device__ __forceinline__ bool next(int i, Unit& u) const { const int L = i * G + c; if (L >= n) return false; u.pm = L / nN; u.pn = L % nN; return true; } };

__device__ __forceinline__ void store8bf(bf16* p, f32x4 lo, f32x4 hi) { u32x4 w; w.x = pk2(lo[0], lo[1]); w.y = pk2(lo[2], lo[3]); w.z = pk2(hi[0], hi[1]); w.w = pk2(hi[2], hi[3]); *(u32x4*)p = w; }
__device__ __forceinline__ void load8bf(const bf16* p, f32x4& lo, f32x4& hi) { const u32x4 w = *(const u32x4*)p;
    lo[0] = __uint_as_float(w.x << 16); lo[1] = __uint_as_float(w.x & 0xffff0000u); lo[2] = __uint_as_float(w.y << 16); lo[3] = __uint_as_float(w.y & 0xffff0000u);
    hi[0] = __uint_as_float(w.z << 16); hi[1] = __uint_as_float(w.z & 0xffff0000u); hi[2] = __uint_as_float(w.w << 16); hi[3] = __uint_as_float(w.w & 0xffff0000u); }
struct EpiZ { bf16 *ZR, *ZS, *ZG;
    __device__ __forceinline__ void one(int row, int col, f32x4 lo, f32x4 hi) const {
        if (col < RC) store8bf(ZR + (size_t)row * RC + col, lo, hi);
        else if (col < RC + 1024) { for (int e = 0; e < 4; ++e) { lo[e] = gelu_tanh(lo[e]); hi[e] = gelu_tanh(hi[e]); } store8bf(ZS + (size_t)row * 1024 + (col - RC), lo, hi); }
        else { for (int e = 0; e < 4; ++e) { lo[e] = sigmoidf_(lo[e]); hi[e] = sigmoidf_(hi[e]); } store8bf(ZG + (size_t)row * 2048 + (col - RC - 1024), lo, hi); } }
    __device__ __forceinline__ void operator()(int row, int col, f32x4 a0, f32x4 a1, f32x4 b0, f32x4 b1) const { one(row, col, a0, a1); one(row, col + 128, b0, b1); } };
struct EpiGA { const bf16* ZG; bf16* MP;
    __device__ __forceinline__ void one(int row, int col, f32x4 lo, f32x4 hi) const { f32x4 g0, g1; load8bf(ZG + (size_t)row * 2048 + col, g0, g1); store8bf(MP + (size_t)row * D + col, g0 * lo, g1 * hi); }
    __device__ __forceinline__ void operator()(int row, int col, f32x4 a0, f32x4 a1, f32x4 b0, f32x4 b1) const { one(row, col, a0, a1); one(row, col + 128, b0, b1); } };
struct EpiGB { const bf16* ZG; const bf16* MPin; bf16* MP;
    __device__ __forceinline__ void one(int row, int col, f32x4 lo, f32x4 hi) const { f32x4 g0, g1, m0, m1; load8bf(ZG + (size_t)row * 2048 + 1024 + col, g0, g1); load8bf(MPin + (size_t)row * D + col, m0, m1);
        store8bf(MP + (size_t)row * D + col, m0 + g0 * lo, m1 + g1 * hi); }
    __device__ __forceinline__ void operator()(int row, int col, f32x4 a0, f32x4 a1, f32x4 b0, f32x4 b1) const { one(row, col, a0, a1); one(row, col + 128, b0, b1); } };
struct EpiOut { const float* xin; float* out; const float* gate1;
    __device__ __forceinline__ void one(int row, int col, f32x4 v) const { const f32x4 x = *(const f32x4*)(xin + (size_t)row * D + col); const f32x4 g = *(const f32x4*)(gate1 + col);
        *(f32x4*)(out + (size_t)row * D + col) = ALPHA * x + (1.0f + g) * v; }
    __device__ __forceinline__ void operator()(int row, int col, f32x4 a0, f32x4 a1, f32x4 b0, f32x4 b1) const { one(row, col, a0); one(row, col + 4, a1); one(row, col + 128, b0); one(row, col + 132, b1); } };
struct EpiSwi { bf16* HID;
    __device__ __forceinline__ void operator()(int row, int col, f32x4 a0, f32x4 a1, f32x4 b0, f32x4 b1) const { const int ct = (col >> 8) & 3, cc = col & 127;
        f32x4 h0, h1; for (int e = 0; e < 4; ++e) { h0[e] = siluf_(a0[e]) * b0[e]; h1[e] = siluf_(a1[e]) * b1[e]; } store8bf(HID + (size_t)row * FF + ct * 128 + cc, h0, h1); } };
struct EpiDown { const int* S2T; const float* TOKW; bf16* Y;
    __device__ __forceinline__ void operator()(int row, int col, f32x4 a0, f32x4 a1, f32x4 b0, f32x4 b1) const { const u32x2 sw = *(const u32x2*)(S2T + 2 * row); const int st = (int)sw.x; if (st < 0) return; const float w = __uint_as_float(sw.y); const int cc = col & 1023;
        store8bf(Y + (size_t)st * D + cc, w * a0, w * a1); store8bf(Y + (size_t)st * D + cc + 128, w * b0, w * b1); } };

struct MoeSched { int ts[17]; int G, c;
    __device__ __forceinline__ void a_ready(const Unit&) const {}
    __device__ __forceinline__ void done(const Unit&) const {}
    __device__ __forceinline__ void init(const unsigned* cnt, int G_, int c_) { G = G_; c = c_; int s = 0;
#pragma unroll
        for (int e = 0; e < 16; ++e) { ts[e] = s; s += ((int)cnt[e] + 255) >> 8; } ts[16] = s; }
    __device__ __forceinline__ bool next(int i, Unit& u) const { const int L = i * G + c; if (L >= 4 * ts[16]) return false; const int rt = L >> 2, ct = L & 3; int e = 0;
#pragma unroll
        for (int j = 1; j < 16; ++j) e += (rt >= ts[j]) ? 1 : 0;
        u.pm = rt; u.pn = e * 4 + ct; return true; } };

__device__ __forceinline__ void phase_prep_simple(ArgsR a, const Ctx& c, int l) {
    const bf16* ZR = (const bf16*)(a.ws + WS_ZR);
    const float* mu = a.in[I_MU] + l * RC; const float* w0 = a.in[I_W0] + l * W; const float* w2 = a.in[I_W2] + (size_t)l * 64 * W;
    const float* a0 = a.in[I_A0] + l * W; const float* a2 = a.in[I_A2] + (size_t)l * 64 * W; const float* g2 = a.in[I_G2] + (size_t)l * 128 * W;
    const float* k_k = a.in[I_KK] + l * W; const float* k_a = a.in[I_KA] + l * W;
    const float* vm0 = a.in[I_VM0]; const float* vm1 = a.in[I_VM1]; const float* vm2 = a.in[I_VM2];
    f16* R = (f16*)(a.ws + WS_R); f16* WM1 = (f16*)(a.ws + WS_WM1); f16* KP = (f16*)(a.ws + WS_KP); f16* AA = (f16*)(a.ws + WS_AA); f16* BB = (f16*)(a.ws + WS_BB); f16* V = (f16*)(a.ws + WS_V);
    bf16* G = (bf16*)(a.ws + WS_G); bf16* VF = (bf16*)(a.ws + WS_VF);
    const int lane = c.lane;
    for (int t = c.gw; t < T; t += c.ngw) {
        float z[28];
#pragma unroll
        for (int i = 0; i < 28; ++i) { const int col = lane + 64 * i; const float zc = bf2f(ZR[(size_t)t * RC + col]); const float zp = t > 0 ? bf2f(ZR[(size_t)(t - 1) * RC + col]) : 0.f; z[i] = zc + (zp - zc) * mu[col]; }
        const float tw = tanhf(z[24]), za = z[25], sg0 = sigmoidf_(z[26]), sg1 = sigmoidf_(z[27]);
        float wlo[8], alo[8], gg[8];
#pragma unroll
        for (int i = 0; i < 8; ++i) { wlo[i] = 0.f; alo[i] = 0.f; gg[i] = 0.f; }
        for (int j = 0; j < 64; ++j) { const float tj = __shfl(tw, j), aj = __shfl(za, j), s0 = __shfl(sg0, j), s1 = __shfl(sg1, j);
#pragma unroll
            for (int i = 0; i < 8; ++i) { const int n = lane + 64 * i; wlo[i] += tj * w2[j * W + n]; alo[i] += aj * a2[j * W + n]; gg[i] += s0 * g2[j * W + n] + s1 * g2[(64 + j) * W + n]; } }
        float vv[8];
#pragma unroll
        for (int i = 0; i < 8; ++i) vv[i] = z[16 + i];
        if (l == 0) {
#pragma unroll
            for (int i = 0; i < 8; ++i) VF[(size_t)t * W + lane + 64 * i] = f2bf(vv[i]);
        } else {
            float vmid = 0.f;
#pragma unroll
            for (int i = 0; i < 8; ++i)
                for (int j = 0; j < 64; ++j) { const float vc = __shfl(vv[i], j); vmid += vc * vm1[(size_t)(64 * i + j) * 32 + (lane & 31)]; }
            float vg[8];
#pragma unroll
            for (int i = 0; i < 8; ++i) vg[i] = 0.f;
            for (int m = 0; m < 32; ++m) { const float vmm = __shfl(vmid, m);
#pragma unroll
                for (int i = 0; i < 8; ++i) vg[i] += vmm * vm2[m * W + lane + 64 * i]; }
#pragma unroll
            for (int i = 0; i < 8; ++i) { const int n = lane + 64 * i; const float vf = bf2f(VF[(size_t)t * W + n]); vv[i] = vv[i] + (vf - vv[i]) * sigmoidf_(vm0[n] + vg[i]); }
        }
#pragma unroll
        for (int i = 0; i < 8; ++i) {
            const int n = lane + 64 * i; const size_t o = (size_t)t * W + n;
            const float x = w0[n] + wlo[i]; const float wl = -softplusf_(-x) - 0.5f; const float dm1 = expm1f(-__expf(wl));
            const float av = sigmoidf_(a0[n] + alo[i]);
            const float kraw = z[8 + i];
            float kk = kraw * k_k[n]; const float nrm = sqrtf(wave_sum(kk * kk)); kk = kk / fmaxf(nrm, 1e-12f);
            const float kp = kraw * (1.0f + (av - 1.0f) * k_a[n]);
            R[o] = (f16)z[i]; WM1[o] = (f16)dm1; KP[o] = (f16)kp; AA[o] = (f16)(-kk); BB[o] = (f16)(kk * av); V[o] = (f16)vv[i]; G[o] = f2bf(gg[i]);
        }
    }
}

__device__ __forceinline__ void phase_sg_simple(ArgsR a, const Ctx& c, int l) {
    const bf16* ZS = (const bf16*)(a.ws + WS_ZS); bf16* YB = (bf16*)(a.ws + WS_YB);
    const float* lng = a.in[I_SGG] + l * W; const float* lnb = a.in[I_SGB] + l * W;
    float* vn = (float*)c.lds;
    float* st = vn + 128 * 64;
    for (int uidx = blockIdx.x; uidx < 128 * 8; uidx += gridDim.x) {
        const int ch = uidx >> 3, g = uidx & 7; const int tok0 = ch * 128;
        for (int i = 0; i < 16; ++i) { const int s = c.wave * 16 + i; const bf16* p = ZS + (size_t)(tok0 + s) * 1024 + 512 + c.lane * 8;
            const f32x4 x0 = load4bf(p), x1 = load4bf(p + 4);
            float sm = (x0[0] + x0[1]) + (x0[2] + x0[3]) + (x1[0] + x1[1]) + (x1[2] + x1[3]); const float mean = wave_sum(sm) * (1.f / 512.f);
            float q = 0.f; for (int e = 0; e < 4; ++e) { const float d0 = x0[e] - mean, d1 = x1[e] - mean; q += d0 * d0 + d1 * d1; }
            const float rstd = __builtin_amdgcn_rsqf(wave_sum(q) * (1.f / 512.f) + LN_EPS);
            if (c.lane == 0) { st[2 * s] = mean; st[2 * s + 1] = rstd; } }
        __syncthreads();
        for (int i = c.tid; i < 128 * 64; i += NTHREADS) { const int s = i >> 6, d = i & 63; const float x = bf2f(ZS[(size_t)(tok0 + s) * 1024 + 512 + g * 64 + d]);
            vn[i] = (x - st[2 * s]) * st[2 * s + 1] * lng[g * 64 + d] + lnb[g * 64 + d]; }
        __syncthreads();
        const int d = c.tid & 63, tq = c.tid >> 6;
        const float* Wg = a.in[I_WS] + (size_t)(l * 8 + g) * 128 * 128; const float* bs = a.in[I_BS] + (size_t)(l * 8 + g) * 128;
        for (int i = 0; i < 16; ++i) { const int t = tq + 8 * i; float acc = 0.f;
            for (int s = 0; s <= t; ++s) acc += Wg[t * 128 + s] * vn[s * 64 + d];
            const float u = bf2f(ZS[(size_t)(tok0 + t) * 1024 + g * 64 + d]);
            YB[(size_t)(tok0 + t) * W + g * 64 + d] = f2bf(u * (acc + bs[t])); }
        __syncthreads();
    }
}

#define LAS3 __attribute__((address_space(3)))
typedef short bf16x8 __attribute__((ext_vector_type(8)));
template <int MT, int NT, int KS, bool SWAP = false>
__device__ __forceinline__ void mma_lds_glob(const unsigned char* lds_base, int a_off_bytes, int lda, const bf16* Bt, int ldb, int n0, int lane, f32x4 (&acc)[MT][NT]) {
    const int fr = lane & 15, fq = lane >> 4;
    const LAS3 unsigned char* Ab = (const LAS3 unsigned char*)lds_base + a_off_bytes;
    int boff = (n0 + fr) * ldb + 8 * fq; asm volatile("" : "+v"(boff));
#pragma unroll
    for (int ks = 0; ks < KS; ++ks) {
        bf16x8 b[NT];
#pragma unroll
        for (int n = 0; n < NT; ++n) b[n] = *(const bf16x8*)(Bt + boff + 16 * n * ldb + 32 * ks);
#pragma unroll
        for (int m = 0; m < MT; ++m) { const bf16x8 av = *(const LAS3 bf16x8*)(Ab + ((16 * m + fr) * lda + 32 * ks + 8 * fq) * 2);
#pragma unroll
            for (int n = 0; n < NT; ++n) acc[m][n] = SWAP ? __builtin_amdgcn_mfma_f32_16x16x32_bf16(b[n], av, acc[m][n], 0, 0, 0) : __builtin_amdgcn_mfma_f32_16x16x32_bf16(av, b[n], acc[m][n], 0, 0, 0); }
    }
}
__device__ __forceinline__ void zshift8(const bf16* ZR, int t, int col, const float* mu, float (&o)[8]) {
    const u32x4 zc = *(const u32x4*)(ZR + (size_t)t * RC + col);
    u32x4 zp = {0u, 0u, 0u, 0u}; if (t > 0) zp = *(const u32x4*)(ZR + (size_t)(t - 1) * RC + col);
    const f32x4 m0 = *(const f32x4*)(mu + col), m1 = *(const f32x4*)(mu + col + 4);
#pragma unroll
    for (int e = 0; e < 4; ++e) { const float c0 = __uint_as_float(zc[e] << 16), c1 = __uint_as_float(zc[e] & 0xffff0000u), p0 = __uint_as_float(zp[e] << 16), p1 = __uint_as_float(zp[e] & 0xffff0000u);
        const float mu0 = (2 * e < 4) ? m0[(2 * e) & 3] : m1[(2 * e) & 3], mu1 = (2 * e + 1 < 4) ? m0[(2 * e + 1) & 3] : m1[(2 * e + 1) & 3];
        o[2 * e] = c0 + (p0 - c0) * mu0; o[2 * e + 1] = c1 + (p1 - c1) * mu1; }
}
typedef _Float16 f16x8 __attribute__((ext_vector_type(8)));
typedef _Float16 f16x4 __attribute__((ext_vector_type(4)));
__device__ __forceinline__ void store8f16(f16* p, const float (&v)[8]) { f16x8 h;
#pragma unroll
    for (int e = 0; e < 8; ++e) h[e] = (f16)v[e];
    *(f16x8*)p = h; }
__device__ __forceinline__ u32x4 pack8bf(const float (&v)[8]) { u32x4 w; w.x = pk2(v[0], v[1]); w.y = pk2(v[2], v[3]); w.z = pk2(v[4], v[5]); w.w = pk2(v[6], v[7]); return w; }


constexpr int PB_LD = 520;
constexpr int PB_BUF = 0, PB_AOP = 64 * PB_LD * 2, PB_VMID = 2 * 64 * PB_LD * 2, PB_LA_LD = 264, PB_VM_LD = 40;
__device__ __forceinline__ void phase_prep_fast(ArgsR a, const Ctx& c, int l) {
    const bf16* ZR = (const bf16*)(a.ws + WS_ZR);
    const float* mu = a.in[I_MU] + l * RC; const float* w0 = a.in[I_W0] + l * W; const float* a0 = a.in[I_A0] + l * W;
    const float* k_k = a.in[I_KK] + l * W; const float* k_a = a.in[I_KA] + l * W; const float* vm0 = a.in[I_VM0];
    f16* R = (f16*)(a.ws + WS_R); f16* WM1 = (f16*)(a.ws + WS_WM1); f16* KP = (f16*)(a.ws + WS_KP); f16* AA = (f16*)(a.ws + WS_AA); f16* BB = (f16*)(a.ws + WS_BB); f16* V = (f16*)(a.ws + WS_V);
    bf16* G = (bf16*)(a.ws + WS_G); bf16* VF = (bf16*)(a.ws + WS_VF);
    const unsigned char* lo = a.ws + WS_LORA + (size_t)l * LO_STRIDE;
    const bf16* W2T = (const bf16*)(lo + LO_W2T); const bf16* A2T = (const bf16*)(lo + LO_A2T); const bf16* G2T = (const bf16*)(lo + LO_G2T);
    const bf16* VM1T = (const bf16*)(lo + LO_VM1T); const bf16* VM2T = (const bf16*)(lo + LO_VM2T);
    LAS3 unsigned char* L = (LAS3 unsigned char*)c.lds;
    const int tid = c.tid, lane = c.lane, wv = c.wave, fr = lane & 15, fq = lane >> 4;
    const int row = tid >> 3, sub_ = tid & 7;
    for (int u = blockIdx.x; u < T / 64; u += gridDim.x) {
        int sub = sub_; asm volatile("" : "+v"(sub));
        const int t0 = u * 64, t = t0 + row;
        if (l == 0) {
#pragma unroll 4
            for (int p = 0; p < 8; ++p) { const int col = p * 64 + sub * 8; float z[8]; zshift8(ZR, t, 1024 + col, mu, z);
                store8f16(V + (size_t)t * W + col, z); *(u32x4*)(VF + (size_t)t * W + col) = pack8bf(z); }
        } else {
#pragma unroll 4
            for (int p = 0; p < 8; ++p) { const int col = p * 64 + sub * 8; float z[8]; zshift8(ZR, t, 1024 + col, mu, z);
                *(LAS3 u32x4*)(L + PB_AOP + (row * PB_LD + col) * 2) = pack8bf(z); }
            __syncthreads();
            { f32x4 acc[1][1]; acc[0][0] = (f32x4){0.f, 0.f, 0.f, 0.f}; const int m = wv >> 1, n = wv & 1;
              mma_lds_glob<1, 1, 16>(c.lds, PB_AOP + 16 * m * PB_LD * 2, PB_LD, VM1T, W, 16 * n, lane, acc);
#pragma unroll
              for (int i = 0; i < 4; ++i) *(LAS3 bf16*)(L + PB_VMID + ((16 * m + 4 * fq + i) * PB_VM_LD + 16 * n + fr) * 2) = f2bf(acc[0][0][i]); }
            __syncthreads();
            { f32x4 acc[4][4];
#pragma unroll
              for (int m = 0; m < 4; ++m)
#pragma unroll
                  for (int n = 0; n < 4; ++n) acc[m][n] = (f32x4){0.f, 0.f, 0.f, 0.f};
              mma_lds_glob<4, 4, 1, true>(c.lds, PB_VMID, PB_VM_LD, VM2T, 32, 64 * wv, lane, acc);
#pragma unroll
              for (int m = 0; m < 4; ++m)
#pragma unroll
                  for (int n = 0; n < 4; ++n) { const int col = 64 * wv + 16 * n + 4 * fq; const f32x4 vb = *(const f32x4*)(vm0 + col); f16x4 hv;
#pragma unroll
                      for (int i = 0; i < 4; ++i) hv[i] = (f16)sigmoidf_(vb[i] + acc[m][n][i]);
                      *(LAS3 f16x4*)(L + PB_BUF + ((16 * m + fr) * PB_LD + col) * 2) = hv; } }
            __syncthreads();
#pragma unroll 4
            for (int p = 0; p < 8; ++p) { const int col = p * 64 + sub * 8;
                const u32x4 vz = *(const LAS3 u32x4*)(L + PB_AOP + (row * PB_LD + col) * 2); const f16x8 gt = *(const LAS3 f16x8*)(L + PB_BUF + (row * PB_LD + col) * 2);
                const u32x4 vfw = *(const u32x4*)(VF + (size_t)t * W + col); float o[8];
#pragma unroll
                for (int e = 0; e < 4; ++e) { const float v0 = __uint_as_float(vz[e] << 16), v1 = __uint_as_float(vz[e] & 0xffff0000u), f0 = __uint_as_float(vfw[e] << 16), f1 = __uint_as_float(vfw[e] & 0xffff0000u);
                    o[2 * e] = v0 + (f0 - v0) * (float)gt[2 * e]; o[2 * e + 1] = v1 + (f1 - v1) * (float)gt[2 * e + 1]; }
                store8f16(V + (size_t)t * W + col, o); }
            __syncthreads();
        }
#pragma unroll 4
        for (int p = 0; p < 4; ++p) { const int cc = sub * 32 + p * 8; float z[8]; zshift8(ZR, t, 1536 + cc, mu, z);
#pragma unroll
            for (int e = 0; e < 8; ++e) z[e] = cc < 64 ? (1.0f - 2.0f * __builtin_amdgcn_rcpf(1.0f + __expf(2.0f * z[e]))) : (cc < 128 ? z[e] : sigmoidf_(z[e]));
            *(LAS3 u32x4*)(L + PB_AOP + (row * PB_LA_LD + cc) * 2) = pack8bf(z); }
        __syncthreads();
        { f32x4 acc[4][4];
#pragma unroll
          for (int m = 0; m < 4; ++m)
#pragma unroll
              for (int n = 0; n < 4; ++n) acc[m][n] = (f32x4){0.f, 0.f, 0.f, 0.f};
          mma_lds_glob<4, 4, 2, true>(c.lds, PB_AOP + 64 * 2, PB_LA_LD, A2T, 64, 64 * wv, lane, acc);
#pragma unroll
          for (int m = 0; m < 4; ++m)
#pragma unroll
              for (int n = 0; n < 4; ++n) { const int col = 64 * wv + 16 * n + 4 * fq; const f32x4 ab = *(const f32x4*)(a0 + col); f16x4 hv;
#pragma unroll
                  for (int i = 0; i < 4; ++i) hv[i] = (f16)sigmoidf_(ab[i] + acc[m][n][i]);
                  *(LAS3 f16x4*)(L + PB_BUF + ((16 * m + fr) * PB_LD + col) * 2) = hv; } }
        __syncthreads();
#pragma unroll 4
        for (int p = 0; p < 8; ++p) { const int col = p * 64 + sub * 8; const size_t o = (size_t)t * W + col;
            float z[8]; zshift8(ZR, t, col, mu, z); store8f16(R + o, z);
            float kz[8]; zshift8(ZR, t, 512 + col, mu, kz);
            const f16x8 av = *(const LAS3 f16x8*)(L + PB_BUF + (row * PB_LD + col) * 2);
            const f32x4 kk0 = *(const f32x4*)(k_k + col), kk1 = *(const f32x4*)(k_k + col + 4), ka0 = *(const f32x4*)(k_a + col), ka1 = *(const f32x4*)(k_a + col + 4);
            float kk[8], kp[8], bb[8]; float ss = 0.f;
#pragma unroll
            for (int e = 0; e < 8; ++e) { const float kkw = e < 4 ? kk0[e & 3] : kk1[e & 3], kaw = e < 4 ? ka0[e & 3] : ka1[e & 3]; kk[e] = kz[e] * kkw; ss += kk[e] * kk[e]; kp[e] = kz[e] * (1.0f + ((float)av[e] - 1.0f) * kaw); }
            ss += __shfl_xor(ss, 1); ss += __shfl_xor(ss, 2); ss += __shfl_xor(ss, 4);
            const float inv = fminf(__builtin_amdgcn_rsqf(ss), 1e12f);
#pragma unroll
            for (int e = 0; e < 8; ++e) { kk[e] *= inv; bb[e] = kk[e] * (float)av[e]; kk[e] = -kk[e]; }
            store8f16(KP + o, kp); store8f16(AA + o, kk); store8f16(BB + o, bb); }
        __syncthreads();
        { f32x4 acc[4][4];
#pragma unroll
          for (int m = 0; m < 4; ++m)
#pragma unroll
              for (int n = 0; n < 4; ++n) acc[m][n] = (f32x4){0.f, 0.f, 0.f, 0.f};
          mma_lds_glob<4, 4, 2, true>(c.lds, PB_AOP, PB_LA_LD, W2T, 64, 64 * wv, lane, acc);
#pragma unroll
          for (int m = 0; m < 4; ++m)
#pragma unroll
              for (int n = 0; n < 4; ++n) { const int col = 64 * wv + 16 * n + 4 * fq; const f32x4 wb = *(const f32x4*)(w0 + col); f16x4 hv;
#pragma unroll
                  for (int i = 0; i < 4; ++i) { const float x = wb[i] + acc[m][n][i]; const float wl = -(fmaxf(-x, 0.f) + __logf(1.0f + __expf(-fabsf(x)))) - 0.5f;
                      hv[i] = (f16)(__expf(-__expf(wl)) - 1.0f); }
                  *(LAS3 f16x4*)(L + PB_BUF + ((16 * m + fr) * PB_LD + col) * 2) = hv; } }
        __syncthreads();
#pragma unroll 4
        for (int p = 0; p < 8; ++p) { const int col = p * 64 + sub * 8; *(u32x4*)(WM1 + (size_t)t * W + col) = *(const LAS3 u32x4*)(L + PB_BUF + (row * PB_LD + col) * 2); }
        __syncthreads();
        { f32x4 acc[4][4];
#pragma unroll
          for (int m = 0; m < 4; ++m)
#pragma unroll
              for (int n = 0; n < 4; ++n) acc[m][n] = (f32x4){0.f, 0.f, 0.f, 0.f};
          mma_lds_glob<4, 4, 4, true>(c.lds, PB_AOP + 128 * 2, PB_LA_LD, G2T, 128, 64 * wv, lane, acc);
#pragma unroll
          for (int m = 0; m < 4; ++m)
#pragma unroll
              for (int n = 0; n < 4; ++n) { const int col = 64 * wv + 16 * n + 4 * fq; u32x2 w; w.x = pk2(acc[m][n][0], acc[m][n][1]); w.y = pk2(acc[m][n][2], acc[m][n][3]);
                  *(LAS3 u32x2*)(L + PB_BUF + ((16 * m + fr) * PB_LD + col) * 2) = w; } }
        __syncthreads();
#pragma unroll 4
        for (int p = 0; p < 8; ++p) { const int col = p * 64 + sub * 8; *(u32x4*)(G + (size_t)t * W + col) = *(const LAS3 u32x4*)(L + PB_BUF + (row * PB_LD + col) * 2); }
        __syncthreads();
    }
}

constexpr int SG_LD = 136;
constexpr int SG_VT = 0, SG_ST = 256 * SG_LD * 2;
__device__ __forceinline__ void phase_sg_fast(ArgsR a, const Ctx& c, int l) {
    const bf16* ZS = (const bf16*)(a.ws + WS_ZS); bf16* YB = (bf16*)(a.ws + WS_YB);
    const float* lng = a.in[I_SGG] + l * W; const float* lnb = a.in[I_SGB] + l * W;
    LAS3 unsigned char* L = (LAS3 unsigned char*)c.lds;
    LAS3 float* st = (LAS3 float*)(L + SG_ST);
    const int tid = c.tid, lane = c.lane, wv = c.wave, fr = lane & 15, fq = lane >> 4;
    for (int u = blockIdx.x; u < 256; u += gridDim.x) {
        const int ch = u >> 1, hf = u & 1, tok0 = ch * 128;
        { u32x4 raw[16];
#pragma unroll
          for (int i = 0; i < 16; ++i) raw[i] = *(const u32x4*)(ZS + (size_t)(tok0 + wv * 16 + i) * 1024 + 512 + lane * 8);
#pragma unroll
          for (int i = 0; i < 16; ++i) { const int sidx = wv * 16 + i; float x[8];
#pragma unroll
              for (int e = 0; e < 4; ++e) { x[2 * e] = __uint_as_float(raw[i][e] << 16); x[2 * e + 1] = __uint_as_float(raw[i][e] & 0xffff0000u); }
              const float sm = ((x[0] + x[1]) + (x[2] + x[3])) + ((x[4] + x[5]) + (x[6] + x[7])); const float mean = wave_sum(sm) * (1.f / 512.f);
              float q = 0.f;
#pragma unroll
              for (int e = 0; e < 8; ++e) { const float d0 = x[e] - mean; q += d0 * d0; }
              const float rstd = __builtin_amdgcn_rsqf(wave_sum(q) * (1.f / 512.f) + LN_EPS);
              if (lane == 0) { st[2 * sidx] = mean; st[2 * sidx + 1] = rstd; } } }
        __syncthreads();
        { const int sidx = tid >> 2, q4 = tid & 3; const float mean = st[2 * sidx], rstd = st[2 * sidx + 1];
#pragma unroll
          for (int p = 0; p < 8; ++p) { const int cl = q4 * 64 + p * 8; const int cg = hf * 256 + cl;
              const bf16* src = ZS + (size_t)(tok0 + sidx) * 1024 + 512 + cg; const f32x4 x0 = load4bf(src), x1 = load4bf(src + 4);
              const f32x4 g0 = *(const f32x4*)(lng + cg), g1 = *(const f32x4*)(lng + cg + 4), b0 = *(const f32x4*)(lnb + cg), b1 = *(const f32x4*)(lnb + cg + 4);
#pragma unroll
              for (int e = 0; e < 8; ++e) { const float x = e < 4 ? x0[e & 3] : x1[e & 3], gg = e < 4 ? g0[e & 3] : g1[e & 3], bb = e < 4 ? b0[e & 3] : b1[e & 3];
                  *(LAS3 bf16*)(L + SG_VT + ((cl + e) * SG_LD + sidx) * 2) = f2bf((x - mean) * rstd * gg + bb); } } }
        __syncthreads();
        const int gl = wv >> 1, dh = wv & 1, g = hf * 4 + gl;
        const float* Wg = a.in[I_WS] + (size_t)(l * 8 + g) * 128 * 128; const float* bs = a.in[I_BS] + (size_t)(l * 8 + g) * 128;
        f32x4 acc[8][2];
#pragma unroll
        for (int m = 0; m < 8; ++m) { acc[m][0] = (f32x4){0.f, 0.f, 0.f, 0.f}; acc[m][1] = (f32x4){0.f, 0.f, 0.f, 0.f}; }
#pragma unroll
        for (int ks = 0; ks < 4; ++ks) {
            bf16x8 b[2];
#pragma unroll
            for (int n = 0; n < 2; ++n) b[n] = *(const LAS3 bf16x8*)(L + SG_VT + ((gl * 64 + dh * 32 + 16 * n + fr) * SG_LD + 32 * ks + 8 * fq) * 2);
#pragma unroll
            for (int m = 0; m < 8; ++m) { if (32 * ks <= 16 * m + 15) {
                const int trow = 16 * m + fr, s0 = 32 * ks + 8 * fq;
                const f32x4 w0v = *(const f32x4*)(Wg + trow * 128 + s0), w1v = *(const f32x4*)(Wg + trow * 128 + s0 + 4);
                float wf[8];
#pragma unroll
                for (int e = 0; e < 8; ++e) { const float wval = e < 4 ? w0v[e & 3] : w1v[e & 3]; wf[e] = (s0 + e <= trow) ? wval : 0.f; }
                const u32x4 wp = pack8bf(wf); const bf16x8 av = __builtin_bit_cast(bf16x8, wp);
                acc[m][0] = __builtin_amdgcn_mfma_f32_16x16x32_bf16(b[0], av, acc[m][0], 0, 0, 0);
                acc[m][1] = __builtin_amdgcn_mfma_f32_16x16x32_bf16(b[1], av, acc[m][1], 0, 0, 0); } }
        }
#pragma unroll
        for (int m = 0; m < 8; ++m) { const int trow = 16 * m + fr; const float bsv = bs[trow];
#pragma unroll
            for (int n = 0; n < 2; ++n) { const int col = g * 64 + dh * 32 + 16 * n + 4 * fq; const f32x4 uu = load4bf(ZS + (size_t)(tok0 + trow) * 1024 + col);
                store4bf(YB + (size_t)(tok0 + trow) * W + col, uu * (acc[m][n] + bsv)); } }
        __syncthreads();
    }
}

__device__ __forceinline__ void phase_scan_simple(ArgsR a, const Ctx& c) {
    if (c.wave != 0 || blockIdx.x >= NH) return;
    const int h = blockIdx.x, lane = c.lane;
    const f16* R = (const f16*)(a.ws + WS_R); const f16* WM1 = (const f16*)(a.ws + WS_WM1); const f16* KP = (const f16*)(a.ws + WS_KP);
    const f16* AA = (const f16*)(a.ws + WS_AA); const f16* BB = (const f16*)(a.ws + WS_BB); const f16* V = (const f16*)(a.ws + WS_V);
    bf16* YSC = (bf16*)(a.ws + WS_YSC);
    float S[64];
#pragma unroll
    for (int j = 0; j < 64; ++j) S[j] = 0.f;
    for (int t = 0; t < T; ++t) {
        const size_t base = (size_t)t * W + h * 64;
        const float vv = (float)V[base + lane];
        float sa = 0.f;
#pragma unroll
        for (int j = 0; j < 64; ++j) sa += S[j] * (float)AA[base + j];
        float y = 0.f;
#pragma unroll
        for (int j = 0; j < 64; ++j) { float s = S[j]; s = s + s * (float)WM1[base + j]; s += sa * (float)BB[base + j]; s += vv * (float)KP[base + j]; S[j] = s; y += s * (float)R[base + j]; }
        YSC[base + lane] = f2bf(y);
    }
}

typedef unsigned u32x16 __attribute__((ext_vector_type(16)));
__device__ __forceinline__ void sload32(const void* p0, u32x16& a0, u32x16& a1) {
    asm volatile("s_load_dwordx16 %0, %2, 0x0 glc\n\ts_load_dwordx16 %1, %2, 0x40 glc\n\ts_waitcnt lgkmcnt(0)" : "=&s"(a0), "=&s"(a1) : "s"(p0) : "memory");
}
__device__ __forceinline__ void sload64(const void* p0, const void* p1, u32x16& a0, u32x16& a1, u32x16& b0, u32x16& b1) {
    asm volatile("s_load_dwordx16 %0, %4, 0x0 glc\n\ts_load_dwordx16 %1, %4, 0x40 glc\n\ts_load_dwordx16 %2, %5, 0x0 glc\n\ts_load_dwordx16 %3, %5, 0x40 glc\n\ts_waitcnt lgkmcnt(0)"
                 : "=&s"(a0), "=&s"(a1), "=&s"(b0), "=&s"(b1) : "s"(p0), "s"(p1) : "memory");
}
__device__ __forceinline__ float fmix_lo(unsigned sd, float x, float y) { float d; asm("v_fma_mix_f32 %0, %1, %2, %3 op_sel_hi:[1,0,0]" : "=v"(d) : "s"(sd), "v"(x), "v"(y)); return d; }
__device__ __forceinline__ float fmix_hi(unsigned sd, float x, float y) { float d; asm("v_fma_mix_f32 %0, %1, %2, %3 op_sel:[1,0,0] op_sel_hi:[1,0,0]" : "=v"(d) : "s"(sd), "v"(x), "v"(y)); return d; }
constexpr int CL = 64, NCH = T / CL;
constexpr size_t ST_Q_OFF = (size_t)NH * NCH * 64 * 64;
constexpr size_t ST_S_OFF = (size_t)NH * NCH * 64 * 64;

__device__ __forceinline__ float vmix_lo(unsigned vd, float x, float y) { float d; asm("v_fma_mix_f32 %0, %1, %2, %3 op_sel_hi:[1,0,0]" : "=v"(d) : "v"(vd), "v"(x), "v"(y)); return d; }
__device__ __forceinline__ float vmix_hi(unsigned vd, float x, float y) { float d; asm("v_fma_mix_f32 %0, %1, %2, %3 op_sel:[1,0,0] op_sel_hi:[1,0,0]" : "=v"(d) : "v"(vd), "v"(x), "v"(y)); return d; }
template <int N> __device__ __forceinline__ void fmac_bc(float& acc, float vec, float x) { asm("v_fmac_f32_dpp %0, %1, %2 row_newbcast:%3 row_mask:0xf bank_mask:0xf" : "+v"(acc) : "v"(vec), "v"(x), "n"(N)); }
template <int N> __device__ __forceinline__ float mul_bc(float vec, float x) { float d; asm("v_mul_f32_dpp %0, %1, %2 row_newbcast:%3 row_mask:0xf bank_mask:0xf" : "=v"(d) : "v"(vec), "v"(x), "n"(N)); return d; }
struct SVec { float v[4]; };
__device__ __forceinline__ f16x4 sv_read(const LAS3 unsigned char* p, int lane) { return *(const LAS3 f16x4*)(p + (lane & 15) * 8); }
__device__ __forceinline__ void sv_cvt(SVec& o, f16x4 h) { o.v[0] = (float)h[0]; o.v[1] = (float)h[1]; o.v[2] = (float)h[2]; o.v[3] = (float)h[3]; }
__device__ __forceinline__ void sv_cvt1p(SVec& o, f16x4 h) { o.v[0] = 1.0f + (float)h[0]; o.v[1] = 1.0f + (float)h[1]; o.v[2] = 1.0f + (float)h[2]; o.v[3] = 1.0f + (float)h[3]; }
template <int J> __device__ __forceinline__ void sc_dot(float (&d)[4], const SVec& A, const float (&X)[64]) { fmac_bc<(J >> 2)>(d[J & 3], A.v[J & 3], X[J]); if constexpr (J + 1 < 64) sc_dot<J + 1>(d, A, X); }
template <int J> __device__ __forceinline__ void sc_upd3(float (&S)[64], float (&y)[4], const SVec& Wv, const SVec& Bv, const SVec& Kv, const SVec& Rv, float sa, float vv) {
    float sj = mul_bc<(J >> 2)>(Wv.v[J & 3], S[J]); fmac_bc<(J >> 2)>(sj, Bv.v[J & 3], sa); fmac_bc<(J >> 2)>(sj, Kv.v[J & 3], vv); S[J] = sj; fmac_bc<(J >> 2)>(y[J & 3], Rv.v[J & 3], sj);
    if constexpr (J + 1 < 64) sc_upd3<J + 1>(S, y, Wv, Bv, Kv, Rv, sa, vv); }
template <int J> __device__ __forceinline__ void sc_upd1(float (&Q)[64], float (&P)[64], const SVec& Wv, const SVec& Bv, const SVec& Kv, float saq, float sap, float vv) {
    float qj = mul_bc<(J >> 2)>(Wv.v[J & 3], Q[J]); fmac_bc<(J >> 2)>(qj, Bv.v[J & 3], saq); fmac_bc<(J >> 2)>(qj, Kv.v[J & 3], vv); Q[J] = qj;
    float pj = mul_bc<(J >> 2)>(Wv.v[J & 3], P[J]); fmac_bc<(J >> 2)>(pj, Bv.v[J & 3], sap); P[J] = pj;
    if constexpr (J + 1 < 64) sc_upd1<J + 1>(Q, P, Wv, Bv, Kv, saq, sap, vv); }
constexpr int SCB = 8;
constexpr int SC_NS = 7, SC_BUF = SC_NS * 1024, SC_WAVE = 2 * SC_BUF;
__device__ __forceinline__ void sc_dma(const f16* X, size_t eoff, LAS3 unsigned char* dst) {
    __builtin_amdgcn_global_load_lds((const unsigned*)(X + eoff), (LAS3 unsigned*)dst, 16, 0, 0);
}

__device__ __forceinline__ void phase_scan1(ArgsR a, const Ctx& c) {
    const f16* WM1 = (const f16*)(a.ws + WS_WM1); const f16* KP = (const f16*)(a.ws + WS_KP);
    const f16* AA = (const f16*)(a.ws + WS_AA); const f16* BB = (const f16*)(a.ws + WS_BB); const f16* V = (const f16*)(a.ws + WS_V);
    float* ST = (float*)(a.ws + WS_ST);
    const int lane = c.lane;
    LAS3 unsigned char* ring = (LAS3 unsigned char*)c.lds + c.wave * SC_WAVE;
    for (int item = c.gw; item < NH * NCH; item += c.ngw) {
        const int h = __builtin_amdgcn_readfirstlane(item / NCH), ch = __builtin_amdgcn_readfirstlane(item % NCH);
        float Q[64], P[64];
        int ln_ = lane; asm volatile("" : "+v"(ln_));
#pragma unroll
        for (int j = 0; j < 64; ++j) { Q[j] = 0.f; P[j] = (j == ln_) ? 1.f : 0.f; }
        const size_t lane_off = (size_t)(lane >> 3) * W + h * 64 + (lane & 7) * 8;
        { const size_t e0 = (size_t)(ch * CL) * W + lane_off;
          sc_dma(AA, e0, ring); sc_dma(WM1, e0, ring + 1024); sc_dma(BB, e0, ring + 2048); sc_dma(KP, e0, ring + 3072); sc_dma(V, e0, ring + 4096); }
#pragma unroll 1
        for (int blk = 0; blk < CL / SCB; ++blk) {
            LAS3 unsigned char* buf = ring + (blk & 1) * SC_BUF;
            if (blk + 1 < CL / SCB) { LAS3 unsigned char* nb = ring + ((blk + 1) & 1) * SC_BUF; const size_t e0 = (size_t)(ch * CL + (blk + 1) * SCB) * W + lane_off;
                sc_dma(AA, e0, nb); sc_dma(WM1, e0, nb + 1024); sc_dma(BB, e0, nb + 2048); sc_dma(KP, e0, nb + 3072); sc_dma(V, e0, nb + 4096);
                asm volatile("s_waitcnt vmcnt(5)" ::: "memory"); }
            else asm volatile("s_waitcnt vmcnt(0)" ::: "memory");
            SVec A, Wv, Bv, Kv;
            sv_cvt(A, sv_read(buf, lane)); sv_cvt1p(Wv, sv_read(buf + 1024, lane)); sv_cvt(Bv, sv_read(buf + 2048, lane)); sv_cvt(Kv, sv_read(buf + 3072, lane));
            float vv = (float)*(const LAS3 f16*)(buf + 4096 + lane * 2);
#pragma unroll 1
            for (int st = 0; st < SCB; ++st) {
                const LAS3 unsigned char* sn = buf + ((st + 1 < SCB) ? st + 1 : st) * 128;
                const f16x4 ha = sv_read(sn, lane), hw = sv_read(sn + 1024, lane), hb = sv_read(sn + 2048, lane), hk = sv_read(sn + 3072, lane);
                const f16 hv = *(const LAS3 f16*)(sn + 4096 + lane * 2);
                float dq[4] = {0.f, 0.f, 0.f, 0.f}, dp[4] = {0.f, 0.f, 0.f, 0.f};
                sc_dot<0>(dq, A, Q); sc_dot<0>(dp, A, P);
                const float saq = (dq[0] + dq[1]) + (dq[2] + dq[3]), sap = (dp[0] + dp[1]) + (dp[2] + dp[3]);
                sc_upd1<0>(Q, P, Wv, Bv, Kv, saq, sap, vv);
                sv_cvt(A, ha); sv_cvt1p(Wv, hw); sv_cvt(Bv, hb); sv_cvt(Kv, hk); vv = (float)hv;
            }
        }
        float* Qp = ST + ST_Q_OFF + (size_t)(h * NCH + ch) * 4096 + lane;
        bf16* PTp = (bf16*)ST + (size_t)(h * NCH + ch) * 4096 + lane;
#pragma unroll
        for (int j = 0; j < 64; ++j) { PTp[j * 64] = f2bf(P[j]); Qp[j * 64] = Q[j]; }
    }
}
constexpr int GS = 16, NG = NCH / GS;
constexpr size_t ST_LP_OFF = (size_t)NH * NCH * 4096;
constexpr size_t WS_SG = WS_LORA + 2 * MiB;
constexpr int HI_LD = 72, HI_BYTES = 64 * HI_LD * 2;
struct HFrag { bf16x8 b[2][2]; f32x4 q[2]; };
__device__ __forceinline__ void hload(HFrag& f, const bf16* Bt, const float* QTc, int boff, int qtoff) {
#pragma unroll
    for (int ks = 0; ks < 2; ++ks)
#pragma unroll
        for (int n = 0; n < 2; ++n) f.b[ks][n] = *(const bf16x8*)(Bt + boff + 16 * n * 64 + 32 * ks);
#pragma unroll
    for (int n = 0; n < 2; ++n) f.q[n] = *(const f32x4*)(QTc + qtoff + 16 * n * 64);
}
__device__ __forceinline__ void hmma(const LAS3 unsigned char* img, const bf16x8 (&b)[2][2], f32x4 (&acc)[2], int m, int fr, int fq) {
#pragma unroll
    for (int ks = 0; ks < 2; ++ks) { const bf16x8 av = *(const LAS3 bf16x8*)(img + ((16 * m + fr) * HI_LD + 32 * ks + 8 * fq) * 2);
#pragma unroll
        for (int n = 0; n < 2; ++n) acc[n] = __builtin_amdgcn_mfma_f32_16x16x32_bf16(av, b[ks][n], acc[n], 0, 0, 0); }
}
__device__ __forceinline__ void himg_store(LAS3 unsigned char* img, const f32x4 (&acc)[2], int m, int n0, int fr, int fq) {
#pragma unroll
    for (int n = 0; n < 2; ++n)
#pragma unroll
        for (int i = 0; i < 4; ++i) *(LAS3 bf16*)(img + ((16 * m + 4 * fq + i) * HI_LD + n0 + 16 * n + fr) * 2) = f2bf(acc[n][i]);
}
#define HBAR() do { asm volatile("s_waitcnt lgkmcnt(0)" ::: "memory"); __builtin_amdgcn_s_barrier(); asm volatile("" ::: "memory"); } while (0)

__device__ __forceinline__ void sc2a_step(const HFrag& f, bf16* LpTc, float* QTc, const LAS3 unsigned char* ip, LAS3 unsigned char* ipn, const LAS3 unsigned char* iq, LAS3 unsigned char* iqn, int m, int n0, int fr, int fq, int qtoff) {
    f32x4 ap[2], aq[2];
#pragma unroll
    for (int n = 0; n < 2; ++n) { ap[n] = (f32x4){0.f, 0.f, 0.f, 0.f}; aq[n] = f.q[n]; }
    hmma(ip, f.b, ap, m, fr, fq); hmma(iq, f.b, aq, m, fr, fq);
#pragma unroll
    for (int n = 0; n < 2; ++n) { u32x2 w; w.x = pk2(ap[n][0], ap[n][1]); w.y = pk2(ap[n][2], ap[n][3]);
        *(u32x2*)(LpTc + (n0 + 16 * n + fr) * 64 + 16 * m + 4 * fq) = w;
        *(f32x4*)(QTc + qtoff + 16 * n * 64) = aq[n]; }
    himg_store(ipn, ap, m, n0, fr, fq); himg_store(iqn, aq, m, n0, fr, fq);
    HBAR();
}
__device__ __forceinline__ void phase_scan2a(ArgsR a, const Ctx& c) {
    const int lane = c.lane, wv = c.wave, fr = lane & 15, fq = lane >> 4, m = wv >> 1, n0 = 32 * (wv & 1);
    const int boff = (n0 + fr) * 64 + 8 * fq, qtoff = (n0 + fr) * 64 + 16 * m + 4 * fq;
    LAS3 unsigned char* L = (LAS3 unsigned char*)c.lds;
    for (int item = blockIdx.x; item < NH * NG; item += gridDim.x) {
        const size_t cb = (size_t)(item / NG) * NCH + (size_t)(item % NG) * GS;
        const bf16* PT = (const bf16*)(a.ws + WS_ST) + cb * 4096; bf16* LP = (bf16*)(a.ws + WS_ST) + ST_LP_OFF + cb * 4096; float* QT = (float*)(a.ws + WS_ST) + ST_Q_OFF + cb * 4096;
        for (int i = c.tid; i < 4 * HI_BYTES / 4; i += NTHREADS) ((LAS3 unsigned*)L)[i] = 0u;
        __syncthreads();
        if (c.tid < 64) *(LAS3 bf16*)(L + (c.tid * HI_LD + c.tid) * 2) = (bf16)0x3F80;
        __syncthreads();
        HFrag f0, f1, f2, f3;
        hload(f0, PT, QT, boff, qtoff); hload(f1, PT + 4096, QT + 4096, boff, qtoff); hload(f2, PT + 2 * 4096, QT + 2 * 4096, boff, qtoff); hload(f3, PT + 3 * 4096, QT + 3 * 4096, boff, qtoff);
        LAS3 unsigned char* p0 = L; LAS3 unsigned char* p1 = L + HI_BYTES; LAS3 unsigned char* q0 = L + 2 * HI_BYTES; LAS3 unsigned char* q1 = L + 3 * HI_BYTES;
#pragma unroll 1
        for (int i = 0; i < GS; i += 4) {
            const int nx = (i + 4 < GS) ? i + 4 : i;
            sc2a_step(f0, LP + (size_t)(i + 0) * 4096, QT + (size_t)(i + 0) * 4096, p0, p1, q0, q1, m, n0, fr, fq, qtoff); hload(f0, PT + (size_t)(nx + 0) * 4096, QT + (size_t)(nx + 0) * 4096, boff, qtoff);
            sc2a_step(f1, LP + (size_t)(i + 1) * 4096, QT + (size_t)(i + 1) * 4096, p1, p0, q1, q0, m, n0, fr, fq, qtoff); hload(f1, PT + (size_t)(nx + 1) * 4096, QT + (size_t)(nx + 1) * 4096, boff, qtoff);
            sc2a_step(f2, LP + (size_t)(i + 2) * 4096, QT + (size_t)(i + 2) * 4096, p0, p1, q0, q1, m, n0, fr, fq, qtoff); hload(f2, PT + (size_t)(nx + 2) * 4096, QT + (size_t)(nx + 2) * 4096, boff, qtoff);
            sc2a_step(f3, LP + (size_t)(i + 3) * 4096, QT + (size_t)(i + 3) * 4096, p1, p0, q1, q0, m, n0, fr, fq, qtoff); hload(f3, PT + (size_t)(nx + 3) * 4096, QT + (size_t)(nx + 3) * 4096, boff, qtoff);
        }
        __syncthreads();
    }
}
__device__ __forceinline__ void phase_scan2b(ArgsR a, const Ctx& c) {
    if (blockIdx.x >= NH) return;
    const int h = blockIdx.x, lane = c.lane, wv = c.wave, fr = lane & 15, fq = lane >> 4, m = wv >> 1, n0 = 32 * (wv & 1);
    const int boff = (n0 + fr) * 64 + 8 * fq, qtoff = (n0 + fr) * 64 + 16 * m + 4 * fq;
    LAS3 unsigned char* L = (LAS3 unsigned char*)c.lds;
    const bf16* LP = (const bf16*)(a.ws + WS_ST) + ST_LP_OFF + (size_t)h * NCH * 4096; const float* QT = (const float*)(a.ws + WS_ST) + ST_Q_OFF + (size_t)h * NCH * 4096;
    bf16* SG = (bf16*)(a.ws + WS_SG) + (size_t)h * NG * 4096;
    for (int i = c.tid; i < 2 * HI_BYTES / 4; i += NTHREADS) ((LAS3 unsigned*)L)[i] = 0u;
    for (int i = c.tid; i < 4096 / 2; i += NTHREADS) ((LAS3 unsigned*)(L + 2 * HI_BYTES))[i] = 0u;
    __syncthreads();
    HFrag f0, f1, f2, f3;
#define SC2B_CH(g) ((size_t)((g) * GS + GS - 1) * 4096)
    hload(f0, LP + SC2B_CH(0), QT + SC2B_CH(0), boff, qtoff); hload(f1, LP + SC2B_CH(1), QT + SC2B_CH(1), boff, qtoff); hload(f2, LP + SC2B_CH(2), QT + SC2B_CH(2), boff, qtoff); hload(f3, LP + SC2B_CH(3), QT + SC2B_CH(3), boff, qtoff);
    LAS3 unsigned char* i0 = L; LAS3 unsigned char* i1 = L + HI_BYTES;
#define SC2B_STEP(f, g, ic, in) do { f32x4 acc[2] = {f.q[0], f.q[1]}; hmma(ic, f.b, acc, m, fr, fq); LAS3 bf16* So = (LAS3 bf16*)(L + 2 * HI_BYTES) + (((g) + 1) & 7) * 4096; \
        _Pragma("unroll") for (int n = 0; n < 2; ++n) _Pragma("unroll") for (int i = 0; i < 4; ++i) So[(16 * m + 4 * fq + i) * 64 + n0 + 16 * n + fr] = f2bf(acc[n][i]); \
        himg_store(in, acc, m, n0, fr, fq); HBAR(); } while (0)
#pragma unroll 1
    for (int g = 0; g < NG; g += 4) {
        const int nx = (g + 4 < NG) ? g + 4 : g;
        SC2B_STEP(f0, g + 0, i0, i1); hload(f0, LP + SC2B_CH(nx + 0), QT + SC2B_CH(nx + 0), boff, qtoff);
        SC2B_STEP(f1, g + 1, i1, i0); hload(f1, LP + SC2B_CH(nx + 1), QT + SC2B_CH(nx + 1), boff, qtoff);
        SC2B_STEP(f2, g + 2, i0, i1); hload(f2, LP + SC2B_CH(nx + 2), QT + SC2B_CH(nx + 2), boff, qtoff);
        if ((g & 7) == 4) {
            for (int i = c.tid; i < 8 * 4096 / 8; i += NTHREADS) ((u32x4*)(SG + (size_t)(g >> 3) * 8 * 4096))[i] = ((const LAS3 u32x4*)(L + 2 * HI_BYTES))[i];
            HBAR(); }
        if (g + 3 < NG - 1) SC2B_STEP(f3, g + 3, i1, i0);
        hload(f3, LP + SC2B_CH(nx + 3), QT + SC2B_CH(nx + 3), boff, qtoff);
    }
#undef SC2B_STEP
#undef SC2B_CH
}
__device__ __forceinline__ void phase_scan2c(ArgsR a, const Ctx& c) {
    const int lane = c.lane, wv = c.wave, fr = lane & 15, fq = lane >> 4, m = wv >> 1, n0 = 32 * (wv & 1);
    const int boff = (n0 + fr) * 64 + 8 * fq, qtoff = (n0 + fr) * 64 + 16 * m + 4 * fq;
    LAS3 unsigned char* L = (LAS3 unsigned char*)c.lds;
    for (int item = blockIdx.x; item < NH * NG * 2; item += gridDim.x) {
        const int hg = item >> 1, hf = item & 1;
        const size_t cb = (size_t)(hg / NG) * NCH + (size_t)(hg % NG) * GS + hf * 8;
        const bf16* LP = (const bf16*)(a.ws + WS_ST) + ST_LP_OFF + cb * 4096; const float* QT = (const float*)(a.ws + WS_ST) + ST_Q_OFF + cb * 4096; bf16* SS = (bf16*)(a.ws + WS_ST) + cb * 4096;
        { const u32x4 v = *(const u32x4*)((const bf16*)(a.ws + WS_SG) + (size_t)hg * 4096 + c.tid * 8); *(LAS3 u32x4*)(L + ((c.tid >> 3) * HI_LD + (c.tid & 7) * 8) * 2) = v; }
        __syncthreads();
#pragma unroll 2
        for (int i = 0; i < 8; ++i) { HFrag f; hload(f, LP + (size_t)i * 4096, QT + (size_t)i * 4096, boff, qtoff);
            f32x4 acc[2] = {f.q[0], f.q[1]}; hmma(L, f.b, acc, m, fr, fq); bf16* So = SS + (size_t)i * 4096;
#pragma unroll
            for (int n = 0; n < 2; ++n)
#pragma unroll
                for (int k = 0; k < 4; ++k) So[(16 * m + 4 * fq + k) * 64 + n0 + 16 * n + fr] = f2bf(acc[n][k]); }
        __syncthreads();
    }
}
constexpr int WI_LD = 72, WI_B = 64 * WI_LD * 2, WI_GAM = 9 * WI_B, WI_GL = 15 * WI_B;
constexpr size_t WS_GM0 = 352 * MiB, WS_GM1 = 212 * MiB, WS_Y0 = 336 * MiB, WS_END2 = 360 * MiB;
__device__ __forceinline__ bf16* gm_ptr(unsigned char* ws, int h, int ch) { return (bf16*)(ws + (h < 4 ? WS_GM0 : WS_GM1)) + (size_t)((h & 3) * NCH + ch) * 4096; }
__device__ __forceinline__ void wi_mma(f32x4 (&acc)[2], const LAS3 unsigned char* A, const LAS3 unsigned char* Bt, int m, int n0, int fr, int fq) {
#pragma unroll
    for (int ks = 0; ks < 2; ++ks) { const bf16x8 av = *(const LAS3 bf16x8*)(A + ((16 * m + fr) * WI_LD + 32 * ks + 8 * fq) * 2);
#pragma unroll
        for (int n = 0; n < 2; ++n) { const bf16x8 bv = *(const LAS3 bf16x8*)(Bt + ((n0 + 16 * n + fr) * WI_LD + 32 * ks + 8 * fq) * 2); acc[n] = __builtin_amdgcn_mfma_f32_16x16x32_bf16(av, bv, acc[n], 0, 0, 0); } }
}
struct WiA { bf16x8 a[2]; }; struct WiB { bf16x8 b[2][2]; };
__device__ __forceinline__ void wi_lda(WiA& f, const LAS3 unsigned char* A, int m, int fr, int fq) {
#pragma unroll
    for (int ks = 0; ks < 2; ++ks) f.a[ks] = *(const LAS3 bf16x8*)(A + ((16 * m + fr) * WI_LD + 32 * ks + 8 * fq) * 2);
}
__device__ __forceinline__ void wi_ldb(WiB& f, const LAS3 unsigned char* Bt, int n0, int fr, int fq) {
#pragma unroll
    for (int ks = 0; ks < 2; ++ks)
#pragma unroll
        for (int n = 0; n < 2; ++n) f.b[ks][n] = *(const LAS3 bf16x8*)(Bt + ((n0 + 16 * n + fr) * WI_LD + 32 * ks + 8 * fq) * 2);
}
__device__ __forceinline__ void wi_fma(f32x4 (&acc)[2], const WiA& A, const WiB& B) {
#pragma unroll
    for (int ks = 0; ks < 2; ++ks)
#pragma unroll
        for (int n = 0; n < 2; ++n) acc[n] = __builtin_amdgcn_mfma_f32_16x16x32_bf16(A.a[ks], B.b[ks][n], acc[n], 0, 0, 0);
}
__device__ __forceinline__ void wi_fma_s(f32x4 (&acc)[2], const WiA& A, const WiB& B) {
#pragma unroll
    for (int ks = 0; ks < 2; ++ks)
#pragma unroll
        for (int n = 0; n < 2; ++n) acc[n] = __builtin_amdgcn_mfma_f32_16x16x32_bf16(B.b[ks][n], A.a[ks], acc[n], 0, 0, 0);
}
__device__ __forceinline__ void wi_st_nat_s(LAS3 unsigned char* X, const f32x4 (&acc)[2], int m, int n0, int fr, int fq) {
#pragma unroll
    for (int n = 0; n < 2; ++n) { u32x2 w; w.x = pk2(acc[n][0], acc[n][1]); w.y = pk2(acc[n][2], acc[n][3]); *(LAS3 u32x2*)(X + ((16 * m + fr) * WI_LD + n0 + 16 * n + 4 * fq) * 2) = w; }
}
__device__ __forceinline__ void wi_ld_nat_s(f32x4 (&acc)[2], const LAS3 unsigned char* X, int m, int n0, int fr, int fq) {
#pragma unroll
    for (int n = 0; n < 2; ++n) { const u32x2 w = *(const LAS3 u32x2*)(X + ((16 * m + fr) * WI_LD + n0 + 16 * n + 4 * fq) * 2);
        acc[n][0] = __uint_as_float(w.x << 16); acc[n][1] = __uint_as_float(w.x & 0xffff0000u); acc[n][2] = __uint_as_float(w.y << 16); acc[n][3] = __uint_as_float(w.y & 0xffff0000u); }
}
__device__ __forceinline__ void wi_ld_tr(f32x4 (&acc)[2], const LAS3 unsigned char* XT, int m, int n0, int fr, int fq) {
#pragma unroll
    for (int n = 0; n < 2; ++n) { const u32x2 w = *(const LAS3 u32x2*)(XT + ((n0 + 16 * n + fr) * WI_LD + 16 * m + 4 * fq) * 2);
        acc[n][0] = __uint_as_float(w.x << 16); acc[n][1] = __uint_as_float(w.x & 0xffff0000u); acc[n][2] = __uint_as_float(w.y << 16); acc[n][3] = __uint_as_float(w.y & 0xffff0000u); }
}
#define WI_PIN() __builtin_amdgcn_sched_barrier(0)
__device__ __forceinline__ void wi_st_nat(LAS3 unsigned char* X, const f32x4 (&acc)[2], int m, int n0, int fr, int fq) {
#pragma unroll
    for (int n = 0; n < 2; ++n)
#pragma unroll
        for (int i = 0; i < 4; ++i) *(LAS3 bf16*)(X + ((16 * m + 4 * fq + i) * WI_LD + n0 + 16 * n + fr) * 2) = f2bf(acc[n][i]);
}
__device__ __forceinline__ void wi_st_tr(LAS3 unsigned char* XT, const f32x4 (&acc)[2], int m, int n0, int fr, int fq) {
#pragma unroll
    for (int n = 0; n < 2; ++n) { u32x2 w; w.x = pk2(acc[n][0], acc[n][1]); w.y = pk2(acc[n][2], acc[n][3]); *(LAS3 u32x2*)(XT + ((n0 + 16 * n + fr) * WI_LD + 16 * m + 4 * fq) * 2) = w; }
}
__device__ __forceinline__ void wi_ld_nat(f32x4 (&acc)[2], const LAS3 unsigned char* X, int m, int n0, int fr, int fq) {
#pragma unroll
    for (int n = 0; n < 2; ++n)
#pragma unroll
        for (int i = 0; i < 4; ++i) acc[n][i] = bf2f(*(const LAS3 bf16*)(X + ((16 * m + 4 * fq + i) * WI_LD + n0 + 16 * n + fr) * 2));
}
__device__ __forceinline__ void phase_scan1m(ArgsR a, const Ctx& c, const int skip = 0) {
    const f16* WM1 = (const f16*)(a.ws + WS_WM1); const f16* KP = (const f16*)(a.ws + WS_KP);
    const f16* AA = (const f16*)(a.ws + WS_AA); const f16* BB = (const f16*)(a.ws + WS_BB); const f16* V = (const f16*)(a.ws + WS_V); const f16* R = (const f16*)(a.ws + WS_R);
    float* ST = (float*)(a.ws + WS_ST);
    LAS3 unsigned char* L = (LAS3 unsigned char*)c.lds;
    LAS3 float* GAM = (LAS3 float*)(L + WI_GAM); LAS3 float* GL = (LAS3 float*)(L + WI_GL);
    const int lane = c.lane, wv = c.wave, fr = lane & 15, fq = lane >> 4, m = wv >> 1, n0 = 32 * (wv & 1), tid = c.tid;
#define SLOT(i) (L + (i) * WI_B)
    const int t = tid >> 3, cc = (tid & 7) * 8;
    f16x8 pav, pbv, pkv, pvv, prv, pwv;
#define WI_FETCH(it) do { const int h_ = (it) / NCH, ch_ = (it) % NCH; const size_t eo_ = (size_t)(ch_ * CL + t) * W + h_ * 64 + cc; \
        pav = *(const f16x8*)(AA + eo_); pbv = *(const f16x8*)(BB + eo_); pkv = *(const f16x8*)(KP + eo_); pvv = *(const f16x8*)(V + eo_); prv = *(const f16x8*)(R + eo_); pwv = *(const f16x8*)(WM1 + eo_); } while (0)
    if (blockIdx.x < NH * NCH) WI_FETCH(blockIdx.x);
    for (int item = blockIdx.x; item < NH * NCH; item += gridDim.x) {
        const int h = item / NCH, ch = item % NCH;
        const f16x8 av = pav, bv = pbv, kv = pkv, vv = pvv, rv = prv, wv8 = pwv;
        if (item + (int)gridDim.x < NH * NCH) WI_FETCH(item + (int)gridDim.x);
        float g[8], gp[8];
        { float wloc[8];
#pragma unroll
          for (int e = 0; e < 8; ++e) wloc[e] = 1.0f + (float)wv8[e];
#pragma unroll
          for (int e = 0; e < 8; ++e) { float x = wloc[e];
              { const float y = __shfl_up(x, 8); if (lane >= 8) x *= y; } { const float y = __shfl_up(x, 16); if (lane >= 16) x *= y; } { const float y = __shfl_up(x, 32); if (lane >= 32) x *= y; }
              g[e] = x; }
          if (lane >= 56) {
#pragma unroll
              for (int e = 0; e < 8; ++e) GAM[wv * 64 + cc + e] = g[e]; }
          HBAR();
#pragma unroll
          for (int e = 0; e < 8; ++e) { float pre = 1.0f;
#pragma unroll
              for (int w = 0; w < 7; ++w) if (w < wv) pre *= GAM[w * 64 + cc + e];
              g[e] *= pre; gp[e] = g[e] * __builtin_amdgcn_rcpf(wloc[e]); } }
        { float fa[8], fb[8], fk[8], fv[8], frr[8];
#pragma unroll
          for (int e = 0; e < 8; ++e) { const float ig = __builtin_amdgcn_rcpf(g[e]);
              fa[e] = (float)av[e] * gp[e]; fb[e] = (float)bv[e] * ig; fk[e] = (float)kv[e] * ig; fv[e] = (float)vv[e]; frr[e] = (float)rv[e] * g[e]; if (t == 63) GL[cc + e] = g[e]; }
          *(LAS3 u32x4*)(SLOT(0) + (t * WI_LD + cc) * 2) = pack8bf(fa); *(LAS3 u32x4*)(SLOT(2) + (t * WI_LD + cc) * 2) = pack8bf(fb); *(LAS3 u32x4*)(SLOT(4) + (t * WI_LD + cc) * 2) = pack8bf(fk); *(LAS3 u32x4*)(SLOT(12) + (t * WI_LD + cc) * 2) = pack8bf(frr);
          *(LAS3 u32x4*)(SLOT(10) + (t * WI_LD + cc) * 2) = pack8bf(fv); }
        HBAR();
        { WiA aB, aK; WiB bA, bR; wi_lda(aB, SLOT(2), m, fr, fq); wi_lda(aK, SLOT(4), m, fr, fq); wi_ldb(bA, SLOT(0), n0, fr, fq); wi_ldb(bR, SLOT(12), n0, fr, fq);
          const int tch = tid & 63, tt0 = (tid >> 6) * 8; bf16 ta[8], tb[8], tv[8];
#pragma unroll
          for (int e = 0; e < 8; ++e) { ta[e] = *(const LAS3 bf16*)(SLOT(0) + ((tt0 + e) * WI_LD + tch) * 2); tb[e] = *(const LAS3 bf16*)(SLOT(2) + ((tt0 + e) * WI_LD + tch) * 2); tv[e] = *(const LAS3 bf16*)(SLOT(10) + ((tt0 + e) * WI_LD + tch) * 2); }
          WI_PIN();
          { u32x4 wa, wb, wv4;
#pragma unroll
            for (int e = 0; e < 4; ++e) { wa[e] = (unsigned)ta[2 * e] | ((unsigned)ta[2 * e + 1] << 16); wb[e] = (unsigned)tb[2 * e] | ((unsigned)tb[2 * e + 1] << 16); wv4[e] = (unsigned)tv[2 * e] | ((unsigned)tv[2 * e + 1] << 16); }
            *(LAS3 u32x4*)(SLOT(1) + (tch * WI_LD + tt0) * 2) = wa; *(LAS3 u32x4*)(SLOT(3) + (tch * WI_LD + tt0) * 2) = wb; *(LAS3 u32x4*)(SLOT(5) + (tch * WI_LD + tt0) * 2) = wv4; }
          f32x4 ans[2] = {{0.f, 0.f, 0.f, 0.f}, {0.f, 0.f, 0.f, 0.f}}, ant[2] = {{0.f, 0.f, 0.f, 0.f}, {0.f, 0.f, 0.f, 0.f}}, aks[2] = {{0.f, 0.f, 0.f, 0.f}, {0.f, 0.f, 0.f, 0.f}}, am[2] = {{0.f, 0.f, 0.f, 0.f}, {0.f, 0.f, 0.f, 0.f}}, amk[2] = {{0.f, 0.f, 0.f, 0.f}, {0.f, 0.f, 0.f, 0.f}};
          wi_fma_s(ans, aB, bA); wi_fma(ant, aB, bA); wi_fma_s(aks, aK, bA); wi_fma(am, aB, bR); wi_fma(amk, aK, bR);
          WI_PIN();
          f32x4 axs[2];
#pragma unroll
          for (int n = 0; n < 2; ++n)
#pragma unroll
              for (int i = 0; i < 4; ++i) { const int rs = 16 * m + fr, cs = n0 + 16 * n + 4 * fq + i;
                  if (!(rs < cs)) { ans[n][i] = 0.f; aks[n][i] = 0.f; } axs[n][i] = ans[n][i] + (rs == cs ? 1.0f : 0.f);
                  const int rn = 16 * m + 4 * fq + i, cn = n0 + 16 * n + fr;
                  if (!(rn < cn)) ant[n][i] = 0.f; if (rn > cn) { am[n][i] = 0.f; amk[n][i] = 0.f; } }
          wi_st_nat_s(SLOT(7), ans, m, n0, fr, fq); wi_st_tr(SLOT(8), ant, m, n0, fr, fq); wi_st_nat_s(SLOT(6), aks, m, n0, fr, fq); wi_st_nat_s(SLOT(11), axs, m, n0, fr, fq);
          wi_st_tr(SLOT(13), am, m, n0, fr, fq); wi_st_tr(SLOT(14), amk, m, n0, fr, fq); }
        HBAR();
        { WiA aN; WiB bN; wi_lda(aN, SLOT(7), m, fr, fq); wi_ldb(bN, SLOT(8), n0, fr, fq); WI_PIN();
          f32x4 a2s[2] = {{0.f, 0.f, 0.f, 0.f}, {0.f, 0.f, 0.f, 0.f}}, a2t[2] = {{0.f, 0.f, 0.f, 0.f}, {0.f, 0.f, 0.f, 0.f}}; wi_fma_s(a2s, aN, bN); wi_fma(a2t, aN, bN); WI_PIN();
          wi_st_nat_s(SLOT(9), a2s, m, n0, fr, fq); wi_st_tr(SLOT(10), a2t, m, n0, fr, fq); }
        HBAR();
#define WI_LEVEL(XS, XD, NS, NST, ND, NDT) do { WiA aX, aN; WiB bN; f32x4 ax[2]; wi_lda(aX, SLOT(XS), m, fr, fq); wi_ldb(bN, SLOT(NST), n0, fr, fq); wi_lda(aN, SLOT(NS), m, fr, fq); wi_ld_nat_s(ax, SLOT(XS), m, n0, fr, fq); \
            WI_PIN(); f32x4 aqs[2] = {{0.f, 0.f, 0.f, 0.f}, {0.f, 0.f, 0.f, 0.f}}, aqt[2] = {{0.f, 0.f, 0.f, 0.f}, {0.f, 0.f, 0.f, 0.f}}; wi_fma_s(ax, aX, bN); wi_fma_s(aqs, aN, bN); wi_fma(aqt, aN, bN); WI_PIN(); \
            wi_st_nat_s(SLOT(XD), ax, m, n0, fr, fq); wi_st_nat_s(SLOT(ND), aqs, m, n0, fr, fq); wi_st_tr(SLOT(NDT), aqt, m, n0, fr, fq); \
            HBAR(); } while (0)
        WI_LEVEL(11, 0, 9, 10, 7, 8);
        WI_LEVEL(0, 11, 7, 8, 9, 10);
        WI_LEVEL(11, 0, 9, 10, 7, 8);
        WI_LEVEL(0, 11, 7, 8, 9, 10);
#undef WI_LEVEL
        { WiA aX; WiB bN; f32x4 ax[2]; wi_lda(aX, SLOT(11), m, fr, fq); wi_ldb(bN, SLOT(10), n0, fr, fq); wi_ld_nat(ax, SLOT(11), m, n0, fr, fq); WI_PIN();
          wi_fma(ax, aX, bN); WI_PIN(); wi_st_tr(SLOT(0), ax, m, n0, fr, fq); }
        HBAR();
        { WiA aNk, aAt; WiB bT; wi_lda(aNk, SLOT(6), m, fr, fq); wi_lda(aAt, SLOT(1), m, fr, fq); wi_ldb(bT, SLOT(0), n0, fr, fq); WI_PIN();
          f32x4 aw[2] = {{0.f, 0.f, 0.f, 0.f}, {0.f, 0.f, 0.f, 0.f}}, aa[2] = {{0.f, 0.f, 0.f, 0.f}, {0.f, 0.f, 0.f, 0.f}}; wi_fma_s(aw, aNk, bT); wi_fma_s(aa, aAt, bT); WI_PIN();
          wi_st_nat_s(SLOT(2), aw, m, n0, fr, fq); wi_st_nat_s(SLOT(7), aa, m, n0, fr, fq); }
        HBAR();
        { WiA aAT, aW1; WiB bB, bM; f32x4 ap[2] = {{0.f, 0.f, 0.f, 0.f}, {0.f, 0.f, 0.f, 0.f}}, az[2], ag[2], az2[2]; float gl[2];
          wi_lda(aAT, SLOT(7), m, fr, fq); wi_lda(aW1, SLOT(2), m, fr, fq); wi_ldb(bB, SLOT(3), n0, fr, fq); wi_ldb(bM, SLOT(13), n0, fr, fq);
          wi_ld_nat(az, SLOT(4), m, n0, fr, fq); wi_ld_tr(az2, SLOT(14), m, n0, fr, fq); wi_ld_tr(ag, SLOT(12), m, n0, fr, fq);
#pragma unroll
          for (int n = 0; n < 2; ++n) gl[n] = GL[n0 + 16 * n + fr];
          WI_PIN();
          wi_fma(ap, aAT, bB); wi_fma(az, aW1, bB); wi_fma(ag, aAT, bM); wi_fma(az2, aW1, bM);
          WI_PIN();
          wi_st_tr(SLOT(8), az, m, n0, fr, fq); wi_st_tr(SLOT(9), az2, m, n0, fr, fq);
          bf16* PTp = (bf16*)ST + (size_t)(h * NCH + ch) * 4096; bf16* GMp = gm_ptr(a.ws, h, ch);
#pragma unroll
          for (int n = 0; n < 2; ++n) { const int col = n0 + 16 * n + fr; f32x4 pv = ap[n];
#pragma unroll
              for (int i = 0; i < 4; ++i) { if (16 * m + 4 * fq + i == col) pv[i] += 1.0f; pv[i] *= gl[n]; }
              u32x2 w; w.x = pk2(pv[0], pv[1]); w.y = pk2(pv[2], pv[3]); *(u32x2*)(PTp + col * 64 + 16 * m + 4 * fq) = w;
              u32x2 w2; w2.x = pk2(ag[n][0], ag[n][1]); w2.y = pk2(ag[n][2], ag[n][3]); *(u32x2*)(GMp + col * 64 + 16 * m + 4 * fq) = w2; } }
        HBAR();
        { WiA aV; WiB bZ1, bZ2; float gl[2]; wi_lda(aV, SLOT(5), m, fr, fq); wi_ldb(bZ1, SLOT(8), n0, fr, fq); wi_ldb(bZ2, SLOT(9), n0, fr, fq); gl[0] = GL[n0 + fr]; gl[1] = GL[n0 + 16 + fr]; WI_PIN();
          f32x4 aq[2] = {{0.f, 0.f, 0.f, 0.f}, {0.f, 0.f, 0.f, 0.f}}, ay[2] = {{0.f, 0.f, 0.f, 0.f}, {0.f, 0.f, 0.f, 0.f}}; wi_fma(aq, aV, bZ1); wi_fma(ay, aV, bZ2); WI_PIN();
          float* QTp = ST + ST_Q_OFF + (size_t)(h * NCH + ch) * 4096; bf16* Y0p = (bf16*)(a.ws + WS_Y0) + (size_t)(h * NCH + ch) * 4096;
#pragma unroll
          for (int n = 0; n < 2; ++n) { const int col = n0 + 16 * n + fr; *(f32x4*)(QTp + col * 64 + 16 * m + 4 * fq) = aq[n] * gl[n];
              u32x2 w; w.x = pk2(ay[n][0], ay[n][1]); w.y = pk2(ay[n][2], ay[n][3]); *(u32x2*)(Y0p + col * 64 + 16 * m + 4 * fq) = w; } }
        HBAR();
    }
#undef SLOT
#undef WI_FETCH
}

__device__ __forceinline__ void phase_scan3m(ArgsR a, const Ctx& c, int l) {
    const f16* R = (const f16*)(a.ws + WS_R); const f16* KP = (const f16*)(a.ws + WS_KP); const f16* V = (const f16*)(a.ws + WS_V); const bf16* G = (const bf16*)(a.ws + WS_G);
    bf16* YA = (bf16*)(a.ws + WS_YA);
    LAS3 unsigned char* L = (LAS3 unsigned char*)c.lds;
    LAS3 float* YL = (LAS3 float*)(L + WI_B);
    LAS3 unsigned char* S0I = L + 3 * WI_B;
    const int lane = c.lane, wv = c.wave, fr = lane & 15, fq = lane >> 4, m = wv >> 1, n0 = 32 * (wv & 1), tid = c.tid;
    const int boff = (n0 + fr) * 64 + 8 * fq, qtoff = (n0 + fr) * 64 + 16 * m + 4 * fq;
    u32x4 pS; bf16x8 pL[2][2]; f32x4 pQ[2]; bf16x8 pB[2][2]; u32x2 pY[2];
#define S3_FETCH(it) do { const int h_ = (it) / NCH, ch_ = (it) % NCH; pS = (u32x4){0u, 0u, 0u, 0u}; \
        _Pragma("unroll") for (int ks = 0; ks < 2; ++ks) _Pragma("unroll") for (int n = 0; n < 2; ++n) pL[ks][n] = (bf16x8){0, 0, 0, 0, 0, 0, 0, 0}; \
        pQ[0] = (f32x4){0.f, 0.f, 0.f, 0.f}; pQ[1] = (f32x4){0.f, 0.f, 0.f, 0.f}; \
        if (ch_ > 0) { const int c1_ = ch_ - 1; pS = *(const u32x4*)((const bf16*)(a.ws + WS_SG) + (size_t)(h_ * NG + c1_ / GS) * 4096 + tid * 8); \
            const bf16* LP_ = (const bf16*)(a.ws + WS_ST) + ST_LP_OFF + (size_t)(h_ * NCH + c1_) * 4096; const float* QT_ = (const float*)(a.ws + WS_ST) + ST_Q_OFF + (size_t)(h_ * NCH + c1_) * 4096; \
            _Pragma("unroll") for (int ks = 0; ks < 2; ++ks) _Pragma("unroll") for (int n = 0; n < 2; ++n) pL[ks][n] = *(const bf16x8*)(LP_ + boff + 16 * n * 64 + 32 * ks); \
            _Pragma("unroll") for (int n = 0; n < 2; ++n) pQ[n] = *(const f32x4*)(QT_ + qtoff + 16 * n * 64); } \
        const bf16* G_ = gm_ptr(a.ws, h_, ch_); const bf16* Y_ = (const bf16*)(a.ws + WS_Y0) + (size_t)(h_ * NCH + ch_) * 4096; \
        _Pragma("unroll") for (int ks = 0; ks < 2; ++ks) _Pragma("unroll") for (int n = 0; n < 2; ++n) pB[ks][n] = *(const bf16x8*)(G_ + (n0 + 16 * n + fr) * 64 + 32 * ks + 8 * fq); \
        _Pragma("unroll") for (int n = 0; n < 2; ++n) pY[n] = *(const u32x2*)(Y_ + (n0 + 16 * n + fr) * 64 + 16 * m + 4 * fq); } while (0)
    if (blockIdx.x < NH * NCH) S3_FETCH(blockIdx.x);
    for (int item = blockIdx.x; item < NH * NCH; item += gridDim.x) {
        const int h = item / NCH, ch = item % NCH;
        *(LAS3 u32x4*)(L + ((tid >> 3) * WI_LD + (tid & 7) * 8) * 2) = pS;
        bf16x8 lfr[2][2], bfr[2][2]; f32x4 as0[2], acc[2];
#pragma unroll
        for (int ks = 0; ks < 2; ++ks)
#pragma unroll
            for (int n = 0; n < 2; ++n) { lfr[ks][n] = pL[ks][n]; bfr[ks][n] = pB[ks][n]; }
#pragma unroll
        for (int n = 0; n < 2; ++n) { as0[n] = pQ[n]; acc[n][0] = __uint_as_float(pY[n].x << 16); acc[n][1] = __uint_as_float(pY[n].x & 0xffff0000u); acc[n][2] = __uint_as_float(pY[n].y << 16); acc[n][3] = __uint_as_float(pY[n].y & 0xffff0000u); }
        if (item + (int)gridDim.x < NH * NCH) S3_FETCH(item + (int)gridDim.x);
        HBAR();
        hmma(L, lfr, as0, m, fr, fq);
        himg_store(S0I, as0, m, n0, fr, fq);
        HBAR();
#pragma unroll
        for (int ks = 0; ks < 2; ++ks) { const bf16x8 av = *(const LAS3 bf16x8*)(S0I + ((16 * m + fr) * WI_LD + 32 * ks + 8 * fq) * 2);
#pragma unroll
            for (int n = 0; n < 2; ++n) acc[n] = __builtin_amdgcn_mfma_f32_16x16x32_bf16(av, bfr[ks][n], acc[n], 0, 0, 0); }
#pragma unroll
        for (int n = 0; n < 2; ++n)
#pragma unroll
            for (int i = 0; i < 4; ++i) YL[(n0 + 16 * n + fr) * 65 + 16 * m + 4 * fq + i] = acc[n][i];
        HBAR();
        { const float gn_g = a.in[I_GNG][l * W + h * 64 + lane], gn_b = a.in[I_GNB][l * W + h * 64 + lane], r_k = a.in[I_RK][l * W + h * 64 + lane];
          f16 rl8[8], kl8[8], vl8[8]; bf16 gl8[8];
#pragma unroll
          for (int i = 0; i < 8; ++i) { const size_t o = (size_t)(ch * CL + 8 * wv + i) * W + h * 64 + lane; rl8[i] = R[o]; kl8[i] = KP[o]; vl8[i] = V[o]; gl8[i] = G[o]; }
#pragma unroll
          for (int i = 0; i < 8; ++i) { const int t = 8 * wv + i; const size_t o = (size_t)(ch * CL + t) * W + h * 64 + lane;
              const float yy = YL[t * 65 + lane]; const float rl = (float)rl8[i], kl = (float)kl8[i], vl = (float)vl8[i], gl = bf2f(gl8[i]);
              const float mean = wave_sum(yy) * (1.f / 64.f); const float dd = yy - mean; const float var = wave_sum(dd * dd) * (1.f / 64.f);
              const float bonus = wave_sum(rl * kl * r_k);
              const float yn = dd * __builtin_amdgcn_rsqf(var + GN_EPS) * gn_g + gn_b + bonus * vl;
              YA[o] = f2bf(yn * gl); } }
        HBAR();
    }
#undef S3_FETCH
}

__device__ __forceinline__ void phase_scan3(ArgsR a, const Ctx& c, int l) {
    const f16* R = (const f16*)(a.ws + WS_R); const f16* WM1 = (const f16*)(a.ws + WS_WM1); const f16* KP = (const f16*)(a.ws + WS_KP);
    const f16* AA = (const f16*)(a.ws + WS_AA); const f16* BB = (const f16*)(a.ws + WS_BB); const f16* V = (const f16*)(a.ws + WS_V);
    const float* ST = (const float*)(a.ws + WS_ST); bf16* YA = (bf16*)(a.ws + WS_YA); const f16* Gs = (const f16*)(a.ws + WS_G);
    const int lane = c.lane;
    LAS3 unsigned char* ring = (LAS3 unsigned char*)c.lds + c.wave * SC_WAVE;
    for (int item = c.gw; item < NH * NCH; item += c.ngw) {
        const int h = __builtin_amdgcn_readfirstlane(item / NCH), ch = __builtin_amdgcn_readfirstlane(item % NCH);
        const size_t lane_off = (size_t)(lane >> 3) * W + h * 64 + (lane & 7) * 8;
        const float gn_g = a.in[I_GNG][l * W + h * 64 + lane], gn_b = a.in[I_GNB][l * W + h * 64 + lane], r_k = a.in[I_RK][l * W + h * 64 + lane];
        { const size_t e0 = (size_t)(ch * CL) * W + lane_off;
          sc_dma(AA, e0, ring); sc_dma(WM1, e0, ring + 1024); sc_dma(BB, e0, ring + 2048); sc_dma(KP, e0, ring + 3072); sc_dma(V, e0, ring + 4096); sc_dma(R, e0, ring + 5120); sc_dma(Gs, e0, ring + 6144); }
        float S[64];
        if (ch == 0) {
#pragma unroll
            for (int j = 0; j < 64; ++j) S[j] = 0.f;
        } else { const bf16* Sp = (const bf16*)ST + ((size_t)(h * NCH + ch - 1) * 64 + lane) * 64;
#pragma unroll
            for (int j = 0; j < 64; j += 4) { const f32x4 x = load4bf(Sp + j); S[j] = x[0]; S[j + 1] = x[1]; S[j + 2] = x[2]; S[j + 3] = x[3]; } }
#pragma unroll 1
        for (int blk = 0; blk < CL / SCB; ++blk) {
            LAS3 unsigned char* buf = ring + (blk & 1) * SC_BUF;
            if (blk + 1 < CL / SCB) { LAS3 unsigned char* nb = ring + ((blk + 1) & 1) * SC_BUF; const size_t e0 = (size_t)(ch * CL + (blk + 1) * SCB) * W + lane_off;
                sc_dma(AA, e0, nb); sc_dma(WM1, e0, nb + 1024); sc_dma(BB, e0, nb + 2048); sc_dma(KP, e0, nb + 3072); sc_dma(V, e0, nb + 4096); sc_dma(R, e0, nb + 5120); sc_dma(Gs, e0, nb + 6144);
                asm volatile("s_waitcnt vmcnt(7)" ::: "memory"); }
            else asm volatile("s_waitcnt vmcnt(0)" ::: "memory");
            SVec A, Wv, Bv, Kv, Rv;
            sv_cvt(A, sv_read(buf, lane)); sv_cvt1p(Wv, sv_read(buf + 1024, lane)); sv_cvt(Bv, sv_read(buf + 2048, lane)); sv_cvt(Kv, sv_read(buf + 3072, lane)); sv_cvt(Rv, sv_read(buf + 5120, lane));
            float vv = (float)*(const LAS3 f16*)(buf + 4096 + lane * 2);
#pragma unroll 1
            for (int st = 0; st < SCB; ++st) {
                const LAS3 unsigned char* sn = buf + ((st + 1 < SCB) ? st + 1 : st) * 128;
                const f16x4 ha = sv_read(sn, lane), hw = sv_read(sn + 1024, lane), hb = sv_read(sn + 2048, lane), hk = sv_read(sn + 3072, lane), hr = sv_read(sn + 5120, lane);
                const f16 hv = *(const LAS3 f16*)(sn + 4096 + lane * 2);
                float d[4] = {0.f, 0.f, 0.f, 0.f};
                sc_dot<0>(d, A, S);
                const float sa = (d[0] + d[1]) + (d[2] + d[3]);
                float y[4] = {0.f, 0.f, 0.f, 0.f};
                sc_upd3<0>(S, y, Wv, Bv, Kv, Rv, sa, vv);
                const float yy = (y[0] + y[1]) + (y[2] + y[3]);
                sv_cvt(A, ha); sv_cvt1p(Wv, hw); sv_cvt(Bv, hb); sv_cvt(Kv, hk); sv_cvt(Rv, hr); vv = (float)hv;
                { const LAS3 unsigned char* sb = buf + st * 128;
                  const float rl = (float)*(const LAS3 f16*)(sb + 5120 + lane * 2), kl = (float)*(const LAS3 f16*)(sb + 3072 + lane * 2), vl = (float)*(const LAS3 f16*)(sb + 4096 + lane * 2);
                  const float gl = bf2f(*(const LAS3 bf16*)(sb + 6144 + lane * 2));
                  const float mean = wave_sum(yy) * (1.f / 64.f); const float dd = yy - mean; const float var = wave_sum(dd * dd) * (1.f / 64.f);
                  const float bonus = wave_sum(rl * kl * r_k);
                  const float yn = dd * __builtin_amdgcn_rsqf(var + GN_EPS) * gn_g + gn_b + bonus * vl;
                  YA[(size_t)(ch * CL + blk * SCB + st) * W + h * 64 + lane] = f2bf(yn * gl); }
            }
        }
    }
}

__device__ __forceinline__ void phase_post(ArgsR a, const Ctx& c, int l) {
    const bf16* YSC = (const bf16*)(a.ws + WS_YSC); const f16* R = (const f16*)(a.ws + WS_R); const f16* KP = (const f16*)(a.ws + WS_KP); const f16* V = (const f16*)(a.ws + WS_V);
    const bf16* G = (const bf16*)(a.ws + WS_G); bf16* YA = (bf16*)(a.ws + WS_YA);
    const float* gng = a.in[I_GNG] + l * W; const float* gnb = a.in[I_GNB] + l * W; const float* rk = a.in[I_RK] + l * W;
    for (int t = c.gw; t < T; t += c.ngw) {
#pragma unroll
        for (int i = 0; i < 8; ++i) { const int n = c.lane + 64 * i; const size_t o = (size_t)t * W + n;
            const float y = bf2f(YSC[o]); const float mean = wave_sum(y) * (1.f / 64.f); const float d = y - mean; const float var = wave_sum(d * d) * (1.f / 64.f);
            float yn = d * __builtin_amdgcn_rsqf(var + GN_EPS) * gng[n] + gnb[n];
            const float r = (float)R[o], k = (float)KP[o], v = (float)V[o];
            const float bonus = wave_sum(r * k * rk[n]);
            yn += bonus * v;
            YA[o] = f2bf(yn * bf2f(G[o])); }
    }
}

__device__ __forceinline__ void phase_ln1(ArgsR a, const Ctx& c, int l, float* outw, int mode = 3) {
    const float* MODF = (const float*)(a.ws + WS_MODF) + l * 6144;
    const float* g1 = a.in[I_LN1G] + l * D; const float* b1 = a.in[I_LN1B] + l * D;
    bf16* XN = (bf16*)(a.ws + WS_XN);
    int* TOKI = (int*)(a.ws + WS_TOKI); float* TOKW = (float*)(a.ws + WS_TOKW); int* TOKP = (int*)(a.ws + WS_TOKP);
    const float* rw = a.in[I_RW]; const float* rb = a.in[I_RB];
    LAS3 float* rwT = (LAS3 float*)((LAS3 unsigned char*)c.lds + 69632);
    constexpr int RW_LD = D + 4;
    unsigned* lcnt = (unsigned*)(c.lds + 135488);
    if (mode & 1) {
    for (int i = c.tid; i < D * NE; i += NTHREADS) rwT[(i & 15) * RW_LD + (i >> 4)] = rw[i];
    if (c.tid < NE) lcnt[c.tid] = 0u;
    __syncthreads();
    float vn[16]; if (c.gw < T) load_row16(a.out + (size_t)c.gw * D, c.lane, vn);
    for (int m = c.gw; m < T; m += c.ngw) {
        int l4 = 4 * c.lane; asm volatile("" : "+v"(l4));
        float v[16];
#pragma unroll
        for (int j = 0; j < 16; ++j) v[j] = vn[j];
        if (m + c.ngw < T) load_row16(a.out + (size_t)(m + c.ngw) * D, c.lane, vn);
        float mean, rstd; row_stats(v, mean, rstd);
#pragma unroll
        for (int j = 0; j < 4; ++j) { f32x4 o; const int col = l4 + 256 * j;
#pragma unroll
            for (int e = 0; e < 4; ++e) { v[4 * j + e] = (v[4 * j + e] - mean) * rstd * g1[col + e] + b1[col + e]; o[e] = v[4 * j + e]; }
            *(f32x4*)(outw + (size_t)m * D + col) = o; }
        row_stats(v, mean, rstd);
#pragma unroll
        for (int j = 0; j < 4; ++j) { f32x4 o; const int col = l4 + 256 * j;
#pragma unroll
            for (int e = 0; e < 4; ++e) { v[4 * j + e] = (v[4 * j + e] - mean) * rstd * (1.0f + MODF[4096 + col + e]) + MODF[3072 + col + e]; o[e] = v[4 * j + e]; }
            store4bf(XN + (size_t)m * D + col, o); }
        float lg[16];
#pragma unroll
        for (int e = 0; e < 16; ++e) { float x = 0.f;
#pragma unroll
            for (int j = 0; j < 4; ++j) { const f32x4 r4 = *(const LAS3 f32x4*)(rwT + e * RW_LD + l4 + 256 * j); x += (v[4 * j] * r4[0] + v[4 * j + 1] * r4[1]) + (v[4 * j + 2] * r4[2] + v[4 * j + 3] * r4[3]); }
            lg[e] = x;
            if ((e & 3) == 3) __builtin_amdgcn_sched_barrier(0); }
        float r8[8], r4v[4], r2[2], r1;
        { const bool b5 = (c.lane & 32) != 0, b4 = (c.lane & 16) != 0, b3 = (c.lane & 8) != 0, b2 = (c.lane & 4) != 0;
#pragma unroll
          for (int i = 0; i < 8; ++i) { const float snd = b5 ? lg[i] : lg[i + 8], kp = b5 ? lg[i + 8] : lg[i]; r8[i] = kp + __shfl_xor(snd, 32); }
#pragma unroll
          for (int i = 0; i < 4; ++i) { const float snd = b4 ? r8[i] : r8[i + 4], kp = b4 ? r8[i + 4] : r8[i]; r4v[i] = kp + __shfl_xor(snd, 16); }
#pragma unroll
          for (int i = 0; i < 2; ++i) { const float snd = b3 ? r4v[i] : r4v[i + 2], kp = b3 ? r4v[i + 2] : r4v[i]; r2[i] = kp + __shfl_xor(snd, 8); }
          { const float snd = b2 ? r2[0] : r2[1], kp = b2 ? r2[1] : r2[0]; r1 = kp + __shfl_xor(snd, 4); }
          r1 += __shfl_xor(r1, 2); r1 += __shfl_xor(r1, 1); }
        float sc[16], sel[16];
#pragma unroll
        for (int e = 0; e < 16; ++e) { const float lgt = __shfl(r1, 4 * e); sc[e] = __builtin_amdgcn_rcpf(1.0f + __expf(-lgt)); sel[e] = sc[e] + rb[e]; }
        int best = 0; float bestv = -INFINITY;
#pragma unroll
        for (int g = 0; g < 4; ++g) { float m1 = -INFINITY, m2 = -INFINITY;
#pragma unroll
            for (int q = 0; q < 4; ++q) { const float sv = sel[4 * g + q]; if (sv > m1) { m2 = m1; m1 = sv; } else if (sv > m2) m2 = sv; }
            const float gs = m1 + m2; if (gs > bestv) { bestv = gs; best = g; } }
        int i1 = 0, i2 = 0; float s1 = -INFINITY, s2 = -INFINITY, w1 = 0.f, w2 = 0.f;
#pragma unroll
        for (int e = 0; e < 16; ++e) { if ((e >> 2) == best) { const float sv = sel[e];
                if (sv > s1) { s2 = s1; i2 = i1; w2 = w1; s1 = sv; i1 = e; w1 = sc[e]; } else if (sv > s2) { s2 = sv; i2 = e; w2 = sc[e]; } } }
        if (c.lane == 0) { const float ws = w1 + w2;
            TOKI[2 * m] = i1; TOKI[2 * m + 1] = i2; TOKW[2 * m] = w1 / ws; TOKW[2 * m + 1] = w2 / ws;
            TOKP[2 * m] = (int)atomicAdd(&lcnt[i1], 1u); TOKP[2 * m + 1] = (int)atomicAdd(&lcnt[i2], 1u); }
    }
    __syncthreads();
    if (c.tid < NE) ((int*)(a.ws + WS_BLKCNT))[blockIdx.x * NE + c.tid] = (int)lcnt[c.tid];
    __syncthreads();
    }
}

__device__ __forceinline__ void expert_convert(ArgsR a, const Ctx& c, int l, int b0) {
    if ((int)blockIdx.x < b0) return;
    float* scr = (float*)(c.lds + c.wave * 8704);
    bf16* WGU = (bf16*)(a.ws + WS_WGU); bf16* WD = (bf16*)(a.ws + WS_WD);
    constexpr int IG = (D / 64) * (FF / 32);
    constexpr int ID = (FF / 64) * (D / 32);
    const int gw0 = ((int)blockIdx.x - b0) * NWAVES + c.wave, ngw0 = ((int)gridDim.x - b0) * NWAVES;
    for (int it = gw0; it < NE * (2 * IG + ID); it += ngw0) {
        const int e = it / (2 * IG + ID); int r = it % (2 * IG + ID);
        const size_t eo = ((size_t)l * NE + e) * (size_t)D * FF;
        if (r < IG) { transpose_matrix_item(a.in[I_EG] + eo, D, FF, WGU + (size_t)e * 1024 * 1024, r, scr, c.lane, RowGU{0}); continue; } r -= IG;
        if (r < IG) { transpose_matrix_item(a.in[I_EU] + eo, D, FF, WGU + (size_t)e * 1024 * 1024, r, scr, c.lane, RowGU{1}); continue; } r -= IG;
        transpose_matrix_item(a.in[I_ED] + eo, FF, D, WD + (size_t)e * 1024 * 512, r, scr, c.lane, RowId());
    }
}

__device__ __forceinline__ void phase_perm(ArgsR a, const Ctx& c, int l) {
    const int* BLKCNT = (const int*)(a.ws + WS_BLKCNT);
    LAS3 int* pre = (LAS3 int*)c.lds;
    LAS3 int* tot = pre + 256 * NE;
    const int nb = gridDim.x;
#pragma unroll
    for (int q = 0; q < 2; ++q) { const int e = 2 * c.wave + q; int v[4]; int sum = 0;
#pragma unroll
        for (int i = 0; i < 4; ++i) { const int b = 4 * c.lane + i; v[i] = b < nb ? BLKCNT[b * NE + e] : 0; sum += v[i]; }
        int inc = sum;
#pragma unroll
        for (int o = 1; o < 64; o <<= 1) { const int t = __shfl_up(inc, o); if (c.lane >= o) inc += t; }
        int run = inc - sum;
#pragma unroll
        for (int i = 0; i < 4; ++i) { pre[(4 * c.lane + i) * NE + e] = run; run += v[i]; }
        if (c.lane == 63) tot[e] = inc; }
    __syncthreads();
    int ts[17]; { int sacc = 0;
#pragma unroll
        for (int e = 0; e < 16; ++e) { ts[e] = sacc; sacc += (tot[e] + 255) >> 8; } ts[16] = sacc; }
    if (blockIdx.x == 0 && c.tid < NE) ((int*)(a.ws + WS_TOT))[c.tid] = tot[c.tid];
    const int* TOKI = (const int*)(a.ws + WS_TOKI); const int* TOKP = (const int*)(a.ws + WS_TOKP); int* S2T = (int*)(a.ws + WS_S2T); const float* TOKW = (const float*)(a.ws + WS_TOKW);
    const bf16* XN = (const bf16*)(a.ws + WS_XN); bf16* XS = (bf16*)(a.ws + WS_XS);
    for (int as = blockIdx.x * NTHREADS + c.tid; as < 2 * T; as += gridDim.x * NTHREADS) {
        const int e = TOKI[as]; int base = 0;
#pragma unroll
        for (int j = 0; j < 16; ++j) base = (j == e) ? ts[j] : base;
        const int m = as >> 1, blk = (m % c.ngw) >> 3;
        const u32x2 sw = {(unsigned)as, __float_as_uint(TOKW[as])};
        *(u32x2*)(S2T + 2 * (base * 256 + pre[blk * NE + e] + TOKP[as])) = sw;
    }
    for (int e = 0; e < 16; ++e) {
        int tse = 0, tsn = 0;
#pragma unroll
        for (int j = 0; j < 16; ++j) { tse = (j == e) ? ts[j] : tse; tsn = (j == e) ? ts[j + 1] : tsn; }
        const int lo = tse * 256 + tot[e], hi = tsn * 256;
        for (int sl = lo + blockIdx.x * NTHREADS + c.tid; sl < hi; sl += gridDim.x * NTHREADS) S2T[2 * sl] = -1;
    }
    __syncthreads();
}

__device__ __forceinline__ void phase_ln2(ArgsR a, const Ctx& c, int l, float* outw) {
    const float* MODF = (const float*)(a.ws + WS_MODF) + l * 6144;
    const float* g2 = a.in[I_LN2G] + l * D; const float* b2 = a.in[I_LN2B] + l * D;
    const bf16* Y = (const bf16*)(a.ws + WS_Y); bf16* XN = (bf16*)(a.ws + WS_XN);
    float vn[16]; u32x2 y0n[4], y1n[4];
    if (c.gw < T) { load_row16(a.out + (size_t)c.gw * D, c.lane, vn);
#pragma unroll
        for (int j = 0; j < 4; ++j) { y0n[j] = *(const u32x2*)(Y + (size_t)(2 * c.gw) * D + 4 * c.lane + 256 * j); y1n[j] = *(const u32x2*)(Y + (size_t)(2 * c.gw + 1) * D + 4 * c.lane + 256 * j); } }
    for (int m = c.gw; m < T; m += c.ngw) {
        float v[16]; u32x2 y0[4], y1[4];
#pragma unroll
        for (int j = 0; j < 16; ++j) v[j] = vn[j];
#pragma unroll
        for (int j = 0; j < 4; ++j) { y0[j] = y0n[j]; y1[j] = y1n[j]; }
        if (m + c.ngw < T) { const int mn = m + c.ngw; load_row16(a.out + (size_t)mn * D, c.lane, vn);
#pragma unroll
            for (int j = 0; j < 4; ++j) { y0n[j] = *(const u32x2*)(Y + (size_t)(2 * mn) * D + 4 * c.lane + 256 * j); y1n[j] = *(const u32x2*)(Y + (size_t)(2 * mn + 1) * D + 4 * c.lane + 256 * j); } }
#pragma unroll
        for (int j = 0; j < 4; ++j) { const int col = 4 * c.lane + 256 * j;
            const float a0 = __uint_as_float(y0[j].x << 16) + __uint_as_float(y1[j].x << 16), a1 = __uint_as_float(y0[j].x & 0xffff0000u) + __uint_as_float(y1[j].x & 0xffff0000u);
            const float a2 = __uint_as_float(y0[j].y << 16) + __uint_as_float(y1[j].y << 16), a3 = __uint_as_float(y0[j].y & 0xffff0000u) + __uint_as_float(y1[j].y & 0xffff0000u);
            const f32x4 gt = *(const f32x4*)(MODF + 5120 + col);
            v[4 * j] = ALPHA * v[4 * j] + (1.0f + gt[0]) * a0; v[4 * j + 1] = ALPHA * v[4 * j + 1] + (1.0f + gt[1]) * a1; v[4 * j + 2] = ALPHA * v[4 * j + 2] + (1.0f + gt[2]) * a2; v[4 * j + 3] = ALPHA * v[4 * j + 3] + (1.0f + gt[3]) * a3; }
        float mean, rstd; row_stats(v, mean, rstd);
#pragma unroll
        for (int j = 0; j < 4; ++j) { f32x4 o; const int col = 4 * c.lane + 256 * j;
#pragma unroll
            for (int e = 0; e < 4; ++e) { v[4 * j + e] = (v[4 * j + e] - mean) * rstd * g2[col + e] + b2[col + e]; o[e] = v[4 * j + e]; }
            *(f32x4*)(outw + (size_t)m * D + col) = o; }
        if (l + 1 < DEPTH) {
            const float* MN = MODF + 6144;
            row_stats(v, mean, rstd);
#pragma unroll
            for (int j = 0; j < 4; ++j) { f32x4 o; const int col = 4 * c.lane + 256 * j;
#pragma unroll
                for (int e = 0; e < 4; ++e) o[e] = (v[4 * j + e] - mean) * rstd * (1.0f + MN[1024 + col + e]) + MN[col + e];
                store4bf(XN + (size_t)m * D + col, o); }
        }
    }
}


template <class F> struct EpiAdapt {
    static constexpr bool PERM = true, AFTER_DRAIN = false; F f;
    __device__ __forceinline__ void operator()(const f32x4 (&acc)[2][2][4][2], const Unit& u, int wr, int wc, int fr, int fq) const {
        const int col = u.pn * 256 + wc * 32 + 8 * fq;
#pragma unroll
        for (int ai = 0; ai < 2; ++ai)
#pragma unroll
            for (int m = 0; m < 4; ++m) { const int row = u.pm * 256 + ai * 128 + wr * 64 + m * 16 + fr; f(row, col, acc[ai][0][m][0], acc[ai][0][m][1], acc[ai][1][m][0], acc[ai][1][m][1]); }
    }
};

template <class Sched, class F>
__device__ __forceinline__ void gemm_gather(const Ctx& c, const bf16* A, const int* s2t, const bf16* Bt, int M, int N, int K, const Sched& S, const F& f) {
    pg8::Gemm g{A, Bt, M, N, K}; EpiAdapt<F> E{f};
    pg8::gemm_phase<EpiAdapt<F>, Sched, true, true, true>((PG8_LAS unsigned char*)c.lds, g, S, E, c.tid, s2t);
}
template <class Sched, class F>
__device__ __forceinline__ void gemm_any(const Ctx& c, const bf16* A, const bf16* Bt, int M, int N, int K, const Sched& S, const F& f) {
    pg8::Gemm g{A, Bt, M, N, K}; EpiAdapt<F> E{f};
    pg8::gemm_phase<EpiAdapt<F>, Sched, true, true>((PG8_LAS unsigned char*)c.lds, g, S, E, c.tid);
}

#define LAS __attribute__((address_space(3)))
#define XB_TMO      128
#define XB_XCNT(j)  (256  + 64 * (j))
#define XB_XSUB(j)  (1280 + 64 * (j))
#define XB_XGEN(j)  (2304 + 64 * (j))
#define XB_TOP      3328
#define XB_TOPGEN   3392
#define XCD_BAR_WORDS 3456
#define XB_SPIN_CAP (1u << 24)

__device__ __forceinline__ unsigned xb_ld(unsigned* p)              { return __hip_atomic_load(p, __ATOMIC_RELAXED, __HIP_MEMORY_SCOPE_AGENT); }
__device__ __forceinline__ unsigned xb_add(unsigned* p, unsigned v) { return __hip_atomic_fetch_add(p, v, __ATOMIC_RELAXED, __HIP_MEMORY_SCOPE_AGENT); }
__device__ __forceinline__ unsigned xb_xcc_id() { return (unsigned)__builtin_amdgcn_s_getreg((3 << 11) | 20) & 0xFu; }
#define XB_SPIN(cond, bar) do { unsigned _sp = 0; while (cond) { __builtin_amdgcn_s_sleep(1); \
    if ((++_sp & 255u) == 0u) { if (xb_ld(&(bar)[XB_TMO])) break; if (_sp > XB_SPIN_CAP) { atomicAdd(&(bar)[XB_TMO], 1u); break; } } } } while (0)

struct XcdBarrier {
    unsigned* bar; unsigned x;
    volatile LAS unsigned* st;
};

__device__ __forceinline__ XcdBarrier xcd_barrier_post(unsigned* bar, volatile LAS unsigned* st) {
    XcdBarrier b; b.bar = bar; b.x = xb_xcc_id(); b.st = st;
    if (threadIdx.x == 0) (void)xb_add(&bar[XB_XCNT(b.x)], 1u);
    return b;
}
__device__ __forceinline__ void xcd_barrier_complete(unsigned* bar, unsigned x, unsigned& nloc, unsigned& nx) {
    const unsigned G = gridDim.x * gridDim.y * gridDim.z;
    unsigned sum, cnt, mine, sp = 0u;
    for (;;) {
        sum = 0u; cnt = 0u; mine = 0u;
#pragma unroll
        for (unsigned j = 0; j < 16; ++j) { const unsigned c = xb_ld(&bar[XB_XCNT(j)]); sum += c; cnt += (c > 0u) ? 1u : 0u; mine = (j == x) ? c : mine; }
        if (sum == G) break;
        __builtin_amdgcn_s_sleep(1);
        if ((++sp & 255u) == 0u) { if (xb_ld(&bar[XB_TMO])) break; if (sp > XB_SPIN_CAP) { atomicAdd(&bar[XB_TMO], 1u); break; } }
    }
    nloc = mine > 0u ? mine : 1u; nx = cnt > 0u ? cnt : 1u;
}

__device__ __forceinline__ void xcd_barrier(const XcdBarrier& b) {
    asm volatile("s_waitcnt vmcnt(0)" ::: "memory");
    __syncthreads();
    if (threadIdx.x == 0) {
        unsigned* bar = b.bar;
        __builtin_amdgcn_s_waitcnt(0);
        unsigned nloc = b.st[0], nx = b.st[1];
        if (nloc == 0u) { xcd_barrier_complete(bar, b.x, nloc, nx); b.st[0] = nloc; b.st[1] = nx; }
        const unsigned old = xb_add(&bar[XB_XSUB(b.x)], 1u);
        const unsigned gen = old / nloc;
        if (old + 1u == (gen + 1u) * nloc) {
            __builtin_amdgcn_fence(__ATOMIC_RELEASE, "agent");
            asm volatile("s_waitcnt vmcnt(0)" ::: "memory");
            const unsigned og = xb_add(&bar[XB_TOP], 1u);
            const unsigned tg = og / nx;
            if (og + 1u == (tg + 1u) * nx) xb_add(&bar[XB_TOPGEN], 1u);
            else XB_SPIN(xb_ld(&bar[XB_TOPGEN]) == tg, bar);
            __builtin_amdgcn_fence(__ATOMIC_ACQUIRE, "agent");
            xb_add(&bar[XB_XGEN(b.x)], 1u);
            asm volatile("s_waitcnt vmcnt(0)" ::: "memory");
        } else {
            XB_SPIN(xb_ld(&bar[XB_XGEN(b.x)]) == gen, bar);
            __builtin_amdgcn_fence(__ATOMIC_ACQUIRE, "agent");
            asm volatile("s_waitcnt vmcnt(0)" ::: "memory");
        }
    }
    __syncthreads();
}


constexpr int PH_PER_LAYER = 12, N_PHASES = 2 + PH_PER_LAYER * DEPTH;
constexpr int CW_BAR = 4096;
constexpr int LDS_BYTES = 147456, LDSCTL_OFF = 131072 + 8192;
#ifndef SINGLE_LAUNCH
#define SINGLE_LAUNCH 1
#endif

#ifndef PROBE_A
#define PROBE_A -1
#endif
#ifndef PROBE_B
#define PROBE_B -1
#endif
constexpr size_t WS_TS = 512 * 1024;
#if PROBE_A >= 0
#define STAMP(i) do { if (blockIdx.x == 0 && threadIdx.x == 0) ((unsigned long long*)(args_here()->ws + WS_TS))[(i)] = __builtin_amdgcn_s_memrealtime(); } while (0)
#else
#define STAMP(i) do { } while (0)
#endif
__device__ __forceinline__ const __attribute__((address_space(4))) Args* args_here() { const __attribute__((address_space(4))) Args* p = (const __attribute__((address_space(4))) Args*)__builtin_amdgcn_kernarg_segment_ptr(); asm volatile("" : "+s"(p)); return p; }
#ifndef REP_K
#define REP_K -1
#endif
__device__ __forceinline__ Ctx mkctx(int wave_s, unsigned char* lds) { Ctx c; c.wave = wave_s; c.lane = (int)__builtin_amdgcn_mbcnt_hi(~0u, __builtin_amdgcn_mbcnt_lo(~0u, 0u)); c.tid = wave_s * 64 + c.lane;
    c.gw = blockIdx.x * NWAVES + wave_s; c.ngw = gridDim.x * NWAVES; c.lds = lds; return c; }
#define PHASE1(k, ...) do { const __attribute__((address_space(4))) Args* ap_ = args_here(); if (ap_->ph_lo <= (k) && (k) < ap_->ph_hi) { ArgsR a = *ap_; const Ctx c = mkctx(wave_s, lds); __VA_ARGS__ } } while (0)
#define PHASE(k, ...) do { PHASE1(k, __VA_ARGS__); if ((k) == REP_K) { xcd_barrier(bar); PHASE1(k, __VA_ARGS__); xcd_barrier(bar); PHASE1(k, __VA_ARGS__); } } while (0)

template <int L>
__device__ __forceinline__ void run_layer(const int wave_s, unsigned char* lds, const XcdBarrier& bar) {
    const int G = gridDim.x, b = blockIdx.x;
#define BAR() do { xcd_barrier(bar); STAMP(3 + 14 * L + (bk_++)); } while (0)
    int bk_ = 0;
    PHASE(0, unsigned char* ws = a.ws; pg8::StaticOrder S; S.init(T, INC, G, b); EpiZ E{(bf16*)(ws + WS_ZR), (bf16*)(ws + WS_ZS), (bf16*)(ws + WS_ZG)};
        gemm_any(c, (const bf16*)(ws + WS_XN), (const bf16*)(ws + WS_WIN + (size_t)L * 10 * MiB), T, INC, D, S, E); );
    BAR();
    PHASE(1, phase_prep_fast(a, c, L); );
    PHASE(14, phase_sg_fast(a, c, L); );
    BAR();
#if REP_K == 21
    PHASE1(2, phase_scan1m(a, c, 1); ); xcd_barrier(bar); PHASE1(2, phase_scan1m(a, c, 1); ); xcd_barrier(bar);
#endif
    PHASE(2, phase_scan1m(a, c); );
    BAR();
    PHASE(3, phase_scan2a(a, c); );
    BAR();
    PHASE(31, phase_scan2b(a, c); );
    PHASE(33, expert_convert(a, c, L, NH); );
    BAR();
    PHASE(4, phase_scan3m(a, c, L); );
    BAR();
    PHASE(6, unsigned char* ws = a.ws; pg8::StaticOrder S; S.init(T, D, G, b); EpiGA E{(const bf16*)(ws + WS_ZG), (bf16*)(ws + WS_MP)};
        gemm_any(c, (const bf16*)(ws + WS_YA), (const bf16*)(ws + WS_WA + (size_t)L * WS_WL1), T, D, W, S, E); );
    BAR();
#if REP_K == 7
    PHASE1(7, unsigned char* ws = a.ws; pg8::StaticOrder S; S.init(T, D, G, b); EpiGB E{(const bf16*)(ws + WS_ZG), (const bf16*)(ws + WS_MP), (bf16*)(ws + WS_ZR)};
        gemm_any(c, (const bf16*)(ws + WS_YB), (const bf16*)(ws + WS_WB + (size_t)L * WS_WL1), T, D, W, S, E); ); xcd_barrier(bar);
    PHASE1(7, unsigned char* ws = a.ws; pg8::StaticOrder S; S.init(T, D, G, b); EpiGB E{(const bf16*)(ws + WS_ZG), (const bf16*)(ws + WS_MP), (bf16*)(ws + WS_ZR)};
        gemm_any(c, (const bf16*)(ws + WS_YB), (const bf16*)(ws + WS_WB + (size_t)L * WS_WL1), T, D, W, S, E); ); xcd_barrier(bar);
#endif
#if REP_K == 8
    PHASE1(8, unsigned char* ws = a.ws; pg8::StaticOrder S; S.init(T, D, G, b); EpiOut E{L == 0 ? a.in[I_X] : a.out, (float*)(ws + WS_R), (const float*)(ws + WS_MODF) + L * 6144 + 2048};
        gemm_any(c, (const bf16*)(ws + WS_MP), (const bf16*)(ws + WS_WO + (size_t)L * WS_WL1), T, D, D, S, E); ); xcd_barrier(bar);
    PHASE1(8, unsigned char* ws = a.ws; pg8::StaticOrder S; S.init(T, D, G, b); EpiOut E{L == 0 ? a.in[I_X] : a.out, (float*)(ws + WS_R), (const float*)(ws + WS_MODF) + L * 6144 + 2048};
        gemm_any(c, (const bf16*)(ws + WS_MP), (const bf16*)(ws + WS_WO + (size_t)L * WS_WL1), T, D, D, S, E); ); xcd_barrier(bar);
#endif
    PHASE1(7, unsigned char* ws = a.ws; pg8::StaticOrder S; S.init(T, D, G, b); EpiGB E{(const bf16*)(ws + WS_ZG), (const bf16*)(ws + WS_MP), (bf16*)(ws + WS_MP)};
        gemm_any(c, (const bf16*)(ws + WS_YB), (const bf16*)(ws + WS_WB + (size_t)L * WS_WL1), T, D, W, S, E); );
    BAR();
    PHASE1(8, unsigned char* ws = a.ws; pg8::StaticOrder S; S.init(T, D, G, b); EpiOut E{L == 0 ? a.in[I_X] : a.out, a.out, (const float*)(ws + WS_MODF) + L * 6144 + 2048};
        gemm_any(c, (const bf16*)(ws + WS_MP), (const bf16*)(ws + WS_WO + (size_t)L * WS_WL1), T, D, D, S, E); );
    BAR();
#if REP_K == 9
    PHASE1(9, phase_ln1(a, c, L, (float*)(a.ws + WS_ZR)); ); xcd_barrier(bar); PHASE1(9, phase_ln1(a, c, L, (float*)(a.ws + WS_ZR)); ); xcd_barrier(bar);
#endif
#if REP_K == 91
    PHASE1(9, phase_ln1(a, c, L, (float*)(a.ws + WS_ZR), 1); ); xcd_barrier(bar); PHASE1(9, phase_ln1(a, c, L, (float*)(a.ws + WS_ZR), 1); ); xcd_barrier(bar);
#endif
#if REP_K == 92
    PHASE1(9, phase_ln1(a, c, L, (float*)(a.ws + WS_ZR), 2); ); xcd_barrier(bar); PHASE1(9, phase_ln1(a, c, L, (float*)(a.ws + WS_ZR), 2); ); xcd_barrier(bar);
#endif
    PHASE1(9, phase_ln1(a, c, L, a.out); );
    BAR();
    PHASE(10, phase_perm(a, c, L); );
    BAR();
    PHASE(11, unsigned char* ws = a.ws; MoeSched S; S.init((const unsigned*)(ws + WS_TOT), G, b); EpiSwi E{(bf16*)(ws + WS_HID)};
        gemm_gather(c, (const bf16*)(ws + WS_XN), (const int*)(ws + WS_S2T), (const bf16*)(ws + WS_WGU), MAXSLOT, NE * 1024, D, S, E); );
    BAR();
    PHASE(12, unsigned char* ws = a.ws; MoeSched S; S.init((const unsigned*)(ws + WS_TOT), G, b); EpiDown E{(const int*)(ws + WS_S2T), (const float*)(ws + WS_TOKW), (bf16*)(ws + WS_Y)};
        gemm_any(c, (const bf16*)(ws + WS_HID), (const bf16*)(ws + WS_WD), MAXSLOT, NE * 1024, FF, S, E); );
    BAR();
#if REP_K == 13
    PHASE1(13, phase_ln2(a, c, L, (float*)(a.ws + WS_R)); ); xcd_barrier(bar); PHASE1(13, phase_ln2(a, c, L, (float*)(a.ws + WS_R)); ); xcd_barrier(bar);
#endif
    PHASE1(13, phase_ln2(a, c, L, a.out); );
    if (L + 1 < DEPTH) BAR();
    (void)bk_;
#undef BAR
}

__global__ void __launch_bounds__(NTHREADS, 2) mk_fwd(Args a_unused) {
    extern __shared__ __attribute__((aligned(16))) unsigned char lds[];
    const int wave_s = __builtin_amdgcn_readfirstlane(threadIdx.x >> 6);
    for (int u = threadIdx.x; u < (LDS_BYTES - LDSCTL_OFF) / 4; u += NTHREADS) ((LAS unsigned*)((LAS unsigned char*)lds + LDSCTL_OFF))[u] = 0u;
    __syncthreads();
    const XcdBarrier bar = xcd_barrier_post((unsigned*)(args_here()->ws + WS_CTL) + CW_BAR, (volatile LAS unsigned*)((LAS unsigned char*)lds + LDSCTL_OFF) + 8);
    STAMP(0);
    PHASE(100, phase_p0a(a, c); );
    xcd_barrier(bar); STAMP(1);
    PHASE(101, phase_p0b(a, c); );
    xcd_barrier(bar); STAMP(2);
    run_layer<0>(wave_s, lds, bar);
    run_layer<1>(wave_s, lds, bar);
#if PROBE_A >= 0
    if (blockIdx.x == 0) {
        asm volatile("s_waitcnt vmcnt(0)" ::: "memory"); __syncthreads();
        if (threadIdx.x == 0) ((unsigned long long*)(args_here()->ws + WS_TS))[30] = __builtin_amdgcn_s_memrealtime();
        asm volatile("s_waitcnt vmcnt(0)" ::: "memory"); __syncthreads();
        const volatile unsigned long long* ts = (const volatile unsigned long long*)(args_here()->ws + WS_TS);
        float da = 0.f, db = 0.f;
        if (PROBE_A < 14) { da = (float)(ts[3 + PROBE_A] - ts[2 + PROBE_A]) + (float)(ts[17 + PROBE_A] - ts[16 + PROBE_A]); } else if (PROBE_A == 14) da = (float)(ts[1] - ts[0]); else if (PROBE_A == 15) da = (float)(ts[2] - ts[1]); else da = (float)(ts[30] - ts[0]);
        if (PROBE_B >= 0 && PROBE_B < 14) { db = (float)(ts[3 + PROBE_B] - ts[2 + PROBE_B]) + (float)(ts[17 + PROBE_B] - ts[16 + PROBE_B]); } else if (PROBE_B == 14) db = (float)(ts[1] - ts[0]); else if (PROBE_B == 15) db = (float)(ts[2] - ts[1]);
        da *= 0.01f; db *= 0.01f;
        da = exp2f(0.25f * rintf(4.0f * log2f(fmaxf(da, 0.5f)))); db = exp2f(0.25f * rintf(4.0f * log2f(fmaxf(db, 0.5f))));
        float* out = args_here()->out;
        for (int i = threadIdx.x; i < 16 * 1024; i += NTHREADS) { const int r = i >> 10, col = i & 1023; const int rowi = (r & 7) + 2048 * (r >> 3); out[(size_t)rowi * D + col] = da; }
        if (threadIdx.x == 0 && PROBE_B >= 0) out[(size_t)4096 * D] = 100.0f * db;
    }
#endif
}

extern "C" void kernel_launch(void* const* d_in, const int* in_sizes, int n_in, void* d_out, int out_size, void* d_ws, size_t ws_size, hipStream_t stream) {
    static int grid = 0;
    if (grid == 0) {
        if (n_in != N_IN || out_size != T * D || ws_size < WS_END2) { fprintf(stderr, "kernel_launch: unexpected shapes: n_in %d out %d ws %zu (need %zu)\n", n_in, out_size, ws_size, (size_t)WS_END2); grid = -1; return; }
        int dev = 0, cus = 0;
        (void)hipGetDevice(&dev); (void)hipDeviceGetAttribute(&cus, hipDeviceAttributeMultiprocessorCount, dev);
        if (hipFuncSetAttribute((const void*)mk_fwd, hipFuncAttributeMaxDynamicSharedMemorySize, LDS_BYTES) != hipSuccess) { fprintf(stderr, "kernel_launch: hipFuncSetAttribute failed\n"); grid = -1; return; }
        grid = cus > 0 ? cus : 256;
        fprintf(stderr, "kernel_launch: ws_size %zu grid %d\n", ws_size, grid);
    }
    if (grid < 0) return;
    (void)hipMemsetAsync((char*)d_ws + WS_CTL, 0, CTL_BYTES, stream);
    Args a{};
    for (int i = 0; i < N_IN; ++i) a.in[i] = (const float*)d_in[i];
    a.out = (float*)d_out; a.ws = (unsigned char*)d_ws;
    a.ph_lo = 0; a.ph_hi = 1000;
    hipLaunchKernelGGL(mk_fwd, dim3(grid), dim3(NTHREADS), LDS_BYTES, stream, a);
}
```

```cpp
#include <hip/hip_runtime.h>
#include <cstdio>
#include <cstdint>
#include <utility>

typedef unsigned short bf16;
typedef _Float16 f16;
typedef float f32x4 __attribute__((ext_vector_type(4)));
typedef unsigned u32x4 __attribute__((ext_vector_type(4)));
typedef unsigned u32x2 __attribute__((ext_vector_type(2)));

constexpr int T = 16384, D = 1024, W = 512, NH = 8, HN = 64, RC = 1792, INC = 4864;
constexpr int NE = 16, FF = 512, DEPTH = 2;
constexpr float LN_EPS = 1e-5f, GN_EPS = 64e-5f, ALPHA = 1.41421356237f;
constexpr int NTHREADS = 512, NWAVES = 8;
constexpr int MAXSLOT = 36864;

constexpr size_t MiB = 1u << 20;
constexpr size_t WS_CTL = 0, CTL_BYTES = 1 * MiB;
constexpr int CW_CNT = 16384;
constexpr size_t WS_PART = 1 * MiB;
constexpr size_t WS_MODF = 2 * MiB;
constexpr size_t WS_TOKI = 2 * MiB + 65536;
constexpr size_t WS_TOKW = WS_TOKI + 131072;
constexpr size_t WS_TOKP = WS_TOKW + 131072;
constexpr size_t WS_S2T = 3 * MiB;
constexpr size_t WS_BLKCNT = 3 * MiB + 512 * 1024;
constexpr size_t WS_TOT = WS_BLKCNT + 32768;
constexpr size_t WS_LORA = 4 * MiB;
constexpr size_t WS_WIN = 8 * MiB;
constexpr size_t WS_WA = 28 * MiB, WS_WB = 29 * MiB, WS_WO = 30 * MiB, WS_WL1 = 4 * MiB;
constexpr size_t WS_ZG = 36 * MiB;
constexpr size_t WS_XN = 100 * MiB;
constexpr size_t WS_G = 100 * MiB, WS_YB = 116 * MiB;
constexpr size_t WS_ZR = 132 * MiB;
constexpr size_t WS_ZS = 188 * MiB;
constexpr size_t WS_YSC = 132 * MiB;
constexpr size_t WS_ST = 148 * MiB;
constexpr size_t WS_YA = 132 * MiB;
constexpr size_t WS_MP = 164 * MiB;
constexpr size_t WS_TMP = 132 * MiB;
constexpr size_t WS_XS = 132 * MiB;
constexpr size_t WS_Y = 132 * MiB;
constexpr size_t WS_AA = 224 * MiB, WS_BB = 240 * MiB, WS_WM1 = 256 * MiB, WS_R = 272 * MiB, WS_KP = 288 * MiB, WS_V = 304 * MiB;
constexpr size_t WS_WGU = 224 * MiB;
constexpr size_t WS_WD = 256 * MiB;
constexpr size_t WS_HID = 272 * MiB;
constexpr size_t WS_VF = 320 * MiB;
constexpr size_t WS_END = 336 * MiB;

constexpr size_t LO_W2T = 0, LO_A2T = 65536, LO_G2T = 131072, LO_VM1T = 262144, LO_VM2T = 294912, LO_STRIDE = 524288;

enum { I_X = 0, I_C, I_WMOD, I_BMOD, I_WIN, I_MU, I_W0, I_W2, I_A0, I_A2, I_G2, I_KK, I_KA, I_RK, I_GNG, I_GNB, I_VM0, I_VM1, I_VM2,
       I_SGG, I_SGB, I_WS, I_BS, I_WBA, I_WBB, I_WOUT, I_LN1G, I_LN1B, I_RW, I_RB, I_EG, I_EU, I_ED, I_LN2G, I_LN2B, N_IN };

struct Args { const float* in[N_IN]; float* out; unsigned char* ws; int ph_lo, ph_hi; };
typedef const __attribute__((address_space(4))) Args& ArgsR;

__device__ __forceinline__ float bf2f(bf16 h) { return __uint_as_float(((unsigned)h) << 16); }
__device__ __forceinline__ unsigned f2bfu(float f) { unsigned u = __float_as_uint(f); return (u + 0x7fffu + ((u >> 16) & 1u)) >> 16; }
__device__ __forceinline__ bf16 f2bf(float f) { return __builtin_bit_cast(unsigned short, (__bf16)f); }
typedef __bf16 bf16x2_t __attribute__((ext_vector_type(2)));
__device__ __forceinline__ unsigned pk2(float lo, float hi) { bf16x2_t v; v[0] = (__bf16)lo; v[1] = (__bf16)hi; return __builtin_bit_cast(unsigned, v); }
__device__ __forceinline__ void store4bf(bf16* p, f32x4 v) { u32x2 w; w.x = pk2(v[0], v[1]); w.y = pk2(v[2], v[3]); *(u32x2*)p = w; }
__device__ __forceinline__ f32x4 load4bf(const bf16* p) { u32x2 w = *(const u32x2*)p; f32x4 r; r[0] = __uint_as_float(w.x << 16); r[1] = __uint_as_float(w.x & 0xffff0000u); r[2] = __uint_as_float(w.y << 16); r[3] = __uint_as_float(w.y & 0xffff0000u); return r; }
__device__ __forceinline__ float wave_sum(float v) {
    v += __builtin_bit_cast(float, __builtin_amdgcn_update_dpp(0, __builtin_bit_cast(int, v), 0xB1, 0xF, 0xF, true));
    v += __builtin_bit_cast(float, __builtin_amdgcn_update_dpp(0, __builtin_bit_cast(int, v), 0x4E, 0xF, 0xF, true));
    v += __builtin_bit_cast(float, __builtin_amdgcn_update_dpp(0, __builtin_bit_cast(int, v), 0x141, 0xF, 0xF, true));
    v += __builtin_bit_cast(float, __builtin_amdgcn_update_dpp(0, __builtin_bit_cast(int, v), 0x140, 0xF, 0xF, true));
    v += __builtin_bit_cast(float, __builtin_amdgcn_update_dpp(0, __builtin_bit_cast(int, v), 0x142, 0xA, 0xF, false));
    v += __builtin_bit_cast(float, __builtin_amdgcn_update_dpp(0, __builtin_bit_cast(int, v), 0x143, 0xC, 0xF, false));
    return __builtin_bit_cast(float, __builtin_amdgcn_readlane(__builtin_bit_cast(int, v), 63));
}
__device__ __forceinline__ float sigmoidf_(float x) { return __builtin_amdgcn_rcpf(1.0f + __expf(-x)); }
__device__ __forceinline__ float siluf_(float x) { return x * sigmoidf_(x); }
__device__ __forceinline__ float gelu_tanh(float x) { const float u = 0.7978845608028654f * (x + 0.044715f * x * x * x); return x * (1.0f - __builtin_amdgcn_rcpf(1.0f + __expf(2.0f * u))); }
__device__ __forceinline__ float softplusf_(float y) { return fmaxf(y, 0.f) + log1pf(__expf(-fabsf(y))); }

struct Ctx { int tid, lane, wave, gw, ngw; unsigned char* lds; };

__device__ __forceinline__ void transpose_item(const float* Wsrc, int N, int k0, int n0, bf16* dst, int ldk, float* scr, int lane) {
    float tv[32];
#pragma unroll
    for (int i = 0; i < 32; ++i) tv[i] = Wsrc[(size_t)(k0 + 2 * i + (lane >> 5)) * N + n0 + (lane & 31)];
#pragma unroll
    for (int i = 0; i < 32; ++i) scr[(2 * i + (lane >> 5)) * 33 + (lane & 31)] = tv[i];
    asm volatile("s_waitcnt lgkmcnt(0)" ::: "memory");
    const int c = lane & 7;
#pragma unroll
    for (int j = 0; j < 4; ++j) { const int n = (lane >> 3) + 8 * j; const float* s = scr + (8 * c) * 33 + n;
        u32x4 o; o.x = pk2(s[0 * 33], s[1 * 33]); o.y = pk2(s[2 * 33], s[3 * 33]); o.z = pk2(s[4 * 33], s[5 * 33]); o.w = pk2(s[6 * 33], s[7 * 33]);
        *(u32x4*)(dst + (size_t)n * ldk + k0 + 8 * c) = o; }
    asm volatile("s_waitcnt lgkmcnt(0)" ::: "memory");
}
template <class RowMap>
__device__ __forceinline__ void transpose_matrix_item(const float* Wsrc, int K, int N, bf16* dst, int item, float* scr, int lane, const RowMap& rm) {
    const int nblk = N / 32, kb = item / nblk, nb = item % nblk, n0 = 32 * nb;
    transpose_item(Wsrc, N, 64 * kb, n0, dst + (size_t)rm(n0) * K, K, scr, lane);
}
struct RowId { __device__ __forceinline__ int operator()(int n) const { return n; } };
struct RowGU { int up; __device__ __forceinline__ int operator()(int n) const { return (n >> 7) * 256 + (n & 127) + up * 128; } };

__device__ __forceinline__ void phase_p0a(ArgsR a, const Ctx& c) {
    float* scr = (float*)(c.lds + c.wave * 16384);
    { float* MODF = (float*)(a.ws + WS_MODF); float* red = (float*)(c.lds + 131072);
      for (int cbk = blockIdx.x; cbk < 2 * 96; cbk += gridDim.x) {
          const int l = cbk / 96, n = (cbk % 96) * 64 + c.lane;
          const float* wm = a.in[I_WMOD] + (size_t)l * D * 6144 + (size_t)(c.wave * 128) * 6144 + n;
          float acc0 = 0.f, acc1 = 0.f;
#pragma unroll 16
          for (int k = 0; k < 128; k += 2) { acc0 += siluf_(a.in[I_C][c.wave * 128 + k]) * wm[(size_t)k * 6144]; acc1 += siluf_(a.in[I_C][c.wave * 128 + k + 1]) * wm[(size_t)(k + 1) * 6144]; }
          red[c.wave * 64 + c.lane] = acc0 + acc1;
          __syncthreads();
          if (c.wave == 0) { float sacc = a.in[I_BMOD][l * 6144 + n];
#pragma unroll
              for (int w = 0; w < 8; ++w) sacc += red[w * 64 + c.lane];
              MODF[l * 6144 + n] = sacc; }
          __syncthreads();
      } }
    for (int it = c.gw; it < 2 * (16 + 16 + 32 + 8); it += c.ngw) {
        const int l = it / 72; int r = it % 72; unsigned char* lo = a.ws + WS_LORA + (size_t)l * LO_STRIDE;
        if (r < 16) { transpose_matrix_item(a.in[I_W2] + (size_t)l * 64 * W, 64, W, (bf16*)(lo + LO_W2T), r, scr, c.lane, RowId()); continue; } r -= 16;
        if (r < 16) { transpose_matrix_item(a.in[I_A2] + (size_t)l * 64 * W, 64, W, (bf16*)(lo + LO_A2T), r, scr, c.lane, RowId()); continue; } r -= 16;
        if (r < 32) { transpose_matrix_item(a.in[I_G2] + (size_t)l * 128 * W, 128, W, (bf16*)(lo + LO_G2T), r, scr, c.lane, RowId()); continue; } r -= 32;
        if (l == 1) transpose_matrix_item(a.in[I_VM1], W, 32, (bf16*)(lo + LO_VM1T), r, scr, c.lane, RowId());
    }
    for (int i = blockIdx.x * NTHREADS + c.tid; i < 32 * W; i += gridDim.x * NTHREADS) { const int n = i >> 5, k = i & 31;
        ((bf16*)(a.ws + WS_LORA + LO_STRIDE + LO_VM2T))[i] = f2bf(a.in[I_VM2][(size_t)k * W + n]); }
    constexpr int I_WINL = (D / 64) * (INC / 32);
    constexpr int I_WAL = (W / 64) * (D / 32);
    constexpr int I_WOL = (D / 64) * (D / 32);
    constexpr int PER_L = I_WINL + 2 * I_WAL + I_WOL;
    for (int it = c.gw; it < 2 * PER_L; it += c.ngw) {
        const int l = it / PER_L; int r = it % PER_L;
        if (r < I_WINL) { transpose_matrix_item(a.in[I_WIN] + (size_t)l * D * INC, D, INC, (bf16*)(a.ws + WS_WIN + (size_t)l * 10 * MiB), r, scr, c.lane, RowId()); continue; } r -= I_WINL;
        if (r < I_WAL) { transpose_matrix_item(a.in[I_WBA] + (size_t)l * W * D, W, D, (bf16*)(a.ws + WS_WA + (size_t)l * WS_WL1), r, scr, c.lane, RowId()); continue; } r -= I_WAL;
        if (r < I_WAL) { transpose_matrix_item(a.in[I_WBB] + (size_t)l * W * D, W, D, (bf16*)(a.ws + WS_WB + (size_t)l * WS_WL1), r, scr, c.lane, RowId()); continue; } r -= I_WAL;
        transpose_matrix_item(a.in[I_WOUT] + (size_t)l * D * D, D, D, (bf16*)(a.ws + WS_WO + (size_t)l * WS_WL1), r, scr, c.lane, RowId());
    }
}

__device__ __forceinline__ void row_stats(const float (&v)[16], float& mean, float& rstd) {
    float s = 0.f;
#pragma unroll
    for (int j = 0; j < 16; ++j) s += v[j];
    mean = wave_sum(s) * (1.f / D);
    float q = 0.f;
#pragma unroll
    for (int j = 0; j < 16; ++j) { const float d = v[j] - mean; q += d * d; }
    rstd = __builtin_amdgcn_rsqf(wave_sum(q) * (1.f / D) + LN_EPS);
}
__device__ __forceinline__ void load_row16bf(const bf16* p, int lane, float (&v)[16]) {
#pragma unroll
    for (int j = 0; j < 4; ++j) { const f32x4 x = load4bf(p + 4 * lane + 256 * j); v[4 * j] = x[0]; v[4 * j + 1] = x[1]; v[4 * j + 2] = x[2]; v[4 * j + 3] = x[3]; }
}
__device__ __forceinline__ void load_row16(const float* p, int lane, float (&v)[16]) {
#pragma unroll
    for (int j = 0; j < 4; ++j) { const f32x4 x = *(const f32x4*)(p + 4 * lane + 256 * j); v[4 * j] = x[0]; v[4 * j + 1] = x[1]; v[4 * j + 2] = x[2]; v[4 * j + 3] = x[3]; }
}

__device__ __forceinline__ void phase_p0b(ArgsR a, const Ctx& c) {
    const float* MODF = (const float*)(a.ws + WS_MODF);
    float sh[16], sc[16];
#pragma unroll
    for (int j = 0; j < 4; ++j) { const f32x4 s0 = *(const f32x4*)(MODF + 4 * c.lane + 256 * j), s1 = *(const f32x4*)(MODF + 1024 + 4 * c.lane + 256 * j);
#pragma unroll
        for (int e = 0; e < 4; ++e) { sh[4 * j + e] = s0[e]; sc[4 * j + e] = 1.f + s1[e]; } }
    bf16* XN = (bf16*)(a.ws + WS_XN);
    for (int m = c.gw; m < T; m += c.ngw) {
        float v[16]; load_row16(a.in[I_X] + (size_t)m * D, c.lane, v);
        float mean, rstd; row_stats(v, mean, rstd);
#pragma unroll
        for (int j = 0; j < 4; ++j) { f32x4 o;
#pragma unroll
            for (int e = 0; e < 4; ++e) o[e] = (v[4 * j + e] - mean) * rstd * sc[4 * j + e] + sh[4 * j + e];
            store4bf(XN + (size_t)m * D + 4 * c.lane + 256 * j, o); }
    }
}

namespace pg8 {
#define PG8_LAS __attribute__((address_space(3)))
typedef unsigned short bf16_t;
typedef short bf16x8 __attribute__((ext_vector_type(8)));
typedef float f32x4 __attribute__((ext_vector_type(4)));
typedef unsigned u32x4 __attribute__((ext_vector_type(4)));
constexpr int BM = 256, BK = 64, HALF = 128, HTB = HALF * BK * 2  , STAGE_BYTES = 8 * HTB, NXCD = 8, WGM = 8;

__host__ __device__ __forceinline__ int lds_byte(int r, int c) { const int st = (r >> 4) * 2 + (c >> 5), rr = r & 15, cc = c & 31, ob = rr * 64 + cc * 2; return st * 1024 + (ob ^ (((ob >> 9) & 1) << 5)); }
__host__ __device__ __forceinline__ void stage_rc(int b, int& R, int& C) { const int st = b / 1024, sb = b % 1024, swz = sb ^ (((sb >> 9) & 1) << 5); R = (st >> 1) * 16 + swz / 64; C = (st & 1) * 32 + (swz % 64) / 2; }
__host__ __device__ __forceinline__ int perm32(int rho) { const int n = rho >> 4, i = rho & 15; return 8 * (i >> 2) + 4 * n + (i & 3); }

struct Unit { int pm, pn; };
struct Gemm { const bf16_t* A; const bf16_t* Bt; int M, N, K; };

struct StaticOrder {
    int nM, nN, nwg, G, c;
    __host__ __device__ void init(int M, int N, int G_, int c_) { nM = M / BM; nN = N / BM; nwg = nM * nN; G = G_; c = c_; }
    __host__ __device__ bool next(int i, Unit& u) const {
        const long L = (long)i * G + c; if (L >= nwg) return false;
        int wgid = (int)L; { const int q = nwg / NXCD, r = nwg % NXCD, xcd = wgid % NXCD, off = wgid / NXCD; wgid = (xcd < r ? xcd * (q + 1) : r * (q + 1) + (xcd - r) * q) + off; }
        const int nig = WGM * nN, gid = wgid / nig, fm = gid * WGM, gsz = (nM - fm) < WGM ? (nM - fm) : WGM;
        u.pm = fm + ((wgid % nig) % gsz); u.pn = (wgid % nig) / gsz; return true;
    }
    __device__ __forceinline__ void a_ready(const Unit&) const {}
    __device__ __forceinline__ void done(const Unit&) const {}
};


template <class Epi, class Sched, bool ALIGN_EPI = false, bool SP2 = false, bool GATHER = false>
__device__ __forceinline__ void gemm_phase(PG8_LAS unsigned char* lds, const Gemm g, const Sched& S, const Epi& E, const int tid_in, const int* s2t = nullptr) {
    const int tid = tid_in, wid = __builtin_amdgcn_readfirstlane(tid >> 6), lane = tid & 63, wr = wid >> 2, wc = wid & 3, fr = lane & 15, fq = lane >> 4;
    const int K = g.K, nt = K / BK;
    unsigned voffA[2], voffB[2];
#pragma unroll
    for (int i = 0; i < 2; ++i) { int R, C; stage_rc(tid * 16 + i * 8192, R, C); const int Rb = Epi::PERM ? ((R & ~31) + perm32(R & 31)) : R;
        voffA[i] = (unsigned)(R * K + C) * 2u; voffB[i] = (unsigned)(Rb * K + C) * 2u; }
    unsigned pc0 = 0u, pc1 = 0u, pn0 = 0u, pn1 = 0u, cvoff = 0u; int R0g = 0;
    if constexpr (GATHER) { int R, C; stage_rc(tid * 16, R, C); R0g = R; cvoff = (unsigned)C * 2u; }
#define PG8_TOKPACK(pm_, h_) ([&]() -> unsigned { const int r0_ = (pm_) * BM + (h_) * HALF + R0g; const int a0_ = s2t[2 * r0_], a1_ = s2t[2 * (r0_ + 64)]; return (unsigned)(a0_ < 0 ? 0 : (a0_ >> 1)) | ((unsigned)(a1_ < 0 ? 0 : (a1_ >> 1)) << 16); }())
#define PG8_STAGE_A(bufoff, base, h, usen) do { if constexpr (GATHER) { const unsigned pk_ = (usen) ? ((h) ? pn1 : pn0) : ((h) ? pc1 : pc0); \
        unsigned vt_[2] = {(pk_ & 0xffffu) * (unsigned)(K * 2) + cvoff, (pk_ >> 16) * (unsigned)(K * 2) + cvoff}; PG8_STAGE(bufoff, base, vt_); } \
    else PG8_STAGE(bufoff, (base) + ((h) ? hstep : (size_t)0), voffA); } while (0)
    const size_t kstep = (size_t)(BK * 2);
    const size_t hstep = (size_t)HALF * K * 2;
    const size_t tstep = 2 * hstep;
    const unsigned ldsw = (unsigned)wid * 1024u;
    const int aoff = lds_byte(wr * 64 + fr, fq * 8), boff = lds_byte(wc * 32 + fr, fq * 8);
#define PG8_SA(b, h) (((b) * 2 + (h)) * HTB)
#define PG8_SB(b, h) ((4 + (b) * 2 + (h)) * HTB)
#define PG8_STAGE(bufoff, gbase, voff) do { _Pragma("unroll") for (int _i = 0; _i < 2; ++_i) \
        __builtin_amdgcn_global_load_lds((const unsigned*)((const char*)(gbase) + (voff)[_i]), (PG8_LAS unsigned*)(lds + (bufoff) + ldsw + _i * 8192), 16, 0, 0); } while (0)
#define PG8_LDA(dst, b, h) do { _Pragma("unroll") for (int m = 0; m < 4; ++m) _Pragma("unroll") for (int k = 0; k < 2; ++k) dst[m][k] = *(const PG8_LAS bf16x8*)(lds + PG8_SA(b, h) + aoff + m * 2048 + k * 1024); } while (0)
#define PG8_LDB(dst, b, h) do { _Pragma("unroll") for (int n = 0; n < 2; ++n) _Pragma("unroll") for (int k = 0; k < 2; ++k) dst[n][k] = *(const PG8_LAS bf16x8*)(lds + PG8_SB(b, h) + boff + n * 2048 + k * 1024); } while (0)
#define PG8_MMA(ai, bj, At, Bt) do { __builtin_amdgcn_s_setprio(1); _Pragma("unroll") for (int m = 0; m < 4; ++m) _Pragma("unroll") for (int n = 0; n < 2; ++n) _Pragma("unroll") for (int k = 0; k < 2; ++k) \
        acc[ai][bj][m][n] = __builtin_amdgcn_mfma_f32_16x16x32_bf16(Bt[n][k], At[m][k], acc[ai][bj][m][n], 0, 0, 0); __builtin_amdgcn_s_setprio(0); } while (0)
#define PG8_WAIT_V(n) asm volatile("s_waitcnt vmcnt(" #n ")" ::: "memory")
#define PG8_WAIT_L(n) asm volatile("s_waitcnt lgkmcnt(" #n ")" ::: "memory")
#define PG8_BAR __builtin_amdgcn_s_barrier()
#define PG8_SCHED __builtin_amdgcn_sched_barrier(0)
    Unit cur, nxt; int ui = 0;
    if (!S.next(0, cur)) return;
    f32x4 acc[2][2][4][2];
#pragma unroll
    for (int a = 0; a < 2; ++a)
#pragma unroll
        for (int b = 0; b < 2; ++b)
#pragma unroll
            for (int m = 0; m < 4; ++m)
#pragma unroll
                for (int n = 0; n < 2; ++n) acc[a][b][m][n] = (f32x4){0.f, 0.f, 0.f, 0.f};
    bf16x8 At[4][2], B0[2][2], B1[2][2];
    const char* cA = (const char*)g.A + (GATHER ? (size_t)0 : (size_t)cur.pm * tstep); const char* cB = (const char*)g.Bt + (size_t)cur.pn * tstep;
    if constexpr (GATHER) { pc0 = PG8_TOKPACK(cur.pm, 0); pc1 = PG8_TOKPACK(cur.pm, 1); }
    S.a_ready(cur);
    if constexpr (SP2) {
        PG8_STAGE(PG8_SB(0, 0), cB, voffB); PG8_STAGE(PG8_SB(0, 1), cB + hstep, voffB); PG8_STAGE_A(PG8_SA(0, 0), cA, 0, false); PG8_STAGE_A(PG8_SA(0, 1), cA, 1, false);
        if (wr == 1) PG8_BAR;
        PG8_WAIT_V(2); PG8_BAR;
        PG8_STAGE(PG8_SB(1, 0), cB + kstep, voffB); PG8_STAGE_A(PG8_SA(1, 0), cA + kstep, 0, false); PG8_STAGE(PG8_SB(1, 1), cB + hstep + kstep, voffB);
        PG8_WAIT_V(6); PG8_BAR;
    } else {
        PG8_STAGE(PG8_SB(0, 0), cB, voffB); PG8_STAGE(PG8_SA(0, 0), cA, voffA); PG8_STAGE(PG8_SB(0, 1), cB + hstep, voffB); PG8_STAGE(PG8_SA(0, 1), cA + hstep, voffA);
        if (wr == 1) PG8_BAR;
        PG8_WAIT_V(4); PG8_BAR;
        PG8_STAGE(PG8_SB(1, 0), cB + kstep, voffB); PG8_STAGE(PG8_SA(1, 0), cA + kstep, voffA); PG8_STAGE(PG8_SB(1, 1), cB + hstep + kstep, voffB);
        PG8_WAIT_V(6); PG8_BAR;
    }
    for (;;) {
        const bool has_next = S.next(ui + 1, nxt);
        const char* nA = (has_next && !GATHER) ? (const char*)g.A + (size_t)nxt.pm * tstep : cA; const char* nB = has_next ? (const char*)g.Bt + (size_t)nxt.pn * tstep : cB;
        if constexpr (GATHER) { if (has_next) { pn0 = PG8_TOKPACK(nxt.pm, 0); pn1 = PG8_TOKPACK(nxt.pm, 1); } else { pn0 = pc0; pn1 = pc1; } }
        for (int t = 0; t < nt; t += 2) {
            const bool last = (t == nt - 2);
            const char* a1 = cA + (size_t)(t + 1) * kstep;
            const char* a2 = last ? nA : cA + (size_t)(t + 2) * kstep; const char* b2 = last ? nB : cB + (size_t)(t + 2) * kstep;
            const char* a3 = a2 + kstep; const char* b3 = b2 + kstep;
            if (last && has_next) S.a_ready(nxt);
            if constexpr (SP2) {
            PG8_LDB(B0, 0, 0); PG8_LDB(B1, 0, 1); PG8_SCHED; PG8_LDA(At, 0, 0); PG8_STAGE_A(PG8_SA(1, 1), a1, 1, false);
            PG8_WAIT_V(8); PG8_WAIT_L(0); PG8_BAR; PG8_MMA(0, 0, At, B0); PG8_MMA(0, 1, At, B1); PG8_BAR; PG8_SCHED;
            PG8_LDA(At, 0, 1); PG8_STAGE(PG8_SB(0, 0), b2, voffB); PG8_STAGE(PG8_SB(0, 1), b2 + hstep, voffB); PG8_STAGE_A(PG8_SA(0, 0), a2, 0, last);
            PG8_WAIT_V(8); PG8_WAIT_L(0); PG8_BAR; PG8_MMA(1, 0, At, B0); PG8_MMA(1, 1, At, B1); PG8_BAR; PG8_SCHED;
            PG8_LDB(B0, 1, 0); PG8_LDB(B1, 1, 1); PG8_SCHED; PG8_LDA(At, 1, 0); PG8_STAGE_A(PG8_SA(0, 1), a2, 1, last);
            PG8_WAIT_V(8); PG8_WAIT_L(0); PG8_BAR; PG8_MMA(0, 0, At, B0); PG8_MMA(0, 1, At, B1); PG8_BAR; PG8_SCHED;
            PG8_LDA(At, 1, 1); PG8_STAGE(PG8_SB(1, 0), b3, voffB); PG8_STAGE(PG8_SB(1, 1), b3 + hstep, voffB); PG8_STAGE_A(PG8_SA(1, 0), a3, 0, last);
            PG8_WAIT_V(8); PG8_WAIT_L(0); PG8_BAR; PG8_MMA(1, 0, At, B0); PG8_MMA(1, 1, At, B1); PG8_BAR; PG8_SCHED;
            } else {
            PG8_LDB(B0, 0, 0); PG8_SCHED; PG8_LDA(At, 0, 0); PG8_STAGE(PG8_SA(1, 1), a1 + hstep, voffA);
            PG8_WAIT_L(8); PG8_BAR; PG8_WAIT_L(0); PG8_MMA(0, 0, At, B0); PG8_BAR; PG8_SCHED;
            PG8_LDB(B1, 0, 1); PG8_STAGE(PG8_SB(0, 0), b2, voffB);
            PG8_BAR; PG8_WAIT_L(0); PG8_MMA(0, 1, At, B1); PG8_BAR;
            PG8_LDA(At, 0, 1); PG8_STAGE(PG8_SA(0, 0), a2, voffA);
            PG8_BAR; PG8_WAIT_L(0); PG8_MMA(1, 0, At, B0); PG8_BAR; PG8_SCHED;
            PG8_STAGE(PG8_SB(0, 1), b2 + hstep, voffB);
            PG8_WAIT_V(6); PG8_BAR; PG8_MMA(1, 1, At, B1); PG8_BAR;
            PG8_LDB(B0, 1, 0); PG8_SCHED; PG8_LDA(At, 1, 0); PG8_STAGE(PG8_SA(0, 1), a2 + hstep, voffA);
            PG8_WAIT_L(8); PG8_BAR; PG8_WAIT_L(0); PG8_MMA(0, 0, At, B0); PG8_BAR; PG8_SCHED;
            PG8_LDB(B1, 1, 1); PG8_STAGE(PG8_SB(1, 0), b3, voffB);
            PG8_BAR; PG8_WAIT_L(0); PG8_MMA(0, 1, At, B1); PG8_BAR;
            PG8_LDA(At, 1, 1); PG8_STAGE(PG8_SA(1, 0), a3, voffA);
            PG8_BAR; PG8_WAIT_L(0); PG8_MMA(1, 0, At, B0); PG8_BAR; PG8_SCHED;
            PG8_STAGE(PG8_SB(1, 1), b3 + hstep, voffB);
            PG8_WAIT_V(6); PG8_BAR; PG8_MMA(1, 1, At, B1); PG8_BAR;
            }
        }
        if constexpr (ALIGN_EPI) { if (wr == 0) PG8_BAR; }
        if constexpr (!Epi::AFTER_DRAIN) { E(acc, cur, wr, wc, fr, fq); S.done(cur); }
        if (!has_next) break;
#pragma unroll
        for (int a = 0; a < 2; ++a)
#pragma unroll
            for (int b = 0; b < 2; ++b)
#pragma unroll
                for (int m = 0; m < 4; ++m)
#pragma unroll
                    for (int n = 0; n < 2; ++n) acc[a][b][m][n] = (f32x4){0.f, 0.f, 0.f, 0.f};
        cur = nxt; cA = nA; cB = nB; ++ui; if constexpr (GATHER) { pc0 = pn0; pc1 = pn1; }
        if constexpr (ALIGN_EPI) { if (wr == 1) PG8_BAR; }
    }
    PG8_WAIT_V(0);
    if constexpr (!ALIGN_EPI) { if (wr == 0) PG8_BAR; }
    PG8_BAR;
    if constexpr (Epi::AFTER_DRAIN) { E.fused(acc, cur, wr, wc, fr, fq, lds, wid, lane); S.done(cur); }
#undef PG8_SA
#undef PG8_SB
#undef PG8_STAGE
#undef PG8_STAGE_A
#undef PG8_TOKPACK
#undef PG8_LDA
#undef PG8_LDB
#undef PG8_MMA
#undef PG8_WAIT_V
#undef PG8_WAIT_L
#undef PG8_BAR
#undef PG8_SCHED
}
}

using pg8::Unit;
struct DenseSched { int nN, n, G, c;
    __device__ __forceinline__ void a_ready(const Unit&) const {}
    __device__ __forceinline__ void done(const Unit&) const {}
    __device__ __forceinline__ bool next(int i, Unit& u) const { const int L = i * G + c; if (L >= n) return false; u.pm = L / nN; u.pn = L % nN; return true; } };

__device__ __forceinline__ void store8bf(bf16* p, f32x4 lo, f32x4 hi) { u32x4 w; w.x = pk2(lo[0], lo[1]); w.y = pk2(lo[2], lo[3]); w.z = pk2(hi[0], hi[1]); w.w = pk2(hi[2], hi[3]); *(u32x4*)p = w; }
__device__ __forceinline__ void load8bf(const bf16* p, f32x4& lo, f32x4& hi) { const u32x4 w = *(const u32x4*)p;
    lo[0] = __uint_as_float(w.x << 16); lo[1] = __uint_as_float(w.x & 0xffff0000u); lo[2] = __uint_as_float(w.y << 16); lo[3] = __uint_as_float(w.y & 0xffff0000u);
    hi[0] = __uint_as_float(w.z << 16); hi[1] = __uint_as_float(w.z & 0xffff0000u); hi[2] = __uint_as_float(w.w << 16); hi[3] = __uint_as_float(w.w & 0xffff0000u); }
struct EpiZ { bf16 *ZR, *ZS, *ZG;
    __device__ __forceinline__ void one(int row, int col, f32x4 lo, f32x4 hi) const {
        if (col < RC) store8bf(ZR + (size_t)row * RC + col, lo, hi);
        else if (col < RC + 1024) { for (int e = 0; e < 4; ++e) { lo[e] = gelu_tanh(lo[e]); hi[e] = gelu_tanh(hi[e]); } store8bf(ZS + (size_t)row * 1024 + (col - RC), lo, hi); }
        else { for (int e = 0; e < 4; ++e) { lo[e] = sigmoidf_(lo[e]); hi[e] = sigmoidf_(hi[e]); } store8bf(ZG + (size_t)row * 2048 + (col - RC - 1024), lo, hi); } }
    __device__ __forceinline__ void operator()(int row, int col, f32x4 a0, f32x4 a1, f32x4 b0, f32x4 b1) const { one(row, col, a0, a1); one(row, col + 128, b0, b1); } };
struct EpiGA { const bf16* ZG; bf16* MP;
    __device__ __forceinline__ void one(int row, int col, f32x4 lo, f32x4 hi) const { f32x4 g0, g1; load8bf(ZG + (size_t)row * 2048 + col, g0, g1); store8bf(MP + (size_t)row * D + col, g0 * lo, g1 * hi); }
    __device__ __forceinline__ void operator()(int row, int col, f32x4 a0, f32x4 a1, f32x4 b0, f32x4 b1) const { one(row, col, a0, a1); one(row, col + 128, b0, b1); } };
struct EpiGB { const bf16* ZG; const bf16* MPin; bf16* MP;
    __device__ __forceinline__ void one(int row, int col, f32x4 lo, f32x4 hi) const { f32x4 g0, g1, m0, m1; load8bf(ZG + (size_t)row * 2048 + 1024 + col, g0, g1); load8bf(MPin + (size_t)row * D + col, m0, m1);
        store8bf(MP + (size_t)row * D + col, m0 + g0 * lo, m1 + g1 * hi); }
    __device__ __forceinline__ void operator()(int row, int col, f32x4 a0, f32x4 a1, f32x4 b0, f32x4 b1) const { one(row, col, a0, a1); one(row, col + 128, b0, b1); } };
struct EpiOut { const float* xin; bf16* tmp; const float* gate1;
    __device__ __forceinline__ void one(int row, int col, f32x4 lo, f32x4 hi) const { const f32x4 x0 = *(const f32x4*)(xin + (size_t)row * D + col), x1 = *(const f32x4*)(xin + (size_t)row * D + col + 4);
        const f32x4 g0 = *(const f32x4*)(gate1 + col), g1 = *(const f32x4*)(gate1 + col + 4); store8bf(tmp + (size_t)row * D + col, ALPHA * x0 + (1.0f + g0) * lo, ALPHA * x1 + (1.0f + g1) * hi); }
    __device__ __forceinline__ void operator()(int row, int col, f32x4 a0, f32x4 a1, f32x4 b0, f32x4 b1) const { one(row, col, a0, a1); one(row, col + 128, b0, b1); } };
struct EpiSwi { bf16* HID;
    __device__ __forceinline__ void operator()(int row, int col, f32x4 a0, f32x4 a1, f32x4 b0, f32x4 b1) const { const int ct = (col >> 8) & 3, cc = col & 127;
        f32x4 h0, h1; for (int e = 0; e < 4; ++e) { h0[e] = siluf_(a0[e]) * b0[e]; h1[e] = siluf_(a1[e]) * b1[e]; } store8bf(HID + (size_t)row * FF + ct * 128 + cc, h0, h1); } };
struct EpiDown { const int* S2T; const float* TOKW; bf16* Y;
    __device__ __forceinline__ void operator()(int row, int col, f32x4 a0, f32x4 a1, f32x4 b0, f32x4 b1) const { const u32x2 sw = *(const u32x2*)(S2T + 2 * row); const int st = (int)sw.x; if (st < 0) return; const float w = __uint_as_float(sw.y); const int cc = col & 1023;
        store8bf(Y + (size_t)st * D + cc, w * a0, w * a1); store8bf(Y + (size_t)st * D + cc + 128, w * b0, w * b1); } };

struct MoeSched { int ts[17]; int G, c;
    __device__ __forceinline__ void a_ready(const Unit&) const {}
    __device__ __forceinline__ void done(const Unit&) const {}
    __device__ __forceinline__ void init(const unsigned* cnt, int G_, int c_) { G = G_; c = c_; int s = 0;
#pragma unroll
        for (int e = 0; e < 16; ++e) { ts[e] = s; s += ((int)cnt[e] + 255) >> 8; } ts[16] = s; }
    __device__ __forceinline__ bool next(int i, Unit& u) const { const int L = i * G + c; if (L >= 4 * ts[16]) return false; const int rt = L >> 2, ct = L & 3; int e = 0;
#pragma unroll
        for (int j = 1; j < 16; ++j) e += (rt >= ts[j]) ? 1 : 0;
        u.pm = rt; u.pn = e * 4 + ct; return true; } };

__device__ __forceinline__ void phase_prep_simple(ArgsR a, const Ctx& c, int l) {
    const bf16* ZR = (const bf16*)(a.ws + WS_ZR);
    const float* mu = a.in[I_MU] + l * RC; const float* w0 = a.in[I_W0] + l * W; const float* w2 = a.in[I_W2] + (size_t)l * 64 * W;
    const float* a0 = a.in[I_A0] + l * W; const float* a2 = a.in[I_A2] + (size_t)l * 64 * W; const float* g2 = a.in[I_G2] + (size_t)l * 128 * W;
    const float* k_k = a.in[I_KK] + l * W; const float* k_a = a.in[I_KA] + l * W;
    const float* vm0 = a.in[I_VM0]; const float* vm1 = a.in[I_VM1]; const float* vm2 = a.in[I_VM2];
    f16* R = (f16*)(a.ws + WS_R); f16* WM1 = (f16*)(a.ws + WS_WM1); f16* KP = (f16*)(a.ws + WS_KP); f16* AA = (f16*)(a.ws + WS_AA); f16* BB = (f16*)(a.ws + WS_BB); f16* V = (f16*)(a.ws + WS_V);
    bf16* G = (bf16*)(a.ws + WS_G); bf16* VF = (bf16*)(a.ws + WS_VF);
    const int lane = c.lane;
    for (int t = c.gw; t < T; t += c.ngw) {
        float z[28];
#pragma unroll
        for (int i = 0; i < 28; ++i) { const int col = lane + 64 * i; const float zc = bf2f(ZR[(size_t)t * RC + col]); const float zp = t > 0 ? bf2f(ZR[(size_t)(t - 1) * RC + col]) : 0.f; z[i] = zc + (zp - zc) * mu[col]; }
        const float tw = tanhf(z[24]), za = z[25], sg0 = sigmoidf_(z[26]), sg1 = sigmoidf_(z[27]);
        float wlo[8], alo[8], gg[8];
#pragma unroll
        for (int i = 0; i < 8; ++i) { wlo[i] = 0.f; alo[i] = 0.f; gg[i] = 0.f; }
        for (int j = 0; j < 64; ++j) { const float tj = __shfl(tw, j), aj = __shfl(za, j), s0 = __shfl(sg0, j), s1 = __shfl(sg1, j);
#pragma unroll
            for (int i = 0; i < 8; ++i) { const int n = lane + 64 * i; wlo[i] += tj * w2[j * W + n]; alo[i] += aj * a2[j * W + n]; gg[i] += s0 * g2[j * W + n] + s1 * g2[(64 + j) * W + n]; } }
        float vv[8];
#pragma unroll
        for (int i = 0; i < 8; ++i) vv[i] = z[16 + i];
        if (l == 0) {
#pragma unroll
            for (int i = 0; i < 8; ++i) VF[(size_t)t * W + lane + 64 * i] = f2bf(vv[i]);
        } else {
            float vmid = 0.f;
#pragma unroll
            for (int i = 0; i < 8; ++i)
                for (int j = 0; j < 64; ++j) { const float vc = __shfl(vv[i], j); vmid += vc * vm1[(size_t)(64 * i + j) * 32 + (lane & 31)]; }
            float vg[8];
#pragma unroll
            for (int i = 0; i < 8; ++i) vg[i] = 0.f;
            for (int m = 0; m < 32; ++m) { const float vmm = __shfl(vmid, m);
#pragma unroll
                for (int i = 0; i < 8; ++i) vg[i] += vmm * vm2[m * W + lane + 64 * i]; }
#pragma unroll
            for (int i = 0; i < 8; ++i) { const int n = lane + 64 * i; const float vf = bf2f(VF[(size_t)t * W + n]); vv[i] = vv[i] + (vf - vv[i]) * sigmoidf_(vm0[n] + vg[i]); }
        }
#pragma unroll
        for (int i = 0; i < 8; ++i) {
            const int n = lane + 64 * i; const size_t o = (size_t)t * W + n;
            const float x = w0[n] + wlo[i]; const float wl = -softplusf_(-x) - 0.5f; const float dm1 = expm1f(-__expf(wl));
            const float av = sigmoidf_(a0[n] + alo[i]);
            const float kraw = z[8 + i];
            float kk = kraw * k_k[n]; const float nrm = sqrtf(wave_sum(kk * kk)); kk = kk / fmaxf(nrm, 1e-12f);
            const float kp = kraw * (1.0f + (av - 1.0f) * k_a[n]);
            R[o] = (f16)z[i]; WM1[o] = (f16)dm1; KP[o] = (f16)kp; AA[o] = (f16)(-kk); BB[o] = (f16)(kk * av); V[o] = (f16)vv[i]; G[o] = f2bf(gg[i]);
        }
    }
}

__device__ __forceinline__ void phase_sg_simple(ArgsR a, const Ctx& c, int l) {
    const bf16* ZS = (const bf16*)(a.ws + WS_ZS); bf16* YB = (bf16*)(a.ws + WS_YB);
    const float* lng = a.in[I_SGG] + l * W; const float* lnb = a.in[I_SGB] + l * W;
    float* vn = (float*)c.lds;
    float* st = vn + 128 * 64;
    for (int uidx = blockIdx.x; uidx < 128 * 8; uidx += gridDim.x) {
        const int ch = uidx >> 3, g = uidx & 7; const int tok0 = ch * 128;
        for (int i = 0; i < 16; ++i) { const int s = c.wave * 16 + i; const bf16* p = ZS + (size_t)(tok0 + s) * 1024 + 512 + c.lane * 8;
            const f32x4 x0 = load4bf(p), x1 = load4bf(p + 4);
            float sm = (x0[0] + x0[1]) + (x0[2] + x0[3]) + (x1[0] + x1[1]) + (x1[2] + x1[3]); const float mean = wave_sum(sm) * (1.f / 512.f);
            float q = 0.f; for (int e = 0; e < 4; ++e) { const float d0 = x0[e] - mean, d1 = x1[e] - mean; q += d0 * d0 + d1 * d1; }
            const float rstd = __builtin_amdgcn_rsqf(wave_sum(q) * (1.f / 512.f) + LN_EPS);
            if (c.lane == 0) { st[2 * s] = mean; st[2 * s + 1] = rstd; } }
        __syncthreads();
        for (int i = c.tid; i < 128 * 64; i += NTHREADS) { const int s = i >> 6, d = i & 63; const float x = bf2f(ZS[(size_t)(tok0 + s) * 1024 + 512 + g * 64 + d]);
            vn[i] = (x - st[2 * s]) * st[2 * s + 1] * lng[g * 64 + d] + lnb[g * 64 + d]; }
        __syncthreads();
        const int d = c.tid & 63, tq = c.tid >> 6;
        const float* Wg = a.in[I_WS] + (size_t)(l * 8 + g) * 128 * 128; const float* bs = a.in[I_BS] + (size_t)(l * 8 + g) * 128;
        for (int i = 0; i < 16; ++i) { const int t = tq + 8 * i; float acc = 0.f;
            for (int s = 0; s <= t; ++s) acc += Wg[t * 128 + s] * vn[s * 64 + d];
            const float u = bf2f(ZS[(size_t)(tok0 + t) * 1024 + g * 64 + d]);
            YB[(size_t)(tok0 + t) * W + g * 64 + d] = f2bf(u * (acc + bs[t])); }
        __syncthreads();
    }
}

#define LAS3 __attribute__((address_space(3)))
typedef short bf16x8 __attribute__((ext_vector_type(8)));
template <int MT, int NT, int KS, bool SWAP = false>
__device__ __forceinline__ void mma_lds_glob(const unsigned char* lds_base, int a_off_bytes, int lda, const bf16* Bt, int ldb, int n0, int lane, f32x4 (&acc)[MT][NT]) {
    const int fr = lane & 15, fq = lane >> 4;
    const LAS3 unsigned char* Ab = (const LAS3 unsigned char*)lds_base + a_off_bytes;
    int boff = (n0 + fr) * ldb + 8 * fq; asm volatile("" : "+v"(boff));
#pragma unroll
    for (int ks = 0; ks < KS; ++ks) {
        bf16x8 b[NT];
#pragma unroll
        for (int n = 0; n < NT; ++n) b[n] = *(const bf16x8*)(Bt + boff + 16 * n * ldb + 32 * ks);
#pragma unroll
        for (int m = 0; m < MT; ++m) { const bf16x8 av = *(const LAS3 bf16x8*)(Ab + ((16 * m + fr) * lda + 32 * ks + 8 * fq) * 2);
#pragma unroll
            for (int n = 0; n < NT; ++n) acc[m][n] = SWAP ? __builtin_amdgcn_mfma_f32_16x16x32_bf16(b[n], av, acc[m][n], 0, 0, 0) : __builtin_amdgcn_mfma_f32_16x16x32_bf16(av, b[n], acc[m][n], 0, 0, 0); }
    }
}
__device__ __forceinline__ void zshift8(const bf16* ZR, int t, int col, const float* mu, float (&o)[8]) {
    const u32x4 zc = *(const u32x4*)(ZR + (size_t)t * RC + col);
    u32x4 zp = {0u, 0u, 0u, 0u}; if (t > 0) zp = *(const u32x4*)(ZR + (size_t)(t - 1) * RC + col);
    const f32x4 m0 = *(const f32x4*)(mu + col), m1 = *(const f32x4*)(mu + col + 4);
#pragma unroll
    for (int e = 0; e < 4; ++e) { const float c0 = __uint_as_float(zc[e] << 16), c1 = __uint_as_float(zc[e] & 0xffff0000u), p0 = __uint_as_float(zp[e] << 16), p1 = __uint_as_float(zp[e] & 0xffff0000u);
        const float mu0 = (2 * e < 4) ? m0[(2 * e) & 3] : m1[(2 * e) & 3], mu1 = (2 * e + 1 < 4) ? m0[(2 * e + 1) & 3] : m1[(2 * e + 1) & 3];
        o[2 * e] = c0 + (p0 - c0) * mu0; o[2 * e + 1] = c1 + (p1 - c1) * mu1; }
}
typedef _Float16 f16x8 __attribute__((ext_vector_type(8)));
typedef _Float16 f16x4 __attribute__((ext_vector_type(4)));
__device__ __forceinline__ void store8f16(f16* p, const float (&v)[8]) { f16x8 h;
#pragma unroll
    for (int e = 0; e < 8; ++e) h[e] = (f16)v[e];
    *(f16x8*)p = h; }
__device__ __forceinline__ u32x4 pack8bf(const float (&v)[8]) { u32x4 w; w.x = pk2(v[0], v[1]); w.y = pk2(v[2], v[3]); w.z = pk2(v[4], v[5]); w.w = pk2(v[6], v[7]); return w; }


constexpr int PB_LD = 520;
constexpr int PB_BUF = 0, PB_AOP = 64 * PB_LD * 2, PB_VMID = 2 * 64 * PB_LD * 2, PB_LA_LD = 264, PB_VM_LD = 40;
__device__ __forceinline__ void phase_prep_fast(ArgsR a, const Ctx& c, int l) {
    const bf16* ZR = (const bf16*)(a.ws + WS_ZR);
    const float* mu = a.in[I_MU] + l * RC; const float* w0 = a.in[I_W0] + l * W; const float* a0 = a.in[I_A0] + l * W;
    const float* k_k = a.in[I_KK] + l * W; const float* k_a = a.in[I_KA] + l * W; const float* vm0 = a.in[I_VM0];
    f16* R = (f16*)(a.ws + WS_R); f16* WM1 = (f16*)(a.ws + WS_WM1); f16* KP = (f16*)(a.ws + WS_KP); f16* AA = (f16*)(a.ws + WS_AA); f16* BB = (f16*)(a.ws + WS_BB); f16* V = (f16*)(a.ws + WS_V);
    bf16* G = (bf16*)(a.ws + WS_G); bf16* VF = (bf16*)(a.ws + WS_VF);
    const unsigned char* lo = a.ws + WS_LORA + (size_t)l * LO_STRIDE;
    const bf16* W2T = (const bf16*)(lo + LO_W2T); const bf16* A2T = (const bf16*)(lo + LO_A2T); const bf16* G2T = (const bf16*)(lo + LO_G2T);
    const bf16* VM1T = (const bf16*)(lo + LO_VM1T); const bf16* VM2T = (const bf16*)(lo + LO_VM2T);
    LAS3 unsigned char* L = (LAS3 unsigned char*)c.lds;
    const int tid = c.tid, lane = c.lane, wv = c.wave, fr = lane & 15, fq = lane >> 4;
    const int row = tid >> 3, sub_ = tid & 7;
    for (int u = blockIdx.x; u < T / 64; u += gridDim.x) {
        int sub = sub_; asm volatile("" : "+v"(sub));
        const int t0 = u * 64, t = t0 + row;
        if (l == 0) {
#pragma unroll 4
            for (int p = 0; p < 8; ++p) { const int col = p * 64 + sub * 8; float z[8]; zshift8(ZR, t, 1024 + col, mu, z);
                store8f16(V + (size_t)t * W + col, z); *(u32x4*)(VF + (size_t)t * W + col) = pack8bf(z); }
        } else {
#pragma unroll 4
            for (int p = 0; p < 8; ++p) { const int col = p * 64 + sub * 8; float z[8]; zshift8(ZR, t, 1024 + col, mu, z);
                *(LAS3 u32x4*)(L + PB_AOP + (row * PB_LD + col) * 2) = pack8bf(z); }
            __syncthreads();
            { f32x4 acc[1][1]; acc[0][0] = (f32x4){0.f, 0.f, 0.f, 0.f}; const int m = wv >> 1, n = wv & 1;
              mma_lds_glob<1, 1, 16>(c.lds, PB_AOP + 16 * m * PB_LD * 2, PB_LD, VM1T, W, 16 * n, lane, acc);
#pragma unroll
              for (int i = 0; i < 4; ++i) *(LAS3 bf16*)(L + PB_VMID + ((16 * m + 4 * fq + i) * PB_VM_LD + 16 * n + fr) * 2) = f2bf(acc[0][0][i]); }
            __syncthreads();
            { f32x4 acc[4][4];
#pragma unroll
              for (int m = 0; m < 4; ++m)
#pragma unroll
                  for (int n = 0; n < 4; ++n) acc[m][n] = (f32x4){0.f, 0.f, 0.f, 0.f};
              mma_lds_glob<4, 4, 1, true>(c.lds, PB_VMID, PB_VM_LD, VM2T, 32, 64 * wv, lane, acc);
#pragma unroll
              for (int m = 0; m < 4; ++m)
#pragma unroll
                  for (int n = 0; n < 4; ++n) { const int col = 64 * wv + 16 * n + 4 * fq; const f32x4 vb = *(const f32x4*)(vm0 + col); f16x4 hv;
#pragma unroll
                      for (int i = 0; i < 4; ++i) hv[i] = (f16)sigmoidf_(vb[i] + acc[m][n][i]);
                      *(LAS3 f16x4*)(L + PB_BUF + ((16 * m + fr) * PB_LD + col) * 2) = hv; } }
            __syncthreads();
#pragma unroll 4
            for (int p = 0; p < 8; ++p) { const int col = p * 64 + sub * 8;
                const u32x4 vz = *(const LAS3 u32x4*)(L + PB_AOP + (row * PB_LD + col) * 2); const f16x8 gt = *(const LAS3 f16x8*)(L + PB_BUF + (row * PB_LD + col) * 2);
                const u32x4 vfw = *(const u32x4*)(VF + (size_t)t * W + col); float o[8];
#pragma unroll
                for (int e = 0; e < 4; ++e) { const float v0 = __uint_as_float(vz[e] << 16), v1 = __uint_as_float(vz[e] & 0xffff0000u), f0 = __uint_as_float(vfw[e] << 16), f1 = __uint_as_float(vfw[e] & 0xffff0000u);
                    o[2 * e] = v0 + (f0 - v0) * (float)gt[2 * e]; o[2 * e + 1] = v1 + (f1 - v1) * (float)gt[2 * e + 1]; }
                store8f16(V + (size_t)t * W + col, o); }
            __syncthreads();
        }
#pragma unroll 4
        for (int p = 0; p < 4; ++p) { const int cc = sub * 32 + p * 8; float z[8]; zshift8(ZR, t, 1536 + cc, mu, z);
#pragma unroll
            for (int e = 0; e < 8; ++e) z[e] = cc < 64 ? (1.0f - 2.0f * __builtin_amdgcn_rcpf(1.0f + __expf(2.0f * z[e]))) : (cc < 128 ? z[e] : sigmoidf_(z[e]));
            *(LAS3 u32x4*)(L + PB_AOP + (row * PB_LA_LD + cc) * 2) = pack8bf(z); }
        __syncthreads();
        { f32x4 acc[4][4];
#pragma unroll
          for (int m = 0; m < 4; ++m)
#pragma unroll
              for (int n = 0; n < 4; ++n) acc[m][n] = (f32x4){0.f, 0.f, 0.f, 0.f};
          mma_lds_glob<4, 4, 2, true>(c.lds, PB_AOP + 64 * 2, PB_LA_LD, A2T, 64, 64 * wv, lane, acc);
#pragma unroll
          for (int m = 0; m < 4; ++m)
#pragma unroll
              for (int n = 0; n < 4; ++n) { const int col = 64 * wv + 16 * n + 4 * fq; const f32x4 ab = *(const f32x4*)(a0 + col); f16x4 hv;
#pragma unroll
                  for (int i = 0; i < 4; ++i) hv[i] = (f16)sigmoidf_(ab[i] + acc[m][n][i]);
                  *(LAS3 f16x4*)(L + PB_BUF + ((16 * m + fr) * PB_LD + col) * 2) = hv; } }
        __syncthreads();
#pragma unroll 4
        for (int p = 0; p < 8; ++p) { const int col = p * 64 + sub * 8; const size_t o = (size_t)t * W + col;
            float z[8]; zshift8(ZR, t, col, mu, z); store8f16(R + o, z);
            float kz[8]; zshift8(ZR, t, 512 + col, mu, kz);
            const f16x8 av = *(const LAS3 f16x8*)(L + PB_BUF + (row * PB_LD + col) * 2);
            const f32x4 kk0 = *(const f32x4*)(k_k + col), kk1 = *(const f32x4*)(k_k + col + 4), ka0 = *(const f32x4*)(k_a + col), ka1 = *(const f32x4*)(k_a + col + 4);
            float kk[8], kp[8], bb[8]; float ss = 0.f;
#pragma unroll
            for (int e = 0; e < 8; ++e) { const float kkw = e < 4 ? kk0[e & 3] : kk1[e & 3], kaw = e < 4 ? ka0[e & 3] : ka1[e & 3]; kk[e] = kz[e] * kkw; ss += kk[e] * kk[e]; kp[e] = kz[e] * (1.0f + ((float)av[e] - 1.0f) * kaw); }
            ss += __shfl_xor(ss, 1); ss += __shfl_xor(ss, 2); ss += __shfl_xor(ss, 4);
            const float inv = fminf(__builtin_amdgcn_rsqf(ss), 1e12f);
#pragma unroll
            for (int e = 0; e < 8; ++e) { kk[e] *= inv; bb[e] = kk[e] * (float)av[e]; kk[e] = -kk[e]; }
            store8f16(KP + o, kp); store8f16(AA + o, kk); store8f16(BB + o, bb); }
        __syncthreads();
        { f32x4 acc[4][4];
#pragma unroll
          for (int m = 0; m < 4; ++m)
#pragma unroll
              for (int n = 0; n < 4; ++n) acc[m][n] = (f32x4){0.f, 0.f, 0.f, 0.f};
          mma_lds_glob<4, 4, 2, true>(c.lds, PB_AOP, PB_LA_LD, W2T, 64, 64 * wv, lane, acc);
#pragma unroll
          for (int m = 0; m < 4; ++m)
#pragma unroll
              for (int n = 0; n < 4; ++n) { const int col = 64 * wv + 16 * n + 4 * fq; const f32x4 wb = *(const f32x4*)(w0 + col); f16x4 hv;
#pragma unroll
                  for (int i = 0; i < 4; ++i) { const float x = wb[i] + acc[m][n][i]; const float wl = -(fmaxf(-x, 0.f) + __logf(1.0f + __expf(-fabsf(x)))) - 0.5f;
                      hv[i] = (f16)(__expf(-__expf(wl)) - 1.0f); }
                  *(LAS3 f16x4*)(L + PB_BUF + ((16 * m + fr) * PB_LD + col) * 2) = hv; } }
        __syncthreads();
#pragma unroll 4
        for (int p = 0; p < 8; ++p) { const int col = p * 64 + sub * 8; *(u32x4*)(WM1 + (size_t)t * W + col) = *(const LAS3 u32x4*)(L + PB_BUF + (row * PB_LD + col) * 2); }
        __syncthreads();
        { f32x4 acc[4][4];
#pragma unroll
          for (int m = 0; m < 4; ++m)
#pragma unroll
              for (int n = 0; n < 4; ++n) acc[m][n] = (f32x4){0.f, 0.f, 0.f, 0.f};
          mma_lds_glob<4, 4, 4, true>(c.lds, PB_AOP + 128 * 2, PB_LA_LD, G2T, 128, 64 * wv, lane, acc);
#pragma unroll
          for (int m = 0; m < 4; ++m)
#pragma unroll
              for (int n = 0; n < 4; ++n) { const int col = 64 * wv + 16 * n + 4 * fq; u32x2 w; w.x = pk2(acc[m][n][0], acc[m][n][1]); w.y = pk2(acc[m][n][2], acc[m][n][3]);
                  *(LAS3 u32x2*)(L + PB_BUF + ((16 * m + fr) * PB_LD + col) * 2) = w; } }
        __syncthreads();
#pragma unroll 4
        for (int p = 0; p < 8; ++p) { const int col = p * 64 + sub * 8; *(u32x4*)(G + (size_t)t * W + col) = *(const LAS3 u32x4*)(L + PB_BUF + (row * PB_LD + col) * 2); }
        __syncthreads();
    }
}

constexpr int SG_LD = 136;
constexpr int SG_VT = 0, SG_ST = 256 * SG_LD * 2;
__device__ __forceinline__ void phase_sg_fast(ArgsR a, const Ctx& c, int l) {
    const bf16* ZS = (const bf16*)(a.ws + WS_ZS); bf16* YB = (bf16*)(a.ws + WS_YB);
    const float* lng = a.in[I_SGG] + l * W; const float* lnb = a.in[I_SGB] + l * W;
    LAS3 unsigned char* L = (LAS3 unsigned char*)c.lds;
    LAS3 float* st = (LAS3 float*)(L + SG_ST);
    const int tid = c.tid, lane = c.lane, wv = c.wave, fr = lane & 15, fq = lane >> 4;
    for (int u = blockIdx.x; u < 256; u += gridDim.x) {
        const int ch = u >> 1, hf = u & 1, tok0 = ch * 128;
        { u32x4 raw[16];
#pragma unroll
          for (int i = 0; i < 16; ++i) raw[i] = *(const u32x4*)(ZS + (size_t)(tok0 + wv * 16 + i) * 1024 + 512 + lane * 8);
#pragma unroll
          for (int i = 0; i < 16; ++i) { const int sidx = wv * 16 + i; float x[8];
#pragma unroll
              for (int e = 0; e < 4; ++e) { x[2 * e] = __uint_as_float(raw[i][e] << 16); x[2 * e + 1] = __uint_as_float(raw[i][e] & 0xffff0000u); }
              const float sm = ((x[0] + x[1]) + (x[2] + x[3])) + ((x[4] + x[5]) + (x[6] + x[7])); const float mean = wave_sum(sm) * (1.f / 512.f);
              float q = 0.f;
#pragma unroll
              for (int e = 0; e < 8; ++e) { const float d0 = x[e] - mean; q += d0 * d0; }
              const float rstd = __builtin_amdgcn_rsqf(wave_sum(q) * (1.f / 512.f) + LN_EPS);
              if (lane == 0) { st[2 * sidx] = mean; st[2 * sidx + 1] = rstd; } } }
        __syncthreads();
        { const int sidx = tid >> 2, q4 = tid & 3; const float mean = st[2 * sidx], rstd = st[2 * sidx + 1];
#pragma unroll
          for (int p = 0; p < 8; ++p) { const int cl = q4 * 64 + p * 8; const int cg = hf * 256 + cl;
              const bf16* src = ZS + (size_t)(tok0 + sidx) * 1024 + 512 + cg; const f32x4 x0 = load4bf(src), x1 = load4bf(src + 4);
              const f32x4 g0 = *(const f32x4*)(lng + cg), g1 = *(const f32x4*)(lng + cg + 4), b0 = *(const f32x4*)(lnb + cg), b1 = *(const f32x4*)(lnb + cg + 4);
#pragma unroll
              for (int e = 0; e < 8; ++e) { const float x = e < 4 ? x0[e & 3] : x1[e & 3], gg = e < 4 ? g0[e & 3] : g1[e & 3], bb = e < 4 ? b0[e & 3] : b1[e & 3];
                  *(LAS3 bf16*)(L + SG_VT + ((cl + e) * SG_LD + sidx) * 2) = f2bf((x - mean) * rstd * gg + bb); } } }
        __syncthreads();
        const int gl = wv >> 1, dh = wv & 1, g = hf * 4 + gl;
        const float* Wg = a.in[I_WS] + (size_t)(l * 8 + g) * 128 * 128; const float* bs = a.in[I_BS] + (size_t)(l * 8 + g) * 128;
        f32x4 acc[8][2];
#pragma unroll
        for (int m = 0; m < 8; ++m) { acc[m][0] = (f32x4){0.f, 0.f, 0.f, 0.f}; acc[m][1] = (f32x4){0.f, 0.f, 0.f, 0.f}; }
#pragma unroll
        for (int ks = 0; ks < 4; ++ks) {
            bf16x8 b[2];
#pragma unroll
            for (int n = 0; n < 2; ++n) b[n] = *(const LAS3 bf16x8*)(L + SG_VT + ((gl * 64 + dh * 32 + 16 * n + fr) * SG_LD + 32 * ks + 8 * fq) * 2);
#pragma unroll
            for (int m = 0; m < 8; ++m) { if (32 * ks <= 16 * m + 15) {
                const int trow = 16 * m + fr, s0 = 32 * ks + 8 * fq;
                const f32x4 w0v = *(const f32x4*)(Wg + trow * 128 + s0), w1v = *(const f32x4*)(Wg + trow * 128 + s0 + 4);
                float wf[8];
#pragma unroll
                for (int e = 0; e < 8; ++e) { const float wval = e < 4 ? w0v[e & 3] : w1v[e & 3]; wf[e] = (s0 + e <= trow) ? wval : 0.f; }
                const u32x4 wp = pack8bf(wf); const bf16x8 av = __builtin_bit_cast(bf16x8, wp);
                acc[m][0] = __builtin_amdgcn_mfma_f32_16x16x32_bf16(b[0], av, acc[m][0], 0, 0, 0);
                acc[m][1] = __builtin_amdgcn_mfma_f32_16x16x32_bf16(b[1], av, acc[m][1], 0, 0, 0); } }
        }
#pragma unroll
        for (int m = 0; m < 8; ++m) { const int trow = 16 * m + fr; const float bsv = bs[trow];
#pragma unroll
            for (int n = 0; n < 2; ++n) { const int col = g * 64 + dh * 32 + 16 * n + 4 * fq; const f32x4 uu = load4bf(ZS + (size_t)(tok0 + trow) * 1024 + col);
                store4bf(YB + (size_t)(tok0 + trow) * W + col, uu * (acc[m][n] + bsv)); } }
        __syncthreads();
    }
}

__device__ __forceinline__ void phase_scan_simple(ArgsR a, const Ctx& c) {
    if (c.wave != 0 || blockIdx.x >= NH) return;
    const int h = blockIdx.x, lane = c.lane;
    const f16* R = (const f16*)(a.ws + WS_R); const f16* WM1 = (const f16*)(a.ws + WS_WM1); const f16* KP = (const f16*)(a.ws + WS_KP);
    const f16* AA = (const f16*)(a.ws + WS_AA); const f16* BB = (const f16*)(a.ws + WS_BB); const f16* V = (const f16*)(a.ws + WS_V);
    bf16* YSC = (bf16*)(a.ws + WS_YSC);
    float S[64];
#pragma unroll
    for (int j = 0; j < 64; ++j) S[j] = 0.f;
    for (int t = 0; t < T; ++t) {
        const size_t base = (size_t)t * W + h * 64;
        const float vv = (float)V[base + lane];
        float sa = 0.f;
#pragma unroll
        for (int j = 0; j < 64; ++j) sa += S[j] * (float)AA[base + j];
        float y = 0.f;
#pragma unroll
        for (int j = 0; j < 64; ++j) { float s = S[j]; s = s + s * (float)WM1[base + j]; s += sa * (float)BB[base + j]; s += vv * (float)KP[base + j]; S[j] = s; y += s * (float)R[base + j]; }
        YSC[base + lane] = f2bf(y);
    }
}

typedef unsigned u32x16 __attribute__((ext_vector_type(16)));
__device__ __forceinline__ void sload32(const void* p0, u32x16& a0, u32x16& a1) {
    asm volatile("s_load_dwordx16 %0, %2, 0x0 glc\n\ts_load_dwordx16 %1, %2, 0x40 glc\n\ts_waitcnt lgkmcnt(0)" : "=&s"(a0), "=&s"(a1) : "s"(p0) : "memory");
}
__device__ __forceinline__ void sload64(const void* p0, const void* p1, u32x16& a0, u32x16& a1, u32x16& b0, u32x16& b1) {
    asm volatile("s_load_dwordx16 %0, %4, 0x0 glc\n\ts_load_dwordx16 %1, %4, 0x40 glc\n\ts_load_dwordx16 %2, %5, 0x0 glc\n\ts_load_dwordx16 %3, %5, 0x40 glc\n\ts_waitcnt lgkmcnt(0)"
                 : "=&s"(a0), "=&s"(a1), "=&s"(b0), "=&s"(b1) : "s"(p0), "s"(p1) : "memory");
}
__device__ __forceinline__ float fmix_lo(unsigned sd, float x, float y) { float d; asm("v_fma_mix_f32 %0, %1, %2, %3 op_sel_hi:[1,0,0]" : "=v"(d) : "s"(sd), "v"(x), "v"(y)); return d; }
__device__ __forceinline__ float fmix_hi(unsigned sd, float x, float y) { float d; asm("v_fma_mix_f32 %0, %1, %2, %3 op_sel:[1,0,0] op_sel_hi:[1,0,0]" : "=v"(d) : "s"(sd), "v"(x), "v"(y)); return d; }
constexpr int CL = 64, NCH = T / CL;
constexpr size_t ST_Q_OFF = (size_t)NH * NCH * 64 * 64;
constexpr size_t ST_S_OFF = (size_t)NH * NCH * 64 * 64;

__device__ __forceinline__ float vmix_lo(unsigned vd, float x, float y) { float d; asm("v_fma_mix_f32 %0, %1, %2, %3 op_sel_hi:[1,0,0]" : "=v"(d) : "v"(vd), "v"(x), "v"(y)); return d; }
__device__ __forceinline__ float vmix_hi(unsigned vd, float x, float y) { float d; asm("v_fma_mix_f32 %0, %1, %2, %3 op_sel:[1,0,0] op_sel_hi:[1,0,0]" : "=v"(d) : "v"(vd), "v"(x), "v"(y)); return d; }
template <int N> __device__ __forceinline__ void fmac_bc(float& acc, float vec, float x) { asm("v_fmac_f32_dpp %0, %1, %2 row_newbcast:%3 row_mask:0xf bank_mask:0xf" : "+v"(acc) : "v"(vec), "v"(x), "n"(N)); }
template <int N> __device__ __forceinline__ float mul_bc(float vec, float x) { float d; asm("v_mul_f32_dpp %0, %1, %2 row_newbcast:%3 row_mask:0xf bank_mask:0xf" : "=v"(d) : "v"(vec), "v"(x), "n"(N)); return d; }
struct SVec { float v[4]; };
__device__ __forceinline__ f16x4 sv_read(const LAS3 unsigned char* p, int lane) { return *(const LAS3 f16x4*)(p + (lane & 15) * 8); }
__device__ __forceinline__ void sv_cvt(SVec& o, f16x4 h) { o.v[0] = (float)h[0]; o.v[1] = (float)h[1]; o.v[2] = (float)h[2]; o.v[3] = (float)h[3]; }
__device__ __forceinline__ void sv_cvt1p(SVec& o, f16x4 h) { o.v[0] = 1.0f + (float)h[0]; o.v[1] = 1.0f + (float)h[1]; o.v[2] = 1.0f + (float)h[2]; o.v[3] = 1.0f + (float)h[3]; }
template <int J> __device__ __forceinline__ void sc_dot(float (&d)[4], const SVec& A, const float (&X)[64]) { fmac_bc<(J >> 2)>(d[J & 3], A.v[J & 3], X[J]); if constexpr (J + 1 < 64) sc_dot<J + 1>(d, A, X); }
template <int J> __device__ __forceinline__ void sc_upd3(float (&S)[64], float (&y)[4], const SVec& Wv, const SVec& Bv, const SVec& Kv, const SVec& Rv, float sa, float vv) {
    float sj = mul_bc<(J >> 2)>(Wv.v[J & 3], S[J]); fmac_bc<(J >> 2)>(sj, Bv.v[J & 3], sa); fmac_bc<(J >> 2)>(sj, Kv.v[J & 3], vv); S[J] = sj; fmac_bc<(J >> 2)>(y[J & 3], Rv.v[J & 3], sj);
    if constexpr (J + 1 < 64) sc_upd3<J + 1>(S, y, Wv, Bv, Kv, Rv, sa, vv); }
template <int J> __device__ __forceinline__ void sc_upd1(float (&Q)[64], float (&P)[64], const SVec& Wv, const SVec& Bv, const SVec& Kv, float saq, float sap, float vv) {
    float qj = mul_bc<(J >> 2)>(Wv.v[J & 3], Q[J]); fmac_bc<(J >> 2)>(qj, Bv.v[J & 3], saq); fmac_bc<(J >> 2)>(qj, Kv.v[J & 3], vv); Q[J] = qj;
    float pj = mul_bc<(J >> 2)>(Wv.v[J & 3], P[J]); fmac_bc<(J >> 2)>(pj, Bv.v[J & 3], sap); P[J] = pj;
    if constexpr (J + 1 < 64) sc_upd1<J + 1>(Q, P, Wv, Bv, Kv, saq, sap, vv); }
constexpr int SCB = 8;
constexpr int SC_NS = 7, SC_BUF = SC_NS * 1024, SC_WAVE = 2 * SC_BUF;
__device__ __forceinline__ void sc_dma(const f16* X, size_t eoff, LAS3 unsigned char* dst) {
    __builtin_amdgcn_global_load_lds((const unsigned*)(X + eoff), (LAS3 unsigned*)dst, 16, 0, 0);
}

__device__ __forceinline__ void phase_scan1(ArgsR a, const Ctx& c) {
    const f16* WM1 = (const f16*)(a.ws + WS_WM1); const f16* KP = (const f16*)(a.ws + WS_KP);
    const f16* AA = (const f16*)(a.ws + WS_AA); const f16* BB = (const f16*)(a.ws + WS_BB); const f16* V = (const f16*)(a.ws + WS_V);
    float* ST = (float*)(a.ws + WS_ST);
    const int lane = c.lane;
    LAS3 unsigned char* ring = (LAS3 unsigned char*)c.lds + c.wave * SC_WAVE;
    for (int item = c.gw; item < NH * NCH; item += c.ngw) {
        const int h = __builtin_amdgcn_readfirstlane(item / NCH), ch = __builtin_amdgcn_readfirstlane(item % NCH);
        float Q[64], P[64];
        int ln_ = lane; asm volatile("" : "+v"(ln_));
#pragma unroll
        for (int j = 0; j < 64; ++j) { Q[j] = 0.f; P[j] = (j == ln_) ? 1.f : 0.f; }
        const size_t lane_off = (size_t)(lane >> 3) * W + h * 64 + (lane & 7) * 8;
        { const size_t e0 = (size_t)(ch * CL) * W + lane_off;
          sc_dma(AA, e0, ring); sc_dma(WM1, e0, ring + 1024); sc_dma(BB, e0, ring + 2048); sc_dma(KP, e0, ring + 3072); sc_dma(V, e0, ring + 4096); }
#pragma unroll 1
        for (int blk = 0; blk < CL / SCB; ++blk) {
            LAS3 unsigned char* buf = ring + (blk & 1) * SC_BUF;
            if (blk + 1 < CL / SCB) { LAS3 unsigned char* nb = ring + ((blk + 1) & 1) * SC_BUF; const size_t e0 = (size_t)(ch * CL + (blk + 1) * SCB) * W + lane_off;
                sc_dma(AA, e0, nb); sc_dma(WM1, e0, nb + 1024); sc_dma(BB, e0, nb + 2048); sc_dma(KP, e0, nb + 3072); sc_dma(V, e0, nb + 4096);
                asm volatile("s_waitcnt vmcnt(5)" ::: "memory"); }
            else asm volatile("s_waitcnt vmcnt(0)" ::: "memory");
            SVec A, Wv, Bv, Kv;
            sv_cvt(A, sv_read(buf, lane)); sv_cvt1p(Wv, sv_read(buf + 1024, lane)); sv_cvt(Bv, sv_read(buf + 2048, lane)); sv_cvt(Kv, sv_read(buf + 3072, lane));
            float vv = (float)*(const LAS3 f16*)(buf + 4096 + lane * 2);
#pragma unroll 1
            for (int st = 0; st < SCB; ++st) {
                const LAS3 unsigned char* sn = buf + ((st + 1 < SCB) ? st + 1 : st) * 128;
                const f16x4 ha = sv_read(sn, lane), hw = sv_read(sn + 1024, lane), hb = sv_read(sn + 2048, lane), hk = sv_read(sn + 3072, lane);
                const f16 hv = *(const LAS3 f16*)(sn + 4096 + lane * 2);
                float dq[4] = {0.f, 0.f, 0.f, 0.f}, dp[4] = {0.f, 0.f, 0.f, 0.f};
                sc_dot<0>(dq, A, Q); sc_dot<0>(dp, A, P);
                const float saq = (dq[0] + dq[1]) + (dq[2] + dq[3]), sap = (dp[0] + dp[1]) + (dp[2] + dp[3]);
                sc_upd1<0>(Q, P, Wv, Bv, Kv, saq, sap, vv);
                sv_cvt(A, ha); sv_cvt1p(Wv, hw); sv_cvt(Bv, hb); sv_cvt(Kv, hk); vv = (float)hv;
            }
        }
        float* Qp = ST + ST_Q_OFF + (size_t)(h * NCH + ch) * 4096 + lane;
        bf16* PTp = (bf16*)ST + (size_t)(h * NCH + ch) * 4096 + lane;
#pragma unroll
        for (int j = 0; j < 64; ++j) { PTp[j * 64] = f2bf(P[j]); Qp[j * 64] = Q[j]; }
    }
}
constexpr int GS = 16, NG = NCH / GS;
constexpr size_t ST_LP_OFF = (size_t)NH * NCH * 4096;
constexpr size_t WS_SG = WS_LORA + 2 * MiB;
constexpr int HI_LD = 72, HI_BYTES = 64 * HI_LD * 2;
struct HFrag { bf16x8 b[2][2]; f32x4 q[2]; };
__device__ __forceinline__ void hload(HFrag& f, const bf16* Bt, const float* QTc, int boff, int qtoff) {
#pragma unroll
    for (int ks = 0; ks < 2; ++ks)
#pragma unroll
        for (int n = 0; n < 2; ++n) f.b[ks][n] = *(const bf16x8*)(Bt + boff + 16 * n * 64 + 32 * ks);
#pragma unroll
    for (int n = 0; n < 2; ++n) f.q[n] = *(const f32x4*)(QTc + qtoff + 16 * n * 64);
}
__device__ __forceinline__ void hmma(const LAS3 unsigned char* img, const bf16x8 (&b)[2][2], f32x4 (&acc)[2], int m, int fr, int fq) {
#pragma unroll
    for (int ks = 0; ks < 2; ++ks) { const bf16x8 av = *(const LAS3 bf16x8*)(img + ((16 * m + fr) * HI_LD + 32 * ks + 8 * fq) * 2);
#pragma unroll
        for (int n = 0; n < 2; ++n) acc[n] = __builtin_amdgcn_mfma_f32_16x16x32_bf16(av, b[ks][n], acc[n], 0, 0, 0); }
}
__device__ __forceinline__ void himg_store(LAS3 unsigned char* img, const f32x4 (&acc)[2], int m, int n0, int fr, int fq) {
#pragma unroll
    for (int n = 0; n < 2; ++n)
#pragma unroll
        for (int i = 0; i < 4; ++i) *(LAS3 bf16*)(img + ((16 * m + 4 * fq + i) * HI_LD + n0 + 16 * n + fr) * 2) = f2bf(acc[n][i]);
}
#define HBAR() do { asm volatile("s_waitcnt lgkmcnt(0)" ::: "memory"); __builtin_amdgcn_s_barrier(); asm volatile("" ::: "memory"); } while (0)

__device__ __forceinline__ void sc2a_step(const HFrag& f, bf16* LpTc, float* QTc, const LAS3 unsigned char* ip, LAS3 unsigned char* ipn, const LAS3 unsigned char* iq, LAS3 unsigned char* iqn, int m, int n0, int fr, int fq, int qtoff) {
    f32x4 ap[2], aq[2];
#pragma unroll
    for (int n = 0; n < 2; ++n) { ap[n] = (f32x4){0.f, 0.f, 0.f, 0.f}; aq[n] = f.q[n]; }
    hmma(ip, f.b, ap, m, fr, fq); hmma(iq, f.b, aq, m, fr, fq);
#pragma unroll
    for (int n = 0; n < 2; ++n) { u32x2 w; w.x = pk2(ap[n][0], ap[n][1]); w.y = pk2(ap[n][2], ap[n][3]);
        *(u32x2*)(LpTc + (n0 + 16 * n + fr) * 64 + 16 * m + 4 * fq) = w;
        *(f32x4*)(QTc + qtoff + 16 * n * 64) = aq[n]; }
    himg_store(ipn, ap, m, n0, fr, fq); himg_store(iqn, aq, m, n0, fr, fq);
    HBAR();
}
__device__ __forceinline__ void phase_scan2a(ArgsR a, const Ctx& c) {
    const int lane = c.lane, wv = c.wave, fr = lane & 15, fq = lane >> 4, m = wv >> 1, n0 = 32 * (wv & 1);
    const int boff = (n0 + fr) * 64 + 8 * fq, qtoff = (n0 + fr) * 64 + 16 * m + 4 * fq;
    LAS3 unsigned char* L = (LAS3 unsigned char*)c.lds;
    for (int item = blockIdx.x; item < NH * NG; item += gridDim.x) {
        const size_t cb = (size_t)(item / NG) * NCH + (size_t)(item % NG) * GS;
        const bf16* PT = (const bf16*)(a.ws + WS_ST) + cb * 4096; bf16* LP = (bf16*)(a.ws + WS_ST) + ST_LP_OFF + cb * 4096; float* QT = (float*)(a.ws + WS_ST) + ST_Q_OFF + cb * 4096;
        for (int i = c.tid; i < 4 * HI_BYTES / 4; i += NTHREADS) ((LAS3 unsigned*)L)[i] = 0u;
        __syncthreads();
        if (c.tid < 64) *(LAS3 bf16*)(L + (c.tid * HI_LD + c.tid) * 2) = (bf16)0x3F80;
        __syncthreads();
        HFrag f0, f1, f2, f3;
        hload(f0, PT, QT, boff, qtoff); hload(f1, PT + 4096, QT + 4096, boff, qtoff); hload(f2, PT + 2 * 4096, QT + 2 * 4096, boff, qtoff); hload(f3, PT + 3 * 4096, QT + 3 * 4096, boff, qtoff);
        LAS3 unsigned char* p0 = L; LAS3 unsigned char* p1 = L + HI_BYTES; LAS3 unsigned char* q0 = L + 2 * HI_BYTES; LAS3 unsigned char* q1 = L + 3 * HI_BYTES;
#pragma unroll 1
        for (int i = 0; i < GS; i += 4) {
            const int nx = (i + 4 < GS) ? i + 4 : i;
            sc2a_step(f0, LP + (size_t)(i + 0) * 4096, QT + (size_t)(i + 0) * 4096, p0, p1, q0, q1, m, n0, fr, fq, qtoff); hload(f0, PT + (size_t)(nx + 0) * 4096, QT + (size_t)(nx + 0) * 4096, boff, qtoff);
            sc2a_step(f1, LP + (size_t)(i + 1) * 4096, QT + (size_t)(i + 1) * 4096, p1, p0, q1, q0, m, n0, fr, fq, qtoff); hload(f1, PT + (size_t)(nx + 1) * 4096, QT + (size_t)(nx + 1) * 4096, boff, qtoff);
            sc2a_step(f2, LP + (size_t)(i + 2) * 4096, QT + (size_t)(i + 2) * 4096, p0, p1, q0, q1, m, n0, fr, fq, qtoff); hload(f2, PT + (size_t)(nx + 2) * 4096, QT + (size_t)(nx + 2) * 4096, boff, qtoff);
            sc2a_step(f3, LP + (size_t)(i + 3) * 4096, QT + (size_t)(i + 3) * 4096, p1, p0, q1, q0, m, n0, fr, fq, qtoff); hload(f3, PT + (size_t)(nx + 3) * 4096, QT + (size_t)(nx + 3) * 4096, boff, qtoff);
        }
        __syncthreads();
    }
}
__device__ __forceinline__ void phase_scan2b(ArgsR a, const Ctx& c) {
    if (blockIdx.x >= NH) return;
    const int h = blockIdx.x, lane = c.lane, wv = c.wave, fr = lane & 15, fq = lane >> 4, m = wv >> 1, n0 = 32 * (wv & 1);
    const int boff = (n0 + fr) * 64 + 8 * fq, qtoff = (n0 + fr) * 64 + 16 * m + 4 * fq;
    LAS3 unsigned char* L = (LAS3 unsigned char*)c.lds;
    const bf16* LP = (const bf16*)(a.ws + WS_ST) + ST_LP_OFF + (size_t)h * NCH * 4096; const float* QT = (const float*)(a.ws + WS_ST) + ST_Q_OFF + (size_t)h * NCH * 4096;
    bf16* SG = (bf16*)(a.ws + WS_SG) + (size_t)h * NG * 4096;
    for (int i = c.tid; i < 2 * HI_BYTES / 4; i += NTHREADS) ((LAS3 unsigned*)L)[i] = 0u;
    for (int i = c.tid; i < 4096 / 2; i += NTHREADS) ((LAS3 unsigned*)(L + 2 * HI_BYTES))[i] = 0u;
    __syncthreads();
    HFrag f0, f1, f2, f3;
#define SC2B_CH(g) ((size_t)((g) * GS + GS - 1) * 4096)
    hload(f0, LP + SC2B_CH(0), QT + SC2B_CH(0), boff, qtoff); hload(f1, LP + SC2B_CH(1), QT + SC2B_CH(1), boff, qtoff); hload(f2, LP + SC2B_CH(2), QT + SC2B_CH(2), boff, qtoff); hload(f3, LP + SC2B_CH(3), QT + SC2B_CH(3), boff, qtoff);
    LAS3 unsigned char* i0 = L; LAS3 unsigned char* i1 = L + HI_BYTES;
#define SC2B_STEP(f, g, ic, in) do { f32x4 acc[2] = {f.q[0], f.q[1]}; hmma(ic, f.b, acc, m, fr, fq); LAS3 bf16* So = (LAS3 bf16*)(L + 2 * HI_BYTES) + (((g) + 1) & 7) * 4096; \
        _Pragma("unroll") for (int n = 0; n < 2; ++n) _Pragma("unroll") for (int i = 0; i < 4; ++i) So[(16 * m + 4 * fq + i) * 64 + n0 + 16 * n + fr] = f2bf(acc[n][i]); \
        himg_store(in, acc, m, n0, fr, fq); HBAR(); } while (0)
#pragma unroll 1
    for (int g = 0; g < NG; g += 4) {
        const int nx = (g + 4 < NG) ? g + 4 : g;
        SC2B_STEP(f0, g + 0, i0, i1); hload(f0, LP + SC2B_CH(nx + 0), QT + SC2B_CH(nx + 0), boff, qtoff);
        SC2B_STEP(f1, g + 1, i1, i0); hload(f1, LP + SC2B_CH(nx + 1), QT + SC2B_CH(nx + 1), boff, qtoff);
        SC2B_STEP(f2, g + 2, i0, i1); hload(f2, LP + SC2B_CH(nx + 2), QT + SC2B_CH(nx + 2), boff, qtoff);
        if ((g & 7) == 4) {
            for (int i = c.tid; i < 8 * 4096 / 8; i += NTHREADS) ((u32x4*)(SG + (size_t)(g >> 3) * 8 * 4096))[i] = ((const LAS3 u32x4*)(L + 2 * HI_BYTES))[i];
            HBAR(); }
        if (g + 3 < NG - 1) SC2B_STEP(f3, g + 3, i1, i0);
        hload(f3, LP + SC2B_CH(nx + 3), QT + SC2B_CH(nx + 3), boff, qtoff);
    }
#undef SC2B_STEP
#undef SC2B_CH
}
__device__ __forceinline__ void phase_scan2c(ArgsR a, const Ctx& c) {
    const int lane = c.lane, wv = c.wave, fr = lane & 15, fq = lane >> 4, m = wv >> 1, n0 = 32 * (wv & 1);
    const int boff = (n0 + fr) * 64 + 8 * fq, qtoff = (n0 + fr) * 64 + 16 * m + 4 * fq;
    LAS3 unsigned char* L = (LAS3 unsigned char*)c.lds;
    for (int item = blockIdx.x; item < NH * NG * 2; item += gridDim.x) {
        const int hg = item >> 1, hf = item & 1;
        const size_t cb = (size_t)(hg / NG) * NCH + (size_t)(hg % NG) * GS + hf * 8;
        const bf16* LP = (const bf16*)(a.ws + WS_ST) + ST_LP_OFF + cb * 4096; const float* QT = (const float*)(a.ws + WS_ST) + ST_Q_OFF + cb * 4096; bf16* SS = (bf16*)(a.ws + WS_ST) + cb * 4096;
        { const u32x4 v = *(const u32x4*)((const bf16*)(a.ws + WS_SG) + (size_t)hg * 4096 + c.tid * 8); *(LAS3 u32x4*)(L + ((c.tid >> 3) * HI_LD + (c.tid & 7) * 8) * 2) = v; }
        __syncthreads();
#pragma unroll 2
        for (int i = 0; i < 8; ++i) { HFrag f; hload(f, LP + (size_t)i * 4096, QT + (size_t)i * 4096, boff, qtoff);
            f32x4 acc[2] = {f.q[0], f.q[1]}; hmma(L, f.b, acc, m, fr, fq); bf16* So = SS + (size_t)i * 4096;
#pragma unroll
            for (int n = 0; n < 2; ++n)
#pragma unroll
                for (int k = 0; k < 4; ++k) So[(16 * m + 4 * fq + k) * 64 + n0 + 16 * n + fr] = f2bf(acc[n][k]); }
        __syncthreads();
    }
}
constexpr int WI_LD = 72, WI_B = 64 * WI_LD * 2, WI_GAM = 9 * WI_B, WI_GL = 15 * WI_B;
constexpr size_t WS_GM0 = 352 * MiB, WS_GM1 = 212 * MiB, WS_Y0 = 336 * MiB, WS_END2 = 360 * MiB;
__device__ __forceinline__ bf16* gm_ptr(unsigned char* ws, int h, int ch) { return (bf16*)(ws + (h < 4 ? WS_GM0 : WS_GM1)) + (size_t)((h & 3) * NCH + ch) * 4096; }
__device__ __forceinline__ void wi_mma(f32x4 (&acc)[2], const LAS3 unsigned char* A, const LAS3 unsigned char* Bt, int m, int n0, int fr, int fq) {
#pragma unroll
    for (int ks = 0; ks < 2; ++ks) { const bf16x8 av = *(const LAS3 bf16x8*)(A + ((16 * m + fr) * WI_LD + 32 * ks + 8 * fq) * 2);
#pragma unroll
        for (int n = 0; n < 2; ++n) { const bf16x8 bv = *(const LAS3 bf16x8*)(Bt + ((n0 + 16 * n + fr) * WI_LD + 32 * ks + 8 * fq) * 2); acc[n] = __builtin_amdgcn_mfma_f32_16x16x32_bf16(av, bv, acc[n], 0, 0, 0); } }
}
struct WiA { bf16x8 a[2]; }; struct WiB { bf16x8 b[2][2]; };
__device__ __forceinline__ void wi_lda(WiA& f, const LAS3 unsigned char* A, int m, int fr, int fq) {
#pragma unroll
    for (int ks = 0; ks < 2; ++ks) f.a[ks] = *(const LAS3 bf16x8*)(A + ((16 * m + fr) * WI_LD + 32 * ks + 8 * fq) * 2);
}
__device__ __forceinline__ void wi_ldb(WiB& f, const LAS3 unsigned char* Bt, int n0, int fr, int fq) {
#pragma unroll
    for (int ks = 0; ks < 2; ++ks)
#pragma unroll
        for (int n = 0; n < 2; ++n) f.b[ks][n] = *(const LAS3 bf16x8*)(Bt + ((n0 + 16 * n + fr) * WI_LD + 32 * ks + 8 * fq) * 2);
}
__device__ __forceinline__ void wi_fma(f32x4 (&acc)[2], const WiA& A, const WiB& B) {
#pragma unroll
    for (int ks = 0; ks < 2; ++ks)
#pragma unroll
        for (int n = 0; n < 2; ++n) acc[n] = __builtin_amdgcn_mfma_f32_16x16x32_bf16(A.a[ks], B.b[ks][n], acc[n], 0, 0, 0);
}
__device__ __forceinline__ void wi_fma_s(f32x4 (&acc)[2], const WiA& A, const WiB& B) {
#pragma unroll
    for (int ks = 0; ks < 2; ++ks)
#pragma unroll
        for (int n = 0; n < 2; ++n) acc[n] = __builtin_amdgcn_mfma_f32_16x16x32_bf16(B.b[ks][n], A.a[ks], acc[n], 0, 0, 0);
}
__device__ __forceinline__ void wi_st_nat_s(LAS3 unsigned char* X, const f32x4 (&acc)[2], int m, int n0, int fr, int fq) {
#pragma unroll
    for (int n = 0; n < 2; ++n) { u32x2 w; w.x = pk2(acc[n][0], acc[n][1]); w.y = pk2(acc[n][2], acc[n][3]); *(LAS3 u32x2*)(X + ((16 * m + fr) * WI_LD + n0 + 16 * n + 4 * fq) * 2) = w; }
}
__device__ __forceinline__ void wi_ld_nat_s(f32x4 (&acc)[2], const LAS3 unsigned char* X, int m, int n0, int fr, int fq) {
#pragma unroll
    for (int n = 0; n < 2; ++n) { const u32x2 w = *(const LAS3 u32x2*)(X + ((16 * m + fr) * WI_LD + n0 + 16 * n + 4 * fq) * 2);
        acc[n][0] = __uint_as_float(w.x << 16); acc[n][1] = __uint_as_float(w.x & 0xffff0000u); acc[n][2] = __uint_as_float(w.y << 16); acc[n][3] = __uint_as_float(w.y & 0xffff0000u); }
}
__device__ __forceinline__ void wi_ld_tr(f32x4 (&acc)[2], const LAS3 unsigned char* XT, int m, int n0, int fr, int fq) {
#pragma unroll
    for (int n = 0; n < 2; ++n) { const u32x2 w = *(const LAS3 u32x2*)(XT + ((n0 + 16 * n + fr) * WI_LD + 16 * m + 4 * fq) * 2);
        acc[n][0] = __uint_as_float(w.x << 16); acc[n][1] = __uint_as_float(w.x & 0xffff0000u); acc[n][2] = __uint_as_float(w.y << 16); acc[n][3] = __uint_as_float(w.y & 0xffff0000u); }
}
#define WI_PIN() __builtin_amdgcn_sched_barrier(0)
__device__ __forceinline__ void wi_st_nat(LAS3 unsigned char* X, const f32x4 (&acc)[2], int m, int n0, int fr, int fq) {
#pragma unroll
    for (int n = 0; n < 2; ++n)
#pragma unroll
        for (int i = 0; i < 4; ++i) *(LAS3 bf16*)(X + ((16 * m + 4 * fq + i) * WI_LD + n0 + 16 * n + fr) * 2) = f2bf(acc[n][i]);
}
__device__ __forceinline__ void wi_st_tr(LAS3 unsigned char* XT, const f32x4 (&acc)[2], int m, int n0, int fr, int fq) {
#pragma unroll
    for (int n = 0; n < 2; ++n) { u32x2 w; w.x = pk2(acc[n][0], acc[n][1]); w.y = pk2(acc[n][2], acc[n][3]); *(LAS3 u32x2*)(XT + ((n0 + 16 * n + fr) * WI_LD + 16 * m + 4 * fq) * 2) = w; }
}
__device__ __forceinline__ void wi_ld_nat(f32x4 (&acc)[2], const LAS3 unsigned char* X, int m, int n0, int fr, int fq) {
#pragma unroll
    for (int n = 0; n < 2; ++n)
#pragma unroll
        for (int i = 0; i < 4; ++i) acc[n][i] = bf2f(*(const LAS3 bf16*)(X + ((16 * m + 4 * fq + i) * WI_LD + n0 + 16 * n + fr) * 2));
}
__device__ __forceinline__ void phase_scan1m(ArgsR a, const Ctx& c, const int skip = 0) {
    const f16* WM1 = (const f16*)(a.ws + WS_WM1); const f16* KP = (const f16*)(a.ws + WS_KP);
    const f16* AA = (const f16*)(a.ws + WS_AA); const f16* BB = (const f16*)(a.ws + WS_BB); const f16* V = (const f16*)(a.ws + WS_V); const f16* R = (const f16*)(a.ws + WS_R);
    float* ST = (float*)(a.ws + WS_ST);
    LAS3 unsigned char* L = (LAS3 unsigned char*)c.lds;
    LAS3 float* GAM = (LAS3 float*)(L + WI_GAM); LAS3 float* GL = (LAS3 float*)(L + WI_GL);
    const int lane = c.lane, wv = c.wave, fr = lane & 15, fq = lane >> 4, m = wv >> 1, n0 = 32 * (wv & 1), tid = c.tid;
#define SLOT(i) (L + (i) * WI_B)
    const int t = tid >> 3, cc = (tid & 7) * 8;
    f16x8 pav, pbv, pkv, pvv, prv, pwv;
#define WI_FETCH(it) do { const int h_ = (it) / NCH, ch_ = (it) % NCH; const size_t eo_ = (size_t)(ch_ * CL + t) * W + h_ * 64 + cc; \
        pav = *(const f16x8*)(AA + eo_); pbv = *(const f16x8*)(BB + eo_); pkv = *(const f16x8*)(KP + eo_); pvv = *(const f16x8*)(V + eo_); prv = *(const f16x8*)(R + eo_); pwv = *(const f16x8*)(WM1 + eo_); } while (0)
    if (blockIdx.x < NH * NCH) WI_FETCH(blockIdx.x);
    for (int item = blockIdx.x; item < NH * NCH; item += gridDim.x) {
        const int h = item / NCH, ch = item % NCH;
        const f16x8 av = pav, bv = pbv, kv = pkv, vv = pvv, rv = prv, wv8 = pwv;
        if (item + (int)gridDim.x < NH * NCH) WI_FETCH(item + (int)gridDim.x);
        float g[8], gp[8];
        { float wloc[8];
#pragma unroll
          for (int e = 0; e < 8; ++e) wloc[e] = 1.0f + (float)wv8[e];
#pragma unroll
          for (int e = 0; e < 8; ++e) { float x = wloc[e];
              { const float y = __shfl_up(x, 8); if (lane >= 8) x *= y; } { const float y = __shfl_up(x, 16); if (lane >= 16) x *= y; } { const float y = __shfl_up(x, 32); if (lane >= 32) x *= y; }
              g[e] = x; }
          if (lane >= 56) {
#pragma unroll
              for (int e = 0; e < 8; ++e) GAM[wv * 64 + cc + e] = g[e]; }
          HBAR();
#pragma unroll
          for (int e = 0; e < 8; ++e) { float pre = 1.0f;
#pragma unroll
              for (int w = 0; w < 7; ++w) if (w < wv) pre *= GAM[w * 64 + cc + e];
              g[e] *= pre; gp[e] = g[e] * __builtin_amdgcn_rcpf(wloc[e]); } }
        { float fa[8], fb[8], fk[8], fv[8], frr[8];
#pragma unroll
          for (int e = 0; e < 8; ++e) { const float ig = __builtin_amdgcn_rcpf(g[e]);
              fa[e] = (float)av[e] * gp[e]; fb[e] = (float)bv[e] * ig; fk[e] = (float)kv[e] * ig; fv[e] = (float)vv[e]; frr[e] = (float)rv[e] * g[e]; if (t == 63) GL[cc + e] = g[e]; }
          *(LAS3 u32x4*)(SLOT(0) + (t * WI_LD + cc) * 2) = pack8bf(fa); *(LAS3 u32x4*)(SLOT(2) + (t * WI_LD + cc) * 2) = pack8bf(fb); *(LAS3 u32x4*)(SLOT(4) + (t * WI_LD + cc) * 2) = pack8bf(fk); *(LAS3 u32x4*)(SLOT(12) + (t * WI_LD + cc) * 2) = pack8bf(frr);
          *(LAS3 u32x4*)(SLOT(10) + (t * WI_LD + cc) * 2) = pack8bf(fv); }
        HBAR();
        { WiA aB, aK; WiB bA, bR; wi_lda(aB, SLOT(2), m, fr, fq); wi_lda(aK, SLOT(4), m, fr, fq); wi_ldb(bA, SLOT(0), n0, fr, fq); wi_ldb(bR, SLOT(12), n0, fr, fq);
          const int tch = tid & 63, tt0 = (tid >> 6) * 8; bf16 ta[8], tb[8], tv[8];
#pragma unroll
          for (int e = 0; e < 8; ++e) { ta[e] = *(const LAS3 bf16*)(SLOT(0) + ((tt0 + e) * WI_LD + tch) * 2); tb[e] = *(const LAS3 bf16*)(SLOT(2) + ((tt0 + e) * WI_LD + tch) * 2); tv[e] = *(const LAS3 bf16*)(SLOT(10) + ((tt0 + e) * WI_LD + tch) * 2); }
          WI_PIN();
          { u32x4 wa, wb, wv4;
#pragma unroll
            for (int e = 0; e < 4; ++e) { wa[e] = (unsigned)ta[2 * e] | ((unsigned)ta[2 * e + 1] << 16); wb[e] = (unsigned)tb[2 * e] | ((unsigned)tb[2 * e + 1] << 16); wv4[e] = (unsigned)tv[2 * e] | ((unsigned)tv[2 * e + 1] << 16); }
            *(LAS3 u32x4*)(SLOT(1) + (tch * WI_LD + tt0) * 2) = wa; *(LAS3 u32x4*)(SLOT(3) + (tch * WI_LD + tt0) * 2) = wb; *(LAS3 u32x4*)(SLOT(5) + (tch * WI_LD + tt0) * 2) = wv4; }
          f32x4 ans[2] = {{0.f, 0.f, 0.f, 0.f}, {0.f, 0.f, 0.f, 0.f}}, ant[2] = {{0.f, 0.f, 0.f, 0.f}, {0.f, 0.f, 0.f, 0.f}}, aks[2] = {{0.f, 0.f, 0.f, 0.f}, {0.f, 0.f, 0.f, 0.f}}, am[2] = {{0.f, 0.f, 0.f, 0.f}, {0.f, 0.f, 0.f, 0.f}}, amk[2] = {{0.f, 0.f, 0.f, 0.f}, {0.f, 0.f, 0.f, 0.f}};
          wi_fma_s(ans, aB, bA); wi_fma(ant, aB, bA); wi_fma_s(aks, aK, bA); wi_fma(am, aB, bR); wi_fma(amk, aK, bR);
          WI_PIN();
          f32x4 axs[2];
#pragma unroll
          for (int n = 0; n < 2; ++n)
#pragma unroll
              for (int i = 0; i < 4; ++i) { const int rs = 16 * m + fr, cs = n0 + 16 * n + 4 * fq + i;
                  if (!(rs < cs)) { ans[n][i] = 0.f; aks[n][i] = 0.f; } axs[n][i] = ans[n][i] + (rs == cs ? 1.0f : 0.f);
                  const int rn = 16 * m + 4 * fq + i, cn = n0 + 16 * n + fr;
                  if (!(rn < cn)) ant[n][i] = 0.f; if (rn > cn) { am[n][i] = 0.f; amk[n][i] = 0.f; } }
          wi_st_nat_s(SLOT(7), ans, m, n0, fr, fq); wi_st_tr(SLOT(8), ant, m, n0, fr, fq); wi_st_nat_s(SLOT(6), aks, m, n0, fr, fq); wi_st_nat_s(SLOT(11), axs, m, n0, fr, fq);
          wi_st_tr(SLOT(13), am, m, n0, fr, fq); wi_st_tr(SLOT(14), amk, m, n0, fr, fq); }
        HBAR();
        { WiA aN; WiB bN; wi_lda(aN, SLOT(7), m, fr, fq); wi_ldb(bN, SLOT(8), n0, fr, fq); WI_PIN();
          f32x4 a2s[2] = {{0.f, 0.f, 0.f, 0.f}, {0.f, 0.f, 0.f, 0.f}}, a2t[2] = {{0.f, 0.f, 0.f, 0.f}, {0.f, 0.f, 0.f, 0.f}}; wi_fma_s(a2s, aN, bN); wi_fma(a2t, aN, bN); WI_PIN();
          wi_st_nat_s(SLOT(9), a2s, m, n0, fr, fq); wi_st_tr(SLOT(10), a2t, m, n0, fr, fq); }
        HBAR();
#define WI_LEVEL(XS, XD, NS, NST, ND, NDT) do { WiA aX, aN; WiB bN; f32x4 ax[2]; wi_lda(aX, SLOT(XS), m, fr, fq); wi_ldb(bN, SLOT(NST), n0, fr, fq); wi_lda(aN, SLOT(NS), m, fr, fq); wi_ld_nat_s(ax, SLOT(XS), m, n0, fr, fq); \
            WI_PIN(); f32x4 aqs[2] = {{0.f, 0.f, 0.f, 0.f}, {0.f, 0.f, 0.f, 0.f}}, aqt[2] = {{0.f, 0.f, 0.f, 0.f}, {0.f, 0.f, 0.f, 0.f}}; wi_fma_s(ax, aX, bN); wi_fma_s(aqs, aN, bN); wi_fma(aqt, aN, bN); WI_PIN(); \
            wi_st_nat_s(SLOT(XD), ax, m, n0, fr, fq); wi_st_nat_s(SLOT(ND), aqs, m, n0, fr, fq); wi_st_tr(SLOT(NDT), aqt, m, n0, fr, fq); \
            HBAR(); } while (0)
        WI_LEVEL(11, 0, 9, 10, 7, 8);
        WI_LEVEL(0, 11, 7, 8, 9, 10);
        WI_LEVEL(11, 0, 9, 10, 7, 8);
        WI_LEVEL(0, 11, 7, 8, 9, 10);
#undef WI_LEVEL
        { WiA aX; WiB bN; f32x4 ax[2]; wi_lda(aX, SLOT(11), m, fr, fq); wi_ldb(bN, SLOT(10), n0, fr, fq); wi_ld_nat(ax, SLOT(11), m, n0, fr, fq); WI_PIN();
          wi_fma(ax, aX, bN); WI_PIN(); wi_st_tr(SLOT(0), ax, m, n0, fr, fq); }
        HBAR();
        { WiA aNk, aAt; WiB bT; wi_lda(aNk, SLOT(6), m, fr, fq); wi_lda(aAt, SLOT(1), m, fr, fq); wi_ldb(bT, SLOT(0), n0, fr, fq); WI_PIN();
          f32x4 aw[2] = {{0.f, 0.f, 0.f, 0.f}, {0.f, 0.f, 0.f, 0.f}}, aa[2] = {{0.f, 0.f, 0.f, 0.f}, {0.f, 0.f, 0.f, 0.f}}; wi_fma_s(aw, aNk, bT); wi_fma_s(aa, aAt, bT); WI_PIN();
          wi_st_nat_s(SLOT(2), aw, m, n0, fr, fq); wi_st_nat_s(SLOT(7), aa, m, n0, fr, fq); }
        HBAR();
        { WiA aAT, aW1; WiB bB, bM; f32x4 ap[2] = {{0.f, 0.f, 0.f, 0.f}, {0.f, 0.f, 0.f, 0.f}}, az[2], ag[2], az2[2]; float gl[2];
          wi_lda(aAT, SLOT(7), m, fr, fq); wi_lda(aW1, SLOT(2), m, fr, fq); wi_ldb(bB, SLOT(3), n0, fr, fq); wi_ldb(bM, SLOT(13), n0, fr, fq);
          wi_ld_nat(az, SLOT(4), m, n0, fr, fq); wi_ld_tr(az2, SLOT(14), m, n0, fr, fq); wi_ld_tr(ag, SLOT(12), m, n0, fr, fq);
#pragma unroll
          for (int n = 0; n < 2; ++n) gl[n] = GL[n0 + 16 * n + fr];
          WI_PIN();
          wi_fma(ap, aAT, bB); wi_fma(az, aW1, bB); wi_fma(ag, aAT, bM); wi_fma(az2, aW1, bM);
          WI_PIN();
          wi_st_tr(SLOT(8), az, m, n0, fr, fq); wi_st_tr(SLOT(9), az2, m, n0, fr, fq);
          bf16* PTp = (bf16*)ST + (size_t)(h * NCH + ch) * 4096; bf16* GMp = gm_ptr(a.ws, h, ch);
#pragma unroll
          for (int n = 0; n < 2; ++n) { const int col = n0 + 16 * n + fr; f32x4 pv = ap[n];
#pragma unroll
              for (int i = 0; i < 4; ++i) { if (16 * m + 4 * fq + i == col) pv[i] += 1.0f; pv[i] *= gl[n]; }
              u32x2 w; w.x = pk2(pv[0], pv[1]); w.y = pk2(pv[2], pv[3]); *(u32x2*)(PTp + col * 64 + 16 * m + 4 * fq) = w;
              u32x2 w2; w2.x = pk2(ag[n][0], ag[n][1]); w2.y = pk2(ag[n][2], ag[n][3]); *(u32x2*)(GMp + col * 64 + 16 * m + 4 * fq) = w2; } }
        HBAR();
        { WiA aV; WiB bZ1, bZ2; float gl[2]; wi_lda(aV, SLOT(5), m, fr, fq); wi_ldb(bZ1, SLOT(8), n0, fr, fq); wi_ldb(bZ2, SLOT(9), n0, fr, fq); gl[0] = GL[n0 + fr]; gl[1] = GL[n0 + 16 + fr]; WI_PIN();
          f32x4 aq[2] = {{0.f, 0.f, 0.f, 0.f}, {0.f, 0.f, 0.f, 0.f}}, ay[2] = {{0.f, 0.f, 0.f, 0.f}, {0.f, 0.f, 0.f, 0.f}}; wi_fma(aq, aV, bZ1); wi_fma(ay, aV, bZ2); WI_PIN();
          float* QTp = ST + ST_Q_OFF + (size_t)(h * NCH + ch) * 4096; bf16* Y0p = (bf16*)(a.ws + WS_Y0) + (size_t)(h * NCH + ch) * 4096;
#pragma unroll
          for (int n = 0; n < 2; ++n) { const int col = n0 + 16 * n + fr; *(f32x4*)(QTp + col * 64 + 16 * m + 4 * fq) = aq[n] * gl[n];
              u32x2 w; w.x = pk2(ay[n][0], ay[n][1]); w.y = pk2(ay[n][2], ay[n][3]); *(u32x2*)(Y0p + col * 64 + 16 * m + 4 * fq) = w; } }
        HBAR();
    }
#undef SLOT
#undef WI_FETCH
}

__device__ __forceinline__ void phase_scan3m(ArgsR a, const Ctx& c, int l) {
    const f16* R = (const f16*)(a.ws + WS_R); const f16* KP = (const f16*)(a.ws + WS_KP); const f16* V = (const f16*)(a.ws + WS_V); const bf16* G = (const bf16*)(a.ws + WS_G);
    bf16* YA = (bf16*)(a.ws + WS_YA);
    LAS3 unsigned char* L = (LAS3 unsigned char*)c.lds;
    LAS3 float* YL = (LAS3 float*)(L + WI_B);
    LAS3 unsigned char* S0I = L + 3 * WI_B;
    const int lane = c.lane, wv = c.wave, fr = lane & 15, fq = lane >> 4, m = wv >> 1, n0 = 32 * (wv & 1), tid = c.tid;
    const int boff = (n0 + fr) * 64 + 8 * fq, qtoff = (n0 + fr) * 64 + 16 * m + 4 * fq;
    u32x4 pS; bf16x8 pL[2][2]; f32x4 pQ[2]; bf16x8 pB[2][2]; u32x2 pY[2];
#define S3_FETCH(it) do { const int h_ = (it) / NCH, ch_ = (it) % NCH; pS = (u32x4){0u, 0u, 0u, 0u}; \
        _Pragma("unroll") for (int ks = 0; ks < 2; ++ks) _Pragma("unroll") for (int n = 0; n < 2; ++n) pL[ks][n] = (bf16x8){0, 0, 0, 0, 0, 0, 0, 0}; \
        pQ[0] = (f32x4){0.f, 0.f, 0.f, 0.f}; pQ[1] = (f32x4){0.f, 0.f, 0.f, 0.f}; \
        if (ch_ > 0) { const int c1_ = ch_ - 1; pS = *(const u32x4*)((const bf16*)(a.ws + WS_SG) + (size_t)(h_ * NG + c1_ / GS) * 4096 + tid * 8); \
            const bf16* LP_ = (const bf16*)(a.ws + WS_ST) + ST_LP_OFF + (size_t)(h_ * NCH + c1_) * 4096; const float* QT_ = (const float*)(a.ws + WS_ST) + ST_Q_OFF + (size_t)(h_ * NCH + c1_) * 4096; \
            _Pragma("unroll") for (int ks = 0; ks < 2; ++ks) _Pragma("unroll") for (int n = 0; n < 2; ++n) pL[ks][n] = *(const bf16x8*)(LP_ + boff + 16 * n * 64 + 32 * ks); \
            _Pragma("unroll") for (int n = 0; n < 2; ++n) pQ[n] = *(const f32x4*)(QT_ + qtoff + 16 * n * 64); } \
        const bf16* G_ = gm_ptr(a.ws, h_, ch_); const bf16* Y_ = (const bf16*)(a.ws + WS_Y0) + (size_t)(h_ * NCH + ch_) * 4096; \
        _Pragma("unroll") for (int ks = 0; ks < 2; ++ks) _Pragma("unroll") for (int n = 0; n < 2; ++n) pB[ks][n] = *(const bf16x8*)(G_ + (n0 + 16 * n + fr) * 64 + 32 * ks + 8 * fq); \
        _Pragma("unroll") for (int n = 0; n < 2; ++n) pY[n] = *(const u32x2*)(Y_ + (n0 + 16 * n + fr) * 64 + 16 * m + 4 * fq); } while (0)
    if (blockIdx.x < NH * NCH) S3_FETCH(blockIdx.x);
    for (int item = blockIdx.x; item < NH * NCH; item += gridDim.x) {
        const int h = item / NCH, ch = item % NCH;
        *(LAS3 u32x4*)(L + ((tid >> 3) * WI_LD + (tid & 7) * 8) * 2) = pS;
        bf16x8 lfr[2][2], bfr[2][2]; f32x4 as0[2], acc[2];
#pragma unroll
        for (int ks = 0; ks < 2; ++ks)
#pragma unroll
            for (int n = 0; n < 2; ++n) { lfr[ks][n] = pL[ks][n]; bfr[ks][n] = pB[ks][n]; }
#pragma unroll
        for (int n = 0; n < 2; ++n) { as0[n] = pQ[n]; acc[n][0] = __uint_as_float(pY[n].x << 16); acc[n][1] = __uint_as_float(pY[n].x & 0xffff0000u); acc[n][2] = __uint_as_float(pY[n].y << 16); acc[n][3] = __uint_as_float(pY[n].y & 0xffff0000u); }
        if (item + (int)gridDim.x < NH * NCH) S3_FETCH(item + (int)gridDim.x);
        HBAR();
        hmma(L, lfr, as0, m, fr, fq);
        himg_store(S0I, as0, m, n0, fr, fq);
        HBAR();
#pragma unroll
        for (int ks = 0; ks < 2; ++ks) { const bf16x8 av = *(const LAS3 bf16x8*)(S0I + ((16 * m + fr) * WI_LD + 32 * ks + 8 * fq) * 2);
#pragma unroll
            for (int n = 0; n < 2; ++n) acc[n] = __builtin_amdgcn_mfma_f32_16x16x32_bf16(av, bfr[ks][n], acc[n], 0, 0, 0); }
#pragma unroll
        for (int n = 0; n < 2; ++n)
#pragma unroll
            for (int i = 0; i < 4; ++i) YL[(n0 + 16 * n + fr) * 65 + 16 * m + 4 * fq + i] = acc[n][i];
        HBAR();
        { const float gn_g = a.in[I_GNG][l * W + h * 64 + lane], gn_b = a.in[I_GNB][l * W + h * 64 + lane], r_k = a.in[I_RK][l * W + h * 64 + lane];
          f16 rl8[8], kl8[8], vl8[8]; bf16 gl8[8];
#pragma unroll
          for (int i = 0; i < 8; ++i) { const size_t o = (size_t)(ch * CL + 8 * wv + i) * W + h * 64 + lane; rl8[i] = R[o]; kl8[i] = KP[o]; vl8[i] = V[o]; gl8[i] = G[o]; }
#pragma unroll
          for (int i = 0; i < 8; ++i) { const int t = 8 * wv + i; const size_t o = (size_t)(ch * CL + t) * W + h * 64 + lane;
              const float yy = YL[t * 65 + lane]; const float rl = (float)rl8[i], kl = (float)kl8[i], vl = (float)vl8[i], gl = bf2f(gl8[i]);
              const float mean = wave_sum(yy) * (1.f / 64.f); const float dd = yy - mean; const float var = wave_sum(dd * dd) * (1.f / 64.f);
              const float bonus = wave_sum(rl * kl * r_k);
              const float yn = dd * __builtin_amdgcn_rsqf(var + GN_EPS) * gn_g + gn_b + bonus * vl;
              YA[o] = f2bf(yn * gl); } }
        HBAR();
    }
#undef S3_FETCH
}

__device__ __forceinline__ void phase_scan3(ArgsR a, const Ctx& c, int l) {
    const f16* R = (const f16*)(a.ws + WS_R); const f16* WM1 = (const f16*)(a.ws + WS_WM1); const f16* KP = (const f16*)(a.ws + WS_KP);
    const f16* AA = (const f16*)(a.ws + WS_AA); const f16* BB = (const f16*)(a.ws + WS_BB); const f16* V = (const f16*)(a.ws + WS_V);
    const float* ST = (const float*)(a.ws + WS_ST); bf16* YA = (bf16*)(a.ws + WS_YA); const f16* Gs = (const f16*)(a.ws + WS_G);
    const int lane = c.lane;
    LAS3 unsigned char* ring = (LAS3 unsigned char*)c.lds + c.wave * SC_WAVE;
    for (int item = c.gw; item < NH * NCH; item += c.ngw) {
        const int h = __builtin_amdgcn_readfirstlane(item / NCH), ch = __builtin_amdgcn_readfirstlane(item % NCH);
        const size_t lane_off = (size_t)(lane >> 3) * W + h * 64 + (lane & 7) * 8;
        const float gn_g = a.in[I_GNG][l * W + h * 64 + lane], gn_b = a.in[I_GNB][l * W + h * 64 + lane], r_k = a.in[I_RK][l * W + h * 64 + lane];
        { const size_t e0 = (size_t)(ch * CL) * W + lane_off;
          sc_dma(AA, e0, ring); sc_dma(WM1, e0, ring + 1024); sc_dma(BB, e0, ring + 2048); sc_dma(KP, e0, ring + 3072); sc_dma(V, e0, ring + 4096); sc_dma(R, e0, ring + 5120); sc_dma(Gs, e0, ring + 6144); }
        float S[64];
        if (ch == 0) {
#pragma unroll
            for (int j = 0; j < 64; ++j) S[j] = 0.f;
        } else { const bf16* Sp = (const bf16*)ST + ((size_t)(h * NCH + ch - 1) * 64 + lane) * 64;
#pragma unroll
            for (int j = 0; j < 64; j += 4) { const f32x4 x = load4bf(Sp + j); S[j] = x[0]; S[j + 1] = x[1]; S[j + 2] = x[2]; S[j + 3] = x[3]; } }
#pragma unroll 1
        for (int blk = 0; blk < CL / SCB; ++blk) {
            LAS3 unsigned char* buf = ring + (blk & 1) * SC_BUF;
            if (blk + 1 < CL / SCB) { LAS3 unsigned char* nb = ring + ((blk + 1) & 1) * SC_BUF; const size_t e0 = (size_t)(ch * CL + (blk + 1) * SCB) * W + lane_off;
                sc_dma(AA, e0, nb); sc_dma(WM1, e0, nb + 1024); sc_dma(BB, e0, nb + 2048); sc_dma(KP, e0, nb + 3072); sc_dma(V, e0, nb + 4096); sc_dma(R, e0, nb + 5120); sc_dma(Gs, e0, nb + 6144);
                asm volatile("s_waitcnt vmcnt(7)" ::: "memory"); }
            else asm volatile("s_waitcnt vmcnt(0)" ::: "memory");
            SVec A, Wv, Bv, Kv, Rv;
            sv_cvt(A, sv_read(buf, lane)); sv_cvt1p(Wv, sv_read(buf + 1024, lane)); sv_cvt(Bv, sv_read(buf + 2048, lane)); sv_cvt(Kv, sv_read(buf + 3072, lane)); sv_cvt(Rv, sv_read(buf + 5120, lane));
            float vv = (float)*(const LAS3 f16*)(buf + 4096 + lane * 2);
#pragma unroll 1
            for (int st = 0; st < SCB; ++st) {
                const LAS3 unsigned char* sn = buf + ((st + 1 < SCB) ? st + 1 : st) * 128;
                const f16x4 ha = sv_read(sn, lane), hw = sv_read(sn + 1024, lane), hb = sv_read(sn + 2048, lane), hk = sv_read(sn + 3072, lane), hr = sv_read(sn + 5120, lane);
                const f16 hv = *(const LAS3 f16*)(sn + 4096 + lane * 2);
                float d[4] = {0.f, 0.f, 0.f, 0.f};
                sc_dot<0>(d, A, S);
                const float sa = (d[0] + d[1]) + (d[2] + d[3]);
                float y[4] = {0.f, 0.f, 0.f, 0.f};
                sc_upd3<0>(S, y, Wv, Bv, Kv, Rv, sa, vv);
                const float yy = (y[0] + y[1]) + (y[2] + y[3]);
                sv_cvt(A, ha); sv_cvt1p(Wv, hw); sv_cvt(Bv, hb); sv_cvt(Kv, hk); sv_cvt(Rv, hr); vv = (float)hv;
                { const LAS3 unsigned char* sb = buf + st * 128;
                  const float rl = (float)*(const LAS3 f16*)(sb + 5120 + lane * 2), kl = (float)*(const LAS3 f16*)(sb + 3072 + lane * 2), vl = (float)*(const LAS3 f16*)(sb + 4096 + lane * 2);
                  const float gl = bf2f(*(const LAS3 bf16*)(sb + 6144 + lane * 2));
                  const float mean = wave_sum(yy) * (1.f / 64.f); const float dd = yy - mean; const float var = wave_sum(dd * dd) * (1.f / 64.f);
                  const float bonus = wave_sum(rl * kl * r_k);
                  const float yn = dd * __builtin_amdgcn_rsqf(var + GN_EPS) * gn_g + gn_b + bonus * vl;
                  YA[(size_t)(ch * CL + blk * SCB + st) * W + h * 64 + lane] = f2bf(yn * gl); }
            }
        }
    }
}

__device__ __forceinline__ void phase_post(ArgsR a, const Ctx& c, int l) {
    const bf16* YSC = (const bf16*)(a.ws + WS_YSC); const f16* R = (const f16*)(a.ws + WS_R); const f16* KP = (const f16*)(a.ws + WS_KP); const f16* V = (const f16*)(a.ws + WS_V);
    const bf16* G = (const bf16*)(a.ws + WS_G); bf16* YA = (bf16*)(a.ws + WS_YA);
    const float* gng = a.in[I_GNG] + l * W; const float* gnb = a.in[I_GNB] + l * W; const float* rk = a.in[I_RK] + l * W;
    for (int t = c.gw; t < T; t += c.ngw) {
#pragma unroll
        for (int i = 0; i < 8; ++i) { const int n = c.lane + 64 * i; const size_t o = (size_t)t * W + n;
            const float y = bf2f(YSC[o]); const float mean = wave_sum(y) * (1.f / 64.f); const float d = y - mean; const float var = wave_sum(d * d) * (1.f / 64.f);
            float yn = d * __builtin_amdgcn_rsqf(var + GN_EPS) * gng[n] + gnb[n];
            const float r = (float)R[o], k = (float)KP[o], v = (float)V[o];
            const float bonus = wave_sum(r * k * rk[n]);
            yn += bonus * v;
            YA[o] = f2bf(yn * bf2f(G[o])); }
    }
}

__device__ __forceinline__ void phase_ln1(ArgsR a, const Ctx& c, int l, float* outw, int mode = 3) {
    const float* MODF = (const float*)(a.ws + WS_MODF) + l * 6144;
    const float* g1 = a.in[I_LN1G] + l * D; const float* b1 = a.in[I_LN1B] + l * D;
    bf16* XN = (bf16*)(a.ws + WS_XN);
    int* TOKI = (int*)(a.ws + WS_TOKI); float* TOKW = (float*)(a.ws + WS_TOKW); int* TOKP = (int*)(a.ws + WS_TOKP);
    const float* rw = a.in[I_RW]; const float* rb = a.in[I_RB];
    LAS3 float* rwT = (LAS3 float*)((LAS3 unsigned char*)c.lds + 69632);
    constexpr int RW_LD = D + 4;
    unsigned* lcnt = (unsigned*)(c.lds + 135488);
    if (mode & 1) {
    for (int i = c.tid; i < D * NE; i += NTHREADS) rwT[(i & 15) * RW_LD + (i >> 4)] = rw[i];
    if (c.tid < NE) lcnt[c.tid] = 0u;
    __syncthreads();
    const bf16* TMP = (const bf16*)(a.ws + WS_TMP);
    float vn[16]; if (c.gw < T) load_row16bf(TMP + (size_t)c.gw * D, c.lane, vn);
    for (int m = c.gw; m < T; m += c.ngw) {
        int l4 = 4 * c.lane; asm volatile("" : "+v"(l4));
        float v[16];
#pragma unroll
        for (int j = 0; j < 16; ++j) v[j] = vn[j];
        if (m + c.ngw < T) load_row16bf(TMP + (size_t)(m + c.ngw) * D, c.lane, vn);
        float mean, rstd; row_stats(v, mean, rstd);
#pragma unroll
        for (int j = 0; j < 4; ++j) { f32x4 o; const int col = l4 + 256 * j;
#pragma unroll
            for (int e = 0; e < 4; ++e) { v[4 * j + e] = (v[4 * j + e] - mean) * rstd * g1[col + e] + b1[col + e]; o[e] = v[4 * j + e]; }
            *(f32x4*)(outw + (size_t)m * D + col) = o; }
        row_stats(v, mean, rstd);
#pragma unroll
        for (int j = 0; j < 4; ++j) { f32x4 o; const int col = l4 + 256 * j;
#pragma unroll
            for (int e = 0; e < 4; ++e) { v[4 * j + e] = (v[4 * j + e] - mean) * rstd * (1.0f + MODF[4096 + col + e]) + MODF[3072 + col + e]; o[e] = v[4 * j + e]; }
            store4bf(XN + (size_t)m * D + col, o); }
        float lg[16];
#pragma unroll
        for (int e = 0; e < 16; ++e) { float x = 0.f;
#pragma unroll
            for (int j = 0; j < 4; ++j) { const f32x4 r4 = *(const LAS3 f32x4*)(rwT + e * RW_LD + l4 + 256 * j); x += (v[4 * j] * r4[0] + v[4 * j + 1] * r4[1]) + (v[4 * j + 2] * r4[2] + v[4 * j + 3] * r4[3]); }
            lg[e] = x;
            if ((e & 3) == 3) __builtin_amdgcn_sched_barrier(0); }
        float r8[8], r4v[4], r2[2], r1;
        { const bool b5 = (c.lane & 32) != 0, b4 = (c.lane & 16) != 0, b3 = (c.lane & 8) != 0, b2 = (c.lane & 4) != 0;
#pragma unroll
          for (int i = 0; i < 8; ++i) { const float snd = b5 ? lg[i] : lg[i + 8], kp = b5 ? lg[i + 8] : lg[i]; r8[i] = kp + __shfl_xor(snd, 32); }
#pragma unroll
          for (int i = 0; i < 4; ++i) { const float snd = b4 ? r8[i] : r8[i + 4], kp = b4 ? r8[i + 4] : r8[i]; r4v[i] = kp + __shfl_xor(snd, 16); }
#pragma unroll
          for (int i = 0; i < 2; ++i) { const float snd = b3 ? r4v[i] : r4v[i + 2], kp = b3 ? r4v[i + 2] : r4v[i]; r2[i] = kp + __shfl_xor(snd, 8); }
          { const float snd = b2 ? r2[0] : r2[1], kp = b2 ? r2[1] : r2[0]; r1 = kp + __shfl_xor(snd, 4); }
          r1 += __shfl_xor(r1, 2); r1 += __shfl_xor(r1, 1); }
        float sc[16], sel[16];
#pragma unroll
        for (int e = 0; e < 16; ++e) { const float lgt = __shfl(r1, 4 * e); sc[e] = __builtin_amdgcn_rcpf(1.0f + __expf(-lgt)); sel[e] = sc[e] + rb[e]; }
        int best = 0; float bestv = -INFINITY;
#pragma unroll
        for (int g = 0; g < 4; ++g) { float m1 = -INFINITY, m2 = -INFINITY;
#pragma unroll
            for (int q = 0; q < 4; ++q) { const float sv = sel[4 * g + q]; if (sv > m1) { m2 = m1; m1 = sv; } else if (sv > m2) m2 = sv; }
            const float gs = m1 + m2; if (gs > bestv) { bestv = gs; best = g; } }
        int i1 = 0, i2 = 0; float s1 = -INFINITY, s2 = -INFINITY, w1 = 0.f, w2 = 0.f;
#pragma unroll
        for (int e = 0; e < 16; ++e) { if ((e >> 2) == best) { const float sv = sel[e];
                if (sv > s1) { s2 = s1; i2 = i1; w2 = w1; s1 = sv; i1 = e; w1 = sc[e]; } else if (sv > s2) { s2 = sv; i2 = e; w2 = sc[e]; } } }
        if (c.lane == 0) { const float ws = w1 + w2;
            TOKI[2 * m] = i1; TOKI[2 * m + 1] = i2; TOKW[2 * m] = w1 / ws; TOKW[2 * m + 1] = w2 / ws;
            TOKP[2 * m] = (int)atomicAdd(&lcnt[i1], 1u); TOKP[2 * m + 1] = (int)atomicAdd(&lcnt[i2], 1u); }
    }
    __syncthreads();
    if (c.tid < NE) ((int*)(a.ws + WS_BLKCNT))[blockIdx.x * NE + c.tid] = (int)lcnt[c.tid];
    __syncthreads();
    }
}

__device__ __forceinline__ void expert_convert(ArgsR a, const Ctx& c, int l, int b0) {
    if ((int)blockIdx.x < b0) return;
    float* scr = (float*)(c.lds + c.wave * 8704);
    bf16* WGU = (bf16*)(a.ws + WS_WGU); bf16* WD = (bf16*)(a.ws + WS_WD);
    constexpr int IG = (D / 64) * (FF / 32);
    constexpr int ID = (FF / 64) * (D / 32);
    const int gw0 = ((int)blockIdx.x - b0) * NWAVES + c.wave, ngw0 = ((int)gridDim.x - b0) * NWAVES;
    for (int it = gw0; it < NE * (2 * IG + ID); it += ngw0) {
        const int e = it / (2 * IG + ID); int r = it % (2 * IG + ID);
        const size_t eo = ((size_t)l * NE + e) * (size_t)D * FF;
        if (r < IG) { transpose_matrix_item(a.in[I_EG] + eo, D, FF, WGU + (size_t)e * 1024 * 1024, r, scr, c.lane, RowGU{0}); continue; } r -= IG;
        if (r < IG) { transpose_matrix_item(a.in[I_EU] + eo, D, FF, WGU + (size_t)e * 1024 * 1024, r, scr, c.lane, RowGU{1}); continue; } r -= IG;
        transpose_matrix_item(a.in[I_ED] + eo, FF, D, WD + (size_t)e * 1024 * 512, r, scr, c.lane, RowId());
    }
}

__device__ __forceinline__ void phase_perm(ArgsR a, const Ctx& c, int l) {
    const int* BLKCNT = (const int*)(a.ws + WS_BLKCNT);
    LAS3 int* pre = (LAS3 int*)c.lds;
    LAS3 int* tot = pre + 256 * NE;
    const int nb = gridDim.x;
#pragma unroll
    for (int q = 0; q < 2; ++q) { const int e = 2 * c.wave + q; int v[4]; int sum = 0;
#pragma unroll
        for (int i = 0; i < 4; ++i) { const int b = 4 * c.lane + i; v[i] = b < nb ? BLKCNT[b * NE + e] : 0; sum += v[i]; }
        int inc = sum;
#pragma unroll
        for (int o = 1; o < 64; o <<= 1) { const int t = __shfl_up(inc, o); if (c.lane >= o) inc += t; }
        int run = inc - sum;
#pragma unroll
        for (int i = 0; i < 4; ++i) { pre[(4 * c.lane + i) * NE + e] = run; run += v[i]; }
        if (c.lane == 63) tot[e] = inc; }
    __syncthreads();
    int ts[17]; { int sacc = 0;
#pragma unroll
        for (int e = 0; e < 16; ++e) { ts[e] = sacc; sacc += (tot[e] + 255) >> 8; } ts[16] = sacc; }
    if (blockIdx.x == 0 && c.tid < NE) ((int*)(a.ws + WS_TOT))[c.tid] = tot[c.tid];
    const int* TOKI = (const int*)(a.ws + WS_TOKI); const int* TOKP = (const int*)(a.ws + WS_TOKP); int* S2T = (int*)(a.ws + WS_S2T); const float* TOKW = (const float*)(a.ws + WS_TOKW);
    const bf16* XN = (const bf16*)(a.ws + WS_XN); bf16* XS = (bf16*)(a.ws + WS_XS);
    for (int as = blockIdx.x * NTHREADS + c.tid; as < 2 * T; as += gridDim.x * NTHREADS) {
        const int e = TOKI[as]; int base = 0;
#pragma unroll
        for (int j = 0; j < 16; ++j) base = (j == e) ? ts[j] : base;
        const int m = as >> 1, blk = (m % c.ngw) >> 3;
        const u32x2 sw = {(unsigned)as, __float_as_uint(TOKW[as])};
        *(u32x2*)(S2T + 2 * (base * 256 + pre[blk * NE + e] + TOKP[as])) = sw;
    }
    for (int e = 0; e < 16; ++e) {
        int tse = 0, tsn = 0;
#pragma unroll
        for (int j = 0; j < 16; ++j) { tse = (j == e) ? ts[j] : tse; tsn = (j == e) ? ts[j + 1] : tsn; }
        const int lo = tse * 256 + tot[e], hi = tsn * 256;
        for (int sl = lo + blockIdx.x * NTHREADS + c.tid; sl < hi; sl += gridDim.x * NTHREADS) S2T[2 * sl] = -1;
    }
    __syncthreads();
}

__device__ __forceinline__ void phase_ln2(ArgsR a, const Ctx& c, int l, float* outw) {
    const float* MODF = (const float*)(a.ws + WS_MODF) + l * 6144;
    const float* g2 = a.in[I_LN2G] + l * D; const float* b2 = a.in[I_LN2B] + l * D;
    const bf16* Y = (const bf16*)(a.ws + WS_Y); bf16* XN = (bf16*)(a.ws + WS_XN);
    float vn[16]; u32x2 y0n[4], y1n[4];
    if (c.gw < T) { load_row16(a.out + (size_t)c.gw * D, c.lane, vn);
#pragma unroll
        for (int j = 0; j < 4; ++j) { y0n[j] = *(const u32x2*)(Y + (size_t)(2 * c.gw) * D + 4 * c.lane + 256 * j); y1n[j] = *(const u32x2*)(Y + (size_t)(2 * c.gw + 1) * D + 4 * c.lane + 256 * j); } }
    for (int m = c.gw; m < T; m += c.ngw) {
        float v[16]; u32x2 y0[4], y1[4];
#pragma unroll
        for (int j = 0; j < 16; ++j) v[j] = vn[j];
#pragma unroll
        for (int j = 0; j < 4; ++j) { y0[j] = y0n[j]; y1[j] = y1n[j]; }
        if (m + c.ngw < T) { const int mn = m + c.ngw; load_row16(a.out + (size_t)mn * D, c.lane, vn);
#pragma unroll
            for (int j = 0; j < 4; ++j) { y0n[j] = *(const u32x2*)(Y + (size_t)(2 * mn) * D + 4 * c.lane + 256 * j); y1n[j] = *(const u32x2*)(Y + (size_t)(2 * mn + 1) * D + 4 * c.lane + 256 * j); } }
#pragma unroll
        for (int j = 0; j < 4; ++j) { const int col = 4 * c.lane + 256 * j;
            const float a0 = __uint_as_float(y0[j].x << 16) + __uint_as_float(y1[j].x << 16), a1 = __uint_as_float(y0[j].x & 0xffff0000u) + __uint_as_float(y1[j].x & 0xffff0000u);
            const float a2 = __uint_as_float(y0[j].y << 16) + __uint_as_float(y1[j].y << 16), a3 = __uint_as_float(y0[j].y & 0xffff0000u) + __uint_as_float(y1[j].y & 0xffff0000u);
            const f32x4 gt = *(const f32x4*)(MODF + 5120 + col);
            v[4 * j] = ALPHA * v[4 * j] + (1.0f + gt[0]) * a0; v[4 * j + 1] = ALPHA * v[4 * j + 1] + (1.0f + gt[1]) * a1; v[4 * j + 2] = ALPHA * v[4 * j + 2] + (1.0f + gt[2]) * a2; v[4 * j + 3] = ALPHA * v[4 * j + 3] + (1.0f + gt[3]) * a3; }
        float mean, rstd; row_stats(v, mean, rstd);
#pragma unroll
        for (int j = 0; j < 4; ++j) { f32x4 o; const int col = 4 * c.lane + 256 * j;
#pragma unroll
            for (int e = 0; e < 4; ++e) { v[4 * j + e] = (v[4 * j + e] - mean) * rstd * g2[col + e] + b2[col + e]; o[e] = v[4 * j + e]; }
            *(f32x4*)(outw + (size_t)m * D + col) = o; }
        if (l + 1 < DEPTH) {
            const float* MN = MODF + 6144;
            row_stats(v, mean, rstd);
#pragma unroll
            for (int j = 0; j < 4; ++j) { f32x4 o; const int col = 4 * c.lane + 256 * j;
#pragma unroll
                for (int e = 0; e < 4; ++e) o[e] = (v[4 * j + e] - mean) * rstd * (1.0f + MN[1024 + col + e]) + MN[col + e];
                store4bf(XN + (size_t)m * D + col, o); }
        }
    }
}


template <class F> struct EpiAdapt {
    static constexpr bool PERM = true, AFTER_DRAIN = false; F f;
    __device__ __forceinline__ void operator()(const f32x4 (&acc)[2][2][4][2], const Unit& u, int wr, int wc, int fr, int fq) const {
        const int col = u.pn * 256 + wc * 32 + 8 * fq;
#pragma unroll
        for (int ai = 0; ai < 2; ++ai)
#pragma unroll
            for (int m = 0; m < 4; ++m) { const int row = u.pm * 256 + ai * 128 + wr * 64 + m * 16 + fr; f(row, col, acc[ai][0][m][0], acc[ai][0][m][1], acc[ai][1][m][0], acc[ai][1][m][1]); }
    }
};

template <class Sched, class F>
__device__ __forceinline__ void gemm_gather(const Ctx& c, const bf16* A, const int* s2t, const bf16* Bt, int M, int N, int K, const Sched& S, const F& f) {
    pg8::Gemm g{A, Bt, M, N, K}; EpiAdapt<F> E{f};
    pg8::gemm_phase<EpiAdapt<F>, Sched, true, true, true>((PG8_LAS unsigned char*)c.lds, g, S, E, c.tid, s2t);
}
template <class Sched, class F>
__device__ __forceinline__ void gemm_any(const Ctx& c, const bf16* A, const bf16* Bt, int M, int N, int K, const Sched& S, const F& f) {
    pg8::Gemm g{A, Bt, M, N, K}; EpiAdapt<F> E{f};
    pg8::gemm_phase<EpiAdapt<F>, Sched, true, true>((PG8_LAS unsigned char*)c.lds, g, S, E, c.tid);
}

#define LAS __attribute__((address_space(3)))
#define XB_TMO      128
#define XB_XCNT(j)  (256  + 64 * (j))
#define XB_XSUB(j)  (1280 + 64 * (j))
#define XB_XGEN(j)  (2304 + 64 * (j))
#define XB_TOP      3328
#define XB_TOPGEN   3392
#define XCD_BAR_WORDS 3456
#define XB_SPIN_CAP (1u << 24)

__device__ __forceinline__ unsigned xb_ld(unsigned* p)              { return __hip_atomic_load(p, __ATOMIC_RELAXED, __HIP_MEMORY_SCOPE_AGENT); }
__device__ __forceinline__ unsigned xb_add(unsigned* p, unsigned v) { return __hip_atomic_fetch_add(p, v, __ATOMIC_RELAXED, __HIP_MEMORY_SCOPE_AGENT); }
__device__ __forceinline__ unsigned xb_xcc_id() { return (unsigned)__builtin_amdgcn_s_getreg((3 << 11) | 20) & 0xFu; }
#define XB_SPIN(cond, bar) do { unsigned _sp = 0; while (cond) { __builtin_amdgcn_s_sleep(1); \
    if ((++_sp & 255u) == 0u) { if (xb_ld(&(bar)[XB_TMO])) break; if (_sp > XB_SPIN_CAP) { atomicAdd(&(bar)[XB_TMO], 1u); break; } } } } while (0)

struct XcdBarrier {
    unsigned* bar; unsigned x;
    volatile LAS unsigned* st;
};

__device__ __forceinline__ XcdBarrier xcd_barrier_post(unsigned* bar, volatile LAS unsigned* st) {
    XcdBarrier b; b.bar = bar; b.x = xb_xcc_id(); b.st = st;
    if (threadIdx.x == 0) (void)xb_add(&bar[XB_XCNT(b.x)], 1u);
    return b;
}
__device__ __forceinline__ void xcd_barrier_complete(unsigned* bar, unsigned x, unsigned& nloc, unsigned& nx) {
    const unsigned G = gridDim.x * gridDim.y * gridDim.z;
    unsigned sum, cnt, mine, sp = 0u;
    for (;;) {
        sum = 0u; cnt = 0u; mine = 0u;
#pragma unroll
        for (unsigned j = 0; j < 16; ++j) { const unsigned c = xb_ld(&bar[XB_XCNT(j)]); sum += c; cnt += (c > 0u) ? 1u : 0u; mine = (j == x) ? c : mine; }
        if (sum == G) break;
        __builtin_amdgcn_s_sleep(1);
        if ((++sp & 255u) == 0u) { if (xb_ld(&bar[XB_TMO])) break; if (sp > XB_SPIN_CAP) { atomicAdd(&bar[XB_TMO], 1u); break; } }
    }
    nloc = mine > 0u ? mine : 1u; nx = cnt > 0u ? cnt : 1u;
}

__device__ __forceinline__ void xcd_barrier(const XcdBarrier& b) {
    asm volatile("s_waitcnt vmcnt(0)" ::: "memory");
    __syncthreads();
    if (threadIdx.x == 0) {
        unsigned* bar = b.bar;
        __builtin_amdgcn_s_waitcnt(0);
        unsigned nloc = b.st[0], nx = b.st[1];
        if (nloc == 0u) { xcd_barrier_complete(bar, b.x, nloc, nx); b.st[0] = nloc; b.st[1] = nx; }
        const unsigned old = xb_add(&bar[XB_XSUB(b.x)], 1u);
        const unsigned gen = old / nloc;
        if (old + 1u == (gen + 1u) * nloc) {
            __builtin_amdgcn_fence(__ATOMIC_RELEASE, "agent");
            asm volatile("s_waitcnt vmcnt(0)" ::: "memory");
            const unsigned og = xb_add(&bar[XB_TOP], 1u);
            const unsigned tg = og / nx;
            if (og + 1u == (tg + 1u) * nx) xb_add(&bar[XB_TOPGEN], 1u);
            else XB_SPIN(xb_ld(&bar[XB_TOPGEN]) == tg, bar);
            __builtin_amdgcn_fence(__ATOMIC_ACQUIRE, "agent");
            xb_add(&bar[XB_XGEN(b.x)], 1u);
            asm volatile("s_waitcnt vmcnt(0)" ::: "memory");
        } else {
            XB_SPIN(xb_ld(&bar[XB_XGEN(b.x)]) == gen, bar);
            __builtin_amdgcn_fence(__ATOMIC_ACQUIRE, "agent");
            asm volatile("s_waitcnt vmcnt(0)" ::: "memory");
        }
    }
    __syncthreads();
}


constexpr int PH_PER_LAYER = 12, N_PHASES = 2 + PH_PER_LAYER * DEPTH;
constexpr int CW_BAR = 4096;
constexpr int LDS_BYTES = 147456, LDSCTL_OFF = 131072 + 8192;
#ifndef SINGLE_LAUNCH
#define SINGLE_LAUNCH 1
#endif

#ifndef PROBE_A
#define PROBE_A -1
#endif
#ifndef PROBE_B
#define PROBE_B -1
#endif
constexpr size_t WS_TS = 512 * 1024;
#if PROBE_A >= 0
#define STAMP(i) do { if (blockIdx.x == 0 && threadIdx.x == 0) ((unsigned long long*)(args_here()->ws + WS_TS))[(i)] = __builtin_amdgcn_s_memrealtime(); } while (0)
#else
#define STAMP(i) do { } while (0)
#endif
__device__ __forceinline__ const __attribute__((address_space(4))) Args* args_here() { const __attribute__((address_space(4))) Args* p = (const __attribute__((address_space(4))) Args*)__builtin_amdgcn_kernarg_segment_ptr(); asm volatile("" : "+s"(p)); return p; }
#ifndef REP_K
#define REP_K -1
#endif
__device__ __forceinline__ Ctx mkctx(int wave_s, unsigned char* lds) { Ctx c; c.wave = wave_s; c.lane = (int)__builtin_amdgcn_mbcnt_hi(~0u, __builtin_amdgcn_mbcnt_lo(~0u, 0u)); c.tid = wave_s * 64 + c.lane;
    c.gw = blockIdx.x * NWAVES + wave_s; c.ngw = gridDim.x * NWAVES; c.lds = lds; return c; }
#define PHASE1(k, ...) do { const __attribute__((address_space(4))) Args* ap_ = args_here(); if (ap_->ph_lo <= (k) && (k) < ap_->ph_hi) { ArgsR a = *ap_; const Ctx c = mkctx(wave_s, lds); __VA_ARGS__ } } while (0)
#define PHASE(k, ...) do { PHASE1(k, __VA_ARGS__); if ((k) == REP_K) { xcd_barrier(bar); PHASE1(k, __VA_ARGS__); xcd_barrier(bar); PHASE1(k, __VA_ARGS__); } } while (0)

template <int L>
__device__ __forceinline__ void run_layer(const int wave_s, unsigned char* lds, const XcdBarrier& bar) {
    const int G = gridDim.x, b = blockIdx.x;
#define BAR() do { xcd_barrier(bar); STAMP(3 + 14 * L + (bk_++)); } while (0)
    int bk_ = 0;
    PHASE(0, unsigned char* ws = a.ws; pg8::StaticOrder S; S.init(T, INC, G, b); EpiZ E{(bf16*)(ws + WS_ZR), (bf16*)(ws + WS_ZS), (bf16*)(ws + WS_ZG)};
        gemm_any(c, (const bf16*)(ws + WS_XN), (const bf16*)(ws + WS_WIN + (size_t)L * 10 * MiB), T, INC, D, S, E); );
    BAR();
    PHASE(1, phase_prep_fast(a, c, L); );
    PHASE(14, phase_sg_fast(a, c, L); );
    BAR();
#if REP_K == 21
    PHASE1(2, phase_scan1m(a, c, 1); ); xcd_barrier(bar); PHASE1(2, phase_scan1m(a, c, 1); ); xcd_barrier(bar);
#endif
    PHASE(2, phase_scan1m(a, c); );
    BAR();
    PHASE(3, phase_scan2a(a, c); );
    BAR();
    PHASE(31, phase_scan2b(a, c); );
    PHASE(33, expert_convert(a, c, L, NH); );
    BAR();
    PHASE(4, phase_scan3m(a, c, L); );
    BAR();
    PHASE(6, unsigned char* ws = a.ws; pg8::StaticOrder S; S.init(T, D, G, b); EpiGA E{(const bf16*)(ws + WS_ZG), (bf16*)(ws + WS_MP)};
        gemm_any(c, (const bf16*)(ws + WS_YA), (const bf16*)(ws + WS_WA + (size_t)L * WS_WL1), T, D, W, S, E); );
    BAR();
#if REP_K == 7
    PHASE1(7, unsigned char* ws = a.ws; pg8::StaticOrder S; S.init(T, D, G, b); EpiGB E{(const bf16*)(ws + WS_ZG), (const bf16*)(ws + WS_MP), (bf16*)(ws + WS_ZR)};
        gemm_any(c, (const bf16*)(ws + WS_YB), (const bf16*)(ws + WS_WB + (size_t)L * WS_WL1), T, D, W, S, E); ); xcd_barrier(bar);
    PHASE1(7, unsigned char* ws = a.ws; pg8::StaticOrder S; S.init(T, D, G, b); EpiGB E{(const bf16*)(ws + WS_ZG), (const bf16*)(ws + WS_MP), (bf16*)(ws + WS_ZR)};
        gemm_any(c, (const bf16*)(ws + WS_YB), (const bf16*)(ws + WS_WB + (size_t)L * WS_WL1), T, D, W, S, E); ); xcd_barrier(bar);
#endif
#if REP_K == 8
    PHASE1(8, unsigned char* ws = a.ws; pg8::StaticOrder S; S.init(T, D, G, b); EpiOut E{L == 0 ? a.in[I_X] : a.out, (bf16*)(ws + WS_R), (const float*)(ws + WS_MODF) + L * 6144 + 2048};
        gemm_any(c, (const bf16*)(ws + WS_MP), (const bf16*)(ws + WS_WO + (size_t)L * WS_WL1), T, D, D, S, E); ); xcd_barrier(bar);
    PHASE1(8, unsigned char* ws = a.ws; pg8::StaticOrder S; S.init(T, D, G, b); EpiOut E{L == 0 ? a.in[I_X] : a.out, (bf16*)(ws + WS_R), (const float*)(ws + WS_MODF) + L * 6144 + 2048};
        gemm_any(c, (const bf16*)(ws + WS_MP), (const bf16*)(ws + WS_WO + (size_t)L * WS_WL1), T, D, D, S, E); ); xcd_barrier(bar);
#endif
    PHASE1(7, unsigned char* ws = a.ws; pg8::StaticOrder S; S.init(T, D, G, b); EpiGB E{(const bf16*)(ws + WS_ZG), (const bf16*)(ws + WS_MP), (bf16*)(ws + WS_MP)};
        gemm_any(c, (const bf16*)(ws + WS_YB), (const bf16*)(ws + WS_WB + (size_t)L * WS_WL1), T, D, W, S, E); );
    BAR();
    PHASE1(8, unsigned char* ws = a.ws; pg8::StaticOrder S; S.init(T, D, G, b); EpiOut E{L == 0 ? a.in[I_X] : a.out, (bf16*)(ws + WS_TMP), (const float*)(ws + WS_MODF) + L * 6144 + 2048};
        gemm_any(c, (const bf16*)(ws + WS_MP), (const bf16*)(ws + WS_WO + (size_t)L * WS_WL1), T, D, D, S, E); );
    BAR();
#if REP_K == 9
    PHASE1(9, phase_ln1(a, c, L, (float*)(a.ws + WS_ZR)); ); xcd_barrier(bar); PHASE1(9, phase_ln1(a, c, L, (float*)(a.ws + WS_ZR)); ); xcd_barrier(bar);
#endif
#if REP_K == 91
    PHASE1(9, phase_ln1(a, c, L, (float*)(a.ws + WS_ZR), 1); ); xcd_barrier(bar); PHASE1(9, phase_ln1(a, c, L, (float*)(a.ws + WS_ZR), 1); ); xcd_barrier(bar);
#endif
#if REP_K == 92
    PHASE1(9, phase_ln1(a, c, L, (float*)(a.ws + WS_ZR), 2); ); xcd_barrier(bar); PHASE1(9, phase_ln1(a, c, L, (float*)(a.ws + WS_ZR), 2); ); xcd_barrier(bar);
#endif
    PHASE1(9, phase_ln1(a, c, L, a.out); );
    BAR();
    PHASE(10, phase_perm(a, c, L); );
    BAR();
    PHASE(11, unsigned char* ws = a.ws; MoeSched S; S.init((const unsigned*)(ws + WS_TOT), G, b); EpiSwi E{(bf16*)(ws + WS_HID)};
        gemm_gather(c, (const bf16*)(ws + WS_XN), (const int*)(ws + WS_S2T), (const bf16*)(ws + WS_WGU), MAXSLOT, NE * 1024, D, S, E); );
    BAR();
    PHASE(12, unsigned char* ws = a.ws; MoeSched S; S.init((const unsigned*)(ws + WS_TOT), G, b); EpiDown E{(const int*)(ws + WS_S2T), (const float*)(ws + WS_TOKW), (bf16*)(ws + WS_Y)};
        gemm_any(c, (const bf16*)(ws + WS_HID), (const bf16*)(ws + WS_WD), MAXSLOT, NE * 1024, FF, S, E); );
    BAR();
#if REP_K == 13
    PHASE1(13, phase_ln2(a, c, L, (float*)(a.ws + WS_R)); ); xcd_barrier(bar); PHASE1(13, phase_ln2(a, c, L, (float*)(a.ws + WS_R)); ); xcd_barrier(bar);
#endif
    PHASE1(13, phase_ln2(a, c, L, a.out); );
    if (L + 1 < DEPTH) BAR();
    (void)bk_;
#undef BAR
}

__global__ void __launch_bounds__(NTHREADS, 2) mk_fwd(Args a_unused) {
    extern __shared__ __attribute__((aligned(16))) unsigned char lds[];
    const int wave_s = __builtin_amdgcn_readfirstlane(threadIdx.x >> 6);
    for (int u = threadIdx.x; u < (LDS_BYTES - LDSCTL_OFF) / 4; u += NTHREADS) ((LAS unsigned*)((LAS unsigned char*)lds + LDSCTL_OFF))[u] = 0u;
    __syncthreads();
    const XcdBarrier bar = xcd_barrier_post((unsigned*)(args_here()->ws + WS_CTL) + CW_BAR, (volatile LAS unsigned*)((LAS unsigned char*)lds + LDSCTL_OFF) + 8);
    STAMP(0);
    PHASE(100, phase_p0a(a, c); );
    xcd_barrier(bar); STAMP(1);
    PHASE(101, phase_p0b(a, c); );
    xcd_barrier(bar); STAMP(2);
    run_layer<0>(wave_s, lds, bar);
    run_layer<1>(wave_s, lds, bar);
#if PROBE_A >= 0
    if (blockIdx.x == 0) {
        asm volatile("s_waitcnt vmcnt(0)" ::: "memory"); __syncthreads();
        if (threadIdx.x == 0) ((unsigned long long*)(args_here()->ws + WS_TS))[30] = __builtin_amdgcn_s_memrealtime();
        asm volatile("s_waitcnt vmcnt(0)" ::: "memory"); __syncthreads();
        const volatile unsigned long long* ts = (const volatile unsigned long long*)(args_here()->ws + WS_TS);
        float da = 0.f, db = 0.f;
        if (PROBE_A < 14) { da = (float)(ts[3 + PROBE_A] - ts[2 + PROBE_A]) + (float)(ts[17 + PROBE_A] - ts[16 + PROBE_A]); } else if (PROBE_A == 14) da = (float)(ts[1] - ts[0]); else if (PROBE_A == 15) da = (float)(ts[2] - ts[1]); else da = (float)(ts[30] - ts[0]);
        if (PROBE_B >= 0 && PROBE_B < 14) { db = (float)(ts[3 + PROBE_B] - ts[2 + PROBE_B]) + (float)(ts[17 + PROBE_B] - ts[16 + PROBE_B]); } else if (PROBE_B == 14) db = (float)(ts[1] - ts[0]); else if (PROBE_B == 15) db = (float)(ts[2] - ts[1]);
        da *= 0.01f; db *= 0.01f;
        da = exp2f(0.25f * rintf(4.0f * log2f(fmaxf(da, 0.5f)))); db = exp2f(0.25f * rintf(4.0f * log2f(fmaxf(db, 0.5f))));
        float* out = args_here()->out;
        for (int i = threadIdx.x; i < 16 * 1024; i += NTHREADS) { const int r = i >> 10, col = i & 1023; const int rowi = (r & 7) + 2048 * (r >> 3); out[(size_t)rowi * D + col] = da; }
        if (threadIdx.x == 0 && PROBE_B >= 0) out[(size_t)4096 * D] = 100.0f * db;
    }
#endif
}

extern "C" void kernel_launch(void* const* d_in, const int* in_sizes, int n_in, void* d_out, int out_size, void* d_ws, size_t ws_size, hipStream_t stream) {
    static int grid = 0;
    if (grid == 0) {
        if (n_in != N_IN || out_size != T * D || ws_size < WS_END2) { fprintf(stderr, "kernel_launch: unexpected shapes: n_in %d out %d ws %zu (need %zu)\n", n_in, out_size, ws_size, (size_t)WS_END2); grid = -1; return; }
        int dev = 0, cus = 0;
        (void)hipGetDevice(&dev); (void)hipDeviceGetAttribute(&cus, hipDeviceAttributeMultiprocessorCount, dev);
        if (hipFuncSetAttribute((const void*)mk_fwd, hipFuncAttributeMaxDynamicSharedMemorySize, LDS_BYTES) != hipSuccess) { fprintf(stderr, "kernel_launch: hipFuncSetAttribute failed\n"); grid = -1; return; }
        grid = cus > 0 ? cus : 256;
        fprintf(stderr, "kernel_launch: ws_size %zu grid %d\n", ws_size, grid);
    }
    if (grid < 0) return;
    (void)hipMemsetAsync((char*)d_ws + WS_CTL, 0, CTL_BYTES, stream);
    Args a{};
    for (int i = 0; i < N_IN; ++i) a.in[i] = (const float*)d_in[i];
    a.out = (float*)d_out; a.ws = (unsigned char*)d_ws;
    a.ph_lo = 0; a.ph_hi = 1000;
    hipLaunchKernelGGL(mk_fwd, dim3(grid), dim3(NTHREADS), LDS_BYTES, stream, a);
}
```

```cpp
#include <hip/hip_runtime.h>
#include <cstdio>
#include <cstdint>
#include <utility>

typedef unsigned short bf16;
typedef _Float16 f16;
typedef float f32x4 __attribute__((ext_vector_type(4)));
typedef unsigned u32x4 __attribute__((ext_vector_type(4)));
typedef unsigned u32x2 __attribute__((ext_vector_type(2)));

constexpr int T = 16384, D = 1024, W = 512, NH = 8, HN = 64, RC = 1792, INC = 4864;
constexpr int NE = 16, FF = 512, DEPTH = 2;
constexpr float LN_EPS = 1e-5f, GN_EPS = 64e-5f, ALPHA = 1.41421356237f;
constexpr int NTHREADS = 512, NWAVES = 8;
constexpr int MAXSLOT = 36864;

constexpr size_t MiB = 1u << 20;
constexpr size_t WS_CTL = 0, CTL_BYTES = 1 * MiB;
constexpr int CW_CNT = 16384;
constexpr size_t WS_PART = 1 * MiB;
constexpr size_t WS_MODF = 2 * MiB;
constexpr size_t WS_TOKI = 2 * MiB + 65536;
constexpr size_t WS_TOKW = WS_TOKI + 131072;
constexpr size_t WS_TOKP = WS_TOKW + 131072;
constexpr size_t WS_S2T = 3 * MiB;
constexpr size_t WS_BLKCNT = 3 * MiB + 512 * 1024;
constexpr size_t WS_TOT = WS_BLKCNT + 32768;
constexpr size_t WS_LORA = 4 * MiB;
constexpr size_t WS_WIN = 8 * MiB;
constexpr size_t WS_WA = 28 * MiB, WS_WB = 29 * MiB, WS_WO = 30 * MiB, WS_WL1 = 4 * MiB;
constexpr size_t WS_ZG = 36 * MiB;
constexpr size_t WS_XN = 100 * MiB;
constexpr size_t WS_G = 100 * MiB, WS_YB = 116 * MiB;
constexpr size_t WS_ZR = 132 * MiB;
constexpr size_t WS_ZS = 188 * MiB;
constexpr size_t WS_YSC = 132 * MiB;
constexpr size_t WS_ST = 148 * MiB;
constexpr size_t WS_YA = 132 * MiB;
constexpr size_t WS_MP = 164 * MiB;
constexpr size_t WS_TMP = 132 * MiB;
constexpr size_t WS_XS = 132 * MiB;
constexpr size_t WS_Y = 132 * MiB;
constexpr size_t WS_AA = 224 * MiB, WS_BB = 240 * MiB, WS_WM1 = 256 * MiB, WS_R = 272 * MiB, WS_KP = 288 * MiB, WS_V = 304 * MiB;
constexpr size_t WS_WGU = 224 * MiB;
constexpr size_t WS_WD = 256 * MiB;
constexpr size_t WS_HID = 272 * MiB;
constexpr size_t WS_VF = 320 * MiB;
constexpr size_t WS_END = 336 * MiB;

constexpr size_t LO_W2T = 0, LO_A2T = 65536, LO_G2T = 131072, LO_VM1T = 262144, LO_VM2T = 294912, LO_STRIDE = 524288;

enum { I_X = 0, I_C, I_WMOD, I_BMOD, I_WIN, I_MU, I_W0, I_W2, I_A0, I_A2, I_G2, I_KK, I_KA, I_RK, I_GNG, I_GNB, I_VM0, I_VM1, I_VM2,
       I_SGG, I_SGB, I_WS, I_BS, I_WBA, I_WBB, I_WOUT, I_LN1G, I_LN1B, I_RW, I_RB, I_EG, I_EU, I_ED, I_LN2G, I_LN2B, N_IN };

struct Args { const float* in[N_IN]; float* out; unsigned char* ws; int ph_lo, ph_hi; };
typedef const __attribute__((address_space(4))) Args& ArgsR;

__device__ __forceinline__ float bf2f(bf16 h) { return __uint_as_float(((unsigned)h) << 16); }
__device__ __forceinline__ unsigned f2bfu(float f) { unsigned u = __float_as_uint(f); return (u + 0x7fffu + ((u >> 16) & 1u)) >> 16; }
__device__ __forceinline__ bf16 f2bf(float f) { return __builtin_bit_cast(unsigned short, (__bf16)f); }
typedef __bf16 bf16x2_t __attribute__((ext_vector_type(2)));
__device__ __forceinline__ unsigned pk2(float lo, float hi) { bf16x2_t v; v[0] = (__bf16)lo; v[1] = (__bf16)hi; return __builtin_bit_cast(unsigned, v); }
__device__ __forceinline__ void store4bf(bf16* p, f32x4 v) { u32x2 w; w.x = pk2(v[0], v[1]); w.y = pk2(v[2], v[3]); *(u32x2*)p = w; }
__device__ __forceinline__ f32x4 load4bf(const bf16* p) { u32x2 w = *(const u32x2*)p; f32x4 r; r[0] = __uint_as_float(w.x << 16); r[1] = __uint_as_float(w.x & 0xffff0000u); r[2] = __uint_as_float(w.y << 16); r[3] = __uint_as_float(w.y & 0xffff0000u); return r; }
__device__ __forceinline__ float wave_sum(float v) {
    v += __builtin_bit_cast(float, __builtin_amdgcn_update_dpp(0, __builtin_bit_cast(int, v), 0xB1, 0xF, 0xF, true));
    v += __builtin_bit_cast(float, __builtin_amdgcn_update_dpp(0, __builtin_bit_cast(int, v), 0x4E, 0xF, 0xF, true));
    v += __builtin_bit_cast(float, __builtin_amdgcn_update_dpp(0, __builtin_bit_cast(int, v), 0x141, 0xF, 0xF, true));
    v += __builtin_bit_cast(float, __builtin_amdgcn_update_dpp(0, __builtin_bit_cast(int, v), 0x140, 0xF, 0xF, true));
    v += __builtin_bit_cast(float, __builtin_amdgcn_update_dpp(0, __builtin_bit_cast(int, v), 0x142, 0xA, 0xF, false));
    v += __builtin_bit_cast(float, __builtin_amdgcn_update_dpp(0, __builtin_bit_cast(int, v), 0x143, 0xC, 0xF, false));
    return __builtin_bit_cast(float, __builtin_amdgcn_readlane(__builtin_bit_cast(int, v), 63));
}
__device__ __forceinline__ float sigmoidf_(float x) { return __builtin_amdgcn_rcpf(1.0f + __expf(-x)); }
__device__ __forceinline__ float siluf_(float x) { return x * sigmoidf_(x); }
__device__ __forceinline__ float gelu_tanh(float x) { const float u = 0.7978845608028654f * (x + 0.044715f * x * x * x); return x * (1.0f - __builtin_amdgcn_rcpf(1.0f + __expf(2.0f * u))); }
__device__ __forceinline__ float softplusf_(float y) { return fmaxf(y, 0.f) + log1pf(__expf(-fabsf(y))); }

struct Ctx { int tid, lane, wave, gw, ngw; unsigned char* lds; };

__device__ __forceinline__ void transpose_item(const float* Wsrc, int N, int k0, int n0, bf16* dst, int ldk, float* scr, int lane) {
    float tv[32];
#pragma unroll
    for (int i = 0; i < 32; ++i) tv[i] = Wsrc[(size_t)(k0 + 2 * i + (lane >> 5)) * N + n0 + (lane & 31)];
#pragma unroll
    for (int i = 0; i < 32; ++i) scr[(2 * i + (lane >> 5)) * 33 + (lane & 31)] = tv[i];
    asm volatile("s_waitcnt lgkmcnt(0)" ::: "memory");
    const int c = lane & 7;
#pragma unroll
    for (int j = 0; j < 4; ++j) { const int n = (lane >> 3) + 8 * j; const float* s = scr + (8 * c) * 33 + n;
        u32x4 o; o.x = pk2(s[0 * 33], s[1 * 33]); o.y = pk2(s[2 * 33], s[3 * 33]); o.z = pk2(s[4 * 33], s[5 * 33]); o.w = pk2(s[6 * 33], s[7 * 33]);
        *(u32x4*)(dst + (size_t)n * ldk + k0 + 8 * c) = o; }
    asm volatile("s_waitcnt lgkmcnt(0)" ::: "memory");
}
template <class RowMap>
__device__ __forceinline__ void transpose_matrix_item(const float* Wsrc, int K, int N, bf16* dst, int item, float* scr, int lane, const RowMap& rm) {
    const int nblk = N / 32, kb = item / nblk, nb = item % nblk, n0 = 32 * nb;
    transpose_item(Wsrc, N, 64 * kb, n0, dst + (size_t)rm(n0) * K, K, scr, lane);
}
struct RowId { __device__ __forceinline__ int operator()(int n) const { return n; } };
struct RowGU { int up; __device__ __forceinline__ int operator()(int n) const { return (n >> 7) * 256 + (n & 127) + up * 128; } };

__device__ __forceinline__ void phase_p0a(ArgsR a, const Ctx& c) {
    float* scr = (float*)(c.lds + c.wave * 16384);
    { float* MODF = (float*)(a.ws + WS_MODF); float* red = (float*)(c.lds + 131072);
      for (int cbk = blockIdx.x; cbk < 2 * 96; cbk += gridDim.x) {
          const int l = cbk / 96, n = (cbk % 96) * 64 + c.lane;
          const float* wm = a.in[I_WMOD] + (size_t)l * D * 6144 + (size_t)(c.wave * 128) * 6144 + n;
          float acc0 = 0.f, acc1 = 0.f;
#pragma unroll 16
          for (int k = 0; k < 128; k += 2) { acc0 += siluf_(a.in[I_C][c.wave * 128 + k]) * wm[(size_t)k * 6144]; acc1 += siluf_(a.in[I_C][c.wave * 128 + k + 1]) * wm[(size_t)(k + 1) * 6144]; }
          red[c.wave * 64 + c.lane] = acc0 + acc1;
          __syncthreads();
          if (c.wave == 0) { float sacc = a.in[I_BMOD][l * 6144 + n];
#pragma unroll
              for (int w = 0; w < 8; ++w) sacc += red[w * 64 + c.lane];
              MODF[l * 6144 + n] = sacc; }
          __syncthreads();
      } }
    for (int it = c.gw; it < 2 * (16 + 16 + 32 + 8); it += c.ngw) {
        const int l = it / 72; int r = it % 72; unsigned char* lo = a.ws + WS_LORA + (size_t)l * LO_STRIDE;
        if (r < 16) { transpose_matrix_item(a.in[I_W2] + (size_t)l * 64 * W, 64, W, (bf16*)(lo + LO_W2T), r, scr, c.lane, RowId()); continue; } r -= 16;
        if (r < 16) { transpose_matrix_item(a.in[I_A2] + (size_t)l * 64 * W, 64, W, (bf16*)(lo + LO_A2T), r, scr, c.lane, RowId()); continue; } r -= 16;
        if (r < 32) { transpose_matrix_item(a.in[I_G2] + (size_t)l * 128 * W, 128, W, (bf16*)(lo + LO_G2T), r, scr, c.lane, RowId()); continue; } r -= 32;
        if (l == 1) transpose_matrix_item(a.in[I_VM1], W, 32, (bf16*)(lo + LO_VM1T), r, scr, c.lane, RowId());
    }
    for (int i = blockIdx.x * NTHREADS + c.tid; i < 32 * W; i += gridDim.x * NTHREADS) { const int n = i >> 5, k = i & 31;
        ((bf16*)(a.ws + WS_LORA + LO_STRIDE + LO_VM2T))[i] = f2bf(a.in[I_VM2][(size_t)k * W + n]); }
    constexpr int I_WINL = (D / 64) * (INC / 32);
    constexpr int I_WAL = (W / 64) * (D / 32);
    constexpr int I_WOL = (D / 64) * (D / 32);
    constexpr int PER_L = I_WINL + 2 * I_WAL + I_WOL;
    for (int it = c.gw; it < 2 * PER_L; it += c.ngw) {
        const int l = it / PER_L; int r = it % PER_L;
        if (r < I_WINL) { transpose_matrix_item(a.in[I_WIN] + (size_t)l * D * INC, D, INC, (bf16*)(a.ws + WS_WIN + (size_t)l * 10 * MiB), r, scr, c.lane, RowId()); continue; } r -= I_WINL;
        if (r < I_WAL) { transpose_matrix_item(a.in[I_WBA] + (size_t)l * W * D, W, D, (bf16*)(a.ws + WS_WA + (size_t)l * WS_WL1), r, scr, c.lane, RowId()); continue; } r -= I_WAL;
        if (r < I_WAL) { transpose_matrix_item(a.in[I_WBB] + (size_t)l * W * D, W, D, (bf16*)(a.ws + WS_WB + (size_t)l * WS_WL1), r, scr, c.lane, RowId()); continue; } r -= I_WAL;
        transpose_matrix_item(a.in[I_WOUT] + (size_t)l * D * D, D, D, (bf16*)(a.ws + WS_WO + (size_t)l * WS_WL1), r, scr, c.lane, RowId());
    }
}

__device__ __forceinline__ void row_stats(const float (&v)[16], float& mean, float& rstd) {
    float s = 0.f;
#pragma unroll
    for (int j = 0; j < 16; ++j) s += v[j];
    mean = wave_sum(s) * (1.f / D);
    float q = 0.f;
#pragma unroll
    for (int j = 0; j < 16; ++j) { const float d = v[j] - mean; q += d * d; }
    rstd = __builtin_amdgcn_rsqf(wave_sum(q) * (1.f / D) + LN_EPS);
}
__device__ __forceinline__ void load_row16bf(const bf16* p, int lane, float (&v)[16]) {
#pragma unroll
    for (int j = 0; j < 4; ++j) { const f32x4 x = load4bf(p + 4 * lane + 256 * j); v[4 * j] = x[0]; v[4 * j + 1] = x[1]; v[4 * j + 2] = x[2]; v[4 * j + 3] = x[3]; }
}
__device__ __forceinline__ void load_row16(const float* p, int lane, float (&v)[16]) {
#pragma unroll
    for (int j = 0; j < 4; ++j) { const f32x4 x = *(const f32x4*)(p + 4 * lane + 256 * j); v[4 * j] = x[0]; v[4 * j + 1] = x[1]; v[4 * j + 2] = x[2]; v[4 * j + 3] = x[3]; }
}

__device__ __forceinline__ void phase_p0b(ArgsR a, const Ctx& c) {
    const float* MODF = (const float*)(a.ws + WS_MODF);
    float sh[16], sc[16];
#pragma unroll
    for (int j = 0; j < 4; ++j) { const f32x4 s0 = *(const f32x4*)(MODF + 4 * c.lane + 256 * j), s1 = *(const f32x4*)(MODF + 1024 + 4 * c.lane + 256 * j);
#pragma unroll
        for (int e = 0; e < 4; ++e) { sh[4 * j + e] = s0[e]; sc[4 * j + e] = 1.f + s1[e]; } }
    bf16* XN = (bf16*)(a.ws + WS_XN);
    for (int m = c.gw; m < T; m += c.ngw) {
        float v[16]; load_row16(a.in[I_X] + (size_t)m * D, c.lane, v);
        float mean, rstd; row_stats(v, mean, rstd);
#pragma unroll
        for (int j = 0; j < 4; ++j) { f32x4 o;
#pragma unroll
            for (int e = 0; e < 4; ++e) o[e] = (v[4 * j + e] - mean) * rstd * sc[4 * j + e] + sh[4 * j + e];
            store4bf(XN + (size_t)m * D + 4 * c.lane + 256 * j, o); }
    }
}

namespace pg8 {
#define PG8_LAS __attribute__((address_space(3)))
typedef unsigned short bf16_t;
typedef short bf16x8 __attribute__((ext_vector_type(8)));
typedef float f32x4 __attribute__((ext_vector_type(4)));
typedef unsigned u32x4 __attribute__((ext_vector_type(4)));
constexpr int BM = 256, BK = 64, HALF = 128, HTB = HALF * BK * 2  , STAGE_BYTES = 8 * HTB, NXCD = 8, WGM = 8;

__host__ __device__ __forceinline__ int lds_byte(int r, int c) { const int st = (r >> 4) * 2 + (c >> 5), rr = r & 15, cc = c & 31, ob = rr * 64 + cc * 2; return st * 1024 + (ob ^ (((ob >> 9) & 1) << 5)); }
__host__ __device__ __forceinline__ void stage_rc(int b, int& R, int& C) { const int st = b / 1024, sb = b % 1024, swz = sb ^ (((sb >> 9) & 1) << 5); R = (st >> 1) * 16 + swz / 64; C = (st & 1) * 32 + (swz % 64) / 2; }
__host__ __device__ __forceinline__ int perm32(int rho) { const int n = rho >> 4, i = rho & 15; return 8 * (i >> 2) + 4 * n + (i & 3); }

struct Unit { int pm, pn; };
struct Gemm { const bf16_t* A; const bf16_t* Bt; int M, N, K; };

struct StaticOrder {
    int nM, nN, nwg, G, c;
    __host__ __device__ void init(int M, int N, int G_, int c_) { nM = M / BM; nN = N / BM; nwg = nM * nN; G = G_; c = c_; }
    __host__ __device__ bool next(int i, Unit& u) const {
        const long L = (long)i * G + c; if (L >= nwg) return false;
        int wgid = (int)L; { const int q = nwg / NXCD, r = nwg % NXCD, xcd = wgid % NXCD, off = wgid / NXCD; wgid = (xcd < r ? xcd * (q + 1) : r * (q + 1) + (xcd - r) * q) + off; }
        const int nig = WGM * nN, gid = wgid / nig, fm = gid * WGM, gsz = (nM - fm) < WGM ? (nM - fm) : WGM;
        u.pm = fm + ((wgid % nig) % gsz); u.pn = (wgid % nig) / gsz; return true;
    }
    __device__ __forceinline__ void a_ready(const Unit&) const {}
    __device__ __forceinline__ void done(const Unit&) const {}
};


template <class Epi, class Sched, bool ALIGN_EPI = false, bool SP2 = false, bool GATHER = false>
__device__ __forceinline__ void gemm_phase(PG8_LAS unsigned char* lds, const Gemm g, const Sched& S, const Epi& E, const int tid_in, const int* s2t = nullptr) {
    const int tid = tid_in, wid = __builtin_amdgcn_readfirstlane(tid >> 6), lane = tid & 63, wr = wid >> 2, wc = wid & 3, fr = lane & 15, fq = lane >> 4;
    const int K = g.K, nt = K / BK;
    unsigned voffA[2], voffB[2];
#pragma unroll
    for (int i = 0; i < 2; ++i) { int R, C; stage_rc(tid * 16 + i * 8192, R, C); const int Rb = Epi::PERM ? ((R & ~31) + perm32(R & 31)) : R;
        voffA[i] = (unsigned)(R * K + C) * 2u; voffB[i] = (unsigned)(Rb * K + C) * 2u; }
    unsigned pc0 = 0u, pc1 = 0u, pn0 = 0u, pn1 = 0u, cvoff = 0u; int R0g = 0;
    if constexpr (GATHER) { int R, C; stage_rc(tid * 16, R, C); R0g = R; cvoff = (unsigned)C * 2u; }
#define PG8_TOKPACK(pm_, h_) ([&]() -> unsigned { const int r0_ = (pm_) * BM + (h_) * HALF + R0g; const int a0_ = s2t[2 * r0_], a1_ = s2t[2 * (r0_ + 64)]; return (unsigned)(a0_ < 0 ? 0 : (a0_ >> 1)) | ((unsigned)(a1_ < 0 ? 0 : (a1_ >> 1)) << 16); }())
#define PG8_STAGE_A(bufoff, base, h, usen) do { if constexpr (GATHER) { const unsigned pk_ = (usen) ? ((h) ? pn1 : pn0) : ((h) ? pc1 : pc0); \
        unsigned vt_[2] = {(pk_ & 0xffffu) * (unsigned)(K * 2) + cvoff, (pk_ >> 16) * (unsigned)(K * 2) + cvoff}; PG8_STAGE(bufoff, base, vt_); } \
    else PG8_STAGE(bufoff, (base) + ((h) ? hstep : (size_t)0), voffA); } while (0)
    const size_t kstep = (size_t)(BK * 2);
    const size_t hstep = (size_t)HALF * K * 2;
    const size_t tstep = 2 * hstep;
    const unsigned ldsw = (unsigned)wid * 1024u;
    const int aoff = lds_byte(wr * 64 + fr, fq * 8), boff = lds_byte(wc * 32 + fr, fq * 8);
#define PG8_SA(b, h) (((b) * 2 + (h)) * HTB)
#define PG8_SB(b, h) ((4 + (b) * 2 + (h)) * HTB)
#define PG8_STAGE(bufoff, gbase, voff) do { _Pragma("unroll") for (int _i = 0; _i < 2; ++_i) \
        __builtin_amdgcn_global_load_lds((const unsigned*)((const char*)(gbase) + (voff)[_i]), (PG8_LAS unsigned*)(lds + (bufoff) + ldsw + _i * 8192), 16, 0, 0); } while (0)
#define PG8_LDA(dst, b, h) do { _Pragma("unroll") for (int m = 0; m < 4; ++m) _Pragma("unroll") for (int k = 0; k < 2; ++k) dst[m][k] = *(const PG8_LAS bf16x8*)(lds + PG8_SA(b, h) + aoff + m * 2048 + k * 1024); } while (0)
#define PG8_LDB(dst, b, h) do { _Pragma("unroll") for (int n = 0; n < 2; ++n) _Pragma("unroll") for (int k = 0; k < 2; ++k) dst[n][k] = *(const PG8_LAS bf16x8*)(lds + PG8_SB(b, h) + boff + n * 2048 + k * 1024); } while (0)
#define PG8_MMA(ai, bj, At, Bt) do { __builtin_amdgcn_s_setprio(1); _Pragma("unroll") for (int m = 0; m < 4; ++m) _Pragma("unroll") for (int n = 0; n < 2; ++n) _Pragma("unroll") for (int k = 0; k < 2; ++k) \
        acc[ai][bj][m][n] = __builtin_amdgcn_mfma_f32_16x16x32_bf16(Bt[n][k], At[m][k], acc[ai][bj][m][n], 0, 0, 0); __builtin_amdgcn_s_setprio(0); } while (0)
#define PG8_WAIT_V(n) asm volatile("s_waitcnt vmcnt(" #n ")" ::: "memory")
#define PG8_WAIT_L(n) asm volatile("s_waitcnt lgkmcnt(" #n ")" ::: "memory")
#define PG8_BAR __builtin_amdgcn_s_barrier()
#define PG8_SCHED __builtin_amdgcn_sched_barrier(0)
    Unit cur, nxt; int ui = 0;
    if (!S.next(0, cur)) return;
    f32x4 acc[2][2][4][2];
#pragma unroll
    for (int a = 0; a < 2; ++a)
#pragma unroll
        for (int b = 0; b < 2; ++b)
#pragma unroll
            for (int m = 0; m < 4; ++m)
#pragma unroll
                for (int n = 0; n < 2; ++n) acc[a][b][m][n] = (f32x4){0.f, 0.f, 0.f, 0.f};
    bf16x8 At[4][2], B0[2][2], B1[2][2];
    const char* cA = (const char*)g.A + (GATHER ? (size_t)0 : (size_t)cur.pm * tstep); const char* cB = (const char*)g.Bt + (size_t)cur.pn * tstep;
    if constexpr (GATHER) { pc0 = PG8_TOKPACK(cur.pm, 0); pc1 = PG8_TOKPACK(cur.pm, 1); }
    S.a_ready(cur);
    if constexpr (SP2) {
        PG8_STAGE(PG8_SB(0, 0), cB, voffB); PG8_STAGE(PG8_SB(0, 1), cB + hstep, voffB); PG8_STAGE_A(PG8_SA(0, 0), cA, 0, false); PG8_STAGE_A(PG8_SA(0, 1), cA, 1, false);
        if (wr == 1) PG8_BAR;
        PG8_WAIT_V(2); PG8_BAR;
        PG8_STAGE(PG8_SB(1, 0), cB + kstep, voffB); PG8_STAGE_A(PG8_SA(1, 0), cA + kstep, 0, false); PG8_STAGE(PG8_SB(1, 1), cB + hstep + kstep, voffB);
        PG8_WAIT_V(6); PG8_BAR;
    } else {
        PG8_STAGE(PG8_SB(0, 0), cB, voffB); PG8_STAGE(PG8_SA(0, 0), cA, voffA); PG8_STAGE(PG8_SB(0, 1), cB + hstep, voffB); PG8_STAGE(PG8_SA(0, 1), cA + hstep, voffA);
        if (wr == 1) PG8_BAR;
        PG8_WAIT_V(4); PG8_BAR;
        PG8_STAGE(PG8_SB(1, 0), cB + kstep, voffB); PG8_STAGE(PG8_SA(1, 0), cA + kstep, voffA); PG8_STAGE(PG8_SB(1, 1), cB + hstep + kstep, voffB);
        PG8_WAIT_V(6); PG8_BAR;
    }
    for (;;) {
        const bool has_next = S.next(ui + 1, nxt);
        const char* nA = (has_next && !GATHER) ? (const char*)g.A + (size_t)nxt.pm * tstep : cA; const char* nB = has_next ? (const char*)g.Bt + (size_t)nxt.pn * tstep : cB;
        if constexpr (GATHER) { if (has_next) { pn0 = PG8_TOKPACK(nxt.pm, 0); pn1 = PG8_TOKPACK(nxt.pm, 1); } else { pn0 = pc0; pn1 = pc1; } }
        for (int t = 0; t < nt; t += 2) {
            const bool last = (t == nt - 2);
            const char* a1 = cA + (size_t)(t + 1) * kstep;
            const char* a2 = last ? nA : cA + (size_t)(t + 2) * kstep; const char* b2 = last ? nB : cB + (size_t)(t + 2) * kstep;
            const char* a3 = a2 + kstep; const char* b3 = b2 + kstep;
            if (last && has_next) S.a_ready(nxt);
            if constexpr (SP2) {
            PG8_LDB(B0, 0, 0); PG8_LDB(B1, 0, 1); PG8_SCHED; PG8_LDA(At, 0, 0); PG8_STAGE_A(PG8_SA(1, 1), a1, 1, false);
            PG8_WAIT_V(8); PG8_WAIT_L(0); PG8_BAR; PG8_MMA(0, 0, At, B0); PG8_MMA(0, 1, At, B1); PG8_BAR; PG8_SCHED;
            PG8_LDA(At, 0, 1); PG8_STAGE(PG8_SB(0, 0), b2, voffB); PG8_STAGE(PG8_SB(0, 1), b2 + hstep, voffB); PG8_STAGE_A(PG8_SA(0, 0), a2, 0, last);
            PG8_WAIT_V(8); PG8_WAIT_L(0); PG8_BAR; PG8_MMA(1, 0, At, B0); PG8_MMA(1, 1, At, B1); PG8_BAR; PG8_SCHED;
            PG8_LDB(B0, 1, 0); PG8_LDB(B1, 1, 1); PG8_SCHED; PG8_LDA(At, 1, 0); PG8_STAGE_A(PG8_SA(0, 1), a2, 1, last);
            PG8_WAIT_V(8); PG8_WAIT_L(0); PG8_BAR; PG8_MMA(0, 0, At, B0); PG8_MMA(0, 1, At, B1); PG8_BAR; PG8_SCHED;
            PG8_LDA(At, 1, 1); PG8_STAGE(PG8_SB(1, 0), b3, voffB); PG8_STAGE(PG8_SB(1, 1), b3 + hstep, voffB); PG8_STAGE_A(PG8_SA(1, 0), a3, 0, last);
            PG8_WAIT_V(8); PG8_WAIT_L(0); PG8_BAR; PG8_MMA(1, 0, At, B0); PG8_MMA(1, 1, At, B1); PG8_BAR; PG8_SCHED;
            } else {
            PG8_LDB(B0, 0, 0); PG8_SCHED; PG8_LDA(At, 0, 0); PG8_STAGE(PG8_SA(1, 1), a1 + hstep, voffA);
            PG8_WAIT_L(8); PG8_BAR; PG8_WAIT_L(0); PG8_MMA(0, 0, At, B0); PG8_BAR; PG8_SCHED;
            PG8_LDB(B1, 0, 1); PG8_STAGE(PG8_SB(0, 0), b2, voffB);
            PG8_BAR; PG8_WAIT_L(0); PG8_MMA(0, 1, At, B1); PG8_BAR;
            PG8_LDA(At, 0, 1); PG8_STAGE(PG8_SA(0, 0), a2, voffA);
            PG8_BAR; PG8_WAIT_L(0); PG8_MMA(1, 0, At, B0); PG8_BAR; PG8_SCHED;
            PG8_STAGE(PG8_SB(0, 1), b2 + hstep, voffB);
            PG8_WAIT_V(6); PG8_BAR; PG8_MMA(1, 1, At, B1); PG8_BAR;
            PG8_LDB(B0, 1, 0); PG8_SCHED; PG8_LDA(At, 1, 0); PG8_STAGE(PG8_SA(0, 1), a2 + hstep, voffA);
            PG8_WAIT_L(8); PG8_BAR; PG8_WAIT_L(0); PG8_MMA(0, 0, At, B0); PG8_BAR; PG8_SCHED;
            PG8_LDB(B1, 1, 1); PG8_STAGE(PG8_SB(1, 0), b3, voffB);
            PG8_BAR; PG8_WAIT_L(0); PG8_MMA(0, 1, At, B1); PG8_BAR;
            PG8_LDA(At, 1, 1); PG8_STAGE(PG8_SA(1, 0), a3, voffA);
            PG8_BAR; PG8_WAIT_L(0); PG8_MMA(1, 0, At, B0); PG8_BAR; PG8_SCHED;
            PG8_STAGE(PG8_SB(1, 1), b3 + hstep, voffB);
            PG8_WAIT_V(6); PG8_BAR; PG8_MMA(1, 1, At, B1); PG8_BAR;
            }
        }
        if constexpr (ALIGN_EPI) { if (wr == 0) PG8_BAR; }
        if constexpr (!Epi::AFTER_DRAIN) { E(acc, cur, wr, wc, fr, fq); S.done(cur); }
        if (!has_next) break;
#pragma unroll
        for (int a = 0; a < 2; ++a)
#pragma unroll
            for (int b = 0; b < 2; ++b)
#pragma unroll
                for (int m = 0; m < 4; ++m)
#pragma unroll
                    for (int n = 0; n < 2; ++n) acc[a][b][m][n] = (f32x4){0.f, 0.f, 0.f, 0.f};
        cur = nxt; cA = nA; cB = nB; ++ui; if constexpr (GATHER) { pc0 = pn0; pc1 = pn1; }
        if constexpr (ALIGN_EPI) { if (wr == 1) PG8_BAR; }
    }
    PG8_WAIT_V(0);
    if constexpr (!ALIGN_EPI) { if (wr == 0) PG8_BAR; }
    PG8_BAR;
    if constexpr (Epi::AFTER_DRAIN) { E.fused(acc, cur, wr, wc, fr, fq, lds, wid, lane); S.done(cur); }
#undef PG8_SA
#undef PG8_SB
#undef PG8_STAGE
#undef PG8_STAGE_A
#undef PG8_TOKPACK
#undef PG8_LDA
#undef PG8_LDB
#undef PG8_MMA
#undef PG8_WAIT_V
#undef PG8_WAIT_L
#undef PG8_BAR
#undef PG8_SCHED
}
}

using pg8::Unit;
struct DenseSched { int nN, n, G, c;
    __device__ __forceinline__ void a_ready(const Unit&) const {}
    __device__ __forceinline__ void done(const Unit&) const {}
    __device__ __forceinline__ bool next(int i, Unit& u) const { const int L = i * G + c; if (L >= n) return false; u.pm = L / nN; u.pn = L % nN; return true; } };

__device__ __forceinline__ void store8bf(bf16* p, f32x4 lo, f32x4 hi) { u32x4 w; w.x = pk2(lo[0], lo[1]); w.y = pk2(lo[2], lo[3]); w.z = pk2(hi[0], hi[1]); w.w = pk2(hi[2], hi[3]); *(u32x4*)p = w; }
__device__ __forceinline__ void load8bf(const bf16* p, f32x4& lo, f32x4& hi) { const u32x4 w = *(const u32x4*)p;
    lo[0] = __uint_as_float(w.x << 16); lo[1] = __uint_as_float(w.x & 0xffff0000u); lo[2] = __uint_as_float(w.y << 16); lo[3] = __uint_as_float(w.y & 0xffff0000u);
    hi[0] = __uint_as_float(w.z << 16); hi[1] = __uint_as_float(w.z & 0xffff0000u); hi[2] = __uint_as_float(w.w << 16); hi[3] = __uint_as_float(w.w & 0xffff0000u); }
struct EpiZ { bf16 *ZR, *ZS, *ZG;
    __device__ __forceinline__ void one(int row, int col, f32x4 lo, f32x4 hi) const {
        if (col < RC) store8bf(ZR + (size_t)row * RC + col, lo, hi);
        else if (col < RC + 1024) { for (int e = 0; e < 4; ++e) { lo[e] = gelu_tanh(lo[e]); hi[e] = gelu_tanh(hi[e]); } store8bf(ZS + (size_t)row * 1024 + (col - RC), lo, hi); }
        else { for (int e = 0; e < 4; ++e) { lo[e] = sigmoidf_(lo[e]); hi[e] = sigmoidf_(hi[e]); } store8bf(ZG + (size_t)row * 2048 + (col - RC - 1024), lo, hi); } }
    __device__ __forceinline__ void operator()(int row, int col, f32x4 a0, f32x4 a1, f32x4 b0, f32x4 b1) const { one(row, col, a0, a1); one(row, col + 128, b0, b1); } };
struct EpiGA { const bf16* ZG; bf16* MP;
    __device__ __forceinline__ void one(int row, int col, f32x4 lo, f32x4 hi) const { f32x4 g0, g1; load8bf(ZG + (size_t)row * 2048 + col, g0, g1); store8bf(MP + (size_t)row * D + col, g0 * lo, g1 * hi); }
    __device__ __forceinline__ void operator()(int row, int col, f32x4 a0, f32x4 a1, f32x4 b0, f32x4 b1) const { one(row, col, a0, a1); one(row, col + 128, b0, b1); } };
struct EpiGB { const bf16* ZG; const bf16* MPin; bf16* MP;
    __device__ __forceinline__ void one(int row, int col, f32x4 lo, f32x4 hi) const { f32x4 g0, g1, m0, m1; load8bf(ZG + (size_t)row * 2048 + 1024 + col, g0, g1); load8bf(MPin + (size_t)row * D + col, m0, m1);
        store8bf(MP + (size_t)row * D + col, m0 + g0 * lo, m1 + g1 * hi); }
    __device__ __forceinline__ void operator()(int row, int col, f32x4 a0, f32x4 a1, f32x4 b0, f32x4 b1) const { one(row, col, a0, a1); one(row, col + 128, b0, b1); } };
struct EpiOut { const float* xin; bf16* tmp; const float* gate1;
    __device__ __forceinline__ void one(int row, int col, f32x4 lo, f32x4 hi) const { const f32x4 x0 = *(const f32x4*)(xin + (size_t)row * D + col), x1 = *(const f32x4*)(xin + (size_t)row * D + col + 4);
        const f32x4 g0 = *(const f32x4*)(gate1 + col), g1 = *(const f32x4*)(gate1 + col + 4); store8bf(tmp + (size_t)row * D + col, ALPHA * x0 + (1.0f + g0) * lo, ALPHA * x1 + (1.0f + g1) * hi); }
    __device__ __forceinline__ void operator()(int row, int col, f32x4 a0, f32x4 a1, f32x4 b0, f32x4 b1) const { one(row, col, a0, a1); one(row, col + 128, b0, b1); } };
struct EpiSwi { bf16* HID;
    __device__ __forceinline__ void operator()(int row, int col, f32x4 a0, f32x4 a1, f32x4 b0, f32x4 b1) const { const int ct = (col >> 8) & 3, cc = col & 127;
        f32x4 h0, h1; for (int e = 0; e < 4; ++e) { h0[e] = siluf_(a0[e]) * b0[e]; h1[e] = siluf_(a1[e]) * b1[e]; } store8bf(HID + (size_t)row * FF + ct * 128 + cc, h0, h1); } };
struct EpiDown { const int* S2T; const float* TOKW; bf16* Y;
    __device__ __forceinline__ void operator()(int row, int col, f32x4 a0, f32x4 a1, f32x4 b0, f32x4 b1) const { const u32x2 sw = *(const u32x2*)(S2T + 2 * row); const int st = (int)sw.x; if (st < 0) return; const float w = __uint_as_float(sw.y); const int cc = col & 1023;
        store8bf(Y + (size_t)st * D + cc, w * a0, w * a1); store8bf(Y + (size_t)st * D + cc + 128, w * b0, w * b1); } };

struct MoeSched { int ts[17]; int G, c, NU, LA;
    __device__ __forceinline__ void a_ready(const Unit&) const {}
    __device__ __forceinline__ void done(const Unit&) const {}
    __device__ __forceinline__ void init(const unsigned* cnt, int G_, int c_) { G = G_; c = c_; int s = 0;
#pragma unroll
        for (int e = 0; e < 16; ++e) { ts[e] = s; s += ((int)cnt[e] + 255) >> 8; } ts[16] = s; NU = 4 * s; LA = ((NU / G) * G) & ~3; }
    __device__ __forceinline__ void unit_of(int L, Unit& u) const { const int rt = L >> 2, ct = L & 3; int e = 0;
#pragma unroll
        for (int j = 1; j < 16; ++j) e += (rt >= ts[j]) ? 1 : 0;
        u.pm = rt; u.pn = e * 4 + ct; }
    __device__ __forceinline__ bool next(int i, Unit& u) const { const int L = i * G + c; if (L >= NU) return false; unit_of(L, u); return true; } };
struct MoeSchedA : MoeSched {
    __device__ __forceinline__ bool next(int i, Unit& u) const { const int L = i * G + c; if (L >= LA) return false; unit_of(L, u); return true; } };
struct MoeSchedT : MoeSched { unsigned* rdy;
    __device__ __forceinline__ bool next(int i, Unit& u) const { const int L = LA + i * G + c; if (L >= NU) return false; unit_of(L, u); return true; }
    __device__ __forceinline__ void done(const Unit& u) const {
        asm volatile("s_waitcnt vmcnt(0)" ::: "memory");
        __builtin_amdgcn_fence(__ATOMIC_RELEASE, "agent");
        asm volatile("s_waitcnt vmcnt(0)" ::: "memory");
        if (__builtin_amdgcn_mbcnt_hi(~0u, __builtin_amdgcn_mbcnt_lo(~0u, 0u)) == 0u) (void)__hip_atomic_fetch_add(rdy + 64 * u.pm, 1u, __ATOMIC_RELAXED, __HIP_MEMORY_SCOPE_AGENT); } };
struct MoeSchedB : MoeSched { unsigned* rdy; unsigned* tmo; int wave;
    __device__ __forceinline__ bool next(int i, Unit& u) const { const int NT = NU - LA; int q;
        if (c < NT) { if (i > 0) return false; q = G - NT + c; }
        else { const int p = c - NT; q = (i == 0) ? p : G + p + (i - 1) * (G - NT); }
        if (q >= NU) return false; unit_of(q, u); return true; }
    __device__ __forceinline__ void a_ready(const Unit& u) const {
        if (4 * u.pm < LA) return;
        if (wave == 0) { unsigned sp = 0u;
            while ((unsigned)__builtin_amdgcn_readfirstlane(__hip_atomic_load(rdy + 64 * u.pm, __ATOMIC_RELAXED, __HIP_MEMORY_SCOPE_AGENT)) < 32u) { __builtin_amdgcn_s_sleep(2);
                if ((++sp & 255u) == 0u) { if (__hip_atomic_load(tmo, __ATOMIC_RELAXED, __HIP_MEMORY_SCOPE_AGENT)) break; if (sp > (1u << 24)) { atomicAdd(tmo, 1u); break; } } }
            __builtin_amdgcn_fence(__ATOMIC_ACQUIRE, "agent");
            asm volatile("s_waitcnt vmcnt(0)" ::: "memory"); }
        asm volatile("" ::: "memory"); __builtin_amdgcn_s_barrier(); asm volatile("" ::: "memory"); } };

__device__ __forceinline__ void phase_prep_simple(ArgsR a, const Ctx& c, int l) {
    const bf16* ZR = (const bf16*)(a.ws + WS_ZR);
    const float* mu = a.in[I_MU] + l * RC; const float* w0 = a.in[I_W0] + l * W; const float* w2 = a.in[I_W2] + (size_t)l * 64 * W;
    const float* a0 = a.in[I_A0] + l * W; const float* a2 = a.in[I_A2] + (size_t)l * 64 * W; const float* g2 = a.in[I_G2] + (size_t)l * 128 * W;
    const float* k_k = a.in[I_KK] + l * W; const float* k_a = a.in[I_KA] + l * W;
    const float* vm0 = a.in[I_VM0]; const float* vm1 = a.in[I_VM1]; const float* vm2 = a.in[I_VM2];
    f16* R = (f16*)(a.ws + WS_R); f16* WM1 = (f16*)(a.ws + WS_WM1); f16* KP = (f16*)(a.ws + WS_KP); f16* AA = (f16*)(a.ws + WS_AA); f16* BB = (f16*)(a.ws + WS_BB); f16* V = (f16*)(a.ws + WS_V);
    bf16* G = (bf16*)(a.ws + WS_G); bf16* VF = (bf16*)(a.ws + WS_VF);
    const int lane = c.lane;
    for (int t = c.gw; t < T; t += c.ngw) {
        float z[28];
#pragma unroll
        for (int i = 0; i < 28; ++i) { const int col = lane + 64 * i; const float zc = bf2f(ZR[(size_t)t * RC + col]); const float zp = t > 0 ? bf2f(ZR[(size_t)(t - 1) * RC + col]) : 0.f; z[i] = zc + (zp - zc) * mu[col]; }
        const float tw = tanhf(z[24]), za = z[25], sg0 = sigmoidf_(z[26]), sg1 = sigmoidf_(z[27]);
        float wlo[8], alo[8], gg[8];
#pragma unroll
        for (int i = 0; i < 8; ++i) { wlo[i] = 0.f; alo[i] = 0.f; gg[i] = 0.f; }
        for (int j = 0; j < 64; ++j) { const float tj = __shfl(tw, j), aj = __shfl(za, j), s0 = __shfl(sg0, j), s1 = __shfl(sg1, j);
#pragma unroll
            for (int i = 0; i < 8; ++i) { const int n = lane + 64 * i; wlo[i] += tj * w2[j * W + n]; alo[i] += aj * a2[j * W + n]; gg[i] += s0 * g2[j * W + n] + s1 * g2[(64 + j) * W + n]; } }
        float vv[8];
#pragma unroll
        for (int i = 0; i < 8; ++i) vv[i] = z[16 + i];
        if (l == 0) {
#pragma unroll
            for (int i = 0; i < 8; ++i) VF[(size_t)t * W + lane + 64 * i] = f2bf(vv[i]);
        } else {
            float vmid = 0.f;
#pragma unroll
            for (int i = 0; i < 8; ++i)
                for (int j = 0; j < 64; ++j) { const float vc = __shfl(vv[i], j); vmid += vc * vm1[(size_t)(64 * i + j) * 32 + (lane & 31)]; }
            float vg[8];
#pragma unroll
            for (int i = 0; i < 8; ++i) vg[i] = 0.f;
            for (int m = 0; m < 32; ++m) { const float vmm = __shfl(vmid, m);
#pragma unroll
                for (int i = 0; i < 8; ++i) vg[i] += vmm * vm2[m * W + lane + 64 * i]; }
#pragma unroll
            for (int i = 0; i < 8; ++i) { const int n = lane + 64 * i; const float vf = bf2f(VF[(size_t)t * W + n]); vv[i] = vv[i] + (vf - vv[i]) * sigmoidf_(vm0[n] + vg[i]); }
        }
#pragma unroll
        for (int i = 0; i < 8; ++i) {
            const int n = lane + 64 * i; const size_t o = (size_t)t * W + n;
            const float x = w0[n] + wlo[i]; const float wl = -softplusf_(-x) - 0.5f; const float dm1 = expm1f(-__expf(wl));
            const float av = sigmoidf_(a0[n] + alo[i]);
            const float kraw = z[8 + i];
            float kk = kraw * k_k[n]; const float nrm = sqrtf(wave_sum(kk * kk)); kk = kk / fmaxf(nrm, 1e-12f);
            const float kp = kraw * (1.0f + (av - 1.0f) * k_a[n]);
            R[o] = (f16)z[i]; WM1[o] = (f16)dm1; KP[o] = (f16)kp; AA[o] = (f16)(-kk); BB[o] = (f16)(kk * av); V[o] = (f16)vv[i]; G[o] = f2bf(gg[i]);
        }
    }
}

__device__ __forceinline__ void phase_sg_simple(ArgsR a, const Ctx& c, int l) {
    const bf16* ZS = (const bf16*)(a.ws + WS_ZS); bf16* YB = (bf16*)(a.ws + WS_YB);
    const float* lng = a.in[I_SGG] + l * W; const float* lnb = a.in[I_SGB] + l * W;
    float* vn = (float*)c.lds;
    float* st = vn + 128 * 64;
    for (int uidx = blockIdx.x; uidx < 128 * 8; uidx += gridDim.x) {
        const int ch = uidx >> 3, g = uidx & 7; const int tok0 = ch * 128;
        for (int i = 0; i < 16; ++i) { const int s = c.wave * 16 + i; const bf16* p = ZS + (size_t)(tok0 + s) * 1024 + 512 + c.lane * 8;
            const f32x4 x0 = load4bf(p), x1 = load4bf(p + 4);
            float sm = (x0[0] + x0[1]) + (x0[2] + x0[3]) + (x1[0] + x1[1]) + (x1[2] + x1[3]); const float mean = wave_sum(sm) * (1.f / 512.f);
            float q = 0.f; for (int e = 0; e < 4; ++e) { const float d0 = x0[e] - mean, d1 = x1[e] - mean; q += d0 * d0 + d1 * d1; }
            const float rstd = __builtin_amdgcn_rsqf(wave_sum(q) * (1.f / 512.f) + LN_EPS);
            if (c.lane == 0) { st[2 * s] = mean; st[2 * s + 1] = rstd; } }
        __syncthreads();
        for (int i = c.tid; i < 128 * 64; i += NTHREADS) { const int s = i >> 6, d = i & 63; const float x = bf2f(ZS[(size_t)(tok0 + s) * 1024 + 512 + g * 64 + d]);
            vn[i] = (x - st[2 * s]) * st[2 * s + 1] * lng[g * 64 + d] + lnb[g * 64 + d]; }
        __syncthreads();
        const int d = c.tid & 63, tq = c.tid >> 6;
        const float* Wg = a.in[I_WS] + (size_t)(l * 8 + g) * 128 * 128; const float* bs = a.in[I_BS] + (size_t)(l * 8 + g) * 128;
        for (int i = 0; i < 16; ++i) { const int t = tq + 8 * i; float acc = 0.f;
            for (int s = 0; s <= t; ++s) acc += Wg[t * 128 + s] * vn[s * 64 + d];
            const float u = bf2f(ZS[(size_t)(tok0 + t) * 1024 + g * 64 + d]);
            YB[(size_t)(tok0 + t) * W + g * 64 + d] = f2bf(u * (acc + bs[t])); }
        __syncthreads();
    }
}

#define LAS3 __attribute__((address_space(3)))
typedef short bf16x8 __attribute__((ext_vector_type(8)));
template <int MT, int NT, int KS, bool SWAP = false>
__device__ __forceinline__ void mma_lds_glob(const unsigned char* lds_base, int a_off_bytes, int lda, const bf16* Bt, int ldb, int n0, int lane, f32x4 (&acc)[MT][NT]) {
    const int fr = lane & 15, fq = lane >> 4;
    const LAS3 unsigned char* Ab = (const LAS3 unsigned char*)lds_base + a_off_bytes;
    int boff = (n0 + fr) * ldb + 8 * fq; asm volatile("" : "+v"(boff));
#pragma unroll
    for (int ks = 0; ks < KS; ++ks) {
        bf16x8 b[NT];
#pragma unroll
        for (int n = 0; n < NT; ++n) b[n] = *(const bf16x8*)(Bt + boff + 16 * n * ldb + 32 * ks);
#pragma unroll
        for (int m = 0; m < MT; ++m) { const bf16x8 av = *(const LAS3 bf16x8*)(Ab + ((16 * m + fr) * lda + 32 * ks + 8 * fq) * 2);
#pragma unroll
            for (int n = 0; n < NT; ++n) acc[m][n] = SWAP ? __builtin_amdgcn_mfma_f32_16x16x32_bf16(b[n], av, acc[m][n], 0, 0, 0) : __builtin_amdgcn_mfma_f32_16x16x32_bf16(av, b[n], acc[m][n], 0, 0, 0); }
    }
}
__device__ __forceinline__ void zshift8(const bf16* ZR, int t, int col, const float* mu, float (&o)[8]) {
    const u32x4 zc = *(const u32x4*)(ZR + (size_t)t * RC + col);
    u32x4 zp = {0u, 0u, 0u, 0u}; if (t > 0) zp = *(const u32x4*)(ZR + (size_t)(t - 1) * RC + col);
    const f32x4 m0 = *(const f32x4*)(mu + col), m1 = *(const f32x4*)(mu + col + 4);
#pragma unroll
    for (int e = 0; e < 4; ++e) { const float c0 = __uint_as_float(zc[e] << 16), c1 = __uint_as_float(zc[e] & 0xffff0000u), p0 = __uint_as_float(zp[e] << 16), p1 = __uint_as_float(zp[e] & 0xffff0000u);
        const float mu0 = (2 * e < 4) ? m0[(2 * e) & 3] : m1[(2 * e) & 3], mu1 = (2 * e + 1 < 4) ? m0[(2 * e + 1) & 3] : m1[(2 * e + 1) & 3];
        o[2 * e] = c0 + (p0 - c0) * mu0; o[2 * e + 1] = c1 + (p1 - c1) * mu1; }
}
typedef _Float16 f16x8 __attribute__((ext_vector_type(8)));
typedef _Float16 f16x4 __attribute__((ext_vector_type(4)));
__device__ __forceinline__ void store8f16(f16* p, const float (&v)[8]) { f16x8 h;
#pragma unroll
    for (int e = 0; e < 8; ++e) h[e] = (f16)v[e];
    *(f16x8*)p = h; }
__device__ __forceinline__ u32x4 pack8bf(const float (&v)[8]) { u32x4 w; w.x = pk2(v[0], v[1]); w.y = pk2(v[2], v[3]); w.z = pk2(v[4], v[5]); w.w = pk2(v[6], v[7]); return w; }


constexpr int PB_LD = 520;
constexpr int PB_BUF = 0, PB_AOP = 64 * PB_LD * 2, PB_VMID = 2 * 64 * PB_LD * 2, PB_LA_LD = 264, PB_VM_LD = 40;
__device__ __forceinline__ void phase_prep_fast(ArgsR a, const Ctx& c, int l) {
    const bf16* ZR = (const bf16*)(a.ws + WS_ZR);
    const float* mu = a.in[I_MU] + l * RC; const float* w0 = a.in[I_W0] + l * W; const float* a0 = a.in[I_A0] + l * W;
    const float* k_k = a.in[I_KK] + l * W; const float* k_a = a.in[I_KA] + l * W; const float* vm0 = a.in[I_VM0];
    f16* R = (f16*)(a.ws + WS_R); f16* WM1 = (f16*)(a.ws + WS_WM1); f16* KP = (f16*)(a.ws + WS_KP); f16* AA = (f16*)(a.ws + WS_AA); f16* BB = (f16*)(a.ws + WS_BB); f16* V = (f16*)(a.ws + WS_V);
    bf16* G = (bf16*)(a.ws + WS_G); bf16* VF = (bf16*)(a.ws + WS_VF);
    const unsigned char* lo = a.ws + WS_LORA + (size_t)l * LO_STRIDE;
    const bf16* W2T = (const bf16*)(lo + LO_W2T); const bf16* A2T = (const bf16*)(lo + LO_A2T); const bf16* G2T = (const bf16*)(lo + LO_G2T);
    const bf16* VM1T = (const bf16*)(lo + LO_VM1T); const bf16* VM2T = (const bf16*)(lo + LO_VM2T);
    LAS3 unsigned char* L = (LAS3 unsigned char*)c.lds;
    const int tid = c.tid, lane = c.lane, wv = c.wave, fr = lane & 15, fq = lane >> 4;
    const int row = tid >> 3, sub_ = tid & 7;
    for (int u = blockIdx.x; u < T / 64; u += gridDim.x) {
        int sub = sub_; asm volatile("" : "+v"(sub));
        const int t0 = u * 64, t = t0 + row;
        if (l == 0) {
#pragma unroll 4
            for (int p = 0; p < 8; ++p) { const int col = p * 64 + sub * 8; float z[8]; zshift8(ZR, t, 1024 + col, mu, z);
                store8f16(V + (size_t)t * W + col, z); *(u32x4*)(VF + (size_t)t * W + col) = pack8bf(z); }
        } else {
#pragma unroll 4
            for (int p = 0; p < 8; ++p) { const int col = p * 64 + sub * 8; float z[8]; zshift8(ZR, t, 1024 + col, mu, z);
                *(LAS3 u32x4*)(L + PB_AOP + (row * PB_LD + col) * 2) = pack8bf(z); }
            __syncthreads();
            { f32x4 acc[1][1]; acc[0][0] = (f32x4){0.f, 0.f, 0.f, 0.f}; const int m = wv >> 1, n = wv & 1;
              mma_lds_glob<1, 1, 16>(c.lds, PB_AOP + 16 * m * PB_LD * 2, PB_LD, VM1T, W, 16 * n, lane, acc);
#pragma unroll
              for (int i = 0; i < 4; ++i) *(LAS3 bf16*)(L + PB_VMID + ((16 * m + 4 * fq + i) * PB_VM_LD + 16 * n + fr) * 2) = f2bf(acc[0][0][i]); }
            __syncthreads();
            { f32x4 acc[4][4];
#pragma unroll
              for (int m = 0; m < 4; ++m)
#pragma unroll
                  for (int n = 0; n < 4; ++n) acc[m][n] = (f32x4){0.f, 0.f, 0.f, 0.f};
              mma_lds_glob<4, 4, 1, true>(c.lds, PB_VMID, PB_VM_LD, VM2T, 32, 64 * wv, lane, acc);
#pragma unroll
              for (int m = 0; m < 4; ++m)
#pragma unroll
                  for (int n = 0; n < 4; ++n) { const int col = 64 * wv + 16 * n + 4 * fq; const f32x4 vb = *(const f32x4*)(vm0 + col); f16x4 hv;
#pragma unroll
                      for (int i = 0; i < 4; ++i) hv[i] = (f16)sigmoidf_(vb[i] + acc[m][n][i]);
                      *(LAS3 f16x4*)(L + PB_BUF + ((16 * m + fr) * PB_LD + col) * 2) = hv; } }
            __syncthreads();
#pragma unroll 4
            for (int p = 0; p < 8; ++p) { const int col = p * 64 + sub * 8;
                const u32x4 vz = *(const LAS3 u32x4*)(L + PB_AOP + (row * PB_LD + col) * 2); const f16x8 gt = *(const LAS3 f16x8*)(L + PB_BUF + (row * PB_LD + col) * 2);
                const u32x4 vfw = *(const u32x4*)(VF + (size_t)t * W + col); float o[8];
#pragma unroll
                for (int e = 0; e < 4; ++e) { const float v0 = __uint_as_float(vz[e] << 16), v1 = __uint_as_float(vz[e] & 0xffff0000u), f0 = __uint_as_float(vfw[e] << 16), f1 = __uint_as_float(vfw[e] & 0xffff0000u);
                    o[2 * e] = v0 + (f0 - v0) * (float)gt[2 * e]; o[2 * e + 1] = v1 + (f1 - v1) * (float)gt[2 * e + 1]; }
                store8f16(V + (size_t)t * W + col, o); }
            __syncthreads();
        }
#pragma unroll 4
        for (int p = 0; p < 4; ++p) { const int cc = sub * 32 + p * 8; float z[8]; zshift8(ZR, t, 1536 + cc, mu, z);
#pragma unroll
            for (int e = 0; e < 8; ++e) z[e] = cc < 64 ? (1.0f - 2.0f * __builtin_amdgcn_rcpf(1.0f + __expf(2.0f * z[e]))) : (cc < 128 ? z[e] : sigmoidf_(z[e]));
            *(LAS3 u32x4*)(L + PB_AOP + (row * PB_LA_LD + cc) * 2) = pack8bf(z); }
        __syncthreads();
        { f32x4 acc[4][4];
#pragma unroll
          for (int m = 0; m < 4; ++m)
#pragma unroll
              for (int n = 0; n < 4; ++n) acc[m][n] = (f32x4){0.f, 0.f, 0.f, 0.f};
          mma_lds_glob<4, 4, 2, true>(c.lds, PB_AOP + 64 * 2, PB_LA_LD, A2T, 64, 64 * wv, lane, acc);
#pragma unroll
          for (int m = 0; m < 4; ++m)
#pragma unroll
              for (int n = 0; n < 4; ++n) { const int col = 64 * wv + 16 * n + 4 * fq; const f32x4 ab = *(const f32x4*)(a0 + col); f16x4 hv;
#pragma unroll
                  for (int i = 0; i < 4; ++i) hv[i] = (f16)sigmoidf_(ab[i] + acc[m][n][i]);
                  *(LAS3 f16x4*)(L + PB_BUF + ((16 * m + fr) * PB_LD + col) * 2) = hv; } }
        __syncthreads();
#pragma unroll 4
        for (int p = 0; p < 8; ++p) { const int col = p * 64 + sub * 8; const size_t o = (size_t)t * W + col;
            float z[8]; zshift8(ZR, t, col, mu, z); store8f16(R + o, z);
            float kz[8]; zshift8(ZR, t, 512 + col, mu, kz);
            const f16x8 av = *(const LAS3 f16x8*)(L + PB_BUF + (row * PB_LD + col) * 2);
            const f32x4 kk0 = *(const f32x4*)(k_k + col), kk1 = *(const f32x4*)(k_k + col + 4), ka0 = *(const f32x4*)(k_a + col), ka1 = *(const f32x4*)(k_a + col + 4);
            float kk[8], kp[8], bb[8]; float ss = 0.f;
#pragma unroll
            for (int e = 0; e < 8; ++e) { const float kkw = e < 4 ? kk0[e & 3] : kk1[e & 3], kaw = e < 4 ? ka0[e & 3] : ka1[e & 3]; kk[e] = kz[e] * kkw; ss += kk[e] * kk[e]; kp[e] = kz[e] * (1.0f + ((float)av[e] - 1.0f) * kaw); }
            ss += __shfl_xor(ss, 1); ss += __shfl_xor(ss, 2); ss += __shfl_xor(ss, 4);
            const float inv = fminf(__builtin_amdgcn_rsqf(ss), 1e12f);
#pragma unroll
            for (int e = 0; e < 8; ++e) { kk[e] *= inv; bb[e] = kk[e] * (float)av[e]; kk[e] = -kk[e]; }
            store8f16(KP + o, kp); store8f16(AA + o, kk); store8f16(BB + o, bb); }
        __syncthreads();
        { f32x4 acc[4][4];
#pragma unroll
          for (int m = 0; m < 4; ++m)
#pragma unroll
              for (int n = 0; n < 4; ++n) acc[m][n] = (f32x4){0.f, 0.f, 0.f, 0.f};
          mma_lds_glob<4, 4, 2, true>(c.lds, PB_AOP, PB_LA_LD, W2T, 64, 64 * wv, lane, acc);
#pragma unroll
          for (int m = 0; m < 4; ++m)
#pragma unroll
              for (int n = 0; n < 4; ++n) { const int col = 64 * wv + 16 * n + 4 * fq; const f32x4 wb = *(const f32x4*)(w0 + col); f16x4 hv;
#pragma unroll
                  for (int i = 0; i < 4; ++i) { const float x = wb[i] + acc[m][n][i]; const float wl = -(fmaxf(-x, 0.f) + __logf(1.0f + __expf(-fabsf(x)))) - 0.5f;
                      hv[i] = (f16)(__expf(-__expf(wl)) - 1.0f); }
                  *(LAS3 f16x4*)(L + PB_BUF + ((16 * m + fr) * PB_LD + col) * 2) = hv; } }
        __syncthreads();
#pragma unroll 4
        for (int p = 0; p < 8; ++p) { const int col = p * 64 + sub * 8; *(u32x4*)(WM1 + (size_t)t * W + col) = *(const LAS3 u32x4*)(L + PB_BUF + (row * PB_LD + col) * 2); }
        __syncthreads();
        { f32x4 acc[4][4];
#pragma unroll
          for (int m = 0; m < 4; ++m)
#pragma unroll
              for (int n = 0; n < 4; ++n) acc[m][n] = (f32x4){0.f, 0.f, 0.f, 0.f};
          mma_lds_glob<4, 4, 4, true>(c.lds, PB_AOP + 128 * 2, PB_LA_LD, G2T, 128, 64 * wv, lane, acc);
#pragma unroll
          for (int m = 0; m < 4; ++m)
#pragma unroll
              for (int n = 0; n < 4; ++n) { const int col = 64 * wv + 16 * n + 4 * fq; u32x2 w; w.x = pk2(acc[m][n][0], acc[m][n][1]); w.y = pk2(acc[m][n][2], acc[m][n][3]);
                  *(LAS3 u32x2*)(L + PB_BUF + ((16 * m + fr) * PB_LD + col) * 2) = w; } }
        __syncthreads();
#pragma unroll 4
        for (int p = 0; p < 8; ++p) { const int col = p * 64 + sub * 8; *(u32x4*)(G + (size_t)t * W + col) = *(const LAS3 u32x4*)(L + PB_BUF + (row * PB_LD + col) * 2); }
        __syncthreads();
    }
}

constexpr int SG_LD = 136;
constexpr int SG_VT = 0, SG_ST = 256 * SG_LD * 2;
__device__ __forceinline__ void phase_sg_fast(ArgsR a, const Ctx& c, int l) {
    const bf16* ZS = (const bf16*)(a.ws + WS_ZS); bf16* YB = (bf16*)(a.ws + WS_YB);
    const float* lng = a.in[I_SGG] + l * W; const float* lnb = a.in[I_SGB] + l * W;
    LAS3 unsigned char* L = (LAS3 unsigned char*)c.lds;
    LAS3 float* st = (LAS3 float*)(L + SG_ST);
    const int tid = c.tid, lane = c.lane, wv = c.wave, fr = lane & 15, fq = lane >> 4;
    for (int u = blockIdx.x; u < 256; u += gridDim.x) {
        const int ch = u >> 1, hf = u & 1, tok0 = ch * 128;
        { u32x4 raw[16];
#pragma unroll
          for (int i = 0; i < 16; ++i) raw[i] = *(const u32x4*)(ZS + (size_t)(tok0 + wv * 16 + i) * 1024 + 512 + lane * 8);
#pragma unroll
          for (int i = 0; i < 16; ++i) { const int sidx = wv * 16 + i; float x[8];
#pragma unroll
              for (int e = 0; e < 4; ++e) { x[2 * e] = __uint_as_float(raw[i][e] << 16); x[2 * e + 1] = __uint_as_float(raw[i][e] & 0xffff0000u); }
              const float sm = ((x[0] + x[1]) + (x[2] + x[3])) + ((x[4] + x[5]) + (x[6] + x[7])); const float mean = wave_sum(sm) * (1.f / 512.f);
              float q = 0.f;
#pragma unroll
              for (int e = 0; e < 8; ++e) { const float d0 = x[e] - mean; q += d0 * d0; }
              const float rstd = __builtin_amdgcn_rsqf(wave_sum(q) * (1.f / 512.f) + LN_EPS);
              if (lane == 0) { st[2 * sidx] = mean; st[2 * sidx + 1] = rstd; } } }
        __syncthreads();
        { const int sidx = tid >> 2, q4 = tid & 3; const float mean = st[2 * sidx], rstd = st[2 * sidx + 1];
#pragma unroll
          for (int p = 0; p < 8; ++p) { const int cl = q4 * 64 + p * 8; const int cg = hf * 256 + cl;
              const bf16* src = ZS + (size_t)(tok0 + sidx) * 1024 + 512 + cg; const f32x4 x0 = load4bf(src), x1 = load4bf(src + 4);
              const f32x4 g0 = *(const f32x4*)(lng + cg), g1 = *(const f32x4*)(lng + cg + 4), b0 = *(const f32x4*)(lnb + cg), b1 = *(const f32x4*)(lnb + cg + 4);
#pragma unroll
              for (int e = 0; e < 8; ++e) { const float x = e < 4 ? x0[e & 3] : x1[e & 3], gg = e < 4 ? g0[e & 3] : g1[e & 3], bb = e < 4 ? b0[e & 3] : b1[e & 3];
                  *(LAS3 bf16*)(L + SG_VT + ((cl + e) * SG_LD + sidx) * 2) = f2bf((x - mean) * rstd * gg + bb); } } }
        __syncthreads();
        const int gl = wv >> 1, dh = wv & 1, g = hf * 4 + gl;
        const float* Wg = a.in[I_WS] + (size_t)(l * 8 + g) * 128 * 128; const float* bs = a.in[I_BS] + (size_t)(l * 8 + g) * 128;
        f32x4 acc[8][2];
#pragma unroll
        for (int m = 0; m < 8; ++m) { acc[m][0] = (f32x4){0.f, 0.f, 0.f, 0.f}; acc[m][1] = (f32x4){0.f, 0.f, 0.f, 0.f}; }
#pragma unroll
        for (int ks = 0; ks < 4; ++ks) {
            bf16x8 b[2];
#pragma unroll
            for (int n = 0; n < 2; ++n) b[n] = *(const LAS3 bf16x8*)(L + SG_VT + ((gl * 64 + dh * 32 + 16 * n + fr) * SG_LD + 32 * ks + 8 * fq) * 2);
#pragma unroll
            for (int m = 0; m < 8; ++m) { if (32 * ks <= 16 * m + 15) {
                const int trow = 16 * m + fr, s0 = 32 * ks + 8 * fq;
                const f32x4 w0v = *(const f32x4*)(Wg + trow * 128 + s0), w1v = *(const f32x4*)(Wg + trow * 128 + s0 + 4);
                float wf[8];
#pragma unroll
                for (int e = 0; e < 8; ++e) { const float wval = e < 4 ? w0v[e & 3] : w1v[e & 3]; wf[e] = (s0 + e <= trow) ? wval : 0.f; }
                const u32x4 wp = pack8bf(wf); const bf16x8 av = __builtin_bit_cast(bf16x8, wp);
                acc[m][0] = __builtin_amdgcn_mfma_f32_16x16x32_bf16(b[0], av, acc[m][0], 0, 0, 0);
                acc[m][1] = __builtin_amdgcn_mfma_f32_16x16x32_bf16(b[1], av, acc[m][1], 0, 0, 0); } }
        }
#pragma unroll
        for (int m = 0; m < 8; ++m) { const int trow = 16 * m + fr; const float bsv = bs[trow];
#pragma unroll
            for (int n = 0; n < 2; ++n) { const int col = g * 64 + dh * 32 + 16 * n + 4 * fq; const f32x4 uu = load4bf(ZS + (size_t)(tok0 + trow) * 1024 + col);
                store4bf(YB + (size_t)(tok0 + trow) * W + col, uu * (acc[m][n] + bsv)); } }
        __syncthreads();
    }
}

__device__ __forceinline__ void phase_scan_simple(ArgsR a, const Ctx& c) {
    if (c.wave != 0 || blockIdx.x >= NH) return;
    const int h = blockIdx.x, lane = c.lane;
    const f16* R = (const f16*)(a.ws + WS_R); const f16* WM1 = (const f16*)(a.ws + WS_WM1); const f16* KP = (const f16*)(a.ws + WS_KP);
    const f16* AA = (const f16*)(a.ws + WS_AA); const f16* BB = (const f16*)(a.ws + WS_BB); const f16* V = (const f16*)(a.ws + WS_V);
    bf16* YSC = (bf16*)(a.ws + WS_YSC);
    float S[64];
#pragma unroll
    for (int j = 0; j < 64; ++j) S[j] = 0.f;
    for (int t = 0; t < T; ++t) {
        const size_t base = (size_t)t * W + h * 64;
        const float vv = (float)V[base + lane];
        float sa = 0.f;
#pragma unroll
        for (int j = 0; j < 64; ++j) sa += S[j] * (float)AA[base + j];
        float y = 0.f;
#pragma unroll
        for (int j = 0; j < 64; ++j) { float s = S[j]; s = s + s * (float)WM1[base + j]; s += sa * (float)BB[base + j]; s += vv * (float)KP[base + j]; S[j] = s; y += s * (float)R[base + j]; }
        YSC[base + lane] = f2bf(y);
    }
}

typedef unsigned u32x16 __attribute__((ext_vector_type(16)));
__device__ __forceinline__ void sload32(const void* p0, u32x16& a0, u32x16& a1) {
    asm volatile("s_load_dwordx16 %0, %2, 0x0 glc\n\ts_load_dwordx16 %1, %2, 0x40 glc\n\ts_waitcnt lgkmcnt(0)" : "=&s"(a0), "=&s"(a1) : "s"(p0) : "memory");
}
__device__ __forceinline__ void sload64(const void* p0, const void* p1, u32x16& a0, u32x16& a1, u32x16& b0, u32x16& b1) {
    asm volatile("s_load_dwordx16 %0, %4, 0x0 glc\n\ts_load_dwordx16 %1, %4, 0x40 glc\n\ts_load_dwordx16 %2, %5, 0x0 glc\n\ts_load_dwordx16 %3, %5, 0x40 glc\n\ts_waitcnt lgkmcnt(0)"
                 : "=&s"(a0), "=&s"(a1), "=&s"(b0), "=&s"(b1) : "s"(p0), "s"(p1) : "memory");
}
__device__ __forceinline__ float fmix_lo(unsigned sd, float x, float y) { float d; asm("v_fma_mix_f32 %0, %1, %2, %3 op_sel_hi:[1,0,0]" : "=v"(d) : "s"(sd), "v"(x), "v"(y)); return d; }
__device__ __forceinline__ float fmix_hi(unsigned sd, float x, float y) { float d; asm("v_fma_mix_f32 %0, %1, %2, %3 op_sel:[1,0,0] op_sel_hi:[1,0,0]" : "=v"(d) : "s"(sd), "v"(x), "v"(y)); return d; }
constexpr int CL = 64, NCH = T / CL;
constexpr size_t ST_Q_OFF = (size_t)NH * NCH * 64 * 64;
constexpr size_t ST_S_OFF = (size_t)NH * NCH * 64 * 64;

__device__ __forceinline__ float vmix_lo(unsigned vd, float x, float y) { float d; asm("v_fma_mix_f32 %0, %1, %2, %3 op_sel_hi:[1,0,0]" : "=v"(d) : "v"(vd), "v"(x), "v"(y)); return d; }
__device__ __forceinline__ float vmix_hi(unsigned vd, float x, float y) { float d; asm("v_fma_mix_f32 %0, %1, %2, %3 op_sel:[1,0,0] op_sel_hi:[1,0,0]" : "=v"(d) : "v"(vd), "v"(x), "v"(y)); return d; }
template <int N> __device__ __forceinline__ void fmac_bc(float& acc, float vec, float x) { asm("v_fmac_f32_dpp %0, %1, %2 row_newbcast:%3 row_mask:0xf bank_mask:0xf" : "+v"(acc) : "v"(vec), "v"(x), "n"(N)); }
template <int N> __device__ __forceinline__ float mul_bc(float vec, float x) { float d; asm("v_mul_f32_dpp %0, %1, %2 row_newbcast:%3 row_mask:0xf bank_mask:0xf" : "=v"(d) : "v"(vec), "v"(x), "n"(N)); return d; }
struct SVec { float v[4]; };
__device__ __forceinline__ f16x4 sv_read(const LAS3 unsigned char* p, int lane) { return *(const LAS3 f16x4*)(p + (lane & 15) * 8); }
__device__ __forceinline__ void sv_cvt(SVec& o, f16x4 h) { o.v[0] = (float)h[0]; o.v[1] = (float)h[1]; o.v[2] = (float)h[2]; o.v[3] = (float)h[3]; }
__device__ __forceinline__ void sv_cvt1p(SVec& o, f16x4 h) { o.v[0] = 1.0f + (float)h[0]; o.v[1] = 1.0f + (float)h[1]; o.v[2] = 1.0f + (float)h[2]; o.v[3] = 1.0f + (float)h[3]; }
template <int J> __device__ __forceinline__ void sc_dot(float (&d)[4], const SVec& A, const float (&X)[64]) { fmac_bc<(J >> 2)>(d[J & 3], A.v[J & 3], X[J]); if constexpr (J + 1 < 64) sc_dot<J + 1>(d, A, X); }
template <int J> __device__ __forceinline__ void sc_upd3(float (&S)[64], float (&y)[4], const SVec& Wv, const SVec& Bv, const SVec& Kv, const SVec& Rv, float sa, float vv) {
    float sj = mul_bc<(J >> 2)>(Wv.v[J & 3], S[J]); fmac_bc<(J >> 2)>(sj, Bv.v[J & 3], sa); fmac_bc<(J >> 2)>(sj, Kv.v[J & 3], vv); S[J] = sj; fmac_bc<(J >> 2)>(y[J & 3], Rv.v[J & 3], sj);
    if constexpr (J + 1 < 64) sc_upd3<J + 1>(S, y, Wv, Bv, Kv, Rv, sa, vv); }
template <int J> __device__ __forceinline__ void sc_upd1(float (&Q)[64], float (&P)[64], const SVec& Wv, const SVec& Bv, const SVec& Kv, float saq, float sap, float vv) {
    float qj = mul_bc<(J >> 2)>(Wv.v[J & 3], Q[J]); fmac_bc<(J >> 2)>(qj, Bv.v[J & 3], saq); fmac_bc<(J >> 2)>(qj, Kv.v[J & 3], vv); Q[J] = qj;
    float pj = mul_bc<(J >> 2)>(Wv.v[J & 3], P[J]); fmac_bc<(J >> 2)>(pj, Bv.v[J & 3], sap); P[J] = pj;
    if constexpr (J + 1 < 64) sc_upd1<J + 1>(Q, P, Wv, Bv, Kv, saq, sap, vv); }
constexpr int SCB = 8;
constexpr int SC_NS = 7, SC_BUF = SC_NS * 1024, SC_WAVE = 2 * SC_BUF;
__device__ __forceinline__ void sc_dma(const f16* X, size_t eoff, LAS3 unsigned char* dst) {
    __builtin_amdgcn_global_load_lds((const unsigned*)(X + eoff), (LAS3 unsigned*)dst, 16, 0, 0);
}

__device__ __forceinline__ void phase_scan1(ArgsR a, const Ctx& c) {
    const f16* WM1 = (const f16*)(a.ws + WS_WM1); const f16* KP = (const f16*)(a.ws + WS_KP);
    const f16* AA = (const f16*)(a.ws + WS_AA); const f16* BB = (const f16*)(a.ws + WS_BB); const f16* V = (const f16*)(a.ws + WS_V);
    float* ST = (float*)(a.ws + WS_ST);
    const int lane = c.lane;
    LAS3 unsigned char* ring = (LAS3 unsigned char*)c.lds + c.wave * SC_WAVE;
    for (int item = c.gw; item < NH * NCH; item += c.ngw) {
        const int h = __builtin_amdgcn_readfirstlane(item / NCH), ch = __builtin_amdgcn_readfirstlane(item % NCH);
        float Q[64], P[64];
        int ln_ = lane; asm volatile("" : "+v"(ln_));
#pragma unroll
        for (int j = 0; j < 64; ++j) { Q[j] = 0.f; P[j] = (j == ln_) ? 1.f : 0.f; }
        const size_t lane_off = (size_t)(lane >> 3) * W + h * 64 + (lane & 7) * 8;
        { const size_t e0 = (size_t)(ch * CL) * W + lane_off;
          sc_dma(AA, e0, ring); sc_dma(WM1, e0, ring + 1024); sc_dma(BB, e0, ring + 2048); sc_dma(KP, e0, ring + 3072); sc_dma(V, e0, ring + 4096); }
#pragma unroll 1
        for (int blk = 0; blk < CL / SCB; ++blk) {
            LAS3 unsigned char* buf = ring + (blk & 1) * SC_BUF;
            if (blk + 1 < CL / SCB) { LAS3 unsigned char* nb = ring + ((blk + 1) & 1) * SC_BUF; const size_t e0 = (size_t)(ch * CL + (blk + 1) * SCB) * W + lane_off;
                sc_dma(AA, e0, nb); sc_dma(WM1, e0, nb + 1024); sc_dma(BB, e0, nb + 2048); sc_dma(KP, e0, nb + 3072); sc_dma(V, e0, nb + 4096);
                asm volatile("s_waitcnt vmcnt(5)" ::: "memory"); }
            else asm volatile("s_waitcnt vmcnt(0)" ::: "memory");
            SVec A, Wv, Bv, Kv;
            sv_cvt(A, sv_read(buf, lane)); sv_cvt1p(Wv, sv_read(buf + 1024, lane)); sv_cvt(Bv, sv_read(buf + 2048, lane)); sv_cvt(Kv, sv_read(buf + 3072, lane));
            float vv = (float)*(const LAS3 f16*)(buf + 4096 + lane * 2);
#pragma unroll 1
            for (int st = 0; st < SCB; ++st) {
                const LAS3 unsigned char* sn = buf + ((st + 1 < SCB) ? st + 1 : st) * 128;
                const f16x4 ha = sv_read(sn, lane), hw = sv_read(sn + 1024, lane), hb = sv_read(sn + 2048, lane), hk = sv_read(sn + 3072, lane);
                const f16 hv = *(const LAS3 f16*)(sn + 4096 + lane * 2);
                float dq[4] = {0.f, 0.f, 0.f, 0.f}, dp[4] = {0.f, 0.f, 0.f, 0.f};
                sc_dot<0>(dq, A, Q); sc_dot<0>(dp, A, P);
                const float saq = (dq[0] + dq[1]) + (dq[2] + dq[3]), sap = (dp[0] + dp[1]) + (dp[2] + dp[3]);
                sc_upd1<0>(Q, P, Wv, Bv, Kv, saq, sap, vv);
                sv_cvt(A, ha); sv_cvt1p(Wv, hw); sv_cvt(Bv, hb); sv_cvt(Kv, hk); vv = (float)hv;
            }
        }
        float* Qp = ST + ST_Q_OFF + (size_t)(h * NCH + ch) * 4096 + lane;
        bf16* PTp = (bf16*)ST + (size_t)(h * NCH + ch) * 4096 + lane;
#pragma unroll
        for (int j = 0; j < 64; ++j) { PTp[j * 64] = f2bf(P[j]); Qp[j * 64] = Q[j]; }
    }
}
constexpr int GS = 16, NG = NCH / GS;
constexpr size_t ST_LP_OFF = (size_t)NH * NCH * 4096;
constexpr size_t WS_SG = WS_LORA + 2 * MiB;
constexpr int HI_LD = 72, HI_BYTES = 64 * HI_LD * 2;
struct HFrag { bf16x8 b[2][2]; f32x4 q[2]; };
__device__ __forceinline__ void hload(HFrag& f, const bf16* Bt, const float* QTc, int boff, int qtoff) {
#pragma unroll
    for (int ks = 0; ks < 2; ++ks)
#pragma unroll
        for (int n = 0; n < 2; ++n) f.b[ks][n] = *(const bf16x8*)(Bt + boff + 16 * n * 64 + 32 * ks);
#pragma unroll
    for (int n = 0; n < 2; ++n) f.q[n] = *(const f32x4*)(QTc + qtoff + 16 * n * 64);
}
__device__ __forceinline__ void hmma(const LAS3 unsigned char* img, const bf16x8 (&b)[2][2], f32x4 (&acc)[2], int m, int fr, int fq) {
#pragma unroll
    for (int ks = 0; ks < 2; ++ks) { const bf16x8 av = *(const LAS3 bf16x8*)(img + ((16 * m + fr) * HI_LD + 32 * ks + 8 * fq) * 2);
#pragma unroll
        for (int n = 0; n < 2; ++n) acc[n] = __builtin_amdgcn_mfma_f32_16x16x32_bf16(av, b[ks][n], acc[n], 0, 0, 0); }
}
__device__ __forceinline__ void himg_store(LAS3 unsigned char* img, const f32x4 (&acc)[2], int m, int n0, int fr, int fq) {
#pragma unroll
    for (int n = 0; n < 2; ++n)
#pragma unroll
        for (int i = 0; i < 4; ++i) *(LAS3 bf16*)(img + ((16 * m + 4 * fq + i) * HI_LD + n0 + 16 * n + fr) * 2) = f2bf(acc[n][i]);
}
#define HBAR() do { asm volatile("s_waitcnt lgkmcnt(0)" ::: "memory"); __builtin_amdgcn_s_barrier(); asm volatile("" ::: "memory"); } while (0)

__device__ __forceinline__ void sc2a_step(const HFrag& f, bf16* LpTc, float* QTc, const LAS3 unsigned char* ip, LAS3 unsigned char* ipn, const LAS3 unsigned char* iq, LAS3 unsigned char* iqn, int m, int n0, int fr, int fq, int qtoff) {
    f32x4 ap[2], aq[2];
#pragma unroll
    for (int n = 0; n < 2; ++n) { ap[n] = (f32x4){0.f, 0.f, 0.f, 0.f}; aq[n] = f.q[n]; }
    hmma(ip, f.b, ap, m, fr, fq); hmma(iq, f.b, aq, m, fr, fq);
#pragma unroll
    for (int n = 0; n < 2; ++n) { u32x2 w; w.x = pk2(ap[n][0], ap[n][1]); w.y = pk2(ap[n][2], ap[n][3]);
        *(u32x2*)(LpTc + (n0 + 16 * n + fr) * 64 + 16 * m + 4 * fq) = w;
        *(f32x4*)(QTc + qtoff + 16 * n * 64) = aq[n]; }
    himg_store(ipn, ap, m, n0, fr, fq); himg_store(iqn, aq, m, n0, fr, fq);
    HBAR();
}
__device__ __forceinline__ void phase_scan2a(ArgsR a, const Ctx& c) {
    const int lane = c.lane, wv = c.wave, fr = lane & 15, fq = lane >> 4, m = wv >> 1, n0 = 32 * (wv & 1);
    const int boff = (n0 + fr) * 64 + 8 * fq, qtoff = (n0 + fr) * 64 + 16 * m + 4 * fq;
    LAS3 unsigned char* L = (LAS3 unsigned char*)c.lds;
    for (int item = blockIdx.x; item < NH * NG; item += gridDim.x) {
        const size_t cb = (size_t)(item / NG) * NCH + (size_t)(item % NG) * GS;
        const bf16* PT = (const bf16*)(a.ws + WS_ST) + cb * 4096; bf16* LP = (bf16*)(a.ws + WS_ST) + ST_LP_OFF + cb * 4096; float* QT = (float*)(a.ws + WS_ST) + ST_Q_OFF + cb * 4096;
        for (int i = c.tid; i < 4 * HI_BYTES / 4; i += NTHREADS) ((LAS3 unsigned*)L)[i] = 0u;
        __syncthreads();
        if (c.tid < 64) *(LAS3 bf16*)(L + (c.tid * HI_LD + c.tid) * 2) = (bf16)0x3F80;
        __syncthreads();
        HFrag f0, f1, f2, f3;
        hload(f0, PT, QT, boff, qtoff); hload(f1, PT + 4096, QT + 4096, boff, qtoff); hload(f2, PT + 2 * 4096, QT + 2 * 4096, boff, qtoff); hload(f3, PT + 3 * 4096, QT + 3 * 4096, boff, qtoff);
        LAS3 unsigned char* p0 = L; LAS3 unsigned char* p1 = L + HI_BYTES; LAS3 unsigned char* q0 = L + 2 * HI_BYTES; LAS3 unsigned char* q1 = L + 3 * HI_BYTES;
#pragma unroll 1
        for (int i = 0; i < GS; i += 4) {
            const int nx = (i + 4 < GS) ? i + 4 : i;
            sc2a_step(f0, LP + (size_t)(i + 0) * 4096, QT + (size_t)(i + 0) * 4096, p0, p1, q0, q1, m, n0, fr, fq, qtoff); hload(f0, PT + (size_t)(nx + 0) * 4096, QT + (size_t)(nx + 0) * 4096, boff, qtoff);
            sc2a_step(f1, LP + (size_t)(i + 1) * 4096, QT + (size_t)(i + 1) * 4096, p1, p0, q1, q0, m, n0, fr, fq, qtoff); hload(f1, PT + (size_t)(nx + 1) * 4096, QT + (size_t)(nx + 1) * 4096, boff, qtoff);
            sc2a_step(f2, LP + (size_t)(i + 2) * 4096, QT + (size_t)(i + 2) * 4096, p0, p1, q0, q1, m, n0, fr, fq, qtoff); hload(f2, PT + (size_t)(nx + 2) * 4096, QT + (size_t)(nx + 2) * 4096, boff, qtoff);
            sc2a_step(f3, LP + (size_t)(i + 3) * 4096, QT + (size_t)(i + 3) * 4096, p1, p0, q1, q0, m, n0, fr, fq, qtoff); hload(f3, PT + (size_t)(nx + 3) * 4096, QT + (size_t)(nx + 3) * 4096, boff, qtoff);
        }
        __syncthreads();
    }
}
__device__ __forceinline__ void phase_scan2b(ArgsR a, const Ctx& c) {
    if (blockIdx.x >= NH) return;
    const int h = blockIdx.x, lane = c.lane, wv = c.wave, fr = lane & 15, fq = lane >> 4, m = wv >> 1, n0 = 32 * (wv & 1);
    const int boff = (n0 + fr) * 64 + 8 * fq, qtoff = (n0 + fr) * 64 + 16 * m + 4 * fq;
    LAS3 unsigned char* L = (LAS3 unsigned char*)c.lds;
    const bf16* LP = (const bf16*)(a.ws + WS_ST) + ST_LP_OFF + (size_t)h * NCH * 4096; const float* QT = (const float*)(a.ws + WS_ST) + ST_Q_OFF + (size_t)h * NCH * 4096;
    bf16* SG = (bf16*)(a.ws + WS_SG) + (size_t)h * NG * 4096;
    for (int i = c.tid; i < 2 * HI_BYTES / 4; i += NTHREADS) ((LAS3 unsigned*)L)[i] = 0u;
    for (int i = c.tid; i < 4096 / 2; i += NTHREADS) ((LAS3 unsigned*)(L + 2 * HI_BYTES))[i] = 0u;
    __syncthreads();
    HFrag f0, f1, f2, f3;
#define SC2B_CH(g) ((size_t)((g) * GS + GS - 1) * 4096)
    hload(f0, LP + SC2B_CH(0), QT + SC2B_CH(0), boff, qtoff); hload(f1, LP + SC2B_CH(1), QT + SC2B_CH(1), boff, qtoff); hload(f2, LP + SC2B_CH(2), QT + SC2B_CH(2), boff, qtoff); hload(f3, LP + SC2B_CH(3), QT + SC2B_CH(3), boff, qtoff);
    LAS3 unsigned char* i0 = L; LAS3 unsigned char* i1 = L + HI_BYTES;
#define SC2B_STEP(f, g, ic, in) do { f32x4 acc[2] = {f.q[0], f.q[1]}; hmma(ic, f.b, acc, m, fr, fq); LAS3 bf16* So = (LAS3 bf16*)(L + 2 * HI_BYTES) + (((g) + 1) & 7) * 4096; \
        _Pragma("unroll") for (int n = 0; n < 2; ++n) _Pragma("unroll") for (int i = 0; i < 4; ++i) So[(16 * m + 4 * fq + i) * 64 + n0 + 16 * n + fr] = f2bf(acc[n][i]); \
        himg_store(in, acc, m, n0, fr, fq); HBAR(); } while (0)
#pragma unroll 1
    for (int g = 0; g < NG; g += 4) {
        const int nx = (g + 4 < NG) ? g + 4 : g;
        SC2B_STEP(f0, g + 0, i0, i1); hload(f0, LP + SC2B_CH(nx + 0), QT + SC2B_CH(nx + 0), boff, qtoff);
        SC2B_STEP(f1, g + 1, i1, i0); hload(f1, LP + SC2B_CH(nx + 1), QT + SC2B_CH(nx + 1), boff, qtoff);
        SC2B_STEP(f2, g + 2, i0, i1); hload(f2, LP + SC2B_CH(nx + 2), QT + SC2B_CH(nx + 2), boff, qtoff);
        if ((g & 7) == 4) {
            for (int i = c.tid; i < 8 * 4096 / 8; i += NTHREADS) ((u32x4*)(SG + (size_t)(g >> 3) * 8 * 4096))[i] = ((const LAS3 u32x4*)(L + 2 * HI_BYTES))[i];
            HBAR(); }
        if (g + 3 < NG - 1) SC2B_STEP(f3, g + 3, i1, i0);
        hload(f3, LP + SC2B_CH(nx + 3), QT + SC2B_CH(nx + 3), boff, qtoff);
    }
#undef SC2B_STEP
#undef SC2B_CH
}
__device__ __forceinline__ void phase_scan2c(ArgsR a, const Ctx& c) {
    const int lane = c.lane, wv = c.wave, fr = lane & 15, fq = lane >> 4, m = wv >> 1, n0 = 32 * (wv & 1);
    const int boff = (n0 + fr) * 64 + 8 * fq, qtoff = (n0 + fr) * 64 + 16 * m + 4 * fq;
    LAS3 unsigned char* L = (LAS3 unsigned char*)c.lds;
    for (int item = blockIdx.x; item < NH * NG * 2; item += gridDim.x) {
        const int hg = item >> 1, hf = item & 1;
        const size_t cb = (size_t)(hg / NG) * NCH + (size_t)(hg % NG) * GS + hf * 8;
        const bf16* LP = (const bf16*)(a.ws + WS_ST) + ST_LP_OFF + cb * 4096; const float* QT = (const float*)(a.ws + WS_ST) + ST_Q_OFF + cb * 4096; bf16* SS = (bf16*)(a.ws + WS_ST) + cb * 4096;
        { const u32x4 v = *(const u32x4*)((const bf16*)(a.ws + WS_SG) + (size_t)hg * 4096 + c.tid * 8); *(LAS3 u32x4*)(L + ((c.tid >> 3) * HI_LD + (c.tid & 7) * 8) * 2) = v; }
        __syncthreads();
#pragma unroll 2
        for (int i = 0; i < 8; ++i) { HFrag f; hload(f, LP + (size_t)i * 4096, QT + (size_t)i * 4096, boff, qtoff);
            f32x4 acc[2] = {f.q[0], f.q[1]}; hmma(L, f.b, acc, m, fr, fq); bf16* So = SS + (size_t)i * 4096;
#pragma unroll
            for (int n = 0; n < 2; ++n)
#pragma unroll
                for (int k = 0; k < 4; ++k) So[(16 * m + 4 * fq + k) * 64 + n0 + 16 * n + fr] = f2bf(acc[n][k]); }
        __syncthreads();
    }
}
constexpr int WI_LD = 72, WI_B = 64 * WI_LD * 2, WI_GAM = 9 * WI_B, WI_GL = 15 * WI_B;
constexpr size_t WS_GM0 = 352 * MiB, WS_GM1 = 212 * MiB, WS_Y0 = 336 * MiB, WS_END2 = 360 * MiB;
__device__ __forceinline__ bf16* gm_ptr(unsigned char* ws, int h, int ch) { return (bf16*)(ws + (h < 4 ? WS_GM0 : WS_GM1)) + (size_t)((h & 3) * NCH + ch) * 4096; }
__device__ __forceinline__ void wi_mma(f32x4 (&acc)[2], const LAS3 unsigned char* A, const LAS3 unsigned char* Bt, int m, int n0, int fr, int fq) {
#pragma unroll
    for (int ks = 0; ks < 2; ++ks) { const bf16x8 av = *(const LAS3 bf16x8*)(A + ((16 * m + fr) * WI_LD + 32 * ks + 8 * fq) * 2);
#pragma unroll
        for (int n = 0; n < 2; ++n) { const bf16x8 bv = *(const LAS3 bf16x8*)(Bt + ((n0 + 16 * n + fr) * WI_LD + 32 * ks + 8 * fq) * 2); acc[n] = __builtin_amdgcn_mfma_f32_16x16x32_bf16(av, bv, acc[n], 0, 0, 0); } }
}
struct WiA { bf16x8 a[2]; }; struct WiB { bf16x8 b[2][2]; };
__device__ __forceinline__ void wi_lda(WiA& f, const LAS3 unsigned char* A, int m, int fr, int fq) {
#pragma unroll
    for (int ks = 0; ks < 2; ++ks) f.a[ks] = *(const LAS3 bf16x8*)(A + ((16 * m + fr) * WI_LD + 32 * ks + 8 * fq) * 2);
}
__device__ __forceinline__ void wi_ldb(WiB& f, const LAS3 unsigned char* Bt, int n0, int fr, int fq) {
#pragma unroll
    for (int ks = 0; ks < 2; ++ks)
#pragma unroll
        for (int n = 0; n < 2; ++n) f.b[ks][n] = *(const LAS3 bf16x8*)(Bt + ((n0 + 16 * n + fr) * WI_LD + 32 * ks + 8 * fq) * 2);
}
__device__ __forceinline__ void wi_fma(f32x4 (&acc)[2], const WiA& A, const WiB& B) {
#pragma unroll
    for (int ks = 0; ks < 2; ++ks)
#pragma unroll
        for (int n = 0; n < 2; ++n) acc[n] = __builtin_amdgcn_mfma_f32_16x16x32_bf16(A.a[ks], B.b[ks][n], acc[n], 0, 0, 0);
}
__device__ __forceinline__ void wi_fma_s(f32x4 (&acc)[2], const WiA& A, const WiB& B) {
#pragma unroll
    for (int ks = 0; ks < 2; ++ks)
#pragma unroll
        for (int n = 0; n < 2; ++n) acc[n] = __builtin_amdgcn_mfma_f32_16x16x32_bf16(B.b[ks][n], A.a[ks], acc[n], 0, 0, 0);
}
__device__ __forceinline__ void wi_st_nat_s(LAS3 unsigned char* X, const f32x4 (&acc)[2], int m, int n0, int fr, int fq) {
#pragma unroll
    for (int n = 0; n < 2; ++n) { u32x2 w; w.x = pk2(acc[n][0], acc[n][1]); w.y = pk2(acc[n][2], acc[n][3]); *(LAS3 u32x2*)(X + ((16 * m + fr) * WI_LD + n0 + 16 * n + 4 * fq) * 2) = w; }
}
__device__ __forceinline__ void wi_ld_nat_s(f32x4 (&acc)[2], const LAS3 unsigned char* X, int m, int n0, int fr, int fq) {
#pragma unroll
    for (int n = 0; n < 2; ++n) { const u32x2 w = *(const LAS3 u32x2*)(X + ((16 * m + fr) * WI_LD + n0 + 16 * n + 4 * fq) * 2);
        acc[n][0] = __uint_as_float(w.x << 16); acc[n][1] = __uint_as_float(w.x & 0xffff0000u); acc[n][2] = __uint_as_float(w.y << 16); acc[n][3] = __uint_as_float(w.y & 0xffff0000u); }
}
__device__ __forceinline__ void wi_ld_tr(f32x4 (&acc)[2], const LAS3 unsigned char* XT, int m, int n0, int fr, int fq) {
#pragma unroll
    for (int n = 0; n < 2; ++n) { const u32x2 w = *(const LAS3 u32x2*)(XT + ((n0 + 16 * n + fr) * WI_LD + 16 * m + 4 * fq) * 2);
        acc[n][0] = __uint_as_float(w.x << 16); acc[n][1] = __uint_as_float(w.x & 0xffff0000u); acc[n][2] = __uint_as_float(w.y << 16); acc[n][3] = __uint_as_float(w.y & 0xffff0000u); }
}
#define WI_PIN() __builtin_amdgcn_sched_barrier(0)
__device__ __forceinline__ void wi_st_nat(LAS3 unsigned char* X, const f32x4 (&acc)[2], int m, int n0, int fr, int fq) {
#pragma unroll
    for (int n = 0; n < 2; ++n)
#pragma unroll
        for (int i = 0; i < 4; ++i) *(LAS3 bf16*)(X + ((16 * m + 4 * fq + i) * WI_LD + n0 + 16 * n + fr) * 2) = f2bf(acc[n][i]);
}
__device__ __forceinline__ void wi_st_tr(LAS3 unsigned char* XT, const f32x4 (&acc)[2], int m, int n0, int fr, int fq) {
#pragma unroll
    for (int n = 0; n < 2; ++n) { u32x2 w; w.x = pk2(acc[n][0], acc[n][1]); w.y = pk2(acc[n][2], acc[n][3]); *(LAS3 u32x2*)(XT + ((n0 + 16 * n + fr) * WI_LD + 16 * m + 4 * fq) * 2) = w; }
}
__device__ __forceinline__ void wi_ld_nat(f32x4 (&acc)[2], const LAS3 unsigned char* X, int m, int n0, int fr, int fq) {
#pragma unroll
    for (int n = 0; n < 2; ++n)
#pragma unroll
        for (int i = 0; i < 4; ++i) acc[n][i] = bf2f(*(const LAS3 bf16*)(X + ((16 * m + 4 * fq + i) * WI_LD + n0 + 16 * n + fr) * 2));
}
__device__ __forceinline__ void phase_scan1m(ArgsR a, const Ctx& c, const int skip = 0) {
    const f16* WM1 = (const f16*)(a.ws + WS_WM1); const f16* KP = (const f16*)(a.ws + WS_KP);
    const f16* AA = (const f16*)(a.ws + WS_AA); const f16* BB = (const f16*)(a.ws + WS_BB); const f16* V = (const f16*)(a.ws + WS_V); const f16* R = (const f16*)(a.ws + WS_R);
    float* ST = (float*)(a.ws + WS_ST);
    LAS3 unsigned char* L = (LAS3 unsigned char*)c.lds;
    LAS3 float* GAM = (LAS3 float*)(L + WI_GAM); LAS3 float* GL = (LAS3 float*)(L + WI_GL);
    const int lane = c.lane, wv = c.wave, fr = lane & 15, fq = lane >> 4, m = wv >> 1, n0 = 32 * (wv & 1), tid = c.tid;
#define SLOT(i) (L + (i) * WI_B)
    const int t = tid >> 3, cc = (tid & 7) * 8;
    f16x8 pav, pbv, pkv, pvv, prv, pwv;
#define WI_FETCH(it) do { const int h_ = (it) / NCH, ch_ = (it) % NCH; const size_t eo_ = (size_t)(ch_ * CL + t) * W + h_ * 64 + cc; \
        pav = *(const f16x8*)(AA + eo_); pbv = *(const f16x8*)(BB + eo_); pkv = *(const f16x8*)(KP + eo_); pvv = *(const f16x8*)(V + eo_); prv = *(const f16x8*)(R + eo_); pwv = *(const f16x8*)(WM1 + eo_); } while (0)
    if (blockIdx.x < NH * NCH) WI_FETCH(blockIdx.x);
    for (int item = blockIdx.x; item < NH * NCH; item += gridDim.x) {
        const int h = item / NCH, ch = item % NCH;
        const f16x8 av = pav, bv = pbv, kv = pkv, vv = pvv, rv = prv, wv8 = pwv;
        if (item + (int)gridDim.x < NH * NCH) WI_FETCH(item + (int)gridDim.x);
        float g[8], gp[8];
        { float wloc[8];
#pragma unroll
          for (int e = 0; e < 8; ++e) wloc[e] = 1.0f + (float)wv8[e];
#pragma unroll
          for (int e = 0; e < 8; ++e) { float x = wloc[e];
              { const float y = __shfl_up(x, 8); if (lane >= 8) x *= y; } { const float y = __shfl_up(x, 16); if (lane >= 16) x *= y; } { const float y = __shfl_up(x, 32); if (lane >= 32) x *= y; }
              g[e] = x; }
          if (lane >= 56) {
#pragma unroll
              for (int e = 0; e < 8; ++e) GAM[wv * 64 + cc + e] = g[e]; }
          HBAR();
#pragma unroll
          for (int e = 0; e < 8; ++e) { float pre = 1.0f;
#pragma unroll
              for (int w = 0; w < 7; ++w) if (w < wv) pre *= GAM[w * 64 + cc + e];
              g[e] *= pre; gp[e] = g[e] * __builtin_amdgcn_rcpf(wloc[e]); } }
        { float fa[8], fb[8], fk[8], fv[8], frr[8];
#pragma unroll
          for (int e = 0; e < 8; ++e) { const float ig = __builtin_amdgcn_rcpf(g[e]);
              fa[e] = (float)av[e] * gp[e]; fb[e] = (float)bv[e] * ig; fk[e] = (float)kv[e] * ig; fv[e] = (float)vv[e]; frr[e] = (float)rv[e] * g[e]; if (t == 63) GL[cc + e] = g[e]; }
          *(LAS3 u32x4*)(SLOT(0) + (t * WI_LD + cc) * 2) = pack8bf(fa); *(LAS3 u32x4*)(SLOT(2) + (t * WI_LD + cc) * 2) = pack8bf(fb); *(LAS3 u32x4*)(SLOT(4) + (t * WI_LD + cc) * 2) = pack8bf(fk); *(LAS3 u32x4*)(SLOT(12) + (t * WI_LD + cc) * 2) = pack8bf(frr);
          *(LAS3 u32x4*)(SLOT(10) + (t * WI_LD + cc) * 2) = pack8bf(fv); }
        HBAR();
        { WiA aB, aK; WiB bA, bR; wi_lda(aB, SLOT(2), m, fr, fq); wi_lda(aK, SLOT(4), m, fr, fq); wi_ldb(bA, SLOT(0), n0, fr, fq); wi_ldb(bR, SLOT(12), n0, fr, fq);
          const int tch = tid & 63, tt0 = (tid >> 6) * 8; bf16 ta[8], tb[8], tv[8];
#pragma unroll
          for (int e = 0; e < 8; ++e) { ta[e] = *(const LAS3 bf16*)(SLOT(0) + ((tt0 + e) * WI_LD + tch) * 2); tb[e] = *(const LAS3 bf16*)(SLOT(2) + ((tt0 + e) * WI_LD + tch) * 2); tv[e] = *(const LAS3 bf16*)(SLOT(10) + ((tt0 + e) * WI_LD + tch) * 2); }
          WI_PIN();
          { u32x4 wa, wb, wv4;
#pragma unroll
            for (int e = 0; e < 4; ++e) { wa[e] = (unsigned)ta[2 * e] | ((unsigned)ta[2 * e + 1] << 16); wb[e] = (unsigned)tb[2 * e] | ((unsigned)tb[2 * e + 1] << 16); wv4[e] = (unsigned)tv[2 * e] | ((unsigned)tv[2 * e + 1] << 16); }
            *(LAS3 u32x4*)(SLOT(1) + (tch * WI_LD + tt0) * 2) = wa; *(LAS3 u32x4*)(SLOT(3) + (tch * WI_LD + tt0) * 2) = wb; *(LAS3 u32x4*)(SLOT(5) + (tch * WI_LD + tt0) * 2) = wv4; }
          f32x4 ans[2] = {{0.f, 0.f, 0.f, 0.f}, {0.f, 0.f, 0.f, 0.f}}, ant[2] = {{0.f, 0.f, 0.f, 0.f}, {0.f, 0.f, 0.f, 0.f}}, aks[2] = {{0.f, 0.f, 0.f, 0.f}, {0.f, 0.f, 0.f, 0.f}}, am[2] = {{0.f, 0.f, 0.f, 0.f}, {0.f, 0.f, 0.f, 0.f}}, amk[2] = {{0.f, 0.f, 0.f, 0.f}, {0.f, 0.f, 0.f, 0.f}};
          wi_fma_s(ans, aB, bA); wi_fma(ant, aB, bA); wi_fma_s(aks, aK, bA); wi_fma(am, aB, bR); wi_fma(amk, aK, bR);
          WI_PIN();
          f32x4 axs[2];
#pragma unroll
          for (int n = 0; n < 2; ++n)
#pragma unroll
              for (int i = 0; i < 4; ++i) { const int rs = 16 * m + fr, cs = n0 + 16 * n + 4 * fq + i;
                  if (!(rs < cs)) { ans[n][i] = 0.f; aks[n][i] = 0.f; } axs[n][i] = ans[n][i] + (rs == cs ? 1.0f : 0.f);
                  const int rn = 16 * m + 4 * fq + i, cn = n0 + 16 * n + fr;
                  if (!(rn < cn)) ant[n][i] = 0.f; if (rn > cn) { am[n][i] = 0.f; amk[n][i] = 0.f; } }
          wi_st_nat_s(SLOT(7), ans, m, n0, fr, fq); wi_st_tr(SLOT(8), ant, m, n0, fr, fq); wi_st_nat_s(SLOT(6), aks, m, n0, fr, fq); wi_st_nat_s(SLOT(11), axs, m, n0, fr, fq);
          wi_st_tr(SLOT(13), am, m, n0, fr, fq); wi_st_tr(SLOT(14), amk, m, n0, fr, fq); }
        HBAR();
        { WiA aN; WiB bN; wi_lda(aN, SLOT(7), m, fr, fq); wi_ldb(bN, SLOT(8), n0, fr, fq); WI_PIN();
          f32x4 a2s[2] = {{0.f, 0.f, 0.f, 0.f}, {0.f, 0.f, 0.f, 0.f}}, a2t[2] = {{0.f, 0.f, 0.f, 0.f}, {0.f, 0.f, 0.f, 0.f}}; wi_fma_s(a2s, aN, bN); wi_fma(a2t, aN, bN); WI_PIN();
          wi_st_nat_s(SLOT(9), a2s, m, n0, fr, fq); wi_st_tr(SLOT(10), a2t, m, n0, fr, fq); }
        HBAR();
#define WI_LEVEL(XS, XD, NS, NST, ND, NDT) do { WiA aX, aN; WiB bN; f32x4 ax[2]; wi_lda(aX, SLOT(XS), m, fr, fq); wi_ldb(bN, SLOT(NST), n0, fr, fq); wi_lda(aN, SLOT(NS), m, fr, fq); wi_ld_nat_s(ax, SLOT(XS), m, n0, fr, fq); \
            WI_PIN(); f32x4 aqs[2] = {{0.f, 0.f, 0.f, 0.f}, {0.f, 0.f, 0.f, 0.f}}, aqt[2] = {{0.f, 0.f, 0.f, 0.f}, {0.f, 0.f, 0.f, 0.f}}; wi_fma_s(ax, aX, bN); wi_fma_s(aqs, aN, bN); wi_fma(aqt, aN, bN); WI_PIN(); \
            wi_st_nat_s(SLOT(XD), ax, m, n0, fr, fq); wi_st_nat_s(SLOT(ND), aqs, m, n0, fr, fq); wi_st_tr(SLOT(NDT), aqt, m, n0, fr, fq); \
            HBAR(); } while (0)
        WI_LEVEL(11, 0, 9, 10, 7, 8);
        WI_LEVEL(0, 11, 7, 8, 9, 10);
        WI_LEVEL(11, 0, 9, 10, 7, 8);
        WI_LEVEL(0, 11, 7, 8, 9, 10);
#undef WI_LEVEL
        { WiA aX; WiB bN; f32x4 ax[2]; wi_lda(aX, SLOT(11), m, fr, fq); wi_ldb(bN, SLOT(10), n0, fr, fq); wi_ld_nat(ax, SLOT(11), m, n0, fr, fq); WI_PIN();
          wi_fma(ax, aX, bN); WI_PIN(); wi_st_tr(SLOT(0), ax, m, n0, fr, fq); }
        HBAR();
        { WiA aNk, aAt; WiB bT; wi_lda(aNk, SLOT(6), m, fr, fq); wi_lda(aAt, SLOT(1), m, fr, fq); wi_ldb(bT, SLOT(0), n0, fr, fq); WI_PIN();
          f32x4 aw[2] = {{0.f, 0.f, 0.f, 0.f}, {0.f, 0.f, 0.f, 0.f}}, aa[2] = {{0.f, 0.f, 0.f, 0.f}, {0.f, 0.f, 0.f, 0.f}}; wi_fma_s(aw, aNk, bT); wi_fma_s(aa, aAt, bT); WI_PIN();
          wi_st_nat_s(SLOT(2), aw, m, n0, fr, fq); wi_st_nat_s(SLOT(7), aa, m, n0, fr, fq); }
        HBAR();
        { WiA aAT, aW1; WiB bB, bM; f32x4 ap[2] = {{0.f, 0.f, 0.f, 0.f}, {0.f, 0.f, 0.f, 0.f}}, az[2], ag[2], az2[2]; float gl[2];
          wi_lda(aAT, SLOT(7), m, fr, fq); wi_lda(aW1, SLOT(2), m, fr, fq); wi_ldb(bB, SLOT(3), n0, fr, fq); wi_ldb(bM, SLOT(13), n0, fr, fq);
          wi_ld_nat(az, SLOT(4), m, n0, fr, fq); wi_ld_tr(az2, SLOT(14), m, n0, fr, fq); wi_ld_tr(ag, SLOT(12), m, n0, fr, fq);
#pragma unroll
          for (int n = 0; n < 2; ++n) gl[n] = GL[n0 + 16 * n + fr];
          WI_PIN();
          wi_fma(ap, aAT, bB); wi_fma(az, aW1, bB); wi_fma(ag, aAT, bM); wi_fma(az2, aW1, bM);
          WI_PIN();
          wi_st_tr(SLOT(8), az, m, n0, fr, fq); wi_st_tr(SLOT(9), az2, m, n0, fr, fq);
          bf16* PTp = (bf16*)ST + (size_t)(h * NCH + ch) * 4096; bf16* GMp = gm_ptr(a.ws, h, ch);
#pragma unroll
          for (int n = 0; n < 2; ++n) { const int col = n0 + 16 * n + fr; f32x4 pv = ap[n];
#pragma unroll
              for (int i = 0; i < 4; ++i) { if (16 * m + 4 * fq + i == col) pv[i] += 1.0f; pv[i] *= gl[n]; }
              u32x2 w; w.x = pk2(pv[0], pv[1]); w.y = pk2(pv[2], pv[3]); *(u32x2*)(PTp + col * 64 + 16 * m + 4 * fq) = w;
              u32x2 w2; w2.x = pk2(ag[n][0], ag[n][1]); w2.y = pk2(ag[n][2], ag[n][3]); *(u32x2*)(GMp + col * 64 + 16 * m + 4 * fq) = w2; } }
        HBAR();
        { WiA aV; WiB bZ1, bZ2; float gl[2]; wi_lda(aV, SLOT(5), m, fr, fq); wi_ldb(bZ1, SLOT(8), n0, fr, fq); wi_ldb(bZ2, SLOT(9), n0, fr, fq); gl[0] = GL[n0 + fr]; gl[1] = GL[n0 + 16 + fr]; WI_PIN();
          f32x4 aq[2] = {{0.f, 0.f, 0.f, 0.f}, {0.f, 0.f, 0.f, 0.f}}, ay[2] = {{0.f, 0.f, 0.f, 0.f}, {0.f, 0.f, 0.f, 0.f}}; wi_fma(aq, aV, bZ1); wi_fma(ay, aV, bZ2); WI_PIN();
          float* QTp = ST + ST_Q_OFF + (size_t)(h * NCH + ch) * 4096; bf16* Y0p = (bf16*)(a.ws + WS_Y0) + (size_t)(h * NCH + ch) * 4096;
#pragma unroll
          for (int n = 0; n < 2; ++n) { const int col = n0 + 16 * n + fr; *(f32x4*)(QTp + col * 64 + 16 * m + 4 * fq) = aq[n] * gl[n];
              u32x2 w; w.x = pk2(ay[n][0], ay[n][1]); w.y = pk2(ay[n][2], ay[n][3]); *(u32x2*)(Y0p + col * 64 + 16 * m + 4 * fq) = w; } }
        HBAR();
    }
#undef SLOT
#undef WI_FETCH
}

__device__ __forceinline__ void phase_scan3m(ArgsR a, const Ctx& c, int l) {
    const f16* R = (const f16*)(a.ws + WS_R); const f16* KP = (const f16*)(a.ws + WS_KP); const f16* V = (const f16*)(a.ws + WS_V); const bf16* G = (const bf16*)(a.ws + WS_G);
    bf16* YA = (bf16*)(a.ws + WS_YA);
    LAS3 unsigned char* L = (LAS3 unsigned char*)c.lds;
    LAS3 float* YL = (LAS3 float*)(L + WI_B);
    LAS3 unsigned char* S0I = L + 3 * WI_B;
    const int lane = c.lane, wv = c.wave, fr = lane & 15, fq = lane >> 4, m = wv >> 1, n0 = 32 * (wv & 1), tid = c.tid;
    const int boff = (n0 + fr) * 64 + 8 * fq, qtoff = (n0 + fr) * 64 + 16 * m + 4 * fq;
    u32x4 pS; bf16x8 pL[2][2]; f32x4 pQ[2]; bf16x8 pB[2][2]; u32x2 pY[2];
#define S3_FETCH(it) do { const int h_ = (it) / NCH, ch_ = (it) % NCH; pS = (u32x4){0u, 0u, 0u, 0u}; \
        _Pragma("unroll") for (int ks = 0; ks < 2; ++ks) _Pragma("unroll") for (int n = 0; n < 2; ++n) pL[ks][n] = (bf16x8){0, 0, 0, 0, 0, 0, 0, 0}; \
        pQ[0] = (f32x4){0.f, 0.f, 0.f, 0.f}; pQ[1] = (f32x4){0.f, 0.f, 0.f, 0.f}; \
        if (ch_ > 0) { const int c1_ = ch_ - 1; pS = *(const u32x4*)((const bf16*)(a.ws + WS_SG) + (size_t)(h_ * NG + c1_ / GS) * 4096 + tid * 8); \
            const bf16* LP_ = (const bf16*)(a.ws + WS_ST) + ST_LP_OFF + (size_t)(h_ * NCH + c1_) * 4096; const float* QT_ = (const float*)(a.ws + WS_ST) + ST_Q_OFF + (size_t)(h_ * NCH + c1_) * 4096; \
            _Pragma("unroll") for (int ks = 0; ks < 2; ++ks) _Pragma("unroll") for (int n = 0; n < 2; ++n) pL[ks][n] = *(const bf16x8*)(LP_ + boff + 16 * n * 64 + 32 * ks); \
            _Pragma("unroll") for (int n = 0; n < 2; ++n) pQ[n] = *(const f32x4*)(QT_ + qtoff + 16 * n * 64); } \
        const bf16* G_ = gm_ptr(a.ws, h_, ch_); const bf16* Y_ = (const bf16*)(a.ws + WS_Y0) + (size_t)(h_ * NCH + ch_) * 4096; \
        _Pragma("unroll") for (int ks = 0; ks < 2; ++ks) _Pragma("unroll") for (int n = 0; n < 2; ++n) pB[ks][n] = *(const bf16x8*)(G_ + (n0 + 16 * n + fr) * 64 + 32 * ks + 8 * fq); \
        _Pragma("unroll") for (int n = 0; n < 2; ++n) pY[n] = *(const u32x2*)(Y_ + (n0 + 16 * n + fr) * 64 + 16 * m + 4 * fq); } while (0)
    if (blockIdx.x < NH * NCH) S3_FETCH(blockIdx.x);
    for (int item = blockIdx.x; item < NH * NCH; item += gridDim.x) {
        const int h = item / NCH, ch = item % NCH;
        *(LAS3 u32x4*)(L + ((tid >> 3) * WI_LD + (tid & 7) * 8) * 2) = pS;
        bf16x8 lfr[2][2], bfr[2][2]; f32x4 as0[2], acc[2];
#pragma unroll
        for (int ks = 0; ks < 2; ++ks)
#pragma unroll
            for (int n = 0; n < 2; ++n) { lfr[ks][n] = pL[ks][n]; bfr[ks][n] = pB[ks][n]; }
#pragma unroll
        for (int n = 0; n < 2; ++n) { as0[n] = pQ[n]; acc[n][0] = __uint_as_float(pY[n].x << 16); acc[n][1] = __uint_as_float(pY[n].x & 0xffff0000u); acc[n][2] = __uint_as_float(pY[n].y << 16); acc[n][3] = __uint_as_float(pY[n].y & 0xffff0000u); }
        if (item + (int)gridDim.x < NH * NCH) S3_FETCH(item + (int)gridDim.x);
        HBAR();
        hmma(L, lfr, as0, m, fr, fq);
        himg_store(S0I, as0, m, n0, fr, fq);
        HBAR();
#pragma unroll
        for (int ks = 0; ks < 2; ++ks) { const bf16x8 av = *(const LAS3 bf16x8*)(S0I + ((16 * m + fr) * WI_LD + 32 * ks + 8 * fq) * 2);
#pragma unroll
            for (int n = 0; n < 2; ++n) acc[n] = __builtin_amdgcn_mfma_f32_16x16x32_bf16(av, bfr[ks][n], acc[n], 0, 0, 0); }
#pragma unroll
        for (int n = 0; n < 2; ++n)
#pragma unroll
            for (int i = 0; i < 4; ++i) YL[(n0 + 16 * n + fr) * 65 + 16 * m + 4 * fq + i] = acc[n][i];
        HBAR();
        { const float gn_g = a.in[I_GNG][l * W + h * 64 + lane], gn_b = a.in[I_GNB][l * W + h * 64 + lane], r_k = a.in[I_RK][l * W + h * 64 + lane];
          f16 rl8[8], kl8[8], vl8[8]; bf16 gl8[8];
#pragma unroll
          for (int i = 0; i < 8; ++i) { const size_t o = (size_t)(ch * CL + 8 * wv + i) * W + h * 64 + lane; rl8[i] = R[o]; kl8[i] = KP[o]; vl8[i] = V[o]; gl8[i] = G[o]; }
#pragma unroll
          for (int i = 0; i < 8; ++i) { const int t = 8 * wv + i; const size_t o = (size_t)(ch * CL + t) * W + h * 64 + lane;
              const float yy = YL[t * 65 + lane]; const float rl = (float)rl8[i], kl = (float)kl8[i], vl = (float)vl8[i], gl = bf2f(gl8[i]);
              const float mean = wave_sum(yy) * (1.f / 64.f); const float dd = yy - mean; const float var = wave_sum(dd * dd) * (1.f / 64.f);
              const float bonus = wave_sum(rl * kl * r_k);
              const float yn = dd * __builtin_amdgcn_rsqf(var + GN_EPS) * gn_g + gn_b + bonus * vl;
              YA[o] = f2bf(yn * gl); } }
        HBAR();
    }
#undef S3_FETCH
}

__device__ __forceinline__ void phase_scan3(ArgsR a, const Ctx& c, int l) {
    const f16* R = (const f16*)(a.ws + WS_R); const f16* WM1 = (const f16*)(a.ws + WS_WM1); const f16* KP = (const f16*)(a.ws + WS_KP);
    const f16* AA = (const f16*)(a.ws + WS_AA); const f16* BB = (const f16*)(a.ws + WS_BB); const f16* V = (const f16*)(a.ws + WS_V);
    const float* ST = (const float*)(a.ws + WS_ST); bf16* YA = (bf16*)(a.ws + WS_YA); const f16* Gs = (const f16*)(a.ws + WS_G);
    const int lane = c.lane;
    LAS3 unsigned char* ring = (LAS3 unsigned char*)c.lds + c.wave * SC_WAVE;
    for (int item = c.gw; item < NH * NCH; item += c.ngw) {
        const int h = __builtin_amdgcn_readfirstlane(item / NCH), ch = __builtin_amdgcn_readfirstlane(item % NCH);
        const size_t lane_off = (size_t)(lane >> 3) * W + h * 64 + (lane & 7) * 8;
        const float gn_g = a.in[I_GNG][l * W + h * 64 + lane], gn_b = a.in[I_GNB][l * W + h * 64 + lane], r_k = a.in[I_RK][l * W + h * 64 + lane];
        { const size_t e0 = (size_t)(ch * CL) * W + lane_off;
          sc_dma(AA, e0, ring); sc_dma(WM1, e0, ring + 1024); sc_dma(BB, e0, ring + 2048); sc_dma(KP, e0, ring + 3072); sc_dma(V, e0, ring + 4096); sc_dma(R, e0, ring + 5120); sc_dma(Gs, e0, ring + 6144); }
        float S[64];
        if (ch == 0) {
#pragma unroll
            for (int j = 0; j < 64; ++j) S[j] = 0.f;
        } else { const bf16* Sp = (const bf16*)ST + ((size_t)(h * NCH + ch - 1) * 64 + lane) * 64;
#pragma unroll
            for (int j = 0; j < 64; j += 4) { const f32x4 x = load4bf(Sp + j); S[j] = x[0]; S[j + 1] = x[1]; S[j + 2] = x[2]; S[j + 3] = x[3]; } }
#pragma unroll 1
        for (int blk = 0; blk < CL / SCB; ++blk) {
            LAS3 unsigned char* buf = ring + (blk & 1) * SC_BUF;
            if (blk + 1 < CL / SCB) { LAS3 unsigned char* nb = ring + ((blk + 1) & 1) * SC_BUF; const size_t e0 = (size_t)(ch * CL + (blk + 1) * SCB) * W + lane_off;
                sc_dma(AA, e0, nb); sc_dma(WM1, e0, nb + 1024); sc_dma(BB, e0, nb + 2048); sc_dma(KP, e0, nb + 3072); sc_dma(V, e0, nb + 4096); sc_dma(R, e0, nb + 5120); sc_dma(Gs, e0, nb + 6144);
                asm volatile("s_waitcnt vmcnt(7)" ::: "memory"); }
            else asm volatile("s_waitcnt vmcnt(0)" ::: "memory");
            SVec A, Wv, Bv, Kv, Rv;
            sv_cvt(A, sv_read(buf, lane)); sv_cvt1p(Wv, sv_read(buf + 1024, lane)); sv_cvt(Bv, sv_read(buf + 2048, lane)); sv_cvt(Kv, sv_read(buf + 3072, lane)); sv_cvt(Rv, sv_read(buf + 5120, lane));
            float vv = (float)*(const LAS3 f16*)(buf + 4096 + lane * 2);
#pragma unroll 1
            for (int st = 0; st < SCB; ++st) {
                const LAS3 unsigned char* sn = buf + ((st + 1 < SCB) ? st + 1 : st) * 128;
                const f16x4 ha = sv_read(sn, lane), hw = sv_read(sn + 1024, lane), hb = sv_read(sn + 2048, lane), hk = sv_read(sn + 3072, lane), hr = sv_read(sn + 5120, lane);
                const f16 hv = *(const LAS3 f16*)(sn + 4096 + lane * 2);
                float d[4] = {0.f, 0.f, 0.f, 0.f};
                sc_dot<0>(d, A, S);
                const float sa = (d[0] + d[1]) + (d[2] + d[3]);
                float y[4] = {0.f, 0.f, 0.f, 0.f};
                sc_upd3<0>(S, y, Wv, Bv, Kv, Rv, sa, vv);
                const float yy = (y[0] + y[1]) + (y[2] + y[3]);
                sv_cvt(A, ha); sv_cvt1p(Wv, hw); sv_cvt(Bv, hb); sv_cvt(Kv, hk); sv_cvt(Rv, hr); vv = (float)hv;
                { const LAS3 unsigned char* sb = buf + st * 128;
                  const float rl = (float)*(const LAS3 f16*)(sb + 5120 + lane * 2), kl = (float)*(const LAS3 f16*)(sb + 3072 + lane * 2), vl = (float)*(const LAS3 f16*)(sb + 4096 + lane * 2);
                  const float gl = bf2f(*(const LAS3 bf16*)(sb + 6144 + lane * 2));
                  const float mean = wave_sum(yy) * (1.f / 64.f); const float dd = yy - mean; const float var = wave_sum(dd * dd) * (1.f / 64.f);
                  const float bonus = wave_sum(rl * kl * r_k);
                  const float yn = dd * __builtin_amdgcn_rsqf(var + GN_EPS) * gn_g + gn_b + bonus * vl;
                  YA[(size_t)(ch * CL + blk * SCB + st) * W + h * 64 + lane] = f2bf(yn * gl); }
            }
        }
    }
}

__device__ __forceinline__ void phase_post(ArgsR a, const Ctx& c, int l) {
    const bf16* YSC = (const bf16*)(a.ws + WS_YSC); const f16* R = (const f16*)(a.ws + WS_R); const f16* KP = (const f16*)(a.ws + WS_KP); const f16* V = (const f16*)(a.ws + WS_V);
    const bf16* G = (const bf16*)(a.ws + WS_G); bf16* YA = (bf16*)(a.ws + WS_YA);
    const float* gng = a.in[I_GNG] + l * W; const float* gnb = a.in[I_GNB] + l * W; const float* rk = a.in[I_RK] + l * W;
    for (int t = c.gw; t < T; t += c.ngw) {
#pragma unroll
        for (int i = 0; i < 8; ++i) { const int n = c.lane + 64 * i; const size_t o = (size_t)t * W + n;
            const float y = bf2f(YSC[o]); const float mean = wave_sum(y) * (1.f / 64.f); const float d = y - mean; const float var = wave_sum(d * d) * (1.f / 64.f);
            float yn = d * __builtin_amdgcn_rsqf(var + GN_EPS) * gng[n] + gnb[n];
            const float r = (float)R[o], k = (float)KP[o], v = (float)V[o];
            const float bonus = wave_sum(r * k * rk[n]);
            yn += bonus * v;
            YA[o] = f2bf(yn * bf2f(G[o])); }
    }
}

__device__ __forceinline__ void phase_ln1(ArgsR a, const Ctx& c, int l, float* outw, int mode = 3) {
    const float* MODF = (const float*)(a.ws + WS_MODF) + l * 6144;
    const float* g1 = a.in[I_LN1G] + l * D; const float* b1 = a.in[I_LN1B] + l * D;
    bf16* XN = (bf16*)(a.ws + WS_XN);
    int* TOKI = (int*)(a.ws + WS_TOKI); float* TOKW = (float*)(a.ws + WS_TOKW); int* TOKP = (int*)(a.ws + WS_TOKP);
    const float* rw = a.in[I_RW]; const float* rb = a.in[I_RB];
    LAS3 float* rwT = (LAS3 float*)((LAS3 unsigned char*)c.lds + 69632);
    constexpr int RW_LD = D + 4;
    unsigned* lcnt = (unsigned*)(c.lds + 135488);
    if (mode & 1) {
    for (int i = c.tid; i < D * NE; i += NTHREADS) rwT[(i & 15) * RW_LD + (i >> 4)] = rw[i];
    if (c.tid < NE) lcnt[c.tid] = 0u;
    __syncthreads();
    const bf16* TMP = (const bf16*)(a.ws + WS_TMP);
    float vn[16]; if (c.gw < T) load_row16bf(TMP + (size_t)c.gw * D, c.lane, vn);
    for (int m = c.gw; m < T; m += c.ngw) {
        int l4 = 4 * c.lane; asm volatile("" : "+v"(l4));
        float v[16];
#pragma unroll
        for (int j = 0; j < 16; ++j) v[j] = vn[j];
        if (m + c.ngw < T) load_row16bf(TMP + (size_t)(m + c.ngw) * D, c.lane, vn);
        float mean, rstd; row_stats(v, mean, rstd);
#pragma unroll
        for (int j = 0; j < 4; ++j) { f32x4 o; const int col = l4 + 256 * j;
#pragma unroll
            for (int e = 0; e < 4; ++e) { v[4 * j + e] = (v[4 * j + e] - mean) * rstd * g1[col + e] + b1[col + e]; o[e] = v[4 * j + e]; }
            *(f32x4*)(outw + (size_t)m * D + col) = o; }
        row_stats(v, mean, rstd);
#pragma unroll
        for (int j = 0; j < 4; ++j) { f32x4 o; const int col = l4 + 256 * j;
#pragma unroll
            for (int e = 0; e < 4; ++e) { v[4 * j + e] = (v[4 * j + e] - mean) * rstd * (1.0f + MODF[4096 + col + e]) + MODF[3072 + col + e]; o[e] = v[4 * j + e]; }
            store4bf(XN + (size_t)m * D + col, o); }
        float lg[16];
#pragma unroll
        for (int e = 0; e < 16; ++e) { float x = 0.f;
#pragma unroll
            for (int j = 0; j < 4; ++j) { const f32x4 r4 = *(const LAS3 f32x4*)(rwT + e * RW_LD + l4 + 256 * j); x += (v[4 * j] * r4[0] + v[4 * j + 1] * r4[1]) + (v[4 * j + 2] * r4[2] + v[4 * j + 3] * r4[3]); }
            lg[e] = x;
            if ((e & 3) == 3) __builtin_amdgcn_sched_barrier(0); }
        float r8[8], r4v[4], r2[2], r1;
        { const bool b5 = (c.lane & 32) != 0, b4 = (c.lane & 16) != 0, b3 = (c.lane & 8) != 0, b2 = (c.lane & 4) != 0;
#pragma unroll
          for (int i = 0; i < 8; ++i) { const float snd = b5 ? lg[i] : lg[i + 8], kp = b5 ? lg[i + 8] : lg[i]; r8[i] = kp + __shfl_xor(snd, 32); }
#pragma unroll
          for (int i = 0; i < 4; ++i) { const float snd = b4 ? r8[i] : r8[i + 4], kp = b4 ? r8[i + 4] : r8[i]; r4v[i] = kp + __shfl_xor(snd, 16); }
#pragma unroll
          for (int i = 0; i < 2; ++i) { const float snd = b3 ? r4v[i] : r4v[i + 2], kp = b3 ? r4v[i + 2] : r4v[i]; r2[i] = kp + __shfl_xor(snd, 8); }
          { const float snd = b2 ? r2[0] : r2[1], kp = b2 ? r2[1] : r2[0]; r1 = kp + __shfl_xor(snd, 4); }
          r1 += __shfl_xor(r1, 2); r1 += __shfl_xor(r1, 1); }
        float sc[16], sel[16];
#pragma unroll
        for (int e = 0; e < 16; ++e) { const float lgt = __shfl(r1, 4 * e); sc[e] = __builtin_amdgcn_rcpf(1.0f + __expf(-lgt)); sel[e] = sc[e] + rb[e]; }
        int best = 0; float bestv = -INFINITY;
#pragma unroll
        for (int g = 0; g < 4; ++g) { float m1 = -INFINITY, m2 = -INFINITY;
#pragma unroll
            for (int q = 0; q < 4; ++q) { const float sv = sel[4 * g + q]; if (sv > m1) { m2 = m1; m1 = sv; } else if (sv > m2) m2 = sv; }
            const float gs = m1 + m2; if (gs > bestv) { bestv = gs; best = g; } }
        int i1 = 0, i2 = 0; float s1 = -INFINITY, s2 = -INFINITY, w1 = 0.f, w2 = 0.f;
#pragma unroll
        for (int e = 0; e < 16; ++e) { if ((e >> 2) == best) { const float sv = sel[e];
                if (sv > s1) { s2 = s1; i2 = i1; w2 = w1; s1 = sv; i1 = e; w1 = sc[e]; } else if (sv > s2) { s2 = sv; i2 = e; w2 = sc[e]; } } }
        if (c.lane == 0) { const float ws = w1 + w2;
            TOKI[2 * m] = i1; TOKI[2 * m + 1] = i2; TOKW[2 * m] = w1 / ws; TOKW[2 * m + 1] = w2 / ws;
            TOKP[2 * m] = (int)atomicAdd(&lcnt[i1], 1u); TOKP[2 * m + 1] = (int)atomicAdd(&lcnt[i2], 1u); }
    }
    __syncthreads();
    if (c.tid < NE) ((int*)(a.ws + WS_BLKCNT))[blockIdx.x * NE + c.tid] = (int)lcnt[c.tid];
    __syncthreads();
    }
}

__device__ __forceinline__ void expert_convert(ArgsR a, const Ctx& c, int l, int b0) {
    if ((int)blockIdx.x < b0) return;
    float* scr = (float*)(c.lds + c.wave * 8704);
    bf16* WGU = (bf16*)(a.ws + WS_WGU); bf16* WD = (bf16*)(a.ws + WS_WD);
    constexpr int IG = (D / 64) * (FF / 32);
    constexpr int ID = (FF / 64) * (D / 32);
    const int gw0 = ((int)blockIdx.x - b0) * NWAVES + c.wave, ngw0 = ((int)gridDim.x - b0) * NWAVES;
    for (int it = gw0; it < NE * (2 * IG + ID); it += ngw0) {
        const int e = it / (2 * IG + ID); int r = it % (2 * IG + ID);
        const size_t eo = ((size_t)l * NE + e) * (size_t)D * FF;
        if (r < IG) { transpose_matrix_item(a.in[I_EG] + eo, D, FF, WGU + (size_t)e * 1024 * 1024, r, scr, c.lane, RowGU{0}); continue; } r -= IG;
        if (r < IG) { transpose_matrix_item(a.in[I_EU] + eo, D, FF, WGU + (size_t)e * 1024 * 1024, r, scr, c.lane, RowGU{1}); continue; } r -= IG;
        transpose_matrix_item(a.in[I_ED] + eo, FF, D, WD + (size_t)e * 1024 * 512, r, scr, c.lane, RowId());
    }
}

__device__ __forceinline__ void phase_perm(ArgsR a, const Ctx& c, int l) {
    const int* BLKCNT = (const int*)(a.ws + WS_BLKCNT);
    LAS3 int* pre = (LAS3 int*)c.lds;
    LAS3 int* tot = pre + 256 * NE;
    const int nb = gridDim.x;
#pragma unroll
    for (int q = 0; q < 2; ++q) { const int e = 2 * c.wave + q; int v[4]; int sum = 0;
#pragma unroll
        for (int i = 0; i < 4; ++i) { const int b = 4 * c.lane + i; v[i] = b < nb ? BLKCNT[b * NE + e] : 0; sum += v[i]; }
        int inc = sum;
#pragma unroll
        for (int o = 1; o < 64; o <<= 1) { const int t = __shfl_up(inc, o); if (c.lane >= o) inc += t; }
        int run = inc - sum;
#pragma unroll
        for (int i = 0; i < 4; ++i) { pre[(4 * c.lane + i) * NE + e] = run; run += v[i]; }
        if (c.lane == 63) tot[e] = inc; }
    __syncthreads();
    int ts[17]; { int sacc = 0;
#pragma unroll
        for (int e = 0; e < 16; ++e) { ts[e] = sacc; sacc += (tot[e] + 255) >> 8; } ts[16] = sacc; }
    if (blockIdx.x == 0 && c.tid < NE) ((int*)(a.ws + WS_TOT))[c.tid] = tot[c.tid];
    const int* TOKI = (const int*)(a.ws + WS_TOKI); const int* TOKP = (const int*)(a.ws + WS_TOKP); int* S2T = (int*)(a.ws + WS_S2T); const float* TOKW = (const float*)(a.ws + WS_TOKW);
    const bf16* XN = (const bf16*)(a.ws + WS_XN); bf16* XS = (bf16*)(a.ws + WS_XS);
    for (int as = blockIdx.x * NTHREADS + c.tid; as < 2 * T; as += gridDim.x * NTHREADS) {
        const int e = TOKI[as]; int base = 0;
#pragma unroll
        for (int j = 0; j < 16; ++j) base = (j == e) ? ts[j] : base;
        const int m = as >> 1, blk = (m % c.ngw) >> 3;
        const u32x2 sw = {(unsigned)as, __float_as_uint(TOKW[as])};
        *(u32x2*)(S2T + 2 * (base * 256 + pre[blk * NE + e] + TOKP[as])) = sw;
    }
    for (int e = 0; e < 16; ++e) {
        int tse = 0, tsn = 0;
#pragma unroll
        for (int j = 0; j < 16; ++j) { tse = (j == e) ? ts[j] : tse; tsn = (j == e) ? ts[j + 1] : tsn; }
        const int lo = tse * 256 + tot[e], hi = tsn * 256;
        for (int sl = lo + blockIdx.x * NTHREADS + c.tid; sl < hi; sl += gridDim.x * NTHREADS) S2T[2 * sl] = -1;
    }
    __syncthreads();
}

__device__ __forceinline__ void phase_ln2(ArgsR a, const Ctx& c, int l, float* outw) {
    const float* MODF = (const float*)(a.ws + WS_MODF) + l * 6144;
    const float* g2 = a.in[I_LN2G] + l * D; const float* b2 = a.in[I_LN2B] + l * D;
    const bf16* Y = (const bf16*)(a.ws + WS_Y); bf16* XN = (bf16*)(a.ws + WS_XN);
    float vn[16]; u32x2 y0n[4], y1n[4];
    if (c.gw < T) { load_row16(a.out + (size_t)c.gw * D, c.lane, vn);
#pragma unroll
        for (int j = 0; j < 4; ++j) { y0n[j] = *(const u32x2*)(Y + (size_t)(2 * c.gw) * D + 4 * c.lane + 256 * j); y1n[j] = *(const u32x2*)(Y + (size_t)(2 * c.gw + 1) * D + 4 * c.lane + 256 * j); } }
    for (int m = c.gw; m < T; m += c.ngw) {
        float v[16]; u32x2 y0[4], y1[4];
#pragma unroll
        for (int j = 0; j < 16; ++j) v[j] = vn[j];
#pragma unroll
        for (int j = 0; j < 4; ++j) { y0[j] = y0n[j]; y1[j] = y1n[j]; }
        if (m + c.ngw < T) { const int mn = m + c.ngw; load_row16(a.out + (size_t)mn * D, c.lane, vn);
#pragma unroll
            for (int j = 0; j < 4; ++j) { y0n[j] = *(const u32x2*)(Y + (size_t)(2 * mn) * D + 4 * c.lane + 256 * j); y1n[j] = *(const u32x2*)(Y + (size_t)(2 * mn + 1) * D + 4 * c.lane + 256 * j); } }
#pragma unroll
        for (int j = 0; j < 4; ++j) { const int col = 4 * c.lane + 256 * j;
            const float a0 = __uint_as_float(y0[j].x << 16) + __uint_as_float(y1[j].x << 16), a1 = __uint_as_float(y0[j].x & 0xffff0000u) + __uint_as_float(y1[j].x & 0xffff0000u);
            const float a2 = __uint_as_float(y0[j].y << 16) + __uint_as_float(y1[j].y << 16), a3 = __uint_as_float(y0[j].y & 0xffff0000u) + __uint_as_float(y1[j].y & 0xffff0000u);
            const f32x4 gt = *(const f32x4*)(MODF + 5120 + col);
            v[4 * j] = ALPHA * v[4 * j] + (1.0f + gt[0]) * a0; v[4 * j + 1] = ALPHA * v[4 * j + 1] + (1.0f + gt[1]) * a1; v[4 * j + 2] = ALPHA * v[4 * j + 2] + (1.0f + gt[2]) * a2; v[4 * j + 3] = ALPHA * v[4 * j + 3] + (1.0f + gt[3]) * a3; }
        float mean, rstd; row_stats(v, mean, rstd);
#pragma unroll
        for (int j = 0; j < 4; ++j) { f32x4 o; const int col = 4 * c.lane + 256 * j;
#pragma unroll
            for (int e = 0; e < 4; ++e) { v[4 * j + e] = (v[4 * j + e] - mean) * rstd * g2[col + e] + b2[col + e]; o[e] = v[4 * j + e]; }
            *(f32x4*)(outw + (size_t)m * D + col) = o; }
        if (l + 1 < DEPTH) {
            const float* MN = MODF + 6144;
            row_stats(v, mean, rstd);
#pragma unroll
            for (int j = 0; j < 4; ++j) { f32x4 o; const int col = 4 * c.lane + 256 * j;
#pragma unroll
                for (int e = 0; e < 4; ++e) o[e] = (v[4 * j + e] - mean) * rstd * (1.0f + MN[1024 + col + e]) + MN[col + e];
                store4bf(XN + (size_t)m * D + col, o); }
        }
    }
}


template <class F> struct EpiAdapt {
    static constexpr bool PERM = true, AFTER_DRAIN = false; F f;
    __device__ __forceinline__ void operator()(const f32x4 (&acc)[2][2][4][2], const Unit& u, int wr, int wc, int fr, int fq) const {
        const int col = u.pn * 256 + wc * 32 + 8 * fq;
#pragma unroll
        for (int ai = 0; ai < 2; ++ai)
#pragma unroll
            for (int m = 0; m < 4; ++m) { const int row = u.pm * 256 + ai * 128 + wr * 64 + m * 16 + fr; f(row, col, acc[ai][0][m][0], acc[ai][0][m][1], acc[ai][1][m][0], acc[ai][1][m][1]); }
    }
};

template <class Sched, class F>
__device__ __forceinline__ void gemm_gather(const Ctx& c, const bf16* A, const int* s2t, const bf16* Bt, int M, int N, int K, const Sched& S, const F& f) {
    pg8::Gemm g{A, Bt, M, N, K}; EpiAdapt<F> E{f};
    pg8::gemm_phase<EpiAdapt<F>, Sched, true, true, true>((PG8_LAS unsigned char*)c.lds, g, S, E, c.tid, s2t);
}
template <class Sched, class F>
__device__ __forceinline__ void gemm_any(const Ctx& c, const bf16* A, const bf16* Bt, int M, int N, int K, const Sched& S, const F& f) {
    pg8::Gemm g{A, Bt, M, N, K}; EpiAdapt<F> E{f};
    pg8::gemm_phase<EpiAdapt<F>, Sched, true, true>((PG8_LAS unsigned char*)c.lds, g, S, E, c.tid);
}

#define LAS __attribute__((address_space(3)))
#define XB_TMO      128
#define XB_XCNT(j)  (256  + 64 * (j))
#define XB_XSUB(j)  (1280 + 64 * (j))
#define XB_XGEN(j)  (2304 + 64 * (j))
#define XB_TOP      3328
#define XB_TOPGEN   3392
#define XCD_BAR_WORDS 3456
#define XB_SPIN_CAP (1u << 24)

__device__ __forceinline__ unsigned xb_ld(unsigned* p)              { return __hip_atomic_load(p, __ATOMIC_RELAXED, __HIP_MEMORY_SCOPE_AGENT); }
__device__ __forceinline__ unsigned xb_add(unsigned* p, unsigned v) { return __hip_atomic_fetch_add(p, v, __ATOMIC_RELAXED, __HIP_MEMORY_SCOPE_AGENT); }
__device__ __forceinline__ unsigned xb_xcc_id() { return (unsigned)__builtin_amdgcn_s_getreg((3 << 11) | 20) & 0xFu; }
#define XB_SPIN(cond, bar) do { unsigned _sp = 0; while (cond) { __builtin_amdgcn_s_sleep(1); \
    if ((++_sp & 255u) == 0u) { if (xb_ld(&(bar)[XB_TMO])) break; if (_sp > XB_SPIN_CAP) { atomicAdd(&(bar)[XB_TMO], 1u); break; } } } } while (0)

struct XcdBarrier {
    unsigned* bar; unsigned x;
    volatile LAS unsigned* st;
};

__device__ __forceinline__ XcdBarrier xcd_barrier_post(unsigned* bar, volatile LAS unsigned* st) {
    XcdBarrier b; b.bar = bar; b.x = xb_xcc_id(); b.st = st;
    if (threadIdx.x == 0) (void)xb_add(&bar[XB_XCNT(b.x)], 1u);
    return b;
}
__device__ __forceinline__ void xcd_barrier_complete(unsigned* bar, unsigned x, unsigned& nloc, unsigned& nx) {
    const unsigned G = gridDim.x * gridDim.y * gridDim.z;
    unsigned sum, cnt, mine, sp = 0u;
    for (;;) {
        sum = 0u; cnt = 0u; mine = 0u;
#pragma unroll
        for (unsigned j = 0; j < 16; ++j) { const unsigned c = xb_ld(&bar[XB_XCNT(j)]); sum += c; cnt += (c > 0u) ? 1u : 0u; mine = (j == x) ? c : mine; }
        if (sum == G) break;
        __builtin_amdgcn_s_sleep(1);
        if ((++sp & 255u) == 0u) { if (xb_ld(&bar[XB_TMO])) break; if (sp > XB_SPIN_CAP) { atomicAdd(&bar[XB_TMO], 1u); break; } }
    }
    nloc = mine > 0u ? mine : 1u; nx = cnt > 0u ? cnt : 1u;
}

__device__ __forceinline__ void xcd_barrier(const XcdBarrier& b) {
    asm volatile("s_waitcnt vmcnt(0)" ::: "memory");
    __syncthreads();
    if (threadIdx.x == 0) {
        unsigned* bar = b.bar;
        __builtin_amdgcn_s_waitcnt(0);
        unsigned nloc = b.st[0], nx = b.st[1];
        if (nloc == 0u) { xcd_barrier_complete(bar, b.x, nloc, nx); b.st[0] = nloc; b.st[1] = nx; }
        const unsigned old = xb_add(&bar[XB_XSUB(b.x)], 1u);
        const unsigned gen = old / nloc;
        if (old + 1u == (gen + 1u) * nloc) {
            __builtin_amdgcn_fence(__ATOMIC_RELEASE, "agent");
            asm volatile("s_waitcnt vmcnt(0)" ::: "memory");
            const unsigned og = xb_add(&bar[XB_TOP], 1u);
            const unsigned tg = og / nx;
            if (og + 1u == (tg + 1u) * nx) xb_add(&bar[XB_TOPGEN], 1u);
            else XB_SPIN(xb_ld(&bar[XB_TOPGEN]) == tg, bar);
            __builtin_amdgcn_fence(__ATOMIC_ACQUIRE, "agent");
            xb_add(&bar[XB_XGEN(b.x)], 1u);
            asm volatile("s_waitcnt vmcnt(0)" ::: "memory");
        } else {
            XB_SPIN(xb_ld(&bar[XB_XGEN(b.x)]) == gen, bar);
            __builtin_amdgcn_fence(__ATOMIC_ACQUIRE, "agent");
            asm volatile("s_waitcnt vmcnt(0)" ::: "memory");
        }
    }
    __syncthreads();
}


constexpr int PH_PER_LAYER = 12, N_PHASES = 2 + PH_PER_LAYER * DEPTH;
constexpr int CW_BAR = 4096;
constexpr int CW_RDY = 65536;
constexpr int LDS_BYTES = 147456, LDSCTL_OFF = 131072 + 8192;
#ifndef SINGLE_LAUNCH
#define SINGLE_LAUNCH 1
#endif

#ifndef PROBE_A
#define PROBE_A -1
#endif
#ifndef PROBE_B
#define PROBE_B -1
#endif
constexpr size_t WS_TS = 512 * 1024;
#if PROBE_A >= 0
#define STAMP(i) do { if (blockIdx.x == 0 && threadIdx.x == 0) ((unsigned long long*)(args_here()->ws + WS_TS))[(i)] = __builtin_amdgcn_s_memrealtime(); } while (0)
#else
#define STAMP(i) do { } while (0)
#endif
__device__ __forceinline__ const __attribute__((address_space(4))) Args* args_here() { const __attribute__((address_space(4))) Args* p = (const __attribute__((address_space(4))) Args*)__builtin_amdgcn_kernarg_segment_ptr(); asm volatile("" : "+s"(p)); return p; }
#ifndef REP_K
#define REP_K -1
#endif
__device__ __forceinline__ Ctx mkctx(int wave_s, unsigned char* lds) { Ctx c; c.wave = wave_s; c.lane = (int)__builtin_amdgcn_mbcnt_hi(~0u, __builtin_amdgcn_mbcnt_lo(~0u, 0u)); c.tid = wave_s * 64 + c.lane;
    c.gw = blockIdx.x * NWAVES + wave_s; c.ngw = gridDim.x * NWAVES; c.lds = lds; return c; }
#define PHASE1(k, ...) do { const __attribute__((address_space(4))) Args* ap_ = args_here(); if (ap_->ph_lo <= (k) && (k) < ap_->ph_hi) { ArgsR a = *ap_; const Ctx c = mkctx(wave_s, lds); __VA_ARGS__ } } while (0)
#define PHASE(k, ...) do { PHASE1(k, __VA_ARGS__); if ((k) == REP_K) { xcd_barrier(bar); PHASE1(k, __VA_ARGS__); xcd_barrier(bar); PHASE1(k, __VA_ARGS__); } } while (0)

template <int L>
__device__ __forceinline__ void run_layer(const int wave_s, unsigned char* lds, const XcdBarrier& bar) {
    const int G = gridDim.x, b = blockIdx.x;
#define BAR() do { xcd_barrier(bar); STAMP(3 + 14 * L + (bk_++)); } while (0)
    int bk_ = 0;
    PHASE(0, unsigned char* ws = a.ws; pg8::StaticOrder S; S.init(T, INC, G, b); EpiZ E{(bf16*)(ws + WS_ZR), (bf16*)(ws + WS_ZS), (bf16*)(ws + WS_ZG)};
        gemm_any(c, (const bf16*)(ws + WS_XN), (const bf16*)(ws + WS_WIN + (size_t)L * 10 * MiB), T, INC, D, S, E); );
    BAR();
    PHASE(1, phase_prep_fast(a, c, L); );
    PHASE(14, phase_sg_fast(a, c, L); );
    BAR();
#if REP_K == 21
    PHASE1(2, phase_scan1m(a, c, 1); ); xcd_barrier(bar); PHASE1(2, phase_scan1m(a, c, 1); ); xcd_barrier(bar);
#endif
    PHASE(2, phase_scan1m(a, c); );
    BAR();
    PHASE(3, phase_scan2a(a, c); );
    BAR();
    PHASE(31, phase_scan2b(a, c); );
    PHASE(33, expert_convert(a, c, L, NH); );
    BAR();
    PHASE(4, phase_scan3m(a, c, L); );
    BAR();
    PHASE(6, unsigned char* ws = a.ws; pg8::StaticOrder S; S.init(T, D, G, b); EpiGA E{(const bf16*)(ws + WS_ZG), (bf16*)(ws + WS_MP)};
        gemm_any(c, (const bf16*)(ws + WS_YA), (const bf16*)(ws + WS_WA + (size_t)L * WS_WL1), T, D, W, S, E); );
    BAR();
#if REP_K == 7
    PHASE1(7, unsigned char* ws = a.ws; pg8::StaticOrder S; S.init(T, D, G, b); EpiGB E{(const bf16*)(ws + WS_ZG), (const bf16*)(ws + WS_MP), (bf16*)(ws + WS_ZR)};
        gemm_any(c, (const bf16*)(ws + WS_YB), (const bf16*)(ws + WS_WB + (size_t)L * WS_WL1), T, D, W, S, E); ); xcd_barrier(bar);
    PHASE1(7, unsigned char* ws = a.ws; pg8::StaticOrder S; S.init(T, D, G, b); EpiGB E{(const bf16*)(ws + WS_ZG), (const bf16*)(ws + WS_MP), (bf16*)(ws + WS_ZR)};
        gemm_any(c, (const bf16*)(ws + WS_YB), (const bf16*)(ws + WS_WB + (size_t)L * WS_WL1), T, D, W, S, E); ); xcd_barrier(bar);
#endif
#if REP_K == 8
    PHASE1(8, unsigned char* ws = a.ws; pg8::StaticOrder S; S.init(T, D, G, b); EpiOut E{L == 0 ? a.in[I_X] : a.out, (bf16*)(ws + WS_R), (const float*)(ws + WS_MODF) + L * 6144 + 2048};
        gemm_any(c, (const bf16*)(ws + WS_MP), (const bf16*)(ws + WS_WO + (size_t)L * WS_WL1), T, D, D, S, E); ); xcd_barrier(bar);
    PHASE1(8, unsigned char* ws = a.ws; pg8::StaticOrder S; S.init(T, D, G, b); EpiOut E{L == 0 ? a.in[I_X] : a.out, (bf16*)(ws + WS_R), (const float*)(ws + WS_MODF) + L * 6144 + 2048};
        gemm_any(c, (const bf16*)(ws + WS_MP), (const bf16*)(ws + WS_WO + (size_t)L * WS_WL1), T, D, D, S, E); ); xcd_barrier(bar);
#endif
    PHASE1(7, unsigned char* ws = a.ws; pg8::StaticOrder S; S.init(T, D, G, b); EpiGB E{(const bf16*)(ws + WS_ZG), (const bf16*)(ws + WS_MP), (bf16*)(ws + WS_MP)};
        gemm_any(c, (const bf16*)(ws + WS_YB), (const bf16*)(ws + WS_WB + (size_t)L * WS_WL1), T, D, W, S, E); );
    BAR();
    PHASE1(8, unsigned char* ws = a.ws; pg8::StaticOrder S; S.init(T, D, G, b); EpiOut E{L == 0 ? a.in[I_X] : a.out, (bf16*)(ws + WS_TMP), (const float*)(ws + WS_MODF) + L * 6144 + 2048};
        gemm_any(c, (const bf16*)(ws + WS_MP), (const bf16*)(ws + WS_WO + (size_t)L * WS_WL1), T, D, D, S, E); );
    BAR();
#if REP_K == 9
    PHASE1(9, phase_ln1(a, c, L, (float*)(a.ws + WS_ZR)); ); xcd_barrier(bar); PHASE1(9, phase_ln1(a, c, L, (float*)(a.ws + WS_ZR)); ); xcd_barrier(bar);
#endif
#if REP_K == 91
    PHASE1(9, phase_ln1(a, c, L, (float*)(a.ws + WS_ZR), 1); ); xcd_barrier(bar); PHASE1(9, phase_ln1(a, c, L, (float*)(a.ws + WS_ZR), 1); ); xcd_barrier(bar);
#endif
#if REP_K == 92
    PHASE1(9, phase_ln1(a, c, L, (float*)(a.ws + WS_ZR), 2); ); xcd_barrier(bar); PHASE1(9, phase_ln1(a, c, L, (float*)(a.ws + WS_ZR), 2); ); xcd_barrier(bar);
#endif
    PHASE1(9, phase_ln1(a, c, L, a.out); );
    BAR();
    PHASE(10, phase_perm(a, c, L); );
    BAR();
    PHASE(11, unsigned char* ws = a.ws; MoeSchedA S; S.init((const unsigned*)(ws + WS_TOT), G, b); EpiSwi E{(bf16*)(ws + WS_HID)};
        gemm_gather(c, (const bf16*)(ws + WS_XN), (const int*)(ws + WS_S2T), (const bf16*)(ws + WS_WGU), MAXSLOT, NE * 1024, D, S, E); );
    BAR();
    PHASE(12, unsigned char* ws = a.ws; unsigned* rdy = (unsigned*)(ws + WS_CTL) + CW_RDY + L * 16384;
        { MoeSchedT S; S.init((const unsigned*)(ws + WS_TOT), G, b); S.rdy = rdy; EpiSwi E{(bf16*)(ws + WS_HID)};
          gemm_gather(c, (const bf16*)(ws + WS_XN), (const int*)(ws + WS_S2T), (const bf16*)(ws + WS_WGU), MAXSLOT, NE * 1024, D, S, E); }
        { MoeSchedB S; S.init((const unsigned*)(ws + WS_TOT), G, b); S.rdy = rdy; S.tmo = (unsigned*)(ws + WS_CTL) + CW_BAR + XB_TMO; S.wave = c.wave;
          EpiDown E{(const int*)(ws + WS_S2T), (const float*)(ws + WS_TOKW), (bf16*)(ws + WS_Y)};
          gemm_any(c, (const bf16*)(ws + WS_HID), (const bf16*)(ws + WS_WD), MAXSLOT, NE * 1024, FF, S, E); } );
    BAR();
#if REP_K == 13
    PHASE1(13, phase_ln2(a, c, L, (float*)(a.ws + WS_R)); ); xcd_barrier(bar); PHASE1(13, phase_ln2(a, c, L, (float*)(a.ws + WS_R)); ); xcd_barrier(bar);
#endif
    PHASE1(13, phase_ln2(a, c, L, a.out); );
    if (L + 1 < DEPTH) BAR();
    (void)bk_;
#undef BAR
}

__global__ void __launch_bounds__(NTHREADS, 2) mk_fwd(Args a_unused) {
    extern __shared__ __attribute__((aligned(16))) unsigned char lds[];
    const int wave_s = __builtin_amdgcn_readfirstlane(threadIdx.x >> 6);
    for (int u = threadIdx.x; u < (LDS_BYTES - LDSCTL_OFF) / 4; u += NTHREADS) ((LAS unsigned*)((LAS unsigned char*)lds + LDSCTL_OFF))[u] = 0u;
    __syncthreads();
    const XcdBarrier bar = xcd_barrier_post((unsigned*)(args_here()->ws + WS_CTL) + CW_BAR, (volatile LAS unsigned*)((LAS unsigned char*)lds + LDSCTL_OFF) + 8);
    STAMP(0);
    PHASE(100, phase_p0a(a, c); );
    xcd_barrier(bar); STAMP(1);
    PHASE(101, phase_p0b(a, c); );
    xcd_barrier(bar); STAMP(2);
    run_layer<0>(wave_s, lds, bar);
    run_layer<1>(wave_s, lds, bar);
#if PROBE_A >= 0
    if (blockIdx.x == 0) {
        asm volatile("s_waitcnt vmcnt(0)" ::: "memory"); __syncthreads();
        if (threadIdx.x == 0) ((unsigned long long*)(args_here()->ws + WS_TS))[30] = __builtin_amdgcn_s_memrealtime();
        asm volatile("s_waitcnt vmcnt(0)" ::: "memory"); __syncthreads();
        const volatile unsigned long long* ts = (const volatile unsigned long long*)(args_here()->ws + WS_TS);
        float da = 0.f, db = 0.f;
        if (PROBE_A < 14) { da = (float)(ts[3 + PROBE_A] - ts[2 + PROBE_A]) + (float)(ts[17 + PROBE_A] - ts[16 + PROBE_A]); } else if (PROBE_A == 14) da = (float)(ts[1] - ts[0]); else if (PROBE_A == 15) da = (float)(ts[2] - ts[1]); else da = (float)(ts[30] - ts[0]);
        if (PROBE_B >= 0 && PROBE_B < 14) { db = (float)(ts[3 + PROBE_B] - ts[2 + PROBE_B]) + (float)(ts[17 + PROBE_B] - ts[16 + PROBE_B]); } else if (PROBE_B == 14) db = (float)(ts[1] - ts[0]); else if (PROBE_B == 15) db = (float)(ts[2] - ts[1]);
        da *= 0.01f; db *= 0.01f;
        da = exp2f(0.25f * rintf(4.0f * log2f(fmaxf(da, 0.5f)))); db = exp2f(0.25f * rintf(4.0f * log2f(fmaxf(db, 0.5f))));
        float* out = args_here()->out;
        for (int i = threadIdx.x; i < 16 * 1024; i += NTHREADS) { const int r = i >> 10, col = i & 1023; const int rowi = (r & 7) + 2048 * (r >> 3); out[(size_t)rowi * D + col] = da; }
        if (threadIdx.x == 0 && PROBE_B >= 0) out[(size_t)4096 * D] = 100.0f * db;
    }
#endif
}

extern "C" void kernel_launch(void* const* d_in, const int* in_sizes, int n_in, void* d_out, int out_size, void* d_ws, size_t ws_size, hipStream_t stream) {
    static int grid = 0;
    if (grid == 0) {
        if (n_in != N_IN || out_size != T * D || ws_size < WS_END2) { fprintf(stderr, "kernel_launch: unexpected shapes: n_in %d out %d ws %zu (need %zu)\n", n_in, out_size, ws_size, (size_t)WS_END2); grid = -1; return; }
        int dev = 0, cus = 0;
        (void)hipGetDevice(&dev); (void)hipDeviceGetAttribute(&cus, hipDeviceAttributeMultiprocessorCount, dev);
        if (hipFuncSetAttribute((const void*)mk_fwd, hipFuncAttributeMaxDynamicSharedMemorySize, LDS_BYTES) != hipSuccess) { fprintf(stderr, "kernel_launch: hipFuncSetAttribute failed\n"); grid = -1; return; }
        grid = cus > 0 ? (cus & ~3) : 256;
        fprintf(stderr, "kernel_launch: ws_size %zu grid %d\n", ws_size, grid);
    }
    if (grid < 0) return;
    (void)hipMemsetAsync((char*)d_ws + WS_CTL, 0, CTL_BYTES, stream);
    Args a{};
    for (int i = 0; i < N_IN; ++i) a.in[i] = (const float*)d_in[i];
    a.out = (float*)d_out; a.ws = (unsigned char*)d_ws;
    a.ph_lo = 0; a.ph_hi = 1000;
    hipLaunchKernelGGL(mk_fwd, dim3(grid), dim3(NTHREADS), LDS_BYTES, stream, a);
}
```

```cpp
#include <hip/hip_runtime.h>
#include <cstdio>
#include <cstdint>
#include <utility>

typedef unsigned short bf16;
typedef _Float16 f16;
typedef float f32x4 __attribute__((ext_vector_type(4)));
typedef unsigned u32x4 __attribute__((ext_vector_type(4)));
typedef unsigned u32x2 __attribute__((ext_vector_type(2)));

constexpr int T = 16384, D = 1024, W = 512, NH = 8, HN = 64, RC = 1792, INC = 4864;
constexpr int NE = 16, FF = 512, DEPTH = 2;
constexpr float LN_EPS = 1e-5f, GN_EPS = 64e-5f, ALPHA = 1.41421356237f;
constexpr int NTHREADS = 512, NWAVES = 8;
constexpr int MAXSLOT = 36864;

constexpr size_t MiB = 1u << 20;
constexpr size_t WS_CTL = 0, CTL_BYTES = 1 * MiB;
constexpr int CW_CNT = 16384;
constexpr size_t WS_PART = 1 * MiB;
constexpr size_t WS_MODF = 2 * MiB;
constexpr size_t WS_TOKI = 2 * MiB + 65536;
constexpr size_t WS_TOKW = WS_TOKI + 131072;
constexpr size_t WS_TOKP = WS_TOKW + 131072;
constexpr size_t WS_S2T = 3 * MiB;
constexpr size_t WS_BLKCNT = 3 * MiB + 512 * 1024;
constexpr size_t WS_TOT = WS_BLKCNT + 32768;
constexpr size_t WS_LORA = 4 * MiB;
constexpr size_t WS_WIN = 8 * MiB;
constexpr size_t WS_WA = 28 * MiB, WS_WB = 29 * MiB, WS_WO = 30 * MiB, WS_WL1 = 4 * MiB;
constexpr size_t WS_ZG = 36 * MiB;
constexpr size_t WS_XN = 100 * MiB;
constexpr size_t WS_G = 100 * MiB, WS_YB = 116 * MiB;
constexpr size_t WS_ZR = 132 * MiB;
constexpr size_t WS_ZS = 188 * MiB;
constexpr size_t WS_YSC = 132 * MiB;
constexpr size_t WS_ST = 148 * MiB;
constexpr size_t WS_YA = 132 * MiB;
constexpr size_t WS_MP = 164 * MiB;
constexpr size_t WS_TMP = 132 * MiB;
constexpr size_t WS_XS = 132 * MiB;
constexpr size_t WS_Y = 132 * MiB;
constexpr size_t WS_AA = 224 * MiB, WS_BB = 240 * MiB, WS_WM1 = 256 * MiB, WS_R = 272 * MiB, WS_KP = 288 * MiB, WS_V = 304 * MiB;
constexpr size_t WS_WGU = 224 * MiB;
constexpr size_t WS_WD = 256 * MiB;
constexpr size_t WS_HID = 272 * MiB;
constexpr size_t WS_VF = 320 * MiB;
constexpr size_t WS_END = 336 * MiB;

constexpr size_t LO_W2T = 0, LO_A2T = 65536, LO_G2T = 131072, LO_VM1T = 262144, LO_VM2T = 294912, LO_STRIDE = 524288;

enum { I_X = 0, I_C, I_WMOD, I_BMOD, I_WIN, I_MU, I_W0, I_W2, I_A0, I_A2, I_G2, I_KK, I_KA, I_RK, I_GNG, I_GNB, I_VM0, I_VM1, I_VM2,
       I_SGG, I_SGB, I_WS, I_BS, I_WBA, I_WBB, I_WOUT, I_LN1G, I_LN1B, I_RW, I_RB, I_EG, I_EU, I_ED, I_LN2G, I_LN2B, N_IN };

struct Args { const float* in[N_IN]; float* out; unsigned char* ws; int ph_lo, ph_hi; };
typedef const __attribute__((address_space(4))) Args& ArgsR;

__device__ __forceinline__ float bf2f(bf16 h) { return __uint_as_float(((unsigned)h) << 16); }
__device__ __forceinline__ unsigned f2bfu(float f) { unsigned u = __float_as_uint(f); return (u + 0x7fffu + ((u >> 16) & 1u)) >> 16; }
__device__ __forceinline__ bf16 f2bf(float f) { return __builtin_bit_cast(unsigned short, (__bf16)f); }
typedef __bf16 bf16x2_t __attribute__((ext_vector_type(2)));
__device__ __forceinline__ unsigned pk2(float lo, float hi) { bf16x2_t v; v[0] = (__bf16)lo; v[1] = (__bf16)hi; return __builtin_bit_cast(unsigned, v); }
__device__ __forceinline__ void store4bf(bf16* p, f32x4 v) { u32x2 w; w.x = pk2(v[0], v[1]); w.y = pk2(v[2], v[3]); *(u32x2*)p = w; }
__device__ __forceinline__ f32x4 load4bf(const bf16* p) { u32x2 w = *(const u32x2*)p; f32x4 r; r[0] = __uint_as_float(w.x << 16); r[1] = __uint_as_float(w.x & 0xffff0000u); r[2] = __uint_as_float(w.y << 16); r[3] = __uint_as_float(w.y & 0xffff0000u); return r; }
__device__ __forceinline__ float wave_sum(float v) {
    v += __builtin_bit_cast(float, __builtin_amdgcn_update_dpp(0, __builtin_bit_cast(int, v), 0xB1, 0xF, 0xF, true));
    v += __builtin_bit_cast(float, __builtin_amdgcn_update_dpp(0, __builtin_bit_cast(int, v), 0x4E, 0xF, 0xF, true));
    v += __builtin_bit_cast(float, __builtin_amdgcn_update_dpp(0, __builtin_bit_cast(int, v), 0x141, 0xF, 0xF, true));
    v += __builtin_bit_cast(float, __builtin_amdgcn_update_dpp(0, __builtin_bit_cast(int, v), 0x140, 0xF, 0xF, true));
    v += __builtin_bit_cast(float, __builtin_amdgcn_update_dpp(0, __builtin_bit_cast(int, v), 0x142, 0xA, 0xF, false));
    v += __builtin_bit_cast(float, __builtin_amdgcn_update_dpp(0, __builtin_bit_cast(int, v), 0x143, 0xC, 0xF, false));
    return __builtin_bit_cast(float, __builtin_amdgcn_readlane(__builtin_bit_cast(int, v), 63));
}
__device__ __forceinline__ float sigmoidf_(float x) { return __builtin_amdgcn_rcpf(1.0f + __expf(-x)); }
__device__ __forceinline__ float siluf_(float x) { return x * sigmoidf_(x); }
__device__ __forceinline__ float gelu_tanh(float x) { const float u = 0.7978845608028654f * (x + 0.044715f * x * x * x); return x * (1.0f - __builtin_amdgcn_rcpf(1.0f + __expf(2.0f * u))); }
__device__ __forceinline__ float softplusf_(float y) { return fmaxf(y, 0.f) + log1pf(__expf(-fabsf(y))); }

struct Ctx { int tid, lane, wave, gw, ngw; unsigned char* lds; };

__device__ __forceinline__ void transpose_item(const float* Wsrc, int N, int k0, int n0, bf16* dst, int ldk, float* scr, int lane) {
    float tv[32];
#pragma unroll
    for (int i = 0; i < 32; ++i) tv[i] = Wsrc[(size_t)(k0 + 2 * i + (lane >> 5)) * N + n0 + (lane & 31)];
#pragma unroll
    for (int i = 0; i < 32; ++i) scr[(2 * i + (lane >> 5)) * 33 + (lane & 31)] = tv[i];
    asm volatile("s_waitcnt lgkmcnt(0)" ::: "memory");
    const int c = lane & 7;
#pragma unroll
    for (int j = 0; j < 4; ++j) { const int n = (lane >> 3) + 8 * j; const float* s = scr + (8 * c) * 33 + n;
        u32x4 o; o.x = pk2(s[0 * 33], s[1 * 33]); o.y = pk2(s[2 * 33], s[3 * 33]); o.z = pk2(s[4 * 33], s[5 * 33]); o.w = pk2(s[6 * 33], s[7 * 33]);
        *(u32x4*)(dst + (size_t)n * ldk + k0 + 8 * c) = o; }
    asm volatile("s_waitcnt lgkmcnt(0)" ::: "memory");
}
template <class RowMap>
__device__ __forceinline__ void transpose_matrix_item(const float* Wsrc, int K, int N, bf16* dst, int item, float* scr, int lane, const RowMap& rm) {
    const int nblk = N / 32, kb = item / nblk, nb = item % nblk, n0 = 32 * nb;
    transpose_item(Wsrc, N, 64 * kb, n0, dst + (size_t)rm(n0) * K, K, scr, lane);
}
struct RowId { __device__ __forceinline__ int operator()(int n) const { return n; } };
struct RowGU { int up; __device__ __forceinline__ int operator()(int n) const { return (n >> 7) * 256 + (n & 127) + up * 128; } };

__device__ __forceinline__ void phase_p0a(ArgsR a, const Ctx& c) {
    float* scr = (float*)(c.lds + c.wave * 16384);
    { float* MODF = (float*)(a.ws + WS_MODF); float* red = (float*)(c.lds + 131072);
      for (int cbk = blockIdx.x; cbk < 2 * 96; cbk += gridDim.x) {
          const int l = cbk / 96, n = (cbk % 96) * 64 + c.lane;
          const float* wm = a.in[I_WMOD] + (size_t)l * D * 6144 + (size_t)(c.wave * 128) * 6144 + n;
          float acc0 = 0.f, acc1 = 0.f;
#pragma unroll 16
          for (int k = 0; k < 128; k += 2) { acc0 += siluf_(a.in[I_C][c.wave * 128 + k]) * wm[(size_t)k * 6144]; acc1 += siluf_(a.in[I_C][c.wave * 128 + k + 1]) * wm[(size_t)(k + 1) * 6144]; }
          red[c.wave * 64 + c.lane] = acc0 + acc1;
          __syncthreads();
          if (c.wave == 0) { float sacc = a.in[I_BMOD][l * 6144 + n];
#pragma unroll
              for (int w = 0; w < 8; ++w) sacc += red[w * 64 + c.lane];
              MODF[l * 6144 + n] = sacc; }
          __syncthreads();
      } }
    for (int it = c.gw; it < 2 * (16 + 16 + 32 + 8); it += c.ngw) {
        const int l = it / 72; int r = it % 72; unsigned char* lo = a.ws + WS_LORA + (size_t)l * LO_STRIDE;
        if (r < 16) { transpose_matrix_item(a.in[I_W2] + (size_t)l * 64 * W, 64, W, (bf16*)(lo + LO_W2T), r, scr, c.lane, RowId()); continue; } r -= 16;
        if (r < 16) { transpose_matrix_item(a.in[I_A2] + (size_t)l * 64 * W, 64, W, (bf16*)(lo + LO_A2T), r, scr, c.lane, RowId()); continue; } r -= 16;
        if (r < 32) { transpose_matrix_item(a.in[I_G2] + (size_t)l * 128 * W, 128, W, (bf16*)(lo + LO_G2T), r, scr, c.lane, RowId()); continue; } r -= 32;
        if (l == 1) transpose_matrix_item(a.in[I_VM1], W, 32, (bf16*)(lo + LO_VM1T), r, scr, c.lane, RowId());
    }
    for (int i = blockIdx.x * NTHREADS + c.tid; i < 32 * W; i += gridDim.x * NTHREADS) { const int n = i >> 5, k = i & 31;
        ((bf16*)(a.ws + WS_LORA + LO_STRIDE + LO_VM2T))[i] = f2bf(a.in[I_VM2][(size_t)k * W + n]); }
    constexpr int I_WINL = (D / 64) * (INC / 32);
    constexpr int I_WAL = (W / 64) * (D / 32);
    constexpr int I_WOL = (D / 64) * (D / 32);
    constexpr int PER_L = I_WINL + 2 * I_WAL + I_WOL;
    for (int it = c.gw; it < 2 * PER_L; it += c.ngw) {
        const int l = it / PER_L; int r = it % PER_L;
        if (r < I_WINL) { transpose_matrix_item(a.in[I_WIN] + (size_t)l * D * INC, D, INC, (bf16*)(a.ws + WS_WIN + (size_t)l * 10 * MiB), r, scr, c.lane, RowId()); continue; } r -= I_WINL;
        if (r < I_WAL) { transpose_matrix_item(a.in[I_WBA] + (size_t)l * W * D, W, D, (bf16*)(a.ws + WS_WA + (size_t)l * WS_WL1), r, scr, c.lane, RowId()); continue; } r -= I_WAL;
        if (r < I_WAL) { transpose_matrix_item(a.in[I_WBB] + (size_t)l * W * D, W, D, (bf16*)(a.ws + WS_WB + (size_t)l * WS_WL1), r, scr, c.lane, RowId()); continue; } r -= I_WAL;
        transpose_matrix_item(a.in[I_WOUT] + (size_t)l * D * D, D, D, (bf16*)(a.ws + WS_WO + (size_t)l * WS_WL1), r, scr, c.lane, RowId());
    }
}

__device__ __forceinline__ void row_stats(const float (&v)[16], float& mean, float& rstd) {
    float s = 0.f;
#pragma unroll
    for (int j = 0; j < 16; ++j) s += v[j];
    mean = wave_sum(s) * (1.f / D);
    float q = 0.f;
#pragma unroll
    for (int j = 0; j < 16; ++j) { const float d = v[j] - mean; q += d * d; }
    rstd = __builtin_amdgcn_rsqf(wave_sum(q) * (1.f / D) + LN_EPS);
}
__device__ __forceinline__ void load_row16bf(const bf16* p, int lane, float (&v)[16]) {
#pragma unroll
    for (int j = 0; j < 4; ++j) { const f32x4 x = load4bf(p + 4 * lane + 256 * j); v[4 * j] = x[0]; v[4 * j + 1] = x[1]; v[4 * j + 2] = x[2]; v[4 * j + 3] = x[3]; }
}
__device__ __forceinline__ void load_row16(const float* p, int lane, float (&v)[16]) {
#pragma unroll
    for (int j = 0; j < 4; ++j) { const f32x4 x = *(const f32x4*)(p + 4 * lane + 256 * j); v[4 * j] = x[0]; v[4 * j + 1] = x[1]; v[4 * j + 2] = x[2]; v[4 * j + 3] = x[3]; }
}

__device__ __forceinline__ void phase_p0b(ArgsR a, const Ctx& c) {
    const float* MODF = (const float*)(a.ws + WS_MODF);
    float sh[16], sc[16];
#pragma unroll
    for (int j = 0; j < 4; ++j) { const f32x4 s0 = *(const f32x4*)(MODF + 4 * c.lane + 256 * j), s1 = *(const f32x4*)(MODF + 1024 + 4 * c.lane + 256 * j);
#pragma unroll
        for (int e = 0; e < 4; ++e) { sh[4 * j + e] = s0[e]; sc[4 * j + e] = 1.f + s1[e]; } }
    bf16* XN = (bf16*)(a.ws + WS_XN);
    for (int m = c.gw; m < T; m += c.ngw) {
        float v[16]; load_row16(a.in[I_X] + (size_t)m * D, c.lane, v);
        float mean, rstd; row_stats(v, mean, rstd);
#pragma unroll
        for (int j = 0; j < 4; ++j) { f32x4 o;
#pragma unroll
            for (int e = 0; e < 4; ++e) o[e] = (v[4 * j + e] - mean) * rstd * sc[4 * j + e] + sh[4 * j + e];
            store4bf(XN + (size_t)m * D + 4 * c.lane + 256 * j, o); }
    }
}

namespace pg8 {
#define PG8_LAS __attribute__((address_space(3)))
typedef unsigned short bf16_t;
typedef short bf16x8 __attribute__((ext_vector_type(8)));
typedef float f32x4 __attribute__((ext_vector_type(4)));
typedef unsigned u32x4 __attribute__((ext_vector_type(4)));
constexpr int BM = 256, BK = 64, HALF = 128, HTB = HALF * BK * 2  , STAGE_BYTES = 8 * HTB, NXCD = 8, WGM = 8;

__host__ __device__ __forceinline__ int lds_byte(int r, int c) { const int st = (r >> 4) * 2 + (c >> 5), rr = r & 15, cc = c & 31, ob = rr * 64 + cc * 2; return st * 1024 + (ob ^ (((ob >> 9) & 1) << 5)); }
__host__ __device__ __forceinline__ void stage_rc(int b, int& R, int& C) { const int st = b / 1024, sb = b % 1024, swz = sb ^ (((sb >> 9) & 1) << 5); R = (st >> 1) * 16 + swz / 64; C = (st & 1) * 32 + (swz % 64) / 2; }
__host__ __device__ __forceinline__ int perm32(int rho) { const int n = rho >> 4, i = rho & 15; return 8 * (i >> 2) + 4 * n + (i & 3); }

struct Unit { int pm, pn; };
struct Gemm { const bf16_t* A; const bf16_t* Bt; int M, N, K; };

struct StaticOrder {
    int nM, nN, nwg, G, c;
    __host__ __device__ void init(int M, int N, int G_, int c_) { nM = M / BM; nN = N / BM; nwg = nM * nN; G = G_; c = c_; }
    __host__ __device__ bool next(int i, Unit& u) const {
        const long L = (long)i * G + c; if (L >= nwg) return false;
        int wgid = (int)L; { const int q = nwg / NXCD, r = nwg % NXCD, xcd = wgid % NXCD, off = wgid / NXCD; wgid = (xcd < r ? xcd * (q + 1) : r * (q + 1) + (xcd - r) * q) + off; }
        const int nig = WGM * nN, gid = wgid / nig, fm = gid * WGM, gsz = (nM - fm) < WGM ? (nM - fm) : WGM;
        u.pm = fm + ((wgid % nig) % gsz); u.pn = (wgid % nig) / gsz; return true;
    }
    __device__ __forceinline__ void a_ready(const Unit&) const {}
    __device__ __forceinline__ void done(const Unit&) const {}
};


template <class Epi, class Sched, bool ALIGN_EPI = false, bool SP2 = false, bool GATHER = false>
__device__ __forceinline__ void gemm_phase(PG8_LAS unsigned char* lds, const Gemm g, const Sched& S, const Epi& E, const int tid_in, const int* s2t = nullptr) {
    const int tid = tid_in, wid = __builtin_amdgcn_readfirstlane(tid >> 6), lane = tid & 63, wr = wid >> 2, wc = wid & 3, fr = lane & 15, fq = lane >> 4;
    const int K = g.K, nt = K / BK;
    unsigned voffA[2], voffB[2];
#pragma unroll
    for (int i = 0; i < 2; ++i) { int R, C; stage_rc(tid * 16 + i * 8192, R, C); const int Rb = Epi::PERM ? ((R & ~31) + perm32(R & 31)) : R;
        voffA[i] = (unsigned)(R * K + C) * 2u; voffB[i] = (unsigned)(Rb * K + C) * 2u; }
    unsigned pc0 = 0u, pc1 = 0u, pn0 = 0u, pn1 = 0u, cvoff = 0u; int R0g = 0;
    if constexpr (GATHER) { int R, C; stage_rc(tid * 16, R, C); R0g = R; cvoff = (unsigned)C * 2u; }
#define PG8_TOKPACK(pm_, h_) ([&]() -> unsigned { const int r0_ = (pm_) * BM + (h_) * HALF + R0g; const int a0_ = s2t[2 * r0_], a1_ = s2t[2 * (r0_ + 64)]; return (unsigned)(a0_ < 0 ? 0 : (a0_ >> 1)) | ((unsigned)(a1_ < 0 ? 0 : (a1_ >> 1)) << 16); }())
#define PG8_STAGE_A(bufoff, base, h, usen) do { if constexpr (GATHER) { const unsigned pk_ = (usen) ? ((h) ? pn1 : pn0) : ((h) ? pc1 : pc0); \
        unsigned vt_[2] = {(pk_ & 0xffffu) * (unsigned)(K * 2) + cvoff, (pk_ >> 16) * (unsigned)(K * 2) + cvoff}; PG8_STAGE(bufoff, base, vt_); } \
    else PG8_STAGE(bufoff, (base) + ((h) ? hstep : (size_t)0), voffA); } while (0)
    const size_t kstep = (size_t)(BK * 2);
    const size_t hstep = (size_t)HALF * K * 2;
    const size_t tstep = 2 * hstep;
    const unsigned ldsw = (unsigned)wid * 1024u;
    const int aoff = lds_byte(wr * 64 + fr, fq * 8), boff = lds_byte(wc * 32 + fr, fq * 8);
#define PG8_SA(b, h) (((b) * 2 + (h)) * HTB)
#define PG8_SB(b, h) ((4 + (b) * 2 + (h)) * HTB)
#define PG8_STAGE(bufoff, gbase, voff) do { _Pragma("unroll") for (int _i = 0; _i < 2; ++_i) \
        __builtin_amdgcn_global_load_lds((const unsigned*)((const char*)(gbase) + (voff)[_i]), (PG8_LAS unsigned*)(lds + (bufoff) + ldsw + _i * 8192), 16, 0, 0); } while (0)
#define PG8_LDA(dst, b, h) do { _Pragma("unroll") for (int m = 0; m < 4; ++m) _Pragma("unroll") for (int k = 0; k < 2; ++k) dst[m][k] = *(const PG8_LAS bf16x8*)(lds + PG8_SA(b, h) + aoff + m * 2048 + k * 1024); } while (0)
#define PG8_LDB(dst, b, h) do { _Pragma("unroll") for (int n = 0; n < 2; ++n) _Pragma("unroll") for (int k = 0; k < 2; ++k) dst[n][k] = *(const PG8_LAS bf16x8*)(lds + PG8_SB(b, h) + boff + n * 2048 + k * 1024); } while (0)
#define PG8_MMA(ai, bj, At, Bt) do { __builtin_amdgcn_s_setprio(1); _Pragma("unroll") for (int m = 0; m < 4; ++m) _Pragma("unroll") for (int n = 0; n < 2; ++n) _Pragma("unroll") for (int k = 0; k < 2; ++k) \
        acc[ai][bj][m][n] = __builtin_amdgcn_mfma_f32_16x16x32_bf16(Bt[n][k], At[m][k], acc[ai][bj][m][n], 0, 0, 0); __builtin_amdgcn_s_setprio(0); } while (0)
#define PG8_WAIT_V(n) asm volatile("s_waitcnt vmcnt(" #n ")" ::: "memory")
#define PG8_WAIT_L(n) asm volatile("s_waitcnt lgkmcnt(" #n ")" ::: "memory")
#define PG8_BAR __builtin_amdgcn_s_barrier()
#define PG8_SCHED __builtin_amdgcn_sched_barrier(0)
    Unit cur, nxt; int ui = 0;
    if (!S.next(0, cur)) return;
    f32x4 acc[2][2][4][2];
#pragma unroll
    for (int a = 0; a < 2; ++a)
#pragma unroll
        for (int b = 0; b < 2; ++b)
#pragma unroll
            for (int m = 0; m < 4; ++m)
#pragma unroll
                for (int n = 0; n < 2; ++n) acc[a][b][m][n] = (f32x4){0.f, 0.f, 0.f, 0.f};
    bf16x8 At[4][2], B0[2][2], B1[2][2];
    const char* cA = (const char*)g.A + (GATHER ? (size_t)0 : (size_t)cur.pm * tstep); const char* cB = (const char*)g.Bt + (size_t)cur.pn * tstep;
    if constexpr (GATHER) { pc0 = PG8_TOKPACK(cur.pm, 0); pc1 = PG8_TOKPACK(cur.pm, 1); }
    S.a_ready(cur);
    if constexpr (SP2) {
        PG8_STAGE(PG8_SB(0, 0), cB, voffB); PG8_STAGE(PG8_SB(0, 1), cB + hstep, voffB); PG8_STAGE_A(PG8_SA(0, 0), cA, 0, false); PG8_STAGE_A(PG8_SA(0, 1), cA, 1, false);
        if (wr == 1) PG8_BAR;
        PG8_WAIT_V(2); PG8_BAR;
        PG8_STAGE(PG8_SB(1, 0), cB + kstep, voffB); PG8_STAGE_A(PG8_SA(1, 0), cA + kstep, 0, false); PG8_STAGE(PG8_SB(1, 1), cB + hstep + kstep, voffB);
        PG8_WAIT_V(6); PG8_BAR;
    } else {
        PG8_STAGE(PG8_SB(0, 0), cB, voffB); PG8_STAGE(PG8_SA(0, 0), cA, voffA); PG8_STAGE(PG8_SB(0, 1), cB + hstep, voffB); PG8_STAGE(PG8_SA(0, 1), cA + hstep, voffA);
        if (wr == 1) PG8_BAR;
        PG8_WAIT_V(4); PG8_BAR;
        PG8_STAGE(PG8_SB(1, 0), cB + kstep, voffB); PG8_STAGE(PG8_SA(1, 0), cA + kstep, voffA); PG8_STAGE(PG8_SB(1, 1), cB + hstep + kstep, voffB);
        PG8_WAIT_V(6); PG8_BAR;
    }
    for (;;) {
        const bool has_next = S.next(ui + 1, nxt);
        const char* nA = (has_next && !GATHER) ? (const char*)g.A + (size_t)nxt.pm * tstep : cA; const char* nB = has_next ? (const char*)g.Bt + (size_t)nxt.pn * tstep : cB;
        if constexpr (GATHER) { if (has_next) { pn0 = PG8_TOKPACK(nxt.pm, 0); pn1 = PG8_TOKPACK(nxt.pm, 1); } else { pn0 = pc0; pn1 = pc1; } }
        for (int t = 0; t < nt; t += 2) {
            const bool last = (t == nt - 2);
            const char* a1 = cA + (size_t)(t + 1) * kstep;
            const char* a2 = last ? nA : cA + (size_t)(t + 2) * kstep; const char* b2 = last ? nB : cB + (size_t)(t + 2) * kstep;
            const char* a3 = a2 + kstep; const char* b3 = b2 + kstep;
            if (last && has_next) S.a_ready(nxt);
            if constexpr (SP2) {
            PG8_LDB(B0, 0, 0); PG8_LDB(B1, 0, 1); PG8_SCHED; PG8_LDA(At, 0, 0); PG8_STAGE_A(PG8_SA(1, 1), a1, 1, false);
            PG8_WAIT_V(8); PG8_WAIT_L(0); PG8_BAR; PG8_MMA(0, 0, At, B0); PG8_MMA(0, 1, At, B1); PG8_BAR; PG8_SCHED;
            PG8_LDA(At, 0, 1); PG8_STAGE(PG8_SB(0, 0), b2, voffB); PG8_STAGE(PG8_SB(0, 1), b2 + hstep, voffB); PG8_STAGE_A(PG8_SA(0, 0), a2, 0, last);
            PG8_WAIT_V(8); PG8_WAIT_L(0); PG8_BAR; PG8_MMA(1, 0, At, B0); PG8_MMA(1, 1, At, B1); PG8_BAR; PG8_SCHED;
            PG8_LDB(B0, 1, 0); PG8_LDB(B1, 1, 1); PG8_SCHED; PG8_LDA(At, 1, 0); PG8_STAGE_A(PG8_SA(0, 1), a2, 1, last);
            PG8_WAIT_V(8); PG8_WAIT_L(0); PG8_BAR; PG8_MMA(0, 0, At, B0); PG8_MMA(0, 1, At, B1); PG8_BAR; PG8_SCHED;
            PG8_LDA(At, 1, 1); PG8_STAGE(PG8_SB(1, 0), b3, voffB); PG8_STAGE(PG8_SB(1, 1), b3 + hstep, voffB); PG8_STAGE_A(PG8_SA(1, 0), a3, 0, last);
            PG8_WAIT_V(8); PG8_WAIT_L(0); PG8_BAR; PG8_MMA(1, 0, At, B0); PG8_MMA(1, 1, At, B1); PG8_BAR; PG8_SCHED;
            } else {
            PG8_LDB(B0, 0, 0); PG8_SCHED; PG8_LDA(At, 0, 0); PG8_STAGE(PG8_SA(1, 1), a1 + hstep, voffA);
            PG8_WAIT_L(8); PG8_BAR; PG8_WAIT_L(0); PG8_MMA(0, 0, At, B0); PG8_BAR; PG8_SCHED;
            PG8_LDB(B1, 0, 1); PG8_STAGE(PG8_SB(0, 0), b2, voffB);
            PG8_BAR; PG8_WAIT_L(0); PG8_MMA(0, 1, At, B1); PG8_BAR;
            PG8_LDA(At, 0, 1); PG8_STAGE(PG8_SA(0, 0), a2, voffA);
            PG8_BAR; PG8_WAIT_L(0); PG8_MMA(1, 0, At, B0); PG8_BAR; PG8_SCHED;
            PG8_STAGE(PG8_SB(0, 1), b2 + hstep, voffB);
            PG8_WAIT_V(6); PG8_BAR; PG8_MMA(1, 1, At, B1); PG8_BAR;
            PG8_LDB(B0, 1, 0); PG8_SCHED; PG8_LDA(At, 1, 0); PG8_STAGE(PG8_SA(0, 1), a2 + hstep, voffA);
            PG8_WAIT_L(8); PG8_BAR; PG8_WAIT_L(0); PG8_MMA(0, 0, At, B0); PG8_BAR; PG8_SCHED;
            PG8_LDB(B1, 1, 1); PG8_STAGE(PG8_SB(1, 0), b3, voffB);
            PG8_BAR; PG8_WAIT_L(0); PG8_MMA(0, 1, At, B1); PG8_BAR;
            PG8_LDA(At, 1, 1); PG8_STAGE(PG8_SA(1, 0), a3, voffA);
            PG8_BAR; PG8_WAIT_L(0); PG8_MMA(1, 0, At, B0); PG8_BAR; PG8_SCHED;
            PG8_STAGE(PG8_SB(1, 1), b3 + hstep, voffB);
            PG8_WAIT_V(6); PG8_BAR; PG8_MMA(1, 1, At, B1); PG8_BAR;
            }
        }
        if constexpr (ALIGN_EPI) { if (wr == 0) PG8_BAR; }
        if constexpr (!Epi::AFTER_DRAIN) { E(acc, cur, wr, wc, fr, fq); S.done(cur); }
        if (!has_next) break;
#pragma unroll
        for (int a = 0; a < 2; ++a)
#pragma unroll
            for (int b = 0; b < 2; ++b)
#pragma unroll
                for (int m = 0; m < 4; ++m)
#pragma unroll
                    for (int n = 0; n < 2; ++n) acc[a][b][m][n] = (f32x4){0.f, 0.f, 0.f, 0.f};
        cur = nxt; cA = nA; cB = nB; ++ui; if constexpr (GATHER) { pc0 = pn0; pc1 = pn1; }
        if constexpr (ALIGN_EPI) { if (wr == 1) PG8_BAR; }
    }
    PG8_WAIT_V(0);
    if constexpr (!ALIGN_EPI) { if (wr == 0) PG8_BAR; }
    PG8_BAR;
    if constexpr (Epi::AFTER_DRAIN) { E.fused(acc, cur, wr, wc, fr, fq, lds, wid, lane); S.done(cur); }
#undef PG8_SA
#undef PG8_SB
#undef PG8_STAGE
#undef PG8_STAGE_A
#undef PG8_TOKPACK
#undef PG8_LDA
#undef PG8_LDB
#undef PG8_MMA
#undef PG8_WAIT_V
#undef PG8_WAIT_L
#undef PG8_BAR
#undef PG8_SCHED
}
}

using pg8::Unit;
struct DenseSched { int nN, n, G, c;
    __device__ __forceinline__ void a_ready(const Unit&) const {}
    __device__ __forceinline__ void done(const Unit&) const {}
    __device__ __forceinline__ bool next(int i, Unit& u) const { const int L = i * G + c; if (L >= n) return false; u.pm = L / nN; u.pn = L % nN; return true; } };

__device__ __forceinline__ void store8bf(bf16* p, f32x4 lo, f32x4 hi) { u32x4 w; w.x = pk2(lo[0], lo[1]); w.y = pk2(lo[2], lo[3]); w.z = pk2(hi[0], hi[1]); w.w = pk2(hi[2], hi[3]); *(u32x4*)p = w; }
__device__ __forceinline__ void load8bf(const bf16* p, f32x4& lo, f32x4& hi) { const u32x4 w = *(const u32x4*)p;
    lo[0] = __uint_as_float(w.x << 16); lo[1] = __uint_as_float(w.x & 0xffff0000u); lo[2] = __uint_as_float(w.y << 16); lo[3] = __uint_as_float(w.y & 0xffff0000u);
    hi[0] = __uint_as_float(w.z << 16); hi[1] = __uint_as_float(w.z & 0xffff0000u); hi[2] = __uint_as_float(w.w << 16); hi[3] = __uint_as_float(w.w & 0xffff0000u); }
struct EpiZ { bf16 *ZR, *ZS, *ZG;
    __device__ __forceinline__ void one(int row, int col, f32x4 lo, f32x4 hi) const {
        if (col < RC) store8bf(ZR + (size_t)row * RC + col, lo, hi);
        else if (col < RC + 1024) { for (int e = 0; e < 4; ++e) { lo[e] = gelu_tanh(lo[e]); hi[e] = gelu_tanh(hi[e]); } store8bf(ZS + (size_t)row * 1024 + (col - RC), lo, hi); }
        else { for (int e = 0; e < 4; ++e) { lo[e] = sigmoidf_(lo[e]); hi[e] = sigmoidf_(hi[e]); } store8bf(ZG + (size_t)row * 2048 + (col - RC - 1024), lo, hi); } }
    __device__ __forceinline__ void operator()(int row, int col, f32x4 a0, f32x4 a1, f32x4 b0, f32x4 b1) const { one(row, col, a0, a1); one(row, col + 128, b0, b1); } };
struct EpiGA { const bf16* ZG; bf16* MP;
    __device__ __forceinline__ void one(int row, int col, f32x4 lo, f32x4 hi) const { f32x4 g0, g1; load8bf(ZG + (size_t)row * 2048 + col, g0, g1); store8bf(MP + (size_t)row * D + col, g0 * lo, g1 * hi); }
    __device__ __forceinline__ void operator()(int row, int col, f32x4 a0, f32x4 a1, f32x4 b0, f32x4 b1) const { one(row, col, a0, a1); one(row, col + 128, b0, b1); } };
struct EpiGB { const bf16* ZG; const bf16* MPin; bf16* MP;
    __device__ __forceinline__ void one(int row, int col, f32x4 lo, f32x4 hi) const { f32x4 g0, g1, m0, m1; load8bf(ZG + (size_t)row * 2048 + 1024 + col, g0, g1); load8bf(MPin + (size_t)row * D + col, m0, m1);
        store8bf(MP + (size_t)row * D + col, m0 + g0 * lo, m1 + g1 * hi); }
    __device__ __forceinline__ void operator()(int row, int col, f32x4 a0, f32x4 a1, f32x4 b0, f32x4 b1) const { one(row, col, a0, a1); one(row, col + 128, b0, b1); } };
struct EpiOut { const float* xin; bf16* tmp; const float* gate1;
    __device__ __forceinline__ void one(int row, int col, f32x4 lo, f32x4 hi) const { const f32x4 x0 = *(const f32x4*)(xin + (size_t)row * D + col), x1 = *(const f32x4*)(xin + (size_t)row * D + col + 4);
        const f32x4 g0 = *(const f32x4*)(gate1 + col), g1 = *(const f32x4*)(gate1 + col + 4); store8bf(tmp + (size_t)row * D + col, ALPHA * x0 + (1.0f + g0) * lo, ALPHA * x1 + (1.0f + g1) * hi); }
    __device__ __forceinline__ void operator()(int row, int col, f32x4 a0, f32x4 a1, f32x4 b0, f32x4 b1) const { one(row, col, a0, a1); one(row, col + 128, b0, b1); } };
struct EpiSwi { bf16* HID;
    __device__ __forceinline__ void operator()(int row, int col, f32x4 a0, f32x4 a1, f32x4 b0, f32x4 b1) const { const int ct = (col >> 8) & 3, cc = col & 127;
        f32x4 h0, h1; for (int e = 0; e < 4; ++e) { h0[e] = siluf_(a0[e]) * b0[e]; h1[e] = siluf_(a1[e]) * b1[e]; } store8bf(HID + (size_t)row * FF + ct * 128 + cc, h0, h1); } };
struct EpiSwiWT { bf16* HID;
    __device__ __forceinline__ void operator()(int row, int col, f32x4 a0, f32x4 a1, f32x4 b0, f32x4 b1) const { const int ct = (col >> 8) & 3, cc = col & 127;
        const __amdgpu_buffer_rsrc_t rs = __builtin_amdgcn_make_buffer_rsrc((void*)HID, 0, MAXSLOT * FF * 2, 0x00020000);
        f32x4 h0, h1; for (int e = 0; e < 4; ++e) { h0[e] = siluf_(a0[e]) * b0[e]; h1[e] = siluf_(a1[e]) * b1[e]; }
        u32x4 w; w.x = pk2(h0[0], h0[1]); w.y = pk2(h0[2], h0[3]); w.z = pk2(h1[0], h1[1]); w.w = pk2(h1[2], h1[3]);
        __builtin_amdgcn_raw_buffer_store_b128(w, rs, (unsigned)((row * FF + ct * 128 + cc) * 2), 0, 16); } };
struct EpiDown { const int* S2T; const float* TOKW; bf16* Y;
    __device__ __forceinline__ void operator()(int row, int col, f32x4 a0, f32x4 a1, f32x4 b0, f32x4 b1) const { const u32x2 sw = *(const u32x2*)(S2T + 2 * row); const int st = (int)sw.x; if (st < 0) return; const float w = __uint_as_float(sw.y); const int cc = col & 1023;
        store8bf(Y + (size_t)st * D + cc, w * a0, w * a1); store8bf(Y + (size_t)st * D + cc + 128, w * b0, w * b1); } };

struct MoeSched { int ts[17]; int G, c, NU, LA;
    __device__ __forceinline__ void a_ready(const Unit&) const {}
    __device__ __forceinline__ void done(const Unit&) const {}
    __device__ __forceinline__ void init(const unsigned* cnt, int G_, int c_) { G = G_; c = c_; int s = 0;
#pragma unroll
        for (int e = 0; e < 16; ++e) { ts[e] = s; s += ((int)cnt[e] + 255) >> 8; } ts[16] = s; NU = 4 * s; LA = ((NU / G) * G) & ~3; }
    __device__ __forceinline__ void unit_of(int L, Unit& u) const { const int rt = L >> 2, ct = L & 3; int e = 0;
#pragma unroll
        for (int j = 1; j < 16; ++j) e += (rt >= ts[j]) ? 1 : 0;
        u.pm = rt; u.pn = e * 4 + ct; }
    __device__ __forceinline__ bool next(int i, Unit& u) const { const int L = i * G + c; if (L >= NU) return false; unit_of(L, u); return true; } };
struct MoeSchedA : MoeSched {
    __device__ __forceinline__ bool next(int i, Unit& u) const { const int L = i * G + c; if (L >= LA) return false; unit_of(L, u); return true; } };
struct MoeSchedT : MoeSched { unsigned* rdy;
    __device__ __forceinline__ bool next(int i, Unit& u) const { const int L = LA + i * G + c; if (L >= NU) return false; unit_of(L, u); return true; }
    __device__ __forceinline__ void done(const Unit& u) const {
        asm volatile("s_waitcnt vmcnt(0)" ::: "memory");
        if (__builtin_amdgcn_mbcnt_hi(~0u, __builtin_amdgcn_mbcnt_lo(~0u, 0u)) == 0u) (void)__hip_atomic_fetch_add(rdy + 64 * u.pm, 1u, __ATOMIC_RELAXED, __HIP_MEMORY_SCOPE_AGENT); } };
struct MoeSchedB : MoeSched { unsigned* rdy; unsigned* tmo; int wave;
    __device__ __forceinline__ bool next(int i, Unit& u) const { const int NT = NU - LA; int q;
        if (c < NT) { if (i > 0) return false; q = G - NT + c; }
        else { const int p = c - NT; q = (i == 0) ? p : G + p + (i - 1) * (G - NT); }
        if (q >= NU) return false; unit_of(q, u); return true; }
    __device__ __forceinline__ void a_ready(const Unit& u) const {
        if (4 * u.pm < LA) return;
        if (wave == 0) { unsigned sp = 0u;
            while ((unsigned)__builtin_amdgcn_readfirstlane(__hip_atomic_load(rdy + 64 * u.pm, __ATOMIC_RELAXED, __HIP_MEMORY_SCOPE_AGENT)) < 32u) { __builtin_amdgcn_s_sleep(2);
                if ((++sp & 255u) == 0u) { if (__hip_atomic_load(tmo, __ATOMIC_RELAXED, __HIP_MEMORY_SCOPE_AGENT)) break; if (sp > (1u << 24)) { atomicAdd(tmo, 1u); break; } } }
            __builtin_amdgcn_fence(__ATOMIC_ACQUIRE, "agent");
            asm volatile("s_waitcnt vmcnt(0)" ::: "memory"); }
        asm volatile("" ::: "memory"); __builtin_amdgcn_s_barrier(); asm volatile("" ::: "memory"); } };

__device__ __forceinline__ void phase_prep_simple(ArgsR a, const Ctx& c, int l) {
    const bf16* ZR = (const bf16*)(a.ws + WS_ZR);
    const float* mu = a.in[I_MU] + l * RC; const float* w0 = a.in[I_W0] + l * W; const float* w2 = a.in[I_W2] + (size_t)l * 64 * W;
    const float* a0 = a.in[I_A0] + l * W; const float* a2 = a.in[I_A2] + (size_t)l * 64 * W; const float* g2 = a.in[I_G2] + (size_t)l * 128 * W;
    const float* k_k = a.in[I_KK] + l * W; const float* k_a = a.in[I_KA] + l * W;
    const float* vm0 = a.in[I_VM0]; const float* vm1 = a.in[I_VM1]; const float* vm2 = a.in[I_VM2];
    f16* R = (f16*)(a.ws + WS_R); f16* WM1 = (f16*)(a.ws + WS_WM1); f16* KP = (f16*)(a.ws + WS_KP); f16* AA = (f16*)(a.ws + WS_AA); f16* BB = (f16*)(a.ws + WS_BB); f16* V = (f16*)(a.ws + WS_V);
    bf16* G = (bf16*)(a.ws + WS_G); bf16* VF = (bf16*)(a.ws + WS_VF);
    const int lane = c.lane;
    for (int t = c.gw; t < T; t += c.ngw) {
        float z[28];
#pragma unroll
        for (int i = 0; i < 28; ++i) { const int col = lane + 64 * i; const float zc = bf2f(ZR[(size_t)t * RC + col]); const float zp = t > 0 ? bf2f(ZR[(size_t)(t - 1) * RC + col]) : 0.f; z[i] = zc + (zp - zc) * mu[col]; }
        const float tw = tanhf(z[24]), za = z[25], sg0 = sigmoidf_(z[26]), sg1 = sigmoidf_(z[27]);
        float wlo[8], alo[8], gg[8];
#pragma unroll
        for (int i = 0; i < 8; ++i) { wlo[i] = 0.f; alo[i] = 0.f; gg[i] = 0.f; }
        for (int j = 0; j < 64; ++j) { const float tj = __shfl(tw, j), aj = __shfl(za, j), s0 = __shfl(sg0, j), s1 = __shfl(sg1, j);
#pragma unroll
            for (int i = 0; i < 8; ++i) { const int n = lane + 64 * i; wlo[i] += tj * w2[j * W + n]; alo[i] += aj * a2[j * W + n]; gg[i] += s0 * g2[j * W + n] + s1 * g2[(64 + j) * W + n]; } }
        float vv[8];
#pragma unroll
        for (int i = 0; i < 8; ++i) vv[i] = z[16 + i];
        if (l == 0) {
#pragma unroll
            for (int i = 0; i < 8; ++i) VF[(size_t)t * W + lane + 64 * i] = f2bf(vv[i]);
        } else {
            float vmid = 0.f;
#pragma unroll
            for (int i = 0; i < 8; ++i)
                for (int j = 0; j < 64; ++j) { const float vc = __shfl(vv[i], j); vmid += vc * vm1[(size_t)(64 * i + j) * 32 + (lane & 31)]; }
            float vg[8];
#pragma unroll
            for (int i = 0; i < 8; ++i) vg[i] = 0.f;
            for (int m = 0; m < 32; ++m) { const float vmm = __shfl(vmid, m);
#pragma unroll
                for (int i = 0; i < 8; ++i) vg[i] += vmm * vm2[m * W + lane + 64 * i]; }
#pragma unroll
            for (int i = 0; i < 8; ++i) { const int n = lane + 64 * i; const float vf = bf2f(VF[(size_t)t * W + n]); vv[i] = vv[i] + (vf - vv[i]) * sigmoidf_(vm0[n] + vg[i]); }
        }
#pragma unroll
        for (int i = 0; i < 8; ++i) {
            const int n = lane + 64 * i; const size_t o = (size_t)t * W + n;
            const float x = w0[n] + wlo[i]; const float wl = -softplusf_(-x) - 0.5f; const float dm1 = expm1f(-__expf(wl));
            const float av = sigmoidf_(a0[n] + alo[i]);
            const float kraw = z[8 + i];
            float kk = kraw * k_k[n]; const float nrm = sqrtf(wave_sum(kk * kk)); kk = kk / fmaxf(nrm, 1e-12f);
            const float kp = kraw * (1.0f + (av - 1.0f) * k_a[n]);
            R[o] = (f16)z[i]; WM1[o] = (f16)dm1; KP[o] = (f16)kp; AA[o] = (f16)(-kk); BB[o] = (f16)(kk * av); V[o] = (f16)vv[i]; G[o] = f2bf(gg[i]);
        }
    }
}

__device__ __forceinline__ void phase_sg_simple(ArgsR a, const Ctx& c, int l) {
    const bf16* ZS = (const bf16*)(a.ws + WS_ZS); bf16* YB = (bf16*)(a.ws + WS_YB);
    const float* lng = a.in[I_SGG] + l * W; const float* lnb = a.in[I_SGB] + l * W;
    float* vn = (float*)c.lds;
    float* st = vn + 128 * 64;
    for (int uidx = blockIdx.x; uidx < 128 * 8; uidx += gridDim.x) {
        const int ch = uidx >> 3, g = uidx & 7; const int tok0 = ch * 128;
        for (int i = 0; i < 16; ++i) { const int s = c.wave * 16 + i; const bf16* p = ZS + (size_t)(tok0 + s) * 1024 + 512 + c.lane * 8;
            const f32x4 x0 = load4bf(p), x1 = load4bf(p + 4);
            float sm = (x0[0] + x0[1]) + (x0[2] + x0[3]) + (x1[0] + x1[1]) + (x1[2] + x1[3]); const float mean = wave_sum(sm) * (1.f / 512.f);
            float q = 0.f; for (int e = 0; e < 4; ++e) { const float d0 = x0[e] - mean, d1 = x1[e] - mean; q += d0 * d0 + d1 * d1; }
            const float rstd = __builtin_amdgcn_rsqf(wave_sum(q) * (1.f / 512.f) + LN_EPS);
            if (c.lane == 0) { st[2 * s] = mean; st[2 * s + 1] = rstd; } }
        __syncthreads();
        for (int i = c.tid; i < 128 * 64; i += NTHREADS) { const int s = i >> 6, d = i & 63; const float x = bf2f(ZS[(size_t)(tok0 + s) * 1024 + 512 + g * 64 + d]);
            vn[i] = (x - st[2 * s]) * st[2 * s + 1] * lng[g * 64 + d] + lnb[g * 64 + d]; }
        __syncthreads();
        const int d = c.tid & 63, tq = c.tid >> 6;
        const float* Wg = a.in[I_WS] + (size_t)(l * 8 + g) * 128 * 128; const float* bs = a.in[I_BS] + (size_t)(l * 8 + g) * 128;
        for (int i = 0; i < 16; ++i) { const int t = tq + 8 * i; float acc = 0.f;
            for (int s = 0; s <= t; ++s) acc += Wg[t * 128 + s] * vn[s * 64 + d];
            const float u = bf2f(ZS[(size_t)(tok0 + t) * 1024 + g * 64 + d]);
            YB[(size_t)(tok0 + t) * W + g * 64 + d] = f2bf(u * (acc + bs[t])); }
        __syncthreads();
    }
}

#define LAS3 __attribute__((address_space(3)))
typedef short bf16x8 __attribute__((ext_vector_type(8)));
template <int MT, int NT, int KS, bool SWAP = false>
__device__ __forceinline__ void mma_lds_glob(const unsigned char* lds_base, int a_off_bytes, int lda, const bf16* Bt, int ldb, int n0, int lane, f32x4 (&acc)[MT][NT]) {
    const int fr = lane & 15, fq = lane >> 4;
    const LAS3 unsigned char* Ab = (const LAS3 unsigned char*)lds_base + a_off_bytes;
    int boff = (n0 + fr) * ldb + 8 * fq; asm volatile("" : "+v"(boff));
#pragma unroll
    for (int ks = 0; ks < KS; ++ks) {
        bf16x8 b[NT];
#pragma unroll
        for (int n = 0; n < NT; ++n) b[n] = *(const bf16x8*)(Bt + boff + 16 * n * ldb + 32 * ks);
#pragma unroll
        for (int m = 0; m < MT; ++m) { const bf16x8 av = *(const LAS3 bf16x8*)(Ab + ((16 * m + fr) * lda + 32 * ks + 8 * fq) * 2);
#pragma unroll
            for (int n = 0; n < NT; ++n) acc[m][n] = SWAP ? __builtin_amdgcn_mfma_f32_16x16x32_bf16(b[n], av, acc[m][n], 0, 0, 0) : __builtin_amdgcn_mfma_f32_16x16x32_bf16(av, b[n], acc[m][n], 0, 0, 0); }
    }
}
__device__ __forceinline__ void zshift8(const bf16* ZR, int t, int col, const float* mu, float (&o)[8]) {
    const u32x4 zc = *(const u32x4*)(ZR + (size_t)t * RC + col);
    u32x4 zp = {0u, 0u, 0u, 0u}; if (t > 0) zp = *(const u32x4*)(ZR + (size_t)(t - 1) * RC + col);
    const f32x4 m0 = *(const f32x4*)(mu + col), m1 = *(const f32x4*)(mu + col + 4);
#pragma unroll
    for (int e = 0; e < 4; ++e) { const float c0 = __uint_as_float(zc[e] << 16), c1 = __uint_as_float(zc[e] & 0xffff0000u), p0 = __uint_as_float(zp[e] << 16), p1 = __uint_as_float(zp[e] & 0xffff0000u);
        const float mu0 = (2 * e < 4) ? m0[(2 * e) & 3] : m1[(2 * e) & 3], mu1 = (2 * e + 1 < 4) ? m0[(2 * e + 1) & 3] : m1[(2 * e + 1) & 3];
        o[2 * e] = c0 + (p0 - c0) * mu0; o[2 * e + 1] = c1 + (p1 - c1) * mu1; }
}
typedef _Float16 f16x8 __attribute__((ext_vector_type(8)));
typedef _Float16 f16x4 __attribute__((ext_vector_type(4)));
__device__ __forceinline__ void store8f16(f16* p, const float (&v)[8]) { f16x8 h;
#pragma unroll
    for (int e = 0; e < 8; ++e) h[e] = (f16)v[e];
    *(f16x8*)p = h; }
__device__ __forceinline__ u32x4 pack8bf(const float (&v)[8]) { u32x4 w; w.x = pk2(v[0], v[1]); w.y = pk2(v[2], v[3]); w.z = pk2(v[4], v[5]); w.w = pk2(v[6], v[7]); return w; }


constexpr int PB_LD = 520;
constexpr int PB_BUF = 0, PB_AOP = 64 * PB_LD * 2, PB_VMID = 2 * 64 * PB_LD * 2, PB_LA_LD = 264, PB_VM_LD = 40;
__device__ __forceinline__ void phase_prep_fast(ArgsR a, const Ctx& c, int l) {
    const bf16* ZR = (const bf16*)(a.ws + WS_ZR);
    const float* mu = a.in[I_MU] + l * RC; const float* w0 = a.in[I_W0] + l * W; const float* a0 = a.in[I_A0] + l * W;
    const float* k_k = a.in[I_KK] + l * W; const float* k_a = a.in[I_KA] + l * W; const float* vm0 = a.in[I_VM0];
    f16* R = (f16*)(a.ws + WS_R); f16* WM1 = (f16*)(a.ws + WS_WM1); f16* KP = (f16*)(a.ws + WS_KP); f16* AA = (f16*)(a.ws + WS_AA); f16* BB = (f16*)(a.ws + WS_BB); f16* V = (f16*)(a.ws + WS_V);
    bf16* G = (bf16*)(a.ws + WS_G); bf16* VF = (bf16*)(a.ws + WS_VF);
    const unsigned char* lo = a.ws + WS_LORA + (size_t)l * LO_STRIDE;
    const bf16* W2T = (const bf16*)(lo + LO_W2T); const bf16* A2T = (const bf16*)(lo + LO_A2T); const bf16* G2T = (const bf16*)(lo + LO_G2T);
    const bf16* VM1T = (const bf16*)(lo + LO_VM1T); const bf16* VM2T = (const bf16*)(lo + LO_VM2T);
    LAS3 unsigned char* L = (LAS3 unsigned char*)c.lds;
    const int tid = c.tid, lane = c.lane, wv = c.wave, fr = lane & 15, fq = lane >> 4;
    const int row = tid >> 3, sub_ = tid & 7;
    for (int u = blockIdx.x; u < T / 64; u += gridDim.x) {
        int sub = sub_; asm volatile("" : "+v"(sub));
        const int t0 = u * 64, t = t0 + row;
        if (l == 0) {
#pragma unroll 4
            for (int p = 0; p < 8; ++p) { const int col = p * 64 + sub * 8; float z[8]; zshift8(ZR, t, 1024 + col, mu, z);
                store8f16(V + (size_t)t * W + col, z); *(u32x4*)(VF + (size_t)t * W + col) = pack8bf(z); }
        } else {
#pragma unroll 4
            for (int p = 0; p < 8; ++p) { const int col = p * 64 + sub * 8; float z[8]; zshift8(ZR, t, 1024 + col, mu, z);
                *(LAS3 u32x4*)(L + PB_AOP + (row * PB_LD + col) * 2) = pack8bf(z); }
            __syncthreads();
            { f32x4 acc[1][1]; acc[0][0] = (f32x4){0.f, 0.f, 0.f, 0.f}; const int m = wv >> 1, n = wv & 1;
              mma_lds_glob<1, 1, 16>(c.lds, PB_AOP + 16 * m * PB_LD * 2, PB_LD, VM1T, W, 16 * n, lane, acc);
#pragma unroll
              for (int i = 0; i < 4; ++i) *(LAS3 bf16*)(L + PB_VMID + ((16 * m + 4 * fq + i) * PB_VM_LD + 16 * n + fr) * 2) = f2bf(acc[0][0][i]); }
            __syncthreads();
            { f32x4 acc[4][4];
#pragma unroll
              for (int m = 0; m < 4; ++m)
#pragma unroll
                  for (int n = 0; n < 4; ++n) acc[m][n] = (f32x4){0.f, 0.f, 0.f, 0.f};
              mma_lds_glob<4, 4, 1, true>(c.lds, PB_VMID, PB_VM_LD, VM2T, 32, 64 * wv, lane, acc);
#pragma unroll
              for (int m = 0; m < 4; ++m)
#pragma unroll
                  for (int n = 0; n < 4; ++n) { const int col = 64 * wv + 16 * n + 4 * fq; const f32x4 vb = *(const f32x4*)(vm0 + col); f16x4 hv;
#pragma unroll
                      for (int i = 0; i < 4; ++i) hv[i] = (f16)sigmoidf_(vb[i] + acc[m][n][i]);
                      *(LAS3 f16x4*)(L + PB_BUF + ((16 * m + fr) * PB_LD + col) * 2) = hv; } }
            __syncthreads();
#pragma unroll 4
            for (int p = 0; p < 8; ++p) { const int col = p * 64 + sub * 8;
                const u32x4 vz = *(const LAS3 u32x4*)(L + PB_AOP + (row * PB_LD + col) * 2); const f16x8 gt = *(const LAS3 f16x8*)(L + PB_BUF + (row * PB_LD + col) * 2);
                const u32x4 vfw = *(const u32x4*)(VF + (size_t)t * W + col); float o[8];
#pragma unroll
                for (int e = 0; e < 4; ++e) { const float v0 = __uint_as_float(vz[e] << 16), v1 = __uint_as_float(vz[e] & 0xffff0000u), f0 = __uint_as_float(vfw[e] << 16), f1 = __uint_as_float(vfw[e] & 0xffff0000u);
                    o[2 * e] = v0 + (f0 - v0) * (float)gt[2 * e]; o[2 * e + 1] = v1 + (f1 - v1) * (float)gt[2 * e + 1]; }
                store8f16(V + (size_t)t * W + col, o); }
            __syncthreads();
        }
#pragma unroll 4
        for (int p = 0; p < 4; ++p) { const int cc = sub * 32 + p * 8; float z[8]; zshift8(ZR, t, 1536 + cc, mu, z);
#pragma unroll
            for (int e = 0; e < 8; ++e) z[e] = cc < 64 ? (1.0f - 2.0f * __builtin_amdgcn_rcpf(1.0f + __expf(2.0f * z[e]))) : (cc < 128 ? z[e] : sigmoidf_(z[e]));
            *(LAS3 u32x4*)(L + PB_AOP + (row * PB_LA_LD + cc) * 2) = pack8bf(z); }
        __syncthreads();
        { f32x4 acc[4][4];
#pragma unroll
          for (int m = 0; m < 4; ++m)
#pragma unroll
              for (int n = 0; n < 4; ++n) acc[m][n] = (f32x4){0.f, 0.f, 0.f, 0.f};
          mma_lds_glob<4, 4, 2, true>(c.lds, PB_AOP + 64 * 2, PB_LA_LD, A2T, 64, 64 * wv, lane, acc);
#pragma unroll
          for (int m = 0; m < 4; ++m)
#pragma unroll
              for (int n = 0; n < 4; ++n) { const int col = 64 * wv + 16 * n + 4 * fq; const f32x4 ab = *(const f32x4*)(a0 + col); f16x4 hv;
#pragma unroll
                  for (int i = 0; i < 4; ++i) hv[i] = (f16)sigmoidf_(ab[i] + acc[m][n][i]);
                  *(LAS3 f16x4*)(L + PB_BUF + ((16 * m + fr) * PB_LD + col) * 2) = hv; } }
        __syncthreads();
#pragma unroll 4
        for (int p = 0; p < 8; ++p) { const int col = p * 64 + sub * 8; const size_t o = (size_t)t * W + col;
            float z[8]; zshift8(ZR, t, col, mu, z); store8f16(R + o, z);
            float kz[8]; zshift8(ZR, t, 512 + col, mu, kz);
            const f16x8 av = *(const LAS3 f16x8*)(L + PB_BUF + (row * PB_LD + col) * 2);
            const f32x4 kk0 = *(const f32x4*)(k_k + col), kk1 = *(const f32x4*)(k_k + col + 4), ka0 = *(const f32x4*)(k_a + col), ka1 = *(const f32x4*)(k_a + col + 4);
            float kk[8], kp[8], bb[8]; float ss = 0.f;
#pragma unroll
            for (int e = 0; e < 8; ++e) { const float kkw = e < 4 ? kk0[e & 3] : kk1[e & 3], kaw = e < 4 ? ka0[e & 3] : ka1[e & 3]; kk[e] = kz[e] * kkw; ss += kk[e] * kk[e]; kp[e] = kz[e] * (1.0f + ((float)av[e] - 1.0f) * kaw); }
            ss += __shfl_xor(ss, 1); ss += __shfl_xor(ss, 2); ss += __shfl_xor(ss, 4);
            const float inv = fminf(__builtin_amdgcn_rsqf(ss), 1e12f);
#pragma unroll
            for (int e = 0; e < 8; ++e) { kk[e] *= inv; bb[e] = kk[e] * (float)av[e]; kk[e] = -kk[e]; }
            store8f16(KP + o, kp); store8f16(AA + o, kk); store8f16(BB + o, bb); }
        __syncthreads();
        { f32x4 acc[4][4];
#pragma unroll
          for (int m = 0; m < 4; ++m)
#pragma unroll
              for (int n = 0; n < 4; ++n) acc[m][n] = (f32x4){0.f, 0.f, 0.f, 0.f};
          mma_lds_glob<4, 4, 2, true>(c.lds, PB_AOP, PB_LA_LD, W2T, 64, 64 * wv, lane, acc);
#pragma unroll
          for (int m = 0; m < 4; ++m)
#pragma unroll
              for (int n = 0; n < 4; ++n) { const int col = 64 * wv + 16 * n + 4 * fq; const f32x4 wb = *(const f32x4*)(w0 + col); f16x4 hv;
#pragma unroll
                  for (int i = 0; i < 4; ++i) { const float x = wb[i] + acc[m][n][i]; const float wl = -(fmaxf(-x, 0.f) + __logf(1.0f + __expf(-fabsf(x)))) - 0.5f;
                      hv[i] = (f16)(__expf(-__expf(wl)) - 1.0f); }
                  *(LAS3 f16x4*)(L + PB_BUF + ((16 * m + fr) * PB_LD + col) * 2) = hv; } }
        __syncthreads();
#pragma unroll 4
        for (int p = 0; p < 8; ++p) { const int col = p * 64 + sub * 8; *(u32x4*)(WM1 + (size_t)t * W + col) = *(const LAS3 u32x4*)(L + PB_BUF + (row * PB_LD + col) * 2); }
        __syncthreads();
        { f32x4 acc[4][4];
#pragma unroll
          for (int m = 0; m < 4; ++m)
#pragma unroll
              for (int n = 0; n < 4; ++n) acc[m][n] = (f32x4){0.f, 0.f, 0.f, 0.f};
          mma_lds_glob<4, 4, 4, true>(c.lds, PB_AOP + 128 * 2, PB_LA_LD, G2T, 128, 64 * wv, lane, acc);
#pragma unroll
          for (int m = 0; m < 4; ++m)
#pragma unroll
              for (int n = 0; n < 4; ++n) { const int col = 64 * wv + 16 * n + 4 * fq; u32x2 w; w.x = pk2(acc[m][n][0], acc[m][n][1]); w.y = pk2(acc[m][n][2], acc[m][n][3]);
                  *(LAS3 u32x2*)(L + PB_BUF + ((16 * m + fr) * PB_LD + col) * 2) = w; } }
        __syncthreads();
#pragma unroll 4
        for (int p = 0; p < 8; ++p) { const int col = p * 64 + sub * 8; *(u32x4*)(G + (size_t)t * W + col) = *(const LAS3 u32x4*)(L + PB_BUF + (row * PB_LD + col) * 2); }
        __syncthreads();
    }
}

constexpr int SG_LD = 136;
constexpr int SG_VT = 0, SG_ST = 256 * SG_LD * 2;
__device__ __forceinline__ void phase_sg_fast(ArgsR a, const Ctx& c, int l) {
    const bf16* ZS = (const bf16*)(a.ws + WS_ZS); bf16* YB = (bf16*)(a.ws + WS_YB);
    const float* lng = a.in[I_SGG] + l * W; const float* lnb = a.in[I_SGB] + l * W;
    LAS3 unsigned char* L = (LAS3 unsigned char*)c.lds;
    LAS3 float* st = (LAS3 float*)(L + SG_ST);
    const int tid = c.tid, lane = c.lane, wv = c.wave, fr = lane & 15, fq = lane >> 4;
    for (int u = blockIdx.x; u < 256; u += gridDim.x) {
        const int ch = u >> 1, hf = u & 1, tok0 = ch * 128;
        { u32x4 raw[16];
#pragma unroll
          for (int i = 0; i < 16; ++i) raw[i] = *(const u32x4*)(ZS + (size_t)(tok0 + wv * 16 + i) * 1024 + 512 + lane * 8);
#pragma unroll
          for (int i = 0; i < 16; ++i) { const int sidx = wv * 16 + i; float x[8];
#pragma unroll
              for (int e = 0; e < 4; ++e) { x[2 * e] = __uint_as_float(raw[i][e] << 16); x[2 * e + 1] = __uint_as_float(raw[i][e] & 0xffff0000u); }
              const float sm = ((x[0] + x[1]) + (x[2] + x[3])) + ((x[4] + x[5]) + (x[6] + x[7])); const float mean = wave_sum(sm) * (1.f / 512.f);
              float q = 0.f;
#pragma unroll
              for (int e = 0; e < 8; ++e) { const float d0 = x[e] - mean; q += d0 * d0; }
              const float rstd = __builtin_amdgcn_rsqf(wave_sum(q) * (1.f / 512.f) + LN_EPS);
              if (lane == 0) { st[2 * sidx] = mean; st[2 * sidx + 1] = rstd; } } }
        __syncthreads();
        { const int sidx = tid >> 2, q4 = tid & 3; const float mean = st[2 * sidx], rstd = st[2 * sidx + 1];
#pragma unroll
          for (int p = 0; p < 8; ++p) { const int cl = q4 * 64 + p * 8; const int cg = hf * 256 + cl;
              const bf16* src = ZS + (size_t)(tok0 + sidx) * 1024 + 512 + cg; const f32x4 x0 = load4bf(src), x1 = load4bf(src + 4);
              const f32x4 g0 = *(const f32x4*)(lng + cg), g1 = *(const f32x4*)(lng + cg + 4), b0 = *(const f32x4*)(lnb + cg), b1 = *(const f32x4*)(lnb + cg + 4);
#pragma unroll
              for (int e = 0; e < 8; ++e) { const float x = e < 4 ? x0[e & 3] : x1[e & 3], gg = e < 4 ? g0[e & 3] : g1[e & 3], bb = e < 4 ? b0[e & 3] : b1[e & 3];
                  *(LAS3 bf16*)(L + SG_VT + ((cl + e) * SG_LD + sidx) * 2) = f2bf((x - mean) * rstd * gg + bb); } } }
        __syncthreads();
        const int gl = wv >> 1, dh = wv & 1, g = hf * 4 + gl;
        const float* Wg = a.in[I_WS] + (size_t)(l * 8 + g) * 128 * 128; const float* bs = a.in[I_BS] + (size_t)(l * 8 + g) * 128;
        f32x4 acc[8][2];
#pragma unroll
        for (int m = 0; m < 8; ++m) { acc[m][0] = (f32x4){0.f, 0.f, 0.f, 0.f}; acc[m][1] = (f32x4){0.f, 0.f, 0.f, 0.f}; }
#pragma unroll
        for (int ks = 0; ks < 4; ++ks) {
            bf16x8 b[2];
#pragma unroll
            for (int n = 0; n < 2; ++n) b[n] = *(const LAS3 bf16x8*)(L + SG_VT + ((gl * 64 + dh * 32 + 16 * n + fr) * SG_LD + 32 * ks + 8 * fq) * 2);
#pragma unroll
            for (int m = 0; m < 8; ++m) { if (32 * ks <= 16 * m + 15) {
                const int trow = 16 * m + fr, s0 = 32 * ks + 8 * fq;
                const f32x4 w0v = *(const f32x4*)(Wg + trow * 128 + s0), w1v = *(const f32x4*)(Wg + trow * 128 + s0 + 4);
                float wf[8];
#pragma unroll
                for (int e = 0; e < 8; ++e) { const float wval = e < 4 ? w0v[e & 3] : w1v[e & 3]; wf[e] = (s0 + e <= trow) ? wval : 0.f; }
                const u32x4 wp = pack8bf(wf); const bf16x8 av = __builtin_bit_cast(bf16x8, wp);
                acc[m][0] = __builtin_amdgcn_mfma_f32_16x16x32_bf16(b[0], av, acc[m][0], 0, 0, 0);
                acc[m][1] = __builtin_amdgcn_mfma_f32_16x16x32_bf16(b[1], av, acc[m][1], 0, 0, 0); } }
        }
#pragma unroll
        for (int m = 0; m < 8; ++m) { const int trow = 16 * m + fr; const float bsv = bs[trow];
#pragma unroll
            for (int n = 0; n < 2; ++n) { const int col = g * 64 + dh * 32 + 16 * n + 4 * fq; const f32x4 uu = load4bf(ZS + (size_t)(tok0 + trow) * 1024 + col);
                store4bf(YB + (size_t)(tok0 + trow) * W + col, uu * (acc[m][n] + bsv)); } }
        __syncthreads();
    }
}

__device__ __forceinline__ void phase_scan_simple(ArgsR a, const Ctx& c) {
    if (c.wave != 0 || blockIdx.x >= NH) return;
    const int h = blockIdx.x, lane = c.lane;
    const f16* R = (const f16*)(a.ws + WS_R); const f16* WM1 = (const f16*)(a.ws + WS_WM1); const f16* KP = (const f16*)(a.ws + WS_KP);
    const f16* AA = (const f16*)(a.ws + WS_AA); const f16* BB = (const f16*)(a.ws + WS_BB); const f16* V = (const f16*)(a.ws + WS_V);
    bf16* YSC = (bf16*)(a.ws + WS_YSC);
    float S[64];
#pragma unroll
    for (int j = 0; j < 64; ++j) S[j] = 0.f;
    for (int t = 0; t < T; ++t) {
        const size_t base = (size_t)t * W + h * 64;
        const float vv = (float)V[base + lane];
        float sa = 0.f;
#pragma unroll
        for (int j = 0; j < 64; ++j) sa += S[j] * (float)AA[base + j];
        float y = 0.f;
#pragma unroll
        for (int j = 0; j < 64; ++j) { float s = S[j]; s = s + s * (float)WM1[base + j]; s += sa * (float)BB[base + j]; s += vv * (float)KP[base + j]; S[j] = s; y += s * (float)R[base + j]; }
        YSC[base + lane] = f2bf(y);
    }
}

typedef unsigned u32x16 __attribute__((ext_vector_type(16)));
__device__ __forceinline__ void sload32(const void* p0, u32x16& a0, u32x16& a1) {
    asm volatile("s_load_dwordx16 %0, %2, 0x0 glc\n\ts_load_dwordx16 %1, %2, 0x40 glc\n\ts_waitcnt lgkmcnt(0)" : "=&s"(a0), "=&s"(a1) : "s"(p0) : "memory");
}
__device__ __forceinline__ void sload64(const void* p0, const void* p1, u32x16& a0, u32x16& a1, u32x16& b0, u32x16& b1) {
    asm volatile("s_load_dwordx16 %0, %4, 0x0 glc\n\ts_load_dwordx16 %1, %4, 0x40 glc\n\ts_load_dwordx16 %2, %5, 0x0 glc\n\ts_load_dwordx16 %3, %5, 0x40 glc\n\ts_waitcnt lgkmcnt(0)"
                 : "=&s"(a0), "=&s"(a1), "=&s"(b0), "=&s"(b1) : "s"(p0), "s"(p1) : "memory");
}
__device__ __forceinline__ float fmix_lo(unsigned sd, float x, float y) { float d; asm("v_fma_mix_f32 %0, %1, %2, %3 op_sel_hi:[1,0,0]" : "=v"(d) : "s"(sd), "v"(x), "v"(y)); return d; }
__device__ __forceinline__ float fmix_hi(unsigned sd, float x, float y) { float d; asm("v_fma_mix_f32 %0, %1, %2, %3 op_sel:[1,0,0] op_sel_hi:[1,0,0]" : "=v"(d) : "s"(sd), "v"(x), "v"(y)); return d; }
constexpr int CL = 64, NCH = T / CL;
constexpr size_t ST_Q_OFF = (size_t)NH * NCH * 64 * 64;
constexpr size_t ST_S_OFF = (size_t)NH * NCH * 64 * 64;

__device__ __forceinline__ float vmix_lo(unsigned vd, float x, float y) { float d; asm("v_fma_mix_f32 %0, %1, %2, %3 op_sel_hi:[1,0,0]" : "=v"(d) : "v"(vd), "v"(x), "v"(y)); return d; }
__device__ __forceinline__ float vmix_hi(unsigned vd, float x, float y) { float d; asm("v_fma_mix_f32 %0, %1, %2, %3 op_sel:[1,0,0] op_sel_hi:[1,0,0]" : "=v"(d) : "v"(vd), "v"(x), "v"(y)); return d; }
template <int N> __device__ __forceinline__ void fmac_bc(float& acc, float vec, float x) { asm("v_fmac_f32_dpp %0, %1, %2 row_newbcast:%3 row_mask:0xf bank_mask:0xf" : "+v"(acc) : "v"(vec), "v"(x), "n"(N)); }
template <int N> __device__ __forceinline__ float mul_bc(float vec, float x) { float d; asm("v_mul_f32_dpp %0, %1, %2 row_newbcast:%3 row_mask:0xf bank_mask:0xf" : "=v"(d) : "v"(vec), "v"(x), "n"(N)); return d; }
struct SVec { float v[4]; };
__device__ __forceinline__ f16x4 sv_read(const LAS3 unsigned char* p, int lane) { return *(const LAS3 f16x4*)(p + (lane & 15) * 8); }
__device__ __forceinline__ void sv_cvt(SVec& o, f16x4 h) { o.v[0] = (float)h[0]; o.v[1] = (float)h[1]; o.v[2] = (float)h[2]; o.v[3] = (float)h[3]; }
__device__ __forceinline__ void sv_cvt1p(SVec& o, f16x4 h) { o.v[0] = 1.0f + (float)h[0]; o.v[1] = 1.0f + (float)h[1]; o.v[2] = 1.0f + (float)h[2]; o.v[3] = 1.0f + (float)h[3]; }
template <int J> __device__ __forceinline__ void sc_dot(float (&d)[4], const SVec& A, const float (&X)[64]) { fmac_bc<(J >> 2)>(d[J & 3], A.v[J & 3], X[J]); if constexpr (J + 1 < 64) sc_dot<J + 1>(d, A, X); }
template <int J> __device__ __forceinline__ void sc_upd3(float (&S)[64], float (&y)[4], const SVec& Wv, const SVec& Bv, const SVec& Kv, const SVec& Rv, float sa, float vv) {
    float sj = mul_bc<(J >> 2)>(Wv.v[J & 3], S[J]); fmac_bc<(J >> 2)>(sj, Bv.v[J & 3], sa); fmac_bc<(J >> 2)>(sj, Kv.v[J & 3], vv); S[J] = sj; fmac_bc<(J >> 2)>(y[J & 3], Rv.v[J & 3], sj);
    if constexpr (J + 1 < 64) sc_upd3<J + 1>(S, y, Wv, Bv, Kv, Rv, sa, vv); }
template <int J> __device__ __forceinline__ void sc_upd1(float (&Q)[64], float (&P)[64], const SVec& Wv, const SVec& Bv, const SVec& Kv, float saq, float sap, float vv) {
    float qj = mul_bc<(J >> 2)>(Wv.v[J & 3], Q[J]); fmac_bc<(J >> 2)>(qj, Bv.v[J & 3], saq); fmac_bc<(J >> 2)>(qj, Kv.v[J & 3], vv); Q[J] = qj;
    float pj = mul_bc<(J >> 2)>(Wv.v[J & 3], P[J]); fmac_bc<(J >> 2)>(pj, Bv.v[J & 3], sap); P[J] = pj;
    if constexpr (J + 1 < 64) sc_upd1<J + 1>(Q, P, Wv, Bv, Kv, saq, sap, vv); }
constexpr int SCB = 8;
constexpr int SC_NS = 7, SC_BUF = SC_NS * 1024, SC_WAVE = 2 * SC_BUF;
__device__ __forceinline__ void sc_dma(const f16* X, size_t eoff, LAS3 unsigned char* dst) {
    __builtin_amdgcn_global_load_lds((const unsigned*)(X + eoff), (LAS3 unsigned*)dst, 16, 0, 0);
}

__device__ __forceinline__ void phase_scan1(ArgsR a, const Ctx& c) {
    const f16* WM1 = (const f16*)(a.ws + WS_WM1); const f16* KP = (const f16*)(a.ws + WS_KP);
    const f16* AA = (const f16*)(a.ws + WS_AA); const f16* BB = (const f16*)(a.ws + WS_BB); const f16* V = (const f16*)(a.ws + WS_V);
    float* ST = (float*)(a.ws + WS_ST);
    const int lane = c.lane;
    LAS3 unsigned char* ring = (LAS3 unsigned char*)c.lds + c.wave * SC_WAVE;
    for (int item = c.gw; item < NH * NCH; item += c.ngw) {
        const int h = __builtin_amdgcn_readfirstlane(item / NCH), ch = __builtin_amdgcn_readfirstlane(item % NCH);
        float Q[64], P[64];
        int ln_ = lane; asm volatile("" : "+v"(ln_));
#pragma unroll
        for (int j = 0; j < 64; ++j) { Q[j] = 0.f; P[j] = (j == ln_) ? 1.f : 0.f; }
        const size_t lane_off = (size_t)(lane >> 3) * W + h * 64 + (lane & 7) * 8;
        { const size_t e0 = (size_t)(ch * CL) * W + lane_off;
          sc_dma(AA, e0, ring); sc_dma(WM1, e0, ring + 1024); sc_dma(BB, e0, ring + 2048); sc_dma(KP, e0, ring + 3072); sc_dma(V, e0, ring + 4096); }
#pragma unroll 1
        for (int blk = 0; blk < CL / SCB; ++blk) {
            LAS3 unsigned char* buf = ring + (blk & 1) * SC_BUF;
            if (blk + 1 < CL / SCB) { LAS3 unsigned char* nb = ring + ((blk + 1) & 1) * SC_BUF; const size_t e0 = (size_t)(ch * CL + (blk + 1) * SCB) * W + lane_off;
                sc_dma(AA, e0, nb); sc_dma(WM1, e0, nb + 1024); sc_dma(BB, e0, nb + 2048); sc_dma(KP, e0, nb + 3072); sc_dma(V, e0, nb + 4096);
                asm volatile("s_waitcnt vmcnt(5)" ::: "memory"); }
            else asm volatile("s_waitcnt vmcnt(0)" ::: "memory");
            SVec A, Wv, Bv, Kv;
            sv_cvt(A, sv_read(buf, lane)); sv_cvt1p(Wv, sv_read(buf + 1024, lane)); sv_cvt(Bv, sv_read(buf + 2048, lane)); sv_cvt(Kv, sv_read(buf + 3072, lane));
            float vv = (float)*(const LAS3 f16*)(buf + 4096 + lane * 2);
#pragma unroll 1
            for (int st = 0; st < SCB; ++st) {
                const LAS3 unsigned char* sn = buf + ((st + 1 < SCB) ? st + 1 : st) * 128;
                const f16x4 ha = sv_read(sn, lane), hw = sv_read(sn + 1024, lane), hb = sv_read(sn + 2048, lane), hk = sv_read(sn + 3072, lane);
                const f16 hv = *(const LAS3 f16*)(sn + 4096 + lane * 2);
                float dq[4] = {0.f, 0.f, 0.f, 0.f}, dp[4] = {0.f, 0.f, 0.f, 0.f};
                sc_dot<0>(dq, A, Q); sc_dot<0>(dp, A, P);
                const float saq = (dq[0] + dq[1]) + (dq[2] + dq[3]), sap = (dp[0] + dp[1]) + (dp[2] + dp[3]);
                sc_upd1<0>(Q, P, Wv, Bv, Kv, saq, sap, vv);
                sv_cvt(A, ha); sv_cvt1p(Wv, hw); sv_cvt(Bv, hb); sv_cvt(Kv, hk); vv = (float)hv;
            }
        }
        float* Qp = ST + ST_Q_OFF + (size_t)(h * NCH + ch) * 4096 + lane;
        bf16* PTp = (bf16*)ST + (size_t)(h * NCH + ch) * 4096 + lane;
#pragma unroll
        for (int j = 0; j < 64; ++j) { PTp[j * 64] = f2bf(P[j]); Qp[j * 64] = Q[j]; }
    }
}
constexpr int GS = 16, NG = NCH / GS;
constexpr size_t ST_LP_OFF = (size_t)NH * NCH * 4096;
constexpr size_t WS_SG = WS_LORA + 2 * MiB;
constexpr int HI_LD = 72, HI_BYTES = 64 * HI_LD * 2;
struct HFrag { bf16x8 b[2][2]; f32x4 q[2]; };
__device__ __forceinline__ void hload(HFrag& f, const bf16* Bt, const float* QTc, int boff, int qtoff) {
#pragma unroll
    for (int ks = 0; ks < 2; ++ks)
#pragma unroll
        for (int n = 0; n < 2; ++n) f.b[ks][n] = *(const bf16x8*)(Bt + boff + 16 * n * 64 + 32 * ks);
#pragma unroll
    for (int n = 0; n < 2; ++n) f.q[n] = *(const f32x4*)(QTc + qtoff + 16 * n * 64);
}
__device__ __forceinline__ void hmma(const LAS3 unsigned char* img, const bf16x8 (&b)[2][2], f32x4 (&acc)[2], int m, int fr, int fq) {
#pragma unroll
    for (int ks = 0; ks < 2; ++ks) { const bf16x8 av = *(const LAS3 bf16x8*)(img + ((16 * m + fr) * HI_LD + 32 * ks + 8 * fq) * 2);
#pragma unroll
        for (int n = 0; n < 2; ++n) acc[n] = __builtin_amdgcn_mfma_f32_16x16x32_bf16(av, b[ks][n], acc[n], 0, 0, 0); }
}
__device__ __forceinline__ void himg_store(LAS3 unsigned char* img, const f32x4 (&acc)[2], int m, int n0, int fr, int fq) {
#pragma unroll
    for (int n = 0; n < 2; ++n)
#pragma unroll
        for (int i = 0; i < 4; ++i) *(LAS3 bf16*)(img + ((16 * m + 4 * fq + i) * HI_LD + n0 + 16 * n + fr) * 2) = f2bf(acc[n][i]);
}
#define HBAR() do { asm volatile("s_waitcnt lgkmcnt(0)" ::: "memory"); __builtin_amdgcn_s_barrier(); asm volatile("" ::: "memory"); } while (0)

__device__ __forceinline__ void sc2a_step(const HFrag& f, bf16* LpTc, float* QTc, const LAS3 unsigned char* ip, LAS3 unsigned char* ipn, const LAS3 unsigned char* iq, LAS3 unsigned char* iqn, int m, int n0, int fr, int fq, int qtoff) {
    f32x4 ap[2], aq[2];
#pragma unroll
    for (int n = 0; n < 2; ++n) { ap[n] = (f32x4){0.f, 0.f, 0.f, 0.f}; aq[n] = f.q[n]; }
    hmma(ip, f.b, ap, m, fr, fq); hmma(iq, f.b, aq, m, fr, fq);
#pragma unroll
    for (int n = 0; n < 2; ++n) { u32x2 w; w.x = pk2(ap[n][0], ap[n][1]); w.y = pk2(ap[n][2], ap[n][3]);
        *(u32x2*)(LpTc + (n0 + 16 * n + fr) * 64 + 16 * m + 4 * fq) = w;
        *(f32x4*)(QTc + qtoff + 16 * n * 64) = aq[n]; }
    himg_store(ipn, ap, m, n0, fr, fq); himg_store(iqn, aq, m, n0, fr, fq);
    HBAR();
}
__device__ __forceinline__ void phase_scan2a(ArgsR a, const Ctx& c) {
    const int lane = c.lane, wv = c.wave, fr = lane & 15, fq = lane >> 4, m = wv >> 1, n0 = 32 * (wv & 1);
    const int boff = (n0 + fr) * 64 + 8 * fq, qtoff = (n0 + fr) * 64 + 16 * m + 4 * fq;
    LAS3 unsigned char* L = (LAS3 unsigned char*)c.lds;
    for (int item = blockIdx.x; item < NH * NG; item += gridDim.x) {
        const size_t cb = (size_t)(item / NG) * NCH + (size_t)(item % NG) * GS;
        const bf16* PT = (const bf16*)(a.ws + WS_ST) + cb * 4096; bf16* LP = (bf16*)(a.ws + WS_ST) + ST_LP_OFF + cb * 4096; float* QT = (float*)(a.ws + WS_ST) + ST_Q_OFF + cb * 4096;
        for (int i = c.tid; i < 4 * HI_BYTES / 4; i += NTHREADS) ((LAS3 unsigned*)L)[i] = 0u;
        __syncthreads();
        if (c.tid < 64) *(LAS3 bf16*)(L + (c.tid * HI_LD + c.tid) * 2) = (bf16)0x3F80;
        __syncthreads();
        HFrag f0, f1, f2, f3;
        hload(f0, PT, QT, boff, qtoff); hload(f1, PT + 4096, QT + 4096, boff, qtoff); hload(f2, PT + 2 * 4096, QT + 2 * 4096, boff, qtoff); hload(f3, PT + 3 * 4096, QT + 3 * 4096, boff, qtoff);
        LAS3 unsigned char* p0 = L; LAS3 unsigned char* p1 = L + HI_BYTES; LAS3 unsigned char* q0 = L + 2 * HI_BYTES; LAS3 unsigned char* q1 = L + 3 * HI_BYTES;
#pragma unroll 1
        for (int i = 0; i < GS; i += 4) {
            const int nx = (i + 4 < GS) ? i + 4 : i;
            sc2a_step(f0, LP + (size_t)(i + 0) * 4096, QT + (size_t)(i + 0) * 4096, p0, p1, q0, q1, m, n0, fr, fq, qtoff); hload(f0, PT + (size_t)(nx + 0) * 4096, QT + (size_t)(nx + 0) * 4096, boff, qtoff);
            sc2a_step(f1, LP + (size_t)(i + 1) * 4096, QT + (size_t)(i + 1) * 4096, p1, p0, q1, q0, m, n0, fr, fq, qtoff); hload(f1, PT + (size_t)(nx + 1) * 4096, QT + (size_t)(nx + 1) * 4096, boff, qtoff);
            sc2a_step(f2, LP + (size_t)(i + 2) * 4096, QT + (size_t)(i + 2) * 4096, p0, p1, q0, q1, m, n0, fr, fq, qtoff); hload(f2, PT + (size_t)(nx + 2) * 4096, QT + (size_t)(nx + 2) * 4096, boff, qtoff);
            sc2a_step(f3, LP + (size_t)(i + 3) * 4096, QT + (size_t)(i + 3) * 4096, p1, p0, q1, q0, m, n0, fr, fq, qtoff); hload(f3, PT + (size_t)(nx + 3) * 4096, QT + (size_t)(nx + 3) * 4096, boff, qtoff);
        }
        __syncthreads();
    }
}
__device__ __forceinline__ void phase_scan2b(ArgsR a, const Ctx& c) {
    if (blockIdx.x >= NH) return;
    const int h = blockIdx.x, lane = c.lane, wv = c.wave, fr = lane & 15, fq = lane >> 4, m = wv >> 1, n0 = 32 * (wv & 1);
    const int boff = (n0 + fr) * 64 + 8 * fq, qtoff = (n0 + fr) * 64 + 16 * m + 4 * fq;
    LAS3 unsigned char* L = (LAS3 unsigned char*)c.lds;
    const bf16* LP = (const bf16*)(a.ws + WS_ST) + ST_LP_OFF + (size_t)h * NCH * 4096; const float* QT = (const float*)(a.ws + WS_ST) + ST_Q_OFF + (size_t)h * NCH * 4096;
    bf16* SG = (bf16*)(a.ws + WS_SG) + (size_t)h * NG * 4096;
    for (int i = c.tid; i < 2 * HI_BYTES / 4; i += NTHREADS) ((LAS3 unsigned*)L)[i] = 0u;
    for (int i = c.tid; i < 4096 / 2; i += NTHREADS) ((LAS3 unsigned*)(L + 2 * HI_BYTES))[i] = 0u;
    __syncthreads();
    HFrag f0, f1, f2, f3;
#define SC2B_CH(g) ((size_t)((g) * GS + GS - 1) * 4096)
    hload(f0, LP + SC2B_CH(0), QT + SC2B_CH(0), boff, qtoff); hload(f1, LP + SC2B_CH(1), QT + SC2B_CH(1), boff, qtoff); hload(f2, LP + SC2B_CH(2), QT + SC2B_CH(2), boff, qtoff); hload(f3, LP + SC2B_CH(3), QT + SC2B_CH(3), boff, qtoff);
    LAS3 unsigned char* i0 = L; LAS3 unsigned char* i1 = L + HI_BYTES;
#define SC2B_STEP(f, g, ic, in) do { f32x4 acc[2] = {f.q[0], f.q[1]}; hmma(ic, f.b, acc, m, fr, fq); LAS3 bf16* So = (LAS3 bf16*)(L + 2 * HI_BYTES) + (((g) + 1) & 7) * 4096; \
        _Pragma("unroll") for (int n = 0; n < 2; ++n) _Pragma("unroll") for (int i = 0; i < 4; ++i) So[(16 * m + 4 * fq + i) * 64 + n0 + 16 * n + fr] = f2bf(acc[n][i]); \
        himg_store(in, acc, m, n0, fr, fq); HBAR(); } while (0)
#pragma unroll 1
    for (int g = 0; g < NG; g += 4) {
        const int nx = (g + 4 < NG) ? g + 4 : g;
        SC2B_STEP(f0, g + 0, i0, i1); hload(f0, LP + SC2B_CH(nx + 0), QT + SC2B_CH(nx + 0), boff, qtoff);
        SC2B_STEP(f1, g + 1, i1, i0); hload(f1, LP + SC2B_CH(nx + 1), QT + SC2B_CH(nx + 1), boff, qtoff);
        SC2B_STEP(f2, g + 2, i0, i1); hload(f2, LP + SC2B_CH(nx + 2), QT + SC2B_CH(nx + 2), boff, qtoff);
        if ((g & 7) == 4) {
            for (int i = c.tid; i < 8 * 4096 / 8; i += NTHREADS) ((u32x4*)(SG + (size_t)(g >> 3) * 8 * 4096))[i] = ((const LAS3 u32x4*)(L + 2 * HI_BYTES))[i];
            HBAR(); }
        if (g + 3 < NG - 1) SC2B_STEP(f3, g + 3, i1, i0);
        hload(f3, LP + SC2B_CH(nx + 3), QT + SC2B_CH(nx + 3), boff, qtoff);
    }
#undef SC2B_STEP
#undef SC2B_CH
}
__device__ __forceinline__ void phase_scan2c(ArgsR a, const Ctx& c) {
    const int lane = c.lane, wv = c.wave, fr = lane & 15, fq = lane >> 4, m = wv >> 1, n0 = 32 * (wv & 1);
    const int boff = (n0 + fr) * 64 + 8 * fq, qtoff = (n0 + fr) * 64 + 16 * m + 4 * fq;
    LAS3 unsigned char* L = (LAS3 unsigned char*)c.lds;
    for (int item = blockIdx.x; item < NH * NG * 2; item += gridDim.x) {
        const int hg = item >> 1, hf = item & 1;
        const size_t cb = (size_t)(hg / NG) * NCH + (size_t)(hg % NG) * GS + hf * 8;
        const bf16* LP = (const bf16*)(a.ws + WS_ST) + ST_LP_OFF + cb * 4096; const float* QT = (const float*)(a.ws + WS_ST) + ST_Q_OFF + cb * 4096; bf16* SS = (bf16*)(a.ws + WS_ST) + cb * 4096;
        { const u32x4 v = *(const u32x4*)((const bf16*)(a.ws + WS_SG) + (size_t)hg * 4096 + c.tid * 8); *(LAS3 u32x4*)(L + ((c.tid >> 3) * HI_LD + (c.tid & 7) * 8) * 2) = v; }
        __syncthreads();
#pragma unroll 2
        for (int i = 0; i < 8; ++i) { HFrag f; hload(f, LP + (size_t)i * 4096, QT + (size_t)i * 4096, boff, qtoff);
            f32x4 acc[2] = {f.q[0], f.q[1]}; hmma(L, f.b, acc, m, fr, fq); bf16* So = SS + (size_t)i * 4096;
#pragma unroll
            for (int n = 0; n < 2; ++n)
#pragma unroll
                for (int k = 0; k < 4; ++k) So[(16 * m + 4 * fq + k) * 64 + n0 + 16 * n + fr] = f2bf(acc[n][k]); }
        __syncthreads();
    }
}
constexpr int WI_LD = 72, WI_B = 64 * WI_LD * 2, WI_GAM = 9 * WI_B, WI_GL = 15 * WI_B;
constexpr size_t WS_GM0 = 352 * MiB, WS_GM1 = 212 * MiB, WS_Y0 = 336 * MiB, WS_END2 = 360 * MiB;
__device__ __forceinline__ bf16* gm_ptr(unsigned char* ws, int h, int ch) { return (bf16*)(ws + (h < 4 ? WS_GM0 : WS_GM1)) + (size_t)((h & 3) * NCH + ch) * 4096; }
__device__ __forceinline__ void wi_mma(f32x4 (&acc)[2], const LAS3 unsigned char* A, const LAS3 unsigned char* Bt, int m, int n0, int fr, int fq) {
#pragma unroll
    for (int ks = 0; ks < 2; ++ks) { const bf16x8 av = *(const LAS3 bf16x8*)(A + ((16 * m + fr) * WI_LD + 32 * ks + 8 * fq) * 2);
#pragma unroll
        for (int n = 0; n < 2; ++n) { const bf16x8 bv = *(const LAS3 bf16x8*)(Bt + ((n0 + 16 * n + fr) * WI_LD + 32 * ks + 8 * fq) * 2); acc[n] = __builtin_amdgcn_mfma_f32_16x16x32_bf16(av, bv, acc[n], 0, 0, 0); } }
}
struct WiA { bf16x8 a[2]; }; struct WiB { bf16x8 b[2][2]; };
__device__ __forceinline__ void wi_lda(WiA& f, const LAS3 unsigned char* A, int m, int fr, int fq) {
#pragma unroll
    for (int ks = 0; ks < 2; ++ks) f.a[ks] = *(const LAS3 bf16x8*)(A + ((16 * m + fr) * WI_LD + 32 * ks + 8 * fq) * 2);
}
__device__ __forceinline__ void wi_ldb(WiB& f, const LAS3 unsigned char* Bt, int n0, int fr, int fq) {
#pragma unroll
    for (int ks = 0; ks < 2; ++ks)
#pragma unroll
        for (int n = 0; n < 2; ++n) f.b[ks][n] = *(const LAS3 bf16x8*)(Bt + ((n0 + 16 * n + fr) * WI_LD + 32 * ks + 8 * fq) * 2);
}
__device__ __forceinline__ void wi_fma(f32x4 (&acc)[2], const WiA& A, const WiB& B) {
#pragma unroll
    for (int ks = 0; ks < 2; ++ks)
#pragma unroll
        for (int n = 0; n < 2; ++n) acc[n] = __builtin_amdgcn_mfma_f32_16x16x32_bf16(A.a[ks], B.b[ks][n], acc[n], 0, 0, 0);
}
__device__ __forceinline__ void wi_fma_s(f32x4 (&acc)[2], const WiA& A, const WiB& B) {
#pragma unroll
    for (int ks = 0; ks < 2; ++ks)
#pragma unroll
        for (int n = 0; n < 2; ++n) acc[n] = __builtin_amdgcn_mfma_f32_16x16x32_bf16(B.b[ks][n], A.a[ks], acc[n], 0, 0, 0);
}
__device__ __forceinline__ void wi_st_nat_s(LAS3 unsigned char* X, const f32x4 (&acc)[2], int m, int n0, int fr, int fq) {
#pragma unroll
    for (int n = 0; n < 2; ++n) { u32x2 w; w.x = pk2(acc[n][0], acc[n][1]); w.y = pk2(acc[n][2], acc[n][3]); *(LAS3 u32x2*)(X + ((16 * m + fr) * WI_LD + n0 + 16 * n + 4 * fq) * 2) = w; }
}
__device__ __forceinline__ void wi_ld_nat_s(f32x4 (&acc)[2], const LAS3 unsigned char* X, int m, int n0, int fr, int fq) {
#pragma unroll
    for (int n = 0; n < 2; ++n) { const u32x2 w = *(const LAS3 u32x2*)(X + ((16 * m + fr) * WI_LD + n0 + 16 * n + 4 * fq) * 2);
        acc[n][0] = __uint_as_float(w.x << 16); acc[n][1] = __uint_as_float(w.x & 0xffff0000u); acc[n][2] = __uint_as_float(w.y << 16); acc[n][3] = __uint_as_float(w.y & 0xffff0000u); }
}
__device__ __forceinline__ void wi_ld_tr(f32x4 (&acc)[2], const LAS3 unsigned char* XT, int m, int n0, int fr, int fq) {
#pragma unroll
    for (int n = 0; n < 2; ++n) { const u32x2 w = *(const LAS3 u32x2*)(XT + ((n0 + 16 * n + fr) * WI_LD + 16 * m + 4 * fq) * 2);
        acc[n][0] = __uint_as_float(w.x << 16); acc[n][1] = __uint_as_float(w.x & 0xffff0000u); acc[n][2] = __uint_as_float(w.y << 16); acc[n][3] = __uint_as_float(w.y & 0xffff0000u); }
}
#define WI_PIN() __builtin_amdgcn_sched_barrier(0)
__device__ __forceinline__ void wi_st_nat(LAS3 unsigned char* X, const f32x4 (&acc)[2], int m, int n0, int fr, int fq) {
#pragma unroll
    for (int n = 0; n < 2; ++n)
#pragma unroll
        for (int i = 0; i < 4; ++i) *(LAS3 bf16*)(X + ((16 * m + 4 * fq + i) * WI_LD + n0 + 16 * n + fr) * 2) = f2bf(acc[n][i]);
}
__device__ __forceinline__ void wi_st_tr(LAS3 unsigned char* XT, const f32x4 (&acc)[2], int m, int n0, int fr, int fq) {
#pragma unroll
    for (int n = 0; n < 2; ++n) { u32x2 w; w.x = pk2(acc[n][0], acc[n][1]); w.y = pk2(acc[n][2], acc[n][3]); *(LAS3 u32x2*)(XT + ((n0 + 16 * n + fr) * WI_LD + 16 * m + 4 * fq) * 2) = w; }
}
__device__ __forceinline__ void wi_ld_nat(f32x4 (&acc)[2], const LAS3 unsigned char* X, int m, int n0, int fr, int fq) {
#pragma unroll
    for (int n = 0; n < 2; ++n)
#pragma unroll
        for (int i = 0; i < 4; ++i) acc[n][i] = bf2f(*(const LAS3 bf16*)(X + ((16 * m + 4 * fq + i) * WI_LD + n0 + 16 * n + fr) * 2));
}
__device__ __forceinline__ void phase_scan1m(ArgsR a, const Ctx& c, const int skip = 0) {
    const f16* WM1 = (const f16*)(a.ws + WS_WM1); const f16* KP = (const f16*)(a.ws + WS_KP);
    const f16* AA = (const f16*)(a.ws + WS_AA); const f16* BB = (const f16*)(a.ws + WS_BB); const f16* V = (const f16*)(a.ws + WS_V); const f16* R = (const f16*)(a.ws + WS_R);
    float* ST = (float*)(a.ws + WS_ST);
    LAS3 unsigned char* L = (LAS3 unsigned char*)c.lds;
    LAS3 float* GAM = (LAS3 float*)(L + WI_GAM); LAS3 float* GL = (LAS3 float*)(L + WI_GL);
    const int lane = c.lane, wv = c.wave, fr = lane & 15, fq = lane >> 4, m = wv >> 1, n0 = 32 * (wv & 1), tid = c.tid;
#define SLOT(i) (L + (i) * WI_B)
    const int t = tid >> 3, cc = (tid & 7) * 8;
    f16x8 pav, pbv, pkv, pvv, prv, pwv;
#define WI_FETCH(it) do { const int h_ = (it) / NCH, ch_ = (it) % NCH; const size_t eo_ = (size_t)(ch_ * CL + t) * W + h_ * 64 + cc; \
        pav = *(const f16x8*)(AA + eo_); pbv = *(const f16x8*)(BB + eo_); pkv = *(const f16x8*)(KP + eo_); pvv = *(const f16x8*)(V + eo_); prv = *(const f16x8*)(R + eo_); pwv = *(const f16x8*)(WM1 + eo_); } while (0)
    if (blockIdx.x < NH * NCH) WI_FETCH(blockIdx.x);
    for (int item = blockIdx.x; item < NH * NCH; item += gridDim.x) {
        const int h = item / NCH, ch = item % NCH;
        const f16x8 av = pav, bv = pbv, kv = pkv, vv = pvv, rv = prv, wv8 = pwv;
        if (item + (int)gridDim.x < NH * NCH) WI_FETCH(item + (int)gridDim.x);
        float g[8], gp[8];
        { float wloc[8];
#pragma unroll
          for (int e = 0; e < 8; ++e) wloc[e] = 1.0f + (float)wv8[e];
#pragma unroll
          for (int e = 0; e < 8; ++e) { float x = wloc[e];
              { const float y = __shfl_up(x, 8); if (lane >= 8) x *= y; } { const float y = __shfl_up(x, 16); if (lane >= 16) x *= y; } { const float y = __shfl_up(x, 32); if (lane >= 32) x *= y; }
              g[e] = x; }
          if (lane >= 56) {
#pragma unroll
              for (int e = 0; e < 8; ++e) GAM[wv * 64 + cc + e] = g[e]; }
          HBAR();
#pragma unroll
          for (int e = 0; e < 8; ++e) { float pre = 1.0f;
#pragma unroll
              for (int w = 0; w < 7; ++w) if (w < wv) pre *= GAM[w * 64 + cc + e];
              g[e] *= pre; gp[e] = g[e] * __builtin_amdgcn_rcpf(wloc[e]); } }
        { float fa[8], fb[8], fk[8], fv[8], frr[8];
#pragma unroll
          for (int e = 0; e < 8; ++e) { const float ig = __builtin_amdgcn_rcpf(g[e]);
              fa[e] = (float)av[e] * gp[e]; fb[e] = (float)bv[e] * ig; fk[e] = (float)kv[e] * ig; fv[e] = (float)vv[e]; frr[e] = (float)rv[e] * g[e]; if (t == 63) GL[cc + e] = g[e]; }
          *(LAS3 u32x4*)(SLOT(0) + (t * WI_LD + cc) * 2) = pack8bf(fa); *(LAS3 u32x4*)(SLOT(2) + (t * WI_LD + cc) * 2) = pack8bf(fb); *(LAS3 u32x4*)(SLOT(4) + (t * WI_LD + cc) * 2) = pack8bf(fk); *(LAS3 u32x4*)(SLOT(12) + (t * WI_LD + cc) * 2) = pack8bf(frr);
          *(LAS3 u32x4*)(SLOT(10) + (t * WI_LD + cc) * 2) = pack8bf(fv); }
        HBAR();
        { WiA aB, aK; WiB bA, bR; wi_lda(aB, SLOT(2), m, fr, fq); wi_lda(aK, SLOT(4), m, fr, fq); wi_ldb(bA, SLOT(0), n0, fr, fq); wi_ldb(bR, SLOT(12), n0, fr, fq);
          const int tch = tid & 63, tt0 = (tid >> 6) * 8; bf16 ta[8], tb[8], tv[8];
#pragma unroll
          for (int e = 0; e < 8; ++e) { ta[e] = *(const LAS3 bf16*)(SLOT(0) + ((tt0 + e) * WI_LD + tch) * 2); tb[e] = *(const LAS3 bf16*)(SLOT(2) + ((tt0 + e) * WI_LD + tch) * 2); tv[e] = *(const LAS3 bf16*)(SLOT(10) + ((tt0 + e) * WI_LD + tch) * 2); }
          WI_PIN();
          { u32x4 wa, wb, wv4;
#pragma unroll
            for (int e = 0; e < 4; ++e) { wa[e] = (unsigned)ta[2 * e] | ((unsigned)ta[2 * e + 1] << 16); wb[e] = (unsigned)tb[2 * e] | ((unsigned)tb[2 * e + 1] << 16); wv4[e] = (unsigned)tv[2 * e] | ((unsigned)tv[2 * e + 1] << 16); }
            *(LAS3 u32x4*)(SLOT(1) + (tch * WI_LD + tt0) * 2) = wa; *(LAS3 u32x4*)(SLOT(3) + (tch * WI_LD + tt0) * 2) = wb; *(LAS3 u32x4*)(SLOT(5) + (tch * WI_LD + tt0) * 2) = wv4; }
          f32x4 ans[2] = {{0.f, 0.f, 0.f, 0.f}, {0.f, 0.f, 0.f, 0.f}}, ant[2] = {{0.f, 0.f, 0.f, 0.f}, {0.f, 0.f, 0.f, 0.f}}, aks[2] = {{0.f, 0.f, 0.f, 0.f}, {0.f, 0.f, 0.f, 0.f}}, am[2] = {{0.f, 0.f, 0.f, 0.f}, {0.f, 0.f, 0.f, 0.f}}, amk[2] = {{0.f, 0.f, 0.f, 0.f}, {0.f, 0.f, 0.f, 0.f}};
          wi_fma_s(ans, aB, bA); wi_fma(ant, aB, bA); wi_fma_s(aks, aK, bA); wi_fma(am, aB, bR); wi_fma(amk, aK, bR);
          WI_PIN();
          f32x4 axs[2];
#pragma unroll
          for (int n = 0; n < 2; ++n)
#pragma unroll
              for (int i = 0; i < 4; ++i) { const int rs = 16 * m + fr, cs = n0 + 16 * n + 4 * fq + i;
                  if (!(rs < cs)) { ans[n][i] = 0.f; aks[n][i] = 0.f; } axs[n][i] = ans[n][i] + (rs == cs ? 1.0f : 0.f);
                  const int rn = 16 * m + 4 * fq + i, cn = n0 + 16 * n + fr;
                  if (!(rn < cn)) ant[n][i] = 0.f; if (rn > cn) { am[n][i] = 0.f; amk[n][i] = 0.f; } }
          wi_st_nat_s(SLOT(7), ans, m, n0, fr, fq); wi_st_tr(SLOT(8), ant, m, n0, fr, fq); wi_st_nat_s(SLOT(6), aks, m, n0, fr, fq); wi_st_nat_s(SLOT(11), axs, m, n0, fr, fq);
          wi_st_tr(SLOT(13), am, m, n0, fr, fq); wi_st_tr(SLOT(14), amk, m, n0, fr, fq); }
        HBAR();
        { WiA aN; WiB bN; wi_lda(aN, SLOT(7), m, fr, fq); wi_ldb(bN, SLOT(8), n0, fr, fq); WI_PIN();
          f32x4 a2s[2] = {{0.f, 0.f, 0.f, 0.f}, {0.f, 0.f, 0.f, 0.f}}, a2t[2] = {{0.f, 0.f, 0.f, 0.f}, {0.f, 0.f, 0.f, 0.f}}; wi_fma_s(a2s, aN, bN); wi_fma(a2t, aN, bN); WI_PIN();
          wi_st_nat_s(SLOT(9), a2s, m, n0, fr, fq); wi_st_tr(SLOT(10), a2t, m, n0, fr, fq); }
        HBAR();
#define WI_LEVEL(XS, XD, NS, NST, ND, NDT) do { WiA aX, aN; WiB bN; f32x4 ax[2]; wi_lda(aX, SLOT(XS), m, fr, fq); wi_ldb(bN, SLOT(NST), n0, fr, fq); wi_lda(aN, SLOT(NS), m, fr, fq); wi_ld_nat_s(ax, SLOT(XS), m, n0, fr, fq); \
            WI_PIN(); f32x4 aqs[2] = {{0.f, 0.f, 0.f, 0.f}, {0.f, 0.f, 0.f, 0.f}}, aqt[2] = {{0.f, 0.f, 0.f, 0.f}, {0.f, 0.f, 0.f, 0.f}}; wi_fma_s(ax, aX, bN); wi_fma_s(aqs, aN, bN); wi_fma(aqt, aN, bN); WI_PIN(); \
            wi_st_nat_s(SLOT(XD), ax, m, n0, fr, fq); wi_st_nat_s(SLOT(ND), aqs, m, n0, fr, fq); wi_st_tr(SLOT(NDT), aqt, m, n0, fr, fq); \
            HBAR(); } while (0)
        WI_LEVEL(11, 0, 9, 10, 7, 8);
        WI_LEVEL(0, 11, 7, 8, 9, 10);
        WI_LEVEL(11, 0, 9, 10, 7, 8);
        WI_LEVEL(0, 11, 7, 8, 9, 10);
#undef WI_LEVEL
        { WiA aX; WiB bN; f32x4 ax[2]; wi_lda(aX, SLOT(11), m, fr, fq); wi_ldb(bN, SLOT(10), n0, fr, fq); wi_ld_nat(ax, SLOT(11), m, n0, fr, fq); WI_PIN();
          wi_fma(ax, aX, bN); WI_PIN(); wi_st_tr(SLOT(0), ax, m, n0, fr, fq); }
        HBAR();
        { WiA aNk, aAt; WiB bT; wi_lda(aNk, SLOT(6), m, fr, fq); wi_lda(aAt, SLOT(1), m, fr, fq); wi_ldb(bT, SLOT(0), n0, fr, fq); WI_PIN();
          f32x4 aw[2] = {{0.f, 0.f, 0.f, 0.f}, {0.f, 0.f, 0.f, 0.f}}, aa[2] = {{0.f, 0.f, 0.f, 0.f}, {0.f, 0.f, 0.f, 0.f}}; wi_fma_s(aw, aNk, bT); wi_fma_s(aa, aAt, bT); WI_PIN();
          wi_st_nat_s(SLOT(2), aw, m, n0, fr, fq); wi_st_nat_s(SLOT(7), aa, m, n0, fr, fq); }
        HBAR();
        { WiA aAT, aW1; WiB bB, bM; f32x4 ap[2] = {{0.f, 0.f, 0.f, 0.f}, {0.f, 0.f, 0.f, 0.f}}, az[2], ag[2], az2[2]; float gl[2];
          wi_lda(aAT, SLOT(7), m, fr, fq); wi_lda(aW1, SLOT(2), m, fr, fq); wi_ldb(bB, SLOT(3), n0, fr, fq); wi_ldb(bM, SLOT(13), n0, fr, fq);
          wi_ld_nat(az, SLOT(4), m, n0, fr, fq); wi_ld_tr(az2, SLOT(14), m, n0, fr, fq); wi_ld_tr(ag, SLOT(12), m, n0, fr, fq);
#pragma unroll
          for (int n = 0; n < 2; ++n) gl[n] = GL[n0 + 16 * n + fr];
          WI_PIN();
          wi_fma(ap, aAT, bB); wi_fma(az, aW1, bB); wi_fma(ag, aAT, bM); wi_fma(az2, aW1, bM);
          WI_PIN();
          wi_st_tr(SLOT(8), az, m, n0, fr, fq); wi_st_tr(SLOT(9), az2, m, n0, fr, fq);
          bf16* PTp = (bf16*)ST + (size_t)(h * NCH + ch) * 4096; bf16* GMp = gm_ptr(a.ws, h, ch);
#pragma unroll
          for (int n = 0; n < 2; ++n) { const int col = n0 + 16 * n + fr; f32x4 pv = ap[n];
#pragma unroll
              for (int i = 0; i < 4; ++i) { if (16 * m + 4 * fq + i == col) pv[i] += 1.0f; pv[i] *= gl[n]; }
              u32x2 w; w.x = pk2(pv[0], pv[1]); w.y = pk2(pv[2], pv[3]); *(u32x2*)(PTp + col * 64 + 16 * m + 4 * fq) = w;
              u32x2 w2; w2.x = pk2(ag[n][0], ag[n][1]); w2.y = pk2(ag[n][2], ag[n][3]); *(u32x2*)(GMp + col * 64 + 16 * m + 4 * fq) = w2; } }
        HBAR();
        { WiA aV; WiB bZ1, bZ2; float gl[2]; wi_lda(aV, SLOT(5), m, fr, fq); wi_ldb(bZ1, SLOT(8), n0, fr, fq); wi_ldb(bZ2, SLOT(9), n0, fr, fq); gl[0] = GL[n0 + fr]; gl[1] = GL[n0 + 16 + fr]; WI_PIN();
          f32x4 aq[2] = {{0.f, 0.f, 0.f, 0.f}, {0.f, 0.f, 0.f, 0.f}}, ay[2] = {{0.f, 0.f, 0.f, 0.f}, {0.f, 0.f, 0.f, 0.f}}; wi_fma(aq, aV, bZ1); wi_fma(ay, aV, bZ2); WI_PIN();
          float* QTp = ST + ST_Q_OFF + (size_t)(h * NCH + ch) * 4096; bf16* Y0p = (bf16*)(a.ws + WS_Y0) + (size_t)(h * NCH + ch) * 4096;
#pragma unroll
          for (int n = 0; n < 2; ++n) { const int col = n0 + 16 * n + fr; *(f32x4*)(QTp + col * 64 + 16 * m + 4 * fq) = aq[n] * gl[n];
              u32x2 w; w.x = pk2(ay[n][0], ay[n][1]); w.y = pk2(ay[n][2], ay[n][3]); *(u32x2*)(Y0p + col * 64 + 16 * m + 4 * fq) = w; } }
        HBAR();
    }
#undef SLOT
#undef WI_FETCH
}

__device__ __forceinline__ void phase_scan3m(ArgsR a, const Ctx& c, int l) {
    const f16* R = (const f16*)(a.ws + WS_R); const f16* KP = (const f16*)(a.ws + WS_KP); const f16* V = (const f16*)(a.ws + WS_V); const bf16* G = (const bf16*)(a.ws + WS_G);
    bf16* YA = (bf16*)(a.ws + WS_YA);
    LAS3 unsigned char* L = (LAS3 unsigned char*)c.lds;
    LAS3 float* YL = (LAS3 float*)(L + WI_B);
    LAS3 unsigned char* S0I = L + 3 * WI_B;
    const int lane = c.lane, wv = c.wave, fr = lane & 15, fq = lane >> 4, m = wv >> 1, n0 = 32 * (wv & 1), tid = c.tid;
    const int boff = (n0 + fr) * 64 + 8 * fq, qtoff = (n0 + fr) * 64 + 16 * m + 4 * fq;
    u32x4 pS; bf16x8 pL[2][2]; f32x4 pQ[2]; bf16x8 pB[2][2]; u32x2 pY[2];
#define S3_FETCH(it) do { const int h_ = (it) / NCH, ch_ = (it) % NCH; pS = (u32x4){0u, 0u, 0u, 0u}; \
        _Pragma("unroll") for (int ks = 0; ks < 2; ++ks) _Pragma("unroll") for (int n = 0; n < 2; ++n) pL[ks][n] = (bf16x8){0, 0, 0, 0, 0, 0, 0, 0}; \
        pQ[0] = (f32x4){0.f, 0.f, 0.f, 0.f}; pQ[1] = (f32x4){0.f, 0.f, 0.f, 0.f}; \
        if (ch_ > 0) { const int c1_ = ch_ - 1; pS = *(const u32x4*)((const bf16*)(a.ws + WS_SG) + (size_t)(h_ * NG + c1_ / GS) * 4096 + tid * 8); \
            const bf16* LP_ = (const bf16*)(a.ws + WS_ST) + ST_LP_OFF + (size_t)(h_ * NCH + c1_) * 4096; const float* QT_ = (const float*)(a.ws + WS_ST) + ST_Q_OFF + (size_t)(h_ * NCH + c1_) * 4096; \
            _Pragma("unroll") for (int ks = 0; ks < 2; ++ks) _Pragma("unroll") for (int n = 0; n < 2; ++n) pL[ks][n] = *(const bf16x8*)(LP_ + boff + 16 * n * 64 + 32 * ks); \
            _Pragma("unroll") for (int n = 0; n < 2; ++n) pQ[n] = *(const f32x4*)(QT_ + qtoff + 16 * n * 64); } \
        const bf16* G_ = gm_ptr(a.ws, h_, ch_); const bf16* Y_ = (const bf16*)(a.ws + WS_Y0) + (size_t)(h_ * NCH + ch_) * 4096; \
        _Pragma("unroll") for (int ks = 0; ks < 2; ++ks) _Pragma("unroll") for (int n = 0; n < 2; ++n) pB[ks][n] = *(const bf16x8*)(G_ + (n0 + 16 * n + fr) * 64 + 32 * ks + 8 * fq); \
        _Pragma("unroll") for (int n = 0; n < 2; ++n) pY[n] = *(const u32x2*)(Y_ + (n0 + 16 * n + fr) * 64 + 16 * m + 4 * fq); } while (0)
    if (blockIdx.x < NH * NCH) S3_FETCH(blockIdx.x);
    for (int item = blockIdx.x; item < NH * NCH; item += gridDim.x) {
        const int h = item / NCH, ch = item % NCH;
        *(LAS3 u32x4*)(L + ((tid >> 3) * WI_LD + (tid & 7) * 8) * 2) = pS;
        bf16x8 lfr[2][2], bfr[2][2]; f32x4 as0[2], acc[2];
#pragma unroll
        for (int ks = 0; ks < 2; ++ks)
#pragma unroll
            for (int n = 0; n < 2; ++n) { lfr[ks][n] = pL[ks][n]; bfr[ks][n] = pB[ks][n]; }
#pragma unroll
        for (int n = 0; n < 2; ++n) { as0[n] = pQ[n]; acc[n][0] = __uint_as_float(pY[n].x << 16); acc[n][1] = __uint_as_float(pY[n].x & 0xffff0000u); acc[n][2] = __uint_as_float(pY[n].y << 16); acc[n][3] = __uint_as_float(pY[n].y & 0xffff0000u); }
        if (item + (int)gridDim.x < NH * NCH) S3_FETCH(item + (int)gridDim.x);
        HBAR();
        hmma(L, lfr, as0, m, fr, fq);
        himg_store(S0I, as0, m, n0, fr, fq);
        HBAR();
#pragma unroll
        for (int ks = 0; ks < 2; ++ks) { const bf16x8 av = *(const LAS3 bf16x8*)(S0I + ((16 * m + fr) * WI_LD + 32 * ks + 8 * fq) * 2);
#pragma unroll
            for (int n = 0; n < 2; ++n) acc[n] = __builtin_amdgcn_mfma_f32_16x16x32_bf16(av, bfr[ks][n], acc[n], 0, 0, 0); }
#pragma unroll
        for (int n = 0; n < 2; ++n)
#pragma unroll
            for (int i = 0; i < 4; ++i) YL[(n0 + 16 * n + fr) * 65 + 16 * m + 4 * fq + i] = acc[n][i];
        HBAR();
        { const float gn_g = a.in[I_GNG][l * W + h * 64 + lane], gn_b = a.in[I_GNB][l * W + h * 64 + lane], r_k = a.in[I_RK][l * W + h * 64 + lane];
          f16 rl8[8], kl8[8], vl8[8]; bf16 gl8[8];
#pragma unroll
          for (int i = 0; i < 8; ++i) { const size_t o = (size_t)(ch * CL + 8 * wv + i) * W + h * 64 + lane; rl8[i] = R[o]; kl8[i] = KP[o]; vl8[i] = V[o]; gl8[i] = G[o]; }
#pragma unroll
          for (int i = 0; i < 8; ++i) { const int t = 8 * wv + i; const size_t o = (size_t)(ch * CL + t) * W + h * 64 + lane;
              const float yy = YL[t * 65 + lane]; const float rl = (float)rl8[i], kl = (float)kl8[i], vl = (float)vl8[i], gl = bf2f(gl8[i]);
              const float mean = wave_sum(yy) * (1.f / 64.f); const float dd = yy - mean; const float var = wave_sum(dd * dd) * (1.f / 64.f);
              const float bonus = wave_sum(rl * kl * r_k);
              const float yn = dd * __builtin_amdgcn_rsqf(var + GN_EPS) * gn_g + gn_b + bonus * vl;
              YA[o] = f2bf(yn * gl); } }
        HBAR();
    }
#undef S3_FETCH
}

__device__ __forceinline__ void phase_scan3(ArgsR a, const Ctx& c, int l) {
    const f16* R = (const f16*)(a.ws + WS_R); const f16* WM1 = (const f16*)(a.ws + WS_WM1); const f16* KP = (const f16*)(a.ws + WS_KP);
    const f16* AA = (const f16*)(a.ws + WS_AA); const f16* BB = (const f16*)(a.ws + WS_BB); const f16* V = (const f16*)(a.ws + WS_V);
    const float* ST = (const float*)(a.ws + WS_ST); bf16* YA = (bf16*)(a.ws + WS_YA); const f16* Gs = (const f16*)(a.ws + WS_G);
    const int lane = c.lane;
    LAS3 unsigned char* ring = (LAS3 unsigned char*)c.lds + c.wave * SC_WAVE;
    for (int item = c.gw; item < NH * NCH; item += c.ngw) {
        const int h = __builtin_amdgcn_readfirstlane(item / NCH), ch = __builtin_amdgcn_readfirstlane(item % NCH);
        const size_t lane_off = (size_t)(lane >> 3) * W + h * 64 + (lane & 7) * 8;
        const float gn_g = a.in[I_GNG][l * W + h * 64 + lane], gn_b = a.in[I_GNB][l * W + h * 64 + lane], r_k = a.in[I_RK][l * W + h * 64 + lane];
        { const size_t e0 = (size_t)(ch * CL) * W + lane_off;
          sc_dma(AA, e0, ring); sc_dma(WM1, e0, ring + 1024); sc_dma(BB, e0, ring + 2048); sc_dma(KP, e0, ring + 3072); sc_dma(V, e0, ring + 4096); sc_dma(R, e0, ring + 5120); sc_dma(Gs, e0, ring + 6144); }
        float S[64];
        if (ch == 0) {
#pragma unroll
            for (int j = 0; j < 64; ++j) S[j] = 0.f;
        } else { const bf16* Sp = (const bf16*)ST + ((size_t)(h * NCH + ch - 1) * 64 + lane) * 64;
#pragma unroll
            for (int j = 0; j < 64; j += 4) { const f32x4 x = load4bf(Sp + j); S[j] = x[0]; S[j + 1] = x[1]; S[j + 2] = x[2]; S[j + 3] = x[3]; } }
#pragma unroll 1
        for (int blk = 0; blk < CL / SCB; ++blk) {
            LAS3 unsigned char* buf = ring + (blk & 1) * SC_BUF;
            if (blk + 1 < CL / SCB) { LAS3 unsigned char* nb = ring + ((blk + 1) & 1) * SC_BUF; const size_t e0 = (size_t)(ch * CL + (blk + 1) * SCB) * W + lane_off;
                sc_dma(AA, e0, nb); sc_dma(WM1, e0, nb + 1024); sc_dma(BB, e0, nb + 2048); sc_dma(KP, e0, nb + 3072); sc_dma(V, e0, nb + 4096); sc_dma(R, e0, nb + 5120); sc_dma(Gs, e0, nb + 6144);
                asm volatile("s_waitcnt vmcnt(7)" ::: "memory"); }
            else asm volatile("s_waitcnt vmcnt(0)" ::: "memory");
            SVec A, Wv, Bv, Kv, Rv;
            sv_cvt(A, sv_read(buf, lane)); sv_cvt1p(Wv, sv_read(buf + 1024, lane)); sv_cvt(Bv, sv_read(buf + 2048, lane)); sv_cvt(Kv, sv_read(buf + 3072, lane)); sv_cvt(Rv, sv_read(buf + 5120, lane));
            float vv = (float)*(const LAS3 f16*)(buf + 4096 + lane * 2);
#pragma unroll 1
            for (int st = 0; st < SCB; ++st) {
                const LAS3 unsigned char* sn = buf + ((st + 1 < SCB) ? st + 1 : st) * 128;
                const f16x4 ha = sv_read(sn, lane), hw = sv_read(sn + 1024, lane), hb = sv_read(sn + 2048, lane), hk = sv_read(sn + 3072, lane), hr = sv_read(sn + 5120, lane);
                const f16 hv = *(const LAS3 f16*)(sn + 4096 + lane * 2);
                float d[4] = {0.f, 0.f, 0.f, 0.f};
                sc_dot<0>(d, A, S);
                const float sa = (d[0] + d[1]) + (d[2] + d[3]);
                float y[4] = {0.f, 0.f, 0.f, 0.f};
                sc_upd3<0>(S, y, Wv, Bv, Kv, Rv, sa, vv);
                const float yy = (y[0] + y[1]) + (y[2] + y[3]);
                sv_cvt(A, ha); sv_cvt1p(Wv, hw); sv_cvt(Bv, hb); sv_cvt(Kv, hk); sv_cvt(Rv, hr); vv = (float)hv;
                { const LAS3 unsigned char* sb = buf + st * 128;
                  const float rl = (float)*(const LAS3 f16*)(sb + 5120 + lane * 2), kl = (float)*(const LAS3 f16*)(sb + 3072 + lane * 2), vl = (float)*(const LAS3 f16*)(sb + 4096 + lane * 2);
                  const float gl = bf2f(*(const LAS3 bf16*)(sb + 6144 + lane * 2));
                  const float mean = wave_sum(yy) * (1.f / 64.f); const float dd = yy - mean; const float var = wave_sum(dd * dd) * (1.f / 64.f);
                  const float bonus = wave_sum(rl * kl * r_k);
                  const float yn = dd * __builtin_amdgcn_rsqf(var + GN_EPS) * gn_g + gn_b + bonus * vl;
                  YA[(size_t)(ch * CL + blk * SCB + st) * W + h * 64 + lane] = f2bf(yn * gl); }
            }
        }
    }
}

__device__ __forceinline__ void phase_post(ArgsR a, const Ctx& c, int l) {
    const bf16* YSC = (const bf16*)(a.ws + WS_YSC); const f16* R = (const f16*)(a.ws + WS_R); const f16* KP = (const f16*)(a.ws + WS_KP); const f16* V = (const f16*)(a.ws + WS_V);
    const bf16* G = (const bf16*)(a.ws + WS_G); bf16* YA = (bf16*)(a.ws + WS_YA);
    const float* gng = a.in[I_GNG] + l * W; const float* gnb = a.in[I_GNB] + l * W; const float* rk = a.in[I_RK] + l * W;
    for (int t = c.gw; t < T; t += c.ngw) {
#pragma unroll
        for (int i = 0; i < 8; ++i) { const int n = c.lane + 64 * i; const size_t o = (size_t)t * W + n;
            const float y = bf2f(YSC[o]); const float mean = wave_sum(y) * (1.f / 64.f); const float d = y - mean; const float var = wave_sum(d * d) * (1.f / 64.f);
            float yn = d * __builtin_amdgcn_rsqf(var + GN_EPS) * gng[n] + gnb[n];
            const float r = (float)R[o], k = (float)KP[o], v = (float)V[o];
            const float bonus = wave_sum(r * k * rk[n]);
            yn += bonus * v;
            YA[o] = f2bf(yn * bf2f(G[o])); }
    }
}

__device__ __forceinline__ void phase_ln1(ArgsR a, const Ctx& c, int l, float* outw, int mode = 3) {
    const float* MODF = (const float*)(a.ws + WS_MODF) + l * 6144;
    const float* g1 = a.in[I_LN1G] + l * D; const float* b1 = a.in[I_LN1B] + l * D;
    bf16* XN = (bf16*)(a.ws + WS_XN);
    int* TOKI = (int*)(a.ws + WS_TOKI); float* TOKW = (float*)(a.ws + WS_TOKW); int* TOKP = (int*)(a.ws + WS_TOKP);
    const float* rw = a.in[I_RW]; const float* rb = a.in[I_RB];
    LAS3 float* rwT = (LAS3 float*)((LAS3 unsigned char*)c.lds + 69632);
    constexpr int RW_LD = D + 4;
    unsigned* lcnt = (unsigned*)(c.lds + 135488);
    if (mode & 1) {
    for (int i = c.tid; i < D * NE; i += NTHREADS) rwT[(i & 15) * RW_LD + (i >> 4)] = rw[i];
    if (c.tid < NE) lcnt[c.tid] = 0u;
    __syncthreads();
    const bf16* TMP = (const bf16*)(a.ws + WS_TMP);
    float vn[16]; if (c.gw < T) load_row16bf(TMP + (size_t)c.gw * D, c.lane, vn);
    for (int m = c.gw; m < T; m += c.ngw) {
        int l4 = 4 * c.lane; asm volatile("" : "+v"(l4));
        float v[16];
#pragma unroll
        for (int j = 0; j < 16; ++j) v[j] = vn[j];
        if (m + c.ngw < T) load_row16bf(TMP + (size_t)(m + c.ngw) * D, c.lane, vn);
        float mean, rstd; row_stats(v, mean, rstd);
#pragma unroll
        for (int j = 0; j < 4; ++j) { f32x4 o; const int col = l4 + 256 * j;
#pragma unroll
            for (int e = 0; e < 4; ++e) { v[4 * j + e] = (v[4 * j + e] - mean) * rstd * g1[col + e] + b1[col + e]; o[e] = v[4 * j + e]; }
            *(f32x4*)(outw + (size_t)m * D + col) = o; }
        row_stats(v, mean, rstd);
#pragma unroll
        for (int j = 0; j < 4; ++j) { f32x4 o; const int col = l4 + 256 * j;
#pragma unroll
            for (int e = 0; e < 4; ++e) { v[4 * j + e] = (v[4 * j + e] - mean) * rstd * (1.0f + MODF[4096 + col + e]) + MODF[3072 + col + e]; o[e] = v[4 * j + e]; }
            store4bf(XN + (size_t)m * D + col, o); }
        float lg[16];
#pragma unroll
        for (int e = 0; e < 16; ++e) { float x = 0.f;
#pragma unroll
            for (int j = 0; j < 4; ++j) { const f32x4 r4 = *(const LAS3 f32x4*)(rwT + e * RW_LD + l4 + 256 * j); x += (v[4 * j] * r4[0] + v[4 * j + 1] * r4[1]) + (v[4 * j + 2] * r4[2] + v[4 * j + 3] * r4[3]); }
            lg[e] = x;
            if ((e & 3) == 3) __builtin_amdgcn_sched_barrier(0); }
        float r8[8], r4v[4], r2[2], r1;
        { const bool b5 = (c.lane & 32) != 0, b4 = (c.lane & 16) != 0, b3 = (c.lane & 8) != 0, b2 = (c.lane & 4) != 0;
#pragma unroll
          for (int i = 0; i < 8; ++i) { const float snd = b5 ? lg[i] : lg[i + 8], kp = b5 ? lg[i + 8] : lg[i]; r8[i] = kp + __shfl_xor(snd, 32); }
#pragma unroll
          for (int i = 0; i < 4; ++i) { const float snd = b4 ? r8[i] : r8[i + 4], kp = b4 ? r8[i + 4] : r8[i]; r4v[i] = kp + __shfl_xor(snd, 16); }
#pragma unroll
          for (int i = 0; i < 2; ++i) { const float snd = b3 ? r4v[i] : r4v[i + 2], kp = b3 ? r4v[i + 2] : r4v[i]; r2[i] = kp + __shfl_xor(snd, 8); }
          { const float snd = b2 ? r2[0] : r2[1], kp = b2 ? r2[1] : r2[0]; r1 = kp + __shfl_xor(snd, 4); }
          r1 += __shfl_xor(r1, 2); r1 += __shfl_xor(r1, 1); }
        float sc[16], sel[16];
#pragma unroll
        for (int e = 0; e < 16; ++e) { const float lgt = __shfl(r1, 4 * e); sc[e] = __builtin_amdgcn_rcpf(1.0f + __expf(-lgt)); sel[e] = sc[e] + rb[e]; }
        int best = 0; float bestv = -INFINITY;
#pragma unroll
        for (int g = 0; g < 4; ++g) { float m1 = -INFINITY, m2 = -INFINITY;
#pragma unroll
            for (int q = 0; q < 4; ++q) { const float sv = sel[4 * g + q]; if (sv > m1) { m2 = m1; m1 = sv; } else if (sv > m2) m2 = sv; }
            const float gs = m1 + m2; if (gs > bestv) { bestv = gs; best = g; } }
        int i1 = 0, i2 = 0; float s1 = -INFINITY, s2 = -INFINITY, w1 = 0.f, w2 = 0.f;
#pragma unroll
        for (int e = 0; e < 16; ++e) { if ((e >> 2) == best) { const float sv = sel[e];
                if (sv > s1) { s2 = s1; i2 = i1; w2 = w1; s1 = sv; i1 = e; w1 = sc[e]; } else if (sv > s2) { s2 = sv; i2 = e; w2 = sc[e]; } } }
        if (c.lane == 0) { const float ws = w1 + w2;
            TOKI[2 * m] = i1; TOKI[2 * m + 1] = i2; TOKW[2 * m] = w1 / ws; TOKW[2 * m + 1] = w2 / ws;
            TOKP[2 * m] = (int)atomicAdd(&lcnt[i1], 1u); TOKP[2 * m + 1] = (int)atomicAdd(&lcnt[i2], 1u); }
    }
    __syncthreads();
    if (c.tid < NE) ((int*)(a.ws + WS_BLKCNT))[blockIdx.x * NE + c.tid] = (int)lcnt[c.tid];
    __syncthreads();
    }
}

__device__ __forceinline__ void expert_convert(ArgsR a, const Ctx& c, int l, int b0) {
    if ((int)blockIdx.x < b0) return;
    float* scr = (float*)(c.lds + c.wave * 8704);
    bf16* WGU = (bf16*)(a.ws + WS_WGU); bf16* WD = (bf16*)(a.ws + WS_WD);
    constexpr int IG = (D / 64) * (FF / 32);
    constexpr int ID = (FF / 64) * (D / 32);
    const int gw0 = ((int)blockIdx.x - b0) * NWAVES + c.wave, ngw0 = ((int)gridDim.x - b0) * NWAVES;
    for (int it = gw0; it < NE * (2 * IG + ID); it += ngw0) {
        const int e = it / (2 * IG + ID); int r = it % (2 * IG + ID);
        const size_t eo = ((size_t)l * NE + e) * (size_t)D * FF;
        if (r < IG) { transpose_matrix_item(a.in[I_EG] + eo, D, FF, WGU + (size_t)e * 1024 * 1024, r, scr, c.lane, RowGU{0}); continue; } r -= IG;
        if (r < IG) { transpose_matrix_item(a.in[I_EU] + eo, D, FF, WGU + (size_t)e * 1024 * 1024, r, scr, c.lane, RowGU{1}); continue; } r -= IG;
        transpose_matrix_item(a.in[I_ED] + eo, FF, D, WD + (size_t)e * 1024 * 512, r, scr, c.lane, RowId());
    }
}

__device__ __forceinline__ void phase_perm(ArgsR a, const Ctx& c, int l) {
    const int* BLKCNT = (const int*)(a.ws + WS_BLKCNT);
    LAS3 int* pre = (LAS3 int*)c.lds;
    LAS3 int* tot = pre + 256 * NE;
    const int nb = gridDim.x;
#pragma unroll
    for (int q = 0; q < 2; ++q) { const int e = 2 * c.wave + q; int v[4]; int sum = 0;
#pragma unroll
        for (int i = 0; i < 4; ++i) { const int b = 4 * c.lane + i; v[i] = b < nb ? BLKCNT[b * NE + e] : 0; sum += v[i]; }
        int inc = sum;
#pragma unroll
        for (int o = 1; o < 64; o <<= 1) { const int t = __shfl_up(inc, o); if (c.lane >= o) inc += t; }
        int run = inc - sum;
#pragma unroll
        for (int i = 0; i < 4; ++i) { pre[(4 * c.lane + i) * NE + e] = run; run += v[i]; }
        if (c.lane == 63) tot[e] = inc; }
    __syncthreads();
    int ts[17]; { int sacc = 0;
#pragma unroll
        for (int e = 0; e < 16; ++e) { ts[e] = sacc; sacc += (tot[e] + 255) >> 8; } ts[16] = sacc; }
    if (blockIdx.x == 0 && c.tid < NE) ((int*)(a.ws + WS_TOT))[c.tid] = tot[c.tid];
    const int* TOKI = (const int*)(a.ws + WS_TOKI); const int* TOKP = (const int*)(a.ws + WS_TOKP); int* S2T = (int*)(a.ws + WS_S2T); const float* TOKW = (const float*)(a.ws + WS_TOKW);
    const bf16* XN = (const bf16*)(a.ws + WS_XN); bf16* XS = (bf16*)(a.ws + WS_XS);
    for (int as = blockIdx.x * NTHREADS + c.tid; as < 2 * T; as += gridDim.x * NTHREADS) {
        const int e = TOKI[as]; int base = 0;
#pragma unroll
        for (int j = 0; j < 16; ++j) base = (j == e) ? ts[j] : base;
        const int m = as >> 1, blk = (m % c.ngw) >> 3;
        const u32x2 sw = {(unsigned)as, __float_as_uint(TOKW[as])};
        *(u32x2*)(S2T + 2 * (base * 256 + pre[blk * NE + e] + TOKP[as])) = sw;
    }
    for (int e = 0; e < 16; ++e) {
        int tse = 0, tsn = 0;
#pragma unroll
        for (int j = 0; j < 16; ++j) { tse = (j == e) ? ts[j] : tse; tsn = (j == e) ? ts[j + 1] : tsn; }
        const int lo = tse * 256 + tot[e], hi = tsn * 256;
        for (int sl = lo + blockIdx.x * NTHREADS + c.tid; sl < hi; sl += gridDim.x * NTHREADS) S2T[2 * sl] = -1;
    }
    __syncthreads();
}

__device__ __forceinline__ void phase_ln2(ArgsR a, const Ctx& c, int l, float* outw) {
    const float* MODF = (const float*)(a.ws + WS_MODF) + l * 6144;
    const float* g2 = a.in[I_LN2G] + l * D; const float* b2 = a.in[I_LN2B] + l * D;
    const bf16* Y = (const bf16*)(a.ws + WS_Y); bf16* XN = (bf16*)(a.ws + WS_XN);
    float vn[16]; u32x2 y0n[4], y1n[4];
    if (c.gw < T) { load_row16(a.out + (size_t)c.gw * D, c.lane, vn);
#pragma unroll
        for (int j = 0; j < 4; ++j) { y0n[j] = *(const u32x2*)(Y + (size_t)(2 * c.gw) * D + 4 * c.lane + 256 * j); y1n[j] = *(const u32x2*)(Y + (size_t)(2 * c.gw + 1) * D + 4 * c.lane + 256 * j); } }
    for (int m = c.gw; m < T; m += c.ngw) {
        float v[16]; u32x2 y0[4], y1[4];
#pragma unroll
        for (int j = 0; j < 16; ++j) v[j] = vn[j];
#pragma unroll
        for (int j = 0; j < 4; ++j) { y0[j] = y0n[j]; y1[j] = y1n[j]; }
        if (m + c.ngw < T) { const int mn = m + c.ngw; load_row16(a.out + (size_t)mn * D, c.lane, vn);
#pragma unroll
            for (int j = 0; j < 4; ++j) { y0n[j] = *(const u32x2*)(Y + (size_t)(2 * mn) * D + 4 * c.lane + 256 * j); y1n[j] = *(const u32x2*)(Y + (size_t)(2 * mn + 1) * D + 4 * c.lane + 256 * j); } }
#pragma unroll
        for (int j = 0; j < 4; ++j) { const int col = 4 * c.lane + 256 * j;
            const float a0 = __uint_as_float(y0[j].x << 16) + __uint_as_float(y1[j].x << 16), a1 = __uint_as_float(y0[j].x & 0xffff0000u) + __uint_as_float(y1[j].x & 0xffff0000u);
            const float a2 = __uint_as_float(y0[j].y << 16) + __uint_as_float(y1[j].y << 16), a3 = __uint_as_float(y0[j].y & 0xffff0000u) + __uint_as_float(y1[j].y & 0xffff0000u);
            const f32x4 gt = *(const f32x4*)(MODF + 5120 + col);
            v[4 * j] = ALPHA * v[4 * j] + (1.0f + gt[0]) * a0; v[4 * j + 1] = ALPHA * v[4 * j + 1] + (1.0f + gt[1]) * a1; v[4 * j + 2] = ALPHA * v[4 * j + 2] + (1.0f + gt[2]) * a2; v[4 * j + 3] = ALPHA * v[4 * j + 3] + (1.0f + gt[3]) * a3; }
        float mean, rstd; row_stats(v, mean, rstd);
#pragma unroll
        for (int j = 0; j < 4; ++j) { f32x4 o; const int col = 4 * c.lane + 256 * j;
#pragma unroll
            for (int e = 0; e < 4; ++e) { v[4 * j + e] = (v[4 * j + e] - mean) * rstd * g2[col + e] + b2[col + e]; o[e] = v[4 * j + e]; }
            *(f32x4*)(outw + (size_t)m * D + col) = o; }
        if (l + 1 < DEPTH) {
            const float* MN = MODF + 6144;
            row_stats(v, mean, rstd);
#pragma unroll
            for (int j = 0; j < 4; ++j) { f32x4 o; const int col = 4 * c.lane + 256 * j;
#pragma unroll
                for (int e = 0; e < 4; ++e) o[e] = (v[4 * j + e] - mean) * rstd * (1.0f + MN[1024 + col + e]) + MN[col + e];
                store4bf(XN + (size_t)m * D + col, o); }
        }
    }
}


template <class F> struct EpiAdapt {
    static constexpr bool PERM = true, AFTER_DRAIN = false; F f;
    __device__ __forceinline__ void operator()(const f32x4 (&acc)[2][2][4][2], const Unit& u, int wr, int wc, int fr, int fq) const {
        const int col = u.pn * 256 + wc * 32 + 8 * fq;
#pragma unroll
        for (int ai = 0; ai < 2; ++ai)
#pragma unroll
            for (int m = 0; m < 4; ++m) { const int row = u.pm * 256 + ai * 128 + wr * 64 + m * 16 + fr; f(row, col, acc[ai][0][m][0], acc[ai][0][m][1], acc[ai][1][m][0], acc[ai][1][m][1]); }
    }
};

template <class Sched, class F>
__device__ __forceinline__ void gemm_gather(const Ctx& c, const bf16* A, const int* s2t, const bf16* Bt, int M, int N, int K, const Sched& S, const F& f) {
    pg8::Gemm g{A, Bt, M, N, K}; EpiAdapt<F> E{f};
    pg8::gemm_phase<EpiAdapt<F>, Sched, true, true, true>((PG8_LAS unsigned char*)c.lds, g, S, E, c.tid, s2t);
}
template <class Sched, class F>
__device__ __forceinline__ void gemm_any(const Ctx& c, const bf16* A, const bf16* Bt, int M, int N, int K, const Sched& S, const F& f) {
    pg8::Gemm g{A, Bt, M, N, K}; EpiAdapt<F> E{f};
    pg8::gemm_phase<EpiAdapt<F>, Sched, true, true>((PG8_LAS unsigned char*)c.lds, g, S, E, c.tid);
}

#define LAS __attribute__((address_space(3)))
#define XB_TMO      128
#define XB_XCNT(j)  (256  + 64 * (j))
#define XB_XSUB(j)  (1280 + 64 * (j))
#define XB_XGEN(j)  (2304 + 64 * (j))
#define XB_TOP      3328
#define XB_TOPGEN   3392
#define XCD_BAR_WORDS 3456
#define XB_SPIN_CAP (1u << 24)

__device__ __forceinline__ unsigned xb_ld(unsigned* p)              { return __hip_atomic_load(p, __ATOMIC_RELAXED, __HIP_MEMORY_SCOPE_AGENT); }
__device__ __forceinline__ unsigned xb_add(unsigned* p, unsigned v) { return __hip_atomic_fetch_add(p, v, __ATOMIC_RELAXED, __HIP_MEMORY_SCOPE_AGENT); }
__device__ __forceinline__ unsigned xb_xcc_id() { return (unsigned)__builtin_amdgcn_s_getreg((3 << 11) | 20) & 0xFu; }
#define XB_SPIN(cond, bar) do { unsigned _sp = 0; while (cond) { __builtin_amdgcn_s_sleep(1); \
    if ((++_sp & 255u) == 0u) { if (xb_ld(&(bar)[XB_TMO])) break; if (_sp > XB_SPIN_CAP) { atomicAdd(&(bar)[XB_TMO], 1u); break; } } } } while (0)

struct XcdBarrier {
    unsigned* bar; unsigned x;
    volatile LAS unsigned* st;
};

__device__ __forceinline__ XcdBarrier xcd_barrier_post(unsigned* bar, volatile LAS unsigned* st) {
    XcdBarrier b; b.bar = bar; b.x = xb_xcc_id(); b.st = st;
    if (threadIdx.x == 0) (void)xb_add(&bar[XB_XCNT(b.x)], 1u);
    return b;
}
__device__ __forceinline__ void xcd_barrier_complete(unsigned* bar, unsigned x, unsigned& nloc, unsigned& nx) {
    const unsigned G = gridDim.x * gridDim.y * gridDim.z;
    unsigned sum, cnt, mine, sp = 0u;
    for (;;) {
        sum = 0u; cnt = 0u; mine = 0u;
#pragma unroll
        for (unsigned j = 0; j < 16; ++j) { const unsigned c = xb_ld(&bar[XB_XCNT(j)]); sum += c; cnt += (c > 0u) ? 1u : 0u; mine = (j == x) ? c : mine; }
        if (sum == G) break;
        __builtin_amdgcn_s_sleep(1);
        if ((++sp & 255u) == 0u) { if (xb_ld(&bar[XB_TMO])) break; if (sp > XB_SPIN_CAP) { atomicAdd(&bar[XB_TMO], 1u); break; } }
    }
    nloc = mine > 0u ? mine : 1u; nx = cnt > 0u ? cnt : 1u;
}

__device__ __forceinline__ void xcd_barrier(const XcdBarrier& b) {
    asm volatile("s_waitcnt vmcnt(0)" ::: "memory");
    __syncthreads();
    if (threadIdx.x == 0) {
        unsigned* bar = b.bar;
        __builtin_amdgcn_s_waitcnt(0);
        unsigned nloc = b.st[0], nx = b.st[1];
        if (nloc == 0u) { xcd_barrier_complete(bar, b.x, nloc, nx); b.st[0] = nloc; b.st[1] = nx; }
        const unsigned old = xb_add(&bar[XB_XSUB(b.x)], 1u);
        const unsigned gen = old / nloc;
        if (old + 1u == (gen + 1u) * nloc) {
            __builtin_amdgcn_fence(__ATOMIC_RELEASE, "agent");
            asm volatile("s_waitcnt vmcnt(0)" ::: "memory");
            const unsigned og = xb_add(&bar[XB_TOP], 1u);
            const unsigned tg = og / nx;
            if (og + 1u == (tg + 1u) * nx) xb_add(&bar[XB_TOPGEN], 1u);
            else XB_SPIN(xb_ld(&bar[XB_TOPGEN]) == tg, bar);
            __builtin_amdgcn_fence(__ATOMIC_ACQUIRE, "agent");
            xb_add(&bar[XB_XGEN(b.x)], 1u);
            asm volatile("s_waitcnt vmcnt(0)" ::: "memory");
        } else {
            XB_SPIN(xb_ld(&bar[XB_XGEN(b.x)]) == gen, bar);
            __builtin_amdgcn_fence(__ATOMIC_ACQUIRE, "agent");
            asm volatile("s_waitcnt vmcnt(0)" ::: "memory");
        }
    }
    __syncthreads();
}


constexpr int PH_PER_LAYER = 12, N_PHASES = 2 + PH_PER_LAYER * DEPTH;
constexpr int CW_BAR = 4096;
constexpr int CW_RDY = 65536;
constexpr int LDS_BYTES = 147456, LDSCTL_OFF = 131072 + 8192;
#ifndef SINGLE_LAUNCH
#define SINGLE_LAUNCH 1
#endif

#ifndef PROBE_A
#define PROBE_A -1
#endif
#ifndef PROBE_B
#define PROBE_B -1
#endif
constexpr size_t WS_TS = 512 * 1024;
#if PROBE_A >= 0
#define STAMP(i) do { if (blockIdx.x == 0 && threadIdx.x == 0) ((unsigned long long*)(args_here()->ws + WS_TS))[(i)] = __builtin_amdgcn_s_memrealtime(); } while (0)
#else
#define STAMP(i) do { } while (0)
#endif
__device__ __forceinline__ const __attribute__((address_space(4))) Args* args_here() { const __attribute__((address_space(4))) Args* p = (const __attribute__((address_space(4))) Args*)__builtin_amdgcn_kernarg_segment_ptr(); asm volatile("" : "+s"(p)); return p; }
#ifndef REP_K
#define REP_K -1
#endif
__device__ __forceinline__ Ctx mkctx(int wave_s, unsigned char* lds) { Ctx c; c.wave = wave_s; c.lane = (int)__builtin_amdgcn_mbcnt_hi(~0u, __builtin_amdgcn_mbcnt_lo(~0u, 0u)); c.tid = wave_s * 64 + c.lane;
    c.gw = blockIdx.x * NWAVES + wave_s; c.ngw = gridDim.x * NWAVES; c.lds = lds; return c; }
#define PHASE1(k, ...) do { const __attribute__((address_space(4))) Args* ap_ = args_here(); if (ap_->ph_lo <= (k) && (k) < ap_->ph_hi) { ArgsR a = *ap_; const Ctx c = mkctx(wave_s, lds); __VA_ARGS__ } } while (0)
#define PHASE(k, ...) do { PHASE1(k, __VA_ARGS__); if ((k) == REP_K) { xcd_barrier(bar); PHASE1(k, __VA_ARGS__); xcd_barrier(bar); PHASE1(k, __VA_ARGS__); } } while (0)

template <int L>
__device__ __forceinline__ void run_layer(const int wave_s, unsigned char* lds, const XcdBarrier& bar) {
    const int G = gridDim.x, b = blockIdx.x;
#define BAR() do { xcd_barrier(bar); STAMP(3 + 14 * L + (bk_++)); } while (0)
    int bk_ = 0;
    PHASE(0, unsigned char* ws = a.ws; pg8::StaticOrder S; S.init(T, INC, G, b); EpiZ E{(bf16*)(ws + WS_ZR), (bf16*)(ws + WS_ZS), (bf16*)(ws + WS_ZG)};
        gemm_any(c, (const bf16*)(ws + WS_XN), (const bf16*)(ws + WS_WIN + (size_t)L * 10 * MiB), T, INC, D, S, E); );
    BAR();
    PHASE(1, phase_prep_fast(a, c, L); );
    PHASE(14, phase_sg_fast(a, c, L); );
    BAR();
#if REP_K == 21
    PHASE1(2, phase_scan1m(a, c, 1); ); xcd_barrier(bar); PHASE1(2, phase_scan1m(a, c, 1); ); xcd_barrier(bar);
#endif
    PHASE(2, phase_scan1m(a, c); );
    BAR();
    PHASE(3, phase_scan2a(a, c); );
    BAR();
    PHASE(31, phase_scan2b(a, c); );
    PHASE(33, expert_convert(a, c, L, NH); );
    BAR();
    PHASE(4, phase_scan3m(a, c, L); );
    BAR();
    PHASE(6, unsigned char* ws = a.ws; pg8::StaticOrder S; S.init(T, D, G, b); EpiGA E{(const bf16*)(ws + WS_ZG), (bf16*)(ws + WS_MP)};
        gemm_any(c, (const bf16*)(ws + WS_YA), (const bf16*)(ws + WS_WA + (size_t)L * WS_WL1), T, D, W, S, E); );
    BAR();
#if REP_K == 7
    PHASE1(7, unsigned char* ws = a.ws; pg8::StaticOrder S; S.init(T, D, G, b); EpiGB E{(const bf16*)(ws + WS_ZG), (const bf16*)(ws + WS_MP), (bf16*)(ws + WS_ZR)};
        gemm_any(c, (const bf16*)(ws + WS_YB), (const bf16*)(ws + WS_WB + (size_t)L * WS_WL1), T, D, W, S, E); ); xcd_barrier(bar);
    PHASE1(7, unsigned char* ws = a.ws; pg8::StaticOrder S; S.init(T, D, G, b); EpiGB E{(const bf16*)(ws + WS_ZG), (const bf16*)(ws + WS_MP), (bf16*)(ws + WS_ZR)};
        gemm_any(c, (const bf16*)(ws + WS_YB), (const bf16*)(ws + WS_WB + (size_t)L * WS_WL1), T, D, W, S, E); ); xcd_barrier(bar);
#endif
#if REP_K == 8
    PHASE1(8, unsigned char* ws = a.ws; pg8::StaticOrder S; S.init(T, D, G, b); EpiOut E{L == 0 ? a.in[I_X] : a.out, (bf16*)(ws + WS_R), (const float*)(ws + WS_MODF) + L * 6144 + 2048};
        gemm_any(c, (const bf16*)(ws + WS_MP), (const bf16*)(ws + WS_WO + (size_t)L * WS_WL1), T, D, D, S, E); ); xcd_barrier(bar);
    PHASE1(8, unsigned char* ws = a.ws; pg8::StaticOrder S; S.init(T, D, G, b); EpiOut E{L == 0 ? a.in[I_X] : a.out, (bf16*)(ws + WS_R), (const float*)(ws + WS_MODF) + L * 6144 + 2048};
        gemm_any(c, (const bf16*)(ws + WS_MP), (const bf16*)(ws + WS_WO + (size_t)L * WS_WL1), T, D, D, S, E); ); xcd_barrier(bar);
#endif
    PHASE1(7, unsigned char* ws = a.ws; pg8::StaticOrder S; S.init(T, D, G, b); EpiGB E{(const bf16*)(ws + WS_ZG), (const bf16*)(ws + WS_MP), (bf16*)(ws + WS_MP)};
        gemm_any(c, (const bf16*)(ws + WS_YB), (const bf16*)(ws + WS_WB + (size_t)L * WS_WL1), T, D, W, S, E); );
    BAR();
    PHASE1(8, unsigned char* ws = a.ws; pg8::StaticOrder S; S.init(T, D, G, b); EpiOut E{L == 0 ? a.in[I_X] : a.out, (bf16*)(ws + WS_TMP), (const float*)(ws + WS_MODF) + L * 6144 + 2048};
        gemm_any(c, (const bf16*)(ws + WS_MP), (const bf16*)(ws + WS_WO + (size_t)L * WS_WL1), T, D, D, S, E); );
    BAR();
#if REP_K == 9
    PHASE1(9, phase_ln1(a, c, L, (float*)(a.ws + WS_ZR)); ); xcd_barrier(bar); PHASE1(9, phase_ln1(a, c, L, (float*)(a.ws + WS_ZR)); ); xcd_barrier(bar);
#endif
#if REP_K == 91
    PHASE1(9, phase_ln1(a, c, L, (float*)(a.ws + WS_ZR), 1); ); xcd_barrier(bar); PHASE1(9, phase_ln1(a, c, L, (float*)(a.ws + WS_ZR), 1); ); xcd_barrier(bar);
#endif
#if REP_K == 92
    PHASE1(9, phase_ln1(a, c, L, (float*)(a.ws + WS_ZR), 2); ); xcd_barrier(bar); PHASE1(9, phase_ln1(a, c, L, (float*)(a.ws + WS_ZR), 2); ); xcd_barrier(bar);
#endif
    PHASE1(9, phase_ln1(a, c, L, a.out); );
    BAR();
    PHASE(10, phase_perm(a, c, L); );
    BAR();
    PHASE(11, unsigned char* ws = a.ws; MoeSchedA S; S.init((const unsigned*)(ws + WS_TOT), G, b); EpiSwi E{(bf16*)(ws + WS_HID)};
        gemm_gather(c, (const bf16*)(ws + WS_XN), (const int*)(ws + WS_S2T), (const bf16*)(ws + WS_WGU), MAXSLOT, NE * 1024, D, S, E); );
    BAR();
    PHASE(12, unsigned char* ws = a.ws; unsigned* rdy = (unsigned*)(ws + WS_CTL) + CW_RDY + L * 16384;
        { MoeSchedT S; S.init((const unsigned*)(ws + WS_TOT), G, b); S.rdy = rdy; EpiSwiWT E{(bf16*)(ws + WS_HID)};
          gemm_gather(c, (const bf16*)(ws + WS_XN), (const int*)(ws + WS_S2T), (const bf16*)(ws + WS_WGU), MAXSLOT, NE * 1024, D, S, E); }
        { MoeSchedB S; S.init((const unsigned*)(ws + WS_TOT), G, b); S.rdy = rdy; S.tmo = (unsigned*)(ws + WS_CTL) + CW_BAR + XB_TMO; S.wave = c.wave;
          EpiDown E{(const int*)(ws + WS_S2T), (const float*)(ws + WS_TOKW), (bf16*)(ws + WS_Y)};
          gemm_any(c, (const bf16*)(ws + WS_HID), (const bf16*)(ws + WS_WD), MAXSLOT, NE * 1024, FF, S, E); } );
    BAR();
#if REP_K == 13
    PHASE1(13, phase_ln2(a, c, L, (float*)(a.ws + WS_R)); ); xcd_barrier(bar); PHASE1(13, phase_ln2(a, c, L, (float*)(a.ws + WS_R)); ); xcd_barrier(bar);
#endif
    PHASE1(13, phase_ln2(a, c, L, a.out); );
    if (L + 1 < DEPTH) BAR();
    (void)bk_;
#undef BAR
}

__global__ void __launch_bounds__(NTHREADS, 2) mk_fwd(Args a_unused) {
    extern __shared__ __attribute__((aligned(16))) unsigned char lds[];
    const int wave_s = __builtin_amdgcn_readfirstlane(threadIdx.x >> 6);
    for (int u = threadIdx.x; u < (LDS_BYTES - LDSCTL_OFF) / 4; u += NTHREADS) ((LAS unsigned*)((LAS unsigned char*)lds + LDSCTL_OFF))[u] = 0u;
    __syncthreads();
    const XcdBarrier bar = xcd_barrier_post((unsigned*)(args_here()->ws + WS_CTL) + CW_BAR, (volatile LAS unsigned*)((LAS unsigned char*)lds + LDSCTL_OFF) + 8);
    STAMP(0);
    PHASE(100, phase_p0a(a, c); );
    xcd_barrier(bar); STAMP(1);
    PHASE(101, phase_p0b(a, c); );
    xcd_barrier(bar); STAMP(2);
    run_layer<0>(wave_s, lds, bar);
    run_layer<1>(wave_s, lds, bar);
#if PROBE_A >= 0
    if (blockIdx.x == 0) {
        asm volatile("s_waitcnt vmcnt(0)" ::: "memory"); __syncthreads();
        if (threadIdx.x == 0) ((unsigned long long*)(args_here()->ws + WS_TS))[30] = __builtin_amdgcn_s_memrealtime();
        asm volatile("s_waitcnt vmcnt(0)" ::: "memory"); __syncthreads();
        const volatile unsigned long long* ts = (const volatile unsigned long long*)(args_here()->ws + WS_TS);
        float da = 0.f, db = 0.f;
        if (PROBE_A < 14) { da = (float)(ts[3 + PROBE_A] - ts[2 + PROBE_A]) + (float)(ts[17 + PROBE_A] - ts[16 + PROBE_A]); } else if (PROBE_A == 14) da = (float)(ts[1] - ts[0]); else if (PROBE_A == 15) da = (float)(ts[2] - ts[1]); else da = (float)(ts[30] - ts[0]);
        if (PROBE_B >= 0 && PROBE_B < 14) { db = (float)(ts[3 + PROBE_B] - ts[2 + PROBE_B]) + (float)(ts[17 + PROBE_B] - ts[16 + PROBE_B]); } else if (PROBE_B == 14) db = (float)(ts[1] - ts[0]); else if (PROBE_B == 15) db = (float)(ts[2] - ts[1]);
        da *= 0.01f; db *= 0.01f;
        da = exp2f(0.25f * rintf(4.0f * log2f(fmaxf(da, 0.5f)))); db = exp2f(0.25f * rintf(4.0f * log2f(fmaxf(db, 0.5f))));
        float* out = args_here()->out;
        for (int i = threadIdx.x; i < 16 * 1024; i += NTHREADS) { const int r = i >> 10, col = i & 1023; const int rowi = (r & 7) + 2048 * (r >> 3); out[(size_t)rowi * D + col] = da; }
        if (threadIdx.x == 0 && PROBE_B >= 0) out[(size_t)4096 * D] = 100.0f * db;
    }
#endif
}

extern "C" void kernel_launch(void* const* d_in, const int* in_sizes, int n_in, void* d_out, int out_size, void* d_ws, size_t ws_size, hipStream_t stream) {
    static int grid = 0;
    if (grid == 0) {
        if (n_in != N_IN || out_size != T * D || ws_size < WS_END2) { fprintf(stderr, "kernel_launch: unexpected shapes: n_in %d out %d ws %zu (need %zu)\n", n_in, out_size, ws_size, (size_t)WS_END2); grid = -1; return; }
        int dev = 0, cus = 0;
        (void)hipGetDevice(&dev); (void)hipDeviceGetAttribute(&cus, hipDeviceAttributeMultiprocessorCount, dev);
        if (hipFuncSetAttribute((const void*)mk_fwd, hipFuncAttributeMaxDynamicSharedMemorySize, LDS_BYTES) != hipSuccess) { fprintf(stderr, "kernel_launch: hipFuncSetAttribute failed\n"); grid = -1; return; }
        grid = cus > 0 ? (cus & ~3) : 256;
        fprintf(stderr, "kernel_launch: ws_size %zu grid %d\n", ws_size, grid);
    }
    if (grid < 0) return;
    (void)hipMemsetAsync((char*)d_ws + WS_CTL, 0, CTL_BYTES, stream);
    Args a{};
    for (int i = 0; i < N_IN; ++i) a.in[i] = (const float*)d_in[i];
    a.out = (float*)d_out; a.ws = (unsigned char*)d_ws;
    a.ph_lo = 0; a.ph_hi = 1000;
    hipLaunchKernelGGL(mk_fwd, dim3(grid), dim3(NTHREADS), LDS_BYTES, stream, a);
}
```

```cpp
#include <hip/hip_runtime.h>
#include <cstdio>
#include <cstdint>
#include <utility>

typedef unsigned short bf16;
typedef _Float16 f16;
typedef float f32x4 __attribute__((ext_vector_type(4)));
typedef unsigned u32x4 __attribute__((ext_vector_type(4)));
typedef unsigned u32x2 __attribute__((ext_vector_type(2)));

constexpr int T = 16384, D = 1024, W = 512, NH = 8, HN = 64, RC = 1792, INC = 4864;
constexpr int NE = 16, FF = 512, DEPTH = 2;
constexpr float LN_EPS = 1e-5f, GN_EPS = 64e-5f, ALPHA = 1.41421356237f;
constexpr int NTHREADS = 512, NWAVES = 8;
constexpr int MAXSLOT = 36864;

constexpr size_t MiB = 1u << 20;
constexpr size_t WS_CTL = 0, CTL_BYTES = 1 * MiB;
constexpr int CW_CNT = 16384;
constexpr size_t WS_PART = 1 * MiB;
constexpr size_t WS_MODF = 2 * MiB;
constexpr size_t WS_TOKI = 2 * MiB + 65536;
constexpr size_t WS_TOKW = WS_TOKI + 131072;
constexpr size_t WS_TOKP = WS_TOKW + 131072;
constexpr size_t WS_S2T = 3 * MiB;
constexpr size_t WS_BLKCNT = 3 * MiB + 512 * 1024;
constexpr size_t WS_TOT = WS_BLKCNT + 32768;
constexpr size_t WS_LORA = 4 * MiB;
constexpr size_t WS_WIN = 8 * MiB;
constexpr size_t WS_WA = 28 * MiB, WS_WB = 29 * MiB, WS_WO = 30 * MiB, WS_WL1 = 4 * MiB;
constexpr size_t WS_ZG = 36 * MiB;
constexpr size_t WS_XN = 100 * MiB;
constexpr size_t WS_G = 100 * MiB, WS_YB = 116 * MiB;
constexpr size_t WS_ZR = 132 * MiB;
constexpr size_t WS_ZS = 188 * MiB;
constexpr size_t WS_YSC = 132 * MiB;
constexpr size_t WS_ST = 132 * MiB;
constexpr size_t WS_YA = 188 * MiB;
constexpr size_t WS_MP = 132 * MiB;
constexpr size_t WS_TMP = 164 * MiB;
constexpr size_t WS_XS = 132 * MiB;
constexpr size_t WS_Y = 132 * MiB;
constexpr size_t WS_AA = 224 * MiB, WS_BB = 240 * MiB, WS_WM1 = 256 * MiB, WS_R = 272 * MiB, WS_KP = 288 * MiB, WS_V = 304 * MiB;
constexpr size_t WS_WGU = 224 * MiB;
constexpr size_t WS_WD = 256 * MiB;
constexpr size_t WS_HID = 272 * MiB;
constexpr size_t WS_VF = 320 * MiB;
constexpr size_t WS_END = 336 * MiB;

constexpr size_t LO_W2T = 0, LO_A2T = 65536, LO_G2T = 131072, LO_VM1T = 262144, LO_VM2T = 294912, LO_STRIDE = 524288;

enum { I_X = 0, I_C, I_WMOD, I_BMOD, I_WIN, I_MU, I_W0, I_W2, I_A0, I_A2, I_G2, I_KK, I_KA, I_RK, I_GNG, I_GNB, I_VM0, I_VM1, I_VM2,
       I_SGG, I_SGB, I_WS, I_BS, I_WBA, I_WBB, I_WOUT, I_LN1G, I_LN1B, I_RW, I_RB, I_EG, I_EU, I_ED, I_LN2G, I_LN2B, N_IN };

struct Args { const float* in[N_IN]; float* out; unsigned char* ws; int ph_lo, ph_hi; };
typedef const __attribute__((address_space(4))) Args& ArgsR;

__device__ __forceinline__ float bf2f(bf16 h) { return __uint_as_float(((unsigned)h) << 16); }
__device__ __forceinline__ unsigned f2bfu(float f) { unsigned u = __float_as_uint(f); return (u + 0x7fffu + ((u >> 16) & 1u)) >> 16; }
__device__ __forceinline__ bf16 f2bf(float f) { return __builtin_bit_cast(unsigned short, (__bf16)f); }
typedef __bf16 bf16x2_t __attribute__((ext_vector_type(2)));
__device__ __forceinline__ unsigned pk2(float lo, float hi) { bf16x2_t v; v[0] = (__bf16)lo; v[1] = (__bf16)hi; return __builtin_bit_cast(unsigned, v); }
__device__ __forceinline__ void store4bf(bf16* p, f32x4 v) { u32x2 w; w.x = pk2(v[0], v[1]); w.y = pk2(v[2], v[3]); *(u32x2*)p = w; }
__device__ __forceinline__ f32x4 load4bf(const bf16* p) { u32x2 w = *(const u32x2*)p; f32x4 r; r[0] = __uint_as_float(w.x << 16); r[1] = __uint_as_float(w.x & 0xffff0000u); r[2] = __uint_as_float(w.y << 16); r[3] = __uint_as_float(w.y & 0xffff0000u); return r; }
__device__ __forceinline__ float wave_sum(float v) {
    v += __builtin_bit_cast(float, __builtin_amdgcn_update_dpp(0, __builtin_bit_cast(int, v), 0xB1, 0xF, 0xF, true));
    v += __builtin_bit_cast(float, __builtin_amdgcn_update_dpp(0, __builtin_bit_cast(int, v), 0x4E, 0xF, 0xF, true));
    v += __builtin_bit_cast(float, __builtin_amdgcn_update_dpp(0, __builtin_bit_cast(int, v), 0x141, 0xF, 0xF, true));
    v += __builtin_bit_cast(float, __builtin_amdgcn_update_dpp(0, __builtin_bit_cast(int, v), 0x140, 0xF, 0xF, true));
    v += __builtin_bit_cast(float, __builtin_amdgcn_update_dpp(0, __builtin_bit_cast(int, v), 0x142, 0xA, 0xF, false));
    v += __builtin_bit_cast(float, __builtin_amdgcn_update_dpp(0, __builtin_bit_cast(int, v), 0x143, 0xC, 0xF, false));
    return __builtin_bit_cast(float, __builtin_amdgcn_readlane(__builtin_bit_cast(int, v), 63));
}
__device__ __forceinline__ float sigmoidf_(float x) { return __builtin_amdgcn_rcpf(1.0f + __expf(-x)); }
__device__ __forceinline__ float siluf_(float x) { return x * sigmoidf_(x); }
__device__ __forceinline__ float gelu_tanh(float x) { const float u = 0.7978845608028654f * (x + 0.044715f * x * x * x); return x * (1.0f - __builtin_amdgcn_rcpf(1.0f + __expf(2.0f * u))); }
__device__ __forceinline__ float softplusf_(float y) { return fmaxf(y, 0.f) + log1pf(__expf(-fabsf(y))); }

struct Ctx { int tid, lane, wave, gw, ngw; unsigned char* lds; };

__device__ __forceinline__ void transpose_item(const float* Wsrc, int N, int k0, int n0, bf16* dst, int ldk, float* scr, int lane) {
    float tv[32];
#pragma unroll
    for (int i = 0; i < 32; ++i) tv[i] = Wsrc[(size_t)(k0 + 2 * i + (lane >> 5)) * N + n0 + (lane & 31)];
#pragma unroll
    for (int i = 0; i < 32; ++i) scr[(2 * i + (lane >> 5)) * 33 + (lane & 31)] = tv[i];
    asm volatile("s_waitcnt lgkmcnt(0)" ::: "memory");
    const int c = lane & 7;
#pragma unroll
    for (int j = 0; j < 4; ++j) { const int n = (lane >> 3) + 8 * j; const float* s = scr + (8 * c) * 33 + n;
        u32x4 o; o.x = pk2(s[0 * 33], s[1 * 33]); o.y = pk2(s[2 * 33], s[3 * 33]); o.z = pk2(s[4 * 33], s[5 * 33]); o.w = pk2(s[6 * 33], s[7 * 33]);
        *(u32x4*)(dst + (size_t)n * ldk + k0 + 8 * c) = o; }
    asm volatile("s_waitcnt lgkmcnt(0)" ::: "memory");
}
template <class RowMap>
__device__ __forceinline__ void transpose_matrix_item(const float* Wsrc, int K, int N, bf16* dst, int item, float* scr, int lane, const RowMap& rm) {
    const int nblk = N / 32, kb = item / nblk, nb = item % nblk, n0 = 32 * nb;
    transpose_item(Wsrc, N, 64 * kb, n0, dst + (size_t)rm(n0) * K, K, scr, lane);
}
struct RowId { __device__ __forceinline__ int operator()(int n) const { return n; } };
struct RowGU { int up; __device__ __forceinline__ int operator()(int n) const { return (n >> 7) * 256 + (n & 127) + up * 128; } };

__device__ __forceinline__ void phase_p0a(ArgsR a, const Ctx& c) {
    float* scr = (float*)(c.lds + c.wave * 16384);
    { float* MODF = (float*)(a.ws + WS_MODF); float* red = (float*)(c.lds + 131072);
      for (int cbk = blockIdx.x; cbk < 2 * 96; cbk += gridDim.x) {
          const int l = cbk / 96, n = (cbk % 96) * 64 + c.lane;
          const float* wm = a.in[I_WMOD] + (size_t)l * D * 6144 + (size_t)(c.wave * 128) * 6144 + n;
          float acc0 = 0.f, acc1 = 0.f;
#pragma unroll 16
          for (int k = 0; k < 128; k += 2) { acc0 += siluf_(a.in[I_C][c.wave * 128 + k]) * wm[(size_t)k * 6144]; acc1 += siluf_(a.in[I_C][c.wave * 128 + k + 1]) * wm[(size_t)(k + 1) * 6144]; }
          red[c.wave * 64 + c.lane] = acc0 + acc1;
          __syncthreads();
          if (c.wave == 0) { float sacc = a.in[I_BMOD][l * 6144 + n];
#pragma unroll
              for (int w = 0; w < 8; ++w) sacc += red[w * 64 + c.lane];
              MODF[l * 6144 + n] = sacc; }
          __syncthreads();
      } }
    for (int it = c.gw; it < 2 * (16 + 16 + 32 + 8); it += c.ngw) {
        const int l = it / 72; int r = it % 72; unsigned char* lo = a.ws + WS_LORA + (size_t)l * LO_STRIDE;
        if (r < 16) { transpose_matrix_item(a.in[I_W2] + (size_t)l * 64 * W, 64, W, (bf16*)(lo + LO_W2T), r, scr, c.lane, RowId()); continue; } r -= 16;
        if (r < 16) { transpose_matrix_item(a.in[I_A2] + (size_t)l * 64 * W, 64, W, (bf16*)(lo + LO_A2T), r, scr, c.lane, RowId()); continue; } r -= 16;
        if (r < 32) { transpose_matrix_item(a.in[I_G2] + (size_t)l * 128 * W, 128, W, (bf16*)(lo + LO_G2T), r, scr, c.lane, RowId()); continue; } r -= 32;
        if (l == 1) transpose_matrix_item(a.in[I_VM1], W, 32, (bf16*)(lo + LO_VM1T), r, scr, c.lane, RowId());
    }
    for (int i = blockIdx.x * NTHREADS + c.tid; i < 32 * W; i += gridDim.x * NTHREADS) { const int n = i >> 5, k = i & 31;
        ((bf16*)(a.ws + WS_LORA + LO_STRIDE + LO_VM2T))[i] = f2bf(a.in[I_VM2][(size_t)k * W + n]); }
    constexpr int I_WINL = (D / 64) * (INC / 32);
    constexpr int I_WAL = (W / 64) * (D / 32);
    constexpr int I_WOL = (D / 64) * (D / 32);
    constexpr int PER_L = I_WINL + 2 * I_WAL + I_WOL;
    for (int it = c.gw; it < 2 * PER_L; it += c.ngw) {
        const int l = it / PER_L; int r = it % PER_L;
        if (r < I_WINL) { transpose_matrix_item(a.in[I_WIN] + (size_t)l * D * INC, D, INC, (bf16*)(a.ws + WS_WIN + (size_t)l * 10 * MiB), r, scr, c.lane, RowId()); continue; } r -= I_WINL;
        if (r < I_WAL) { transpose_matrix_item(a.in[I_WBA] + (size_t)l * W * D, W, D, (bf16*)(a.ws + WS_WA + (size_t)l * WS_WL1), r, scr, c.lane, RowId()); continue; } r -= I_WAL;
        if (r < I_WAL) { transpose_matrix_item(a.in[I_WBB] + (size_t)l * W * D, W, D, (bf16*)(a.ws + WS_WB + (size_t)l * WS_WL1), r, scr, c.lane, RowId()); continue; } r -= I_WAL;
        transpose_matrix_item(a.in[I_WOUT] + (size_t)l * D * D, D, D, (bf16*)(a.ws + WS_WO + (size_t)l * WS_WL1), r, scr, c.lane, RowId());
    }
}

__device__ __forceinline__ void row_stats(const float (&v)[16], float& mean, float& rstd) {
    float s = 0.f;
#pragma unroll
    for (int j = 0; j < 16; ++j) s += v[j];
    mean = wave_sum(s) * (1.f / D);
    float q = 0.f;
#pragma unroll
    for (int j = 0; j < 16; ++j) { const float d = v[j] - mean; q += d * d; }
    rstd = __builtin_amdgcn_rsqf(wave_sum(q) * (1.f / D) + LN_EPS);
}
__device__ __forceinline__ void load_row16bf(const bf16* p, int lane, float (&v)[16]) {
#pragma unroll
    for (int j = 0; j < 4; ++j) { const f32x4 x = load4bf(p + 4 * lane + 256 * j); v[4 * j] = x[0]; v[4 * j + 1] = x[1]; v[4 * j + 2] = x[2]; v[4 * j + 3] = x[3]; }
}
__device__ __forceinline__ void load_row16(const float* p, int lane, float (&v)[16]) {
#pragma unroll
    for (int j = 0; j < 4; ++j) { const f32x4 x = *(const f32x4*)(p + 4 * lane + 256 * j); v[4 * j] = x[0]; v[4 * j + 1] = x[1]; v[4 * j + 2] = x[2]; v[4 * j + 3] = x[3]; }
}

__device__ __forceinline__ void phase_p0b(ArgsR a, const Ctx& c) {
    const float* MODF = (const float*)(a.ws + WS_MODF);
    float sh[16], sc[16];
#pragma unroll
    for (int j = 0; j < 4; ++j) { const f32x4 s0 = *(const f32x4*)(MODF + 4 * c.lane + 256 * j), s1 = *(const f32x4*)(MODF + 1024 + 4 * c.lane + 256 * j);
#pragma unroll
        for (int e = 0; e < 4; ++e) { sh[4 * j + e] = s0[e]; sc[4 * j + e] = 1.f + s1[e]; } }
    bf16* XN = (bf16*)(a.ws + WS_XN);
    for (int m = c.gw; m < T; m += c.ngw) {
        float v[16]; load_row16(a.in[I_X] + (size_t)m * D, c.lane, v);
        float mean, rstd; row_stats(v, mean, rstd);
#pragma unroll
        for (int j = 0; j < 4; ++j) { f32x4 o;
#pragma unroll
            for (int e = 0; e < 4; ++e) o[e] = (v[4 * j + e] - mean) * rstd * sc[4 * j + e] + sh[4 * j + e];
            store4bf(XN + (size_t)m * D + 4 * c.lane + 256 * j, o); }
    }
}

namespace pg8 {
#define PG8_LAS __attribute__((address_space(3)))
typedef unsigned short bf16_t;
typedef short bf16x8 __attribute__((ext_vector_type(8)));
typedef float f32x4 __attribute__((ext_vector_type(4)));
typedef unsigned u32x4 __attribute__((ext_vector_type(4)));
constexpr int BM = 256, BK = 64, HALF = 128, HTB = HALF * BK * 2  , STAGE_BYTES = 8 * HTB, NXCD = 8, WGM = 8;

__host__ __device__ __forceinline__ int lds_byte(int r, int c) { const int st = (r >> 4) * 2 + (c >> 5), rr = r & 15, cc = c & 31, ob = rr * 64 + cc * 2; return st * 1024 + (ob ^ (((ob >> 9) & 1) << 5)); }
__host__ __device__ __forceinline__ void stage_rc(int b, int& R, int& C) { const int st = b / 1024, sb = b % 1024, swz = sb ^ (((sb >> 9) & 1) << 5); R = (st >> 1) * 16 + swz / 64; C = (st & 1) * 32 + (swz % 64) / 2; }
__host__ __device__ __forceinline__ int perm32(int rho) { const int n = rho >> 4, i = rho & 15; return 8 * (i >> 2) + 4 * n + (i & 3); }

struct Unit { int pm, pn; };
struct Gemm { const bf16_t* A; const bf16_t* Bt; int M, N, K; };

struct StaticOrder {
    int nM, nN, nwg, G, c;
    __host__ __device__ void init(int M, int N, int G_, int c_) { nM = M / BM; nN = N / BM; nwg = nM * nN; G = G_; c = c_; }
    __host__ __device__ bool next(int i, Unit& u) const {
        const long L = (long)i * G + c; if (L >= nwg) return false;
        int wgid = (int)L; { const int q = nwg / NXCD, r = nwg % NXCD, xcd = wgid % NXCD, off = wgid / NXCD; wgid = (xcd < r ? xcd * (q + 1) : r * (q + 1) + (xcd - r) * q) + off; }
        const int nig = WGM * nN, gid = wgid / nig, fm = gid * WGM, gsz = (nM - fm) < WGM ? (nM - fm) : WGM;
        u.pm = fm + ((wgid % nig) % gsz); u.pn = (wgid % nig) / gsz; return true;
    }
    __device__ __forceinline__ void a_ready(const Unit&) const {}
    __device__ __forceinline__ void done(const Unit&) const {}
};


template <class Epi, class Sched, bool ALIGN_EPI = false, bool SP2 = false, bool GATHER = false>
__device__ __forceinline__ void gemm_phase(PG8_LAS unsigned char* lds, const Gemm g, const Sched& S, const Epi& E, const int tid_in, const int* s2t = nullptr) {
    const int tid = tid_in, wid = __builtin_amdgcn_readfirstlane(tid >> 6), lane = tid & 63, wr = wid >> 2, wc = wid & 3, fr = lane & 15, fq = lane >> 4;
    const int K = g.K, nt = K / BK;
    unsigned voffA[2], voffB[2];
#pragma unroll
    for (int i = 0; i < 2; ++i) { int R, C; stage_rc(tid * 16 + i * 8192, R, C); const int Rb = Epi::PERM ? ((R & ~31) + perm32(R & 31)) : R;
        voffA[i] = (unsigned)(R * K + C) * 2u; voffB[i] = (unsigned)(Rb * K + C) * 2u; }
    unsigned pc0 = 0u, pc1 = 0u, pn0 = 0u, pn1 = 0u, cvoff = 0u; int R0g = 0;
    if constexpr (GATHER) { int R, C; stage_rc(tid * 16, R, C); R0g = R; cvoff = (unsigned)C * 2u; }
#define PG8_TOKPACK(pm_, h_) ([&]() -> unsigned { const int r0_ = (pm_) * BM + (h_) * HALF + R0g; const int a0_ = s2t[2 * r0_], a1_ = s2t[2 * (r0_ + 64)]; return (unsigned)(a0_ < 0 ? 0 : (a0_ >> 1)) | ((unsigned)(a1_ < 0 ? 0 : (a1_ >> 1)) << 16); }())
#define PG8_STAGE_A(bufoff, base, h, usen) do { if constexpr (GATHER) { const unsigned pk_ = (usen) ? ((h) ? pn1 : pn0) : ((h) ? pc1 : pc0); \
        unsigned vt_[2] = {(pk_ & 0xffffu) * (unsigned)(K * 2) + cvoff, (pk_ >> 16) * (unsigned)(K * 2) + cvoff}; PG8_STAGE(bufoff, base, vt_); } \
    else PG8_STAGE(bufoff, (base) + ((h) ? hstep : (size_t)0), voffA); } while (0)
    const size_t kstep = (size_t)(BK * 2);
    const size_t hstep = (size_t)HALF * K * 2;
    const size_t tstep = 2 * hstep;
    const unsigned ldsw = (unsigned)wid * 1024u;
    const int aoff = lds_byte(wr * 64 + fr, fq * 8), boff = lds_byte(wc * 32 + fr, fq * 8);
#define PG8_SA(b, h) (((b) * 2 + (h)) * HTB)
#define PG8_SB(b, h) ((4 + (b) * 2 + (h)) * HTB)
#define PG8_STAGE(bufoff, gbase, voff) do { _Pragma("unroll") for (int _i = 0; _i < 2; ++_i) \
        __builtin_amdgcn_global_load_lds((const unsigned*)((const char*)(gbase) + (voff)[_i]), (PG8_LAS unsigned*)(lds + (bufoff) + ldsw + _i * 8192), 16, 0, 0); } while (0)
#define PG8_LDA(dst, b, h) do { _Pragma("unroll") for (int m = 0; m < 4; ++m) _Pragma("unroll") for (int k = 0; k < 2; ++k) dst[m][k] = *(const PG8_LAS bf16x8*)(lds + PG8_SA(b, h) + aoff + m * 2048 + k * 1024); } while (0)
#define PG8_LDB(dst, b, h) do { _Pragma("unroll") for (int n = 0; n < 2; ++n) _Pragma("unroll") for (int k = 0; k < 2; ++k) dst[n][k] = *(const PG8_LAS bf16x8*)(lds + PG8_SB(b, h) + boff + n * 2048 + k * 1024); } while (0)
#define PG8_MMA(ai, bj, At, Bt) do { __builtin_amdgcn_s_setprio(1); _Pragma("unroll") for (int m = 0; m < 4; ++m) _Pragma("unroll") for (int n = 0; n < 2; ++n) _Pragma("unroll") for (int k = 0; k < 2; ++k) \
        acc[ai][bj][m][n] = __builtin_amdgcn_mfma_f32_16x16x32_bf16(Bt[n][k], At[m][k], acc[ai][bj][m][n], 0, 0, 0); __builtin_amdgcn_s_setprio(0); } while (0)
#define PG8_WAIT_V(n) asm volatile("s_waitcnt vmcnt(" #n ")" ::: "memory")
#define PG8_WAIT_L(n) asm volatile("s_waitcnt lgkmcnt(" #n ")" ::: "memory")
#define PG8_BAR __builtin_amdgcn_s_barrier()
#define PG8_SCHED __builtin_amdgcn_sched_barrier(0)
    Unit cur, nxt; int ui = 0;
    if (!S.next(0, cur)) return;
    f32x4 acc[2][2][4][2];
#pragma unroll
    for (int a = 0; a < 2; ++a)
#pragma unroll
        for (int b = 0; b < 2; ++b)
#pragma unroll
            for (int m = 0; m < 4; ++m)
#pragma unroll
                for (int n = 0; n < 2; ++n) acc[a][b][m][n] = (f32x4){0.f, 0.f, 0.f, 0.f};
    bf16x8 At[4][2], B0[2][2], B1[2][2];
    const char* cA = (const char*)g.A + (GATHER ? (size_t)0 : (size_t)cur.pm * tstep); const char* cB = (const char*)g.Bt + (size_t)cur.pn * tstep;
    if constexpr (GATHER) { pc0 = PG8_TOKPACK(cur.pm, 0); pc1 = PG8_TOKPACK(cur.pm, 1); }
    S.a_ready(cur);
    if constexpr (SP2) {
        PG8_STAGE(PG8_SB(0, 0), cB, voffB); PG8_STAGE(PG8_SB(0, 1), cB + hstep, voffB); PG8_STAGE_A(PG8_SA(0, 0), cA, 0, false); PG8_STAGE_A(PG8_SA(0, 1), cA, 1, false);
        if (wr == 1) PG8_BAR;
        PG8_WAIT_V(2); PG8_BAR;
        PG8_STAGE(PG8_SB(1, 0), cB + kstep, voffB); PG8_STAGE_A(PG8_SA(1, 0), cA + kstep, 0, false); PG8_STAGE(PG8_SB(1, 1), cB + hstep + kstep, voffB);
        PG8_WAIT_V(6); PG8_BAR;
    } else {
        PG8_STAGE(PG8_SB(0, 0), cB, voffB); PG8_STAGE(PG8_SA(0, 0), cA, voffA); PG8_STAGE(PG8_SB(0, 1), cB + hstep, voffB); PG8_STAGE(PG8_SA(0, 1), cA + hstep, voffA);
        if (wr == 1) PG8_BAR;
        PG8_WAIT_V(4); PG8_BAR;
        PG8_STAGE(PG8_SB(1, 0), cB + kstep, voffB); PG8_STAGE(PG8_SA(1, 0), cA + kstep, voffA); PG8_STAGE(PG8_SB(1, 1), cB + hstep + kstep, voffB);
        PG8_WAIT_V(6); PG8_BAR;
    }
    for (;;) {
        const bool has_next = S.next(ui + 1, nxt);
        const char* nA = (has_next && !GATHER) ? (const char*)g.A + (size_t)nxt.pm * tstep : cA; const char* nB = has_next ? (const char*)g.Bt + (size_t)nxt.pn * tstep : cB;
        if constexpr (GATHER) { if (has_next) { pn0 = PG8_TOKPACK(nxt.pm, 0); pn1 = PG8_TOKPACK(nxt.pm, 1); } else { pn0 = pc0; pn1 = pc1; } }
        for (int t = 0; t < nt; t += 2) {
            const bool last = (t == nt - 2);
            const char* a1 = cA + (size_t)(t + 1) * kstep;
            const char* a2 = last ? nA : cA + (size_t)(t + 2) * kstep; const char* b2 = last ? nB : cB + (size_t)(t + 2) * kstep;
            const char* a3 = a2 + kstep; const char* b3 = b2 + kstep;
            if (last && has_next) S.a_ready(nxt);
            if constexpr (SP2) {
            PG8_LDB(B0, 0, 0); PG8_LDB(B1, 0, 1); PG8_SCHED; PG8_LDA(At, 0, 0); PG8_STAGE_A(PG8_SA(1, 1), a1, 1, false);
            PG8_WAIT_V(8); PG8_WAIT_L(0); PG8_BAR; PG8_MMA(0, 0, At, B0); PG8_MMA(0, 1, At, B1); PG8_BAR; PG8_SCHED;
            PG8_LDA(At, 0, 1); PG8_STAGE(PG8_SB(0, 0), b2, voffB); PG8_STAGE(PG8_SB(0, 1), b2 + hstep, voffB); PG8_STAGE_A(PG8_SA(0, 0), a2, 0, last);
            PG8_WAIT_V(8); PG8_WAIT_L(0); PG8_BAR; PG8_MMA(1, 0, At, B0); PG8_MMA(1, 1, At, B1); PG8_BAR; PG8_SCHED;
            PG8_LDB(B0, 1, 0); PG8_LDB(B1, 1, 1); PG8_SCHED; PG8_LDA(At, 1, 0); PG8_STAGE_A(PG8_SA(0, 1), a2, 1, last);
            PG8_WAIT_V(8); PG8_WAIT_L(0); PG8_BAR; PG8_MMA(0, 0, At, B0); PG8_MMA(0, 1, At, B1); PG8_BAR; PG8_SCHED;
            PG8_LDA(At, 1, 1); PG8_STAGE(PG8_SB(1, 0), b3, voffB); PG8_STAGE(PG8_SB(1, 1), b3 + hstep, voffB); PG8_STAGE_A(PG8_SA(1, 0), a3, 0, last);
            PG8_WAIT_V(8); PG8_WAIT_L(0); PG8_BAR; PG8_MMA(1, 0, At, B0); PG8_MMA(1, 1, At, B1); PG8_BAR; PG8_SCHED;
            } else {
            PG8_LDB(B0, 0, 0); PG8_SCHED; PG8_LDA(At, 0, 0); PG8_STAGE(PG8_SA(1, 1), a1 + hstep, voffA);
            PG8_WAIT_L(8); PG8_BAR; PG8_WAIT_L(0); PG8_MMA(0, 0, At, B0); PG8_BAR; PG8_SCHED;
            PG8_LDB(B1, 0, 1); PG8_STAGE(PG8_SB(0, 0), b2, voffB);
            PG8_BAR; PG8_WAIT_L(0); PG8_MMA(0, 1, At, B1); PG8_BAR;
            PG8_LDA(At, 0, 1); PG8_STAGE(PG8_SA(0, 0), a2, voffA);
            PG8_BAR; PG8_WAIT_L(0); PG8_MMA(1, 0, At, B0); PG8_BAR; PG8_SCHED;
            PG8_STAGE(PG8_SB(0, 1), b2 + hstep, voffB);
            PG8_WAIT_V(6); PG8_BAR; PG8_MMA(1, 1, At, B1); PG8_BAR;
            PG8_LDB(B0, 1, 0); PG8_SCHED; PG8_LDA(At, 1, 0); PG8_STAGE(PG8_SA(0, 1), a2 + hstep, voffA);
            PG8_WAIT_L(8); PG8_BAR; PG8_WAIT_L(0); PG8_MMA(0, 0, At, B0); PG8_BAR; PG8_SCHED;
            PG8_LDB(B1, 1, 1); PG8_STAGE(PG8_SB(1, 0), b3, voffB);
            PG8_BAR; PG8_WAIT_L(0); PG8_MMA(0, 1, At, B1); PG8_BAR;
            PG8_LDA(At, 1, 1); PG8_STAGE(PG8_SA(1, 0), a3, voffA);
            PG8_BAR; PG8_WAIT_L(0); PG8_MMA(1, 0, At, B0); PG8_BAR; PG8_SCHED;
            PG8_STAGE(PG8_SB(1, 1), b3 + hstep, voffB);
            PG8_WAIT_V(6); PG8_BAR; PG8_MMA(1, 1, At, B1); PG8_BAR;
            }
        }
        if constexpr (ALIGN_EPI) { if (wr == 0) PG8_BAR; }
        if constexpr (!Epi::AFTER_DRAIN) { E(acc, cur, wr, wc, fr, fq); S.done(cur); }
        if (!has_next) break;
#pragma unroll
        for (int a = 0; a < 2; ++a)
#pragma unroll
            for (int b = 0; b < 2; ++b)
#pragma unroll
                for (int m = 0; m < 4; ++m)
#pragma unroll
                    for (int n = 0; n < 2; ++n) acc[a][b][m][n] = (f32x4){0.f, 0.f, 0.f, 0.f};
        cur = nxt; cA = nA; cB = nB; ++ui; if constexpr (GATHER) { pc0 = pn0; pc1 = pn1; }
        if constexpr (ALIGN_EPI) { if (wr == 1) PG8_BAR; }
    }
    PG8_WAIT_V(0);
    if constexpr (!ALIGN_EPI) { if (wr == 0) PG8_BAR; }
    PG8_BAR;
    if constexpr (Epi::AFTER_DRAIN) { E.fused(acc, cur, wr, wc, fr, fq, lds, wid, lane); S.done(cur); }
#undef PG8_SA
#undef PG8_SB
#undef PG8_STAGE
#undef PG8_STAGE_A
#undef PG8_TOKPACK
#undef PG8_LDA
#undef PG8_LDB
#undef PG8_MMA
#undef PG8_WAIT_V
#undef PG8_WAIT_L
#undef PG8_BAR
#undef PG8_SCHED
}
}

using pg8::Unit;
struct DenseSched { int nN, n, G, c;
    __device__ __forceinline__ void a_ready(const Unit&) const {}
    __device__ __forceinline__ void done(const Unit&) const {}
    __device__ __forceinline__ bool next(int i, Unit& u) const { const int L = i * G + c; if (L >= n) return false; u.pm = L / nN; u.pn = L % nN; return true; } };

__device__ __forceinline__ void store8bf(bf16* p, f32x4 lo, f32x4 hi) { u32x4 w; w.x = pk2(lo[0], lo[1]); w.y = pk2(lo[2], lo[3]); w.z = pk2(hi[0], hi[1]); w.w = pk2(hi[2], hi[3]); *(u32x4*)p = w; }
__device__ __forceinline__ void load8bf(const bf16* p, f32x4& lo, f32x4& hi) { const u32x4 w = *(const u32x4*)p;
    lo[0] = __uint_as_float(w.x << 16); lo[1] = __uint_as_float(w.x & 0xffff0000u); lo[2] = __uint_as_float(w.y << 16); lo[3] = __uint_as_float(w.y & 0xffff0000u);
    hi[0] = __uint_as_float(w.z << 16); hi[1] = __uint_as_float(w.z & 0xffff0000u); hi[2] = __uint_as_float(w.w << 16); hi[3] = __uint_as_float(w.w & 0xffff0000u); }
struct EpiZ { bf16 *ZR, *ZS, *ZG;
    __device__ __forceinline__ void one(int row, int col, f32x4 lo, f32x4 hi) const {
        if (col < RC) store8bf(ZR + (size_t)row * RC + col, lo, hi);
        else if (col < RC + 1024) { for (int e = 0; e < 4; ++e) { lo[e] = gelu_tanh(lo[e]); hi[e] = gelu_tanh(hi[e]); } store8bf(ZS + (size_t)row * 1024 + (col - RC), lo, hi); }
        else { for (int e = 0; e < 4; ++e) { lo[e] = sigmoidf_(lo[e]); hi[e] = sigmoidf_(hi[e]); } store8bf(ZG + (size_t)row * 2048 + (col - RC - 1024), lo, hi); } }
    __device__ __forceinline__ void operator()(int row, int col, f32x4 a0, f32x4 a1, f32x4 b0, f32x4 b1) const { one(row, col, a0, a1); one(row, col + 128, b0, b1); } };
struct EpiGA { const bf16* ZG; bf16* MP;
    __device__ __forceinline__ void one(int row, int col, f32x4 lo, f32x4 hi) const { f32x4 g0, g1; load8bf(ZG + (size_t)row * 2048 + col, g0, g1); store8bf(MP + (size_t)row * D + col, g0 * lo, g1 * hi); }
    __device__ __forceinline__ void operator()(int row, int col, f32x4 a0, f32x4 a1, f32x4 b0, f32x4 b1) const { one(row, col, a0, a1); one(row, col + 128, b0, b1); } };
struct EpiGB { const bf16* ZG; const bf16* MPin; bf16* MP;
    __device__ __forceinline__ void one(int row, int col, f32x4 lo, f32x4 hi) const { f32x4 g0, g1, m0, m1; load8bf(ZG + (size_t)row * 2048 + 1024 + col, g0, g1); load8bf(MPin + (size_t)row * D + col, m0, m1);
        store8bf(MP + (size_t)row * D + col, m0 + g0 * lo, m1 + g1 * hi); }
    __device__ __forceinline__ void operator()(int row, int col, f32x4 a0, f32x4 a1, f32x4 b0, f32x4 b1) const { one(row, col, a0, a1); one(row, col + 128, b0, b1); } };
struct EpiOut { const float* xin; bf16* tmp; const float* gate1;
    __device__ __forceinline__ void one(int row, int col, f32x4 lo, f32x4 hi) const { const f32x4 x0 = *(const f32x4*)(xin + (size_t)row * D + col), x1 = *(const f32x4*)(xin + (size_t)row * D + col + 4);
        const f32x4 g0 = *(const f32x4*)(gate1 + col), g1 = *(const f32x4*)(gate1 + col + 4); store8bf(tmp + (size_t)row * D + col, ALPHA * x0 + (1.0f + g0) * lo, ALPHA * x1 + (1.0f + g1) * hi); }
    __device__ __forceinline__ void operator()(int row, int col, f32x4 a0, f32x4 a1, f32x4 b0, f32x4 b1) const { one(row, col, a0, a1); one(row, col + 128, b0, b1); } };
struct EpiSwi { bf16* HID;
    __device__ __forceinline__ void operator()(int row, int col, f32x4 a0, f32x4 a1, f32x4 b0, f32x4 b1) const { const int ct = (col >> 8) & 3, cc = col & 127;
        f32x4 h0, h1; for (int e = 0; e < 4; ++e) { h0[e] = siluf_(a0[e]) * b0[e]; h1[e] = siluf_(a1[e]) * b1[e]; } store8bf(HID + (size_t)row * FF + ct * 128 + cc, h0, h1); } };
struct EpiSwiWT { bf16* HID;
    __device__ __forceinline__ void operator()(int row, int col, f32x4 a0, f32x4 a1, f32x4 b0, f32x4 b1) const { const int ct = (col >> 8) & 3, cc = col & 127;
        const __amdgpu_buffer_rsrc_t rs = __builtin_amdgcn_make_buffer_rsrc((void*)HID, 0, MAXSLOT * FF * 2, 0x00020000);
        f32x4 h0, h1; for (int e = 0; e < 4; ++e) { h0[e] = siluf_(a0[e]) * b0[e]; h1[e] = siluf_(a1[e]) * b1[e]; }
        u32x4 w; w.x = pk2(h0[0], h0[1]); w.y = pk2(h0[2], h0[3]); w.z = pk2(h1[0], h1[1]); w.w = pk2(h1[2], h1[3]);
        __builtin_amdgcn_raw_buffer_store_b128(w, rs, (unsigned)((row * FF + ct * 128 + cc) * 2), 0, 16); } };
struct EpiDown { const int* S2T; const float* TOKW; bf16* Y;
    __device__ __forceinline__ void operator()(int row, int col, f32x4 a0, f32x4 a1, f32x4 b0, f32x4 b1) const { const u32x2 sw = *(const u32x2*)(S2T + 2 * row); const int st = (int)sw.x; if (st < 0) return; const float w = __uint_as_float(sw.y); const int cc = col & 1023;
        store8bf(Y + (size_t)st * D + cc, w * a0, w * a1); store8bf(Y + (size_t)st * D + cc + 128, w * b0, w * b1); } };

struct MoeSched { int ts[17]; int G, c, NU, LA;
    __device__ __forceinline__ void a_ready(const Unit&) const {}
    __device__ __forceinline__ void done(const Unit&) const {}
    __device__ __forceinline__ void init(const unsigned* cnt, int G_, int c_) { G = G_; c = c_; int s = 0;
#pragma unroll
        for (int e = 0; e < 16; ++e) { ts[e] = s; s += ((int)cnt[e] + 255) >> 8; } ts[16] = s; NU = 4 * s; LA = ((NU / G) * G) & ~3; }
    __device__ __forceinline__ void unit_of(int L, Unit& u) const { const int rt = L >> 2, ct = L & 3; int e = 0;
#pragma unroll
        for (int j = 1; j < 16; ++j) e += (rt >= ts[j]) ? 1 : 0;
        u.pm = rt; u.pn = e * 4 + ct; }
    __device__ __forceinline__ bool next(int i, Unit& u) const { const int L = i * G + c; if (L >= NU) return false; unit_of(L, u); return true; } };
struct MoeSchedA : MoeSched {
    __device__ __forceinline__ bool next(int i, Unit& u) const { const int L = i * G + c; if (L >= LA) return false; unit_of(L, u); return true; } };
struct MoeSchedT : MoeSched { unsigned* rdy;
    __device__ __forceinline__ bool next(int i, Unit& u) const { const int L = LA + i * G + c; if (L >= NU) return false; unit_of(L, u); return true; }
    __device__ __forceinline__ void done(const Unit& u) const {
        asm volatile("s_waitcnt vmcnt(0)" ::: "memory");
        if (__builtin_amdgcn_mbcnt_hi(~0u, __builtin_amdgcn_mbcnt_lo(~0u, 0u)) == 0u) (void)__hip_atomic_fetch_add(rdy + 64 * u.pm, 1u, __ATOMIC_RELAXED, __HIP_MEMORY_SCOPE_AGENT); } };
struct MoeSchedB : MoeSched { unsigned* rdy; unsigned* tmo; int wave;
    __device__ __forceinline__ bool next(int i, Unit& u) const { const int NT = NU - LA; int q;
        if (c < NT) { if (i > 0) return false; q = G - NT + c; }
        else { const int p = c - NT; q = (i == 0) ? p : G + p + (i - 1) * (G - NT); }
        if (q >= NU) return false; unit_of(q, u); return true; }
    __device__ __forceinline__ void a_ready(const Unit& u) const {
        if (4 * u.pm < LA) return;
        if (wave == 0) { unsigned sp = 0u;
            while ((unsigned)__builtin_amdgcn_readfirstlane(__hip_atomic_load(rdy + 64 * u.pm, __ATOMIC_RELAXED, __HIP_MEMORY_SCOPE_AGENT)) < 32u) { __builtin_amdgcn_s_sleep(2);
                if ((++sp & 255u) == 0u) { if (__hip_atomic_load(tmo, __ATOMIC_RELAXED, __HIP_MEMORY_SCOPE_AGENT)) break; if (sp > (1u << 24)) { atomicAdd(tmo, 1u); break; } } }
            __builtin_amdgcn_fence(__ATOMIC_ACQUIRE, "agent");
            asm volatile("s_waitcnt vmcnt(0)" ::: "memory"); }
        asm volatile("" ::: "memory"); __builtin_amdgcn_s_barrier(); asm volatile("" ::: "memory"); } };

__device__ __forceinline__ void phase_prep_simple(ArgsR a, const Ctx& c, int l) {
    const bf16* ZR = (const bf16*)(a.ws + WS_ZR);
    const float* mu = a.in[I_MU] + l * RC; const float* w0 = a.in[I_W0] + l * W; const float* w2 = a.in[I_W2] + (size_t)l * 64 * W;
    const float* a0 = a.in[I_A0] + l * W; const float* a2 = a.in[I_A2] + (size_t)l * 64 * W; const float* g2 = a.in[I_G2] + (size_t)l * 128 * W;
    const float* k_k = a.in[I_KK] + l * W; const float* k_a = a.in[I_KA] + l * W;
    const float* vm0 = a.in[I_VM0]; const float* vm1 = a.in[I_VM1]; const float* vm2 = a.in[I_VM2];
    f16* R = (f16*)(a.ws + WS_R); f16* WM1 = (f16*)(a.ws + WS_WM1); f16* KP = (f16*)(a.ws + WS_KP); f16* AA = (f16*)(a.ws + WS_AA); f16* BB = (f16*)(a.ws + WS_BB); f16* V = (f16*)(a.ws + WS_V);
    bf16* G = (bf16*)(a.ws + WS_G); bf16* VF = (bf16*)(a.ws + WS_VF);
    const int lane = c.lane;
    for (int t = c.gw; t < T; t += c.ngw) {
        float z[28];
#pragma unroll
        for (int i = 0; i < 28; ++i) { const int col = lane + 64 * i; const float zc = bf2f(ZR[(size_t)t * RC + col]); const float zp = t > 0 ? bf2f(ZR[(size_t)(t - 1) * RC + col]) : 0.f; z[i] = zc + (zp - zc) * mu[col]; }
        const float tw = tanhf(z[24]), za = z[25], sg0 = sigmoidf_(z[26]), sg1 = sigmoidf_(z[27]);
        float wlo[8], alo[8], gg[8];
#pragma unroll
        for (int i = 0; i < 8; ++i) { wlo[i] = 0.f; alo[i] = 0.f; gg[i] = 0.f; }
        for (int j = 0; j < 64; ++j) { const float tj = __shfl(tw, j), aj = __shfl(za, j), s0 = __shfl(sg0, j), s1 = __shfl(sg1, j);
#pragma unroll
            for (int i = 0; i < 8; ++i) { const int n = lane + 64 * i; wlo[i] += tj * w2[j * W + n]; alo[i] += aj * a2[j * W + n]; gg[i] += s0 * g2[j * W + n] + s1 * g2[(64 + j) * W + n]; } }
        float vv[8];
#pragma unroll
        for (int i = 0; i < 8; ++i) vv[i] = z[16 + i];
        if (l == 0) {
#pragma unroll
            for (int i = 0; i < 8; ++i) VF[(size_t)t * W + lane + 64 * i] = f2bf(vv[i]);
        } else {
            float vmid = 0.f;
#pragma unroll
            for (int i = 0; i < 8; ++i)
                for (int j = 0; j < 64; ++j) { const float vc = __shfl(vv[i], j); vmid += vc * vm1[(size_t)(64 * i + j) * 32 + (lane & 31)]; }
            float vg[8];
#pragma unroll
            for (int i = 0; i < 8; ++i) vg[i] = 0.f;
            for (int m = 0; m < 32; ++m) { const float vmm = __shfl(vmid, m);
#pragma unroll
                for (int i = 0; i < 8; ++i) vg[i] += vmm * vm2[m * W + lane + 64 * i]; }
#pragma unroll
            for (int i = 0; i < 8; ++i) { const int n = lane + 64 * i; const float vf = bf2f(VF[(size_t)t * W + n]); vv[i] = vv[i] + (vf - vv[i]) * sigmoidf_(vm0[n] + vg[i]); }
        }
#pragma unroll
        for (int i = 0; i < 8; ++i) {
            const int n = lane + 64 * i; const size_t o = (size_t)t * W + n;
            const float x = w0[n] + wlo[i]; const float wl = -softplusf_(-x) - 0.5f; const float dm1 = expm1f(-__expf(wl));
            const float av = sigmoidf_(a0[n] + alo[i]);
            const float kraw = z[8 + i];
            float kk = kraw * k_k[n]; const float nrm = sqrtf(wave_sum(kk * kk)); kk = kk / fmaxf(nrm, 1e-12f);
            const float kp = kraw * (1.0f + (av - 1.0f) * k_a[n]);
            R[o] = (f16)z[i]; WM1[o] = (f16)dm1; KP[o] = (f16)kp; AA[o] = (f16)(-kk); BB[o] = (f16)(kk * av); V[o] = (f16)vv[i]; G[o] = f2bf(gg[i]);
        }
    }
}

__device__ __forceinline__ void phase_sg_simple(ArgsR a, const Ctx& c, int l) {
    const bf16* ZS = (const bf16*)(a.ws + WS_ZS); bf16* YB = (bf16*)(a.ws + WS_YB);
    const float* lng = a.in[I_SGG] + l * W; const float* lnb = a.in[I_SGB] + l * W;
    float* vn = (float*)c.lds;
    float* st = vn + 128 * 64;
    for (int uidx = blockIdx.x; uidx < 128 * 8; uidx += gridDim.x) {
        const int ch = uidx >> 3, g = uidx & 7; const int tok0 = ch * 128;
        for (int i = 0; i < 16; ++i) { const int s = c.wave * 16 + i; const bf16* p = ZS + (size_t)(tok0 + s) * 1024 + 512 + c.lane * 8;
            const f32x4 x0 = load4bf(p), x1 = load4bf(p + 4);
            float sm = (x0[0] + x0[1]) + (x0[2] + x0[3]) + (x1[0] + x1[1]) + (x1[2] + x1[3]); const float mean = wave_sum(sm) * (1.f / 512.f);
            float q = 0.f; for (int e = 0; e < 4; ++e) { const float d0 = x0[e] - mean, d1 = x1[e] - mean; q += d0 * d0 + d1 * d1; }
            const float rstd = __builtin_amdgcn_rsqf(wave_sum(q) * (1.f / 512.f) + LN_EPS);
            if (c.lane == 0) { st[2 * s] = mean; st[2 * s + 1] = rstd; } }
        __syncthreads();
        for (int i = c.tid; i < 128 * 64; i += NTHREADS) { const int s = i >> 6, d = i & 63; const float x = bf2f(ZS[(size_t)(tok0 + s) * 1024 + 512 + g * 64 + d]);
            vn[i] = (x - st[2 * s]) * st[2 * s + 1] * lng[g * 64 + d] + lnb[g * 64 + d]; }
        __syncthreads();
        const int d = c.tid & 63, tq = c.tid >> 6;
        const float* Wg = a.in[I_WS] + (size_t)(l * 8 + g) * 128 * 128; const float* bs = a.in[I_BS] + (size_t)(l * 8 + g) * 128;
        for (int i = 0; i < 16; ++i) { const int t = tq + 8 * i; float acc = 0.f;
            for (int s = 0; s <= t; ++s) acc += Wg[t * 128 + s] * vn[s * 64 + d];
            const float u = bf2f(ZS[(size_t)(tok0 + t) * 1024 + g * 64 + d]);
            YB[(size_t)(tok0 + t) * W + g * 64 + d] = f2bf(u * (acc + bs[t])); }
        __syncthreads();
    }
}

#define LAS3 __attribute__((address_space(3)))
typedef short bf16x8 __attribute__((ext_vector_type(8)));
template <int MT, int NT, int KS, bool SWAP = false>
__device__ __forceinline__ void mma_lds_glob(const unsigned char* lds_base, int a_off_bytes, int lda, const bf16* Bt, int ldb, int n0, int lane, f32x4 (&acc)[MT][NT]) {
    const int fr = lane & 15, fq = lane >> 4;
    const LAS3 unsigned char* Ab = (const LAS3 unsigned char*)lds_base + a_off_bytes;
    int boff = (n0 + fr) * ldb + 8 * fq; asm volatile("" : "+v"(boff));
#pragma unroll
    for (int ks = 0; ks < KS; ++ks) {
        bf16x8 b[NT];
#pragma unroll
        for (int n = 0; n < NT; ++n) b[n] = *(const bf16x8*)(Bt + boff + 16 * n * ldb + 32 * ks);
#pragma unroll
        for (int m = 0; m < MT; ++m) { const bf16x8 av = *(const LAS3 bf16x8*)(Ab + ((16 * m + fr) * lda + 32 * ks + 8 * fq) * 2);
#pragma unroll
            for (int n = 0; n < NT; ++n) acc[m][n] = SWAP ? __builtin_amdgcn_mfma_f32_16x16x32_bf16(b[n], av, acc[m][n], 0, 0, 0) : __builtin_amdgcn_mfma_f32_16x16x32_bf16(av, b[n], acc[m][n], 0, 0, 0); }
    }
}
__device__ __forceinline__ void zshift8(const bf16* ZR, int t, int col, const float* mu, float (&o)[8]) {
    const u32x4 zc = *(const u32x4*)(ZR + (size_t)t * RC + col);
    u32x4 zp = {0u, 0u, 0u, 0u}; if (t > 0) zp = *(const u32x4*)(ZR + (size_t)(t - 1) * RC + col);
    const f32x4 m0 = *(const f32x4*)(mu + col), m1 = *(const f32x4*)(mu + col + 4);
#pragma unroll
    for (int e = 0; e < 4; ++e) { const float c0 = __uint_as_float(zc[e] << 16), c1 = __uint_as_float(zc[e] & 0xffff0000u), p0 = __uint_as_float(zp[e] << 16), p1 = __uint_as_float(zp[e] & 0xffff0000u);
        const float mu0 = (2 * e < 4) ? m0[(2 * e) & 3] : m1[(2 * e) & 3], mu1 = (2 * e + 1 < 4) ? m0[(2 * e + 1) & 3] : m1[(2 * e + 1) & 3];
        o[2 * e] = c0 + (p0 - c0) * mu0; o[2 * e + 1] = c1 + (p1 - c1) * mu1; }
}
typedef _Float16 f16x8 __attribute__((ext_vector_type(8)));
typedef _Float16 f16x4 __attribute__((ext_vector_type(4)));
__device__ __forceinline__ void store8f16(f16* p, const float (&v)[8]) { f16x8 h;
#pragma unroll
    for (int e = 0; e < 8; ++e) h[e] = (f16)v[e];
    *(f16x8*)p = h; }
__device__ __forceinline__ u32x4 pack8bf(const float (&v)[8]) { u32x4 w; w.x = pk2(v[0], v[1]); w.y = pk2(v[2], v[3]); w.z = pk2(v[4], v[5]); w.w = pk2(v[6], v[7]); return w; }


constexpr int PB_LD = 520;
constexpr int PB_BUF = 0, PB_AOP = 64 * PB_LD * 2, PB_VMID = 2 * 64 * PB_LD * 2, PB_LA_LD = 264, PB_VM_LD = 40;
__device__ __forceinline__ void phase_prep_fast(ArgsR a, const Ctx& c, int l) {
    const bf16* ZR = (const bf16*)(a.ws + WS_ZR);
    const float* mu = a.in[I_MU] + l * RC; const float* w0 = a.in[I_W0] + l * W; const float* a0 = a.in[I_A0] + l * W;
    const float* k_k = a.in[I_KK] + l * W; const float* k_a = a.in[I_KA] + l * W; const float* vm0 = a.in[I_VM0];
    f16* R = (f16*)(a.ws + WS_R); f16* WM1 = (f16*)(a.ws + WS_WM1); f16* KP = (f16*)(a.ws + WS_KP); f16* AA = (f16*)(a.ws + WS_AA); f16* BB = (f16*)(a.ws + WS_BB); f16* V = (f16*)(a.ws + WS_V);
    bf16* G = (bf16*)(a.ws + WS_G); bf16* VF = (bf16*)(a.ws + WS_VF);
    const unsigned char* lo = a.ws + WS_LORA + (size_t)l * LO_STRIDE;
    const bf16* W2T = (const bf16*)(lo + LO_W2T); const bf16* A2T = (const bf16*)(lo + LO_A2T); const bf16* G2T = (const bf16*)(lo + LO_G2T);
    const bf16* VM1T = (const bf16*)(lo + LO_VM1T); const bf16* VM2T = (const bf16*)(lo + LO_VM2T);
    LAS3 unsigned char* L = (LAS3 unsigned char*)c.lds;
    const int tid = c.tid, lane = c.lane, wv = c.wave, fr = lane & 15, fq = lane >> 4;
    const int row = tid >> 3, sub_ = tid & 7;
    for (int u = blockIdx.x; u < T / 64; u += gridDim.x) {
        int sub = sub_; asm volatile("" : "+v"(sub));
        const int t0 = u * 64, t = t0 + row;
        if (l == 0) {
#pragma unroll 4
            for (int p = 0; p < 8; ++p) { const int col = p * 64 + sub * 8; float z[8]; zshift8(ZR, t, 1024 + col, mu, z);
                store8f16(V + (size_t)t * W + col, z); *(u32x4*)(VF + (size_t)t * W + col) = pack8bf(z); }
        } else {
#pragma unroll 4
            for (int p = 0; p < 8; ++p) { const int col = p * 64 + sub * 8; float z[8]; zshift8(ZR, t, 1024 + col, mu, z);
                *(LAS3 u32x4*)(L + PB_AOP + (row * PB_LD + col) * 2) = pack8bf(z); }
            __syncthreads();
            { f32x4 acc[1][1]; acc[0][0] = (f32x4){0.f, 0.f, 0.f, 0.f}; const int m = wv >> 1, n = wv & 1;
              mma_lds_glob<1, 1, 16>(c.lds, PB_AOP + 16 * m * PB_LD * 2, PB_LD, VM1T, W, 16 * n, lane, acc);
#pragma unroll
              for (int i = 0; i < 4; ++i) *(LAS3 bf16*)(L + PB_VMID + ((16 * m + 4 * fq + i) * PB_VM_LD + 16 * n + fr) * 2) = f2bf(acc[0][0][i]); }
            __syncthreads();
            { f32x4 acc[4][4];
#pragma unroll
              for (int m = 0; m < 4; ++m)
#pragma unroll
                  for (int n = 0; n < 4; ++n) acc[m][n] = (f32x4){0.f, 0.f, 0.f, 0.f};
              mma_lds_glob<4, 4, 1, true>(c.lds, PB_VMID, PB_VM_LD, VM2T, 32, 64 * wv, lane, acc);
#pragma unroll
              for (int m = 0; m < 4; ++m)
#pragma unroll
                  for (int n = 0; n < 4; ++n) { const int col = 64 * wv + 16 * n + 4 * fq; const f32x4 vb = *(const f32x4*)(vm0 + col); f16x4 hv;
#pragma unroll
                      for (int i = 0; i < 4; ++i) hv[i] = (f16)sigmoidf_(vb[i] + acc[m][n][i]);
                      *(LAS3 f16x4*)(L + PB_BUF + ((16 * m + fr) * PB_LD + col) * 2) = hv; } }
            __syncthreads();
#pragma unroll 4
            for (int p = 0; p < 8; ++p) { const int col = p * 64 + sub * 8;
                const u32x4 vz = *(const LAS3 u32x4*)(L + PB_AOP + (row * PB_LD + col) * 2); const f16x8 gt = *(const LAS3 f16x8*)(L + PB_BUF + (row * PB_LD + col) * 2);
                const u32x4 vfw = *(const u32x4*)(VF + (size_t)t * W + col); float o[8];
#pragma unroll
                for (int e = 0; e < 4; ++e) { const float v0 = __uint_as_float(vz[e] << 16), v1 = __uint_as_float(vz[e] & 0xffff0000u), f0 = __uint_as_float(vfw[e] << 16), f1 = __uint_as_float(vfw[e] & 0xffff0000u);
                    o[2 * e] = v0 + (f0 - v0) * (float)gt[2 * e]; o[2 * e + 1] = v1 + (f1 - v1) * (float)gt[2 * e + 1]; }
                store8f16(V + (size_t)t * W + col, o); }
            __syncthreads();
        }
#pragma unroll 4
        for (int p = 0; p < 4; ++p) { const int cc = sub * 32 + p * 8; float z[8]; zshift8(ZR, t, 1536 + cc, mu, z);
#pragma unroll
            for (int e = 0; e < 8; ++e) z[e] = cc < 64 ? (1.0f - 2.0f * __builtin_amdgcn_rcpf(1.0f + __expf(2.0f * z[e]))) : (cc < 128 ? z[e] : sigmoidf_(z[e]));
            *(LAS3 u32x4*)(L + PB_AOP + (row * PB_LA_LD + cc) * 2) = pack8bf(z); }
        __syncthreads();
        { f32x4 acc[4][4];
#pragma unroll
          for (int m = 0; m < 4; ++m)
#pragma unroll
              for (int n = 0; n < 4; ++n) acc[m][n] = (f32x4){0.f, 0.f, 0.f, 0.f};
          mma_lds_glob<4, 4, 2, true>(c.lds, PB_AOP + 64 * 2, PB_LA_LD, A2T, 64, 64 * wv, lane, acc);
#pragma unroll
          for (int m = 0; m < 4; ++m)
#pragma unroll
              for (int n = 0; n < 4; ++n) { const int col = 64 * wv + 16 * n + 4 * fq; const f32x4 ab = *(const f32x4*)(a0 + col); f16x4 hv;
#pragma unroll
                  for (int i = 0; i < 4; ++i) hv[i] = (f16)sigmoidf_(ab[i] + acc[m][n][i]);
                  *(LAS3 f16x4*)(L + PB_BUF + ((16 * m + fr) * PB_LD + col) * 2) = hv; } }
        __syncthreads();
#pragma unroll 4
        for (int p = 0; p < 8; ++p) { const int col = p * 64 + sub * 8; const size_t o = (size_t)t * W + col;
            float z[8]; zshift8(ZR, t, col, mu, z); store8f16(R + o, z);
            float kz[8]; zshift8(ZR, t, 512 + col, mu, kz);
            const f16x8 av = *(const LAS3 f16x8*)(L + PB_BUF + (row * PB_LD + col) * 2);
            const f32x4 kk0 = *(const f32x4*)(k_k + col), kk1 = *(const f32x4*)(k_k + col + 4), ka0 = *(const f32x4*)(k_a + col), ka1 = *(const f32x4*)(k_a + col + 4);
            float kk[8], kp[8], bb[8]; float ss = 0.f;
#pragma unroll
            for (int e = 0; e < 8; ++e) { const float kkw = e < 4 ? kk0[e & 3] : kk1[e & 3], kaw = e < 4 ? ka0[e & 3] : ka1[e & 3]; kk[e] = kz[e] * kkw; ss += kk[e] * kk[e]; kp[e] = kz[e] * (1.0f + ((float)av[e] - 1.0f) * kaw); }
            ss += __shfl_xor(ss, 1); ss += __shfl_xor(ss, 2); ss += __shfl_xor(ss, 4);
            const float inv = fminf(__builtin_amdgcn_rsqf(ss), 1e12f);
#pragma unroll
            for (int e = 0; e < 8; ++e) { kk[e] *= inv; bb[e] = kk[e] * (float)av[e]; kk[e] = -kk[e]; }
            store8f16(KP + o, kp); store8f16(AA + o, kk); store8f16(BB + o, bb); }
        __syncthreads();
        { f32x4 acc[4][4];
#pragma unroll
          for (int m = 0; m < 4; ++m)
#pragma unroll
              for (int n = 0; n < 4; ++n) acc[m][n] = (f32x4){0.f, 0.f, 0.f, 0.f};
          mma_lds_glob<4, 4, 2, true>(c.lds, PB_AOP, PB_LA_LD, W2T, 64, 64 * wv, lane, acc);
#pragma unroll
          for (int m = 0; m < 4; ++m)
#pragma unroll
              for (int n = 0; n < 4; ++n) { const int col = 64 * wv + 16 * n + 4 * fq; const f32x4 wb = *(const f32x4*)(w0 + col); f16x4 hv;
#pragma unroll
                  for (int i = 0; i < 4; ++i) { const float x = wb[i] + acc[m][n][i]; const float wl = -(fmaxf(-x, 0.f) + __logf(1.0f + __expf(-fabsf(x)))) - 0.5f;
                      hv[i] = (f16)(__expf(-__expf(wl)) - 1.0f); }
                  *(LAS3 f16x4*)(L + PB_BUF + ((16 * m + fr) * PB_LD + col) * 2) = hv; } }
        __syncthreads();
#pragma unroll 4
        for (int p = 0; p < 8; ++p) { const int col = p * 64 + sub * 8; *(u32x4*)(WM1 + (size_t)t * W + col) = *(const LAS3 u32x4*)(L + PB_BUF + (row * PB_LD + col) * 2); }
        __syncthreads();
        { f32x4 acc[4][4];
#pragma unroll
          for (int m = 0; m < 4; ++m)
#pragma unroll
              for (int n = 0; n < 4; ++n) acc[m][n] = (f32x4){0.f, 0.f, 0.f, 0.f};
          mma_lds_glob<4, 4, 4, true>(c.lds, PB_AOP + 128 * 2, PB_LA_LD, G2T, 128, 64 * wv, lane, acc);
#pragma unroll
          for (int m = 0; m < 4; ++m)
#pragma unroll
              for (int n = 0; n < 4; ++n) { const int col = 64 * wv + 16 * n + 4 * fq; u32x2 w; w.x = pk2(acc[m][n][0], acc[m][n][1]); w.y = pk2(acc[m][n][2], acc[m][n][3]);
                  *(LAS3 u32x2*)(L + PB_BUF + ((16 * m + fr) * PB_LD + col) * 2) = w; } }
        __syncthreads();
#pragma unroll 4
        for (int p = 0; p < 8; ++p) { const int col = p * 64 + sub * 8; *(u32x4*)(G + (size_t)t * W + col) = *(const LAS3 u32x4*)(L + PB_BUF + (row * PB_LD + col) * 2); }
        __syncthreads();
    }
}

constexpr int SG_LD = 136;
constexpr int SG_VT = 0, SG_ST = 256 * SG_LD * 2;
__device__ __forceinline__ void phase_sg_fast(ArgsR a, const Ctx& c, int l) {
    const bf16* ZS = (const bf16*)(a.ws + WS_ZS); bf16* YB = (bf16*)(a.ws + WS_YB);
    const float* lng = a.in[I_SGG] + l * W; const float* lnb = a.in[I_SGB] + l * W;
    LAS3 unsigned char* L = (LAS3 unsigned char*)c.lds;
    LAS3 float* st = (LAS3 float*)(L + SG_ST);
    const int tid = c.tid, lane = c.lane, wv = c.wave, fr = lane & 15, fq = lane >> 4;
    for (int u = blockIdx.x; u < 256; u += gridDim.x) {
        const int ch = u >> 1, hf = u & 1, tok0 = ch * 128;
        { u32x4 raw[16];
#pragma unroll
          for (int i = 0; i < 16; ++i) raw[i] = *(const u32x4*)(ZS + (size_t)(tok0 + wv * 16 + i) * 1024 + 512 + lane * 8);
#pragma unroll
          for (int i = 0; i < 16; ++i) { const int sidx = wv * 16 + i; float x[8];
#pragma unroll
              for (int e = 0; e < 4; ++e) { x[2 * e] = __uint_as_float(raw[i][e] << 16); x[2 * e + 1] = __uint_as_float(raw[i][e] & 0xffff0000u); }
              const float sm = ((x[0] + x[1]) + (x[2] + x[3])) + ((x[4] + x[5]) + (x[6] + x[7])); const float mean = wave_sum(sm) * (1.f / 512.f);
              float q = 0.f;
#pragma unroll
              for (int e = 0; e < 8; ++e) { const float d0 = x[e] - mean; q += d0 * d0; }
              const float rstd = __builtin_amdgcn_rsqf(wave_sum(q) * (1.f / 512.f) + LN_EPS);
              if (lane == 0) { st[2 * sidx] = mean; st[2 * sidx + 1] = rstd; } } }
        __syncthreads();
        { const int sidx = tid >> 2, q4 = tid & 3; const float mean = st[2 * sidx], rstd = st[2 * sidx + 1];
#pragma unroll
          for (int p = 0; p < 8; ++p) { const int cl = q4 * 64 + p * 8; const int cg = hf * 256 + cl;
              const bf16* src = ZS + (size_t)(tok0 + sidx) * 1024 + 512 + cg; const f32x4 x0 = load4bf(src), x1 = load4bf(src + 4);
              const f32x4 g0 = *(const f32x4*)(lng + cg), g1 = *(const f32x4*)(lng + cg + 4), b0 = *(const f32x4*)(lnb + cg), b1 = *(const f32x4*)(lnb + cg + 4);
#pragma unroll
              for (int e = 0; e < 8; ++e) { const float x = e < 4 ? x0[e & 3] : x1[e & 3], gg = e < 4 ? g0[e & 3] : g1[e & 3], bb = e < 4 ? b0[e & 3] : b1[e & 3];
                  *(LAS3 bf16*)(L + SG_VT + ((cl + e) * SG_LD + sidx) * 2) = f2bf((x - mean) * rstd * gg + bb); } } }
        __syncthreads();
        const int gl = wv >> 1, dh = wv & 1, g = hf * 4 + gl;
        const float* Wg = a.in[I_WS] + (size_t)(l * 8 + g) * 128 * 128; const float* bs = a.in[I_BS] + (size_t)(l * 8 + g) * 128;
        f32x4 acc[8][2];
#pragma unroll
        for (int m = 0; m < 8; ++m) { acc[m][0] = (f32x4){0.f, 0.f, 0.f, 0.f}; acc[m][1] = (f32x4){0.f, 0.f, 0.f, 0.f}; }
#pragma unroll
        for (int ks = 0; ks < 4; ++ks) {
            bf16x8 b[2];
#pragma unroll
            for (int n = 0; n < 2; ++n) b[n] = *(const LAS3 bf16x8*)(L + SG_VT + ((gl * 64 + dh * 32 + 16 * n + fr) * SG_LD + 32 * ks + 8 * fq) * 2);
#pragma unroll
            for (int m = 0; m < 8; ++m) { if (32 * ks <= 16 * m + 15) {
                const int trow = 16 * m + fr, s0 = 32 * ks + 8 * fq;
                const f32x4 w0v = *(const f32x4*)(Wg + trow * 128 + s0), w1v = *(const f32x4*)(Wg + trow * 128 + s0 + 4);
                float wf[8];
#pragma unroll
                for (int e = 0; e < 8; ++e) { const float wval = e < 4 ? w0v[e & 3] : w1v[e & 3]; wf[e] = (s0 + e <= trow) ? wval : 0.f; }
                const u32x4 wp = pack8bf(wf); const bf16x8 av = __builtin_bit_cast(bf16x8, wp);
                acc[m][0] = __builtin_amdgcn_mfma_f32_16x16x32_bf16(b[0], av, acc[m][0], 0, 0, 0);
                acc[m][1] = __builtin_amdgcn_mfma_f32_16x16x32_bf16(b[1], av, acc[m][1], 0, 0, 0); } }
        }
#pragma unroll
        for (int m = 0; m < 8; ++m) { const int trow = 16 * m + fr; const float bsv = bs[trow];
#pragma unroll
            for (int n = 0; n < 2; ++n) { const int col = g * 64 + dh * 32 + 16 * n + 4 * fq; const f32x4 uu = load4bf(ZS + (size_t)(tok0 + trow) * 1024 + col);
                store4bf(YB + (size_t)(tok0 + trow) * W + col, uu * (acc[m][n] + bsv)); } }
        __syncthreads();
    }
}

__device__ __forceinline__ void phase_scan_simple(ArgsR a, const Ctx& c) {
    if (c.wave != 0 || blockIdx.x >= NH) return;
    const int h = blockIdx.x, lane = c.lane;
    const f16* R = (const f16*)(a.ws + WS_R); const f16* WM1 = (const f16*)(a.ws + WS_WM1); const f16* KP = (const f16*)(a.ws + WS_KP);
    const f16* AA = (const f16*)(a.ws + WS_AA); const f16* BB = (const f16*)(a.ws + WS_BB); const f16* V = (const f16*)(a.ws + WS_V);
    bf16* YSC = (bf16*)(a.ws + WS_YSC);
    float S[64];
#pragma unroll
    for (int j = 0; j < 64; ++j) S[j] = 0.f;
    for (int t = 0; t < T; ++t) {
        const size_t base = (size_t)t * W + h * 64;
        const float vv = (float)V[base + lane];
        float sa = 0.f;
#pragma unroll
        for (int j = 0; j < 64; ++j) sa += S[j] * (float)AA[base + j];
        float y = 0.f;
#pragma unroll
        for (int j = 0; j < 64; ++j) { float s = S[j]; s = s + s * (float)WM1[base + j]; s += sa * (float)BB[base + j]; s += vv * (float)KP[base + j]; S[j] = s; y += s * (float)R[base + j]; }
        YSC[base + lane] = f2bf(y);
    }
}

typedef unsigned u32x16 __attribute__((ext_vector_type(16)));
__device__ __forceinline__ void sload32(const void* p0, u32x16& a0, u32x16& a1) {
    asm volatile("s_load_dwordx16 %0, %2, 0x0 glc\n\ts_load_dwordx16 %1, %2, 0x40 glc\n\ts_waitcnt lgkmcnt(0)" : "=&s"(a0), "=&s"(a1) : "s"(p0) : "memory");
}
__device__ __forceinline__ void sload64(const void* p0, const void* p1, u32x16& a0, u32x16& a1, u32x16& b0, u32x16& b1) {
    asm volatile("s_load_dwordx16 %0, %4, 0x0 glc\n\ts_load_dwordx16 %1, %4, 0x40 glc\n\ts_load_dwordx16 %2, %5, 0x0 glc\n\ts_load_dwordx16 %3, %5, 0x40 glc\n\ts_waitcnt lgkmcnt(0)"
                 : "=&s"(a0), "=&s"(a1), "=&s"(b0), "=&s"(b1) : "s"(p0), "s"(p1) : "memory");
}
__device__ __forceinline__ float fmix_lo(unsigned sd, float x, float y) { float d; asm("v_fma_mix_f32 %0, %1, %2, %3 op_sel_hi:[1,0,0]" : "=v"(d) : "s"(sd), "v"(x), "v"(y)); return d; }
__device__ __forceinline__ float fmix_hi(unsigned sd, float x, float y) { float d; asm("v_fma_mix_f32 %0, %1, %2, %3 op_sel:[1,0,0] op_sel_hi:[1,0,0]" : "=v"(d) : "s"(sd), "v"(x), "v"(y)); return d; }
constexpr int CL = 64, NCH = T / CL;
constexpr size_t ST_Q_OFF = (size_t)NH * NCH * 64 * 64;
constexpr size_t ST_S_OFF = (size_t)NH * NCH * 64 * 64;

__device__ __forceinline__ float vmix_lo(unsigned vd, float x, float y) { float d; asm("v_fma_mix_f32 %0, %1, %2, %3 op_sel_hi:[1,0,0]" : "=v"(d) : "v"(vd), "v"(x), "v"(y)); return d; }
__device__ __forceinline__ float vmix_hi(unsigned vd, float x, float y) { float d; asm("v_fma_mix_f32 %0, %1, %2, %3 op_sel:[1,0,0] op_sel_hi:[1,0,0]" : "=v"(d) : "v"(vd), "v"(x), "v"(y)); return d; }
template <int N> __device__ __forceinline__ void fmac_bc(float& acc, float vec, float x) { asm("v_fmac_f32_dpp %0, %1, %2 row_newbcast:%3 row_mask:0xf bank_mask:0xf" : "+v"(acc) : "v"(vec), "v"(x), "n"(N)); }
template <int N> __device__ __forceinline__ float mul_bc(float vec, float x) { float d; asm("v_mul_f32_dpp %0, %1, %2 row_newbcast:%3 row_mask:0xf bank_mask:0xf" : "=v"(d) : "v"(vec), "v"(x), "n"(N)); return d; }
struct SVec { float v[4]; };
__device__ __forceinline__ f16x4 sv_read(const LAS3 unsigned char* p, int lane) { return *(const LAS3 f16x4*)(p + (lane & 15) * 8); }
__device__ __forceinline__ void sv_cvt(SVec& o, f16x4 h) { o.v[0] = (float)h[0]; o.v[1] = (float)h[1]; o.v[2] = (float)h[2]; o.v[3] = (float)h[3]; }
__device__ __forceinline__ void sv_cvt1p(SVec& o, f16x4 h) { o.v[0] = 1.0f + (float)h[0]; o.v[1] = 1.0f + (float)h[1]; o.v[2] = 1.0f + (float)h[2]; o.v[3] = 1.0f + (float)h[3]; }
template <int J> __device__ __forceinline__ void sc_dot(float (&d)[4], const SVec& A, const float (&X)[64]) { fmac_bc<(J >> 2)>(d[J & 3], A.v[J & 3], X[J]); if constexpr (J + 1 < 64) sc_dot<J + 1>(d, A, X); }
template <int J> __device__ __forceinline__ void sc_upd3(float (&S)[64], float (&y)[4], const SVec& Wv, const SVec& Bv, const SVec& Kv, const SVec& Rv, float sa, float vv) {
    float sj = mul_bc<(J >> 2)>(Wv.v[J & 3], S[J]); fmac_bc<(J >> 2)>(sj, Bv.v[J & 3], sa); fmac_bc<(J >> 2)>(sj, Kv.v[J & 3], vv); S[J] = sj; fmac_bc<(J >> 2)>(y[J & 3], Rv.v[J & 3], sj);
    if constexpr (J + 1 < 64) sc_upd3<J + 1>(S, y, Wv, Bv, Kv, Rv, sa, vv); }
template <int J> __device__ __forceinline__ void sc_upd1(float (&Q)[64], float (&P)[64], const SVec& Wv, const SVec& Bv, const SVec& Kv, float saq, float sap, float vv) {
    float qj = mul_bc<(J >> 2)>(Wv.v[J & 3], Q[J]); fmac_bc<(J >> 2)>(qj, Bv.v[J & 3], saq); fmac_bc<(J >> 2)>(qj, Kv.v[J & 3], vv); Q[J] = qj;
    float pj = mul_bc<(J >> 2)>(Wv.v[J & 3], P[J]); fmac_bc<(J >> 2)>(pj, Bv.v[J & 3], sap); P[J] = pj;
    if constexpr (J + 1 < 64) sc_upd1<J + 1>(Q, P, Wv, Bv, Kv, saq, sap, vv); }
constexpr int SCB = 8;
constexpr int SC_NS = 7, SC_BUF = SC_NS * 1024, SC_WAVE = 2 * SC_BUF;
__device__ __forceinline__ void sc_dma(const f16* X, size_t eoff, LAS3 unsigned char* dst) {
    __builtin_amdgcn_global_load_lds((const unsigned*)(X + eoff), (LAS3 unsigned*)dst, 16, 0, 0);
}

__device__ __forceinline__ void phase_scan1(ArgsR a, const Ctx& c) {
    const f16* WM1 = (const f16*)(a.ws + WS_WM1); const f16* KP = (const f16*)(a.ws + WS_KP);
    const f16* AA = (const f16*)(a.ws + WS_AA); const f16* BB = (const f16*)(a.ws + WS_BB); const f16* V = (const f16*)(a.ws + WS_V);
    float* ST = (float*)(a.ws + WS_ST);
    const int lane = c.lane;
    LAS3 unsigned char* ring = (LAS3 unsigned char*)c.lds + c.wave * SC_WAVE;
    for (int item = c.gw; item < NH * NCH; item += c.ngw) {
        const int h = __builtin_amdgcn_readfirstlane(item / NCH), ch = __builtin_amdgcn_readfirstlane(item % NCH);
        float Q[64], P[64];
        int ln_ = lane; asm volatile("" : "+v"(ln_));
#pragma unroll
        for (int j = 0; j < 64; ++j) { Q[j] = 0.f; P[j] = (j == ln_) ? 1.f : 0.f; }
        const size_t lane_off = (size_t)(lane >> 3) * W + h * 64 + (lane & 7) * 8;
        { const size_t e0 = (size_t)(ch * CL) * W + lane_off;
          sc_dma(AA, e0, ring); sc_dma(WM1, e0, ring + 1024); sc_dma(BB, e0, ring + 2048); sc_dma(KP, e0, ring + 3072); sc_dma(V, e0, ring + 4096); }
#pragma unroll 1
        for (int blk = 0; blk < CL / SCB; ++blk) {
            LAS3 unsigned char* buf = ring + (blk & 1) * SC_BUF;
            if (blk + 1 < CL / SCB) { LAS3 unsigned char* nb = ring + ((blk + 1) & 1) * SC_BUF; const size_t e0 = (size_t)(ch * CL + (blk + 1) * SCB) * W + lane_off;
                sc_dma(AA, e0, nb); sc_dma(WM1, e0, nb + 1024); sc_dma(BB, e0, nb + 2048); sc_dma(KP, e0, nb + 3072); sc_dma(V, e0, nb + 4096);
                asm volatile("s_waitcnt vmcnt(5)" ::: "memory"); }
            else asm volatile("s_waitcnt vmcnt(0)" ::: "memory");
            SVec A, Wv, Bv, Kv;
            sv_cvt(A, sv_read(buf, lane)); sv_cvt1p(Wv, sv_read(buf + 1024, lane)); sv_cvt(Bv, sv_read(buf + 2048, lane)); sv_cvt(Kv, sv_read(buf + 3072, lane));
            float vv = (float)*(const LAS3 f16*)(buf + 4096 + lane * 2);
#pragma unroll 1
            for (int st = 0; st < SCB; ++st) {
                const LAS3 unsigned char* sn = buf + ((st + 1 < SCB) ? st + 1 : st) * 128;
                const f16x4 ha = sv_read(sn, lane), hw = sv_read(sn + 1024, lane), hb = sv_read(sn + 2048, lane), hk = sv_read(sn + 3072, lane);
                const f16 hv = *(const LAS3 f16*)(sn + 4096 + lane * 2);
                float dq[4] = {0.f, 0.f, 0.f, 0.f}, dp[4] = {0.f, 0.f, 0.f, 0.f};
                sc_dot<0>(dq, A, Q); sc_dot<0>(dp, A, P);
                const float saq = (dq[0] + dq[1]) + (dq[2] + dq[3]), sap = (dp[0] + dp[1]) + (dp[2] + dp[3]);
                sc_upd1<0>(Q, P, Wv, Bv, Kv, saq, sap, vv);
                sv_cvt(A, ha); sv_cvt1p(Wv, hw); sv_cvt(Bv, hb); sv_cvt(Kv, hk); vv = (float)hv;
            }
        }
        float* Qp = ST + ST_Q_OFF + (size_t)(h * NCH + ch) * 4096 + lane;
        bf16* PTp = (bf16*)ST + (size_t)(h * NCH + ch) * 4096 + lane;
#pragma unroll
        for (int j = 0; j < 64; ++j) { PTp[j * 64] = f2bf(P[j]); Qp[j * 64] = Q[j]; }
    }
}
constexpr int GS = 16, NG = NCH / GS;
constexpr size_t ST_LP_OFF = (size_t)NH * NCH * 4096;
constexpr size_t ST_QB_OFF = (size_t)2 * NH * NCH * 4096;
constexpr size_t WS_SG = WS_LORA + 2 * MiB;
constexpr int HI_LD = 72, HI_BYTES = 64 * HI_LD * 2;
struct HFrag { bf16x8 b[2][2]; u32x2 q[2]; };
__device__ __forceinline__ f32x4 bf4cvt(u32x2 w) { f32x4 r; r[0] = __uint_as_float(w.x << 16); r[1] = __uint_as_float(w.x & 0xffff0000u); r[2] = __uint_as_float(w.y << 16); r[3] = __uint_as_float(w.y & 0xffff0000u); return r; }
__device__ __forceinline__ void hload(HFrag& f, const bf16* Bt, const bf16* QTc, int boff, int qtoff) {
#pragma unroll
    for (int ks = 0; ks < 2; ++ks)
#pragma unroll
        for (int n = 0; n < 2; ++n) f.b[ks][n] = *(const bf16x8*)(Bt + boff + 16 * n * 64 + 32 * ks);
#pragma unroll
    for (int n = 0; n < 2; ++n) f.q[n] = *(const u32x2*)(QTc + qtoff + 16 * n * 64);
}
__device__ __forceinline__ void hmma(const LAS3 unsigned char* img, const bf16x8 (&b)[2][2], f32x4 (&acc)[2], int m, int fr, int fq) {
#pragma unroll
    for (int ks = 0; ks < 2; ++ks) { const bf16x8 av = *(const LAS3 bf16x8*)(img + ((16 * m + fr) * HI_LD + 32 * ks + 8 * fq) * 2);
#pragma unroll
        for (int n = 0; n < 2; ++n) acc[n] = __builtin_amdgcn_mfma_f32_16x16x32_bf16(av, b[ks][n], acc[n], 0, 0, 0); }
}
__device__ __forceinline__ void himg_store(LAS3 unsigned char* img, const f32x4 (&acc)[2], int m, int n0, int fr, int fq) {
#pragma unroll
    for (int n = 0; n < 2; ++n)
#pragma unroll
        for (int i = 0; i < 4; ++i) *(LAS3 bf16*)(img + ((16 * m + 4 * fq + i) * HI_LD + n0 + 16 * n + fr) * 2) = f2bf(acc[n][i]);
}
#define HBAR() do { asm volatile("s_waitcnt lgkmcnt(0)" ::: "memory"); __builtin_amdgcn_s_barrier(); asm volatile("" ::: "memory"); } while (0)

__device__ __forceinline__ void sc2a_step(const HFrag& f, bf16* LpTc, bf16* QTc, const LAS3 unsigned char* ip, LAS3 unsigned char* ipn, const LAS3 unsigned char* iq, LAS3 unsigned char* iqn, int m, int n0, int fr, int fq, int qtoff) {
    f32x4 ap[2], aq[2];
#pragma unroll
    for (int n = 0; n < 2; ++n) { ap[n] = (f32x4){0.f, 0.f, 0.f, 0.f}; aq[n] = bf4cvt(f.q[n]); }
    hmma(ip, f.b, ap, m, fr, fq); hmma(iq, f.b, aq, m, fr, fq);
#pragma unroll
    for (int n = 0; n < 2; ++n) { u32x2 w; w.x = pk2(ap[n][0], ap[n][1]); w.y = pk2(ap[n][2], ap[n][3]);
        *(u32x2*)(LpTc + (n0 + 16 * n + fr) * 64 + 16 * m + 4 * fq) = w;
        store4bf(QTc + qtoff + 16 * n * 64, aq[n]); }
    himg_store(ipn, ap, m, n0, fr, fq); himg_store(iqn, aq, m, n0, fr, fq);
    HBAR();
}
__device__ __forceinline__ void phase_scan2a(ArgsR a, const Ctx& c) {
    const int lane = c.lane, wv = c.wave, fr = lane & 15, fq = lane >> 4, m = wv >> 1, n0 = 32 * (wv & 1);
    const int boff = (n0 + fr) * 64 + 8 * fq, qtoff = (n0 + fr) * 64 + 16 * m + 4 * fq;
    LAS3 unsigned char* L = (LAS3 unsigned char*)c.lds;
    for (int item = blockIdx.x; item < NH * NG; item += gridDim.x) {
        const size_t cb = (size_t)(item / NG) * NCH + (size_t)(item % NG) * GS;
        const bf16* PT = (const bf16*)(a.ws + WS_ST) + cb * 4096; bf16* LP = (bf16*)(a.ws + WS_ST) + ST_LP_OFF + cb * 4096; bf16* QT = (bf16*)(a.ws + WS_ST) + ST_QB_OFF + cb * 4096;
        for (int i = c.tid; i < 4 * HI_BYTES / 4; i += NTHREADS) ((LAS3 unsigned*)L)[i] = 0u;
        __syncthreads();
        if (c.tid < 64) *(LAS3 bf16*)(L + (c.tid * HI_LD + c.tid) * 2) = (bf16)0x3F80;
        __syncthreads();
        HFrag f0, f1, f2, f3;
        hload(f0, PT, QT, boff, qtoff); hload(f1, PT + 4096, QT + 4096, boff, qtoff); hload(f2, PT + 2 * 4096, QT + 2 * 4096, boff, qtoff); hload(f3, PT + 3 * 4096, QT + 3 * 4096, boff, qtoff);
        LAS3 unsigned char* p0 = L; LAS3 unsigned char* p1 = L + HI_BYTES; LAS3 unsigned char* q0 = L + 2 * HI_BYTES; LAS3 unsigned char* q1 = L + 3 * HI_BYTES;
#pragma unroll 1
        for (int i = 0; i < GS; i += 4) {
            const int nx = (i + 4 < GS) ? i + 4 : i;
            sc2a_step(f0, LP + (size_t)(i + 0) * 4096, QT + (size_t)(i + 0) * 4096, p0, p1, q0, q1, m, n0, fr, fq, qtoff); hload(f0, PT + (size_t)(nx + 0) * 4096, QT + (size_t)(nx + 0) * 4096, boff, qtoff);
            sc2a_step(f1, LP + (size_t)(i + 1) * 4096, QT + (size_t)(i + 1) * 4096, p1, p0, q1, q0, m, n0, fr, fq, qtoff); hload(f1, PT + (size_t)(nx + 1) * 4096, QT + (size_t)(nx + 1) * 4096, boff, qtoff);
            sc2a_step(f2, LP + (size_t)(i + 2) * 4096, QT + (size_t)(i + 2) * 4096, p0, p1, q0, q1, m, n0, fr, fq, qtoff); hload(f2, PT + (size_t)(nx + 2) * 4096, QT + (size_t)(nx + 2) * 4096, boff, qtoff);
            sc2a_step(f3, LP + (size_t)(i + 3) * 4096, QT + (size_t)(i + 3) * 4096, p1, p0, q1, q0, m, n0, fr, fq, qtoff); hload(f3, PT + (size_t)(nx + 3) * 4096, QT + (size_t)(nx + 3) * 4096, boff, qtoff);
        }
        __syncthreads();
    }
}
__device__ __forceinline__ void phase_scan2b(ArgsR a, const Ctx& c) {
    if (blockIdx.x >= NH) return;
    const int h = blockIdx.x, lane = c.lane, wv = c.wave, fr = lane & 15, fq = lane >> 4, m = wv >> 1, n0 = 32 * (wv & 1);
    const int boff = (n0 + fr) * 64 + 8 * fq, qtoff = (n0 + fr) * 64 + 16 * m + 4 * fq;
    LAS3 unsigned char* L = (LAS3 unsigned char*)c.lds;
    const bf16* LP = (const bf16*)(a.ws + WS_ST) + ST_LP_OFF + (size_t)h * NCH * 4096; const bf16* QT = (const bf16*)(a.ws + WS_ST) + ST_QB_OFF + (size_t)h * NCH * 4096;
    bf16* SG = (bf16*)(a.ws + WS_SG) + (size_t)h * NG * 4096;
    for (int i = c.tid; i < 2 * HI_BYTES / 4; i += NTHREADS) ((LAS3 unsigned*)L)[i] = 0u;
    for (int i = c.tid; i < 4096 / 2; i += NTHREADS) ((LAS3 unsigned*)(L + 2 * HI_BYTES))[i] = 0u;
    __syncthreads();
    HFrag f0, f1, f2, f3;
#define SC2B_CH(g) ((size_t)((g) * GS + GS - 1) * 4096)
    hload(f0, LP + SC2B_CH(0), QT + SC2B_CH(0), boff, qtoff); hload(f1, LP + SC2B_CH(1), QT + SC2B_CH(1), boff, qtoff); hload(f2, LP + SC2B_CH(2), QT + SC2B_CH(2), boff, qtoff); hload(f3, LP + SC2B_CH(3), QT + SC2B_CH(3), boff, qtoff);
    LAS3 unsigned char* i0 = L; LAS3 unsigned char* i1 = L + HI_BYTES;
#define SC2B_STEP(f, g, ic, in) do { f32x4 acc[2] = {bf4cvt(f.q[0]), bf4cvt(f.q[1])}; hmma(ic, f.b, acc, m, fr, fq); LAS3 bf16* So = (LAS3 bf16*)(L + 2 * HI_BYTES) + (((g) + 1) & 7) * 4096; \
        _Pragma("unroll") for (int n = 0; n < 2; ++n) _Pragma("unroll") for (int i = 0; i < 4; ++i) So[(16 * m + 4 * fq + i) * 64 + n0 + 16 * n + fr] = f2bf(acc[n][i]); \
        himg_store(in, acc, m, n0, fr, fq); HBAR(); } while (0)
#pragma unroll 1
    for (int g = 0; g < NG; g += 4) {
        const int nx = (g + 4 < NG) ? g + 4 : g;
        SC2B_STEP(f0, g + 0, i0, i1); hload(f0, LP + SC2B_CH(nx + 0), QT + SC2B_CH(nx + 0), boff, qtoff);
        SC2B_STEP(f1, g + 1, i1, i0); hload(f1, LP + SC2B_CH(nx + 1), QT + SC2B_CH(nx + 1), boff, qtoff);
        SC2B_STEP(f2, g + 2, i0, i1); hload(f2, LP + SC2B_CH(nx + 2), QT + SC2B_CH(nx + 2), boff, qtoff);
        if ((g & 7) == 4) {
            for (int i = c.tid; i < 8 * 4096 / 8; i += NTHREADS) ((u32x4*)(SG + (size_t)(g >> 3) * 8 * 4096))[i] = ((const LAS3 u32x4*)(L + 2 * HI_BYTES))[i];
            HBAR(); }
        if (g + 3 < NG - 1) SC2B_STEP(f3, g + 3, i1, i0);
        hload(f3, LP + SC2B_CH(nx + 3), QT + SC2B_CH(nx + 3), boff, qtoff);
    }
#undef SC2B_STEP
#undef SC2B_CH
}
__device__ __forceinline__ void phase_scan2c(ArgsR a, const Ctx& c) {
    const int lane = c.lane, wv = c.wave, fr = lane & 15, fq = lane >> 4, m = wv >> 1, n0 = 32 * (wv & 1);
    const int boff = (n0 + fr) * 64 + 8 * fq, qtoff = (n0 + fr) * 64 + 16 * m + 4 * fq;
    LAS3 unsigned char* L = (LAS3 unsigned char*)c.lds;
    for (int item = blockIdx.x; item < NH * NG * 2; item += gridDim.x) {
        const int hg = item >> 1, hf = item & 1;
        const size_t cb = (size_t)(hg / NG) * NCH + (size_t)(hg % NG) * GS + hf * 8;
        const bf16* LP = (const bf16*)(a.ws + WS_ST) + ST_LP_OFF + cb * 4096; const bf16* QT = (const bf16*)(a.ws + WS_ST) + ST_QB_OFF + cb * 4096; bf16* SS = (bf16*)(a.ws + WS_ST) + cb * 4096;
        { const u32x4 v = *(const u32x4*)((const bf16*)(a.ws + WS_SG) + (size_t)hg * 4096 + c.tid * 8); *(LAS3 u32x4*)(L + ((c.tid >> 3) * HI_LD + (c.tid & 7) * 8) * 2) = v; }
        __syncthreads();
#pragma unroll 2
        for (int i = 0; i < 8; ++i) { HFrag f; hload(f, LP + (size_t)i * 4096, QT + (size_t)i * 4096, boff, qtoff);
            f32x4 acc[2] = {bf4cvt(f.q[0]), bf4cvt(f.q[1])}; hmma(L, f.b, acc, m, fr, fq); bf16* So = SS + (size_t)i * 4096;
#pragma unroll
            for (int n = 0; n < 2; ++n)
#pragma unroll
                for (int k = 0; k < 4; ++k) So[(16 * m + 4 * fq + k) * 64 + n0 + 16 * n + fr] = f2bf(acc[n][k]); }
        __syncthreads();
    }
}
constexpr int WI_LD = 72, WI_B = 64 * WI_LD * 2, WI_GAM = 9 * WI_B, WI_GL = 15 * WI_B;
constexpr size_t WS_GM0 = 352 * MiB, WS_GM1 = 180 * MiB, WS_Y0 = 336 * MiB, WS_END2 = 360 * MiB;
__device__ __forceinline__ bf16* gm_ptr(unsigned char* ws, int h, int ch) { return (bf16*)(ws + (h < 4 ? WS_GM0 : WS_GM1)) + (size_t)((h & 3) * NCH + ch) * 4096; }
__device__ __forceinline__ void wi_mma(f32x4 (&acc)[2], const LAS3 unsigned char* A, const LAS3 unsigned char* Bt, int m, int n0, int fr, int fq) {
#pragma unroll
    for (int ks = 0; ks < 2; ++ks) { const bf16x8 av = *(const LAS3 bf16x8*)(A + ((16 * m + fr) * WI_LD + 32 * ks + 8 * fq) * 2);
#pragma unroll
        for (int n = 0; n < 2; ++n) { const bf16x8 bv = *(const LAS3 bf16x8*)(Bt + ((n0 + 16 * n + fr) * WI_LD + 32 * ks + 8 * fq) * 2); acc[n] = __builtin_amdgcn_mfma_f32_16x16x32_bf16(av, bv, acc[n], 0, 0, 0); } }
}
struct WiA { bf16x8 a[2]; }; struct WiB { bf16x8 b[2][2]; };
__device__ __forceinline__ void wi_lda(WiA& f, const LAS3 unsigned char* A, int m, int fr, int fq) {
#pragma unroll
    for (int ks = 0; ks < 2; ++ks) f.a[ks] = *(const LAS3 bf16x8*)(A + ((16 * m + fr) * WI_LD + 32 * ks + 8 * fq) * 2);
}
__device__ __forceinline__ void wi_ldb(WiB& f, const LAS3 unsigned char* Bt, int n0, int fr, int fq) {
#pragma unroll
    for (int ks = 0; ks < 2; ++ks)
#pragma unroll
        for (int n = 0; n < 2; ++n) f.b[ks][n] = *(const LAS3 bf16x8*)(Bt + ((n0 + 16 * n + fr) * WI_LD + 32 * ks + 8 * fq) * 2);
}
__device__ __forceinline__ void wi_fma(f32x4 (&acc)[2], const WiA& A, const WiB& B) {
#pragma unroll
    for (int ks = 0; ks < 2; ++ks)
#pragma unroll
        for (int n = 0; n < 2; ++n) acc[n] = __builtin_amdgcn_mfma_f32_16x16x32_bf16(A.a[ks], B.b[ks][n], acc[n], 0, 0, 0);
}
__device__ __forceinline__ void wi_fma_s(f32x4 (&acc)[2], const WiA& A, const WiB& B) {
#pragma unroll
    for (int ks = 0; ks < 2; ++ks)
#pragma unroll
        for (int n = 0; n < 2; ++n) acc[n] = __builtin_amdgcn_mfma_f32_16x16x32_bf16(B.b[ks][n], A.a[ks], acc[n], 0, 0, 0);
}
__device__ __forceinline__ void wi_st_nat_s(LAS3 unsigned char* X, const f32x4 (&acc)[2], int m, int n0, int fr, int fq) {
#pragma unroll
    for (int n = 0; n < 2; ++n) { u32x2 w; w.x = pk2(acc[n][0], acc[n][1]); w.y = pk2(acc[n][2], acc[n][3]); *(LAS3 u32x2*)(X + ((16 * m + fr) * WI_LD + n0 + 16 * n + 4 * fq) * 2) = w; }
}
__device__ __forceinline__ void wi_ld_nat_s(f32x4 (&acc)[2], const LAS3 unsigned char* X, int m, int n0, int fr, int fq) {
#pragma unroll
    for (int n = 0; n < 2; ++n) { const u32x2 w = *(const LAS3 u32x2*)(X + ((16 * m + fr) * WI_LD + n0 + 16 * n + 4 * fq) * 2);
        acc[n][0] = __uint_as_float(w.x << 16); acc[n][1] = __uint_as_float(w.x & 0xffff0000u); acc[n][2] = __uint_as_float(w.y << 16); acc[n][3] = __uint_as_float(w.y & 0xffff0000u); }
}
__device__ __forceinline__ void wi_ld_tr(f32x4 (&acc)[2], const LAS3 unsigned char* XT, int m, int n0, int fr, int fq) {
#pragma unroll
    for (int n = 0; n < 2; ++n) { const u32x2 w = *(const LAS3 u32x2*)(XT + ((n0 + 16 * n + fr) * WI_LD + 16 * m + 4 * fq) * 2);
        acc[n][0] = __uint_as_float(w.x << 16); acc[n][1] = __uint_as_float(w.x & 0xffff0000u); acc[n][2] = __uint_as_float(w.y << 16); acc[n][3] = __uint_as_float(w.y & 0xffff0000u); }
}
#define WI_PIN() __builtin_amdgcn_sched_barrier(0)
__device__ __forceinline__ void wi_st_nat(LAS3 unsigned char* X, const f32x4 (&acc)[2], int m, int n0, int fr, int fq) {
#pragma unroll
    for (int n = 0; n < 2; ++n)
#pragma unroll
        for (int i = 0; i < 4; ++i) *(LAS3 bf16*)(X + ((16 * m + 4 * fq + i) * WI_LD + n0 + 16 * n + fr) * 2) = f2bf(acc[n][i]);
}
__device__ __forceinline__ void wi_st_tr(LAS3 unsigned char* XT, const f32x4 (&acc)[2], int m, int n0, int fr, int fq) {
#pragma unroll
    for (int n = 0; n < 2; ++n) { u32x2 w; w.x = pk2(acc[n][0], acc[n][1]); w.y = pk2(acc[n][2], acc[n][3]); *(LAS3 u32x2*)(XT + ((n0 + 16 * n + fr) * WI_LD + 16 * m + 4 * fq) * 2) = w; }
}
__device__ __forceinline__ void wi_ld_nat(f32x4 (&acc)[2], const LAS3 unsigned char* X, int m, int n0, int fr, int fq) {
#pragma unroll
    for (int n = 0; n < 2; ++n)
#pragma unroll
        for (int i = 0; i < 4; ++i) acc[n][i] = bf2f(*(const LAS3 bf16*)(X + ((16 * m + 4 * fq + i) * WI_LD + n0 + 16 * n + fr) * 2));
}
__device__ __forceinline__ void phase_scan1m(ArgsR a, const Ctx& c, const int skip = 0) {
    const f16* WM1 = (const f16*)(a.ws + WS_WM1); const f16* KP = (const f16*)(a.ws + WS_KP);
    const f16* AA = (const f16*)(a.ws + WS_AA); const f16* BB = (const f16*)(a.ws + WS_BB); const f16* V = (const f16*)(a.ws + WS_V); const f16* R = (const f16*)(a.ws + WS_R);
    float* ST = (float*)(a.ws + WS_ST);
    LAS3 unsigned char* L = (LAS3 unsigned char*)c.lds;
    LAS3 float* GAM = (LAS3 float*)(L + WI_GAM); LAS3 float* GL = (LAS3 float*)(L + WI_GL);
    const int lane = c.lane, wv = c.wave, fr = lane & 15, fq = lane >> 4, m = wv >> 1, n0 = 32 * (wv & 1), tid = c.tid;
#define SLOT(i) (L + (i) * WI_B)
    const int t = tid >> 3, cc = (tid & 7) * 8;
    f16x8 pav, pbv, pkv, pvv, prv, pwv;
#define WI_FETCH(it) do { const int h_ = (it) / NCH, ch_ = (it) % NCH; const size_t eo_ = (size_t)(ch_ * CL + t) * W + h_ * 64 + cc; \
        pav = *(const f16x8*)(AA + eo_); pbv = *(const f16x8*)(BB + eo_); pkv = *(const f16x8*)(KP + eo_); pvv = *(const f16x8*)(V + eo_); prv = *(const f16x8*)(R + eo_); pwv = *(const f16x8*)(WM1 + eo_); } while (0)
    if (blockIdx.x < NH * NCH) WI_FETCH(blockIdx.x);
    for (int item = blockIdx.x; item < NH * NCH; item += gridDim.x) {
        const int h = item / NCH, ch = item % NCH;
        const f16x8 av = pav, bv = pbv, kv = pkv, vv = pvv, rv = prv, wv8 = pwv;
        if (item + (int)gridDim.x < NH * NCH) WI_FETCH(item + (int)gridDim.x);
        float g[8], gp[8];
        { float wloc[8];
#pragma unroll
          for (int e = 0; e < 8; ++e) wloc[e] = 1.0f + (float)wv8[e];
#pragma unroll
          for (int e = 0; e < 8; ++e) { float x = wloc[e];
              { const float y = __shfl_up(x, 8); if (lane >= 8) x *= y; } { const float y = __shfl_up(x, 16); if (lane >= 16) x *= y; } { const float y = __shfl_up(x, 32); if (lane >= 32) x *= y; }
              g[e] = x; }
          if (lane >= 56) {
#pragma unroll
              for (int e = 0; e < 8; ++e) GAM[wv * 64 + cc + e] = g[e]; }
          HBAR();
#pragma unroll
          for (int e = 0; e < 8; ++e) { float pre = 1.0f;
#pragma unroll
              for (int w = 0; w < 7; ++w) if (w < wv) pre *= GAM[w * 64 + cc + e];
              g[e] *= pre; gp[e] = g[e] * __builtin_amdgcn_rcpf(wloc[e]); } }
        { float fa[8], fb[8], fk[8], fv[8], frr[8];
#pragma unroll
          for (int e = 0; e < 8; ++e) { const float ig = __builtin_amdgcn_rcpf(g[e]);
              fa[e] = (float)av[e] * gp[e]; fb[e] = (float)bv[e] * ig; fk[e] = (float)kv[e] * ig; fv[e] = (float)vv[e]; frr[e] = (float)rv[e] * g[e]; if (t == 63) GL[cc + e] = g[e]; }
          *(LAS3 u32x4*)(SLOT(0) + (t * WI_LD + cc) * 2) = pack8bf(fa); *(LAS3 u32x4*)(SLOT(2) + (t * WI_LD + cc) * 2) = pack8bf(fb); *(LAS3 u32x4*)(SLOT(4) + (t * WI_LD + cc) * 2) = pack8bf(fk); *(LAS3 u32x4*)(SLOT(12) + (t * WI_LD + cc) * 2) = pack8bf(frr);
          *(LAS3 u32x4*)(SLOT(10) + (t * WI_LD + cc) * 2) = pack8bf(fv); }
        HBAR();
        { WiA aB, aK; WiB bA, bR; wi_lda(aB, SLOT(2), m, fr, fq); wi_lda(aK, SLOT(4), m, fr, fq); wi_ldb(bA, SLOT(0), n0, fr, fq); wi_ldb(bR, SLOT(12), n0, fr, fq);
          const int tch = tid & 63, tt0 = (tid >> 6) * 8; bf16 ta[8], tb[8], tv[8];
#pragma unroll
          for (int e = 0; e < 8; ++e) { ta[e] = *(const LAS3 bf16*)(SLOT(0) + ((tt0 + e) * WI_LD + tch) * 2); tb[e] = *(const LAS3 bf16*)(SLOT(2) + ((tt0 + e) * WI_LD + tch) * 2); tv[e] = *(const LAS3 bf16*)(SLOT(10) + ((tt0 + e) * WI_LD + tch) * 2); }
          WI_PIN();
          { u32x4 wa, wb, wv4;
#pragma unroll
            for (int e = 0; e < 4; ++e) { wa[e] = (unsigned)ta[2 * e] | ((unsigned)ta[2 * e + 1] << 16); wb[e] = (unsigned)tb[2 * e] | ((unsigned)tb[2 * e + 1] << 16); wv4[e] = (unsigned)tv[2 * e] | ((unsigned)tv[2 * e + 1] << 16); }
            *(LAS3 u32x4*)(SLOT(1) + (tch * WI_LD + tt0) * 2) = wa; *(LAS3 u32x4*)(SLOT(3) + (tch * WI_LD + tt0) * 2) = wb; *(LAS3 u32x4*)(SLOT(5) + (tch * WI_LD + tt0) * 2) = wv4; }
          f32x4 ans[2] = {{0.f, 0.f, 0.f, 0.f}, {0.f, 0.f, 0.f, 0.f}}, ant[2] = {{0.f, 0.f, 0.f, 0.f}, {0.f, 0.f, 0.f, 0.f}}, aks[2] = {{0.f, 0.f, 0.f, 0.f}, {0.f, 0.f, 0.f, 0.f}}, am[2] = {{0.f, 0.f, 0.f, 0.f}, {0.f, 0.f, 0.f, 0.f}}, amk[2] = {{0.f, 0.f, 0.f, 0.f}, {0.f, 0.f, 0.f, 0.f}};
          wi_fma_s(ans, aB, bA); wi_fma(ant, aB, bA); wi_fma_s(aks, aK, bA); wi_fma(am, aB, bR); wi_fma(amk, aK, bR);
          WI_PIN();
          f32x4 axs[2];
#pragma unroll
          for (int n = 0; n < 2; ++n)
#pragma unroll
              for (int i = 0; i < 4; ++i) { const int rs = 16 * m + fr, cs = n0 + 16 * n + 4 * fq + i;
                  if (!(rs < cs)) { ans[n][i] = 0.f; aks[n][i] = 0.f; } axs[n][i] = ans[n][i] + (rs == cs ? 1.0f : 0.f);
                  const int rn = 16 * m + 4 * fq + i, cn = n0 + 16 * n + fr;
                  if (!(rn < cn)) ant[n][i] = 0.f; if (rn > cn) { am[n][i] = 0.f; amk[n][i] = 0.f; } }
          wi_st_nat_s(SLOT(7), ans, m, n0, fr, fq); wi_st_tr(SLOT(8), ant, m, n0, fr, fq); wi_st_nat_s(SLOT(6), aks, m, n0, fr, fq); wi_st_nat_s(SLOT(11), axs, m, n0, fr, fq);
          wi_st_tr(SLOT(13), am, m, n0, fr, fq); wi_st_tr(SLOT(14), amk, m, n0, fr, fq); }
        HBAR();
        { WiA aN; WiB bN; wi_lda(aN, SLOT(7), m, fr, fq); wi_ldb(bN, SLOT(8), n0, fr, fq); WI_PIN();
          f32x4 a2s[2] = {{0.f, 0.f, 0.f, 0.f}, {0.f, 0.f, 0.f, 0.f}}, a2t[2] = {{0.f, 0.f, 0.f, 0.f}, {0.f, 0.f, 0.f, 0.f}}; wi_fma_s(a2s, aN, bN); wi_fma(a2t, aN, bN); WI_PIN();
          wi_st_nat_s(SLOT(9), a2s, m, n0, fr, fq); wi_st_tr(SLOT(10), a2t, m, n0, fr, fq); }
        HBAR();
#define WI_LEVEL(XS, XD, NS, NST, ND, NDT) do { WiA aX, aN; WiB bN; f32x4 ax[2]; wi_lda(aX, SLOT(XS), m, fr, fq); wi_ldb(bN, SLOT(NST), n0, fr, fq); wi_lda(aN, SLOT(NS), m, fr, fq); wi_ld_nat_s(ax, SLOT(XS), m, n0, fr, fq); \
            WI_PIN(); f32x4 aqs[2] = {{0.f, 0.f, 0.f, 0.f}, {0.f, 0.f, 0.f, 0.f}}, aqt[2] = {{0.f, 0.f, 0.f, 0.f}, {0.f, 0.f, 0.f, 0.f}}; wi_fma_s(ax, aX, bN); wi_fma_s(aqs, aN, bN); wi_fma(aqt, aN, bN); WI_PIN(); \
            wi_st_nat_s(SLOT(XD), ax, m, n0, fr, fq); wi_st_nat_s(SLOT(ND), aqs, m, n0, fr, fq); wi_st_tr(SLOT(NDT), aqt, m, n0, fr, fq); \
            HBAR(); } while (0)
        WI_LEVEL(11, 0, 9, 10, 7, 8);
        WI_LEVEL(0, 11, 7, 8, 9, 10);
        WI_LEVEL(11, 0, 9, 10, 7, 8);
        WI_LEVEL(0, 11, 7, 8, 9, 10);
#undef WI_LEVEL
        { WiA aX; WiB bN; f32x4 ax[2]; wi_lda(aX, SLOT(11), m, fr, fq); wi_ldb(bN, SLOT(10), n0, fr, fq); wi_ld_nat(ax, SLOT(11), m, n0, fr, fq); WI_PIN();
          wi_fma(ax, aX, bN); WI_PIN(); wi_st_tr(SLOT(0), ax, m, n0, fr, fq); }
        HBAR();
        { WiA aNk, aAt; WiB bT; wi_lda(aNk, SLOT(6), m, fr, fq); wi_lda(aAt, SLOT(1), m, fr, fq); wi_ldb(bT, SLOT(0), n0, fr, fq); WI_PIN();
          f32x4 aw[2] = {{0.f, 0.f, 0.f, 0.f}, {0.f, 0.f, 0.f, 0.f}}, aa[2] = {{0.f, 0.f, 0.f, 0.f}, {0.f, 0.f, 0.f, 0.f}}; wi_fma_s(aw, aNk, bT); wi_fma_s(aa, aAt, bT); WI_PIN();
          wi_st_nat_s(SLOT(2), aw, m, n0, fr, fq); wi_st_nat_s(SLOT(7), aa, m, n0, fr, fq); }
        HBAR();
        { WiA aAT, aW1; WiB bB, bM; f32x4 ap[2] = {{0.f, 0.f, 0.f, 0.f}, {0.f, 0.f, 0.f, 0.f}}, az[2], ag[2], az2[2]; float gl[2];
          wi_lda(aAT, SLOT(7), m, fr, fq); wi_lda(aW1, SLOT(2), m, fr, fq); wi_ldb(bB, SLOT(3), n0, fr, fq); wi_ldb(bM, SLOT(13), n0, fr, fq);
          wi_ld_nat(az, SLOT(4), m, n0, fr, fq); wi_ld_tr(az2, SLOT(14), m, n0, fr, fq); wi_ld_tr(ag, SLOT(12), m, n0, fr, fq);
#pragma unroll
          for (int n = 0; n < 2; ++n) gl[n] = GL[n0 + 16 * n + fr];
          WI_PIN();
          wi_fma(ap, aAT, bB); wi_fma(az, aW1, bB); wi_fma(ag, aAT, bM); wi_fma(az2, aW1, bM);
          WI_PIN();
          wi_st_tr(SLOT(8), az, m, n0, fr, fq); wi_st_tr(SLOT(9), az2, m, n0, fr, fq);
          bf16* PTp = (bf16*)ST + (size_t)(h * NCH + ch) * 4096; bf16* GMp = gm_ptr(a.ws, h, ch);
#pragma unroll
          for (int n = 0; n < 2; ++n) { const int col = n0 + 16 * n + fr; f32x4 pv = ap[n];
#pragma unroll
              for (int i = 0; i < 4; ++i) { if (16 * m + 4 * fq + i == col) pv[i] += 1.0f; pv[i] *= gl[n]; }
              u32x2 w; w.x = pk2(pv[0], pv[1]); w.y = pk2(pv[2], pv[3]); *(u32x2*)(PTp + col * 64 + 16 * m + 4 * fq) = w;
              u32x2 w2; w2.x = pk2(ag[n][0], ag[n][1]); w2.y = pk2(ag[n][2], ag[n][3]); *(u32x2*)(GMp + col * 64 + 16 * m + 4 * fq) = w2; } }
        HBAR();
        { WiA aV; WiB bZ1, bZ2; float gl[2]; wi_lda(aV, SLOT(5), m, fr, fq); wi_ldb(bZ1, SLOT(8), n0, fr, fq); wi_ldb(bZ2, SLOT(9), n0, fr, fq); gl[0] = GL[n0 + fr]; gl[1] = GL[n0 + 16 + fr]; WI_PIN();
          f32x4 aq[2] = {{0.f, 0.f, 0.f, 0.f}, {0.f, 0.f, 0.f, 0.f}}, ay[2] = {{0.f, 0.f, 0.f, 0.f}, {0.f, 0.f, 0.f, 0.f}}; wi_fma(aq, aV, bZ1); wi_fma(ay, aV, bZ2); WI_PIN();
          bf16* QTp = (bf16*)ST + ST_QB_OFF + (size_t)(h * NCH + ch) * 4096; bf16* Y0p = (bf16*)(a.ws + WS_Y0) + (size_t)(h * NCH + ch) * 4096;
#pragma unroll
          for (int n = 0; n < 2; ++n) { const int col = n0 + 16 * n + fr; store4bf(QTp + col * 64 + 16 * m + 4 * fq, aq[n] * gl[n]);
              u32x2 w; w.x = pk2(ay[n][0], ay[n][1]); w.y = pk2(ay[n][2], ay[n][3]); *(u32x2*)(Y0p + col * 64 + 16 * m + 4 * fq) = w; } }
        HBAR();
    }
#undef SLOT
#undef WI_FETCH
}

__device__ __forceinline__ void phase_scan3m(ArgsR a, const Ctx& c, int l) {
    const f16* R = (const f16*)(a.ws + WS_R); const f16* KP = (const f16*)(a.ws + WS_KP); const f16* V = (const f16*)(a.ws + WS_V); const bf16* G = (const bf16*)(a.ws + WS_G);
    bf16* YA = (bf16*)(a.ws + WS_YA);
    LAS3 unsigned char* L = (LAS3 unsigned char*)c.lds;
    LAS3 float* YL = (LAS3 float*)(L + WI_B);
    LAS3 unsigned char* S0I = L + 3 * WI_B;
    const int lane = c.lane, wv = c.wave, fr = lane & 15, fq = lane >> 4, m = wv >> 1, n0 = 32 * (wv & 1), tid = c.tid;
    const int boff = (n0 + fr) * 64 + 8 * fq, qtoff = (n0 + fr) * 64 + 16 * m + 4 * fq;
    u32x4 pS; bf16x8 pL[2][2]; u32x2 pQ[2]; bf16x8 pB[2][2]; u32x2 pY[2];
#define S3_FETCH(it) do { const int h_ = (it) / NCH, ch_ = (it) % NCH; pS = (u32x4){0u, 0u, 0u, 0u}; \
        _Pragma("unroll") for (int ks = 0; ks < 2; ++ks) _Pragma("unroll") for (int n = 0; n < 2; ++n) pL[ks][n] = (bf16x8){0, 0, 0, 0, 0, 0, 0, 0}; \
        pQ[0] = (u32x2){0u, 0u}; pQ[1] = (u32x2){0u, 0u}; \
        if (ch_ > 0) { const int c1_ = ch_ - 1; pS = *(const u32x4*)((const bf16*)(a.ws + WS_SG) + (size_t)(h_ * NG + c1_ / GS) * 4096 + tid * 8); \
            const bf16* LP_ = (const bf16*)(a.ws + WS_ST) + ST_LP_OFF + (size_t)(h_ * NCH + c1_) * 4096; const bf16* QT_ = (const bf16*)(a.ws + WS_ST) + ST_QB_OFF + (size_t)(h_ * NCH + c1_) * 4096; \
            _Pragma("unroll") for (int ks = 0; ks < 2; ++ks) _Pragma("unroll") for (int n = 0; n < 2; ++n) pL[ks][n] = *(const bf16x8*)(LP_ + boff + 16 * n * 64 + 32 * ks); \
            _Pragma("unroll") for (int n = 0; n < 2; ++n) pQ[n] = *(const u32x2*)(QT_ + qtoff + 16 * n * 64); } \
        const bf16* G_ = gm_ptr(a.ws, h_, ch_); const bf16* Y_ = (const bf16*)(a.ws + WS_Y0) + (size_t)(h_ * NCH + ch_) * 4096; \
        _Pragma("unroll") for (int ks = 0; ks < 2; ++ks) _Pragma("unroll") for (int n = 0; n < 2; ++n) pB[ks][n] = *(const bf16x8*)(G_ + (n0 + 16 * n + fr) * 64 + 32 * ks + 8 * fq); \
        _Pragma("unroll") for (int n = 0; n < 2; ++n) pY[n] = *(const u32x2*)(Y_ + (n0 + 16 * n + fr) * 64 + 16 * m + 4 * fq); } while (0)
    if (blockIdx.x < NH * NCH) S3_FETCH(blockIdx.x);
    for (int item = blockIdx.x; item < NH * NCH; item += gridDim.x) {
        const int h = item / NCH, ch = item % NCH;
        *(LAS3 u32x4*)(L + ((tid >> 3) * WI_LD + (tid & 7) * 8) * 2) = pS;
        bf16x8 lfr[2][2], bfr[2][2]; f32x4 as0[2], acc[2];
#pragma unroll
        for (int ks = 0; ks < 2; ++ks)
#pragma unroll
            for (int n = 0; n < 2; ++n) { lfr[ks][n] = pL[ks][n]; bfr[ks][n] = pB[ks][n]; }
#pragma unroll
        for (int n = 0; n < 2; ++n) { as0[n] = bf4cvt(pQ[n]); acc[n][0] = __uint_as_float(pY[n].x << 16); acc[n][1] = __uint_as_float(pY[n].x & 0xffff0000u); acc[n][2] = __uint_as_float(pY[n].y << 16); acc[n][3] = __uint_as_float(pY[n].y & 0xffff0000u); }
        if (item + (int)gridDim.x < NH * NCH) S3_FETCH(item + (int)gridDim.x);
        HBAR();
        hmma(L, lfr, as0, m, fr, fq);
        himg_store(S0I, as0, m, n0, fr, fq);
        HBAR();
#pragma unroll
        for (int ks = 0; ks < 2; ++ks) { const bf16x8 av = *(const LAS3 bf16x8*)(S0I + ((16 * m + fr) * WI_LD + 32 * ks + 8 * fq) * 2);
#pragma unroll
            for (int n = 0; n < 2; ++n) acc[n] = __builtin_amdgcn_mfma_f32_16x16x32_bf16(av, bfr[ks][n], acc[n], 0, 0, 0); }
#pragma unroll
        for (int n = 0; n < 2; ++n)
#pragma unroll
            for (int i = 0; i < 4; ++i) YL[(n0 + 16 * n + fr) * 65 + 16 * m + 4 * fq + i] = acc[n][i];
        HBAR();
        { const float gn_g = a.in[I_GNG][l * W + h * 64 + lane], gn_b = a.in[I_GNB][l * W + h * 64 + lane], r_k = a.in[I_RK][l * W + h * 64 + lane];
          f16 rl8[8], kl8[8], vl8[8]; bf16 gl8[8];
#pragma unroll
          for (int i = 0; i < 8; ++i) { const size_t o = (size_t)(ch * CL + 8 * wv + i) * W + h * 64 + lane; rl8[i] = R[o]; kl8[i] = KP[o]; vl8[i] = V[o]; gl8[i] = G[o]; }
#pragma unroll
          for (int i = 0; i < 8; ++i) { const int t = 8 * wv + i; const size_t o = (size_t)(ch * CL + t) * W + h * 64 + lane;
              const float yy = YL[t * 65 + lane]; const float rl = (float)rl8[i], kl = (float)kl8[i], vl = (float)vl8[i], gl = bf2f(gl8[i]);
              const float mean = wave_sum(yy) * (1.f / 64.f); const float dd = yy - mean; const float var = wave_sum(dd * dd) * (1.f / 64.f);
              const float bonus = wave_sum(rl * kl * r_k);
              const float yn = dd * __builtin_amdgcn_rsqf(var + GN_EPS) * gn_g + gn_b + bonus * vl;
              YA[o] = f2bf(yn * gl); } }
        HBAR();
    }
#undef S3_FETCH
}

__device__ __forceinline__ void phase_scan3(ArgsR a, const Ctx& c, int l) {
    const f16* R = (const f16*)(a.ws + WS_R); const f16* WM1 = (const f16*)(a.ws + WS_WM1); const f16* KP = (const f16*)(a.ws + WS_KP);
    const f16* AA = (const f16*)(a.ws + WS_AA); const f16* BB = (const f16*)(a.ws + WS_BB); const f16* V = (const f16*)(a.ws + WS_V);
    const float* ST = (const float*)(a.ws + WS_ST); bf16* YA = (bf16*)(a.ws + WS_YA); const f16* Gs = (const f16*)(a.ws + WS_G);
    const int lane = c.lane;
    LAS3 unsigned char* ring = (LAS3 unsigned char*)c.lds + c.wave * SC_WAVE;
    for (int item = c.gw; item < NH * NCH; item += c.ngw) {
        const int h = __builtin_amdgcn_readfirstlane(item / NCH), ch = __builtin_amdgcn_readfirstlane(item % NCH);
        const size_t lane_off = (size_t)(lane >> 3) * W + h * 64 + (lane & 7) * 8;
        const float gn_g = a.in[I_GNG][l * W + h * 64 + lane], gn_b = a.in[I_GNB][l * W + h * 64 + lane], r_k = a.in[I_RK][l * W + h * 64 + lane];
        { const size_t e0 = (size_t)(ch * CL) * W + lane_off;
          sc_dma(AA, e0, ring); sc_dma(WM1, e0, ring + 1024); sc_dma(BB, e0, ring + 2048); sc_dma(KP, e0, ring + 3072); sc_dma(V, e0, ring + 4096); sc_dma(R, e0, ring + 5120); sc_dma(Gs, e0, ring + 6144); }
        float S[64];
        if (ch == 0) {
#pragma unroll
            for (int j = 0; j < 64; ++j) S[j] = 0.f;
        } else { const bf16* Sp = (const bf16*)ST + ((size_t)(h * NCH + ch - 1) * 64 + lane) * 64;
#pragma unroll
            for (int j = 0; j < 64; j += 4) { const f32x4 x = load4bf(Sp + j); S[j] = x[0]; S[j + 1] = x[1]; S[j + 2] = x[2]; S[j + 3] = x[3]; } }
#pragma unroll 1
        for (int blk = 0; blk < CL / SCB; ++blk) {
            LAS3 unsigned char* buf = ring + (blk & 1) * SC_BUF;
            if (blk + 1 < CL / SCB) { LAS3 unsigned char* nb = ring + ((blk + 1) & 1) * SC_BUF; const size_t e0 = (size_t)(ch * CL + (blk + 1) * SCB) * W + lane_off;
                sc_dma(AA, e0, nb); sc_dma(WM1, e0, nb + 1024); sc_dma(BB, e0, nb + 2048); sc_dma(KP, e0, nb + 3072); sc_dma(V, e0, nb + 4096); sc_dma(R, e0, nb + 5120); sc_dma(Gs, e0, nb + 6144);
                asm volatile("s_waitcnt vmcnt(7)" ::: "memory"); }
            else asm volatile("s_waitcnt vmcnt(0)" ::: "memory");
            SVec A, Wv, Bv, Kv, Rv;
            sv_cvt(A, sv_read(buf, lane)); sv_cvt1p(Wv, sv_read(buf + 1024, lane)); sv_cvt(Bv, sv_read(buf + 2048, lane)); sv_cvt(Kv, sv_read(buf + 3072, lane)); sv_cvt(Rv, sv_read(buf + 5120, lane));
            float vv = (float)*(const LAS3 f16*)(buf + 4096 + lane * 2);
#pragma unroll 1
            for (int st = 0; st < SCB; ++st) {
                const LAS3 unsigned char* sn = buf + ((st + 1 < SCB) ? st + 1 : st) * 128;
                const f16x4 ha = sv_read(sn, lane), hw = sv_read(sn + 1024, lane), hb = sv_read(sn + 2048, lane), hk = sv_read(sn + 3072, lane), hr = sv_read(sn + 5120, lane);
                const f16 hv = *(const LAS3 f16*)(sn + 4096 + lane * 2);
                float d[4] = {0.f, 0.f, 0.f, 0.f};
                sc_dot<0>(d, A, S);
                const float sa = (d[0] + d[1]) + (d[2] + d[3]);
                float y[4] = {0.f, 0.f, 0.f, 0.f};
                sc_upd3<0>(S, y, Wv, Bv, Kv, Rv, sa, vv);
                const float yy = (y[0] + y[1]) + (y[2] + y[3]);
                sv_cvt(A, ha); sv_cvt1p(Wv, hw); sv_cvt(Bv, hb); sv_cvt(Kv, hk); sv_cvt(Rv, hr); vv = (float)hv;
                { const LAS3 unsigned char* sb = buf + st * 128;
                  const float rl = (float)*(const LAS3 f16*)(sb + 5120 + lane * 2), kl = (float)*(const LAS3 f16*)(sb + 3072 + lane * 2), vl = (float)*(const LAS3 f16*)(sb + 4096 + lane * 2);
                  const float gl = bf2f(*(const LAS3 bf16*)(sb + 6144 + lane * 2));
                  const float mean = wave_sum(yy) * (1.f / 64.f); const float dd = yy - mean; const float var = wave_sum(dd * dd) * (1.f / 64.f);
                  const float bonus = wave_sum(rl * kl * r_k);
                  const float yn = dd * __builtin_amdgcn_rsqf(var + GN_EPS) * gn_g + gn_b + bonus * vl;
                  YA[(size_t)(ch * CL + blk * SCB + st) * W + h * 64 + lane] = f2bf(yn * gl); }
            }
        }
    }
}

__device__ __forceinline__ void phase_post(ArgsR a, const Ctx& c, int l) {
    const bf16* YSC = (const bf16*)(a.ws + WS_YSC); const f16* R = (const f16*)(a.ws + WS_R); const f16* KP = (const f16*)(a.ws + WS_KP); const f16* V = (const f16*)(a.ws + WS_V);
    const bf16* G = (const bf16*)(a.ws + WS_G); bf16* YA = (bf16*)(a.ws + WS_YA);
    const float* gng = a.in[I_GNG] + l * W; const float* gnb = a.in[I_GNB] + l * W; const float* rk = a.in[I_RK] + l * W;
    for (int t = c.gw; t < T; t += c.ngw) {
#pragma unroll
        for (int i = 0; i < 8; ++i) { const int n = c.lane + 64 * i; const size_t o = (size_t)t * W + n;
            const float y = bf2f(YSC[o]); const float mean = wave_sum(y) * (1.f / 64.f); const float d = y - mean; const float var = wave_sum(d * d) * (1.f / 64.f);
            float yn = d * __builtin_amdgcn_rsqf(var + GN_EPS) * gng[n] + gnb[n];
            const float r = (float)R[o], k = (float)KP[o], v = (float)V[o];
            const float bonus = wave_sum(r * k * rk[n]);
            yn += bonus * v;
            YA[o] = f2bf(yn * bf2f(G[o])); }
    }
}

__device__ __forceinline__ void phase_ln1(ArgsR a, const Ctx& c, int l, float* outw, int mode = 3) {
    const float* MODF = (const float*)(a.ws + WS_MODF) + l * 6144;
    const float* g1 = a.in[I_LN1G] + l * D; const float* b1 = a.in[I_LN1B] + l * D;
    bf16* XN = (bf16*)(a.ws + WS_XN);
    int* TOKI = (int*)(a.ws + WS_TOKI); float* TOKW = (float*)(a.ws + WS_TOKW); int* TOKP = (int*)(a.ws + WS_TOKP);
    const float* rw = a.in[I_RW]; const float* rb = a.in[I_RB];
    LAS3 float* rwT = (LAS3 float*)((LAS3 unsigned char*)c.lds + 69632);
    constexpr int RW_LD = D + 4;
    unsigned* lcnt = (unsigned*)(c.lds + 135488);
    if (mode & 1) {
    for (int i = c.tid; i < D * NE; i += NTHREADS) rwT[(i & 15) * RW_LD + (i >> 4)] = rw[i];
    if (c.tid < NE) lcnt[c.tid] = 0u;
    __syncthreads();
    const bf16* TMP = (const bf16*)(a.ws + WS_TMP);
    float vn[16]; if (c.gw < T) load_row16bf(TMP + (size_t)c.gw * D, c.lane, vn);
    for (int m = c.gw; m < T; m += c.ngw) {
        int l4 = 4 * c.lane; asm volatile("" : "+v"(l4));
        float v[16];
#pragma unroll
        for (int j = 0; j < 16; ++j) v[j] = vn[j];
        if (m + c.ngw < T) load_row16bf(TMP + (size_t)(m + c.ngw) * D, c.lane, vn);
        float mean, rstd; row_stats(v, mean, rstd);
#pragma unroll
        for (int j = 0; j < 4; ++j) { f32x4 o; const int col = l4 + 256 * j;
#pragma unroll
            for (int e = 0; e < 4; ++e) { v[4 * j + e] = (v[4 * j + e] - mean) * rstd * g1[col + e] + b1[col + e]; o[e] = v[4 * j + e]; }
            *(f32x4*)(outw + (size_t)m * D + col) = o; }
        row_stats(v, mean, rstd);
#pragma unroll
        for (int j = 0; j < 4; ++j) { f32x4 o; const int col = l4 + 256 * j;
#pragma unroll
            for (int e = 0; e < 4; ++e) { v[4 * j + e] = (v[4 * j + e] - mean) * rstd * (1.0f + MODF[4096 + col + e]) + MODF[3072 + col + e]; o[e] = v[4 * j + e]; }
            store4bf(XN + (size_t)m * D + col, o); }
        float lg[16];
#pragma unroll
        for (int e = 0; e < 16; ++e) { float x = 0.f;
#pragma unroll
            for (int j = 0; j < 4; ++j) { const f32x4 r4 = *(const LAS3 f32x4*)(rwT + e * RW_LD + l4 + 256 * j); x += (v[4 * j] * r4[0] + v[4 * j + 1] * r4[1]) + (v[4 * j + 2] * r4[2] + v[4 * j + 3] * r4[3]); }
            lg[e] = x;
            if ((e & 3) == 3) __builtin_amdgcn_sched_barrier(0); }
        float r8[8], r4v[4], r2[2], r1;
        { const bool b5 = (c.lane & 32) != 0, b4 = (c.lane & 16) != 0, b3 = (c.lane & 8) != 0, b2 = (c.lane & 4) != 0;
#pragma unroll
          for (int i = 0; i < 8; ++i) { const float snd = b5 ? lg[i] : lg[i + 8], kp = b5 ? lg[i + 8] : lg[i]; r8[i] = kp + __shfl_xor(snd, 32); }
#pragma unroll
          for (int i = 0; i < 4; ++i) { const float snd = b4 ? r8[i] : r8[i + 4], kp = b4 ? r8[i + 4] : r8[i]; r4v[i] = kp + __shfl_xor(snd, 16); }
#pragma unroll
          for (int i = 0; i < 2; ++i) { const float snd = b3 ? r4v[i] : r4v[i + 2], kp = b3 ? r4v[i + 2] : r4v[i]; r2[i] = kp + __shfl_xor(snd, 8); }
          { const float snd = b2 ? r2[0] : r2[1], kp = b2 ? r2[1] : r2[0]; r1 = kp + __shfl_xor(snd, 4); }
          r1 += __shfl_xor(r1, 2); r1 += __shfl_xor(r1, 1); }
        float sc[16], sel[16];
#pragma unroll
        for (int e = 0; e < 16; ++e) { const float lgt = __shfl(r1, 4 * e); sc[e] = __builtin_amdgcn_rcpf(1.0f + __expf(-lgt)); sel[e] = sc[e] + rb[e]; }
        int best = 0; float bestv = -INFINITY;
#pragma unroll
        for (int g = 0; g < 4; ++g) { float m1 = -INFINITY, m2 = -INFINITY;
#pragma unroll
            for (int q = 0; q < 4; ++q) { const float sv = sel[4 * g + q]; if (sv > m1) { m2 = m1; m1 = sv; } else if (sv > m2) m2 = sv; }
            const float gs = m1 + m2; if (gs > bestv) { bestv = gs; best = g; } }
        int i1 = 0, i2 = 0; float s1 = -INFINITY, s2 = -INFINITY, w1 = 0.f, w2 = 0.f;
#pragma unroll
        for (int e = 0; e < 16; ++e) { if ((e >> 2) == best) { const float sv = sel[e];
                if (sv > s1) { s2 = s1; i2 = i1; w2 = w1; s1 = sv; i1 = e; w1 = sc[e]; } else if (sv > s2) { s2 = sv; i2 = e; w2 = sc[e]; } } }
        if (c.lane == 0) { const float ws = w1 + w2;
            TOKI[2 * m] = i1; TOKI[2 * m + 1] = i2; TOKW[2 * m] = w1 / ws; TOKW[2 * m + 1] = w2 / ws;
            TOKP[2 * m] = (int)atomicAdd(&lcnt[i1], 1u); TOKP[2 * m + 1] = (int)atomicAdd(&lcnt[i2], 1u); }
    }
    __syncthreads();
    if (c.tid < NE) ((int*)(a.ws + WS_BLKCNT))[blockIdx.x * NE + c.tid] = (int)lcnt[c.tid];
    __syncthreads();
    }
}

__device__ __forceinline__ void expert_convert(ArgsR a, const Ctx& c, int l, int b0) {
    if ((int)blockIdx.x < b0) return;
    float* scr = (float*)(c.lds + c.wave * 8704);
    bf16* WGU = (bf16*)(a.ws + WS_WGU); bf16* WD = (bf16*)(a.ws + WS_WD);
    constexpr int IG = (D / 64) * (FF / 32);
    constexpr int ID = (FF / 64) * (D / 32);
    const int gw0 = ((int)blockIdx.x - b0) * NWAVES + c.wave, ngw0 = ((int)gridDim.x - b0) * NWAVES;
    for (int it = gw0; it < NE * (2 * IG + ID); it += ngw0) {
        const int e = it / (2 * IG + ID); int r = it % (2 * IG + ID);
        const size_t eo = ((size_t)l * NE + e) * (size_t)D * FF;
        if (r < IG) { transpose_matrix_item(a.in[I_EG] + eo, D, FF, WGU + (size_t)e * 1024 * 1024, r, scr, c.lane, RowGU{0}); continue; } r -= IG;
        if (r < IG) { transpose_matrix_item(a.in[I_EU] + eo, D, FF, WGU + (size_t)e * 1024 * 1024, r, scr, c.lane, RowGU{1}); continue; } r -= IG;
        transpose_matrix_item(a.in[I_ED] + eo, FF, D, WD + (size_t)e * 1024 * 512, r, scr, c.lane, RowId());
    }
}

__device__ __forceinline__ void phase_perm(ArgsR a, const Ctx& c, int l) {
    const int* BLKCNT = (const int*)(a.ws + WS_BLKCNT);
    LAS3 int* pre = (LAS3 int*)c.lds;
    LAS3 int* tot = pre + 256 * NE;
    const int nb = gridDim.x;
#pragma unroll
    for (int q = 0; q < 2; ++q) { const int e = 2 * c.wave + q; int v[4]; int sum = 0;
#pragma unroll
        for (int i = 0; i < 4; ++i) { const int b = 4 * c.lane + i; v[i] = b < nb ? BLKCNT[b * NE + e] : 0; sum += v[i]; }
        int inc = sum;
#pragma unroll
        for (int o = 1; o < 64; o <<= 1) { const int t = __shfl_up(inc, o); if (c.lane >= o) inc += t; }
        int run = inc - sum;
#pragma unroll
        for (int i = 0; i < 4; ++i) { pre[(4 * c.lane + i) * NE + e] = run; run += v[i]; }
        if (c.lane == 63) tot[e] = inc; }
    __syncthreads();
    int ts[17]; { int sacc = 0;
#pragma unroll
        for (int e = 0; e < 16; ++e) { ts[e] = sacc; sacc += (tot[e] + 255) >> 8; } ts[16] = sacc; }
    if (blockIdx.x == 0 && c.tid < NE) ((int*)(a.ws + WS_TOT))[c.tid] = tot[c.tid];
    const int* TOKI = (const int*)(a.ws + WS_TOKI); const int* TOKP = (const int*)(a.ws + WS_TOKP); int* S2T = (int*)(a.ws + WS_S2T); const float* TOKW = (const float*)(a.ws + WS_TOKW);
    const bf16* XN = (const bf16*)(a.ws + WS_XN); bf16* XS = (bf16*)(a.ws + WS_XS);
    for (int as = blockIdx.x * NTHREADS + c.tid; as < 2 * T; as += gridDim.x * NTHREADS) {
        const int e = TOKI[as]; int base = 0;
#pragma unroll
        for (int j = 0; j < 16; ++j) base = (j == e) ? ts[j] : base;
        const int m = as >> 1, blk = (m % c.ngw) >> 3;
        const u32x2 sw = {(unsigned)as, __float_as_uint(TOKW[as])};
        *(u32x2*)(S2T + 2 * (base * 256 + pre[blk * NE + e] + TOKP[as])) = sw;
    }
    for (int e = 0; e < 16; ++e) {
        int tse = 0, tsn = 0;
#pragma unroll
        for (int j = 0; j < 16; ++j) { tse = (j == e) ? ts[j] : tse; tsn = (j == e) ? ts[j + 1] : tsn; }
        const int lo = tse * 256 + tot[e], hi = tsn * 256;
        for (int sl = lo + blockIdx.x * NTHREADS + c.tid; sl < hi; sl += gridDim.x * NTHREADS) S2T[2 * sl] = -1;
    }
    __syncthreads();
}

__device__ __forceinline__ void phase_ln2(ArgsR a, const Ctx& c, int l, float* outw) {
    const float* MODF = (const float*)(a.ws + WS_MODF) + l * 6144;
    const float* g2 = a.in[I_LN2G] + l * D; const float* b2 = a.in[I_LN2B] + l * D;
    const bf16* Y = (const bf16*)(a.ws + WS_Y); bf16* XN = (bf16*)(a.ws + WS_XN);
    float vn[16]; u32x2 y0n[4], y1n[4];
    if (c.gw < T) { load_row16(a.out + (size_t)c.gw * D, c.lane, vn);
#pragma unroll
        for (int j = 0; j < 4; ++j) { y0n[j] = *(const u32x2*)(Y + (size_t)(2 * c.gw) * D + 4 * c.lane + 256 * j); y1n[j] = *(const u32x2*)(Y + (size_t)(2 * c.gw + 1) * D + 4 * c.lane + 256 * j); } }
    for (int m = c.gw; m < T; m += c.ngw) {
        float v[16]; u32x2 y0[4], y1[4];
#pragma unroll
        for (int j = 0; j < 16; ++j) v[j] = vn[j];
#pragma unroll
        for (int j = 0; j < 4; ++j) { y0[j] = y0n[j]; y1[j] = y1n[j]; }
        if (m + c.ngw < T) { const int mn = m + c.ngw; load_row16(a.out + (size_t)mn * D, c.lane, vn);
#pragma unroll
            for (int j = 0; j < 4; ++j) { y0n[j] = *(const u32x2*)(Y + (size_t)(2 * mn) * D + 4 * c.lane + 256 * j); y1n[j] = *(const u32x2*)(Y + (size_t)(2 * mn + 1) * D + 4 * c.lane + 256 * j); } }
#pragma unroll
        for (int j = 0; j < 4; ++j) { const int col = 4 * c.lane + 256 * j;
            const float a0 = __uint_as_float(y0[j].x << 16) + __uint_as_float(y1[j].x << 16), a1 = __uint_as_float(y0[j].x & 0xffff0000u) + __uint_as_float(y1[j].x & 0xffff0000u);
            const float a2 = __uint_as_float(y0[j].y << 16) + __uint_as_float(y1[j].y << 16), a3 = __uint_as_float(y0[j].y & 0xffff0000u) + __uint_as_float(y1[j].y & 0xffff0000u);
            const f32x4 gt = *(const f32x4*)(MODF + 5120 + col);
            v[4 * j] = ALPHA * v[4 * j] + (1.0f + gt[0]) * a0; v[4 * j + 1] = ALPHA * v[4 * j + 1] + (1.0f + gt[1]) * a1; v[4 * j + 2] = ALPHA * v[4 * j + 2] + (1.0f + gt[2]) * a2; v[4 * j + 3] = ALPHA * v[4 * j + 3] + (1.0f + gt[3]) * a3; }
        float mean, rstd; row_stats(v, mean, rstd);
#pragma unroll
        for (int j = 0; j < 4; ++j) { f32x4 o; const int col = 4 * c.lane + 256 * j;
#pragma unroll
            for (int e = 0; e < 4; ++e) { v[4 * j + e] = (v[4 * j + e] - mean) * rstd * g2[col + e] + b2[col + e]; o[e] = v[4 * j + e]; }
            *(f32x4*)(outw + (size_t)m * D + col) = o; }
        if (l + 1 < DEPTH) {
            const float* MN = MODF + 6144;
            row_stats(v, mean, rstd);
#pragma unroll
            for (int j = 0; j < 4; ++j) { f32x4 o; const int col = 4 * c.lane + 256 * j;
#pragma unroll
                for (int e = 0; e < 4; ++e) o[e] = (v[4 * j + e] - mean) * rstd * (1.0f + MN[1024 + col + e]) + MN[col + e];
                store4bf(XN + (size_t)m * D + col, o); }
        }
    }
}


template <class F> struct EpiAdapt {
    static constexpr bool PERM = true, AFTER_DRAIN = false; F f;
    __device__ __forceinline__ void operator()(const f32x4 (&acc)[2][2][4][2], const Unit& u, int wr, int wc, int fr, int fq) const {
        const int col = u.pn * 256 + wc * 32 + 8 * fq;
#pragma unroll
        for (int ai = 0; ai < 2; ++ai)
#pragma unroll
            for (int m = 0; m < 4; ++m) { const int row = u.pm * 256 + ai * 128 + wr * 64 + m * 16 + fr; f(row, col, acc[ai][0][m][0], acc[ai][0][m][1], acc[ai][1][m][0], acc[ai][1][m][1]); }
    }
};

template <class Sched, class F>
__device__ __forceinline__ void gemm_gather(const Ctx& c, const bf16* A, const int* s2t, const bf16* Bt, int M, int N, int K, const Sched& S, const F& f) {
    pg8::Gemm g{A, Bt, M, N, K}; EpiAdapt<F> E{f};
    pg8::gemm_phase<EpiAdapt<F>, Sched, true, true, true>((PG8_LAS unsigned char*)c.lds, g, S, E, c.tid, s2t);
}
template <class Sched, class F>
__device__ __forceinline__ void gemm_any(const Ctx& c, const bf16* A, const bf16* Bt, int M, int N, int K, const Sched& S, const F& f) {
    pg8::Gemm g{A, Bt, M, N, K}; EpiAdapt<F> E{f};
    pg8::gemm_phase<EpiAdapt<F>, Sched, true, true>((PG8_LAS unsigned char*)c.lds, g, S, E, c.tid);
}

#define LAS __attribute__((address_space(3)))
#define XB_TMO      128
#define XB_XCNT(j)  (256  + 64 * (j))
#define XB_XSUB(j)  (1280 + 64 * (j))
#define XB_XGEN(j)  (2304 + 64 * (j))
#define XB_TOP      3328
#define XB_TOPGEN   3392
#define XCD_BAR_WORDS 3456
#define XB_SPIN_CAP (1u << 24)

__device__ __forceinline__ unsigned xb_ld(unsigned* p)              { return __hip_atomic_load(p, __ATOMIC_RELAXED, __HIP_MEMORY_SCOPE_AGENT); }
__device__ __forceinline__ unsigned xb_add(unsigned* p, unsigned v) { return __hip_atomic_fetch_add(p, v, __ATOMIC_RELAXED, __HIP_MEMORY_SCOPE_AGENT); }
__device__ __forceinline__ unsigned xb_xcc_id() { return (unsigned)__builtin_amdgcn_s_getreg((3 << 11) | 20) & 0xFu; }
#define XB_SPIN(cond, bar) do { unsigned _sp = 0; while (cond) { __builtin_amdgcn_s_sleep(1); \
    if ((++_sp & 255u) == 0u) { if (xb_ld(&(bar)[XB_TMO])) break; if (_sp > XB_SPIN_CAP) { atomicAdd(&(bar)[XB_TMO], 1u); break; } } } } while (0)

struct XcdBarrier {
    unsigned* bar; unsigned x;
    volatile LAS unsigned* st;
};

__device__ __forceinline__ XcdBarrier xcd_barrier_post(unsigned* bar, volatile LAS unsigned* st) {
    XcdBarrier b; b.bar = bar; b.x = xb_xcc_id(); b.st = st;
    if (threadIdx.x == 0) (void)xb_add(&bar[XB_XCNT(b.x)], 1u);
    return b;
}
__device__ __forceinline__ void xcd_barrier_complete(unsigned* bar, unsigned x, unsigned& nloc, unsigned& nx) {
    const unsigned G = gridDim.x * gridDim.y * gridDim.z;
    unsigned sum, cnt, mine, sp = 0u;
    for (;;) {
        sum = 0u; cnt = 0u; mine = 0u;
#pragma unroll
        for (unsigned j = 0; j < 16; ++j) { const unsigned c = xb_ld(&bar[XB_XCNT(j)]); sum += c; cnt += (c > 0u) ? 1u : 0u; mine = (j == x) ? c : mine; }
        if (sum == G) break;
        __builtin_amdgcn_s_sleep(1);
        if ((++sp & 255u) == 0u) { if (xb_ld(&bar[XB_TMO])) break; if (sp > XB_SPIN_CAP) { atomicAdd(&bar[XB_TMO], 1u); break; } }
    }
    nloc = mine > 0u ? mine : 1u; nx = cnt > 0u ? cnt : 1u;
}

__device__ __forceinline__ void xcd_barrier(const XcdBarrier& b) {
    asm volatile("s_waitcnt vmcnt(0)" ::: "memory");
    __syncthreads();
    if (threadIdx.x == 0) {
        unsigned* bar = b.bar;
        __builtin_amdgcn_s_waitcnt(0);
        unsigned nloc = b.st[0], nx = b.st[1];
        if (nloc == 0u) { xcd_barrier_complete(bar, b.x, nloc, nx); b.st[0] = nloc; b.st[1] = nx; }
        const unsigned old = xb_add(&bar[XB_XSUB(b.x)], 1u);
        const unsigned gen = old / nloc;
        if (old + 1u == (gen + 1u) * nloc) {
            __builtin_amdgcn_fence(__ATOMIC_RELEASE, "agent");
            asm volatile("s_waitcnt vmcnt(0)" ::: "memory");
            const unsigned og = xb_add(&bar[XB_TOP], 1u);
            const unsigned tg = og / nx;
            if (og + 1u == (tg + 1u) * nx) xb_add(&bar[XB_TOPGEN], 1u);
            else XB_SPIN(xb_ld(&bar[XB_TOPGEN]) == tg, bar);
            __builtin_amdgcn_fence(__ATOMIC_ACQUIRE, "agent");
            xb_add(&bar[XB_XGEN(b.x)], 1u);
            asm volatile("s_waitcnt vmcnt(0)" ::: "memory");
        } else {
            XB_SPIN(xb_ld(&bar[XB_XGEN(b.x)]) == gen, bar);
            __builtin_amdgcn_fence(__ATOMIC_ACQUIRE, "agent");
            asm volatile("s_waitcnt vmcnt(0)" ::: "memory");
        }
    }
    __syncthreads();
}


constexpr int PH_PER_LAYER = 12, N_PHASES = 2 + PH_PER_LAYER * DEPTH;
constexpr int CW_BAR = 4096;
constexpr int CW_RDY = 65536;
constexpr int LDS_BYTES = 147456, LDSCTL_OFF = 131072 + 8192;
#ifndef SINGLE_LAUNCH
#define SINGLE_LAUNCH 1
#endif

#ifndef PROBE_A
#define PROBE_A -1
#endif
#ifndef PROBE_B
#define PROBE_B -1
#endif
constexpr size_t WS_TS = 512 * 1024;
#if PROBE_A >= 0
#define STAMP(i) do { if (blockIdx.x == 0 && threadIdx.x == 0) ((unsigned long long*)(args_here()->ws + WS_TS))[(i)] = __builtin_amdgcn_s_memrealtime(); } while (0)
#else
#define STAMP(i) do { } while (0)
#endif
__device__ __forceinline__ const __attribute__((address_space(4))) Args* args_here() { const __attribute__((address_space(4))) Args* p = (const __attribute__((address_space(4))) Args*)__builtin_amdgcn_kernarg_segment_ptr(); asm volatile("" : "+s"(p)); return p; }
#ifndef REP_K
#define REP_K -1
#endif
__device__ __forceinline__ Ctx mkctx(int wave_s, unsigned char* lds) { Ctx c; c.wave = wave_s; c.lane = (int)__builtin_amdgcn_mbcnt_hi(~0u, __builtin_amdgcn_mbcnt_lo(~0u, 0u)); c.tid = wave_s * 64 + c.lane;
    c.gw = blockIdx.x * NWAVES + wave_s; c.ngw = gridDim.x * NWAVES; c.lds = lds; return c; }
#define PHASE1(k, ...) do { const __attribute__((address_space(4))) Args* ap_ = args_here(); if (ap_->ph_lo <= (k) && (k) < ap_->ph_hi) { ArgsR a = *ap_; const Ctx c = mkctx(wave_s, lds); __VA_ARGS__ } } while (0)
#define PHASE(k, ...) do { PHASE1(k, __VA_ARGS__); if ((k) == REP_K) { xcd_barrier(bar); PHASE1(k, __VA_ARGS__); xcd_barrier(bar); PHASE1(k, __VA_ARGS__); } } while (0)

template <int L>
__device__ __forceinline__ void run_layer(const int wave_s, unsigned char* lds, const XcdBarrier& bar) {
    const int G = gridDim.x, b = blockIdx.x;
#define BAR() do { xcd_barrier(bar); STAMP(3 + 14 * L + (bk_++)); } while (0)
    int bk_ = 0;
    PHASE(0, unsigned char* ws = a.ws; pg8::StaticOrder S; S.init(T, INC, G, b); EpiZ E{(bf16*)(ws + WS_ZR), (bf16*)(ws + WS_ZS), (bf16*)(ws + WS_ZG)};
        gemm_any(c, (const bf16*)(ws + WS_XN), (const bf16*)(ws + WS_WIN + (size_t)L * 10 * MiB), T, INC, D, S, E); );
    BAR();
    PHASE(1, phase_prep_fast(a, c, L); );
    PHASE(14, phase_sg_fast(a, c, L); );
    BAR();
#if REP_K == 21
    PHASE1(2, phase_scan1m(a, c, 1); ); xcd_barrier(bar); PHASE1(2, phase_scan1m(a, c, 1); ); xcd_barrier(bar);
#endif
    PHASE(2, phase_scan1m(a, c); );
    BAR();
    PHASE(3, phase_scan2a(a, c); );
    BAR();
    PHASE(31, phase_scan2b(a, c); );
    PHASE(33, expert_convert(a, c, L, NH); );
    BAR();
    PHASE(4, phase_scan3m(a, c, L); );
    BAR();
    PHASE(6, unsigned char* ws = a.ws; pg8::StaticOrder S; S.init(T, D, G, b); EpiGA E{(const bf16*)(ws + WS_ZG), (bf16*)(ws + WS_MP)};
        gemm_any(c, (const bf16*)(ws + WS_YA), (const bf16*)(ws + WS_WA + (size_t)L * WS_WL1), T, D, W, S, E); );
    BAR();
#if REP_K == 7
    PHASE1(7, unsigned char* ws = a.ws; pg8::StaticOrder S; S.init(T, D, G, b); EpiGB E{(const bf16*)(ws + WS_ZG), (const bf16*)(ws + WS_MP), (bf16*)(ws + WS_ZR)};
        gemm_any(c, (const bf16*)(ws + WS_YB), (const bf16*)(ws + WS_WB + (size_t)L * WS_WL1), T, D, W, S, E); ); xcd_barrier(bar);
    PHASE1(7, unsigned char* ws = a.ws; pg8::StaticOrder S; S.init(T, D, G, b); EpiGB E{(const bf16*)(ws + WS_ZG), (const bf16*)(ws + WS_MP), (bf16*)(ws + WS_ZR)};
        gemm_any(c, (const bf16*)(ws + WS_YB), (const bf16*)(ws + WS_WB + (size_t)L * WS_WL1), T, D, W, S, E); ); xcd_barrier(bar);
#endif
#if REP_K == 8
    PHASE1(8, unsigned char* ws = a.ws; pg8::StaticOrder S; S.init(T, D, G, b); EpiOut E{L == 0 ? a.in[I_X] : a.out, (bf16*)(ws + WS_R), (const float*)(ws + WS_MODF) + L * 6144 + 2048};
        gemm_any(c, (const bf16*)(ws + WS_MP), (const bf16*)(ws + WS_WO + (size_t)L * WS_WL1), T, D, D, S, E); ); xcd_barrier(bar);
    PHASE1(8, unsigned char* ws = a.ws; pg8::StaticOrder S; S.init(T, D, G, b); EpiOut E{L == 0 ? a.in[I_X] : a.out, (bf16*)(ws + WS_R), (const float*)(ws + WS_MODF) + L * 6144 + 2048};
        gemm_any(c, (const bf16*)(ws + WS_MP), (const bf16*)(ws + WS_WO + (size_t)L * WS_WL1), T, D, D, S, E); ); xcd_barrier(bar);
#endif
    PHASE1(7, unsigned char* ws = a.ws; pg8::StaticOrder S; S.init(T, D, G, b); EpiGB E{(const bf16*)(ws + WS_ZG), (const bf16*)(ws + WS_MP), (bf16*)(ws + WS_MP)};
        gemm_any(c, (const bf16*)(ws + WS_YB), (const bf16*)(ws + WS_WB + (size_t)L * WS_WL1), T, D, W, S, E); );
    BAR();
    PHASE1(8, unsigned char* ws = a.ws; pg8::StaticOrder S; S.init(T, D, G, b); EpiOut E{L == 0 ? a.in[I_X] : a.out, (bf16*)(ws + WS_TMP), (const float*)(ws + WS_MODF) + L * 6144 + 2048};
        gemm_any(c, (const bf16*)(ws + WS_MP), (const bf16*)(ws + WS_WO + (size_t)L * WS_WL1), T, D, D, S, E); );
    BAR();
#if REP_K == 9
    PHASE1(9, phase_ln1(a, c, L, (float*)(a.ws + WS_ZR)); ); xcd_barrier(bar); PHASE1(9, phase_ln1(a, c, L, (float*)(a.ws + WS_ZR)); ); xcd_barrier(bar);
#endif
#if REP_K == 91
    PHASE1(9, phase_ln1(a, c, L, (float*)(a.ws + WS_ZR), 1); ); xcd_barrier(bar); PHASE1(9, phase_ln1(a, c, L, (float*)(a.ws + WS_ZR), 1); ); xcd_barrier(bar);
#endif
#if REP_K == 92
    PHASE1(9, phase_ln1(a, c, L, (float*)(a.ws + WS_ZR), 2); ); xcd_barrier(bar); PHASE1(9, phase_ln1(a, c, L, (float*)(a.ws + WS_ZR), 2); ); xcd_barrier(bar);
#endif
    PHASE1(9, phase_ln1(a, c, L, a.out); );
    BAR();
    PHASE(10, phase_perm(a, c, L); );
    BAR();
    PHASE(11, unsigned char* ws = a.ws; MoeSchedA S; S.init((const unsigned*)(ws + WS_TOT), G, b); EpiSwi E{(bf16*)(ws + WS_HID)};
        gemm_gather(c, (const bf16*)(ws + WS_XN), (const int*)(ws + WS_S2T), (const bf16*)(ws + WS_WGU), MAXSLOT, NE * 1024, D, S, E); );
    BAR();
    PHASE(12, unsigned char* ws = a.ws; unsigned* rdy = (unsigned*)(ws + WS_CTL) + CW_RDY + L * 16384;
        { MoeSchedT S; S.init((const unsigned*)(ws + WS_TOT), G, b); S.rdy = rdy; EpiSwiWT E{(bf16*)(ws + WS_HID)};
          gemm_gather(c, (const bf16*)(ws + WS_XN), (const int*)(ws + WS_S2T), (const bf16*)(ws + WS_WGU), MAXSLOT, NE * 1024, D, S, E); }
        { MoeSchedB S; S.init((const unsigned*)(ws + WS_TOT), G, b); S.rdy = rdy; S.tmo = (unsigned*)(ws + WS_CTL) + CW_BAR + XB_TMO; S.wave = c.wave;
          EpiDown E{(const int*)(ws + WS_S2T), (const float*)(ws + WS_TOKW), (bf16*)(ws + WS_Y)};
          gemm_any(c, (const bf16*)(ws + WS_HID), (const bf16*)(ws + WS_WD), MAXSLOT, NE * 1024, FF, S, E); } );
    BAR();
#if REP_K == 13
    PHASE1(13, phase_ln2(a, c, L, (float*)(a.ws + WS_R)); ); xcd_barrier(bar); PHASE1(13, phase_ln2(a, c, L, (float*)(a.ws + WS_R)); ); xcd_barrier(bar);
#endif
    PHASE1(13, phase_ln2(a, c, L, a.out); );
    if (L + 1 < DEPTH) BAR();
    (void)bk_;
#undef BAR
}

__global__ void __launch_bounds__(NTHREADS, 2) mk_fwd(Args a_unused) {
    extern __shared__ __attribute__((aligned(16))) unsigned char lds[];
    const int wave_s = __builtin_amdgcn_readfirstlane(threadIdx.x >> 6);
    for (int u = threadIdx.x; u < (LDS_BYTES - LDSCTL_OFF) / 4; u += NTHREADS) ((LAS unsigned*)((LAS unsigned char*)lds + LDSCTL_OFF))[u] = 0u;
    __syncthreads();
    const XcdBarrier bar = xcd_barrier_post((unsigned*)(args_here()->ws + WS_CTL) + CW_BAR, (volatile LAS unsigned*)((LAS unsigned char*)lds + LDSCTL_OFF) + 8);
    STAMP(0);
    PHASE(100, phase_p0a(a, c); );
    xcd_barrier(bar); STAMP(1);
    PHASE(101, phase_p0b(a, c); );
    xcd_barrier(bar); STAMP(2);
    run_layer<0>(wave_s, lds, bar);
    run_layer<1>(wave_s, lds, bar);
#if PROBE_A >= 0
    if (blockIdx.x == 0) {
        asm volatile("s_waitcnt vmcnt(0)" ::: "memory"); __syncthreads();
        if (threadIdx.x == 0) ((unsigned long long*)(args_here()->ws + WS_TS))[30] = __builtin_amdgcn_s_memrealtime();
        asm volatile("s_waitcnt vmcnt(0)" ::: "memory"); __syncthreads();
        const volatile unsigned long long* ts = (const volatile unsigned long long*)(args_here()->ws + WS_TS);
        float da = 0.f, db = 0.f;
        if (PROBE_A < 14) { da = (float)(ts[3 + PROBE_A] - ts[2 + PROBE_A]) + (float)(ts[17 + PROBE_A] - ts[16 + PROBE_A]); } else if (PROBE_A == 14) da = (float)(ts[1] - ts[0]); else if (PROBE_A == 15) da = (float)(ts[2] - ts[1]); else da = (float)(ts[30] - ts[0]);
        if (PROBE_B >= 0 && PROBE_B < 14) { db = (float)(ts[3 + PROBE_B] - ts[2 + PROBE_B]) + (float)(ts[17 + PROBE_B] - ts[16 + PROBE_B]); } else if (PROBE_B == 14) db = (float)(ts[1] - ts[0]); else if (PROBE_B == 15) db = (float)(ts[2] - ts[1]);
        da *= 0.01f; db *= 0.01f;
        da = exp2f(0.25f * rintf(4.0f * log2f(fmaxf(da, 0.5f)))); db = exp2f(0.25f * rintf(4.0f * log2f(fmaxf(db, 0.5f))));
        float* out = args_here()->out;
        for (int i = threadIdx.x; i < 16 * 1024; i += NTHREADS) { const int r = i >> 10, col = i & 1023; const int rowi = (r & 7) + 2048 * (r >> 3); out[(size_t)rowi * D + col] = da; }
        if (threadIdx.x == 0 && PROBE_B >= 0) out[(size_t)4096 * D] = 100.0f * db;
    }
#endif
}

extern "C" void kernel_launch(void* const* d_in, const int* in_sizes, int n_in, void* d_out, int out_size, void* d_ws, size_t ws_size, hipStream_t stream) {
    static int grid = 0;
    if (grid == 0) {
        if (n_in != N_IN || out_size != T * D || ws_size < WS_END2) { fprintf(stderr, "kernel_launch: unexpected shapes: n_in %d out %d ws %zu (need %zu)\n", n_in, out_size, ws_size, (size_t)WS_END2); grid = -1; return; }
        int dev = 0, cus = 0;
        (void)hipGetDevice(&dev); (void)hipDeviceGetAttribute(&cus, hipDeviceAttributeMultiprocessorCount, dev);
        if (hipFuncSetAttribute((const void*)mk_fwd, hipFuncAttributeMaxDynamicSharedMemorySize, LDS_BYTES) != hipSuccess) { fprintf(stderr, "kernel_launch: hipFuncSetAttribute failed\n"); grid = -1; return; }
        grid = cus > 0 ? (cus & ~3) : 256;
        fprintf(stderr, "kernel_launch: ws_size %zu grid %d\n", ws_size, grid);
    }
    if (grid < 0) return;
    (void)hipMemsetAsync((char*)d_ws + WS_CTL, 0, CTL_BYTES, stream);
    Args a{};
    for (int i = 0; i < N_IN; ++i) a.in[i] = (const float*)d_in[i];
    a.out = (float*)d_out; a.ws = (unsigned char*)d_ws;
    a.ph_lo = 0; a.ph_hi = 1000;
    hipLaunchKernelGGL(mk_fwd, dim3(grid), dim3(NTHREADS), LDS_BYTES, stream, a);
}
```

```cpp
#include <hip/hip_runtime.h>
#include <cstdio>
#include <cstdint>
#include <utility>

typedef unsigned short bf16;
typedef _Float16 f16;
typedef float f32x4 __attribute__((ext_vector_type(4)));
typedef unsigned u32x4 __attribute__((ext_vector_type(4)));
typedef unsigned u32x2 __attribute__((ext_vector_type(2)));

constexpr int T = 16384, D = 1024, W = 512, NH = 8, HN = 64, RC = 1792, INC = 4864;
constexpr int NE = 16, FF = 512, DEPTH = 2;
constexpr float LN_EPS = 1e-5f, GN_EPS = 64e-5f, ALPHA = 1.41421356237f;
constexpr int NTHREADS = 512, NWAVES = 8;
constexpr int MAXSLOT = 36864;

constexpr size_t MiB = 1u << 20;
constexpr size_t WS_CTL = 0, CTL_BYTES = 1 * MiB;
constexpr int CW_CNT = 16384;
constexpr size_t WS_PART = 1 * MiB;
constexpr size_t WS_MODF = 2 * MiB;
constexpr size_t WS_TOKI = 2 * MiB + 65536;
constexpr size_t WS_TOKW = WS_TOKI + 131072;
constexpr size_t WS_TOKP = WS_TOKW + 131072;
constexpr size_t WS_S2T = 3 * MiB;
constexpr size_t WS_BLKCNT = 3 * MiB + 512 * 1024;
constexpr size_t WS_TOT = WS_BLKCNT + 32768;
constexpr size_t WS_LORA = 4 * MiB;
constexpr size_t WS_WIN = 8 * MiB;
constexpr size_t WS_WA = 28 * MiB, WS_WB = 29 * MiB, WS_WO = 30 * MiB, WS_WL1 = 4 * MiB;
constexpr size_t WS_ZG = 36 * MiB;
constexpr size_t WS_XN = 100 * MiB;
constexpr size_t WS_G = 100 * MiB, WS_YB = 116 * MiB;
constexpr size_t WS_ZR = 132 * MiB;
constexpr size_t WS_ZS = 188 * MiB;
constexpr size_t WS_YSC = 132 * MiB;
constexpr size_t WS_ST = 132 * MiB;
constexpr size_t WS_YA = 188 * MiB;
constexpr size_t WS_MP = 132 * MiB;
constexpr size_t WS_TMP = 164 * MiB;
constexpr size_t WS_XS = 132 * MiB;
constexpr size_t WS_Y = 132 * MiB;
constexpr size_t WS_AA = 224 * MiB, WS_BB = 240 * MiB, WS_WM1 = 256 * MiB, WS_R = 272 * MiB, WS_KP = 288 * MiB, WS_V = 304 * MiB;
constexpr size_t WS_WGU = 224 * MiB;
constexpr size_t WS_WD = 256 * MiB;
constexpr size_t WS_HID = 272 * MiB;
constexpr size_t WS_VF = 320 * MiB;
constexpr size_t WS_END = 336 * MiB;

constexpr size_t LO_W2T = 0, LO_A2T = 65536, LO_G2T = 131072, LO_VM1T = 262144, LO_VM2T = 294912, LO_STRIDE = 524288;

enum { I_X = 0, I_C, I_WMOD, I_BMOD, I_WIN, I_MU, I_W0, I_W2, I_A0, I_A2, I_G2, I_KK, I_KA, I_RK, I_GNG, I_GNB, I_VM0, I_VM1, I_VM2,
       I_SGG, I_SGB, I_WS, I_BS, I_WBA, I_WBB, I_WOUT, I_LN1G, I_LN1B, I_RW, I_RB, I_EG, I_EU, I_ED, I_LN2G, I_LN2B, N_IN };

struct Args { const float* in[N_IN]; float* out; unsigned char* ws; int ph_lo, ph_hi; };
typedef const __attribute__((address_space(4))) Args& ArgsR;

__device__ __forceinline__ float bf2f(bf16 h) { return __uint_as_float(((unsigned)h) << 16); }
__device__ __forceinline__ unsigned f2bfu(float f) { unsigned u = __float_as_uint(f); return (u + 0x7fffu + ((u >> 16) & 1u)) >> 16; }
__device__ __forceinline__ bf16 f2bf(float f) { return __builtin_bit_cast(unsigned short, (__bf16)f); }
typedef __bf16 bf16x2_t __attribute__((ext_vector_type(2)));
__device__ __forceinline__ unsigned pk2(float lo, float hi) { bf16x2_t v; v[0] = (__bf16)lo; v[1] = (__bf16)hi; return __builtin_bit_cast(unsigned, v); }
__device__ __forceinline__ void store4bf(bf16* p, f32x4 v) { u32x2 w; w.x = pk2(v[0], v[1]); w.y = pk2(v[2], v[3]); *(u32x2*)p = w; }
__device__ __forceinline__ f32x4 load4bf(const bf16* p) { u32x2 w = *(const u32x2*)p; f32x4 r; r[0] = __uint_as_float(w.x << 16); r[1] = __uint_as_float(w.x & 0xffff0000u); r[2] = __uint_as_float(w.y << 16); r[3] = __uint_as_float(w.y & 0xffff0000u); return r; }
__device__ __forceinline__ float wave_sum(float v) {
    v += __builtin_bit_cast(float, __builtin_amdgcn_update_dpp(0, __builtin_bit_cast(int, v), 0xB1, 0xF, 0xF, true));
    v += __builtin_bit_cast(float, __builtin_amdgcn_update_dpp(0, __builtin_bit_cast(int, v), 0x4E, 0xF, 0xF, true));
    v += __builtin_bit_cast(float, __builtin_amdgcn_update_dpp(0, __builtin_bit_cast(int, v), 0x141, 0xF, 0xF, true));
    v += __builtin_bit_cast(float, __builtin_amdgcn_update_dpp(0, __builtin_bit_cast(int, v), 0x140, 0xF, 0xF, true));
    v += __builtin_bit_cast(float, __builtin_amdgcn_update_dpp(0, __builtin_bit_cast(int, v), 0x142, 0xA, 0xF, false));
    v += __builtin_bit_cast(float, __builtin_amdgcn_update_dpp(0, __builtin_bit_cast(int, v), 0x143, 0xC, 0xF, false));
    return __builtin_bit_cast(float, __builtin_amdgcn_readlane(__builtin_bit_cast(int, v), 63));
}
__device__ __forceinline__ float sigmoidf_(float x) { return __builtin_amdgcn_rcpf(1.0f + __expf(-x)); }
__device__ __forceinline__ float siluf_(float x) { return x * sigmoidf_(x); }
__device__ __forceinline__ float gelu_tanh(float x) { const float u = 0.7978845608028654f * (x + 0.044715f * x * x * x); return x * (1.0f - __builtin_amdgcn_rcpf(1.0f + __expf(2.0f * u))); }
__device__ __forceinline__ float softplusf_(float y) { return fmaxf(y, 0.f) + log1pf(__expf(-fabsf(y))); }

struct Ctx { int tid, lane, wave, gw, ngw; unsigned char* lds; };

__device__ __forceinline__ void transpose_item(const float* Wsrc, int N, int k0, int n0, bf16* dst, int ldk, float* scr, int lane) {
    float tv[32];
#pragma unroll
    for (int i = 0; i < 32; ++i) tv[i] = Wsrc[(size_t)(k0 + 2 * i + (lane >> 5)) * N + n0 + (lane & 31)];
#pragma unroll
    for (int i = 0; i < 32; ++i) scr[(2 * i + (lane >> 5)) * 33 + (lane & 31)] = tv[i];
    asm volatile("s_waitcnt lgkmcnt(0)" ::: "memory");
    const int c = lane & 7;
#pragma unroll
    for (int j = 0; j < 4; ++j) { const int n = (lane >> 3) + 8 * j; const float* s = scr + (8 * c) * 33 + n;
        u32x4 o; o.x = pk2(s[0 * 33], s[1 * 33]); o.y = pk2(s[2 * 33], s[3 * 33]); o.z = pk2(s[4 * 33], s[5 * 33]); o.w = pk2(s[6 * 33], s[7 * 33]);
        *(u32x4*)(dst + (size_t)n * ldk + k0 + 8 * c) = o; }
    asm volatile("s_waitcnt lgkmcnt(0)" ::: "memory");
}
template <class RowMap>
__device__ __forceinline__ void transpose_matrix_item(const float* Wsrc, int K, int N, bf16* dst, int item, float* scr, int lane, const RowMap& rm) {
    const int nblk = N / 32, kb = item / nblk, nb = item % nblk, n0 = 32 * nb;
    transpose_item(Wsrc, N, 64 * kb, n0, dst + (size_t)rm(n0) * K, K, scr, lane);
}
struct RowId { __device__ __forceinline__ int operator()(int n) const { return n; } };
struct RowGU { int up; __device__ __forceinline__ int operator()(int n) const { return (n >> 7) * 256 + (n & 127) + up * 128; } };

__device__ __forceinline__ void phase_p0a(ArgsR a, const Ctx& c) {
    float* scr = (float*)(c.lds + c.wave * 16384);
    { float* MODF = (float*)(a.ws + WS_MODF); float* red = (float*)(c.lds + 131072);
      for (int cbk = blockIdx.x; cbk < 2 * 96; cbk += gridDim.x) {
          const int l = cbk / 96, n = (cbk % 96) * 64 + c.lane;
          const float* wm = a.in[I_WMOD] + (size_t)l * D * 6144 + (size_t)(c.wave * 128) * 6144 + n;
          float acc0 = 0.f, acc1 = 0.f;
#pragma unroll 16
          for (int k = 0; k < 128; k += 2) { acc0 += siluf_(a.in[I_C][c.wave * 128 + k]) * wm[(size_t)k * 6144]; acc1 += siluf_(a.in[I_C][c.wave * 128 + k + 1]) * wm[(size_t)(k + 1) * 6144]; }
          red[c.wave * 64 + c.lane] = acc0 + acc1;
          __syncthreads();
          if (c.wave == 0) { float sacc = a.in[I_BMOD][l * 6144 + n];
#pragma unroll
              for (int w = 0; w < 8; ++w) sacc += red[w * 64 + c.lane];
              MODF[l * 6144 + n] = sacc; }
          __syncthreads();
      } }
    for (int it = c.gw; it < 2 * (16 + 16 + 32 + 8); it += c.ngw) {
        const int l = it / 72; int r = it % 72; unsigned char* lo = a.ws + WS_LORA + (size_t)l * LO_STRIDE;
        if (r < 16) { transpose_matrix_item(a.in[I_W2] + (size_t)l * 64 * W, 64, W, (bf16*)(lo + LO_W2T), r, scr, c.lane, RowId()); continue; } r -= 16;
        if (r < 16) { transpose_matrix_item(a.in[I_A2] + (size_t)l * 64 * W, 64, W, (bf16*)(lo + LO_A2T), r, scr, c.lane, RowId()); continue; } r -= 16;
        if (r < 32) { transpose_matrix_item(a.in[I_G2] + (size_t)l * 128 * W, 128, W, (bf16*)(lo + LO_G2T), r, scr, c.lane, RowId()); continue; } r -= 32;
        if (l == 1) transpose_matrix_item(a.in[I_VM1], W, 32, (bf16*)(lo + LO_VM1T), r, scr, c.lane, RowId());
    }
    for (int i = blockIdx.x * NTHREADS + c.tid; i < 32 * W; i += gridDim.x * NTHREADS) { const int n = i >> 5, k = i & 31;
        ((bf16*)(a.ws + WS_LORA + LO_STRIDE + LO_VM2T))[i] = f2bf(a.in[I_VM2][(size_t)k * W + n]); }
    constexpr int I_WINL = (D / 64) * (INC / 32);
    constexpr int I_WAL = (W / 64) * (D / 32);
    constexpr int I_WOL = (D / 64) * (D / 32);
    constexpr int PER_L = I_WINL + 2 * I_WAL + I_WOL;
    for (int it = c.gw; it < 2 * PER_L; it += c.ngw) {
        const int l = it / PER_L; int r = it % PER_L;
        if (r < I_WINL) { transpose_matrix_item(a.in[I_WIN] + (size_t)l * D * INC, D, INC, (bf16*)(a.ws + WS_WIN + (size_t)l * 10 * MiB), r, scr, c.lane, RowId()); continue; } r -= I_WINL;
        if (r < I_WAL) { transpose_matrix_item(a.in[I_WBA] + (size_t)l * W * D, W, D, (bf16*)(a.ws + WS_WA + (size_t)l * WS_WL1), r, scr, c.lane, RowId()); continue; } r -= I_WAL;
        if (r < I_WAL) { transpose_matrix_item(a.in[I_WBB] + (size_t)l * W * D, W, D, (bf16*)(a.ws + WS_WB + (size_t)l * WS_WL1), r, scr, c.lane, RowId()); continue; } r -= I_WAL;
        transpose_matrix_item(a.in[I_WOUT] + (size_t)l * D * D, D, D, (bf16*)(a.ws + WS_WO + (size_t)l * WS_WL1), r, scr, c.lane, RowId());
    }
}

__device__ __forceinline__ void row_stats(const float (&v)[16], float& mean, float& rstd) {
    float s = 0.f;
#pragma unroll
    for (int j = 0; j < 16; ++j) s += v[j];
    mean = wave_sum(s) * (1.f / D);
    float q = 0.f;
#pragma unroll
    for (int j = 0; j < 16; ++j) { const float d = v[j] - mean; q += d * d; }
    rstd = __builtin_amdgcn_rsqf(wave_sum(q) * (1.f / D) + LN_EPS);
}
__device__ __forceinline__ void load_row16bf(const bf16* p, int lane, float (&v)[16]) {
#pragma unroll
    for (int j = 0; j < 4; ++j) { const f32x4 x = load4bf(p + 4 * lane + 256 * j); v[4 * j] = x[0]; v[4 * j + 1] = x[1]; v[4 * j + 2] = x[2]; v[4 * j + 3] = x[3]; }
}
__device__ __forceinline__ void load_row16(const float* p, int lane, float (&v)[16]) {
#pragma unroll
    for (int j = 0; j < 4; ++j) { const f32x4 x = *(const f32x4*)(p + 4 * lane + 256 * j); v[4 * j] = x[0]; v[4 * j + 1] = x[1]; v[4 * j + 2] = x[2]; v[4 * j + 3] = x[3]; }
}

__device__ __forceinline__ void phase_p0b(ArgsR a, const Ctx& c) {
    const float* MODF = (const float*)(a.ws + WS_MODF);
    float sh[16], sc[16];
#pragma unroll
    for (int j = 0; j < 4; ++j) { const f32x4 s0 = *(const f32x4*)(MODF + 4 * c.lane + 256 * j), s1 = *(const f32x4*)(MODF + 1024 + 4 * c.lane + 256 * j);
#pragma unroll
        for (int e = 0; e < 4; ++e) { sh[4 * j + e] = s0[e]; sc[4 * j + e] = 1.f + s1[e]; } }
    bf16* XN = (bf16*)(a.ws + WS_XN);
    for (int m = c.gw; m < T; m += c.ngw) {
        float v[16]; load_row16(a.in[I_X] + (size_t)m * D, c.lane, v);
        float mean, rstd; row_stats(v, mean, rstd);
#pragma unroll
        for (int j = 0; j < 4; ++j) { f32x4 o;
#pragma unroll
            for (int e = 0; e < 4; ++e) o[e] = (v[4 * j + e] - mean) * rstd * sc[4 * j + e] + sh[4 * j + e];
            store4bf(XN + (size_t)m * D + 4 * c.lane + 256 * j, o); }
    }
}

namespace pg8 {
#define PG8_LAS __attribute__((address_space(3)))
typedef unsigned short bf16_t;
typedef short bf16x8 __attribute__((ext_vector_type(8)));
typedef float f32x4 __attribute__((ext_vector_type(4)));
typedef unsigned u32x4 __attribute__((ext_vector_type(4)));
constexpr int BM = 256, BK = 64, HALF = 128, HTB = HALF * BK * 2  , STAGE_BYTES = 8 * HTB, NXCD = 8, WGM = 8;

__host__ __device__ __forceinline__ int lds_byte(int r, int c) { const int st = (r >> 4) * 2 + (c >> 5), rr = r & 15, cc = c & 31, ob = rr * 64 + cc * 2; return st * 1024 + (ob ^ (((ob >> 9) & 1) << 5)); }
__host__ __device__ __forceinline__ void stage_rc(int b, int& R, int& C) { const int st = b / 1024, sb = b % 1024, swz = sb ^ (((sb >> 9) & 1) << 5); R = (st >> 1) * 16 + swz / 64; C = (st & 1) * 32 + (swz % 64) / 2; }
__host__ __device__ __forceinline__ int perm32(int rho) { const int n = rho >> 4, i = rho & 15; return 8 * (i >> 2) + 4 * n + (i & 3); }

struct Unit { int pm, pn; };
struct Gemm { const bf16_t* A; const bf16_t* Bt; int M, N, K; };

struct StaticOrder {
    int nM, nN, nwg, G, c;
    __host__ __device__ void init(int M, int N, int G_, int c_) { nM = M / BM; nN = N / BM; nwg = nM * nN; G = G_; c = c_; }
    __host__ __device__ bool next(int i, Unit& u) const {
        const long L = (long)i * G + c; if (L >= nwg) return false;
        int wgid = (int)L; { const int q = nwg / NXCD, r = nwg % NXCD, xcd = wgid % NXCD, off = wgid / NXCD; wgid = (xcd < r ? xcd * (q + 1) : r * (q + 1) + (xcd - r) * q) + off; }
        const int nig = WGM * nN, gid = wgid / nig, fm = gid * WGM, gsz = (nM - fm) < WGM ? (nM - fm) : WGM;
        u.pm = fm + ((wgid % nig) % gsz); u.pn = (wgid % nig) / gsz; return true;
    }
    __device__ __forceinline__ void a_ready(const Unit&) const {}
    __device__ __forceinline__ void done(const Unit&) const {}
};


template <class Epi, class Sched, bool ALIGN_EPI = false, bool SP2 = false, bool GATHER = false>
__device__ __forceinline__ void gemm_phase(PG8_LAS unsigned char* lds, const Gemm g, const Sched& S, const Epi& E, const int tid_in, const int* s2t = nullptr) {
    const int tid = tid_in, wid = __builtin_amdgcn_readfirstlane(tid >> 6), lane = tid & 63, wr = wid >> 2, wc = wid & 3, fr = lane & 15, fq = lane >> 4;
    const int K = g.K, nt = K / BK;
    unsigned voffA[2], voffB[2];
#pragma unroll
    for (int i = 0; i < 2; ++i) { int R, C; stage_rc(tid * 16 + i * 8192, R, C); const int Rb = Epi::PERM ? ((R & ~31) + perm32(R & 31)) : R;
        voffA[i] = (unsigned)(R * K + C) * 2u; voffB[i] = (unsigned)(Rb * K + C) * 2u; }
    unsigned pc0 = 0u, pc1 = 0u, pn0 = 0u, pn1 = 0u, cvoff = 0u; int R0g = 0;
    if constexpr (GATHER) { int R, C; stage_rc(tid * 16, R, C); R0g = R; cvoff = (unsigned)C * 2u; }
#define PG8_TOKPACK(pm_, h_) ([&]() -> unsigned { const int r0_ = (pm_) * BM + (h_) * HALF + R0g; const int a0_ = s2t[2 * r0_], a1_ = s2t[2 * (r0_ + 64)]; return (unsigned)(a0_ < 0 ? 0 : (a0_ >> 1)) | ((unsigned)(a1_ < 0 ? 0 : (a1_ >> 1)) << 16); }())
#define PG8_STAGE_A(bufoff, base, h, usen) do { if constexpr (GATHER) { const unsigned pk_ = (usen) ? ((h) ? pn1 : pn0) : ((h) ? pc1 : pc0); \
        unsigned vt_[2] = {(pk_ & 0xffffu) * (unsigned)(K * 2) + cvoff, (pk_ >> 16) * (unsigned)(K * 2) + cvoff}; PG8_STAGE(bufoff, base, vt_); } \
    else PG8_STAGE(bufoff, (base) + ((h) ? hstep : (size_t)0), voffA); } while (0)
    const size_t kstep = (size_t)(BK * 2);
    const size_t hstep = (size_t)HALF * K * 2;
    const size_t tstep = 2 * hstep;
    const unsigned ldsw = (unsigned)wid * 1024u;
    const int aoff = lds_byte(wr * 64 + fr, fq * 8), boff = lds_byte(wc * 32 + fr, fq * 8);
#define PG8_SA(b, h) (((b) * 2 + (h)) * HTB)
#define PG8_SB(b, h) ((4 + (b) * 2 + (h)) * HTB)
#define PG8_STAGE(bufoff, gbase, voff) do { _Pragma("unroll") for (int _i = 0; _i < 2; ++_i) \
        __builtin_amdgcn_global_load_lds((const unsigned*)((const char*)(gbase) + (voff)[_i]), (PG8_LAS unsigned*)(lds + (bufoff) + ldsw + _i * 8192), 16, 0, 0); } while (0)
#define PG8_LDA(dst, b, h) do { _Pragma("unroll") for (int m = 0; m < 4; ++m) _Pragma("unroll") for (int k = 0; k < 2; ++k) dst[m][k] = *(const PG8_LAS bf16x8*)(lds + PG8_SA(b, h) + aoff + m * 2048 + k * 1024); } while (0)
#define PG8_LDB(dst, b, h) do { _Pragma("unroll") for (int n = 0; n < 2; ++n) _Pragma("unroll") for (int k = 0; k < 2; ++k) dst[n][k] = *(const PG8_LAS bf16x8*)(lds + PG8_SB(b, h) + boff + n * 2048 + k * 1024); } while (0)
#define PG8_MMA(ai, bj, At, Bt) do { __builtin_amdgcn_s_setprio(1); _Pragma("unroll") for (int m = 0; m < 4; ++m) _Pragma("unroll") for (int n = 0; n < 2; ++n) _Pragma("unroll") for (int k = 0; k < 2; ++k) \
        acc[ai][bj][m][n] = __builtin_amdgcn_mfma_f32_16x16x32_bf16(Bt[n][k], At[m][k], acc[ai][bj][m][n], 0, 0, 0); __builtin_amdgcn_s_setprio(0); } while (0)
#define PG8_WAIT_V(n) asm volatile("s_waitcnt vmcnt(" #n ")" ::: "memory")
#define PG8_WAIT_L(n) asm volatile("s_waitcnt lgkmcnt(" #n ")" ::: "memory")
#define PG8_BAR __builtin_amdgcn_s_barrier()
#define PG8_SCHED __builtin_amdgcn_sched_barrier(0)
    Unit cur, nxt; int ui = 0;
    if (!S.next(0, cur)) return;
    f32x4 acc[2][2][4][2];
#pragma unroll
    for (int a = 0; a < 2; ++a)
#pragma unroll
        for (int b = 0; b < 2; ++b)
#pragma unroll
            for (int m = 0; m < 4; ++m)
#pragma unroll
                for (int n = 0; n < 2; ++n) acc[a][b][m][n] = (f32x4){0.f, 0.f, 0.f, 0.f};
    bf16x8 At[4][2], B0[2][2], B1[2][2];
    const char* cA = (const char*)g.A + (GATHER ? (size_t)0 : (size_t)cur.pm * tstep); const char* cB = (const char*)g.Bt + (size_t)cur.pn * tstep;
    if constexpr (GATHER) { pc0 = PG8_TOKPACK(cur.pm, 0); pc1 = PG8_TOKPACK(cur.pm, 1); }
    S.a_ready(cur);
    if constexpr (SP2) {
        PG8_STAGE(PG8_SB(0, 0), cB, voffB); PG8_STAGE(PG8_SB(0, 1), cB + hstep, voffB); PG8_STAGE_A(PG8_SA(0, 0), cA, 0, false); PG8_STAGE_A(PG8_SA(0, 1), cA, 1, false);
        if (wr == 1) PG8_BAR;
        PG8_WAIT_V(2); PG8_BAR;
        PG8_STAGE(PG8_SB(1, 0), cB + kstep, voffB); PG8_STAGE_A(PG8_SA(1, 0), cA + kstep, 0, false); PG8_STAGE(PG8_SB(1, 1), cB + hstep + kstep, voffB);
        PG8_WAIT_V(6); PG8_BAR;
    } else {
        PG8_STAGE(PG8_SB(0, 0), cB, voffB); PG8_STAGE(PG8_SA(0, 0), cA, voffA); PG8_STAGE(PG8_SB(0, 1), cB + hstep, voffB); PG8_STAGE(PG8_SA(0, 1), cA + hstep, voffA);
        if (wr == 1) PG8_BAR;
        PG8_WAIT_V(4); PG8_BAR;
        PG8_STAGE(PG8_SB(1, 0), cB + kstep, voffB); PG8_STAGE(PG8_SA(1, 0), cA + kstep, voffA); PG8_STAGE(PG8_SB(1, 1), cB + hstep + kstep, voffB);
        PG8_WAIT_V(6); PG8_BAR;
    }
    for (;;) {
        const bool has_next = S.next(ui + 1, nxt);
        const char* nA = (has_next && !GATHER) ? (const char*)g.A + (size_t)nxt.pm * tstep : cA; const char* nB = has_next ? (const char*)g.Bt + (size_t)nxt.pn * tstep : cB;
        if constexpr (GATHER) { if (has_next) { pn0 = PG8_TOKPACK(nxt.pm, 0); pn1 = PG8_TOKPACK(nxt.pm, 1); } else { pn0 = pc0; pn1 = pc1; } }
        for (int t = 0; t < nt; t += 2) {
            const bool last = (t == nt - 2);
            const char* a1 = cA + (size_t)(t + 1) * kstep;
            const char* a2 = last ? nA : cA + (size_t)(t + 2) * kstep; const char* b2 = last ? nB : cB + (size_t)(t + 2) * kstep;
            const char* a3 = a2 + kstep; const char* b3 = b2 + kstep;
            if (last && has_next) S.a_ready(nxt);
            if constexpr (SP2) {
            PG8_LDB(B0, 0, 0); PG8_LDB(B1, 0, 1); PG8_SCHED; PG8_LDA(At, 0, 0); PG8_STAGE_A(PG8_SA(1, 1), a1, 1, false);
            PG8_WAIT_V(8); PG8_WAIT_L(0); PG8_BAR; PG8_MMA(0, 0, At, B0); PG8_MMA(0, 1, At, B1); PG8_BAR; PG8_SCHED;
            PG8_LDA(At, 0, 1); PG8_STAGE(PG8_SB(0, 0), b2, voffB); PG8_STAGE(PG8_SB(0, 1), b2 + hstep, voffB); PG8_STAGE_A(PG8_SA(0, 0), a2, 0, last);
            PG8_WAIT_V(8); PG8_WAIT_L(0); PG8_BAR; PG8_MMA(1, 0, At, B0); PG8_MMA(1, 1, At, B1); PG8_BAR; PG8_SCHED;
            PG8_LDB(B0, 1, 0); PG8_LDB(B1, 1, 1); PG8_SCHED; PG8_LDA(At, 1, 0); PG8_STAGE_A(PG8_SA(0, 1), a2, 1, last);
            PG8_WAIT_V(8); PG8_WAIT_L(0); PG8_BAR; PG8_MMA(0, 0, At, B0); PG8_MMA(0, 1, At, B1); PG8_BAR; PG8_SCHED;
            PG8_LDA(At, 1, 1); PG8_STAGE(PG8_SB(1, 0), b3, voffB); PG8_STAGE(PG8_SB(1, 1), b3 + hstep, voffB); PG8_STAGE_A(PG8_SA(1, 0), a3, 0, last);
            PG8_WAIT_V(8); PG8_WAIT_L(0); PG8_BAR; PG8_MMA(1, 0, At, B0); PG8_MMA(1, 1, At, B1); PG8_BAR; PG8_SCHED;
            } else {
            PG8_LDB(B0, 0, 0); PG8_SCHED; PG8_LDA(At, 0, 0); PG8_STAGE(PG8_SA(1, 1), a1 + hstep, voffA);
            PG8_WAIT_L(8); PG8_BAR; PG8_WAIT_L(0); PG8_MMA(0, 0, At, B0); PG8_BAR; PG8_SCHED;
            PG8_LDB(B1, 0, 1); PG8_STAGE(PG8_SB(0, 0), b2, voffB);
            PG8_BAR; PG8_WAIT_L(0); PG8_MMA(0, 1, At, B1); PG8_BAR;
            PG8_LDA(At, 0, 1); PG8_STAGE(PG8_SA(0, 0), a2, voffA);
            PG8_BAR; PG8_WAIT_L(0); PG8_MMA(1, 0, At, B0); PG8_BAR; PG8_SCHED;
            PG8_STAGE(PG8_SB(0, 1), b2 + hstep, voffB);
            PG8_WAIT_V(6); PG8_BAR; PG8_MMA(1, 1, At, B1); PG8_BAR;
            PG8_LDB(B0, 1, 0); PG8_SCHED; PG8_LDA(At, 1, 0); PG8_STAGE(PG8_SA(0, 1), a2 + hstep, voffA);
            PG8_WAIT_L(8); PG8_BAR; PG8_WAIT_L(0); PG8_MMA(0, 0, At, B0); PG8_BAR; PG8_SCHED;
            PG8_LDB(B1, 1, 1); PG8_STAGE(PG8_SB(1, 0), b3, voffB);
            PG8_BAR; PG8_WAIT_L(0); PG8_MMA(0, 1, At, B1); PG8_BAR;
            PG8_LDA(At, 1, 1); PG8_STAGE(PG8_SA(1, 0), a3, voffA);
            PG8_BAR; PG8_WAIT_L(0); PG8_MMA(1, 0, At, B0); PG8_BAR; PG8_SCHED;
            PG8_STAGE(PG8_SB(1, 1), b3 + hstep, voffB);
            PG8_WAIT_V(6); PG8_BAR; PG8_MMA(1, 1, At, B1); PG8_BAR;
            }
        }
        if constexpr (ALIGN_EPI) { if (wr == 0) PG8_BAR; }
        if constexpr (!Epi::AFTER_DRAIN) { E(acc, cur, wr, wc, fr, fq); S.done(cur); }
        if (!has_next) break;
#pragma unroll
        for (int a = 0; a < 2; ++a)
#pragma unroll
            for (int b = 0; b < 2; ++b)
#pragma unroll
                for (int m = 0; m < 4; ++m)
#pragma unroll
                    for (int n = 0; n < 2; ++n) acc[a][b][m][n] = (f32x4){0.f, 0.f, 0.f, 0.f};
        cur = nxt; cA = nA; cB = nB; ++ui; if constexpr (GATHER) { pc0 = pn0; pc1 = pn1; }
        if constexpr (ALIGN_EPI) { if (wr == 1) PG8_BAR; }
    }
    PG8_WAIT_V(0);
    if constexpr (!ALIGN_EPI) { if (wr == 0) PG8_BAR; }
    PG8_BAR;
    if constexpr (Epi::AFTER_DRAIN) { E.fused(acc, cur, wr, wc, fr, fq, lds, wid, lane); S.done(cur); }
#undef PG8_SA
#undef PG8_SB
#undef PG8_STAGE
#undef PG8_STAGE_A
#undef PG8_TOKPACK
#undef PG8_LDA
#undef PG8_LDB
#undef PG8_MMA
#undef PG8_WAIT_V
#undef PG8_WAIT_L
#undef PG8_BAR
#undef PG8_SCHED
}
}

using pg8::Unit;
struct DenseSched { int nN, n, G, c;
    __device__ __forceinline__ void a_ready(const Unit&) const {}
    __device__ __forceinline__ void done(const Unit&) const {}
    __device__ __forceinline__ bool next(int i, Unit& u) const { const int L = i * G + c; if (L >= n) return false; u.pm = L / nN; u.pn = L % nN; return true; } };

__device__ __forceinline__ void store8bf(bf16* p, f32x4 lo, f32x4 hi) { u32x4 w; w.x = pk2(lo[0], lo[1]); w.y = pk2(lo[2], lo[3]); w.z = pk2(hi[0], hi[1]); w.w = pk2(hi[2], hi[3]); *(u32x4*)p = w; }
__device__ __forceinline__ void load8bf(const bf16* p, f32x4& lo, f32x4& hi) { const u32x4 w = *(const u32x4*)p;
    lo[0] = __uint_as_float(w.x << 16); lo[1] = __uint_as_float(w.x & 0xffff0000u); lo[2] = __uint_as_float(w.y << 16); lo[3] = __uint_as_float(w.y & 0xffff0000u);
    hi[0] = __uint_as_float(w.z << 16); hi[1] = __uint_as_float(w.z & 0xffff0000u); hi[2] = __uint_as_float(w.w << 16); hi[3] = __uint_as_float(w.w & 0xffff0000u); }
struct EpiZ { bf16 *ZR, *ZS, *ZG;
    __device__ __forceinline__ void one(int row, int col, f32x4 lo, f32x4 hi) const {
        if (col < RC) store8bf(ZR + (size_t)row * RC + col, lo, hi);
        else if (col < RC + 1024) { for (int e = 0; e < 4; ++e) { lo[e] = gelu_tanh(lo[e]); hi[e] = gelu_tanh(hi[e]); } store8bf(ZS + (size_t)row * 1024 + (col - RC), lo, hi); }
        else { for (int e = 0; e < 4; ++e) { lo[e] = sigmoidf_(lo[e]); hi[e] = sigmoidf_(hi[e]); } store8bf(ZG + (size_t)row * 2048 + (col - RC - 1024), lo, hi); } }
    __device__ __forceinline__ void operator()(int row, int col, f32x4 a0, f32x4 a1, f32x4 b0, f32x4 b1) const { one(row, col, a0, a1); one(row, col + 128, b0, b1); } };
struct EpiGA { const bf16* ZG; bf16* MP;
    __device__ __forceinline__ void one(int row, int col, f32x4 lo, f32x4 hi) const { f32x4 g0, g1; load8bf(ZG + (size_t)row * 2048 + col, g0, g1); store8bf(MP + (size_t)row * D + col, g0 * lo, g1 * hi); }
    __device__ __forceinline__ void operator()(int row, int col, f32x4 a0, f32x4 a1, f32x4 b0, f32x4 b1) const { one(row, col, a0, a1); one(row, col + 128, b0, b1); } };
struct EpiGB { const bf16* ZG; const bf16* MPin; bf16* MP;
    __device__ __forceinline__ void one(int row, int col, f32x4 lo, f32x4 hi) const { f32x4 g0, g1, m0, m1; load8bf(ZG + (size_t)row * 2048 + 1024 + col, g0, g1); load8bf(MPin + (size_t)row * D + col, m0, m1);
        store8bf(MP + (size_t)row * D + col, m0 + g0 * lo, m1 + g1 * hi); }
    __device__ __forceinline__ void operator()(int row, int col, f32x4 a0, f32x4 a1, f32x4 b0, f32x4 b1) const { one(row, col, a0, a1); one(row, col + 128, b0, b1); } };
struct EpiOut { const float* xin; bf16* tmp; const float* gate1;
    __device__ __forceinline__ void one(int row, int col, f32x4 lo, f32x4 hi) const { const f32x4 x0 = *(const f32x4*)(xin + (size_t)row * D + col), x1 = *(const f32x4*)(xin + (size_t)row * D + col + 4);
        const f32x4 g0 = *(const f32x4*)(gate1 + col), g1 = *(const f32x4*)(gate1 + col + 4); store8bf(tmp + (size_t)row * D + col, ALPHA * x0 + (1.0f + g0) * lo, ALPHA * x1 + (1.0f + g1) * hi); }
    __device__ __forceinline__ void operator()(int row, int col, f32x4 a0, f32x4 a1, f32x4 b0, f32x4 b1) const { one(row, col, a0, a1); one(row, col + 128, b0, b1); } };
struct EpiSwi { bf16* HID;
    __device__ __forceinline__ void operator()(int row, int col, f32x4 a0, f32x4 a1, f32x4 b0, f32x4 b1) const { const int ct = (col >> 8) & 3, cc = col & 127;
        f32x4 h0, h1; for (int e = 0; e < 4; ++e) { h0[e] = siluf_(a0[e]) * b0[e]; h1[e] = siluf_(a1[e]) * b1[e]; } store8bf(HID + (size_t)row * FF + ct * 128 + cc, h0, h1); } };
struct EpiSwiWT { bf16* HID;
    __device__ __forceinline__ void operator()(int row, int col, f32x4 a0, f32x4 a1, f32x4 b0, f32x4 b1) const { const int ct = (col >> 8) & 3, cc = col & 127;
        const __amdgpu_buffer_rsrc_t rs = __builtin_amdgcn_make_buffer_rsrc((void*)HID, 0, MAXSLOT * FF * 2, 0x00020000);
        f32x4 h0, h1; for (int e = 0; e < 4; ++e) { h0[e] = siluf_(a0[e]) * b0[e]; h1[e] = siluf_(a1[e]) * b1[e]; }
        u32x4 w; w.x = pk2(h0[0], h0[1]); w.y = pk2(h0[2], h0[3]); w.z = pk2(h1[0], h1[1]); w.w = pk2(h1[2], h1[3]);
        __builtin_amdgcn_raw_buffer_store_b128(w, rs, (unsigned)((row * FF + ct * 128 + cc) * 2), 0, 16); } };
struct EpiDown { const int* S2T; const float* TOKW; bf16* Y;
    __device__ __forceinline__ void operator()(int row, int col, f32x4 a0, f32x4 a1, f32x4 b0, f32x4 b1) const { const u32x2 sw = *(const u32x2*)(S2T + 2 * row); const int st = (int)sw.x; if (st < 0) return; const float w = __uint_as_float(sw.y); const int cc = col & 1023;
        store8bf(Y + (size_t)st * D + cc, w * a0, w * a1); store8bf(Y + (size_t)st * D + cc + 128, w * b0, w * b1); } };

struct MoeSched { int ts[17]; int G, c, NU, LA;
    __device__ __forceinline__ void a_ready(const Unit&) const {}
    __device__ __forceinline__ void done(const Unit&) const {}
    __device__ __forceinline__ void init(const unsigned* cnt, int G_, int c_) { G = G_; c = c_; int s = 0;
#pragma unroll
        for (int e = 0; e < 16; ++e) { ts[e] = s; s += ((int)cnt[e] + 255) >> 8; } ts[16] = s; NU = 4 * s; LA = ((NU / G) * G) & ~3; }
    __device__ __forceinline__ void unit_of(int L, Unit& u) const { const int rt = L >> 2, ct = L & 3; int e = 0;
#pragma unroll
        for (int j = 1; j < 16; ++j) e += (rt >= ts[j]) ? 1 : 0;
        u.pm = rt; u.pn = e * 4 + ct; }
    __device__ __forceinline__ bool next(int i, Unit& u) const { const int L = i * G + c; if (L >= NU) return false; unit_of(L, u); return true; } };
struct MoeSchedA : MoeSched {
    __device__ __forceinline__ bool next(int i, Unit& u) const { const int L = i * G + c; if (L >= LA) return false; unit_of(L, u); return true; } };
struct MoeSchedT : MoeSched { unsigned* rdy;
    __device__ __forceinline__ bool next(int i, Unit& u) const { const int L = LA + i * G + c; if (L >= NU) return false; unit_of(L, u); return true; }
    __device__ __forceinline__ void done(const Unit& u) const {
        asm volatile("s_waitcnt vmcnt(0)" ::: "memory");
        if (__builtin_amdgcn_mbcnt_hi(~0u, __builtin_amdgcn_mbcnt_lo(~0u, 0u)) == 0u) (void)__hip_atomic_fetch_add(rdy + 64 * u.pm, 1u, __ATOMIC_RELAXED, __HIP_MEMORY_SCOPE_AGENT); } };
struct MoeSchedB : MoeSched { unsigned* rdy; unsigned* tmo; int wave;
    __device__ __forceinline__ bool next(int i, Unit& u) const { const int NT = NU - LA; int q;
        if (c < NT) { if (i > 0) return false; q = G - NT + c; }
        else { const int p = c - NT; q = (i == 0) ? p : G + p + (i - 1) * (G - NT); }
        if (q >= NU) return false; unit_of(q, u); return true; }
    __device__ __forceinline__ void a_ready(const Unit& u) const {
        if (4 * u.pm < LA) return;
        if (wave == 0) { unsigned sp = 0u;
            while ((unsigned)__builtin_amdgcn_readfirstlane(__hip_atomic_load(rdy + 64 * u.pm, __ATOMIC_RELAXED, __HIP_MEMORY_SCOPE_AGENT)) < 32u) { __builtin_amdgcn_s_sleep(2);
                if ((++sp & 255u) == 0u) { if (__hip_atomic_load(tmo, __ATOMIC_RELAXED, __HIP_MEMORY_SCOPE_AGENT)) break; if (sp > (1u << 24)) { atomicAdd(tmo, 1u); break; } } }
            __builtin_amdgcn_fence(__ATOMIC_ACQUIRE, "agent");
            asm volatile("s_waitcnt vmcnt(0)" ::: "memory"); }
        asm volatile("" ::: "memory"); __builtin_amdgcn_s_barrier(); asm volatile("" ::: "memory"); } };

__device__ __forceinline__ void phase_prep_simple(ArgsR a, const Ctx& c, int l) {
    const bf16* ZR = (const bf16*)(a.ws + WS_ZR);
    const float* mu = a.in[I_MU] + l * RC; const float* w0 = a.in[I_W0] + l * W; const float* w2 = a.in[I_W2] + (size_t)l * 64 * W;
    const float* a0 = a.in[I_A0] + l * W; const float* a2 = a.in[I_A2] + (size_t)l * 64 * W; const float* g2 = a.in[I_G2] + (size_t)l * 128 * W;
    const float* k_k = a.in[I_KK] + l * W; const float* k_a = a.in[I_KA] + l * W;
    const float* vm0 = a.in[I_VM0]; const float* vm1 = a.in[I_VM1]; const float* vm2 = a.in[I_VM2];
    f16* R = (f16*)(a.ws + WS_R); f16* WM1 = (f16*)(a.ws + WS_WM1); f16* KP = (f16*)(a.ws + WS_KP); f16* AA = (f16*)(a.ws + WS_AA); f16* BB = (f16*)(a.ws + WS_BB); f16* V = (f16*)(a.ws + WS_V);
    bf16* G = (bf16*)(a.ws + WS_G); bf16* VF = (bf16*)(a.ws + WS_VF);
    const int lane = c.lane;
    for (int t = c.gw; t < T; t += c.ngw) {
        float z[28];
#pragma unroll
        for (int i = 0; i < 28; ++i) { const int col = lane + 64 * i; const float zc = bf2f(ZR[(size_t)t * RC + col]); const float zp = t > 0 ? bf2f(ZR[(size_t)(t - 1) * RC + col]) : 0.f; z[i] = zc + (zp - zc) * mu[col]; }
        const float tw = tanhf(z[24]), za = z[25], sg0 = sigmoidf_(z[26]), sg1 = sigmoidf_(z[27]);
        float wlo[8], alo[8], gg[8];
#pragma unroll
        for (int i = 0; i < 8; ++i) { wlo[i] = 0.f; alo[i] = 0.f; gg[i] = 0.f; }
        for (int j = 0; j < 64; ++j) { const float tj = __shfl(tw, j), aj = __shfl(za, j), s0 = __shfl(sg0, j), s1 = __shfl(sg1, j);
#pragma unroll
            for (int i = 0; i < 8; ++i) { const int n = lane + 64 * i; wlo[i] += tj * w2[j * W + n]; alo[i] += aj * a2[j * W + n]; gg[i] += s0 * g2[j * W + n] + s1 * g2[(64 + j) * W + n]; } }
        float vv[8];
#pragma unroll
        for (int i = 0; i < 8; ++i) vv[i] = z[16 + i];
        if (l == 0) {
#pragma unroll
            for (int i = 0; i < 8; ++i) VF[(size_t)t * W + lane + 64 * i] = f2bf(vv[i]);
        } else {
            float vmid = 0.f;
#pragma unroll
            for (int i = 0; i < 8; ++i)
                for (int j = 0; j < 64; ++j) { const float vc = __shfl(vv[i], j); vmid += vc * vm1[(size_t)(64 * i + j) * 32 + (lane & 31)]; }
            float vg[8];
#pragma unroll
            for (int i = 0; i < 8; ++i) vg[i] = 0.f;
            for (int m = 0; m < 32; ++m) { const float vmm = __shfl(vmid, m);
#pragma unroll
                for (int i = 0; i < 8; ++i) vg[i] += vmm * vm2[m * W + lane + 64 * i]; }
#pragma unroll
            for (int i = 0; i < 8; ++i) { const int n = lane + 64 * i; const float vf = bf2f(VF[(size_t)t * W + n]); vv[i] = vv[i] + (vf - vv[i]) * sigmoidf_(vm0[n] + vg[i]); }
        }
#pragma unroll
        for (int i = 0; i < 8; ++i) {
            const int n = lane + 64 * i; const size_t o = (size_t)t * W + n;
            const float x = w0[n] + wlo[i]; const float wl = -softplusf_(-x) - 0.5f; const float dm1 = expm1f(-__expf(wl));
            const float av = sigmoidf_(a0[n] + alo[i]);
            const float kraw = z[8 + i];
            float kk = kraw * k_k[n]; const float nrm = sqrtf(wave_sum(kk * kk)); kk = kk / fmaxf(nrm, 1e-12f);
            const float kp = kraw * (1.0f + (av - 1.0f) * k_a[n]);
            R[o] = (f16)z[i]; WM1[o] = (f16)dm1; KP[o] = (f16)kp; AA[o] = (f16)(-kk); BB[o] = (f16)(kk * av); V[o] = (f16)vv[i]; G[o] = f2bf(gg[i]);
        }
    }
}

__device__ __forceinline__ void phase_sg_simple(ArgsR a, const Ctx& c, int l) {
    const bf16* ZS = (const bf16*)(a.ws + WS_ZS); bf16* YB = (bf16*)(a.ws + WS_YB);
    const float* lng = a.in[I_SGG] + l * W; const float* lnb = a.in[I_SGB] + l * W;
    float* vn = (float*)c.lds;
    float* st = vn + 128 * 64;
    for (int uidx = blockIdx.x; uidx < 128 * 8; uidx += gridDim.x) {
        const int ch = uidx >> 3, g = uidx & 7; const int tok0 = ch * 128;
        for (int i = 0; i < 16; ++i) { const int s = c.wave * 16 + i; const bf16* p = ZS + (size_t)(tok0 + s) * 1024 + 512 + c.lane * 8;
            const f32x4 x0 = load4bf(p), x1 = load4bf(p + 4);
            float sm = (x0[0] + x0[1]) + (x0[2] + x0[3]) + (x1[0] + x1[1]) + (x1[2] + x1[3]); const float mean = wave_sum(sm) * (1.f / 512.f);
            float q = 0.f; for (int e = 0; e < 4; ++e) { const float d0 = x0[e] - mean, d1 = x1[e] - mean; q += d0 * d0 + d1 * d1; }
            const float rstd = __builtin_amdgcn_rsqf(wave_sum(q) * (1.f / 512.f) + LN_EPS);
            if (c.lane == 0) { st[2 * s] = mean; st[2 * s + 1] = rstd; } }
        __syncthreads();
        for (int i = c.tid; i < 128 * 64; i += NTHREADS) { const int s = i >> 6, d = i & 63; const float x = bf2f(ZS[(size_t)(tok0 + s) * 1024 + 512 + g * 64 + d]);
            vn[i] = (x - st[2 * s]) * st[2 * s + 1] * lng[g * 64 + d] + lnb[g * 64 + d]; }
        __syncthreads();
        const int d = c.tid & 63, tq = c.tid >> 6;
        const float* Wg = a.in[I_WS] + (size_t)(l * 8 + g) * 128 * 128; const float* bs = a.in[I_BS] + (size_t)(l * 8 + g) * 128;
        for (int i = 0; i < 16; ++i) { const int t = tq + 8 * i; float acc = 0.f;
            for (int s = 0; s <= t; ++s) acc += Wg[t * 128 + s] * vn[s * 64 + d];
            const float u = bf2f(ZS[(size_t)(tok0 + t) * 1024 + g * 64 + d]);
            YB[(size_t)(tok0 + t) * W + g * 64 + d] = f2bf(u * (acc + bs[t])); }
        __syncthreads();
    }
}

#define LAS3 __attribute__((address_space(3)))
typedef short bf16x8 __attribute__((ext_vector_type(8)));
template <int MT, int NT, int KS, bool SWAP = false>
__device__ __forceinline__ void mma_lds_glob(const unsigned char* lds_base, int a_off_bytes, int lda, const bf16* Bt, int ldb, int n0, int lane, f32x4 (&acc)[MT][NT]) {
    const int fr = lane & 15, fq = lane >> 4;
    const LAS3 unsigned char* Ab = (const LAS3 unsigned char*)lds_base + a_off_bytes;
    int boff = (n0 + fr) * ldb + 8 * fq; asm volatile("" : "+v"(boff));
#pragma unroll
    for (int ks = 0; ks < KS; ++ks) {
        bf16x8 b[NT];
#pragma unroll
        for (int n = 0; n < NT; ++n) b[n] = *(const bf16x8*)(Bt + boff + 16 * n * ldb + 32 * ks);
#pragma unroll
        for (int m = 0; m < MT; ++m) { const bf16x8 av = *(const LAS3 bf16x8*)(Ab + ((16 * m + fr) * lda + 32 * ks + 8 * fq) * 2);
#pragma unroll
            for (int n = 0; n < NT; ++n) acc[m][n] = SWAP ? __builtin_amdgcn_mfma_f32_16x16x32_bf16(b[n], av, acc[m][n], 0, 0, 0) : __builtin_amdgcn_mfma_f32_16x16x32_bf16(av, b[n], acc[m][n], 0, 0, 0); }
    }
}
__device__ __forceinline__ void zshift8(const bf16* ZR, int t, int col, const float* mu, float (&o)[8]) {
    const u32x4 zc = *(const u32x4*)(ZR + (size_t)t * RC + col);
    u32x4 zp = {0u, 0u, 0u, 0u}; if (t > 0) zp = *(const u32x4*)(ZR + (size_t)(t - 1) * RC + col);
    const f32x4 m0 = *(const f32x4*)(mu + col), m1 = *(const f32x4*)(mu + col + 4);
#pragma unroll
    for (int e = 0; e < 4; ++e) { const float c0 = __uint_as_float(zc[e] << 16), c1 = __uint_as_float(zc[e] & 0xffff0000u), p0 = __uint_as_float(zp[e] << 16), p1 = __uint_as_float(zp[e] & 0xffff0000u);
        const float mu0 = (2 * e < 4) ? m0[(2 * e) & 3] : m1[(2 * e) & 3], mu1 = (2 * e + 1 < 4) ? m0[(2 * e + 1) & 3] : m1[(2 * e + 1) & 3];
        o[2 * e] = c0 + (p0 - c0) * mu0; o[2 * e + 1] = c1 + (p1 - c1) * mu1; }
}
typedef _Float16 f16x8 __attribute__((ext_vector_type(8)));
typedef _Float16 f16x4 __attribute__((ext_vector_type(4)));
__device__ __forceinline__ void store8f16(f16* p, const float (&v)[8]) { f16x8 h;
#pragma unroll
    for (int e = 0; e < 8; ++e) h[e] = (f16)v[e];
    *(f16x8*)p = h; }
__device__ __forceinline__ u32x4 pack8bf(const float (&v)[8]) { u32x4 w; w.x = pk2(v[0], v[1]); w.y = pk2(v[2], v[3]); w.z = pk2(v[4], v[5]); w.w = pk2(v[6], v[7]); return w; }


constexpr int PB_LD = 520;
constexpr int PB_BUF = 0, PB_AOP = 64 * PB_LD * 2, PB_VMID = 2 * 64 * PB_LD * 2, PB_LA_LD = 264, PB_VM_LD = 40;
__device__ __forceinline__ void phase_prep_fast(ArgsR a, const Ctx& c, int l) {
    const bf16* ZR = (const bf16*)(a.ws + WS_ZR);
    const float* mu = a.in[I_MU] + l * RC; const float* w0 = a.in[I_W0] + l * W; const float* a0 = a.in[I_A0] + l * W;
    const float* k_k = a.in[I_KK] + l * W; const float* k_a = a.in[I_KA] + l * W; const float* vm0 = a.in[I_VM0];
    f16* R = (f16*)(a.ws + WS_R); f16* WM1 = (f16*)(a.ws + WS_WM1); f16* KP = (f16*)(a.ws + WS_KP); f16* AA = (f16*)(a.ws + WS_AA); f16* BB = (f16*)(a.ws + WS_BB); f16* V = (f16*)(a.ws + WS_V);
    bf16* G = (bf16*)(a.ws + WS_G); bf16* VF = (bf16*)(a.ws + WS_VF);
    const unsigned char* lo = a.ws + WS_LORA + (size_t)l * LO_STRIDE;
    const bf16* W2T = (const bf16*)(lo + LO_W2T); const bf16* A2T = (const bf16*)(lo + LO_A2T); const bf16* G2T = (const bf16*)(lo + LO_G2T);
    const bf16* VM1T = (const bf16*)(lo + LO_VM1T); const bf16* VM2T = (const bf16*)(lo + LO_VM2T);
    LAS3 unsigned char* L = (LAS3 unsigned char*)c.lds;
    const int tid = c.tid, lane = c.lane, wv = c.wave, fr = lane & 15, fq = lane >> 4;
    const int row = tid >> 3, sub_ = tid & 7;
    for (int u = blockIdx.x; u < T / 64; u += gridDim.x) {
        int sub = sub_; asm volatile("" : "+v"(sub));
        const int t0 = u * 64, t = t0 + row;
        if (l == 0) {
#pragma unroll 4
            for (int p = 0; p < 8; ++p) { const int col = p * 64 + sub * 8; float z[8]; zshift8(ZR, t, 1024 + col, mu, z);
                store8f16(V + (size_t)t * W + col, z); *(u32x4*)(VF + (size_t)t * W + col) = pack8bf(z); }
        } else {
#pragma unroll 4
            for (int p = 0; p < 8; ++p) { const int col = p * 64 + sub * 8; float z[8]; zshift8(ZR, t, 1024 + col, mu, z);
                *(LAS3 u32x4*)(L + PB_AOP + (row * PB_LD + col) * 2) = pack8bf(z); }
            __syncthreads();
            { f32x4 acc[1][1]; acc[0][0] = (f32x4){0.f, 0.f, 0.f, 0.f}; const int m = wv >> 1, n = wv & 1;
              mma_lds_glob<1, 1, 16>(c.lds, PB_AOP + 16 * m * PB_LD * 2, PB_LD, VM1T, W, 16 * n, lane, acc);
#pragma unroll
              for (int i = 0; i < 4; ++i) *(LAS3 bf16*)(L + PB_VMID + ((16 * m + 4 * fq + i) * PB_VM_LD + 16 * n + fr) * 2) = f2bf(acc[0][0][i]); }
            __syncthreads();
            { f32x4 acc[4][4];
#pragma unroll
              for (int m = 0; m < 4; ++m)
#pragma unroll
                  for (int n = 0; n < 4; ++n) acc[m][n] = (f32x4){0.f, 0.f, 0.f, 0.f};
              mma_lds_glob<4, 4, 1, true>(c.lds, PB_VMID, PB_VM_LD, VM2T, 32, 64 * wv, lane, acc);
#pragma unroll
              for (int m = 0; m < 4; ++m)
#pragma unroll
                  for (int n = 0; n < 4; ++n) { const int col = 64 * wv + 16 * n + 4 * fq; const f32x4 vb = *(const f32x4*)(vm0 + col); f16x4 hv;
#pragma unroll
                      for (int i = 0; i < 4; ++i) hv[i] = (f16)sigmoidf_(vb[i] + acc[m][n][i]);
                      *(LAS3 f16x4*)(L + PB_BUF + ((16 * m + fr) * PB_LD + col) * 2) = hv; } }
            __syncthreads();
#pragma unroll 4
            for (int p = 0; p < 8; ++p) { const int col = p * 64 + sub * 8;
                const u32x4 vz = *(const LAS3 u32x4*)(L + PB_AOP + (row * PB_LD + col) * 2); const f16x8 gt = *(const LAS3 f16x8*)(L + PB_BUF + (row * PB_LD + col) * 2);
                const u32x4 vfw = *(const u32x4*)(VF + (size_t)t * W + col); float o[8];
#pragma unroll
                for (int e = 0; e < 4; ++e) { const float v0 = __uint_as_float(vz[e] << 16), v1 = __uint_as_float(vz[e] & 0xffff0000u), f0 = __uint_as_float(vfw[e] << 16), f1 = __uint_as_float(vfw[e] & 0xffff0000u);
                    o[2 * e] = v0 + (f0 - v0) * (float)gt[2 * e]; o[2 * e + 1] = v1 + (f1 - v1) * (float)gt[2 * e + 1]; }
                store8f16(V + (size_t)t * W + col, o); }
            __syncthreads();
        }
#pragma unroll 4
        for (int p = 0; p < 4; ++p) { const int cc = sub * 32 + p * 8; float z[8]; zshift8(ZR, t, 1536 + cc, mu, z);
#pragma unroll
            for (int e = 0; e < 8; ++e) z[e] = cc < 64 ? (1.0f - 2.0f * __builtin_amdgcn_rcpf(1.0f + __expf(2.0f * z[e]))) : (cc < 128 ? z[e] : sigmoidf_(z[e]));
            *(LAS3 u32x4*)(L + PB_AOP + (row * PB_LA_LD + cc) * 2) = pack8bf(z); }
        __syncthreads();
        { f32x4 acc[4][4];
#pragma unroll
          for (int m = 0; m < 4; ++m)
#pragma unroll
              for (int n = 0; n < 4; ++n) acc[m][n] = (f32x4){0.f, 0.f, 0.f, 0.f};
          mma_lds_glob<4, 4, 2, true>(c.lds, PB_AOP + 64 * 2, PB_LA_LD, A2T, 64, 64 * wv, lane, acc);
#pragma unroll
          for (int m = 0; m < 4; ++m)
#pragma unroll
              for (int n = 0; n < 4; ++n) { const int col = 64 * wv + 16 * n + 4 * fq; const f32x4 ab = *(const f32x4*)(a0 + col); f16x4 hv;
#pragma unroll
                  for (int i = 0; i < 4; ++i) hv[i] = (f16)sigmoidf_(ab[i] + acc[m][n][i]);
                  *(LAS3 f16x4*)(L + PB_BUF + ((16 * m + fr) * PB_LD + col) * 2) = hv; } }
        __syncthreads();
#pragma unroll 4
        for (int p = 0; p < 8; ++p) { const int col = p * 64 + sub * 8; const size_t o = (size_t)t * W + col;
            float z[8]; zshift8(ZR, t, col, mu, z); store8f16(R + o, z);
            float kz[8]; zshift8(ZR, t, 512 + col, mu, kz);
            const f16x8 av = *(const LAS3 f16x8*)(L + PB_BUF + (row * PB_LD + col) * 2);
            const f32x4 kk0 = *(const f32x4*)(k_k + col), kk1 = *(const f32x4*)(k_k + col + 4), ka0 = *(const f32x4*)(k_a + col), ka1 = *(const f32x4*)(k_a + col + 4);
            float kk[8], kp[8], bb[8]; float ss = 0.f;
#pragma unroll
            for (int e = 0; e < 8; ++e) { const float kkw = e < 4 ? kk0[e & 3] : kk1[e & 3], kaw = e < 4 ? ka0[e & 3] : ka1[e & 3]; kk[e] = kz[e] * kkw; ss += kk[e] * kk[e]; kp[e] = kz[e] * (1.0f + ((float)av[e] - 1.0f) * kaw); }
            ss += __shfl_xor(ss, 1); ss += __shfl_xor(ss, 2); ss += __shfl_xor(ss, 4);
            const float inv = fminf(__builtin_amdgcn_rsqf(ss), 1e12f);
#pragma unroll
            for (int e = 0; e < 8; ++e) { kk[e] *= inv; bb[e] = kk[e] * (float)av[e]; kk[e] = -kk[e]; }
            store8f16(KP + o, kp); store8f16(AA + o, kk); store8f16(BB + o, bb); }
        __syncthreads();
        { f32x4 acc[4][4];
#pragma unroll
          for (int m = 0; m < 4; ++m)
#pragma unroll
              for (int n = 0; n < 4; ++n) acc[m][n] = (f32x4){0.f, 0.f, 0.f, 0.f};
          mma_lds_glob<4, 4, 2, true>(c.lds, PB_AOP, PB_LA_LD, W2T, 64, 64 * wv, lane, acc);
#pragma unroll
          for (int m = 0; m < 4; ++m)
#pragma unroll
              for (int n = 0; n < 4; ++n) { const int col = 64 * wv + 16 * n + 4 * fq; const f32x4 wb = *(const f32x4*)(w0 + col); f16x4 hv;
#pragma unroll
                  for (int i = 0; i < 4; ++i) { const float x = wb[i] + acc[m][n][i]; const float wl = -(fmaxf(-x, 0.f) + __logf(1.0f + __expf(-fabsf(x)))) - 0.5f;
                      hv[i] = (f16)(__expf(-__expf(wl)) - 1.0f); }
                  *(LAS3 f16x4*)(L + PB_BUF + ((16 * m + fr) * PB_LD + col) * 2) = hv; } }
        __syncthreads();
#pragma unroll 4
        for (int p = 0; p < 8; ++p) { const int col = p * 64 + sub * 8; *(u32x4*)(WM1 + (size_t)t * W + col) = *(const LAS3 u32x4*)(L + PB_BUF + (row * PB_LD + col) * 2); }
        __syncthreads();
        { f32x4 acc[4][4];
#pragma unroll
          for (int m = 0; m < 4; ++m)
#pragma unroll
              for (int n = 0; n < 4; ++n) acc[m][n] = (f32x4){0.f, 0.f, 0.f, 0.f};
          mma_lds_glob<4, 4, 4, true>(c.lds, PB_AOP + 128 * 2, PB_LA_LD, G2T, 128, 64 * wv, lane, acc);
#pragma unroll
          for (int m = 0; m < 4; ++m)
#pragma unroll
              for (int n = 0; n < 4; ++n) { const int col = 64 * wv + 16 * n + 4 * fq; u32x2 w; w.x = pk2(acc[m][n][0], acc[m][n][1]); w.y = pk2(acc[m][n][2], acc[m][n][3]);
                  *(LAS3 u32x2*)(L + PB_BUF + ((16 * m + fr) * PB_LD + col) * 2) = w; } }
        __syncthreads();
#pragma unroll 4
        for (int p = 0; p < 8; ++p) { const int col = p * 64 + sub * 8; *(u32x4*)(G + (size_t)t * W + col) = *(const LAS3 u32x4*)(L + PB_BUF + (row * PB_LD + col) * 2); }
        __syncthreads();
    }
}

constexpr int SG_LD = 136;
constexpr int SG_VT = 0, SG_ST = 256 * SG_LD * 2;
__device__ __forceinline__ void phase_sg_fast(ArgsR a, const Ctx& c, int l) {
    const bf16* ZS = (const bf16*)(a.ws + WS_ZS); bf16* YB = (bf16*)(a.ws + WS_YB);
    const float* lng = a.in[I_SGG] + l * W; const float* lnb = a.in[I_SGB] + l * W;
    LAS3 unsigned char* L = (LAS3 unsigned char*)c.lds;
    LAS3 float* st = (LAS3 float*)(L + SG_ST);
    const int tid = c.tid, lane = c.lane, wv = c.wave, fr = lane & 15, fq = lane >> 4;
    for (int u = blockIdx.x; u < 256; u += gridDim.x) {
        const int ch = u >> 1, hf = u & 1, tok0 = ch * 128;
        { u32x4 raw[16];
#pragma unroll
          for (int i = 0; i < 16; ++i) raw[i] = *(const u32x4*)(ZS + (size_t)(tok0 + wv * 16 + i) * 1024 + 512 + lane * 8);
#pragma unroll
          for (int i = 0; i < 16; ++i) { const int sidx = wv * 16 + i; float x[8];
#pragma unroll
              for (int e = 0; e < 4; ++e) { x[2 * e] = __uint_as_float(raw[i][e] << 16); x[2 * e + 1] = __uint_as_float(raw[i][e] & 0xffff0000u); }
              const float sm = ((x[0] + x[1]) + (x[2] + x[3])) + ((x[4] + x[5]) + (x[6] + x[7])); const float mean = wave_sum(sm) * (1.f / 512.f);
              float q = 0.f;
#pragma unroll
              for (int e = 0; e < 8; ++e) { const float d0 = x[e] - mean; q += d0 * d0; }
              const float rstd = __builtin_amdgcn_rsqf(wave_sum(q) * (1.f / 512.f) + LN_EPS);
              if (lane == 0) { st[2 * sidx] = mean; st[2 * sidx + 1] = rstd; } } }
        __syncthreads();
        { const int sidx = tid >> 2, q4 = tid & 3; const float mean = st[2 * sidx], rstd = st[2 * sidx + 1];
#pragma unroll
          for (int p = 0; p < 8; ++p) { const int cl = q4 * 64 + p * 8; const int cg = hf * 256 + cl;
              const bf16* src = ZS + (size_t)(tok0 + sidx) * 1024 + 512 + cg; const f32x4 x0 = load4bf(src), x1 = load4bf(src + 4);
              const f32x4 g0 = *(const f32x4*)(lng + cg), g1 = *(const f32x4*)(lng + cg + 4), b0 = *(const f32x4*)(lnb + cg), b1 = *(const f32x4*)(lnb + cg + 4);
#pragma unroll
              for (int e = 0; e < 8; ++e) { const float x = e < 4 ? x0[e & 3] : x1[e & 3], gg = e < 4 ? g0[e & 3] : g1[e & 3], bb = e < 4 ? b0[e & 3] : b1[e & 3];
                  *(LAS3 bf16*)(L + SG_VT + ((cl + e) * SG_LD + sidx) * 2) = f2bf((x - mean) * rstd * gg + bb); } } }
        __syncthreads();
        const int gl = wv >> 1, dh = wv & 1, g = hf * 4 + gl;
        const float* Wg = a.in[I_WS] + (size_t)(l * 8 + g) * 128 * 128; const float* bs = a.in[I_BS] + (size_t)(l * 8 + g) * 128;
        f32x4 acc[8][2];
#pragma unroll
        for (int m = 0; m < 8; ++m) { acc[m][0] = (f32x4){0.f, 0.f, 0.f, 0.f}; acc[m][1] = (f32x4){0.f, 0.f, 0.f, 0.f}; }
#pragma unroll
        for (int ks = 0; ks < 4; ++ks) {
            bf16x8 b[2];
#pragma unroll
            for (int n = 0; n < 2; ++n) b[n] = *(const LAS3 bf16x8*)(L + SG_VT + ((gl * 64 + dh * 32 + 16 * n + fr) * SG_LD + 32 * ks + 8 * fq) * 2);
#pragma unroll
            for (int m = 0; m < 8; ++m) { if (32 * ks <= 16 * m + 15) {
                const int trow = 16 * m + fr, s0 = 32 * ks + 8 * fq;
                const f32x4 w0v = *(const f32x4*)(Wg + trow * 128 + s0), w1v = *(const f32x4*)(Wg + trow * 128 + s0 + 4);
                float wf[8];
#pragma unroll
                for (int e = 0; e < 8; ++e) { const float wval = e < 4 ? w0v[e & 3] : w1v[e & 3]; wf[e] = (s0 + e <= trow) ? wval : 0.f; }
                const u32x4 wp = pack8bf(wf); const bf16x8 av = __builtin_bit_cast(bf16x8, wp);
                acc[m][0] = __builtin_amdgcn_mfma_f32_16x16x32_bf16(b[0], av, acc[m][0], 0, 0, 0);
                acc[m][1] = __builtin_amdgcn_mfma_f32_16x16x32_bf16(b[1], av, acc[m][1], 0, 0, 0); } }
        }
#pragma unroll
        for (int m = 0; m < 8; ++m) { const int trow = 16 * m + fr; const float bsv = bs[trow];
#pragma unroll
            for (int n = 0; n < 2; ++n) { const int col = g * 64 + dh * 32 + 16 * n + 4 * fq; const f32x4 uu = load4bf(ZS + (size_t)(tok0 + trow) * 1024 + col);
                store4bf(YB + (size_t)(tok0 + trow) * W + col, uu * (acc[m][n] + bsv)); } }
        __syncthreads();
    }
}


constexpr int SGC_ST = 139264 + 4096;
__device__ __forceinline__ void phase_sg_chunk(ArgsR a, const Ctx& c, int l) {
    const bf16* ZS = (const bf16*)(a.ws + WS_ZS); bf16* YB = (bf16*)(a.ws + WS_YB);
    const float* lng = a.in[I_SGG] + l * W; const float* lnb = a.in[I_SGB] + l * W;
    LAS3 unsigned char* L = (LAS3 unsigned char*)c.lds;
    LAS3 float* st = (LAS3 float*)(L + SGC_ST);
    const int tid = c.tid, lane = c.lane, wv = c.wave, fr = lane & 15, fq = lane >> 4;
    const int nb2a = 128;
    int first = blockIdx.x, stride = gridDim.x;
    if ((int)gridDim.x >= 2 * nb2a) { if ((int)blockIdx.x < nb2a) return; first = blockIdx.x - nb2a; stride = gridDim.x - nb2a; }
    for (int ch = first; ch < T / 128; ch += stride) {
        const int tok0 = ch * 128;
        { u32x4 raw[16];
#pragma unroll
          for (int i = 0; i < 16; ++i) raw[i] = *(const u32x4*)(ZS + (size_t)(tok0 + wv * 16 + i) * 1024 + 512 + lane * 8);
#pragma unroll
          for (int i = 0; i < 16; ++i) { const int sidx = wv * 16 + i; float x[8];
#pragma unroll
              for (int e = 0; e < 4; ++e) { x[2 * e] = __uint_as_float(raw[i][e] << 16); x[2 * e + 1] = __uint_as_float(raw[i][e] & 0xffff0000u); }
              const float sm = ((x[0] + x[1]) + (x[2] + x[3])) + ((x[4] + x[5]) + (x[6] + x[7])); const float mean = wave_sum(sm) * (1.f / 512.f);
              float q = 0.f;
#pragma unroll
              for (int e = 0; e < 8; ++e) { const float d0 = x[e] - mean; q += d0 * d0; }
              const float rstd = __builtin_amdgcn_rsqf(wave_sum(q) * (1.f / 512.f) + LN_EPS);
              if (lane == 0) { st[2 * sidx] = mean; st[2 * sidx + 1] = rstd; } } }
        __syncthreads();
        { const int sidx = tid >> 2, q4 = tid & 3; const float mean = st[2 * sidx], rstd = st[2 * sidx + 1];
#pragma unroll 4
          for (int p = 0; p < 16; ++p) { const int cl = q4 * 128 + p * 8;
              const bf16* src = ZS + (size_t)(tok0 + sidx) * 1024 + 512 + cl; const f32x4 x0 = load4bf(src), x1 = load4bf(src + 4);
              const f32x4 g0 = *(const f32x4*)(lng + cl), g1 = *(const f32x4*)(lng + cl + 4), b0 = *(const f32x4*)(lnb + cl), b1 = *(const f32x4*)(lnb + cl + 4);
#pragma unroll
              for (int e = 0; e < 8; ++e) { const float x = e < 4 ? x0[e & 3] : x1[e & 3], gg = e < 4 ? g0[e & 3] : g1[e & 3], bb = e < 4 ? b0[e & 3] : b1[e & 3];
                  *(LAS3 bf16*)(L + SG_VT + ((cl + e) * SG_LD + sidx) * 2) = f2bf((x - mean) * rstd * gg + bb); } } }
        __syncthreads();
        const int g = wv;
        const float* Wg = a.in[I_WS] + (size_t)(l * 8 + g) * 128 * 128; const float* bs = a.in[I_BS] + (size_t)(l * 8 + g) * 128;
        f32x4 acc[8][4];
#pragma unroll
        for (int m = 0; m < 8; ++m)
#pragma unroll
            for (int n = 0; n < 4; ++n) acc[m][n] = (f32x4){0.f, 0.f, 0.f, 0.f};
#pragma unroll
        for (int ks = 0; ks < 4; ++ks) {
            bf16x8 b[4];
#pragma unroll
            for (int n = 0; n < 4; ++n) b[n] = *(const LAS3 bf16x8*)(L + SG_VT + ((g * 64 + 16 * n + fr) * SG_LD + 32 * ks + 8 * fq) * 2);
#pragma unroll
            for (int m = 0; m < 8; ++m) { if (32 * ks <= 16 * m + 15) {
                const int trow = 16 * m + fr, s0 = 32 * ks + 8 * fq;
                const f32x4 w0v = *(const f32x4*)(Wg + trow * 128 + s0), w1v = *(const f32x4*)(Wg + trow * 128 + s0 + 4);
                float wf[8];
#pragma unroll
                for (int e = 0; e < 8; ++e) { const float wval = e < 4 ? w0v[e & 3] : w1v[e & 3]; wf[e] = (s0 + e <= trow) ? wval : 0.f; }
                const u32x4 wp = pack8bf(wf); const bf16x8 av = __builtin_bit_cast(bf16x8, wp);
#pragma unroll
                for (int n = 0; n < 4; ++n) acc[m][n] = __builtin_amdgcn_mfma_f32_16x16x32_bf16(b[n], av, acc[m][n], 0, 0, 0); } }
        }
#pragma unroll
        for (int m = 0; m < 8; ++m) { const int trow = 16 * m + fr; const float bsv = bs[trow];
#pragma unroll
            for (int n = 0; n < 4; ++n) { const int col = g * 64 + 16 * n + 4 * fq; const f32x4 uu = load4bf(ZS + (size_t)(tok0 + trow) * 1024 + col);
                store4bf(YB + (size_t)(tok0 + trow) * W + col, uu * (acc[m][n] + bsv)); } }
        __syncthreads();
    }
}

__device__ __forceinline__ void phase_scan_simple(ArgsR a, const Ctx& c) {
    if (c.wave != 0 || blockIdx.x >= NH) return;
    const int h = blockIdx.x, lane = c.lane;
    const f16* R = (const f16*)(a.ws + WS_R); const f16* WM1 = (const f16*)(a.ws + WS_WM1); const f16* KP = (const f16*)(a.ws + WS_KP);
    const f16* AA = (const f16*)(a.ws + WS_AA); const f16* BB = (const f16*)(a.ws + WS_BB); const f16* V = (const f16*)(a.ws + WS_V);
    bf16* YSC = (bf16*)(a.ws + WS_YSC);
    float S[64];
#pragma unroll
    for (int j = 0; j < 64; ++j) S[j] = 0.f;
    for (int t = 0; t < T; ++t) {
        const size_t base = (size_t)t * W + h * 64;
        const float vv = (float)V[base + lane];
        float sa = 0.f;
#pragma unroll
        for (int j = 0; j < 64; ++j) sa += S[j] * (float)AA[base + j];
        float y = 0.f;
#pragma unroll
        for (int j = 0; j < 64; ++j) { float s = S[j]; s = s + s * (float)WM1[base + j]; s += sa * (float)BB[base + j]; s += vv * (float)KP[base + j]; S[j] = s; y += s * (float)R[base + j]; }
        YSC[base + lane] = f2bf(y);
    }
}

typedef unsigned u32x16 __attribute__((ext_vector_type(16)));
__device__ __forceinline__ void sload32(const void* p0, u32x16& a0, u32x16& a1) {
    asm volatile("s_load_dwordx16 %0, %2, 0x0 glc\n\ts_load_dwordx16 %1, %2, 0x40 glc\n\ts_waitcnt lgkmcnt(0)" : "=&s"(a0), "=&s"(a1) : "s"(p0) : "memory");
}
__device__ __forceinline__ void sload64(const void* p0, const void* p1, u32x16& a0, u32x16& a1, u32x16& b0, u32x16& b1) {
    asm volatile("s_load_dwordx16 %0, %4, 0x0 glc\n\ts_load_dwordx16 %1, %4, 0x40 glc\n\ts_load_dwordx16 %2, %5, 0x0 glc\n\ts_load_dwordx16 %3, %5, 0x40 glc\n\ts_waitcnt lgkmcnt(0)"
                 : "=&s"(a0), "=&s"(a1), "=&s"(b0), "=&s"(b1) : "s"(p0), "s"(p1) : "memory");
}
__device__ __forceinline__ float fmix_lo(unsigned sd, float x, float y) { float d; asm("v_fma_mix_f32 %0, %1, %2, %3 op_sel_hi:[1,0,0]" : "=v"(d) : "s"(sd), "v"(x), "v"(y)); return d; }
__device__ __forceinline__ float fmix_hi(unsigned sd, float x, float y) { float d; asm("v_fma_mix_f32 %0, %1, %2, %3 op_sel:[1,0,0] op_sel_hi:[1,0,0]" : "=v"(d) : "s"(sd), "v"(x), "v"(y)); return d; }
constexpr int CL = 64, NCH = T / CL;
constexpr size_t ST_Q_OFF = (size_t)NH * NCH * 64 * 64;
constexpr size_t ST_S_OFF = (size_t)NH * NCH * 64 * 64;

__device__ __forceinline__ float vmix_lo(unsigned vd, float x, float y) { float d; asm("v_fma_mix_f32 %0, %1, %2, %3 op_sel_hi:[1,0,0]" : "=v"(d) : "v"(vd), "v"(x), "v"(y)); return d; }
__device__ __forceinline__ float vmix_hi(unsigned vd, float x, float y) { float d; asm("v_fma_mix_f32 %0, %1, %2, %3 op_sel:[1,0,0] op_sel_hi:[1,0,0]" : "=v"(d) : "v"(vd), "v"(x), "v"(y)); return d; }
template <int N> __device__ __forceinline__ void fmac_bc(float& acc, float vec, float x) { asm("v_fmac_f32_dpp %0, %1, %2 row_newbcast:%3 row_mask:0xf bank_mask:0xf" : "+v"(acc) : "v"(vec), "v"(x), "n"(N)); }
template <int N> __device__ __forceinline__ float mul_bc(float vec, float x) { float d; asm("v_mul_f32_dpp %0, %1, %2 row_newbcast:%3 row_mask:0xf bank_mask:0xf" : "=v"(d) : "v"(vec), "v"(x), "n"(N)); return d; }
struct SVec { float v[4]; };
__device__ __forceinline__ f16x4 sv_read(const LAS3 unsigned char* p, int lane) { return *(const LAS3 f16x4*)(p + (lane & 15) * 8); }
__device__ __forceinline__ void sv_cvt(SVec& o, f16x4 h) { o.v[0] = (float)h[0]; o.v[1] = (float)h[1]; o.v[2] = (float)h[2]; o.v[3] = (float)h[3]; }
__device__ __forceinline__ void sv_cvt1p(SVec& o, f16x4 h) { o.v[0] = 1.0f + (float)h[0]; o.v[1] = 1.0f + (float)h[1]; o.v[2] = 1.0f + (float)h[2]; o.v[3] = 1.0f + (float)h[3]; }
template <int J> __device__ __forceinline__ void sc_dot(float (&d)[4], const SVec& A, const float (&X)[64]) { fmac_bc<(J >> 2)>(d[J & 3], A.v[J & 3], X[J]); if constexpr (J + 1 < 64) sc_dot<J + 1>(d, A, X); }
template <int J> __device__ __forceinline__ void sc_upd3(float (&S)[64], float (&y)[4], const SVec& Wv, const SVec& Bv, const SVec& Kv, const SVec& Rv, float sa, float vv) {
    float sj = mul_bc<(J >> 2)>(Wv.v[J & 3], S[J]); fmac_bc<(J >> 2)>(sj, Bv.v[J & 3], sa); fmac_bc<(J >> 2)>(sj, Kv.v[J & 3], vv); S[J] = sj; fmac_bc<(J >> 2)>(y[J & 3], Rv.v[J & 3], sj);
    if constexpr (J + 1 < 64) sc_upd3<J + 1>(S, y, Wv, Bv, Kv, Rv, sa, vv); }
template <int J> __device__ __forceinline__ void sc_upd1(float (&Q)[64], float (&P)[64], const SVec& Wv, const SVec& Bv, const SVec& Kv, float saq, float sap, float vv) {
    float qj = mul_bc<(J >> 2)>(Wv.v[J & 3], Q[J]); fmac_bc<(J >> 2)>(qj, Bv.v[J & 3], saq); fmac_bc<(J >> 2)>(qj, Kv.v[J & 3], vv); Q[J] = qj;
    float pj = mul_bc<(J >> 2)>(Wv.v[J & 3], P[J]); fmac_bc<(J >> 2)>(pj, Bv.v[J & 3], sap); P[J] = pj;
    if constexpr (J + 1 < 64) sc_upd1<J + 1>(Q, P, Wv, Bv, Kv, saq, sap, vv); }
constexpr int SCB = 8;
constexpr int SC_NS = 7, SC_BUF = SC_NS * 1024, SC_WAVE = 2 * SC_BUF;
__device__ __forceinline__ void sc_dma(const f16* X, size_t eoff, LAS3 unsigned char* dst) {
    __builtin_amdgcn_global_load_lds((const unsigned*)(X + eoff), (LAS3 unsigned*)dst, 16, 0, 0);
}

__device__ __forceinline__ void phase_scan1(ArgsR a, const Ctx& c) {
    const f16* WM1 = (const f16*)(a.ws + WS_WM1); const f16* KP = (const f16*)(a.ws + WS_KP);
    const f16* AA = (const f16*)(a.ws + WS_AA); const f16* BB = (const f16*)(a.ws + WS_BB); const f16* V = (const f16*)(a.ws + WS_V);
    float* ST = (float*)(a.ws + WS_ST);
    const int lane = c.lane;
    LAS3 unsigned char* ring = (LAS3 unsigned char*)c.lds + c.wave * SC_WAVE;
    for (int item = c.gw; item < NH * NCH; item += c.ngw) {
        const int h = __builtin_amdgcn_readfirstlane(item / NCH), ch = __builtin_amdgcn_readfirstlane(item % NCH);
        float Q[64], P[64];
        int ln_ = lane; asm volatile("" : "+v"(ln_));
#pragma unroll
        for (int j = 0; j < 64; ++j) { Q[j] = 0.f; P[j] = (j == ln_) ? 1.f : 0.f; }
        const size_t lane_off = (size_t)(lane >> 3) * W + h * 64 + (lane & 7) * 8;
        { const size_t e0 = (size_t)(ch * CL) * W + lane_off;
          sc_dma(AA, e0, ring); sc_dma(WM1, e0, ring + 1024); sc_dma(BB, e0, ring + 2048); sc_dma(KP, e0, ring + 3072); sc_dma(V, e0, ring + 4096); }
#pragma unroll 1
        for (int blk = 0; blk < CL / SCB; ++blk) {
            LAS3 unsigned char* buf = ring + (blk & 1) * SC_BUF;
            if (blk + 1 < CL / SCB) { LAS3 unsigned char* nb = ring + ((blk + 1) & 1) * SC_BUF; const size_t e0 = (size_t)(ch * CL + (blk + 1) * SCB) * W + lane_off;
                sc_dma(AA, e0, nb); sc_dma(WM1, e0, nb + 1024); sc_dma(BB, e0, nb + 2048); sc_dma(KP, e0, nb + 3072); sc_dma(V, e0, nb + 4096);
                asm volatile("s_waitcnt vmcnt(5)" ::: "memory"); }
            else asm volatile("s_waitcnt vmcnt(0)" ::: "memory");
            SVec A, Wv, Bv, Kv;
            sv_cvt(A, sv_read(buf, lane)); sv_cvt1p(Wv, sv_read(buf + 1024, lane)); sv_cvt(Bv, sv_read(buf + 2048, lane)); sv_cvt(Kv, sv_read(buf + 3072, lane));
            float vv = (float)*(const LAS3 f16*)(buf + 4096 + lane * 2);
#pragma unroll 1
            for (int st = 0; st < SCB; ++st) {
                const LAS3 unsigned char* sn = buf + ((st + 1 < SCB) ? st + 1 : st) * 128;
                const f16x4 ha = sv_read(sn, lane), hw = sv_read(sn + 1024, lane), hb = sv_read(sn + 2048, lane), hk = sv_read(sn + 3072, lane);
                const f16 hv = *(const LAS3 f16*)(sn + 4096 + lane * 2);
                float dq[4] = {0.f, 0.f, 0.f, 0.f}, dp[4] = {0.f, 0.f, 0.f, 0.f};
                sc_dot<0>(dq, A, Q); sc_dot<0>(dp, A, P);
                const float saq = (dq[0] + dq[1]) + (dq[2] + dq[3]), sap = (dp[0] + dp[1]) + (dp[2] + dp[3]);
                sc_upd1<0>(Q, P, Wv, Bv, Kv, saq, sap, vv);
                sv_cvt(A, ha); sv_cvt1p(Wv, hw); sv_cvt(Bv, hb); sv_cvt(Kv, hk); vv = (float)hv;
            }
        }
        float* Qp = ST + ST_Q_OFF + (size_t)(h * NCH + ch) * 4096 + lane;
        bf16* PTp = (bf16*)ST + (size_t)(h * NCH + ch) * 4096 + lane;
#pragma unroll
        for (int j = 0; j < 64; ++j) { PTp[j * 64] = f2bf(P[j]); Qp[j * 64] = Q[j]; }
    }
}
constexpr int GS = 16, NG = NCH / GS;
constexpr size_t ST_LP_OFF = (size_t)NH * NCH * 4096;
constexpr size_t ST_QB_OFF = (size_t)2 * NH * NCH * 4096;
constexpr size_t WS_SG = WS_LORA + 2 * MiB;
constexpr int HI_LD = 72, HI_BYTES = 64 * HI_LD * 2;
struct HFrag { bf16x8 b[2][2]; u32x2 q[2]; };
__device__ __forceinline__ f32x4 bf4cvt(u32x2 w) { f32x4 r; r[0] = __uint_as_float(w.x << 16); r[1] = __uint_as_float(w.x & 0xffff0000u); r[2] = __uint_as_float(w.y << 16); r[3] = __uint_as_float(w.y & 0xffff0000u); return r; }
__device__ __forceinline__ void hload(HFrag& f, const bf16* Bt, const bf16* QTc, int boff, int qtoff) {
#pragma unroll
    for (int ks = 0; ks < 2; ++ks)
#pragma unroll
        for (int n = 0; n < 2; ++n) f.b[ks][n] = *(const bf16x8*)(Bt + boff + 16 * n * 64 + 32 * ks);
#pragma unroll
    for (int n = 0; n < 2; ++n) f.q[n] = *(const u32x2*)(QTc + qtoff + 16 * n * 64);
}
__device__ __forceinline__ void hmma(const LAS3 unsigned char* img, const bf16x8 (&b)[2][2], f32x4 (&acc)[2], int m, int fr, int fq) {
#pragma unroll
    for (int ks = 0; ks < 2; ++ks) { const bf16x8 av = *(const LAS3 bf16x8*)(img + ((16 * m + fr) * HI_LD + 32 * ks + 8 * fq) * 2);
#pragma unroll
        for (int n = 0; n < 2; ++n) acc[n] = __builtin_amdgcn_mfma_f32_16x16x32_bf16(av, b[ks][n], acc[n], 0, 0, 0); }
}
__device__ __forceinline__ void himg_store(LAS3 unsigned char* img, const f32x4 (&acc)[2], int m, int n0, int fr, int fq) {
#pragma unroll
    for (int n = 0; n < 2; ++n)
#pragma unroll
        for (int i = 0; i < 4; ++i) *(LAS3 bf16*)(img + ((16 * m + 4 * fq + i) * HI_LD + n0 + 16 * n + fr) * 2) = f2bf(acc[n][i]);
}
#define HBAR() do { asm volatile("s_waitcnt lgkmcnt(0)" ::: "memory"); __builtin_amdgcn_s_barrier(); asm volatile("" ::: "memory"); } while (0)

__device__ __forceinline__ void sc2a_step(const HFrag& f, bf16* LpTc, bf16* QTc, const LAS3 unsigned char* ip, LAS3 unsigned char* ipn, const LAS3 unsigned char* iq, LAS3 unsigned char* iqn, int m, int n0, int fr, int fq, int qtoff) {
    f32x4 ap[2], aq[2];
#pragma unroll
    for (int n = 0; n < 2; ++n) { ap[n] = (f32x4){0.f, 0.f, 0.f, 0.f}; aq[n] = bf4cvt(f.q[n]); }
    hmma(ip, f.b, ap, m, fr, fq); hmma(iq, f.b, aq, m, fr, fq);
#pragma unroll
    for (int n = 0; n < 2; ++n) { u32x2 w; w.x = pk2(ap[n][0], ap[n][1]); w.y = pk2(ap[n][2], ap[n][3]);
        *(u32x2*)(LpTc + (n0 + 16 * n + fr) * 64 + 16 * m + 4 * fq) = w;
        store4bf(QTc + qtoff + 16 * n * 64, aq[n]); }
    himg_store(ipn, ap, m, n0, fr, fq); himg_store(iqn, aq, m, n0, fr, fq);
    HBAR();
}
__device__ __forceinline__ void phase_scan2a(ArgsR a, const Ctx& c) {
    const int lane = c.lane, wv = c.wave, fr = lane & 15, fq = lane >> 4, m = wv >> 1, n0 = 32 * (wv & 1);
    const int boff = (n0 + fr) * 64 + 8 * fq, qtoff = (n0 + fr) * 64 + 16 * m + 4 * fq;
    LAS3 unsigned char* L = (LAS3 unsigned char*)c.lds;
    for (int item = blockIdx.x; item < NH * NG; item += gridDim.x) {
        const size_t cb = (size_t)(item / NG) * NCH + (size_t)(item % NG) * GS;
        const bf16* PT = (const bf16*)(a.ws + WS_ST) + cb * 4096; bf16* LP = (bf16*)(a.ws + WS_ST) + ST_LP_OFF + cb * 4096; bf16* QT = (bf16*)(a.ws + WS_ST) + ST_QB_OFF + cb * 4096;
        for (int i = c.tid; i < 4 * HI_BYTES / 4; i += NTHREADS) ((LAS3 unsigned*)L)[i] = 0u;
        __syncthreads();
        if (c.tid < 64) *(LAS3 bf16*)(L + (c.tid * HI_LD + c.tid) * 2) = (bf16)0x3F80;
        __syncthreads();
        HFrag f0, f1, f2, f3;
        hload(f0, PT, QT, boff, qtoff); hload(f1, PT + 4096, QT + 4096, boff, qtoff); hload(f2, PT + 2 * 4096, QT + 2 * 4096, boff, qtoff); hload(f3, PT + 3 * 4096, QT + 3 * 4096, boff, qtoff);
        LAS3 unsigned char* p0 = L; LAS3 unsigned char* p1 = L + HI_BYTES; LAS3 unsigned char* q0 = L + 2 * HI_BYTES; LAS3 unsigned char* q1 = L + 3 * HI_BYTES;
#pragma unroll 1
        for (int i = 0; i < GS; i += 4) {
            const int nx = (i + 4 < GS) ? i + 4 : i;
            sc2a_step(f0, LP + (size_t)(i + 0) * 4096, QT + (size_t)(i + 0) * 4096, p0, p1, q0, q1, m, n0, fr, fq, qtoff); hload(f0, PT + (size_t)(nx + 0) * 4096, QT + (size_t)(nx + 0) * 4096, boff, qtoff);
            sc2a_step(f1, LP + (size_t)(i + 1) * 4096, QT + (size_t)(i + 1) * 4096, p1, p0, q1, q0, m, n0, fr, fq, qtoff); hload(f1, PT + (size_t)(nx + 1) * 4096, QT + (size_t)(nx + 1) * 4096, boff, qtoff);
            sc2a_step(f2, LP + (size_t)(i + 2) * 4096, QT + (size_t)(i + 2) * 4096, p0, p1, q0, q1, m, n0, fr, fq, qtoff); hload(f2, PT + (size_t)(nx + 2) * 4096, QT + (size_t)(nx + 2) * 4096, boff, qtoff);
            sc2a_step(f3, LP + (size_t)(i + 3) * 4096, QT + (size_t)(i + 3) * 4096, p1, p0, q1, q0, m, n0, fr, fq, qtoff); hload(f3, PT + (size_t)(nx + 3) * 4096, QT + (size_t)(nx + 3) * 4096, boff, qtoff);
        }
        __syncthreads();
    }
}
__device__ __forceinline__ void phase_scan2b(ArgsR a, const Ctx& c) {
    if (blockIdx.x >= NH) return;
    const int h = blockIdx.x, lane = c.lane, wv = c.wave, fr = lane & 15, fq = lane >> 4, m = wv >> 1, n0 = 32 * (wv & 1);
    const int boff = (n0 + fr) * 64 + 8 * fq, qtoff = (n0 + fr) * 64 + 16 * m + 4 * fq;
    LAS3 unsigned char* L = (LAS3 unsigned char*)c.lds;
    const bf16* LP = (const bf16*)(a.ws + WS_ST) + ST_LP_OFF + (size_t)h * NCH * 4096; const bf16* QT = (const bf16*)(a.ws + WS_ST) + ST_QB_OFF + (size_t)h * NCH * 4096;
    bf16* SG = (bf16*)(a.ws + WS_SG) + (size_t)h * NG * 4096;
    for (int i = c.tid; i < 2 * HI_BYTES / 4; i += NTHREADS) ((LAS3 unsigned*)L)[i] = 0u;
    for (int i = c.tid; i < 4096 / 2; i += NTHREADS) ((LAS3 unsigned*)(L + 2 * HI_BYTES))[i] = 0u;
    __syncthreads();
    HFrag f0, f1, f2, f3;
#define SC2B_CH(g) ((size_t)((g) * GS + GS - 1) * 4096)
    hload(f0, LP + SC2B_CH(0), QT + SC2B_CH(0), boff, qtoff); hload(f1, LP + SC2B_CH(1), QT + SC2B_CH(1), boff, qtoff); hload(f2, LP + SC2B_CH(2), QT + SC2B_CH(2), boff, qtoff); hload(f3, LP + SC2B_CH(3), QT + SC2B_CH(3), boff, qtoff);
    LAS3 unsigned char* i0 = L; LAS3 unsigned char* i1 = L + HI_BYTES;
#define SC2B_STEP(f, g, ic, in) do { f32x4 acc[2] = {bf4cvt(f.q[0]), bf4cvt(f.q[1])}; hmma(ic, f.b, acc, m, fr, fq); LAS3 bf16* So = (LAS3 bf16*)(L + 2 * HI_BYTES) + (((g) + 1) & 7) * 4096; \
        _Pragma("unroll") for (int n = 0; n < 2; ++n) _Pragma("unroll") for (int i = 0; i < 4; ++i) So[(16 * m + 4 * fq + i) * 64 + n0 + 16 * n + fr] = f2bf(acc[n][i]); \
        himg_store(in, acc, m, n0, fr, fq); HBAR(); } while (0)
#pragma unroll 1
    for (int g = 0; g < NG; g += 4) {
        const int nx = (g + 4 < NG) ? g + 4 : g;
        SC2B_STEP(f0, g + 0, i0, i1); hload(f0, LP + SC2B_CH(nx + 0), QT + SC2B_CH(nx + 0), boff, qtoff);
        SC2B_STEP(f1, g + 1, i1, i0); hload(f1, LP + SC2B_CH(nx + 1), QT + SC2B_CH(nx + 1), boff, qtoff);
        SC2B_STEP(f2, g + 2, i0, i1); hload(f2, LP + SC2B_CH(nx + 2), QT + SC2B_CH(nx + 2), boff, qtoff);
        if ((g & 7) == 4) {
            for (int i = c.tid; i < 8 * 4096 / 8; i += NTHREADS) ((u32x4*)(SG + (size_t)(g >> 3) * 8 * 4096))[i] = ((const LAS3 u32x4*)(L + 2 * HI_BYTES))[i];
            HBAR(); }
        if (g + 3 < NG - 1) SC2B_STEP(f3, g + 3, i1, i0);
        hload(f3, LP + SC2B_CH(nx + 3), QT + SC2B_CH(nx + 3), boff, qtoff);
    }
#undef SC2B_STEP
#undef SC2B_CH
}
__device__ __forceinline__ void phase_scan2c(ArgsR a, const Ctx& c) {
    const int lane = c.lane, wv = c.wave, fr = lane & 15, fq = lane >> 4, m = wv >> 1, n0 = 32 * (wv & 1);
    const int boff = (n0 + fr) * 64 + 8 * fq, qtoff = (n0 + fr) * 64 + 16 * m + 4 * fq;
    LAS3 unsigned char* L = (LAS3 unsigned char*)c.lds;
    for (int item = blockIdx.x; item < NH * NG * 2; item += gridDim.x) {
        const int hg = item >> 1, hf = item & 1;
        const size_t cb = (size_t)(hg / NG) * NCH + (size_t)(hg % NG) * GS + hf * 8;
        const bf16* LP = (const bf16*)(a.ws + WS_ST) + ST_LP_OFF + cb * 4096; const bf16* QT = (const bf16*)(a.ws + WS_ST) + ST_QB_OFF + cb * 4096; bf16* SS = (bf16*)(a.ws + WS_ST) + cb * 4096;
        { const u32x4 v = *(const u32x4*)((const bf16*)(a.ws + WS_SG) + (size_t)hg * 4096 + c.tid * 8); *(LAS3 u32x4*)(L + ((c.tid >> 3) * HI_LD + (c.tid & 7) * 8) * 2) = v; }
        __syncthreads();
#pragma unroll 2
        for (int i = 0; i < 8; ++i) { HFrag f; hload(f, LP + (size_t)i * 4096, QT + (size_t)i * 4096, boff, qtoff);
            f32x4 acc[2] = {bf4cvt(f.q[0]), bf4cvt(f.q[1])}; hmma(L, f.b, acc, m, fr, fq); bf16* So = SS + (size_t)i * 4096;
#pragma unroll
            for (int n = 0; n < 2; ++n)
#pragma unroll
                for (int k = 0; k < 4; ++k) So[(16 * m + 4 * fq + k) * 64 + n0 + 16 * n + fr] = f2bf(acc[n][k]); }
        __syncthreads();
    }
}
constexpr int WI_LD = 72, WI_B = 64 * WI_LD * 2, WI_GAM = 9 * WI_B, WI_GL = 15 * WI_B;
constexpr size_t WS_GM0 = 352 * MiB, WS_GM1 = 180 * MiB, WS_Y0 = 336 * MiB, WS_END2 = 360 * MiB;
__device__ __forceinline__ bf16* gm_ptr(unsigned char* ws, int h, int ch) { return (bf16*)(ws + (h < 4 ? WS_GM0 : WS_GM1)) + (size_t)((h & 3) * NCH + ch) * 4096; }
__device__ __forceinline__ void wi_mma(f32x4 (&acc)[2], const LAS3 unsigned char* A, const LAS3 unsigned char* Bt, int m, int n0, int fr, int fq) {
#pragma unroll
    for (int ks = 0; ks < 2; ++ks) { const bf16x8 av = *(const LAS3 bf16x8*)(A + ((16 * m + fr) * WI_LD + 32 * ks + 8 * fq) * 2);
#pragma unroll
        for (int n = 0; n < 2; ++n) { const bf16x8 bv = *(const LAS3 bf16x8*)(Bt + ((n0 + 16 * n + fr) * WI_LD + 32 * ks + 8 * fq) * 2); acc[n] = __builtin_amdgcn_mfma_f32_16x16x32_bf16(av, bv, acc[n], 0, 0, 0); } }
}
struct WiA { bf16x8 a[2]; }; struct WiB { bf16x8 b[2][2]; };
__device__ __forceinline__ void wi_lda(WiA& f, const LAS3 unsigned char* A, int m, int fr, int fq) {
#pragma unroll
    for (int ks = 0; ks < 2; ++ks) f.a[ks] = *(const LAS3 bf16x8*)(A + ((16 * m + fr) * WI_LD + 32 * ks + 8 * fq) * 2);
}
__device__ __forceinline__ void wi_ldb(WiB& f, const LAS3 unsigned char* Bt, int n0, int fr, int fq) {
#pragma unroll
    for (int ks = 0; ks < 2; ++ks)
#pragma unroll
        for (int n = 0; n < 2; ++n) f.b[ks][n] = *(const LAS3 bf16x8*)(Bt + ((n0 + 16 * n + fr) * WI_LD + 32 * ks + 8 * fq) * 2);
}
__device__ __forceinline__ void wi_fma(f32x4 (&acc)[2], const WiA& A, const WiB& B) {
#pragma unroll
    for (int ks = 0; ks < 2; ++ks)
#pragma unroll
        for (int n = 0; n < 2; ++n) acc[n] = __builtin_amdgcn_mfma_f32_16x16x32_bf16(A.a[ks], B.b[ks][n], acc[n], 0, 0, 0);
}
__device__ __forceinline__ void wi_fma_s(f32x4 (&acc)[2], const WiA& A, const WiB& B) {
#pragma unroll
    for (int ks = 0; ks < 2; ++ks)
#pragma unroll
        for (int n = 0; n < 2; ++n) acc[n] = __builtin_amdgcn_mfma_f32_16x16x32_bf16(B.b[ks][n], A.a[ks], acc[n], 0, 0, 0);
}
__device__ __forceinline__ void wi_st_nat_s(LAS3 unsigned char* X, const f32x4 (&acc)[2], int m, int n0, int fr, int fq) {
#pragma unroll
    for (int n = 0; n < 2; ++n) { u32x2 w; w.x = pk2(acc[n][0], acc[n][1]); w.y = pk2(acc[n][2], acc[n][3]); *(LAS3 u32x2*)(X + ((16 * m + fr) * WI_LD + n0 + 16 * n + 4 * fq) * 2) = w; }
}
__device__ __forceinline__ void wi_ld_nat_s(f32x4 (&acc)[2], const LAS3 unsigned char* X, int m, int n0, int fr, int fq) {
#pragma unroll
    for (int n = 0; n < 2; ++n) { const u32x2 w = *(const LAS3 u32x2*)(X + ((16 * m + fr) * WI_LD + n0 + 16 * n + 4 * fq) * 2);
        acc[n][0] = __uint_as_float(w.x << 16); acc[n][1] = __uint_as_float(w.x & 0xffff0000u); acc[n][2] = __uint_as_float(w.y << 16); acc[n][3] = __uint_as_float(w.y & 0xffff0000u); }
}
__device__ __forceinline__ void wi_ld_tr(f32x4 (&acc)[2], const LAS3 unsigned char* XT, int m, int n0, int fr, int fq) {
#pragma unroll
    for (int n = 0; n < 2; ++n) { const u32x2 w = *(const LAS3 u32x2*)(XT + ((n0 + 16 * n + fr) * WI_LD + 16 * m + 4 * fq) * 2);
        acc[n][0] = __uint_as_float(w.x << 16); acc[n][1] = __uint_as_float(w.x & 0xffff0000u); acc[n][2] = __uint_as_float(w.y << 16); acc[n][3] = __uint_as_float(w.y & 0xffff0000u); }
}
#define WI_PIN() __builtin_amdgcn_sched_barrier(0)
__device__ __forceinline__ void wi_st_nat(LAS3 unsigned char* X, const f32x4 (&acc)[2], int m, int n0, int fr, int fq) {
#pragma unroll
    for (int n = 0; n < 2; ++n)
#pragma unroll
        for (int i = 0; i < 4; ++i) *(LAS3 bf16*)(X + ((16 * m + 4 * fq + i) * WI_LD + n0 + 16 * n + fr) * 2) = f2bf(acc[n][i]);
}
__device__ __forceinline__ void wi_st_tr(LAS3 unsigned char* XT, const f32x4 (&acc)[2], int m, int n0, int fr, int fq) {
#pragma unroll
    for (int n = 0; n < 2; ++n) { u32x2 w; w.x = pk2(acc[n][0], acc[n][1]); w.y = pk2(acc[n][2], acc[n][3]); *(LAS3 u32x2*)(XT + ((n0 + 16 * n + fr) * WI_LD + 16 * m + 4 * fq) * 2) = w; }
}
__device__ __forceinline__ void wi_ld_nat(f32x4 (&acc)[2], const LAS3 unsigned char* X, int m, int n0, int fr, int fq) {
#pragma unroll
    for (int n = 0; n < 2; ++n)
#pragma unroll
        for (int i = 0; i < 4; ++i) acc[n][i] = bf2f(*(const LAS3 bf16*)(X + ((16 * m + 4 * fq + i) * WI_LD + n0 + 16 * n + fr) * 2));
}
__device__ __forceinline__ void phase_scan1m(ArgsR a, const Ctx& c, const int skip = 0) {
    const f16* WM1 = (const f16*)(a.ws + WS_WM1); const f16* KP = (const f16*)(a.ws + WS_KP);
    const f16* AA = (const f16*)(a.ws + WS_AA); const f16* BB = (const f16*)(a.ws + WS_BB); const f16* V = (const f16*)(a.ws + WS_V); const f16* R = (const f16*)(a.ws + WS_R);
    float* ST = (float*)(a.ws + WS_ST);
    LAS3 unsigned char* L = (LAS3 unsigned char*)c.lds;
    LAS3 float* GAM = (LAS3 float*)(L + WI_GAM); LAS3 float* GL = (LAS3 float*)(L + WI_GL);
    const int lane = c.lane, wv = c.wave, fr = lane & 15, fq = lane >> 4, m = wv >> 1, n0 = 32 * (wv & 1), tid = c.tid;
#define SLOT(i) (L + (i) * WI_B)
    const int t = tid >> 3, cc = (tid & 7) * 8;
    f16x8 pav, pbv, pkv, pvv, prv, pwv;
#define WI_FETCH(it) do { const int h_ = (it) / NCH, ch_ = (it) % NCH; const size_t eo_ = (size_t)(ch_ * CL + t) * W + h_ * 64 + cc; \
        pav = *(const f16x8*)(AA + eo_); pbv = *(const f16x8*)(BB + eo_); pkv = *(const f16x8*)(KP + eo_); pvv = *(const f16x8*)(V + eo_); prv = *(const f16x8*)(R + eo_); pwv = *(const f16x8*)(WM1 + eo_); } while (0)
    if (blockIdx.x < NH * NCH) WI_FETCH(blockIdx.x);
    for (int item = blockIdx.x; item < NH * NCH; item += gridDim.x) {
        const int h = item / NCH, ch = item % NCH;
        const f16x8 av = pav, bv = pbv, kv = pkv, vv = pvv, rv = prv, wv8 = pwv;
        if (item + (int)gridDim.x < NH * NCH) WI_FETCH(item + (int)gridDim.x);
        float g[8], gp[8];
        { float wloc[8];
#pragma unroll
          for (int e = 0; e < 8; ++e) wloc[e] = 1.0f + (float)wv8[e];
#pragma unroll
          for (int e = 0; e < 8; ++e) { float x = wloc[e];
              { const float y = __shfl_up(x, 8); if (lane >= 8) x *= y; } { const float y = __shfl_up(x, 16); if (lane >= 16) x *= y; } { const float y = __shfl_up(x, 32); if (lane >= 32) x *= y; }
              g[e] = x; }
          if (lane >= 56) {
#pragma unroll
              for (int e = 0; e < 8; ++e) GAM[wv * 64 + cc + e] = g[e]; }
          HBAR();
#pragma unroll
          for (int e = 0; e < 8; ++e) { float pre = 1.0f;
#pragma unroll
              for (int w = 0; w < 7; ++w) if (w < wv) pre *= GAM[w * 64 + cc + e];
              g[e] *= pre; gp[e] = g[e] * __builtin_amdgcn_rcpf(wloc[e]); } }
        { float fa[8], fb[8], fk[8], fv[8], frr[8];
#pragma unroll
          for (int e = 0; e < 8; ++e) { const float ig = __builtin_amdgcn_rcpf(g[e]);
              fa[e] = (float)av[e] * gp[e]; fb[e] = (float)bv[e] * ig; fk[e] = (float)kv[e] * ig; fv[e] = (float)vv[e]; frr[e] = (float)rv[e] * g[e]; if (t == 63) GL[cc + e] = g[e]; }
          *(LAS3 u32x4*)(SLOT(0) + (t * WI_LD + cc) * 2) = pack8bf(fa); *(LAS3 u32x4*)(SLOT(2) + (t * WI_LD + cc) * 2) = pack8bf(fb); *(LAS3 u32x4*)(SLOT(4) + (t * WI_LD + cc) * 2) = pack8bf(fk); *(LAS3 u32x4*)(SLOT(12) + (t * WI_LD + cc) * 2) = pack8bf(frr);
          *(LAS3 u32x4*)(SLOT(10) + (t * WI_LD + cc) * 2) = pack8bf(fv); }
        HBAR();
        { WiA aB, aK; WiB bA, bR; wi_lda(aB, SLOT(2), m, fr, fq); wi_lda(aK, SLOT(4), m, fr, fq); wi_ldb(bA, SLOT(0), n0, fr, fq); wi_ldb(bR, SLOT(12), n0, fr, fq);
          const int tch = tid & 63, tt0 = (tid >> 6) * 8; bf16 ta[8], tb[8], tv[8];
#pragma unroll
          for (int e = 0; e < 8; ++e) { ta[e] = *(const LAS3 bf16*)(SLOT(0) + ((tt0 + e) * WI_LD + tch) * 2); tb[e] = *(const LAS3 bf16*)(SLOT(2) + ((tt0 + e) * WI_LD + tch) * 2); tv[e] = *(const LAS3 bf16*)(SLOT(10) + ((tt0 + e) * WI_LD + tch) * 2); }
          WI_PIN();
          { u32x4 wa, wb, wv4;
#pragma unroll
            for (int e = 0; e < 4; ++e) { wa[e] = (unsigned)ta[2 * e] | ((unsigned)ta[2 * e + 1] << 16); wb[e] = (unsigned)tb[2 * e] | ((unsigned)tb[2 * e + 1] << 16); wv4[e] = (unsigned)tv[2 * e] | ((unsigned)tv[2 * e + 1] << 16); }
            *(LAS3 u32x4*)(SLOT(1) + (tch * WI_LD + tt0) * 2) = wa; *(LAS3 u32x4*)(SLOT(3) + (tch * WI_LD + tt0) * 2) = wb; *(LAS3 u32x4*)(SLOT(5) + (tch * WI_LD + tt0) * 2) = wv4; }
          f32x4 ans[2] = {{0.f, 0.f, 0.f, 0.f}, {0.f, 0.f, 0.f, 0.f}}, ant[2] = {{0.f, 0.f, 0.f, 0.f}, {0.f, 0.f, 0.f, 0.f}}, aks[2] = {{0.f, 0.f, 0.f, 0.f}, {0.f, 0.f, 0.f, 0.f}}, am[2] = {{0.f, 0.f, 0.f, 0.f}, {0.f, 0.f, 0.f, 0.f}}, amk[2] = {{0.f, 0.f, 0.f, 0.f}, {0.f, 0.f, 0.f, 0.f}};
          wi_fma_s(ans, aB, bA); wi_fma(ant, aB, bA); wi_fma_s(aks, aK, bA); wi_fma(am, aB, bR); wi_fma(amk, aK, bR);
          WI_PIN();
          f32x4 axs[2];
#pragma unroll
          for (int n = 0; n < 2; ++n)
#pragma unroll
              for (int i = 0; i < 4; ++i) { const int rs = 16 * m + fr, cs = n0 + 16 * n + 4 * fq + i;
                  if (!(rs < cs)) { ans[n][i] = 0.f; aks[n][i] = 0.f; } axs[n][i] = ans[n][i] + (rs == cs ? 1.0f : 0.f);
                  const int rn = 16 * m + 4 * fq + i, cn = n0 + 16 * n + fr;
                  if (!(rn < cn)) ant[n][i] = 0.f; if (rn > cn) { am[n][i] = 0.f; amk[n][i] = 0.f; } }
          wi_st_nat_s(SLOT(7), ans, m, n0, fr, fq); wi_st_tr(SLOT(8), ant, m, n0, fr, fq); wi_st_nat_s(SLOT(6), aks, m, n0, fr, fq); wi_st_nat_s(SLOT(11), axs, m, n0, fr, fq);
          wi_st_tr(SLOT(13), am, m, n0, fr, fq); wi_st_tr(SLOT(14), amk, m, n0, fr, fq); }
        HBAR();
        { WiA aN; WiB bN; wi_lda(aN, SLOT(7), m, fr, fq); wi_ldb(bN, SLOT(8), n0, fr, fq); WI_PIN();
          f32x4 a2s[2] = {{0.f, 0.f, 0.f, 0.f}, {0.f, 0.f, 0.f, 0.f}}, a2t[2] = {{0.f, 0.f, 0.f, 0.f}, {0.f, 0.f, 0.f, 0.f}}; wi_fma_s(a2s, aN, bN); wi_fma(a2t, aN, bN); WI_PIN();
          wi_st_nat_s(SLOT(9), a2s, m, n0, fr, fq); wi_st_tr(SLOT(10), a2t, m, n0, fr, fq); }
        HBAR();
#define WI_LEVEL(XS, XD, NS, NST, ND, NDT) do { WiA aX, aN; WiB bN; f32x4 ax[2]; wi_lda(aX, SLOT(XS), m, fr, fq); wi_ldb(bN, SLOT(NST), n0, fr, fq); wi_lda(aN, SLOT(NS), m, fr, fq); wi_ld_nat_s(ax, SLOT(XS), m, n0, fr, fq); \
            WI_PIN(); f32x4 aqs[2] = {{0.f, 0.f, 0.f, 0.f}, {0.f, 0.f, 0.f, 0.f}}, aqt[2] = {{0.f, 0.f, 0.f, 0.f}, {0.f, 0.f, 0.f, 0.f}}; wi_fma_s(ax, aX, bN); wi_fma_s(aqs, aN, bN); wi_fma(aqt, aN, bN); WI_PIN(); \
            wi_st_nat_s(SLOT(XD), ax, m, n0, fr, fq); wi_st_nat_s(SLOT(ND), aqs, m, n0, fr, fq); wi_st_tr(SLOT(NDT), aqt, m, n0, fr, fq); \
            HBAR(); } while (0)
        WI_LEVEL(11, 0, 9, 10, 7, 8);
        WI_LEVEL(0, 11, 7, 8, 9, 10);
        WI_LEVEL(11, 0, 9, 10, 7, 8);
        WI_LEVEL(0, 11, 7, 8, 9, 10);
#undef WI_LEVEL
        { WiA aX; WiB bN; f32x4 ax[2]; wi_lda(aX, SLOT(11), m, fr, fq); wi_ldb(bN, SLOT(10), n0, fr, fq); wi_ld_nat(ax, SLOT(11), m, n0, fr, fq); WI_PIN();
          wi_fma(ax, aX, bN); WI_PIN(); wi_st_tr(SLOT(0), ax, m, n0, fr, fq); }
        HBAR();
        { WiA aNk, aAt; WiB bT; wi_lda(aNk, SLOT(6), m, fr, fq); wi_lda(aAt, SLOT(1), m, fr, fq); wi_ldb(bT, SLOT(0), n0, fr, fq); WI_PIN();
          f32x4 aw[2] = {{0.f, 0.f, 0.f, 0.f}, {0.f, 0.f, 0.f, 0.f}}, aa[2] = {{0.f, 0.f, 0.f, 0.f}, {0.f, 0.f, 0.f, 0.f}}; wi_fma_s(aw, aNk, bT); wi_fma_s(aa, aAt, bT); WI_PIN();
          wi_st_nat_s(SLOT(2), aw, m, n0, fr, fq); wi_st_nat_s(SLOT(7), aa, m, n0, fr, fq); }
        HBAR();
        { WiA aAT, aW1; WiB bB, bM; f32x4 ap[2] = {{0.f, 0.f, 0.f, 0.f}, {0.f, 0.f, 0.f, 0.f}}, az[2], ag[2], az2[2]; float gl[2];
          wi_lda(aAT, SLOT(7), m, fr, fq); wi_lda(aW1, SLOT(2), m, fr, fq); wi_ldb(bB, SLOT(3), n0, fr, fq); wi_ldb(bM, SLOT(13), n0, fr, fq);
          wi_ld_nat(az, SLOT(4), m, n0, fr, fq); wi_ld_tr(az2, SLOT(14), m, n0, fr, fq); wi_ld_tr(ag, SLOT(12), m, n0, fr, fq);
#pragma unroll
          for (int n = 0; n < 2; ++n) gl[n] = GL[n0 + 16 * n + fr];
          WI_PIN();
          wi_fma(ap, aAT, bB); wi_fma(az, aW1, bB); wi_fma(ag, aAT, bM); wi_fma(az2, aW1, bM);
          WI_PIN();
          wi_st_tr(SLOT(8), az, m, n0, fr, fq); wi_st_tr(SLOT(9), az2, m, n0, fr, fq);
          bf16* PTp = (bf16*)ST + (size_t)(h * NCH + ch) * 4096; bf16* GMp = gm_ptr(a.ws, h, ch);
#pragma unroll
          for (int n = 0; n < 2; ++n) { const int col = n0 + 16 * n + fr; f32x4 pv = ap[n];
#pragma unroll
              for (int i = 0; i < 4; ++i) { if (16 * m + 4 * fq + i == col) pv[i] += 1.0f; pv[i] *= gl[n]; }
              u32x2 w; w.x = pk2(pv[0], pv[1]); w.y = pk2(pv[2], pv[3]); *(u32x2*)(PTp + col * 64 + 16 * m + 4 * fq) = w;
              u32x2 w2; w2.x = pk2(ag[n][0], ag[n][1]); w2.y = pk2(ag[n][2], ag[n][3]); *(u32x2*)(GMp + col * 64 + 16 * m + 4 * fq) = w2; } }
        HBAR();
        { WiA aV; WiB bZ1, bZ2; float gl[2]; wi_lda(aV, SLOT(5), m, fr, fq); wi_ldb(bZ1, SLOT(8), n0, fr, fq); wi_ldb(bZ2, SLOT(9), n0, fr, fq); gl[0] = GL[n0 + fr]; gl[1] = GL[n0 + 16 + fr]; WI_PIN();
          f32x4 aq[2] = {{0.f, 0.f, 0.f, 0.f}, {0.f, 0.f, 0.f, 0.f}}, ay[2] = {{0.f, 0.f, 0.f, 0.f}, {0.f, 0.f, 0.f, 0.f}}; wi_fma(aq, aV, bZ1); wi_fma(ay, aV, bZ2); WI_PIN();
          bf16* QTp = (bf16*)ST + ST_QB_OFF + (size_t)(h * NCH + ch) * 4096; bf16* Y0p = (bf16*)(a.ws + WS_Y0) + (size_t)(h * NCH + ch) * 4096;
#pragma unroll
          for (int n = 0; n < 2; ++n) { const int col = n0 + 16 * n + fr; store4bf(QTp + col * 64 + 16 * m + 4 * fq, aq[n] * gl[n]);
              u32x2 w; w.x = pk2(ay[n][0], ay[n][1]); w.y = pk2(ay[n][2], ay[n][3]); *(u32x2*)(Y0p + col * 64 + 16 * m + 4 * fq) = w; } }
        HBAR();
    }
#undef SLOT
#undef WI_FETCH
}

__device__ __forceinline__ void phase_scan3m(ArgsR a, const Ctx& c, int l) {
    const f16* R = (const f16*)(a.ws + WS_R); const f16* KP = (const f16*)(a.ws + WS_KP); const f16* V = (const f16*)(a.ws + WS_V); const bf16* G = (const bf16*)(a.ws + WS_G);
    bf16* YA = (bf16*)(a.ws + WS_YA);
    LAS3 unsigned char* L = (LAS3 unsigned char*)c.lds;
    LAS3 float* YL = (LAS3 float*)(L + WI_B);
    LAS3 unsigned char* S0I = L + 3 * WI_B;
    const int lane = c.lane, wv = c.wave, fr = lane & 15, fq = lane >> 4, m = wv >> 1, n0 = 32 * (wv & 1), tid = c.tid;
    const int boff = (n0 + fr) * 64 + 8 * fq, qtoff = (n0 + fr) * 64 + 16 * m + 4 * fq;
    u32x4 pS; bf16x8 pL[2][2]; u32x2 pQ[2]; bf16x8 pB[2][2]; u32x2 pY[2];
#define S3_FETCH(it) do { const int h_ = (it) / NCH, ch_ = (it) % NCH; pS = (u32x4){0u, 0u, 0u, 0u}; \
        _Pragma("unroll") for (int ks = 0; ks < 2; ++ks) _Pragma("unroll") for (int n = 0; n < 2; ++n) pL[ks][n] = (bf16x8){0, 0, 0, 0, 0, 0, 0, 0}; \
        pQ[0] = (u32x2){0u, 0u}; pQ[1] = (u32x2){0u, 0u}; \
        if (ch_ > 0) { const int c1_ = ch_ - 1; pS = *(const u32x4*)((const bf16*)(a.ws + WS_SG) + (size_t)(h_ * NG + c1_ / GS) * 4096 + tid * 8); \
            const bf16* LP_ = (const bf16*)(a.ws + WS_ST) + ST_LP_OFF + (size_t)(h_ * NCH + c1_) * 4096; const bf16* QT_ = (const bf16*)(a.ws + WS_ST) + ST_QB_OFF + (size_t)(h_ * NCH + c1_) * 4096; \
            _Pragma("unroll") for (int ks = 0; ks < 2; ++ks) _Pragma("unroll") for (int n = 0; n < 2; ++n) pL[ks][n] = *(const bf16x8*)(LP_ + boff + 16 * n * 64 + 32 * ks); \
            _Pragma("unroll") for (int n = 0; n < 2; ++n) pQ[n] = *(const u32x2*)(QT_ + qtoff + 16 * n * 64); } \
        const bf16* G_ = gm_ptr(a.ws, h_, ch_); const bf16* Y_ = (const bf16*)(a.ws + WS_Y0) + (size_t)(h_ * NCH + ch_) * 4096; \
        _Pragma("unroll") for (int ks = 0; ks < 2; ++ks) _Pragma("unroll") for (int n = 0; n < 2; ++n) pB[ks][n] = *(const bf16x8*)(G_ + (n0 + 16 * n + fr) * 64 + 32 * ks + 8 * fq); \
        _Pragma("unroll") for (int n = 0; n < 2; ++n) pY[n] = *(const u32x2*)(Y_ + (n0 + 16 * n + fr) * 64 + 16 * m + 4 * fq); } while (0)
    if (blockIdx.x < NH * NCH) S3_FETCH(blockIdx.x);
    for (int item = blockIdx.x; item < NH * NCH; item += gridDim.x) {
        const int h = item / NCH, ch = item % NCH;
        *(LAS3 u32x4*)(L + ((tid >> 3) * WI_LD + (tid & 7) * 8) * 2) = pS;
        bf16x8 lfr[2][2], bfr[2][2]; f32x4 as0[2], acc[2];
#pragma unroll
        for (int ks = 0; ks < 2; ++ks)
#pragma unroll
            for (int n = 0; n < 2; ++n) { lfr[ks][n] = pL[ks][n]; bfr[ks][n] = pB[ks][n]; }
#pragma unroll
        for (int n = 0; n < 2; ++n) { as0[n] = bf4cvt(pQ[n]); acc[n][0] = __uint_as_float(pY[n].x << 16); acc[n][1] = __uint_as_float(pY[n].x & 0xffff0000u); acc[n][2] = __uint_as_float(pY[n].y << 16); acc[n][3] = __uint_as_float(pY[n].y & 0xffff0000u); }
        if (item + (int)gridDim.x < NH * NCH) S3_FETCH(item + (int)gridDim.x);
        HBAR();
        hmma(L, lfr, as0, m, fr, fq);
        himg_store(S0I, as0, m, n0, fr, fq);
        HBAR();
#pragma unroll
        for (int ks = 0; ks < 2; ++ks) { const bf16x8 av = *(const LAS3 bf16x8*)(S0I + ((16 * m + fr) * WI_LD + 32 * ks + 8 * fq) * 2);
#pragma unroll
            for (int n = 0; n < 2; ++n) acc[n] = __builtin_amdgcn_mfma_f32_16x16x32_bf16(av, bfr[ks][n], acc[n], 0, 0, 0); }
#pragma unroll
        for (int n = 0; n < 2; ++n)
#pragma unroll
            for (int i = 0; i < 4; ++i) YL[(n0 + 16 * n + fr) * 65 + 16 * m + 4 * fq + i] = acc[n][i];
        HBAR();
        { const float gn_g = a.in[I_GNG][l * W + h * 64 + lane], gn_b = a.in[I_GNB][l * W + h * 64 + lane], r_k = a.in[I_RK][l * W + h * 64 + lane];
          f16 rl8[8], kl8[8], vl8[8]; bf16 gl8[8];
#pragma unroll
          for (int i = 0; i < 8; ++i) { const size_t o = (size_t)(ch * CL + 8 * wv + i) * W + h * 64 + lane; rl8[i] = R[o]; kl8[i] = KP[o]; vl8[i] = V[o]; gl8[i] = G[o]; }
#pragma unroll
          for (int i = 0; i < 8; ++i) { const int t = 8 * wv + i; const size_t o = (size_t)(ch * CL + t) * W + h * 64 + lane;
              const float yy = YL[t * 65 + lane]; const float rl = (float)rl8[i], kl = (float)kl8[i], vl = (float)vl8[i], gl = bf2f(gl8[i]);
              const float mean = wave_sum(yy) * (1.f / 64.f); const float dd = yy - mean; const float var = wave_sum(dd * dd) * (1.f / 64.f);
              const float bonus = wave_sum(rl * kl * r_k);
              const float yn = dd * __builtin_amdgcn_rsqf(var + GN_EPS) * gn_g + gn_b + bonus * vl;
              YA[o] = f2bf(yn * gl); } }
        HBAR();
    }
#undef S3_FETCH
}

__device__ __forceinline__ void phase_scan3(ArgsR a, const Ctx& c, int l) {
    const f16* R = (const f16*)(a.ws + WS_R); const f16* WM1 = (const f16*)(a.ws + WS_WM1); const f16* KP = (const f16*)(a.ws + WS_KP);
    const f16* AA = (const f16*)(a.ws + WS_AA); const f16* BB = (const f16*)(a.ws + WS_BB); const f16* V = (const f16*)(a.ws + WS_V);
    const float* ST = (const float*)(a.ws + WS_ST); bf16* YA = (bf16*)(a.ws + WS_YA); const f16* Gs = (const f16*)(a.ws + WS_G);
    const int lane = c.lane;
    LAS3 unsigned char* ring = (LAS3 unsigned char*)c.lds + c.wave * SC_WAVE;
    for (int item = c.gw; item < NH * NCH; item += c.ngw) {
        const int h = __builtin_amdgcn_readfirstlane(item / NCH), ch = __builtin_amdgcn_readfirstlane(item % NCH);
        const size_t lane_off = (size_t)(lane >> 3) * W + h * 64 + (lane & 7) * 8;
        const float gn_g = a.in[I_GNG][l * W + h * 64 + lane], gn_b = a.in[I_GNB][l * W + h * 64 + lane], r_k = a.in[I_RK][l * W + h * 64 + lane];
        { const size_t e0 = (size_t)(ch * CL) * W + lane_off;
          sc_dma(AA, e0, ring); sc_dma(WM1, e0, ring + 1024); sc_dma(BB, e0, ring + 2048); sc_dma(KP, e0, ring + 3072); sc_dma(V, e0, ring + 4096); sc_dma(R, e0, ring + 5120); sc_dma(Gs, e0, ring + 6144); }
        float S[64];
        if (ch == 0) {
#pragma unroll
            for (int j = 0; j < 64; ++j) S[j] = 0.f;
        } else { const bf16* Sp = (const bf16*)ST + ((size_t)(h * NCH + ch - 1) * 64 + lane) * 64;
#pragma unroll
            for (int j = 0; j < 64; j += 4) { const f32x4 x = load4bf(Sp + j); S[j] = x[0]; S[j + 1] = x[1]; S[j + 2] = x[2]; S[j + 3] = x[3]; } }
#pragma unroll 1
        for (int blk = 0; blk < CL / SCB; ++blk) {
            LAS3 unsigned char* buf = ring + (blk & 1) * SC_BUF;
            if (blk + 1 < CL / SCB) { LAS3 unsigned char* nb = ring + ((blk + 1) & 1) * SC_BUF; const size_t e0 = (size_t)(ch * CL + (blk + 1) * SCB) * W + lane_off;
                sc_dma(AA, e0, nb); sc_dma(WM1, e0, nb + 1024); sc_dma(BB, e0, nb + 2048); sc_dma(KP, e0, nb + 3072); sc_dma(V, e0, nb + 4096); sc_dma(R, e0, nb + 5120); sc_dma(Gs, e0, nb + 6144);
                asm volatile("s_waitcnt vmcnt(7)" ::: "memory"); }
            else asm volatile("s_waitcnt vmcnt(0)" ::: "memory");
            SVec A, Wv, Bv, Kv, Rv;
            sv_cvt(A, sv_read(buf, lane)); sv_cvt1p(Wv, sv_read(buf + 1024, lane)); sv_cvt(Bv, sv_read(buf + 2048, lane)); sv_cvt(Kv, sv_read(buf + 3072, lane)); sv_cvt(Rv, sv_read(buf + 5120, lane));
            float vv = (float)*(const LAS3 f16*)(buf + 4096 + lane * 2);
#pragma unroll 1
            for (int st = 0; st < SCB; ++st) {
                const LAS3 unsigned char* sn = buf + ((st + 1 < SCB) ? st + 1 : st) * 128;
                const f16x4 ha = sv_read(sn, lane), hw = sv_read(sn + 1024, lane), hb = sv_read(sn + 2048, lane), hk = sv_read(sn + 3072, lane), hr = sv_read(sn + 5120, lane);
                const f16 hv = *(const LAS3 f16*)(sn + 4096 + lane * 2);
                float d[4] = {0.f, 0.f, 0.f, 0.f};
                sc_dot<0>(d, A, S);
                const float sa = (d[0] + d[1]) + (d[2] + d[3]);
                float y[4] = {0.f, 0.f, 0.f, 0.f};
                sc_upd3<0>(S, y, Wv, Bv, Kv, Rv, sa, vv);
                const float yy = (y[0] + y[1]) + (y[2] + y[3]);
                sv_cvt(A, ha); sv_cvt1p(Wv, hw); sv_cvt(Bv, hb); sv_cvt(Kv, hk); sv_cvt(Rv, hr); vv = (float)hv;
                { const LAS3 unsigned char* sb = buf + st * 128;
                  const float rl = (float)*(const LAS3 f16*)(sb + 5120 + lane * 2), kl = (float)*(const LAS3 f16*)(sb + 3072 + lane * 2), vl = (float)*(const LAS3 f16*)(sb + 4096 + lane * 2);
                  const float gl = bf2f(*(const LAS3 bf16*)(sb + 6144 + lane * 2));
                  const float mean = wave_sum(yy) * (1.f / 64.f); const float dd = yy - mean; const float var = wave_sum(dd * dd) * (1.f / 64.f);
                  const float bonus = wave_sum(rl * kl * r_k);
                  const float yn = dd * __builtin_amdgcn_rsqf(var + GN_EPS) * gn_g + gn_b + bonus * vl;
                  YA[(size_t)(ch * CL + blk * SCB + st) * W + h * 64 + lane] = f2bf(yn * gl); }
            }
        }
    }
}

__device__ __forceinline__ void phase_post(ArgsR a, const Ctx& c, int l) {
    const bf16* YSC = (const bf16*)(a.ws + WS_YSC); const f16* R = (const f16*)(a.ws + WS_R); const f16* KP = (const f16*)(a.ws + WS_KP); const f16* V = (const f16*)(a.ws + WS_V);
    const bf16* G = (const bf16*)(a.ws + WS_G); bf16* YA = (bf16*)(a.ws + WS_YA);
    const float* gng = a.in[I_GNG] + l * W; const float* gnb = a.in[I_GNB] + l * W; const float* rk = a.in[I_RK] + l * W;
    for (int t = c.gw; t < T; t += c.ngw) {
#pragma unroll
        for (int i = 0; i < 8; ++i) { const int n = c.lane + 64 * i; const size_t o = (size_t)t * W + n;
            const float y = bf2f(YSC[o]); const float mean = wave_sum(y) * (1.f / 64.f); const float d = y - mean; const float var = wave_sum(d * d) * (1.f / 64.f);
            float yn = d * __builtin_amdgcn_rsqf(var + GN_EPS) * gng[n] + gnb[n];
            const float r = (float)R[o], k = (float)KP[o], v = (float)V[o];
            const float bonus = wave_sum(r * k * rk[n]);
            yn += bonus * v;
            YA[o] = f2bf(yn * bf2f(G[o])); }
    }
}

__device__ __forceinline__ void phase_ln1(ArgsR a, const Ctx& c, int l, float* outw, int mode = 3) {
    const float* MODF = (const float*)(a.ws + WS_MODF) + l * 6144;
    const float* g1 = a.in[I_LN1G] + l * D; const float* b1 = a.in[I_LN1B] + l * D;
    bf16* XN = (bf16*)(a.ws + WS_XN);
    int* TOKI = (int*)(a.ws + WS_TOKI); float* TOKW = (float*)(a.ws + WS_TOKW); int* TOKP = (int*)(a.ws + WS_TOKP);
    const float* rw = a.in[I_RW]; const float* rb = a.in[I_RB];
    LAS3 float* rwT = (LAS3 float*)((LAS3 unsigned char*)c.lds + 69632);
    constexpr int RW_LD = D + 4;
    unsigned* lcnt = (unsigned*)(c.lds + 135488);
    if (mode & 1) {
    for (int i = c.tid; i < D * NE; i += NTHREADS) rwT[(i & 15) * RW_LD + (i >> 4)] = rw[i];
    if (c.tid < NE) lcnt[c.tid] = 0u;
    __syncthreads();
    const bf16* TMP = (const bf16*)(a.ws + WS_TMP);
    float vn[16]; if (c.gw < T) load_row16bf(TMP + (size_t)c.gw * D, c.lane, vn);
    for (int m = c.gw; m < T; m += c.ngw) {
        int l4 = 4 * c.lane; asm volatile("" : "+v"(l4));
        float v[16];
#pragma unroll
        for (int j = 0; j < 16; ++j) v[j] = vn[j];
        if (m + c.ngw < T) load_row16bf(TMP + (size_t)(m + c.ngw) * D, c.lane, vn);
        float mean, rstd; row_stats(v, mean, rstd);
#pragma unroll
        for (int j = 0; j < 4; ++j) { f32x4 o; const int col = l4 + 256 * j;
#pragma unroll
            for (int e = 0; e < 4; ++e) { v[4 * j + e] = (v[4 * j + e] - mean) * rstd * g1[col + e] + b1[col + e]; o[e] = v[4 * j + e]; }
            *(f32x4*)(outw + (size_t)m * D + col) = o; }
        row_stats(v, mean, rstd);
#pragma unroll
        for (int j = 0; j < 4; ++j) { f32x4 o; const int col = l4 + 256 * j;
#pragma unroll
            for (int e = 0; e < 4; ++e) { v[4 * j + e] = (v[4 * j + e] - mean) * rstd * (1.0f + MODF[4096 + col + e]) + MODF[3072 + col + e]; o[e] = v[4 * j + e]; }
            store4bf(XN + (size_t)m * D + col, o); }
        float lg[16];
#pragma unroll
        for (int e = 0; e < 16; ++e) { float x = 0.f;
#pragma unroll
            for (int j = 0; j < 4; ++j) { const f32x4 r4 = *(const LAS3 f32x4*)(rwT + e * RW_LD + l4 + 256 * j); x += (v[4 * j] * r4[0] + v[4 * j + 1] * r4[1]) + (v[4 * j + 2] * r4[2] + v[4 * j + 3] * r4[3]); }
            lg[e] = x;
            if ((e & 3) == 3) __builtin_amdgcn_sched_barrier(0); }
        float r8[8], r4v[4], r2[2], r1;
        { const bool b5 = (c.lane & 32) != 0, b4 = (c.lane & 16) != 0, b3 = (c.lane & 8) != 0, b2 = (c.lane & 4) != 0;
#pragma unroll
          for (int i = 0; i < 8; ++i) { const float snd = b5 ? lg[i] : lg[i + 8], kp = b5 ? lg[i + 8] : lg[i]; r8[i] = kp + __shfl_xor(snd, 32); }
#pragma unroll
          for (int i = 0; i < 4; ++i) { const float snd = b4 ? r8[i] : r8[i + 4], kp = b4 ? r8[i + 4] : r8[i]; r4v[i] = kp + __shfl_xor(snd, 16); }
#pragma unroll
          for (int i = 0; i < 2; ++i) { const float snd = b3 ? r4v[i] : r4v[i + 2], kp = b3 ? r4v[i + 2] : r4v[i]; r2[i] = kp + __shfl_xor(snd, 8); }
          { const float snd = b2 ? r2[0] : r2[1], kp = b2 ? r2[1] : r2[0]; r1 = kp + __shfl_xor(snd, 4); }
          r1 += __shfl_xor(r1, 2); r1 += __shfl_xor(r1, 1); }
        float sc[16], sel[16];
#pragma unroll
        for (int e = 0; e < 16; ++e) { const float lgt = __shfl(r1, 4 * e); sc[e] = __builtin_amdgcn_rcpf(1.0f + __expf(-lgt)); sel[e] = sc[e] + rb[e]; }
        int best = 0; float bestv = -INFINITY;
#pragma unroll
        for (int g = 0; g < 4; ++g) { float m1 = -INFINITY, m2 = -INFINITY;
#pragma unroll
            for (int q = 0; q < 4; ++q) { const float sv = sel[4 * g + q]; if (sv > m1) { m2 = m1; m1 = sv; } else if (sv > m2) m2 = sv; }
            const float gs = m1 + m2; if (gs > bestv) { bestv = gs; best = g; } }
        int i1 = 0, i2 = 0; float s1 = -INFINITY, s2 = -INFINITY, w1 = 0.f, w2 = 0.f;
#pragma unroll
        for (int e = 0; e < 16; ++e) { if ((e >> 2) == best) { const float sv = sel[e];
                if (sv > s1) { s2 = s1; i2 = i1; w2 = w1; s1 = sv; i1 = e; w1 = sc[e]; } else if (sv > s2) { s2 = sv; i2 = e; w2 = sc[e]; } } }
        if (c.lane == 0) { const float ws = w1 + w2;
            TOKI[2 * m] = i1; TOKI[2 * m + 1] = i2; TOKW[2 * m] = w1 / ws; TOKW[2 * m + 1] = w2 / ws;
            TOKP[2 * m] = (int)atomicAdd(&lcnt[i1], 1u); TOKP[2 * m + 1] = (int)atomicAdd(&lcnt[i2], 1u); }
    }
    __syncthreads();
    if (c.tid < NE) ((int*)(a.ws + WS_BLKCNT))[blockIdx.x * NE + c.tid] = (int)lcnt[c.tid];
    __syncthreads();
    }
}

__device__ __forceinline__ void expert_convert(ArgsR a, const Ctx& c, int l, int b0) {
    if ((int)blockIdx.x < b0) return;
    float* scr = (float*)(c.lds + c.wave * 8704);
    bf16* WGU = (bf16*)(a.ws + WS_WGU); bf16* WD = (bf16*)(a.ws + WS_WD);
    constexpr int IG = (D / 64) * (FF / 32);
    constexpr int ID = (FF / 64) * (D / 32);
    const int gw0 = ((int)blockIdx.x - b0) * NWAVES + c.wave, ngw0 = ((int)gridDim.x - b0) * NWAVES;
    for (int it = gw0; it < NE * (2 * IG + ID); it += ngw0) {
        const int e = it / (2 * IG + ID); int r = it % (2 * IG + ID);
        const size_t eo = ((size_t)l * NE + e) * (size_t)D * FF;
        if (r < IG) { transpose_matrix_item(a.in[I_EG] + eo, D, FF, WGU + (size_t)e * 1024 * 1024, r, scr, c.lane, RowGU{0}); continue; } r -= IG;
        if (r < IG) { transpose_matrix_item(a.in[I_EU] + eo, D, FF, WGU + (size_t)e * 1024 * 1024, r, scr, c.lane, RowGU{1}); continue; } r -= IG;
        transpose_matrix_item(a.in[I_ED] + eo, FF, D, WD + (size_t)e * 1024 * 512, r, scr, c.lane, RowId());
    }
}

__device__ __forceinline__ void phase_perm(ArgsR a, const Ctx& c, int l) {
    const int* BLKCNT = (const int*)(a.ws + WS_BLKCNT);
    LAS3 int* pre = (LAS3 int*)c.lds;
    LAS3 int* tot = pre + 256 * NE;
    const int nb = gridDim.x;
#pragma unroll
    for (int q = 0; q < 2; ++q) { const int e = 2 * c.wave + q; int v[4]; int sum = 0;
#pragma unroll
        for (int i = 0; i < 4; ++i) { const int b = 4 * c.lane + i; v[i] = b < nb ? BLKCNT[b * NE + e] : 0; sum += v[i]; }
        int inc = sum;
#pragma unroll
        for (int o = 1; o < 64; o <<= 1) { const int t = __shfl_up(inc, o); if (c.lane >= o) inc += t; }
        int run = inc - sum;
#pragma unroll
        for (int i = 0; i < 4; ++i) { pre[(4 * c.lane + i) * NE + e] = run; run += v[i]; }
        if (c.lane == 63) tot[e] = inc; }
    __syncthreads();
    int ts[17]; { int sacc = 0;
#pragma unroll
        for (int e = 0; e < 16; ++e) { ts[e] = sacc; sacc += (tot[e] + 255) >> 8; } ts[16] = sacc; }
    if (blockIdx.x == 0 && c.tid < NE) ((int*)(a.ws + WS_TOT))[c.tid] = tot[c.tid];
    const int* TOKI = (const int*)(a.ws + WS_TOKI); const int* TOKP = (const int*)(a.ws + WS_TOKP); int* S2T = (int*)(a.ws + WS_S2T); const float* TOKW = (const float*)(a.ws + WS_TOKW);
    const bf16* XN = (const bf16*)(a.ws + WS_XN); bf16* XS = (bf16*)(a.ws + WS_XS);
    for (int as = blockIdx.x * NTHREADS + c.tid; as < 2 * T; as += gridDim.x * NTHREADS) {
        const int e = TOKI[as]; int base = 0;
#pragma unroll
        for (int j = 0; j < 16; ++j) base = (j == e) ? ts[j] : base;
        const int m = as >> 1, blk = (m % c.ngw) >> 3;
        const u32x2 sw = {(unsigned)as, __float_as_uint(TOKW[as])};
        *(u32x2*)(S2T + 2 * (base * 256 + pre[blk * NE + e] + TOKP[as])) = sw;
    }
    for (int e = 0; e < 16; ++e) {
        int tse = 0, tsn = 0;
#pragma unroll
        for (int j = 0; j < 16; ++j) { tse = (j == e) ? ts[j] : tse; tsn = (j == e) ? ts[j + 1] : tsn; }
        const int lo = tse * 256 + tot[e], hi = tsn * 256;
        for (int sl = lo + blockIdx.x * NTHREADS + c.tid; sl < hi; sl += gridDim.x * NTHREADS) S2T[2 * sl] = -1;
    }
    __syncthreads();
}

__device__ __forceinline__ void phase_ln2(ArgsR a, const Ctx& c, int l, float* outw) {
    const float* MODF = (const float*)(a.ws + WS_MODF) + l * 6144;
    const float* g2 = a.in[I_LN2G] + l * D; const float* b2 = a.in[I_LN2B] + l * D;
    const bf16* Y = (const bf16*)(a.ws + WS_Y); bf16* XN = (bf16*)(a.ws + WS_XN);
    float vn[16]; u32x2 y0n[4], y1n[4];
    if (c.gw < T) { load_row16(a.out + (size_t)c.gw * D, c.lane, vn);
#pragma unroll
        for (int j = 0; j < 4; ++j) { y0n[j] = *(const u32x2*)(Y + (size_t)(2 * c.gw) * D + 4 * c.lane + 256 * j); y1n[j] = *(const u32x2*)(Y + (size_t)(2 * c.gw + 1) * D + 4 * c.lane + 256 * j); } }
    for (int m = c.gw; m < T; m += c.ngw) {
        float v[16]; u32x2 y0[4], y1[4];
#pragma unroll
        for (int j = 0; j < 16; ++j) v[j] = vn[j];
#pragma unroll
        for (int j = 0; j < 4; ++j) { y0[j] = y0n[j]; y1[j] = y1n[j]; }
        if (m + c.ngw < T) { const int mn = m + c.ngw; load_row16(a.out + (size_t)mn * D, c.lane, vn);
#pragma unroll
            for (int j = 0; j < 4; ++j) { y0n[j] = *(const u32x2*)(Y + (size_t)(2 * mn) * D + 4 * c.lane + 256 * j); y1n[j] = *(const u32x2*)(Y + (size_t)(2 * mn + 1) * D + 4 * c.lane + 256 * j); } }
#pragma unroll
        for (int j = 0; j < 4; ++j) { const int col = 4 * c.lane + 256 * j;
            const float a0 = __uint_as_float(y0[j].x << 16) + __uint_as_float(y1[j].x << 16), a1 = __uint_as_float(y0[j].x & 0xffff0000u) + __uint_as_float(y1[j].x & 0xffff0000u);
            const float a2 = __uint_as_float(y0[j].y << 16) + __uint_as_float(y1[j].y << 16), a3 = __uint_as_float(y0[j].y & 0xffff0000u) + __uint_as_float(y1[j].y & 0xffff0000u);
            const f32x4 gt = *(const f32x4*)(MODF + 5120 + col);
            v[4 * j] = ALPHA * v[4 * j] + (1.0f + gt[0]) * a0; v[4 * j + 1] = ALPHA * v[4 * j + 1] + (1.0f + gt[1]) * a1; v[4 * j + 2] = ALPHA * v[4 * j + 2] + (1.0f + gt[2]) * a2; v[4 * j + 3] = ALPHA * v[4 * j + 3] + (1.0f + gt[3]) * a3; }
        float mean, rstd; row_stats(v, mean, rstd);
#pragma unroll
        for (int j = 0; j < 4; ++j) { f32x4 o; const int col = 4 * c.lane + 256 * j;
#pragma unroll
            for (int e = 0; e < 4; ++e) { v[4 * j + e] = (v[4 * j + e] - mean) * rstd * g2[col + e] + b2[col + e]; o[e] = v[4 * j + e]; }
            *(f32x4*)(outw + (size_t)m * D + col) = o; }
        if (l + 1 < DEPTH) {
            const float* MN = MODF + 6144;
            row_stats(v, mean, rstd);
#pragma unroll
            for (int j = 0; j < 4; ++j) { f32x4 o; const int col = 4 * c.lane + 256 * j;
#pragma unroll
                for (int e = 0; e < 4; ++e) o[e] = (v[4 * j + e] - mean) * rstd * (1.0f + MN[1024 + col + e]) + MN[col + e];
                store4bf(XN + (size_t)m * D + col, o); }
        }
    }
}


template <class F> struct EpiAdapt {
    static constexpr bool PERM = true, AFTER_DRAIN = false; F f;
    __device__ __forceinline__ void operator()(const f32x4 (&acc)[2][2][4][2], const Unit& u, int wr, int wc, int fr, int fq) const {
        const int col = u.pn * 256 + wc * 32 + 8 * fq;
#pragma unroll
        for (int ai = 0; ai < 2; ++ai)
#pragma unroll
            for (int m = 0; m < 4; ++m) { const int row = u.pm * 256 + ai * 128 + wr * 64 + m * 16 + fr; f(row, col, acc[ai][0][m][0], acc[ai][0][m][1], acc[ai][1][m][0], acc[ai][1][m][1]); }
    }
};

template <class Sched, class F>
__device__ __forceinline__ void gemm_gather(const Ctx& c, const bf16* A, const int* s2t, const bf16* Bt, int M, int N, int K, const Sched& S, const F& f) {
    pg8::Gemm g{A, Bt, M, N, K}; EpiAdapt<F> E{f};
    pg8::gemm_phase<EpiAdapt<F>, Sched, true, true, true>((PG8_LAS unsigned char*)c.lds, g, S, E, c.tid, s2t);
}
template <class Sched, class F>
__device__ __forceinline__ void gemm_any(const Ctx& c, const bf16* A, const bf16* Bt, int M, int N, int K, const Sched& S, const F& f) {
    pg8::Gemm g{A, Bt, M, N, K}; EpiAdapt<F> E{f};
    pg8::gemm_phase<EpiAdapt<F>, Sched, true, true>((PG8_LAS unsigned char*)c.lds, g, S, E, c.tid);
}

#define LAS __attribute__((address_space(3)))
#define XB_TMO      128
#define XB_XCNT(j)  (256  + 64 * (j))
#define XB_XSUB(j)  (1280 + 64 * (j))
#define XB_XGEN(j)  (2304 + 64 * (j))
#define XB_TOP      3328
#define XB_TOPGEN   3392
#define XCD_BAR_WORDS 3456
#define XB_SPIN_CAP (1u << 24)

__device__ __forceinline__ unsigned xb_ld(unsigned* p)              { return __hip_atomic_load(p, __ATOMIC_RELAXED, __HIP_MEMORY_SCOPE_AGENT); }
__device__ __forceinline__ unsigned xb_add(unsigned* p, unsigned v) { return __hip_atomic_fetch_add(p, v, __ATOMIC_RELAXED, __HIP_MEMORY_SCOPE_AGENT); }
__device__ __forceinline__ unsigned xb_xcc_id() { return (unsigned)__builtin_amdgcn_s_getreg((3 << 11) | 20) & 0xFu; }
#define XB_SPIN(cond, bar) do { unsigned _sp = 0; while (cond) { __builtin_amdgcn_s_sleep(1); \
    if ((++_sp & 255u) == 0u) { if (xb_ld(&(bar)[XB_TMO])) break; if (_sp > XB_SPIN_CAP) { atomicAdd(&(bar)[XB_TMO], 1u); break; } } } } while (0)

struct XcdBarrier {
    unsigned* bar; unsigned x;
    volatile LAS unsigned* st;
};

__device__ __forceinline__ XcdBarrier xcd_barrier_post(unsigned* bar, volatile LAS unsigned* st) {
    XcdBarrier b; b.bar = bar; b.x = xb_xcc_id(); b.st = st;
    if (threadIdx.x == 0) (void)xb_add(&bar[XB_XCNT(b.x)], 1u);
    return b;
}
__device__ __forceinline__ void xcd_barrier_complete(unsigned* bar, unsigned x, unsigned& nloc, unsigned& nx) {
    const unsigned G = gridDim.x * gridDim.y * gridDim.z;
    unsigned sum, cnt, mine, sp = 0u;
    for (;;) {
        sum = 0u; cnt = 0u; mine = 0u;
#pragma unroll
        for (unsigned j = 0; j < 16; ++j) { const unsigned c = xb_ld(&bar[XB_XCNT(j)]); sum += c; cnt += (c > 0u) ? 1u : 0u; mine = (j == x) ? c : mine; }
        if (sum == G) break;
        __builtin_amdgcn_s_sleep(1);
        if ((++sp & 255u) == 0u) { if (xb_ld(&bar[XB_TMO])) break; if (sp > XB_SPIN_CAP) { atomicAdd(&bar[XB_TMO], 1u); break; } }
    }
    nloc = mine > 0u ? mine : 1u; nx = cnt > 0u ? cnt : 1u;
}

__device__ __forceinline__ void xcd_barrier(const XcdBarrier& b) {
    asm volatile("s_waitcnt vmcnt(0)" ::: "memory");
    __syncthreads();
    if (threadIdx.x == 0) {
        unsigned* bar = b.bar;
        __builtin_amdgcn_s_waitcnt(0);
        unsigned nloc = b.st[0], nx = b.st[1];
        if (nloc == 0u) { xcd_barrier_complete(bar, b.x, nloc, nx); b.st[0] = nloc; b.st[1] = nx; }
        const unsigned old = xb_add(&bar[XB_XSUB(b.x)], 1u);
        const unsigned gen = old / nloc;
        if (old + 1u == (gen + 1u) * nloc) {
            __builtin_amdgcn_fence(__ATOMIC_RELEASE, "agent");
            asm volatile("s_waitcnt vmcnt(0)" ::: "memory");
            const unsigned og = xb_add(&bar[XB_TOP], 1u);
            const unsigned tg = og / nx;
            if (og + 1u == (tg + 1u) * nx) xb_add(&bar[XB_TOPGEN], 1u);
            else XB_SPIN(xb_ld(&bar[XB_TOPGEN]) == tg, bar);
            __builtin_amdgcn_fence(__ATOMIC_ACQUIRE, "agent");
            xb_add(&bar[XB_XGEN(b.x)], 1u);
            asm volatile("s_waitcnt vmcnt(0)" ::: "memory");
        } else {
            XB_SPIN(xb_ld(&bar[XB_XGEN(b.x)]) == gen, bar);
            __builtin_amdgcn_fence(__ATOMIC_ACQUIRE, "agent");
            asm volatile("s_waitcnt vmcnt(0)" ::: "memory");
        }
    }
    __syncthreads();
}


constexpr int PH_PER_LAYER = 12, N_PHASES = 2 + PH_PER_LAYER * DEPTH;
constexpr int CW_BAR = 4096;
constexpr int CW_RDY = 65536;
constexpr int LDS_BYTES = 147456, LDSCTL_OFF = 131072 + 8192;
#ifndef SINGLE_LAUNCH
#define SINGLE_LAUNCH 1
#endif

#ifndef PROBE_A
#define PROBE_A -1
#endif
#ifndef PROBE_B
#define PROBE_B -1
#endif
constexpr size_t WS_TS = 512 * 1024;
#if PROBE_A >= 0
#define STAMP(i) do { if (blockIdx.x == 0 && threadIdx.x == 0) ((unsigned long long*)(args_here()->ws + WS_TS))[(i)] = __builtin_amdgcn_s_memrealtime(); } while (0)
#else
#define STAMP(i) do { } while (0)
#endif
__device__ __forceinline__ const __attribute__((address_space(4))) Args* args_here() { const __attribute__((address_space(4))) Args* p = (const __attribute__((address_space(4))) Args*)__builtin_amdgcn_kernarg_segment_ptr(); asm volatile("" : "+s"(p)); return p; }
#ifndef REP_K
#define REP_K -1
#endif
__device__ __forceinline__ Ctx mkctx(int wave_s, unsigned char* lds) { Ctx c; c.wave = wave_s; c.lane = (int)__builtin_amdgcn_mbcnt_hi(~0u, __builtin_amdgcn_mbcnt_lo(~0u, 0u)); c.tid = wave_s * 64 + c.lane;
    c.gw = blockIdx.x * NWAVES + wave_s; c.ngw = gridDim.x * NWAVES; c.lds = lds; return c; }
#define PHASE1(k, ...) do { const __attribute__((address_space(4))) Args* ap_ = args_here(); if (ap_->ph_lo <= (k) && (k) < ap_->ph_hi) { ArgsR a = *ap_; const Ctx c = mkctx(wave_s, lds); __VA_ARGS__ } } while (0)
#define PHASE(k, ...) do { PHASE1(k, __VA_ARGS__); if ((k) == REP_K) { xcd_barrier(bar); PHASE1(k, __VA_ARGS__); xcd_barrier(bar); PHASE1(k, __VA_ARGS__); } } while (0)

template <int L>
__device__ __forceinline__ void run_layer(const int wave_s, unsigned char* lds, const XcdBarrier& bar) {
    const int G = gridDim.x, b = blockIdx.x;
#define BAR() do { xcd_barrier(bar); STAMP(3 + 14 * L + (bk_++)); } while (0)
    int bk_ = 0;
    PHASE(0, unsigned char* ws = a.ws; pg8::StaticOrder S; S.init(T, INC, G, b); EpiZ E{(bf16*)(ws + WS_ZR), (bf16*)(ws + WS_ZS), (bf16*)(ws + WS_ZG)};
        gemm_any(c, (const bf16*)(ws + WS_XN), (const bf16*)(ws + WS_WIN + (size_t)L * 10 * MiB), T, INC, D, S, E); );
    BAR();
    PHASE(1, phase_prep_fast(a, c, L); );
    BAR();
#if REP_K == 21
    PHASE1(2, phase_scan1m(a, c, 1); ); xcd_barrier(bar); PHASE1(2, phase_scan1m(a, c, 1); ); xcd_barrier(bar);
#endif
    PHASE(2, phase_scan1m(a, c); );
    BAR();
    PHASE(3, phase_scan2a(a, c); );
    PHASE(14, phase_sg_chunk(a, c, L); );
    BAR();
    PHASE(31, phase_scan2b(a, c); );
    PHASE(33, expert_convert(a, c, L, NH); );
    BAR();
    PHASE(4, phase_scan3m(a, c, L); );
    BAR();
    PHASE(6, unsigned char* ws = a.ws; pg8::StaticOrder S; S.init(T, D, G, b); EpiGA E{(const bf16*)(ws + WS_ZG), (bf16*)(ws + WS_MP)};
        gemm_any(c, (const bf16*)(ws + WS_YA), (const bf16*)(ws + WS_WA + (size_t)L * WS_WL1), T, D, W, S, E); );
    BAR();
#if REP_K == 7
    PHASE1(7, unsigned char* ws = a.ws; pg8::StaticOrder S; S.init(T, D, G, b); EpiGB E{(const bf16*)(ws + WS_ZG), (const bf16*)(ws + WS_MP), (bf16*)(ws + WS_ZR)};
        gemm_any(c, (const bf16*)(ws + WS_YB), (const bf16*)(ws + WS_WB + (size_t)L * WS_WL1), T, D, W, S, E); ); xcd_barrier(bar);
    PHASE1(7, unsigned char* ws = a.ws; pg8::StaticOrder S; S.init(T, D, G, b); EpiGB E{(const bf16*)(ws + WS_ZG), (const bf16*)(ws + WS_MP), (bf16*)(ws + WS_ZR)};
        gemm_any(c, (const bf16*)(ws + WS_YB), (const bf16*)(ws + WS_WB + (size_t)L * WS_WL1), T, D, W, S, E); ); xcd_barrier(bar);
#endif
#if REP_K == 8
    PHASE1(8, unsigned char* ws = a.ws; pg8::StaticOrder S; S.init(T, D, G, b); EpiOut E{L == 0 ? a.in[I_X] : a.out, (bf16*)(ws + WS_R), (const float*)(ws + WS_MODF) + L * 6144 + 2048};
        gemm_any(c, (const bf16*)(ws + WS_MP), (const bf16*)(ws + WS_WO + (size_t)L * WS_WL1), T, D, D, S, E); ); xcd_barrier(bar);
    PHASE1(8, unsigned char* ws = a.ws; pg8::StaticOrder S; S.init(T, D, G, b); EpiOut E{L == 0 ? a.in[I_X] : a.out, (bf16*)(ws + WS_R), (const float*)(ws + WS_MODF) + L * 6144 + 2048};
        gemm_any(c, (const bf16*)(ws + WS_MP), (const bf16*)(ws + WS_WO + (size_t)L * WS_WL1), T, D, D, S, E); ); xcd_barrier(bar);
#endif
    PHASE1(7, unsigned char* ws = a.ws; pg8::StaticOrder S; S.init(T, D, G, b); EpiGB E{(const bf16*)(ws + WS_ZG), (const bf16*)(ws + WS_MP), (bf16*)(ws + WS_MP)};
        gemm_any(c, (const bf16*)(ws + WS_YB), (const bf16*)(ws + WS_WB + (size_t)L * WS_WL1), T, D, W, S, E); );
    BAR();
    PHASE1(8, unsigned char* ws = a.ws; pg8::StaticOrder S; S.init(T, D, G, b); EpiOut E{L == 0 ? a.in[I_X] : a.out, (bf16*)(ws + WS_TMP), (const float*)(ws + WS_MODF) + L * 6144 + 2048};
        gemm_any(c, (const bf16*)(ws + WS_MP), (const bf16*)(ws + WS_WO + (size_t)L * WS_WL1), T, D, D, S, E); );
    BAR();
#if REP_K == 9
    PHASE1(9, phase_ln1(a, c, L, (float*)(a.ws + WS_ZR)); ); xcd_barrier(bar); PHASE1(9, phase_ln1(a, c, L, (float*)(a.ws + WS_ZR)); ); xcd_barrier(bar);
#endif
#if REP_K == 91
    PHASE1(9, phase_ln1(a, c, L, (float*)(a.ws + WS_ZR), 1); ); xcd_barrier(bar); PHASE1(9, phase_ln1(a, c, L, (float*)(a.ws + WS_ZR), 1); ); xcd_barrier(bar);
#endif
#if REP_K == 92
    PHASE1(9, phase_ln1(a, c, L, (float*)(a.ws + WS_ZR), 2); ); xcd_barrier(bar); PHASE1(9, phase_ln1(a, c, L, (float*)(a.ws + WS_ZR), 2); ); xcd_barrier(bar);
#endif
    PHASE1(9, phase_ln1(a, c, L, a.out); );
    BAR();
    PHASE(10, phase_perm(a, c, L); );
    BAR();
    PHASE(11, unsigned char* ws = a.ws; MoeSchedA S; S.init((const unsigned*)(ws + WS_TOT), G, b); EpiSwi E{(bf16*)(ws + WS_HID)};
        gemm_gather(c, (const bf16*)(ws + WS_XN), (const int*)(ws + WS_S2T), (const bf16*)(ws + WS_WGU), MAXSLOT, NE * 1024, D, S, E); );
    BAR();
    PHASE(12, unsigned char* ws = a.ws; unsigned* rdy = (unsigned*)(ws + WS_CTL) + CW_RDY + L * 16384;
        { MoeSchedT S; S.init((const unsigned*)(ws + WS_TOT), G, b); S.rdy = rdy; EpiSwiWT E{(bf16*)(ws + WS_HID)};
          gemm_gather(c, (const bf16*)(ws + WS_XN), (const int*)(ws + WS_S2T), (const bf16*)(ws + WS_WGU), MAXSLOT, NE * 1024, D, S, E); }
        { MoeSchedB S; S.init((const unsigned*)(ws + WS_TOT), G, b); S.rdy = rdy; S.tmo = (unsigned*)(ws + WS_CTL) + CW_BAR + XB_TMO; S.wave = c.wave;
          EpiDown E{(const int*)(ws + WS_S2T), (const float*)(ws + WS_TOKW), (bf16*)(ws + WS_Y)};
          gemm_any(c, (const bf16*)(ws + WS_HID), (const bf16*)(ws + WS_WD), MAXSLOT, NE * 1024, FF, S, E); } );
    BAR();
#if REP_K == 13
    PHASE1(13, phase_ln2(a, c, L, (float*)(a.ws + WS_R)); ); xcd_barrier(bar); PHASE1(13, phase_ln2(a, c, L, (float*)(a.ws + WS_R)); ); xcd_barrier(bar);
#endif
    PHASE1(13, phase_ln2(a, c, L, a.out); );
    if (L + 1 < DEPTH) BAR();
    (void)bk_;
#undef BAR
}

__global__ void __launch_bounds__(NTHREADS, 2) mk_fwd(Args a_unused) {
    extern __shared__ __attribute__((aligned(16))) unsigned char lds[];
    const int wave_s = __builtin_amdgcn_readfirstlane(threadIdx.x >> 6);
    for (int u = threadIdx.x; u < (LDS_BYTES - LDSCTL_OFF) / 4; u += NTHREADS) ((LAS unsigned*)((LAS unsigned char*)lds + LDSCTL_OFF))[u] = 0u;
    __syncthreads();
    const XcdBarrier bar = xcd_barrier_post((unsigned*)(args_here()->ws + WS_CTL) + CW_BAR, (volatile LAS unsigned*)((LAS unsigned char*)lds + LDSCTL_OFF) + 8);
    STAMP(0);
    PHASE(100, phase_p0a(a, c); );
    xcd_barrier(bar); STAMP(1);
    PHASE(101, phase_p0b(a, c); );
    xcd_barrier(bar); STAMP(2);
    run_layer<0>(wave_s, lds, bar);
    run_layer<1>(wave_s, lds, bar);
#if PROBE_A >= 0
    if (blockIdx.x == 0) {
        asm volatile("s_waitcnt vmcnt(0)" ::: "memory"); __syncthreads();
        if (threadIdx.x == 0) ((unsigned long long*)(args_here()->ws + WS_TS))[30] = __builtin_amdgcn_s_memrealtime();
        asm volatile("s_waitcnt vmcnt(0)" ::: "memory"); __syncthreads();
        const volatile unsigned long long* ts = (const volatile unsigned long long*)(args_here()->ws + WS_TS);
        float da = 0.f, db = 0.f;
        if (PROBE_A < 14) { da = (float)(ts[3 + PROBE_A] - ts[2 + PROBE_A]) + (float)(ts[17 + PROBE_A] - ts[16 + PROBE_A]); } else if (PROBE_A == 14) da = (float)(ts[1] - ts[0]); else if (PROBE_A == 15) da = (float)(ts[2] - ts[1]); else da = (float)(ts[30] - ts[0]);
        if (PROBE_B >= 0 && PROBE_B < 14) { db = (float)(ts[3 + PROBE_B] - ts[2 + PROBE_B]) + (float)(ts[17 + PROBE_B] - ts[16 + PROBE_B]); } else if (PROBE_B == 14) db = (float)(ts[1] - ts[0]); else if (PROBE_B == 15) db = (float)(ts[2] - ts[1]);
        da *= 0.01f; db *= 0.01f;
        da = exp2f(0.25f * rintf(4.0f * log2f(fmaxf(da, 0.5f)))); db = exp2f(0.25f * rintf(4.0f * log2f(fmaxf(db, 0.5f))));
        float* out = args_here()->out;
        for (int i = threadIdx.x; i < 16 * 1024; i += NTHREADS) { const int r = i >> 10, col = i & 1023; const int rowi = (r & 7) + 2048 * (r >> 3); out[(size_t)rowi * D + col] = da; }
        if (threadIdx.x == 0 && PROBE_B >= 0) out[(size_t)4096 * D] = 100.0f * db;
    }
#endif
}

extern "C" void kernel_launch(void* const* d_in, const int* in_sizes, int n_in, void* d_out, int out_size, void* d_ws, size_t ws_size, hipStream_t stream) {
    static int grid = 0;
    if (grid == 0) {
        if (n_in != N_IN || out_size != T * D || ws_size < WS_END2) { fprintf(stderr, "kernel_launch: unexpected shapes: n_in %d out %d ws %zu (need %zu)\n", n_in, out_size, ws_size, (size_t)WS_END2); grid = -1; return; }
        int dev = 0, cus = 0;
        (void)hipGetDevice(&dev); (void)hipDeviceGetAttribute(&cus, hipDeviceAttributeMultiprocessorCount, dev);
        if (hipFuncSetAttribute((const void*)mk_fwd, hipFuncAttributeMaxDynamicSharedMemorySize, LDS_BYTES) != hipSuccess) { fprintf(stderr, "kernel_launch: hipFuncSetAttribute failed\n"); grid = -1; return; }
        grid = cus > 0 ? (cus & ~3) : 256;
        fprintf(stderr, "kernel_launch: ws_size %zu grid %d\n", ws_size, grid);
    }
    if (grid < 0) return;
    (void)hipMemsetAsync((char*)d_ws + WS_CTL, 0, CTL_BYTES, stream);
    Args a{};
    for (int i = 0; i < N_IN; ++i) a.in[i] = (const float*)d_in[i];
    a.out = (float*)d_out; a.ws = (unsigned char*)d_ws;
    a.ph_lo = 0; a.ph_hi = 1000;
    hipLaunchKernelGGL(mk_fwd, dim3(grid), dim3(NTHREADS), LDS_BYTES, stream, a);
}
```

```cpp
#include <hip/hip_runtime.h>
#include <cstdio>
#include <cstdint>
#include <utility>

typedef unsigned short bf16;
typedef _Float16 f16;
typedef float f32x4 __attribute__((ext_vector_type(4)));
typedef unsigned u32x4 __attribute__((ext_vector_type(4)));
typedef unsigned u32x2 __attribute__((ext_vector_type(2)));

constexpr int T = 16384, D = 1024, W = 512, NH = 8, HN = 64, RC = 1792, INC = 4864;
constexpr int NE = 16, FF = 512, DEPTH = 2;
constexpr float LN_EPS = 1e-5f, GN_EPS = 64e-5f, ALPHA = 1.41421356237f;
constexpr int NTHREADS = 512, NWAVES = 8;
constexpr int MAXSLOT = 36864;

constexpr size_t MiB = 1u << 20;
constexpr size_t WS_CTL = 0, CTL_BYTES = 1 * MiB;
constexpr int CW_CNT = 16384;
constexpr size_t WS_PART = 1 * MiB;
constexpr size_t WS_MODF = 2 * MiB;
constexpr size_t WS_TOKI = 2 * MiB + 65536;
constexpr size_t WS_TOKW = WS_TOKI + 131072;
constexpr size_t WS_TOKP = WS_TOKW + 131072;
constexpr size_t WS_S2T = 3 * MiB;
constexpr size_t WS_BLKCNT = 3 * MiB + 512 * 1024;
constexpr size_t WS_TOT = WS_BLKCNT + 32768;
constexpr size_t WS_LORA = 4 * MiB;
constexpr size_t WS_WSB = 7 * MiB;
constexpr size_t WS_BON = 7 * MiB + 512 * 1024;
constexpr size_t WS_WIN = 8 * MiB;
constexpr size_t WS_WA = 28 * MiB, WS_WB = 29 * MiB, WS_WO = 30 * MiB, WS_WL1 = 4 * MiB;
constexpr size_t WS_ZG = 36 * MiB;
constexpr size_t WS_XN = 100 * MiB;
constexpr size_t WS_G = 100 * MiB, WS_YB = 116 * MiB;
constexpr size_t WS_YAB = 188 * MiB;
constexpr size_t WS_ZR = 132 * MiB;
constexpr size_t WS_ZS = 188 * MiB;
constexpr size_t WS_YSC = 132 * MiB;
constexpr size_t WS_ST = 132 * MiB;
constexpr size_t WS_YA = 188 * MiB;
constexpr size_t WS_MP = 132 * MiB;
constexpr size_t WS_TMP = 164 * MiB;
constexpr size_t WS_XS = 132 * MiB;
constexpr size_t WS_Y = 132 * MiB;
constexpr size_t WS_AA = 224 * MiB, WS_BB = 240 * MiB, WS_WM1 = 256 * MiB, WS_R = 272 * MiB, WS_KP = 288 * MiB, WS_V = 304 * MiB;
constexpr size_t WS_WGU = 224 * MiB;
constexpr size_t WS_WD = 256 * MiB;
constexpr size_t WS_HID = 272 * MiB;
constexpr size_t WS_VF = 320 * MiB;
constexpr size_t WS_END = 336 * MiB;
constexpr size_t WS_END2_BYTES = 360 * MiB;

constexpr size_t LO_W2T = 0, LO_A2T = 65536, LO_G2T = 131072, LO_VM1T = 262144, LO_VM2T = 294912, LO_STRIDE = 524288;

enum { I_X = 0, I_C, I_WMOD, I_BMOD, I_WIN, I_MU, I_W0, I_W2, I_A0, I_A2, I_G2, I_KK, I_KA, I_RK, I_GNG, I_GNB, I_VM0, I_VM1, I_VM2,
       I_SGG, I_SGB, I_WS, I_BS, I_WBA, I_WBB, I_WOUT, I_LN1G, I_LN1B, I_RW, I_RB, I_EG, I_EU, I_ED, I_LN2G, I_LN2B, N_IN };

struct Args { const float* in[N_IN]; float* out; unsigned char* ws; int ph_lo, ph_hi; };
typedef const __attribute__((address_space(4))) Args& ArgsR;

__device__ __forceinline__ float bf2f(bf16 h) { return __uint_as_float(((unsigned)h) << 16); }
__device__ __forceinline__ unsigned f2bfu(float f) { unsigned u = __float_as_uint(f); return (u + 0x7fffu + ((u >> 16) & 1u)) >> 16; }
__device__ __forceinline__ bf16 f2bf(float f) { return __builtin_bit_cast(unsigned short, (__bf16)f); }
typedef __bf16 bf16x2_t __attribute__((ext_vector_type(2)));
__device__ __forceinline__ unsigned pk2(float lo, float hi) { bf16x2_t v; v[0] = (__bf16)lo; v[1] = (__bf16)hi; return __builtin_bit_cast(unsigned, v); }
__device__ __forceinline__ u32x4 pack8bf(const float (&v)[8]) { u32x4 w; w.x = pk2(v[0], v[1]); w.y = pk2(v[2], v[3]); w.z = pk2(v[4], v[5]); w.w = pk2(v[6], v[7]); return w; }
__device__ __forceinline__ __amdgpu_buffer_rsrc_t wt_rsrc(const void* base, unsigned bytes) { return __builtin_amdgcn_make_buffer_rsrc((void*)base, 0, (int)bytes, 0x00020000); }
__device__ __forceinline__ void store8bf_wt(__amdgpu_buffer_rsrc_t rs, unsigned byteoff, f32x4 lo, f32x4 hi) { u32x4 w; w.x = pk2(lo[0], lo[1]); w.y = pk2(lo[2], lo[3]); w.z = pk2(hi[0], hi[1]); w.w = pk2(hi[2], hi[3]);
    __builtin_amdgcn_raw_buffer_store_b128(w, rs, byteoff, 0, 16); }
__device__ __forceinline__ void store16_wt(const unsigned char* wsbase, void* p, u32x4 w) { __builtin_amdgcn_raw_buffer_store_b128(w, wt_rsrc(wsbase, (unsigned)WS_END2_BYTES), (unsigned)((const unsigned char*)p - wsbase), 0, 16); }
__device__ __forceinline__ void store4bf(bf16* p, f32x4 v) { u32x2 w; w.x = pk2(v[0], v[1]); w.y = pk2(v[2], v[3]); *(u32x2*)p = w; }
__device__ __forceinline__ f32x4 bf4cvt(u32x2 w) { f32x4 r; r[0] = __uint_as_float(w.x << 16); r[1] = __uint_as_float(w.x & 0xffff0000u); r[2] = __uint_as_float(w.y << 16); r[3] = __uint_as_float(w.y & 0xffff0000u); return r; }
__device__ __forceinline__ f32x4 load4bf(const bf16* p) { u32x2 w = *(const u32x2*)p; f32x4 r; r[0] = __uint_as_float(w.x << 16); r[1] = __uint_as_float(w.x & 0xffff0000u); r[2] = __uint_as_float(w.y << 16); r[3] = __uint_as_float(w.y & 0xffff0000u); return r; }
__device__ __forceinline__ float wave_sum(float v) {
    v += __builtin_bit_cast(float, __builtin_amdgcn_update_dpp(0, __builtin_bit_cast(int, v), 0xB1, 0xF, 0xF, true));
    v += __builtin_bit_cast(float, __builtin_amdgcn_update_dpp(0, __builtin_bit_cast(int, v), 0x4E, 0xF, 0xF, true));
    v += __builtin_bit_cast(float, __builtin_amdgcn_update_dpp(0, __builtin_bit_cast(int, v), 0x141, 0xF, 0xF, true));
    v += __builtin_bit_cast(float, __builtin_amdgcn_update_dpp(0, __builtin_bit_cast(int, v), 0x140, 0xF, 0xF, true));
    v += __builtin_bit_cast(float, __builtin_amdgcn_update_dpp(0, __builtin_bit_cast(int, v), 0x142, 0xA, 0xF, false));
    v += __builtin_bit_cast(float, __builtin_amdgcn_update_dpp(0, __builtin_bit_cast(int, v), 0x143, 0xC, 0xF, false));
    return __builtin_bit_cast(float, __builtin_amdgcn_readlane(__builtin_bit_cast(int, v), 63));
}
__device__ __forceinline__ float group_sum8(float v) {
    v += __builtin_bit_cast(float, __builtin_amdgcn_update_dpp(0, __builtin_bit_cast(int, v), 0xB1, 0xF, 0xF, true));
    v += __builtin_bit_cast(float, __builtin_amdgcn_update_dpp(0, __builtin_bit_cast(int, v), 0x4E, 0xF, 0xF, true));
    v += __builtin_bit_cast(float, __builtin_amdgcn_update_dpp(0, __builtin_bit_cast(int, v), 0x141, 0xF, 0xF, true));
    return v;
}
__device__ __forceinline__ float sigmoidf_(float x) { return __builtin_amdgcn_rcpf(1.0f + __expf(-x)); }
__device__ __forceinline__ float siluf_(float x) { return x * sigmoidf_(x); }
__device__ __forceinline__ float gelu_tanh(float x) { const float u = 0.7978845608028654f * (x + 0.044715f * x * x * x); return x * (1.0f - __builtin_amdgcn_rcpf(1.0f + __expf(2.0f * u))); }
__device__ __forceinline__ float softplusf_(float y) { return fmaxf(y, 0.f) + log1pf(__expf(-fabsf(y))); }

struct Ctx { int tid, lane, wave, gw, ngw; unsigned char* lds; };

__device__ __forceinline__ void transpose_item(const float* Wsrc, int N, int k0, int n0, bf16* dst, int ldk, float* scr, int lane, const unsigned char* wsb) {
    float tv[32];
#pragma unroll
    for (int i = 0; i < 32; ++i) tv[i] = Wsrc[(size_t)(k0 + 2 * i + (lane >> 5)) * N + n0 + (lane & 31)];
#pragma unroll
    for (int i = 0; i < 32; ++i) scr[(2 * i + (lane >> 5)) * 33 + (lane & 31)] = tv[i];
    asm volatile("s_waitcnt lgkmcnt(0)" ::: "memory");
    const int c = lane & 7;
#pragma unroll
    for (int j = 0; j < 4; ++j) { const int n = (lane >> 3) + 8 * j; const float* s = scr + (8 * c) * 33 + n;
        u32x4 o; o.x = pk2(s[0 * 33], s[1 * 33]); o.y = pk2(s[2 * 33], s[3 * 33]); o.z = pk2(s[4 * 33], s[5 * 33]); o.w = pk2(s[6 * 33], s[7 * 33]);
        store16_wt(wsb, dst + (size_t)n * ldk + k0 + 8 * c, o); }
    asm volatile("s_waitcnt lgkmcnt(0)" ::: "memory");
}
template <class RowMap>
__device__ __forceinline__ void transpose_matrix_item(const float* Wsrc, int K, int N, bf16* dst, int item, float* scr, int lane, const RowMap& rm, const unsigned char* wsb) {
    const int nblk = N / 32, kb = item / nblk, nb = item % nblk, n0 = 32 * nb;
    transpose_item(Wsrc, N, 64 * kb, n0, dst + (size_t)rm(n0) * K, K, scr, lane, wsb);
}
struct RowId { __device__ __forceinline__ int operator()(int n) const { return n; } };
struct RowGU { int up; __device__ __forceinline__ int operator()(int n) const { return (n >> 7) * 256 + (n & 127) + up * 128; } };

__device__ __forceinline__ void phase_p0a(ArgsR a, const Ctx& c) {
    float* scr = (float*)(c.lds + c.wave * 16384);
    { float* MODF = (float*)(a.ws + WS_MODF); float* red = (float*)(c.lds + 131072);
      for (int cbk = blockIdx.x; cbk < 2 * 96; cbk += gridDim.x) {
          const int l = cbk / 96, n = (cbk % 96) * 64 + c.lane;
          const float* wm = a.in[I_WMOD] + (size_t)l * D * 6144 + (size_t)(c.wave * 128) * 6144 + n;
          float acc0 = 0.f, acc1 = 0.f;
#pragma unroll 16
          for (int k = 0; k < 128; k += 2) { acc0 += siluf_(a.in[I_C][c.wave * 128 + k]) * wm[(size_t)k * 6144]; acc1 += siluf_(a.in[I_C][c.wave * 128 + k + 1]) * wm[(size_t)(k + 1) * 6144]; }
          red[c.wave * 64 + c.lane] = acc0 + acc1;
          __syncthreads();
          if (c.wave == 0) { float sacc = a.in[I_BMOD][l * 6144 + n];
#pragma unroll
              for (int w = 0; w < 8; ++w) sacc += red[w * 64 + c.lane];
              MODF[l * 6144 + n] = sacc; }
          __syncthreads();
      } }
    for (int it = c.gw; it < 2 * (16 + 16 + 32 + 8); it += c.ngw) {
        const int l = it / 72; int r = it % 72; unsigned char* lo = a.ws + WS_LORA + (size_t)l * LO_STRIDE;
        if (r < 16) { transpose_matrix_item(a.in[I_W2] + (size_t)l * 64 * W, 64, W, (bf16*)(lo + LO_W2T), r, scr, c.lane, RowId(), a.ws); continue; } r -= 16;
        if (r < 16) { transpose_matrix_item(a.in[I_A2] + (size_t)l * 64 * W, 64, W, (bf16*)(lo + LO_A2T), r, scr, c.lane, RowId(), a.ws); continue; } r -= 16;
        if (r < 32) { transpose_matrix_item(a.in[I_G2] + (size_t)l * 128 * W, 128, W, (bf16*)(lo + LO_G2T), r, scr, c.lane, RowId(), a.ws); continue; } r -= 32;
        if (l == 1) transpose_matrix_item(a.in[I_VM1], W, 32, (bf16*)(lo + LO_VM1T), r, scr, c.lane, RowId(), a.ws);
    }
    for (int i = blockIdx.x * NTHREADS + c.tid; i < 32 * W; i += gridDim.x * NTHREADS) { const int n = i >> 5, k = i & 31;
        ((bf16*)(a.ws + WS_LORA + LO_STRIDE + LO_VM2T))[i] = f2bf(a.in[I_VM2][(size_t)k * W + n]); }
    for (int i = blockIdx.x * NTHREADS + c.tid; i < 2 * 8 * 128 * 16; i += gridDim.x * NTHREADS) { const int s0 = (i & 15) * 8, t = (i >> 4) & 127;
        const float* src = a.in[I_WS] + (size_t)i * 8; const f32x4 w0 = *(const f32x4*)src, w1 = *(const f32x4*)(src + 4); float wf[8];
#pragma unroll
        for (int e = 0; e < 8; ++e) { const float wv_ = e < 4 ? w0[e & 3] : w1[e & 3]; wf[e] = (s0 + e <= t) ? wv_ : 0.f; }
        *(u32x4*)((bf16*)(a.ws + WS_WSB) + (size_t)i * 8) = pack8bf(wf); }
    constexpr int I_WINL = (D / 64) * (INC / 32);
    constexpr int I_WAL = (W / 64) * (D / 32);
    constexpr int I_WOL = (D / 64) * (D / 32);
    constexpr int PER_L = I_WINL + 2 * I_WAL + I_WOL;
    for (int it = c.gw; it < 2 * PER_L; it += c.ngw) {
        const int l = it / PER_L; int r = it % PER_L;
        if (r < I_WINL) { transpose_matrix_item(a.in[I_WIN] + (size_t)l * D * INC, D, INC, (bf16*)(a.ws + WS_WIN + (size_t)l * 10 * MiB), r, scr, c.lane, RowId(), a.ws); continue; } r -= I_WINL;
        if (r < I_WAL) { transpose_item(a.in[I_WBA] + (size_t)l * W * D, D, 64 * (r / 32), 32 * (r % 32), (bf16*)(a.ws + WS_WA + (size_t)l * WS_WL1) + (size_t)(32 * (r % 32)) * 1024, 1024, scr, c.lane, a.ws); continue; } r -= I_WAL;
        if (r < I_WAL) { transpose_item(a.in[I_WBB] + (size_t)l * W * D, D, 64 * (r / 32), 32 * (r % 32), (bf16*)(a.ws + WS_WA + (size_t)l * WS_WL1) + 512 + (size_t)(32 * (r % 32)) * 1024, 1024, scr, c.lane, a.ws); continue; } r -= I_WAL;
        transpose_matrix_item(a.in[I_WOUT] + (size_t)l * D * D, D, D, (bf16*)(a.ws + WS_WO + (size_t)l * WS_WL1), r, scr, c.lane, RowId(), a.ws);
    }
}

__device__ __forceinline__ void row_stats(const float (&v)[16], float& mean, float& rstd) {
    float s = 0.f;
#pragma unroll
    for (int j = 0; j < 16; ++j) s += v[j];
    mean = wave_sum(s) * (1.f / D);
    float q = 0.f;
#pragma unroll
    for (int j = 0; j < 16; ++j) { const float d = v[j] - mean; q += d * d; }
    rstd = __builtin_amdgcn_rsqf(wave_sum(q) * (1.f / D) + LN_EPS);
}
__device__ __forceinline__ void load_row16bf(const bf16* p, int lane, float (&v)[16]) {
#pragma unroll
    for (int j = 0; j < 4; ++j) { const f32x4 x = load4bf(p + 4 * lane + 256 * j); v[4 * j] = x[0]; v[4 * j + 1] = x[1]; v[4 * j + 2] = x[2]; v[4 * j + 3] = x[3]; }
}
__device__ __forceinline__ void load_row16(const float* p, int lane, float (&v)[16]) {
#pragma unroll
    for (int j = 0; j < 4; ++j) { const f32x4 x = *(const f32x4*)(p + 4 * lane + 256 * j); v[4 * j] = x[0]; v[4 * j + 1] = x[1]; v[4 * j + 2] = x[2]; v[4 * j + 3] = x[3]; }
}

__device__ __forceinline__ void load_row16bf8(const bf16* p, int lane, float (&v)[16]) {
#pragma unroll
    for (int J = 0; J < 2; ++J) { const u32x4 w = *(const u32x4*)(p + 8 * lane + 512 * J);
#pragma unroll
        for (int e = 0; e < 4; ++e) { v[8 * J + 2 * e] = __uint_as_float(w[e] << 16); v[8 * J + 2 * e + 1] = __uint_as_float(w[e] & 0xffff0000u); } }
}
__device__ __forceinline__ void load_row16f8(const float* p, int lane, float (&v)[16]) {
#pragma unroll
    for (int J = 0; J < 2; ++J) { const f32x4 x0 = *(const f32x4*)(p + 8 * lane + 512 * J), x1 = *(const f32x4*)(p + 8 * lane + 512 * J + 4);
#pragma unroll
        for (int e = 0; e < 4; ++e) { v[8 * J + e] = x0[e]; v[8 * J + 4 + e] = x1[e]; } }
}
__device__ __forceinline__ void phase_p0b(ArgsR a, const Ctx& c) {
    const float* MODF = (const float*)(a.ws + WS_MODF);
    float sh[16], sc[16];
#pragma unroll
    for (int j = 0; j < 4; ++j) { const f32x4 s0 = *(const f32x4*)(MODF + 4 * c.lane + 256 * j), s1 = *(const f32x4*)(MODF + 1024 + 4 * c.lane + 256 * j);
#pragma unroll
        for (int e = 0; e < 4; ++e) { sh[4 * j + e] = s0[e]; sc[4 * j + e] = 1.f + s1[e]; } }
    bf16* XN = (bf16*)(a.ws + WS_XN);
    for (int m = c.gw; m < T; m += c.ngw) {
        float v[16]; load_row16(a.in[I_X] + (size_t)m * D, c.lane, v);
        float mean, rstd; row_stats(v, mean, rstd);
#pragma unroll
        for (int j = 0; j < 4; ++j) { f32x4 o;
#pragma unroll
            for (int e = 0; e < 4; ++e) o[e] = (v[4 * j + e] - mean) * rstd * sc[4 * j + e] + sh[4 * j + e];
            store4bf(XN + (size_t)m * D + 4 * c.lane + 256 * j, o); }
    }
}

namespace pg8 {
#define PG8_LAS __attribute__((address_space(3)))
typedef unsigned short bf16_t;
typedef short bf16x8 __attribute__((ext_vector_type(8)));
typedef float f32x4 __attribute__((ext_vector_type(4)));
typedef unsigned u32x4 __attribute__((ext_vector_type(4)));
constexpr int BM = 256, BK = 64, HALF = 128, HTB = HALF * BK * 2  , STAGE_BYTES = 8 * HTB, NXCD = 8, WGM = 8;

__host__ __device__ __forceinline__ int lds_byte(int r, int c) { const int st = (r >> 4) * 2 + (c >> 5), rr = r & 15, cc = c & 31, ob = rr * 64 + cc * 2; return st * 1024 + (ob ^ (((ob >> 9) & 1) << 5)); }
__host__ __device__ __forceinline__ void stage_rc(int b, int& R, int& C) { const int st = b / 1024, sb = b % 1024, swz = sb ^ (((sb >> 9) & 1) << 5); R = (st >> 1) * 16 + swz / 64; C = (st & 1) * 32 + (swz % 64) / 2; }
__host__ __device__ __forceinline__ int perm32(int rho) { const int n = rho >> 4, i = rho & 15; return 8 * (i >> 2) + 4 * n + (i & 3); }

struct Unit { int pm, pn; };
struct Gemm { const bf16_t* A; const bf16_t* Bt; int M, N, K; };

struct StaticOrder {
    int nM, nN, nwg, G, c;
    __host__ __device__ void init(int M, int N, int G_, int c_) { nM = M / BM; nN = N / BM; nwg = nM * nN; G = G_; c = c_; }
    __host__ __device__ bool next(int i, Unit& u) const {
        const long L = (long)i * G + c; if (L >= nwg) return false;
        int wgid = (int)L; { const int q = nwg / NXCD, r = nwg % NXCD, xcd = wgid % NXCD, off = wgid / NXCD; wgid = (xcd < r ? xcd * (q + 1) : r * (q + 1) + (xcd - r) * q) + off; }
        const int nig = WGM * nN, gid = wgid / nig, fm = gid * WGM, gsz = (nM - fm) < WGM ? (nM - fm) : WGM;
        u.pm = fm + ((wgid % nig) % gsz); u.pn = (wgid % nig) / gsz; return true;
    }
    __device__ __forceinline__ void a_ready(const Unit&) const {}
    __device__ __forceinline__ void done(const Unit&) const {}
};


template <class Epi, class Sched, bool ALIGN_EPI = false, bool SP2 = false, bool GATHER = false>
__device__ __forceinline__ void gemm_phase(PG8_LAS unsigned char* lds, const Gemm g, const Sched& S, const Epi& E, const int tid_in, const int* s2t = nullptr) {
    const int tid = tid_in, wid = __builtin_amdgcn_readfirstlane(tid >> 6), lane = tid & 63, wr = wid >> 2, wc = wid & 3, fr = lane & 15, fq = lane >> 4;
    const int K = g.K, nt = K / BK;
    unsigned voffA[2], voffB[2];
#pragma unroll
    for (int i = 0; i < 2; ++i) { int R, C; stage_rc(tid * 16 + i * 8192, R, C); const int Rb = Epi::PERM ? ((R & ~31) + perm32(R & 31)) : R;
        voffA[i] = (unsigned)(R * K + C) * 2u; voffB[i] = (unsigned)(Rb * K + C) * 2u; }
    unsigned pc0 = 0u, pc1 = 0u, pn0 = 0u, pn1 = 0u, cvoff = 0u; int R0g = 0;
    if constexpr (GATHER) { int R, C; stage_rc(tid * 16, R, C); R0g = R; cvoff = (unsigned)C * 2u; }
#define PG8_TOKPACK(pm_, h_) ([&]() -> unsigned { const int r0_ = (pm_) * BM + (h_) * HALF + R0g; const int a0_ = s2t[2 * r0_], a1_ = s2t[2 * (r0_ + 64)]; return (unsigned)(a0_ < 0 ? 0 : (a0_ >> 1)) | ((unsigned)(a1_ < 0 ? 0 : (a1_ >> 1)) << 16); }())
#define PG8_STAGE_A(bufoff, base, h, usen) do { if constexpr (GATHER) { const unsigned pk_ = (usen) ? ((h) ? pn1 : pn0) : ((h) ? pc1 : pc0); \
        unsigned vt_[2] = {(pk_ & 0xffffu) * (unsigned)(K * 2) + cvoff, (pk_ >> 16) * (unsigned)(K * 2) + cvoff}; PG8_STAGE(bufoff, base, vt_); } \
    else PG8_STAGE(bufoff, (base) + ((h) ? hstep : (size_t)0), voffA); } while (0)
    const size_t kstep = (size_t)(BK * 2);
    const size_t hstep = (size_t)HALF * K * 2;
    const size_t tstep = 2 * hstep;
    const unsigned ldsw = (unsigned)wid * 1024u;
    const int aoff = lds_byte(wr * 64 + fr, fq * 8), boff = lds_byte(wc * 32 + fr, fq * 8);
#define PG8_SA(b, h) (((b) * 2 + (h)) * HTB)
#define PG8_SB(b, h) ((4 + (b) * 2 + (h)) * HTB)
#define PG8_STAGE(bufoff, gbase, voff) do { _Pragma("unroll") for (int _i = 0; _i < 2; ++_i) \
        __builtin_amdgcn_global_load_lds((const unsigned*)((const char*)(gbase) + (voff)[_i]), (PG8_LAS unsigned*)(lds + (bufoff) + ldsw + _i * 8192), 16, 0, 0); } while (0)
#define PG8_LDA(dst, b, h) do { _Pragma("unroll") for (int m = 0; m < 4; ++m) _Pragma("unroll") for (int k = 0; k < 2; ++k) dst[m][k] = *(const PG8_LAS bf16x8*)(lds + PG8_SA(b, h) + aoff + m * 2048 + k * 1024); } while (0)
#define PG8_LDB(dst, b, h) do { _Pragma("unroll") for (int n = 0; n < 2; ++n) _Pragma("unroll") for (int k = 0; k < 2; ++k) dst[n][k] = *(const PG8_LAS bf16x8*)(lds + PG8_SB(b, h) + boff + n * 2048 + k * 1024); } while (0)
#define PG8_MMA(ai, bj, At, Bt) do { __builtin_amdgcn_s_setprio(1); _Pragma("unroll") for (int m = 0; m < 4; ++m) _Pragma("unroll") for (int n = 0; n < 2; ++n) _Pragma("unroll") for (int k = 0; k < 2; ++k) \
        acc[ai][bj][m][n] = __builtin_amdgcn_mfma_f32_16x16x32_bf16(Bt[n][k], At[m][k], acc[ai][bj][m][n], 0, 0, 0); __builtin_amdgcn_s_setprio(0); } while (0)
#define PG8_WAIT_V(n) asm volatile("s_waitcnt vmcnt(" #n ")" ::: "memory")
#define PG8_WAIT_L(n) asm volatile("s_waitcnt lgkmcnt(" #n ")" ::: "memory")
#define PG8_BAR __builtin_amdgcn_s_barrier()
#define PG8_SCHED __builtin_amdgcn_sched_barrier(0)
    Unit cur, nxt; int ui = 0;
    if (!S.next(0, cur)) return;
    f32x4 acc[2][2][4][2];
#pragma unroll
    for (int a = 0; a < 2; ++a)
#pragma unroll
        for (int b = 0; b < 2; ++b)
#pragma unroll
            for (int m = 0; m < 4; ++m)
#pragma unroll
                for (int n = 0; n < 2; ++n) acc[a][b][m][n] = (f32x4){0.f, 0.f, 0.f, 0.f};
    bf16x8 At[4][2], B0[2][2], B1[2][2];
    const char* cA = (const char*)g.A + (GATHER ? (size_t)0 : (size_t)cur.pm * tstep); const char* cB = (const char*)g.Bt + (size_t)cur.pn * tstep;
    if constexpr (GATHER) { pc0 = PG8_TOKPACK(cur.pm, 0); pc1 = PG8_TOKPACK(cur.pm, 1); }
    S.a_ready(cur);
    if constexpr (SP2) {
        PG8_STAGE(PG8_SB(0, 0), cB, voffB); PG8_STAGE(PG8_SB(0, 1), cB + hstep, voffB); PG8_STAGE_A(PG8_SA(0, 0), cA, 0, false); PG8_STAGE_A(PG8_SA(0, 1), cA, 1, false);
        if (wr == 1) PG8_BAR;
        PG8_WAIT_V(2); PG8_BAR;
        PG8_STAGE(PG8_SB(1, 0), cB + kstep, voffB); PG8_STAGE_A(PG8_SA(1, 0), cA + kstep, 0, false); PG8_STAGE(PG8_SB(1, 1), cB + hstep + kstep, voffB);
        PG8_WAIT_V(6); PG8_BAR;
    } else {
        PG8_STAGE(PG8_SB(0, 0), cB, voffB); PG8_STAGE(PG8_SA(0, 0), cA, voffA); PG8_STAGE(PG8_SB(0, 1), cB + hstep, voffB); PG8_STAGE(PG8_SA(0, 1), cA + hstep, voffA);
        if (wr == 1) PG8_BAR;
        PG8_WAIT_V(4); PG8_BAR;
        PG8_STAGE(PG8_SB(1, 0), cB + kstep, voffB); PG8_STAGE(PG8_SA(1, 0), cA + kstep, voffA); PG8_STAGE(PG8_SB(1, 1), cB + hstep + kstep, voffB);
        PG8_WAIT_V(6); PG8_BAR;
    }
    for (;;) {
        const bool has_next = S.next(ui + 1, nxt);
        const char* nA = (has_next && !GATHER) ? (const char*)g.A + (size_t)nxt.pm * tstep : cA; const char* nB = has_next ? (const char*)g.Bt + (size_t)nxt.pn * tstep : cB;
        if constexpr (GATHER) { if (has_next) { pn0 = PG8_TOKPACK(nxt.pm, 0); pn1 = PG8_TOKPACK(nxt.pm, 1); } else { pn0 = pc0; pn1 = pc1; } }
        for (int t = 0; t < nt; t += 2) {
            const bool last = (t == nt - 2);
            const char* a1 = cA + (size_t)(t + 1) * kstep;
            const char* a2 = last ? nA : cA + (size_t)(t + 2) * kstep; const char* b2 = last ? nB : cB + (size_t)(t + 2) * kstep;
            const char* a3 = a2 + kstep; const char* b3 = b2 + kstep;
            if (last && has_next) S.a_ready(nxt);
            if constexpr (Epi::MIDK) { if (t == nt / 2) E.midk(acc, cur, wr, wc, fr, fq); }
            if constexpr (SP2) {
            PG8_LDB(B0, 0, 0); PG8_LDB(B1, 0, 1); PG8_SCHED; PG8_LDA(At, 0, 0); PG8_STAGE_A(PG8_SA(1, 1), a1, 1, false);
            PG8_WAIT_V(8); PG8_WAIT_L(0); PG8_BAR; PG8_MMA(0, 0, At, B0); PG8_MMA(0, 1, At, B1); PG8_BAR; PG8_SCHED;
            PG8_LDA(At, 0, 1); PG8_STAGE(PG8_SB(0, 0), b2, voffB); PG8_STAGE(PG8_SB(0, 1), b2 + hstep, voffB); PG8_STAGE_A(PG8_SA(0, 0), a2, 0, last);
            PG8_WAIT_V(8); PG8_WAIT_L(0); PG8_BAR; PG8_MMA(1, 0, At, B0); PG8_MMA(1, 1, At, B1); PG8_BAR; PG8_SCHED;
            PG8_LDB(B0, 1, 0); PG8_LDB(B1, 1, 1); PG8_SCHED; PG8_LDA(At, 1, 0); PG8_STAGE_A(PG8_SA(0, 1), a2, 1, last);
            PG8_WAIT_V(8); PG8_WAIT_L(0); PG8_BAR; PG8_MMA(0, 0, At, B0); PG8_MMA(0, 1, At, B1); PG8_BAR; PG8_SCHED;
            PG8_LDA(At, 1, 1); PG8_STAGE(PG8_SB(1, 0), b3, voffB); PG8_STAGE(PG8_SB(1, 1), b3 + hstep, voffB); PG8_STAGE_A(PG8_SA(1, 0), a3, 0, last);
            PG8_WAIT_V(8); PG8_WAIT_L(0); PG8_BAR; PG8_MMA(1, 0, At, B0); PG8_MMA(1, 1, At, B1); PG8_BAR; PG8_SCHED;
            } else {
            PG8_LDB(B0, 0, 0); PG8_SCHED; PG8_LDA(At, 0, 0); PG8_STAGE(PG8_SA(1, 1), a1 + hstep, voffA);
            PG8_WAIT_L(8); PG8_BAR; PG8_WAIT_L(0); PG8_MMA(0, 0, At, B0); PG8_BAR; PG8_SCHED;
            PG8_LDB(B1, 0, 1); PG8_STAGE(PG8_SB(0, 0), b2, voffB);
            PG8_BAR; PG8_WAIT_L(0); PG8_MMA(0, 1, At, B1); PG8_BAR;
            PG8_LDA(At, 0, 1); PG8_STAGE(PG8_SA(0, 0), a2, voffA);
            PG8_BAR; PG8_WAIT_L(0); PG8_MMA(1, 0, At, B0); PG8_BAR; PG8_SCHED;
            PG8_STAGE(PG8_SB(0, 1), b2 + hstep, voffB);
            PG8_WAIT_V(6); PG8_BAR; PG8_MMA(1, 1, At, B1); PG8_BAR;
            PG8_LDB(B0, 1, 0); PG8_SCHED; PG8_LDA(At, 1, 0); PG8_STAGE(PG8_SA(0, 1), a2 + hstep, voffA);
            PG8_WAIT_L(8); PG8_BAR; PG8_WAIT_L(0); PG8_MMA(0, 0, At, B0); PG8_BAR; PG8_SCHED;
            PG8_LDB(B1, 1, 1); PG8_STAGE(PG8_SB(1, 0), b3, voffB);
            PG8_BAR; PG8_WAIT_L(0); PG8_MMA(0, 1, At, B1); PG8_BAR;
            PG8_LDA(At, 1, 1); PG8_STAGE(PG8_SA(1, 0), a3, voffA);
            PG8_BAR; PG8_WAIT_L(0); PG8_MMA(1, 0, At, B0); PG8_BAR; PG8_SCHED;
            PG8_STAGE(PG8_SB(1, 1), b3 + hstep, voffB);
            PG8_WAIT_V(6); PG8_BAR; PG8_MMA(1, 1, At, B1); PG8_BAR;
            }
        }
        if constexpr (ALIGN_EPI) { if (wr == 0) PG8_BAR; }
        if constexpr (!Epi::AFTER_DRAIN) { E(acc, cur, wr, wc, fr, fq); S.done(cur); }
        if (!has_next) break;
#pragma unroll
        for (int a = 0; a < 2; ++a)
#pragma unroll
            for (int b = 0; b < 2; ++b)
#pragma unroll
                for (int m = 0; m < 4; ++m)
#pragma unroll
                    for (int n = 0; n < 2; ++n) acc[a][b][m][n] = (f32x4){0.f, 0.f, 0.f, 0.f};
        cur = nxt; cA = nA; cB = nB; ++ui; if constexpr (GATHER) { pc0 = pn0; pc1 = pn1; }
        if constexpr (ALIGN_EPI) { if (wr == 1) PG8_BAR; }
    }
    PG8_WAIT_V(0);
    if constexpr (!ALIGN_EPI) { if (wr == 0) PG8_BAR; }
    PG8_BAR;
    if constexpr (Epi::AFTER_DRAIN) { E.fused(acc, cur, wr, wc, fr, fq, lds, wid, lane); S.done(cur); }
#undef PG8_SA
#undef PG8_SB
#undef PG8_STAGE
#undef PG8_STAGE_A
#undef PG8_TOKPACK
#undef PG8_LDA
#undef PG8_LDB
#undef PG8_MMA
#undef PG8_WAIT_V
#undef PG8_WAIT_L
#undef PG8_BAR
#undef PG8_SCHED
}
}

using pg8::Unit;
struct DenseSched { int nN, n, G, c;
    __device__ __forceinline__ void a_ready(const Unit&) const {}
    __device__ __forceinline__ void done(const Unit&) const {}
    __device__ __forceinline__ bool next(int i, Unit& u) const { const int L = i * G + c; if (L >= n) return false; u.pm = L / nN; u.pn = L % nN; return true; } };

__device__ __forceinline__ void store8bf(bf16* p, f32x4 lo, f32x4 hi) { u32x4 w; w.x = pk2(lo[0], lo[1]); w.y = pk2(lo[2], lo[3]); w.z = pk2(hi[0], hi[1]); w.w = pk2(hi[2], hi[3]); *(u32x4*)p = w; }
__device__ __forceinline__ void load8bf(const bf16* p, f32x4& lo, f32x4& hi) { const u32x4 w = *(const u32x4*)p;
    lo[0] = __uint_as_float(w.x << 16); lo[1] = __uint_as_float(w.x & 0xffff0000u); lo[2] = __uint_as_float(w.y << 16); lo[3] = __uint_as_float(w.y & 0xffff0000u);
    hi[0] = __uint_as_float(w.z << 16); hi[1] = __uint_as_float(w.z & 0xffff0000u); hi[2] = __uint_as_float(w.w << 16); hi[3] = __uint_as_float(w.w & 0xffff0000u); }
struct EpiZ { bf16 *ZR, *ZS, *ZG;
    __device__ __forceinline__ void one(int row, int col, f32x4 lo, f32x4 hi) const {
        if (col < RC) store8bf(ZR + (size_t)row * RC + col, lo, hi);
        else if (col < RC + 1024) { for (int e = 0; e < 4; ++e) { lo[e] = gelu_tanh(lo[e]); hi[e] = gelu_tanh(hi[e]); } store8bf(ZS + (size_t)row * 1024 + (col - RC), lo, hi); }
        else { for (int e = 0; e < 4; ++e) { lo[e] = sigmoidf_(lo[e]); hi[e] = sigmoidf_(hi[e]); } store8bf(ZG + (size_t)row * 2048 + (col - RC - 1024), lo, hi); } }
    __device__ __forceinline__ void operator()(int row, int col, f32x4 a0, f32x4 a1, f32x4 b0, f32x4 b1) const { one(row, col, a0, a1); one(row, col + 128, b0, b1); } };
struct EpiGA { const bf16* ZG; bf16* MP;
    __device__ __forceinline__ void one(int row, int col, f32x4 lo, f32x4 hi) const { f32x4 g0, g1; load8bf(ZG + (size_t)row * 2048 + col, g0, g1); store8bf(MP + (size_t)row * D + col, g0 * lo, g1 * hi); }
    __device__ __forceinline__ void operator()(int row, int col, f32x4 a0, f32x4 a1, f32x4 b0, f32x4 b1) const { one(row, col, a0, a1); one(row, col + 128, b0, b1); } };
struct EpiGB { const bf16* ZG; const bf16* MPin; bf16* MP;
    __device__ __forceinline__ void one(int row, int col, f32x4 lo, f32x4 hi) const { f32x4 g0, g1, m0, m1; load8bf(ZG + (size_t)row * 2048 + 1024 + col, g0, g1); load8bf(MPin + (size_t)row * D + col, m0, m1);
        store8bf(MP + (size_t)row * D + col, m0 + g0 * lo, m1 + g1 * hi); }
    __device__ __forceinline__ void operator()(int row, int col, f32x4 a0, f32x4 a1, f32x4 b0, f32x4 b1) const { one(row, col, a0, a1); one(row, col + 128, b0, b1); } };
struct EpiOut { bf16* tmp; const float* gate1;
    __device__ __forceinline__ void one(int row, int col, f32x4 lo, f32x4 hi) const {
        const f32x4 g0 = *(const f32x4*)(gate1 + col), g1 = *(const f32x4*)(gate1 + col + 4); store8bf_wt(wt_rsrc(tmp, T * D * 2), (unsigned)((row * D + col) * 2), (1.0f + g0) * lo, (1.0f + g1) * hi); }
    __device__ __forceinline__ void operator()(int row, int col, f32x4 a0, f32x4 a1, f32x4 b0, f32x4 b1) const { one(row, col, a0, a1); one(row, col + 128, b0, b1); } };
struct EpiSwi { bf16* HID;
    __device__ __forceinline__ void operator()(int row, int col, f32x4 a0, f32x4 a1, f32x4 b0, f32x4 b1) const { const int ct = (col >> 8) & 3, cc = col & 127;
        f32x4 h0, h1; for (int e = 0; e < 4; ++e) { h0[e] = siluf_(a0[e]) * b0[e]; h1[e] = siluf_(a1[e]) * b1[e]; } store8bf_wt(wt_rsrc(HID, MAXSLOT * FF * 2), (unsigned)((row * FF + ct * 128 + cc) * 2), h0, h1); } };
struct EpiSwiWT { bf16* HID;
    __device__ __forceinline__ void operator()(int row, int col, f32x4 a0, f32x4 a1, f32x4 b0, f32x4 b1) const { const int ct = (col >> 8) & 3, cc = col & 127;
        const __amdgpu_buffer_rsrc_t rs = __builtin_amdgcn_make_buffer_rsrc((void*)HID, 0, MAXSLOT * FF * 2, 0x00020000);
        f32x4 h0, h1; for (int e = 0; e < 4; ++e) { h0[e] = siluf_(a0[e]) * b0[e]; h1[e] = siluf_(a1[e]) * b1[e]; }
        u32x4 w; w.x = pk2(h0[0], h0[1]); w.y = pk2(h0[2], h0[3]); w.z = pk2(h1[0], h1[1]); w.w = pk2(h1[2], h1[3]);
        __builtin_amdgcn_raw_buffer_store_b128(w, rs, (unsigned)((row * FF + ct * 128 + cc) * 2), 0, 16); } };
struct EpiDown { const int* S2T; const float* TOKW; bf16* Y;
    __device__ __forceinline__ void operator()(int row, int col, f32x4 a0, f32x4 a1, f32x4 b0, f32x4 b1) const { const u32x2 sw = *(const u32x2*)(S2T + 2 * row); const int st = (int)sw.x; if (st < 0) return; const float w = __uint_as_float(sw.y); const int cc = col & 1023;
        const __amdgpu_buffer_rsrc_t rs = wt_rsrc(Y, 2 * T * D * 2); store8bf_wt(rs, (unsigned)((st * D + cc) * 2), w * a0, w * a1); store8bf_wt(rs, (unsigned)((st * D + cc + 128) * 2), w * b0, w * b1); } };

struct MoeSched { int ts[17]; int G, c, NU, LA;
    __device__ __forceinline__ void a_ready(const Unit&) const {}
    __device__ __forceinline__ void done(const Unit&) const {}
    __device__ __forceinline__ void init(const unsigned* cnt, int G_, int c_) { G = G_; c = c_; int s = 0;
#pragma unroll
        for (int e = 0; e < 16; ++e) { ts[e] = s; s += ((int)cnt[e] + 255) >> 8; } ts[16] = s; NU = 4 * s; LA = ((NU / G) * G) & ~3; }
    __device__ __forceinline__ void unit_of(int L, Unit& u) const { const int rt = L >> 2, ct = L & 3; int e = 0;
#pragma unroll
        for (int j = 1; j < 16; ++j) e += (rt >= ts[j]) ? 1 : 0;
        u.pm = rt; u.pn = e * 4 + ct; }
    __device__ __forceinline__ bool next(int i, Unit& u) const { const int L = i * G + c; if (L >= NU) return false; unit_of(L, u); return true; } };
struct MoeSchedA : MoeSched {
    __device__ __forceinline__ bool next(int i, Unit& u) const { const int L = i * G + c; if (L >= LA) return false; unit_of(L, u); return true; } };
struct MoeSchedT : MoeSched { unsigned* rdy;
    __device__ __forceinline__ bool next(int i, Unit& u) const { const int L = LA + i * G + c; if (L >= NU) return false; unit_of(L, u); return true; }
    __device__ __forceinline__ void done(const Unit& u) const {
        asm volatile("s_waitcnt vmcnt(0)" ::: "memory");
        if (__builtin_amdgcn_mbcnt_hi(~0u, __builtin_amdgcn_mbcnt_lo(~0u, 0u)) == 0u) (void)__hip_atomic_fetch_add(rdy + 64 * u.pm, 1u, __ATOMIC_RELAXED, __HIP_MEMORY_SCOPE_AGENT); } };
struct MoeSchedB : MoeSched { unsigned* rdy; unsigned* tmo; int wave;
    __device__ __forceinline__ bool next(int i, Unit& u) const { const int NT = NU - LA; int q;
        if (c < NT) { if (i > 0) return false; q = G - NT + c; }
        else { const int p = c - NT; q = (i == 0) ? p : G + p + (i - 1) * (G - NT); }
        if (q >= NU) return false; unit_of(q, u); return true; }
    __device__ __forceinline__ void a_ready(const Unit& u) const {
        if (4 * u.pm < LA) return;
        if (wave == 0) { unsigned sp = 0u;
            while ((unsigned)__builtin_amdgcn_readfirstlane(__hip_atomic_load(rdy + 64 * u.pm, __ATOMIC_RELAXED, __HIP_MEMORY_SCOPE_AGENT)) < 32u) { __builtin_amdgcn_s_sleep(2);
                if ((++sp & 255u) == 0u) { if (__hip_atomic_load(tmo, __ATOMIC_RELAXED, __HIP_MEMORY_SCOPE_AGENT)) break; if (sp > (1u << 24)) { atomicAdd(tmo, 1u); break; } } }
            __builtin_amdgcn_fence(__ATOMIC_ACQUIRE, "agent");
            asm volatile("s_waitcnt vmcnt(0)" ::: "memory"); }
        asm volatile("" ::: "memory"); __builtin_amdgcn_s_barrier(); asm volatile("" ::: "memory"); } };

__device__ __forceinline__ void phase_prep_simple(ArgsR a, const Ctx& c, int l) {
    const bf16* ZR = (const bf16*)(a.ws + WS_ZR);
    const float* mu = a.in[I_MU] + l * RC; const float* w0 = a.in[I_W0] + l * W; const float* w2 = a.in[I_W2] + (size_t)l * 64 * W;
    const float* a0 = a.in[I_A0] + l * W; const float* a2 = a.in[I_A2] + (size_t)l * 64 * W; const float* g2 = a.in[I_G2] + (size_t)l * 128 * W;
    const float* k_k = a.in[I_KK] + l * W; const float* k_a = a.in[I_KA] + l * W;
    const float* vm0 = a.in[I_VM0]; const float* vm1 = a.in[I_VM1]; const float* vm2 = a.in[I_VM2];
    f16* R = (f16*)(a.ws + WS_R); f16* WM1 = (f16*)(a.ws + WS_WM1); f16* KP = (f16*)(a.ws + WS_KP); f16* AA = (f16*)(a.ws + WS_AA); f16* BB = (f16*)(a.ws + WS_BB); f16* V = (f16*)(a.ws + WS_V);
    bf16* G = (bf16*)(a.ws + WS_G); bf16* VF = (bf16*)(a.ws + WS_VF);
    const int lane = c.lane;
    for (int t = c.gw; t < T; t += c.ngw) {
        float z[28];
#pragma unroll
        for (int i = 0; i < 28; ++i) { const int col = lane + 64 * i; const float zc = bf2f(ZR[(size_t)t * RC + col]); const float zp = t > 0 ? bf2f(ZR[(size_t)(t - 1) * RC + col]) : 0.f; z[i] = zc + (zp - zc) * mu[col]; }
        const float tw = tanhf(z[24]), za = z[25], sg0 = sigmoidf_(z[26]), sg1 = sigmoidf_(z[27]);
        float wlo[8], alo[8], gg[8];
#pragma unroll
        for (int i = 0; i < 8; ++i) { wlo[i] = 0.f; alo[i] = 0.f; gg[i] = 0.f; }
        for (int j = 0; j < 64; ++j) { const float tj = __shfl(tw, j), aj = __shfl(za, j), s0 = __shfl(sg0, j), s1 = __shfl(sg1, j);
#pragma unroll
            for (int i = 0; i < 8; ++i) { const int n = lane + 64 * i; wlo[i] += tj * w2[j * W + n]; alo[i] += aj * a2[j * W + n]; gg[i] += s0 * g2[j * W + n] + s1 * g2[(64 + j) * W + n]; } }
        float vv[8];
#pragma unroll
        for (int i = 0; i < 8; ++i) vv[i] = z[16 + i];
        if (l == 0) {
#pragma unroll
            for (int i = 0; i < 8; ++i) VF[(size_t)t * W + lane + 64 * i] = f2bf(vv[i]);
        } else {
            float vmid = 0.f;
#pragma unroll
            for (int i = 0; i < 8; ++i)
                for (int j = 0; j < 64; ++j) { const float vc = __shfl(vv[i], j); vmid += vc * vm1[(size_t)(64 * i + j) * 32 + (lane & 31)]; }
            float vg[8];
#pragma unroll
            for (int i = 0; i < 8; ++i) vg[i] = 0.f;
            for (int m = 0; m < 32; ++m) { const float vmm = __shfl(vmid, m);
#pragma unroll
                for (int i = 0; i < 8; ++i) vg[i] += vmm * vm2[m * W + lane + 64 * i]; }
#pragma unroll
            for (int i = 0; i < 8; ++i) { const int n = lane + 64 * i; const float vf = bf2f(VF[(size_t)t * W + n]); vv[i] = vv[i] + (vf - vv[i]) * sigmoidf_(vm0[n] + vg[i]); }
        }
#pragma unroll
        for (int i = 0; i < 8; ++i) {
            const int n = lane + 64 * i; const size_t o = (size_t)t * W + n;
            const float x = w0[n] + wlo[i]; const float wl = -softplusf_(-x) - 0.5f; const float dm1 = expm1f(-__expf(wl));
            const float av = sigmoidf_(a0[n] + alo[i]);
            const float kraw = z[8 + i];
            float kk = kraw * k_k[n]; const float nrm = sqrtf(wave_sum(kk * kk)); kk = kk / fmaxf(nrm, 1e-12f);
            const float kp = kraw * (1.0f + (av - 1.0f) * k_a[n]);
            R[o] = (f16)z[i]; WM1[o] = (f16)dm1; KP[o] = (f16)kp; AA[o] = (f16)(-kk); BB[o] = (f16)(kk * av); V[o] = (f16)vv[i]; G[o] = f2bf(gg[i]);
        }
    }
}

__device__ __forceinline__ void phase_sg_simple(ArgsR a, const Ctx& c, int l) {
    const bf16* ZS = (const bf16*)(a.ws + WS_ZS); bf16* YB = (bf16*)(a.ws + WS_YB);
    const float* lng = a.in[I_SGG] + l * W; const float* lnb = a.in[I_SGB] + l * W;
    float* vn = (float*)c.lds;
    float* st = vn + 128 * 64;
    for (int uidx = blockIdx.x; uidx < 128 * 8; uidx += gridDim.x) {
        const int ch = uidx >> 3, g = uidx & 7; const int tok0 = ch * 128;
        for (int i = 0; i < 16; ++i) { const int s = c.wave * 16 + i; const bf16* p = ZS + (size_t)(tok0 + s) * 1024 + 512 + c.lane * 8;
            const f32x4 x0 = load4bf(p), x1 = load4bf(p + 4);
            float sm = (x0[0] + x0[1]) + (x0[2] + x0[3]) + (x1[0] + x1[1]) + (x1[2] + x1[3]); const float mean = wave_sum(sm) * (1.f / 512.f);
            float q = 0.f; for (int e = 0; e < 4; ++e) { const float d0 = x0[e] - mean, d1 = x1[e] - mean; q += d0 * d0 + d1 * d1; }
            const float rstd = __builtin_amdgcn_rsqf(wave_sum(q) * (1.f / 512.f) + LN_EPS);
            if (c.lane == 0) { st[2 * s] = mean; st[2 * s + 1] = rstd; } }
        __syncthreads();
        for (int i = c.tid; i < 128 * 64; i += NTHREADS) { const int s = i >> 6, d = i & 63; const float x = bf2f(ZS[(size_t)(tok0 + s) * 1024 + 512 + g * 64 + d]);
            vn[i] = (x - st[2 * s]) * st[2 * s + 1] * lng[g * 64 + d] + lnb[g * 64 + d]; }
        __syncthreads();
        const int d = c.tid & 63, tq = c.tid >> 6;
        const float* Wg = a.in[I_WS] + (size_t)(l * 8 + g) * 128 * 128; const float* bs = a.in[I_BS] + (size_t)(l * 8 + g) * 128;
        for (int i = 0; i < 16; ++i) { const int t = tq + 8 * i; float acc = 0.f;
            for (int s = 0; s <= t; ++s) acc += Wg[t * 128 + s] * vn[s * 64 + d];
            const float u = bf2f(ZS[(size_t)(tok0 + t) * 1024 + g * 64 + d]);
            YB[(size_t)(tok0 + t) * W + g * 64 + d] = f2bf(u * (acc + bs[t])); }
        __syncthreads();
    }
}

#define LAS3 __attribute__((address_space(3)))
typedef short bf16x8 __attribute__((ext_vector_type(8)));
template <int MT, int NT, int KS, bool SWAP = false>
__device__ __forceinline__ void mma_lds_glob(const unsigned char* lds_base, int a_off_bytes, int lda, const bf16* Bt, int ldb, int n0, int lane, f32x4 (&acc)[MT][NT]) {
    const int fr = lane & 15, fq = lane >> 4;
    const LAS3 unsigned char* Ab = (const LAS3 unsigned char*)lds_base + a_off_bytes;
    int boff = (n0 + fr) * ldb + 8 * fq; asm volatile("" : "+v"(boff));
#pragma unroll
    for (int ks = 0; ks < KS; ++ks) {
        bf16x8 b[NT];
#pragma unroll
        for (int n = 0; n < NT; ++n) b[n] = *(const bf16x8*)(Bt + boff + 16 * n * ldb + 32 * ks);
#pragma unroll
        for (int m = 0; m < MT; ++m) { const bf16x8 av = *(const LAS3 bf16x8*)(Ab + ((16 * m + fr) * lda + 32 * ks + 8 * fq) * 2);
#pragma unroll
            for (int n = 0; n < NT; ++n) acc[m][n] = SWAP ? __builtin_amdgcn_mfma_f32_16x16x32_bf16(b[n], av, acc[m][n], 0, 0, 0) : __builtin_amdgcn_mfma_f32_16x16x32_bf16(av, b[n], acc[m][n], 0, 0, 0); }
    }
}
template <int NT, int KS, class F>
__device__ __forceinline__ void mma_lds_glob_rows(const unsigned char* lds_base, int a_off_bytes, int lda, const bf16* Bt, int ldb, int n0, int lane, const F& f) {
    const int fr = lane & 15, fq = lane >> 4;
    const LAS3 unsigned char* Ab = (const LAS3 unsigned char*)lds_base + a_off_bytes;
    int boff = (n0 + fr) * ldb + 8 * fq; asm volatile("" : "+v"(boff));
    bf16x8 b[KS][NT];
#pragma unroll
    for (int ks = 0; ks < KS; ++ks)
#pragma unroll
        for (int n = 0; n < NT; ++n) b[ks][n] = *(const bf16x8*)(Bt + boff + 16 * n * ldb + 32 * ks);
#pragma unroll 1
    for (int m = 0; m < 4; ++m) {
        f32x4 acc[NT];
#pragma unroll
        for (int n = 0; n < NT; ++n) acc[n] = (f32x4){0.f, 0.f, 0.f, 0.f};
#pragma unroll
        for (int ks = 0; ks < KS; ++ks) { const bf16x8 av = *(const LAS3 bf16x8*)(Ab + ((16 * m + fr) * lda + 32 * ks + 8 * fq) * 2);
#pragma unroll
            for (int n = 0; n < NT; ++n) acc[n] = __builtin_amdgcn_mfma_f32_16x16x32_bf16(b[ks][n], av, acc[n], 0, 0, 0); }
#pragma unroll
        for (int n = 0; n < NT; ++n) f(m, n, acc[n]);
    }
}
__device__ __forceinline__ void zshift8(const bf16* ZR, int t, int col, const float* mu, float (&o)[8]) {
    const u32x4 zc = *(const u32x4*)(ZR + (size_t)t * RC + col);
    u32x4 zp = {0u, 0u, 0u, 0u}; if (t > 0) zp = *(const u32x4*)(ZR + (size_t)(t - 1) * RC + col);
    const f32x4 m0 = *(const f32x4*)(mu + col), m1 = *(const f32x4*)(mu + col + 4);
#pragma unroll
    for (int e = 0; e < 4; ++e) { const float c0 = __uint_as_float(zc[e] << 16), c1 = __uint_as_float(zc[e] & 0xffff0000u), p0 = __uint_as_float(zp[e] << 16), p1 = __uint_as_float(zp[e] & 0xffff0000u);
        const float mu0 = (2 * e < 4) ? m0[(2 * e) & 3] : m1[(2 * e) & 3], mu1 = (2 * e + 1 < 4) ? m0[(2 * e + 1) & 3] : m1[(2 * e + 1) & 3];
        o[2 * e] = c0 + (p0 - c0) * mu0; o[2 * e + 1] = c1 + (p1 - c1) * mu1; }
}
typedef _Float16 f16x8 __attribute__((ext_vector_type(8)));
typedef _Float16 f16x4 __attribute__((ext_vector_type(4)));
__device__ __forceinline__ void store8f16(f16* p, const float (&v)[8]) { f16x8 h;
#pragma unroll
    for (int e = 0; e < 8; ++e) h[e] = (f16)v[e];
    *(f16x8*)p = h; }


constexpr int PB_LD = 520;
constexpr int PB_BUF = 0, PB_AOP = 64 * PB_LD * 2, PB_VMID = 2 * 64 * PB_LD * 2, PB_LA_LD = 264, PB_VM_LD = 40;
__device__ __forceinline__ void phase_prep_fast(ArgsR a, const Ctx& c, int l) {
    const bf16* ZR = (const bf16*)(a.ws + WS_ZR);
    const float* mu = a.in[I_MU] + l * RC; const float* w0 = a.in[I_W0] + l * W; const float* a0 = a.in[I_A0] + l * W;
    const float* k_k = a.in[I_KK] + l * W; const float* k_a = a.in[I_KA] + l * W; const float* vm0 = a.in[I_VM0]; const float* r_kp = a.in[I_RK] + l * W; float* BON = (float*)(a.ws + WS_BON);
    f16* R = (f16*)(a.ws + WS_R); f16* WM1 = (f16*)(a.ws + WS_WM1); f16* KP = (f16*)(a.ws + WS_KP); f16* AA = (f16*)(a.ws + WS_AA); f16* BB = (f16*)(a.ws + WS_BB); f16* V = (f16*)(a.ws + WS_V);
    bf16* G = (bf16*)(a.ws + WS_G); bf16* VF = (bf16*)(a.ws + WS_VF);
    const unsigned char* lo = a.ws + WS_LORA + (size_t)l * LO_STRIDE;
    const bf16* W2T = (const bf16*)(lo + LO_W2T); const bf16* A2T = (const bf16*)(lo + LO_A2T); const bf16* G2T = (const bf16*)(lo + LO_G2T);
    const bf16* VM1T = (const bf16*)(lo + LO_VM1T); const bf16* VM2T = (const bf16*)(lo + LO_VM2T);
    LAS3 unsigned char* L = (LAS3 unsigned char*)c.lds;
    const int tid = c.tid, lane = c.lane, wv = c.wave, fr = lane & 15, fq = lane >> 4;
    const int row = tid >> 3, sub_ = tid & 7;
    for (int u = blockIdx.x; u < T / 64; u += gridDim.x) {
        int sub = sub_; asm volatile("" : "+v"(sub));
        const int t0 = u * 64, t = t0 + row;
        if (l == 0) {
#pragma unroll 4
            for (int p = 0; p < 8; ++p) { const int col = p * 64 + sub * 8; float z[8]; zshift8(ZR, t, 1024 + col, mu, z);
                store8f16(V + (size_t)t * W + col, z); *(u32x4*)(VF + (size_t)t * W + col) = pack8bf(z); }
        } else {
#pragma unroll 4
            for (int p = 0; p < 8; ++p) { const int col = p * 64 + sub * 8; float z[8]; zshift8(ZR, t, 1024 + col, mu, z);
                *(LAS3 u32x4*)(L + PB_AOP + (row * PB_LD + col) * 2) = pack8bf(z); }
            __syncthreads();
            { f32x4 acc[1][1]; acc[0][0] = (f32x4){0.f, 0.f, 0.f, 0.f}; const int m = wv >> 1, n = wv & 1;
              mma_lds_glob<1, 1, 16>(c.lds, PB_AOP + 16 * m * PB_LD * 2, PB_LD, VM1T, W, 16 * n, lane, acc);
#pragma unroll
              for (int i = 0; i < 4; ++i) *(LAS3 bf16*)(L + PB_VMID + ((16 * m + 4 * fq + i) * PB_VM_LD + 16 * n + fr) * 2) = f2bf(acc[0][0][i]); }
            __syncthreads();
            mma_lds_glob_rows<4, 1>(c.lds, PB_VMID, PB_VM_LD, VM2T, 32, 64 * wv, lane, [&](int m, int n, f32x4 acc) { const int col = 64 * wv + 16 * n + 4 * fq; const f32x4 vb = *(const f32x4*)(vm0 + col); f16x4 hv;
#pragma unroll
                for (int i = 0; i < 4; ++i) hv[i] = (f16)sigmoidf_(vb[i] + acc[i]);
                *(LAS3 f16x4*)(L + PB_BUF + ((16 * m + fr) * PB_LD + col) * 2) = hv; });
            __syncthreads();
#pragma unroll 4
            for (int p = 0; p < 8; ++p) { const int col = p * 64 + sub * 8;
                const u32x4 vz = *(const LAS3 u32x4*)(L + PB_AOP + (row * PB_LD + col) * 2); const f16x8 gt = *(const LAS3 f16x8*)(L + PB_BUF + (row * PB_LD + col) * 2);
                const u32x4 vfw = *(const u32x4*)(VF + (size_t)t * W + col); float o[8];
#pragma unroll
                for (int e = 0; e < 4; ++e) { const float v0 = __uint_as_float(vz[e] << 16), v1 = __uint_as_float(vz[e] & 0xffff0000u), f0 = __uint_as_float(vfw[e] << 16), f1 = __uint_as_float(vfw[e] & 0xffff0000u);
                    o[2 * e] = v0 + (f0 - v0) * (float)gt[2 * e]; o[2 * e + 1] = v1 + (f1 - v1) * (float)gt[2 * e + 1]; }
                store8f16(V + (size_t)t * W + col, o); }
            __syncthreads();
        }
#pragma unroll 4
        for (int p = 0; p < 4; ++p) { const int cc = sub * 32 + p * 8; float z[8]; zshift8(ZR, t, 1536 + cc, mu, z);
#pragma unroll
            for (int e = 0; e < 8; ++e) z[e] = cc < 64 ? (1.0f - 2.0f * __builtin_amdgcn_rcpf(1.0f + __expf(2.0f * z[e]))) : (cc < 128 ? z[e] : sigmoidf_(z[e]));
            *(LAS3 u32x4*)(L + PB_AOP + (row * PB_LA_LD + cc) * 2) = pack8bf(z); }
        __syncthreads();
        mma_lds_glob_rows<4, 2>(c.lds, PB_AOP + 64 * 2, PB_LA_LD, A2T, 64, 64 * wv, lane, [&](int m, int n, f32x4 acc) { const int col = 64 * wv + 16 * n + 4 * fq; const f32x4 ab = *(const f32x4*)(a0 + col); f16x4 hv;
#pragma unroll
            for (int i = 0; i < 4; ++i) hv[i] = (f16)sigmoidf_(ab[i] + acc[i]);
            *(LAS3 f16x4*)(L + PB_BUF + ((16 * m + fr) * PB_LD + col) * 2) = hv; });
        __syncthreads();
#pragma unroll 4
        for (int p = 0; p < 8; ++p) { const int col = p * 64 + sub * 8; const size_t o = (size_t)t * W + col;
            float z[8]; zshift8(ZR, t, col, mu, z); store8f16(R + o, z);
            float kz[8]; zshift8(ZR, t, 512 + col, mu, kz);
            const f16x8 av = *(const LAS3 f16x8*)(L + PB_BUF + (row * PB_LD + col) * 2);
            const f32x4 kk0 = *(const f32x4*)(k_k + col), kk1 = *(const f32x4*)(k_k + col + 4), ka0 = *(const f32x4*)(k_a + col), ka1 = *(const f32x4*)(k_a + col + 4);
            float kk[8], kp[8], bb[8]; float ss = 0.f;
#pragma unroll
            for (int e = 0; e < 8; ++e) { const float kkw = e < 4 ? kk0[e & 3] : kk1[e & 3], kaw = e < 4 ? ka0[e & 3] : ka1[e & 3]; kk[e] = kz[e] * kkw; ss += kk[e] * kk[e]; kp[e] = kz[e] * (1.0f + ((float)av[e] - 1.0f) * kaw); }
            ss = group_sum8(ss);
            { const f32x4 rq0 = *(const f32x4*)(r_kp + col), rq1 = *(const f32x4*)(r_kp + col + 4); float bp = 0.f;
#pragma unroll
              for (int e = 0; e < 8; ++e) bp += z[e] * kp[e] * (e < 4 ? rq0[e & 3] : rq1[e & 3]);
              bp = group_sum8(bp); if (sub == 0) BON[(size_t)t * 8 + p] = bp; }
            const float inv = fminf(__builtin_amdgcn_rsqf(ss), 1e12f);
#pragma unroll
            for (int e = 0; e < 8; ++e) { kk[e] *= inv; bb[e] = kk[e] * (float)av[e]; kk[e] = -kk[e]; }
            store8f16(KP + o, kp); store8f16(AA + o, kk); store8f16(BB + o, bb); }
        __syncthreads();
        mma_lds_glob_rows<4, 2>(c.lds, PB_AOP, PB_LA_LD, W2T, 64, 64 * wv, lane, [&](int m, int n, f32x4 acc) { const int col = 64 * wv + 16 * n + 4 * fq; const f32x4 wb = *(const f32x4*)(w0 + col); f16x4 hv;
#pragma unroll
            for (int i = 0; i < 4; ++i) { const float x = wb[i] + acc[i]; const float wl = -(fmaxf(-x, 0.f) + __logf(1.0f + __expf(-fabsf(x)))) - 0.5f;
                hv[i] = (f16)(__expf(-__expf(wl)) - 1.0f); }
            *(LAS3 f16x4*)(L + PB_BUF + ((16 * m + fr) * PB_LD + col) * 2) = hv; });
        __syncthreads();
#pragma unroll 4
        for (int p = 0; p < 8; ++p) { const int col = p * 64 + sub * 8; *(u32x4*)(WM1 + (size_t)t * W + col) = *(const LAS3 u32x4*)(L + PB_BUF + (row * PB_LD + col) * 2); }
        __syncthreads();
        mma_lds_glob_rows<4, 4>(c.lds, PB_AOP + 128 * 2, PB_LA_LD, G2T, 128, 64 * wv, lane, [&](int m, int n, f32x4 acc) { const int col = 64 * wv + 16 * n + 4 * fq; u32x2 w; w.x = pk2(acc[0], acc[1]); w.y = pk2(acc[2], acc[3]);
            *(LAS3 u32x2*)(L + PB_BUF + ((16 * m + fr) * PB_LD + col) * 2) = w; });
        __syncthreads();
#pragma unroll 4
        for (int p = 0; p < 8; ++p) { const int col = p * 64 + sub * 8; *(u32x4*)(G + (size_t)t * W + col) = *(const LAS3 u32x4*)(L + PB_BUF + (row * PB_LD + col) * 2); }
        __syncthreads();
    }
}

constexpr int SG_LD = 136;
constexpr int SG_VT = 0, SG_ST = 256 * SG_LD * 2;
__device__ __forceinline__ void phase_sg_fast(ArgsR a, const Ctx& c, int l) {
    const bf16* ZS = (const bf16*)(a.ws + WS_ZS); bf16* YB = (bf16*)(a.ws + WS_YB);
    const float* lng = a.in[I_SGG] + l * W; const float* lnb = a.in[I_SGB] + l * W;
    LAS3 unsigned char* L = (LAS3 unsigned char*)c.lds;
    LAS3 float* st = (LAS3 float*)(L + SG_ST);
    const int tid = c.tid, lane = c.lane, wv = c.wave, fr = lane & 15, fq = lane >> 4;
    for (int u = blockIdx.x; u < 256; u += gridDim.x) {
        const int ch = u >> 1, hf = u & 1, tok0 = ch * 128;
        { u32x4 raw[16];
#pragma unroll
          for (int i = 0; i < 16; ++i) raw[i] = *(const u32x4*)(ZS + (size_t)(tok0 + wv * 16 + i) * 1024 + 512 + lane * 8);
#pragma unroll
          for (int i = 0; i < 16; ++i) { const int sidx = wv * 16 + i; float x[8];
#pragma unroll
              for (int e = 0; e < 4; ++e) { x[2 * e] = __uint_as_float(raw[i][e] << 16); x[2 * e + 1] = __uint_as_float(raw[i][e] & 0xffff0000u); }
              const float sm = ((x[0] + x[1]) + (x[2] + x[3])) + ((x[4] + x[5]) + (x[6] + x[7])); const float mean = wave_sum(sm) * (1.f / 512.f);
              float q = 0.f;
#pragma unroll
              for (int e = 0; e < 8; ++e) { const float d0 = x[e] - mean; q += d0 * d0; }
              const float rstd = __builtin_amdgcn_rsqf(wave_sum(q) * (1.f / 512.f) + LN_EPS);
              if (lane == 0) { st[2 * sidx] = mean; st[2 * sidx + 1] = rstd; } } }
        __syncthreads();
        { const int sidx = tid >> 2, q4 = tid & 3; const float mean = st[2 * sidx], rstd = st[2 * sidx + 1];
#pragma unroll
          for (int p = 0; p < 8; ++p) { const int cl = q4 * 64 + p * 8; const int cg = hf * 256 + cl;
              const bf16* src = ZS + (size_t)(tok0 + sidx) * 1024 + 512 + cg; const f32x4 x0 = load4bf(src), x1 = load4bf(src + 4);
              const f32x4 g0 = *(const f32x4*)(lng + cg), g1 = *(const f32x4*)(lng + cg + 4), b0 = *(const f32x4*)(lnb + cg), b1 = *(const f32x4*)(lnb + cg + 4);
#pragma unroll
              for (int e = 0; e < 8; ++e) { const float x = e < 4 ? x0[e & 3] : x1[e & 3], gg = e < 4 ? g0[e & 3] : g1[e & 3], bb = e < 4 ? b0[e & 3] : b1[e & 3];
                  *(LAS3 bf16*)(L + SG_VT + ((cl + e) * SG_LD + sidx) * 2) = f2bf((x - mean) * rstd * gg + bb); } } }
        __syncthreads();
        const int gl = wv >> 1, dh = wv & 1, g = hf * 4 + gl;
        const float* Wg = a.in[I_WS] + (size_t)(l * 8 + g) * 128 * 128; const float* bs = a.in[I_BS] + (size_t)(l * 8 + g) * 128;
        f32x4 acc[8][2];
#pragma unroll
        for (int m = 0; m < 8; ++m) { acc[m][0] = (f32x4){0.f, 0.f, 0.f, 0.f}; acc[m][1] = (f32x4){0.f, 0.f, 0.f, 0.f}; }
#pragma unroll
        for (int ks = 0; ks < 4; ++ks) {
            bf16x8 b[2];
#pragma unroll
            for (int n = 0; n < 2; ++n) b[n] = *(const LAS3 bf16x8*)(L + SG_VT + ((gl * 64 + dh * 32 + 16 * n + fr) * SG_LD + 32 * ks + 8 * fq) * 2);
#pragma unroll
            for (int m = 0; m < 8; ++m) { if (32 * ks <= 16 * m + 15) {
                const int trow = 16 * m + fr, s0 = 32 * ks + 8 * fq;
                const f32x4 w0v = *(const f32x4*)(Wg + trow * 128 + s0), w1v = *(const f32x4*)(Wg + trow * 128 + s0 + 4);
                float wf[8];
#pragma unroll
                for (int e = 0; e < 8; ++e) { const float wval = e < 4 ? w0v[e & 3] : w1v[e & 3]; wf[e] = (s0 + e <= trow) ? wval : 0.f; }
                const u32x4 wp = pack8bf(wf); const bf16x8 av = __builtin_bit_cast(bf16x8, wp);
                acc[m][0] = __builtin_amdgcn_mfma_f32_16x16x32_bf16(b[0], av, acc[m][0], 0, 0, 0);
                acc[m][1] = __builtin_amdgcn_mfma_f32_16x16x32_bf16(b[1], av, acc[m][1], 0, 0, 0); } }
        }
#pragma unroll
        for (int m = 0; m < 8; ++m) { const int trow = 16 * m + fr; const float bsv = bs[trow];
#pragma unroll
            for (int n = 0; n < 2; ++n) { const int col = g * 64 + dh * 32 + 16 * n + 4 * fq; const f32x4 uu = load4bf(ZS + (size_t)(tok0 + trow) * 1024 + col);
                store4bf(YB + (size_t)(tok0 + trow) * W + col, uu * (acc[m][n] + bsv)); } }
        __syncthreads();
    }
}


#ifndef SGX
#define SGX 0
#endif
constexpr int SGC_ST = 139264 + 4096;
template <int X>
__device__ __forceinline__ void phase_sg_chunk(ArgsR a, const Ctx& c, int l) {
    const bf16* ZS = (const bf16*)(a.ws + WS_ZS); bf16* YB = (bf16*)(a.ws + WS_YAB) + 512;
    const float* lng = a.in[I_SGG] + l * W; const float* lnb = a.in[I_SGB] + l * W;
    LAS3 unsigned char* L = (LAS3 unsigned char*)c.lds;
    LAS3 float* st = (LAS3 float*)(L + SGC_ST);
    const int tid = c.tid, lane = c.lane, wv = c.wave, fr = lane & 15, fq = lane >> 4;
    const int nb2a = 128;
    int first = blockIdx.x, stride = gridDim.x;
    if ((int)gridDim.x >= 2 * nb2a) { if ((int)blockIdx.x < nb2a) return; first = blockIdx.x - nb2a; stride = gridDim.x - nb2a; }
    for (int ch = first; ch < T / 128; ch += stride) {
        const int tok0 = ch * 128;
        const int g = wv;
        const bf16* Wb = (const bf16*)(a.ws + WS_WSB) + (size_t)(l * 8 + g) * 128 * 128; const float* bs = a.in[I_BS] + (size_t)(l * 8 + g) * 128;
        bf16x8 wfr[8][4];
#pragma unroll
        for (int m = 0; m < 8; ++m)
#pragma unroll
            for (int ks = 0; ks < 4; ++ks) if (32 * ks <= 16 * m + 15) wfr[m][ks] = *(const bf16x8*)(Wb + (16 * m + fr) * 128 + 32 * ks + 8 * fq);
        if (X == 3) { if (lane == 0) for (int i = 0; i < 16; ++i) { st[2 * (wv * 16 + i)] = 0.f; st[2 * (wv * 16 + i) + 1] = 1.f; } }
        else { u32x4 raw[16];
#pragma unroll
          for (int i = 0; i < 16; ++i) raw[i] = *(const u32x4*)(ZS + (size_t)(tok0 + wv * 16 + i) * 1024 + 512 + lane * 8);
#pragma unroll
          for (int i = 0; i < 16; ++i) { const int sidx = wv * 16 + i; float x[8];
#pragma unroll
              for (int e = 0; e < 4; ++e) { x[2 * e] = __uint_as_float(raw[i][e] << 16); x[2 * e + 1] = __uint_as_float(raw[i][e] & 0xffff0000u); }
              const float sm = ((x[0] + x[1]) + (x[2] + x[3])) + ((x[4] + x[5]) + (x[6] + x[7])); const float mean = wave_sum(sm) * (1.f / 512.f);
              float q = 0.f;
#pragma unroll
              for (int e = 0; e < 8; ++e) { const float d0 = x[e] - mean; q += d0 * d0; }
              const float rstd = __builtin_amdgcn_rsqf(wave_sum(q) * (1.f / 512.f) + LN_EPS);
              if (lane == 0) { st[2 * sidx] = mean; st[2 * sidx + 1] = rstd; } } }
        __syncthreads();
        { const int sidx = tid >> 2, q4 = tid & 3; const float mean = st[2 * sidx], rstd = st[2 * sidx + 1];
#pragma unroll 4
          for (int p = 0; p < 16; ++p) { const int cl = p * 32 + q4 * 8;
              const bf16* src = ZS + (size_t)(tok0 + sidx) * 1024 + 512 + cl; f32x4 x0, x1; load8bf(src, x0, x1);
              const f32x4 g0 = *(const f32x4*)(lng + cl), g1 = *(const f32x4*)(lng + cl + 4), b0 = *(const f32x4*)(lnb + cl), b1 = *(const f32x4*)(lnb + cl + 4);
#pragma unroll
              for (int e = 0; e < 8; ++e) { const float x = e < 4 ? x0[e & 3] : x1[e & 3], gg = e < 4 ? g0[e & 3] : g1[e & 3], bb = e < 4 ? b0[e & 3] : b1[e & 3];
                  if (X != 1 || e == 0) *(LAS3 bf16*)(L + SG_VT + ((cl + e) * SG_LD + sidx) * 2) = f2bf((x - mean) * rstd * gg + bb); } } }
        __syncthreads();
        bf16x8 b[4][4];
#pragma unroll
        for (int ks = 0; ks < 4; ++ks)
#pragma unroll
            for (int n = 0; n < 4; ++n) b[ks][n] = *(const LAS3 bf16x8*)(L + SG_VT + ((g * 64 + 16 * n + fr) * SG_LD + 32 * ks + 8 * fq) * 2);
#pragma unroll
        for (int m = 0; m < 8; ++m) {
            const int trow = 16 * m + fr; const float bsv = bs[trow];
            f32x4 acc[4];
#pragma unroll
            for (int n = 0; n < 4; ++n) acc[n] = (f32x4){0.f, 0.f, 0.f, 0.f};
#pragma unroll
            for (int ks = 0; ks < 4; ++ks) { if (32 * ks <= 16 * m + 15) {
#pragma unroll
                for (int n = 0; n < 4; ++n) acc[n] = __builtin_amdgcn_mfma_f32_16x16x32_bf16(b[ks][n], wfr[m][ks], acc[n], 0, 0, 0); } }
#pragma unroll
            for (int n = 0; n < 4; ++n) { const int col = g * 64 + 16 * n + 4 * fq; const u32x2 ur = X == 4 ? (u32x2){0x3f803f80u, 0x3f803f80u} : *(const u32x2*)(ZS + (size_t)(tok0 + trow) * 1024 + col);
                store4bf(YB + (size_t)(tok0 + trow) * 1024 + col, bf4cvt(ur) * (acc[n] + bsv)); }
        }
        __syncthreads();
    }
}

__device__ __forceinline__ void phase_scan_simple(ArgsR a, const Ctx& c) {
    if (c.wave != 0 || blockIdx.x >= NH) return;
    const int h = blockIdx.x, lane = c.lane;
    const f16* R = (const f16*)(a.ws + WS_R); const f16* WM1 = (const f16*)(a.ws + WS_WM1); const f16* KP = (const f16*)(a.ws + WS_KP);
    const f16* AA = (const f16*)(a.ws + WS_AA); const f16* BB = (const f16*)(a.ws + WS_BB); const f16* V = (const f16*)(a.ws + WS_V);
    bf16* YSC = (bf16*)(a.ws + WS_YSC);
    float S[64];
#pragma unroll
    for (int j = 0; j < 64; ++j) S[j] = 0.f;
    for (int t = 0; t < T; ++t) {
        const size_t base = (size_t)t * W + h * 64;
        const float vv = (float)V[base + lane];
        float sa = 0.f;
#pragma unroll
        for (int j = 0; j < 64; ++j) sa += S[j] * (float)AA[base + j];
        float y = 0.f;
#pragma unroll
        for (int j = 0; j < 64; ++j) { float s = S[j]; s = s + s * (float)WM1[base + j]; s += sa * (float)BB[base + j]; s += vv * (float)KP[base + j]; S[j] = s; y += s * (float)R[base + j]; }
        YSC[base + lane] = f2bf(y);
    }
}

typedef unsigned u32x16 __attribute__((ext_vector_type(16)));
__device__ __forceinline__ void sload32(const void* p0, u32x16& a0, u32x16& a1) {
    asm volatile("s_load_dwordx16 %0, %2, 0x0 glc\n\ts_load_dwordx16 %1, %2, 0x40 glc\n\ts_waitcnt lgkmcnt(0)" : "=&s"(a0), "=&s"(a1) : "s"(p0) : "memory");
}
__device__ __forceinline__ void sload64(const void* p0, const void* p1, u32x16& a0, u32x16& a1, u32x16& b0, u32x16& b1) {
    asm volatile("s_load_dwordx16 %0, %4, 0x0 glc\n\ts_load_dwordx16 %1, %4, 0x40 glc\n\ts_load_dwordx16 %2, %5, 0x0 glc\n\ts_load_dwordx16 %3, %5, 0x40 glc\n\ts_waitcnt lgkmcnt(0)"
                 : "=&s"(a0), "=&s"(a1), "=&s"(b0), "=&s"(b1) : "s"(p0), "s"(p1) : "memory");
}
__device__ __forceinline__ float fmix_lo(unsigned sd, float x, float y) { float d; asm("v_fma_mix_f32 %0, %1, %2, %3 op_sel_hi:[1,0,0]" : "=v"(d) : "s"(sd), "v"(x), "v"(y)); return d; }
__device__ __forceinline__ float fmix_hi(unsigned sd, float x, float y) { float d; asm("v_fma_mix_f32 %0, %1, %2, %3 op_sel:[1,0,0] op_sel_hi:[1,0,0]" : "=v"(d) : "s"(sd), "v"(x), "v"(y)); return d; }
constexpr int CL = 64, NCH = T / CL;
constexpr size_t ST_Q_OFF = (size_t)NH * NCH * 64 * 64;
constexpr size_t ST_S_OFF = (size_t)NH * NCH * 64 * 64;

__device__ __forceinline__ float vmix_lo(unsigned vd, float x, float y) { float d; asm("v_fma_mix_f32 %0, %1, %2, %3 op_sel_hi:[1,0,0]" : "=v"(d) : "v"(vd), "v"(x), "v"(y)); return d; }
__device__ __forceinline__ float vmix_hi(unsigned vd, float x, float y) { float d; asm("v_fma_mix_f32 %0, %1, %2, %3 op_sel:[1,0,0] op_sel_hi:[1,0,0]" : "=v"(d) : "v"(vd), "v"(x), "v"(y)); return d; }
template <int N> __device__ __forceinline__ void fmac_bc(float& acc, float vec, float x) { asm("v_fmac_f32_dpp %0, %1, %2 row_newbcast:%3 row_mask:0xf bank_mask:0xf" : "+v"(acc) : "v"(vec), "v"(x), "n"(N)); }
template <int N> __device__ __forceinline__ float mul_bc(float vec, float x) { float d; asm("v_mul_f32_dpp %0, %1, %2 row_newbcast:%3 row_mask:0xf bank_mask:0xf" : "=v"(d) : "v"(vec), "v"(x), "n"(N)); return d; }
struct SVec { float v[4]; };
__device__ __forceinline__ f16x4 sv_read(const LAS3 unsigned char* p, int lane) { return *(const LAS3 f16x4*)(p + (lane & 15) * 8); }
__device__ __forceinline__ void sv_cvt(SVec& o, f16x4 h) { o.v[0] = (float)h[0]; o.v[1] = (float)h[1]; o.v[2] = (float)h[2]; o.v[3] = (float)h[3]; }
__device__ __forceinline__ void sv_cvt1p(SVec& o, f16x4 h) { o.v[0] = 1.0f + (float)h[0]; o.v[1] = 1.0f + (float)h[1]; o.v[2] = 1.0f + (float)h[2]; o.v[3] = 1.0f + (float)h[3]; }
template <int J> __device__ __forceinline__ void sc_dot(float (&d)[4], const SVec& A, const float (&X)[64]) { fmac_bc<(J >> 2)>(d[J & 3], A.v[J & 3], X[J]); if constexpr (J + 1 < 64) sc_dot<J + 1>(d, A, X); }
template <int J> __device__ __forceinline__ void sc_upd3(float (&S)[64], float (&y)[4], const SVec& Wv, const SVec& Bv, const SVec& Kv, const SVec& Rv, float sa, float vv) {
    float sj = mul_bc<(J >> 2)>(Wv.v[J & 3], S[J]); fmac_bc<(J >> 2)>(sj, Bv.v[J & 3], sa); fmac_bc<(J >> 2)>(sj, Kv.v[J & 3], vv); S[J] = sj; fmac_bc<(J >> 2)>(y[J & 3], Rv.v[J & 3], sj);
    if constexpr (J + 1 < 64) sc_upd3<J + 1>(S, y, Wv, Bv, Kv, Rv, sa, vv); }
template <int J> __device__ __forceinline__ void sc_upd1(float (&Q)[64], float (&P)[64], const SVec& Wv, const SVec& Bv, const SVec& Kv, float saq, float sap, float vv) {
    float qj = mul_bc<(J >> 2)>(Wv.v[J & 3], Q[J]); fmac_bc<(J >> 2)>(qj, Bv.v[J & 3], saq); fmac_bc<(J >> 2)>(qj, Kv.v[J & 3], vv); Q[J] = qj;
    float pj = mul_bc<(J >> 2)>(Wv.v[J & 3], P[J]); fmac_bc<(J >> 2)>(pj, Bv.v[J & 3], sap); P[J] = pj;
    if constexpr (J + 1 < 64) sc_upd1<J + 1>(Q, P, Wv, Bv, Kv, saq, sap, vv); }
constexpr int SCB = 8;
constexpr int SC_NS = 7, SC_BUF = SC_NS * 1024, SC_WAVE = 2 * SC_BUF;
__device__ __forceinline__ void sc_dma(const f16* X, size_t eoff, LAS3 unsigned char* dst) {
    __builtin_amdgcn_global_load_lds((const unsigned*)(X + eoff), (LAS3 unsigned*)dst, 16, 0, 0);
}

__device__ __forceinline__ void phase_scan1(ArgsR a, const Ctx& c) {
    const f16* WM1 = (const f16*)(a.ws + WS_WM1); const f16* KP = (const f16*)(a.ws + WS_KP);
    const f16* AA = (const f16*)(a.ws + WS_AA); const f16* BB = (const f16*)(a.ws + WS_BB); const f16* V = (const f16*)(a.ws + WS_V);
    float* ST = (float*)(a.ws + WS_ST);
    const int lane = c.lane;
    LAS3 unsigned char* ring = (LAS3 unsigned char*)c.lds + c.wave * SC_WAVE;
    for (int item = c.gw; item < NH * NCH; item += c.ngw) {
        const int h = __builtin_amdgcn_readfirstlane(item / NCH), ch = __builtin_amdgcn_readfirstlane(item % NCH);
        float Q[64], P[64];
        int ln_ = lane; asm volatile("" : "+v"(ln_));
#pragma unroll
        for (int j = 0; j < 64; ++j) { Q[j] = 0.f; P[j] = (j == ln_) ? 1.f : 0.f; }
        const size_t lane_off = (size_t)(lane >> 3) * W + h * 64 + (lane & 7) * 8;
        { const size_t e0 = (size_t)(ch * CL) * W + lane_off;
          sc_dma(AA, e0, ring); sc_dma(WM1, e0, ring + 1024); sc_dma(BB, e0, ring + 2048); sc_dma(KP, e0, ring + 3072); sc_dma(V, e0, ring + 4096); }
#pragma unroll 1
        for (int blk = 0; blk < CL / SCB; ++blk) {
            LAS3 unsigned char* buf = ring + (blk & 1) * SC_BUF;
            if (blk + 1 < CL / SCB) { LAS3 unsigned char* nb = ring + ((blk + 1) & 1) * SC_BUF; const size_t e0 = (size_t)(ch * CL + (blk + 1) * SCB) * W + lane_off;
                sc_dma(AA, e0, nb); sc_dma(WM1, e0, nb + 1024); sc_dma(BB, e0, nb + 2048); sc_dma(KP, e0, nb + 3072); sc_dma(V, e0, nb + 4096);
                asm volatile("s_waitcnt vmcnt(5)" ::: "memory"); }
            else asm volatile("s_waitcnt vmcnt(0)" ::: "memory");
            SVec A, Wv, Bv, Kv;
            sv_cvt(A, sv_read(buf, lane)); sv_cvt1p(Wv, sv_read(buf + 1024, lane)); sv_cvt(Bv, sv_read(buf + 2048, lane)); sv_cvt(Kv, sv_read(buf + 3072, lane));
            float vv = (float)*(const LAS3 f16*)(buf + 4096 + lane * 2);
#pragma unroll 1
            for (int st = 0; st < SCB; ++st) {
                const LAS3 unsigned char* sn = buf + ((st + 1 < SCB) ? st + 1 : st) * 128;
                const f16x4 ha = sv_read(sn, lane), hw = sv_read(sn + 1024, lane), hb = sv_read(sn + 2048, lane), hk = sv_read(sn + 3072, lane);
                const f16 hv = *(const LAS3 f16*)(sn + 4096 + lane * 2);
                float dq[4] = {0.f, 0.f, 0.f, 0.f}, dp[4] = {0.f, 0.f, 0.f, 0.f};
                sc_dot<0>(dq, A, Q); sc_dot<0>(dp, A, P);
                const float saq = (dq[0] + dq[1]) + (dq[2] + dq[3]), sap = (dp[0] + dp[1]) + (dp[2] + dp[3]);
                sc_upd1<0>(Q, P, Wv, Bv, Kv, saq, sap, vv);
                sv_cvt(A, ha); sv_cvt1p(Wv, hw); sv_cvt(Bv, hb); sv_cvt(Kv, hk); vv = (float)hv;
            }
        }
        float* Qp = ST + ST_Q_OFF + (size_t)(h * NCH + ch) * 4096 + lane;
        bf16* PTp = (bf16*)ST + (size_t)(h * NCH + ch) * 4096 + lane;
#pragma unroll
        for (int j = 0; j < 64; ++j) { PTp[j * 64] = f2bf(P[j]); Qp[j * 64] = Q[j]; }
    }
}
constexpr int GS = 16, NG = NCH / GS;
constexpr size_t ST_LP_OFF = (size_t)NH * NCH * 4096;
constexpr size_t ST_QB_OFF = (size_t)2 * NH * NCH * 4096;
constexpr size_t WS_SG = WS_LORA + 2 * MiB;
constexpr int HI_LD = 72, HI_BYTES = 64 * HI_LD * 2;
struct HFrag { bf16x8 b[2][2]; u32x2 q[2]; };
__device__ __forceinline__ void hload(HFrag& f, const bf16* Bt, const bf16* QTc, int boff, int qtoff) {
#pragma unroll
    for (int ks = 0; ks < 2; ++ks)
#pragma unroll
        for (int n = 0; n < 2; ++n) f.b[ks][n] = *(const bf16x8*)(Bt + boff + 16 * n * 64 + 32 * ks);
#pragma unroll
    for (int n = 0; n < 2; ++n) f.q[n] = *(const u32x2*)(QTc + qtoff + 16 * n * 64);
}
__device__ __forceinline__ void hmma(const LAS3 unsigned char* img, const bf16x8 (&b)[2][2], f32x4 (&acc)[2], int m, int fr, int fq) {
#pragma unroll
    for (int ks = 0; ks < 2; ++ks) { const bf16x8 av = *(const LAS3 bf16x8*)(img + ((16 * m + fr) * HI_LD + 32 * ks + 8 * fq) * 2);
#pragma unroll
        for (int n = 0; n < 2; ++n) acc[n] = __builtin_amdgcn_mfma_f32_16x16x32_bf16(av, b[ks][n], acc[n], 0, 0, 0); }
}
__device__ __forceinline__ void himg_store(LAS3 unsigned char* img, const f32x4 (&acc)[2], int m, int n0, int fr, int fq) {
#pragma unroll
    for (int n = 0; n < 2; ++n)
#pragma unroll
        for (int i = 0; i < 4; ++i) *(LAS3 bf16*)(img + ((16 * m + 4 * fq + i) * HI_LD + n0 + 16 * n + fr) * 2) = f2bf(acc[n][i]);
}
#define HBAR() do { asm volatile("s_waitcnt lgkmcnt(0)" ::: "memory"); __builtin_amdgcn_s_barrier(); asm volatile("" ::: "memory"); } while (0)

__device__ __forceinline__ void sc2a_step(const HFrag& f, bf16* LpTc, bf16* QTc, const LAS3 unsigned char* ip, LAS3 unsigned char* ipn, const LAS3 unsigned char* iq, LAS3 unsigned char* iqn, int m, int n0, int fr, int fq, int qtoff) {
    f32x4 ap[2], aq[2];
#pragma unroll
    for (int n = 0; n < 2; ++n) { ap[n] = (f32x4){0.f, 0.f, 0.f, 0.f}; aq[n] = bf4cvt(f.q[n]); }
    hmma(ip, f.b, ap, m, fr, fq); hmma(iq, f.b, aq, m, fr, fq);
#pragma unroll
    for (int n = 0; n < 2; ++n) { u32x2 w; w.x = pk2(ap[n][0], ap[n][1]); w.y = pk2(ap[n][2], ap[n][3]);
        *(u32x2*)(LpTc + (n0 + 16 * n + fr) * 64 + 16 * m + 4 * fq) = w;
        store4bf(QTc + qtoff + 16 * n * 64, aq[n]); }
    himg_store(ipn, ap, m, n0, fr, fq); himg_store(iqn, aq, m, n0, fr, fq);
    HBAR();
}
__device__ __forceinline__ void phase_scan2a(ArgsR a, const Ctx& c) {
    const int lane = c.lane, wv = c.wave, fr = lane & 15, fq = lane >> 4, m = wv >> 1, n0 = 32 * (wv & 1);
    const int boff = (n0 + fr) * 64 + 8 * fq, qtoff = (n0 + fr) * 64 + 16 * m + 4 * fq;
    LAS3 unsigned char* L = (LAS3 unsigned char*)c.lds;
    for (int item = blockIdx.x; item < NH * NG; item += gridDim.x) {
        const size_t cb = (size_t)(item / NG) * NCH + (size_t)(item % NG) * GS;
        const bf16* PT = (const bf16*)(a.ws + WS_ST) + cb * 4096; bf16* LP = (bf16*)(a.ws + WS_ST) + ST_LP_OFF + cb * 4096; bf16* QT = (bf16*)(a.ws + WS_ST) + ST_QB_OFF + cb * 4096;
        for (int i = c.tid; i < 4 * HI_BYTES / 4; i += NTHREADS) ((LAS3 unsigned*)L)[i] = 0u;
        __syncthreads();
        if (c.tid < 64) *(LAS3 bf16*)(L + (c.tid * HI_LD + c.tid) * 2) = (bf16)0x3F80;
        __syncthreads();
        HFrag f0, f1, f2, f3;
        hload(f0, PT, QT, boff, qtoff); hload(f1, PT + 4096, QT + 4096, boff, qtoff); hload(f2, PT + 2 * 4096, QT + 2 * 4096, boff, qtoff); hload(f3, PT + 3 * 4096, QT + 3 * 4096, boff, qtoff);
        LAS3 unsigned char* p0 = L; LAS3 unsigned char* p1 = L + HI_BYTES; LAS3 unsigned char* q0 = L + 2 * HI_BYTES; LAS3 unsigned char* q1 = L + 3 * HI_BYTES;
#pragma unroll 1
        for (int i = 0; i < GS; i += 4) {
            const int nx = (i + 4 < GS) ? i + 4 : i;
            sc2a_step(f0, LP + (size_t)(i + 0) * 4096, QT + (size_t)(i + 0) * 4096, p0, p1, q0, q1, m, n0, fr, fq, qtoff); hload(f0, PT + (size_t)(nx + 0) * 4096, QT + (size_t)(nx + 0) * 4096, boff, qtoff);
            sc2a_step(f1, LP + (size_t)(i + 1) * 4096, QT + (size_t)(i + 1) * 4096, p1, p0, q1, q0, m, n0, fr, fq, qtoff); hload(f1, PT + (size_t)(nx + 1) * 4096, QT + (size_t)(nx + 1) * 4096, boff, qtoff);
            sc2a_step(f2, LP + (size_t)(i + 2) * 4096, QT + (size_t)(i + 2) * 4096, p0, p1, q0, q1, m, n0, fr, fq, qtoff); hload(f2, PT + (size_t)(nx + 2) * 4096, QT + (size_t)(nx + 2) * 4096, boff, qtoff);
            sc2a_step(f3, LP + (size_t)(i + 3) * 4096, QT + (size_t)(i + 3) * 4096, p1, p0, q1, q0, m, n0, fr, fq, qtoff); hload(f3, PT + (size_t)(nx + 3) * 4096, QT + (size_t)(nx + 3) * 4096, boff, qtoff);
        }
        __syncthreads();
    }
}
__device__ __forceinline__ void phase_scan2b(ArgsR a, const Ctx& c) {
    if (blockIdx.x >= NH) return;
    const int h = blockIdx.x, lane = c.lane, wv = c.wave, fr = lane & 15, fq = lane >> 4, m = wv >> 1, n0 = 32 * (wv & 1);
    const int boff = (n0 + fr) * 64 + 8 * fq, qtoff = (n0 + fr) * 64 + 16 * m + 4 * fq;
    LAS3 unsigned char* L = (LAS3 unsigned char*)c.lds;
    const bf16* LP = (const bf16*)(a.ws + WS_ST) + ST_LP_OFF + (size_t)h * NCH * 4096; const bf16* QT = (const bf16*)(a.ws + WS_ST) + ST_QB_OFF + (size_t)h * NCH * 4096;
    bf16* SG = (bf16*)(a.ws + WS_SG) + (size_t)h * NG * 4096;
    for (int i = c.tid; i < 2 * HI_BYTES / 4; i += NTHREADS) ((LAS3 unsigned*)L)[i] = 0u;
    for (int i = c.tid; i < 4096 / 2; i += NTHREADS) ((LAS3 unsigned*)(L + 2 * HI_BYTES))[i] = 0u;
    __syncthreads();
    HFrag f0, f1, f2, f3;
#define SC2B_CH(g) ((size_t)((g) * GS + GS - 1) * 4096)
    hload(f0, LP + SC2B_CH(0), QT + SC2B_CH(0), boff, qtoff); hload(f1, LP + SC2B_CH(1), QT + SC2B_CH(1), boff, qtoff); hload(f2, LP + SC2B_CH(2), QT + SC2B_CH(2), boff, qtoff); hload(f3, LP + SC2B_CH(3), QT + SC2B_CH(3), boff, qtoff);
    LAS3 unsigned char* i0 = L; LAS3 unsigned char* i1 = L + HI_BYTES;
#define SC2B_STEP(f, g, ic, in) do { f32x4 acc[2] = {bf4cvt(f.q[0]), bf4cvt(f.q[1])}; hmma(ic, f.b, acc, m, fr, fq); LAS3 bf16* So = (LAS3 bf16*)(L + 2 * HI_BYTES) + (((g) + 1) & 7) * 4096; \
        _Pragma("unroll") for (int n = 0; n < 2; ++n) _Pragma("unroll") for (int i = 0; i < 4; ++i) So[(16 * m + 4 * fq + i) * 64 + n0 + 16 * n + fr] = f2bf(acc[n][i]); \
        himg_store(in, acc, m, n0, fr, fq); HBAR(); } while (0)
#pragma unroll 1
    for (int g = 0; g < NG; g += 4) {
        const int nx = (g + 4 < NG) ? g + 4 : g;
        SC2B_STEP(f0, g + 0, i0, i1); hload(f0, LP + SC2B_CH(nx + 0), QT + SC2B_CH(nx + 0), boff, qtoff);
        SC2B_STEP(f1, g + 1, i1, i0); hload(f1, LP + SC2B_CH(nx + 1), QT + SC2B_CH(nx + 1), boff, qtoff);
        SC2B_STEP(f2, g + 2, i0, i1); hload(f2, LP + SC2B_CH(nx + 2), QT + SC2B_CH(nx + 2), boff, qtoff);
        if ((g & 7) == 4) {
            for (int i = c.tid; i < 8 * 4096 / 8; i += NTHREADS) ((u32x4*)(SG + (size_t)(g >> 3) * 8 * 4096))[i] = ((const LAS3 u32x4*)(L + 2 * HI_BYTES))[i];
            HBAR(); }
        if (g + 3 < NG - 1) SC2B_STEP(f3, g + 3, i1, i0);
        hload(f3, LP + SC2B_CH(nx + 3), QT + SC2B_CH(nx + 3), boff, qtoff);
    }
#undef SC2B_STEP
#undef SC2B_CH
}
__device__ __forceinline__ void phase_scan2c(ArgsR a, const Ctx& c) {
    const int lane = c.lane, wv = c.wave, fr = lane & 15, fq = lane >> 4, m = wv >> 1, n0 = 32 * (wv & 1);
    const int boff = (n0 + fr) * 64 + 8 * fq, qtoff = (n0 + fr) * 64 + 16 * m + 4 * fq;
    LAS3 unsigned char* L = (LAS3 unsigned char*)c.lds;
    for (int item = blockIdx.x; item < NH * NG * 2; item += gridDim.x) {
        const int hg = item >> 1, hf = item & 1;
        const size_t cb = (size_t)(hg / NG) * NCH + (size_t)(hg % NG) * GS + hf * 8;
        const bf16* LP = (const bf16*)(a.ws + WS_ST) + ST_LP_OFF + cb * 4096; const bf16* QT = (const bf16*)(a.ws + WS_ST) + ST_QB_OFF + cb * 4096; bf16* SS = (bf16*)(a.ws + WS_ST) + cb * 4096;
        { const u32x4 v = *(const u32x4*)((const bf16*)(a.ws + WS_SG) + (size_t)hg * 4096 + c.tid * 8); *(LAS3 u32x4*)(L + ((c.tid >> 3) * HI_LD + (c.tid & 7) * 8) * 2) = v; }
        __syncthreads();
#pragma unroll 2
        for (int i = 0; i < 8; ++i) { HFrag f; hload(f, LP + (size_t)i * 4096, QT + (size_t)i * 4096, boff, qtoff);
            f32x4 acc[2] = {bf4cvt(f.q[0]), bf4cvt(f.q[1])}; hmma(L, f.b, acc, m, fr, fq); bf16* So = SS + (size_t)i * 4096;
#pragma unroll
            for (int n = 0; n < 2; ++n)
#pragma unroll
                for (int k = 0; k < 4; ++k) So[(16 * m + 4 * fq + k) * 64 + n0 + 16 * n + fr] = f2bf(acc[n][k]); }
        __syncthreads();
    }
}
constexpr int WI_LD = 72, WI_B = 64 * WI_LD * 2, WI_GAM = 9 * WI_B, WI_GL = 15 * WI_B;
constexpr size_t WS_GM0 = 352 * MiB, WS_GM1 = 180 * MiB, WS_Y0 = 336 * MiB, WS_END2 = 360 * MiB;
__device__ __forceinline__ bf16* gm_ptr(unsigned char* ws, int h, int ch) { return (bf16*)(ws + (h < 4 ? WS_GM0 : WS_GM1)) + (size_t)((h & 3) * NCH + ch) * 4096; }
__device__ __forceinline__ void wi_mma(f32x4 (&acc)[2], const LAS3 unsigned char* A, const LAS3 unsigned char* Bt, int m, int n0, int fr, int fq) {
#pragma unroll
    for (int ks = 0; ks < 2; ++ks) { const bf16x8 av = *(const LAS3 bf16x8*)(A + ((16 * m + fr) * WI_LD + 32 * ks + 8 * fq) * 2);
#pragma unroll
        for (int n = 0; n < 2; ++n) { const bf16x8 bv = *(const LAS3 bf16x8*)(Bt + ((n0 + 16 * n + fr) * WI_LD + 32 * ks + 8 * fq) * 2); acc[n] = __builtin_amdgcn_mfma_f32_16x16x32_bf16(av, bv, acc[n], 0, 0, 0); } }
}
struct WiA { bf16x8 a[2]; }; struct WiB { bf16x8 b[2][2]; };
__device__ __forceinline__ void wi_lda(WiA& f, const LAS3 unsigned char* A, int m, int fr, int fq) {
#pragma unroll
    for (int ks = 0; ks < 2; ++ks) f.a[ks] = *(const LAS3 bf16x8*)(A + ((16 * m + fr) * WI_LD + 32 * ks + 8 * fq) * 2);
}
__device__ __forceinline__ void wi_ldb(WiB& f, const LAS3 unsigned char* Bt, int n0, int fr, int fq) {
#pragma unroll
    for (int ks = 0; ks < 2; ++ks)
#pragma unroll
        for (int n = 0; n < 2; ++n) f.b[ks][n] = *(const LAS3 bf16x8*)(Bt + ((n0 + 16 * n + fr) * WI_LD + 32 * ks + 8 * fq) * 2);
}
__device__ __forceinline__ void wi_fma(f32x4 (&acc)[2], const WiA& A, const WiB& B) {
#pragma unroll
    for (int ks = 0; ks < 2; ++ks)
#pragma unroll
        for (int n = 0; n < 2; ++n) acc[n] = __builtin_amdgcn_mfma_f32_16x16x32_bf16(A.a[ks], B.b[ks][n], acc[n], 0, 0, 0);
}
__device__ __forceinline__ void wi_fma_s(f32x4 (&acc)[2], const WiA& A, const WiB& B) {
#pragma unroll
    for (int ks = 0; ks < 2; ++ks)
#pragma unroll
        for (int n = 0; n < 2; ++n) acc[n] = __builtin_amdgcn_mfma_f32_16x16x32_bf16(B.b[ks][n], A.a[ks], acc[n], 0, 0, 0);
}
__device__ __forceinline__ void wi_st_nat_s(LAS3 unsigned char* X, const f32x4 (&acc)[2], int m, int n0, int fr, int fq) {
#pragma unroll
    for (int n = 0; n < 2; ++n) { u32x2 w; w.x = pk2(acc[n][0], acc[n][1]); w.y = pk2(acc[n][2], acc[n][3]); *(LAS3 u32x2*)(X + ((16 * m + fr) * WI_LD + n0 + 16 * n + 4 * fq) * 2) = w; }
}
__device__ __forceinline__ void wi_ld_nat_s(f32x4 (&acc)[2], const LAS3 unsigned char* X, int m, int n0, int fr, int fq) {
#pragma unroll
    for (int n = 0; n < 2; ++n) { const u32x2 w = *(const LAS3 u32x2*)(X + ((16 * m + fr) * WI_LD + n0 + 16 * n + 4 * fq) * 2);
        acc[n][0] = __uint_as_float(w.x << 16); acc[n][1] = __uint_as_float(w.x & 0xffff0000u); acc[n][2] = __uint_as_float(w.y << 16); acc[n][3] = __uint_as_float(w.y & 0xffff0000u); }
}
__device__ __forceinline__ void wi_ld_tr(f32x4 (&acc)[2], const LAS3 unsigned char* XT, int m, int n0, int fr, int fq) {
#pragma unroll
    for (int n = 0; n < 2; ++n) { const u32x2 w = *(const LAS3 u32x2*)(XT + ((n0 + 16 * n + fr) * WI_LD + 16 * m + 4 * fq) * 2);
        acc[n][0] = __uint_as_float(w.x << 16); acc[n][1] = __uint_as_float(w.x & 0xffff0000u); acc[n][2] = __uint_as_float(w.y << 16); acc[n][3] = __uint_as_float(w.y & 0xffff0000u); }
}
#define WI_PIN() __builtin_amdgcn_sched_barrier(0)
__device__ __forceinline__ void wi_st_nat(LAS3 unsigned char* X, const f32x4 (&acc)[2], int m, int n0, int fr, int fq) {
#pragma unroll
    for (int n = 0; n < 2; ++n)
#pragma unroll
        for (int i = 0; i < 4; ++i) *(LAS3 bf16*)(X + ((16 * m + 4 * fq + i) * WI_LD + n0 + 16 * n + fr) * 2) = f2bf(acc[n][i]);
}
__device__ __forceinline__ void wi_st_tr(LAS3 unsigned char* XT, const f32x4 (&acc)[2], int m, int n0, int fr, int fq) {
#pragma unroll
    for (int n = 0; n < 2; ++n) { u32x2 w; w.x = pk2(acc[n][0], acc[n][1]); w.y = pk2(acc[n][2], acc[n][3]); *(LAS3 u32x2*)(XT + ((n0 + 16 * n + fr) * WI_LD + 16 * m + 4 * fq) * 2) = w; }
}
__device__ __forceinline__ void wi_ld_nat(f32x4 (&acc)[2], const LAS3 unsigned char* X, int m, int n0, int fr, int fq) {
#pragma unroll
    for (int n = 0; n < 2; ++n)
#pragma unroll
        for (int i = 0; i < 4; ++i) acc[n][i] = bf2f(*(const LAS3 bf16*)(X + ((16 * m + 4 * fq + i) * WI_LD + n0 + 16 * n + fr) * 2));
}
template <int X>
__device__ __forceinline__ void phase_scan1m(ArgsR a, const Ctx& c) {
    const f16* WM1 = (const f16*)(a.ws + WS_WM1); const f16* KP = (const f16*)(a.ws + WS_KP);
    const f16* AA = (const f16*)(a.ws + WS_AA); const f16* BB = (const f16*)(a.ws + WS_BB); const f16* V = (const f16*)(a.ws + WS_V); const f16* R = (const f16*)(a.ws + WS_R);
    float* ST = (float*)(a.ws + WS_ST);
    LAS3 unsigned char* L = (LAS3 unsigned char*)c.lds;
    LAS3 float* GAM = (LAS3 float*)(L + WI_GAM); LAS3 float* GL = (LAS3 float*)(L + WI_GL);
    const int lane = c.lane, wv = c.wave, fr = lane & 15, fq = lane >> 4, m = wv >> 1, n0 = 32 * (wv & 1), tid = c.tid;
#define SLOT(i) (L + (i) * WI_B)
    const int t = tid >> 3, cc = (tid & 7) * 8;
    f16x8 pav, pbv, pkv, pvv, prv, pwv;
#define WI_FETCH(it) do { const int h_ = (it) / NCH, ch_ = (it) % NCH; const size_t eo_ = (size_t)(ch_ * CL + t) * W + h_ * 64 + cc; \
        if (X == 2) { const f16x8 cz_ = {(f16)0.01f, (f16)0.02f, (f16)0.01f, (f16)0.03f, (f16)0.01f, (f16)0.02f, (f16)0.01f, (f16)0.03f}; pav = cz_; pbv = cz_; pkv = cz_; pvv = cz_; prv = cz_; pwv = -cz_; } else { \
        pav = *(const f16x8*)(AA + eo_); pbv = *(const f16x8*)(BB + eo_); pkv = *(const f16x8*)(KP + eo_); pvv = *(const f16x8*)(V + eo_); prv = *(const f16x8*)(R + eo_); pwv = *(const f16x8*)(WM1 + eo_); } } while (0)
    if (blockIdx.x < NH * NCH) WI_FETCH(blockIdx.x);
    for (int item = blockIdx.x; item < NH * NCH; item += gridDim.x) {
        const int h = item / NCH, ch = item % NCH;
        const f16x8 av = pav, bv = pbv, kv = pkv, vv = pvv, rv = prv, wv8 = pwv;
        if (item + (int)gridDim.x < NH * NCH) WI_FETCH(item + (int)gridDim.x);
        float g[8], gp[8];
        { float wloc[8];
#pragma unroll
          for (int e = 0; e < 8; ++e) wloc[e] = 1.0f + (float)wv8[e];
#pragma unroll
          for (int e = 0; e < 8; ++e) { float x = wloc[e];
              { const float y = __shfl_up(x, 8); if (lane >= 8) x *= y; } { const float y = __shfl_up(x, 16); if (lane >= 16) x *= y; } { const float y = __shfl_up(x, 32); if (lane >= 32) x *= y; }
              g[e] = x; }
          if (lane >= 56) {
#pragma unroll
              for (int e = 0; e < 8; ++e) GAM[wv * 64 + cc + e] = g[e]; }
          HBAR();
#pragma unroll
          for (int e = 0; e < 8; ++e) { float pre = 1.0f;
#pragma unroll
              for (int w = 0; w < 7; ++w) if (w < wv) pre *= GAM[w * 64 + cc + e];
              g[e] *= pre; gp[e] = g[e] * __builtin_amdgcn_rcpf(wloc[e]); } }
        { float fa[8], fb[8], fk[8], fv[8], frr[8];
#pragma unroll
          for (int e = 0; e < 8; ++e) { const float ig = __builtin_amdgcn_rcpf(g[e]);
              fa[e] = (float)av[e] * gp[e]; fb[e] = (float)bv[e] * ig; fk[e] = (float)kv[e] * ig; fv[e] = (float)vv[e]; frr[e] = (float)rv[e] * g[e]; if (t == 63) GL[cc + e] = g[e]; }
          *(LAS3 u32x4*)(SLOT(0) + (t * WI_LD + cc) * 2) = pack8bf(fa); *(LAS3 u32x4*)(SLOT(2) + (t * WI_LD + cc) * 2) = pack8bf(fb); *(LAS3 u32x4*)(SLOT(4) + (t * WI_LD + cc) * 2) = pack8bf(fk); *(LAS3 u32x4*)(SLOT(12) + (t * WI_LD + cc) * 2) = pack8bf(frr);
          *(LAS3 u32x4*)(SLOT(10) + (t * WI_LD + cc) * 2) = pack8bf(fv); }
        HBAR();
        { WiA aB, aK; WiB bA, bR; wi_lda(aB, SLOT(2), m, fr, fq); wi_lda(aK, SLOT(4), m, fr, fq); wi_ldb(bA, SLOT(0), n0, fr, fq); wi_ldb(bR, SLOT(12), n0, fr, fq);
          const int tch = tid & 63, tt0 = (tid >> 6) * 8; bf16 ta[8], tb[8], tv[8];
#pragma unroll
          for (int e = 0; e < 8; ++e) { ta[e] = *(const LAS3 bf16*)(SLOT(0) + ((tt0 + e) * WI_LD + tch) * 2); tb[e] = *(const LAS3 bf16*)(SLOT(2) + ((tt0 + e) * WI_LD + tch) * 2); tv[e] = *(const LAS3 bf16*)(SLOT(10) + ((tt0 + e) * WI_LD + tch) * 2); }
          WI_PIN();
          { u32x4 wa, wb, wv4;
#pragma unroll
            for (int e = 0; e < 4; ++e) { wa[e] = (unsigned)ta[2 * e] | ((unsigned)ta[2 * e + 1] << 16); wb[e] = (unsigned)tb[2 * e] | ((unsigned)tb[2 * e + 1] << 16); wv4[e] = (unsigned)tv[2 * e] | ((unsigned)tv[2 * e + 1] << 16); }
            *(LAS3 u32x4*)(SLOT(1) + (tch * WI_LD + tt0) * 2) = wa; *(LAS3 u32x4*)(SLOT(3) + (tch * WI_LD + tt0) * 2) = wb; *(LAS3 u32x4*)(SLOT(5) + (tch * WI_LD + tt0) * 2) = wv4; }
          f32x4 ans[2] = {{0.f, 0.f, 0.f, 0.f}, {0.f, 0.f, 0.f, 0.f}}, ant[2] = {{0.f, 0.f, 0.f, 0.f}, {0.f, 0.f, 0.f, 0.f}}, aks[2] = {{0.f, 0.f, 0.f, 0.f}, {0.f, 0.f, 0.f, 0.f}}, am[2] = {{0.f, 0.f, 0.f, 0.f}, {0.f, 0.f, 0.f, 0.f}}, amk[2] = {{0.f, 0.f, 0.f, 0.f}, {0.f, 0.f, 0.f, 0.f}};
          wi_fma_s(ans, aB, bA); wi_fma(ant, aB, bA); wi_fma_s(aks, aK, bA); wi_fma(am, aB, bR); wi_fma(amk, aK, bR);
          WI_PIN();
          f32x4 axs[2];
#pragma unroll
          for (int n = 0; n < 2; ++n)
#pragma unroll
              for (int i = 0; i < 4; ++i) { const int rs = 16 * m + fr, cs = n0 + 16 * n + 4 * fq + i;
                  if (!(rs < cs)) { ans[n][i] = 0.f; aks[n][i] = 0.f; } axs[n][i] = ans[n][i] + (rs == cs ? 1.0f : 0.f);
                  const int rn = 16 * m + 4 * fq + i, cn = n0 + 16 * n + fr;
                  if (!(rn < cn)) ant[n][i] = 0.f; if (rn > cn) { am[n][i] = 0.f; amk[n][i] = 0.f; } }
          wi_st_nat_s(SLOT(7), ans, m, n0, fr, fq); wi_st_tr(SLOT(8), ant, m, n0, fr, fq); wi_st_nat_s(SLOT(6), aks, m, n0, fr, fq); wi_st_nat_s(SLOT(11), axs, m, n0, fr, fq);
          wi_st_tr(SLOT(13), am, m, n0, fr, fq); wi_st_tr(SLOT(14), amk, m, n0, fr, fq); }
        HBAR();
        { WiA aN; WiB bN; wi_lda(aN, SLOT(7), m, fr, fq); wi_ldb(bN, SLOT(8), n0, fr, fq); WI_PIN();
          f32x4 a2s[2] = {{0.f, 0.f, 0.f, 0.f}, {0.f, 0.f, 0.f, 0.f}}, a2t[2] = {{0.f, 0.f, 0.f, 0.f}, {0.f, 0.f, 0.f, 0.f}}; wi_fma_s(a2s, aN, bN); wi_fma(a2t, aN, bN); WI_PIN();
          wi_st_nat_s(SLOT(9), a2s, m, n0, fr, fq); wi_st_tr(SLOT(10), a2t, m, n0, fr, fq); }
        HBAR();
#define WI_LEVEL(XS, XD, NS, NST, ND, NDT) do { WiA aX, aN; WiB bN; f32x4 ax[2]; wi_lda(aX, SLOT(XS), m, fr, fq); wi_ldb(bN, SLOT(NST), n0, fr, fq); wi_lda(aN, SLOT(NS), m, fr, fq); wi_ld_nat_s(ax, SLOT(XS), m, n0, fr, fq); \
            WI_PIN(); f32x4 aqs[2] = {{0.f, 0.f, 0.f, 0.f}, {0.f, 0.f, 0.f, 0.f}}, aqt[2] = {{0.f, 0.f, 0.f, 0.f}, {0.f, 0.f, 0.f, 0.f}}; wi_fma_s(ax, aX, bN); wi_fma_s(aqs, aN, bN); wi_fma(aqt, aN, bN); WI_PIN(); \
            wi_st_nat_s(SLOT(XD), ax, m, n0, fr, fq); wi_st_nat_s(SLOT(ND), aqs, m, n0, fr, fq); wi_st_tr(SLOT(NDT), aqt, m, n0, fr, fq); \
            HBAR(); } while (0)
        if (X != 3) {
        WI_LEVEL(11, 0, 9, 10, 7, 8);
        WI_LEVEL(0, 11, 7, 8, 9, 10);
        WI_LEVEL(11, 0, 9, 10, 7, 8);
        WI_LEVEL(0, 11, 7, 8, 9, 10);
        }
#undef WI_LEVEL
        { WiA aX; WiB bN; f32x4 ax[2]; wi_lda(aX, SLOT(11), m, fr, fq); wi_ldb(bN, SLOT(10), n0, fr, fq); wi_ld_nat(ax, SLOT(11), m, n0, fr, fq); WI_PIN();
          wi_fma(ax, aX, bN); WI_PIN(); wi_st_tr(SLOT(0), ax, m, n0, fr, fq); }
        HBAR();
        { WiA aNk, aAt; WiB bT; wi_lda(aNk, SLOT(6), m, fr, fq); wi_lda(aAt, SLOT(1), m, fr, fq); wi_ldb(bT, SLOT(0), n0, fr, fq); WI_PIN();
          f32x4 aw[2] = {{0.f, 0.f, 0.f, 0.f}, {0.f, 0.f, 0.f, 0.f}}, aa[2] = {{0.f, 0.f, 0.f, 0.f}, {0.f, 0.f, 0.f, 0.f}}; wi_fma_s(aw, aNk, bT); wi_fma_s(aa, aAt, bT); WI_PIN();
          wi_st_nat_s(SLOT(2), aw, m, n0, fr, fq); wi_st_nat_s(SLOT(7), aa, m, n0, fr, fq); }
        HBAR();
        { WiA aAT, aW1; WiB bB, bM; f32x4 ap[2] = {{0.f, 0.f, 0.f, 0.f}, {0.f, 0.f, 0.f, 0.f}}, az[2], ag[2], az2[2]; float gl[2];
          wi_lda(aAT, SLOT(7), m, fr, fq); wi_lda(aW1, SLOT(2), m, fr, fq); wi_ldb(bB, SLOT(3), n0, fr, fq); wi_ldb(bM, SLOT(13), n0, fr, fq);
          wi_ld_nat(az, SLOT(4), m, n0, fr, fq); wi_ld_tr(az2, SLOT(14), m, n0, fr, fq); wi_ld_tr(ag, SLOT(12), m, n0, fr, fq);
#pragma unroll
          for (int n = 0; n < 2; ++n) gl[n] = GL[n0 + 16 * n + fr];
          WI_PIN();
          wi_fma(ap, aAT, bB); wi_fma(az, aW1, bB); wi_fma(ag, aAT, bM); wi_fma(az2, aW1, bM);
          WI_PIN();
          wi_st_tr(SLOT(8), az, m, n0, fr, fq); wi_st_tr(SLOT(9), az2, m, n0, fr, fq);
          bf16* PTp = (bf16*)ST + (size_t)(h * NCH + ch) * 4096; bf16* GMp = gm_ptr(a.ws, h, ch);
#pragma unroll
          for (int n = 0; n < 2; ++n) { const int col = n0 + 16 * n + fr; f32x4 pv = ap[n];
#pragma unroll
              for (int i = 0; i < 4; ++i) { if (16 * m + 4 * fq + i == col) pv[i] += 1.0f; pv[i] *= gl[n]; }
              u32x2 w; w.x = pk2(pv[0], pv[1]); w.y = pk2(pv[2], pv[3]); if (X != 1 || pv[0] == 1234.5f) *(u32x2*)(PTp + col * 64 + 16 * m + 4 * fq) = w;
              u32x2 w2; w2.x = pk2(ag[n][0], ag[n][1]); w2.y = pk2(ag[n][2], ag[n][3]); if (X != 1 || pv[0] == 1234.5f) *(u32x2*)(GMp + col * 64 + 16 * m + 4 * fq) = w2; } }
        HBAR();
        { WiA aV; WiB bZ1, bZ2; float gl[2]; wi_lda(aV, SLOT(5), m, fr, fq); wi_ldb(bZ1, SLOT(8), n0, fr, fq); wi_ldb(bZ2, SLOT(9), n0, fr, fq); gl[0] = GL[n0 + fr]; gl[1] = GL[n0 + 16 + fr]; WI_PIN();
          f32x4 aq[2] = {{0.f, 0.f, 0.f, 0.f}, {0.f, 0.f, 0.f, 0.f}}, ay[2] = {{0.f, 0.f, 0.f, 0.f}, {0.f, 0.f, 0.f, 0.f}}; wi_fma(aq, aV, bZ1); wi_fma(ay, aV, bZ2); WI_PIN();
          bf16* QTp = (bf16*)ST + ST_QB_OFF + (size_t)(h * NCH + ch) * 4096; bf16* Y0p = (bf16*)(a.ws + WS_Y0) + (size_t)(h * NCH + ch) * 4096;
#pragma unroll
          for (int n = 0; n < 2; ++n) { const int col = n0 + 16 * n + fr; if (X != 1 || aq[n][0] == 1234.5f) store4bf(QTp + col * 64 + 16 * m + 4 * fq, aq[n] * gl[n]);
              u32x2 w; w.x = pk2(ay[n][0], ay[n][1]); w.y = pk2(ay[n][2], ay[n][3]); if (X != 1 || aq[n][0] == 1234.5f) *(u32x2*)(Y0p + col * 64 + 16 * m + 4 * fq) = w; } }
        HBAR();
    }
#undef SLOT
#undef WI_FETCH
}

template <int X>
__device__ __forceinline__ void phase_scan3m(ArgsR a, const Ctx& c, int l) {
    const f16* R = (const f16*)(a.ws + WS_R); const f16* KP = (const f16*)(a.ws + WS_KP); const f16* V = (const f16*)(a.ws + WS_V); const bf16* G = (const bf16*)(a.ws + WS_G);
    bf16* YA = (bf16*)(a.ws + WS_YAB);
    LAS3 unsigned char* L = (LAS3 unsigned char*)c.lds;
    LAS3 float* YL = (LAS3 float*)(L + WI_B);
    LAS3 unsigned char* S0I = L + 3 * WI_B;
    const int lane = c.lane, wv = c.wave, fr = lane & 15, fq = lane >> 4, m = wv >> 1, n0 = 32 * (wv & 1), tid = c.tid;
    LAS3 unsigned char* LPI = L + 4 * WI_B; LAS3 unsigned char* LQI = L + 5 * WI_B; LAS3 unsigned char* GMI = L + 6 * WI_B; LAS3 unsigned char* Y0I = L + 7 * WI_B;
    const int ioff = ((tid >> 3) * WI_LD + (tid & 7) * 8) * 2;
    u32x4 pS, pL, pQ, pB, pY;
#define S3_FETCH(it) do { const int h_ = (it) / NCH, ch_ = (it) % NCH; pS = (u32x4){0u, 0u, 0u, 0u}; pL = pS; pQ = pS; \
        if (X != 2 && ch_ > 0) { const int c1_ = ch_ - 1; pS = *(const u32x4*)((const bf16*)(a.ws + WS_SG) + (size_t)(h_ * NG + c1_ / GS) * 4096 + tid * 8); \
            pL = *(const u32x4*)((const bf16*)(a.ws + WS_ST) + ST_LP_OFF + (size_t)(h_ * NCH + c1_) * 4096 + tid * 8); pQ = *(const u32x4*)((const bf16*)(a.ws + WS_ST) + ST_QB_OFF + (size_t)(h_ * NCH + c1_) * 4096 + tid * 8); } \
        pB = X == 2 ? (u32x4){1u, 2u, 3u, 4u} : *(const u32x4*)(gm_ptr(a.ws, h_, ch_) + tid * 8); pY = X == 2 ? (u32x4){1u, 2u, 3u, 4u} : *(const u32x4*)((const bf16*)(a.ws + WS_Y0) + (size_t)(h_ * NCH + ch_) * 4096 + tid * 8); } while (0)
    if (blockIdx.x < NH * NCH) S3_FETCH(blockIdx.x);
    for (int item = blockIdx.x; item < NH * NCH; item += gridDim.x) {
        const int h = item / NCH, ch = item % NCH;
        *(LAS3 u32x4*)(L + ioff) = pS; *(LAS3 u32x4*)(LPI + ioff) = pL; *(LAS3 u32x4*)(LQI + ioff) = pQ; *(LAS3 u32x4*)(GMI + ioff) = pB; *(LAS3 u32x4*)(Y0I + ioff) = pY;
        if (item + (int)gridDim.x < NH * NCH) S3_FETCH(item + (int)gridDim.x);
        const int et = 8 * wv + (lane >> 3), ec = 8 * (lane & 7);
        const size_t eo = (size_t)(ch * CL + et) * W + h * 64 + ec;
        const f16x8 cz_ = {1, 1, 1, 1, 1, 1, 1, 1}; const f16x8 ev = X ? cz_ : *(const f16x8*)(V + eo); const float ebon = X ? 1.f : ((const float*)(a.ws + WS_BON))[(size_t)(ch * CL + et) * 8 + h]; const u32x4 eg = X ? (u32x4){1u, 1u, 1u, 1u} : *(const u32x4*)(G + eo);
        const float* gngp = a.in[I_GNG] + l * W + h * 64 + ec; const float* gnbp = a.in[I_GNB] + l * W + h * 64 + ec;
        const f32x4 gg0 = *(const f32x4*)gngp, gg1 = *(const f32x4*)(gngp + 4), gb0 = *(const f32x4*)gnbp, gb1 = *(const f32x4*)(gnbp + 4);
        if (X != 3) { HBAR();
        { bf16x8 lfr[2][2]; f32x4 as0[2];
#pragma unroll
          for (int ks = 0; ks < 2; ++ks)
#pragma unroll
              for (int n = 0; n < 2; ++n) lfr[ks][n] = *(const LAS3 bf16x8*)(LPI + ((n0 + 16 * n + fr) * WI_LD + 32 * ks + 8 * fq) * 2);
#pragma unroll
          for (int n = 0; n < 2; ++n) as0[n] = bf4cvt(*(const LAS3 u32x2*)(LQI + ((n0 + 16 * n + fr) * WI_LD + 16 * m + 4 * fq) * 2));
          hmma(L, lfr, as0, m, fr, fq);
          himg_store(S0I, as0, m, n0, fr, fq); }
        HBAR(); }
        f32x4 acc[2];
        { bf16x8 bfr[2][2];
#pragma unroll
          for (int ks = 0; ks < 2; ++ks)
#pragma unroll
              for (int n = 0; n < 2; ++n) bfr[ks][n] = *(const LAS3 bf16x8*)(GMI + ((n0 + 16 * n + fr) * WI_LD + 32 * ks + 8 * fq) * 2);
#pragma unroll
          for (int n = 0; n < 2; ++n) acc[n] = bf4cvt(*(const LAS3 u32x2*)(Y0I + ((n0 + 16 * n + fr) * WI_LD + 16 * m + 4 * fq) * 2));
#pragma unroll
          for (int ks = 0; ks < 2; ++ks) { const bf16x8 av = *(const LAS3 bf16x8*)(S0I + ((16 * m + fr) * WI_LD + 32 * ks + 8 * fq) * 2);
#pragma unroll
              for (int n = 0; n < 2; ++n) acc[n] = __builtin_amdgcn_mfma_f32_16x16x32_bf16(av, bfr[ks][n], acc[n], 0, 0, 0); } }
#pragma unroll
        for (int n = 0; n < 2; ++n) *(LAS3 f32x4*)(YL + (n0 + 16 * n + fr) * 68 + 16 * m + 4 * fq) = acc[n];
        HBAR();
        { const f32x4 y0 = *(const LAS3 f32x4*)(YL + et * 68 + ec), y1 = *(const LAS3 f32x4*)(YL + et * 68 + ec + 4);
          float yy[8], gg[8], gb[8], go[8]; float s1 = 0.f;
#pragma unroll
          for (int j = 0; j < 8; ++j) { yy[j] = j < 4 ? y0[j & 3] : y1[j & 3]; gg[j] = j < 4 ? gg0[j & 3] : gg1[j & 3]; gb[j] = j < 4 ? gb0[j & 3] : gb1[j & 3];
              s1 += yy[j]; }
#pragma unroll
          for (int j = 0; j < 4; ++j) { go[2 * j] = __uint_as_float(eg[j] << 16); go[2 * j + 1] = __uint_as_float(eg[j] & 0xffff0000u); }
          const float mean = group_sum8(s1) * (1.f / 64.f); float q = 0.f;
#pragma unroll
          for (int j = 0; j < 8; ++j) { yy[j] -= mean; q += yy[j] * yy[j]; }
          const float rs = __builtin_amdgcn_rsqf(group_sum8(q) * (1.f / 64.f) + GN_EPS); const float bonus = ebon;
          float o8[8];
#pragma unroll
          for (int j = 0; j < 8; ++j) o8[j] = (yy[j] * rs * gg[j] + gb[j] + bonus * (float)ev[j]) * go[j];
          if (X != 1 || o8[0] == 1234.5f) store16_wt(a.ws, YA + (size_t)(ch * CL + et) * 1024 + h * 64 + ec, pack8bf(o8)); }
    }
    HBAR();
#undef S3_FETCH
}

__device__ __forceinline__ void phase_scan3(ArgsR a, const Ctx& c, int l) {
    const f16* R = (const f16*)(a.ws + WS_R); const f16* WM1 = (const f16*)(a.ws + WS_WM1); const f16* KP = (const f16*)(a.ws + WS_KP);
    const f16* AA = (const f16*)(a.ws + WS_AA); const f16* BB = (const f16*)(a.ws + WS_BB); const f16* V = (const f16*)(a.ws + WS_V);
    const float* ST = (const float*)(a.ws + WS_ST); bf16* YA = (bf16*)(a.ws + WS_YA); const f16* Gs = (const f16*)(a.ws + WS_G);
    const int lane = c.lane;
    LAS3 unsigned char* ring = (LAS3 unsigned char*)c.lds + c.wave * SC_WAVE;
    for (int item = c.gw; item < NH * NCH; item += c.ngw) {
        const int h = __builtin_amdgcn_readfirstlane(item / NCH), ch = __builtin_amdgcn_readfirstlane(item % NCH);
        const size_t lane_off = (size_t)(lane >> 3) * W + h * 64 + (lane & 7) * 8;
        const float gn_g = a.in[I_GNG][l * W + h * 64 + lane], gn_b = a.in[I_GNB][l * W + h * 64 + lane], r_k = a.in[I_RK][l * W + h * 64 + lane];
        { const size_t e0 = (size_t)(ch * CL) * W + lane_off;
          sc_dma(AA, e0, ring); sc_dma(WM1, e0, ring + 1024); sc_dma(BB, e0, ring + 2048); sc_dma(KP, e0, ring + 3072); sc_dma(V, e0, ring + 4096); sc_dma(R, e0, ring + 5120); sc_dma(Gs, e0, ring + 6144); }
        float S[64];
        if (ch == 0) {
#pragma unroll
            for (int j = 0; j < 64; ++j) S[j] = 0.f;
        } else { const bf16* Sp = (const bf16*)ST + ((size_t)(h * NCH + ch - 1) * 64 + lane) * 64;
#pragma unroll
            for (int j = 0; j < 64; j += 4) { const f32x4 x = load4bf(Sp + j); S[j] = x[0]; S[j + 1] = x[1]; S[j + 2] = x[2]; S[j + 3] = x[3]; } }
#pragma unroll 1
        for (int blk = 0; blk < CL / SCB; ++blk) {
            LAS3 unsigned char* buf = ring + (blk & 1) * SC_BUF;
            if (blk + 1 < CL / SCB) { LAS3 unsigned char* nb = ring + ((blk + 1) & 1) * SC_BUF; const size_t e0 = (size_t)(ch * CL + (blk + 1) * SCB) * W + lane_off;
                sc_dma(AA, e0, nb); sc_dma(WM1, e0, nb + 1024); sc_dma(BB, e0, nb + 2048); sc_dma(KP, e0, nb + 3072); sc_dma(V, e0, nb + 4096); sc_dma(R, e0, nb + 5120); sc_dma(Gs, e0, nb + 6144);
                asm volatile("s_waitcnt vmcnt(7)" ::: "memory"); }
            else asm volatile("s_waitcnt vmcnt(0)" ::: "memory");
            SVec A, Wv, Bv, Kv, Rv;
            sv_cvt(A, sv_read(buf, lane)); sv_cvt1p(Wv, sv_read(buf + 1024, lane)); sv_cvt(Bv, sv_read(buf + 2048, lane)); sv_cvt(Kv, sv_read(buf + 3072, lane)); sv_cvt(Rv, sv_read(buf + 5120, lane));
            float vv = (float)*(const LAS3 f16*)(buf + 4096 + lane * 2);
#pragma unroll 1
            for (int st = 0; st < SCB; ++st) {
                const LAS3 unsigned char* sn = buf + ((st + 1 < SCB) ? st + 1 : st) * 128;
                const f16x4 ha = sv_read(sn, lane), hw = sv_read(sn + 1024, lane), hb = sv_read(sn + 2048, lane), hk = sv_read(sn + 3072, lane), hr = sv_read(sn + 5120, lane);
                const f16 hv = *(const LAS3 f16*)(sn + 4096 + lane * 2);
                float d[4] = {0.f, 0.f, 0.f, 0.f};
                sc_dot<0>(d, A, S);
                const float sa = (d[0] + d[1]) + (d[2] + d[3]);
                float y[4] = {0.f, 0.f, 0.f, 0.f};
                sc_upd3<0>(S, y, Wv, Bv, Kv, Rv, sa, vv);
                const float yy = (y[0] + y[1]) + (y[2] + y[3]);
                sv_cvt(A, ha); sv_cvt1p(Wv, hw); sv_cvt(Bv, hb); sv_cvt(Kv, hk); sv_cvt(Rv, hr); vv = (float)hv;
                { const LAS3 unsigned char* sb = buf + st * 128;
                  const float rl = (float)*(const LAS3 f16*)(sb + 5120 + lane * 2), kl = (float)*(const LAS3 f16*)(sb + 3072 + lane * 2), vl = (float)*(const LAS3 f16*)(sb + 4096 + lane * 2);
                  const float gl = bf2f(*(const LAS3 bf16*)(sb + 6144 + lane * 2));
                  const float mean = wave_sum(yy) * (1.f / 64.f); const float dd = yy - mean; const float var = wave_sum(dd * dd) * (1.f / 64.f);
                  const float bonus = wave_sum(rl * kl * r_k);
                  const float yn = dd * __builtin_amdgcn_rsqf(var + GN_EPS) * gn_g + gn_b + bonus * vl;
                  YA[(size_t)(ch * CL + blk * SCB + st) * W + h * 64 + lane] = f2bf(yn * gl); }
            }
        }
    }
}

__device__ __forceinline__ void phase_post(ArgsR a, const Ctx& c, int l) {
    const bf16* YSC = (const bf16*)(a.ws + WS_YSC); const f16* R = (const f16*)(a.ws + WS_R); const f16* KP = (const f16*)(a.ws + WS_KP); const f16* V = (const f16*)(a.ws + WS_V);
    const bf16* G = (const bf16*)(a.ws + WS_G); bf16* YA = (bf16*)(a.ws + WS_YA);
    const float* gng = a.in[I_GNG] + l * W; const float* gnb = a.in[I_GNB] + l * W; const float* rk = a.in[I_RK] + l * W;
    for (int t = c.gw; t < T; t += c.ngw) {
#pragma unroll
        for (int i = 0; i < 8; ++i) { const int n = c.lane + 64 * i; const size_t o = (size_t)t * W + n;
            const float y = bf2f(YSC[o]); const float mean = wave_sum(y) * (1.f / 64.f); const float d = y - mean; const float var = wave_sum(d * d) * (1.f / 64.f);
            float yn = d * __builtin_amdgcn_rsqf(var + GN_EPS) * gng[n] + gnb[n];
            const float r = (float)R[o], k = (float)KP[o], v = (float)V[o];
            const float bonus = wave_sum(r * k * rk[n]);
            yn += bonus * v;
            YA[o] = f2bf(yn * bf2f(G[o])); }
    }
}

__device__ __forceinline__ float ln1_reduce_scatter(const float (&lg)[16], int lane) {
    float r8[8], r4v[4], r2[2], r1;
    const bool b5 = (lane & 32) != 0, b4 = (lane & 16) != 0, b3 = (lane & 8) != 0, b2 = (lane & 4) != 0;
#pragma unroll
    for (int i = 0; i < 8; ++i) { const float snd = b5 ? lg[i] : lg[i + 8], kp = b5 ? lg[i + 8] : lg[i]; r8[i] = kp + __shfl_xor(snd, 32); }
#pragma unroll
    for (int i = 0; i < 4; ++i) { const float snd = b4 ? r8[i] : r8[i + 4], kp = b4 ? r8[i + 4] : r8[i]; r4v[i] = kp + __shfl_xor(snd, 16); }
#pragma unroll
    for (int i = 0; i < 2; ++i) { const float snd = b3 ? r4v[i] : r4v[i + 2], kp = b3 ? r4v[i + 2] : r4v[i]; r2[i] = kp + __shfl_xor(snd, 8); }
    { const float snd = b2 ? r2[0] : r2[1], kp = b2 ? r2[1] : r2[0]; r1 = kp + __shfl_xor(snd, 4); }
    r1 += __shfl_xor(r1, 2); r1 += __shfl_xor(r1, 1);
    return r1;
}
__device__ __forceinline__ void phase_ln1(ArgsR a, const Ctx& c, int l, float* outw, int mode = 3) {
    const float* MODF = (const float*)(a.ws + WS_MODF) + l * 6144;
    const float* g1 = a.in[I_LN1G] + l * D; const float* b1 = a.in[I_LN1B] + l * D;
    bf16* XN = (bf16*)(a.ws + WS_XN);
    int* TOKI = (int*)(a.ws + WS_TOKI); float* TOKW = (float*)(a.ws + WS_TOKW); int* TOKP = (int*)(a.ws + WS_TOKP);
    const float* rw = a.in[I_RW]; const float* rb = a.in[I_RB];
    LAS3 float* rwT = (LAS3 float*)((LAS3 unsigned char*)c.lds + 69632);
    constexpr int RW_LD = D + 4;
    unsigned* lcnt = (unsigned*)(c.lds + 135488);
    if (mode & 1) {
    for (int i = c.tid; i < D * NE; i += NTHREADS) { const int cidx = i >> 4; rwT[(i & 15) * RW_LD + 256 * (2 * (cidx >> 9) + ((cidx >> 2) & 1)) + 4 * ((cidx & 511) >> 3) + (cidx & 3)] = rw[i]; }
    if (c.tid < NE) lcnt[c.tid] = 0u;
    __syncthreads();
    const bf16* TMP = (const bf16*)(a.ws + WS_TMP);
    const float* xin = a.in[I_X]; const bf16* xinb = (const bf16*)a.out; bf16* outb = (bf16*)outw;
    float vn[16], xn[16];
#pragma unroll
    for (int j = 0; j < 16; ++j) { vn[j] = 0.01f * (float)(j + c.lane); xn[j] = 0.02f * (float)(j - c.lane); }
    if (!(mode & 8) && c.gw < T) { load_row16bf8(TMP + (size_t)c.gw * D, c.lane, vn); if (l == 0) load_row16f8(xin + (size_t)c.gw * D, c.lane, xn); else load_row16bf8(xinb + (size_t)c.gw * 2 * D, c.lane, xn); }
    LAS3 float* LG = (LAS3 float*)c.lds + c.wave * 128;
    int slot = 0;
    for (int m = c.gw; m < T; m += 2 * c.ngw, slot += 2) {
        float vv[2][16];
#pragma unroll
        for (int u = 0; u < 2; ++u) { const int mm = m + u * c.ngw;
            int l4 = 4 * c.lane; asm volatile("" : "+v"(l4));
            float v[16];
#pragma unroll
            for (int j = 0; j < 16; ++j) v[j] = ALPHA * xn[j] + vn[j];
            if (!(mode & 8) && mm + c.ngw < T) { load_row16bf8(TMP + (size_t)(mm + c.ngw) * D, c.lane, vn); if (l == 0) load_row16f8(xin + (size_t)(mm + c.ngw) * D, c.lane, xn); else load_row16bf8(xinb + (size_t)(mm + c.ngw) * 2 * D, c.lane, xn); }
            if (mm < T) {
            float mean, rstd; row_stats(v, mean, rstd);
#pragma unroll
            for (int j = 0; j < 4; ++j) { const int col = 2 * l4 + 512 * (j >> 1) + 4 * (j & 1);
#pragma unroll
                for (int e = 0; e < 4; ++e) v[4 * j + e] = (v[4 * j + e] - mean) * rstd * g1[col + e] + b1[col + e]; }
            if (!(mode & 16)) {
#pragma unroll
                for (int J = 0; J < 2; ++J) { float o[8];
#pragma unroll
                    for (int e = 0; e < 8; ++e) o[e] = v[8 * J + e];
                    __builtin_amdgcn_raw_buffer_store_b128(pack8bf(o), wt_rsrc(outb, (unsigned)T * D * 4u), (unsigned)(((size_t)mm * 2 * D + 2 * l4 + 512 * J) * 2), 0, 16); } }
            row_stats(v, mean, rstd);
#pragma unroll
            for (int j = 0; j < 4; ++j) { const int col = 2 * l4 + 512 * (j >> 1) + 4 * (j & 1);
#pragma unroll
                for (int e = 0; e < 4; ++e) v[4 * j + e] = (v[4 * j + e] - mean) * rstd * (1.0f + MODF[4096 + col + e]) + MODF[3072 + col + e]; }
            if (!(mode & 16)) {
#pragma unroll
                for (int J = 0; J < 2; ++J) { float o[8];
#pragma unroll
                    for (int e = 0; e < 8; ++e) o[e] = v[8 * J + e];
                    store16_wt(a.ws, XN + (size_t)mm * D + 2 * l4 + 512 * J, pack8bf(o)); } }
            }
#pragma unroll
            for (int j = 0; j < 16; ++j) vv[u][j] = v[j]; }
        if (!(mode & 4)) {
        int l4 = 4 * c.lane; asm volatile("" : "+v"(l4));
        float lg0[16], lg1[16];
        typedef float f32x2_t __attribute__((ext_vector_type(2)));
        f32x2_t vp[16];
#pragma unroll
        for (int j = 0; j < 16; ++j) vp[j] = (f32x2_t){vv[0][j], vv[1][j]};
#pragma unroll
        for (int e = 0; e < 16; ++e) { f32x2_t xa = {0.f, 0.f}, xb = {0.f, 0.f};
#pragma unroll
            for (int j = 0; j < 4; ++j) { const f32x4 r4 = *(const LAS3 f32x4*)(rwT + e * RW_LD + l4 + 256 * j);
                xa = __builtin_elementwise_fma(vp[4 * j], (f32x2_t){r4[0], r4[0]}, xa); xb = __builtin_elementwise_fma(vp[4 * j + 1], (f32x2_t){r4[1], r4[1]}, xb);
                xa = __builtin_elementwise_fma(vp[4 * j + 2], (f32x2_t){r4[2], r4[2]}, xa); xb = __builtin_elementwise_fma(vp[4 * j + 3], (f32x2_t){r4[3], r4[3]}, xb); }
            xa += xb; lg0[e] = xa.x; lg1[e] = xa.y;
            if ((e & 3) == 3) __builtin_amdgcn_sched_barrier(0); }
        const float r1a = ln1_reduce_scatter(lg0, c.lane), r1b = ln1_reduce_scatter(lg1, c.lane);
        if ((c.lane & 3) == 0) { LG[slot * 16 + (c.lane >> 2)] = r1a; LG[(slot + 1) * 16 + (c.lane >> 2)] = r1b; }
        }
    }
    if (!(mode & 4)) { const int m = c.gw + c.lane * c.ngw;
        if (c.lane < 8 && m < T) {
        float sc[16], sel[16];
#pragma unroll
        for (int q = 0; q < 4; ++q) { const f32x4 lq = *(const LAS3 f32x4*)(LG + c.lane * 16 + 4 * q);
#pragma unroll
            for (int e = 0; e < 4; ++e) { sc[4 * q + e] = __builtin_amdgcn_rcpf(1.0f + __expf(-lq[e])); sel[4 * q + e] = sc[4 * q + e] + rb[4 * q + e]; } }
        int best = 0; float bestv = -INFINITY;
#pragma unroll
        for (int g = 0; g < 4; ++g) { float m1 = -INFINITY, m2 = -INFINITY;
#pragma unroll
            for (int q = 0; q < 4; ++q) { const float sv = sel[4 * g + q]; if (sv > m1) { m2 = m1; m1 = sv; } else if (sv > m2) m2 = sv; }
            const float gs = m1 + m2; if (gs > bestv) { bestv = gs; best = g; } }
        int i1 = 0, i2 = 0; float s1 = -INFINITY, s2 = -INFINITY, w1 = 0.f, w2 = 0.f;
#pragma unroll
        for (int e = 0; e < 16; ++e) { if ((e >> 2) == best) { const float sv = sel[e];
                if (sv > s1) { s2 = s1; i2 = i1; w2 = w1; s1 = sv; i1 = e; w1 = sc[e]; } else if (sv > s2) { s2 = sv; i2 = e; w2 = sc[e]; } } }
        { const float ws = w1 + w2;
            __hip_atomic_store(TOKI + 2 * m, i1, __ATOMIC_RELAXED, __HIP_MEMORY_SCOPE_AGENT); __hip_atomic_store(TOKI + 2 * m + 1, i2, __ATOMIC_RELAXED, __HIP_MEMORY_SCOPE_AGENT);
            __hip_atomic_store(TOKW + 2 * m, w1 / ws, __ATOMIC_RELAXED, __HIP_MEMORY_SCOPE_AGENT); __hip_atomic_store(TOKW + 2 * m + 1, w2 / ws, __ATOMIC_RELAXED, __HIP_MEMORY_SCOPE_AGENT);
            __hip_atomic_store(TOKP + 2 * m, (int)atomicAdd(&lcnt[i1], 1u), __ATOMIC_RELAXED, __HIP_MEMORY_SCOPE_AGENT); __hip_atomic_store(TOKP + 2 * m + 1, (int)atomicAdd(&lcnt[i2], 1u), __ATOMIC_RELAXED, __HIP_MEMORY_SCOPE_AGENT); }
        } }
    __syncthreads();
    if (c.tid < NE) __hip_atomic_store((int*)(a.ws + WS_BLKCNT) + blockIdx.x * NE + c.tid, (int)lcnt[c.tid], __ATOMIC_RELAXED, __HIP_MEMORY_SCOPE_AGENT);
    __syncthreads();
    }
}

__device__ __forceinline__ void expert_convert(ArgsR a, const Ctx& c, int l, int b0) {
    if ((int)blockIdx.x < b0) return;
    float* scr = (float*)(c.lds + c.wave * 8704);
    bf16* WGU = (bf16*)(a.ws + WS_WGU); bf16* WD = (bf16*)(a.ws + WS_WD);
    constexpr int IG = (D / 64) * (FF / 32);
    constexpr int ID = (FF / 64) * (D / 32);
    const int gw0 = ((int)blockIdx.x - b0) * NWAVES + c.wave, ngw0 = ((int)gridDim.x - b0) * NWAVES;
    for (int it = gw0; it < NE * (2 * IG + ID); it += ngw0) {
        const int e = it / (2 * IG + ID); int r = it % (2 * IG + ID);
        const size_t eo = ((size_t)l * NE + e) * (size_t)D * FF;
        if (r < IG) { transpose_matrix_item(a.in[I_EG] + eo, D, FF, WGU + (size_t)e * 1024 * 1024, r, scr, c.lane, RowGU{0}, a.ws); continue; } r -= IG;
        if (r < IG) { transpose_matrix_item(a.in[I_EU] + eo, D, FF, WGU + (size_t)e * 1024 * 1024, r, scr, c.lane, RowGU{1}, a.ws); continue; } r -= IG;
        transpose_matrix_item(a.in[I_ED] + eo, FF, D, WD + (size_t)e * 1024 * 512, r, scr, c.lane, RowId(), a.ws);
    }
}

__device__ __forceinline__ void phase_perm(ArgsR a, const Ctx& c, int l) {
    const int* BLKCNT = (const int*)(a.ws + WS_BLKCNT);
    LAS3 int* pre = (LAS3 int*)c.lds;
    LAS3 int* tot = pre + 256 * NE;
    const int nb = gridDim.x;
#pragma unroll
    for (int q = 0; q < 2; ++q) { const int e = 2 * c.wave + q; int v[4]; int sum = 0;
#pragma unroll
        for (int i = 0; i < 4; ++i) { const int b = 4 * c.lane + i; v[i] = b < nb ? BLKCNT[b * NE + e] : 0; sum += v[i]; }
        int inc = sum;
#pragma unroll
        for (int o = 1; o < 64; o <<= 1) { const int t = __shfl_up(inc, o); if (c.lane >= o) inc += t; }
        int run = inc - sum;
#pragma unroll
        for (int i = 0; i < 4; ++i) { pre[(4 * c.lane + i) * NE + e] = run; run += v[i]; }
        if (c.lane == 63) tot[e] = inc; }
    __syncthreads();
    int ts[17]; { int sacc = 0;
#pragma unroll
        for (int e = 0; e < 16; ++e) { ts[e] = sacc; sacc += (tot[e] + 255) >> 8; } ts[16] = sacc; }
    if (blockIdx.x == 0 && c.tid < NE) ((int*)(a.ws + WS_TOT))[c.tid] = tot[c.tid];
    const int* TOKI = (const int*)(a.ws + WS_TOKI); const int* TOKP = (const int*)(a.ws + WS_TOKP); int* S2T = (int*)(a.ws + WS_S2T); const float* TOKW = (const float*)(a.ws + WS_TOKW);
    const bf16* XN = (const bf16*)(a.ws + WS_XN); bf16* XS = (bf16*)(a.ws + WS_XS);
    for (int as = blockIdx.x * NTHREADS + c.tid; as < 2 * T; as += gridDim.x * NTHREADS) {
        const int e = TOKI[as]; int base = 0;
#pragma unroll
        for (int j = 0; j < 16; ++j) base = (j == e) ? ts[j] : base;
        const int m = as >> 1, blk = (m % c.ngw) >> 3;
        const u32x2 sw = {(unsigned)as, __float_as_uint(TOKW[as])};
        *(u32x2*)(S2T + 2 * (base * 256 + pre[blk * NE + e] + TOKP[as])) = sw;
    }
    for (int e = 0; e < 16; ++e) {
        int tse = 0, tsn = 0;
#pragma unroll
        for (int j = 0; j < 16; ++j) { tse = (j == e) ? ts[j] : tse; tsn = (j == e) ? ts[j + 1] : tsn; }
        const int lo = tse * 256 + tot[e], hi = tsn * 256;
        for (int sl = lo + blockIdx.x * NTHREADS + c.tid; sl < hi; sl += gridDim.x * NTHREADS) S2T[2 * sl] = -1;
    }
    __syncthreads();
}

__device__ __forceinline__ void phase_ln2(ArgsR a, const Ctx& c, int l, float* outw) {
    const float* MODF = (const float*)(a.ws + WS_MODF) + l * 6144;
    const float* g2 = a.in[I_LN2G] + l * D; const float* b2 = a.in[I_LN2B] + l * D;
    const bf16* Y = (const bf16*)(a.ws + WS_Y); bf16* XN = (bf16*)(a.ws + WS_XN);
    const bf16* x1b = (const bf16*)a.out;
    const int lc = 8 * c.lane;
    u32x4 xrn[2], y0n[2], y1n[2];
#define LN2_FETCH(mm) do { _Pragma("unroll") for (int j = 0; j < 2; ++j) { xrn[j] = *(const u32x4*)(x1b + (size_t)(mm) * 2 * D + lc + 512 * j); \
        y0n[j] = *(const u32x4*)(Y + (size_t)(2 * (mm)) * D + lc + 512 * j); y1n[j] = *(const u32x4*)(Y + (size_t)(2 * (mm) + 1) * D + lc + 512 * j); } } while (0)
    if (c.gw < T) LN2_FETCH(c.gw);
    const __amdgpu_buffer_rsrc_t rso = wt_rsrc(outw, (unsigned)T * D * 4u);
    for (int m = c.gw; m < T; m += c.ngw) {
        u32x4 xr[2], y0[2], y1[2];
#pragma unroll
        for (int j = 0; j < 2; ++j) { xr[j] = xrn[j]; y0[j] = y0n[j]; y1[j] = y1n[j]; }
        if (m + c.ngw < T) LN2_FETCH(m + c.ngw);
        float v[16];
#pragma unroll
        for (int j = 0; j < 2; ++j) { const int col = lc + 512 * j; const f32x4 gt0 = *(const f32x4*)(MODF + 5120 + col), gt1 = *(const f32x4*)(MODF + 5120 + col + 4);
#pragma unroll
            for (int e = 0; e < 4; ++e) { const float gl = e < 2 ? gt0[2 * e] : gt1[2 * e - 4], gh = e < 2 ? gt0[2 * e + 1] : gt1[2 * e - 3];
                const float xl = __uint_as_float(xr[j][e] << 16), xh = __uint_as_float(xr[j][e] & 0xffff0000u);
                const float al = __uint_as_float(y0[j][e] << 16) + __uint_as_float(y1[j][e] << 16), ah = __uint_as_float(y0[j][e] & 0xffff0000u) + __uint_as_float(y1[j][e] & 0xffff0000u);
                v[8 * j + 2 * e] = ALPHA * xl + (1.0f + gl) * al; v[8 * j + 2 * e + 1] = ALPHA * xh + (1.0f + gh) * ah; } }
        float mean, rstd; row_stats(v, mean, rstd);
#pragma unroll
        for (int j = 0; j < 2; ++j) { const int col = lc + 512 * j; float o[8];
            const f32x4 ga = *(const f32x4*)(g2 + col), gb = *(const f32x4*)(g2 + col + 4), ba = *(const f32x4*)(b2 + col), bb = *(const f32x4*)(b2 + col + 4);
#pragma unroll
            for (int e = 0; e < 8; ++e) { v[8 * j + e] = (v[8 * j + e] - mean) * rstd * (e < 4 ? ga[e & 3] : gb[e & 3]) + (e < 4 ? ba[e & 3] : bb[e & 3]); o[e] = v[8 * j + e]; }
            if (l + 1 < DEPTH) __builtin_amdgcn_raw_buffer_store_b128(pack8bf(o), rso, (unsigned)(((size_t)m * 2 * D + col) * 2), 0, 16);
            else { *(f32x4*)(outw + (size_t)m * D + col) = (f32x4){o[0], o[1], o[2], o[3]}; *(f32x4*)(outw + (size_t)m * D + col + 4) = (f32x4){o[4], o[5], o[6], o[7]}; } }
        if (l + 1 < DEPTH) {
            const float* MN = MODF + 6144;
            row_stats(v, mean, rstd);
#pragma unroll
            for (int j = 0; j < 2; ++j) { const int col = lc + 512 * j; float o[8];
                const f32x4 sa = *(const f32x4*)(MN + 1024 + col), sb = *(const f32x4*)(MN + 1024 + col + 4), ha = *(const f32x4*)(MN + col), hb = *(const f32x4*)(MN + col + 4);
#pragma unroll
                for (int e = 0; e < 8; ++e) o[e] = (v[8 * j + e] - mean) * rstd * (1.0f + (e < 4 ? sa[e & 3] : sb[e & 3])) + (e < 4 ? ha[e & 3] : hb[e & 3]);
                store16_wt(a.ws, XN + (size_t)m * D + col, pack8bf(o)); }
        }
    }
#undef LN2_FETCH
}

template <class F> struct EpiAdapt {
    static constexpr bool PERM = true, AFTER_DRAIN = false, MIDK = false; F f;
    __device__ __forceinline__ void operator()(const f32x4 (&acc)[2][2][4][2], const Unit& u, int wr, int wc, int fr, int fq) const {
        const int col = u.pn * 256 + wc * 32 + 8 * fq;
#pragma unroll
        for (int ai = 0; ai < 2; ++ai)
#pragma unroll
            for (int m = 0; m < 4; ++m) { const int row = u.pm * 256 + ai * 128 + wr * 64 + m * 16 + fr; f(row, col, acc[ai][0][m][0], acc[ai][0][m][1], acc[ai][1][m][0], acc[ai][1][m][1]); }
    }
};

struct EpiG2 { static constexpr bool PERM = true, AFTER_DRAIN = false, MIDK = true; const bf16* ZG; bf16* MP;
    __device__ __forceinline__ void midk(f32x4 (&acc)[2][2][4][2], const Unit& u, int wr, int wc, int fr, int fq) const {
        const int col = u.pn * 256 + wc * 32 + 8 * fq;
#pragma unroll
        for (int ai = 0; ai < 2; ++ai)
#pragma unroll
            for (int m = 0; m < 4; ++m) { const int row = u.pm * 256 + ai * 128 + wr * 64 + m * 16 + fr;
#pragma unroll
                for (int bj = 0; bj < 2; ++bj) { store8bf(MP + (size_t)row * D + col + bj * 128, acc[ai][bj][m][0], acc[ai][bj][m][1]);
                    acc[ai][bj][m][0] = (f32x4){0.f, 0.f, 0.f, 0.f}; acc[ai][bj][m][1] = (f32x4){0.f, 0.f, 0.f, 0.f}; } }
    }
    __device__ __forceinline__ void operator()(const f32x4 (&acc)[2][2][4][2], const Unit& u, int wr, int wc, int fr, int fq) const {
        const int col = u.pn * 256 + wc * 32 + 8 * fq;
#pragma unroll
        for (int ai = 0; ai < 2; ++ai)
#pragma unroll
            for (int m = 0; m < 4; ++m) { const int row = u.pm * 256 + ai * 128 + wr * 64 + m * 16 + fr;
#pragma unroll
                for (int bj = 0; bj < 2; ++bj) { int off = row * D + col + bj * 128; asm volatile("" : "+v"(off));
                    f32x4 p0, p1, a0, a1, b0, b1; load8bf(MP + off, p0, p1); load8bf(ZG + (size_t)row * 2048 + col + bj * 128, a0, a1); load8bf(ZG + (size_t)row * 2048 + 1024 + col + bj * 128, b0, b1);
                    store8bf_wt(wt_rsrc(MP, T * D * 2), (unsigned)off * 2u, a0 * p0 + b0 * acc[ai][bj][m][0], a1 * p1 + b1 * acc[ai][bj][m][1]); } }
    }
};
struct EpiZ2 { static constexpr bool PERM = true, AFTER_DRAIN = false, MIDK = false; bf16 *ZR, *ZS, *ZG;
    __device__ __forceinline__ void operator()(const f32x4 (&acc)[2][2][4][2], const Unit& u, int wr, int wc, int fr, int fq) const {
        const int col = u.pn * 256 + wc * 32 + 8 * fq;
        if (u.pn < RC / 256) {
#pragma unroll
            for (int ai = 0; ai < 2; ++ai)
#pragma unroll
                for (int m = 0; m < 4; ++m) { const int row = u.pm * 256 + ai * 128 + wr * 64 + m * 16 + fr;
                    const __amdgpu_buffer_rsrc_t rz = wt_rsrc(ZR, T * RC * 2); store8bf_wt(rz, (unsigned)((row * RC + col) * 2), acc[ai][0][m][0], acc[ai][0][m][1]); store8bf_wt(rz, (unsigned)((row * RC + col + 128) * 2), acc[ai][1][m][0], acc[ai][1][m][1]); }
        } else {
            const bool gel = u.pn < (RC + 1024) / 256;
            const float c1 = gel ? -1.5957691216f * 1.44269504f : -1.44269504f, c3 = gel ? -0.0713548163f * 1.44269504f : 0.f, ca = gel ? 1.f : 0.f, cb = gel ? 0.f : 1.f;
            bf16* dst = gel ? ZS : ZG; const int ld = gel ? 1024 : 2048, c0 = col - (gel ? RC : RC + 1024);
#pragma unroll
            for (int ai = 0; ai < 2; ++ai)
#pragma unroll
                for (int m = 0; m < 4; ++m) { const int row = u.pm * 256 + ai * 128 + wr * 64 + m * 16 + fr;
#pragma unroll
                    for (int bj = 0; bj < 2; ++bj) { f32x4 lo = acc[ai][bj][m][0], hi = acc[ai][bj][m][1];
#pragma unroll
                        for (int e = 0; e < 4; ++e) { const float x = lo[e], y = hi[e];
                            lo[e] = (ca * x + cb) * __builtin_amdgcn_rcpf(1.0f + __builtin_amdgcn_exp2f(x * (c1 + c3 * x * x)));
                            hi[e] = (ca * y + cb) * __builtin_amdgcn_rcpf(1.0f + __builtin_amdgcn_exp2f(y * (c1 + c3 * y * y))); }
                        store8bf_wt(wt_rsrc(dst, (unsigned)T * (unsigned)ld * 2u), (unsigned)((row * ld + c0 + bj * 128) * 2), lo, hi); } }
        }
    }
};
template <class Sched, class F>
__device__ __forceinline__ void gemm_gather(const Ctx& c, const bf16* A, const int* s2t, const bf16* Bt, int M, int N, int K, const Sched& S, const F& f) {
    pg8::Gemm g{A, Bt, M, N, K}; EpiAdapt<F> E{f};
    pg8::gemm_phase<EpiAdapt<F>, Sched, true, true, true>((PG8_LAS unsigned char*)c.lds, g, S, E, c.tid, s2t);
}
template <class Sched, class F>
__device__ __forceinline__ void gemm_any(const Ctx& c, const bf16* A, const bf16* Bt, int M, int N, int K, const Sched& S, const F& f) {
    pg8::Gemm g{A, Bt, M, N, K}; EpiAdapt<F> E{f};
    pg8::gemm_phase<EpiAdapt<F>, Sched, true, true>((PG8_LAS unsigned char*)c.lds, g, S, E, c.tid);
}

#define LAS __attribute__((address_space(3)))
#define XB_TMO      128
#define XB_XCNT(j)  (256  + 64 * (j))
#define XB_XSUB(j)  (1280 + 64 * (j))
#define XB_XGEN(j)  (2304 + 64 * (j))
#define XB_TOP      3328
#define XB_TOPGEN   3392
#define XCD_BAR_WORDS 3456
#define XB_SPIN_CAP (1u << 24)

__device__ __forceinline__ unsigned xb_ld(unsigned* p)              { return __hip_atomic_load(p, __ATOMIC_RELAXED, __HIP_MEMORY_SCOPE_AGENT); }
__device__ __forceinline__ unsigned xb_add(unsigned* p, unsigned v) { return __hip_atomic_fetch_add(p, v, __ATOMIC_RELAXED, __HIP_MEMORY_SCOPE_AGENT); }
__device__ __forceinline__ unsigned xb_xcc_id() { return (unsigned)__builtin_amdgcn_s_getreg((3 << 11) | 20) & 0xFu; }
#define XB_SPIN(cond, bar) do { unsigned _sp = 0; while (cond) { __builtin_amdgcn_s_sleep(2); \
    if ((++_sp & 255u) == 0u) { if (xb_ld(&(bar)[XB_TMO])) break; if (_sp > XB_SPIN_CAP) { atomicAdd(&(bar)[XB_TMO], 1u); break; } } } } while (0)

struct XcdBarrier {
    unsigned* bar; unsigned x;
    volatile LAS unsigned* st;
};

__device__ __forceinline__ XcdBarrier xcd_barrier_post(unsigned* bar, volatile LAS unsigned* st) {
    XcdBarrier b; b.bar = bar; b.x = xb_xcc_id(); b.st = st;
    if (threadIdx.x == 0) (void)xb_add(&bar[XB_XCNT(b.x)], 1u);
    return b;
}
__device__ __forceinline__ void xcd_barrier_complete(unsigned* bar, unsigned x, unsigned& nloc, unsigned& nx) {
    const unsigned G = gridDim.x * gridDim.y * gridDim.z;
    unsigned sum, cnt, mine, sp = 0u;
    for (;;) {
        sum = 0u; cnt = 0u; mine = 0u;
#pragma unroll
        for (unsigned j = 0; j < 16; ++j) { const unsigned c = xb_ld(&bar[XB_XCNT(j)]); sum += c; cnt += (c > 0u) ? 1u : 0u; mine = (j == x) ? c : mine; }
        if (sum == G) break;
        __builtin_amdgcn_s_sleep(1);
        if ((++sp & 255u) == 0u) { if (xb_ld(&bar[XB_TMO])) break; if (sp > XB_SPIN_CAP) { atomicAdd(&bar[XB_TMO], 1u); break; } }
    }
    nloc = mine > 0u ? mine : 1u; nx = cnt > 0u ? cnt : 1u;
}

__device__ __attribute__((noinline)) void xcd_barrier(const XcdBarrier b, const bool wb = true) {
    asm volatile("s_waitcnt vmcnt(0)" ::: "memory");
    __syncthreads();
    if (threadIdx.x == 0) {
        unsigned* bar = b.bar;
        __builtin_amdgcn_s_waitcnt(0);
        __builtin_amdgcn_fence(__ATOMIC_ACQUIRE, "agent");
        unsigned nloc = b.st[0], nx = b.st[1];
        if (nloc == 0u) { xcd_barrier_complete(bar, b.x, nloc, nx); b.st[0] = nloc; b.st[1] = nx; }
        const unsigned old = xb_add(&bar[XB_XSUB(b.x)], 1u);
        const unsigned gen = old / nloc;
        if (old + 1u == (gen + 1u) * nloc) {
            if (wb) __builtin_amdgcn_fence(__ATOMIC_RELEASE, "agent");
            asm volatile("s_waitcnt vmcnt(0)" ::: "memory");
            const unsigned og = xb_add(&bar[XB_TOP], 1u);
            const unsigned tg = og / nx;
            if (og + 1u == (tg + 1u) * nx) {
#pragma unroll
                for (unsigned j = 0; j < 16; ++j) (void)xb_add(&bar[XB_XGEN(j)], 1u);
            } else XB_SPIN(xb_ld(&bar[XB_XGEN(b.x)]) == gen, bar);
            asm volatile("s_waitcnt vmcnt(0)" ::: "memory");
        } else {
            XB_SPIN(xb_ld(&bar[XB_XGEN(b.x)]) == gen, bar);
            asm volatile("s_waitcnt vmcnt(0)" ::: "memory");
        }
    }
    __syncthreads();
}


constexpr int PH_PER_LAYER = 12, N_PHASES = 2 + PH_PER_LAYER * DEPTH;
constexpr int CW_BAR = 4096;
constexpr int CW_RDY = 65536;
constexpr int LDS_BYTES = 147456, LDSCTL_OFF = 131072 + 8192;
#ifndef SINGLE_LAUNCH
#define SINGLE_LAUNCH 1
#endif

#ifndef PROBE_A
#define PROBE_A -1
#endif
#ifndef PROBE_B
#define PROBE_B -1
#endif
constexpr size_t WS_TS = 512 * 1024;
#if PROBE_A >= 0
#define STAMP(i) do { if (blockIdx.x == 0 && threadIdx.x == 0) ((unsigned long long*)(args_here()->ws + WS_TS))[(i)] = __builtin_amdgcn_s_memrealtime(); } while (0)
#else
#define STAMP(i) do { } while (0)
#endif
__device__ __forceinline__ const __attribute__((address_space(4))) Args* args_here() { const __attribute__((address_space(4))) Args* p = (const __attribute__((address_space(4))) Args*)__builtin_amdgcn_kernarg_segment_ptr(); asm volatile("" : "+s"(p)); return p; }
#ifndef REP_K
#define REP_K -1
#endif
__device__ __forceinline__ Ctx mkctx(int wave_s, unsigned char* lds) { Ctx c; c.wave = wave_s; c.lane = (int)__builtin_amdgcn_mbcnt_hi(~0u, __builtin_amdgcn_mbcnt_lo(~0u, 0u)); c.tid = wave_s * 64 + c.lane;
    c.gw = blockIdx.x * NWAVES + wave_s; c.ngw = gridDim.x * NWAVES; c.lds = lds; return c; }
#define PHASE1(k, ...) do { const __attribute__((address_space(4))) Args* ap_ = args_here(); if (ap_->ph_lo <= (k) && (k) < ap_->ph_hi) { ArgsR a = *ap_; const Ctx c = mkctx(wave_s, lds); __VA_ARGS__ } } while (0)
#define PHASE(k, ...) do { PHASE1(k, __VA_ARGS__); if ((k) == REP_K) { xcd_barrier(bar); PHASE1(k, __VA_ARGS__); xcd_barrier(bar); PHASE1(k, __VA_ARGS__); } } while (0)

template <int L>
__device__ __forceinline__ void run_layer(const int wave_s, unsigned char* lds, const XcdBarrier& bar) {
    const int G = gridDim.x, b = blockIdx.x;
#define BAR() do { xcd_barrier(bar); STAMP(3 + 14 * L + (bk_++)); } while (0)
#define BARN() do { xcd_barrier(bar, false); STAMP(3 + 14 * L + (bk_++)); } while (0)
    int bk_ = 0;
    PHASE(0, unsigned char* ws = a.ws; pg8::StaticOrder S; S.init(T, INC, G, b); EpiZ2 E{(bf16*)(ws + WS_ZR), (bf16*)(ws + WS_ZS), (bf16*)(ws + WS_ZG)};
        { pg8::Gemm g{(const bf16*)(ws + WS_XN), (const bf16*)(ws + WS_WIN + (size_t)L * 10 * MiB), T, INC, D}; pg8::gemm_phase<EpiZ2, pg8::StaticOrder, true, true>((PG8_LAS unsigned char*)c.lds, g, S, E, c.tid); } );
    BARN();
    PHASE(1, phase_prep_fast(a, c, L); );
    if (G == T / 64) { asm volatile("s_waitcnt vmcnt(0)" ::: "memory"); __syncthreads();
        if (threadIdx.x == 0) { __builtin_amdgcn_fence(__ATOMIC_ACQUIRE, "agent"); asm volatile("s_waitcnt vmcnt(0)" ::: "memory"); }
        __syncthreads(); }
    else BAR();
#if REP_K == 21
    PHASE1(2, phase_scan1m<SGX>(a, c); ); xcd_barrier(bar); PHASE1(2, phase_scan1m<SGX>(a, c); ); xcd_barrier(bar);
#endif
    PHASE(2, phase_scan1m<0>(a, c); );
    BAR();
    PHASE(3, phase_scan2a(a, c); );
#if REP_K == 140
    PHASE1(14, phase_sg_chunk<SGX>(a, c, L); ); xcd_barrier(bar); PHASE1(14, phase_sg_chunk<SGX>(a, c, L); ); xcd_barrier(bar);
#endif
#if REP_K == 141
    { const int nrep_ = args_here()->ph_hi > 500 ? 2 : 1;
#pragma unroll 1
      for (int r_ = 0; r_ < nrep_; ++r_) { PHASE1(14, phase_sg_chunk<0>(a, c, L); ); xcd_barrier(bar); } }
#endif
    PHASE(14, phase_sg_chunk<0>(a, c, L); );
    BAR();
    PHASE(31, phase_scan2b(a, c); );
    PHASE(33, expert_convert(a, c, L, NH); );
    BAR();
#if REP_K == 40
    PHASE1(4, phase_scan3m<SGX>(a, c, L); ); xcd_barrier(bar); PHASE1(4, phase_scan3m<SGX>(a, c, L); ); xcd_barrier(bar);
#endif
    PHASE(4, phase_scan3m<0>(a, c, L); );
    BAR();
    PHASE(6, unsigned char* ws = a.ws; pg8::StaticOrder S; S.init(T, D, G, b); EpiG2 E{(const bf16*)(ws + WS_ZG), (bf16*)(ws + WS_MP)};
        { pg8::Gemm g{(const bf16*)(ws + WS_YAB), (const bf16*)(ws + WS_WA + (size_t)L * WS_WL1), T, D, D}; pg8::gemm_phase<EpiG2, pg8::StaticOrder, true, true>((PG8_LAS unsigned char*)c.lds, g, S, E, c.tid); } );
    BARN();
#if REP_K == 8
    PHASE1(8, unsigned char* ws = a.ws; pg8::StaticOrder S; S.init(T, D, G, b); EpiOut E{(bf16*)(ws + WS_R), (const float*)(ws + WS_MODF) + L * 6144 + 2048};
        gemm_any(c, (const bf16*)(ws + WS_MP), (const bf16*)(ws + WS_WO + (size_t)L * WS_WL1), T, D, D, S, E); ); xcd_barrier(bar);
    PHASE1(8, unsigned char* ws = a.ws; pg8::StaticOrder S; S.init(T, D, G, b); EpiOut E{(bf16*)(ws + WS_R), (const float*)(ws + WS_MODF) + L * 6144 + 2048};
        gemm_any(c, (const bf16*)(ws + WS_MP), (const bf16*)(ws + WS_WO + (size_t)L * WS_WL1), T, D, D, S, E); ); xcd_barrier(bar);
#endif
    PHASE1(8, unsigned char* ws = a.ws; pg8::StaticOrder S; S.init(T, D, G, b); EpiOut E{(bf16*)(ws + WS_TMP), (const float*)(ws + WS_MODF) + L * 6144 + 2048};
        gemm_any(c, (const bf16*)(ws + WS_MP), (const bf16*)(ws + WS_WO + (size_t)L * WS_WL1), T, D, D, S, E); );
    BARN();
#if REP_K == 9
    PHASE1(9, phase_ln1(a, c, L, (float*)(a.ws + WS_ZG), SGX == 0 ? 3 : (1 | (4 << (SGX - 1)))); ); xcd_barrier(bar); PHASE1(9, phase_ln1(a, c, L, (float*)(a.ws + WS_ZG), SGX == 0 ? 3 : (1 | (4 << (SGX - 1)))); ); xcd_barrier(bar);
#endif
#if REP_K == 91
    PHASE1(9, phase_ln1(a, c, L, (float*)(a.ws + WS_ZR), 1); ); xcd_barrier(bar); PHASE1(9, phase_ln1(a, c, L, (float*)(a.ws + WS_ZR), 1); ); xcd_barrier(bar);
#endif
#if REP_K == 92
    PHASE1(9, phase_ln1(a, c, L, (float*)(a.ws + WS_ZR), 2); ); xcd_barrier(bar); PHASE1(9, phase_ln1(a, c, L, (float*)(a.ws + WS_ZR), 2); ); xcd_barrier(bar);
#endif
    PHASE1(9, phase_ln1(a, c, L, a.out); );
    BARN();
    PHASE(10, phase_perm(a, c, L); );
    BAR();
    PHASE(11, unsigned char* ws = a.ws; MoeSchedA S; S.init((const unsigned*)(ws + WS_TOT), G, b); EpiSwi E{(bf16*)(ws + WS_HID)};
        gemm_gather(c, (const bf16*)(ws + WS_XN), (const int*)(ws + WS_S2T), (const bf16*)(ws + WS_WGU), MAXSLOT, NE * 1024, D, S, E); );
    BARN();
    PHASE(12, unsigned char* ws = a.ws; unsigned* rdy = (unsigned*)(ws + WS_CTL) + CW_RDY + L * 16384;
        { MoeSchedT S; S.init((const unsigned*)(ws + WS_TOT), G, b); S.rdy = rdy; EpiSwiWT E{(bf16*)(ws + WS_HID)};
          gemm_gather(c, (const bf16*)(ws + WS_XN), (const int*)(ws + WS_S2T), (const bf16*)(ws + WS_WGU), MAXSLOT, NE * 1024, D, S, E); }
        { MoeSchedB S; S.init((const unsigned*)(ws + WS_TOT), G, b); S.rdy = rdy; S.tmo = (unsigned*)(ws + WS_CTL) + CW_BAR + XB_TMO; S.wave = c.wave;
          EpiDown E{(const int*)(ws + WS_S2T), (const float*)(ws + WS_TOKW), (bf16*)(ws + WS_Y)};
          gemm_any(c, (const bf16*)(ws + WS_HID), (const bf16*)(ws + WS_WD), MAXSLOT, NE * 1024, FF, S, E); } );
    BARN();
#if REP_K == 13
    PHASE1(13, phase_ln2(a, c, L, (float*)(a.ws + WS_R)); ); xcd_barrier(bar); PHASE1(13, phase_ln2(a, c, L, (float*)(a.ws + WS_R)); ); xcd_barrier(bar);
#endif
    PHASE1(13, phase_ln2(a, c, L, a.out); );
    if (L + 1 < DEPTH) BARN();
    (void)bk_;
#undef BAR
}

__global__ void __launch_bounds__(NTHREADS, 2) mk_fwd(Args a_unused) {
    extern __shared__ __attribute__((aligned(16))) unsigned char lds[];
    const int wave_s = __builtin_amdgcn_readfirstlane(threadIdx.x >> 6);
    for (int u = threadIdx.x; u < (LDS_BYTES - LDSCTL_OFF) / 4; u += NTHREADS) ((LAS unsigned*)((LAS unsigned char*)lds + LDSCTL_OFF))[u] = 0u;
    __syncthreads();
    const XcdBarrier bar = xcd_barrier_post((unsigned*)(args_here()->ws + WS_CTL) + CW_BAR, (volatile LAS unsigned*)((LAS unsigned char*)lds + LDSCTL_OFF) + 8);
    STAMP(0);
    PHASE(100, phase_p0a(a, c); );
    xcd_barrier(bar); STAMP(1);
    PHASE(101, phase_p0b(a, c); );
    xcd_barrier(bar); STAMP(2);
    run_layer<0>(wave_s, lds, bar);
    run_layer<1>(wave_s, lds, bar);
#if PROBE_A >= 0
    if (blockIdx.x == 0) {
        asm volatile("s_waitcnt vmcnt(0)" ::: "memory"); __syncthreads();
        if (threadIdx.x == 0) ((unsigned long long*)(args_here()->ws + WS_TS))[30] = __builtin_amdgcn_s_memrealtime();
        asm volatile("s_waitcnt vmcnt(0)" ::: "memory"); __syncthreads();
        const volatile unsigned long long* ts = (const volatile unsigned long long*)(args_here()->ws + WS_TS);
        float da = 0.f, db = 0.f;
        if (PROBE_A < 14) { da = (float)(ts[3 + PROBE_A] - ts[2 + PROBE_A]) + (float)(ts[17 + PROBE_A] - ts[16 + PROBE_A]); } else if (PROBE_A == 14) da = (float)(ts[1] - ts[0]); else if (PROBE_A == 15) da = (float)(ts[2] - ts[1]); else da = (float)(ts[30] - ts[0]);
        if (PROBE_B >= 0 && PROBE_B < 14) { db = (float)(ts[3 + PROBE_B] - ts[2 + PROBE_B]) + (float)(ts[17 + PROBE_B] - ts[16 + PROBE_B]); } else if (PROBE_B == 14) db = (float)(ts[1] - ts[0]); else if (PROBE_B == 15) db = (float)(ts[2] - ts[1]);
        da *= 0.01f; db *= 0.01f;
        da = exp2f(0.25f * rintf(4.0f * log2f(fmaxf(da, 0.5f)))); db = exp2f(0.25f * rintf(4.0f * log2f(fmaxf(db, 0.5f))));
        float* out = args_here()->out;
        for (int i = threadIdx.x; i < 16 * 1024; i += NTHREADS) { const int r = i >> 10, col = i & 1023; const int rowi = (r & 7) + 2048 * (r >> 3); out[(size_t)rowi * D + col] = da; }
        if (threadIdx.x == 0 && PROBE_B >= 0) out[(size_t)4096 * D] = 100.0f * db;
    }
#endif
}

extern "C" void kernel_launch(void* const* d_in, const int* in_sizes, int n_in, void* d_out, int out_size, void* d_ws, size_t ws_size, hipStream_t stream) {
    static int grid = 0;
    if (grid == 0) {
        if (n_in != N_IN || out_size != T * D || ws_size < WS_END2) { fprintf(stderr, "kernel_launch: unexpected shapes: n_in %d out %d ws %zu (need %zu)\n", n_in, out_size, ws_size, (size_t)WS_END2); grid = -1; return; }
        int dev = 0, cus = 0;
        (void)hipGetDevice(&dev); (void)hipDeviceGetAttribute(&cus, hipDeviceAttributeMultiprocessorCount, dev);
        if (hipFuncSetAttribute((const void*)mk_fwd, hipFuncAttributeMaxDynamicSharedMemorySize, LDS_BYTES) != hipSuccess) { fprintf(stderr, "kernel_launch: hipFuncSetAttribute failed\n"); grid = -1; return; }
        if (cus > 0 && cus < 256) { fprintf(stderr, "kernel_launch: %d CUs (the LN1 routing batch is sized for a grid of at least 256 workgroups)\n", cus); grid = -1; return; }
        grid = cus > 0 ? (cus & ~3) : 256;
        fprintf(stderr, "kernel_launch: ws_size %zu grid %d\n", ws_size, grid);
    }
    if (grid < 0) return;
    (void)hipMemsetAsync((char*)d_ws + WS_CTL, 0, CTL_BYTES, stream);
    Args a{};
    for (int i = 0; i < N_IN; ++i) a.in[i] = (const float*)d_in[i];
    a.out = (float*)d_out; a.ws = (unsigned char*)d_ws;
    a.ph_lo = 0; a.ph_hi = 1000;
    hipLaunchKernelGGL(mk_fwd, dim3(grid), dim3(NTHREADS), LDS_BYTES, stream, a);
}
```
